# Optimizing an MI355X kernel written in HIP

```python
import math
import jax
import jax.numpy as jnp
from jax import lax
import numpy as np

D_MODEL = 1024
BATCH = 16
SEQ = 2048
DEPTH = 4

GRID_W = 64
CTX_LEN = 256
HEAD_DIM = 64
ROPE_FREQS = HEAD_DIM // 4
ROPE_THETA = 10000.0
ATTN_SCALE = HEAD_DIM ** -0.5
NEG_INF = -1e30
Q_BLOCK = 128
WINDOW = 128
A_HEADS = 8
A_KV = 2
W_HEADS = 8
W_KV = 2
HY_WIDTH = 512
HY_SHORT = 3
HY_BANDS = 16
HY_EMB = 1 + 2 * HY_BANDS
HY_HIDDEN = 64
HY_TARGET = 1e-2
HY_FAST_DECAY = 0.3
HY_SLOW_DECAY = 1.5
N_BRANCH = 3
N_GROUPS = 4
EXPERTS_PER_GROUP = 4
N_EXPERTS = N_GROUPS * EXPERTS_PER_GROUP
TOP_K = 2
D_EXPERT = 512
N_MOD = 6
EPS = 1e-6
IN_SPLITS = (A_HEADS * HEAD_DIM, A_KV * HEAD_DIM, A_KV * HEAD_DIM, 3 * HY_WIDTH,
             W_HEADS * HEAD_DIM, W_KV * HEAD_DIM, W_KV * HEAD_DIM, N_BRANCH * D_MODEL)
IN_OFFSETS = tuple(int(o) for o in np.cumsum(IN_SPLITS)[:-1])
D_IN = int(sum(IN_SPLITS))
F32 = jnp.float32

kernel_name = 'hybrid_flow_trunk'


def rms_norm(t, g):
    tf = t.astype(F32)
    return (tf * lax.rsqrt(jnp.mean(tf * tf, axis=-1, keepdims=True) + EPS) * g.astype(F32)).astype(t.dtype)


def modulate(h, shift, scale):
    return h * (1 + scale) + shift


def heads(t, n):
    return t.reshape(t.shape[:-1] + (n, HEAD_DIM))


def group_q(q, n_kv):
    b, l, h, d = q.shape
    return q.reshape(b, l, n_kv, h // n_kv, d)


def axial_rope(t, cos, sin):
    tf = t.reshape(t.shape[:-1] + (2, 2, ROPE_FREQS))
    a, b = tf[..., 0, :], tf[..., 1, :]
    c, s = cos[:, None], sin[:, None]
    out = jnp.stack([a * c - b * s, b * c + a * s], axis=-2)
    return out.reshape(t.shape).astype(t.dtype)


def gqa_attend(q, k, v, sink=None, mask=None):
    s = jnp.einsum('bqkgd,bskd->bkgqs', q, k).astype(F32) * ATTN_SCALE
    if mask is not None:
        s = jnp.where(mask, s, NEG_INF)
    if sink is not None:
        sk = jnp.broadcast_to(sink.astype(F32)[:, :, None, None], s.shape[:-1] + (1,))
        p = jax.nn.softmax(jnp.concatenate([s, sk], axis=-1), axis=-1)[..., :-1]
    else:
        p = jax.nn.softmax(s, axis=-1)
    return jnp.einsum('bkgqs,bskd->bqkgd', p.astype(v.dtype), v)


def to_blocks(q, n_kv):
    b, s, h, d = q.shape
    return jnp.moveaxis(q.reshape(b, s // Q_BLOCK, Q_BLOCK, n_kv, h // n_kv, d), 1, 0)


def from_blocks(o):
    nb, b, qb, kv, g, d = o.shape
    return jnp.moveaxis(o, 0, 1).reshape(b, nb * qb, kv * g * d)


def band_blocks(t):
    b, s, kv, d = t.shape
    tp = jnp.pad(t, ((0, 0), (Q_BLOCK, Q_BLOCK), (0, 0), (0, 0))).reshape(b, s // Q_BLOCK + 2, Q_BLOCK, kv, d)
    band = jnp.concatenate([tp[:, :-2], tp[:, 1:-1], tp[:, 2:]], axis=2)
    return jnp.moveaxis(band, 1, 0)


def hyena_kernel(n, w1, b1, freq, w2, b2, w3):
    pos = jnp.arange(n, dtype=F32)[:, None]
    t = pos / (n - 1)
    bands = jnp.linspace(1e-4, HY_BANDS - 1, HY_BANDS, dtype=F32)
    ang = 2 * math.pi * bands * pos / n
    z = jnp.concatenate([t, jnp.cos(ang), -jnp.sin(ang)], axis=-1)
    h = jnp.sin(freq * (z @ w1 + b1))
    h = jnp.sin(freq * (h @ w2 + b2))
    h = (h @ w3).astype(F32).reshape(n, 2, HY_WIDTH)
    deltas = jnp.abs(jnp.linspace(math.log(HY_TARGET) / HY_SLOW_DECAY, math.log(HY_TARGET) / HY_FAST_DECAY,
                                  HY_WIDTH, dtype=F32))
    h = h * jnp.exp(-t * deltas)[:, None, :]
    kern = jnp.concatenate([h[:, 0], jnp.zeros((1, HY_WIDTH), F32), h[:0:-1, 1]], axis=0)
    return kern / jnp.sum(jnp.abs(kern), axis=0, keepdims=True)


def bidir_long_conv(u, kern):
    n = u.shape[1]
    uf = jnp.fft.rfft(u.astype(F32), n=2 * n, axis=1)
    kf = jnp.fft.rfft(kern, n=2 * n, axis=0)
    return jnp.fft.irfft(uf * kf[None], n=2 * n, axis=1)[:, :n]


def hyena_mixer(u, short_w, short_b, kern, skip):
    uc = lax.conv_general_dilated(u, short_w[:, None, :], (1,), ((HY_SHORT // 2, HY_SHORT // 2),),
                                  dimension_numbers=('NWC', 'WIO', 'NWC'),
                                  feature_group_count=u.shape[-1]) + short_b
    x0, x1, v = jnp.split(uc.astype(F32), 3, axis=-1)
    v = v * x1
    y = bidir_long_conv(v, kern) + skip.astype(F32) * v
    return (x0 * y).astype(u.dtype)


def merge_branches(ya, yh, yw, gate_logits, w_branch, w_out):
    ga, gh, gw = jnp.split(jax.nn.sigmoid(gate_logits), N_BRANCH, axis=-1)
    m = ga * (ya @ w_branch[0]) + gh * (yh @ w_branch[1]) + gw * (yw @ w_branch[2])
    return m @ w_out


def hier_moe(t, rg_w, rg_b, re_w, re_b, w1, w3, w2):
    n = t.shape[0]
    lg = (t @ rg_w + rg_b).astype(F32)
    g_sel = jnp.argmax(lg, axis=-1)
    p_g = jnp.take_along_axis(jax.nn.softmax(lg, axis=-1), g_sel[:, None], axis=-1)
    le = (t @ re_w + re_b).astype(F32).reshape(n, N_GROUPS, EXPERTS_PER_GROUP)
    le_sel = jnp.take_along_axis(le, g_sel[:, None, None], axis=1)[:, 0]
    top_v, top_i = lax.top_k(le_sel, TOP_K)
    p_e = jax.nn.softmax(top_v, axis=-1) * p_g
    eid = g_sel[:, None] * EXPERTS_PER_GROUP + top_i
    combine = jnp.sum(jax.nn.one_hot(eid, N_EXPERTS, dtype=F32) * p_e[..., None], axis=1).astype(t.dtype)
    out = jnp.zeros_like(t)
    for e in range(N_EXPERTS):
        h = jax.nn.silu(t @ w1[e]) * (t @ w3[e])
        out = out + combine[:, e:e + 1] * (h @ w2[e])
    return out


def trunk_layer(x, xc, c, c_ctx, cos, sin, win_mask, update_ctx,
                ada_w, ada_b, norm1_g, norm2_g, w_in, qk_g,
                hy_short_w, hy_short_b, hy_f_w1, hy_f_b1, hy_f_freq, hy_f_w2, hy_f_b2, hy_f_w3, hy_bias,
                sinks, w_branch, w_out, router_g_w, router_g_b, router_e_w, router_e_b, exp_w1, exp_w3, exp_w2):
    bsz, n_tok, _ = x.shape
    n_ctx = xc.shape[1]
    mod = jnp.split((jax.nn.silu(c) @ ada_w + ada_b)[:, None, :], N_MOD, axis=-1)
    mod_c = jnp.split(jax.nn.silu(c_ctx) @ ada_w + ada_b, N_MOD, axis=-1)

    h = modulate(rms_norm(x, norm1_g), mod[0], mod[1])
    hc = modulate(rms_norm(xc, norm1_g), mod_c[0], mod_c[1])
    qa, ka, va, uh, qw, kw, vw, gts = jnp.split(h @ w_in, IN_OFFSETS, axis=-1)
    qa_c, ka_c, va_c, uh_c, qw_c, kw_c, vw_c, gts_c = jnp.split(hc @ w_in, IN_OFFSETS, axis=-1)

    kac = rms_norm(heads(ka_c, A_KV), qk_g[1])
    vac = heads(va_c, A_KV)
    k_all = jnp.concatenate([kac, axial_rope(rms_norm(heads(ka, A_KV), qk_g[1]), cos, sin)], axis=1)
    v_all = jnp.concatenate([vac, heads(va, A_KV)], axis=1)
    qa_l = axial_rope(rms_norm(heads(qa, A_HEADS), qk_g[0]), cos, sin)
    ya = from_blocks(lax.map(lambda qb: gqa_attend(qb, k_all, v_all), to_blocks(qa_l, A_KV)))

    sink = sinks.reshape(W_KV, W_HEADS // W_KV)
    kwc = rms_norm(heads(kw_c, W_KV), qk_g[3])
    vwc = heads(vw_c, W_KV)
    kw_l = axial_rope(rms_norm(heads(kw, W_KV), qk_g[3]), cos, sin)
    qw_l = axial_rope(rms_norm(heads(qw, W_HEADS), qk_g[2]), cos, sin)

    def window_block(args):
        qb, kb, vb, mb = args
        return gqa_attend(qb, jnp.concatenate([kb, kwc], axis=1), jnp.concatenate([vb, vwc], axis=1), sink, mb)

    yw = from_blocks(lax.map(window_block, (to_blocks(qw_l, W_KV), band_blocks(kw_l),
                                            band_blocks(heads(vw, W_KV)), win_mask)))

    kern = hyena_kernel(n_tok, hy_f_w1, hy_f_b1, hy_f_freq, hy_f_w2, hy_f_b2, hy_f_w3)
    yh = hyena_mixer(uh, hy_short_w, hy_short_b, kern, hy_bias)
    x = x + mod[2] * merge_branches(ya, yh, yw, gts, w_branch, w_out)

    if update_ctx:
        ya_c = gqa_attend(group_q(rms_norm(heads(qa_c, A_HEADS), qk_g[0]), A_KV), kac, vac).reshape(bsz, n_ctx, -1)
        yw_c = gqa_attend(group_q(rms_norm(heads(qw_c, W_HEADS), qk_g[2]), W_KV), kwc, vwc, sink).reshape(bsz, n_ctx, -1)
        kern_c = hyena_kernel(n_ctx, hy_f_w1, hy_f_b1, hy_f_freq, hy_f_w2, hy_f_b2, hy_f_w3)
        yh_c = hyena_mixer(uh_c, hy_short_w, hy_short_b, kern_c, hy_bias)
        xc = xc + mod_c[2] * merge_branches(ya_c, yh_c, yw_c, gts_c, w_branch, w_out)

    tokens = modulate(rms_norm(x, norm2_g), mod[3], mod[4]).reshape(-1, D_MODEL)
    if update_ctx:
        tokens_c = modulate(rms_norm(xc, norm2_g), mod_c[3], mod_c[4]).reshape(-1, D_MODEL)
        tokens = jnp.concatenate([tokens, tokens_c], axis=0)
    f = hier_moe(tokens, router_g_w, router_g_b, router_e_w, router_e_b, exp_w1, exp_w3, exp_w2)
    n_lat = bsz * n_tok
    x = x + mod[5] * f[:n_lat].reshape(x.shape)
    if update_ctx:
        xc = xc + mod_c[5] * f[n_lat:].reshape(xc.shape)
    return x, xc


def setup_inputs(seed: int = 0) -> dict:
    key = jax.random.key(seed)
    ks = jax.random.split(key, 32)
    L, D = DEPTH, D_MODEL

    def nrm(k, shape, scale):
        return jax.random.normal(k, shape, F32) * scale

    return {
        'x': nrm(ks[0], (BATCH, SEQ, D), 1.0),
        'c': nrm(ks[1], (BATCH, D), 1.0),
        'ctx': nrm(ks[2], (BATCH, CTX_LEN, D), 1.0),
        'c_ctx': nrm(ks[3], (D,), 1.0),
        'ada_w': nrm(ks[4], (L, D, N_MOD * D), 0.5 * D ** -0.5),
        'ada_b': nrm(ks[5], (L, N_MOD * D), 0.02),
        'norm1_g': 1.0 + nrm(ks[6], (L, D), 0.05),
        'norm2_g': 1.0 + nrm(ks[7], (L, D), 0.05),
        'w_in': nrm(ks[8], (L, D, D_IN), D ** -0.5),
        'qk_g': 1.0 + nrm(ks[9], (L, 4, HEAD_DIM), 0.05),
        'hy_short_w': nrm(ks[10], (L, HY_SHORT, 3 * HY_WIDTH), HY_SHORT ** -0.5),
        'hy_short_b': nrm(ks[11], (L, 3 * HY_WIDTH), 0.02),
        'hy_f_w1': nrm(ks[12], (L, HY_EMB, HY_HIDDEN), HY_EMB ** -0.5),
        'hy_f_b1': nrm(ks[13], (L, HY_HIDDEN), 0.1),
        'hy_f_freq': 1.0 + nrm(ks[14], (L, HY_HIDDEN), 0.05),
        'hy_f_w2': nrm(ks[15], (L, HY_HIDDEN, HY_HIDDEN), HY_HIDDEN ** -0.5),
        'hy_f_b2': nrm(ks[16], (L, HY_HIDDEN), 0.1),
        'hy_f_w3': nrm(ks[17], (L, HY_HIDDEN, 2 * HY_WIDTH), HY_HIDDEN ** -0.5),
        'hy_bias': nrm(ks[18], (L, HY_WIDTH), 0.1),
        'sinks': nrm(ks[19], (L, W_HEADS), 1.0),
        'w_branch': nrm(ks[20], (L, N_BRANCH, HY_WIDTH, D), HY_WIDTH ** -0.5),
        'w_out': nrm(ks[21], (L, D, D), D ** -0.5),
        'router_g_w': nrm(ks[22], (L, D, N_GROUPS), D ** -0.5),
        'router_g_b': nrm(ks[23], (L, N_GROUPS), 0.01),
        'router_e_w': nrm(ks[24], (L, D, N_EXPERTS), D ** -0.5),
        'router_e_b': nrm(ks[25], (L, N_EXPERTS), 0.01),
        'exp_w1': nrm(ks[26], (L, N_EXPERTS, D, D_EXPERT), D ** -0.5),
        'exp_w3': nrm(ks[27], (L, N_EXPERTS, D, D_EXPERT), D ** -0.5),
        'exp_w2': nrm(ks[28], (L, N_EXPERTS, D_EXPERT, D), D_EXPERT ** -0.5),
    }


def reference(x, c, ctx, c_ctx, ada_w, ada_b, norm1_g, norm2_g, w_in, qk_g,
              hy_short_w, hy_short_b, hy_f_w1, hy_f_b1, hy_f_freq, hy_f_w2, hy_f_b2, hy_f_w3, hy_bias,
              sinks, w_branch, w_out, router_g_w, router_g_b, router_e_w, router_e_b, exp_w1, exp_w3, exp_w2):
    n_tok = x.shape[1]
    n_ctx = ctx.shape[1]
    rows = n_tok // GRID_W
    row_id = jnp.repeat(jnp.arange(rows), GRID_W)
    col_id = jnp.tile(jnp.arange(GRID_W), rows)
    inv_freq = ROPE_THETA ** (-jnp.arange(ROPE_FREQS, dtype=F32) / ROPE_FREQS)
    ang = jnp.stack([row_id[:, None] * inv_freq, col_id[:, None] * inv_freq], axis=1)
    cos, sin = jnp.cos(ang), jnp.sin(ang)
    nb = n_tok // Q_BLOCK
    blk = jnp.arange(nb)[:, None, None]
    qpos = blk * Q_BLOCK + jnp.arange(Q_BLOCK)[None, :, None]
    kpos = (blk - 1) * Q_BLOCK + jnp.arange(3 * Q_BLOCK)[None, None, :]
    band = (jnp.abs(kpos - qpos) <= WINDOW) & (kpos >= 0) & (kpos < n_tok)
    win_mask = jnp.concatenate([band, jnp.ones((nb, Q_BLOCK, n_ctx), dtype=bool)], axis=-1)

    xc = ctx
    for l in range(DEPTH):
        x, xc = trunk_layer(x, xc, c, c_ctx, cos, sin, win_mask, l < DEPTH - 1,
                            ada_w[l], ada_b[l], norm1_g[l], norm2_g[l], w_in[l], qk_g[l],
                            hy_short_w[l], hy_short_b[l], hy_f_w1[l], hy_f_b1[l], hy_f_freq[l], hy_f_w2[l],
                            hy_f_b2[l], hy_f_w3[l], hy_bias[l], sinks[l], w_branch[l], w_out[l],
                            router_g_w[l], router_g_b[l], router_e_w[l], router_e_b[l],
                            exp_w1[l], exp_w3[l], exp_w2[l])
    return x
```

```cpp
#include <hip/hip_runtime.h>
#include <cstdio>
#include <cstdint>

#define GAS __attribute__((address_space(1)))
#define LAS __attribute__((address_space(3)))
#define MK_PER_PHASE 1
namespace pg8 {
#define PG8_LAS __attribute__((address_space(3)))
typedef unsigned short bf16_t;
typedef short bf16x8 __attribute__((ext_vector_type(8)));
typedef float f32x4 __attribute__((ext_vector_type(4)));
typedef unsigned u32x4 __attribute__((ext_vector_type(4)));
constexpr int BM = 256, BK = 64, HALF = 128, HTB = HALF * BK * 2  , STAGE_BYTES = 8 * HTB, NXCD = 8, WGM = 8;

__host__ __device__ __forceinline__ int lds_byte(int r, int c) { const int st = (r >> 4) * 2 + (c >> 5), rr = r & 15, cc = c & 31, ob = rr * 64 + cc * 2; return st * 1024 + (ob ^ (((ob >> 9) & 1) << 5)); }
__host__ __device__ __forceinline__ void stage_rc(int b, int& R, int& C) { const int st = b / 1024, sb = b % 1024, swz = sb ^ (((sb >> 9) & 1) << 5); R = (st >> 1) * 16 + swz / 64; C = (st & 1) * 32 + (swz % 64) / 2; }
__host__ __device__ __forceinline__ int perm32(int rho) { const int n = rho >> 4, i = rho & 15; return 8 * (i >> 2) + 4 * n + (i & 3); }

struct Unit { int pm, pn; };
struct Gemm { const bf16_t* A; const bf16_t* Bt; int M, N, K; };

struct StaticOrder {
    int nM, nN, nwg, G, c;
    __host__ __device__ void init(int M, int N, int G_, int c_) { nM = M / BM; nN = N / BM; nwg = nM * nN; G = G_; c = c_; }
    __host__ __device__ bool next(int i, Unit& u) const {
        const long L = (long)i * G + c; if (L >= nwg) return false;
        int wgid = (int)L; { const int q = nwg / NXCD, r = nwg % NXCD, xcd = wgid % NXCD, off = wgid / NXCD; wgid = (xcd < r ? xcd * (q + 1) : r * (q + 1) + (xcd - r) * q) + off; }
        const int nig = WGM * nN, gid = wgid / nig, fm = gid * WGM, gsz = (nM - fm) < WGM ? (nM - fm) : WGM;
        u.pm = fm + ((wgid % nig) % gsz); u.pn = (wgid % nig) / gsz; return true;
    }
    __device__ __forceinline__ void a_ready(const Unit&) const {}
    __device__ __forceinline__ void done(const Unit&) const {}
};
__device__ __forceinline__ unsigned cvt_pk_bf16(float lo, float hi) { unsigned r; asm volatile("v_cvt_pk_bf16_f32 %0, %1, %2" : "=v"(r) : "v"(lo), "v"(hi)); return r; }
typedef float f32x2 __attribute__((ext_vector_type(2)));
template <class Epi, class Sched, bool ALIGN_EPI = false, bool SP2 = false>
__device__ __forceinline__ void gemm_phase(PG8_LAS unsigned char* lds, const Gemm g, const Sched& S, const Epi& E) {
    int tid_ = threadIdx.x; asm volatile("" : "+v"(tid_));
    const int tid = tid_, wid = __builtin_amdgcn_readfirstlane(tid >> 6), lane = tid & 63, wr = wid >> 2, wc = wid & 3, fr = lane & 15, fq = lane >> 4;
    const int K = g.K, nt = K / BK;
    unsigned voffA[2], voffB[2];
#pragma unroll
    for (int i = 0; i < 2; ++i) { int R, C; stage_rc(tid * 16 + i * 8192, R, C); const int Rb = Epi::PERM ? ((R & ~31) + perm32(R & 31)) : R;
        voffA[i] = (unsigned)(R * K + C) * 2u; voffB[i] = (unsigned)(Rb * K + C) * 2u; }
    const size_t kstep = (size_t)(BK * 2);
    const size_t hstep = (size_t)HALF * K * 2;
    const size_t tstep = 2 * hstep;
    const unsigned ldsw = (unsigned)wid * 1024u;
    const int aoff = lds_byte(wr * 64 + fr, fq * 8), boff = lds_byte(wc * 32 + fr, fq * 8);
#define PG8_SA(b, h) (((b) * 2 + (h)) * HTB)
#define PG8_SB(b, h) ((4 + (b) * 2 + (h)) * HTB)
#define PG8_STAGE(bufoff, gbase, voff) do { _Pragma("unroll") for (int _i = 0; _i < 2; ++_i) \
        __builtin_amdgcn_global_load_lds((const unsigned*)((const char*)(gbase) + (voff)[_i]), (PG8_LAS unsigned*)(lds + (bufoff) + ldsw + _i * 8192), 16, 0, 0); } while (0)
#define PG8_LDA(dst, b, h) do { _Pragma("unroll") for (int m = 0; m < 4; ++m) _Pragma("unroll") for (int k = 0; k < 2; ++k) dst[m][k] = *(const PG8_LAS bf16x8*)(lds + PG8_SA(b, h) + aoff + m * 2048 + k * 1024); } while (0)
#define PG8_LDB(dst, b, h) do { _Pragma("unroll") for (int n = 0; n < 2; ++n) _Pragma("unroll") for (int k = 0; k < 2; ++k) dst[n][k] = *(const PG8_LAS bf16x8*)(lds + PG8_SB(b, h) + boff + n * 2048 + k * 1024); } while (0)
#define PG8_MMA(ai, bj, At, Bt) do { __builtin_amdgcn_s_setprio(1); _Pragma("unroll") for (int m = 0; m < 4; ++m) _Pragma("unroll") for (int n = 0; n < 2; ++n) _Pragma("unroll") for (int k = 0; k < 2; ++k) \
        acc[ai][bj][m][n] = __builtin_amdgcn_mfma_f32_16x16x32_bf16(Bt[n][k], At[m][k], acc[ai][bj][m][n], 0, 0, 0); __builtin_amdgcn_s_setprio(0); } while (0)
#define PG8_WAIT_V(n) asm volatile("s_waitcnt vmcnt(" #n ")" ::: "memory")
#define PG8_WAIT_L(n) asm volatile("s_waitcnt lgkmcnt(" #n ")" ::: "memory")
#define PG8_BAR __builtin_amdgcn_s_barrier()
#define PG8_SCHED __builtin_amdgcn_sched_barrier(0)
    Unit cur, nxt; int ui = 0;
    if (!S.next(0, cur)) return;
    f32x4 acc[2][2][4][2];
#pragma unroll
    for (int a = 0; a < 2; ++a)
#pragma unroll
        for (int b = 0; b < 2; ++b)
#pragma unroll
            for (int m = 0; m < 4; ++m)
#pragma unroll
                for (int n = 0; n < 2; ++n) acc[a][b][m][n] = (f32x4){0.f, 0.f, 0.f, 0.f};
    bf16x8 At[4][2], B0[2][2], B1[2][2];
    const char* cA = (const char*)g.A + (size_t)cur.pm * tstep; const char* cB = (const char*)g.Bt + (size_t)cur.pn * tstep;
    S.a_ready(cur);
    if constexpr (SP2) {
        PG8_STAGE(PG8_SB(0, 0), cB, voffB); PG8_STAGE(PG8_SB(0, 1), cB + hstep, voffB); PG8_STAGE(PG8_SA(0, 0), cA, voffA); PG8_STAGE(PG8_SA(0, 1), cA + hstep, voffA);
        if (wr == 1) PG8_BAR;
        PG8_WAIT_V(2); PG8_BAR;
        PG8_STAGE(PG8_SB(1, 0), cB + kstep, voffB); PG8_STAGE(PG8_SA(1, 0), cA + kstep, voffA); PG8_STAGE(PG8_SB(1, 1), cB + hstep + kstep, voffB);
        PG8_WAIT_V(6); PG8_BAR;
    } else {
        PG8_STAGE(PG8_SB(0, 0), cB, voffB); PG8_STAGE(PG8_SA(0, 0), cA, voffA); PG8_STAGE(PG8_SB(0, 1), cB + hstep, voffB); PG8_STAGE(PG8_SA(0, 1), cA + hstep, voffA);
        if (wr == 1) PG8_BAR;
        PG8_WAIT_V(4); PG8_BAR;
        PG8_STAGE(PG8_SB(1, 0), cB + kstep, voffB); PG8_STAGE(PG8_SA(1, 0), cA + kstep, voffA); PG8_STAGE(PG8_SB(1, 1), cB + hstep + kstep, voffB);
        PG8_WAIT_V(6); PG8_BAR;
    }
    for (;;) {
        const bool has_next = S.next(ui + 1, nxt);
        const char* nA = has_next ? (const char*)g.A + (size_t)nxt.pm * tstep : cA; const char* nB = has_next ? (const char*)g.Bt + (size_t)nxt.pn * tstep : cB;
        for (int t = 0; t < nt; t += 2) {
            const bool last = (t == nt - 2);
            const char* a1 = cA + (size_t)(t + 1) * kstep;
            const char* a2 = last ? nA : cA + (size_t)(t + 2) * kstep; const char* b2 = last ? nB : cB + (size_t)(t + 2) * kstep;
            const char* a3 = a2 + kstep; const char* b3 = b2 + kstep;
            if (last && has_next) S.a_ready(nxt);
            if constexpr (SP2) {
            PG8_LDB(B0, 0, 0); PG8_LDB(B1, 0, 1); PG8_SCHED; PG8_LDA(At, 0, 0); PG8_STAGE(PG8_SA(1, 1), a1 + hstep, voffA);
            PG8_WAIT_V(8); PG8_WAIT_L(0); PG8_BAR; PG8_MMA(0, 0, At, B0); PG8_MMA(0, 1, At, B1); PG8_BAR; PG8_SCHED;
            PG8_LDA(At, 0, 1); PG8_STAGE(PG8_SB(0, 0), b2, voffB); PG8_STAGE(PG8_SB(0, 1), b2 + hstep, voffB); PG8_STAGE(PG8_SA(0, 0), a2, voffA);
            PG8_WAIT_V(8); PG8_WAIT_L(0); PG8_BAR; PG8_MMA(1, 0, At, B0); PG8_MMA(1, 1, At, B1); PG8_BAR; PG8_SCHED;
            PG8_LDB(B0, 1, 0); PG8_LDB(B1, 1, 1); PG8_SCHED; PG8_LDA(At, 1, 0); PG8_STAGE(PG8_SA(0, 1), a2 + hstep, voffA);
            PG8_WAIT_V(8); PG8_WAIT_L(0); PG8_BAR; PG8_MMA(0, 0, At, B0); PG8_MMA(0, 1, At, B1); PG8_BAR; PG8_SCHED;
            PG8_LDA(At, 1, 1); PG8_STAGE(PG8_SB(1, 0), b3, voffB); PG8_STAGE(PG8_SB(1, 1), b3 + hstep, voffB); PG8_STAGE(PG8_SA(1, 0), a3, voffA);
            PG8_WAIT_V(8); PG8_WAIT_L(0); PG8_BAR; PG8_MMA(1, 0, At, B0); PG8_MMA(1, 1, At, B1); PG8_BAR; PG8_SCHED;
            } else {
            PG8_LDB(B0, 0, 0); PG8_SCHED; PG8_LDA(At, 0, 0); PG8_STAGE(PG8_SA(1, 1), a1 + hstep, voffA);
            PG8_WAIT_L(8); PG8_BAR; PG8_WAIT_L(0); PG8_MMA(0, 0, At, B0); PG8_BAR; PG8_SCHED;
            PG8_LDB(B1, 0, 1); PG8_STAGE(PG8_SB(0, 0), b2, voffB);
            PG8_BAR; PG8_WAIT_L(0); PG8_MMA(0, 1, At, B1); PG8_BAR;
            PG8_LDA(At, 0, 1); PG8_STAGE(PG8_SA(0, 0), a2, voffA);
            PG8_BAR; PG8_WAIT_L(0); PG8_MMA(1, 0, At, B0); PG8_BAR; PG8_SCHED;
            PG8_STAGE(PG8_SB(0, 1), b2 + hstep, voffB);
            PG8_WAIT_V(6); PG8_BAR; PG8_MMA(1, 1, At, B1); PG8_BAR;
            PG8_LDB(B0, 1, 0); PG8_SCHED; PG8_LDA(At, 1, 0); PG8_STAGE(PG8_SA(0, 1), a2 + hstep, voffA);
            PG8_WAIT_L(8); PG8_BAR; PG8_WAIT_L(0); PG8_MMA(0, 0, At, B0); PG8_BAR; PG8_SCHED;
            PG8_LDB(B1, 1, 1); PG8_STAGE(PG8_SB(1, 0), b3, voffB);
            PG8_BAR; PG8_WAIT_L(0); PG8_MMA(0, 1, At, B1); PG8_BAR;
            PG8_LDA(At, 1, 1); PG8_STAGE(PG8_SA(1, 0), a3, voffA);
            PG8_BAR; PG8_WAIT_L(0); PG8_MMA(1, 0, At, B0); PG8_BAR; PG8_SCHED;
            PG8_STAGE(PG8_SB(1, 1), b3 + hstep, voffB);
            PG8_WAIT_V(6); PG8_BAR; PG8_MMA(1, 1, At, B1); PG8_BAR;
            }
        }
        if constexpr (ALIGN_EPI) { if (wr == 0) PG8_BAR; }
        if constexpr (!Epi::AFTER_DRAIN) { E(acc, cur, wr, wc, fr, fq); S.done(cur); }
        if (!has_next) break;
#pragma unroll
        for (int a = 0; a < 2; ++a)
#pragma unroll
            for (int b = 0; b < 2; ++b)
#pragma unroll
                for (int m = 0; m < 4; ++m)
#pragma unroll
                    for (int n = 0; n < 2; ++n) acc[a][b][m][n] = (f32x4){0.f, 0.f, 0.f, 0.f};
        cur = nxt; cA = nA; cB = nB; ++ui;
        if constexpr (ALIGN_EPI) { if (wr == 1) PG8_BAR; }
    }
    PG8_WAIT_V(0);
    if constexpr (!ALIGN_EPI) { if (wr == 0) PG8_BAR; }
    PG8_BAR;
    if constexpr (Epi::AFTER_DRAIN) { E.fused(acc, cur, wr, wc, fr, fq, lds, wid, lane); S.done(cur); }
#undef PG8_SA
#undef PG8_SB
#undef PG8_STAGE
#undef PG8_LDA
#undef PG8_LDB
#undef PG8_MMA
#undef PG8_WAIT_V
#undef PG8_WAIT_L
#undef PG8_BAR
#undef PG8_SCHED
}
}
#define XB_TMO      128
#define XB_XCNT(j)  (256  + 64 * (j))
#define XB_XSUB(j)  (1280 + 64 * (j))
#define XB_XGEN(j)  (2304 + 64 * (j))
#define XB_TOP      3328
#define XB_TOPGEN   3392
#define XCD_BAR_WORDS 3456
#define XB_SPIN_CAP (1u << 22)
#define LAS __attribute__((address_space(3)))

__device__ __forceinline__ unsigned xb_ld(unsigned* p)              { return __hip_atomic_load(p, __ATOMIC_RELAXED, __HIP_MEMORY_SCOPE_AGENT); }
__device__ __forceinline__ unsigned xb_add(unsigned* p, unsigned v) { return __hip_atomic_fetch_add(p, v, __ATOMIC_RELAXED, __HIP_MEMORY_SCOPE_AGENT); }
__device__ __forceinline__ unsigned xb_xcc_id() { return (unsigned)__builtin_amdgcn_s_getreg((3 << 11) | 20) & 0xFu; }
#define XB_SPIN(cond, bar) do { unsigned _sp = 0; while (cond) { __builtin_amdgcn_s_sleep(1); \
    if ((++_sp & 255u) == 0u) { if (xb_ld(&(bar)[XB_TMO])) break; if (_sp > XB_SPIN_CAP) { atomicAdd(&(bar)[XB_TMO], 1u); break; } } } } while (0)

struct XcdBarrier {
    unsigned* bar; unsigned x;
    volatile LAS unsigned* st;
};

__device__ __forceinline__ XcdBarrier xcd_barrier_post(unsigned* bar, volatile LAS unsigned* st) {
    XcdBarrier b; b.bar = bar; b.x = xb_xcc_id(); b.st = st;
    if (threadIdx.x == 0) (void)xb_add(&bar[XB_XCNT(b.x)], 1u);
    return b;
}
__device__ __forceinline__ void xcd_barrier_complete(unsigned* bar, unsigned x, unsigned& nloc, unsigned& nx) {
    const unsigned G = gridDim.x * gridDim.y * gridDim.z;
    unsigned sum, cnt, mine, sp = 0u;
    for (;;) {
        sum = 0u; cnt = 0u; mine = 0u;
#pragma unroll
        for (unsigned j = 0; j < 16; ++j) { const unsigned c = xb_ld(&bar[XB_XCNT(j)]); sum += c; cnt += (c > 0u) ? 1u : 0u; mine = (j == x) ? c : mine; }
        if (sum == G) break;
        __builtin_amdgcn_s_sleep(1);
        if ((++sp & 255u) == 0u) { if (xb_ld(&bar[XB_TMO])) break; if (sp > XB_SPIN_CAP) { atomicAdd(&bar[XB_TMO], 1u); break; } }
    }
    nloc = mine > 0u ? mine : 1u; nx = cnt > 0u ? cnt : 1u;
}

__device__ __forceinline__ void xcd_barrier(const XcdBarrier& b) {
    asm volatile("s_waitcnt vmcnt(0)" ::: "memory");
    __syncthreads();
    if (threadIdx.x == 0) {
        unsigned* bar = b.bar;
        __builtin_amdgcn_s_waitcnt(0);
        unsigned nloc = b.st[0], nx = b.st[1];
        if (nloc == 0u) { xcd_barrier_complete(bar, b.x, nloc, nx); b.st[0] = nloc; b.st[1] = nx; }
        const unsigned old = xb_add(&bar[XB_XSUB(b.x)], 1u);
        const unsigned gen = old / nloc;
        if (old + 1u == (gen + 1u) * nloc) {
            __builtin_amdgcn_fence(__ATOMIC_RELEASE, "agent");
            asm volatile("s_waitcnt vmcnt(0)" ::: "memory");
            const unsigned og = xb_add(&bar[XB_TOP], 1u);
            const unsigned tg = og / nx;
            if (og + 1u == (tg + 1u) * nx) xb_add(&bar[XB_TOPGEN], 1u);
            else XB_SPIN(xb_ld(&bar[XB_TOPGEN]) == tg, bar);
            __builtin_amdgcn_fence(__ATOMIC_ACQUIRE, "agent");
            xb_add(&bar[XB_XGEN(b.x)], 1u);
            asm volatile("s_waitcnt vmcnt(0)" ::: "memory");
        } else {
            XB_SPIN(xb_ld(&bar[XB_XGEN(b.x)]) == gen, bar);
            __builtin_amdgcn_fence(__ATOMIC_ACQUIRE, "agent");
            asm volatile("s_waitcnt vmcnt(0)" ::: "memory");
        }
    }
    __syncthreads();
}

typedef unsigned short bf16_t;
typedef short bf16x8 __attribute__((ext_vector_type(8)));
typedef float f32x4 __attribute__((ext_vector_type(4)));
typedef float f32x16 __attribute__((ext_vector_type(16)));
typedef unsigned u32x4 __attribute__((ext_vector_type(4)));
typedef unsigned u32x2 __attribute__((ext_vector_type(2)));

constexpr int D = 1024, NB = 16, SEQ = 2048, CTX = 256, NL = 4;
constexpr int TL = NB * SEQ, TC = NB * CTX, TT = TL + TC;
constexpr int DIN = 6144, HYW = 512, NE = 16, DE = 512, KEYS = CTX + SEQ;
constexpr int NMOD = 6, NBM = NB + 1;
constexpr int APROWS = 2 * TT + NE * 256;
constexpr float EPS = 1e-6f, LOG2E = 1.4426950408889634f;
constexpr float QSCALE = 0.125f * LOG2E;

constexpr size_t MiB = 1u << 20;
constexpr size_t WS_CTL = 0, CTL_ZERO_BYTES = 1 * MiB;
constexpr size_t WS_MOD = 1 * MiB;
constexpr size_t WS_ROPE = 3 * MiB;
constexpr size_t WS_FL = 4 * MiB, WS_FC = 20 * MiB;
constexpr size_t WS_MISC = 22 * MiB;
constexpr size_t WS_FNORM = WS_MISC;
constexpr size_t WS_TOKE = WS_MISC + 64 * 1024, WS_TOKP = WS_MISC + 352 * 1024, WS_TOKW = WS_MISC + 640 * 1024;
constexpr size_t WS_ROWMAP = WS_MISC + 960 * 1024, WS_ROWW = WS_MISC + 1280 * 1024;
constexpr size_t WS_WIN = 24 * MiB, WS_WBR = 36 * MiB, WS_WOUT = 39 * MiB;
constexpr size_t WS_XC = 41 * MiB;
constexpr size_t WS_NP = WS_XC;
constexpr size_t WS_H = 57 * MiB;
constexpr size_t WS_KA = 129 * MiB, WS_VTA = 138 * MiB, WS_KW = 147 * MiB, WS_VTW = 156 * MiB;
constexpr size_t WS_QA = 165 * MiB, WS_QW = 201 * MiB, WS_YH = 237 * MiB, WS_VT = 273 * MiB, WS_YT = 309 * MiB;
constexpr size_t WS_RAWA = 309 * MiB, WS_RAWW = 327 * MiB;
constexpr size_t WS_F = 165 * MiB;
constexpr size_t WS_U = 345 * MiB;
constexpr size_t WS_G = 453 * MiB;
constexpr size_t WS_W13 = 605 * MiB, WS_W2 = 637 * MiB;
constexpr size_t WS_END = 669 * MiB;
static_assert(WS_G + (size_t)APROWS * 2048 <= WS_W13 && WS_W2 + (size_t)16 * 1024 * 512 * 2 <= WS_END && WS_G + (size_t)TT * 3072 * 2 <= WS_END, "ws map");
static_assert(WS_U + (size_t)APROWS * 1024 <= WS_G && WS_F + (size_t)2 * TT * 2048 <= WS_YT, "ws map 2");
constexpr size_t VT_CTX_OFF = (size_t)HYW * NB * SEQ;

constexpr int CW_BAR = 4096, CW_CNT = 8192;
constexpr int LDS_BYTES = 151552, MISC_OFF = 147456;
constexpr int NWAVES = 8, NTHR = 512;

struct Args { const float* in[29]; float* out; unsigned char* ws; int ph_lo, ph_hi; };
enum { I_X = 0, I_C, I_CTX, I_CCTX, I_ADAW, I_ADAB, I_N1G, I_N2G, I_WIN, I_QKG, I_HSW, I_HSB, I_HW1, I_HB1, I_HFR, I_HW2, I_HB2, I_HW3, I_HBIAS, I_SINK, I_WBR, I_WOUT,
       I_RGW, I_RGB, I_REW, I_REB, I_EW1, I_EW3, I_EW2 };

#define LDS_WAIT() asm volatile("s_waitcnt lgkmcnt(0)" ::: "memory")
#define VM_WAIT() asm volatile("s_waitcnt vmcnt(0)" ::: "memory")

typedef float f32x2_t __attribute__((ext_vector_type(2)));
typedef __bf16 bf16x2_t __attribute__((ext_vector_type(2)));
__device__ __forceinline__ unsigned cvtpk(float lo, float hi) { f32x2_t v = {lo, hi}; bf16x2_t b = __builtin_convertvector(v, bf16x2_t); return __builtin_bit_cast(unsigned, b); }
__device__ __forceinline__ float bflo(unsigned u) { return __builtin_bit_cast(float, u << 16); }
__device__ __forceinline__ float bfhi(unsigned u) { return __builtin_bit_cast(float, u & 0xffff0000u); }
__device__ __forceinline__ float bf1(bf16_t u) { return __builtin_bit_cast(float, (unsigned)u << 16); }
__device__ __forceinline__ bf16_t f2bf(float f) { return (bf16_t)(cvtpk(f, 0.f) & 0xffffu); }
__device__ __forceinline__ float wave_sum(float v) {
#pragma unroll
    for (int o = 1; o < 64; o <<= 1) v += __shfl_xor(v, o);
    return v;
}
__device__ __forceinline__ float fast_exp2(float x) { return __builtin_amdgcn_exp2f(x); }
__device__ __forceinline__ float fast_rcp(float x) { return __builtin_amdgcn_rcpf(x); }
__device__ __forceinline__ float sigmoid_f(float x) { return fast_rcp(1.f + fast_exp2(-x * LOG2E)); }

__device__ __forceinline__ void sincos_acc(float x, float& s, float& c) {
    const float q = rintf(x * 0.636619772367581f);
    float y = fmaf(-q, 1.57079625129699707031f, x);
    y = fmaf(-q, 7.54978941586159635335e-08f, y);
    const float y2 = y * y;
    float sp = fmaf(y2, 2.7557314297e-06f, -1.9841270114e-04f); sp = fmaf(sp, y2, 8.3333337680e-03f); sp = fmaf(sp, y2, -1.6666667163e-01f); sp = fmaf(sp * y2, y, y);
    float cp = fmaf(y2, -2.7557314297e-07f, 2.4801587642e-05f); cp = fmaf(cp, y2, -1.3888889225e-03f); cp = fmaf(cp, y2, 4.1666667908e-02f); cp = fmaf(cp, y2, -0.5f); cp = fmaf(cp, y2, 1.0f);
    const int n = (int)q & 3;
    const float s1 = (n & 1) ? cp : sp, c1 = (n & 1) ? sp : cp;
    s = (n & 2) ? -s1 : s1;
    c = ((n + 1) & 2) ? -c1 : c1;
}

struct Fr { LAS unsigned char* lds; int tid, lane, wave, G, bid; };

__device__ __forceinline__ void pro_mod(const Fr& F, const Args& a) {
    LAS float* s = (LAS float*)F.lds;
    LAS float* red = (LAS float*)(F.lds + 69632);
    const float* c = a.in[I_C]; const float* cc = a.in[I_CCTX]; const float* W = a.in[I_ADAW]; const float* Bv = a.in[I_ADAB];
    float* MOD = (float*)(a.ws + WS_MOD);
    for (int i = F.tid; i < NBM * 1024; i += NTHR) { const int bb = i >> 10, k = i & 1023; const float v = (bb < NB) ? c[bb * 1024 + k] : cc[k]; s[i] = v / (1.f + __expf(-v)); }
    __syncthreads();
    const int col = F.tid & 63, ks = F.wave;
    for (int unit = F.bid; unit < NL * 96; unit += F.G) {
        const int l = unit / 96, j0 = (unit % 96) * 64;
        float acc[NBM];
#pragma unroll
        for (int bb = 0; bb < NBM; ++bb) acc[bb] = 0.f;
        const float* Wp = W + ((size_t)l * 1024 + ks * 128) * DIN + j0 + col;
#pragma unroll 4
        for (int k = 0; k < 128; ++k) { const float w = Wp[(size_t)k * DIN];
#pragma unroll
            for (int bb = 0; bb < NBM; ++bb) acc[bb] = fmaf(s[bb * 1024 + ks * 128 + k], w, acc[bb]); }
#pragma unroll
        for (int bb = 0; bb < NBM; ++bb) red[(ks * NBM + bb) * 64 + col] = acc[bb];
        __syncthreads();
        for (int o = F.tid; o < NBM * 64; o += NTHR) { const int bb = o >> 6, cx = o & 63; float sum = 0.f;
#pragma unroll
            for (int k2 = 0; k2 < 8; ++k2) sum += red[(k2 * NBM + bb) * 64 + cx];
            MOD[((size_t)l * NBM + bb) * DIN + j0 + cx] = sum + Bv[l * DIN + j0 + cx]; }
        __syncthreads();
    }
}

__device__ __forceinline__ void pro_rope(const Fr& F, const Args& a) {
    float* ct = (float*)(a.ws + WS_ROPE); float* st = ct + SEQ * 32;
    for (int i = F.bid * NTHR + F.tid; i < SEQ * 32; i += F.G * NTHR) {
        const int pos = i >> 5, ax = (i >> 4) & 1, f = i & 15;
        const float inv = exp2f(-(float)f * (13.287712379549449f / 16.f));
        const float ang = (float)(ax == 0 ? (pos >> 6) : (pos & 63)) * inv;
        float sv, cv; sincos_acc(ang, sv, cv); ct[i] = cv; st[i] = sv;
    }
}

__device__ __forceinline__ void pro_filter(const Fr& F, const Args& a) {
    LAS float* L = (LAS float*)F.lds;
    constexpr int oW1 = 0, oB1 = 2112, oFR = 2176, oB2 = 2240, oW2 = 2304, oZ = 6400, oH1 = 7552, oH2 = 9600, oW3 = 11648;
    bf16_t* FL = (bf16_t*)(a.ws + WS_FL); bf16_t* FC = (bf16_t*)(a.ws + WS_FC); float* NP = (float*)(a.ws + WS_NP);
    const int p = F.tid >> 4, jj = F.tid & 15;
    for (int unit = F.bid; unit < NL * 72; unit += F.G) {
        const int l = unit / 72, ch = unit % 72; const bool lat = ch < 64; const int n = lat ? SEQ : CTX, pos0 = lat ? ch * 32 : (ch - 64) * 32;
        __syncthreads();
        for (int i = F.tid; i < 2112; i += NTHR) L[oW1 + i] = a.in[I_HW1][l * 2112 + i];
        for (int i = F.tid; i < 64; i += NTHR) { L[oB1 + i] = a.in[I_HB1][l * 64 + i]; L[oFR + i] = a.in[I_HFR][l * 64 + i]; L[oB2 + i] = a.in[I_HB2][l * 64 + i]; }
        for (int i = F.tid; i < 4096; i += NTHR) L[oW2 + i] = a.in[I_HW2][l * 4096 + i];
        const int pos = pos0 + p; const float t = (float)pos / (float)(n - 1);
        { const float band = 1e-4f + (float)jj * ((15.f - 1e-4f) / 15.f); const float ang = ((6.2831855f * band) * (float)pos) / (float)n;
          float sv, cv; sincos_acc(ang, sv, cv); L[oZ + p * 36 + 1 + jj] = cv; L[oZ + p * 36 + 17 + jj] = -sv; if (jj == 0) L[oZ + p * 36] = t; }
        __syncthreads();
        { f32x4 acc = *(const LAS f32x4*)(L + oB1 + 4 * jj);
#pragma unroll 3
          for (int i = 0; i < 33; ++i) { const float z = L[oZ + p * 36 + i]; const f32x4 w = *(const LAS f32x4*)(L + oW1 + i * 64 + 4 * jj); acc.x = fmaf(z, w.x, acc.x); acc.y = fmaf(z, w.y, acc.y); acc.z = fmaf(z, w.z, acc.z); acc.w = fmaf(z, w.w, acc.w); }
          const f32x4 fr = *(const LAS f32x4*)(L + oFR + 4 * jj); float sv, cv; f32x4 o;
          sincos_acc(fr.x * acc.x, sv, cv); o.x = sv; sincos_acc(fr.y * acc.y, sv, cv); o.y = sv; sincos_acc(fr.z * acc.z, sv, cv); o.z = sv; sincos_acc(fr.w * acc.w, sv, cv); o.w = sv;
          *(LAS f32x4*)(L + oH1 + p * 64 + 4 * jj) = o; }
        __syncthreads();
        { f32x4 acc = *(const LAS f32x4*)(L + oB2 + 4 * jj);
#pragma unroll 4
          for (int i = 0; i < 64; ++i) { const float z = L[oH1 + p * 64 + i]; const f32x4 w = *(const LAS f32x4*)(L + oW2 + i * 64 + 4 * jj); acc.x = fmaf(z, w.x, acc.x); acc.y = fmaf(z, w.y, acc.y); acc.z = fmaf(z, w.z, acc.z); acc.w = fmaf(z, w.w, acc.w); }
          const f32x4 fr = *(const LAS f32x4*)(L + oFR + 4 * jj); float sv, cv; f32x4 o;
          sincos_acc(fr.x * acc.x, sv, cv); o.x = sv; sincos_acc(fr.y * acc.y, sv, cv); o.y = sv; sincos_acc(fr.z * acc.z, sv, cv); o.z = sv; sincos_acc(fr.w * acc.w, sv, cv); o.w = sv;
          *(LAS f32x4*)(L + oH2 + p * 64 + 4 * jj) = o; }
        f32x4 acc[16];
#pragma unroll
        for (int m = 0; m < 16; ++m) acc[m] = (f32x4){0.f, 0.f, 0.f, 0.f};
#pragma unroll 1
        for (int kc = 0; kc < 4; ++kc) {
            __syncthreads();
            for (int i = F.tid; i < 4096; i += NTHR) *(LAS f32x4*)(L + oW3 + i * 4) = *(const f32x4*)(a.in[I_HW3] + ((size_t)l * 64 + kc * 16) * 1024 + i * 4);
            __syncthreads();
#pragma unroll 1
            for (int k = 0; k < 16; ++k) { const float h = L[oH2 + p * 64 + kc * 16 + k];
#pragma unroll
                for (int m = 0; m < 16; ++m) { const f32x4 w = *(const LAS f32x4*)(L + oW3 + k * 1024 + 64 * m + 4 * jj);
                    acc[m].x = fmaf(h, w.x, acc[m].x); acc[m].y = fmaf(h, w.y, acc[m].y); acc[m].z = fmaf(h, w.z, acc[m].z); acc[m].w = fmaf(h, w.w, acc[m].w); } }
        }
        __syncthreads();
        LAS bf16_t* T = (LAS bf16_t*)(L + oW3);
#pragma unroll
        for (int m = 0; m < 16; ++m) {
            const int colb = 64 * m + 4 * jj; const int dir = colb >> 9;
            const float v4[4] = {acc[m].x, acc[m].y, acc[m].z, acc[m].w};
#pragma unroll
            for (int e = 0; e < 4; ++e) { const int col = colb + e, c = col & 511;
                const float dl = fabsf(-3.0701134573253943f + (-15.350567286626972f + 3.0701134573253943f) * ((float)c / 511.f));
                float v = v4[e] * __expf(-t * dl); if (dir == 1 && pos == 0) v = 0.f;
                T[col * 32 + (dir == 0 ? 31 - p : p)] = f2bf(v); }
        }
        __syncthreads();
        for (int idx = F.tid; idx < 1024 * 32; idx += NTHR) { const int col = idx >> 5, i = idx & 31, dir = col >> 9, c = col & 511;
            const int u = (dir == 0) ? (n - 32 - pos0 + i) : ((pos0 + i == 0) ? 2 * n - 1 : n - 1 + pos0 + i);
            bf16_t* Fb = lat ? FL + ((size_t)l * 512 + c) * 4096 : FC + ((size_t)l * 512 + c) * 512;
            Fb[u] = T[col * 32 + i]; }
        for (int col = F.tid; col < 1024; col += NTHR) { float sum = 0.f;
#pragma unroll 8
            for (int i = 0; i < 32; ++i) sum += fabsf(bf1(T[col * 32 + i]));
            NP[((size_t)l * 72 + ch) * 1024 + col] = sum; }
    }
    __syncthreads();
}
__device__ __forceinline__ void filter_norm_reduce(const Fr& F, const Args& a) {
    const float* NP = (const float*)(a.ws + WS_NP); float* FN = (float*)(a.ws + WS_FNORM);
    for (int o = F.bid * NTHR + F.tid; o < NL * 2 * 512; o += F.G * NTHR) { const int l = o >> 10, isc = (o >> 9) & 1, c = o & 511;
        const int ch0 = isc ? 64 : 0, ch1 = isc ? 72 : 64; float sum = 0.f;
        for (int ch = ch0; ch < ch1; ++ch) sum += NP[((size_t)l * 72 + ch) * 1024 + c] + NP[((size_t)l * 72 + ch) * 1024 + 512 + c];
        FN[o] = 1.f / sum; }
}

template <int MODE>
__device__ __forceinline__ void transpose_item(const float* W, int K, int N, bf16_t* WT, int row_off, LAS float* scr, int item, int lane) {
    const int nblk = N / 32, kb = item / nblk, nb = item % nblk, k0 = 64 * kb, n0 = 32 * nb;
#pragma unroll 8
    for (int i = 0; i < 32; ++i) { const int kk = 2 * i + (lane >> 5); scr[kk * 33 + (lane & 31)] = W[(size_t)(k0 + kk) * N + n0 + (lane & 31)]; }
    LDS_WAIT();
    const int c = lane & 7;
#pragma unroll
    for (int j = 0; j < 4; ++j) { const int n = (lane >> 3) + 8 * j; const LAS float* s = scr + (8 * c) * 33 + n;
        u32x4 o; o.x = cvtpk(s[0 * 33], s[1 * 33]); o.y = cvtpk(s[2 * 33], s[3 * 33]); o.z = cvtpk(s[4 * 33], s[5 * 33]); o.w = cvtpk(s[6 * 33], s[7 * 33]);
        const int nn = n0 + n; const int row = (MODE == 0) ? nn : ((nn >> 2) * 8 + (nn & 3) + (MODE == 2 ? 4 : 0));
        *(u32x4*)(WT + (size_t)(row_off + row) * K + k0 + 8 * c) = o; }
    LDS_WAIT();
}

__device__ __forceinline__ void conv_small_weights(const Fr& F, const Args& a, int l) {
    LAS float* scr = (LAS float*)(F.lds + F.wave * 16384);
    const int gw = F.bid * NWAVES + F.wave, NGW = F.G * NWAVES;
    constexpr int I_IN = (1024 / 64) * (DIN / 32), I_BR = (512 / 64) * (1024 / 32), I_OUT = (1024 / 64) * (1024 / 32);
    constexpr int NIT = I_IN + 3 * I_BR + I_OUT;
    for (int it = gw; it < NIT; it += NGW) {
        int r = it;
        if (r < I_IN) { transpose_item<0>(a.in[I_WIN] + (size_t)l * 1024 * DIN, 1024, DIN, (bf16_t*)(a.ws + WS_WIN), 0, scr, r, F.lane); continue; } r -= I_IN;
        if (r < 3 * I_BR) { const int b = r / I_BR; transpose_item<0>(a.in[I_WBR] + ((size_t)l * 3 + b) * 512 * 1024, 512, 1024, (bf16_t*)(a.ws + WS_WBR) + (size_t)b * 1024 * 512, 0, scr, r % I_BR, F.lane); continue; } r -= 3 * I_BR;
        transpose_item<0>(a.in[I_WOUT] + (size_t)l * 1024 * 1024, 1024, 1024, (bf16_t*)(a.ws + WS_WOUT), 0, scr, r, F.lane);
    }
}
__device__ __forceinline__ void conv_expert_weights(const Fr& F, const Args& a, int l) {
    LAS float* scr = (LAS float*)(F.lds + F.wave * 16384);
    const int gw = F.bid * NWAVES + F.wave, NGW = F.G * NWAVES;
    constexpr int I_1 = (1024 / 64) * (512 / 32), I_2 = (512 / 64) * (1024 / 32);
    constexpr int NIT = NE * (2 * I_1 + I_2);
    for (int it = gw; it < NIT; it += NGW) {
        const int e = it / (2 * I_1 + I_2); int r = it % (2 * I_1 + I_2);
        bf16_t* W13 = (bf16_t*)(a.ws + WS_W13); bf16_t* W2 = (bf16_t*)(a.ws + WS_W2);
        if (r < I_1) { transpose_item<1>(a.in[I_EW1] + ((size_t)l * NE + e) * 1024 * 512, 1024, 512, W13, e * 1024, scr, r, F.lane); continue; } r -= I_1;
        if (r < I_1) { transpose_item<2>(a.in[I_EW3] + ((size_t)l * NE + e) * 1024 * 512, 1024, 512, W13, e * 1024, scr, r, F.lane); continue; } r -= I_1;
        transpose_item<0>(a.in[I_EW2] + ((size_t)l * NE + e) * 512 * 1024, 512, 1024, W2, e * 1024, scr, r, F.lane);
    }
}

__device__ __forceinline__ int mod_row(int row) { return row < TL ? (row >> 11) : NB; }

__device__ __forceinline__ void rows_p0(const Fr& F, const Args& a, int l, int nrows) {
    const int gw = F.bid * NWAVES + F.wave, NGW = F.G * NWAVES;
    const float* g1 = a.in[I_N1G] + l * 1024;
    const float* MODl = (const float*)(a.ws + WS_MOD) + (size_t)l * NBM * DIN;
    const float* MODp = (const float*)(a.ws + WS_MOD) + (size_t)(l > 0 ? l - 1 : 0) * NBM * DIN;
    const bf16_t* Fs = (const bf16_t*)(a.ws + WS_F);
    bf16_t* H = (bf16_t*)(a.ws + WS_H);
    for (int row = gw; row < nrows; row += NGW) {
        const bool lat = row < TL; const int mr = mod_row(row);
        const float* xs; float* xd;
        if (lat) { xd = a.out + (size_t)row * D; xs = (l == 0) ? a.in[I_X] + (size_t)row * D : xd; }
        else { xd = (float*)(a.ws + WS_XC) + (size_t)(row - TL) * D; xs = (l == 0) ? a.in[I_CTX] + (size_t)(row - TL) * D : xd; }
        f32x4 v[4]; float ss = 0.f;
#pragma unroll
        for (int j = 0; j < 4; ++j) v[j] = *(const f32x4*)(xs + F.lane * 4 + 256 * j);
        if (l > 0) {
#pragma unroll
            for (int j = 0; j < 4; ++j) { const int col = F.lane * 4 + 256 * j;
                const u32x2 f0 = *(const u32x2*)(Fs + (size_t)row * D + col), f1 = *(const u32x2*)(Fs + ((size_t)TT + row) * D + col);
                const f32x4 m5 = *(const f32x4*)(MODp + (size_t)mr * DIN + 5 * 1024 + col);
                v[j].x += m5.x * (bflo(f0.x) + bflo(f1.x)); v[j].y += m5.y * (bfhi(f0.x) + bfhi(f1.x)); v[j].z += m5.z * (bflo(f0.y) + bflo(f1.y)); v[j].w += m5.w * (bfhi(f0.y) + bfhi(f1.y));
                *(f32x4*)(xd + col) = v[j]; }
        }
#pragma unroll
        for (int j = 0; j < 4; ++j) ss += (v[j].x * v[j].x + v[j].y * v[j].y) + (v[j].z * v[j].z + v[j].w * v[j].w);
        const float r = 1.f / sqrtf(wave_sum(ss) * (1.f / D) + EPS);
#pragma unroll
        for (int j = 0; j < 4; ++j) { const int col = F.lane * 4 + 256 * j;
            const f32x4 g = *(const f32x4*)(g1 + col), sh = *(const f32x4*)(MODl + (size_t)mr * DIN + col), sc = *(const f32x4*)(MODl + (size_t)mr * DIN + 1024 + col);
            const f32x4 o = (v[j] * r * g) * (sc + 1.f) + sh;
            u32x2 w; w.x = cvtpk(o.x, o.y); w.y = cvtpk(o.z, o.w);
            *(u32x2*)(H + (size_t)row * D + col) = w; }
    }
}
__device__ __forceinline__ void rows_final(const Fr& F, const Args& a) {
    const int gw = F.bid * NWAVES + F.wave, NGW = F.G * NWAVES;
    const float* MODp = (const float*)(a.ws + WS_MOD) + (size_t)(NL - 1) * NBM * DIN;
    const bf16_t* Fs = (const bf16_t*)(a.ws + WS_F);
    for (int row = gw; row < TL; row += NGW) {
        const int mr = row >> 11; float* xd = a.out + (size_t)row * D;
#pragma unroll
        for (int j = 0; j < 4; ++j) { const int col = F.lane * 4 + 256 * j;
            f32x4 v = *(const f32x4*)(xd + col);
            const u32x2 f0 = *(const u32x2*)(Fs + (size_t)row * D + col), f1 = *(const u32x2*)(Fs + ((size_t)TT + row) * D + col);
            const f32x4 m5 = *(const f32x4*)(MODp + (size_t)mr * DIN + 5 * 1024 + col);
            v.x += m5.x * (bflo(f0.x) + bflo(f1.x)); v.y += m5.y * (bfhi(f0.x) + bfhi(f1.x)); v.z += m5.z * (bflo(f0.y) + bflo(f1.y)); v.w += m5.w * (bfhi(f0.y) + bfhi(f1.y));
            *(f32x4*)(xd + col) = v; }
    }
}

__device__ __forceinline__ void rows_p5(const Fr& F, const Args& a, int l, int nrows) {
    LAS float* RW = (LAS float*)F.lds;
    LAS float* RB = (LAS float*)(F.lds + 81920);
    LAS int* LC = (LAS int*)(F.lds + 82048);
    LAS int* TE = (LAS int*)(F.lds + 82304);
    LAS int* TP = TE + 256;
    LAS float* TW = (LAS float*)(TP + 256);
    const float* g2 = a.in[I_N2G] + l * 1024;
    const float* MODl = (const float*)(a.ws + WS_MOD) + (size_t)l * NBM * DIN;
    bf16_t* H = (bf16_t*)(a.ws + WS_H);
    int* TOKE = (int*)(a.ws + WS_TOKE); int* TOKP = (int*)(a.ws + WS_TOKP); float* TOKW = (float*)(a.ws + WS_TOKW);
    unsigned* CNT = (unsigned*)(a.ws + WS_CTL) + CW_CNT + l * 256;
    for (int i = F.tid; i < 1024 * 20; i += NTHR) { const int k = i / 20, cidx = i % 20;
        RW[cidx * 1024 + k] = (cidx < 4) ? a.in[I_RGW][((size_t)l * 1024 + k) * 4 + cidx] : a.in[I_REW][((size_t)l * 1024 + k) * 16 + (cidx - 4)]; }
    if (F.tid < 20) RB[F.tid] = (F.tid < 4) ? a.in[I_RGB][l * 4 + F.tid] : a.in[I_REB][l * 16 + F.tid - 4];
    constexpr int P5_CH = 144;
    const int nch = (nrows + P5_CH - 1) / P5_CH;
    for (int ch = F.bid; ch < nch; ch += F.G) {
    if (F.tid < 32) LC[F.tid] = 0;
    __syncthreads();
    const int r0 = ch * P5_CH, r1 = (r0 + P5_CH < nrows) ? r0 + P5_CH : nrows;
    for (int row = r0 + F.wave; row < r1; row += NWAVES) {
        const bool lat = row < TL; const int mr = mod_row(row);
        const float* xs = lat ? a.out + (size_t)row * D : (const float*)(a.ws + WS_XC) + (size_t)(row - TL) * D;
        f32x4 v[4]; float ss = 0.f;
#pragma unroll
        for (int j = 0; j < 4; ++j) { v[j] = *(const f32x4*)(xs + F.lane * 4 + 256 * j); ss += (v[j].x * v[j].x + v[j].y * v[j].y) + (v[j].z * v[j].z + v[j].w * v[j].w); }
        const float r = 1.f / sqrtf(wave_sum(ss) * (1.f / D) + EPS);
#pragma unroll
        for (int j = 0; j < 4; ++j) { const int col = F.lane * 4 + 256 * j;
            const f32x4 g = *(const f32x4*)(g2 + col), sh = *(const f32x4*)(MODl + (size_t)mr * DIN + 3 * 1024 + col), sc = *(const f32x4*)(MODl + (size_t)mr * DIN + 4 * 1024 + col);
            v[j] = (v[j] * r * g) * (sc + 1.f) + sh;
            u32x2 w; w.x = cvtpk(v[j].x, v[j].y); w.y = cvtpk(v[j].z, v[j].w);
            *(u32x2*)(H + (size_t)row * D + col) = w; }
        float lg[20];
#pragma unroll
        for (int cidx = 0; cidx < 20; ++cidx) { float p = 0.f;
#pragma unroll
            for (int j = 0; j < 4; ++j) { const f32x4 w = *(const LAS f32x4*)(RW + cidx * 1024 + F.lane * 4 + 256 * j);
                p = fmaf(v[j].x, w.x, p); p = fmaf(v[j].y, w.y, p); p = fmaf(v[j].z, w.z, p); p = fmaf(v[j].w, w.w, p); }
            lg[cidx] = wave_sum(p) + RB[cidx]; }
        int gs = 0; float gm = lg[0];
#pragma unroll
        for (int i = 1; i < 4; ++i) if (lg[i] > gm) { gm = lg[i]; gs = i; }
        float gsum = 0.f;
#pragma unroll
        for (int i = 0; i < 4; ++i) gsum += __expf(lg[i] - gm);
        const float pg = 1.f / gsum;
        float le[4];
#pragma unroll
        for (int i = 0; i < 4; ++i) le[i] = (gs == 0) ? lg[4 + i] : (gs == 1) ? lg[8 + i] : (gs == 2) ? lg[12 + i] : lg[16 + i];
        int i0 = 0; float v0 = le[0];
#pragma unroll
        for (int i = 1; i < 4; ++i) if (le[i] > v0) { v0 = le[i]; i0 = i; }
        int i1 = -1; float v1 = -3.4e38f;
#pragma unroll
        for (int i = 0; i < 4; ++i) if (i != i0 && le[i] > v1) { v1 = le[i]; i1 = i; }
        const float e1 = __expf(v1 - v0), den = 1.f / (1.f + e1);
        const float w0 = den * pg, w1 = e1 * den * pg;
        const int ex0 = gs * 4 + i0, ex1 = gs * 4 + i1;
        if (F.lane == 0) {
            const int lp0 = __hip_atomic_fetch_add(&LC[ex0], 1, __ATOMIC_RELAXED, __HIP_MEMORY_SCOPE_WORKGROUP), lp1 = __hip_atomic_fetch_add(&LC[ex1], 1, __ATOMIC_RELAXED, __HIP_MEMORY_SCOPE_WORKGROUP);
            const int lr = row - r0;
            TE[lr] = ex0 | (ex1 << 8); TP[lr] = lp0 | (lp1 << 16); TW[2 * lr] = w0; TW[2 * lr + 1] = w1;
        }
    }
    __syncthreads();
    if (F.tid < NE) LC[16 + F.tid] = (int)atomicAdd(&CNT[F.tid * 16], (unsigned)LC[F.tid]);
    __syncthreads();
    for (int lr = F.tid; lr < r1 - r0; lr += NTHR) {
        const int te = TE[lr], tp = TP[lr], ex0 = te & 255, ex1 = te >> 8, row = r0 + lr;
        TOKE[2 * row] = ex0; TOKE[2 * row + 1] = ex1;
        TOKP[2 * row] = LC[16 + ex0] + (tp & 0xffff); TOKP[2 * row + 1] = LC[16 + ex1] + (tp >> 16);
        TOKW[2 * row] = TW[2 * lr]; TOKW[2 * row + 1] = TW[2 * lr + 1];
    }
    __syncthreads();
    }
    __syncthreads();
}

__device__ __forceinline__ void normrope8(float (&x)[8], const float* g64, bool rope, int pos, const float* ct, const float* st, float scale, int lane) {
    float ss = 0.f;
#pragma unroll
    for (int i = 0; i < 8; ++i) ss += x[i] * x[i];
    ss += __shfl_xor(ss, 1); ss += __shfl_xor(ss, 2); ss += __shfl_xor(ss, 4);
    const float r = 1.f / sqrtf(ss * (1.f / 64.f) + EPS);
    const int ch = lane & 7;
    const f32x4 g0 = *(const f32x4*)(g64 + 8 * ch), g1 = *(const f32x4*)(g64 + 8 * ch + 4);
    x[0] *= r * g0.x; x[1] *= r * g0.y; x[2] *= r * g0.z; x[3] *= r * g0.w; x[4] *= r * g1.x; x[5] *= r * g1.y; x[6] *= r * g1.z; x[7] *= r * g1.w;
    if (rope) {
        const int ax = ch >> 2, half = (ch >> 1) & 1, f0 = 8 * (ch & 1);
        const f32x4 c0 = *(const f32x4*)(ct + pos * 32 + ax * 16 + f0), c1 = *(const f32x4*)(ct + pos * 32 + ax * 16 + f0 + 4);
        const f32x4 s0 = *(const f32x4*)(st + pos * 32 + ax * 16 + f0), s1 = *(const f32x4*)(st + pos * 32 + ax * 16 + f0 + 4);
        const float cs[8] = {c0.x, c0.y, c0.z, c0.w, c1.x, c1.y, c1.z, c1.w}, sn[8] = {s0.x, s0.y, s0.z, s0.w, s1.x, s1.y, s1.z, s1.w};
#pragma unroll
        for (int i = 0; i < 8; ++i) { const float p = __shfl_xor(x[i], 2);
            x[i] = half ? (x[i] * cs[i] + p * sn[i]) : (x[i] * cs[i] - p * sn[i]); }
    }
#pragma unroll
    for (int i = 0; i < 8; ++i) x[i] *= scale;
}
__device__ __forceinline__ void unpack8(const u32x4 w, float (&x)[8]) { x[0] = bflo(w.x); x[1] = bfhi(w.x); x[2] = bflo(w.y); x[3] = bfhi(w.y); x[4] = bflo(w.z); x[5] = bfhi(w.z); x[6] = bflo(w.w); x[7] = bfhi(w.w); }
__device__ __forceinline__ u32x4 pack8(const float (&x)[8]) { u32x4 w; w.x = cvtpk(x[0], x[1]); w.y = cvtpk(x[2], x[3]); w.z = cvtpk(x[4], x[5]); w.w = cvtpk(x[6], x[7]); return w; }

__device__ __forceinline__ void prep_phase(const Fr& F, const Args& a, int l) {
    constexpr int VROW = 272;
    LAS unsigned char* VA_l = F.lds;
    LAS unsigned char* VW_l = F.lds + 17408;
    LAS unsigned char* HT_l = F.lds + 34816;
    constexpr int HROW = 144;
    const float* ct = (const float*)(a.ws + WS_ROPE); const float* st = ct + SEQ * 32;
    const float* qkg = a.in[I_QKG] + l * 256;
    bf16_t* QA = (bf16_t*)(a.ws + WS_QA); bf16_t* QW = (bf16_t*)(a.ws + WS_QW);
    const bf16_t* RAWA = (const bf16_t*)(a.ws + WS_RAWA); const bf16_t* RAWW = (const bf16_t*)(a.ws + WS_RAWW);
    bf16_t* KA = (bf16_t*)(a.ws + WS_KA); bf16_t* KW = (bf16_t*)(a.ws + WS_KW); bf16_t* VTA = (bf16_t*)(a.ws + WS_VTA); bf16_t* VTW = (bf16_t*)(a.ws + WS_VTW);
    const bf16_t* U = (const bf16_t*)(a.ws + WS_U); bf16_t* X0 = (bf16_t*)(a.ws + WS_H); bf16_t* VT = (bf16_t*)(a.ws + WS_VT);
    const float* hsw = a.in[I_HSW] + l * 3 * 1536; const float* hsb = a.in[I_HSB] + l * 1536;
    for (int unit = F.bid; unit < NB * 36; unit += F.G) {
        const bool lat = unit < NB * 32;
        const int b = lat ? unit >> 5 : (unit - NB * 32) >> 2, p0 = lat ? (unit & 31) * 64 : ((unit - NB * 32) & 3) * 64;
        const int n = lat ? SEQ : CTX;
        const int row0 = lat ? b * SEQ + p0 : TL + b * CTX + p0;
        const int j0 = lat ? CTX + p0 : p0;
        __syncthreads();
        for (int tk = F.wave; tk < 64; tk += NWAVES) {
            const int row = row0 + tk, pos = p0 + tk;
            { u32x4 w = *(const u32x4*)(QA + (size_t)row * 512 + F.lane * 8); float x[8]; unpack8(w, x);
              normrope8(x, qkg + 0, lat, pos, ct, st, QSCALE, F.lane); *(u32x4*)(QA + (size_t)row * 512 + F.lane * 8) = pack8(x); }
            { u32x4 w = *(const u32x4*)(QW + (size_t)row * 512 + F.lane * 8); float x[8]; unpack8(w, x);
              normrope8(x, qkg + 128, lat, pos, ct, st, QSCALE, F.lane); *(u32x4*)(QW + (size_t)row * 512 + F.lane * 8) = pack8(x); }
            { const bool isw = (F.lane & 16) != 0; const int l16 = F.lane & 15;
              const bf16_t* src = (isw ? RAWW : RAWA) + (size_t)row * 256 + l16 * 8;
              u32x4 w = *(const u32x4*)src; float x[8]; unpack8(w, x);
              normrope8(x, qkg + (isw ? 192 : 64), lat, pos, ct, st, 1.f, F.lane);
              if (F.lane < 32) *(u32x4*)((isw ? KW : KA) + ((size_t)b * KEYS + j0 + tk) * 128 + l16 * 8) = pack8(x); }
        }
        for (int i = F.tid; i < 2 * 64 * 16; i += NTHR) { const int m = i >> 10, r = (i >> 4) & 63, cch = i & 15;
            const u32x4 w = *(const u32x4*)((m ? RAWW : RAWA) + (size_t)(row0 + r) * 256 + 128 + cch * 8);
            *(LAS u32x4*)((m ? VW_l : VA_l) + r * VROW + cch * 16) = w; }
        {
            const int th = F.tid & 255, half = F.tid >> 8, c = 2 * th;
            float w0[6], w1[6], w2[6], bb[6];
#pragma unroll
            for (int g = 0; g < 3; ++g)
#pragma unroll
                for (int e = 0; e < 2; ++e) { const int ch = g * 512 + c + e; w0[g * 2 + e] = hsw[ch]; w1[g * 2 + e] = hsw[1536 + ch]; w2[g * 2 + e] = hsw[3072 + ch]; bb[g * 2 + e] = hsb[ch]; }
            float up[6], uc[6], un[6];
            const int t0 = 32 * half;
            auto ld = [&](int pos, float (&o)[6]) {
                if (pos < 0 || pos >= n) {
#pragma unroll
                    for (int i = 0; i < 6; ++i) o[i] = 0.f;
                } else { const bf16_t* ur = U + (size_t)(row0 - p0 + pos) * 1536 + c;
#pragma unroll
                    for (int g = 0; g < 3; ++g) { const unsigned w = *(const unsigned*)(ur + g * 512); o[g * 2] = bflo(w); o[g * 2 + 1] = bfhi(w); } } };
            ld(p0 + t0 - 1, up); ld(p0 + t0, uc);
            for (int t = 0; t < 32; ++t) {
                ld(p0 + t0 + t + 1, un);
                float o[6];
#pragma unroll
                for (int i = 0; i < 6; ++i) o[i] = fmaf(w0[i], up[i], fmaf(w1[i], uc[i], fmaf(w2[i], un[i], bb[i])));
                *(unsigned*)(X0 + (size_t)(row0 + t0 + t) * 512 + c) = cvtpk(o[0], o[1]);
                const unsigned pv = cvtpk(o[2] * o[4], o[3] * o[5]);
                *(LAS bf16_t*)(HT_l + (c) * HROW + (t0 + t) * 2) = (bf16_t)(pv & 0xffffu);
                *(LAS bf16_t*)(HT_l + (c + 1) * HROW + (t0 + t) * 2) = (bf16_t)(pv >> 16);
#pragma unroll
                for (int i = 0; i < 6; ++i) { up[i] = uc[i]; uc[i] = un[i]; }
            }
        }
        __syncthreads();
        for (int i = F.tid; i < 2 * 128 * 8; i += NTHR) { const int m = i >> 10, rr = (i >> 3) & 127, c8 = i & 7;
            LAS unsigned char* T = m ? VW_l : VA_l; unsigned short e[8];
#pragma unroll
            for (int jj = 0; jj < 8; ++jj) { const int key = 16 * (c8 >> 1) + 8 * (jj >> 2) + 4 * (c8 & 1) + (jj & 3); e[jj] = *(const LAS bf16_t*)(T + key * VROW + rr * 2); }
            u32x4 w; w.x = e[0] | ((unsigned)e[1] << 16); w.y = e[2] | ((unsigned)e[3] << 16); w.z = e[4] | ((unsigned)e[5] << 16); w.w = e[6] | ((unsigned)e[7] << 16);
            *(u32x4*)((m ? VTW : VTA) + ((size_t)(b * 2 + (rr >> 6)) * 64 + (rr & 63)) * KEYS + j0 + c8 * 8) = w; }
        { bf16_t* VTb = lat ? VT : VT + VT_CTX_OFF;
          for (int i = F.tid; i < 512 * 8; i += NTHR) { const int cch = i >> 3, c8 = i & 7;
              const u32x4 w = *(const LAS u32x4*)(HT_l + cch * HROW + c8 * 16);
              *(u32x4*)(VTb + ((size_t)cch * NB + b) * n + p0 + c8 * 8) = w; } }
    }
    __syncthreads();
}

__device__ __forceinline__ void hyena_final_phase(const Fr& F, const Args& a, int l, bool with_ctx) {
    constexpr int HROW = 144;
    LAS unsigned char* T = F.lds;
    const bf16_t* X0 = (const bf16_t*)(a.ws + WS_H); const bf16_t* VT = (const bf16_t*)(a.ws + WS_VT); const bf16_t* YT = (const bf16_t*)(a.ws + WS_YT);
    bf16_t* YH = (bf16_t*)(a.ws + WS_YH);
    const float* FN = (const float*)(a.ws + WS_FNORM) + l * 1024; const float* skip = a.in[I_HBIAS] + l * 512;
    const int nunits = with_ctx ? NB * 36 : NB * 32;
    for (int unit = F.bid; unit < nunits; unit += F.G) {
        const bool lat = unit < NB * 32;
        const int b = lat ? unit >> 5 : (unit - NB * 32) >> 2, p0 = lat ? (unit & 31) * 64 : ((unit - NB * 32) & 3) * 64;
        const int n = lat ? SEQ : CTX; const int row0 = lat ? b * SEQ + p0 : TL + b * CTX + p0;
        const bf16_t* Yb = lat ? YT : YT + VT_CTX_OFF; const bf16_t* Vb = lat ? VT : VT + VT_CTX_OFF; const float* inv = FN + (lat ? 0 : 512);
        __syncthreads();
        for (int i = F.tid; i < 512 * 8; i += NTHR) { const int cch = i >> 3, c8 = i & 7; const size_t off = ((size_t)cch * NB + b) * n + p0 + c8 * 8;
            const u32x4 y = *(const u32x4*)(Yb + off), v = *(const u32x4*)(Vb + off); const float s = inv[cch], k = skip[cch];
            u32x4 o;
            o.x = cvtpk(bflo(y.x) * s + k * bflo(v.x), bfhi(y.x) * s + k * bfhi(v.x)); o.y = cvtpk(bflo(y.y) * s + k * bflo(v.y), bfhi(y.y) * s + k * bfhi(v.y));
            o.z = cvtpk(bflo(y.z) * s + k * bflo(v.z), bfhi(y.z) * s + k * bfhi(v.z)); o.w = cvtpk(bflo(y.w) * s + k * bflo(v.w), bfhi(y.w) * s + k * bfhi(v.w));
            *(LAS u32x4*)(T + cch * HROW + c8 * 16) = o; }
        __syncthreads();
        { const int th = F.tid & 255, half = F.tid >> 8, c = 2 * th;
          for (int t = 32 * half; t < 32 * half + 32; ++t) {
              const unsigned x0 = *(const unsigned*)(X0 + (size_t)(row0 + t) * 512 + c);
              const float y0 = bf1(*(const LAS bf16_t*)(T + c * HROW + t * 2)), y1 = bf1(*(const LAS bf16_t*)(T + (c + 1) * HROW + t * 2));
              *(unsigned*)(YH + (size_t)(row0 + t) * 512 + c) = cvtpk(bflo(x0) * y0, bfhi(x0) * y1); } }
    }
    __syncthreads();
}

#define MFMA32(a, b, c) __builtin_amdgcn_mfma_f32_32x32x16_bf16((a), (b), (c), 0, 0, 0)
#define MFMA16(a, b, c) __builtin_amdgcn_mfma_f32_16x16x32_bf16((a), (b), (c), 0, 0, 0)

__device__ __forceinline__ int tile_off(int row, int chunk) { return row * 128 + ((chunk ^ ((row >> 1) & 7)) << 4); }

template <bool WIN>
__device__ __forceinline__ void attn_unit(const Fr& F, bf16_t* Qw, const bf16_t* Kb, const bf16_t* VTb, int a0, int na, int b0, int nb, int qpos0, bool has_sink, float sink2) {
    LAS unsigned char* L = F.lds;
    const int r = F.lane & 31, h = F.lane >> 5;
    bf16x8 q[4];
#pragma unroll
    for (int kk = 0; kk < 4; ++kk) q[kk] = *(const bf16x8*)(Qw + (size_t)r * 512 + 16 * kk + 8 * h);
    f32x16 o0, o1;
#pragma unroll
    for (int i = 0; i < 16; ++i) { o0[i] = 0.f; o1[i] = 0.f; }
    float m = -1e30f, lsum = 0.f;
    const int ntile = na + nb;
    const int srow = F.tid >> 3, sch = F.tid & 7;
    u32x4 kreg, vreg;
    { const int kt = a0;
      kreg = *(const u32x4*)(Kb + (size_t)(kt * 64 + srow) * 128 + sch * 8); vreg = *(const u32x4*)(VTb + (size_t)srow * KEYS + kt * 64 + sch * 8); }
    __syncthreads();
    *(LAS u32x4*)(L + tile_off(srow, sch)) = kreg; *(LAS u32x4*)(L + 8192 + tile_off(srow, sch)) = vreg;
    __syncthreads();
    for (int it = 0; it < ntile; ++it) {
        const int kt = it < na ? a0 + it : b0 + (it - na);
        if (it + 1 < ntile) { const int kn = (it + 1) < na ? a0 + it + 1 : b0 + (it + 1 - na);
            kreg = *(const u32x4*)(Kb + (size_t)(kn * 64 + srow) * 128 + sch * 8); vreg = *(const u32x4*)(VTb + (size_t)srow * KEYS + kn * 64 + sch * 8); }
        LAS unsigned char* Kt = L + (it & 1) * 16384; LAS unsigned char* Vt = Kt + 8192;
        f32x16 s0, s1;
#pragma unroll
        for (int i = 0; i < 16; ++i) { s0[i] = 0.f; s1[i] = 0.f; }
#pragma unroll
        for (int kk = 0; kk < 4; ++kk) {
            const bf16x8 ka = *(const LAS bf16x8*)(Kt + tile_off(r, 2 * kk + h)), kb2 = *(const LAS bf16x8*)(Kt + tile_off(32 + r, 2 * kk + h));
            s0 = MFMA32(ka, q[kk], s0); s1 = MFMA32(kb2, q[kk], s1); }
        if (WIN && kt >= 4) {
            const int kbase = (kt - 4) * 64 + 4 * h, qp = qpos0 + r;
#pragma unroll
            for (int i = 0; i < 16; ++i) { const int kr = (i & 3) + 8 * (i >> 2);
                const int d0 = kbase + kr - qp, d1 = d0 + 32;
                if (d0 > 128 || d0 < -128) s0[i] = -1e30f;
                if (d1 > 128 || d1 < -128) s1[i] = -1e30f; }
        }
        float mx = s0[0];
#pragma unroll
        for (int i = 1; i < 16; ++i) mx = fmaxf(mx, s0[i]);
#pragma unroll
        for (int i = 0; i < 16; ++i) mx = fmaxf(mx, s1[i]);
        mx = fmaxf(mx, __shfl_xor(mx, 32));
        const float mn = fmaxf(m, mx), alpha = fast_exp2(m - mn); m = mn;
        float ps = 0.f;
#pragma unroll
        for (int i = 0; i < 16; ++i) { s0[i] = fast_exp2(s0[i] - mn); s1[i] = fast_exp2(s1[i] - mn); ps += s0[i] + s1[i]; }
        lsum = lsum * alpha + ps;
#pragma unroll
        for (int i = 0; i < 16; ++i) { o0[i] *= alpha; o1[i] *= alpha; }
        bf16x8 p[4];
        { u32x4 w;
          w.x = cvtpk(s0[0], s0[1]); w.y = cvtpk(s0[2], s0[3]); w.z = cvtpk(s0[4], s0[5]); w.w = cvtpk(s0[6], s0[7]); p[0] = __builtin_bit_cast(bf16x8, w);
          w.x = cvtpk(s0[8], s0[9]); w.y = cvtpk(s0[10], s0[11]); w.z = cvtpk(s0[12], s0[13]); w.w = cvtpk(s0[14], s0[15]); p[1] = __builtin_bit_cast(bf16x8, w);
          w.x = cvtpk(s1[0], s1[1]); w.y = cvtpk(s1[2], s1[3]); w.z = cvtpk(s1[4], s1[5]); w.w = cvtpk(s1[6], s1[7]); p[2] = __builtin_bit_cast(bf16x8, w);
          w.x = cvtpk(s1[8], s1[9]); w.y = cvtpk(s1[10], s1[11]); w.z = cvtpk(s1[12], s1[13]); w.w = cvtpk(s1[14], s1[15]); p[3] = __builtin_bit_cast(bf16x8, w); }
#pragma unroll
        for (int c = 0; c < 4; ++c) {
            const bf16x8 va = *(const LAS bf16x8*)(Vt + tile_off(r, 2 * c + h)), vb = *(const LAS bf16x8*)(Vt + tile_off(32 + r, 2 * c + h));
            o0 = MFMA32(va, p[c], o0); o1 = MFMA32(vb, p[c], o1); }
        if (it + 1 < ntile) { LAS unsigned char* Kn = L + ((it + 1) & 1) * 16384;
            *(LAS u32x4*)(Kn + tile_off(srow, sch)) = kreg; *(LAS u32x4*)(Kn + 8192 + tile_off(srow, sch)) = vreg; }
        __syncthreads();
    }
    float lt = lsum + __shfl_xor(lsum, 32);
    if (has_sink) lt += fast_exp2(sink2 - m);
    const float inv = 1.f / lt;
#pragma unroll
    for (int g = 0; g < 4; ++g) {
        u32x2 w0, w1;
        w0.x = cvtpk(o0[4 * g] * inv, o0[4 * g + 1] * inv); w0.y = cvtpk(o0[4 * g + 2] * inv, o0[4 * g + 3] * inv);
        w1.x = cvtpk(o1[4 * g] * inv, o1[4 * g + 1] * inv); w1.y = cvtpk(o1[4 * g + 2] * inv, o1[4 * g + 3] * inv);
        *(u32x2*)(Qw + (size_t)r * 512 + 8 * g + 4 * h) = w0;
        *(u32x2*)(Qw + (size_t)r * 512 + 32 + 8 * g + 4 * h) = w1; }
}

__device__ __forceinline__ void hyena_unit_lat(const Fr& F, const bf16_t* Fg, const bf16_t* Vg, bf16_t* Yg) {
    constexpr int FREP = 8192 + 64, VPIT = 4096 + 16, VOFF = 8 * FREP;
    LAS unsigned char* L = F.lds;
    __syncthreads();
    for (int i = F.tid; i < 512; i += NTHR) *(LAS u32x4*)(L + i * 16) = *(const u32x4*)(Fg + i * 8);
    if (F.tid < 4) *(LAS u32x4*)(L + 8192 + F.tid * 16) = (u32x4){0u, 0u, 0u, 0u};
    for (int i = F.tid; i < 16 * 256; i += NTHR) { const int b = i >> 8, x = i & 255; *(LAS u32x4*)(L + VOFF + b * VPIT + x * 16) = *(const u32x4*)(Vg + (size_t)b * SEQ + x * 8); }
    __syncthreads();
    for (int i = F.tid; i < 7 * 2048; i += NTHR) { const int rho = 1 + i / 2048, x2 = (i % 2048) * 2;
        const int s0 = x2 + rho, s1 = x2 + 1 + rho;
        const unsigned e0 = s0 < 4096 ? *(const LAS bf16_t*)(L + s0 * 2) : 0, e1 = s1 < 4096 ? *(const LAS bf16_t*)(L + s1 * 2) : 0;
        *(LAS unsigned*)(L + rho * FREP + x2 * 2) = e0 | (e1 << 16); }
    __syncthreads();
    const int i16 = F.lane & 15, q4 = F.lane >> 4, w = F.wave;
    const int base0 = 2047 - 256 * w - i16 + 8 * q4;
    const int rho = base0 & 7;
    LAS unsigned char* Ap = L + rho * FREP + (base0 - rho) * 2;
    LAS unsigned char* Bp = L + VOFF + i16 * VPIT + q4 * 16;
    bf16x8 A[16]; f32x4 acc[16];
#pragma unroll
    for (int rr = 0; rr < 16; ++rr) { A[rr] = *(const LAS bf16x8*)(Ap - 32 * rr); acc[rr] = (f32x4){0.f, 0.f, 0.f, 0.f}; }
    for (int o = 0; o < 8; ++o) {
#pragma unroll
        for (int u = 0; u < 8; ++u) {
            const int st = o * 8 + u;
            const bf16x8 Bf = *(const LAS bf16x8*)(Bp + 64 * st);
#pragma unroll
            for (int rr = 0; rr < 16; ++rr) acc[rr] = MFMA16(A[(rr - 2 * u) & 15], Bf, acc[rr]);
            if (st < 63) { A[(-2 * u - 2) & 15] = *(const LAS bf16x8*)(Ap + 64 * st + 64); A[(-2 * u - 1) & 15] = *(const LAS bf16x8*)(Ap + 64 * st + 32); }
        }
    }
#pragma unroll
    for (int rr = 0; rr < 16; ++rr) { u32x2 wv; wv.x = cvtpk(acc[rr].x, acc[rr].y); wv.y = cvtpk(acc[rr].z, acc[rr].w);
        *(u32x2*)(Yg + (size_t)i16 * SEQ + 256 * w + 16 * rr + 4 * q4) = wv; }
}
__device__ __forceinline__ void hyena_unit_ctx(const Fr& F, const bf16_t* Fg, const bf16_t* Vg, bf16_t* Yg) {
    constexpr int FREP = 1024 + 64, VPIT = 512 + 16, VOFF = 8 * FREP;
    LAS unsigned char* L = F.lds;
    __syncthreads();
    if (F.tid < 64) *(LAS u32x4*)(L + F.tid * 16) = *(const u32x4*)(Fg + F.tid * 8);
    if (F.tid >= 64 && F.tid < 68) *(LAS u32x4*)(L + 1024 + (F.tid - 64) * 16) = (u32x4){0u, 0u, 0u, 0u};
    { const int b = F.tid >> 5, x = F.tid & 31; *(LAS u32x4*)(L + VOFF + b * VPIT + x * 16) = *(const u32x4*)(Vg + (size_t)b * CTX + x * 8); }
    __syncthreads();
    for (int i = F.tid; i < 7 * 256; i += NTHR) { const int rho = 1 + i / 256, x2 = (i % 256) * 2; const int s0 = x2 + rho, s1 = x2 + 1 + rho;
        const unsigned e0 = s0 < 512 ? *(const LAS bf16_t*)(L + s0 * 2) : 0, e1 = s1 < 512 ? *(const LAS bf16_t*)(L + s1 * 2) : 0;
        *(LAS unsigned*)(L + rho * FREP + x2 * 2) = e0 | (e1 << 16); }
    __syncthreads();
    const int i16 = F.lane & 15, q4 = F.lane >> 4, w = F.wave;
    const int base0 = 255 - 32 * w - i16 + 8 * q4, rho = base0 & 7;
    LAS unsigned char* Ap = L + rho * FREP + (base0 - rho) * 2;
    LAS unsigned char* Bp = L + VOFF + i16 * VPIT + q4 * 16;
    f32x4 acc0 = (f32x4){0.f, 0.f, 0.f, 0.f}, acc1 = acc0;
#pragma unroll
    for (int st = 0; st < 8; ++st) { const bf16x8 Bf = *(const LAS bf16x8*)(Bp + 64 * st);
        const bf16x8 A0 = *(const LAS bf16x8*)(Ap + 64 * st), A1 = *(const LAS bf16x8*)(Ap + 64 * st - 32);
        acc0 = MFMA16(A0, Bf, acc0); acc1 = MFMA16(A1, Bf, acc1); }
    u32x2 wv; wv.x = cvtpk(acc0.x, acc0.y); wv.y = cvtpk(acc0.z, acc0.w); *(u32x2*)(Yg + (size_t)i16 * CTX + 32 * w + 4 * q4) = wv;
    wv.x = cvtpk(acc1.x, acc1.y); wv.y = cvtpk(acc1.z, acc1.w); *(u32x2*)(Yg + (size_t)i16 * CTX + 32 * w + 16 + 4 * q4) = wv;
}

__device__ __forceinline__ void mixer_phase(const Fr& F, const Args& a, int l, bool with_ctx) {
    bf16_t* QA = (bf16_t*)(a.ws + WS_QA); bf16_t* QW = (bf16_t*)(a.ws + WS_QW);
    const bf16_t* KA = (const bf16_t*)(a.ws + WS_KA); const bf16_t* KW = (const bf16_t*)(a.ws + WS_KW);
    const bf16_t* VTA = (const bf16_t*)(a.ws + WS_VTA); const bf16_t* VTW = (const bf16_t*)(a.ws + WS_VTW);
    const float* sinks = a.in[I_SINK] + l * 8;
    const int wq = F.wave >> 1, wh = F.wave & 1;
    for (int unit = F.bid; unit < NB * 2 * 32; unit += F.G) {
        const int b = unit >> 6, kvh = (unit >> 5) & 1, pb = unit & 31;
        bf16_t* Qw = QA + (size_t)(b * SEQ + pb * 64 + wh * 32) * 512 + (kvh * 4 + wq) * 64;
        attn_unit<false>(F, Qw, KA + (size_t)b * KEYS * 128 + kvh * 64, VTA + (size_t)(b * 2 + kvh) * 64 * KEYS, 0, KEYS / 64, 0, 0, 0, false, 0.f);
    }
    for (int unit = F.bid; unit < NB * 2 * 32; unit += F.G) {
        const int b = unit >> 6, kvh = (unit >> 5) & 1, pb = unit & 31;
        bf16_t* Qw = QW + (size_t)(b * SEQ + pb * 64 + wh * 32) * 512 + (kvh * 4 + wq) * 64;
        const int lo = pb - 2 < 0 ? 0 : pb - 2, hi = pb + 2 > 31 ? 31 : pb + 2;
        attn_unit<true>(F, Qw, KW + (size_t)b * KEYS * 128 + kvh * 64, VTW + (size_t)(b * 2 + kvh) * 64 * KEYS, 0, 4, 4 + lo, hi - lo + 1, pb * 64 + wh * 32, true, sinks[kvh * 4 + wq] * LOG2E);
    }
    if (with_ctx) {
        for (int unit = F.bid; unit < 2 * NB * 2 * 4; unit += F.G) {
            const int isw = unit >> 7, u2 = unit & 127, b = u2 >> 3, kvh = (u2 >> 2) & 1, pb = u2 & 3;
            bf16_t* Qw = (isw ? QW : QA) + (size_t)(TL + b * CTX + pb * 64 + wh * 32) * 512 + (kvh * 4 + wq) * 64;
            attn_unit<false>(F, Qw, (isw ? KW : KA) + (size_t)b * KEYS * 128 + kvh * 64, (isw ? VTW : VTA) + (size_t)(b * 2 + kvh) * 64 * KEYS, 0, 4, 0, 0, 0, isw != 0, isw ? sinks[kvh * 4 + wq] * LOG2E : 0.f);
        }
    }
    const bf16_t* FL = (const bf16_t*)(a.ws + WS_FL) + (size_t)l * 512 * 4096; const bf16_t* FC = (const bf16_t*)(a.ws + WS_FC) + (size_t)l * 512 * 512;
    const bf16_t* VT = (const bf16_t*)(a.ws + WS_VT); bf16_t* YT = (bf16_t*)(a.ws + WS_YT);
    for (int c = F.bid; c < HYW; c += F.G) hyena_unit_lat(F, FL + (size_t)c * 4096, VT + (size_t)c * NB * SEQ, YT + (size_t)c * NB * SEQ);
    if (with_ctx) for (int c = F.bid; c < HYW; c += F.G) hyena_unit_ctx(F, FC + (size_t)c * 512, VT + VT_CTX_OFF + (size_t)c * NB * CTX, YT + VT_CTX_OFF + (size_t)c * NB * CTX);
    __syncthreads();
}

struct EpiInProj {
    static constexpr bool PERM = true, AFTER_DRAIN = false;
    bf16_t *QA, *RAWA, *U, *QW, *RAWW, *Gt;
    __device__ __forceinline__ void operator()(const pg8::f32x4 (&acc)[2][2][4][2], const pg8::Unit& u, int wr, int wc, int fr, int fq) const {
        const int pn = u.pn; bf16_t* base; int ldc, colt; bool sig = false;
        if (pn < 2) { base = QA; ldc = 512; colt = pn * 256; }
        else if (pn == 2) { base = RAWA; ldc = 256; colt = 0; }
        else if (pn < 9) { base = U; ldc = 1536; colt = (pn - 3) * 256; }
        else if (pn < 11) { base = QW; ldc = 512; colt = (pn - 9) * 256; }
        else if (pn == 11) { base = RAWW; ldc = 256; colt = 0; }
        else { base = Gt; ldc = 3072; colt = (pn - 12) * 256; sig = true; }
        const int row0 = u.pm * 256 + wr * 64 + fr, col0 = colt + wc * 32 + 8 * fq;
#pragma unroll
        for (int ai = 0; ai < 2; ++ai)
#pragma unroll
            for (int m = 0; m < 4; ++m) { bf16_t* rowp = base + (size_t)(row0 + ai * 128 + m * 16) * ldc + col0;
#pragma unroll
                for (int bj = 0; bj < 2; ++bj) { pg8::f32x4 v0 = acc[ai][bj][m][0], v1 = acc[ai][bj][m][1];
                    if (sig) { v0.x = sigmoid_f(v0.x); v0.y = sigmoid_f(v0.y); v0.z = sigmoid_f(v0.z); v0.w = sigmoid_f(v0.w); v1.x = sigmoid_f(v1.x); v1.y = sigmoid_f(v1.y); v1.z = sigmoid_f(v1.z); v1.w = sigmoid_f(v1.w); }
                    u32x4 w; w.x = cvtpk(v0.x, v0.y); w.y = cvtpk(v0.z, v0.w); w.z = cvtpk(v1.x, v1.y); w.w = cvtpk(v1.z, v1.w);
                    *(u32x4*)(rowp + bj * 128) = w; } }
    }
};
template <int B> struct EpiMerge {
    static constexpr bool PERM = true, AFTER_DRAIN = false;
    bf16_t* Mo; const bf16_t* Gt;
    __device__ __forceinline__ void operator()(const pg8::f32x4 (&acc)[2][2][4][2], const pg8::Unit& u, int wr, int wc, int fr, int fq) const {
        const int row0 = u.pm * 256 + wr * 64 + fr, col0 = u.pn * 256 + wc * 32 + 8 * fq;
#pragma unroll
        for (int ai = 0; ai < 2; ++ai)
#pragma unroll
            for (int m = 0; m < 4; ++m) { const size_t row = (size_t)(row0 + ai * 128 + m * 16);
#pragma unroll
                for (int bj = 0; bj < 2; ++bj) { const pg8::f32x4 v0 = acc[ai][bj][m][0], v1 = acc[ai][bj][m][1];
                    const u32x4 g = *(const u32x4*)(Gt + row * 3072 + B * 1024 + col0 + bj * 128);
                    float o[8] = {v0.x * bflo(g.x), v0.y * bfhi(g.x), v0.z * bflo(g.y), v0.w * bfhi(g.y), v1.x * bflo(g.z), v1.y * bfhi(g.z), v1.z * bflo(g.w), v1.w * bfhi(g.w)};
                    bf16_t* mp = Mo + row * 1024 + col0 + bj * 128;
                    if (B > 0) { const u32x4 p = *(const u32x4*)mp; o[0] += bflo(p.x); o[1] += bfhi(p.x); o[2] += bflo(p.y); o[3] += bfhi(p.y); o[4] += bflo(p.z); o[5] += bfhi(p.z); o[6] += bflo(p.w); o[7] += bfhi(p.w); }
                    u32x4 w; w.x = cvtpk(o[0], o[1]); w.y = cvtpk(o[2], o[3]); w.z = cvtpk(o[4], o[5]); w.w = cvtpk(o[6], o[7]);
                    *(u32x4*)mp = w; } }
    }
};
struct EpiOut {
    static constexpr bool PERM = true, AFTER_DRAIN = false;
    const float* xsL; const float* xsC; float* xdL; float* xdC; const float* MODl;
    __device__ __forceinline__ void operator()(const pg8::f32x4 (&acc)[2][2][4][2], const pg8::Unit& u, int wr, int wc, int fr, int fq) const {
        const int row0 = u.pm * 256 + wr * 64 + fr, col0 = u.pn * 256 + wc * 32 + 8 * fq;
#pragma unroll
        for (int ai = 0; ai < 2; ++ai)
#pragma unroll
            for (int m = 0; m < 4; ++m) { const int row = row0 + ai * 128 + m * 16; const bool lat = row < TL;
                const float* xs = lat ? xsL + (size_t)row * D : xsC + (size_t)(row - TL) * D; float* xd = lat ? xdL + (size_t)row * D : xdC + (size_t)(row - TL) * D;
                const float* md = MODl + (size_t)mod_row(row) * DIN + 2 * 1024;
#pragma unroll
                for (int bj = 0; bj < 2; ++bj)
#pragma unroll
                    for (int n = 0; n < 2; ++n) { const int col = col0 + bj * 128 + 4 * n;
                        const f32x4 xv = *(const f32x4*)(xs + col), mv = *(const f32x4*)(md + col); const pg8::f32x4 av = acc[ai][bj][m][n];
                        f32x4 o; o.x = xv.x + mv.x * av.x; o.y = xv.y + mv.y * av.y; o.z = xv.z + mv.z * av.z; o.w = xv.w + mv.w * av.w;
                        *(f32x4*)(xd + col) = o; } }
    }
};
struct EpiMoe1 {
    static constexpr bool PERM = true, AFTER_DRAIN = false;
    bf16_t* HM;
    __device__ __forceinline__ void operator()(const pg8::f32x4 (&acc)[2][2][4][2], const pg8::Unit& u, int wr, int wc, int fr, int fq) const {
        const int row0 = u.pm * 256 + wr * 64 + fr, hcol0 = (u.pn & 3) * 128 + wc * 16 + 4 * fq;
#pragma unroll
        for (int ai = 0; ai < 2; ++ai)
#pragma unroll
            for (int m = 0; m < 4; ++m) { bf16_t* rowp = HM + (size_t)(row0 + ai * 128 + m * 16) * 512 + hcol0;
#pragma unroll
                for (int bj = 0; bj < 2; ++bj) { const pg8::f32x4 x = acc[ai][bj][m][0], y = acc[ai][bj][m][1];
                    u32x2 w; w.x = cvtpk(x.x * sigmoid_f(x.x) * y.x, x.y * sigmoid_f(x.y) * y.y); w.y = cvtpk(x.z * sigmoid_f(x.z) * y.z, x.w * sigmoid_f(x.w) * y.w);
                    *(u32x2*)(rowp + bj * 64) = w; } }
    }
};
struct EpiMoe2 {
    static constexpr bool PERM = true, AFTER_DRAIN = false;
    bf16_t* Fo; const int* rowmap; const float* roww;
    __device__ __forceinline__ void operator()(const pg8::f32x4 (&acc)[2][2][4][2], const pg8::Unit& u, int wr, int wc, int fr, int fq) const {
        const int row0 = u.pm * 256 + wr * 64 + fr, col0 = (u.pn & 3) * 256 + wc * 32 + 8 * fq;
#pragma unroll
        for (int ai = 0; ai < 2; ++ai)
#pragma unroll
            for (int m = 0; m < 4; ++m) { const int row = row0 + ai * 128 + m * 16; const int rm = rowmap[row];
                if (rm >= 0) { const float wgt = roww[row]; bf16_t* rowp = Fo + ((size_t)(rm & 1) * TT + (rm >> 1)) * D + col0;
#pragma unroll
                    for (int bj = 0; bj < 2; ++bj) { const pg8::f32x4 v0 = acc[ai][bj][m][0], v1 = acc[ai][bj][m][1];
                        u32x4 w; w.x = cvtpk(v0.x * wgt, v0.y * wgt); w.y = cvtpk(v0.z * wgt, v0.w * wgt); w.z = cvtpk(v1.x * wgt, v1.y * wgt); w.w = cvtpk(v1.z * wgt, v1.w * wgt);
                        *(u32x4*)(rowp + bj * 128) = w; } } }
    }
};
struct MoeOrder {
    int nunits, G, c; const LAS int* tile_e;
    __device__ __forceinline__ bool next(int i, pg8::Unit& u) const {
        const int L = i * G + c; if (L >= nunits) return false;
        const int pm = L >> 2; u.pm = pm; u.pn = __builtin_amdgcn_readfirstlane(tile_e[pm]) * 4 + (L & 3); return true; }
    __device__ __forceinline__ void a_ready(const pg8::Unit&) const {}
    __device__ __forceinline__ void done(const pg8::Unit&) const {}
};

__device__ __forceinline__ int moe_tables(const Fr& F, const Args& a, int l, LAS int* ebase  , LAS int* ecnt  , LAS int* tile_e  ) {
    const unsigned* CNT = (const unsigned*)(a.ws + WS_CTL) + CW_CNT + l * 256;
    __syncthreads();
    if (F.tid == 0) { int acc = 0;
        for (int e = 0; e < NE; ++e) { const int c = (int)__hip_atomic_load(&CNT[e * 16], __ATOMIC_RELAXED, __HIP_MEMORY_SCOPE_AGENT); ecnt[e] = c; ebase[e] = acc; const int nt = (c + 255) >> 8;
            for (int t = 0; t < nt; ++t) tile_e[(acc >> 8) + t] = e; acc += nt << 8; }
        ebase[NE] = acc; }
    __syncthreads();
    return ebase[NE] >> 8;
}

__device__ __forceinline__ void gather_phase(const Fr& F, const Args& a, int l, int nrows) {
    LAS int* ebase = (LAS int*)(F.lds + MISC_OFF + 64); LAS int* ecnt = ebase + 20; LAS int* tile_e = (LAS int*)(F.lds + MISC_OFF + 512);
    (void)moe_tables(F, a, l, ebase, ecnt, tile_e);
    const bf16_t* H = (const bf16_t*)(a.ws + WS_H); bf16_t* AP = (bf16_t*)(a.ws + WS_G);
    const int* TOKE = (const int*)(a.ws + WS_TOKE); const int* TOKP = (const int*)(a.ws + WS_TOKP); const float* TOKW = (const float*)(a.ws + WS_TOKW);
    int* rowmap = (int*)(a.ws + WS_ROWMAP); float* roww = (float*)(a.ws + WS_ROWW);
    const int gw = F.bid * NWAVES + F.wave, NGW = F.G * NWAVES;
    for (int row = gw; row < nrows; row += NGW) {
        const u32x4 v0 = *(const u32x4*)(H + (size_t)row * D + F.lane * 8), v1 = *(const u32x4*)(H + (size_t)row * D + 512 + F.lane * 8);
#pragma unroll
        for (int k = 0; k < 2; ++k) { const int dest = ebase[TOKE[2 * row + k]] + TOKP[2 * row + k];
            *(u32x4*)(AP + (size_t)dest * D + F.lane * 8) = v0; *(u32x4*)(AP + (size_t)dest * D + 512 + F.lane * 8) = v1;
            if (F.lane == 0) { rowmap[dest] = row * 2 + k; roww[dest] = TOKW[2 * row + k]; } }
    }
    for (int e = F.bid; e < NE; e += F.G) { const int lo = ebase[e] + ecnt[e], hi = ebase[e + 1];
        for (int rr = lo + F.wave; rr < hi; rr += NWAVES) { *(u32x4*)(AP + (size_t)rr * D + F.lane * 8) = (u32x4){0u, 0u, 0u, 0u}; *(u32x4*)(AP + (size_t)rr * D + 512 + F.lane * 8) = (u32x4){0u, 0u, 0u, 0u};
            if (F.lane == 0) rowmap[rr] = -1; } }
}

#ifndef MK_PER_PHASE
#define MK_PER_PHASE 0
#endif
constexpr int PH_PER_LAYER = 11, PH_FINAL = 1 + NL * PH_PER_LAYER, N_PHASES = PH_FINAL + 1;

__global__ void __launch_bounds__(NTHR, 2) trunk_fwd(Args args) {
    extern __shared__ __attribute__((aligned(16))) unsigned char lds[];
    Fr F; F.lds = (LAS unsigned char*)lds; F.tid = threadIdx.x; F.lane = F.tid & 63; F.wave = __builtin_amdgcn_readfirstlane(F.tid >> 6); F.G = gridDim.x; F.bid = blockIdx.x;
    for (int u = F.tid; u < (LDS_BYTES - MISC_OFF) / 4; u += NTHR) ((LAS unsigned*)(F.lds + MISC_OFF))[u] = 0u;
    __syncthreads();
    const int lo = args.ph_lo, hi = args.ph_hi;
    unsigned* ctl = (unsigned*)(args.ws + WS_CTL);
    XcdBarrier bar; bar.bar = ctl + CW_BAR; bar.x = 0; bar.st = (volatile LAS unsigned*)(F.lds + MISC_OFF);
    if (hi - lo > 1) bar = xcd_barrier_post(ctl + CW_BAR, (volatile LAS unsigned*)(F.lds + MISC_OFF));
#ifndef DBG_ONLY
#define DBG_ONLY -1
#endif
#define SEL(p) (DBG_ONLY < 0 || DBG_ONLY == (p))
#define IN(k) (lo <= (k) && (k) < hi)
#define FRESH() do { int t_ = threadIdx.x; asm volatile("" : "+v"(t_)); F.tid = t_; F.lane = t_ & 63; F.wave = __builtin_amdgcn_readfirstlane(t_ >> 6); } while (0)
#define SEAM(k) do { if (IN(k) && IN((k) + 1)) xcd_barrier(bar); } while (0)
    unsigned char* ws = args.ws;
    LAS int* ebase = (LAS int*)(F.lds + MISC_OFF + 64); LAS int* ecnt = ebase + 20; LAS int* tile_e = (LAS int*)(F.lds + MISC_OFF + 512);

    #ifndef DBG_PRO
#define DBG_PRO 7
#endif
    if (SEL(100) && IN(0)) { FRESH(); if (DBG_PRO & 1) pro_mod(F, args); __syncthreads(); if (DBG_PRO & 2) pro_rope(F, args); if (DBG_PRO & 4) pro_filter(F, args); __syncthreads(); }
    SEAM(0);
    for (int l = 0; l < NL; ++l) {
        const int pb = 1 + PH_PER_LAYER * l; const bool uc = l < NL - 1; const int M2 = uc ? TT : TL;
        if (SEL(0) && IN(pb + 0)) { FRESH(); if (l == 0) filter_norm_reduce(F, args); conv_small_weights(F, args, l); rows_p0(F, args, l, TT); __syncthreads(); }
        SEAM(pb + 0);
        if (SEL(1) && IN(pb + 1)) {
            pg8::Gemm g{(const bf16_t*)(ws + WS_H), (const bf16_t*)(ws + WS_WIN), TT, DIN, 1024}; pg8::StaticOrder S; S.init(TT, DIN, F.G, F.bid);
            EpiInProj E{(bf16_t*)(ws + WS_QA), (bf16_t*)(ws + WS_RAWA), (bf16_t*)(ws + WS_U), (bf16_t*)(ws + WS_QW), (bf16_t*)(ws + WS_RAWW), (bf16_t*)(ws + WS_G)};
            pg8::gemm_phase<EpiInProj, pg8::StaticOrder, true, true>(F.lds, g, S, E);
        }
        SEAM(pb + 1);
        if (SEL(2) && IN(pb + 2)) { FRESH(); prep_phase(F, args, l); }
        SEAM(pb + 2);
        if (SEL(3) && IN(pb + 3)) { FRESH(); mixer_phase(F, args, l, uc); }
        SEAM(pb + 3);
        if (SEL(4) && IN(pb + 4)) { FRESH(); hyena_final_phase(F, args, l, uc); }
        SEAM(pb + 4);
        if (SEL(5) && IN(pb + 5)) {
            pg8::StaticOrder S; S.init(M2, 1024, F.G, F.bid);
            { pg8::Gemm g{(const bf16_t*)(ws + WS_QA), (const bf16_t*)(ws + WS_WBR), M2, 1024, 512}; EpiMerge<0> E{(bf16_t*)(ws + WS_H), (const bf16_t*)(ws + WS_G)};
              pg8::gemm_phase<EpiMerge<0>, pg8::StaticOrder, true, true>(F.lds, g, S, E); }
            { pg8::Gemm g{(const bf16_t*)(ws + WS_YH), (const bf16_t*)(ws + WS_WBR) + (size_t)1024 * 512, M2, 1024, 512}; EpiMerge<1> E{(bf16_t*)(ws + WS_H), (const bf16_t*)(ws + WS_G)};
              pg8::gemm_phase<EpiMerge<1>, pg8::StaticOrder, true, true>(F.lds, g, S, E); }
            { pg8::Gemm g{(const bf16_t*)(ws + WS_QW), (const bf16_t*)(ws + WS_WBR) + (size_t)2 * 1024 * 512, M2, 1024, 512}; EpiMerge<2> E{(bf16_t*)(ws + WS_H), (const bf16_t*)(ws + WS_G)};
              pg8::gemm_phase<EpiMerge<2>, pg8::StaticOrder, true, true>(F.lds, g, S, E); }
        }
        SEAM(pb + 5);
        if (SEL(6) && IN(pb + 6)) {
            pg8::Gemm g{(const bf16_t*)(ws + WS_H), (const bf16_t*)(ws + WS_WOUT), M2, 1024, 1024}; pg8::StaticOrder S; S.init(M2, 1024, F.G, F.bid);
            EpiOut E{l == 0 ? args.in[I_X] : args.out, l == 0 ? args.in[I_CTX] : (const float*)(ws + WS_XC), args.out, (float*)(ws + WS_XC), (const float*)(ws + WS_MOD) + (size_t)l * NBM * DIN};
            pg8::gemm_phase<EpiOut, pg8::StaticOrder, true, true>(F.lds, g, S, E);
        }
        SEAM(pb + 6);
        if (SEL(7) && IN(pb + 7)) { FRESH(); rows_p5(F, args, l, M2); conv_expert_weights(F, args, l); __syncthreads(); }
        SEAM(pb + 7);
        if (SEL(8) && IN(pb + 8)) { FRESH(); gather_phase(F, args, l, M2); }
        SEAM(pb + 8);
        if (SEL(9) && IN(pb + 9)) { FRESH();
            const int ntile = moe_tables(F, args, l, ebase, ecnt, tile_e);
            pg8::Gemm g{(const bf16_t*)(ws + WS_G), (const bf16_t*)(ws + WS_W13), ntile * 256, NE * 1024, 1024}; MoeOrder S{ntile * 4, F.G, F.bid, tile_e};
            EpiMoe1 E{(bf16_t*)(ws + WS_U)};
            pg8::gemm_phase<EpiMoe1, MoeOrder, true, true>(F.lds, g, S, E);
        }
        SEAM(pb + 9);
        if (SEL(10) && IN(pb + 10)) { FRESH();
            const int ntile = moe_tables(F, args, l, ebase, ecnt, tile_e);
            pg8::Gemm g{(const bf16_t*)(ws + WS_U), (const bf16_t*)(ws + WS_W2), ntile * 256, NE * 1024, 512}; MoeOrder S{ntile * 4, F.G, F.bid, tile_e};
            EpiMoe2 E{(bf16_t*)(ws + WS_F), (const int*)(ws + WS_ROWMAP), (const float*)(ws + WS_ROWW)};
            pg8::gemm_phase<EpiMoe2, MoeOrder, true, true>(F.lds, g, S, E);
        }
        SEAM(pb + 10);
    }
    if (SEL(101) && IN(PH_FINAL)) { FRESH(); rows_final(F, args); }
#undef IN
#undef SEAM
}

__global__ void dbg_dump(const unsigned char* src, size_t nelem, int is_f32, float* out, size_t nout) {
    for (size_t i = (size_t)blockIdx.x * blockDim.x + threadIdx.x; i < nout; i += (size_t)gridDim.x * blockDim.x) {
        const size_t j = i % nelem; out[i] = is_f32 ? ((const float*)src)[j] : bf1(((const bf16_t*)src)[j]); }
}
extern "C" void kernel_launch(void* const* d_in, const int* in_sizes, int n_in, void* d_out, int out_size, void* d_ws, size_t ws_size, hipStream_t stream) {
    static int grid = 0;
    if (grid == 0) {
        if (n_in != 29 || in_sizes[0] != TL * D || out_size != TL * D || ws_size < WS_END) { fprintf(stderr, "kernel_launch: unexpected shapes / workspace (n_in %d, ws %zu < %zu); nothing launched\n", n_in, ws_size, (size_t)WS_END); grid = -1; return; }
        int dev = 0, cus = 0, per_cu = 0;
        if (hipGetDevice(&dev) != hipSuccess || hipDeviceGetAttribute(&cus, hipDeviceAttributeMultiprocessorCount, dev) != hipSuccess) { grid = -1; return; }
        if (hipFuncSetAttribute((const void*)trunk_fwd, hipFuncAttributeMaxDynamicSharedMemorySize, LDS_BYTES) != hipSuccess) { fprintf(stderr, "kernel_launch: hipFuncSetAttribute failed\n"); grid = -1; return; }
        if (hipOccupancyMaxActiveBlocksPerMultiprocessor(&per_cu, (const void*)trunk_fwd, NTHR, LDS_BYTES) != hipSuccess || per_cu < 1) { fprintf(stderr, "kernel_launch: occupancy query reports %d\n", per_cu); }
        (void)hipGetLastError();
        grid = cus;
    }
    if (grid < 0) return;
    (void)hipMemsetAsync((char*)d_ws + WS_CTL, 0, CTL_ZERO_BYTES, stream);
    Args a{};
    for (int i = 0; i < 29; ++i) a.in[i] = (const float*)d_in[i];
    a.out = (float*)d_out; a.ws = (unsigned char*)d_ws;
#if defined(DBG_STOP)
    for (int k = 0; k <= DBG_STOP; ++k) { a.ph_lo = k; a.ph_hi = k + 1; hipLaunchKernelGGL(trunk_fwd, dim3(grid), dim3(NTHR), LDS_BYTES, stream, a); }
#if defined(DBG_DUMP_OFF)
    hipLaunchKernelGGL(dbg_dump, dim3(2048), dim3(256), 0, stream, (const unsigned char*)d_ws + (size_t)(DBG_DUMP_OFF), (size_t)(DBG_DUMP_N), (int)(DBG_DUMP_F32), (float*)d_out, (size_t)out_size);
#endif
#elif MK_PER_PHASE
    for (int k = 0; k < N_PHASES; ++k) { a.ph_lo = k; a.ph_hi = k + 1; hipLaunchKernelGGL(trunk_fwd, dim3(grid), dim3(NTHR), LDS_BYTES, stream, a); }
#else
    a.ph_lo = 0; a.ph_hi = N_PHASES;
    hipLaunchKernelGGL(trunk_fwd, dim3(grid), dim3(NTHR), LDS_BYTES, stream, a);
#endif
}
```

```cpp
#include <hip/hip_runtime.h>
#include <cstdio>
#include <cstdint>

#define GAS __attribute__((address_space(1)))
#define LAS __attribute__((address_space(3)))
#define MK_PER_PHASE 0
namespace pg8 {
#define PG8_LAS __attribute__((address_space(3)))
typedef unsigned short bf16_t;
typedef short bf16x8 __attribute__((ext_vector_type(8)));
typedef float f32x4 __attribute__((ext_vector_type(4)));
typedef unsigned u32x4 __attribute__((ext_vector_type(4)));
constexpr int BM = 256, BK = 64, HALF = 128, HTB = HALF * BK * 2  , STAGE_BYTES = 8 * HTB, NXCD = 8, WGM = 8;

__host__ __device__ __forceinline__ int lds_byte(int r, int c) { const int st = (r >> 4) * 2 + (c >> 5), rr = r & 15, cc = c & 31, ob = rr * 64 + cc * 2; return st * 1024 + (ob ^ (((ob >> 9) & 1) << 5)); }
__host__ __device__ __forceinline__ void stage_rc(int b, int& R, int& C) { const int st = b / 1024, sb = b % 1024, swz = sb ^ (((sb >> 9) & 1) << 5); R = (st >> 1) * 16 + swz / 64; C = (st & 1) * 32 + (swz % 64) / 2; }
__host__ __device__ __forceinline__ int perm32(int rho) { const int n = rho >> 4, i = rho & 15; return 8 * (i >> 2) + 4 * n + (i & 3); }

struct Unit { int pm, pn; };
struct Gemm { const bf16_t* A; const bf16_t* Bt; int M, N, K; };

struct StaticOrder {
    int nM, nN, nwg, G, c;
    __host__ __device__ void init(int M, int N, int G_, int c_) { nM = M / BM; nN = N / BM; nwg = nM * nN; G = G_; c = c_; }
    __host__ __device__ bool next(int i, Unit& u) const {
        const long L = (long)i * G + c; if (L >= nwg) return false;
        int wgid = (int)L; { const int q = nwg / NXCD, r = nwg % NXCD, xcd = wgid % NXCD, off = wgid / NXCD; wgid = (xcd < r ? xcd * (q + 1) : r * (q + 1) + (xcd - r) * q) + off; }
        const int nig = WGM * nN, gid = wgid / nig, fm = gid * WGM, gsz = (nM - fm) < WGM ? (nM - fm) : WGM;
        u.pm = fm + ((wgid % nig) % gsz); u.pn = (wgid % nig) / gsz; return true;
    }
    __device__ __forceinline__ void a_ready(const Unit&) const {}
    __device__ __forceinline__ void done(const Unit&) const {}
};
__device__ __forceinline__ unsigned cvt_pk_bf16(float lo, float hi) { unsigned r; asm volatile("v_cvt_pk_bf16_f32 %0, %1, %2" : "=v"(r) : "v"(lo), "v"(hi)); return r; }
typedef float f32x2 __attribute__((ext_vector_type(2)));
template <class Epi, class Sched, bool ALIGN_EPI = false, bool SP2 = false>
__device__ __forceinline__ void gemm_phase(PG8_LAS unsigned char* lds, const Gemm g, const Sched& S, const Epi& E) {
    int tid_ = threadIdx.x; asm volatile("" : "+v"(tid_));
    const int tid = tid_, wid = __builtin_amdgcn_readfirstlane(tid >> 6), lane = tid & 63, wr = wid >> 2, wc = wid & 3, fr = lane & 15, fq = lane >> 4;
    const int K = g.K, nt = K / BK;
    unsigned voffA[2], voffB[2];
#pragma unroll
    for (int i = 0; i < 2; ++i) { int R, C; stage_rc(tid * 16 + i * 8192, R, C); const int Rb = Epi::PERM ? ((R & ~31) + perm32(R & 31)) : R;
        voffA[i] = (unsigned)(R * K + C) * 2u; voffB[i] = (unsigned)(Rb * K + C) * 2u; }
    const size_t kstep = (size_t)(BK * 2);
    const size_t hstep = (size_t)HALF * K * 2;
    const size_t tstep = 2 * hstep;
    const unsigned ldsw = (unsigned)wid * 1024u;
    const int aoff = lds_byte(wr * 64 + fr, fq * 8), boff = lds_byte(wc * 32 + fr, fq * 8);
#define PG8_SA(b, h) (((b) * 2 + (h)) * HTB)
#define PG8_SB(b, h) ((4 + (b) * 2 + (h)) * HTB)
#define PG8_STAGE(bufoff, gbase, voff) do { _Pragma("unroll") for (int _i = 0; _i < 2; ++_i) \
        __builtin_amdgcn_global_load_lds((const unsigned*)((const char*)(gbase) + (voff)[_i]), (PG8_LAS unsigned*)(lds + (bufoff) + ldsw + _i * 8192), 16, 0, 0); } while (0)
#define PG8_LDA(dst, b, h) do { _Pragma("unroll") for (int m = 0; m < 4; ++m) _Pragma("unroll") for (int k = 0; k < 2; ++k) dst[m][k] = *(const PG8_LAS bf16x8*)(lds + PG8_SA(b, h) + aoff + m * 2048 + k * 1024); } while (0)
#define PG8_LDB(dst, b, h) do { _Pragma("unroll") for (int n = 0; n < 2; ++n) _Pragma("unroll") for (int k = 0; k < 2; ++k) dst[n][k] = *(const PG8_LAS bf16x8*)(lds + PG8_SB(b, h) + boff + n * 2048 + k * 1024); } while (0)
#define PG8_MMA(ai, bj, At, Bt) do { __builtin_amdgcn_s_setprio(1); _Pragma("unroll") for (int m = 0; m < 4; ++m) _Pragma("unroll") for (int n = 0; n < 2; ++n) _Pragma("unroll") for (int k = 0; k < 2; ++k) \
        acc[ai][bj][m][n] = __builtin_amdgcn_mfma_f32_16x16x32_bf16(Bt[n][k], At[m][k], acc[ai][bj][m][n], 0, 0, 0); __builtin_amdgcn_s_setprio(0); } while (0)
#define PG8_WAIT_V(n) asm volatile("s_waitcnt vmcnt(" #n ")" ::: "memory")
#define PG8_WAIT_L(n) asm volatile("s_waitcnt lgkmcnt(" #n ")" ::: "memory")
#define PG8_BAR __builtin_amdgcn_s_barrier()
#define PG8_SCHED __builtin_amdgcn_sched_barrier(0)
    Unit cur, nxt; int ui = 0;
    if (!S.next(0, cur)) return;
    f32x4 acc[2][2][4][2];
#pragma unroll
    for (int a = 0; a < 2; ++a)
#pragma unroll
        for (int b = 0; b < 2; ++b)
#pragma unroll
            for (int m = 0; m < 4; ++m)
#pragma unroll
                for (int n = 0; n < 2; ++n) acc[a][b][m][n] = (f32x4){0.f, 0.f, 0.f, 0.f};
    bf16x8 At[4][2], B0[2][2], B1[2][2];
    const char* cA = (const char*)g.A + (size_t)cur.pm * tstep; const char* cB = (const char*)g.Bt + (size_t)cur.pn * tstep;
    S.a_ready(cur);
    if constexpr (SP2) {
        PG8_STAGE(PG8_SB(0, 0), cB, voffB); PG8_STAGE(PG8_SB(0, 1), cB + hstep, voffB); PG8_STAGE(PG8_SA(0, 0), cA, voffA); PG8_STAGE(PG8_SA(0, 1), cA + hstep, voffA);
        if (wr == 1) PG8_BAR;
        PG8_WAIT_V(2); PG8_BAR;
        PG8_STAGE(PG8_SB(1, 0), cB + kstep, voffB); PG8_STAGE(PG8_SA(1, 0), cA + kstep, voffA); PG8_STAGE(PG8_SB(1, 1), cB + hstep + kstep, voffB);
        PG8_WAIT_V(6); PG8_BAR;
    } else {
        PG8_STAGE(PG8_SB(0, 0), cB, voffB); PG8_STAGE(PG8_SA(0, 0), cA, voffA); PG8_STAGE(PG8_SB(0, 1), cB + hstep, voffB); PG8_STAGE(PG8_SA(0, 1), cA + hstep, voffA);
        if (wr == 1) PG8_BAR;
        PG8_WAIT_V(4); PG8_BAR;
        PG8_STAGE(PG8_SB(1, 0), cB + kstep, voffB); PG8_STAGE(PG8_SA(1, 0), cA + kstep, voffA); PG8_STAGE(PG8_SB(1, 1), cB + hstep + kstep, voffB);
        PG8_WAIT_V(6); PG8_BAR;
    }
    for (;;) {
        const bool has_next = S.next(ui + 1, nxt);
        const char* nA = has_next ? (const char*)g.A + (size_t)nxt.pm * tstep : cA; const char* nB = has_next ? (const char*)g.Bt + (size_t)nxt.pn * tstep : cB;
        for (int t = 0; t < nt; t += 2) {
            const bool last = (t == nt - 2);
            const char* a1 = cA + (size_t)(t + 1) * kstep;
            const char* a2 = last ? nA : cA + (size_t)(t + 2) * kstep; const char* b2 = last ? nB : cB + (size_t)(t + 2) * kstep;
            const char* a3 = a2 + kstep; const char* b3 = b2 + kstep;
            if (last && has_next) S.a_ready(nxt);
            if constexpr (SP2) {
            PG8_LDB(B0, 0, 0); PG8_LDB(B1, 0, 1); PG8_SCHED; PG8_LDA(At, 0, 0); PG8_STAGE(PG8_SA(1, 1), a1 + hstep, voffA);
            PG8_WAIT_V(8); PG8_WAIT_L(0); PG8_BAR; PG8_MMA(0, 0, At, B0); PG8_MMA(0, 1, At, B1); PG8_BAR; PG8_SCHED;
            PG8_LDA(At, 0, 1); PG8_STAGE(PG8_SB(0, 0), b2, voffB); PG8_STAGE(PG8_SB(0, 1), b2 + hstep, voffB); PG8_STAGE(PG8_SA(0, 0), a2, voffA);
            PG8_WAIT_V(8); PG8_WAIT_L(0); PG8_BAR; PG8_MMA(1, 0, At, B0); PG8_MMA(1, 1, At, B1); PG8_BAR; PG8_SCHED;
            PG8_LDB(B0, 1, 0); PG8_LDB(B1, 1, 1); PG8_SCHED; PG8_LDA(At, 1, 0); PG8_STAGE(PG8_SA(0, 1), a2 + hstep, voffA);
            PG8_WAIT_V(8); PG8_WAIT_L(0); PG8_BAR; PG8_MMA(0, 0, At, B0); PG8_MMA(0, 1, At, B1); PG8_BAR; PG8_SCHED;
            PG8_LDA(At, 1, 1); PG8_STAGE(PG8_SB(1, 0), b3, voffB); PG8_STAGE(PG8_SB(1, 1), b3 + hstep, voffB); PG8_STAGE(PG8_SA(1, 0), a3, voffA);
            PG8_WAIT_V(8); PG8_WAIT_L(0); PG8_BAR; PG8_MMA(1, 0, At, B0); PG8_MMA(1, 1, At, B1); PG8_BAR; PG8_SCHED;
            } else {
            PG8_LDB(B0, 0, 0); PG8_SCHED; PG8_LDA(At, 0, 0); PG8_STAGE(PG8_SA(1, 1), a1 + hstep, voffA);
            PG8_WAIT_L(8); PG8_BAR; PG8_WAIT_L(0); PG8_MMA(0, 0, At, B0); PG8_BAR; PG8_SCHED;
            PG8_LDB(B1, 0, 1); PG8_STAGE(PG8_SB(0, 0), b2, voffB);
            PG8_BAR; PG8_WAIT_L(0); PG8_MMA(0, 1, At, B1); PG8_BAR;
            PG8_LDA(At, 0, 1); PG8_STAGE(PG8_SA(0, 0), a2, voffA);
            PG8_BAR; PG8_WAIT_L(0); PG8_MMA(1, 0, At, B0); PG8_BAR; PG8_SCHED;
            PG8_STAGE(PG8_SB(0, 1), b2 + hstep, voffB);
            PG8_WAIT_V(6); PG8_BAR; PG8_MMA(1, 1, At, B1); PG8_BAR;
            PG8_LDB(B0, 1, 0); PG8_SCHED; PG8_LDA(At, 1, 0); PG8_STAGE(PG8_SA(0, 1), a2 + hstep, voffA);
            PG8_WAIT_L(8); PG8_BAR; PG8_WAIT_L(0); PG8_MMA(0, 0, At, B0); PG8_BAR; PG8_SCHED;
            PG8_LDB(B1, 1, 1); PG8_STAGE(PG8_SB(1, 0), b3, voffB);
            PG8_BAR; PG8_WAIT_L(0); PG8_MMA(0, 1, At, B1); PG8_BAR;
            PG8_LDA(At, 1, 1); PG8_STAGE(PG8_SA(1, 0), a3, voffA);
            PG8_BAR; PG8_WAIT_L(0); PG8_MMA(1, 0, At, B0); PG8_BAR; PG8_SCHED;
            PG8_STAGE(PG8_SB(1, 1), b3 + hstep, voffB);
            PG8_WAIT_V(6); PG8_BAR; PG8_MMA(1, 1, At, B1); PG8_BAR;
            }
        }
        if constexpr (ALIGN_EPI) { if (wr == 0) PG8_BAR; }
        if constexpr (!Epi::AFTER_DRAIN) { E(acc, cur, wr, wc, fr, fq); S.done(cur); }
        if (!has_next) break;
#pragma unroll
        for (int a = 0; a < 2; ++a)
#pragma unroll
            for (int b = 0; b < 2; ++b)
#pragma unroll
                for (int m = 0; m < 4; ++m)
#pragma unroll
                    for (int n = 0; n < 2; ++n) acc[a][b][m][n] = (f32x4){0.f, 0.f, 0.f, 0.f};
        cur = nxt; cA = nA; cB = nB; ++ui;
        if constexpr (ALIGN_EPI) { if (wr == 1) PG8_BAR; }
    }
    PG8_WAIT_V(0);
    if constexpr (!ALIGN_EPI) { if (wr == 0) PG8_BAR; }
    PG8_BAR;
    if constexpr (Epi::AFTER_DRAIN) { E.fused(acc, cur, wr, wc, fr, fq, lds, wid, lane); S.done(cur); }
#undef PG8_SA
#undef PG8_SB
#undef PG8_STAGE
#undef PG8_LDA
#undef PG8_LDB
#undef PG8_MMA
#undef PG8_WAIT_V
#undef PG8_WAIT_L
#undef PG8_BAR
#undef PG8_SCHED
}
}
#define XB_TMO      128
#define XB_XCNT(j)  (256  + 64 * (j))
#define XB_XSUB(j)  (1280 + 64 * (j))
#define XB_XGEN(j)  (2304 + 64 * (j))
#define XB_TOP      3328
#define XB_TOPGEN   3392
#define XCD_BAR_WORDS 3456
#define XB_SPIN_CAP (1u << 22)
#define LAS __attribute__((address_space(3)))

__device__ __forceinline__ unsigned xb_ld(unsigned* p)              { return __hip_atomic_load(p, __ATOMIC_RELAXED, __HIP_MEMORY_SCOPE_AGENT); }
__device__ __forceinline__ unsigned xb_add(unsigned* p, unsigned v) { return __hip_atomic_fetch_add(p, v, __ATOMIC_RELAXED, __HIP_MEMORY_SCOPE_AGENT); }
__device__ __forceinline__ unsigned xb_xcc_id() { return (unsigned)__builtin_amdgcn_s_getreg((3 << 11) | 20) & 0xFu; }
#define XB_SPIN(cond, bar) do { unsigned _sp = 0; while (cond) { __builtin_amdgcn_s_sleep(1); \
    if ((++_sp & 255u) == 0u) { if (xb_ld(&(bar)[XB_TMO])) break; if (_sp > XB_SPIN_CAP) { atomicAdd(&(bar)[XB_TMO], 1u); break; } } } } while (0)

struct XcdBarrier {
    unsigned* bar; unsigned x;
    volatile LAS unsigned* st;
};

__device__ __forceinline__ XcdBarrier xcd_barrier_post(unsigned* bar, volatile LAS unsigned* st) {
    XcdBarrier b; b.bar = bar; b.x = xb_xcc_id(); b.st = st;
    if (threadIdx.x == 0) (void)xb_add(&bar[XB_XCNT(b.x)], 1u);
    return b;
}
__device__ __forceinline__ void xcd_barrier_complete(unsigned* bar, unsigned x, unsigned& nloc, unsigned& nx) {
    const unsigned G = gridDim.x * gridDim.y * gridDim.z;
    unsigned sum, cnt, mine, sp = 0u;
    for (;;) {
        sum = 0u; cnt = 0u; mine = 0u;
#pragma unroll
        for (unsigned j = 0; j < 16; ++j) { const unsigned c = xb_ld(&bar[XB_XCNT(j)]); sum += c; cnt += (c > 0u) ? 1u : 0u; mine = (j == x) ? c : mine; }
        if (sum == G) break;
        __builtin_amdgcn_s_sleep(1);
        if ((++sp & 255u) == 0u) { if (xb_ld(&bar[XB_TMO])) break; if (sp > XB_SPIN_CAP) { atomicAdd(&bar[XB_TMO], 1u); break; } }
    }
    nloc = mine > 0u ? mine : 1u; nx = cnt > 0u ? cnt : 1u;
}

__device__ __forceinline__ void xcd_barrier(const XcdBarrier& b) {
    asm volatile("s_waitcnt vmcnt(0)" ::: "memory");
    __syncthreads();
    if (threadIdx.x == 0) {
        unsigned* bar = b.bar;
        __builtin_amdgcn_s_waitcnt(0);
        unsigned nloc = b.st[0], nx = b.st[1];
        if (nloc == 0u) { xcd_barrier_complete(bar, b.x, nloc, nx); b.st[0] = nloc; b.st[1] = nx; }
        const unsigned old = xb_add(&bar[XB_XSUB(b.x)], 1u);
        const unsigned gen = old / nloc;
        if (old + 1u == (gen + 1u) * nloc) {
            __builtin_amdgcn_fence(__ATOMIC_RELEASE, "agent");
            asm volatile("s_waitcnt vmcnt(0)" ::: "memory");
            const unsigned og = xb_add(&bar[XB_TOP], 1u);
            const unsigned tg = og / nx;
            if (og + 1u == (tg + 1u) * nx) xb_add(&bar[XB_TOPGEN], 1u);
            else XB_SPIN(xb_ld(&bar[XB_TOPGEN]) == tg, bar);
            __builtin_amdgcn_fence(__ATOMIC_ACQUIRE, "agent");
            xb_add(&bar[XB_XGEN(b.x)], 1u);
            asm volatile("s_waitcnt vmcnt(0)" ::: "memory");
        } else {
            XB_SPIN(xb_ld(&bar[XB_XGEN(b.x)]) == gen, bar);
            __builtin_amdgcn_fence(__ATOMIC_ACQUIRE, "agent");
            asm volatile("s_waitcnt vmcnt(0)" ::: "memory");
        }
    }
    __syncthreads();
}

typedef unsigned short bf16_t;
typedef short bf16x8 __attribute__((ext_vector_type(8)));
typedef float f32x4 __attribute__((ext_vector_type(4)));
typedef float f32x16 __attribute__((ext_vector_type(16)));
typedef unsigned u32x4 __attribute__((ext_vector_type(4)));
typedef unsigned u32x2 __attribute__((ext_vector_type(2)));

constexpr int D = 1024, NB = 16, SEQ = 2048, CTX = 256, NL = 4;
constexpr int TL = NB * SEQ, TC = NB * CTX, TT = TL + TC;
constexpr int DIN = 6144, HYW = 512, NE = 16, DE = 512, KEYS = CTX + SEQ;
constexpr int NMOD = 6, NBM = NB + 1;
constexpr int APROWS = 2 * TT + NE * 256;
constexpr float EPS = 1e-6f, LOG2E = 1.4426950408889634f;
constexpr float QSCALE = 0.125f * LOG2E;

constexpr size_t MiB = 1u << 20;
constexpr size_t WS_CTL = 0, CTL_ZERO_BYTES = 1 * MiB;
constexpr size_t WS_MOD = 1 * MiB;
constexpr size_t WS_ROPE = 3 * MiB;
constexpr size_t WS_FL = 4 * MiB, WS_FC = 20 * MiB;
constexpr size_t WS_MISC = 22 * MiB;
constexpr size_t WS_FNORM = WS_MISC;
constexpr size_t WS_TOKE = WS_MISC + 64 * 1024, WS_TOKP = WS_MISC + 352 * 1024, WS_TOKW = WS_MISC + 640 * 1024;
constexpr size_t WS_ROWMAP = WS_MISC + 960 * 1024, WS_ROWW = WS_MISC + 1280 * 1024;
constexpr size_t WS_WIN = 24 * MiB, WS_WBR = 36 * MiB, WS_WOUT = 39 * MiB;
constexpr size_t WS_XC = 41 * MiB;
constexpr size_t WS_NP = WS_XC;
constexpr size_t WS_H = 57 * MiB;
constexpr size_t WS_KA = 129 * MiB, WS_VTA = 138 * MiB, WS_KW = 147 * MiB, WS_VTW = 156 * MiB;
constexpr size_t WS_QA = 165 * MiB, WS_QW = 201 * MiB, WS_YH = 237 * MiB, WS_VT = 273 * MiB, WS_YT = 309 * MiB;
constexpr size_t WS_RAWA = 309 * MiB, WS_RAWW = 327 * MiB;
constexpr size_t WS_F = 165 * MiB;
constexpr size_t WS_U = 345 * MiB;
constexpr size_t WS_G = 453 * MiB;
constexpr size_t WS_W13 = 605 * MiB, WS_W2 = 637 * MiB;
constexpr size_t WS_END = 669 * MiB;
static_assert(WS_G + (size_t)APROWS * 2048 <= WS_W13 && WS_W2 + (size_t)16 * 1024 * 512 * 2 <= WS_END && WS_G + (size_t)TT * 3072 * 2 <= WS_END, "ws map");
static_assert(WS_U + (size_t)APROWS * 1024 <= WS_G && WS_F + (size_t)2 * TT * 2048 <= WS_YT, "ws map 2");
constexpr size_t VT_CTX_OFF = (size_t)HYW * NB * SEQ;

constexpr int CW_BAR = 4096, CW_CNT = 8192;
constexpr int LDS_BYTES = 151552, MISC_OFF = 147456;
constexpr int NWAVES = 8, NTHR = 512;

struct Args { const float* in[29]; float* out; unsigned char* ws; int ph_lo, ph_hi; };
enum { I_X = 0, I_C, I_CTX, I_CCTX, I_ADAW, I_ADAB, I_N1G, I_N2G, I_WIN, I_QKG, I_HSW, I_HSB, I_HW1, I_HB1, I_HFR, I_HW2, I_HB2, I_HW3, I_HBIAS, I_SINK, I_WBR, I_WOUT,
       I_RGW, I_RGB, I_REW, I_REB, I_EW1, I_EW3, I_EW2 };

#define LDS_WAIT() asm volatile("s_waitcnt lgkmcnt(0)" ::: "memory")
#define VM_WAIT() asm volatile("s_waitcnt vmcnt(0)" ::: "memory")

typedef float f32x2_t __attribute__((ext_vector_type(2)));
typedef __bf16 bf16x2_t __attribute__((ext_vector_type(2)));
__device__ __forceinline__ unsigned cvtpk(float lo, float hi) { f32x2_t v = {lo, hi}; bf16x2_t b = __builtin_convertvector(v, bf16x2_t); return __builtin_bit_cast(unsigned, b); }
__device__ __forceinline__ float bflo(unsigned u) { return __builtin_bit_cast(float, u << 16); }
__device__ __forceinline__ float bfhi(unsigned u) { return __builtin_bit_cast(float, u & 0xffff0000u); }
__device__ __forceinline__ float bf1(bf16_t u) { return __builtin_bit_cast(float, (unsigned)u << 16); }
__device__ __forceinline__ bf16_t f2bf(float f) { return (bf16_t)(cvtpk(f, 0.f) & 0xffffu); }
__device__ __forceinline__ float wave_sum(float v) {
#pragma unroll
    for (int o = 1; o < 64; o <<= 1) v += __shfl_xor(v, o);
    return v;
}
__device__ __forceinline__ float fast_exp2(float x) { return __builtin_amdgcn_exp2f(x); }
__device__ __forceinline__ float fast_rcp(float x) { return __builtin_amdgcn_rcpf(x); }
__device__ __forceinline__ float sigmoid_f(float x) { return fast_rcp(1.f + fast_exp2(-x * LOG2E)); }

__device__ __forceinline__ void sincos_acc(float x, float& s, float& c) {
    const float q = rintf(x * 0.636619772367581f);
    float y = fmaf(-q, 1.57079625129699707031f, x);
    y = fmaf(-q, 7.54978941586159635335e-08f, y);
    const float y2 = y * y;
    float sp = fmaf(y2, 2.7557314297e-06f, -1.9841270114e-04f); sp = fmaf(sp, y2, 8.3333337680e-03f); sp = fmaf(sp, y2, -1.6666667163e-01f); sp = fmaf(sp * y2, y, y);
    float cp = fmaf(y2, -2.7557314297e-07f, 2.4801587642e-05f); cp = fmaf(cp, y2, -1.3888889225e-03f); cp = fmaf(cp, y2, 4.1666667908e-02f); cp = fmaf(cp, y2, -0.5f); cp = fmaf(cp, y2, 1.0f);
    const int n = (int)q & 3;
    const float s1 = (n & 1) ? cp : sp, c1 = (n & 1) ? sp : cp;
    s = (n & 2) ? -s1 : s1;
    c = ((n + 1) & 2) ? -c1 : c1;
}

struct Fr { LAS unsigned char* lds; int tid, lane, wave, G, bid; };

__device__ __forceinline__ void pro_mod(const Fr& F, const Args& a) {
    LAS float* s = (LAS float*)F.lds;
    LAS float* red = (LAS float*)(F.lds + 69632);
    const float* c = a.in[I_C]; const float* cc = a.in[I_CCTX]; const float* W = a.in[I_ADAW]; const float* Bv = a.in[I_ADAB];
    float* MOD = (float*)(a.ws + WS_MOD);
    for (int i = F.tid; i < NBM * 1024; i += NTHR) { const int bb = i >> 10, k = i & 1023; const float v = (bb < NB) ? c[bb * 1024 + k] : cc[k]; s[i] = v / (1.f + __expf(-v)); }
    __syncthreads();
    const int col = F.tid & 63, ks = F.wave;
    for (int unit = F.bid; unit < NL * 96; unit += F.G) {
        const int l = unit / 96, j0 = (unit % 96) * 64;
        float acc[NBM];
#pragma unroll
        for (int bb = 0; bb < NBM; ++bb) acc[bb] = 0.f;
        const float* Wp = W + ((size_t)l * 1024 + ks * 128) * DIN + j0 + col;
#pragma unroll 4
        for (int k = 0; k < 128; ++k) { const float w = Wp[(size_t)k * DIN];
#pragma unroll
            for (int bb = 0; bb < NBM; ++bb) acc[bb] = fmaf(s[bb * 1024 + ks * 128 + k], w, acc[bb]); }
#pragma unroll
        for (int bb = 0; bb < NBM; ++bb) red[(ks * NBM + bb) * 64 + col] = acc[bb];
        __syncthreads();
        for (int o = F.tid; o < NBM * 64; o += NTHR) { const int bb = o >> 6, cx = o & 63; float sum = 0.f;
#pragma unroll
            for (int k2 = 0; k2 < 8; ++k2) sum += red[(k2 * NBM + bb) * 64 + cx];
            MOD[((size_t)l * NBM + bb) * DIN + j0 + cx] = sum + Bv[l * DIN + j0 + cx]; }
        __syncthreads();
    }
}

__device__ __forceinline__ void pro_rope(const Fr& F, const Args& a) {
    float* ct = (float*)(a.ws + WS_ROPE); float* st = ct + SEQ * 32;
    for (int i = F.bid * NTHR + F.tid; i < SEQ * 32; i += F.G * NTHR) {
        const int pos = i >> 5, ax = (i >> 4) & 1, f = i & 15;
        const float inv = exp2f(-(float)f * (13.287712379549449f / 16.f));
        const float ang = (float)(ax == 0 ? (pos >> 6) : (pos & 63)) * inv;
        float sv, cv; sincos_acc(ang, sv, cv); ct[i] = cv; st[i] = sv;
    }
}

__device__ __forceinline__ void pro_filter(const Fr& F, const Args& a) {
    LAS float* L = (LAS float*)F.lds;
    constexpr int oW1 = 0, oB1 = 2112, oFR = 2176, oB2 = 2240, oW2 = 2304, oZ = 6400, oH1 = 7552, oH2 = 9600, oW3 = 11648;
    bf16_t* FL = (bf16_t*)(a.ws + WS_FL); bf16_t* FC = (bf16_t*)(a.ws + WS_FC); float* NP = (float*)(a.ws + WS_NP);
    const int p = F.tid >> 4, jj = F.tid & 15;
    for (int unit = F.bid; unit < NL * 72; unit += F.G) {
        const int l = unit / 72, ch = unit % 72; const bool lat = ch < 64; const int n = lat ? SEQ : CTX, pos0 = lat ? ch * 32 : (ch - 64) * 32;
        __syncthreads();
        for (int i = F.tid; i < 2112; i += NTHR) L[oW1 + i] = a.in[I_HW1][l * 2112 + i];
        for (int i = F.tid; i < 64; i += NTHR) { L[oB1 + i] = a.in[I_HB1][l * 64 + i]; L[oFR + i] = a.in[I_HFR][l * 64 + i]; L[oB2 + i] = a.in[I_HB2][l * 64 + i]; }
        for (int i = F.tid; i < 4096; i += NTHR) L[oW2 + i] = a.in[I_HW2][l * 4096 + i];
        const int pos = pos0 + p; const float t = (float)pos / (float)(n - 1);
        { const float band = 1e-4f + (float)jj * ((15.f - 1e-4f) / 15.f); const float ang = ((6.2831855f * band) * (float)pos) / (float)n;
          float sv, cv; sincos_acc(ang, sv, cv); L[oZ + p * 36 + 1 + jj] = cv; L[oZ + p * 36 + 17 + jj] = -sv; if (jj == 0) L[oZ + p * 36] = t; }
        __syncthreads();
        { f32x4 acc = *(const LAS f32x4*)(L + oB1 + 4 * jj);
#pragma unroll 3
          for (int i = 0; i < 33; ++i) { const float z = L[oZ + p * 36 + i]; const f32x4 w = *(const LAS f32x4*)(L + oW1 + i * 64 + 4 * jj); acc.x = fmaf(z, w.x, acc.x); acc.y = fmaf(z, w.y, acc.y); acc.z = fmaf(z, w.z, acc.z); acc.w = fmaf(z, w.w, acc.w); }
          const f32x4 fr = *(const LAS f32x4*)(L + oFR + 4 * jj); float sv, cv; f32x4 o;
          sincos_acc(fr.x * acc.x, sv, cv); o.x = sv; sincos_acc(fr.y * acc.y, sv, cv); o.y = sv; sincos_acc(fr.z * acc.z, sv, cv); o.z = sv; sincos_acc(fr.w * acc.w, sv, cv); o.w = sv;
          *(LAS f32x4*)(L + oH1 + p * 64 + 4 * jj) = o; }
        __syncthreads();
        { f32x4 acc = *(const LAS f32x4*)(L + oB2 + 4 * jj);
#pragma unroll 4
          for (int i = 0; i < 64; ++i) { const float z = L[oH1 + p * 64 + i]; const f32x4 w = *(const LAS f32x4*)(L + oW2 + i * 64 + 4 * jj); acc.x = fmaf(z, w.x, acc.x); acc.y = fmaf(z, w.y, acc.y); acc.z = fmaf(z, w.z, acc.z); acc.w = fmaf(z, w.w, acc.w); }
          const f32x4 fr = *(const LAS f32x4*)(L + oFR + 4 * jj); float sv, cv; f32x4 o;
          sincos_acc(fr.x * acc.x, sv, cv); o.x = sv; sincos_acc(fr.y * acc.y, sv, cv); o.y = sv; sincos_acc(fr.z * acc.z, sv, cv); o.z = sv; sincos_acc(fr.w * acc.w, sv, cv); o.w = sv;
          *(LAS f32x4*)(L + oH2 + p * 64 + 4 * jj) = o; }
        f32x4 acc[16];
#pragma unroll
        for (int m = 0; m < 16; ++m) acc[m] = (f32x4){0.f, 0.f, 0.f, 0.f};
#pragma unroll 1
        for (int kc = 0; kc < 4; ++kc) {
            __syncthreads();
            for (int i = F.tid; i < 4096; i += NTHR) *(LAS f32x4*)(L + oW3 + i * 4) = *(const f32x4*)(a.in[I_HW3] + ((size_t)l * 64 + kc * 16) * 1024 + i * 4);
            __syncthreads();
#pragma unroll 1
            for (int k = 0; k < 16; ++k) { const float h = L[oH2 + p * 64 + kc * 16 + k];
#pragma unroll
                for (int m = 0; m < 16; ++m) { const f32x4 w = *(const LAS f32x4*)(L + oW3 + k * 1024 + 64 * m + 4 * jj);
                    acc[m].x = fmaf(h, w.x, acc[m].x); acc[m].y = fmaf(h, w.y, acc[m].y); acc[m].z = fmaf(h, w.z, acc[m].z); acc[m].w = fmaf(h, w.w, acc[m].w); } }
        }
        __syncthreads();
        LAS bf16_t* T = (LAS bf16_t*)(L + oW3);
#pragma unroll
        for (int m = 0; m < 16; ++m) {
            const int colb = 64 * m + 4 * jj; const int dir = colb >> 9;
            const float v4[4] = {acc[m].x, acc[m].y, acc[m].z, acc[m].w};
#pragma unroll
            for (int e = 0; e < 4; ++e) { const int col = colb + e, c = col & 511;
                const float dl = fabsf(-3.0701134573253943f + (-15.350567286626972f + 3.0701134573253943f) * ((float)c / 511.f));
                float v = v4[e] * __expf(-t * dl); if (dir == 1 && pos == 0) v = 0.f;
                T[col * 32 + (dir == 0 ? 31 - p : p)] = f2bf(v); }
        }
        __syncthreads();
        for (int idx = F.tid; idx < 1024 * 32; idx += NTHR) { const int col = idx >> 5, i = idx & 31, dir = col >> 9, c = col & 511;
            const int u = (dir == 0) ? (n - 32 - pos0 + i) : ((pos0 + i == 0) ? 2 * n - 1 : n - 1 + pos0 + i);
            bf16_t* Fb = lat ? FL + ((size_t)l * 512 + c) * 4096 : FC + ((size_t)l * 512 + c) * 512;
            Fb[u] = T[col * 32 + i]; }
        for (int col = F.tid; col < 1024; col += NTHR) { float sum = 0.f;
#pragma unroll 8
            for (int i = 0; i < 32; ++i) sum += fabsf(bf1(T[col * 32 + i]));
            NP[((size_t)l * 72 + ch) * 1024 + col] = sum; }
    }
    __syncthreads();
}
__device__ __forceinline__ void filter_norm_reduce(const Fr& F, const Args& a) {
    const float* NP = (const float*)(a.ws + WS_NP); float* FN = (float*)(a.ws + WS_FNORM);
    for (int o = F.bid * NTHR + F.tid; o < NL * 2 * 512; o += F.G * NTHR) { const int l = o >> 10, isc = (o >> 9) & 1, c = o & 511;
        const int ch0 = isc ? 64 : 0, ch1 = isc ? 72 : 64; float sum = 0.f;
        for (int ch = ch0; ch < ch1; ++ch) sum += NP[((size_t)l * 72 + ch) * 1024 + c] + NP[((size_t)l * 72 + ch) * 1024 + 512 + c];
        FN[o] = 1.f / sum; }
}

template <int MODE>
__device__ __forceinline__ void transpose_item(const float* W, int K, int N, bf16_t* WT, int row_off, LAS float* scr, int item, int lane) {
    const int nblk = N / 32, kb = item / nblk, nb = item % nblk, k0 = 64 * kb, n0 = 32 * nb;
#pragma unroll 8
    for (int i = 0; i < 32; ++i) { const int kk = 2 * i + (lane >> 5); scr[kk * 33 + (lane & 31)] = W[(size_t)(k0 + kk) * N + n0 + (lane & 31)]; }
    LDS_WAIT();
    const int c = lane & 7;
#pragma unroll
    for (int j = 0; j < 4; ++j) { const int n = (lane >> 3) + 8 * j; const LAS float* s = scr + (8 * c) * 33 + n;
        u32x4 o; o.x = cvtpk(s[0 * 33], s[1 * 33]); o.y = cvtpk(s[2 * 33], s[3 * 33]); o.z = cvtpk(s[4 * 33], s[5 * 33]); o.w = cvtpk(s[6 * 33], s[7 * 33]);
        const int nn = n0 + n; const int row = (MODE == 0) ? nn : ((nn >> 2) * 8 + (nn & 3) + (MODE == 2 ? 4 : 0));
        *(u32x4*)(WT + (size_t)(row_off + row) * K + k0 + 8 * c) = o; }
    LDS_WAIT();
}

__device__ __forceinline__ void conv_small_weights(const Fr& F, const Args& a, int l) {
    LAS float* scr = (LAS float*)(F.lds + F.wave * 16384);
    const int gw = F.bid * NWAVES + F.wave, NGW = F.G * NWAVES;
    constexpr int I_IN = (1024 / 64) * (DIN / 32), I_BR = (512 / 64) * (1024 / 32), I_OUT = (1024 / 64) * (1024 / 32);
    constexpr int NIT = I_IN + 3 * I_BR + I_OUT;
    for (int it = gw; it < NIT; it += NGW) {
        int r = it;
        if (r < I_IN) { transpose_item<0>(a.in[I_WIN] + (size_t)l * 1024 * DIN, 1024, DIN, (bf16_t*)(a.ws + WS_WIN), 0, scr, r, F.lane); continue; } r -= I_IN;
        if (r < 3 * I_BR) { const int b = r / I_BR; transpose_item<0>(a.in[I_WBR] + ((size_t)l * 3 + b) * 512 * 1024, 512, 1024, (bf16_t*)(a.ws + WS_WBR) + (size_t)b * 1024 * 512, 0, scr, r % I_BR, F.lane); continue; } r -= 3 * I_BR;
        transpose_item<0>(a.in[I_WOUT] + (size_t)l * 1024 * 1024, 1024, 1024, (bf16_t*)(a.ws + WS_WOUT), 0, scr, r, F.lane);
    }
}
__device__ __forceinline__ void conv_expert_weights(const Fr& F, const Args& a, int l) {
    LAS float* scr = (LAS float*)(F.lds + F.wave * 16384);
    const int gw = F.bid * NWAVES + F.wave, NGW = F.G * NWAVES;
    constexpr int I_1 = (1024 / 64) * (512 / 32), I_2 = (512 / 64) * (1024 / 32);
    constexpr int NIT = NE * (2 * I_1 + I_2);
    for (int it = gw; it < NIT; it += NGW) {
        const int e = it / (2 * I_1 + I_2); int r = it % (2 * I_1 + I_2);
        bf16_t* W13 = (bf16_t*)(a.ws + WS_W13); bf16_t* W2 = (bf16_t*)(a.ws + WS_W2);
        if (r < I_1) { transpose_item<1>(a.in[I_EW1] + ((size_t)l * NE + e) * 1024 * 512, 1024, 512, W13, e * 1024, scr, r, F.lane); continue; } r -= I_1;
        if (r < I_1) { transpose_item<2>(a.in[I_EW3] + ((size_t)l * NE + e) * 1024 * 512, 1024, 512, W13, e * 1024, scr, r, F.lane); continue; } r -= I_1;
        transpose_item<0>(a.in[I_EW2] + ((size_t)l * NE + e) * 512 * 1024, 512, 1024, W2, e * 1024, scr, r, F.lane);
    }
}

__device__ __forceinline__ int mod_row(int row) { return row < TL ? (row >> 11) : NB; }

__device__ __forceinline__ void rows_p0(const Fr& F, const Args& a, int l, int nrows) {
    const int gw = F.bid * NWAVES + F.wave, NGW = F.G * NWAVES;
    const float* g1 = a.in[I_N1G] + l * 1024;
    const float* MODl = (const float*)(a.ws + WS_MOD) + (size_t)l * NBM * DIN;
    const float* MODp = (const float*)(a.ws + WS_MOD) + (size_t)(l > 0 ? l - 1 : 0) * NBM * DIN;
    const bf16_t* Fs = (const bf16_t*)(a.ws + WS_F);
    bf16_t* H = (bf16_t*)(a.ws + WS_H);
    for (int row = gw; row < nrows; row += NGW) {
        const bool lat = row < TL; const int mr = mod_row(row);
        const float* xs; float* xd;
        if (lat) { xd = a.out + (size_t)row * D; xs = (l == 0) ? a.in[I_X] + (size_t)row * D : xd; }
        else { xd = (float*)(a.ws + WS_XC) + (size_t)(row - TL) * D; xs = (l == 0) ? a.in[I_CTX] + (size_t)(row - TL) * D : xd; }
        f32x4 v[4]; float ss = 0.f;
#pragma unroll
        for (int j = 0; j < 4; ++j) v[j] = *(const f32x4*)(xs + F.lane * 4 + 256 * j);
        if (l > 0) {
#pragma unroll
            for (int j = 0; j < 4; ++j) { const int col = F.lane * 4 + 256 * j;
                const u32x2 f0 = *(const u32x2*)(Fs + (size_t)row * D + col), f1 = *(const u32x2*)(Fs + ((size_t)TT + row) * D + col);
                const f32x4 m5 = *(const f32x4*)(MODp + (size_t)mr * DIN + 5 * 1024 + col);
                v[j].x += m5.x * (bflo(f0.x) + bflo(f1.x)); v[j].y += m5.y * (bfhi(f0.x) + bfhi(f1.x)); v[j].z += m5.z * (bflo(f0.y) + bflo(f1.y)); v[j].w += m5.w * (bfhi(f0.y) + bfhi(f1.y));
                *(f32x4*)(xd + col) = v[j]; }
        }
#pragma unroll
        for (int j = 0; j < 4; ++j) ss += (v[j].x * v[j].x + v[j].y * v[j].y) + (v[j].z * v[j].z + v[j].w * v[j].w);
        const float r = 1.f / sqrtf(wave_sum(ss) * (1.f / D) + EPS);
#pragma unroll
        for (int j = 0; j < 4; ++j) { const int col = F.lane * 4 + 256 * j;
            const f32x4 g = *(const f32x4*)(g1 + col), sh = *(const f32x4*)(MODl + (size_t)mr * DIN + col), sc = *(const f32x4*)(MODl + (size_t)mr * DIN + 1024 + col);
            const f32x4 o = (v[j] * r * g) * (sc + 1.f) + sh;
            u32x2 w; w.x = cvtpk(o.x, o.y); w.y = cvtpk(o.z, o.w);
            *(u32x2*)(H + (size_t)row * D + col) = w; }
    }
}
__device__ __forceinline__ void rows_final(const Fr& F, const Args& a) {
    const int gw = F.bid * NWAVES + F.wave, NGW = F.G * NWAVES;
    const float* MODp = (const float*)(a.ws + WS_MOD) + (size_t)(NL - 1) * NBM * DIN;
    const bf16_t* Fs = (const bf16_t*)(a.ws + WS_F);
    for (int row = gw; row < TL; row += NGW) {
        const int mr = row >> 11; float* xd = a.out + (size_t)row * D;
#pragma unroll
        for (int j = 0; j < 4; ++j) { const int col = F.lane * 4 + 256 * j;
            f32x4 v = *(const f32x4*)(xd + col);
            const u32x2 f0 = *(const u32x2*)(Fs + (size_t)row * D + col), f1 = *(const u32x2*)(Fs + ((size_t)TT + row) * D + col);
            const f32x4 m5 = *(const f32x4*)(MODp + (size_t)mr * DIN + 5 * 1024 + col);
            v.x += m5.x * (bflo(f0.x) + bflo(f1.x)); v.y += m5.y * (bfhi(f0.x) + bfhi(f1.x)); v.z += m5.z * (bflo(f0.y) + bflo(f1.y)); v.w += m5.w * (bfhi(f0.y) + bfhi(f1.y));
            *(f32x4*)(xd + col) = v; }
    }
}

__device__ __forceinline__ void rows_p5(const Fr& F, const Args& a, int l, int nrows) {
    LAS float* RW = (LAS float*)F.lds;
    LAS float* RB = (LAS float*)(F.lds + 81920);
    LAS int* LC = (LAS int*)(F.lds + 82048);
    LAS int* TE = (LAS int*)(F.lds + 82304);
    LAS int* TP = TE + 256;
    LAS float* TW = (LAS float*)(TP + 256);
    const float* g2 = a.in[I_N2G] + l * 1024;
    const float* MODl = (const float*)(a.ws + WS_MOD) + (size_t)l * NBM * DIN;
    bf16_t* H = (bf16_t*)(a.ws + WS_H);
    int* TOKE = (int*)(a.ws + WS_TOKE); int* TOKP = (int*)(a.ws + WS_TOKP); float* TOKW = (float*)(a.ws + WS_TOKW);
    unsigned* CNT = (unsigned*)(a.ws + WS_CTL) + CW_CNT + l * 256;
    for (int i = F.tid; i < 1024 * 20; i += NTHR) { const int k = i / 20, cidx = i % 20;
        RW[cidx * 1024 + k] = (cidx < 4) ? a.in[I_RGW][((size_t)l * 1024 + k) * 4 + cidx] : a.in[I_REW][((size_t)l * 1024 + k) * 16 + (cidx - 4)]; }
    if (F.tid < 20) RB[F.tid] = (F.tid < 4) ? a.in[I_RGB][l * 4 + F.tid] : a.in[I_REB][l * 16 + F.tid - 4];
    constexpr int P5_CH = 144;
    const int nch = (nrows + P5_CH - 1) / P5_CH;
    for (int ch = F.bid; ch < nch; ch += F.G) {
    if (F.tid < 32) LC[F.tid] = 0;
    __syncthreads();
    const int r0 = ch * P5_CH, r1 = (r0 + P5_CH < nrows) ? r0 + P5_CH : nrows;
    for (int row = r0 + F.wave; row < r1; row += NWAVES) {
        const bool lat = row < TL; const int mr = mod_row(row);
        const float* xs = lat ? a.out + (size_t)row * D : (const float*)(a.ws + WS_XC) + (size_t)(row - TL) * D;
        f32x4 v[4]; float ss = 0.f;
#pragma unroll
        for (int j = 0; j < 4; ++j) { v[j] = *(const f32x4*)(xs + F.lane * 4 + 256 * j); ss += (v[j].x * v[j].x + v[j].y * v[j].y) + (v[j].z * v[j].z + v[j].w * v[j].w); }
        const float r = 1.f / sqrtf(wave_sum(ss) * (1.f / D) + EPS);
#pragma unroll
        for (int j = 0; j < 4; ++j) { const int col = F.lane * 4 + 256 * j;
            const f32x4 g = *(const f32x4*)(g2 + col), sh = *(const f32x4*)(MODl + (size_t)mr * DIN + 3 * 1024 + col), sc = *(const f32x4*)(MODl + (size_t)mr * DIN + 4 * 1024 + col);
            v[j] = (v[j] * r * g) * (sc + 1.f) + sh;
            u32x2 w; w.x = cvtpk(v[j].x, v[j].y); w.y = cvtpk(v[j].z, v[j].w);
            *(u32x2*)(H + (size_t)row * D + col) = w; }
        float lg[20];
#pragma unroll
        for (int cidx = 0; cidx < 20; ++cidx) { float p = 0.f;
#pragma unroll
            for (int j = 0; j < 4; ++j) { const f32x4 w = *(const LAS f32x4*)(RW + cidx * 1024 + F.lane * 4 + 256 * j);
                p = fmaf(v[j].x, w.x, p); p = fmaf(v[j].y, w.y, p); p = fmaf(v[j].z, w.z, p); p = fmaf(v[j].w, w.w, p); }
            lg[cidx] = wave_sum(p) + RB[cidx]; }
        int gs = 0; float gm = lg[0];
#pragma unroll
        for (int i = 1; i < 4; ++i) if (lg[i] > gm) { gm = lg[i]; gs = i; }
        float gsum = 0.f;
#pragma unroll
        for (int i = 0; i < 4; ++i) gsum += __expf(lg[i] - gm);
        const float pg = 1.f / gsum;
        float le[4];
#pragma unroll
        for (int i = 0; i < 4; ++i) le[i] = (gs == 0) ? lg[4 + i] : (gs == 1) ? lg[8 + i] : (gs == 2) ? lg[12 + i] : lg[16 + i];
        int i0 = 0; float v0 = le[0];
#pragma unroll
        for (int i = 1; i < 4; ++i) if (le[i] > v0) { v0 = le[i]; i0 = i; }
        int i1 = -1; float v1 = -3.4e38f;
#pragma unroll
        for (int i = 0; i < 4; ++i) if (i != i0 && le[i] > v1) { v1 = le[i]; i1 = i; }
        const float e1 = __expf(v1 - v0), den = 1.f / (1.f + e1);
        const float w0 = den * pg, w1 = e1 * den * pg;
        const int ex0 = gs * 4 + i0, ex1 = gs * 4 + i1;
        if (F.lane == 0) {
            const int lp0 = __hip_atomic_fetch_add(&LC[ex0], 1, __ATOMIC_RELAXED, __HIP_MEMORY_SCOPE_WORKGROUP), lp1 = __hip_atomic_fetch_add(&LC[ex1], 1, __ATOMIC_RELAXED, __HIP_MEMORY_SCOPE_WORKGROUP);
            const int lr = row - r0;
            TE[lr] = ex0 | (ex1 << 8); TP[lr] = lp0 | (lp1 << 16); TW[2 * lr] = w0; TW[2 * lr + 1] = w1;
        }
    }
    __syncthreads();
    if (F.tid < NE) LC[16 + F.tid] = (int)atomicAdd(&CNT[F.tid * 16], (unsigned)LC[F.tid]);
    __syncthreads();
    for (int lr = F.tid; lr < r1 - r0; lr += NTHR) {
        const int te = TE[lr], tp = TP[lr], ex0 = te & 255, ex1 = te >> 8, row = r0 + lr;
        TOKE[2 * row] = ex0; TOKE[2 * row + 1] = ex1;
        TOKP[2 * row] = LC[16 + ex0] + (tp & 0xffff); TOKP[2 * row + 1] = LC[16 + ex1] + (tp >> 16);
        TOKW[2 * row] = TW[2 * lr]; TOKW[2 * row + 1] = TW[2 * lr + 1];
    }
    __syncthreads();
    }
    __syncthreads();
}

__device__ __forceinline__ void normrope8(float (&x)[8], const float* g64, bool rope, int pos, const float* ct, const float* st, float scale, int lane) {
    float ss = 0.f;
#pragma unroll
    for (int i = 0; i < 8; ++i) ss += x[i] * x[i];
    ss += __shfl_xor(ss, 1); ss += __shfl_xor(ss, 2); ss += __shfl_xor(ss, 4);
    const float r = 1.f / sqrtf(ss * (1.f / 64.f) + EPS);
    const int ch = lane & 7;
    const f32x4 g0 = *(const f32x4*)(g64 + 8 * ch), g1 = *(const f32x4*)(g64 + 8 * ch + 4);
    x[0] *= r * g0.x; x[1] *= r * g0.y; x[2] *= r * g0.z; x[3] *= r * g0.w; x[4] *= r * g1.x; x[5] *= r * g1.y; x[6] *= r * g1.z; x[7] *= r * g1.w;
    if (rope) {
        const int ax = ch >> 2, half = (ch >> 1) & 1, f0 = 8 * (ch & 1);
        const f32x4 c0 = *(const f32x4*)(ct + pos * 32 + ax * 16 + f0), c1 = *(const f32x4*)(ct + pos * 32 + ax * 16 + f0 + 4);
        const f32x4 s0 = *(const f32x4*)(st + pos * 32 + ax * 16 + f0), s1 = *(const f32x4*)(st + pos * 32 + ax * 16 + f0 + 4);
        const float cs[8] = {c0.x, c0.y, c0.z, c0.w, c1.x, c1.y, c1.z, c1.w}, sn[8] = {s0.x, s0.y, s0.z, s0.w, s1.x, s1.y, s1.z, s1.w};
#pragma unroll
        for (int i = 0; i < 8; ++i) { const float p = __shfl_xor(x[i], 2);
            x[i] = half ? (x[i] * cs[i] + p * sn[i]) : (x[i] * cs[i] - p * sn[i]); }
    }
#pragma unroll
    for (int i = 0; i < 8; ++i) x[i] *= scale;
}
__device__ __forceinline__ void unpack8(const u32x4 w, float (&x)[8]) { x[0] = bflo(w.x); x[1] = bfhi(w.x); x[2] = bflo(w.y); x[3] = bfhi(w.y); x[4] = bflo(w.z); x[5] = bfhi(w.z); x[6] = bflo(w.w); x[7] = bfhi(w.w); }
__device__ __forceinline__ u32x4 pack8(const float (&x)[8]) { u32x4 w; w.x = cvtpk(x[0], x[1]); w.y = cvtpk(x[2], x[3]); w.z = cvtpk(x[4], x[5]); w.w = cvtpk(x[6], x[7]); return w; }

__device__ __forceinline__ void prep_phase(const Fr& F, const Args& a, int l) {
    constexpr int VROW = 272;
    LAS unsigned char* VA_l = F.lds;
    LAS unsigned char* VW_l = F.lds + 17408;
    LAS unsigned char* HT_l = F.lds + 34816;
    constexpr int HROW = 144;
    const float* ct = (const float*)(a.ws + WS_ROPE); const float* st = ct + SEQ * 32;
    const float* qkg = a.in[I_QKG] + l * 256;
    bf16_t* QA = (bf16_t*)(a.ws + WS_QA); bf16_t* QW = (bf16_t*)(a.ws + WS_QW);
    const bf16_t* RAWA = (const bf16_t*)(a.ws + WS_RAWA); const bf16_t* RAWW = (const bf16_t*)(a.ws + WS_RAWW);
    bf16_t* KA = (bf16_t*)(a.ws + WS_KA); bf16_t* KW = (bf16_t*)(a.ws + WS_KW); bf16_t* VTA = (bf16_t*)(a.ws + WS_VTA); bf16_t* VTW = (bf16_t*)(a.ws + WS_VTW);
    const bf16_t* U = (const bf16_t*)(a.ws + WS_U); bf16_t* X0 = (bf16_t*)(a.ws + WS_H); bf16_t* VT = (bf16_t*)(a.ws + WS_VT);
    const float* hsw = a.in[I_HSW] + l * 3 * 1536; const float* hsb = a.in[I_HSB] + l * 1536;
    for (int unit = F.bid; unit < NB * 36; unit += F.G) {
        const bool lat = unit < NB * 32;
        const int b = lat ? unit >> 5 : (unit - NB * 32) >> 2, p0 = lat ? (unit & 31) * 64 : ((unit - NB * 32) & 3) * 64;
        const int n = lat ? SEQ : CTX;
        const int row0 = lat ? b * SEQ + p0 : TL + b * CTX + p0;
        const int j0 = lat ? CTX + p0 : p0;
        __syncthreads();
        for (int tk = F.wave; tk < 64; tk += NWAVES) {
            const int row = row0 + tk, pos = p0 + tk;
            { u32x4 w = *(const u32x4*)(QA + (size_t)row * 512 + F.lane * 8); float x[8]; unpack8(w, x);
              normrope8(x, qkg + 0, lat, pos, ct, st, QSCALE, F.lane); *(u32x4*)(QA + (size_t)row * 512 + F.lane * 8) = pack8(x); }
            { u32x4 w = *(const u32x4*)(QW + (size_t)row * 512 + F.lane * 8); float x[8]; unpack8(w, x);
              normrope8(x, qkg + 128, lat, pos, ct, st, QSCALE, F.lane); *(u32x4*)(QW + (size_t)row * 512 + F.lane * 8) = pack8(x); }
            { const bool isw = (F.lane & 16) != 0; const int l16 = F.lane & 15;
              const bf16_t* src = (isw ? RAWW : RAWA) + (size_t)row * 256 + l16 * 8;
              u32x4 w = *(const u32x4*)src; float x[8]; unpack8(w, x);
              normrope8(x, qkg + (isw ? 192 : 64), lat, pos, ct, st, 1.f, F.lane);
              if (F.lane < 32) *(u32x4*)((isw ? KW : KA) + ((size_t)b * KEYS + j0 + tk) * 128 + l16 * 8) = pack8(x); }
        }
        for (int i = F.tid; i < 2 * 64 * 16; i += NTHR) { const int m = i >> 10, r = (i >> 4) & 63, cch = i & 15;
            const u32x4 w = *(const u32x4*)((m ? RAWW : RAWA) + (size_t)(row0 + r) * 256 + 128 + cch * 8);
            *(LAS u32x4*)((m ? VW_l : VA_l) + r * VROW + cch * 16) = w; }
        {
            const int th = F.tid & 255, half = F.tid >> 8, c = 2 * th;
            float w0[6], w1[6], w2[6], bb[6];
#pragma unroll
            for (int g = 0; g < 3; ++g)
#pragma unroll
                for (int e = 0; e < 2; ++e) { const int ch = g * 512 + c + e; w0[g * 2 + e] = hsw[ch]; w1[g * 2 + e] = hsw[1536 + ch]; w2[g * 2 + e] = hsw[3072 + ch]; bb[g * 2 + e] = hsb[ch]; }
            float up[6], uc[6], un[6];
            const int t0 = 32 * half;
            auto ld = [&](int pos, float (&o)[6]) {
                if (pos < 0 || pos >= n) {
#pragma unroll
                    for (int i = 0; i < 6; ++i) o[i] = 0.f;
                } else { const bf16_t* ur = U + (size_t)(row0 - p0 + pos) * 1536 + c;
#pragma unroll
                    for (int g = 0; g < 3; ++g) { const unsigned w = *(const unsigned*)(ur + g * 512); o[g * 2] = bflo(w); o[g * 2 + 1] = bfhi(w); } } };
            ld(p0 + t0 - 1, up); ld(p0 + t0, uc);
            for (int t = 0; t < 32; ++t) {
                ld(p0 + t0 + t + 1, un);
                float o[6];
#pragma unroll
                for (int i = 0; i < 6; ++i) o[i] = fmaf(w0[i], up[i], fmaf(w1[i], uc[i], fmaf(w2[i], un[i], bb[i])));
                *(unsigned*)(X0 + (size_t)(row0 + t0 + t) * 512 + c) = cvtpk(o[0], o[1]);
                const unsigned pv = cvtpk(o[2] * o[4], o[3] * o[5]);
                *(LAS bf16_t*)(HT_l + (c) * HROW + (t0 + t) * 2) = (bf16_t)(pv & 0xffffu);
                *(LAS bf16_t*)(HT_l + (c + 1) * HROW + (t0 + t) * 2) = (bf16_t)(pv >> 16);
#pragma unroll
                for (int i = 0; i < 6; ++i) { up[i] = uc[i]; uc[i] = un[i]; }
            }
        }
        __syncthreads();
        for (int i = F.tid; i < 2 * 128 * 8; i += NTHR) { const int m = i >> 10, rr = (i >> 3) & 127, c8 = i & 7;
            LAS unsigned char* T = m ? VW_l : VA_l; unsigned short e[8];
#pragma unroll
            for (int jj = 0; jj < 8; ++jj) { const int key = 16 * (c8 >> 1) + 8 * (jj >> 2) + 4 * (c8 & 1) + (jj & 3); e[jj] = *(const LAS bf16_t*)(T + key * VROW + rr * 2); }
            u32x4 w; w.x = e[0] | ((unsigned)e[1] << 16); w.y = e[2] | ((unsigned)e[3] << 16); w.z = e[4] | ((unsigned)e[5] << 16); w.w = e[6] | ((unsigned)e[7] << 16);
            *(u32x4*)((m ? VTW : VTA) + ((size_t)(b * 2 + (rr >> 6)) * 64 + (rr & 63)) * KEYS + j0 + c8 * 8) = w; }
        { bf16_t* VTb = lat ? VT : VT + VT_CTX_OFF;
          for (int i = F.tid; i < 512 * 8; i += NTHR) { const int cch = i >> 3, c8 = i & 7;
              const u32x4 w = *(const LAS u32x4*)(HT_l + cch * HROW + c8 * 16);
              *(u32x4*)(VTb + ((size_t)cch * NB + b) * n + p0 + c8 * 8) = w; } }
    }
    __syncthreads();
}

__device__ __forceinline__ void hyena_final_phase(const Fr& F, const Args& a, int l, bool with_ctx) {
    constexpr int HROW = 144;
    LAS unsigned char* T = F.lds;
    const bf16_t* X0 = (const bf16_t*)(a.ws + WS_H); const bf16_t* VT = (const bf16_t*)(a.ws + WS_VT); const bf16_t* YT = (const bf16_t*)(a.ws + WS_YT);
    bf16_t* YH = (bf16_t*)(a.ws + WS_YH);
    const float* FN = (const float*)(a.ws + WS_FNORM) + l * 1024; const float* skip = a.in[I_HBIAS] + l * 512;
    const int nunits = with_ctx ? NB * 36 : NB * 32;
    for (int unit = F.bid; unit < nunits; unit += F.G) {
        const bool lat = unit < NB * 32;
        const int b = lat ? unit >> 5 : (unit - NB * 32) >> 2, p0 = lat ? (unit & 31) * 64 : ((unit - NB * 32) & 3) * 64;
        const int n = lat ? SEQ : CTX; const int row0 = lat ? b * SEQ + p0 : TL + b * CTX + p0;
        const bf16_t* Yb = lat ? YT : YT + VT_CTX_OFF; const bf16_t* Vb = lat ? VT : VT + VT_CTX_OFF; const float* inv = FN + (lat ? 0 : 512);
        __syncthreads();
        for (int i = F.tid; i < 512 * 8; i += NTHR) { const int cch = i >> 3, c8 = i & 7; const size_t off = ((size_t)cch * NB + b) * n + p0 + c8 * 8;
            const u32x4 y = *(const u32x4*)(Yb + off), v = *(const u32x4*)(Vb + off); const float s = inv[cch], k = skip[cch];
            u32x4 o;
            o.x = cvtpk(bflo(y.x) * s + k * bflo(v.x), bfhi(y.x) * s + k * bfhi(v.x)); o.y = cvtpk(bflo(y.y) * s + k * bflo(v.y), bfhi(y.y) * s + k * bfhi(v.y));
            o.z = cvtpk(bflo(y.z) * s + k * bflo(v.z), bfhi(y.z) * s + k * bfhi(v.z)); o.w = cvtpk(bflo(y.w) * s + k * bflo(v.w), bfhi(y.w) * s + k * bfhi(v.w));
            *(LAS u32x4*)(T + cch * HROW + c8 * 16) = o; }
        __syncthreads();
        { const int th = F.tid & 255, half = F.tid >> 8, c = 2 * th;
          for (int t = 32 * half; t < 32 * half + 32; ++t) {
              const unsigned x0 = *(const unsigned*)(X0 + (size_t)(row0 + t) * 512 + c);
              const float y0 = bf1(*(const LAS bf16_t*)(T + c * HROW + t * 2)), y1 = bf1(*(const LAS bf16_t*)(T + (c + 1) * HROW + t * 2));
              *(unsigned*)(YH + (size_t)(row0 + t) * 512 + c) = cvtpk(bflo(x0) * y0, bfhi(x0) * y1); } }
    }
    __syncthreads();
}

#define MFMA32(a, b, c) __builtin_amdgcn_mfma_f32_32x32x16_bf16((a), (b), (c), 0, 0, 0)
#define MFMA16(a, b, c) __builtin_amdgcn_mfma_f32_16x16x32_bf16((a), (b), (c), 0, 0, 0)

__device__ __forceinline__ int tile_off(int row, int chunk) { return row * 128 + ((chunk ^ ((row >> 1) & 7)) << 4); }

template <bool WIN>
__device__ __forceinline__ void attn_unit(const Fr& F, bf16_t* Qw, const bf16_t* Kb, const bf16_t* VTb, int a0, int na, int b0, int nb, int qpos0, bool has_sink, float sink2) {
    LAS unsigned char* L = F.lds;
    const int r = F.lane & 31, h = F.lane >> 5;
    bf16x8 q[4];
#pragma unroll
    for (int kk = 0; kk < 4; ++kk) q[kk] = *(const bf16x8*)(Qw + (size_t)r * 512 + 16 * kk + 8 * h);
    f32x16 o0, o1;
#pragma unroll
    for (int i = 0; i < 16; ++i) { o0[i] = 0.f; o1[i] = 0.f; }
    float m = -1e30f, lsum = 0.f;
    const int ntile = na + nb;
    const int srow = F.tid >> 3, sch = F.tid & 7;
    u32x4 kreg, vreg;
    { const int kt = a0;
      kreg = *(const u32x4*)(Kb + (size_t)(kt * 64 + srow) * 128 + sch * 8); vreg = *(const u32x4*)(VTb + (size_t)srow * KEYS + kt * 64 + sch * 8); }
    __syncthreads();
    *(LAS u32x4*)(L + tile_off(srow, sch)) = kreg; *(LAS u32x4*)(L + 8192 + tile_off(srow, sch)) = vreg;
    __syncthreads();
    for (int it = 0; it < ntile; ++it) {
        const int kt = it < na ? a0 + it : b0 + (it - na);
        if (it + 1 < ntile) { const int kn = (it + 1) < na ? a0 + it + 1 : b0 + (it + 1 - na);
            kreg = *(const u32x4*)(Kb + (size_t)(kn * 64 + srow) * 128 + sch * 8); vreg = *(const u32x4*)(VTb + (size_t)srow * KEYS + kn * 64 + sch * 8); }
        LAS unsigned char* Kt = L + (it & 1) * 16384; LAS unsigned char* Vt = Kt + 8192;
        f32x16 s0, s1;
#pragma unroll
        for (int i = 0; i < 16; ++i) { s0[i] = 0.f; s1[i] = 0.f; }
#pragma unroll
        for (int kk = 0; kk < 4; ++kk) {
            const bf16x8 ka = *(const LAS bf16x8*)(Kt + tile_off(r, 2 * kk + h)), kb2 = *(const LAS bf16x8*)(Kt + tile_off(32 + r, 2 * kk + h));
            s0 = MFMA32(ka, q[kk], s0); s1 = MFMA32(kb2, q[kk], s1); }
        if (WIN && kt >= 4) {
            const int kbase = (kt - 4) * 64 + 4 * h, qp = qpos0 + r;
#pragma unroll
            for (int i = 0; i < 16; ++i) { const int kr = (i & 3) + 8 * (i >> 2);
                const int d0 = kbase + kr - qp, d1 = d0 + 32;
                if (d0 > 128 || d0 < -128) s0[i] = -1e30f;
                if (d1 > 128 || d1 < -128) s1[i] = -1e30f; }
        }
        float mx = s0[0];
#pragma unroll
        for (int i = 1; i < 16; ++i) mx = fmaxf(mx, s0[i]);
#pragma unroll
        for (int i = 0; i < 16; ++i) mx = fmaxf(mx, s1[i]);
        mx = fmaxf(mx, __shfl_xor(mx, 32));
        const float mn = fmaxf(m, mx), alpha = fast_exp2(m - mn); m = mn;
        float ps = 0.f;
#pragma unroll
        for (int i = 0; i < 16; ++i) { s0[i] = fast_exp2(s0[i] - mn); s1[i] = fast_exp2(s1[i] - mn); ps += s0[i] + s1[i]; }
        lsum = lsum * alpha + ps;
#pragma unroll
        for (int i = 0; i < 16; ++i) { o0[i] *= alpha; o1[i] *= alpha; }
        bf16x8 p[4];
        { u32x4 w;
          w.x = cvtpk(s0[0], s0[1]); w.y = cvtpk(s0[2], s0[3]); w.z = cvtpk(s0[4], s0[5]); w.w = cvtpk(s0[6], s0[7]); p[0] = __builtin_bit_cast(bf16x8, w);
          w.x = cvtpk(s0[8], s0[9]); w.y = cvtpk(s0[10], s0[11]); w.z = cvtpk(s0[12], s0[13]); w.w = cvtpk(s0[14], s0[15]); p[1] = __builtin_bit_cast(bf16x8, w);
          w.x = cvtpk(s1[0], s1[1]); w.y = cvtpk(s1[2], s1[3]); w.z = cvtpk(s1[4], s1[5]); w.w = cvtpk(s1[6], s1[7]); p[2] = __builtin_bit_cast(bf16x8, w);
          w.x = cvtpk(s1[8], s1[9]); w.y = cvtpk(s1[10], s1[11]); w.z = cvtpk(s1[12], s1[13]); w.w = cvtpk(s1[14], s1[15]); p[3] = __builtin_bit_cast(bf16x8, w); }
#pragma unroll
        for (int c = 0; c < 4; ++c) {
            const bf16x8 va = *(const LAS bf16x8*)(Vt + tile_off(r, 2 * c + h)), vb = *(const LAS bf16x8*)(Vt + tile_off(32 + r, 2 * c + h));
            o0 = MFMA32(va, p[c], o0); o1 = MFMA32(vb, p[c], o1); }
        if (it + 1 < ntile) { LAS unsigned char* Kn = L + ((it + 1) & 1) * 16384;
            *(LAS u32x4*)(Kn + tile_off(srow, sch)) = kreg; *(LAS u32x4*)(Kn + 8192 + tile_off(srow, sch)) = vreg; }
        __syncthreads();
    }
    float lt = lsum + __shfl_xor(lsum, 32);
    if (has_sink) lt += fast_exp2(sink2 - m);
    const float inv = 1.f / lt;
#pragma unroll
    for (int g = 0; g < 4; ++g) {
        u32x2 w0, w1;
        w0.x = cvtpk(o0[4 * g] * inv, o0[4 * g + 1] * inv); w0.y = cvtpk(o0[4 * g + 2] * inv, o0[4 * g + 3] * inv);
        w1.x = cvtpk(o1[4 * g] * inv, o1[4 * g + 1] * inv); w1.y = cvtpk(o1[4 * g + 2] * inv, o1[4 * g + 3] * inv);
        *(u32x2*)(Qw + (size_t)r * 512 + 8 * g + 4 * h) = w0;
        *(u32x2*)(Qw + (size_t)r * 512 + 32 + 8 * g + 4 * h) = w1; }
}

__device__ __forceinline__ void hyena_unit_lat(const Fr& F, const bf16_t* Fg, const bf16_t* Vg, bf16_t* Yg) {
    constexpr int FREP = 8192 + 64, VPIT = 4096 + 16, VOFF = 8 * FREP;
    LAS unsigned char* L = F.lds;
    __syncthreads();
    for (int i = F.tid; i < 512; i += NTHR) *(LAS u32x4*)(L + i * 16) = *(const u32x4*)(Fg + i * 8);
    if (F.tid < 4) *(LAS u32x4*)(L + 8192 + F.tid * 16) = (u32x4){0u, 0u, 0u, 0u};
    for (int i = F.tid; i < 16 * 256; i += NTHR) { const int b = i >> 8, x = i & 255; *(LAS u32x4*)(L + VOFF + b * VPIT + x * 16) = *(const u32x4*)(Vg + (size_t)b * SEQ + x * 8); }
    __syncthreads();
    for (int i = F.tid; i < 7 * 2048; i += NTHR) { const int rho = 1 + i / 2048, x2 = (i % 2048) * 2;
        const int s0 = x2 + rho, s1 = x2 + 1 + rho;
        const unsigned e0 = s0 < 4096 ? *(const LAS bf16_t*)(L + s0 * 2) : 0, e1 = s1 < 4096 ? *(const LAS bf16_t*)(L + s1 * 2) : 0;
        *(LAS unsigned*)(L + rho * FREP + x2 * 2) = e0 | (e1 << 16); }
    __syncthreads();
    const int i16 = F.lane & 15, q4 = F.lane >> 4, w = F.wave;
    const int base0 = 2047 - 256 * w - i16 + 8 * q4;
    const int rho = base0 & 7;
    LAS unsigned char* Ap = L + rho * FREP + (base0 - rho) * 2;
    LAS unsigned char* Bp = L + VOFF + i16 * VPIT + q4 * 16;
    bf16x8 A[16]; f32x4 acc[16];
#pragma unroll
    for (int rr = 0; rr < 16; ++rr) { A[rr] = *(const LAS bf16x8*)(Ap - 32 * rr); acc[rr] = (f32x4){0.f, 0.f, 0.f, 0.f}; }
    for (int o = 0; o < 8; ++o) {
#pragma unroll
        for (int u = 0; u < 8; ++u) {
            const int st = o * 8 + u;
            const bf16x8 Bf = *(const LAS bf16x8*)(Bp + 64 * st);
#pragma unroll
            for (int rr = 0; rr < 16; ++rr) acc[rr] = MFMA16(A[(rr - 2 * u) & 15], Bf, acc[rr]);
            if (st < 63) { A[(-2 * u - 2) & 15] = *(const LAS bf16x8*)(Ap + 64 * st + 64); A[(-2 * u - 1) & 15] = *(const LAS bf16x8*)(Ap + 64 * st + 32); }
        }
    }
#pragma unroll
    for (int rr = 0; rr < 16; ++rr) { u32x2 wv; wv.x = cvtpk(acc[rr].x, acc[rr].y); wv.y = cvtpk(acc[rr].z, acc[rr].w);
        *(u32x2*)(Yg + (size_t)i16 * SEQ + 256 * w + 16 * rr + 4 * q4) = wv; }
}
__device__ __forceinline__ void hyena_unit_ctx(const Fr& F, const bf16_t* Fg, const bf16_t* Vg, bf16_t* Yg) {
    constexpr int FREP = 1024 + 64, VPIT = 512 + 16, VOFF = 8 * FREP;
    LAS unsigned char* L = F.lds;
    __syncthreads();
    if (F.tid < 64) *(LAS u32x4*)(L + F.tid * 16) = *(const u32x4*)(Fg + F.tid * 8);
    if (F.tid >= 64 && F.tid < 68) *(LAS u32x4*)(L + 1024 + (F.tid - 64) * 16) = (u32x4){0u, 0u, 0u, 0u};
    { const int b = F.tid >> 5, x = F.tid & 31; *(LAS u32x4*)(L + VOFF + b * VPIT + x * 16) = *(const u32x4*)(Vg + (size_t)b * CTX + x * 8); }
    __syncthreads();
    for (int i = F.tid; i < 7 * 256; i += NTHR) { const int rho = 1 + i / 256, x2 = (i % 256) * 2; const int s0 = x2 + rho, s1 = x2 + 1 + rho;
        const unsigned e0 = s0 < 512 ? *(const LAS bf16_t*)(L + s0 * 2) : 0, e1 = s1 < 512 ? *(const LAS bf16_t*)(L + s1 * 2) : 0;
        *(LAS unsigned*)(L + rho * FREP + x2 * 2) = e0 | (e1 << 16); }
    __syncthreads();
    const int i16 = F.lane & 15, q4 = F.lane >> 4, w = F.wave;
    const int base0 = 255 - 32 * w - i16 + 8 * q4, rho = base0 & 7;
    LAS unsigned char* Ap = L + rho * FREP + (base0 - rho) * 2;
    LAS unsigned char* Bp = L + VOFF + i16 * VPIT + q4 * 16;
    f32x4 acc0 = (f32x4){0.f, 0.f, 0.f, 0.f}, acc1 = acc0;
#pragma unroll
    for (int st = 0; st < 8; ++st) { const bf16x8 Bf = *(const LAS bf16x8*)(Bp + 64 * st);
        const bf16x8 A0 = *(const LAS bf16x8*)(Ap + 64 * st), A1 = *(const LAS bf16x8*)(Ap + 64 * st - 32);
        acc0 = MFMA16(A0, Bf, acc0); acc1 = MFMA16(A1, Bf, acc1); }
    u32x2 wv; wv.x = cvtpk(acc0.x, acc0.y); wv.y = cvtpk(acc0.z, acc0.w); *(u32x2*)(Yg + (size_t)i16 * CTX + 32 * w + 4 * q4) = wv;
    wv.x = cvtpk(acc1.x, acc1.y); wv.y = cvtpk(acc1.z, acc1.w); *(u32x2*)(Yg + (size_t)i16 * CTX + 32 * w + 16 + 4 * q4) = wv;
}

__device__ __forceinline__ void mixer_phase(const Fr& F, const Args& a, int l, bool with_ctx) {
    bf16_t* QA = (bf16_t*)(a.ws + WS_QA); bf16_t* QW = (bf16_t*)(a.ws + WS_QW);
    const bf16_t* KA = (const bf16_t*)(a.ws + WS_KA); const bf16_t* KW = (const bf16_t*)(a.ws + WS_KW);
    const bf16_t* VTA = (const bf16_t*)(a.ws + WS_VTA); const bf16_t* VTW = (const bf16_t*)(a.ws + WS_VTW);
    const float* sinks = a.in[I_SINK] + l * 8;
    const int wq = F.wave >> 1, wh = F.wave & 1;
    for (int unit = F.bid; unit < NB * 2 * 32; unit += F.G) {
        const int b = unit >> 6, kvh = (unit >> 5) & 1, pb = unit & 31;
        bf16_t* Qw = QA + (size_t)(b * SEQ + pb * 64 + wh * 32) * 512 + (kvh * 4 + wq) * 64;
        attn_unit<false>(F, Qw, KA + (size_t)b * KEYS * 128 + kvh * 64, VTA + (size_t)(b * 2 + kvh) * 64 * KEYS, 0, KEYS / 64, 0, 0, 0, false, 0.f);
    }
    for (int unit = F.bid; unit < NB * 2 * 32; unit += F.G) {
        const int b = unit >> 6, kvh = (unit >> 5) & 1, pb = unit & 31;
        bf16_t* Qw = QW + (size_t)(b * SEQ + pb * 64 + wh * 32) * 512 + (kvh * 4 + wq) * 64;
        const int lo = pb - 2 < 0 ? 0 : pb - 2, hi = pb + 2 > 31 ? 31 : pb + 2;
        attn_unit<true>(F, Qw, KW + (size_t)b * KEYS * 128 + kvh * 64, VTW + (size_t)(b * 2 + kvh) * 64 * KEYS, 0, 4, 4 + lo, hi - lo + 1, pb * 64 + wh * 32, true, sinks[kvh * 4 + wq] * LOG2E);
    }
    if (with_ctx) {
        for (int unit = F.bid; unit < 2 * NB * 2 * 4; unit += F.G) {
            const int isw = unit >> 7, u2 = unit & 127, b = u2 >> 3, kvh = (u2 >> 2) & 1, pb = u2 & 3;
            bf16_t* Qw = (isw ? QW : QA) + (size_t)(TL + b * CTX + pb * 64 + wh * 32) * 512 + (kvh * 4 + wq) * 64;
            attn_unit<false>(F, Qw, (isw ? KW : KA) + (size_t)b * KEYS * 128 + kvh * 64, (isw ? VTW : VTA) + (size_t)(b * 2 + kvh) * 64 * KEYS, 0, 4, 0, 0, 0, isw != 0, isw ? sinks[kvh * 4 + wq] * LOG2E : 0.f);
        }
    }
    const bf16_t* FL = (const bf16_t*)(a.ws + WS_FL) + (size_t)l * 512 * 4096; const bf16_t* FC = (const bf16_t*)(a.ws + WS_FC) + (size_t)l * 512 * 512;
    const bf16_t* VT = (const bf16_t*)(a.ws + WS_VT); bf16_t* YT = (bf16_t*)(a.ws + WS_YT);
    for (int c = F.bid; c < HYW; c += F.G) hyena_unit_lat(F, FL + (size_t)c * 4096, VT + (size_t)c * NB * SEQ, YT + (size_t)c * NB * SEQ);
    if (with_ctx) for (int c = F.bid; c < HYW; c += F.G) hyena_unit_ctx(F, FC + (size_t)c * 512, VT + VT_CTX_OFF + (size_t)c * NB * CTX, YT + VT_CTX_OFF + (size_t)c * NB * CTX);
    __syncthreads();
}

struct EpiInProj {
    static constexpr bool PERM = true, AFTER_DRAIN = false;
    bf16_t *QA, *RAWA, *U, *QW, *RAWW, *Gt;
    __device__ __forceinline__ void operator()(const pg8::f32x4 (&acc)[2][2][4][2], const pg8::Unit& u, int wr, int wc, int fr, int fq) const {
        const int pn = u.pn; bf16_t* base; int ldc, colt; bool sig = false;
        if (pn < 2) { base = QA; ldc = 512; colt = pn * 256; }
        else if (pn == 2) { base = RAWA; ldc = 256; colt = 0; }
        else if (pn < 9) { base = U; ldc = 1536; colt = (pn - 3) * 256; }
        else if (pn < 11) { base = QW; ldc = 512; colt = (pn - 9) * 256; }
        else if (pn == 11) { base = RAWW; ldc = 256; colt = 0; }
        else { base = Gt; ldc = 3072; colt = (pn - 12) * 256; sig = true; }
        const int row0 = u.pm * 256 + wr * 64 + fr, col0 = colt + wc * 32 + 8 * fq;
#pragma unroll
        for (int ai = 0; ai < 2; ++ai)
#pragma unroll
            for (int m = 0; m < 4; ++m) { bf16_t* rowp = base + (size_t)(row0 + ai * 128 + m * 16) * ldc + col0;
#pragma unroll
                for (int bj = 0; bj < 2; ++bj) { pg8::f32x4 v0 = acc[ai][bj][m][0], v1 = acc[ai][bj][m][1];
                    if (sig) { v0.x = sigmoid_f(v0.x); v0.y = sigmoid_f(v0.y); v0.z = sigmoid_f(v0.z); v0.w = sigmoid_f(v0.w); v1.x = sigmoid_f(v1.x); v1.y = sigmoid_f(v1.y); v1.z = sigmoid_f(v1.z); v1.w = sigmoid_f(v1.w); }
                    u32x4 w; w.x = cvtpk(v0.x, v0.y); w.y = cvtpk(v0.z, v0.w); w.z = cvtpk(v1.x, v1.y); w.w = cvtpk(v1.z, v1.w);
                    *(u32x4*)(rowp + bj * 128) = w; } }
    }
};
template <int B> struct EpiMerge {
    static constexpr bool PERM = true, AFTER_DRAIN = false;
    bf16_t* Mo; const bf16_t* Gt;
    __device__ __forceinline__ void operator()(const pg8::f32x4 (&acc)[2][2][4][2], const pg8::Unit& u, int wr, int wc, int fr, int fq) const {
        const int row0 = u.pm * 256 + wr * 64 + fr, col0 = u.pn * 256 + wc * 32 + 8 * fq;
#pragma unroll
        for (int ai = 0; ai < 2; ++ai)
#pragma unroll
            for (int m = 0; m < 4; ++m) { const size_t row = (size_t)(row0 + ai * 128 + m * 16);
#pragma unroll
                for (int bj = 0; bj < 2; ++bj) { const pg8::f32x4 v0 = acc[ai][bj][m][0], v1 = acc[ai][bj][m][1];
                    const u32x4 g = *(const u32x4*)(Gt + row * 3072 + B * 1024 + col0 + bj * 128);
                    float o[8] = {v0.x * bflo(g.x), v0.y * bfhi(g.x), v0.z * bflo(g.y), v0.w * bfhi(g.y), v1.x * bflo(g.z), v1.y * bfhi(g.z), v1.z * bflo(g.w), v1.w * bfhi(g.w)};
                    bf16_t* mp = Mo + row * 1024 + col0 + bj * 128;
                    if (B > 0) { const u32x4 p = *(const u32x4*)mp; o[0] += bflo(p.x); o[1] += bfhi(p.x); o[2] += bflo(p.y); o[3] += bfhi(p.y); o[4] += bflo(p.z); o[5] += bfhi(p.z); o[6] += bflo(p.w); o[7] += bfhi(p.w); }
                    u32x4 w; w.x = cvtpk(o[0], o[1]); w.y = cvtpk(o[2], o[3]); w.z = cvtpk(o[4], o[5]); w.w = cvtpk(o[6], o[7]);
                    *(u32x4*)mp = w; } }
    }
};
struct EpiOut {
    static constexpr bool PERM = true, AFTER_DRAIN = false;
    const float* xsL; const float* xsC; float* xdL; float* xdC; const float* MODl;
    __device__ __forceinline__ void operator()(const pg8::f32x4 (&acc)[2][2][4][2], const pg8::Unit& u, int wr, int wc, int fr, int fq) const {
        const int row0 = u.pm * 256 + wr * 64 + fr, col0 = u.pn * 256 + wc * 32 + 8 * fq;
#pragma unroll
        for (int ai = 0; ai < 2; ++ai)
#pragma unroll
            for (int m = 0; m < 4; ++m) { const int row = row0 + ai * 128 + m * 16; const bool lat = row < TL;
                const float* xs = lat ? xsL + (size_t)row * D : xsC + (size_t)(row - TL) * D; float* xd = lat ? xdL + (size_t)row * D : xdC + (size_t)(row - TL) * D;
                const float* md = MODl + (size_t)mod_row(row) * DIN + 2 * 1024;
#pragma unroll
                for (int bj = 0; bj < 2; ++bj)
#pragma unroll
                    for (int n = 0; n < 2; ++n) { const int col = col0 + bj * 128 + 4 * n;
                        const f32x4 xv = *(const f32x4*)(xs + col), mv = *(const f32x4*)(md + col); const pg8::f32x4 av = acc[ai][bj][m][n];
                        f32x4 o; o.x = xv.x + mv.x * av.x; o.y = xv.y + mv.y * av.y; o.z = xv.z + mv.z * av.z; o.w = xv.w + mv.w * av.w;
                        *(f32x4*)(xd + col) = o; } }
    }
};
struct EpiMoe1 {
    static constexpr bool PERM = true, AFTER_DRAIN = false;
    bf16_t* HM;
    __device__ __forceinline__ void operator()(const pg8::f32x4 (&acc)[2][2][4][2], const pg8::Unit& u, int wr, int wc, int fr, int fq) const {
        const int row0 = u.pm * 256 + wr * 64 + fr, hcol0 = (u.pn & 3) * 128 + wc * 16 + 4 * fq;
#pragma unroll
        for (int ai = 0; ai < 2; ++ai)
#pragma unroll
            for (int m = 0; m < 4; ++m) { bf16_t* rowp = HM + (size_t)(row0 + ai * 128 + m * 16) * 512 + hcol0;
#pragma unroll
                for (int bj = 0; bj < 2; ++bj) { const pg8::f32x4 x = acc[ai][bj][m][0], y = acc[ai][bj][m][1];
                    u32x2 w; w.x = cvtpk(x.x * sigmoid_f(x.x) * y.x, x.y * sigmoid_f(x.y) * y.y); w.y = cvtpk(x.z * sigmoid_f(x.z) * y.z, x.w * sigmoid_f(x.w) * y.w);
                    *(u32x2*)(rowp + bj * 64) = w; } }
    }
};
struct EpiMoe2 {
    static constexpr bool PERM = true, AFTER_DRAIN = false;
    bf16_t* Fo; const int* rowmap; const float* roww;
    __device__ __forceinline__ void operator()(const pg8::f32x4 (&acc)[2][2][4][2], const pg8::Unit& u, int wr, int wc, int fr, int fq) const {
        const int row0 = u.pm * 256 + wr * 64 + fr, col0 = (u.pn & 3) * 256 + wc * 32 + 8 * fq;
#pragma unroll
        for (int ai = 0; ai < 2; ++ai)
#pragma unroll
            for (int m = 0; m < 4; ++m) { const int row = row0 + ai * 128 + m * 16; const int rm = rowmap[row];
                if (rm >= 0) { const float wgt = roww[row]; bf16_t* rowp = Fo + ((size_t)(rm & 1) * TT + (rm >> 1)) * D + col0;
#pragma unroll
                    for (int bj = 0; bj < 2; ++bj) { const pg8::f32x4 v0 = acc[ai][bj][m][0], v1 = acc[ai][bj][m][1];
                        u32x4 w; w.x = cvtpk(v0.x * wgt, v0.y * wgt); w.y = cvtpk(v0.z * wgt, v0.w * wgt); w.z = cvtpk(v1.x * wgt, v1.y * wgt); w.w = cvtpk(v1.z * wgt, v1.w * wgt);
                        *(u32x4*)(rowp + bj * 128) = w; } } }
    }
};
struct MoeOrder {
    int nunits, G, c; const LAS int* tile_e;
    __device__ __forceinline__ bool next(int i, pg8::Unit& u) const {
        const int L = i * G + c; if (L >= nunits) return false;
        const int pm = L >> 2; u.pm = pm; u.pn = __builtin_amdgcn_readfirstlane(tile_e[pm]) * 4 + (L & 3); return true; }
    __device__ __forceinline__ void a_ready(const pg8::Unit&) const {}
    __device__ __forceinline__ void done(const pg8::Unit&) const {}
};

__device__ __forceinline__ int moe_tables(const Fr& F, const Args& a, int l, LAS int* ebase  , LAS int* ecnt  , LAS int* tile_e  ) {
    const unsigned* CNT = (const unsigned*)(a.ws + WS_CTL) + CW_CNT + l * 256;
    __syncthreads();
    if (F.tid == 0) { int acc = 0;
        for (int e = 0; e < NE; ++e) { const int c = (int)__hip_atomic_load(&CNT[e * 16], __ATOMIC_RELAXED, __HIP_MEMORY_SCOPE_AGENT); ecnt[e] = c; ebase[e] = acc; const int nt = (c + 255) >> 8;
            for (int t = 0; t < nt; ++t) tile_e[(acc >> 8) + t] = e; acc += nt << 8; }
        ebase[NE] = acc; }
    __syncthreads();
    return ebase[NE] >> 8;
}

__device__ __forceinline__ void gather_phase(const Fr& F, const Args& a, int l, int nrows) {
    LAS int* ebase = (LAS int*)(F.lds + MISC_OFF + 64); LAS int* ecnt = ebase + 20; LAS int* tile_e = (LAS int*)(F.lds + MISC_OFF + 512);
    (void)moe_tables(F, a, l, ebase, ecnt, tile_e);
    const bf16_t* H = (const bf16_t*)(a.ws + WS_H); bf16_t* AP = (bf16_t*)(a.ws + WS_G);
    const int* TOKE = (const int*)(a.ws + WS_TOKE); const int* TOKP = (const int*)(a.ws + WS_TOKP); const float* TOKW = (const float*)(a.ws + WS_TOKW);
    int* rowmap = (int*)(a.ws + WS_ROWMAP); float* roww = (float*)(a.ws + WS_ROWW);
    const int gw = F.bid * NWAVES + F.wave, NGW = F.G * NWAVES;
    for (int row = gw; row < nrows; row += NGW) {
        const u32x4 v0 = *(const u32x4*)(H + (size_t)row * D + F.lane * 8), v1 = *(const u32x4*)(H + (size_t)row * D + 512 + F.lane * 8);
#pragma unroll
        for (int k = 0; k < 2; ++k) { const int dest = ebase[TOKE[2 * row + k]] + TOKP[2 * row + k];
            *(u32x4*)(AP + (size_t)dest * D + F.lane * 8) = v0; *(u32x4*)(AP + (size_t)dest * D + 512 + F.lane * 8) = v1;
            if (F.lane == 0) { rowmap[dest] = row * 2 + k; roww[dest] = TOKW[2 * row + k]; } }
    }
    for (int e = F.bid; e < NE; e += F.G) { const int lo = ebase[e] + ecnt[e], hi = ebase[e + 1];
        for (int rr = lo + F.wave; rr < hi; rr += NWAVES) { *(u32x4*)(AP + (size_t)rr * D + F.lane * 8) = (u32x4){0u, 0u, 0u, 0u}; *(u32x4*)(AP + (size_t)rr * D + 512 + F.lane * 8) = (u32x4){0u, 0u, 0u, 0u};
            if (F.lane == 0) rowmap[rr] = -1; } }
}

#ifndef MK_PER_PHASE
#define MK_PER_PHASE 0
#endif
constexpr int PH_PER_LAYER = 11, PH_FINAL = 1 + NL * PH_PER_LAYER, N_PHASES = PH_FINAL + 1;

__global__ void __launch_bounds__(NTHR, 2) trunk_fwd(Args args) {
    extern __shared__ __attribute__((aligned(16))) unsigned char lds[];
    Fr F; F.lds = (LAS unsigned char*)lds; F.tid = threadIdx.x; F.lane = F.tid & 63; F.wave = __builtin_amdgcn_readfirstlane(F.tid >> 6); F.G = gridDim.x; F.bid = blockIdx.x;
    for (int u = F.tid; u < (LDS_BYTES - MISC_OFF) / 4; u += NTHR) ((LAS unsigned*)(F.lds + MISC_OFF))[u] = 0u;
    __syncthreads();
    const int lo = args.ph_lo, hi = args.ph_hi;
    unsigned* ctl = (unsigned*)(args.ws + WS_CTL);
    XcdBarrier bar; bar.bar = ctl + CW_BAR; bar.x = 0; bar.st = (volatile LAS unsigned*)(F.lds + MISC_OFF);
    if (hi - lo > 1) bar = xcd_barrier_post(ctl + CW_BAR, (volatile LAS unsigned*)(F.lds + MISC_OFF));
#ifndef DBG_ONLY
#define DBG_ONLY -1
#endif
#define SEL(p) (DBG_ONLY < 0 || DBG_ONLY == (p))
#define IN(k) (lo <= (k) && (k) < hi)
#define FRESH() do { int t_ = threadIdx.x; asm volatile("" : "+v"(t_)); F.tid = t_; F.lane = t_ & 63; F.wave = __builtin_amdgcn_readfirstlane(t_ >> 6); } while (0)
#define SEAM(k) do { if (IN(k) && IN((k) + 1)) xcd_barrier(bar); } while (0)
    unsigned char* ws = args.ws;
    LAS int* ebase = (LAS int*)(F.lds + MISC_OFF + 64); LAS int* ecnt = ebase + 20; LAS int* tile_e = (LAS int*)(F.lds + MISC_OFF + 512);

    #ifndef DBG_PRO
#define DBG_PRO 7
#endif
    if (SEL(100) && IN(0)) { FRESH(); if (DBG_PRO & 1) pro_mod(F, args); __syncthreads(); if (DBG_PRO & 2) pro_rope(F, args); if (DBG_PRO & 4) pro_filter(F, args); __syncthreads(); }
    SEAM(0);
    for (int l = 0; l < NL; ++l) {
        const int pb = 1 + PH_PER_LAYER * l; const bool uc = l < NL - 1; const int M2 = uc ? TT : TL;
        if (SEL(0) && IN(pb + 0)) { FRESH(); if (l == 0) filter_norm_reduce(F, args); conv_small_weights(F, args, l); rows_p0(F, args, l, TT); __syncthreads(); }
        SEAM(pb + 0);
        if (SEL(1) && IN(pb + 1)) {
            pg8::Gemm g{(const bf16_t*)(ws + WS_H), (const bf16_t*)(ws + WS_WIN), TT, DIN, 1024}; pg8::StaticOrder S; S.init(TT, DIN, F.G, F.bid);
            EpiInProj E{(bf16_t*)(ws + WS_QA), (bf16_t*)(ws + WS_RAWA), (bf16_t*)(ws + WS_U), (bf16_t*)(ws + WS_QW), (bf16_t*)(ws + WS_RAWW), (bf16_t*)(ws + WS_G)};
            pg8::gemm_phase<EpiInProj, pg8::StaticOrder, true, true>(F.lds, g, S, E);
        }
        SEAM(pb + 1);
        if (SEL(2) && IN(pb + 2)) { FRESH(); prep_phase(F, args, l); }
        SEAM(pb + 2);
        if (SEL(3) && IN(pb + 3)) { FRESH(); mixer_phase(F, args, l, uc); }
        SEAM(pb + 3);
        if (SEL(4) && IN(pb + 4)) { FRESH(); hyena_final_phase(F, args, l, uc); }
        SEAM(pb + 4);
        if (SEL(5) && IN(pb + 5)) {
            pg8::StaticOrder S; S.init(M2, 1024, F.G, F.bid);
            { pg8::Gemm g{(const bf16_t*)(ws + WS_QA), (const bf16_t*)(ws + WS_WBR), M2, 1024, 512}; EpiMerge<0> E{(bf16_t*)(ws + WS_H), (const bf16_t*)(ws + WS_G)};
              pg8::gemm_phase<EpiMerge<0>, pg8::StaticOrder, true, true>(F.lds, g, S, E); }
            { pg8::Gemm g{(const bf16_t*)(ws + WS_YH), (const bf16_t*)(ws + WS_WBR) + (size_t)1024 * 512, M2, 1024, 512}; EpiMerge<1> E{(bf16_t*)(ws + WS_H), (const bf16_t*)(ws + WS_G)};
              pg8::gemm_phase<EpiMerge<1>, pg8::StaticOrder, true, true>(F.lds, g, S, E); }
            { pg8::Gemm g{(const bf16_t*)(ws + WS_QW), (const bf16_t*)(ws + WS_WBR) + (size_t)2 * 1024 * 512, M2, 1024, 512}; EpiMerge<2> E{(bf16_t*)(ws + WS_H), (const bf16_t*)(ws + WS_G)};
              pg8::gemm_phase<EpiMerge<2>, pg8::StaticOrder, true, true>(F.lds, g, S, E); }
        }
        SEAM(pb + 5);
        if (SEL(6) && IN(pb + 6)) {
            pg8::Gemm g{(const bf16_t*)(ws + WS_H), (const bf16_t*)(ws + WS_WOUT), M2, 1024, 1024}; pg8::StaticOrder S; S.init(M2, 1024, F.G, F.bid);
            EpiOut E{l == 0 ? args.in[I_X] : args.out, l == 0 ? args.in[I_CTX] : (const float*)(ws + WS_XC), args.out, (float*)(ws + WS_XC), (const float*)(ws + WS_MOD) + (size_t)l * NBM * DIN};
            pg8::gemm_phase<EpiOut, pg8::StaticOrder, true, true>(F.lds, g, S, E);
        }
        SEAM(pb + 6);
        if (SEL(7) && IN(pb + 7)) { FRESH(); rows_p5(F, args, l, M2); conv_expert_weights(F, args, l); __syncthreads(); }
        SEAM(pb + 7);
        if (SEL(8) && IN(pb + 8)) { FRESH(); gather_phase(F, args, l, M2); }
        SEAM(pb + 8);
        if (SEL(9) && IN(pb + 9)) { FRESH();
            const int ntile = moe_tables(F, args, l, ebase, ecnt, tile_e);
            pg8::Gemm g{(const bf16_t*)(ws + WS_G), (const bf16_t*)(ws + WS_W13), ntile * 256, NE * 1024, 1024}; MoeOrder S{ntile * 4, F.G, F.bid, tile_e};
            EpiMoe1 E{(bf16_t*)(ws + WS_U)};
            pg8::gemm_phase<EpiMoe1, MoeOrder, true, true>(F.lds, g, S, E);
        }
        SEAM(pb + 9);
        if (SEL(10) && IN(pb + 10)) { FRESH();
            const int ntile = moe_tables(F, args, l, ebase, ecnt, tile_e);
            pg8::Gemm g{(const bf16_t*)(ws + WS_U), (const bf16_t*)(ws + WS_W2), ntile * 256, NE * 1024, 512}; MoeOrder S{ntile * 4, F.G, F.bid, tile_e};
            EpiMoe2 E{(bf16_t*)(ws + WS_F), (const int*)(ws + WS_ROWMAP), (const float*)(ws + WS_ROWW)};
            pg8::gemm_phase<EpiMoe2, MoeOrder, true, true>(F.lds, g, S, E);
        }
        SEAM(pb + 10);
    }
    if (SEL(101) && IN(PH_FINAL)) { FRESH(); rows_final(F, args); }
#undef IN
#undef SEAM
}

__global__ void dbg_dump(const unsigned char* src, size_t nelem, int is_f32, float* out, size_t nout) {
    for (size_t i = (size_t)blockIdx.x * blockDim.x + threadIdx.x; i < nout; i += (size_t)gridDim.x * blockDim.x) {
        const size_t j = i % nelem; out[i] = is_f32 ? ((const float*)src)[j] : bf1(((const bf16_t*)src)[j]); }
}
extern "C" void kernel_launch(void* const* d_in, const int* in_sizes, int n_in, void* d_out, int out_size, void* d_ws, size_t ws_size, hipStream_t stream) {
    static int grid = 0;
    if (grid == 0) {
        if (n_in != 29 || in_sizes[0] != TL * D || out_size != TL * D || ws_size < WS_END) { fprintf(stderr, "kernel_launch: unexpected shapes / workspace (n_in %d, ws %zu < %zu); nothing launched\n", n_in, ws_size, (size_t)WS_END); grid = -1; return; }
        int dev = 0, cus = 0, per_cu = 0;
        if (hipGetDevice(&dev) != hipSuccess || hipDeviceGetAttribute(&cus, hipDeviceAttributeMultiprocessorCount, dev) != hipSuccess) { grid = -1; return; }
        if (hipFuncSetAttribute((const void*)trunk_fwd, hipFuncAttributeMaxDynamicSharedMemorySize, LDS_BYTES) != hipSuccess) { fprintf(stderr, "kernel_launch: hipFuncSetAttribute failed\n"); grid = -1; return; }
        if (hipOccupancyMaxActiveBlocksPerMultiprocessor(&per_cu, (const void*)trunk_fwd, NTHR, LDS_BYTES) != hipSuccess || per_cu < 1) { fprintf(stderr, "kernel_launch: occupancy query reports %d\n", per_cu); }
        (void)hipGetLastError();
        grid = cus;
    }
    if (grid < 0) return;
    (void)hipMemsetAsync((char*)d_ws + WS_CTL, 0, CTL_ZERO_BYTES, stream);
    Args a{};
    for (int i = 0; i < 29; ++i) a.in[i] = (const float*)d_in[i];
    a.out = (float*)d_out; a.ws = (unsigned char*)d_ws;
#if defined(DBG_STOP)
    for (int k = 0; k <= DBG_STOP; ++k) { a.ph_lo = k; a.ph_hi = k + 1; hipLaunchKernelGGL(trunk_fwd, dim3(grid), dim3(NTHR), LDS_BYTES, stream, a); }
#if defined(DBG_DUMP_OFF)
    hipLaunchKernelGGL(dbg_dump, dim3(2048), dim3(256), 0, stream, (const unsigned char*)d_ws + (size_t)(DBG_DUMP_OFF), (size_t)(DBG_DUMP_N), (int)(DBG_DUMP_F32), (float*)d_out, (size_t)out_size);
#endif
#elif MK_PER_PHASE
    for (int k = 0; k < N_PHASES; ++k) { a.ph_lo = k; a.ph_hi = k + 1; hipLaunchKernelGGL(trunk_fwd, dim3(grid), dim3(NTHR), LDS_BYTES, stream, a); }
#else
    a.ph_lo = 0; a.ph_hi = N_PHASES;
    hipLaunchKernelGGL(trunk_fwd, dim3(grid), dim3(NTHR), LDS_BYTES, stream, a);
#endif
}
```

```cpp
#include <hip/hip_runtime.h>
#include <cstdio>
#include <cstdint>

#define GAS __attribute__((address_space(1)))
#define LAS __attribute__((address_space(3)))
__device__ __forceinline__ int lane_id() { int l; asm volatile("v_mbcnt_lo_u32_b32 %0, -1, 0\n\tv_mbcnt_hi_u32_b32 %0, -1, %0" : "=v"(l)); return l; }
#define MK_PER_PHASE 0
namespace pg8 {
#define PG8_LAS __attribute__((address_space(3)))
typedef unsigned short bf16_t;
typedef short bf16x8 __attribute__((ext_vector_type(8)));
typedef float f32x4 __attribute__((ext_vector_type(4)));
typedef unsigned u32x4 __attribute__((ext_vector_type(4)));
constexpr int BM = 256, BK = 64, HALF = 128, HTB = HALF * BK * 2  , STAGE_BYTES = 8 * HTB, NXCD = 8, WGM = 8;

__host__ __device__ __forceinline__ int lds_byte(int r, int c) { const int st = (r >> 4) * 2 + (c >> 5), rr = r & 15, cc = c & 31, ob = rr * 64 + cc * 2; return st * 1024 + (ob ^ (((ob >> 9) & 1) << 5)); }
__host__ __device__ __forceinline__ void stage_rc(int b, int& R, int& C) { const int st = b / 1024, sb = b % 1024, swz = sb ^ (((sb >> 9) & 1) << 5); R = (st >> 1) * 16 + swz / 64; C = (st & 1) * 32 + (swz % 64) / 2; }
__host__ __device__ __forceinline__ int perm32(int rho) { const int n = rho >> 4, i = rho & 15; return 8 * (i >> 2) + 4 * n + (i & 3); }

struct Unit { int pm, pn; };
struct Gemm { const bf16_t* A; const bf16_t* Bt; int M, N, K; };

struct StaticOrder {
    int nM, nN, nwg, G, c;
    __host__ __device__ void init(int M, int N, int G_, int c_) { nM = M / BM; nN = N / BM; nwg = nM * nN; G = G_; c = c_; }
    __host__ __device__ bool next(int i, Unit& u) const {
        const long L = (long)i * G + c; if (L >= nwg) return false;
        int wgid = (int)L; { const int q = nwg / NXCD, r = nwg % NXCD, xcd = wgid % NXCD, off = wgid / NXCD; wgid = (xcd < r ? xcd * (q + 1) : r * (q + 1) + (xcd - r) * q) + off; }
        const int nig = WGM * nN, gid = wgid / nig, fm = gid * WGM, gsz = (nM - fm) < WGM ? (nM - fm) : WGM;
        u.pm = fm + ((wgid % nig) % gsz); u.pn = (wgid % nig) / gsz; return true;
    }
    __device__ __forceinline__ void a_ready(const Unit&) const {}
    __device__ __forceinline__ void done(const Unit&) const {}
};
__device__ __forceinline__ unsigned cvt_pk_bf16(float lo, float hi) { unsigned r; asm volatile("v_cvt_pk_bf16_f32 %0, %1, %2" : "=v"(r) : "v"(lo), "v"(hi)); return r; }
typedef float f32x2 __attribute__((ext_vector_type(2)));
template <class Epi, class Sched, bool ALIGN_EPI = false, bool SP2 = false, bool GATHER = false>
__device__ __forceinline__ void gemm_phase(PG8_LAS unsigned char* lds, const Gemm g, const Sched& S, const Epi& E, const int wave_id, const PG8_LAS int* gidx = nullptr) {
    static_assert(!GATHER || SP2, "GATHER is implemented for the SP2 loop only");
    int tid_ = wave_id * 64 + lane_id(); asm volatile("" : "+v"(tid_));
    const int tid = tid_, wid = __builtin_amdgcn_readfirstlane(tid >> 6), lane = tid & 63, wr = wid >> 2, wc = wid & 3, fr = lane & 15, fq = lane >> 4;
    const int K = g.K, nt = K / BK;
    unsigned voffA[2], voffB[2];
#pragma unroll
    for (int i = 0; i < 2; ++i) { int R, C; stage_rc(tid * 16 + i * 8192, R, C); const int Rb = Epi::PERM ? ((R & ~31) + perm32(R & 31)) : R;
        voffA[i] = (unsigned)(R * K + C) * 2u; voffB[i] = (unsigned)(Rb * K + C) * 2u; }
    unsigned goffA[2][2], goffN[2][2];
#define PG8_GOFF(dst, j) do { _Pragma("unroll") for (int _h = 0; _h < 2; ++_h) _Pragma("unroll") for (int _i = 0; _i < 2; ++_i) { int R_, C_; stage_rc(tid * 16 + _i * 8192, R_, C_); \
        dst[_h][_i] = ((unsigned)gidx[(j) * 256 + _h * 128 + R_] * (unsigned)K + (unsigned)C_) * 2u; } } while (0)
#define PG8_STAGE_A(bufoff, base, h, nx) do { if constexpr (GATHER) { unsigned o_[2] = {(nx) ? goffN[h][0] : goffA[h][0], (nx) ? goffN[h][1] : goffA[h][1]}; PG8_STAGE(bufoff, base, o_); } \
        else { PG8_STAGE(bufoff, (base) + ((h) ? hstep : 0), voffA); } } while (0)
    const size_t kstep = (size_t)(BK * 2);
    const size_t hstep = (size_t)HALF * K * 2;
    const size_t tstep = 2 * hstep;
    const unsigned ldsw = (unsigned)wid * 1024u;
    const int aoff = lds_byte(wr * 64 + fr, fq * 8), boff = lds_byte(wc * 32 + fr, fq * 8);
#define PG8_SA(b, h) (((b) * 2 + (h)) * HTB)
#define PG8_SB(b, h) ((4 + (b) * 2 + (h)) * HTB)
#define PG8_STAGE(bufoff, gbase, voff) do { _Pragma("unroll") for (int _i = 0; _i < 2; ++_i) \
        __builtin_amdgcn_global_load_lds((const unsigned*)((const char*)(gbase) + (voff)[_i]), (PG8_LAS unsigned*)(lds + (bufoff) + ldsw + _i * 8192), 16, 0, 0); } while (0)
#define PG8_LDA(dst, b, h) do { _Pragma("unroll") for (int m = 0; m < 4; ++m) _Pragma("unroll") for (int k = 0; k < 2; ++k) dst[m][k] = *(const PG8_LAS bf16x8*)(lds + PG8_SA(b, h) + aoff + m * 2048 + k * 1024); } while (0)
#define PG8_LDB(dst, b, h) do { _Pragma("unroll") for (int n = 0; n < 2; ++n) _Pragma("unroll") for (int k = 0; k < 2; ++k) dst[n][k] = *(const PG8_LAS bf16x8*)(lds + PG8_SB(b, h) + boff + n * 2048 + k * 1024); } while (0)
#define PG8_MMA(ai, bj, At, Bt) do { __builtin_amdgcn_s_setprio(1); _Pragma("unroll") for (int m = 0; m < 4; ++m) _Pragma("unroll") for (int n = 0; n < 2; ++n) _Pragma("unroll") for (int k = 0; k < 2; ++k) \
        acc[ai][bj][m][n] = __builtin_amdgcn_mfma_f32_16x16x32_bf16(Bt[n][k], At[m][k], acc[ai][bj][m][n], 0, 0, 0); __builtin_amdgcn_s_setprio(0); } while (0)
#define PG8_WAIT_V(n) asm volatile("s_waitcnt vmcnt(" #n ")" ::: "memory")
#define PG8_WAIT_L(n) asm volatile("s_waitcnt lgkmcnt(" #n ")" ::: "memory")
#define PG8_BAR __builtin_amdgcn_s_barrier()
#define PG8_SCHED __builtin_amdgcn_sched_barrier(0)
    Unit cur, nxt; int ui = 0;
    if (!S.next(0, cur)) return;
    f32x4 acc[2][2][4][2];
#pragma unroll
    for (int a = 0; a < 2; ++a)
#pragma unroll
        for (int b = 0; b < 2; ++b)
#pragma unroll
            for (int m = 0; m < 4; ++m)
#pragma unroll
                for (int n = 0; n < 2; ++n) acc[a][b][m][n] = (f32x4){0.f, 0.f, 0.f, 0.f};
    bf16x8 At[4][2], B0[2][2], B1[2][2];
    const char* cA = GATHER ? (const char*)g.A : (const char*)g.A + (size_t)cur.pm * tstep; const char* cB = (const char*)g.Bt + (size_t)cur.pn * tstep;
    if constexpr (GATHER) PG8_GOFF(goffA, 0);
    S.a_ready(cur);
    if constexpr (SP2) {
        PG8_STAGE(PG8_SB(0, 0), cB, voffB); PG8_STAGE(PG8_SB(0, 1), cB + hstep, voffB); PG8_STAGE_A(PG8_SA(0, 0), cA, 0, false); PG8_STAGE_A(PG8_SA(0, 1), cA, 1, false);
        if (wr == 1) PG8_BAR;
        PG8_WAIT_V(2); PG8_BAR;
        PG8_STAGE(PG8_SB(1, 0), cB + kstep, voffB); PG8_STAGE_A(PG8_SA(1, 0), cA + kstep, 0, false); PG8_STAGE(PG8_SB(1, 1), cB + hstep + kstep, voffB);
        PG8_WAIT_V(6); PG8_BAR;
    } else {
        PG8_STAGE(PG8_SB(0, 0), cB, voffB); PG8_STAGE(PG8_SA(0, 0), cA, voffA); PG8_STAGE(PG8_SB(0, 1), cB + hstep, voffB); PG8_STAGE(PG8_SA(0, 1), cA + hstep, voffA);
        if (wr == 1) PG8_BAR;
        PG8_WAIT_V(4); PG8_BAR;
        PG8_STAGE(PG8_SB(1, 0), cB + kstep, voffB); PG8_STAGE(PG8_SA(1, 0), cA + kstep, voffA); PG8_STAGE(PG8_SB(1, 1), cB + hstep + kstep, voffB);
        PG8_WAIT_V(6); PG8_BAR;
    }
    for (;;) {
        const bool has_next = S.next(ui + 1, nxt);
        if constexpr (GATHER) { if (has_next) PG8_GOFF(goffN, ui + 1); else { _Pragma("unroll") for (int _h = 0; _h < 2; ++_h) _Pragma("unroll") for (int _i = 0; _i < 2; ++_i) goffN[_h][_i] = goffA[_h][_i]; } }
        const char* nA = GATHER ? (const char*)g.A : has_next ? (const char*)g.A + (size_t)nxt.pm * tstep : cA; const char* nB = has_next ? (const char*)g.Bt + (size_t)nxt.pn * tstep : cB;
        for (int t = 0; t < nt; t += 2) {
            const bool last = (t == nt - 2);
            const char* a1 = cA + (size_t)(t + 1) * kstep;
            const char* a2 = last ? nA : cA + (size_t)(t + 2) * kstep; const char* b2 = last ? nB : cB + (size_t)(t + 2) * kstep;
            const char* a3 = a2 + kstep; const char* b3 = b2 + kstep;
            if (last && has_next) S.a_ready(nxt);
            if constexpr (SP2) {
            PG8_LDB(B0, 0, 0); PG8_LDB(B1, 0, 1); PG8_SCHED; PG8_LDA(At, 0, 0); PG8_STAGE_A(PG8_SA(1, 1), a1, 1, false);
            PG8_WAIT_V(8); PG8_WAIT_L(0); PG8_BAR; PG8_MMA(0, 0, At, B0); PG8_MMA(0, 1, At, B1); PG8_BAR; PG8_SCHED;
            PG8_LDA(At, 0, 1); PG8_STAGE(PG8_SB(0, 0), b2, voffB); PG8_STAGE(PG8_SB(0, 1), b2 + hstep, voffB); PG8_STAGE_A(PG8_SA(0, 0), a2, 0, last);
            PG8_WAIT_V(8); PG8_WAIT_L(0); PG8_BAR; PG8_MMA(1, 0, At, B0); PG8_MMA(1, 1, At, B1); PG8_BAR; PG8_SCHED;
            PG8_LDB(B0, 1, 0); PG8_LDB(B1, 1, 1); PG8_SCHED; PG8_LDA(At, 1, 0); PG8_STAGE_A(PG8_SA(0, 1), a2, 1, last);
            PG8_WAIT_V(8); PG8_WAIT_L(0); PG8_BAR; PG8_MMA(0, 0, At, B0); PG8_MMA(0, 1, At, B1); PG8_BAR; PG8_SCHED;
            PG8_LDA(At, 1, 1); PG8_STAGE(PG8_SB(1, 0), b3, voffB); PG8_STAGE(PG8_SB(1, 1), b3 + hstep, voffB); PG8_STAGE_A(PG8_SA(1, 0), a3, 0, last);
            PG8_WAIT_V(8); PG8_WAIT_L(0); PG8_BAR; PG8_MMA(1, 0, At, B0); PG8_MMA(1, 1, At, B1); PG8_BAR; PG8_SCHED;
            if constexpr (Epi::NSEG > 1) {
                if (t + 2 < nt && ((t + 2) & 7) == 0) E.rescale(acc, cur, (t + 2) / 8 - 1, wr, wc, fr, fq);
            }
            } else {
            PG8_LDB(B0, 0, 0); PG8_SCHED; PG8_LDA(At, 0, 0); PG8_STAGE(PG8_SA(1, 1), a1 + hstep, voffA);
            PG8_WAIT_L(8); PG8_BAR; PG8_WAIT_L(0); PG8_MMA(0, 0, At, B0); PG8_BAR; PG8_SCHED;
            PG8_LDB(B1, 0, 1); PG8_STAGE(PG8_SB(0, 0), b2, voffB);
            PG8_BAR; PG8_WAIT_L(0); PG8_MMA(0, 1, At, B1); PG8_BAR;
            PG8_LDA(At, 0, 1); PG8_STAGE(PG8_SA(0, 0), a2, voffA);
            PG8_BAR; PG8_WAIT_L(0); PG8_MMA(1, 0, At, B0); PG8_BAR; PG8_SCHED;
            PG8_STAGE(PG8_SB(0, 1), b2 + hstep, voffB);
            PG8_WAIT_V(6); PG8_BAR; PG8_MMA(1, 1, At, B1); PG8_BAR;
            PG8_LDB(B0, 1, 0); PG8_SCHED; PG8_LDA(At, 1, 0); PG8_STAGE(PG8_SA(0, 1), a2 + hstep, voffA);
            PG8_WAIT_L(8); PG8_BAR; PG8_WAIT_L(0); PG8_MMA(0, 0, At, B0); PG8_BAR; PG8_SCHED;
            PG8_LDB(B1, 1, 1); PG8_STAGE(PG8_SB(1, 0), b3, voffB);
            PG8_BAR; PG8_WAIT_L(0); PG8_MMA(0, 1, At, B1); PG8_BAR;
            PG8_LDA(At, 1, 1); PG8_STAGE(PG8_SA(1, 0), a3, voffA);
            PG8_BAR; PG8_WAIT_L(0); PG8_MMA(1, 0, At, B0); PG8_BAR; PG8_SCHED;
            PG8_STAGE(PG8_SB(1, 1), b3 + hstep, voffB);
            PG8_WAIT_V(6); PG8_BAR; PG8_MMA(1, 1, At, B1); PG8_BAR;
            }
        }
        if constexpr (ALIGN_EPI) { if (wr == 0) PG8_BAR; }
        if constexpr (!Epi::AFTER_DRAIN) { E(acc, cur, wr, wc, fr, fq); S.done(cur); }
        if (!has_next) break;
#pragma unroll
        for (int a = 0; a < 2; ++a)
#pragma unroll
            for (int b = 0; b < 2; ++b)
#pragma unroll
                for (int m = 0; m < 4; ++m)
#pragma unroll
                    for (int n = 0; n < 2; ++n) acc[a][b][m][n] = (f32x4){0.f, 0.f, 0.f, 0.f};
        cur = nxt; cA = nA; cB = nB; ++ui;
        if constexpr (GATHER) { _Pragma("unroll") for (int _h = 0; _h < 2; ++_h) _Pragma("unroll") for (int _i = 0; _i < 2; ++_i) goffA[_h][_i] = goffN[_h][_i]; }
        if constexpr (ALIGN_EPI) { if (wr == 1) PG8_BAR; }
    }
    PG8_WAIT_V(0);
    if constexpr (!ALIGN_EPI) { if (wr == 0) PG8_BAR; }
    PG8_BAR;
    if constexpr (Epi::AFTER_DRAIN) { E.fused(acc, cur, wr, wc, fr, fq, lds, wid, lane); S.done(cur); }
#undef PG8_SA
#undef PG8_SB
#undef PG8_STAGE
#undef PG8_STAGE_A
#undef PG8_GOFF
#undef PG8_LDA
#undef PG8_LDB
#undef PG8_MMA
#undef PG8_WAIT_V
#undef PG8_WAIT_L
#undef PG8_BAR
#undef PG8_SCHED
}
}
#define XB_TMO      128
#define XB_XCNT(j)  (256  + 64 * (j))
#define XB_XSUB(j)  (1280 + 64 * (j))
#define XB_XGEN(j)  (2304 + 64 * (j))
#define XB_TOP      3328
#define XB_TOPGEN   3392
#define XCD_BAR_WORDS 3456
#define XB_SPIN_CAP (1u << 22)
#define LAS __attribute__((address_space(3)))

__device__ __forceinline__ unsigned xb_ld(unsigned* p)              { return __hip_atomic_load(p, __ATOMIC_RELAXED, __HIP_MEMORY_SCOPE_AGENT); }
__device__ __forceinline__ unsigned xb_add(unsigned* p, unsigned v) { asm volatile("" : "+v"(p));
    return __hip_atomic_fetch_add(p, v, __ATOMIC_RELAXED, __HIP_MEMORY_SCOPE_AGENT); }
__device__ __forceinline__ unsigned xb_xcc_id() { return (unsigned)__builtin_amdgcn_s_getreg((3 << 11) | 20) & 0xFu; }
#define XB_SPIN(cond, bar) do { unsigned _sp = 0; while (cond) { __builtin_amdgcn_s_sleep(1); \
    if ((++_sp & 255u) == 0u) { if (xb_ld(&(bar)[XB_TMO])) break; if (_sp > XB_SPIN_CAP) { xb_add(&(bar)[XB_TMO], 1u); break; } } } } while (0)

struct XcdBarrier {
    unsigned* bar; unsigned x; unsigned wv;
    volatile LAS unsigned* st;
};

__device__ __forceinline__ XcdBarrier xcd_barrier_post(unsigned* bar, volatile LAS unsigned* st) {
    XcdBarrier b; b.bar = bar; b.x = xb_xcc_id(); b.st = st;
    if (threadIdx.x == 0) (void)xb_add(&bar[XB_XCNT(b.x)], 1u);
    return b;
}
__device__ __forceinline__ void xcd_barrier_complete(unsigned* bar, unsigned x, unsigned& nloc, unsigned& nx) {
    const unsigned G = gridDim.x * gridDim.y * gridDim.z;
    unsigned sum, cnt, mine, sp = 0u;
    for (;;) {
        sum = 0u; cnt = 0u; mine = 0u;
#pragma unroll
        for (unsigned j = 0; j < 16; ++j) { const unsigned c = xb_ld(&bar[XB_XCNT(j)]); sum += c; cnt += (c > 0u) ? 1u : 0u; mine = (j == x) ? c : mine; }
        if (sum == G) break;
        __builtin_amdgcn_s_sleep(1);
        if ((++sp & 255u) == 0u) { if (xb_ld(&bar[XB_TMO])) break; if (sp > XB_SPIN_CAP) { xb_add(&bar[XB_TMO], 1u); break; } }
    }
    nloc = mine > 0u ? mine : 1u; nx = cnt > 0u ? cnt : 1u;
}

__device__ __forceinline__ void xcd_barrier(const XcdBarrier& b) {
    asm volatile("s_waitcnt vmcnt(0)" ::: "memory");
    __syncthreads();
    if (b.wv == 0u && lane_id() == 0) {
        unsigned* bar = b.bar;
        __builtin_amdgcn_s_waitcnt(0);
        unsigned nloc = b.st[0], nx = b.st[1];
        if (nloc == 0u) { xcd_barrier_complete(bar, b.x, nloc, nx); b.st[0] = nloc; b.st[1] = nx; }
        const unsigned old = xb_add(&bar[XB_XSUB(b.x)], 1u);
        const unsigned gen = old / nloc;
        if (old + 1u == (gen + 1u) * nloc) {
            __builtin_amdgcn_fence(__ATOMIC_RELEASE, "agent");
            asm volatile("s_waitcnt vmcnt(0)" ::: "memory");
            const unsigned og = xb_add(&bar[XB_TOP], 1u);
            const unsigned tg = og / nx;
            if (og + 1u == (tg + 1u) * nx) xb_add(&bar[XB_TOPGEN], 1u);
            else XB_SPIN(xb_ld(&bar[XB_TOPGEN]) == tg, bar);
            __builtin_amdgcn_fence(__ATOMIC_ACQUIRE, "agent");
            xb_add(&bar[XB_XGEN(b.x)], 1u);
            asm volatile("s_waitcnt vmcnt(0)" ::: "memory");
        } else {
            XB_SPIN(xb_ld(&bar[XB_XGEN(b.x)]) == gen, bar);
            __builtin_amdgcn_fence(__ATOMIC_ACQUIRE, "agent");
            asm volatile("s_waitcnt vmcnt(0)" ::: "memory");
        }
    }
    __syncthreads();
}

typedef unsigned short bf16_t;
typedef short bf16x8 __attribute__((ext_vector_type(8)));
typedef float f32x4 __attribute__((ext_vector_type(4)));
typedef float f32x16 __attribute__((ext_vector_type(16)));
typedef unsigned u32x4 __attribute__((ext_vector_type(4)));
typedef unsigned u32x2 __attribute__((ext_vector_type(2)));

constexpr int D = 1024, NB = 16, SEQ = 2048, CTX = 256, NL = 4;
constexpr int TL = NB * SEQ, TC = NB * CTX, TT = TL + TC;
constexpr int DIN = 6144, HYW = 512, NE = 16, DE = 512, KEYS = CTX + SEQ;
constexpr int NMOD = 6, NBM = NB + 1;
constexpr int APROWS = 2 * TT + NE * 256;
constexpr float EPS = 1e-6f, LOG2E = 1.4426950408889634f;
constexpr float QSCALE = 0.125f * LOG2E;

constexpr size_t MiB = 1u << 20;
constexpr size_t WS_CTL = 0, CTL_ZERO_BYTES = 1 * MiB;
constexpr size_t WS_MOD = 1 * MiB;
constexpr size_t WS_ROPE = 3 * MiB;
constexpr size_t WS_FL = 4 * MiB, WS_FC = 20 * MiB;
constexpr size_t WS_MISC = 22 * MiB;
constexpr size_t WS_FNORM = WS_MISC;
constexpr size_t WS_TOKE = WS_MISC + 64 * 1024, WS_TOKP = WS_MISC + 352 * 1024, WS_TOKW = WS_MISC + 640 * 1024;
constexpr size_t WS_ROWMAP = WS_MISC + 960 * 1024, WS_ROWW = WS_MISC + 1280 * 1024;
constexpr size_t WS_WIN = 24 * MiB, WS_WBR = 36 * MiB, WS_WOUT = 39 * MiB;
constexpr size_t WS_XC = 41 * MiB;
constexpr size_t WS_NP = WS_XC;
constexpr size_t WS_H = 57 * MiB;
constexpr size_t WS_KA = 129 * MiB, WS_VTA = 138 * MiB, WS_KW = 147 * MiB, WS_VTW = 156 * MiB;
constexpr size_t WS_QA = 165 * MiB, WS_QW = 201 * MiB, WS_YH = 237 * MiB, WS_VT = 273 * MiB, WS_YT = 309 * MiB;
constexpr size_t WS_RAWA = 309 * MiB, WS_RAWW = 327 * MiB;
constexpr size_t WS_F = 165 * MiB;
constexpr size_t WS_U = 345 * MiB;
constexpr size_t WS_G = 453 * MiB;
constexpr size_t WS_W13 = 605 * MiB, WS_W2 = 637 * MiB;
constexpr size_t WS_EROW = 669 * MiB, WS_EROWW = 672 * MiB;
constexpr size_t WS_END = 675 * MiB;
static_assert(WS_G + (size_t)APROWS * 2048 <= WS_W13 && WS_W2 + (size_t)16 * 1024 * 512 * 2 <= WS_END && WS_G + (size_t)TT * 3072 * 2 <= WS_END, "ws map");
static_assert(WS_U + (size_t)APROWS * 1024 <= WS_G && WS_F + (size_t)2 * TT * 2048 <= WS_YT, "ws map 2");
constexpr size_t VT_CTX_OFF = (size_t)HYW * NB * SEQ;

constexpr int CW_BAR = 4096, CW_CNT = 8192, CW_PANEL = 16384, CW_HTMO = 12288;
constexpr int LDS_BYTES = 151552, MISC_OFF = 147456;
constexpr int NWAVES = 8, NTHR = 512;

struct Args { const float* in[29]; float* out; unsigned char* ws; int ph_lo, ph_hi; };
enum { I_X = 0, I_C, I_CTX, I_CCTX, I_ADAW, I_ADAB, I_N1G, I_N2G, I_WIN, I_QKG, I_HSW, I_HSB, I_HW1, I_HB1, I_HFR, I_HW2, I_HB2, I_HW3, I_HBIAS, I_SINK, I_WBR, I_WOUT,
       I_RGW, I_RGB, I_REW, I_REB, I_EW1, I_EW3, I_EW2 };

#define LDS_WAIT() asm volatile("s_waitcnt lgkmcnt(0)" ::: "memory")
#define VM_WAIT() asm volatile("s_waitcnt vmcnt(0)" ::: "memory")

typedef float f32x2_t __attribute__((ext_vector_type(2)));
typedef __bf16 bf16x2_t __attribute__((ext_vector_type(2)));
__device__ __forceinline__ unsigned cvtpk(float lo, float hi) { f32x2_t v = {lo, hi}; bf16x2_t b = __builtin_convertvector(v, bf16x2_t); return __builtin_bit_cast(unsigned, b); }
__device__ __forceinline__ unsigned zero_u32() { unsigned z; asm volatile("v_mov_b32 %0, 0" : "=v"(z)); return z; }
__device__ __forceinline__ float bflo(unsigned u) { return __builtin_bit_cast(float, u << 16); }
__device__ __forceinline__ float bfhi(unsigned u) { return __builtin_bit_cast(float, u & 0xffff0000u); }
__device__ __forceinline__ float bf1(bf16_t u) { return __builtin_bit_cast(float, (unsigned)u << 16); }
__device__ __forceinline__ bf16_t f2bf(float f) { return (bf16_t)(cvtpk(f, 0.f) & 0xffffu); }
#define DPP_F(v, ctrl) __builtin_bit_cast(float, __builtin_amdgcn_update_dpp(0, __builtin_bit_cast(int, (v)), (ctrl), 0xf, 0xf, false))
__device__ __forceinline__ float row16_sum(float v) {
    v += DPP_F(v, 0xB1);
    v += DPP_F(v, 0x4E);
    v += DPP_F(v, 0x141);
    v += DPP_F(v, 0x140);
    return v;
}
__device__ __forceinline__ float wave_sum(float v) {
    v = row16_sum(v);
    const int iv = __builtin_bit_cast(int, v);
    float r = (__builtin_bit_cast(float, __builtin_amdgcn_readlane(iv, 0)) + __builtin_bit_cast(float, __builtin_amdgcn_readlane(iv, 16)))
            + (__builtin_bit_cast(float, __builtin_amdgcn_readlane(iv, 32)) + __builtin_bit_cast(float, __builtin_amdgcn_readlane(iv, 48)));
    asm volatile("" : "+v"(r));
    return r;
}
__device__ __forceinline__ float fast_exp2(float x) { return __builtin_amdgcn_exp2f(x); }
__device__ __forceinline__ float fast_rcp(float x) { return __builtin_amdgcn_rcpf(x); }
__device__ __forceinline__ float sigmoid_f(float x) { return fast_rcp(1.f + fast_exp2(-x * LOG2E)); }

__device__ __forceinline__ void sincos_acc(float x, float& s, float& c) {
    const float q = rintf(x * 0.636619772367581f);
    float y = fmaf(-q, 1.57079625129699707031f, x);
    y = fmaf(-q, 7.54978941586159635335e-08f, y);
    const float y2 = y * y;
    float sp = fmaf(y2, 2.7557314297e-06f, -1.9841270114e-04f); sp = fmaf(sp, y2, 8.3333337680e-03f); sp = fmaf(sp, y2, -1.6666667163e-01f); sp = fmaf(sp * y2, y, y);
    float cp = fmaf(y2, -2.7557314297e-07f, 2.4801587642e-05f); cp = fmaf(cp, y2, -1.3888889225e-03f); cp = fmaf(cp, y2, 4.1666667908e-02f); cp = fmaf(cp, y2, -0.5f); cp = fmaf(cp, y2, 1.0f);
    const int n = (int)q & 3;
    const float s1 = (n & 1) ? cp : sp, c1 = (n & 1) ? sp : cp;
    s = (n & 2) ? -s1 : s1;
    c = ((n + 1) & 2) ? -c1 : c1;
}

struct Fr { LAS unsigned char* lds; int tid, lane, wave, G, bid; };

__device__ __forceinline__ void pro_mod(const Fr& F, const Args& a) {
    LAS float* s = (LAS float*)F.lds;
    LAS float* red = (LAS float*)(F.lds + 69632);
    const float* c = a.in[I_C]; const float* cc = a.in[I_CCTX]; const float* W = a.in[I_ADAW]; const float* Bv = a.in[I_ADAB];
    float* MOD = (float*)(a.ws + WS_MOD);
    for (int i = F.tid; i < NBM * 1024; i += NTHR) { const int bb = i >> 10, k = i & 1023; const float v = (bb < NB) ? c[bb * 1024 + k] : cc[k]; s[i] = v / (1.f + __expf(-v)); }
    __syncthreads();
    const int col = F.tid & 63, ks = F.wave;
    for (int unit = F.G - 1 - F.bid; unit < NL * 96; unit += F.G) {
        const int l = unit / 96, j0 = (unit % 96) * 64;
        float acc[NBM];
#pragma unroll
        for (int bb = 0; bb < NBM; ++bb) acc[bb] = 0.f;
        const float* Wp = W + ((size_t)l * 1024 + ks * 128) * DIN + j0 + col;
#pragma unroll 2
        for (int k = 0; k < 128; k += 4) {
            const float w0 = Wp[(size_t)k * DIN], w1 = Wp[(size_t)(k + 1) * DIN], w2 = Wp[(size_t)(k + 2) * DIN], w3 = Wp[(size_t)(k + 3) * DIN];
#pragma unroll
            for (int bb = 0; bb < NBM; ++bb) { const f32x4 sv = *(const LAS f32x4*)(s + bb * 1024 + ks * 128 + k);
                acc[bb] = fmaf(sv.x, w0, acc[bb]); acc[bb] = fmaf(sv.y, w1, acc[bb]); acc[bb] = fmaf(sv.z, w2, acc[bb]); acc[bb] = fmaf(sv.w, w3, acc[bb]); } }
#pragma unroll
        for (int bb = 0; bb < NBM; ++bb) red[(ks * NBM + bb) * 64 + col] = acc[bb];
        __syncthreads();
        for (int o = F.tid; o < NBM * 64; o += NTHR) { const int bb = o >> 6, cx = o & 63; float sum = 0.f;
#pragma unroll
            for (int k2 = 0; k2 < 8; ++k2) sum += red[(k2 * NBM + bb) * 64 + cx];
            MOD[((size_t)l * NBM + bb) * DIN + j0 + cx] = sum + Bv[l * DIN + j0 + cx]; }
        __syncthreads();
    }
}

__device__ __forceinline__ void pro_rope(const Fr& F, const Args& a) {
    float* ct = (float*)(a.ws + WS_ROPE); float* st = ct + SEQ * 32;
    for (int i = F.bid * NTHR + F.tid; i < SEQ * 32; i += F.G * NTHR) {
        const int pos = i >> 5, ax = (i >> 4) & 1, f = i & 15;
        const float inv = exp2f(-(float)f * (13.287712379549449f / 16.f));
        const float ang = (float)(ax == 0 ? (pos >> 6) : (pos & 63)) * inv;
        float sv, cv; sincos_acc(ang, sv, cv); ct[i] = cv; st[i] = sv;
    }
}

__device__ __forceinline__ void pro_filter(const Fr& F, const Args& a) {
    LAS float* L = (LAS float*)F.lds;
    constexpr int oW1 = 0, oB1 = 2112, oFR = 2176, oB2 = 2240, oW2 = 2304, oZ = 6400, oH1 = 7552, oH2 = 9600, oW3 = 11648, oT = 19840;
    bf16_t* FL = (bf16_t*)(a.ws + WS_FL); bf16_t* FC = (bf16_t*)(a.ws + WS_FC); float* NP = (float*)(a.ws + WS_NP);
    const int p = F.tid >> 4, jj = F.tid & 15;
    for (int unit = F.bid; unit < NL * 72; unit += F.G) {
        const int l = unit / 72, ch = unit % 72; const bool lat = ch < 64; const int n = lat ? SEQ : CTX, pos0 = lat ? ch * 32 : (ch - 64) * 32;
        __syncthreads();
        for (int i = F.tid; i < 2112; i += NTHR) L[oW1 + i] = a.in[I_HW1][l * 2112 + i];
        for (int i = F.tid; i < 64; i += NTHR) { L[oB1 + i] = a.in[I_HB1][l * 64 + i]; L[oFR + i] = a.in[I_HFR][l * 64 + i]; L[oB2 + i] = a.in[I_HB2][l * 64 + i]; }
        for (int i = F.tid; i < 4096; i += NTHR) L[oW2 + i] = a.in[I_HW2][l * 4096 + i];
        const int pos = pos0 + p; const float t = (float)pos / (float)(n - 1);
        { const float band = 1e-4f + (float)jj * ((15.f - 1e-4f) / 15.f); const float ang = ((6.2831855f * band) * (float)pos) / (float)n;
          float sv, cv; sincos_acc(ang, sv, cv); L[oZ + p * 36 + 1 + jj] = cv; L[oZ + p * 36 + 17 + jj] = -sv; if (jj == 0) L[oZ + p * 36] = t; }
        __syncthreads();
        { f32x4 acc = *(const LAS f32x4*)(L + oB1 + 4 * jj);
#pragma unroll 3
          for (int i = 0; i < 33; ++i) { const float z = L[oZ + p * 36 + i]; const f32x4 w = *(const LAS f32x4*)(L + oW1 + i * 64 + 4 * jj); acc.x = fmaf(z, w.x, acc.x); acc.y = fmaf(z, w.y, acc.y); acc.z = fmaf(z, w.z, acc.z); acc.w = fmaf(z, w.w, acc.w); }
          const f32x4 fr = *(const LAS f32x4*)(L + oFR + 4 * jj); float sv, cv; f32x4 o;
          sincos_acc(fr.x * acc.x, sv, cv); o.x = sv; sincos_acc(fr.y * acc.y, sv, cv); o.y = sv; sincos_acc(fr.z * acc.z, sv, cv); o.z = sv; sincos_acc(fr.w * acc.w, sv, cv); o.w = sv;
          *(LAS f32x4*)(L + oH1 + p * 64 + 4 * jj) = o; }
        __syncthreads();
        { f32x4 acc = *(const LAS f32x4*)(L + oB2 + 4 * jj);
#pragma unroll 4
          for (int i = 0; i < 64; ++i) { const float z = L[oH1 + p * 64 + i]; const f32x4 w = *(const LAS f32x4*)(L + oW2 + i * 64 + 4 * jj); acc.x = fmaf(z, w.x, acc.x); acc.y = fmaf(z, w.y, acc.y); acc.z = fmaf(z, w.z, acc.z); acc.w = fmaf(z, w.w, acc.w); }
          const f32x4 fr = *(const LAS f32x4*)(L + oFR + 4 * jj); float sv, cv; f32x4 o;
          sincos_acc(fr.x * acc.x, sv, cv); o.x = sv; sincos_acc(fr.y * acc.y, sv, cv); o.y = sv; sincos_acc(fr.z * acc.z, sv, cv); o.z = sv; sincos_acc(fr.w * acc.w, sv, cv); o.w = sv;
          *(LAS f32x4*)(L + oH2 + p * 64 + 4 * jj) = o; }
        LAS bf16_t* T = (LAS bf16_t*)(L + oT);
#pragma unroll 1
        for (int mh = 0; mh < 1; ++mh) {
            f32x4 acc[16];
#pragma unroll
            for (int m = 0; m < 16; ++m) acc[m] = (f32x4){0.f, 0.f, 0.f, 0.f};
#pragma unroll 1
            for (int kc = 0; kc < 8; ++kc) {
                __syncthreads();
                for (int i = F.tid; i < 2048; i += NTHR) *(LAS f32x4*)(L + oW3 + i * 4) = *(const f32x4*)(a.in[I_HW3] + ((size_t)l * 64 + kc * 8) * 1024 + i * 4);
                __syncthreads();
#pragma unroll 1
                for (int k = 0; k < 8; ++k) { const float h = L[oH2 + p * 64 + kc * 8 + k];
#pragma unroll
                    for (int m = 0; m < 16; ++m) { const f32x4 w = *(const LAS f32x4*)(L + oW3 + k * 1024 + 64 * m + 4 * jj);
                        acc[m].x = fmaf(h, w.x, acc[m].x); acc[m].y = fmaf(h, w.y, acc[m].y); acc[m].z = fmaf(h, w.z, acc[m].z); acc[m].w = fmaf(h, w.w, acc[m].w); } }
            }
#pragma unroll
            for (int m = 0; m < 16; ++m) {
                const int colb = 64 * m + 4 * jj; const int dirb = m >> 3;
                const float v4[4] = {acc[m].x, acc[m].y, acc[m].z, acc[m].w};
#pragma unroll
                for (int e = 0; e < 4; ++e) { const int col = colb + e, c = col & 511;
                    const float dl = fabsf(-3.0701134573253943f + (-15.350567286626972f + 3.0701134573253943f) * ((float)c / 511.f));
                    float v = v4[e] * __expf(-t * dl); if (dirb == 1 && pos == 0) v = 0.f;
                    T[col * 32 + (dirb == 0 ? 31 - p : p)] = f2bf(v); }
            }
        }
        __syncthreads();
        for (int idx = F.tid; idx < 1024 * 32; idx += NTHR) { const int col = idx >> 5, i = idx & 31, dir = col >> 9, c = col & 511;
            const int u = (dir == 0) ? (n - 32 - pos0 + i) : ((pos0 + i == 0) ? 2 * n - 1 : n - 1 + pos0 + i);
            bf16_t* Fb = lat ? FL + ((size_t)l * 512 + c) * 4096 : FC + ((size_t)l * 512 + c) * 512;
            Fb[u] = T[col * 32 + i]; }
        for (int col = F.tid; col < 1024; col += NTHR) { float sum = 0.f;
#pragma unroll 8
            for (int i = 0; i < 32; ++i) sum += fabsf(bf1(T[col * 32 + i]));
            NP[((size_t)l * 72 + ch) * 1024 + col] = sum; }
    }
    __syncthreads();
}
__device__ __forceinline__ void filter_norm_reduce(const Fr& F, const Args& a) {
    const float* NP = (const float*)(a.ws + WS_NP); float* FN = (float*)(a.ws + WS_FNORM);
    for (int o = F.bid * NTHR + F.tid; o < NL * 2 * 512; o += F.G * NTHR) { const int l = o >> 10, isc = (o >> 9) & 1, c = o & 511;
        const int ch0 = isc ? 64 : 0, ch1 = isc ? 72 : 64; float sum = 0.f;
        for (int ch = ch0; ch < ch1; ++ch) sum += NP[((size_t)l * 72 + ch) * 1024 + c] + NP[((size_t)l * 72 + ch) * 1024 + 512 + c];
        FN[o] = 1.f / sum; }
}

template <int MODE>
__device__ __forceinline__ void transpose_item(const float* W, int K, int N, bf16_t* WT, int row_off, LAS float* scr, int item, int lane, int ldk = 0) {
    if (ldk == 0) ldk = K;
    const int nblk = N / 64, kb = item / nblk, nb = item % nblk, k0 = 64 * kb, n0 = 64 * nb;
    f32x4 v[16];
#pragma unroll
    for (int i = 0; i < 16; ++i) v[i] = *(const f32x4*)(W + (size_t)(k0 + 4 * i + (lane >> 4)) * N + n0 + (lane & 15) * 4);
#pragma unroll
    for (int i = 0; i < 16; ++i) *(LAS f32x4*)(scr + (4 * i + (lane >> 4)) * 68 + (lane & 15) * 4) = v[i];
    LDS_WAIT();
    const int c = lane & 7;
#pragma unroll
    for (int j = 0; j < 8; ++j) { const int n = (lane >> 3) + 8 * j; const LAS float* s = scr + (8 * c) * 68 + n;
        u32x4 o; o.x = cvtpk(s[0 * 68], s[1 * 68]); o.y = cvtpk(s[2 * 68], s[3 * 68]); o.z = cvtpk(s[4 * 68], s[5 * 68]); o.w = cvtpk(s[6 * 68], s[7 * 68]);
        const int nn = n0 + n; const int row = (MODE == 0) ? nn : ((nn >> 2) * 8 + (nn & 3) + (MODE == 2 ? 4 : 0));
        *(u32x4*)(WT + (size_t)(row_off + row) * ldk + k0 + 8 * c) = o; }
    LDS_WAIT();
}

__device__ __forceinline__ void conv_small_weights(const Fr& F, const Args& a, int l, int mask, int b0) {
    if (F.bid < b0) return;
    LAS float* scr = (LAS float*)(F.lds + F.wave * 17408);
    const int gw = (F.bid - b0) * NWAVES + F.wave, NGW = (F.G - b0) * NWAVES;
    constexpr int I_IN = (1024 / 64) * (DIN / 64), I_BR = (512 / 64) * (1024 / 64), I_OUT = (1024 / 64) * (1024 / 64);
    if (mask & 1) for (int it = gw; it < I_IN; it += NGW) transpose_item<0>(a.in[I_WIN] + (size_t)l * 1024 * DIN, 1024, DIN, (bf16_t*)(a.ws + WS_WIN), 0, scr, it, F.lane);
    if (mask & 2) for (int it = gw; it < 3 * I_BR; it += NGW) { const int b = it / I_BR; transpose_item<0>(a.in[I_WBR] + ((size_t)l * 3 + b) * 512 * 1024, 512, 1024, (bf16_t*)(a.ws + WS_WBR) + b * 512, 0, scr, it % I_BR, F.lane, 1536); }
    if (mask & 4) for (int it = gw; it < I_OUT; it += NGW) transpose_item<0>(a.in[I_WOUT] + (size_t)l * 1024 * 1024, 1024, 1024, (bf16_t*)(a.ws + WS_WOUT), 0, scr, it, F.lane);
}
__device__ __forceinline__ void conv_expert_weights(const Fr& F, const Args& a, int l, int b0, int it0, int it1) {
    if (F.bid < b0) return;
    LAS float* scr = (LAS float*)(F.lds + F.wave * 17408);
    const int gw = (F.bid - b0) * NWAVES + F.wave, NGW = (F.G - b0) * NWAVES;
    constexpr int I_1 = (1024 / 64) * (512 / 64), I_2 = (512 / 64) * (1024 / 64);
    for (int it = it0 + gw; it < it1; it += NGW) {
        const int e = it / (2 * I_1 + I_2); int r = it % (2 * I_1 + I_2);
        bf16_t* W13 = (bf16_t*)(a.ws + WS_W13); bf16_t* W2 = (bf16_t*)(a.ws + WS_W2);
        if (r < I_1) { transpose_item<1>(a.in[I_EW1] + ((size_t)l * NE + e) * 1024 * 512, 1024, 512, W13, e * 1024, scr, r, F.lane); continue; } r -= I_1;
        if (r < I_1) { transpose_item<2>(a.in[I_EW3] + ((size_t)l * NE + e) * 1024 * 512, 1024, 512, W13, e * 1024, scr, r, F.lane); continue; } r -= I_1;
        transpose_item<0>(a.in[I_EW2] + ((size_t)l * NE + e) * 512 * 1024, 512, 1024, W2, e * 1024, scr, r, F.lane);
    }
}
constexpr int CONV_E_ITEMS = NE * 384, CONV_E_SPLIT = CONV_E_ITEMS / 2;

__device__ __forceinline__ int mod_row(int row) { return row < TL ? (row >> 11) : NB; }

__device__ __forceinline__ void rows_p0(const Fr& F, const Args& a, int l, int nrows) {
    const int gw = F.bid * NWAVES + F.wave, NGW = F.G * NWAVES;
    const float* g1 = a.in[I_N1G] + l * 1024;
    const float* MODl = (const float*)(a.ws + WS_MOD) + (size_t)l * NBM * DIN;
    const float* MODp = (const float*)(a.ws + WS_MOD) + (size_t)(l > 0 ? l - 1 : 0) * NBM * DIN;
    const bf16_t* Fs = (const bf16_t*)(a.ws + WS_F);
    bf16_t* H = (bf16_t*)(a.ws + WS_H);
    const int per = 2 * ((nrows + 2 * NGW - 1) / (2 * NGW)), w0 = gw * per, w1 = (w0 + per < nrows) ? w0 + per : nrows;
    f32x4 gv[4], shv[4], scv[4], m5v[4]; int cur = -1;
#pragma unroll
    for (int j = 0; j < 4; ++j) { gv[j] = *(const f32x4*)(g1 + F.lane * 4 + 256 * j); shv[j] = gv[j]; scv[j] = gv[j]; m5v[j] = gv[j]; }
#define P0_LOAD(rb, V, F0, F1) do { _Pragma("unroll") for (int q = 0; q < 2; ++q) { const int row = (rb) + q; const bool lat = row < TL; \
            const float* xs = lat ? ((l == 0) ? a.in[I_X] + (size_t)row * D : a.out + (size_t)row * D) : ((l == 0) ? a.in[I_CTX] + (size_t)(row - TL) * D : (const float*)(a.ws + WS_XC) + (size_t)(row - TL) * D); \
            _Pragma("unroll") for (int j = 0; j < 4; ++j) { const int col = F.lane * 4 + 256 * j; V[q][j] = *(const f32x4*)(xs + col); \
                if (l > 0) { F0[q][j] = *(const u32x2*)(Fs + (size_t)row * D + col); F1[q][j] = *(const u32x2*)(Fs + ((size_t)TT + row) * D + col); } } } } while (0)
#define P0_PROC(rb, V, F0, F1) do { _Pragma("unroll") for (int q = 0; q < 2; ++q) { const int row = (rb) + q; const bool lat = row < TL; const int mr = mod_row(row); \
            if (mr != cur) { cur = mr; _Pragma("unroll") for (int j = 0; j < 4; ++j) { const int col = F.lane * 4 + 256 * j; \
                shv[j] = *(const f32x4*)(MODl + (size_t)mr * DIN + col); scv[j] = *(const f32x4*)(MODl + (size_t)mr * DIN + 1024 + col); m5v[j] = *(const f32x4*)(MODp + (size_t)mr * DIN + 5 * 1024 + col); } } \
            float* xd = lat ? a.out + (size_t)row * D : (float*)(a.ws + WS_XC) + (size_t)(row - TL) * D; float ss = 0.f; \
            if (l > 0) { _Pragma("unroll") for (int j = 0; j < 4; ++j) { const int col = F.lane * 4 + 256 * j; \
                    V[q][j].x += m5v[j].x * (bflo(F0[q][j].x) + bflo(F1[q][j].x)); V[q][j].y += m5v[j].y * (bfhi(F0[q][j].x) + bfhi(F1[q][j].x)); \
                    V[q][j].z += m5v[j].z * (bflo(F0[q][j].y) + bflo(F1[q][j].y)); V[q][j].w += m5v[j].w * (bfhi(F0[q][j].y) + bfhi(F1[q][j].y)); \
                    *(f32x4*)(xd + col) = V[q][j]; } } \
            _Pragma("unroll") for (int j = 0; j < 4; ++j) ss += (V[q][j].x * V[q][j].x + V[q][j].y * V[q][j].y) + (V[q][j].z * V[q][j].z + V[q][j].w * V[q][j].w); \
            const float r = 1.f / sqrtf(wave_sum(ss) * (1.f / D) + EPS); \
            _Pragma("unroll") for (int j = 0; j < 4; ++j) { const int col = F.lane * 4 + 256 * j; \
                const f32x4 o = (V[q][j] * r * gv[j]) * (scv[j] + 1.f) + shv[j]; \
                u32x2 w; w.x = cvtpk(o.x, o.y); w.y = cvtpk(o.z, o.w); \
                *(u32x2*)(H + (size_t)row * D + col) = w; } } } while (0)
    f32x4 vA[2][4], vB[2][4]; u32x2 fA0[2][4], fA1[2][4], fB0[2][4], fB1[2][4];
    if (w0 < w1) P0_LOAD(w0, vA, fA0, fA1);
    for (int rb = w0; rb < w1; rb += 4) {
        if (rb + 2 < w1) P0_LOAD(rb + 2, vB, fB0, fB1);
        P0_PROC(rb, vA, fA0, fA1);
        if (rb + 2 < w1) { if (rb + 4 < w1) P0_LOAD(rb + 4, vA, fA0, fA1); P0_PROC(rb + 2, vB, fB0, fB1); }
    }
#undef P0_LOAD
#undef P0_PROC
}
__device__ __forceinline__ void rows_final(const Fr& F, const Args& a) {
    const int gw = F.bid * NWAVES + F.wave, NGW = F.G * NWAVES;
    const float* MODp = (const float*)(a.ws + WS_MOD) + (size_t)(NL - 1) * NBM * DIN;
    const bf16_t* Fs = (const bf16_t*)(a.ws + WS_F);
    for (int row = gw; row < TL; row += NGW) {
        const int mr = row >> 11; float* xd = a.out + (size_t)row * D;
#pragma unroll
        for (int j = 0; j < 4; ++j) { const int col = F.lane * 4 + 256 * j;
            f32x4 v = *(const f32x4*)(xd + col);
            const u32x2 f0 = *(const u32x2*)(Fs + (size_t)row * D + col), f1 = *(const u32x2*)(Fs + ((size_t)TT + row) * D + col);
            const f32x4 m5 = *(const f32x4*)(MODp + (size_t)mr * DIN + 5 * 1024 + col);
            v.x += m5.x * (bflo(f0.x) + bflo(f1.x)); v.y += m5.y * (bfhi(f0.x) + bfhi(f1.x)); v.z += m5.z * (bflo(f0.y) + bflo(f1.y)); v.w += m5.w * (bfhi(f0.y) + bfhi(f1.y));
            *(f32x4*)(xd + col) = v; }
    }
}

__device__ __forceinline__ void rows_p5(const Fr& F, const Args& a, int l, int nrows, unsigned long long& sacc, const int swhich) {
#if defined(PROBE_P)
    unsigned long long st0 = __builtin_amdgcn_s_memrealtime();
#define SUBMARK5(w) do { const unsigned long long t_ = __builtin_amdgcn_s_memrealtime(); if (swhich == (w)) sacc += t_ - st0; st0 = t_; } while (0)
#else
#define SUBMARK5(w) do { } while (0)
#endif
    typedef float f32x4v __attribute__((ext_vector_type(4)));
    LAS float* RW = (LAS float*)F.lds;
    constexpr int RWS = 1028;
    LAS float* RB = (LAS float*)(F.lds + 82304);
    LAS int* LC = (LAS int*)(F.lds + 82432);
    LAS int* TE = (LAS int*)(F.lds + 82560);
    LAS int* TP = TE + 256;
    LAS float* TW = (LAS float*)(TP + 256);
    LAS float* RN = (LAS float*)(F.lds + 86784);
    LAS float* LG = (LAS float*)(F.lds + 87424);
    LAS float* GM = (LAS float*)(F.lds + 99072);
    LAS float* BI = (LAS float*)(F.lds + 107264);
    const float* g2 = a.in[I_N2G] + l * 1024;
    const float* MODl = (const float*)(a.ws + WS_MOD) + (size_t)l * NBM * DIN;
    bf16_t* H = (bf16_t*)(a.ws + WS_H);
    int* EROW = (int*)(a.ws + WS_EROW); float* EROWW = (float*)(a.ws + WS_EROWW);
    unsigned* CNT = (unsigned*)(a.ws + WS_CTL) + CW_CNT + l * 256;
    for (int f = F.tid; f < 1024; f += NTHR) { const f32x4 v = *(const f32x4*)(a.in[I_RGW] + ((size_t)l * 1024 + f) * 4);
        RW[0 * RWS + f] = v.x; RW[1 * RWS + f] = v.y; RW[2 * RWS + f] = v.z; RW[3 * RWS + f] = v.w; }
    for (int f = F.tid; f < 4096; f += NTHR) { const int k = f >> 2, c4 = (f & 3) * 4; const f32x4 v = *(const f32x4*)(a.in[I_REW] + ((size_t)l * 1024 + k) * 16 + c4);
        RW[(4 + c4) * RWS + k] = v.x; RW[(5 + c4) * RWS + k] = v.y; RW[(6 + c4) * RWS + k] = v.z; RW[(7 + c4) * RWS + k] = v.w; }
    if (F.tid < 20) RB[F.tid] = (F.tid < 4) ? a.in[I_RGB][l * 4 + F.tid] : a.in[I_REB][l * 16 + F.tid - 4];
    constexpr int P5_CH = 144;
    const int nch = (nrows + P5_CH - 1) / P5_CH;
    SUBMARK5(40);
    for (int ch = F.bid; ch < nch; ch += F.G) {
    const int r0 = ch * P5_CH, r1 = (r0 + P5_CH < nrows) ? r0 + P5_CH : nrows;
    const int mb0 = mod_row(r0), mb1 = mod_row(r1 - 1);
    if (F.tid < 32) LC[F.tid] = 0;
    for (int i = F.tid; i < 2048; i += NTHR) { const int s = i >> 10, k = i & 1023; GM[i] = g2[k] * (1.f + MODl[(size_t)(s ? mb1 : mb0) * DIN + 4 * 1024 + k]); }
    __syncthreads();
    if (F.wave < 4) {
    for (int rowb = r0 + 2 * F.wave; rowb < r1; rowb += 2 * 4) {
        f32x4 v[2][4]; bool val[2];
#pragma unroll
        for (int q = 0; q < 2; ++q) { const int row = rowb + q; val[q] = row < r1; const int rr = val[q] ? row : rowb;
            const bool lat = rr < TL; const float* xs = lat ? a.out + (size_t)rr * D : (const float*)(a.ws + WS_XC) + (size_t)(rr - TL) * D;
#pragma unroll
            for (int j = 0; j < 4; ++j) v[q][j] = *(const f32x4*)(xs + F.lane * 4 + 256 * j); }
#pragma unroll
        for (int q = 0; q < 2; ++q) { const int rr = val[q] ? rowb + q : rowb; const int mr = mod_row(rr); float ss = 0.f;
#pragma unroll
            for (int j = 0; j < 4; ++j) ss += (v[q][j].x * v[q][j].x + v[q][j].y * v[q][j].y) + (v[q][j].z * v[q][j].z + v[q][j].w * v[q][j].w);
            const float r = 1.f / sqrtf(wave_sum(ss) * (1.f / D) + EPS);
            if (F.lane == 0 && val[q]) RN[rr - r0] = r;
#pragma unroll
            for (int j = 0; j < 4; ++j) { const int col = F.lane * 4 + 256 * j;
                const f32x4 g = *(const f32x4*)(g2 + col), sh = *(const f32x4*)(MODl + (size_t)mr * DIN + 3 * 1024 + col), sc = *(const f32x4*)(MODl + (size_t)mr * DIN + 4 * 1024 + col);
                const f32x4 t = (v[q][j] * r * g) * (sc + 1.f) + sh;
                u32x2 w; w.x = cvtpk(t.x, t.y); w.y = cvtpk(t.z, t.w);
                if (val[q]) *(u32x2*)(H + (size_t)rr * D + col) = w; } }
    }
    } else {
    if (F.wave < 6) { const int sl = F.wave - 4; const int mb = sl ? mb1 : mb0; f32x4 sh[4];
#pragma unroll
        for (int j = 0; j < 4; ++j) sh[j] = *(const f32x4*)(MODl + (size_t)mb * DIN + 3 * 1024 + F.lane * 4 + 256 * j);
#pragma unroll 4
        for (int cidx = 0; cidx < 20; ++cidx) { float p = 0.f;
#pragma unroll
            for (int j = 0; j < 4; ++j) { const f32x4 w = *(const LAS f32x4*)(RW + cidx * RWS + F.lane * 4 + 256 * j);
                p = fmaf(sh[j].x, w.x, p); p = fmaf(sh[j].y, w.y, p); p = fmaf(sh[j].z, w.z, p); p = fmaf(sh[j].w, w.w, p); }
            const float tot = wave_sum(p) + RB[cidx]; if (F.lane == 0) BI[sl * 20 + cidx] = tot; } }
    { const int i16 = F.lane & 15, kq = F.lane >> 4; const int ngrp = (r1 - r0 + 15) >> 4;
      for (int gi = F.wave - 4; gi < ngrp; gi += 4) {
        const int grow = r0 + 16 * gi; const int rowi = (grow + i16 < r1) ? grow + i16 : r1 - 1;
        const bool lat = rowi < TL; const float* xs = (lat ? a.out + (size_t)rowi * D : (const float*)(a.ws + WS_XC) + (size_t)(rowi - TL) * D) + 4 * kq;
        const int slot = (mod_row(grow) == mb0) ? 0 : 1;
        const LAS float* gmp = GM + slot * 1024 + 4 * kq; const LAS float* w0p = RW + i16 * RWS + 4 * kq; const LAS float* w1p = RW + (16 + (i16 & 3)) * RWS + 4 * kq;
        const float m1 = (i16 < 4) ? 1.f : 0.f;
        f32x4v acc0 = {0.f, 0.f, 0.f, 0.f}, acc1 = {0.f, 0.f, 0.f, 0.f};
#pragma unroll 16
        for (int s = 0; s < 64; ++s) {
            const f32x4 xv = *(const f32x4*)(xs + 16 * s); const f32x4 gv = *(const LAS f32x4*)(gmp + 16 * s);
            const f32x4 wa = *(const LAS f32x4*)(w0p + 16 * s), wb = *(const LAS f32x4*)(w1p + 16 * s);
            const f32x4 ba = wa * gv, bb = wb * gv * m1;
            acc0 = __builtin_amdgcn_mfma_f32_16x16x4f32(xv.x, ba.x, acc0, 0, 0, 0); acc1 = __builtin_amdgcn_mfma_f32_16x16x4f32(xv.x, bb.x, acc1, 0, 0, 0);
            acc0 = __builtin_amdgcn_mfma_f32_16x16x4f32(xv.y, ba.y, acc0, 0, 0, 0); acc1 = __builtin_amdgcn_mfma_f32_16x16x4f32(xv.y, bb.y, acc1, 0, 0, 0);
            acc0 = __builtin_amdgcn_mfma_f32_16x16x4f32(xv.z, ba.z, acc0, 0, 0, 0); acc1 = __builtin_amdgcn_mfma_f32_16x16x4f32(xv.z, bb.z, acc1, 0, 0, 0);
            acc0 = __builtin_amdgcn_mfma_f32_16x16x4f32(xv.w, ba.w, acc0, 0, 0, 0); acc1 = __builtin_amdgcn_mfma_f32_16x16x4f32(xv.w, bb.w, acc1, 0, 0, 0);
        }
#pragma unroll
        for (int rg = 0; rg < 4; ++rg) { const int lr = 16 * gi + 4 * kq + rg;
            if (r0 + lr < r1) { LG[lr * 20 + i16] = acc0[rg]; if (i16 < 4) LG[lr * 20 + 16 + i16] = acc1[rg]; } }
      } }
    }
    __syncthreads();
    SUBMARK5(42);
    for (int lr = F.tid; lr < r1 - r0; lr += NTHR) {
        float lg[20]; { const float rn = RN[lr]; const int sl = (mod_row(r0 + lr) == mb0) ? 0 : 1;
#pragma unroll
          for (int i = 0; i < 20; ++i) lg[i] = rn * LG[lr * 20 + i] + BI[sl * 20 + i]; }
        int gs = 0; float gmx = lg[0];
#pragma unroll
        for (int i = 1; i < 4; ++i) if (lg[i] > gmx) { gmx = lg[i]; gs = i; }
        float gsum = 0.f;
#pragma unroll
        for (int i = 0; i < 4; ++i) gsum += __expf(lg[i] - gmx);
        const float pg = 1.f / gsum;
        float le[4];
#pragma unroll
        for (int i = 0; i < 4; ++i) le[i] = (gs == 0) ? lg[4 + i] : (gs == 1) ? lg[8 + i] : (gs == 2) ? lg[12 + i] : lg[16 + i];
        int i0 = 0; float v0 = le[0];
#pragma unroll
        for (int i = 1; i < 4; ++i) if (le[i] > v0) { v0 = le[i]; i0 = i; }
        int i1 = -1; float v1 = -3.4e38f;
#pragma unroll
        for (int i = 0; i < 4; ++i) if (i != i0 && le[i] > v1) { v1 = le[i]; i1 = i; }
        const float e1 = __expf(v1 - v0), den = 1.f / (1.f + e1);
        const int ex0 = gs * 4 + i0, ex1 = gs * 4 + i1;
        const int lp0 = __hip_atomic_fetch_add(&LC[ex0], 1, __ATOMIC_RELAXED, __HIP_MEMORY_SCOPE_WORKGROUP), lp1 = __hip_atomic_fetch_add(&LC[ex1], 1, __ATOMIC_RELAXED, __HIP_MEMORY_SCOPE_WORKGROUP);
        TE[lr] = ex0 | (ex1 << 8); TP[lr] = lp0 | (lp1 << 16); TW[2 * lr] = den * pg; TW[2 * lr + 1] = e1 * den * pg;
    }
    __syncthreads();
    if (F.tid < NE) LC[16 + F.tid] = (int)atomicAdd(&CNT[F.tid * 16], (unsigned)LC[F.tid]);
    __syncthreads();
    for (int lr = F.tid; lr < r1 - r0; lr += NTHR) {
        const int te = TE[lr], tp = TP[lr], ex0 = te & 255, ex1 = te >> 8, row = r0 + lr;
        const int gp0 = LC[16 + ex0] + (tp & 0xffff), gp1 = LC[16 + ex1] + (tp >> 16);
        EROW[(size_t)ex0 * TT + gp0] = row * 2; EROWW[(size_t)ex0 * TT + gp0] = TW[2 * lr];
        EROW[(size_t)ex1 * TT + gp1] = row * 2 + 1; EROWW[(size_t)ex1 * TT + gp1] = TW[2 * lr + 1];
    }
    __syncthreads();
    SUBMARK5(43);
    }
    __syncthreads();
#undef SUBMARK5
}

__device__ __forceinline__ void normrope8(float (&x)[8], const float* g64, bool rope, int pos, const float* ct, const float* st, float scale, int lane) {
    float ss = 0.f;
#pragma unroll
    for (int i = 0; i < 8; ++i) ss += x[i] * x[i];
    ss += DPP_F(ss, 0xB1); ss += DPP_F(ss, 0x4E); ss += DPP_F(ss, 0x141);
    const float r = 1.f / sqrtf(ss * (1.f / 64.f) + EPS);
    const int ch = lane & 7;
    const f32x4 g0 = *(const f32x4*)(g64 + 8 * ch), g1 = *(const f32x4*)(g64 + 8 * ch + 4);
    x[0] *= r * g0.x; x[1] *= r * g0.y; x[2] *= r * g0.z; x[3] *= r * g0.w; x[4] *= r * g1.x; x[5] *= r * g1.y; x[6] *= r * g1.z; x[7] *= r * g1.w;
    if (rope) {
        const int ax = ch >> 2, half = (ch >> 1) & 1, f0 = 8 * (ch & 1);
        const f32x4 c0 = *(const f32x4*)(ct + pos * 32 + ax * 16 + f0), c1 = *(const f32x4*)(ct + pos * 32 + ax * 16 + f0 + 4);
        const f32x4 s0 = *(const f32x4*)(st + pos * 32 + ax * 16 + f0), s1 = *(const f32x4*)(st + pos * 32 + ax * 16 + f0 + 4);
        const float cs[8] = {c0.x, c0.y, c0.z, c0.w, c1.x, c1.y, c1.z, c1.w}, sn[8] = {s0.x, s0.y, s0.z, s0.w, s1.x, s1.y, s1.z, s1.w};
#pragma unroll
        for (int i = 0; i < 8; ++i) { const float p = DPP_F(x[i], 0x4E);
            x[i] = half ? (x[i] * cs[i] + p * sn[i]) : (x[i] * cs[i] - p * sn[i]); }
    }
#pragma unroll
    for (int i = 0; i < 8; ++i) x[i] *= scale;
}
__device__ __forceinline__ void unpack8(const u32x4 w, float (&x)[8]) { x[0] = bflo(w.x); x[1] = bfhi(w.x); x[2] = bflo(w.y); x[3] = bfhi(w.y); x[4] = bflo(w.z); x[5] = bfhi(w.z); x[6] = bflo(w.w); x[7] = bfhi(w.w); }
__device__ __forceinline__ u32x4 pack8(const float (&x)[8]) { u32x4 w; w.x = cvtpk(x[0], x[1]); w.y = cvtpk(x[2], x[3]); w.z = cvtpk(x[4], x[5]); w.w = cvtpk(x[6], x[7]); return w; }

__device__ __forceinline__ void prep_phase(const Fr& F, const Args& a, int l, bool with_ctx) {
    constexpr int VROW = 272;
    LAS unsigned char* VA_l = F.lds;
    LAS unsigned char* VW_l = F.lds + 17408;
    LAS unsigned char* HT_l = F.lds + 34816;
    constexpr int HROW = 144;
    const float* ct = (const float*)(a.ws + WS_ROPE); const float* st = ct + SEQ * 32;
    const float* qkg = a.in[I_QKG] + l * 256;
    const bf16_t* RAWA = (const bf16_t*)(a.ws + WS_RAWA); const bf16_t* RAWW = (const bf16_t*)(a.ws + WS_RAWW);
    bf16_t* KA = (bf16_t*)(a.ws + WS_KA); bf16_t* KW = (bf16_t*)(a.ws + WS_KW); bf16_t* VTA = (bf16_t*)(a.ws + WS_VTA); bf16_t* VTW = (bf16_t*)(a.ws + WS_VTW);
    const bf16_t* U = (const bf16_t*)(a.ws + WS_U); bf16_t* X0 = (bf16_t*)(a.ws + WS_H); bf16_t* VT = (bf16_t*)(a.ws + WS_VT);
    const float* hsw = a.in[I_HSW] + l * 3 * 1536; const float* hsb = a.in[I_HSB] + l * 1536;
    for (int unit = F.bid; unit < NB * 36; unit += F.G) {
        const bool lat = unit < NB * 32;
        const int b = lat ? unit >> 5 : (unit - NB * 32) >> 2, p0 = lat ? (unit & 31) * 64 : ((unit - NB * 32) & 3) * 64;
        const int n = lat ? SEQ : CTX;
        const int row0 = lat ? b * SEQ + p0 : TL + b * CTX + p0;
        const int j0 = lat ? CTX + p0 : p0;
        __syncthreads();
        {
            const bool isw = (F.lane & 16) != 0; const int l16 = F.lane & 15, half = F.lane >> 5;
            u32x4 kw[4];
#pragma unroll
            for (int ps = 0; ps < 4; ++ps) { const int tk = 8 * F.wave + 2 * ps + half; kw[ps] = *(const u32x4*)((isw ? RAWW : RAWA) + (size_t)(row0 + tk) * 256 + l16 * 8); }
#pragma unroll
            for (int ps = 0; ps < 4; ++ps) { const int tk = 8 * F.wave + 2 * ps + half; float x[8]; unpack8(kw[ps], x);
                normrope8(x, qkg + (isw ? 192 : 64), lat, p0 + tk, ct, st, 1.f, F.lane);
                *(u32x4*)((isw ? KW : KA) + ((size_t)b * KEYS + j0 + tk) * 128 + l16 * 8) = pack8(x); }
        }
        for (int i = F.tid; i < 2 * 64 * 16; i += NTHR) { const int m = i >> 10, r = (i >> 4) & 63, cch = i & 15;
            const u32x4 w = *(const u32x4*)((m ? RAWW : RAWA) + (size_t)(row0 + r) * 256 + 128 + cch * 8);
            *(LAS u32x4*)((m ? VW_l : VA_l) + r * VROW + cch * 16) = w; }
        const bool do_hy = lat || with_ctx;
        if (do_hy) {
            const int cg = F.tid & 63, c = 8 * cg, t0 = 8 * F.wave;
            u32x4 x1p[8];
#pragma unroll
            for (int g = 0; g < 3; ++g) {
                const int ch = g * 512 + c;
                float w0[8], w1[8], w2[8], bb[8];
                { const f32x4 a0 = *(const f32x4*)(hsw + ch), a1 = *(const f32x4*)(hsw + ch + 4), b0 = *(const f32x4*)(hsw + 1536 + ch), b1 = *(const f32x4*)(hsw + 1536 + ch + 4),
                              c0 = *(const f32x4*)(hsw + 3072 + ch), c1 = *(const f32x4*)(hsw + 3072 + ch + 4), d0 = *(const f32x4*)(hsb + ch), d1 = *(const f32x4*)(hsb + ch + 4);
                  w0[0] = a0.x; w0[1] = a0.y; w0[2] = a0.z; w0[3] = a0.w; w0[4] = a1.x; w0[5] = a1.y; w0[6] = a1.z; w0[7] = a1.w;
                  w1[0] = b0.x; w1[1] = b0.y; w1[2] = b0.z; w1[3] = b0.w; w1[4] = b1.x; w1[5] = b1.y; w1[6] = b1.z; w1[7] = b1.w;
                  w2[0] = c0.x; w2[1] = c0.y; w2[2] = c0.z; w2[3] = c0.w; w2[4] = c1.x; w2[5] = c1.y; w2[6] = c1.z; w2[7] = c1.w;
                  bb[0] = d0.x; bb[1] = d0.y; bb[2] = d0.z; bb[3] = d0.w; bb[4] = d1.x; bb[5] = d1.y; bb[6] = d1.z; bb[7] = d1.w; }
                u32x4 raw[10];
#pragma unroll
                for (int i = 0; i < 10; ++i) { const int pos = p0 + t0 - 1 + i;
                    if (pos < 0 || pos >= n) { const unsigned z = zero_u32(); raw[i] = (u32x4){z, z, z, z}; } else raw[i] = *(const u32x4*)(U + (size_t)(row0 - p0 + pos) * 1536 + ch); }
#pragma unroll
                for (int t = 0; t < 8; ++t) { float up[8], uc[8], un[8], o[8]; unpack8(raw[t], up); unpack8(raw[t + 1], uc); unpack8(raw[t + 2], un);
#pragma unroll
                    for (int i = 0; i < 8; ++i) o[i] = fmaf(w0[i], up[i], fmaf(w1[i], uc[i], fmaf(w2[i], un[i], bb[i])));
                    if (g == 0) *(u32x4*)(X0 + (size_t)(row0 + t0 + t) * 512 + c) = pack8(o);
                    else if (g == 1) x1p[t] = pack8(o);
                    else { float x1[8]; unpack8(x1p[t], x1);
#pragma unroll
                        for (int i = 0; i < 8; ++i) o[i] *= x1[i];
                        x1p[t] = pack8(o); } }
            }
#pragma unroll
            for (int i = 0; i < 8; ++i) { unsigned short ev[8];
#pragma unroll
                for (int t = 0; t < 8; ++t) { const unsigned wsel = (i >> 1) == 0 ? x1p[t].x : (i >> 1) == 1 ? x1p[t].y : (i >> 1) == 2 ? x1p[t].z : x1p[t].w; ev[t] = (unsigned short)((i & 1) ? (wsel >> 16) : (wsel & 0xffffu)); }
                u32x4 w; w.x = ev[0] | ((unsigned)ev[1] << 16); w.y = ev[2] | ((unsigned)ev[3] << 16); w.z = ev[4] | ((unsigned)ev[5] << 16); w.w = ev[6] | ((unsigned)ev[7] << 16);
                *(LAS u32x4*)(HT_l + (c + i) * HROW + t0 * 2) = w; }
        }
        __syncthreads();
        for (int i = F.tid; i < 2 * 128 * 8; i += NTHR) { const int m = i >> 10, rr = (i >> 3) & 127, c8 = i & 7;
            LAS unsigned char* T = m ? VW_l : VA_l; unsigned short e[8];
#pragma unroll
            for (int jj = 0; jj < 8; ++jj) { const int key = 16 * (c8 >> 1) + 8 * (jj >> 2) + 4 * (c8 & 1) + (jj & 3); e[jj] = *(const LAS bf16_t*)(T + key * VROW + rr * 2); }
            u32x4 w; w.x = e[0] | ((unsigned)e[1] << 16); w.y = e[2] | ((unsigned)e[3] << 16); w.z = e[4] | ((unsigned)e[5] << 16); w.w = e[6] | ((unsigned)e[7] << 16);
            *(u32x4*)((m ? VTW : VTA) + ((size_t)(b * 2 + (rr >> 6)) * 64 + (rr & 63)) * KEYS + j0 + c8 * 8) = w; }
        if (do_hy) { bf16_t* VTb = lat ? VT : VT + VT_CTX_OFF;
          for (int i = F.tid; i < 512 * 8; i += NTHR) { const int cch = i >> 3, c8 = i & 7;
              const u32x4 w = *(const LAS u32x4*)(HT_l + cch * HROW + c8 * 16);
              *(u32x4*)(VTb + ((size_t)cch * NB + b) * n + p0 + c8 * 8) = w; } }
    }
    __syncthreads();
}

__device__ __forceinline__ void hyena_final_phase(const Fr& F, const Args& a, int l, bool with_ctx) {
    constexpr int HROW = 144;
    LAS unsigned char* T = F.lds;
    const bf16_t* X0 = (const bf16_t*)(a.ws + WS_H); const bf16_t* VT = (const bf16_t*)(a.ws + WS_VT); const bf16_t* YT = (const bf16_t*)(a.ws + WS_YT);
    bf16_t* YH = (bf16_t*)(a.ws + WS_QA) + 512;
    const float* FN = (const float*)(a.ws + WS_FNORM) + l * 1024; const float* skip = a.in[I_HBIAS] + l * 512;
    const int nunits = with_ctx ? NB * 36 : NB * 32;
    for (int unit = F.bid; unit < nunits; unit += F.G) {
        const bool lat = unit < NB * 32;
        const int b = lat ? unit >> 5 : (unit - NB * 32) >> 2, p0 = lat ? (unit & 31) * 64 : ((unit - NB * 32) & 3) * 64;
        const int n = lat ? SEQ : CTX; const int row0 = lat ? b * SEQ + p0 : TL + b * CTX + p0;
        const bf16_t* Yb = lat ? YT : YT + VT_CTX_OFF; const bf16_t* Vb = lat ? VT : VT + VT_CTX_OFF; const float* inv = FN + (lat ? 0 : 512);
        __syncthreads();
        for (int i = F.tid; i < 512 * 8; i += NTHR) { const int cch = i >> 3, c8 = i & 7; const size_t off = ((size_t)cch * NB + b) * n + p0 + c8 * 8;
            const u32x4 y = *(const u32x4*)(Yb + off), v = *(const u32x4*)(Vb + off); const float s = inv[cch], k = skip[cch];
            u32x4 o;
            o.x = cvtpk(bflo(y.x) * s + k * bflo(v.x), bfhi(y.x) * s + k * bfhi(v.x)); o.y = cvtpk(bflo(y.y) * s + k * bflo(v.y), bfhi(y.y) * s + k * bfhi(v.y));
            o.z = cvtpk(bflo(y.z) * s + k * bflo(v.z), bfhi(y.z) * s + k * bfhi(v.z)); o.w = cvtpk(bflo(y.w) * s + k * bflo(v.w), bfhi(y.w) * s + k * bfhi(v.w));
            *(LAS u32x4*)(T + cch * HROW + c8 * 16) = o; }
        __syncthreads();
        { const int th = F.tid & 255, half = F.tid >> 8, c = 2 * th;
          for (int t = 32 * half; t < 32 * half + 32; ++t) {
              const unsigned x0 = *(const unsigned*)(X0 + (size_t)(row0 + t) * 512 + c);
              const float y0 = bf1(*(const LAS bf16_t*)(T + c * HROW + t * 2)), y1 = bf1(*(const LAS bf16_t*)(T + (c + 1) * HROW + t * 2));
              *(unsigned*)(YH + (size_t)(row0 + t) * 1536 + c) = cvtpk(bflo(x0) * y0, bfhi(x0) * y1); } }
    }
    __syncthreads();
}

#define MFMA32(a, b, c) __builtin_amdgcn_mfma_f32_32x32x16_bf16((a), (b), (c), 0, 0, 0)
#define MFMA16(a, b, c) __builtin_amdgcn_mfma_f32_16x16x32_bf16((a), (b), (c), 0, 0, 0)

__device__ __forceinline__ int tile_off(int row, int chunk) { return row * 128 + ((chunk ^ ((row >> 1) & 7)) << 4); }

template <bool WIN>
__device__ __forceinline__ void attn_unit(const Fr& F, bf16_t* Qw, const bf16_t* Kb, const bf16_t* VTb, int a0, int na, int b0, int nb, int qpos0, bool has_sink, float sink2, const float* g64, bool rope, const float* ct, const float* st) {
    LAS unsigned char* L = F.lds;
    const int r = F.lane & 31, h = F.lane >> 5;
    const int xaddr = (lane_id() ^ 32) << 2;
#define SWAP32(v) __builtin_bit_cast(float, __builtin_amdgcn_ds_bpermute(xaddr, __builtin_bit_cast(int, (v))))
    bf16x8 q[4];
    {
        float x[4][8]; float ss = 0.f;
#pragma unroll
        for (int kk = 0; kk < 4; ++kk) { const u32x4 w = *(const u32x4*)(Qw + (size_t)r * 1536 + 16 * kk + 8 * h); unpack8(w, x[kk]);
#pragma unroll
            for (int j = 0; j < 8; ++j) ss += x[kk][j] * x[kk][j]; }
        ss += SWAP32(ss);
        const float rn = (1.f / sqrtf(ss * (1.f / 64.f) + EPS)) * QSCALE;
#pragma unroll
        for (int kk = 0; kk < 4; ++kk) { const f32x4 g0 = *(const f32x4*)(g64 + 16 * kk + 8 * h), g1 = *(const f32x4*)(g64 + 16 * kk + 8 * h + 4);
            x[kk][0] *= rn * g0.x; x[kk][1] *= rn * g0.y; x[kk][2] *= rn * g0.z; x[kk][3] *= rn * g0.w; x[kk][4] *= rn * g1.x; x[kk][5] *= rn * g1.y; x[kk][6] *= rn * g1.z; x[kk][7] *= rn * g1.w; }
        if (rope) { const int pos = qpos0 + r;
#pragma unroll
            for (int ax = 0; ax < 2; ++ax) {
                const f32x4 c0 = *(const f32x4*)(ct + pos * 32 + ax * 16 + 8 * h), c1 = *(const f32x4*)(ct + pos * 32 + ax * 16 + 8 * h + 4);
                const f32x4 s0 = *(const f32x4*)(st + pos * 32 + ax * 16 + 8 * h), s1 = *(const f32x4*)(st + pos * 32 + ax * 16 + 8 * h + 4);
                const float cs[8] = {c0.x, c0.y, c0.z, c0.w, c1.x, c1.y, c1.z, c1.w}, sn[8] = {s0.x, s0.y, s0.z, s0.w, s1.x, s1.y, s1.z, s1.w};
#pragma unroll
                for (int j = 0; j < 8; ++j) { const float av = x[2 * ax][j], bv = x[2 * ax + 1][j]; x[2 * ax][j] = av * cs[j] - bv * sn[j]; x[2 * ax + 1][j] = bv * cs[j] + av * sn[j]; } } }
#pragma unroll
        for (int kk = 0; kk < 4; ++kk) q[kk] = __builtin_bit_cast(bf16x8, pack8(x[kk]));
    }
    f32x16 o0, o1;
#pragma unroll
    for (int i = 0; i < 16; ++i) { o0[i] = 0.f; o1[i] = 0.f; }
    f32x16 lacc;
#pragma unroll
    for (int i = 0; i < 16; ++i) lacc[i] = 0.f;
    const bf16x8 ones8 = {0x3F80, 0x3F80, 0x3F80, 0x3F80, 0x3F80, 0x3F80, 0x3F80, 0x3F80};
    const int ntile = na + nb;
    const int srow = F.tid >> 3, sch = F.tid & 7;
    const int soff = tile_off(srow, sch);
    int t4[4];
#pragma unroll
    for (int j = 0; j < 4; ++j) t4[j] = tile_off(r, 2 * j + h);
#define AT_KT(i) ((i) < na ? a0 + (i) : b0 + ((i) - na))
#define AT_LD(i, K0, K1, V0, V1) do { const int kt_ = AT_KT(i); \
        K0 = *(const u32x4*)(Kb + (size_t)(kt_ * 128 + srow) * 128 + sch * 8); K1 = *(const u32x4*)(Kb + (size_t)(kt_ * 128 + 64 + srow) * 128 + sch * 8); \
        V0 = *(const u32x4*)(VTb + (size_t)srow * KEYS + kt_ * 128 + sch * 8); V1 = *(const u32x4*)(VTb + (size_t)srow * KEYS + kt_ * 128 + 64 + sch * 8); } while (0)
#define AT_ST(buf, K0, K1, V0, V1) do { LAS unsigned char* B_ = L + (buf) * 32768 + soff; \
        *(LAS u32x4*)(B_) = K0; *(LAS u32x4*)(B_ + 8192) = K1; *(LAS u32x4*)(B_ + 16384) = V0; *(LAS u32x4*)(B_ + 24576) = V1; } while (0)
#define AT_QK(S0, S1, Kt) do { bf16x8 kf_[8]; \
        _Pragma("unroll") for (int kk = 0; kk < 4; ++kk) { kf_[2 * kk] = *(const LAS bf16x8*)(L + (Kt) + t4[kk]); kf_[2 * kk + 1] = *(const LAS bf16x8*)(L + (Kt) + t4[kk] + 4096); } \
        _Pragma("unroll") for (int i_ = 0; i_ < 16; ++i_) { S0[i_] = 0.f; S1[i_] = 0.f; } \
        _Pragma("unroll") for (int kk = 0; kk < 4; ++kk) { S0 = MFMA32(kf_[2 * kk], q[kk], S0); S1 = MFMA32(kf_[2 * kk + 1], q[kk], S1); } } while (0)
#define AT_EXP(S0, S1, P, kpos0) do { \
        if (WIN && (kpos0) >= 0) { const int kbase = (kpos0) + 4 * h, qp = qpos0 + r; \
            _Pragma("unroll") for (int i = 0; i < 16; ++i) { const int kr = (i & 3) + 8 * (i >> 2); const int d0 = kbase + kr - qp, d1 = d0 + 32; \
                if (d0 > 128 || d0 < -128) S0[i] = -1e30f; if (d1 > 128 || d1 < -128) S1[i] = -1e30f; } } \
        _Pragma("unroll") for (int i = 0; i < 16; ++i) { S0[i] = fast_exp2(S0[i]); S1[i] = fast_exp2(S1[i]); } \
        { u32x4 w; \
          w.x = cvtpk(S0[0], S0[1]); w.y = cvtpk(S0[2], S0[3]); w.z = cvtpk(S0[4], S0[5]); w.w = cvtpk(S0[6], S0[7]); P[0] = __builtin_bit_cast(bf16x8, w); \
          w.x = cvtpk(S0[8], S0[9]); w.y = cvtpk(S0[10], S0[11]); w.z = cvtpk(S0[12], S0[13]); w.w = cvtpk(S0[14], S0[15]); P[1] = __builtin_bit_cast(bf16x8, w); \
          w.x = cvtpk(S1[0], S1[1]); w.y = cvtpk(S1[2], S1[3]); w.z = cvtpk(S1[4], S1[5]); w.w = cvtpk(S1[6], S1[7]); P[2] = __builtin_bit_cast(bf16x8, w); \
          w.x = cvtpk(S1[8], S1[9]); w.y = cvtpk(S1[10], S1[11]); w.z = cvtpk(S1[12], S1[13]); w.w = cvtpk(S1[14], S1[15]); P[3] = __builtin_bit_cast(bf16x8, w); } } while (0)
#define AT_PV(P, Vt) do { bf16x8 vf_[8]; \
        _Pragma("unroll") for (int c = 0; c < 4; ++c) { vf_[2 * c] = *(const LAS bf16x8*)(L + (Vt) + t4[c]); vf_[2 * c + 1] = *(const LAS bf16x8*)(L + (Vt) + t4[c] + 4096); } \
        _Pragma("unroll") for (int c = 0; c < 4; ++c) { o0 = MFMA32(vf_[2 * c], P[c], o0); o1 = MFMA32(vf_[2 * c + 1], P[c], o1); lacc = MFMA32(ones8, P[c], lacc); } } while (0)
#define AT_BODY(it) do { \
        const int kt = AT_KT(it); \
        if ((it) + 1 < ntile) AT_LD((it) + 1, kA0, kA1, vA0, vA1); \
        const int Bc = ((it) & 1) * 32768;                                \
        const int kp = (WIN && kt >= 2) ? (kt - 2) * 128 : -1;            \
        { f32x16 sa0, sa1; bf16x8 pa[4]; \
          AT_QK(sa0, sa1, Bc); AT_EXP(sa0, sa1, pa, kp); AT_PV(pa, Bc + 16384); } \
        __builtin_amdgcn_sched_barrier(0); \
        { f32x16 sb0, sb1; bf16x8 pb_[4]; \
          AT_QK(sb0, sb1, Bc + 8192); AT_EXP(sb0, sb1, pb_, (kp < 0 ? -1 : kp + 64)); AT_PV(pb_, Bc + 24576); } \
        if ((it) + 1 < ntile) AT_ST(((it) + 1) & 1, kA0, kA1, vA0, vA1); \
        __syncthreads(); } while (0)
    u32x4 kA0, kA1, vA0, vA1;
    AT_LD(0, kA0, kA1, vA0, vA1);
    __syncthreads();
    AT_ST(0, kA0, kA1, vA0, vA1);
    __syncthreads();
    for (int it = 0; it < ntile; it += 2) {
        AT_BODY(it);
        if (it + 1 < ntile) AT_BODY(it + 1);
    }
#undef AT_BODY
#undef AT_QK
#undef AT_EXP
#undef AT_PV
#undef AT_ST
#undef AT_LD
#undef AT_KT
    float lt = lacc[0];
    if (has_sink) lt += fast_exp2(sink2);
    const float inv = 1.f / lt;
#pragma unroll
    for (int g = 0; g < 4; ++g) {
        u32x2 w0, w1;
        w0.x = cvtpk(o0[4 * g] * inv, o0[4 * g + 1] * inv); w0.y = cvtpk(o0[4 * g + 2] * inv, o0[4 * g + 3] * inv);
        w1.x = cvtpk(o1[4 * g] * inv, o1[4 * g + 1] * inv); w1.y = cvtpk(o1[4 * g + 2] * inv, o1[4 * g + 3] * inv);
        *(u32x2*)(Qw + (size_t)r * 1536 + 8 * g + 4 * h) = w0;
        *(u32x2*)(Qw + (size_t)r * 1536 + 32 + 8 * g + 4 * h) = w1; }
#undef SWAP32
}

__device__ __forceinline__ void hyena_unit_lat(const Fr& F, const bf16_t* Fg, const bf16_t* Vg, bf16_t* Yg) {
    constexpr int FREP = 8192 + 64, VPIT = 4096 + 16, VOFF = 8 * FREP;
    LAS unsigned char* L = F.lds;
    __syncthreads();
    { const int x = F.tid;
      const u32x4 lo = *(const u32x4*)(Fg + x * 8); u32x4 hi; if (x < 511) hi = *(const u32x4*)(Fg + x * 8 + 8); else { const unsigned z = zero_u32(); hi = (u32x4){z, z, z, z}; }
      const unsigned wv[8] = {lo.x, lo.y, lo.z, lo.w, hi.x, hi.y, hi.z, hi.w};
      *(LAS u32x4*)(L + x * 16) = lo;
#pragma unroll
      for (int rho = 1; rho < 8; ++rho) { u32x4 o;
          unsigned od[4];
#pragma unroll
          for (int d = 0; d < 4; ++d) { const int ob = 4 * d + 2 * rho, i = ob >> 2, s = ob & 3; od[d] = __builtin_amdgcn_alignbyte(wv[i + 1 < 8 ? i + 1 : 7], wv[i], s); }
          o.x = od[0]; o.y = od[1]; o.z = od[2]; o.w = od[3];
          *(LAS u32x4*)(L + rho * FREP + x * 16) = o; } }
    for (int i = F.tid; i < 16 * 256; i += NTHR) { const int b = i >> 8, x = i & 255; *(LAS u32x4*)(L + VOFF + b * VPIT + x * 16) = *(const u32x4*)(Vg + (size_t)b * SEQ + x * 8); }
    __syncthreads();
    const int i16 = F.lane & 15, q4 = F.lane >> 4, w = F.wave;
    const int base0 = 2047 - 256 * w - i16 + 8 * q4;
    const int rho = base0 & 7;
    LAS unsigned char* Ap = L + rho * FREP + (base0 - rho) * 2;
    LAS unsigned char* Bp = L + VOFF + i16 * VPIT + q4 * 16;
    bf16x8 A[16]; f32x4 acc[16];
#pragma unroll
    for (int rr = 0; rr < 16; ++rr) { A[rr] = *(const LAS bf16x8*)(Ap - 32 * rr); acc[rr] = (f32x4){0.f, 0.f, 0.f, 0.f}; }
    bf16x8 Bn = *(const LAS bf16x8*)(Bp);
    for (int o = 0; o < 8; ++o) {
#pragma unroll
        for (int u = 0; u < 8; ++u) {
            const int st = o * 8 + u;
            const bf16x8 Bf = Bn;
            if (st < 63) Bn = *(const LAS bf16x8*)(Bp + 64 * st + 64);
#pragma unroll
            for (int rr = 0; rr < 16; ++rr) acc[rr] = MFMA16(A[(rr - 2 * u) & 15], Bf, acc[rr]);
            if (st < 63) { A[(-2 * u - 2) & 15] = *(const LAS bf16x8*)(Ap + 64 * st + 64); A[(-2 * u - 1) & 15] = *(const LAS bf16x8*)(Ap + 64 * st + 32); }
        }
    }
#pragma unroll
    for (int rr = 0; rr < 16; ++rr) { u32x2 wv; wv.x = cvtpk(acc[rr].x, acc[rr].y); wv.y = cvtpk(acc[rr].z, acc[rr].w);
        *(u32x2*)(Yg + (size_t)i16 * SEQ + 256 * w + 16 * rr + 4 * q4) = wv; }
}
__device__ __forceinline__ void hyena_unit_ctx(const Fr& F, const bf16_t* Fg, const bf16_t* Vg, bf16_t* Yg) {
    constexpr int FREP = 1024 + 64, VPIT = 512 + 16, VOFF = 8 * FREP;
    LAS unsigned char* L = F.lds;
    __syncthreads();
    if (F.tid < 64) *(LAS u32x4*)(L + F.tid * 16) = *(const u32x4*)(Fg + F.tid * 8);
    if (F.tid >= 64 && F.tid < 68) { const unsigned z = zero_u32(); *(LAS u32x4*)(L + 1024 + (F.tid - 64) * 16) = (u32x4){z, z, z, z}; }
    { const int b = F.tid >> 5, x = F.tid & 31; *(LAS u32x4*)(L + VOFF + b * VPIT + x * 16) = *(const u32x4*)(Vg + (size_t)b * CTX + x * 8); }
    __syncthreads();
    for (int i = F.tid; i < 7 * 256; i += NTHR) { const int rho = 1 + i / 256, x2 = (i % 256) * 2; const int s0 = x2 + rho, s1 = x2 + 1 + rho;
        const unsigned e0 = s0 < 512 ? *(const LAS bf16_t*)(L + s0 * 2) : 0, e1 = s1 < 512 ? *(const LAS bf16_t*)(L + s1 * 2) : 0;
        *(LAS unsigned*)(L + rho * FREP + x2 * 2) = e0 | (e1 << 16); }
    __syncthreads();
    const int i16 = F.lane & 15, q4 = F.lane >> 4, w = F.wave;
    const int base0 = 255 - 32 * w - i16 + 8 * q4, rho = base0 & 7;
    LAS unsigned char* Ap = L + rho * FREP + (base0 - rho) * 2;
    LAS unsigned char* Bp = L + VOFF + i16 * VPIT + q4 * 16;
    f32x4 acc0 = (f32x4){0.f, 0.f, 0.f, 0.f}, acc1 = acc0;
#pragma unroll
    for (int st = 0; st < 8; ++st) { const bf16x8 Bf = *(const LAS bf16x8*)(Bp + 64 * st);
        const bf16x8 A0 = *(const LAS bf16x8*)(Ap + 64 * st), A1 = *(const LAS bf16x8*)(Ap + 64 * st - 32);
        acc0 = MFMA16(A0, Bf, acc0); acc1 = MFMA16(A1, Bf, acc1); }
    u32x2 wv; wv.x = cvtpk(acc0.x, acc0.y); wv.y = cvtpk(acc0.z, acc0.w); *(u32x2*)(Yg + (size_t)i16 * CTX + 32 * w + 4 * q4) = wv;
    wv.x = cvtpk(acc1.x, acc1.y); wv.y = cvtpk(acc1.z, acc1.w); *(u32x2*)(Yg + (size_t)i16 * CTX + 32 * w + 16 + 4 * q4) = wv;
}

__device__ __forceinline__ void mixer_phase(const Fr& F, const Args& a, int l, bool with_ctx, unsigned long long& sacc, const int swhich) {
#if defined(PROBE_P)
    unsigned long long st0 = __builtin_amdgcn_s_memrealtime();
#define SUBMARK(w) do { const unsigned long long t_ = __builtin_amdgcn_s_memrealtime(); if (swhich == (w)) sacc += t_ - st0; st0 = t_; } while (0)
#else
#define SUBMARK(w) do { } while (0)
#endif
    bf16_t* QA = (bf16_t*)(a.ws + WS_QA); bf16_t* QW = QA + 1024;
    const bf16_t* KA = (const bf16_t*)(a.ws + WS_KA); const bf16_t* KW = (const bf16_t*)(a.ws + WS_KW);
    const bf16_t* VTA = (const bf16_t*)(a.ws + WS_VTA); const bf16_t* VTW = (const bf16_t*)(a.ws + WS_VTW);
    const float* sinks = a.in[I_SINK] + l * 8; const float* qkg = a.in[I_QKG] + l * 256;
    const float* ct = (const float*)(a.ws + WS_ROPE); const float* st = ct + SEQ * 32;
    const int wq = F.wave >> 1, wh = F.wave & 1;
    const int ubid = (F.G % 8 == 0) ? (F.bid & 7) * (F.G >> 3) + (F.bid >> 3) : F.bid;
#define RELANE(FX) do { int t_ = F.wave * 64 + lane_id(); asm volatile("" : "+v"(t_)); FX.tid = t_; FX.lane = t_ & 63; } while (0)
    Fr FA = F; RELANE(FA);
    for (int unit = ubid; unit < NB * 2 * 32; unit += F.G) {
        const int b = unit >> 6, kvh = (unit >> 5) & 1, pb = unit & 31;
        bf16_t* Qw = QA + (size_t)(b * SEQ + pb * 64 + wh * 32) * 1536 + (kvh * 4 + wq) * 64;
        attn_unit<false>(FA, Qw, KA + (size_t)b * KEYS * 128 + kvh * 64, VTA + (size_t)(b * 2 + kvh) * 64 * KEYS, 0, KEYS / 128, 0, 0, pb * 64 + wh * 32, false, 0.f, qkg, true, ct, st);
    }
    SUBMARK(30);
    Fr FW = F; RELANE(FW);
    for (int unit = ubid; unit < NB * 2 * 32; unit += F.G) {
        const int b = unit >> 6, kvh = (unit >> 5) & 1, pb = unit & 31;
        bf16_t* Qw = QW + (size_t)(b * SEQ + pb * 64 + wh * 32) * 1536 + (kvh * 4 + wq) * 64;
        const int lo = pb < 2 ? 0 : (pb - 2) >> 1, hi = ((64 * pb + 191) >> 7) > 15 ? 15 : ((64 * pb + 191) >> 7);
        attn_unit<true>(FW, Qw, KW + (size_t)b * KEYS * 128 + kvh * 64, VTW + (size_t)(b * 2 + kvh) * 64 * KEYS, 0, 2, 2 + lo, hi - lo + 1, pb * 64 + wh * 32, true, sinks[kvh * 4 + wq] * LOG2E, qkg + 128, true, ct, st);
    }
    SUBMARK(31);
    Fr FC2 = F; RELANE(FC2);
    if (with_ctx) {
        for (int unit = ubid; unit < 2 * NB * 2 * 4; unit += F.G) {
            const int isw = unit >> 7, u2 = unit & 127, b = u2 >> 3, kvh = (u2 >> 2) & 1, pb = u2 & 3;
            bf16_t* Qw = (isw ? QW : QA) + (size_t)(TL + b * CTX + pb * 64 + wh * 32) * 1536 + (kvh * 4 + wq) * 64;
            attn_unit<false>(FC2, Qw, (isw ? KW : KA) + (size_t)b * KEYS * 128 + kvh * 64, (isw ? VTW : VTA) + (size_t)(b * 2 + kvh) * 64 * KEYS, 0, 2, 0, 0, 0, isw != 0, isw ? sinks[kvh * 4 + wq] * LOG2E : 0.f, qkg + (isw ? 128 : 0), false, ct, st);
        }
    }
    SUBMARK(32);
    const bf16_t* FL = (const bf16_t*)(a.ws + WS_FL) + (size_t)l * 512 * 4096; const bf16_t* FC = (const bf16_t*)(a.ws + WS_FC) + (size_t)l * 512 * 512;
    const bf16_t* VT = (const bf16_t*)(a.ws + WS_VT); bf16_t* YT = (bf16_t*)(a.ws + WS_YT);
    Fr FH = F; RELANE(FH);
    for (int c = F.bid; c < HYW; c += F.G) hyena_unit_lat(FH, FL + (size_t)c * 4096, VT + (size_t)c * NB * SEQ, YT + (size_t)c * NB * SEQ);
    if (with_ctx) for (int c = F.bid; c < HYW; c += F.G) hyena_unit_ctx(FH, FC + (size_t)c * 512, VT + VT_CTX_OFF + (size_t)c * NB * CTX, YT + VT_CTX_OFF + (size_t)c * NB * CTX);
    __syncthreads();
    SUBMARK(33);
#undef SUBMARK
#undef RELANE
}

__device__ __forceinline__ float gate_q(float x) { return fminf(256.f * sigmoid_f(x), 255.49f); }
__device__ __forceinline__ unsigned pack_u8x4(float a, float b, float c, float d) { return (unsigned)(int)a | ((unsigned)(int)b << 8) | ((unsigned)(int)c << 16) | ((unsigned)(int)d << 24); }
__device__ __forceinline__ float gq(unsigned w, int k) { return (float)((w >> (8 * k)) & 0xffu) + 0.5f; }
struct EpiInProj {
    static constexpr bool PERM = true, AFTER_DRAIN = false; static constexpr int NSEG = 1;
    unsigned char* ws;
    __device__ __forceinline__ void operator()(const pg8::f32x4 (&acc)[2][2][4][2], const pg8::Unit& u, int wr, int wc, int fr, int fq) const {
        asm volatile("" : "+v"(fr), "+v"(fq));
        const int pn = __builtin_amdgcn_readfirstlane(u.pn); unsigned long long boff; int ldc, colt; bool sig = false;
        if (pn < 2) { boff = WS_QA; ldc = 1536; colt = pn * 256; }
        else if (pn == 2) { boff = WS_RAWA; ldc = 256; colt = 0; }
        else if (pn < 9) { boff = WS_U; ldc = 1536; colt = (pn - 3) * 256; }
        else if (pn < 11) { boff = WS_QA; ldc = 1536; colt = 1024 + (pn - 9) * 256; }
        else if (pn == 11) { boff = WS_RAWW; ldc = 256; colt = 0; }
        else { boff = WS_G; ldc = 3072; colt = (pn - 12) * 256; sig = true; }
        bf16_t* base = (bf16_t*)(ws + boff); unsigned char* Gt = ws + boff;
        const int row0 = u.pm * 256 + wr * 64 + fr, col0 = colt + wc * 32 + 8 * fq;
        if (sig) {
            unsigned char* gb = (unsigned char*)Gt;
#pragma unroll
            for (int ai = 0; ai < 2; ++ai)
#pragma unroll
                for (int m = 0; m < 4; ++m) { unsigned char* rowp = gb + (size_t)(row0 + ai * 128 + m * 16) * 3072 + col0;
#pragma unroll
                    for (int bj = 0; bj < 2; ++bj) { const pg8::f32x4 v0 = acc[ai][bj][m][0], v1 = acc[ai][bj][m][1];
                        u32x2 w; w.x = pack_u8x4(gate_q(v0.x), gate_q(v0.y), gate_q(v0.z), gate_q(v0.w)); w.y = pack_u8x4(gate_q(v1.x), gate_q(v1.y), gate_q(v1.z), gate_q(v1.w));
                        *(u32x2*)(rowp + bj * 128) = w; } }
            return;
        }
#pragma unroll
        for (int ai = 0; ai < 2; ++ai)
#pragma unroll
            for (int m = 0; m < 4; ++m) { bf16_t* rowp = base + (size_t)(row0 + ai * 128 + m * 16) * ldc + col0;
#pragma unroll
                for (int bj = 0; bj < 2; ++bj) { const pg8::f32x4 v0 = acc[ai][bj][m][0], v1 = acc[ai][bj][m][1];
                    u32x4 w; w.x = cvtpk(v0.x, v0.y); w.y = cvtpk(v0.z, v0.w); w.z = cvtpk(v1.x, v1.y); w.w = cvtpk(v1.z, v1.w);
                    *(u32x4*)(rowp + bj * 128) = w; } }
    }
};
struct EpiMerge {
    static constexpr bool PERM = true, AFTER_DRAIN = false; static constexpr int NSEG = 3;
    bf16_t* Mo; const unsigned char* Gt; unsigned* panel_cnt;
    __device__ __forceinline__ void rescale(pg8::f32x4 (&acc)[2][2][4][2], const pg8::Unit& u, int seg, int wr, int wc, int fr, int fq) const {
        asm volatile("" : "+v"(fr), "+v"(fq));
        const int row0 = u.pm * 256 + wr * 64 + fr, col0 = u.pn * 256 + wc * 32 + 8 * fq;
        const unsigned char* G0 = Gt + seg * 1024 + col0;
#pragma unroll
        for (int ai = 0; ai < 2; ++ai)
#pragma unroll
            for (int mh = 0; mh < 2; ++mh) {
                u32x2 ga[2][2], gb[2][2];
#pragma unroll
                for (int mm = 0; mm < 2; ++mm)
#pragma unroll
                    for (int bj = 0; bj < 2; ++bj) { const size_t row = (size_t)(row0 + ai * 128 + (2 * mh + mm) * 16);
                        ga[mm][bj] = *(const u32x2*)(G0 + row * 3072 + bj * 128); gb[mm][bj] = *(const u32x2*)(G0 + row * 3072 + 1024 + bj * 128); }
                __builtin_amdgcn_sched_barrier(0);
#pragma unroll
                for (int mm = 0; mm < 2; ++mm)
#pragma unroll
                    for (int bj = 0; bj < 2; ++bj) { const u32x2 a = ga[mm][bj], b = gb[mm][bj]; pg8::f32x4& v0 = acc[ai][bj][2 * mh + mm][0]; pg8::f32x4& v1 = acc[ai][bj][2 * mh + mm][1];
                        v0.x *= gq(a.x, 0) * fast_rcp(gq(b.x, 0)); v0.y *= gq(a.x, 1) * fast_rcp(gq(b.x, 1)); v0.z *= gq(a.x, 2) * fast_rcp(gq(b.x, 2)); v0.w *= gq(a.x, 3) * fast_rcp(gq(b.x, 3));
                        v1.x *= gq(a.y, 0) * fast_rcp(gq(b.y, 0)); v1.y *= gq(a.y, 1) * fast_rcp(gq(b.y, 1)); v1.z *= gq(a.y, 2) * fast_rcp(gq(b.y, 2)); v1.w *= gq(a.y, 3) * fast_rcp(gq(b.y, 3)); }
                __builtin_amdgcn_sched_barrier(0);
            }
    }
    __device__ __forceinline__ void operator()(const pg8::f32x4 (&acc)[2][2][4][2], const pg8::Unit& u, int wr, int wc, int fr, int fq) const {
        asm volatile("" : "+v"(fr), "+v"(fq));
        const int row0 = u.pm * 256 + wr * 64 + fr, col0 = u.pn * 256 + wc * 32 + 8 * fq;
        constexpr float S = 1.f / 256.f;
        const __amdgpu_buffer_rsrc_t rs = __builtin_amdgcn_make_buffer_rsrc((void*)Mo, 0, TT * 1024 * 2, 0x00020000);
#pragma unroll
        for (int ai = 0; ai < 2; ++ai) {
            u32x2 gv[4][2];
#pragma unroll
            for (int m = 0; m < 4; ++m)
#pragma unroll
                for (int bj = 0; bj < 2; ++bj) gv[m][bj] = *(const u32x2*)(Gt + (size_t)(row0 + ai * 128 + m * 16) * 3072 + 2048 + col0 + bj * 128);
            __builtin_amdgcn_sched_barrier(0);
#pragma unroll
            for (int m = 0; m < 4; ++m)
#pragma unroll
                for (int bj = 0; bj < 2; ++bj) { const pg8::f32x4 v0 = acc[ai][bj][m][0], v1 = acc[ai][bj][m][1]; const u32x2 g = gv[m][bj];
                    u32x4 w; w.x = cvtpk(v0.x * (gq(g.x, 0) * S), v0.y * (gq(g.x, 1) * S)); w.y = cvtpk(v0.z * (gq(g.x, 2) * S), v0.w * (gq(g.x, 3) * S));
                    w.z = cvtpk(v1.x * (gq(g.y, 0) * S), v1.y * (gq(g.y, 1) * S)); w.w = cvtpk(v1.z * (gq(g.y, 2) * S), v1.w * (gq(g.y, 3) * S));
                    if (panel_cnt) __builtin_amdgcn_raw_buffer_store_b128(w, rs, ((row0 + ai * 128 + m * 16) * 1024 + col0 + bj * 128) * 2, 0, 16);
                    else *(u32x4*)(Mo + (size_t)(row0 + ai * 128 + m * 16) * 1024 + col0 + bj * 128) = w; }
            __builtin_amdgcn_sched_barrier(0);
        }
        if (panel_cnt) {
            asm volatile("s_waitcnt vmcnt(0)" ::: "memory");
            if (lane_id() == 0) (void)__hip_atomic_fetch_add(panel_cnt + 64 * u.pm, 1u, __ATOMIC_RELAXED, __HIP_MEMORY_SCOPE_AGENT);
        }
    }
};
struct EpiOut {
    static constexpr bool PERM = true, AFTER_DRAIN = false; static constexpr int NSEG = 1;
    const float* xsL; const float* xsC; float* xdL; float* xdC; const float* MODl;
    __device__ __forceinline__ void operator()(const pg8::f32x4 (&acc)[2][2][4][2], const pg8::Unit& u, int wr, int wc, int fr, int fq) const {
        asm volatile("" : "+v"(fr), "+v"(fq));
        const int trow = u.pm * 256; const bool lat = trow < TL;
        const int row0 = trow + wr * 64 + fr, col0 = u.pn * 256 + wc * 32 + 8 * fq;
        const float* md = MODl + (size_t)mod_row(trow) * DIN + 2 * 1024 + col0;
        const float* xs = lat ? xsL + (size_t)row0 * D + col0 : xsC + (size_t)(row0 - TL) * D + col0; float* xd = lat ? xdL + (size_t)row0 * D + col0 : xdC + (size_t)(row0 - TL) * D + col0;
        f32x4 mv[2][2];
#pragma unroll
        for (int bj = 0; bj < 2; ++bj)
#pragma unroll
            for (int n = 0; n < 2; ++n) mv[bj][n] = *(const f32x4*)(md + bj * 128 + 4 * n);
#pragma unroll
        for (int ai = 0; ai < 2; ++ai)
#pragma unroll
            for (int mh = 0; mh < 2; ++mh) {
                f32x4 xv[2][2][2];
#pragma unroll
                for (int mm = 0; mm < 2; ++mm)
#pragma unroll
                    for (int bj = 0; bj < 2; ++bj)
#pragma unroll
                        for (int n = 0; n < 2; ++n) xv[mm][bj][n] = *(const f32x4*)(xs + (size_t)(ai * 128 + (2 * mh + mm) * 16) * D + bj * 128 + 4 * n);
                __builtin_amdgcn_sched_barrier(0);
#pragma unroll
                for (int mm = 0; mm < 2; ++mm)
#pragma unroll
                    for (int bj = 0; bj < 2; ++bj)
#pragma unroll
                        for (int n = 0; n < 2; ++n) { const pg8::f32x4 av = acc[ai][bj][2 * mh + mm][n]; const f32x4 x4 = xv[mm][bj][n], m4 = mv[bj][n];
                            f32x4 o; o.x = fmaf(m4.x, av.x, x4.x); o.y = fmaf(m4.y, av.y, x4.y); o.z = fmaf(m4.z, av.z, x4.z); o.w = fmaf(m4.w, av.w, x4.w);
                            *(f32x4*)(xd + (size_t)(ai * 128 + (2 * mh + mm) * 16) * D + bj * 128 + 4 * n) = o; }
                __builtin_amdgcn_sched_barrier(0);
            }
    }
};
struct EpiMoe1 {
    static constexpr bool PERM = true, AFTER_DRAIN = false; static constexpr int NSEG = 1;
    bf16_t* HM;
    __device__ __forceinline__ void operator()(const pg8::f32x4 (&acc)[2][2][4][2], const pg8::Unit& u, int wr, int wc, int fr, int fq) const {
        asm volatile("" : "+v"(fr), "+v"(fq));
        const int row0 = u.pm * 256 + wr * 64 + fr, hcol0 = (u.pn & 3) * 128 + wc * 16 + 4 * fq;
#pragma unroll
        for (int ai = 0; ai < 2; ++ai)
#pragma unroll
            for (int m = 0; m < 4; ++m) { bf16_t* rowp = HM + (size_t)(row0 + ai * 128 + m * 16) * 512 + hcol0;
#pragma unroll
                for (int bj = 0; bj < 2; ++bj) { const pg8::f32x4 x = acc[ai][bj][m][0], y = acc[ai][bj][m][1];
                    u32x2 w; w.x = cvtpk(x.x * sigmoid_f(x.x) * y.x, x.y * sigmoid_f(x.y) * y.y); w.y = cvtpk(x.z * sigmoid_f(x.z) * y.z, x.w * sigmoid_f(x.w) * y.w);
                    *(u32x2*)(rowp + bj * 64) = w; } }
    }
};
struct EpiMoe2 {
    static constexpr bool PERM = true, AFTER_DRAIN = false; static constexpr int NSEG = 1;
    bf16_t* Fo; const int* erow; const float* eroww; const LAS int* ebase; const LAS int* ecnt;
    __device__ __forceinline__ void operator()(const pg8::f32x4 (&acc)[2][2][4][2], const pg8::Unit& u, int wr, int wc, int fr, int fq) const {
        asm volatile("" : "+v"(fr), "+v"(fq));
        const int e = u.pn >> 2, cnt = __builtin_amdgcn_readfirstlane(ecnt[e]), pos0 = u.pm * 256 - __builtin_amdgcn_readfirstlane(ebase[e]) + wr * 64 + fr, col0 = (u.pn & 3) * 256 + wc * 32 + 8 * fq;
        const int* er = erow + (size_t)e * TT; const float* ew = eroww + (size_t)e * TT;
#pragma unroll
        for (int ai = 0; ai < 2; ++ai) {
            int rm[4]; float wg[4];
#pragma unroll
            for (int m = 0; m < 4; ++m) { const int pos = pos0 + ai * 128 + m * 16; const bool ok = pos < cnt; rm[m] = ok ? er[ok ? pos : 0] : -1; wg[m] = ew[ok ? pos : 0]; }
            __builtin_amdgcn_sched_barrier(0);
#pragma unroll
            for (int m = 0; m < 4; ++m) { const int r1 = rm[m];
                if (r1 >= 0) { const float wgt = wg[m]; bf16_t* rowp = Fo + ((size_t)(r1 & 1) * TT + (r1 >> 1)) * D + col0;
#pragma unroll
                    for (int bj = 0; bj < 2; ++bj) { const pg8::f32x4 v0 = acc[ai][bj][m][0], v1 = acc[ai][bj][m][1];
                        u32x4 w; w.x = cvtpk(v0.x * wgt, v0.y * wgt); w.y = cvtpk(v0.z * wgt, v0.w * wgt); w.z = cvtpk(v1.x * wgt, v1.y * wgt); w.w = cvtpk(v1.z * wgt, v1.w * wgt);
                        *(u32x4*)(rowp + bj * 128) = w; } } }
            __builtin_amdgcn_sched_barrier(0);
        }
    }
};
struct FusedOutOrder {
    int c, G, nun, wv; const unsigned* ready; unsigned* tmo;
    __device__ __forceinline__ bool next(int i, pg8::Unit& u) const {
        int q;
        if (!ready) { q = i * G + c; if (q >= nun) return false; }
        else if (G == 256 && nun == 576) { if (c < 64) { if (i > 0) return false; q = 512 + c; } else { q = i * 192 + (c - 64); if (q >= 512) return false; } }
        else { q = i * G + (G - 1 - c); if (q >= nun) return false; }
        u.pm = q >> 2; u.pn = q & 3; return true; }
    __device__ __forceinline__ void a_ready(const pg8::Unit& u) const {
        if (!ready) return;
        if (wv == 0) {
            const unsigned long long t0 = __builtin_amdgcn_s_memrealtime(); unsigned polls = 0;
            while ((unsigned)__builtin_amdgcn_readfirstlane(__hip_atomic_load(ready + 64 * u.pm, __ATOMIC_RELAXED, __HIP_MEMORY_SCOPE_AGENT)) < 32u) {
                if ((++polls & 255u) == 0u && __builtin_amdgcn_readfirstlane(__hip_atomic_load(tmo, __ATOMIC_RELAXED, __HIP_MEMORY_SCOPE_AGENT)) != 0u) break;
                if (__builtin_amdgcn_s_memrealtime() - t0 > 20000000ull) { if (lane_id() == 0) __hip_atomic_store(tmo, 1u, __ATOMIC_RELAXED, __HIP_MEMORY_SCOPE_AGENT); break; }
                __builtin_amdgcn_s_sleep(2); }
            __builtin_amdgcn_fence(__ATOMIC_ACQUIRE, "agent");
            asm volatile("s_waitcnt vmcnt(0)" ::: "memory");
        }
        asm volatile("" ::: "memory"); __builtin_amdgcn_s_barrier(); asm volatile("" ::: "memory");
    }
    __device__ __forceinline__ void done(const pg8::Unit&) const {}
};
struct LastInProjOrder {
    pg8::StaticOrder T; int nlat, G, c;
    __device__ __forceinline__ bool next(int i, pg8::Unit& u) const {
        const int L = i * G + c;
        if (L < nlat) return T.next(i, u);
        const int r = L - nlat; if (r >= 32) return false;
        u.pm = 128 + (r >> 1); u.pn = (r & 1) ? 11 : 2; return true; }
    __device__ __forceinline__ void a_ready(const pg8::Unit&) const {}
    __device__ __forceinline__ void done(const pg8::Unit&) const {}
};
struct MoeOrder {
    int nunits, G, c; const LAS int* tile_e;
    __device__ __forceinline__ bool next(int i, pg8::Unit& u) const {
        const int L0 = i * G + c; if (L0 >= nunits) return false;
        const int q = nunits / 8, r = nunits % 8, xcd = L0 % 8, off = L0 / 8; const int L = (xcd < r ? xcd * (q + 1) : r * (q + 1) + (xcd - r) * q) + off;
        const int pm = L >> 2; u.pm = pm; u.pn = __builtin_amdgcn_readfirstlane(tile_e[pm]) * 4 + (L & 3); return true; }
    __device__ __forceinline__ void a_ready(const pg8::Unit&) const {}
    __device__ __forceinline__ void done(const pg8::Unit&) const {}
};

__device__ __forceinline__ int moe_tables(const Fr& F, const Args& a, int l, LAS int* ebase  , LAS int* ecnt  , LAS int* tile_e  ) {
    const unsigned* CNT = (const unsigned*)(a.ws + WS_CTL) + CW_CNT + l * 256;
    __syncthreads();
    if (F.tid == 0) { int acc = 0;
#pragma unroll 1
        for (int e = 0; e < NE; ++e) { const int c = (int)__hip_atomic_load(&CNT[e * 16], __ATOMIC_RELAXED, __HIP_MEMORY_SCOPE_AGENT); ecnt[e] = c; ebase[e] = acc; const int nt = (c + 255) >> 8;
#pragma unroll 1
            for (int t = 0; t < nt; ++t) tile_e[(acc >> 8) + t] = e;
            acc += nt << 8; }
        ebase[NE] = acc; }
    __syncthreads();
    return ebase[NE] >> 8;
}

__device__ __forceinline__ void moe_gather_table(const Fr& F, const Args& a, const MoeOrder& S, const LAS int* ebase, const LAS int* ecnt, LAS int* gidx) {
    const int* EROW = (const int*)(a.ws + WS_EROW);
    for (int j = 0; j < 16; ++j) { pg8::Unit u; if (!S.next(j, u)) break;
        const int e = u.pn >> 2, pos0 = u.pm * 256 - ebase[e], cnt = ecnt[e];
        if (F.tid < 256) { const int pos = pos0 + F.tid; gidx[j * 256 + F.tid] = pos < cnt ? (EROW[(size_t)e * TT + pos] >> 1) : 0; } }
    __syncthreads();
}

#ifndef MK_PER_PHASE
#define MK_PER_PHASE 0
#endif
constexpr int PH_PER_LAYER = 10, PH_FINAL = 1 + NL * PH_PER_LAYER, N_PHASES = PH_FINAL + 1;

__global__ void __launch_bounds__(NTHR, 2) trunk_fwd(Args args) {
    extern __shared__ __attribute__((aligned(16))) unsigned char lds[];
    Fr F; F.lds = (LAS unsigned char*)lds; F.tid = threadIdx.x; F.lane = F.tid & 63; F.wave = __builtin_amdgcn_readfirstlane(F.tid >> 6); F.G = gridDim.x; F.bid = blockIdx.x;
    const int wave0 = F.wave;
    for (int u = F.tid; u < (LDS_BYTES - MISC_OFF) / 4; u += NTHR) ((LAS unsigned*)(F.lds + MISC_OFF))[u] = 0u;
    __syncthreads();
    const int lo = args.ph_lo, hi = args.ph_hi;
    unsigned* ctl = (unsigned*)(args.ws + WS_CTL);
    XcdBarrier bar; bar.bar = ctl + CW_BAR; bar.x = 0; bar.st = (volatile LAS unsigned*)(F.lds + MISC_OFF);
    if (hi - lo > 1) bar = xcd_barrier_post(ctl + CW_BAR, (volatile LAS unsigned*)(F.lds + MISC_OFF));
    bar.wv = (unsigned)wave0;
#ifndef DBG_ONLY
#define DBG_ONLY -1
#endif
#define SEL(p) (DBG_ONLY < 0 || DBG_ONLY == (p))
#define IN(k) (lo <= (k) && (k) < hi)
#define FRESH() do { int t_ = wave0 * 64 + lane_id(); asm volatile("" : "+v"(t_)); F.tid = t_; F.lane = t_ & 63; F.wave = wave0; } while (0)
#define SEAM(k) do { if (IN(k) && IN((k) + 1)) xcd_barrier(bar); } while (0)
#if !defined(PROBE_SUB)
#define PROBE_SUB -1
#endif
    unsigned long long pr_sub = 0ull;
#if defined(PROBE_P)
    unsigned long long pr_acc = 0ull, pr_t0 = __builtin_amdgcn_s_memrealtime();
#define PR_MARK(p) do { const unsigned long long t_ = __builtin_amdgcn_s_memrealtime(); if ((p) == PROBE_P) pr_acc += t_ - pr_t0; pr_t0 = t_; } while (0)
#else
#define PR_MARK(p) do { } while (0)
#endif
    unsigned char* ws = args.ws;
    LAS int* ebase = (LAS int*)(F.lds + MISC_OFF + 64); LAS int* ecnt = ebase + 20; LAS int* tile_e = (LAS int*)(F.lds + MISC_OFF + 512);

    #ifndef DBG_PRO
#define DBG_PRO 7
#endif
    if (SEL(100) && IN(0)) { FRESH(); if (DBG_PRO & 1) pro_mod(F, args); __syncthreads(); if (DBG_PRO & 2) pro_rope(F, args); if (DBG_PRO & 4) pro_filter(F, args); __syncthreads(); }
    SEAM(0); PR_MARK(100);
    for (int l = 0; l < NL; ++l) {
        const int pb = 1 + PH_PER_LAYER * l;
#define LVARS() int lq_ = l; asm volatile("" : "+s"(lq_)); const bool uc = lq_ < NL - 1; const int M2 = uc ? TT : TL; (void)M2; (void)uc
        if (SEL(0) && IN(pb + 0)) { LVARS(); FRESH(); if (l == 0) filter_norm_reduce(F, args); conv_small_weights(F, args, l, 7, 0); rows_p0(F, args, l, TT); __syncthreads(); }
        SEAM(pb + 0); PR_MARK(0);
        if (SEL(1) && IN(pb + 1)) { LVARS();
            pg8::Gemm g{(const bf16_t*)(ws + WS_H), (const bf16_t*)(ws + WS_WIN), TT, DIN, 1024};
            EpiInProj E{ws};
            if (uc) { pg8::StaticOrder S; S.init(TT, DIN, F.G, F.bid); pg8::gemm_phase<EpiInProj, pg8::StaticOrder, true, true>(F.lds, g, S, E, wave0); }
            else { LastInProjOrder S; S.T.init(TL, DIN, F.G, F.bid); S.nlat = (TL / 256) * (DIN / 256); S.G = F.G; S.c = F.bid; pg8::gemm_phase<EpiInProj, LastInProjOrder, true, true>(F.lds, g, S, E, wave0); }
        }
        SEAM(pb + 1); PR_MARK(1);
        if (SEL(2) && IN(pb + 2)) { LVARS(); FRESH(); prep_phase(F, args, l, uc); }
        SEAM(pb + 2); PR_MARK(2);
        if (SEL(3) && IN(pb + 3)) { LVARS(); FRESH(); mixer_phase(F, args, l, uc, pr_sub, PROBE_SUB); }
        SEAM(pb + 3); PR_MARK(3);
        if (SEL(4) && IN(pb + 4)) { LVARS(); FRESH(); hyena_final_phase(F, args, l, uc); }
        SEAM(pb + 4); PR_MARK(4);
        if (SEL(5) && IN(pb + 5)) { LVARS();
            pg8::StaticOrder S; S.init(M2, 1024, F.G, F.bid);
            pg8::Gemm g{(const bf16_t*)(ws + WS_QA), (const bf16_t*)(ws + WS_WBR), M2, 1024, 1536}; EpiMerge E{(bf16_t*)(ws + WS_H), (const unsigned char*)(ws + WS_G), nullptr};
            pg8::gemm_phase<EpiMerge, pg8::StaticOrder, true, true>(F.lds, g, S, E, wave0);
            { FRESH(); __syncthreads(); const int nun = (M2 / 256) * 4, rem = nun % F.G; conv_expert_weights(F, args, l, rem, 0, CONV_E_ITEMS); __syncthreads(); }
        }
        SEAM(pb + 5); PR_MARK(5);
        if (SEL(6) && IN(pb + 6)) { LVARS();
            pg8::Gemm g{(const bf16_t*)(ws + WS_H), (const bf16_t*)(ws + WS_WOUT), M2, 1024, 1024}; pg8::StaticOrder S; S.init(M2, 1024, F.G, F.bid);
            EpiOut E{l == 0 ? args.in[I_X] : args.out, l == 0 ? args.in[I_CTX] : (const float*)(ws + WS_XC), args.out, (float*)(ws + WS_XC), (const float*)(ws + WS_MOD) + (size_t)l * NBM * DIN};
            pg8::gemm_phase<EpiOut, pg8::StaticOrder, true, true>(F.lds, g, S, E, wave0);
        }
        SEAM(pb + 6); PR_MARK(6);
        if (SEL(7) && IN(pb + 7)) { LVARS(); FRESH(); rows_p5(F, args, l, M2, pr_sub, PROBE_SUB); __syncthreads(); }
        SEAM(pb + 7); PR_MARK(7);
        if (SEL(8) && IN(pb + 8)) { LVARS(); FRESH();
            const int ntile = moe_tables(F, args, l, ebase, ecnt, tile_e);
            pg8::Gemm g{(const bf16_t*)(ws + WS_H), (const bf16_t*)(ws + WS_W13), ntile * 256, NE * 1024, 1024}; MoeOrder S{ntile * 4, F.G, F.bid, tile_e};
            LAS int* gidx = (LAS int*)(F.lds + 131072);
            moe_gather_table(F, args, S, ebase, ecnt, gidx);
            EpiMoe1 E{(bf16_t*)(ws + WS_U)};
            pg8::gemm_phase<EpiMoe1, MoeOrder, true, true, true>(F.lds, g, S, E, wave0, gidx);
        }
        SEAM(pb + 8); PR_MARK(8);
        if (SEL(9) && IN(pb + 9)) { LVARS(); FRESH();
            const int ntile = moe_tables(F, args, l, ebase, ecnt, tile_e);
            pg8::Gemm g{(const bf16_t*)(ws + WS_U), (const bf16_t*)(ws + WS_W2), ntile * 256, NE * 1024, 512}; MoeOrder S{ntile * 4, F.G, F.bid, tile_e};
            EpiMoe2 E{(bf16_t*)(ws + WS_F), (const int*)(ws + WS_EROW), (const float*)(ws + WS_EROWW), ebase, ecnt};
            pg8::gemm_phase<EpiMoe2, MoeOrder, true, true>(F.lds, g, S, E, wave0);
        }
        SEAM(pb + 9); PR_MARK(9);
    }
    if (SEL(101) && IN(PH_FINAL)) { FRESH(); rows_final(F, args); }
#if defined(PROBE_P)
    PR_MARK(101);
    pr_acc += pr_sub;
    if (blockIdx.x == 0 && F.wave == 0) { const unsigned long long t1 = __builtin_amdgcn_s_memrealtime() + 4ull * pr_acc; while (__builtin_amdgcn_s_memrealtime() < t1) __builtin_amdgcn_s_sleep(8); }
#endif
#undef IN
#undef SEAM
}

__global__ void dbg_dump(const unsigned char* src, size_t nelem, int is_f32, float* out, size_t nout) {
    for (size_t i = (size_t)blockIdx.x * blockDim.x + threadIdx.x; i < nout; i += (size_t)gridDim.x * blockDim.x) {
        const size_t j = i % nelem; out[i] = is_f32 ? ((const float*)src)[j] : bf1(((const bf16_t*)src)[j]); }
}
extern "C" void kernel_launch(void* const* d_in, const int* in_sizes, int n_in, void* d_out, int out_size, void* d_ws, size_t ws_size, hipStream_t stream) {
    static int grid = 0;
    if (grid == 0) {
        if (n_in != 29 || in_sizes[0] != TL * D || out_size != TL * D || ws_size < WS_END) { fprintf(stderr, "kernel_launch: unexpected shapes / workspace (n_in %d, ws %zu < %zu); nothing launched\n", n_in, ws_size, (size_t)WS_END); grid = -1; return; }
        int dev = 0, cus = 0, per_cu = 0;
        if (hipGetDevice(&dev) != hipSuccess || hipDeviceGetAttribute(&cus, hipDeviceAttributeMultiprocessorCount, dev) != hipSuccess) { grid = -1; return; }
        if (hipFuncSetAttribute((const void*)trunk_fwd, hipFuncAttributeMaxDynamicSharedMemorySize, LDS_BYTES) != hipSuccess) { fprintf(stderr, "kernel_launch: hipFuncSetAttribute failed\n"); grid = -1; return; }
        if (hipOccupancyMaxActiveBlocksPerMultiprocessor(&per_cu, (const void*)trunk_fwd, NTHR, LDS_BYTES) != hipSuccess || per_cu < 1) { fprintf(stderr, "kernel_launch: occupancy query reports %d\n", per_cu); }
        (void)hipGetLastError();
        grid = cus;
    }
    if (grid < 0) return;
    (void)hipMemsetAsync((char*)d_ws + WS_CTL, 0, CTL_ZERO_BYTES, stream);
    Args a{};
    for (int i = 0; i < 29; ++i) a.in[i] = (const float*)d_in[i];
    a.out = (float*)d_out; a.ws = (unsigned char*)d_ws;
#if defined(DBG_STOP)
    for (int k = 0; k <= DBG_STOP; ++k) { a.ph_lo = k; a.ph_hi = k + 1; hipLaunchKernelGGL(trunk_fwd, dim3(grid), dim3(NTHR), LDS_BYTES, stream, a); }
#if defined(DBG_DUMP_OFF)
    hipLaunchKernelGGL(dbg_dump, dim3(2048), dim3(256), 0, stream, (const unsigned char*)d_ws + (size_t)(DBG_DUMP_OFF), (size_t)(DBG_DUMP_N), (int)(DBG_DUMP_F32), (float*)d_out, (size_t)out_size);
#endif
#elif MK_PER_PHASE
    for (int k = 0; k < N_PHASES; ++k) { a.ph_lo = k; a.ph_hi = k + 1; hipLaunchKernelGGL(trunk_fwd, dim3(grid), dim3(NTHR), LDS_BYTES, stream, a); }
#else
    a.ph_lo = 0; a.ph_hi = N_PHASES;
    hipLaunchKernelGGL(trunk_fwd, dim3(grid), dim3(NTHR), LDS_BYTES, stream, a);
#endif
}
```

```cpp
#include <hip/hip_runtime.h>
#include <cstdio>
#include <cstdint>

#define GAS __attribute__((address_space(1)))
#define LAS __attribute__((address_space(3)))
__device__ __forceinline__ int lane_id() { int l; asm volatile("v_mbcnt_lo_u32_b32 %0, -1, 0\n\tv_mbcnt_hi_u32_b32 %0, -1, %0" : "=v"(l)); return l; }
#define MK_PER_PHASE 0
namespace pg8 {
#define PG8_LAS __attribute__((address_space(3)))
typedef unsigned short bf16_t;
typedef short bf16x8 __attribute__((ext_vector_type(8)));
typedef float f32x4 __attribute__((ext_vector_type(4)));
typedef unsigned u32x4 __attribute__((ext_vector_type(4)));
constexpr int BM = 256, BK = 64, HALF = 128, HTB = HALF * BK * 2  , STAGE_BYTES = 8 * HTB, NXCD = 8, WGM = 8;

__host__ __device__ __forceinline__ int lds_byte(int r, int c) { const int st = (r >> 4) * 2 + (c >> 5), rr = r & 15, cc = c & 31, ob = rr * 64 + cc * 2; return st * 1024 + (ob ^ (((ob >> 9) & 1) << 5)); }
__host__ __device__ __forceinline__ void stage_rc(int b, int& R, int& C) { const int st = b / 1024, sb = b % 1024, swz = sb ^ (((sb >> 9) & 1) << 5); R = (st >> 1) * 16 + swz / 64; C = (st & 1) * 32 + (swz % 64) / 2; }
__host__ __device__ __forceinline__ int perm32(int rho) { const int n = rho >> 4, i = rho & 15; return 8 * (i >> 2) + 4 * n + (i & 3); }

struct Unit { int pm, pn; };
struct Gemm { const bf16_t* A; const bf16_t* Bt; int M, N, K; };

struct StaticOrder {
    int nM, nN, nwg, G, c;
    __host__ __device__ void init(int M, int N, int G_, int c_) { nM = M / BM; nN = N / BM; nwg = nM * nN; G = G_; c = c_; }
    __host__ __device__ bool next(int i, Unit& u) const {
        const long L = (long)i * G + c; if (L >= nwg) return false;
        int wgid = (int)L; { const int q = nwg / NXCD, r = nwg % NXCD, xcd = wgid % NXCD, off = wgid / NXCD; wgid = (xcd < r ? xcd * (q + 1) : r * (q + 1) + (xcd - r) * q) + off; }
        const int nig = WGM * nN, gid = wgid / nig, fm = gid * WGM, gsz = (nM - fm) < WGM ? (nM - fm) : WGM;
        u.pm = fm + ((wgid % nig) % gsz); u.pn = (wgid % nig) / gsz; return true;
    }
    __device__ __forceinline__ void a_ready(const Unit&) const {}
    __device__ __forceinline__ void done(const Unit&) const {}
};
__device__ __forceinline__ unsigned cvt_pk_bf16(float lo, float hi) { unsigned r; asm volatile("v_cvt_pk_bf16_f32 %0, %1, %2" : "=v"(r) : "v"(lo), "v"(hi)); return r; }
typedef float f32x2 __attribute__((ext_vector_type(2)));
template <class Epi, class Sched, bool ALIGN_EPI = false, bool SP2 = false, bool GATHER = false>
__device__ __forceinline__ void gemm_phase(PG8_LAS unsigned char* lds, const Gemm g, const Sched& S, const Epi& E, const int wave_id, const PG8_LAS int* gidx = nullptr) {
    static_assert(!GATHER || SP2, "GATHER is implemented for the SP2 loop only");
    int tid_ = wave_id * 64 + lane_id(); asm volatile("" : "+v"(tid_));
    const int tid = tid_, wid = __builtin_amdgcn_readfirstlane(tid >> 6), lane = tid & 63, wr = wid >> 2, wc = wid & 3, fr = lane & 15, fq = lane >> 4;
    const int K = g.K, nt = K / BK;
    unsigned voffA[2], voffB[2];
#pragma unroll
    for (int i = 0; i < 2; ++i) { int R, C; stage_rc(tid * 16 + i * 8192, R, C); const int Rb = Epi::PERM ? ((R & ~31) + perm32(R & 31)) : R;
        voffA[i] = (unsigned)(R * K + C) * 2u; voffB[i] = (unsigned)(Rb * K + C) * 2u; }
    unsigned goffA[2][2], goffN[2][2];
#define PG8_GOFF(dst, j) do { _Pragma("unroll") for (int _h = 0; _h < 2; ++_h) _Pragma("unroll") for (int _i = 0; _i < 2; ++_i) { int R_, C_; stage_rc(tid * 16 + _i * 8192, R_, C_); \
        dst[_h][_i] = ((unsigned)gidx[(j) * 256 + _h * 128 + R_] * (unsigned)K + (unsigned)C_) * 2u; } } while (0)
#define PG8_STAGE_A(bufoff, base, h, nx) do { if constexpr (GATHER) { unsigned o_[2] = {(nx) ? goffN[h][0] : goffA[h][0], (nx) ? goffN[h][1] : goffA[h][1]}; PG8_STAGE(bufoff, base, o_); } \
        else { PG8_STAGE(bufoff, (base) + ((h) ? hstep : 0), voffA); } } while (0)
    const size_t kstep = (size_t)(BK * 2);
    const size_t hstep = (size_t)HALF * K * 2;
    const size_t tstep = 2 * hstep;
    const unsigned ldsw = (unsigned)wid * 1024u;
    const int aoff = lds_byte(wr * 64 + fr, fq * 8), boff = lds_byte(wc * 32 + fr, fq * 8);
#define PG8_SA(b, h) (((b) * 2 + (h)) * HTB)
#define PG8_SB(b, h) ((4 + (b) * 2 + (h)) * HTB)
#define PG8_STAGE(bufoff, gbase, voff) do { _Pragma("unroll") for (int _i = 0; _i < 2; ++_i) \
        __builtin_amdgcn_global_load_lds((const unsigned*)((const char*)(gbase) + (voff)[_i]), (PG8_LAS unsigned*)(lds + (bufoff) + ldsw + _i * 8192), 16, 0, 0); } while (0)
#define PG8_LDA(dst, b, h) do { _Pragma("unroll") for (int m = 0; m < 4; ++m) _Pragma("unroll") for (int k = 0; k < 2; ++k) dst[m][k] = *(const PG8_LAS bf16x8*)(lds + PG8_SA(b, h) + aoff + m * 2048 + k * 1024); } while (0)
#define PG8_LDB(dst, b, h) do { _Pragma("unroll") for (int n = 0; n < 2; ++n) _Pragma("unroll") for (int k = 0; k < 2; ++k) dst[n][k] = *(const PG8_LAS bf16x8*)(lds + PG8_SB(b, h) + boff + n * 2048 + k * 1024); } while (0)
#define PG8_MMA(ai, bj, At, Bt) do { __builtin_amdgcn_s_setprio(1); _Pragma("unroll") for (int m = 0; m < 4; ++m) _Pragma("unroll") for (int n = 0; n < 2; ++n) _Pragma("unroll") for (int k = 0; k < 2; ++k) \
        acc[ai][bj][m][n] = __builtin_amdgcn_mfma_f32_16x16x32_bf16(Bt[n][k], At[m][k], acc[ai][bj][m][n], 0, 0, 0); __builtin_amdgcn_s_setprio(0); } while (0)
#define PG8_WAIT_V(n) asm volatile("s_waitcnt vmcnt(" #n ")" ::: "memory")
#define PG8_WAIT_L(n) asm volatile("s_waitcnt lgkmcnt(" #n ")" ::: "memory")
#define PG8_BAR __builtin_amdgcn_s_barrier()
#define PG8_SCHED __builtin_amdgcn_sched_barrier(0)
    Unit cur, nxt; int ui = 0;
    if (!S.next(0, cur)) return;
    f32x4 acc[2][2][4][2];
#pragma unroll
    for (int a = 0; a < 2; ++a)
#pragma unroll
        for (int b = 0; b < 2; ++b)
#pragma unroll
            for (int m = 0; m < 4; ++m)
#pragma unroll
                for (int n = 0; n < 2; ++n) acc[a][b][m][n] = (f32x4){0.f, 0.f, 0.f, 0.f};
    bf16x8 At[4][2], B0[2][2], B1[2][2];
    const char* cA = GATHER ? (const char*)g.A : (const char*)g.A + (size_t)cur.pm * tstep; const char* cB = (const char*)g.Bt + (size_t)cur.pn * tstep;
    if constexpr (GATHER) PG8_GOFF(goffA, 0);
    S.a_ready(cur);
    if constexpr (SP2) {
        PG8_STAGE(PG8_SB(0, 0), cB, voffB); PG8_STAGE(PG8_SB(0, 1), cB + hstep, voffB); PG8_STAGE_A(PG8_SA(0, 0), cA, 0, false); PG8_STAGE_A(PG8_SA(0, 1), cA, 1, false);
        if (wr == 1) PG8_BAR;
        PG8_WAIT_V(2); PG8_BAR;
        PG8_STAGE(PG8_SB(1, 0), cB + kstep, voffB); PG8_STAGE_A(PG8_SA(1, 0), cA + kstep, 0, false); PG8_STAGE(PG8_SB(1, 1), cB + hstep + kstep, voffB);
        PG8_WAIT_V(6); PG8_BAR;
    } else {
        PG8_STAGE(PG8_SB(0, 0), cB, voffB); PG8_STAGE(PG8_SA(0, 0), cA, voffA); PG8_STAGE(PG8_SB(0, 1), cB + hstep, voffB); PG8_STAGE(PG8_SA(0, 1), cA + hstep, voffA);
        if (wr == 1) PG8_BAR;
        PG8_WAIT_V(4); PG8_BAR;
        PG8_STAGE(PG8_SB(1, 0), cB + kstep, voffB); PG8_STAGE(PG8_SA(1, 0), cA + kstep, voffA); PG8_STAGE(PG8_SB(1, 1), cB + hstep + kstep, voffB);
        PG8_WAIT_V(6); PG8_BAR;
    }
    for (;;) {
        const bool has_next = S.next(ui + 1, nxt);
        if constexpr (GATHER) { if (has_next) PG8_GOFF(goffN, ui + 1); else { _Pragma("unroll") for (int _h = 0; _h < 2; ++_h) _Pragma("unroll") for (int _i = 0; _i < 2; ++_i) goffN[_h][_i] = goffA[_h][_i]; } }
        const char* nA = GATHER ? (const char*)g.A : has_next ? (const char*)g.A + (size_t)nxt.pm * tstep : cA; const char* nB = has_next ? (const char*)g.Bt + (size_t)nxt.pn * tstep : cB;
        for (int t = 0; t < nt; t += 2) {
            const bool last = (t == nt - 2);
            const char* a1 = cA + (size_t)(t + 1) * kstep;
            const char* a2 = last ? nA : cA + (size_t)(t + 2) * kstep; const char* b2 = last ? nB : cB + (size_t)(t + 2) * kstep;
            const char* a3 = a2 + kstep; const char* b3 = b2 + kstep;
            if (last && has_next) S.a_ready(nxt);
            if constexpr (SP2) {
            PG8_LDB(B0, 0, 0); PG8_LDB(B1, 0, 1); PG8_SCHED; PG8_LDA(At, 0, 0); PG8_STAGE_A(PG8_SA(1, 1), a1, 1, false);
            PG8_WAIT_V(8); PG8_WAIT_L(0); PG8_BAR; PG8_MMA(0, 0, At, B0); PG8_MMA(0, 1, At, B1); PG8_BAR; PG8_SCHED;
            PG8_LDA(At, 0, 1); PG8_STAGE(PG8_SB(0, 0), b2, voffB); PG8_STAGE(PG8_SB(0, 1), b2 + hstep, voffB); PG8_STAGE_A(PG8_SA(0, 0), a2, 0, last);
            PG8_WAIT_V(8); PG8_WAIT_L(0); PG8_BAR; PG8_MMA(1, 0, At, B0); PG8_MMA(1, 1, At, B1); PG8_BAR; PG8_SCHED;
            PG8_LDB(B0, 1, 0); PG8_LDB(B1, 1, 1); PG8_SCHED; PG8_LDA(At, 1, 0); PG8_STAGE_A(PG8_SA(0, 1), a2, 1, last);
            PG8_WAIT_V(8); PG8_WAIT_L(0); PG8_BAR; PG8_MMA(0, 0, At, B0); PG8_MMA(0, 1, At, B1); PG8_BAR; PG8_SCHED;
            PG8_LDA(At, 1, 1); PG8_STAGE(PG8_SB(1, 0), b3, voffB); PG8_STAGE(PG8_SB(1, 1), b3 + hstep, voffB); PG8_STAGE_A(PG8_SA(1, 0), a3, 0, last);
            PG8_WAIT_V(8); PG8_WAIT_L(0); PG8_BAR; PG8_MMA(1, 0, At, B0); PG8_MMA(1, 1, At, B1); PG8_BAR; PG8_SCHED;
            if constexpr (Epi::NSEG > 1) {
                if (t + 2 < nt && ((t + 2) & 7) == 0) E.rescale(acc, cur, (t + 2) / 8 - 1, wr, wc, fr, fq);
            }
            } else {
            PG8_LDB(B0, 0, 0); PG8_SCHED; PG8_LDA(At, 0, 0); PG8_STAGE(PG8_SA(1, 1), a1 + hstep, voffA);
            PG8_WAIT_L(8); PG8_BAR; PG8_WAIT_L(0); PG8_MMA(0, 0, At, B0); PG8_BAR; PG8_SCHED;
            PG8_LDB(B1, 0, 1); PG8_STAGE(PG8_SB(0, 0), b2, voffB);
            PG8_BAR; PG8_WAIT_L(0); PG8_MMA(0, 1, At, B1); PG8_BAR;
            PG8_LDA(At, 0, 1); PG8_STAGE(PG8_SA(0, 0), a2, voffA);
            PG8_BAR; PG8_WAIT_L(0); PG8_MMA(1, 0, At, B0); PG8_BAR; PG8_SCHED;
            PG8_STAGE(PG8_SB(0, 1), b2 + hstep, voffB);
            PG8_WAIT_V(6); PG8_BAR; PG8_MMA(1, 1, At, B1); PG8_BAR;
            PG8_LDB(B0, 1, 0); PG8_SCHED; PG8_LDA(At, 1, 0); PG8_STAGE(PG8_SA(0, 1), a2 + hstep, voffA);
            PG8_WAIT_L(8); PG8_BAR; PG8_WAIT_L(0); PG8_MMA(0, 0, At, B0); PG8_BAR; PG8_SCHED;
            PG8_LDB(B1, 1, 1); PG8_STAGE(PG8_SB(1, 0), b3, voffB);
            PG8_BAR; PG8_WAIT_L(0); PG8_MMA(0, 1, At, B1); PG8_BAR;
            PG8_LDA(At, 1, 1); PG8_STAGE(PG8_SA(1, 0), a3, voffA);
            PG8_BAR; PG8_WAIT_L(0); PG8_MMA(1, 0, At, B0); PG8_BAR; PG8_SCHED;
            PG8_STAGE(PG8_SB(1, 1), b3 + hstep, voffB);
            PG8_WAIT_V(6); PG8_BAR; PG8_MMA(1, 1, At, B1); PG8_BAR;
            }
        }
        if constexpr (ALIGN_EPI) { if (wr == 0) PG8_BAR; }
        if constexpr (!Epi::AFTER_DRAIN) { E(acc, cur, wr, wc, fr, fq); S.done(cur); }
        if (!has_next) break;
#pragma unroll
        for (int a = 0; a < 2; ++a)
#pragma unroll
            for (int b = 0; b < 2; ++b)
#pragma unroll
                for (int m = 0; m < 4; ++m)
#pragma unroll
                    for (int n = 0; n < 2; ++n) acc[a][b][m][n] = (f32x4){0.f, 0.f, 0.f, 0.f};
        cur = nxt; cA = nA; cB = nB; ++ui;
        if constexpr (GATHER) { _Pragma("unroll") for (int _h = 0; _h < 2; ++_h) _Pragma("unroll") for (int _i = 0; _i < 2; ++_i) goffA[_h][_i] = goffN[_h][_i]; }
        if constexpr (ALIGN_EPI) { if (wr == 1) PG8_BAR; }
    }
    PG8_WAIT_V(0);
    if constexpr (!ALIGN_EPI) { if (wr == 0) PG8_BAR; }
    PG8_BAR;
    if constexpr (Epi::AFTER_DRAIN) { E.fused(acc, cur, wr, wc, fr, fq, lds, wid, lane); S.done(cur); }
#undef PG8_SA
#undef PG8_SB
#undef PG8_STAGE
#undef PG8_STAGE_A
#undef PG8_GOFF
#undef PG8_LDA
#undef PG8_LDB
#undef PG8_MMA
#undef PG8_WAIT_V
#undef PG8_WAIT_L
#undef PG8_BAR
#undef PG8_SCHED
}
}
#define XB_TMO      128
#define XB_XCNT(j)  (256  + 64 * (j))
#define XB_XSUB(j)  (1280 + 64 * (j))
#define XB_XGEN(j)  (2304 + 64 * (j))
#define XB_TOP      3328
#define XB_TOPGEN   3392
#define XCD_BAR_WORDS 3456
#define XB_SPIN_CAP (1u << 22)
#define LAS __attribute__((address_space(3)))

__device__ __forceinline__ unsigned xb_ld(unsigned* p)              { return __hip_atomic_load(p, __ATOMIC_RELAXED, __HIP_MEMORY_SCOPE_AGENT); }
__device__ __forceinline__ unsigned xb_add(unsigned* p, unsigned v) { asm volatile("" : "+v"(p));
    return __hip_atomic_fetch_add(p, v, __ATOMIC_RELAXED, __HIP_MEMORY_SCOPE_AGENT); }
__device__ __forceinline__ unsigned xb_xcc_id() { return (unsigned)__builtin_amdgcn_s_getreg((3 << 11) | 20) & 0xFu; }
#define XB_SPIN(cond, bar) do { unsigned _sp = 0; while (cond) { __builtin_amdgcn_s_sleep(1); \
    if ((++_sp & 255u) == 0u) { if (xb_ld(&(bar)[XB_TMO])) break; if (_sp > XB_SPIN_CAP) { xb_add(&(bar)[XB_TMO], 1u); break; } } } } while (0)

struct XcdBarrier {
    unsigned* bar; unsigned x; unsigned wv;
    volatile LAS unsigned* st;
};

__device__ __forceinline__ XcdBarrier xcd_barrier_post(unsigned* bar, volatile LAS unsigned* st) {
    XcdBarrier b; b.bar = bar; b.x = xb_xcc_id(); b.st = st;
    if (threadIdx.x == 0) (void)xb_add(&bar[XB_XCNT(b.x)], 1u);
    return b;
}
__device__ __forceinline__ void xcd_barrier_complete(unsigned* bar, unsigned x, unsigned& nloc, unsigned& nx) {
    const unsigned G = gridDim.x * gridDim.y * gridDim.z;
    unsigned sum, cnt, mine, sp = 0u;
    for (;;) {
        sum = 0u; cnt = 0u; mine = 0u;
#pragma unroll
        for (unsigned j = 0; j < 16; ++j) { const unsigned c = xb_ld(&bar[XB_XCNT(j)]); sum += c; cnt += (c > 0u) ? 1u : 0u; mine = (j == x) ? c : mine; }
        if (sum == G) break;
        __builtin_amdgcn_s_sleep(1);
        if ((++sp & 255u) == 0u) { if (xb_ld(&bar[XB_TMO])) break; if (sp > XB_SPIN_CAP) { xb_add(&bar[XB_TMO], 1u); break; } }
    }
    nloc = mine > 0u ? mine : 1u; nx = cnt > 0u ? cnt : 1u;
}

__device__ __forceinline__ void xcd_barrier(const XcdBarrier& b) {
    asm volatile("s_waitcnt vmcnt(0)" ::: "memory");
    __syncthreads();
    if (b.wv == 0u && lane_id() == 0) {
        unsigned* bar = b.bar;
        __builtin_amdgcn_s_waitcnt(0);
        unsigned nloc = b.st[0], nx = b.st[1];
        if (nloc == 0u) { xcd_barrier_complete(bar, b.x, nloc, nx); b.st[0] = nloc; b.st[1] = nx; }
        const unsigned old = xb_add(&bar[XB_XSUB(b.x)], 1u);
        const unsigned gen = old / nloc;
        if (old + 1u == (gen + 1u) * nloc) {
            __builtin_amdgcn_fence(__ATOMIC_RELEASE, "agent");
            asm volatile("s_waitcnt vmcnt(0)" ::: "memory");
            const unsigned og = xb_add(&bar[XB_TOP], 1u);
            const unsigned tg = og / nx;
            if (og + 1u == (tg + 1u) * nx) xb_add(&bar[XB_TOPGEN], 1u);
            else XB_SPIN(xb_ld(&bar[XB_TOPGEN]) == tg, bar);
            __builtin_amdgcn_fence(__ATOMIC_ACQUIRE, "agent");
            xb_add(&bar[XB_XGEN(b.x)], 1u);
            asm volatile("s_waitcnt vmcnt(0)" ::: "memory");
        } else {
            XB_SPIN(xb_ld(&bar[XB_XGEN(b.x)]) == gen, bar);
            __builtin_amdgcn_fence(__ATOMIC_ACQUIRE, "agent");
            asm volatile("s_waitcnt vmcnt(0)" ::: "memory");
        }
    }
    __syncthreads();
}

typedef unsigned short bf16_t;
typedef short bf16x8 __attribute__((ext_vector_type(8)));
typedef float f32x4 __attribute__((ext_vector_type(4)));
typedef float f32x16 __attribute__((ext_vector_type(16)));
typedef unsigned u32x4 __attribute__((ext_vector_type(4)));
typedef unsigned u32x2 __attribute__((ext_vector_type(2)));

constexpr int D = 1024, NB = 16, SEQ = 2048, CTX = 256, NL = 4;
constexpr int TL = NB * SEQ, TC = NB * CTX, TT = TL + TC;
constexpr int DIN = 6144, HYW = 512, NE = 16, DE = 512, KEYS = CTX + SEQ;
constexpr int NMOD = 6, NBM = NB + 1;
constexpr int APROWS = 2 * TT + NE * 256;
constexpr float EPS = 1e-6f, LOG2E = 1.4426950408889634f;
constexpr float QSCALE = 0.125f * LOG2E;

constexpr size_t MiB = 1u << 20;
constexpr size_t WS_CTL = 0, CTL_ZERO_BYTES = 1 * MiB;
constexpr size_t WS_MOD = 1 * MiB;
constexpr size_t WS_ROPE = 3 * MiB;
constexpr size_t WS_FL = 4 * MiB, WS_FC = 20 * MiB;
constexpr size_t WS_MISC = 22 * MiB;
constexpr size_t WS_FNORM = WS_MISC;
constexpr size_t WS_TOKE = WS_MISC + 64 * 1024, WS_TOKP = WS_MISC + 352 * 1024, WS_TOKW = WS_MISC + 640 * 1024;
constexpr size_t WS_ROWMAP = WS_MISC + 960 * 1024, WS_ROWW = WS_MISC + 1280 * 1024;
constexpr size_t WS_WIN = 24 * MiB, WS_WBR = 36 * MiB, WS_WOUT = 39 * MiB;
constexpr size_t WS_XC = 41 * MiB;
constexpr size_t WS_NP = WS_XC;
constexpr size_t WS_H = 57 * MiB;
constexpr size_t WS_KA = 129 * MiB, WS_VTA = 138 * MiB, WS_KW = 147 * MiB, WS_VTW = 156 * MiB;
constexpr size_t WS_QA = 165 * MiB, WS_QW = 201 * MiB, WS_YH = 237 * MiB, WS_VT = 273 * MiB, WS_YT = 309 * MiB;
constexpr size_t WS_RAWA = 309 * MiB, WS_RAWW = 327 * MiB;
constexpr size_t WS_F = 165 * MiB;
constexpr size_t WS_U = 345 * MiB;
constexpr size_t WS_G = 453 * MiB;
constexpr size_t WS_W13 = 605 * MiB, WS_W2 = 637 * MiB;
constexpr size_t WS_EROW = 669 * MiB, WS_EROWW = 672 * MiB;
constexpr size_t WS_END = 675 * MiB;
static_assert(WS_G + (size_t)APROWS * 2048 <= WS_W13 && WS_W2 + (size_t)16 * 1024 * 512 * 2 <= WS_END && WS_G + (size_t)TT * 3072 * 2 <= WS_END, "ws map");
static_assert(WS_U + (size_t)APROWS * 1024 <= WS_G && WS_F + (size_t)2 * TT * 2048 <= WS_YT, "ws map 2");
constexpr size_t VT_CTX_OFF = (size_t)HYW * NB * SEQ;

constexpr int CW_BAR = 4096, CW_CNT = 8192, CW_PANEL = 16384, CW_HTMO = 12288;
constexpr int LDS_BYTES = 151552, MISC_OFF = 147456;
constexpr int NWAVES = 8, NTHR = 512;

struct Args { const float* in[29]; float* out; unsigned char* ws; int ph_lo, ph_hi; };
enum { I_X = 0, I_C, I_CTX, I_CCTX, I_ADAW, I_ADAB, I_N1G, I_N2G, I_WIN, I_QKG, I_HSW, I_HSB, I_HW1, I_HB1, I_HFR, I_HW2, I_HB2, I_HW3, I_HBIAS, I_SINK, I_WBR, I_WOUT,
       I_RGW, I_RGB, I_REW, I_REB, I_EW1, I_EW3, I_EW2 };

#define LDS_WAIT() asm volatile("s_waitcnt lgkmcnt(0)" ::: "memory")
#define VM_WAIT() asm volatile("s_waitcnt vmcnt(0)" ::: "memory")

typedef float f32x2_t __attribute__((ext_vector_type(2)));
typedef __bf16 bf16x2_t __attribute__((ext_vector_type(2)));
__device__ __forceinline__ unsigned cvtpk(float lo, float hi) { f32x2_t v = {lo, hi}; bf16x2_t b = __builtin_convertvector(v, bf16x2_t); return __builtin_bit_cast(unsigned, b); }
__device__ __forceinline__ unsigned zero_u32() { unsigned z; asm volatile("v_mov_b32 %0, 0" : "=v"(z)); return z; }
__device__ __forceinline__ float bflo(unsigned u) { return __builtin_bit_cast(float, u << 16); }
__device__ __forceinline__ float bfhi(unsigned u) { return __builtin_bit_cast(float, u & 0xffff0000u); }
__device__ __forceinline__ float bf1(bf16_t u) { return __builtin_bit_cast(float, (unsigned)u << 16); }
__device__ __forceinline__ bf16_t f2bf(float f) { return (bf16_t)(cvtpk(f, 0.f) & 0xffffu); }
#define DPP_F(v, ctrl) __builtin_bit_cast(float, __builtin_amdgcn_update_dpp(0, __builtin_bit_cast(int, (v)), (ctrl), 0xf, 0xf, false))
__device__ __forceinline__ float row16_sum(float v) {
    v += DPP_F(v, 0xB1);
    v += DPP_F(v, 0x4E);
    v += DPP_F(v, 0x141);
    v += DPP_F(v, 0x140);
    return v;
}
__device__ __forceinline__ float wave_sum(float v) {
    v = row16_sum(v);
    const int iv = __builtin_bit_cast(int, v);
    float r = (__builtin_bit_cast(float, __builtin_amdgcn_readlane(iv, 0)) + __builtin_bit_cast(float, __builtin_amdgcn_readlane(iv, 16)))
            + (__builtin_bit_cast(float, __builtin_amdgcn_readlane(iv, 32)) + __builtin_bit_cast(float, __builtin_amdgcn_readlane(iv, 48)));
    asm volatile("" : "+v"(r));
    return r;
}
__device__ __forceinline__ float fast_exp2(float x) { return __builtin_amdgcn_exp2f(x); }
__device__ __forceinline__ float fast_rcp(float x) { return __builtin_amdgcn_rcpf(x); }
__device__ __forceinline__ float sigmoid_f(float x) { return fast_rcp(1.f + fast_exp2(-x * LOG2E)); }

__device__ __forceinline__ void sincos_acc(float x, float& s, float& c) {
    const float q = rintf(x * 0.636619772367581f);
    float y = fmaf(-q, 1.57079625129699707031f, x);
    y = fmaf(-q, 7.54978941586159635335e-08f, y);
    const float y2 = y * y;
    float sp = fmaf(y2, 2.7557314297e-06f, -1.9841270114e-04f); sp = fmaf(sp, y2, 8.3333337680e-03f); sp = fmaf(sp, y2, -1.6666667163e-01f); sp = fmaf(sp * y2, y, y);
    float cp = fmaf(y2, -2.7557314297e-07f, 2.4801587642e-05f); cp = fmaf(cp, y2, -1.3888889225e-03f); cp = fmaf(cp, y2, 4.1666667908e-02f); cp = fmaf(cp, y2, -0.5f); cp = fmaf(cp, y2, 1.0f);
    const int n = (int)q & 3;
    const float s1 = (n & 1) ? cp : sp, c1 = (n & 1) ? sp : cp;
    s = (n & 2) ? -s1 : s1;
    c = ((n + 1) & 2) ? -c1 : c1;
}

struct Fr { LAS unsigned char* lds; int tid, lane, wave, G, bid; };

__device__ __forceinline__ void pro_mod(const Fr& F, const Args& a) {
    LAS float* s = (LAS float*)F.lds;
    LAS float* red = (LAS float*)(F.lds + 69632);
    const float* c = a.in[I_C]; const float* cc = a.in[I_CCTX]; const float* W = a.in[I_ADAW]; const float* Bv = a.in[I_ADAB];
    float* MOD = (float*)(a.ws + WS_MOD);
    for (int i = F.tid; i < NBM * 1024; i += NTHR) { const int bb = i >> 10, k = i & 1023; const float v = (bb < NB) ? c[bb * 1024 + k] : cc[k]; s[i] = v / (1.f + __expf(-v)); }
    __syncthreads();
    const int col = F.tid & 63, ks = F.wave;
    for (int unit = F.G - 1 - F.bid; unit < NL * 96; unit += F.G) {
        const int l = unit / 96, j0 = (unit % 96) * 64;
        float acc[NBM];
#pragma unroll
        for (int bb = 0; bb < NBM; ++bb) acc[bb] = 0.f;
        const float* Wp = W + ((size_t)l * 1024 + ks * 128) * DIN + j0 + col;
#pragma unroll 2
        for (int k = 0; k < 128; k += 4) {
            const float w0 = Wp[(size_t)k * DIN], w1 = Wp[(size_t)(k + 1) * DIN], w2 = Wp[(size_t)(k + 2) * DIN], w3 = Wp[(size_t)(k + 3) * DIN];
#pragma unroll
            for (int bb = 0; bb < NBM; ++bb) { const f32x4 sv = *(const LAS f32x4*)(s + bb * 1024 + ks * 128 + k);
                acc[bb] = fmaf(sv.x, w0, acc[bb]); acc[bb] = fmaf(sv.y, w1, acc[bb]); acc[bb] = fmaf(sv.z, w2, acc[bb]); acc[bb] = fmaf(sv.w, w3, acc[bb]); } }
#pragma unroll
        for (int bb = 0; bb < NBM; ++bb) red[(ks * NBM + bb) * 64 + col] = acc[bb];
        __syncthreads();
        for (int o = F.tid; o < NBM * 64; o += NTHR) { const int bb = o >> 6, cx = o & 63; float sum = 0.f;
#pragma unroll
            for (int k2 = 0; k2 < 8; ++k2) sum += red[(k2 * NBM + bb) * 64 + cx];
            MOD[((size_t)l * NBM + bb) * DIN + j0 + cx] = sum + Bv[l * DIN + j0 + cx]; }
        __syncthreads();
    }
}

__device__ __forceinline__ void pro_rope(const Fr& F, const Args& a) {
    float* ct = (float*)(a.ws + WS_ROPE); float* st = ct + SEQ * 32;
    for (int i = F.bid * NTHR + F.tid; i < SEQ * 32; i += F.G * NTHR) {
        const int pos = i >> 5, ax = (i >> 4) & 1, f = i & 15;
        const float inv = exp2f(-(float)f * (13.287712379549449f / 16.f));
        const float ang = (float)(ax == 0 ? (pos >> 6) : (pos & 63)) * inv;
        float sv, cv; sincos_acc(ang, sv, cv); ct[i] = cv; st[i] = sv;
    }
}

__device__ __forceinline__ void pro_filter(const Fr& F, const Args& a) {
    LAS float* L = (LAS float*)F.lds;
    constexpr int oW1 = 0, oB1 = 2112, oFR = 2176, oB2 = 2240, oW2 = 2304, oZ = 6400, oH1 = 7552, oH2 = 9600, oW3 = 11648, oT = 19840;
    bf16_t* FL = (bf16_t*)(a.ws + WS_FL); bf16_t* FC = (bf16_t*)(a.ws + WS_FC); float* NP = (float*)(a.ws + WS_NP);
    const int p = F.tid >> 4, jj = F.tid & 15;
    for (int unit = F.bid; unit < NL * 72; unit += F.G) {
        const int l = unit / 72, ch = unit % 72; const bool lat = ch < 64; const int n = lat ? SEQ : CTX, pos0 = lat ? ch * 32 : (ch - 64) * 32;
        __syncthreads();
        for (int i = F.tid; i < 2112; i += NTHR) L[oW1 + i] = a.in[I_HW1][l * 2112 + i];
        for (int i = F.tid; i < 64; i += NTHR) { L[oB1 + i] = a.in[I_HB1][l * 64 + i]; L[oFR + i] = a.in[I_HFR][l * 64 + i]; L[oB2 + i] = a.in[I_HB2][l * 64 + i]; }
        for (int i = F.tid; i < 4096; i += NTHR) L[oW2 + i] = a.in[I_HW2][l * 4096 + i];
        const int pos = pos0 + p; const float t = (float)pos / (float)(n - 1);
        { const float band = 1e-4f + (float)jj * ((15.f - 1e-4f) / 15.f); const float ang = ((6.2831855f * band) * (float)pos) / (float)n;
          float sv, cv; sincos_acc(ang, sv, cv); L[oZ + p * 36 + 1 + jj] = cv; L[oZ + p * 36 + 17 + jj] = -sv; if (jj == 0) L[oZ + p * 36] = t; }
        __syncthreads();
        { f32x4 acc = *(const LAS f32x4*)(L + oB1 + 4 * jj);
#pragma unroll 3
          for (int i = 0; i < 33; ++i) { const float z = L[oZ + p * 36 + i]; const f32x4 w = *(const LAS f32x4*)(L + oW1 + i * 64 + 4 * jj); acc.x = fmaf(z, w.x, acc.x); acc.y = fmaf(z, w.y, acc.y); acc.z = fmaf(z, w.z, acc.z); acc.w = fmaf(z, w.w, acc.w); }
          const f32x4 fr = *(const LAS f32x4*)(L + oFR + 4 * jj); float sv, cv; f32x4 o;
          sincos_acc(fr.x * acc.x, sv, cv); o.x = sv; sincos_acc(fr.y * acc.y, sv, cv); o.y = sv; sincos_acc(fr.z * acc.z, sv, cv); o.z = sv; sincos_acc(fr.w * acc.w, sv, cv); o.w = sv;
          *(LAS f32x4*)(L + oH1 + p * 64 + 4 * jj) = o; }
        __syncthreads();
        { f32x4 acc = *(const LAS f32x4*)(L + oB2 + 4 * jj);
#pragma unroll 4
          for (int i = 0; i < 64; ++i) { const float z = L[oH1 + p * 64 + i]; const f32x4 w = *(const LAS f32x4*)(L + oW2 + i * 64 + 4 * jj); acc.x = fmaf(z, w.x, acc.x); acc.y = fmaf(z, w.y, acc.y); acc.z = fmaf(z, w.z, acc.z); acc.w = fmaf(z, w.w, acc.w); }
          const f32x4 fr = *(const LAS f32x4*)(L + oFR + 4 * jj); float sv, cv; f32x4 o;
          sincos_acc(fr.x * acc.x, sv, cv); o.x = sv; sincos_acc(fr.y * acc.y, sv, cv); o.y = sv; sincos_acc(fr.z * acc.z, sv, cv); o.z = sv; sincos_acc(fr.w * acc.w, sv, cv); o.w = sv;
          *(LAS f32x4*)(L + oH2 + p * 64 + 4 * jj) = o; }
        LAS bf16_t* T = (LAS bf16_t*)(L + oT);
#pragma unroll 1
        for (int mh = 0; mh < 1; ++mh) {
            f32x4 acc[16];
#pragma unroll
            for (int m = 0; m < 16; ++m) acc[m] = (f32x4){0.f, 0.f, 0.f, 0.f};
#pragma unroll 1
            for (int kc = 0; kc < 8; ++kc) {
                __syncthreads();
                for (int i = F.tid; i < 2048; i += NTHR) *(LAS f32x4*)(L + oW3 + i * 4) = *(const f32x4*)(a.in[I_HW3] + ((size_t)l * 64 + kc * 8) * 1024 + i * 4);
                __syncthreads();
#pragma unroll 1
                for (int k = 0; k < 8; ++k) { const float h = L[oH2 + p * 64 + kc * 8 + k];
#pragma unroll
                    for (int m = 0; m < 16; ++m) { const f32x4 w = *(const LAS f32x4*)(L + oW3 + k * 1024 + 64 * m + 4 * jj);
                        acc[m].x = fmaf(h, w.x, acc[m].x); acc[m].y = fmaf(h, w.y, acc[m].y); acc[m].z = fmaf(h, w.z, acc[m].z); acc[m].w = fmaf(h, w.w, acc[m].w); } }
            }
#pragma unroll
            for (int m = 0; m < 16; ++m) {
                const int colb = 64 * m + 4 * jj; const int dirb = m >> 3;
                const float v4[4] = {acc[m].x, acc[m].y, acc[m].z, acc[m].w};
#pragma unroll
                for (int e = 0; e < 4; ++e) { const int col = colb + e, c = col & 511;
                    const float dl = fabsf(-3.0701134573253943f + (-15.350567286626972f + 3.0701134573253943f) * ((float)c / 511.f));
                    float v = v4[e] * __expf(-t * dl); if (dirb == 1 && pos == 0) v = 0.f;
                    T[col * 32 + (dirb == 0 ? 31 - p : p)] = f2bf(v); }
            }
        }
        __syncthreads();
        for (int idx = F.tid; idx < 1024 * 32; idx += NTHR) { const int col = idx >> 5, i = idx & 31, dir = col >> 9, c = col & 511;
            const int u = (dir == 0) ? (n - 32 - pos0 + i) : ((pos0 + i == 0) ? 2 * n - 1 : n - 1 + pos0 + i);
            bf16_t* Fb = lat ? FL + ((size_t)l * 512 + c) * 4096 : FC + ((size_t)l * 512 + c) * 512;
            Fb[u] = T[col * 32 + i]; }
        for (int col = F.tid; col < 1024; col += NTHR) { float sum = 0.f;
#pragma unroll 8
            for (int i = 0; i < 32; ++i) sum += fabsf(bf1(T[col * 32 + i]));
            NP[((size_t)l * 72 + ch) * 1024 + col] = sum; }
    }
    __syncthreads();
}
__device__ __forceinline__ void filter_norm_reduce(const Fr& F, const Args& a) {
    const float* NP = (const float*)(a.ws + WS_NP); float* FN = (float*)(a.ws + WS_FNORM);
    for (int o = F.bid * NTHR + F.tid; o < NL * 2 * 512; o += F.G * NTHR) { const int l = o >> 10, isc = (o >> 9) & 1, c = o & 511;
        const int ch0 = isc ? 64 : 0, ch1 = isc ? 72 : 64; float sum = 0.f;
        for (int ch = ch0; ch < ch1; ++ch) sum += NP[((size_t)l * 72 + ch) * 1024 + c] + NP[((size_t)l * 72 + ch) * 1024 + 512 + c];
        FN[o] = 1.f / sum; }
}

template <int MODE>
__device__ __forceinline__ void transpose_item(const float* W, int K, int N, bf16_t* WT, int row_off, LAS float* scr, int item, int lane, int ldk = 0) {
    if (ldk == 0) ldk = K;
    const int nblk = N / 64, kb = item / nblk, nb = item % nblk, k0 = 64 * kb, n0 = 64 * nb;
    f32x4 v[16];
#pragma unroll
    for (int i = 0; i < 16; ++i) v[i] = *(const f32x4*)(W + (size_t)(k0 + 4 * i + (lane >> 4)) * N + n0 + (lane & 15) * 4);
#pragma unroll
    for (int i = 0; i < 16; ++i) *(LAS f32x4*)(scr + (4 * i + (lane >> 4)) * 68 + (lane & 15) * 4) = v[i];
    LDS_WAIT();
    const int c = lane & 7;
#pragma unroll
    for (int j = 0; j < 8; ++j) { const int n = (lane >> 3) + 8 * j; const LAS float* s = scr + (8 * c) * 68 + n;
        u32x4 o; o.x = cvtpk(s[0 * 68], s[1 * 68]); o.y = cvtpk(s[2 * 68], s[3 * 68]); o.z = cvtpk(s[4 * 68], s[5 * 68]); o.w = cvtpk(s[6 * 68], s[7 * 68]);
        const int nn = n0 + n; const int row = (MODE == 0) ? nn : ((nn >> 2) * 8 + (nn & 3) + (MODE == 2 ? 4 : 0));
        *(u32x4*)(WT + (size_t)(row_off + row) * ldk + k0 + 8 * c) = o; }
    LDS_WAIT();
}

__device__ __forceinline__ void conv_small_weights(const Fr& F, const Args& a, int l, int mask, int b0) {
    if (F.bid < b0) return;
    LAS float* scr = (LAS float*)(F.lds + F.wave * 17408);
    const int gw = (F.bid - b0) * NWAVES + F.wave, NGW = (F.G - b0) * NWAVES;
    constexpr int I_IN = (1024 / 64) * (DIN / 64), I_BR = (512 / 64) * (1024 / 64), I_OUT = (1024 / 64) * (1024 / 64);
    if (mask & 1) for (int it = gw; it < I_IN; it += NGW) transpose_item<0>(a.in[I_WIN] + (size_t)l * 1024 * DIN, 1024, DIN, (bf16_t*)(a.ws + WS_WIN), 0, scr, it, F.lane);
    if (mask & 2) for (int it = gw; it < 3 * I_BR; it += NGW) { const int b = it / I_BR; transpose_item<0>(a.in[I_WBR] + ((size_t)l * 3 + b) * 512 * 1024, 512, 1024, (bf16_t*)(a.ws + WS_WBR) + b * 512, 0, scr, it % I_BR, F.lane, 1536); }
    if (mask & 4) for (int it = gw; it < I_OUT; it += NGW) transpose_item<0>(a.in[I_WOUT] + (size_t)l * 1024 * 1024, 1024, 1024, (bf16_t*)(a.ws + WS_WOUT), 0, scr, it, F.lane);
}
__device__ __forceinline__ void conv_expert_weights(const Fr& F, const Args& a, int l, int b0, int it0, int it1) {
    if (F.bid < b0) return;
    LAS float* scr = (LAS float*)(F.lds + F.wave * 17408);
    const int gw = (F.bid - b0) * NWAVES + F.wave, NGW = (F.G - b0) * NWAVES;
    constexpr int I_1 = (1024 / 64) * (512 / 64), I_2 = (512 / 64) * (1024 / 64);
    for (int it = it0 + gw; it < it1; it += NGW) {
        const int e = it / (2 * I_1 + I_2); int r = it % (2 * I_1 + I_2);
        bf16_t* W13 = (bf16_t*)(a.ws + WS_W13); bf16_t* W2 = (bf16_t*)(a.ws + WS_W2);
        if (r < I_1) { transpose_item<1>(a.in[I_EW1] + ((size_t)l * NE + e) * 1024 * 512, 1024, 512, W13, e * 1024, scr, r, F.lane); continue; } r -= I_1;
        if (r < I_1) { transpose_item<2>(a.in[I_EW3] + ((size_t)l * NE + e) * 1024 * 512, 1024, 512, W13, e * 1024, scr, r, F.lane); continue; } r -= I_1;
        transpose_item<0>(a.in[I_EW2] + ((size_t)l * NE + e) * 512 * 1024, 512, 1024, W2, e * 1024, scr, r, F.lane);
    }
}
constexpr int CONV_E_ITEMS = NE * 384, CONV_E_SPLIT = CONV_E_ITEMS / 2;

__device__ __forceinline__ int mod_row(int row) { return row < TL ? (row >> 11) : NB; }

__device__ __forceinline__ void rows_p0(const Fr& F, const Args& a, int l, int nrows) {
    const int gw = F.bid * NWAVES + F.wave, NGW = F.G * NWAVES;
    const float* g1 = a.in[I_N1G] + l * 1024;
    const float* MODl = (const float*)(a.ws + WS_MOD) + (size_t)l * NBM * DIN;
    const float* MODp = (const float*)(a.ws + WS_MOD) + (size_t)(l > 0 ? l - 1 : 0) * NBM * DIN;
    const bf16_t* Fs = (const bf16_t*)(a.ws + WS_F);
    bf16_t* H = (bf16_t*)(a.ws + WS_H);
    const int per = 2 * ((nrows + 2 * NGW - 1) / (2 * NGW)), w0 = gw * per, w1 = (w0 + per < nrows) ? w0 + per : nrows;
    f32x4 gv[4], shv[4], scv[4], m5v[4]; int cur = -1;
#pragma unroll
    for (int j = 0; j < 4; ++j) { gv[j] = *(const f32x4*)(g1 + F.lane * 4 + 256 * j); shv[j] = gv[j]; scv[j] = gv[j]; m5v[j] = gv[j]; }
#define P0_LOAD(rb, V, F0, F1) do { _Pragma("unroll") for (int q = 0; q < 2; ++q) { const int row = (rb) + q; const bool lat = row < TL; \
            const float* xs = lat ? ((l == 0) ? a.in[I_X] + (size_t)row * D : a.out + (size_t)row * D) : ((l == 0) ? a.in[I_CTX] + (size_t)(row - TL) * D : (const float*)(a.ws + WS_XC) + (size_t)(row - TL) * D); \
            _Pragma("unroll") for (int j = 0; j < 4; ++j) { const int col = F.lane * 4 + 256 * j; V[q][j] = *(const f32x4*)(xs + col); \
                if (l > 0) { F0[q][j] = *(const u32x2*)(Fs + (size_t)row * D + col); F1[q][j] = *(const u32x2*)(Fs + ((size_t)TT + row) * D + col); } } } } while (0)
#define P0_PROC(rb, V, F0, F1) do { _Pragma("unroll") for (int q = 0; q < 2; ++q) { const int row = (rb) + q; const bool lat = row < TL; const int mr = mod_row(row); \
            if (mr != cur) { cur = mr; _Pragma("unroll") for (int j = 0; j < 4; ++j) { const int col = F.lane * 4 + 256 * j; \
                shv[j] = *(const f32x4*)(MODl + (size_t)mr * DIN + col); scv[j] = *(const f32x4*)(MODl + (size_t)mr * DIN + 1024 + col); m5v[j] = *(const f32x4*)(MODp + (size_t)mr * DIN + 5 * 1024 + col); } } \
            float* xd = lat ? a.out + (size_t)row * D : (float*)(a.ws + WS_XC) + (size_t)(row - TL) * D; float ss = 0.f; \
            if (l > 0) { _Pragma("unroll") for (int j = 0; j < 4; ++j) { const int col = F.lane * 4 + 256 * j; \
                    V[q][j].x += m5v[j].x * (bflo(F0[q][j].x) + bflo(F1[q][j].x)); V[q][j].y += m5v[j].y * (bfhi(F0[q][j].x) + bfhi(F1[q][j].x)); \
                    V[q][j].z += m5v[j].z * (bflo(F0[q][j].y) + bflo(F1[q][j].y)); V[q][j].w += m5v[j].w * (bfhi(F0[q][j].y) + bfhi(F1[q][j].y)); \
                    *(f32x4*)(xd + col) = V[q][j]; } } \
            _Pragma("unroll") for (int j = 0; j < 4; ++j) ss += (V[q][j].x * V[q][j].x + V[q][j].y * V[q][j].y) + (V[q][j].z * V[q][j].z + V[q][j].w * V[q][j].w); \
            const float r = 1.f / sqrtf(wave_sum(ss) * (1.f / D) + EPS); \
            _Pragma("unroll") for (int j = 0; j < 4; ++j) { const int col = F.lane * 4 + 256 * j; \
                const f32x4 o = (V[q][j] * r * gv[j]) * (scv[j] + 1.f) + shv[j]; \
                u32x2 w; w.x = cvtpk(o.x, o.y); w.y = cvtpk(o.z, o.w); \
                *(u32x2*)(H + (size_t)row * D + col) = w; } } } while (0)
    f32x4 vA[2][4], vB[2][4]; u32x2 fA0[2][4], fA1[2][4], fB0[2][4], fB1[2][4];
    if (w0 < w1) P0_LOAD(w0, vA, fA0, fA1);
    for (int rb = w0; rb < w1; rb += 4) {
        if (rb + 2 < w1) P0_LOAD(rb + 2, vB, fB0, fB1);
        P0_PROC(rb, vA, fA0, fA1);
        if (rb + 2 < w1) { if (rb + 4 < w1) P0_LOAD(rb + 4, vA, fA0, fA1); P0_PROC(rb + 2, vB, fB0, fB1); }
    }
#undef P0_LOAD
#undef P0_PROC
}
__device__ __forceinline__ void rows_final(const Fr& F, const Args& a) {
    const int gw = F.bid * NWAVES + F.wave, NGW = F.G * NWAVES;
    const float* MODp = (const float*)(a.ws + WS_MOD) + (size_t)(NL - 1) * NBM * DIN;
    const bf16_t* Fs = (const bf16_t*)(a.ws + WS_F);
    for (int row = gw; row < TL; row += NGW) {
        const int mr = row >> 11; float* xd = a.out + (size_t)row * D;
#pragma unroll
        for (int j = 0; j < 4; ++j) { const int col = F.lane * 4 + 256 * j;
            f32x4 v = *(const f32x4*)(xd + col);
            const u32x2 f0 = *(const u32x2*)(Fs + (size_t)row * D + col), f1 = *(const u32x2*)(Fs + ((size_t)TT + row) * D + col);
            const f32x4 m5 = *(const f32x4*)(MODp + (size_t)mr * DIN + 5 * 1024 + col);
            v.x += m5.x * (bflo(f0.x) + bflo(f1.x)); v.y += m5.y * (bfhi(f0.x) + bfhi(f1.x)); v.z += m5.z * (bflo(f0.y) + bflo(f1.y)); v.w += m5.w * (bfhi(f0.y) + bfhi(f1.y));
            *(f32x4*)(xd + col) = v; }
    }
}

__device__ __forceinline__ void rows_p5(const Fr& F, const Args& a, int l, int nrows, unsigned long long& sacc, const int swhich) {
#if defined(PROBE_P)
    unsigned long long st0 = __builtin_amdgcn_s_memrealtime();
#define SUBMARK5(w) do { const unsigned long long t_ = __builtin_amdgcn_s_memrealtime(); if (swhich == (w)) sacc += t_ - st0; st0 = t_; } while (0)
#else
#define SUBMARK5(w) do { } while (0)
#endif
    typedef float f32x4v __attribute__((ext_vector_type(4)));
    LAS float* RW = (LAS float*)F.lds;
    constexpr int RWS = 1028;
    LAS float* RB = (LAS float*)(F.lds + 82304);
    LAS int* LC = (LAS int*)(F.lds + 82432);
    LAS int* TE = (LAS int*)(F.lds + 82560);
    LAS int* TP = TE + 256;
    LAS float* TW = (LAS float*)(TP + 256);
    LAS float* RN = (LAS float*)(F.lds + 86784);
    LAS float* LG = (LAS float*)(F.lds + 87424);
    LAS float* GM = (LAS float*)(F.lds + 99072);
    LAS float* BI = (LAS float*)(F.lds + 107264);
    const float* g2 = a.in[I_N2G] + l * 1024;
    const float* MODl = (const float*)(a.ws + WS_MOD) + (size_t)l * NBM * DIN;
    bf16_t* H = (bf16_t*)(a.ws + WS_H);
    int* EROW = (int*)(a.ws + WS_EROW); float* EROWW = (float*)(a.ws + WS_EROWW);
    unsigned* CNT = (unsigned*)(a.ws + WS_CTL) + CW_CNT + l * 256;
    for (int f = F.tid; f < 1024; f += NTHR) { const f32x4 v = *(const f32x4*)(a.in[I_RGW] + ((size_t)l * 1024 + f) * 4);
        RW[0 * RWS + f] = v.x; RW[1 * RWS + f] = v.y; RW[2 * RWS + f] = v.z; RW[3 * RWS + f] = v.w; }
    for (int f = F.tid; f < 4096; f += NTHR) { const int k = f >> 2, c4 = (f & 3) * 4; const f32x4 v = *(const f32x4*)(a.in[I_REW] + ((size_t)l * 1024 + k) * 16 + c4);
        RW[(4 + c4) * RWS + k] = v.x; RW[(5 + c4) * RWS + k] = v.y; RW[(6 + c4) * RWS + k] = v.z; RW[(7 + c4) * RWS + k] = v.w; }
    if (F.tid < 20) RB[F.tid] = (F.tid < 4) ? a.in[I_RGB][l * 4 + F.tid] : a.in[I_REB][l * 16 + F.tid - 4];
    constexpr int P5_CH = 144;
    const int nch = (nrows + P5_CH - 1) / P5_CH;
    SUBMARK5(40);
    for (int ch = F.bid; ch < nch; ch += F.G) {
    const int r0 = ch * P5_CH, r1 = (r0 + P5_CH < nrows) ? r0 + P5_CH : nrows;
    const int mb0 = mod_row(r0), mb1 = mod_row(r1 - 1);
    if (F.tid < 32) LC[F.tid] = 0;
    for (int i = F.tid; i < 2048; i += NTHR) { const int s = i >> 10, k = i & 1023; GM[i] = g2[k] * (1.f + MODl[(size_t)(s ? mb1 : mb0) * DIN + 4 * 1024 + k]); }
    __syncthreads();
    if (F.wave < 4) {
    for (int rowb = r0 + 2 * F.wave; rowb < r1; rowb += 2 * 4) {
        f32x4 v[2][4]; bool val[2];
#pragma unroll
        for (int q = 0; q < 2; ++q) { const int row = rowb + q; val[q] = row < r1; const int rr = val[q] ? row : rowb;
            const bool lat = rr < TL; const float* xs = lat ? a.out + (size_t)rr * D : (const float*)(a.ws + WS_XC) + (size_t)(rr - TL) * D;
#pragma unroll
            for (int j = 0; j < 4; ++j) v[q][j] = *(const f32x4*)(xs + F.lane * 4 + 256 * j); }
#pragma unroll
        for (int q = 0; q < 2; ++q) { const int rr = val[q] ? rowb + q : rowb; const int mr = mod_row(rr); float ss = 0.f;
#pragma unroll
            for (int j = 0; j < 4; ++j) ss += (v[q][j].x * v[q][j].x + v[q][j].y * v[q][j].y) + (v[q][j].z * v[q][j].z + v[q][j].w * v[q][j].w);
            const float r = 1.f / sqrtf(wave_sum(ss) * (1.f / D) + EPS);
            if (F.lane == 0 && val[q]) RN[rr - r0] = r;
#pragma unroll
            for (int j = 0; j < 4; ++j) { const int col = F.lane * 4 + 256 * j;
                const f32x4 g = *(const f32x4*)(g2 + col), sh = *(const f32x4*)(MODl + (size_t)mr * DIN + 3 * 1024 + col), sc = *(const f32x4*)(MODl + (size_t)mr * DIN + 4 * 1024 + col);
                const f32x4 t = (v[q][j] * r * g) * (sc + 1.f) + sh;
                u32x2 w; w.x = cvtpk(t.x, t.y); w.y = cvtpk(t.z, t.w);
                if (val[q]) *(u32x2*)(H + (size_t)rr * D + col) = w; } }
    }
    } else {
    if (F.wave < 6) { const int sl = F.wave - 4; const int mb = sl ? mb1 : mb0; f32x4 sh[4];
#pragma unroll
        for (int j = 0; j < 4; ++j) sh[j] = *(const f32x4*)(MODl + (size_t)mb * DIN + 3 * 1024 + F.lane * 4 + 256 * j);
#pragma unroll 4
        for (int cidx = 0; cidx < 20; ++cidx) { float p = 0.f;
#pragma unroll
            for (int j = 0; j < 4; ++j) { const f32x4 w = *(const LAS f32x4*)(RW + cidx * RWS + F.lane * 4 + 256 * j);
                p = fmaf(sh[j].x, w.x, p); p = fmaf(sh[j].y, w.y, p); p = fmaf(sh[j].z, w.z, p); p = fmaf(sh[j].w, w.w, p); }
            const float tot = wave_sum(p) + RB[cidx]; if (F.lane == 0) BI[sl * 20 + cidx] = tot; } }
    { const int i16 = F.lane & 15, kq = F.lane >> 4; const int ngrp = (r1 - r0 + 15) >> 4;
      for (int gi = F.wave - 4; gi < ngrp; gi += 4) {
        const int grow = r0 + 16 * gi; const int rowi = (grow + i16 < r1) ? grow + i16 : r1 - 1;
        const bool lat = rowi < TL; const float* xs = (lat ? a.out + (size_t)rowi * D : (const float*)(a.ws + WS_XC) + (size_t)(rowi - TL) * D) + 4 * kq;
        const int slot = (mod_row(grow) == mb0) ? 0 : 1;
        const LAS float* gmp = GM + slot * 1024 + 4 * kq; const LAS float* w0p = RW + i16 * RWS + 4 * kq; const LAS float* w1p = RW + (16 + (i16 & 3)) * RWS + 4 * kq;
        const float m1 = (i16 < 4) ? 1.f : 0.f;
        f32x4v acc0 = {0.f, 0.f, 0.f, 0.f}, acc1 = {0.f, 0.f, 0.f, 0.f};
#pragma unroll 16
        for (int s = 0; s < 64; ++s) {
            const f32x4 xv = *(const f32x4*)(xs + 16 * s); const f32x4 gv = *(const LAS f32x4*)(gmp + 16 * s);
            const f32x4 wa = *(const LAS f32x4*)(w0p + 16 * s), wb = *(const LAS f32x4*)(w1p + 16 * s);
            const f32x4 ba = wa * gv, bb = wb * gv * m1;
            acc0 = __builtin_amdgcn_mfma_f32_16x16x4f32(xv.x, ba.x, acc0, 0, 0, 0); acc1 = __builtin_amdgcn_mfma_f32_16x16x4f32(xv.x, bb.x, acc1, 0, 0, 0);
            acc0 = __builtin_amdgcn_mfma_f32_16x16x4f32(xv.y, ba.y, acc0, 0, 0, 0); acc1 = __builtin_amdgcn_mfma_f32_16x16x4f32(xv.y, bb.y, acc1, 0, 0, 0);
            acc0 = __builtin_amdgcn_mfma_f32_16x16x4f32(xv.z, ba.z, acc0, 0, 0, 0); acc1 = __builtin_amdgcn_mfma_f32_16x16x4f32(xv.z, bb.z, acc1, 0, 0, 0);
            acc0 = __builtin_amdgcn_mfma_f32_16x16x4f32(xv.w, ba.w, acc0, 0, 0, 0); acc1 = __builtin_amdgcn_mfma_f32_16x16x4f32(xv.w, bb.w, acc1, 0, 0, 0);
        }
#pragma unroll
        for (int rg = 0; rg < 4; ++rg) { const int lr = 16 * gi + 4 * kq + rg;
            if (r0 + lr < r1) { LG[lr * 20 + i16] = acc0[rg]; if (i16 < 4) LG[lr * 20 + 16 + i16] = acc1[rg]; } }
      } }
    }
    __syncthreads();
    SUBMARK5(42);
    for (int lr = F.tid; lr < r1 - r0; lr += NTHR) {
        float lg[20]; { const float rn = RN[lr]; const int sl = (mod_row(r0 + lr) == mb0) ? 0 : 1;
#pragma unroll
          for (int i = 0; i < 20; ++i) lg[i] = rn * LG[lr * 20 + i] + BI[sl * 20 + i]; }
        int gs = 0; float gmx = lg[0];
#pragma unroll
        for (int i = 1; i < 4; ++i) if (lg[i] > gmx) { gmx = lg[i]; gs = i; }
        float gsum = 0.f;
#pragma unroll
        for (int i = 0; i < 4; ++i) gsum += __expf(lg[i] - gmx);
        const float pg = 1.f / gsum;
        float le[4];
#pragma unroll
        for (int i = 0; i < 4; ++i) le[i] = (gs == 0) ? lg[4 + i] : (gs == 1) ? lg[8 + i] : (gs == 2) ? lg[12 + i] : lg[16 + i];
        int i0 = 0; float v0 = le[0];
#pragma unroll
        for (int i = 1; i < 4; ++i) if (le[i] > v0) { v0 = le[i]; i0 = i; }
        int i1 = -1; float v1 = -3.4e38f;
#pragma unroll
        for (int i = 0; i < 4; ++i) if (i != i0 && le[i] > v1) { v1 = le[i]; i1 = i; }
        const float e1 = __expf(v1 - v0), den = 1.f / (1.f + e1);
        const int ex0 = gs * 4 + i0, ex1 = gs * 4 + i1;
        const int lp0 = __hip_atomic_fetch_add(&LC[ex0], 1, __ATOMIC_RELAXED, __HIP_MEMORY_SCOPE_WORKGROUP), lp1 = __hip_atomic_fetch_add(&LC[ex1], 1, __ATOMIC_RELAXED, __HIP_MEMORY_SCOPE_WORKGROUP);
        TE[lr] = ex0 | (ex1 << 8); TP[lr] = lp0 | (lp1 << 16); TW[2 * lr] = den * pg; TW[2 * lr + 1] = e1 * den * pg;
    }
    __syncthreads();
    if (F.tid < NE) LC[16 + F.tid] = (int)atomicAdd(&CNT[F.tid * 16], (unsigned)LC[F.tid]);
    __syncthreads();
    for (int lr = F.tid; lr < r1 - r0; lr += NTHR) {
        const int te = TE[lr], tp = TP[lr], ex0 = te & 255, ex1 = te >> 8, row = r0 + lr;
        const int gp0 = LC[16 + ex0] + (tp & 0xffff), gp1 = LC[16 + ex1] + (tp >> 16);
        EROW[(size_t)ex0 * TT + gp0] = row * 2; EROWW[(size_t)ex0 * TT + gp0] = TW[2 * lr];
        EROW[(size_t)ex1 * TT + gp1] = row * 2 + 1; EROWW[(size_t)ex1 * TT + gp1] = TW[2 * lr + 1];
    }
    __syncthreads();
    SUBMARK5(43);
    }
    __syncthreads();
#undef SUBMARK5
}

__device__ __forceinline__ void normrope8(float (&x)[8], const float* g64, bool rope, int pos, const float* ct, const float* st, float scale, int lane) {
    float ss = 0.f;
#pragma unroll
    for (int i = 0; i < 8; ++i) ss += x[i] * x[i];
    ss += DPP_F(ss, 0xB1); ss += DPP_F(ss, 0x4E); ss += DPP_F(ss, 0x141);
    const float r = 1.f / sqrtf(ss * (1.f / 64.f) + EPS);
    const int ch = lane & 7;
    const f32x4 g0 = *(const f32x4*)(g64 + 8 * ch), g1 = *(const f32x4*)(g64 + 8 * ch + 4);
    x[0] *= r * g0.x; x[1] *= r * g0.y; x[2] *= r * g0.z; x[3] *= r * g0.w; x[4] *= r * g1.x; x[5] *= r * g1.y; x[6] *= r * g1.z; x[7] *= r * g1.w;
    if (rope) {
        const int ax = ch >> 2, half = (ch >> 1) & 1, f0 = 8 * (ch & 1);
        const f32x4 c0 = *(const f32x4*)(ct + pos * 32 + ax * 16 + f0), c1 = *(const f32x4*)(ct + pos * 32 + ax * 16 + f0 + 4);
        const f32x4 s0 = *(const f32x4*)(st + pos * 32 + ax * 16 + f0), s1 = *(const f32x4*)(st + pos * 32 + ax * 16 + f0 + 4);
        const float cs[8] = {c0.x, c0.y, c0.z, c0.w, c1.x, c1.y, c1.z, c1.w}, sn[8] = {s0.x, s0.y, s0.z, s0.w, s1.x, s1.y, s1.z, s1.w};
#pragma unroll
        for (int i = 0; i < 8; ++i) { const float p = DPP_F(x[i], 0x4E);
            x[i] = half ? (x[i] * cs[i] + p * sn[i]) : (x[i] * cs[i] - p * sn[i]); }
    }
#pragma unroll
    for (int i = 0; i < 8; ++i) x[i] *= scale;
}
__device__ __forceinline__ void unpack8(const u32x4 w, float (&x)[8]) { x[0] = bflo(w.x); x[1] = bfhi(w.x); x[2] = bflo(w.y); x[3] = bfhi(w.y); x[4] = bflo(w.z); x[5] = bfhi(w.z); x[6] = bflo(w.w); x[7] = bfhi(w.w); }
__device__ __forceinline__ u32x4 pack8(const float (&x)[8]) { u32x4 w; w.x = cvtpk(x[0], x[1]); w.y = cvtpk(x[2], x[3]); w.z = cvtpk(x[4], x[5]); w.w = cvtpk(x[6], x[7]); return w; }

__device__ __forceinline__ void prep_phase(const Fr& F, const Args& a, int l, bool with_ctx) {
    constexpr int VROW = 272;
    LAS unsigned char* VA_l = F.lds;
    LAS unsigned char* VW_l = F.lds + 17408;
    LAS unsigned char* HT_l = F.lds + 34816;
    constexpr int HROW = 144;
    const float* ct = (const float*)(a.ws + WS_ROPE); const float* st = ct + SEQ * 32;
    const float* qkg = a.in[I_QKG] + l * 256;
    const bf16_t* RAWA = (const bf16_t*)(a.ws + WS_RAWA); const bf16_t* RAWW = (const bf16_t*)(a.ws + WS_RAWW);
    bf16_t* KA = (bf16_t*)(a.ws + WS_KA); bf16_t* KW = (bf16_t*)(a.ws + WS_KW); bf16_t* VTA = (bf16_t*)(a.ws + WS_VTA); bf16_t* VTW = (bf16_t*)(a.ws + WS_VTW);
    const bf16_t* U = (const bf16_t*)(a.ws + WS_U); bf16_t* X0 = (bf16_t*)(a.ws + WS_H); bf16_t* VT = (bf16_t*)(a.ws + WS_VT);
    const float* hsw = a.in[I_HSW] + l * 3 * 1536; const float* hsb = a.in[I_HSB] + l * 1536;
    for (int unit = F.bid; unit < NB * 36; unit += F.G) {
        const bool lat = unit < NB * 32;
        const int b = lat ? unit >> 5 : (unit - NB * 32) >> 2, p0 = lat ? (unit & 31) * 64 : ((unit - NB * 32) & 3) * 64;
        const int n = lat ? SEQ : CTX;
        const int row0 = lat ? b * SEQ + p0 : TL + b * CTX + p0;
        const int j0 = lat ? CTX + p0 : p0;
        __syncthreads();
        {
            const bool isw = (F.lane & 16) != 0; const int l16 = F.lane & 15, half = F.lane >> 5;
            u32x4 kw[4];
#pragma unroll
            for (int ps = 0; ps < 4; ++ps) { const int tk = 8 * F.wave + 2 * ps + half; kw[ps] = *(const u32x4*)((isw ? RAWW : RAWA) + (size_t)(row0 + tk) * 256 + l16 * 8); }
#pragma unroll
            for (int ps = 0; ps < 4; ++ps) { const int tk = 8 * F.wave + 2 * ps + half; float x[8]; unpack8(kw[ps], x);
                normrope8(x, qkg + (isw ? 192 : 64), lat, p0 + tk, ct, st, 1.f, F.lane);
                *(u32x4*)((isw ? KW : KA) + ((size_t)b * KEYS + j0 + tk) * 128 + l16 * 8) = pack8(x); }
        }
        for (int i = F.tid; i < 2 * 64 * 16; i += NTHR) { const int m = i >> 10, r = (i >> 4) & 63, cch = i & 15;
            const u32x4 w = *(const u32x4*)((m ? RAWW : RAWA) + (size_t)(row0 + r) * 256 + 128 + cch * 8);
            *(LAS u32x4*)((m ? VW_l : VA_l) + r * VROW + cch * 16) = w; }
        const bool do_hy = lat || with_ctx;
        if (do_hy) {
            const int cg = F.tid & 63, c = 8 * cg, t0 = 8 * F.wave;
            u32x4 x1p[8];
#pragma unroll
            for (int g = 0; g < 3; ++g) {
                const int ch = g * 512 + c;
                float w0[8], w1[8], w2[8], bb[8];
                { const f32x4 a0 = *(const f32x4*)(hsw + ch), a1 = *(const f32x4*)(hsw + ch + 4), b0 = *(const f32x4*)(hsw + 1536 + ch), b1 = *(const f32x4*)(hsw + 1536 + ch + 4),
                              c0 = *(const f32x4*)(hsw + 3072 + ch), c1 = *(const f32x4*)(hsw + 3072 + ch + 4), d0 = *(const f32x4*)(hsb + ch), d1 = *(const f32x4*)(hsb + ch + 4);
                  w0[0] = a0.x; w0[1] = a0.y; w0[2] = a0.z; w0[3] = a0.w; w0[4] = a1.x; w0[5] = a1.y; w0[6] = a1.z; w0[7] = a1.w;
                  w1[0] = b0.x; w1[1] = b0.y; w1[2] = b0.z; w1[3] = b0.w; w1[4] = b1.x; w1[5] = b1.y; w1[6] = b1.z; w1[7] = b1.w;
                  w2[0] = c0.x; w2[1] = c0.y; w2[2] = c0.z; w2[3] = c0.w; w2[4] = c1.x; w2[5] = c1.y; w2[6] = c1.z; w2[7] = c1.w;
                  bb[0] = d0.x; bb[1] = d0.y; bb[2] = d0.z; bb[3] = d0.w; bb[4] = d1.x; bb[5] = d1.y; bb[6] = d1.z; bb[7] = d1.w; }
                u32x4 raw[10];
#pragma unroll
                for (int i = 0; i < 10; ++i) { const int pos = p0 + t0 - 1 + i;
                    if (pos < 0 || pos >= n) { const unsigned z = zero_u32(); raw[i] = (u32x4){z, z, z, z}; } else raw[i] = *(const u32x4*)(U + (size_t)(row0 - p0 + pos) * 1536 + ch); }
#pragma unroll
                for (int t = 0; t < 8; ++t) { float up[8], uc[8], un[8], o[8]; unpack8(raw[t], up); unpack8(raw[t + 1], uc); unpack8(raw[t + 2], un);
#pragma unroll
                    for (int i = 0; i < 8; ++i) o[i] = fmaf(w0[i], up[i], fmaf(w1[i], uc[i], fmaf(w2[i], un[i], bb[i])));
                    if (g == 0) *(u32x4*)(X0 + (size_t)(row0 + t0 + t) * 512 + c) = pack8(o);
                    else if (g == 1) x1p[t] = pack8(o);
                    else { float x1[8]; unpack8(x1p[t], x1);
#pragma unroll
                        for (int i = 0; i < 8; ++i) o[i] *= x1[i];
                        x1p[t] = pack8(o); } }
            }
#pragma unroll
            for (int i = 0; i < 8; ++i) { unsigned short ev[8];
#pragma unroll
                for (int t = 0; t < 8; ++t) { const unsigned wsel = (i >> 1) == 0 ? x1p[t].x : (i >> 1) == 1 ? x1p[t].y : (i >> 1) == 2 ? x1p[t].z : x1p[t].w; ev[t] = (unsigned short)((i & 1) ? (wsel >> 16) : (wsel & 0xffffu)); }
                u32x4 w; w.x = ev[0] | ((unsigned)ev[1] << 16); w.y = ev[2] | ((unsigned)ev[3] << 16); w.z = ev[4] | ((unsigned)ev[5] << 16); w.w = ev[6] | ((unsigned)ev[7] << 16);
                *(LAS u32x4*)(HT_l + (c + i) * HROW + t0 * 2) = w; }
        }
        __syncthreads();
        for (int i = F.tid; i < 2 * 128 * 8; i += NTHR) { const int m = i >> 10, rr = (i >> 3) & 127, c8 = i & 7;
            LAS unsigned char* T = m ? VW_l : VA_l; unsigned short e[8];
#pragma unroll
            for (int jj = 0; jj < 8; ++jj) { const int key = 16 * (c8 >> 1) + 8 * (jj >> 2) + 4 * (c8 & 1) + (jj & 3); e[jj] = *(const LAS bf16_t*)(T + key * VROW + rr * 2); }
            u32x4 w; w.x = e[0] | ((unsigned)e[1] << 16); w.y = e[2] | ((unsigned)e[3] << 16); w.z = e[4] | ((unsigned)e[5] << 16); w.w = e[6] | ((unsigned)e[7] << 16);
            *(u32x4*)((m ? VTW : VTA) + ((size_t)(b * 2 + (rr >> 6)) * 64 + (rr & 63)) * KEYS + j0 + c8 * 8) = w; }
        if (do_hy) { bf16_t* VTb = lat ? VT : VT + VT_CTX_OFF;
          for (int i = F.tid; i < 512 * 8; i += NTHR) { const int cch = i >> 3, c8 = i & 7;
              const u32x4 w = *(const LAS u32x4*)(HT_l + cch * HROW + c8 * 16);
              *(u32x4*)(VTb + ((size_t)cch * NB + b) * n + p0 + c8 * 8) = w; } }
    }
    __syncthreads();
}

__device__ __forceinline__ void hyena_final_phase(const Fr& F, const Args& a, int l, bool with_ctx) {
    constexpr int HROW = 144;
    LAS unsigned char* T = F.lds;
    const bf16_t* X0 = (const bf16_t*)(a.ws + WS_H); const bf16_t* VT = (const bf16_t*)(a.ws + WS_VT); const bf16_t* YT = (const bf16_t*)(a.ws + WS_YT);
    bf16_t* YH = (bf16_t*)(a.ws + WS_QA) + 512;
    const float* FN = (const float*)(a.ws + WS_FNORM) + l * 1024; const float* skip = a.in[I_HBIAS] + l * 512;
    const int nunits = with_ctx ? NB * 36 : NB * 32;
    for (int unit = F.bid; unit < nunits; unit += F.G) {
        const bool lat = unit < NB * 32;
        const int b = lat ? unit >> 5 : (unit - NB * 32) >> 2, p0 = lat ? (unit & 31) * 64 : ((unit - NB * 32) & 3) * 64;
        const int n = lat ? SEQ : CTX; const int row0 = lat ? b * SEQ + p0 : TL + b * CTX + p0;
        const bf16_t* Yb = lat ? YT : YT + VT_CTX_OFF; const bf16_t* Vb = lat ? VT : VT + VT_CTX_OFF; const float* inv = FN + (lat ? 0 : 512);
        __syncthreads();
        for (int i = F.tid; i < 512 * 8; i += NTHR) { const int cch = i >> 3, c8 = i & 7; const size_t off = ((size_t)cch * NB + b) * n + p0 + c8 * 8;
            const u32x4 y = *(const u32x4*)(Yb + off), v = *(const u32x4*)(Vb + off); const float s = inv[cch], k = skip[cch];
            u32x4 o;
            o.x = cvtpk(bflo(y.x) * s + k * bflo(v.x), bfhi(y.x) * s + k * bfhi(v.x)); o.y = cvtpk(bflo(y.y) * s + k * bflo(v.y), bfhi(y.y) * s + k * bfhi(v.y));
            o.z = cvtpk(bflo(y.z) * s + k * bflo(v.z), bfhi(y.z) * s + k * bfhi(v.z)); o.w = cvtpk(bflo(y.w) * s + k * bflo(v.w), bfhi(y.w) * s + k * bfhi(v.w));
            *(LAS u32x4*)(T + cch * HROW + c8 * 16) = o; }
        __syncthreads();
        { const int th = F.tid & 255, half = F.tid >> 8, c = 2 * th;
          for (int t = 32 * half; t < 32 * half + 32; ++t) {
              const unsigned x0 = *(const unsigned*)(X0 + (size_t)(row0 + t) * 512 + c);
              const float y0 = bf1(*(const LAS bf16_t*)(T + c * HROW + t * 2)), y1 = bf1(*(const LAS bf16_t*)(T + (c + 1) * HROW + t * 2));
              *(unsigned*)(YH + (size_t)(row0 + t) * 1536 + c) = cvtpk(bflo(x0) * y0, bfhi(x0) * y1); } }
    }
    __syncthreads();
}

#define MFMA32(a, b, c) __builtin_amdgcn_mfma_f32_32x32x16_bf16((a), (b), (c), 0, 0, 0)
#define MFMA16(a, b, c) __builtin_amdgcn_mfma_f32_16x16x32_bf16((a), (b), (c), 0, 0, 0)

__device__ __forceinline__ int tile_off(int row, int chunk) { return row * 128 + ((chunk ^ ((row >> 1) & 7)) << 4); }

template <bool WIN>
__device__ __forceinline__ void attn_unit(const Fr& F, bf16_t* Qw, const bf16_t* Kb, const bf16_t* VTb, int a0, int na, int b0, int nb, int qpos0, bool has_sink, float sink2, const float* g64, bool rope, const float* ct, const float* st) {
    LAS unsigned char* L = F.lds;
    const int r = F.lane & 31, h = F.lane >> 5;
    const int xaddr = (lane_id() ^ 32) << 2;
#define SWAP32(v) __builtin_bit_cast(float, __builtin_amdgcn_ds_bpermute(xaddr, __builtin_bit_cast(int, (v))))
    bf16x8 q[4];
    {
        float x[4][8]; float ss = 0.f;
#pragma unroll
        for (int kk = 0; kk < 4; ++kk) { const u32x4 w = *(const u32x4*)(Qw + (size_t)r * 1536 + 16 * kk + 8 * h); unpack8(w, x[kk]);
#pragma unroll
            for (int j = 0; j < 8; ++j) ss += x[kk][j] * x[kk][j]; }
        ss += SWAP32(ss);
        const float rn = (1.f / sqrtf(ss * (1.f / 64.f) + EPS)) * QSCALE;
#pragma unroll
        for (int kk = 0; kk < 4; ++kk) { const f32x4 g0 = *(const f32x4*)(g64 + 16 * kk + 8 * h), g1 = *(const f32x4*)(g64 + 16 * kk + 8 * h + 4);
            x[kk][0] *= rn * g0.x; x[kk][1] *= rn * g0.y; x[kk][2] *= rn * g0.z; x[kk][3] *= rn * g0.w; x[kk][4] *= rn * g1.x; x[kk][5] *= rn * g1.y; x[kk][6] *= rn * g1.z; x[kk][7] *= rn * g1.w; }
        if (rope) { const int pos = qpos0 + r;
#pragma unroll
            for (int ax = 0; ax < 2; ++ax) {
                const f32x4 c0 = *(const f32x4*)(ct + pos * 32 + ax * 16 + 8 * h), c1 = *(const f32x4*)(ct + pos * 32 + ax * 16 + 8 * h + 4);
                const f32x4 s0 = *(const f32x4*)(st + pos * 32 + ax * 16 + 8 * h), s1 = *(const f32x4*)(st + pos * 32 + ax * 16 + 8 * h + 4);
                const float cs[8] = {c0.x, c0.y, c0.z, c0.w, c1.x, c1.y, c1.z, c1.w}, sn[8] = {s0.x, s0.y, s0.z, s0.w, s1.x, s1.y, s1.z, s1.w};
#pragma unroll
                for (int j = 0; j < 8; ++j) { const float av = x[2 * ax][j], bv = x[2 * ax + 1][j]; x[2 * ax][j] = av * cs[j] - bv * sn[j]; x[2 * ax + 1][j] = bv * cs[j] + av * sn[j]; } } }
#pragma unroll
        for (int kk = 0; kk < 4; ++kk) q[kk] = __builtin_bit_cast(bf16x8, pack8(x[kk]));
    }
    f32x16 o0, o1;
#pragma unroll
    for (int i = 0; i < 16; ++i) { o0[i] = 0.f; o1[i] = 0.f; }
    float lsum = 0.f;
    const int ntile = na + nb;
    const int srow = F.tid >> 3, sch = F.tid & 7;
    const int soff = tile_off(srow, sch);
    int t4[4];
#pragma unroll
    for (int j = 0; j < 4; ++j) t4[j] = tile_off(r, 2 * j + h);
#define AT_KT(i) ((i) < na ? a0 + (i) : b0 + ((i) - na))
#define AT_LD(i, K0, K1, V0, V1) do { const int kt_ = AT_KT(i); \
        K0 = *(const u32x4*)(Kb + (size_t)(kt_ * 128 + srow) * 128 + sch * 8); K1 = *(const u32x4*)(Kb + (size_t)(kt_ * 128 + 64 + srow) * 128 + sch * 8); \
        V0 = *(const u32x4*)(VTb + (size_t)srow * KEYS + kt_ * 128 + sch * 8); V1 = *(const u32x4*)(VTb + (size_t)srow * KEYS + kt_ * 128 + 64 + sch * 8); } while (0)
#define AT_ST(buf, K0, K1, V0, V1) do { LAS unsigned char* B_ = L + (buf) * 32768 + soff; \
        *(LAS u32x4*)(B_) = K0; *(LAS u32x4*)(B_ + 8192) = K1; *(LAS u32x4*)(B_ + 16384) = V0; *(LAS u32x4*)(B_ + 24576) = V1; } while (0)
#define AT_QK(S0, S1, Kt) do { bf16x8 kf_[8]; \
        _Pragma("unroll") for (int kk = 0; kk < 4; ++kk) { kf_[2 * kk] = *(const LAS bf16x8*)(L + (Kt) + t4[kk]); kf_[2 * kk + 1] = *(const LAS bf16x8*)(L + (Kt) + t4[kk] + 4096); } \
        _Pragma("unroll") for (int i_ = 0; i_ < 16; ++i_) { S0[i_] = 0.f; S1[i_] = 0.f; } \
        _Pragma("unroll") for (int kk = 0; kk < 4; ++kk) { S0 = MFMA32(kf_[2 * kk], q[kk], S0); S1 = MFMA32(kf_[2 * kk + 1], q[kk], S1); } } while (0)
#define AT_EXP(S0, S1, P, kpos0) do { \
        if (WIN && (kpos0) >= 0) { const int kbase = (kpos0) + 4 * h, qp = qpos0 + r; \
            _Pragma("unroll") for (int i = 0; i < 16; ++i) { const int kr = (i & 3) + 8 * (i >> 2); const int d0 = kbase + kr - qp, d1 = d0 + 32; \
                if (d0 > 128 || d0 < -128) S0[i] = -1e30f; if (d1 > 128 || d1 < -128) S1[i] = -1e30f; } } \
        _Pragma("unroll") for (int i = 0; i < 16; ++i) { S0[i] = fast_exp2(S0[i]); S1[i] = fast_exp2(S1[i]); lsum += S0[i] + S1[i]; } \
        { u32x4 w; \
          w.x = cvtpk(S0[0], S0[1]); w.y = cvtpk(S0[2], S0[3]); w.z = cvtpk(S0[4], S0[5]); w.w = cvtpk(S0[6], S0[7]); P[0] = __builtin_bit_cast(bf16x8, w); \
          w.x = cvtpk(S0[8], S0[9]); w.y = cvtpk(S0[10], S0[11]); w.z = cvtpk(S0[12], S0[13]); w.w = cvtpk(S0[14], S0[15]); P[1] = __builtin_bit_cast(bf16x8, w); \
          w.x = cvtpk(S1[0], S1[1]); w.y = cvtpk(S1[2], S1[3]); w.z = cvtpk(S1[4], S1[5]); w.w = cvtpk(S1[6], S1[7]); P[2] = __builtin_bit_cast(bf16x8, w); \
          w.x = cvtpk(S1[8], S1[9]); w.y = cvtpk(S1[10], S1[11]); w.z = cvtpk(S1[12], S1[13]); w.w = cvtpk(S1[14], S1[15]); P[3] = __builtin_bit_cast(bf16x8, w); } } while (0)
#define AT_PV(P, Vt) do { bf16x8 vf_[8]; \
        _Pragma("unroll") for (int c = 0; c < 4; ++c) { vf_[2 * c] = *(const LAS bf16x8*)(L + (Vt) + t4[c]); vf_[2 * c + 1] = *(const LAS bf16x8*)(L + (Vt) + t4[c] + 4096); } \
        _Pragma("unroll") for (int c = 0; c < 4; ++c) { o0 = MFMA32(vf_[2 * c], P[c], o0); o1 = MFMA32(vf_[2 * c + 1], P[c], o1); } } while (0)
#define AT_BODY(it) do { \
        const int kt = AT_KT(it); \
        if ((it) + 1 < ntile) AT_LD((it) + 1, kA0, kA1, vA0, vA1); \
        const int Bc = ((it) & 1) * 32768;                                \
        const int kp = (WIN && kt >= 2) ? (kt - 2) * 128 : -1;            \
        { f32x16 sa0, sa1; bf16x8 pa[4]; \
          AT_QK(sa0, sa1, Bc); AT_EXP(sa0, sa1, pa, kp); AT_PV(pa, Bc + 16384); } \
        __builtin_amdgcn_sched_barrier(0); \
        { f32x16 sb0, sb1; bf16x8 pb_[4]; \
          AT_QK(sb0, sb1, Bc + 8192); AT_EXP(sb0, sb1, pb_, (kp < 0 ? -1 : kp + 64)); AT_PV(pb_, Bc + 24576); } \
        if ((it) + 1 < ntile) AT_ST(((it) + 1) & 1, kA0, kA1, vA0, vA1); \
        __syncthreads(); } while (0)
    u32x4 kA0, kA1, vA0, vA1;
    AT_LD(0, kA0, kA1, vA0, vA1);
    __syncthreads();
    AT_ST(0, kA0, kA1, vA0, vA1);
    __syncthreads();
    for (int it = 0; it < ntile; it += 2) {
        AT_BODY(it);
        if (it + 1 < ntile) AT_BODY(it + 1);
    }
#undef AT_BODY
#undef AT_QK
#undef AT_EXP
#undef AT_PV
#undef AT_ST
#undef AT_LD
#undef AT_KT
    float lt = lsum + SWAP32(lsum);
    if (has_sink) lt += fast_exp2(sink2);
    const float inv = 1.f / lt;
#pragma unroll
    for (int g = 0; g < 4; ++g) {
        u32x2 w0, w1;
        w0.x = cvtpk(o0[4 * g] * inv, o0[4 * g + 1] * inv); w0.y = cvtpk(o0[4 * g + 2] * inv, o0[4 * g + 3] * inv);
        w1.x = cvtpk(o1[4 * g] * inv, o1[4 * g + 1] * inv); w1.y = cvtpk(o1[4 * g + 2] * inv, o1[4 * g + 3] * inv);
        *(u32x2*)(Qw + (size_t)r * 1536 + 8 * g + 4 * h) = w0;
        *(u32x2*)(Qw + (size_t)r * 1536 + 32 + 8 * g + 4 * h) = w1; }
#undef SWAP32
}

__device__ __forceinline__ void hyena_unit_lat(const Fr& F, const bf16_t* Fg, const bf16_t* Vg, bf16_t* Yg) {
    constexpr int FREP = 8192 + 64, VPIT = 4096 + 16, VOFF = 8 * FREP;
    LAS unsigned char* L = F.lds;
    __syncthreads();
    { const int x = F.tid;
      const u32x4 lo = *(const u32x4*)(Fg + x * 8); u32x4 hi; if (x < 511) hi = *(const u32x4*)(Fg + x * 8 + 8); else { const unsigned z = zero_u32(); hi = (u32x4){z, z, z, z}; }
      const unsigned wv[8] = {lo.x, lo.y, lo.z, lo.w, hi.x, hi.y, hi.z, hi.w};
      *(LAS u32x4*)(L + x * 16) = lo;
#pragma unroll
      for (int rho = 1; rho < 8; ++rho) { u32x4 o;
          unsigned od[4];
#pragma unroll
          for (int d = 0; d < 4; ++d) { const int ob = 4 * d + 2 * rho, i = ob >> 2, s = ob & 3; od[d] = __builtin_amdgcn_alignbyte(wv[i + 1 < 8 ? i + 1 : 7], wv[i], s); }
          o.x = od[0]; o.y = od[1]; o.z = od[2]; o.w = od[3];
          *(LAS u32x4*)(L + rho * FREP + x * 16) = o; } }
    for (int i = F.tid; i < 16 * 256; i += NTHR) { const int b = i >> 8, x = i & 255; *(LAS u32x4*)(L + VOFF + b * VPIT + x * 16) = *(const u32x4*)(Vg + (size_t)b * SEQ + x * 8); }
    __syncthreads();
    const int i16 = F.lane & 15, q4 = F.lane >> 4, w = F.wave;
    const int base0 = 2047 - 256 * w - i16 + 8 * q4;
    const int rho = base0 & 7;
    LAS unsigned char* Ap = L + rho * FREP + (base0 - rho) * 2;
    LAS unsigned char* Bp = L + VOFF + i16 * VPIT + q4 * 16;
    bf16x8 A[16]; f32x4 acc[16];
#pragma unroll
    for (int rr = 0; rr < 16; ++rr) { A[rr] = *(const LAS bf16x8*)(Ap - 32 * rr); acc[rr] = (f32x4){0.f, 0.f, 0.f, 0.f}; }
    bf16x8 Bn = *(const LAS bf16x8*)(Bp);
    for (int o = 0; o < 8; ++o) {
#pragma unroll
        for (int u = 0; u < 8; ++u) {
            const int st = o * 8 + u;
            const bf16x8 Bf = Bn;
            if (st < 63) Bn = *(const LAS bf16x8*)(Bp + 64 * st + 64);
#pragma unroll
            for (int rr = 0; rr < 16; ++rr) acc[rr] = MFMA16(A[(rr - 2 * u) & 15], Bf, acc[rr]);
            if (st < 63) { A[(-2 * u - 2) & 15] = *(const LAS bf16x8*)(Ap + 64 * st + 64); A[(-2 * u - 1) & 15] = *(const LAS bf16x8*)(Ap + 64 * st + 32); }
        }
    }
#pragma unroll
    for (int rr = 0; rr < 16; ++rr) { u32x2 wv; wv.x = cvtpk(acc[rr].x, acc[rr].y); wv.y = cvtpk(acc[rr].z, acc[rr].w);
        *(u32x2*)(Yg + (size_t)i16 * SEQ + 256 * w + 16 * rr + 4 * q4) = wv; }
}
__device__ __forceinline__ void hyena_unit_ctx(const Fr& F, const bf16_t* Fg, const bf16_t* Vg, bf16_t* Yg) {
    constexpr int FREP = 1024 + 64, VPIT = 512 + 16, VOFF = 8 * FREP;
    LAS unsigned char* L = F.lds;
    __syncthreads();
    if (F.tid < 64) *(LAS u32x4*)(L + F.tid * 16) = *(const u32x4*)(Fg + F.tid * 8);
    if (F.tid >= 64 && F.tid < 68) { const unsigned z = zero_u32(); *(LAS u32x4*)(L + 1024 + (F.tid - 64) * 16) = (u32x4){z, z, z, z}; }
    { const int b = F.tid >> 5, x = F.tid & 31; *(LAS u32x4*)(L + VOFF + b * VPIT + x * 16) = *(const u32x4*)(Vg + (size_t)b * CTX + x * 8); }
    __syncthreads();
    for (int i = F.tid; i < 7 * 256; i += NTHR) { const int rho = 1 + i / 256, x2 = (i % 256) * 2; const int s0 = x2 + rho, s1 = x2 + 1 + rho;
        const unsigned e0 = s0 < 512 ? *(const LAS bf16_t*)(L + s0 * 2) : 0, e1 = s1 < 512 ? *(const LAS bf16_t*)(L + s1 * 2) : 0;
        *(LAS unsigned*)(L + rho * FREP + x2 * 2) = e0 | (e1 << 16); }
    __syncthreads();
    const int i16 = F.lane & 15, q4 = F.lane >> 4, w = F.wave;
    const int base0 = 255 - 32 * w - i16 + 8 * q4, rho = base0 & 7;
    LAS unsigned char* Ap = L + rho * FREP + (base0 - rho) * 2;
    LAS unsigned char* Bp = L + VOFF + i16 * VPIT + q4 * 16;
    f32x4 acc0 = (f32x4){0.f, 0.f, 0.f, 0.f}, acc1 = acc0;
#pragma unroll
    for (int st = 0; st < 8; ++st) { const bf16x8 Bf = *(const LAS bf16x8*)(Bp + 64 * st);
        const bf16x8 A0 = *(const LAS bf16x8*)(Ap + 64 * st), A1 = *(const LAS bf16x8*)(Ap + 64 * st - 32);
        acc0 = MFMA16(A0, Bf, acc0); acc1 = MFMA16(A1, Bf, acc1); }
    u32x2 wv; wv.x = cvtpk(acc0.x, acc0.y); wv.y = cvtpk(acc0.z, acc0.w); *(u32x2*)(Yg + (size_t)i16 * CTX + 32 * w + 4 * q4) = wv;
    wv.x = cvtpk(acc1.x, acc1.y); wv.y = cvtpk(acc1.z, acc1.w); *(u32x2*)(Yg + (size_t)i16 * CTX + 32 * w + 16 + 4 * q4) = wv;
}

__device__ __forceinline__ void mixer_phase(const Fr& F, const Args& a, int l, bool with_ctx, unsigned long long& sacc, const int swhich) {
#if defined(PROBE_P)
    unsigned long long st0 = __builtin_amdgcn_s_memrealtime();
#define SUBMARK(w) do { const unsigned long long t_ = __builtin_amdgcn_s_memrealtime(); if (swhich == (w)) sacc += t_ - st0; st0 = t_; } while (0)
#else
#define SUBMARK(w) do { } while (0)
#endif
    bf16_t* QA = (bf16_t*)(a.ws + WS_QA); bf16_t* QW = QA + 1024;
    const bf16_t* KA = (const bf16_t*)(a.ws + WS_KA); const bf16_t* KW = (const bf16_t*)(a.ws + WS_KW);
    const bf16_t* VTA = (const bf16_t*)(a.ws + WS_VTA); const bf16_t* VTW = (const bf16_t*)(a.ws + WS_VTW);
    const float* sinks = a.in[I_SINK] + l * 8; const float* qkg = a.in[I_QKG] + l * 256;
    const float* ct = (const float*)(a.ws + WS_ROPE); const float* st = ct + SEQ * 32;
    const int wq = F.wave >> 1, wh = F.wave & 1;
    const int ubid = (F.G % 8 == 0) ? (F.bid & 7) * (F.G >> 3) + (F.bid >> 3) : F.bid;
#define RELANE(FX) do { int t_ = F.wave * 64 + lane_id(); asm volatile("" : "+v"(t_)); FX.tid = t_; FX.lane = t_ & 63; } while (0)
    Fr FA = F; RELANE(FA);
    for (int unit = ubid; unit < NB * 2 * 32; unit += F.G) {
        const int b = unit >> 6, kvh = (unit >> 5) & 1, pb = unit & 31;
        bf16_t* Qw = QA + (size_t)(b * SEQ + pb * 64 + wh * 32) * 1536 + (kvh * 4 + wq) * 64;
        attn_unit<false>(FA, Qw, KA + (size_t)b * KEYS * 128 + kvh * 64, VTA + (size_t)(b * 2 + kvh) * 64 * KEYS, 0, KEYS / 128, 0, 0, pb * 64 + wh * 32, false, 0.f, qkg, true, ct, st);
    }
    SUBMARK(30);
    Fr FW = F; RELANE(FW);
    for (int unit = ubid; unit < NB * 2 * 32; unit += F.G) {
        const int b = unit >> 6, kvh = (unit >> 5) & 1, pb = unit & 31;
        bf16_t* Qw = QW + (size_t)(b * SEQ + pb * 64 + wh * 32) * 1536 + (kvh * 4 + wq) * 64;
        const int lo = pb < 2 ? 0 : (pb - 2) >> 1, hi = ((64 * pb + 191) >> 7) > 15 ? 15 : ((64 * pb + 191) >> 7);
        attn_unit<true>(FW, Qw, KW + (size_t)b * KEYS * 128 + kvh * 64, VTW + (size_t)(b * 2 + kvh) * 64 * KEYS, 0, 2, 2 + lo, hi - lo + 1, pb * 64 + wh * 32, true, sinks[kvh * 4 + wq] * LOG2E, qkg + 128, true, ct, st);
    }
    SUBMARK(31);
    Fr FC2 = F; RELANE(FC2);
    if (with_ctx) {
        for (int unit = ubid; unit < 2 * NB * 2 * 4; unit += F.G) {
            const int isw = unit >> 7, u2 = unit & 127, b = u2 >> 3, kvh = (u2 >> 2) & 1, pb = u2 & 3;
            bf16_t* Qw = (isw ? QW : QA) + (size_t)(TL + b * CTX + pb * 64 + wh * 32) * 1536 + (kvh * 4 + wq) * 64;
            attn_unit<false>(FC2, Qw, (isw ? KW : KA) + (size_t)b * KEYS * 128 + kvh * 64, (isw ? VTW : VTA) + (size_t)(b * 2 + kvh) * 64 * KEYS, 0, 2, 0, 0, 0, isw != 0, isw ? sinks[kvh * 4 + wq] * LOG2E : 0.f, qkg + (isw ? 128 : 0), false, ct, st);
        }
    }
    SUBMARK(32);
    const bf16_t* FL = (const bf16_t*)(a.ws + WS_FL) + (size_t)l * 512 * 4096; const bf16_t* FC = (const bf16_t*)(a.ws + WS_FC) + (size_t)l * 512 * 512;
    const bf16_t* VT = (const bf16_t*)(a.ws + WS_VT); bf16_t* YT = (bf16_t*)(a.ws + WS_YT);
    Fr FH = F; RELANE(FH);
    for (int c = F.bid; c < HYW; c += F.G) hyena_unit_lat(FH, FL + (size_t)c * 4096, VT + (size_t)c * NB * SEQ, YT + (size_t)c * NB * SEQ);
    if (with_ctx) for (int c = F.bid; c < HYW; c += F.G) hyena_unit_ctx(FH, FC + (size_t)c * 512, VT + VT_CTX_OFF + (size_t)c * NB * CTX, YT + VT_CTX_OFF + (size_t)c * NB * CTX);
    __syncthreads();
    SUBMARK(33);
#undef SUBMARK
#undef RELANE
}

__device__ __forceinline__ float gate_q(float x) { return fminf(256.f * sigmoid_f(x), 255.49f); }
__device__ __forceinline__ unsigned pack_u8x4(float a, float b, float c, float d) { return (unsigned)(int)a | ((unsigned)(int)b << 8) | ((unsigned)(int)c << 16) | ((unsigned)(int)d << 24); }
__device__ __forceinline__ float gq(unsigned w, int k) { return (float)((w >> (8 * k)) & 0xffu) + 0.5f; }
struct EpiInProj {
    static constexpr bool PERM = true, AFTER_DRAIN = false; static constexpr int NSEG = 1;
    unsigned char* ws;
    __device__ __forceinline__ void operator()(const pg8::f32x4 (&acc)[2][2][4][2], const pg8::Unit& u, int wr, int wc, int fr, int fq) const {
        asm volatile("" : "+v"(fr), "+v"(fq));
        const int pn = __builtin_amdgcn_readfirstlane(u.pn); unsigned long long boff; int ldc, colt; bool sig = false;
        if (pn < 2) { boff = WS_QA; ldc = 1536; colt = pn * 256; }
        else if (pn == 2) { boff = WS_RAWA; ldc = 256; colt = 0; }
        else if (pn < 9) { boff = WS_U; ldc = 1536; colt = (pn - 3) * 256; }
        else if (pn < 11) { boff = WS_QA; ldc = 1536; colt = 1024 + (pn - 9) * 256; }
        else if (pn == 11) { boff = WS_RAWW; ldc = 256; colt = 0; }
        else { boff = WS_G; ldc = 3072; colt = (pn - 12) * 256; sig = true; }
        bf16_t* base = (bf16_t*)(ws + boff); unsigned char* Gt = ws + boff;
        const int row0 = u.pm * 256 + wr * 64 + fr, col0 = colt + wc * 32 + 8 * fq;
        if (sig) {
            unsigned char* gb = (unsigned char*)Gt;
#pragma unroll
            for (int ai = 0; ai < 2; ++ai)
#pragma unroll
                for (int m = 0; m < 4; ++m) { unsigned char* rowp = gb + (size_t)(row0 + ai * 128 + m * 16) * 3072 + col0;
#pragma unroll
                    for (int bj = 0; bj < 2; ++bj) { const pg8::f32x4 v0 = acc[ai][bj][m][0], v1 = acc[ai][bj][m][1];
                        u32x2 w; w.x = pack_u8x4(gate_q(v0.x), gate_q(v0.y), gate_q(v0.z), gate_q(v0.w)); w.y = pack_u8x4(gate_q(v1.x), gate_q(v1.y), gate_q(v1.z), gate_q(v1.w));
                        *(u32x2*)(rowp + bj * 128) = w; } }
            return;
        }
#pragma unroll
        for (int ai = 0; ai < 2; ++ai)
#pragma unroll
            for (int m = 0; m < 4; ++m) { bf16_t* rowp = base + (size_t)(row0 + ai * 128 + m * 16) * ldc + col0;
#pragma unroll
                for (int bj = 0; bj < 2; ++bj) { const pg8::f32x4 v0 = acc[ai][bj][m][0], v1 = acc[ai][bj][m][1];
                    u32x4 w; w.x = cvtpk(v0.x, v0.y); w.y = cvtpk(v0.z, v0.w); w.z = cvtpk(v1.x, v1.y); w.w = cvtpk(v1.z, v1.w);
                    *(u32x4*)(rowp + bj * 128) = w; } }
    }
};
struct EpiMerge {
    static constexpr bool PERM = true, AFTER_DRAIN = false; static constexpr int NSEG = 3;
    bf16_t* Mo; const unsigned char* Gt; unsigned* panel_cnt;
    __device__ __forceinline__ void rescale(pg8::f32x4 (&acc)[2][2][4][2], const pg8::Unit& u, int seg, int wr, int wc, int fr, int fq) const {
        asm volatile("" : "+v"(fr), "+v"(fq));
        const int row0 = u.pm * 256 + wr * 64 + fr, col0 = u.pn * 256 + wc * 32 + 8 * fq;
        const unsigned char* G0 = Gt + seg * 1024 + col0;
#pragma unroll
        for (int ai = 0; ai < 2; ++ai)
#pragma unroll
            for (int mh = 0; mh < 2; ++mh) {
                u32x2 ga[2][2], gb[2][2];
#pragma unroll
                for (int mm = 0; mm < 2; ++mm)
#pragma unroll
                    for (int bj = 0; bj < 2; ++bj) { const size_t row = (size_t)(row0 + ai * 128 + (2 * mh + mm) * 16);
                        ga[mm][bj] = *(const u32x2*)(G0 + row * 3072 + bj * 128); gb[mm][bj] = *(const u32x2*)(G0 + row * 3072 + 1024 + bj * 128); }
                __builtin_amdgcn_sched_barrier(0);
#pragma unroll
                for (int mm = 0; mm < 2; ++mm)
#pragma unroll
                    for (int bj = 0; bj < 2; ++bj) { const u32x2 a = ga[mm][bj], b = gb[mm][bj]; pg8::f32x4& v0 = acc[ai][bj][2 * mh + mm][0]; pg8::f32x4& v1 = acc[ai][bj][2 * mh + mm][1];
                        v0.x *= gq(a.x, 0) * fast_rcp(gq(b.x, 0)); v0.y *= gq(a.x, 1) * fast_rcp(gq(b.x, 1)); v0.z *= gq(a.x, 2) * fast_rcp(gq(b.x, 2)); v0.w *= gq(a.x, 3) * fast_rcp(gq(b.x, 3));
                        v1.x *= gq(a.y, 0) * fast_rcp(gq(b.y, 0)); v1.y *= gq(a.y, 1) * fast_rcp(gq(b.y, 1)); v1.z *= gq(a.y, 2) * fast_rcp(gq(b.y, 2)); v1.w *= gq(a.y, 3) * fast_rcp(gq(b.y, 3)); }
                __builtin_amdgcn_sched_barrier(0);
            }
    }
    __device__ __forceinline__ void operator()(const pg8::f32x4 (&acc)[2][2][4][2], const pg8::Unit& u, int wr, int wc, int fr, int fq) const {
        asm volatile("" : "+v"(fr), "+v"(fq));
        const int row0 = u.pm * 256 + wr * 64 + fr, col0 = u.pn * 256 + wc * 32 + 8 * fq;
        constexpr float S = 1.f / 256.f;
        const __amdgpu_buffer_rsrc_t rs = __builtin_amdgcn_make_buffer_rsrc((void*)Mo, 0, TT * 1024 * 2, 0x00020000);
#pragma unroll
        for (int ai = 0; ai < 2; ++ai) {
            u32x2 gv[4][2];
#pragma unroll
            for (int m = 0; m < 4; ++m)
#pragma unroll
                for (int bj = 0; bj < 2; ++bj) gv[m][bj] = *(const u32x2*)(Gt + (size_t)(row0 + ai * 128 + m * 16) * 3072 + 2048 + col0 + bj * 128);
            __builtin_amdgcn_sched_barrier(0);
#pragma unroll
            for (int m = 0; m < 4; ++m)
#pragma unroll
                for (int bj = 0; bj < 2; ++bj) { const pg8::f32x4 v0 = acc[ai][bj][m][0], v1 = acc[ai][bj][m][1]; const u32x2 g = gv[m][bj];
                    u32x4 w; w.x = cvtpk(v0.x * (gq(g.x, 0) * S), v0.y * (gq(g.x, 1) * S)); w.y = cvtpk(v0.z * (gq(g.x, 2) * S), v0.w * (gq(g.x, 3) * S));
                    w.z = cvtpk(v1.x * (gq(g.y, 0) * S), v1.y * (gq(g.y, 1) * S)); w.w = cvtpk(v1.z * (gq(g.y, 2) * S), v1.w * (gq(g.y, 3) * S));
                    if (panel_cnt) __builtin_amdgcn_raw_buffer_store_b128(w, rs, ((row0 + ai * 128 + m * 16) * 1024 + col0 + bj * 128) * 2, 0, 16);
                    else *(u32x4*)(Mo + (size_t)(row0 + ai * 128 + m * 16) * 1024 + col0 + bj * 128) = w; }
            __builtin_amdgcn_sched_barrier(0);
        }
        if (panel_cnt) {
            asm volatile("s_waitcnt vmcnt(0)" ::: "memory");
            if (lane_id() == 0) (void)__hip_atomic_fetch_add(panel_cnt + 64 * u.pm, 1u, __ATOMIC_RELAXED, __HIP_MEMORY_SCOPE_AGENT);
        }
    }
};
struct EpiOut {
    static constexpr bool PERM = true, AFTER_DRAIN = false; static constexpr int NSEG = 1;
    const float* xsL; const float* xsC; float* xdL; float* xdC; const float* MODl;
    __device__ __forceinline__ void operator()(const pg8::f32x4 (&acc)[2][2][4][2], const pg8::Unit& u, int wr, int wc, int fr, int fq) const {
        asm volatile("" : "+v"(fr), "+v"(fq));
        const int trow = u.pm * 256; const bool lat = trow < TL;
        const int row0 = trow + wr * 64 + fr, col0 = u.pn * 256 + wc * 32 + 8 * fq;
        const float* md = MODl + (size_t)mod_row(trow) * DIN + 2 * 1024 + col0;
        const float* xs = lat ? xsL + (size_t)row0 * D + col0 : xsC + (size_t)(row0 - TL) * D + col0; float* xd = lat ? xdL + (size_t)row0 * D + col0 : xdC + (size_t)(row0 - TL) * D + col0;
        f32x4 mv[2][2];
#pragma unroll
        for (int bj = 0; bj < 2; ++bj)
#pragma unroll
            for (int n = 0; n < 2; ++n) mv[bj][n] = *(const f32x4*)(md + bj * 128 + 4 * n);
#pragma unroll
        for (int ai = 0; ai < 2; ++ai)
#pragma unroll
            for (int mh = 0; mh < 2; ++mh) {
                f32x4 xv[2][2][2];
#pragma unroll
                for (int mm = 0; mm < 2; ++mm)
#pragma unroll
                    for (int bj = 0; bj < 2; ++bj)
#pragma unroll
                        for (int n = 0; n < 2; ++n) xv[mm][bj][n] = *(const f32x4*)(xs + (size_t)(ai * 128 + (2 * mh + mm) * 16) * D + bj * 128 + 4 * n);
                __builtin_amdgcn_sched_barrier(0);
#pragma unroll
                for (int mm = 0; mm < 2; ++mm)
#pragma unroll
                    for (int bj = 0; bj < 2; ++bj)
#pragma unroll
                        for (int n = 0; n < 2; ++n) { const pg8::f32x4 av = acc[ai][bj][2 * mh + mm][n]; const f32x4 x4 = xv[mm][bj][n], m4 = mv[bj][n];
                            f32x4 o; o.x = fmaf(m4.x, av.x, x4.x); o.y = fmaf(m4.y, av.y, x4.y); o.z = fmaf(m4.z, av.z, x4.z); o.w = fmaf(m4.w, av.w, x4.w);
                            *(f32x4*)(xd + (size_t)(ai * 128 + (2 * mh + mm) * 16) * D + bj * 128 + 4 * n) = o; }
                __builtin_amdgcn_sched_barrier(0);
            }
    }
};
struct EpiMoe1 {
    static constexpr bool PERM = true, AFTER_DRAIN = false; static constexpr int NSEG = 1;
    bf16_t* HM;
    __device__ __forceinline__ void operator()(const pg8::f32x4 (&acc)[2][2][4][2], const pg8::Unit& u, int wr, int wc, int fr, int fq) const {
        asm volatile("" : "+v"(fr), "+v"(fq));
        const int row0 = u.pm * 256 + wr * 64 + fr, hcol0 = (u.pn & 3) * 128 + wc * 16 + 4 * fq;
#pragma unroll
        for (int ai = 0; ai < 2; ++ai)
#pragma unroll
            for (int m = 0; m < 4; ++m) { bf16_t* rowp = HM + (size_t)(row0 + ai * 128 + m * 16) * 512 + hcol0;
#pragma unroll
                for (int bj = 0; bj < 2; ++bj) { const pg8::f32x4 x = acc[ai][bj][m][0], y = acc[ai][bj][m][1];
                    u32x2 w; w.x = cvtpk(x.x * sigmoid_f(x.x) * y.x, x.y * sigmoid_f(x.y) * y.y); w.y = cvtpk(x.z * sigmoid_f(x.z) * y.z, x.w * sigmoid_f(x.w) * y.w);
                    *(u32x2*)(rowp + bj * 64) = w; } }
    }
};
struct EpiMoe2 {
    static constexpr bool PERM = true, AFTER_DRAIN = false; static constexpr int NSEG = 1;
    bf16_t* Fo; const int* erow; const float* eroww; const LAS int* ebase; const LAS int* ecnt;
    __device__ __forceinline__ void operator()(const pg8::f32x4 (&acc)[2][2][4][2], const pg8::Unit& u, int wr, int wc, int fr, int fq) const {
        asm volatile("" : "+v"(fr), "+v"(fq));
        const int e = u.pn >> 2, cnt = __builtin_amdgcn_readfirstlane(ecnt[e]), pos0 = u.pm * 256 - __builtin_amdgcn_readfirstlane(ebase[e]) + wr * 64 + fr, col0 = (u.pn & 3) * 256 + wc * 32 + 8 * fq;
        const int* er = erow + (size_t)e * TT; const float* ew = eroww + (size_t)e * TT;
#pragma unroll
        for (int ai = 0; ai < 2; ++ai) {
            int rm[4]; float wg[4];
#pragma unroll
            for (int m = 0; m < 4; ++m) { const int pos = pos0 + ai * 128 + m * 16; const bool ok = pos < cnt; rm[m] = ok ? er[ok ? pos : 0] : -1; wg[m] = ew[ok ? pos : 0]; }
            __builtin_amdgcn_sched_barrier(0);
#pragma unroll
            for (int m = 0; m < 4; ++m) { const int r1 = rm[m];
                if (r1 >= 0) { const float wgt = wg[m]; bf16_t* rowp = Fo + ((size_t)(r1 & 1) * TT + (r1 >> 1)) * D + col0;
#pragma unroll
                    for (int bj = 0; bj < 2; ++bj) { const pg8::f32x4 v0 = acc[ai][bj][m][0], v1 = acc[ai][bj][m][1];
                        u32x4 w; w.x = cvtpk(v0.x * wgt, v0.y * wgt); w.y = cvtpk(v0.z * wgt, v0.w * wgt); w.z = cvtpk(v1.x * wgt, v1.y * wgt); w.w = cvtpk(v1.z * wgt, v1.w * wgt);
                        *(u32x4*)(rowp + bj * 128) = w; } } }
            __builtin_amdgcn_sched_barrier(0);
        }
    }
};
struct FusedOutOrder {
    int c, G, nun, wv; const unsigned* ready; unsigned* tmo;
    __device__ __forceinline__ bool next(int i, pg8::Unit& u) const {
        int q;
        if (!ready) { q = i * G + c; if (q >= nun) return false; }
        else if (G == 256 && nun == 576) { if (c < 64) { if (i > 0) return false; q = 512 + c; } else { q = i * 192 + (c - 64); if (q >= 512) return false; } }
        else { q = i * G + (G - 1 - c); if (q >= nun) return false; }
        u.pm = q >> 2; u.pn = q & 3; return true; }
    __device__ __forceinline__ void a_ready(const pg8::Unit& u) const {
        if (!ready) return;
        if (wv == 0) {
            const unsigned long long t0 = __builtin_amdgcn_s_memrealtime(); unsigned polls = 0;
            while ((unsigned)__builtin_amdgcn_readfirstlane(__hip_atomic_load(ready + 64 * u.pm, __ATOMIC_RELAXED, __HIP_MEMORY_SCOPE_AGENT)) < 32u) {
                if ((++polls & 255u) == 0u && __builtin_amdgcn_readfirstlane(__hip_atomic_load(tmo, __ATOMIC_RELAXED, __HIP_MEMORY_SCOPE_AGENT)) != 0u) break;
                if (__builtin_amdgcn_s_memrealtime() - t0 > 20000000ull) { if (lane_id() == 0) __hip_atomic_store(tmo, 1u, __ATOMIC_RELAXED, __HIP_MEMORY_SCOPE_AGENT); break; }
                __builtin_amdgcn_s_sleep(2); }
            __builtin_amdgcn_fence(__ATOMIC_ACQUIRE, "agent");
            asm volatile("s_waitcnt vmcnt(0)" ::: "memory");
        }
        asm volatile("" ::: "memory"); __builtin_amdgcn_s_barrier(); asm volatile("" ::: "memory");
    }
    __device__ __forceinline__ void done(const pg8::Unit&) const {}
};
struct LastInProjOrder {
    pg8::StaticOrder T; int nlat, G, c;
    __device__ __forceinline__ bool next(int i, pg8::Unit& u) const {
        const int L = i * G + c;
        if (L < nlat) return T.next(i, u);
        const int r = L - nlat; if (r >= 32) return false;
        u.pm = 128 + (r >> 1); u.pn = (r & 1) ? 11 : 2; return true; }
    __device__ __forceinline__ void a_ready(const pg8::Unit&) const {}
    __device__ __forceinline__ void done(const pg8::Unit&) const {}
};
struct MoeOrder {
    int nunits, G, c; const LAS int* tile_e;
    __device__ __forceinline__ bool next(int i, pg8::Unit& u) const {
        const int L0 = i * G + c; if (L0 >= nunits) return false;
        const int q = nunits / 8, r = nunits % 8, xcd = L0 % 8, off = L0 / 8; const int L = (xcd < r ? xcd * (q + 1) : r * (q + 1) + (xcd - r) * q) + off;
        const int pm = L >> 2; u.pm = pm; u.pn = __builtin_amdgcn_readfirstlane(tile_e[pm]) * 4 + (L & 3); return true; }
    __device__ __forceinline__ void a_ready(const pg8::Unit&) const {}
    __device__ __forceinline__ void done(const pg8::Unit&) const {}
};

__device__ __forceinline__ int moe_tables(const Fr& F, const Args& a, int l, LAS int* ebase  , LAS int* ecnt  , LAS int* tile_e  ) {
    const unsigned* CNT = (const unsigned*)(a.ws + WS_CTL) + CW_CNT + l * 256;
    __syncthreads();
    if (F.tid == 0) { int acc = 0;
#pragma unroll 1
        for (int e = 0; e < NE; ++e) { const int c = (int)__hip_atomic_load(&CNT[e * 16], __ATOMIC_RELAXED, __HIP_MEMORY_SCOPE_AGENT); ecnt[e] = c; ebase[e] = acc; const int nt = (c + 255) >> 8;
#pragma unroll 1
            for (int t = 0; t < nt; ++t) tile_e[(acc >> 8) + t] = e;
            acc += nt << 8; }
        ebase[NE] = acc; }
    __syncthreads();
    return ebase[NE] >> 8;
}

__device__ __forceinline__ void moe_gather_table(const Fr& F, const Args& a, const MoeOrder& S, const LAS int* ebase, const LAS int* ecnt, LAS int* gidx) {
    const int* EROW = (const int*)(a.ws + WS_EROW);
    for (int j = 0; j < 16; ++j) { pg8::Unit u; if (!S.next(j, u)) break;
        const int e = u.pn >> 2, pos0 = u.pm * 256 - ebase[e], cnt = ecnt[e];
        if (F.tid < 256) { const int pos = pos0 + F.tid; gidx[j * 256 + F.tid] = pos < cnt ? (EROW[(size_t)e * TT + pos] >> 1) : 0; } }
    __syncthreads();
}

#ifndef MK_PER_PHASE
#define MK_PER_PHASE 0
#endif
constexpr int PH_PER_LAYER = 10, PH_FINAL = 1 + NL * PH_PER_LAYER, N_PHASES = PH_FINAL + 1;

__global__ void __launch_bounds__(NTHR, 2) trunk_fwd(Args args) {
    extern __shared__ __attribute__((aligned(16))) unsigned char lds[];
    Fr F; F.lds = (LAS unsigned char*)lds; F.tid = threadIdx.x; F.lane = F.tid & 63; F.wave = __builtin_amdgcn_readfirstlane(F.tid >> 6); F.G = gridDim.x; F.bid = blockIdx.x;
    const int wave0 = F.wave;
    for (int u = F.tid; u < (LDS_BYTES - MISC_OFF) / 4; u += NTHR) ((LAS unsigned*)(F.lds + MISC_OFF))[u] = 0u;
    __syncthreads();
    const int lo = args.ph_lo, hi = args.ph_hi;
    unsigned* ctl = (unsigned*)(args.ws + WS_CTL);
    XcdBarrier bar; bar.bar = ctl + CW_BAR; bar.x = 0; bar.st = (volatile LAS unsigned*)(F.lds + MISC_OFF);
    if (hi - lo > 1) bar = xcd_barrier_post(ctl + CW_BAR, (volatile LAS unsigned*)(F.lds + MISC_OFF));
    bar.wv = (unsigned)wave0;
#ifndef DBG_ONLY
#define DBG_ONLY -1
#endif
#define SEL(p) (DBG_ONLY < 0 || DBG_ONLY == (p))
#define IN(k) (lo <= (k) && (k) < hi)
#define FRESH() do { int t_ = wave0 * 64 + lane_id(); asm volatile("" : "+v"(t_)); F.tid = t_; F.lane = t_ & 63; F.wave = wave0; } while (0)
#define SEAM(k) do { if (IN(k) && IN((k) + 1)) xcd_barrier(bar); } while (0)
#if !defined(PROBE_SUB)
#define PROBE_SUB -1
#endif
    unsigned long long pr_sub = 0ull;
#if defined(PROBE_P)
    unsigned long long pr_acc = 0ull, pr_t0 = __builtin_amdgcn_s_memrealtime();
#define PR_MARK(p) do { const unsigned long long t_ = __builtin_amdgcn_s_memrealtime(); if ((p) == PROBE_P) pr_acc += t_ - pr_t0; pr_t0 = t_; } while (0)
#else
#define PR_MARK(p) do { } while (0)
#endif
    unsigned char* ws = args.ws;
    LAS int* ebase = (LAS int*)(F.lds + MISC_OFF + 64); LAS int* ecnt = ebase + 20; LAS int* tile_e = (LAS int*)(F.lds + MISC_OFF + 512);

    #ifndef DBG_PRO
#define DBG_PRO 7
#endif
    if (SEL(100) && IN(0)) { FRESH(); if (DBG_PRO & 1) pro_mod(F, args); __syncthreads(); if (DBG_PRO & 2) pro_rope(F, args); if (DBG_PRO & 4) pro_filter(F, args); __syncthreads(); }
    SEAM(0); PR_MARK(100);
    for (int l = 0; l < NL; ++l) {
        const int pb = 1 + PH_PER_LAYER * l;
#define LVARS() int lq_ = l; asm volatile("" : "+s"(lq_)); const bool uc = lq_ < NL - 1; const int M2 = uc ? TT : TL; (void)M2; (void)uc
        if (SEL(0) && IN(pb + 0)) { LVARS(); FRESH(); if (l == 0) filter_norm_reduce(F, args); conv_small_weights(F, args, l, 7, 0); rows_p0(F, args, l, TT); __syncthreads(); }
        SEAM(pb + 0); PR_MARK(0);
        if (SEL(1) && IN(pb + 1)) { LVARS();
            pg8::Gemm g{(const bf16_t*)(ws + WS_H), (const bf16_t*)(ws + WS_WIN), TT, DIN, 1024};
            EpiInProj E{ws};
            if (uc) { pg8::StaticOrder S; S.init(TT, DIN, F.G, F.bid); pg8::gemm_phase<EpiInProj, pg8::StaticOrder, true, true>(F.lds, g, S, E, wave0); }
            else { LastInProjOrder S; S.T.init(TL, DIN, F.G, F.bid); S.nlat = (TL / 256) * (DIN / 256); S.G = F.G; S.c = F.bid; pg8::gemm_phase<EpiInProj, LastInProjOrder, true, true>(F.lds, g, S, E, wave0); }
        }
        SEAM(pb + 1); PR_MARK(1);
        if (SEL(2) && IN(pb + 2)) { LVARS(); FRESH(); prep_phase(F, args, l, uc); }
        SEAM(pb + 2); PR_MARK(2);
        if (SEL(3) && IN(pb + 3)) { LVARS(); FRESH(); mixer_phase(F, args, l, uc, pr_sub, PROBE_SUB); }
        SEAM(pb + 3); PR_MARK(3);
        if (SEL(4) && IN(pb + 4)) { LVARS(); FRESH(); hyena_final_phase(F, args, l, uc); }
        SEAM(pb + 4); PR_MARK(4);
        if (SEL(5) && IN(pb + 5)) { LVARS();
            pg8::StaticOrder S; S.init(M2, 1024, F.G, F.bid);
            pg8::Gemm g{(const bf16_t*)(ws + WS_QA), (const bf16_t*)(ws + WS_WBR), M2, 1024, 1536}; EpiMerge E{(bf16_t*)(ws + WS_H), (const unsigned char*)(ws + WS_G), nullptr};
            pg8::gemm_phase<EpiMerge, pg8::StaticOrder, true, true>(F.lds, g, S, E, wave0);
            { FRESH(); __syncthreads(); const int nun = (M2 / 256) * 4, rem = nun % F.G; conv_expert_weights(F, args, l, rem, 0, CONV_E_ITEMS); __syncthreads(); }
        }
        SEAM(pb + 5); PR_MARK(5);
        if (SEL(6) && IN(pb + 6)) { LVARS();
            pg8::Gemm g{(const bf16_t*)(ws + WS_H), (const bf16_t*)(ws + WS_WOUT), M2, 1024, 1024}; pg8::StaticOrder S; S.init(M2, 1024, F.G, F.bid);
            EpiOut E{l == 0 ? args.in[I_X] : args.out, l == 0 ? args.in[I_CTX] : (const float*)(ws + WS_XC), args.out, (float*)(ws + WS_XC), (const float*)(ws + WS_MOD) + (size_t)l * NBM * DIN};
            pg8::gemm_phase<EpiOut, pg8::StaticOrder, true, true>(F.lds, g, S, E, wave0);
        }
        SEAM(pb + 6); PR_MARK(6);
        if (SEL(7) && IN(pb + 7)) { LVARS(); FRESH(); rows_p5(F, args, l, M2, pr_sub, PROBE_SUB); __syncthreads(); }
        SEAM(pb + 7); PR_MARK(7);
        if (SEL(8) && IN(pb + 8)) { LVARS(); FRESH();
            const int ntile = moe_tables(F, args, l, ebase, ecnt, tile_e);
            pg8::Gemm g{(const bf16_t*)(ws + WS_H), (const bf16_t*)(ws + WS_W13), ntile * 256, NE * 1024, 1024}; MoeOrder S{ntile * 4, F.G, F.bid, tile_e};
            LAS int* gidx = (LAS int*)(F.lds + 131072);
            moe_gather_table(F, args, S, ebase, ecnt, gidx);
            EpiMoe1 E{(bf16_t*)(ws + WS_U)};
            pg8::gemm_phase<EpiMoe1, MoeOrder, true, true, true>(F.lds, g, S, E, wave0, gidx);
        }
        SEAM(pb + 8); PR_MARK(8);
        if (SEL(9) && IN(pb + 9)) { LVARS(); FRESH();
            const int ntile = moe_tables(F, args, l, ebase, ecnt, tile_e);
            pg8::Gemm g{(const bf16_t*)(ws + WS_U), (const bf16_t*)(ws + WS_W2), ntile * 256, NE * 1024, 512}; MoeOrder S{ntile * 4, F.G, F.bid, tile_e};
            EpiMoe2 E{(bf16_t*)(ws + WS_F), (const int*)(ws + WS_EROW), (const float*)(ws + WS_EROWW), ebase, ecnt};
            pg8::gemm_phase<EpiMoe2, MoeOrder, true, true>(F.lds, g, S, E, wave0);
        }
        SEAM(pb + 9); PR_MARK(9);
    }
    if (SEL(101) && IN(PH_FINAL)) { FRESH(); rows_final(F, args); }
#if defined(PROBE_P)
    PR_MARK(101);
    pr_acc += pr_sub;
    if (blockIdx.x == 0 && F.wave == 0) { const unsigned long long t1 = __builtin_amdgcn_s_memrealtime() + 4ull * pr_acc; while (__builtin_amdgcn_s_memrealtime() < t1) __builtin_amdgcn_s_sleep(8); }
#endif
#undef IN
#undef SEAM
}

extern "C" void kernel_launch(void* const* d_in, const int* in_sizes, int n_in, void* d_out, int out_size, void* d_ws, size_t ws_size, hipStream_t stream) {
    static int grid = 0;
    if (grid == 0) {
        if (n_in != 29 || in_sizes[0] != TL * D || out_size != TL * D || ws_size < WS_END) { fprintf(stderr, "kernel_launch: unexpected shapes / workspace (n_in %d, ws %zu < %zu); nothing launched\n", n_in, ws_size, (size_t)WS_END); grid = -1; return; }
        int dev = 0, cus = 0, per_cu = 0;
        if (hipGetDevice(&dev) != hipSuccess || hipDeviceGetAttribute(&cus, hipDeviceAttributeMultiprocessorCount, dev) != hipSuccess) { grid = -1; return; }
        if (hipFuncSetAttribute((const void*)trunk_fwd, hipFuncAttributeMaxDynamicSharedMemorySize, LDS_BYTES) != hipSuccess) { fprintf(stderr, "kernel_launch: hipFuncSetAttribute failed\n"); grid = -1; return; }
        if (hipOccupancyMaxActiveBlocksPerMultiprocessor(&per_cu, (const void*)trunk_fwd, NTHR, LDS_BYTES) != hipSuccess || per_cu < 1) { fprintf(stderr, "kernel_launch: occupancy query reports %d\n", per_cu); }
        (void)hipGetLastError();
        grid = cus;
    }
    if (grid < 0) return;
    (void)hipMemsetAsync((char*)d_ws + WS_CTL, 0, CTL_ZERO_BYTES, stream);
    Args a{};
    for (int i = 0; i < 29; ++i) a.in[i] = (const float*)d_in[i];
    a.out = (float*)d_out; a.ws = (unsigned char*)d_ws;
#if MK_PER_PHASE
    for (int k = 0; k < N_PHASES; ++k) { a.ph_lo = k; a.ph_hi = k + 1; hipLaunchKernelGGL(trunk_fwd, dim3(grid), dim3(NTHR), LDS_BYTES, stream, a); }
#else
    a.ph_lo = 0; a.ph_hi = N_PHASES;
    hipLaunchKernelGGL(trunk_fwd, dim3(grid), dim3(NTHR), LDS_BYTES, stream, a);
#endif
}
```

```cpp
#include <hip/hip_runtime.h>
#include <cstdio>
#include <cstdint>

#define GAS __attribute__((address_space(1)))
#define LAS __attribute__((address_space(3)))
__device__ __forceinline__ int lane_id() { int l; asm volatile("v_mbcnt_lo_u32_b32 %0, -1, 0\n\tv_mbcnt_hi_u32_b32 %0, -1, %0" : "=v"(l)); return l; }
#define MK_PER_PHASE 0
namespace pg8 {
#define PG8_LAS __attribute__((address_space(3)))
typedef unsigned short bf16_t;
typedef short bf16x8 __attribute__((ext_vector_type(8)));
typedef float f32x4 __attribute__((ext_vector_type(4)));
typedef unsigned u32x4 __attribute__((ext_vector_type(4)));
constexpr int BM = 256, BK = 64, HALF = 128, HTB = HALF * BK * 2  , STAGE_BYTES = 8 * HTB, NXCD = 8, WGM = 8;

__host__ __device__ __forceinline__ int lds_byte(int r, int c) { const int st = (r >> 4) * 2 + (c >> 5), rr = r & 15, cc = c & 31, ob = rr * 64 + cc * 2; return st * 1024 + (ob ^ (((ob >> 9) & 1) << 5)); }
__host__ __device__ __forceinline__ void stage_rc(int b, int& R, int& C) { const int st = b / 1024, sb = b % 1024, swz = sb ^ (((sb >> 9) & 1) << 5); R = (st >> 1) * 16 + swz / 64; C = (st & 1) * 32 + (swz % 64) / 2; }
__host__ __device__ __forceinline__ int perm32(int rho) { const int n = rho >> 4, i = rho & 15; return 8 * (i >> 2) + 4 * n + (i & 3); }

struct Unit { int pm, pn; };
struct Gemm { const bf16_t* A; const bf16_t* Bt; int M, N, K; };

struct StaticOrder {
    int nM, nN, nwg, G, c;
    __host__ __device__ void init(int M, int N, int G_, int c_) { nM = M / BM; nN = N / BM; nwg = nM * nN; G = G_; c = c_; }
    __host__ __device__ bool next(int i, Unit& u) const {
        const long L = (long)i * G + c; if (L >= nwg) return false;
        int wgid = (int)L; { const int q = nwg / NXCD, r = nwg % NXCD, xcd = wgid % NXCD, off = wgid / NXCD; wgid = (xcd < r ? xcd * (q + 1) : r * (q + 1) + (xcd - r) * q) + off; }
        const int nig = WGM * nN, gid = wgid / nig, fm = gid * WGM, gsz = (nM - fm) < WGM ? (nM - fm) : WGM;
        u.pm = fm + ((wgid % nig) % gsz); u.pn = (wgid % nig) / gsz; return true;
    }
    __device__ __forceinline__ void a_ready(const Unit&) const {}
    __device__ __forceinline__ void done(const Unit&) const {}
};
__device__ __forceinline__ unsigned cvt_pk_bf16(float lo, float hi) { unsigned r; asm volatile("v_cvt_pk_bf16_f32 %0, %1, %2" : "=v"(r) : "v"(lo), "v"(hi)); return r; }
typedef float f32x2 __attribute__((ext_vector_type(2)));
template <class Epi, class Sched, bool ALIGN_EPI = false, bool SP2 = false, bool GATHER = false, bool F8 = false, int F8_SW = 0>
__device__ __forceinline__ void gemm_phase(PG8_LAS unsigned char* lds, const Gemm g, const Sched& S, const Epi& E, const int wave_id, const PG8_LAS int* gidx = nullptr) {
    static_assert(!GATHER || SP2, "GATHER is implemented for the SP2 loop only");
    int tid_ = wave_id * 64 + lane_id(); asm volatile("" : "+v"(tid_));
    const int tid = tid_, wid = __builtin_amdgcn_readfirstlane(tid >> 6), lane = tid & 63, wr = wid >> 2, wc = wid & 3, fr = lane & 15, fq = lane >> 4;
    const int K = g.K, nt = K / BK;
    unsigned voffA[2], voffB[2];
#pragma unroll
    for (int i = 0; i < 2; ++i) { int R, C; stage_rc(tid * 16 + i * 8192, R, C); const int Rb = Epi::PERM ? ((R & ~31) + perm32(R & 31)) : R;
        voffA[i] = (unsigned)(R * K + C) * 2u; voffB[i] = (unsigned)(Rb * K + C) * 2u; }
    unsigned goffA[2][2], goffN[2][2];
#define PG8_GOFF(dst, j) do { _Pragma("unroll") for (int _h = 0; _h < 2; ++_h) _Pragma("unroll") for (int _i = 0; _i < 2; ++_i) { int R_, C_; stage_rc(tid * 16 + _i * 8192, R_, C_); \
        dst[_h][_i] = ((unsigned)gidx[(j) * 256 + _h * 128 + R_] * (unsigned)K + (unsigned)C_) * 2u; } } while (0)
#define PG8_STAGE_A(bufoff, base, h, nx) do { if constexpr (GATHER) { unsigned o_[2] = {(nx) ? goffN[h][0] : goffA[h][0], (nx) ? goffN[h][1] : goffA[h][1]}; PG8_STAGE(bufoff, base, o_); } \
        else { PG8_STAGE(bufoff, (base) + ((h) ? hstep : 0), voffA); } } while (0)
    const size_t kstep = (size_t)(BK * 2);
    const size_t hstep = (size_t)HALF * K * 2;
    const size_t tstep = 2 * hstep;
    const unsigned ldsw = (unsigned)wid * 1024u;
    const int aoff = lds_byte(wr * 64 + fr, fq * 8), boff = lds_byte(wc * 32 + fr, fq * 8);
#define PG8_SA(b, h) (((b) * 2 + (h)) * HTB)
#define PG8_SB(b, h) ((4 + (b) * 2 + (h)) * HTB)
#define PG8_STAGE(bufoff, gbase, voff) do { _Pragma("unroll") for (int _i = 0; _i < 2; ++_i) \
        __builtin_amdgcn_global_load_lds((const unsigned*)((const char*)(gbase) + (voff)[_i]), (PG8_LAS unsigned*)(lds + (bufoff) + ldsw + _i * 8192), 16, 0, 0); } while (0)
#define PG8_LDA(dst, b, h) do { _Pragma("unroll") for (int m = 0; m < 4; ++m) _Pragma("unroll") for (int k = 0; k < 2; ++k) dst[m][k] = *(const PG8_LAS bf16x8*)(lds + PG8_SA(b, h) + aoff + m * 2048 + k * 1024); } while (0)
#define PG8_LDB(dst, b, h) do { _Pragma("unroll") for (int n = 0; n < 2; ++n) _Pragma("unroll") for (int k = 0; k < 2; ++k) dst[n][k] = *(const PG8_LAS bf16x8*)(lds + PG8_SB(b, h) + boff + n * 2048 + k * 1024); } while (0)
#define PG8_MMA(ai, bj, At, Bt) do { if constexpr (F8) __builtin_amdgcn_sched_barrier(0); __builtin_amdgcn_s_setprio(1); _Pragma("unroll") for (int m = 0; m < 4; ++m) _Pragma("unroll") for (int n = 0; n < 2; ++n) { \
        if constexpr (F8) { typedef int i32x4_ __attribute__((ext_vector_type(4))); typedef int i32x8_ __attribute__((ext_vector_type(8))); \
            const i32x8_ wf = __builtin_shufflevector(__builtin_bit_cast(i32x4_, Bt[n][0]), __builtin_bit_cast(i32x4_, Bt[n][1]), 0, 1, 2, 3, 4, 5, 6, 7); \
            const i32x8_ af = __builtin_shufflevector(__builtin_bit_cast(i32x4_, At[m][0]), __builtin_bit_cast(i32x4_, At[m][1]), 0, 1, 2, 3, 4, 5, 6, 7); \
              \
            asm volatile("v_mfma_scale_f32_16x16x128_f8f6f4 %0, %1, %2, %0, %3, %4 op_sel_hi:[0,0,0]" : "+v"(acc[ai][bj][m][n]) : "v"(wf), "v"(af), "v"(f8sw), "v"(f8sa)); } \
        else { _Pragma("unroll") for (int k = 0; k < 2; ++k) acc[ai][bj][m][n] = __builtin_amdgcn_mfma_f32_16x16x32_bf16(Bt[n][k], At[m][k], acc[ai][bj][m][n], 0, 0, 0); } } \
        __builtin_amdgcn_s_setprio(0); if constexpr (F8) __builtin_amdgcn_sched_barrier(0); } while (0)
#define PG8_WAIT_V(n) asm volatile("s_waitcnt vmcnt(" #n ")" ::: "memory")
#define PG8_WAIT_L(n) asm volatile("s_waitcnt lgkmcnt(" #n ")" ::: "memory")
#define PG8_BAR __builtin_amdgcn_s_barrier()
#define PG8_SCHED __builtin_amdgcn_sched_barrier(0)
    const int f8sw = 127 + F8_SW, f8sa = 127; (void)f8sw; (void)f8sa;
    Unit cur, nxt; int ui = 0;
    if (!S.next(0, cur)) return;
    f32x4 acc[2][2][4][2];
#pragma unroll
    for (int a = 0; a < 2; ++a)
#pragma unroll
        for (int b = 0; b < 2; ++b)
#pragma unroll
            for (int m = 0; m < 4; ++m)
#pragma unroll
                for (int n = 0; n < 2; ++n) acc[a][b][m][n] = (f32x4){0.f, 0.f, 0.f, 0.f};
    bf16x8 At[4][2], B0[2][2], B1[2][2];
    const char* cA = GATHER ? (const char*)g.A : (const char*)g.A + (size_t)cur.pm * tstep; const char* cB = (const char*)g.Bt + (size_t)cur.pn * tstep;
    if constexpr (GATHER) PG8_GOFF(goffA, 0);
    S.a_ready(cur);
    if constexpr (SP2) {
        PG8_STAGE(PG8_SB(0, 0), cB, voffB); PG8_STAGE(PG8_SB(0, 1), cB + hstep, voffB); PG8_STAGE_A(PG8_SA(0, 0), cA, 0, false); PG8_STAGE_A(PG8_SA(0, 1), cA, 1, false);
        if (wr == 1) PG8_BAR;
        PG8_WAIT_V(2); PG8_BAR;
        PG8_STAGE(PG8_SB(1, 0), cB + kstep, voffB); PG8_STAGE_A(PG8_SA(1, 0), cA + kstep, 0, false); PG8_STAGE(PG8_SB(1, 1), cB + hstep + kstep, voffB);
        PG8_WAIT_V(6); PG8_BAR;
    } else {
        PG8_STAGE(PG8_SB(0, 0), cB, voffB); PG8_STAGE(PG8_SA(0, 0), cA, voffA); PG8_STAGE(PG8_SB(0, 1), cB + hstep, voffB); PG8_STAGE(PG8_SA(0, 1), cA + hstep, voffA);
        if (wr == 1) PG8_BAR;
        PG8_WAIT_V(4); PG8_BAR;
        PG8_STAGE(PG8_SB(1, 0), cB + kstep, voffB); PG8_STAGE(PG8_SA(1, 0), cA + kstep, voffA); PG8_STAGE(PG8_SB(1, 1), cB + hstep + kstep, voffB);
        PG8_WAIT_V(6); PG8_BAR;
    }
    for (;;) {
        const bool has_next = S.next(ui + 1, nxt);
        if constexpr (GATHER) { if (has_next) PG8_GOFF(goffN, ui + 1); else { _Pragma("unroll") for (int _h = 0; _h < 2; ++_h) _Pragma("unroll") for (int _i = 0; _i < 2; ++_i) goffN[_h][_i] = goffA[_h][_i]; } }
        const char* nA = GATHER ? (const char*)g.A : has_next ? (const char*)g.A + (size_t)nxt.pm * tstep : cA; const char* nB = has_next ? (const char*)g.Bt + (size_t)nxt.pn * tstep : cB;
        for (int t = 0; t < nt; t += 2) {
            const bool last = (t == nt - 2);
            const char* a1 = cA + (size_t)(t + 1) * kstep;
            const char* a2 = last ? nA : cA + (size_t)(t + 2) * kstep; const char* b2 = last ? nB : cB + (size_t)(t + 2) * kstep;
            const char* a3 = a2 + kstep; const char* b3 = b2 + kstep;
            if (last && has_next) S.a_ready(nxt);
            if constexpr (SP2) {
            PG8_LDB(B0, 0, 0); PG8_LDB(B1, 0, 1); PG8_SCHED; PG8_LDA(At, 0, 0); PG8_STAGE_A(PG8_SA(1, 1), a1, 1, false);
            PG8_WAIT_V(8); PG8_WAIT_L(0); PG8_BAR; PG8_MMA(0, 0, At, B0); PG8_MMA(0, 1, At, B1); PG8_BAR; PG8_SCHED;
            PG8_LDA(At, 0, 1); PG8_STAGE(PG8_SB(0, 0), b2, voffB); PG8_STAGE(PG8_SB(0, 1), b2 + hstep, voffB); PG8_STAGE_A(PG8_SA(0, 0), a2, 0, last);
            PG8_WAIT_V(8); PG8_WAIT_L(0); PG8_BAR; PG8_MMA(1, 0, At, B0); PG8_MMA(1, 1, At, B1); PG8_BAR; PG8_SCHED;
            PG8_LDB(B0, 1, 0); PG8_LDB(B1, 1, 1); PG8_SCHED; PG8_LDA(At, 1, 0); PG8_STAGE_A(PG8_SA(0, 1), a2, 1, last);
            PG8_WAIT_V(8); PG8_WAIT_L(0); PG8_BAR; PG8_MMA(0, 0, At, B0); PG8_MMA(0, 1, At, B1); PG8_BAR; PG8_SCHED;
            PG8_LDA(At, 1, 1); PG8_STAGE(PG8_SB(1, 0), b3, voffB); PG8_STAGE(PG8_SB(1, 1), b3 + hstep, voffB); PG8_STAGE_A(PG8_SA(1, 0), a3, 0, last);
            PG8_WAIT_V(8); PG8_WAIT_L(0); PG8_BAR; PG8_MMA(1, 0, At, B0); PG8_MMA(1, 1, At, B1); PG8_BAR; PG8_SCHED;
            if constexpr (Epi::NSEG > 1) {
                if (t + 2 < nt && ((t + 2) & 7) == 0) E.rescale(acc, cur, (t + 2) / 8 - 1, wr, wc, fr, fq);
            }
            } else {
            PG8_LDB(B0, 0, 0); PG8_SCHED; PG8_LDA(At, 0, 0); PG8_STAGE(PG8_SA(1, 1), a1 + hstep, voffA);
            PG8_WAIT_L(8); PG8_BAR; PG8_WAIT_L(0); PG8_MMA(0, 0, At, B0); PG8_BAR; PG8_SCHED;
            PG8_LDB(B1, 0, 1); PG8_STAGE(PG8_SB(0, 0), b2, voffB);
            PG8_BAR; PG8_WAIT_L(0); PG8_MMA(0, 1, At, B1); PG8_BAR;
            PG8_LDA(At, 0, 1); PG8_STAGE(PG8_SA(0, 0), a2, voffA);
            PG8_BAR; PG8_WAIT_L(0); PG8_MMA(1, 0, At, B0); PG8_BAR; PG8_SCHED;
            PG8_STAGE(PG8_SB(0, 1), b2 + hstep, voffB);
            PG8_WAIT_V(6); PG8_BAR; PG8_MMA(1, 1, At, B1); PG8_BAR;
            PG8_LDB(B0, 1, 0); PG8_SCHED; PG8_LDA(At, 1, 0); PG8_STAGE(PG8_SA(0, 1), a2 + hstep, voffA);
            PG8_WAIT_L(8); PG8_BAR; PG8_WAIT_L(0); PG8_MMA(0, 0, At, B0); PG8_BAR; PG8_SCHED;
            PG8_LDB(B1, 1, 1); PG8_STAGE(PG8_SB(1, 0), b3, voffB);
            PG8_BAR; PG8_WAIT_L(0); PG8_MMA(0, 1, At, B1); PG8_BAR;
            PG8_LDA(At, 1, 1); PG8_STAGE(PG8_SA(1, 0), a3, voffA);
            PG8_BAR; PG8_WAIT_L(0); PG8_MMA(1, 0, At, B0); PG8_BAR; PG8_SCHED;
            PG8_STAGE(PG8_SB(1, 1), b3 + hstep, voffB);
            PG8_WAIT_V(6); PG8_BAR; PG8_MMA(1, 1, At, B1); PG8_BAR;
            }
        }
        if constexpr (ALIGN_EPI) { if (wr == 0) PG8_BAR; }
        if constexpr (F8) asm volatile("s_nop 15\n\ts_nop 15" ::: "memory");
        if constexpr (!Epi::AFTER_DRAIN) { E(acc, cur, wr, wc, fr, fq); S.done(cur); }
        if (!has_next) break;
#pragma unroll
        for (int a = 0; a < 2; ++a)
#pragma unroll
            for (int b = 0; b < 2; ++b)
#pragma unroll
                for (int m = 0; m < 4; ++m)
#pragma unroll
                    for (int n = 0; n < 2; ++n) acc[a][b][m][n] = (f32x4){0.f, 0.f, 0.f, 0.f};
        cur = nxt; cA = nA; cB = nB; ++ui;
        if constexpr (GATHER) { _Pragma("unroll") for (int _h = 0; _h < 2; ++_h) _Pragma("unroll") for (int _i = 0; _i < 2; ++_i) goffA[_h][_i] = goffN[_h][_i]; }
        if constexpr (ALIGN_EPI) { if (wr == 1) PG8_BAR; }
    }
    PG8_WAIT_V(0);
    if constexpr (!ALIGN_EPI) { if (wr == 0) PG8_BAR; }
    PG8_BAR;
    if constexpr (Epi::AFTER_DRAIN) { E.fused(acc, cur, wr, wc, fr, fq, lds, wid, lane); S.done(cur); }
#undef PG8_SA
#undef PG8_SB
#undef PG8_STAGE
#undef PG8_STAGE_A
#undef PG8_GOFF
#undef PG8_LDA
#undef PG8_LDB
#undef PG8_MMA
#undef PG8_WAIT_V
#undef PG8_WAIT_L
#undef PG8_BAR
#undef PG8_SCHED
}
}
#define XB_TMO      128
#define XB_XCNT(j)  (256  + 64 * (j))
#define XB_XSUB(j)  (1280 + 64 * (j))
#define XB_XGEN(j)  (2304 + 64 * (j))
#define XB_TOP      3328
#define XB_TOPGEN   3392
#define XCD_BAR_WORDS 3456
#define XB_SPIN_CAP (1u << 22)
#define LAS __attribute__((address_space(3)))

__device__ __forceinline__ unsigned xb_ld(unsigned* p)              { return __hip_atomic_load(p, __ATOMIC_RELAXED, __HIP_MEMORY_SCOPE_AGENT); }
__device__ __forceinline__ unsigned xb_add(unsigned* p, unsigned v) { asm volatile("" : "+v"(p));
    return __hip_atomic_fetch_add(p, v, __ATOMIC_RELAXED, __HIP_MEMORY_SCOPE_AGENT); }
__device__ __forceinline__ unsigned xb_xcc_id() { return (unsigned)__builtin_amdgcn_s_getreg((3 << 11) | 20) & 0xFu; }
#define XB_SPIN(cond, bar) do { unsigned _sp = 0; while (cond) { __builtin_amdgcn_s_sleep(1); \
    if ((++_sp & 255u) == 0u) { if (xb_ld(&(bar)[XB_TMO])) break; if (_sp > XB_SPIN_CAP) { xb_add(&(bar)[XB_TMO], 1u); break; } } } } while (0)

struct XcdBarrier {
    unsigned* bar; unsigned x; unsigned wv;
    volatile LAS unsigned* st;
};

__device__ __forceinline__ XcdBarrier xcd_barrier_post(unsigned* bar, volatile LAS unsigned* st) {
    XcdBarrier b; b.bar = bar; b.x = xb_xcc_id(); b.st = st;
    if (threadIdx.x == 0) (void)xb_add(&bar[XB_XCNT(b.x)], 1u);
    return b;
}
__device__ __forceinline__ void xcd_barrier_complete(unsigned* bar, unsigned x, unsigned& nloc, unsigned& nx) {
    const unsigned G = gridDim.x * gridDim.y * gridDim.z;
    unsigned sum, cnt, mine, sp = 0u;
    for (;;) {
        sum = 0u; cnt = 0u; mine = 0u;
#pragma unroll
        for (unsigned j = 0; j < 16; ++j) { const unsigned c = xb_ld(&bar[XB_XCNT(j)]); sum += c; cnt += (c > 0u) ? 1u : 0u; mine = (j == x) ? c : mine; }
        if (sum == G) break;
        __builtin_amdgcn_s_sleep(1);
        if ((++sp & 255u) == 0u) { if (xb_ld(&bar[XB_TMO])) break; if (sp > XB_SPIN_CAP) { xb_add(&bar[XB_TMO], 1u); break; } }
    }
    nloc = mine > 0u ? mine : 1u; nx = cnt > 0u ? cnt : 1u;
}

__device__ __forceinline__ void xcd_barrier(const XcdBarrier& b) {
    asm volatile("s_waitcnt vmcnt(0)" ::: "memory");
    __syncthreads();
    if (b.wv == 0u && lane_id() == 0) {
        unsigned* bar = b.bar;
        __builtin_amdgcn_s_waitcnt(0);
        unsigned nloc = b.st[0], nx = b.st[1];
        if (nloc == 0u) { xcd_barrier_complete(bar, b.x, nloc, nx); b.st[0] = nloc; b.st[1] = nx; }
        const unsigned old = xb_add(&bar[XB_XSUB(b.x)], 1u);
        const unsigned gen = old / nloc;
        if (old + 1u == (gen + 1u) * nloc) {
            __builtin_amdgcn_fence(__ATOMIC_RELEASE, "agent");
            asm volatile("s_waitcnt vmcnt(0)" ::: "memory");
            const unsigned og = xb_add(&bar[XB_TOP], 1u);
            const unsigned tg = og / nx;
            if (og + 1u == (tg + 1u) * nx) xb_add(&bar[XB_TOPGEN], 1u);
            else XB_SPIN(xb_ld(&bar[XB_TOPGEN]) == tg, bar);
            __builtin_amdgcn_fence(__ATOMIC_ACQUIRE, "agent");
            xb_add(&bar[XB_XGEN(b.x)], 1u);
            asm volatile("s_waitcnt vmcnt(0)" ::: "memory");
        } else {
            XB_SPIN(xb_ld(&bar[XB_XGEN(b.x)]) == gen, bar);
            __builtin_amdgcn_fence(__ATOMIC_ACQUIRE, "agent");
            asm volatile("s_waitcnt vmcnt(0)" ::: "memory");
        }
    }
    __syncthreads();
}

typedef unsigned short bf16_t;
typedef short bf16x8 __attribute__((ext_vector_type(8)));
typedef float f32x4 __attribute__((ext_vector_type(4)));
typedef float f32x16 __attribute__((ext_vector_type(16)));
typedef unsigned u32x4 __attribute__((ext_vector_type(4)));
typedef unsigned u32x2 __attribute__((ext_vector_type(2)));

constexpr int D = 1024, NB = 16, SEQ = 2048, CTX = 256, NL = 4;
constexpr int TL = NB * SEQ, TC = NB * CTX, TT = TL + TC;
constexpr int DIN = 6144, HYW = 512, NE = 16, DE = 512, KEYS = CTX + SEQ;
constexpr int NMOD = 6, NBM = NB + 1;
constexpr int APROWS = 2 * TT + NE * 256;
constexpr float EPS = 1e-6f, LOG2E = 1.4426950408889634f;
constexpr float QSCALE = 0.125f * LOG2E;

constexpr size_t MiB = 1u << 20;
constexpr size_t WS_CTL = 0, CTL_ZERO_BYTES = 1 * MiB;
constexpr size_t WS_MOD = 1 * MiB;
constexpr size_t WS_ROPE = 3 * MiB;
constexpr size_t WS_FL = 4 * MiB, WS_FC = 20 * MiB;
constexpr size_t WS_MISC = 22 * MiB;
constexpr size_t WS_FNORM = WS_MISC;
constexpr size_t WS_TOKE = WS_MISC + 64 * 1024, WS_TOKP = WS_MISC + 352 * 1024, WS_TOKW = WS_MISC + 640 * 1024;
constexpr size_t WS_ROWMAP = WS_MISC + 960 * 1024, WS_ROWW = WS_MISC + 1280 * 1024;
constexpr size_t WS_WIN = 24 * MiB, WS_WBR = 36 * MiB, WS_WOUT = 39 * MiB;
constexpr size_t WS_XC = 41 * MiB;
constexpr size_t WS_NP = WS_XC;
constexpr size_t WS_H = 57 * MiB;
constexpr size_t WS_KA = 129 * MiB, WS_VTA = 138 * MiB, WS_KW = 147 * MiB, WS_VTW = 156 * MiB;
constexpr size_t WS_QA = 165 * MiB, WS_QW = 201 * MiB, WS_YH = 237 * MiB, WS_VT = 273 * MiB, WS_YT = 309 * MiB;
constexpr size_t WS_RAWA = 309 * MiB, WS_RAWW = 327 * MiB;
constexpr size_t WS_F = 165 * MiB;
constexpr size_t WS_U = 345 * MiB;
constexpr size_t WS_G = 453 * MiB;
constexpr size_t WS_W13 = 605 * MiB, WS_W2 = 637 * MiB;
constexpr size_t WS_EROW = 669 * MiB, WS_EROWW = 672 * MiB;
constexpr size_t WS_H8 = 675 * MiB;
constexpr size_t WS_WG8 = 711 * MiB;
constexpr size_t WS_END = 714 * MiB;
static_assert(WS_G + (size_t)APROWS * 2048 <= WS_W13 && WS_W2 + (size_t)16 * 1024 * 512 * 2 <= WS_END && WS_G + (size_t)TT * 3072 * 2 <= WS_END, "ws map");
static_assert(WS_U + (size_t)APROWS * 1024 <= WS_G && WS_F + (size_t)2 * TT * 2048 <= WS_YT, "ws map 2");
constexpr size_t VT_CTX_OFF = (size_t)HYW * NB * SEQ;

constexpr int CW_BAR = 4096, CW_CNT = 8192, CW_PANEL = 16384, CW_HTMO = 12288;
constexpr int LDS_BYTES = 151552, MISC_OFF = 147456;
constexpr int NWAVES = 8, NTHR = 512;

struct Args { const float* in[29]; float* out; unsigned char* ws; int ph_lo, ph_hi; };
enum { I_X = 0, I_C, I_CTX, I_CCTX, I_ADAW, I_ADAB, I_N1G, I_N2G, I_WIN, I_QKG, I_HSW, I_HSB, I_HW1, I_HB1, I_HFR, I_HW2, I_HB2, I_HW3, I_HBIAS, I_SINK, I_WBR, I_WOUT,
       I_RGW, I_RGB, I_REW, I_REB, I_EW1, I_EW3, I_EW2 };

#define LDS_WAIT() asm volatile("s_waitcnt lgkmcnt(0)" ::: "memory")
#define VM_WAIT() asm volatile("s_waitcnt vmcnt(0)" ::: "memory")

typedef float f32x2_t __attribute__((ext_vector_type(2)));
typedef __bf16 bf16x2_t __attribute__((ext_vector_type(2)));
__device__ __forceinline__ unsigned cvtpk(float lo, float hi) { f32x2_t v = {lo, hi}; bf16x2_t b = __builtin_convertvector(v, bf16x2_t); return __builtin_bit_cast(unsigned, b); }
__device__ __forceinline__ unsigned zero_u32() { unsigned z; asm volatile("v_mov_b32 %0, 0" : "=v"(z)); return z; }
__device__ __forceinline__ unsigned cvt4_fp8(float a, float b, float c, float d) { int r = __builtin_amdgcn_cvt_pk_fp8_f32(a, b, 0, false); r = __builtin_amdgcn_cvt_pk_fp8_f32(c, d, r, true); return (unsigned)r; }
__device__ __forceinline__ float bflo(unsigned u) { return __builtin_bit_cast(float, u << 16); }
__device__ __forceinline__ float bfhi(unsigned u) { return __builtin_bit_cast(float, u & 0xffff0000u); }
__device__ __forceinline__ float bf1(bf16_t u) { return __builtin_bit_cast(float, (unsigned)u << 16); }
__device__ __forceinline__ bf16_t f2bf(float f) { return (bf16_t)(cvtpk(f, 0.f) & 0xffffu); }
#define DPP_F(v, ctrl) __builtin_bit_cast(float, __builtin_amdgcn_update_dpp(0, __builtin_bit_cast(int, (v)), (ctrl), 0xf, 0xf, false))
__device__ __forceinline__ float row16_sum(float v) {
    v += DPP_F(v, 0xB1);
    v += DPP_F(v, 0x4E);
    v += DPP_F(v, 0x141);
    v += DPP_F(v, 0x140);
    return v;
}
__device__ __forceinline__ float wave_sum(float v) {
    v = row16_sum(v);
    const int iv = __builtin_bit_cast(int, v);
    float r = (__builtin_bit_cast(float, __builtin_amdgcn_readlane(iv, 0)) + __builtin_bit_cast(float, __builtin_amdgcn_readlane(iv, 16)))
            + (__builtin_bit_cast(float, __builtin_amdgcn_readlane(iv, 32)) + __builtin_bit_cast(float, __builtin_amdgcn_readlane(iv, 48)));
    asm volatile("" : "+v"(r));
    return r;
}
__device__ __forceinline__ float fast_exp2(float x) { return __builtin_amdgcn_exp2f(x); }
__device__ __forceinline__ float fast_rcp(float x) { return __builtin_amdgcn_rcpf(x); }
__device__ __forceinline__ float sigmoid_f(float x) { return fast_rcp(1.f + fast_exp2(-x * LOG2E)); }

__device__ __forceinline__ void sincos_acc(float x, float& s, float& c) {
    const float q = rintf(x * 0.636619772367581f);
    float y = fmaf(-q, 1.57079625129699707031f, x);
    y = fmaf(-q, 7.54978941586159635335e-08f, y);
    const float y2 = y * y;
    float sp = fmaf(y2, 2.7557314297e-06f, -1.9841270114e-04f); sp = fmaf(sp, y2, 8.3333337680e-03f); sp = fmaf(sp, y2, -1.6666667163e-01f); sp = fmaf(sp * y2, y, y);
    float cp = fmaf(y2, -2.7557314297e-07f, 2.4801587642e-05f); cp = fmaf(cp, y2, -1.3888889225e-03f); cp = fmaf(cp, y2, 4.1666667908e-02f); cp = fmaf(cp, y2, -0.5f); cp = fmaf(cp, y2, 1.0f);
    const int n = (int)q & 3;
    const float s1 = (n & 1) ? cp : sp, c1 = (n & 1) ? sp : cp;
    s = (n & 2) ? -s1 : s1;
    c = ((n + 1) & 2) ? -c1 : c1;
}

struct Fr { LAS unsigned char* lds; int tid, lane, wave, G, bid; };

__device__ __forceinline__ void pro_mod(const Fr& F, const Args& a) {
    LAS float* s = (LAS float*)F.lds;
    LAS float* red = (LAS float*)(F.lds + 69632);
    const float* c = a.in[I_C]; const float* cc = a.in[I_CCTX]; const float* W = a.in[I_ADAW]; const float* Bv = a.in[I_ADAB];
    float* MOD = (float*)(a.ws + WS_MOD);
    for (int i = F.tid; i < NBM * 1024; i += NTHR) { const int bb = i >> 10, k = i & 1023; const float v = (bb < NB) ? c[bb * 1024 + k] : cc[k]; s[i] = v / (1.f + __expf(-v)); }
    __syncthreads();
    const int col = F.tid & 63, ks = F.wave;
    for (int unit = F.G - 1 - F.bid; unit < NL * 96; unit += F.G) {
        const int l = unit / 96, j0 = (unit % 96) * 64;
        float acc[NBM];
#pragma unroll
        for (int bb = 0; bb < NBM; ++bb) acc[bb] = 0.f;
        const float* Wp = W + ((size_t)l * 1024 + ks * 128) * DIN + j0 + col;
#pragma unroll 2
        for (int k = 0; k < 128; k += 4) {
            const float w0 = Wp[(size_t)k * DIN], w1 = Wp[(size_t)(k + 1) * DIN], w2 = Wp[(size_t)(k + 2) * DIN], w3 = Wp[(size_t)(k + 3) * DIN];
#pragma unroll
            for (int bb = 0; bb < NBM; ++bb) { const f32x4 sv = *(const LAS f32x4*)(s + bb * 1024 + ks * 128 + k);
                acc[bb] = fmaf(sv.x, w0, acc[bb]); acc[bb] = fmaf(sv.y, w1, acc[bb]); acc[bb] = fmaf(sv.z, w2, acc[bb]); acc[bb] = fmaf(sv.w, w3, acc[bb]); } }
#pragma unroll
        for (int bb = 0; bb < NBM; ++bb) red[(ks * NBM + bb) * 64 + col] = acc[bb];
        __syncthreads();
        for (int o = F.tid; o < NBM * 64; o += NTHR) { const int bb = o >> 6, cx = o & 63; float sum = 0.f;
#pragma unroll
            for (int k2 = 0; k2 < 8; ++k2) sum += red[(k2 * NBM + bb) * 64 + cx];
            MOD[((size_t)l * NBM + bb) * DIN + j0 + cx] = sum + Bv[l * DIN + j0 + cx]; }
        __syncthreads();
    }
}

__device__ __forceinline__ void pro_rope(const Fr& F, const Args& a) {
    float* ct = (float*)(a.ws + WS_ROPE); float* st = ct + SEQ * 32;
    for (int i = F.bid * NTHR + F.tid; i < SEQ * 32; i += F.G * NTHR) {
        const int pos = i >> 5, ax = (i >> 4) & 1, f = i & 15;
        const float inv = exp2f(-(float)f * (13.287712379549449f / 16.f));
        const float ang = (float)(ax == 0 ? (pos >> 6) : (pos & 63)) * inv;
        float sv, cv; sincos_acc(ang, sv, cv); ct[i] = cv; st[i] = sv;
    }
}

__device__ __forceinline__ void pro_filter(const Fr& F, const Args& a) {
    LAS float* L = (LAS float*)F.lds;
    constexpr int oW1 = 0, oB1 = 2112, oFR = 2176, oB2 = 2240, oW2 = 2304, oZ = 6400, oH1 = 7552, oH2 = 9600, oW3 = 11648, oT = 19840;
    bf16_t* FL = (bf16_t*)(a.ws + WS_FL); bf16_t* FC = (bf16_t*)(a.ws + WS_FC); float* NP = (float*)(a.ws + WS_NP);
    const int p = F.tid >> 4, jj = F.tid & 15;
    for (int unit = F.bid; unit < NL * 72; unit += F.G) {
        const int l = unit / 72, ch = unit % 72; const bool lat = ch < 64; const int n = lat ? SEQ : CTX, pos0 = lat ? ch * 32 : (ch - 64) * 32;
        __syncthreads();
        for (int i = F.tid; i < 2112; i += NTHR) L[oW1 + i] = a.in[I_HW1][l * 2112 + i];
        for (int i = F.tid; i < 64; i += NTHR) { L[oB1 + i] = a.in[I_HB1][l * 64 + i]; L[oFR + i] = a.in[I_HFR][l * 64 + i]; L[oB2 + i] = a.in[I_HB2][l * 64 + i]; }
        for (int i = F.tid; i < 4096; i += NTHR) L[oW2 + i] = a.in[I_HW2][l * 4096 + i];
        const int pos = pos0 + p; const float t = (float)pos / (float)(n - 1);
        { const float band = 1e-4f + (float)jj * ((15.f - 1e-4f) / 15.f); const float ang = ((6.2831855f * band) * (float)pos) / (float)n;
          float sv, cv; sincos_acc(ang, sv, cv); L[oZ + p * 36 + 1 + jj] = cv; L[oZ + p * 36 + 17 + jj] = -sv; if (jj == 0) L[oZ + p * 36] = t; }
        __syncthreads();
        { f32x4 acc = *(const LAS f32x4*)(L + oB1 + 4 * jj);
#pragma unroll 3
          for (int i = 0; i < 33; ++i) { const float z = L[oZ + p * 36 + i]; const f32x4 w = *(const LAS f32x4*)(L + oW1 + i * 64 + 4 * jj); acc.x = fmaf(z, w.x, acc.x); acc.y = fmaf(z, w.y, acc.y); acc.z = fmaf(z, w.z, acc.z); acc.w = fmaf(z, w.w, acc.w); }
          const f32x4 fr = *(const LAS f32x4*)(L + oFR + 4 * jj); float sv, cv; f32x4 o;
          sincos_acc(fr.x * acc.x, sv, cv); o.x = sv; sincos_acc(fr.y * acc.y, sv, cv); o.y = sv; sincos_acc(fr.z * acc.z, sv, cv); o.z = sv; sincos_acc(fr.w * acc.w, sv, cv); o.w = sv;
          *(LAS f32x4*)(L + oH1 + p * 64 + 4 * jj) = o; }
        __syncthreads();
        { f32x4 acc = *(const LAS f32x4*)(L + oB2 + 4 * jj);
#pragma unroll 4
          for (int i = 0; i < 64; ++i) { const float z = L[oH1 + p * 64 + i]; const f32x4 w = *(const LAS f32x4*)(L + oW2 + i * 64 + 4 * jj); acc.x = fmaf(z, w.x, acc.x); acc.y = fmaf(z, w.y, acc.y); acc.z = fmaf(z, w.z, acc.z); acc.w = fmaf(z, w.w, acc.w); }
          const f32x4 fr = *(const LAS f32x4*)(L + oFR + 4 * jj); float sv, cv; f32x4 o;
          sincos_acc(fr.x * acc.x, sv, cv); o.x = sv; sincos_acc(fr.y * acc.y, sv, cv); o.y = sv; sincos_acc(fr.z * acc.z, sv, cv); o.z = sv; sincos_acc(fr.w * acc.w, sv, cv); o.w = sv;
          *(LAS f32x4*)(L + oH2 + p * 64 + 4 * jj) = o; }
        LAS bf16_t* T = (LAS bf16_t*)(L + oT);
#pragma unroll 1
        for (int mh = 0; mh < 1; ++mh) {
            f32x4 acc[16];
#pragma unroll
            for (int m = 0; m < 16; ++m) acc[m] = (f32x4){0.f, 0.f, 0.f, 0.f};
#pragma unroll 1
            for (int kc = 0; kc < 8; ++kc) {
                __syncthreads();
                for (int i = F.tid; i < 2048; i += NTHR) *(LAS f32x4*)(L + oW3 + i * 4) = *(const f32x4*)(a.in[I_HW3] + ((size_t)l * 64 + kc * 8) * 1024 + i * 4);
                __syncthreads();
#pragma unroll 1
                for (int k = 0; k < 8; ++k) { const float h = L[oH2 + p * 64 + kc * 8 + k];
#pragma unroll
                    for (int m = 0; m < 16; ++m) { const f32x4 w = *(const LAS f32x4*)(L + oW3 + k * 1024 + 64 * m + 4 * jj);
                        acc[m].x = fmaf(h, w.x, acc[m].x); acc[m].y = fmaf(h, w.y, acc[m].y); acc[m].z = fmaf(h, w.z, acc[m].z); acc[m].w = fmaf(h, w.w, acc[m].w); } }
            }
#pragma unroll
            for (int m = 0; m < 16; ++m) {
                const int colb = 64 * m + 4 * jj; const int dirb = m >> 3;
                const float v4[4] = {acc[m].x, acc[m].y, acc[m].z, acc[m].w};
#pragma unroll
                for (int e = 0; e < 4; ++e) { const int col = colb + e, c = col & 511;
                    const float dl = fabsf(-3.0701134573253943f + (-15.350567286626972f + 3.0701134573253943f) * ((float)c / 511.f));
                    float v = v4[e] * __expf(-t * dl); if (dirb == 1 && pos == 0) v = 0.f;
                    T[col * 32 + (dirb == 0 ? 31 - p : p)] = f2bf(v); }
            }
        }
        __syncthreads();
        for (int idx = F.tid; idx < 1024 * 32; idx += NTHR) { const int col = idx >> 5, i = idx & 31, dir = col >> 9, c = col & 511;
            const int u = (dir == 0) ? (n - 32 - pos0 + i) : ((pos0 + i == 0) ? 2 * n - 1 : n - 1 + pos0 + i);
            bf16_t* Fb = lat ? FL + ((size_t)l * 512 + c) * 4096 : FC + ((size_t)l * 512 + c) * 512;
            Fb[u] = T[col * 32 + i]; }
        for (int col = F.tid; col < 1024; col += NTHR) { float sum = 0.f;
#pragma unroll 8
            for (int i = 0; i < 32; ++i) sum += fabsf(bf1(T[col * 32 + i]));
            NP[((size_t)l * 72 + ch) * 1024 + col] = sum; }
    }
    __syncthreads();
}
__device__ __forceinline__ void filter_norm_reduce(const Fr& F, const Args& a) {
    const float* NP = (const float*)(a.ws + WS_NP); float* FN = (float*)(a.ws + WS_FNORM);
    for (int o = F.bid * NTHR + F.tid; o < NL * 2 * 512; o += F.G * NTHR) { const int l = o >> 10, isc = (o >> 9) & 1, c = o & 511;
        const int ch0 = isc ? 64 : 0, ch1 = isc ? 72 : 64; float sum = 0.f;
        for (int ch = ch0; ch < ch1; ++ch) sum += NP[((size_t)l * 72 + ch) * 1024 + c] + NP[((size_t)l * 72 + ch) * 1024 + 512 + c];
        FN[o] = 1.f / sum; }
}

template <int MODE>
__device__ __forceinline__ void transpose_item(const float* W, int K, int N, bf16_t* WT, int row_off, LAS float* scr, int item, int lane, int ldk = 0) {
    if (ldk == 0) ldk = K;
    const int nblk = N / 64, kb = item / nblk, nb = item % nblk, k0 = 64 * kb, n0 = 64 * nb;
    f32x4 v[16];
#pragma unroll
    for (int i = 0; i < 16; ++i) v[i] = *(const f32x4*)(W + (size_t)(k0 + 4 * i + (lane >> 4)) * N + n0 + (lane & 15) * 4);
#pragma unroll
    for (int i = 0; i < 16; ++i) *(LAS f32x4*)(scr + (4 * i + (lane >> 4)) * 68 + (lane & 15) * 4) = v[i];
    LDS_WAIT();
    const int c = lane & 7;
#pragma unroll
    for (int j = 0; j < 8; ++j) { const int n = (lane >> 3) + 8 * j; const LAS float* s = scr + (8 * c) * 68 + n;
        u32x4 o; o.x = cvtpk(s[0 * 68], s[1 * 68]); o.y = cvtpk(s[2 * 68], s[3 * 68]); o.z = cvtpk(s[4 * 68], s[5 * 68]); o.w = cvtpk(s[6 * 68], s[7 * 68]);
        const int nn = n0 + n; const int row = (MODE == 0) ? nn : ((nn >> 2) * 8 + (nn & 3) + (MODE == 2 ? 4 : 0));
        *(u32x4*)(WT + (size_t)(row_off + row) * ldk + k0 + 8 * c) = o; }
    LDS_WAIT();
}

__device__ __forceinline__ void transpose_item_f8(const float* W, bf16_t*  , unsigned char* WT, LAS float* scr, int item, int lane) {
    constexpr int K = 1024, N = DIN; const int nblk = 48, kb = item / nblk, nb = item % nblk, k0 = 64 * kb, n0 = 3072 + 64 * nb;
    f32x4 v[16];
#pragma unroll
    for (int i = 0; i < 16; ++i) v[i] = *(const f32x4*)(W + (size_t)(k0 + 4 * i + (lane >> 4)) * N + n0 + (lane & 15) * 4);
#pragma unroll
    for (int i = 0; i < 16; ++i) *(LAS f32x4*)(scr + (4 * i + (lane >> 4)) * 68 + (lane & 15) * 4) = v[i];
    LDS_WAIT();
    const int c = lane & 7;
#pragma unroll
    for (int j = 0; j < 8; ++j) { const int n = (lane >> 3) + 8 * j; const LAS float* s = scr + (8 * c) * 68 + n;
        u32x2 o; o.x = cvt4_fp8(s[0 * 68] * 64.f, s[1 * 68] * 64.f, s[2 * 68] * 64.f, s[3 * 68] * 64.f); o.y = cvt4_fp8(s[4 * 68] * 64.f, s[5 * 68] * 64.f, s[6 * 68] * 64.f, s[7 * 68] * 64.f);
        *(u32x2*)(WT + (size_t)(n0 - 3072 + n) * K + k0 + 8 * c) = o; }
    LDS_WAIT();
}
__device__ __forceinline__ void conv_small_weights(const Fr& F, const Args& a, int l, int mask, int b0) {
    if (F.bid < b0) return;
    LAS float* scr = (LAS float*)(F.lds + F.wave * 17408);
    const int gw = (F.bid - b0) * NWAVES + F.wave, NGW = (F.G - b0) * NWAVES;
    constexpr int I_IN = (1024 / 64) * (DIN / 64), I_BR = (512 / 64) * (1024 / 64), I_OUT = (1024 / 64) * (1024 / 64);
    if (mask & 1) {
        for (int it = gw; it < 16 * 48; it += NGW) { const int kb = it / 48, nb = it % 48; transpose_item<0>(a.in[I_WIN] + (size_t)l * 1024 * DIN, 1024, DIN, (bf16_t*)(a.ws + WS_WIN), 0, scr, kb * 96 + nb, F.lane); }
        for (int it = gw; it < 16 * 48; it += NGW) transpose_item_f8(a.in[I_WIN] + (size_t)l * 1024 * DIN, nullptr, a.ws + WS_WG8, scr, it, F.lane);
    }
    if (mask & 2) for (int it = gw; it < 3 * I_BR; it += NGW) { const int b = it / I_BR; transpose_item<0>(a.in[I_WBR] + ((size_t)l * 3 + b) * 512 * 1024, 512, 1024, (bf16_t*)(a.ws + WS_WBR) + b * 512, 0, scr, it % I_BR, F.lane, 1536); }
    if (mask & 4) for (int it = gw; it < I_OUT; it += NGW) transpose_item<0>(a.in[I_WOUT] + (size_t)l * 1024 * 1024, 1024, 1024, (bf16_t*)(a.ws + WS_WOUT), 0, scr, it, F.lane);
}
__device__ __forceinline__ void conv_expert_weights(const Fr& F, const Args& a, int l, int b0, int it0, int it1) {
    if (F.bid < b0) return;
    LAS float* scr = (LAS float*)(F.lds + F.wave * 17408);
    const int gw = (F.bid - b0) * NWAVES + F.wave, NGW = (F.G - b0) * NWAVES;
    constexpr int I_1 = (1024 / 64) * (512 / 64), I_2 = (512 / 64) * (1024 / 64);
    for (int it = it0 + gw; it < it1; it += NGW) {
        const int e = it / (2 * I_1 + I_2); int r = it % (2 * I_1 + I_2);
        bf16_t* W13 = (bf16_t*)(a.ws + WS_W13); bf16_t* W2 = (bf16_t*)(a.ws + WS_W2);
        if (r < I_1) { transpose_item<1>(a.in[I_EW1] + ((size_t)l * NE + e) * 1024 * 512, 1024, 512, W13, e * 1024, scr, r, F.lane); continue; } r -= I_1;
        if (r < I_1) { transpose_item<2>(a.in[I_EW3] + ((size_t)l * NE + e) * 1024 * 512, 1024, 512, W13, e * 1024, scr, r, F.lane); continue; } r -= I_1;
        transpose_item<0>(a.in[I_EW2] + ((size_t)l * NE + e) * 512 * 1024, 512, 1024, W2, e * 1024, scr, r, F.lane);
    }
}
constexpr int CONV_E_ITEMS = NE * 384, CONV_E_SPLIT = CONV_E_ITEMS / 2;

__device__ __forceinline__ int mod_row(int row) { return row < TL ? (row >> 11) : NB; }

__device__ __forceinline__ void rows_p0(const Fr& F, const Args& a, int l, int nrows) {
    const int gw = F.bid * NWAVES + F.wave, NGW = F.G * NWAVES;
    const float* g1 = a.in[I_N1G] + l * 1024;
    const float* MODl = (const float*)(a.ws + WS_MOD) + (size_t)l * NBM * DIN;
    const float* MODp = (const float*)(a.ws + WS_MOD) + (size_t)(l > 0 ? l - 1 : 0) * NBM * DIN;
    const bf16_t* Fs = (const bf16_t*)(a.ws + WS_F);
    bf16_t* H = (bf16_t*)(a.ws + WS_H); unsigned char* H8 = a.ws + WS_H8;
    const int per = 2 * ((nrows + 2 * NGW - 1) / (2 * NGW)), w0 = gw * per, w1 = (w0 + per < nrows) ? w0 + per : nrows;
    f32x4 gv[4], shv[4], scv[4], m5v[4]; int cur = -1;
#pragma unroll
    for (int j = 0; j < 4; ++j) { gv[j] = *(const f32x4*)(g1 + F.lane * 4 + 256 * j); shv[j] = gv[j]; scv[j] = gv[j]; m5v[j] = gv[j]; }
#define P0_LOAD(rb, V, F0, F1) do { _Pragma("unroll") for (int q = 0; q < 2; ++q) { const int row = (rb) + q; const bool lat = row < TL; \
            const float* xs = lat ? ((l == 0) ? a.in[I_X] + (size_t)row * D : a.out + (size_t)row * D) : ((l == 0) ? a.in[I_CTX] + (size_t)(row - TL) * D : (const float*)(a.ws + WS_XC) + (size_t)(row - TL) * D); \
            _Pragma("unroll") for (int j = 0; j < 4; ++j) { const int col = F.lane * 4 + 256 * j; V[q][j] = *(const f32x4*)(xs + col); \
                if (l > 0) { F0[q][j] = *(const u32x2*)(Fs + (size_t)row * D + col); F1[q][j] = *(const u32x2*)(Fs + ((size_t)TT + row) * D + col); } } } } while (0)
#define P0_PROC(rb, V, F0, F1) do { _Pragma("unroll") for (int q = 0; q < 2; ++q) { const int row = (rb) + q; const bool lat = row < TL; const int mr = mod_row(row); \
            if (mr != cur) { cur = mr; _Pragma("unroll") for (int j = 0; j < 4; ++j) { const int col = F.lane * 4 + 256 * j; \
                shv[j] = *(const f32x4*)(MODl + (size_t)mr * DIN + col); scv[j] = *(const f32x4*)(MODl + (size_t)mr * DIN + 1024 + col); m5v[j] = *(const f32x4*)(MODp + (size_t)mr * DIN + 5 * 1024 + col); } } \
            float* xd = lat ? a.out + (size_t)row * D : (float*)(a.ws + WS_XC) + (size_t)(row - TL) * D; float ss = 0.f; \
            if (l > 0) { _Pragma("unroll") for (int j = 0; j < 4; ++j) { const int col = F.lane * 4 + 256 * j; \
                    V[q][j].x += m5v[j].x * (bflo(F0[q][j].x) + bflo(F1[q][j].x)); V[q][j].y += m5v[j].y * (bfhi(F0[q][j].x) + bfhi(F1[q][j].x)); \
                    V[q][j].z += m5v[j].z * (bflo(F0[q][j].y) + bflo(F1[q][j].y)); V[q][j].w += m5v[j].w * (bfhi(F0[q][j].y) + bfhi(F1[q][j].y)); \
                    *(f32x4*)(xd + col) = V[q][j]; } } \
            _Pragma("unroll") for (int j = 0; j < 4; ++j) ss += (V[q][j].x * V[q][j].x + V[q][j].y * V[q][j].y) + (V[q][j].z * V[q][j].z + V[q][j].w * V[q][j].w); \
            const float r = 1.f / sqrtf(wave_sum(ss) * (1.f / D) + EPS); \
            _Pragma("unroll") for (int j = 0; j < 4; ++j) { const int col = F.lane * 4 + 256 * j; \
                const f32x4 o = (V[q][j] * r * gv[j]) * (scv[j] + 1.f) + shv[j]; \
                u32x2 w; w.x = cvtpk(o.x, o.y); w.y = cvtpk(o.z, o.w); \
                *(u32x2*)(H + (size_t)row * D + col) = w; \
                *(unsigned*)(H8 + (size_t)row * D + col) = cvt4_fp8(o.x, o.y, o.z, o.w); } } } while (0)
    f32x4 vA[2][4], vB[2][4]; u32x2 fA0[2][4], fA1[2][4], fB0[2][4], fB1[2][4];
    if (w0 < w1) P0_LOAD(w0, vA, fA0, fA1);
    for (int rb = w0; rb < w1; rb += 4) {
        if (rb + 2 < w1) P0_LOAD(rb + 2, vB, fB0, fB1);
        P0_PROC(rb, vA, fA0, fA1);
        if (rb + 2 < w1) { if (rb + 4 < w1) P0_LOAD(rb + 4, vA, fA0, fA1); P0_PROC(rb + 2, vB, fB0, fB1); }
    }
#undef P0_LOAD
#undef P0_PROC
}
__device__ __forceinline__ void rows_final(const Fr& F, const Args& a) {
    const int gw = F.bid * NWAVES + F.wave, NGW = F.G * NWAVES;
    const float* MODp = (const float*)(a.ws + WS_MOD) + (size_t)(NL - 1) * NBM * DIN;
    const bf16_t* Fs = (const bf16_t*)(a.ws + WS_F);
    for (int row = gw; row < TL; row += NGW) {
        const int mr = row >> 11; float* xd = a.out + (size_t)row * D;
#pragma unroll
        for (int j = 0; j < 4; ++j) { const int col = F.lane * 4 + 256 * j;
            f32x4 v = *(const f32x4*)(xd + col);
            const u32x2 f0 = *(const u32x2*)(Fs + (size_t)row * D + col), f1 = *(const u32x2*)(Fs + ((size_t)TT + row) * D + col);
            const f32x4 m5 = *(const f32x4*)(MODp + (size_t)mr * DIN + 5 * 1024 + col);
            v.x += m5.x * (bflo(f0.x) + bflo(f1.x)); v.y += m5.y * (bfhi(f0.x) + bfhi(f1.x)); v.z += m5.z * (bflo(f0.y) + bflo(f1.y)); v.w += m5.w * (bfhi(f0.y) + bfhi(f1.y));
            *(f32x4*)(xd + col) = v; }
    }
}

__device__ __forceinline__ void rows_p5(const Fr& F, const Args& a, int l, int nrows, unsigned long long& sacc, const int swhich) {
#if defined(PROBE_P)
    unsigned long long st0 = __builtin_amdgcn_s_memrealtime();
#define SUBMARK5(w) do { const unsigned long long t_ = __builtin_amdgcn_s_memrealtime(); if (swhich == (w)) sacc += t_ - st0; st0 = t_; } while (0)
#else
#define SUBMARK5(w) do { } while (0)
#endif
    typedef float f32x4v __attribute__((ext_vector_type(4)));
    LAS float* RW = (LAS float*)F.lds;
    constexpr int RWS = 1028;
    LAS float* RB = (LAS float*)(F.lds + 82304);
    LAS int* LC = (LAS int*)(F.lds + 82432);
    LAS int* TE = (LAS int*)(F.lds + 82560);
    LAS int* TP = TE + 256;
    LAS float* TW = (LAS float*)(TP + 256);
    LAS float* RN = (LAS float*)(F.lds + 86784);
    LAS float* LG = (LAS float*)(F.lds + 87424);
    LAS float* GM = (LAS float*)(F.lds + 99072);
    LAS float* BI = (LAS float*)(F.lds + 107264);
    const float* g2 = a.in[I_N2G] + l * 1024;
    const float* MODl = (const float*)(a.ws + WS_MOD) + (size_t)l * NBM * DIN;
    bf16_t* H = (bf16_t*)(a.ws + WS_H);
    int* EROW = (int*)(a.ws + WS_EROW); float* EROWW = (float*)(a.ws + WS_EROWW);
    unsigned* CNT = (unsigned*)(a.ws + WS_CTL) + CW_CNT + l * 256;
    for (int f = F.tid; f < 1024; f += NTHR) { const f32x4 v = *(const f32x4*)(a.in[I_RGW] + ((size_t)l * 1024 + f) * 4);
        RW[0 * RWS + f] = v.x; RW[1 * RWS + f] = v.y; RW[2 * RWS + f] = v.z; RW[3 * RWS + f] = v.w; }
    for (int f = F.tid; f < 4096; f += NTHR) { const int k = f >> 2, c4 = (f & 3) * 4; const f32x4 v = *(const f32x4*)(a.in[I_REW] + ((size_t)l * 1024 + k) * 16 + c4);
        RW[(4 + c4) * RWS + k] = v.x; RW[(5 + c4) * RWS + k] = v.y; RW[(6 + c4) * RWS + k] = v.z; RW[(7 + c4) * RWS + k] = v.w; }
    if (F.tid < 20) RB[F.tid] = (F.tid < 4) ? a.in[I_RGB][l * 4 + F.tid] : a.in[I_REB][l * 16 + F.tid - 4];
    constexpr int P5_CH = 144;
    const int nch = (nrows + P5_CH - 1) / P5_CH;
    SUBMARK5(40);
    for (int ch = F.bid; ch < nch; ch += F.G) {
    const int r0 = ch * P5_CH, r1 = (r0 + P5_CH < nrows) ? r0 + P5_CH : nrows;
    const int mb0 = mod_row(r0), mb1 = mod_row(r1 - 1);
    if (F.tid < 32) LC[F.tid] = 0;
    for (int i = F.tid; i < 2048; i += NTHR) { const int s = i >> 10, k = i & 1023; GM[i] = g2[k] * (1.f + MODl[(size_t)(s ? mb1 : mb0) * DIN + 4 * 1024 + k]); }
    __syncthreads();
    if (F.wave < 4) {
    for (int rowb = r0 + 2 * F.wave; rowb < r1; rowb += 2 * 4) {
        f32x4 v[2][4]; bool val[2];
#pragma unroll
        for (int q = 0; q < 2; ++q) { const int row = rowb + q; val[q] = row < r1; const int rr = val[q] ? row : rowb;
            const bool lat = rr < TL; const float* xs = lat ? a.out + (size_t)rr * D : (const float*)(a.ws + WS_XC) + (size_t)(rr - TL) * D;
#pragma unroll
            for (int j = 0; j < 4; ++j) v[q][j] = *(const f32x4*)(xs + F.lane * 4 + 256 * j); }
#pragma unroll
        for (int q = 0; q < 2; ++q) { const int rr = val[q] ? rowb + q : rowb; const int mr = mod_row(rr); float ss = 0.f;
#pragma unroll
            for (int j = 0; j < 4; ++j) ss += (v[q][j].x * v[q][j].x + v[q][j].y * v[q][j].y) + (v[q][j].z * v[q][j].z + v[q][j].w * v[q][j].w);
            const float r = 1.f / sqrtf(wave_sum(ss) * (1.f / D) + EPS);
            if (F.lane == 0 && val[q]) RN[rr - r0] = r;
#pragma unroll
            for (int j = 0; j < 4; ++j) { const int col = F.lane * 4 + 256 * j;
                const f32x4 g = *(const f32x4*)(g2 + col), sh = *(const f32x4*)(MODl + (size_t)mr * DIN + 3 * 1024 + col), sc = *(const f32x4*)(MODl + (size_t)mr * DIN + 4 * 1024 + col);
                const f32x4 t = (v[q][j] * r * g) * (sc + 1.f) + sh;
                u32x2 w; w.x = cvtpk(t.x, t.y); w.y = cvtpk(t.z, t.w);
                if (val[q]) *(u32x2*)(H + (size_t)rr * D + col) = w; } }
    }
    } else {
    if (F.wave < 6) { const int sl = F.wave - 4; const int mb = sl ? mb1 : mb0; f32x4 sh[4];
#pragma unroll
        for (int j = 0; j < 4; ++j) sh[j] = *(const f32x4*)(MODl + (size_t)mb * DIN + 3 * 1024 + F.lane * 4 + 256 * j);
#pragma unroll 4
        for (int cidx = 0; cidx < 20; ++cidx) { float p = 0.f;
#pragma unroll
            for (int j = 0; j < 4; ++j) { const f32x4 w = *(const LAS f32x4*)(RW + cidx * RWS + F.lane * 4 + 256 * j);
                p = fmaf(sh[j].x, w.x, p); p = fmaf(sh[j].y, w.y, p); p = fmaf(sh[j].z, w.z, p); p = fmaf(sh[j].w, w.w, p); }
            const float tot = wave_sum(p) + RB[cidx]; if (F.lane == 0) BI[sl * 20 + cidx] = tot; } }
    { const int i16 = F.lane & 15, kq = F.lane >> 4; const int ngrp = (r1 - r0 + 15) >> 4;
      for (int gi = F.wave - 4; gi < ngrp; gi += 4) {
        const int grow = r0 + 16 * gi; const int rowi = (grow + i16 < r1) ? grow + i16 : r1 - 1;
        const bool lat = rowi < TL; const float* xs = (lat ? a.out + (size_t)rowi * D : (const float*)(a.ws + WS_XC) + (size_t)(rowi - TL) * D) + 4 * kq;
        const int slot = (mod_row(grow) == mb0) ? 0 : 1;
        const LAS float* gmp = GM + slot * 1024 + 4 * kq; const LAS float* w0p = RW + i16 * RWS + 4 * kq; const LAS float* w1p = RW + (16 + (i16 & 3)) * RWS + 4 * kq;
        const float m1 = (i16 < 4) ? 1.f : 0.f;
        f32x4v acc0 = {0.f, 0.f, 0.f, 0.f}, acc1 = {0.f, 0.f, 0.f, 0.f};
#pragma unroll 16
        for (int s = 0; s < 64; ++s) {
            const f32x4 xv = *(const f32x4*)(xs + 16 * s); const f32x4 gv = *(const LAS f32x4*)(gmp + 16 * s);
            const f32x4 wa = *(const LAS f32x4*)(w0p + 16 * s), wb = *(const LAS f32x4*)(w1p + 16 * s);
            const f32x4 ba = wa * gv, bb = wb * gv * m1;
            acc0 = __builtin_amdgcn_mfma_f32_16x16x4f32(xv.x, ba.x, acc0, 0, 0, 0); acc1 = __builtin_amdgcn_mfma_f32_16x16x4f32(xv.x, bb.x, acc1, 0, 0, 0);
            acc0 = __builtin_amdgcn_mfma_f32_16x16x4f32(xv.y, ba.y, acc0, 0, 0, 0); acc1 = __builtin_amdgcn_mfma_f32_16x16x4f32(xv.y, bb.y, acc1, 0, 0, 0);
            acc0 = __builtin_amdgcn_mfma_f32_16x16x4f32(xv.z, ba.z, acc0, 0, 0, 0); acc1 = __builtin_amdgcn_mfma_f32_16x16x4f32(xv.z, bb.z, acc1, 0, 0, 0);
            acc0 = __builtin_amdgcn_mfma_f32_16x16x4f32(xv.w, ba.w, acc0, 0, 0, 0); acc1 = __builtin_amdgcn_mfma_f32_16x16x4f32(xv.w, bb.w, acc1, 0, 0, 0);
        }
#pragma unroll
        for (int rg = 0; rg < 4; ++rg) { const int lr = 16 * gi + 4 * kq + rg;
            if (r0 + lr < r1) { LG[lr * 20 + i16] = acc0[rg]; if (i16 < 4) LG[lr * 20 + 16 + i16] = acc1[rg]; } }
      } }
    }
    __syncthreads();
    SUBMARK5(42);
    for (int lr = F.tid; lr < r1 - r0; lr += NTHR) {
        float lg[20]; { const float rn = RN[lr]; const int sl = (mod_row(r0 + lr) == mb0) ? 0 : 1;
#pragma unroll
          for (int i = 0; i < 20; ++i) lg[i] = rn * LG[lr * 20 + i] + BI[sl * 20 + i]; }
        int gs = 0; float gmx = lg[0];
#pragma unroll
        for (int i = 1; i < 4; ++i) if (lg[i] > gmx) { gmx = lg[i]; gs = i; }
        float gsum = 0.f;
#pragma unroll
        for (int i = 0; i < 4; ++i) gsum += __expf(lg[i] - gmx);
        const float pg = 1.f / gsum;
        float le[4];
#pragma unroll
        for (int i = 0; i < 4; ++i) le[i] = (gs == 0) ? lg[4 + i] : (gs == 1) ? lg[8 + i] : (gs == 2) ? lg[12 + i] : lg[16 + i];
        int i0 = 0; float v0 = le[0];
#pragma unroll
        for (int i = 1; i < 4; ++i) if (le[i] > v0) { v0 = le[i]; i0 = i; }
        int i1 = -1; float v1 = -3.4e38f;
#pragma unroll
        for (int i = 0; i < 4; ++i) if (i != i0 && le[i] > v1) { v1 = le[i]; i1 = i; }
        const float e1 = __expf(v1 - v0), den = 1.f / (1.f + e1);
        const int ex0 = gs * 4 + i0, ex1 = gs * 4 + i1;
        const int lp0 = __hip_atomic_fetch_add(&LC[ex0], 1, __ATOMIC_RELAXED, __HIP_MEMORY_SCOPE_WORKGROUP), lp1 = __hip_atomic_fetch_add(&LC[ex1], 1, __ATOMIC_RELAXED, __HIP_MEMORY_SCOPE_WORKGROUP);
        TE[lr] = ex0 | (ex1 << 8); TP[lr] = lp0 | (lp1 << 16); TW[2 * lr] = den * pg; TW[2 * lr + 1] = e1 * den * pg;
    }
    __syncthreads();
    if (F.tid < NE) LC[16 + F.tid] = (int)atomicAdd(&CNT[F.tid * 16], (unsigned)LC[F.tid]);
    __syncthreads();
    for (int lr = F.tid; lr < r1 - r0; lr += NTHR) {
        const int te = TE[lr], tp = TP[lr], ex0 = te & 255, ex1 = te >> 8, row = r0 + lr;
        const int gp0 = LC[16 + ex0] + (tp & 0xffff), gp1 = LC[16 + ex1] + (tp >> 16);
        EROW[(size_t)ex0 * TT + gp0] = row * 2; EROWW[(size_t)ex0 * TT + gp0] = TW[2 * lr];
        EROW[(size_t)ex1 * TT + gp1] = row * 2 + 1; EROWW[(size_t)ex1 * TT + gp1] = TW[2 * lr + 1];
    }
    __syncthreads();
    SUBMARK5(43);
    }
    __syncthreads();
#undef SUBMARK5
}

__device__ __forceinline__ void normrope8(float (&x)[8], const float* g64, bool rope, int pos, const float* ct, const float* st, float scale, int lane) {
    float ss = 0.f;
#pragma unroll
    for (int i = 0; i < 8; ++i) ss += x[i] * x[i];
    ss += DPP_F(ss, 0xB1); ss += DPP_F(ss, 0x4E); ss += DPP_F(ss, 0x141);
    const float r = 1.f / sqrtf(ss * (1.f / 64.f) + EPS);
    const int ch = lane & 7;
    const f32x4 g0 = *(const f32x4*)(g64 + 8 * ch), g1 = *(const f32x4*)(g64 + 8 * ch + 4);
    x[0] *= r * g0.x; x[1] *= r * g0.y; x[2] *= r * g0.z; x[3] *= r * g0.w; x[4] *= r * g1.x; x[5] *= r * g1.y; x[6] *= r * g1.z; x[7] *= r * g1.w;
    if (rope) {
        const int ax = ch >> 2, half = (ch >> 1) & 1, f0 = 8 * (ch & 1);
        const f32x4 c0 = *(const f32x4*)(ct + pos * 32 + ax * 16 + f0), c1 = *(const f32x4*)(ct + pos * 32 + ax * 16 + f0 + 4);
        const f32x4 s0 = *(const f32x4*)(st + pos * 32 + ax * 16 + f0), s1 = *(const f32x4*)(st + pos * 32 + ax * 16 + f0 + 4);
        const float cs[8] = {c0.x, c0.y, c0.z, c0.w, c1.x, c1.y, c1.z, c1.w}, sn[8] = {s0.x, s0.y, s0.z, s0.w, s1.x, s1.y, s1.z, s1.w};
#pragma unroll
        for (int i = 0; i < 8; ++i) { const float p = DPP_F(x[i], 0x4E);
            x[i] = half ? (x[i] * cs[i] + p * sn[i]) : (x[i] * cs[i] - p * sn[i]); }
    }
#pragma unroll
    for (int i = 0; i < 8; ++i) x[i] *= scale;
}
__device__ __forceinline__ void unpack8(const u32x4 w, float (&x)[8]) { x[0] = bflo(w.x); x[1] = bfhi(w.x); x[2] = bflo(w.y); x[3] = bfhi(w.y); x[4] = bflo(w.z); x[5] = bfhi(w.z); x[6] = bflo(w.w); x[7] = bfhi(w.w); }
__device__ __forceinline__ u32x4 pack8(const float (&x)[8]) { u32x4 w; w.x = cvtpk(x[0], x[1]); w.y = cvtpk(x[2], x[3]); w.z = cvtpk(x[4], x[5]); w.w = cvtpk(x[6], x[7]); return w; }

__device__ __forceinline__ void prep_phase(const Fr& F, const Args& a, int l, bool with_ctx) {
    constexpr int VROW = 272;
    LAS unsigned char* VA_l = F.lds;
    LAS unsigned char* VW_l = F.lds + 17408;
    LAS unsigned char* HT_l = F.lds + 34816;
    constexpr int HROW = 144;
    const float* ct = (const float*)(a.ws + WS_ROPE); const float* st = ct + SEQ * 32;
    const float* qkg = a.in[I_QKG] + l * 256;
    const bf16_t* RAWA = (const bf16_t*)(a.ws + WS_RAWA); const bf16_t* RAWW = (const bf16_t*)(a.ws + WS_RAWW);
    bf16_t* KA = (bf16_t*)(a.ws + WS_KA); bf16_t* KW = (bf16_t*)(a.ws + WS_KW); bf16_t* VTA = (bf16_t*)(a.ws + WS_VTA); bf16_t* VTW = (bf16_t*)(a.ws + WS_VTW);
    const bf16_t* U = (const bf16_t*)(a.ws + WS_U); bf16_t* X0 = (bf16_t*)(a.ws + WS_H); bf16_t* VT = (bf16_t*)(a.ws + WS_VT);
    const float* hsw = a.in[I_HSW] + l * 3 * 1536; const float* hsb = a.in[I_HSB] + l * 1536;
    for (int unit = F.bid; unit < NB * 36; unit += F.G) {
        const bool lat = unit < NB * 32;
        const int b = lat ? unit >> 5 : (unit - NB * 32) >> 2, p0 = lat ? (unit & 31) * 64 : ((unit - NB * 32) & 3) * 64;
        const int n = lat ? SEQ : CTX;
        const int row0 = lat ? b * SEQ + p0 : TL + b * CTX + p0;
        const int j0 = lat ? CTX + p0 : p0;
        __syncthreads();
        {
            const bool isw = (F.lane & 16) != 0; const int l16 = F.lane & 15, half = F.lane >> 5;
            u32x4 kw[4];
#pragma unroll
            for (int ps = 0; ps < 4; ++ps) { const int tk = 8 * F.wave + 2 * ps + half; kw[ps] = *(const u32x4*)((isw ? RAWW : RAWA) + (size_t)(row0 + tk) * 256 + l16 * 8); }
#pragma unroll
            for (int ps = 0; ps < 4; ++ps) { const int tk = 8 * F.wave + 2 * ps + half; float x[8]; unpack8(kw[ps], x);
                normrope8(x, qkg + (isw ? 192 : 64), lat, p0 + tk, ct, st, 1.f, F.lane);
                *(u32x4*)((isw ? KW : KA) + ((size_t)b * KEYS + j0 + tk) * 128 + l16 * 8) = pack8(x); }
        }
        for (int i = F.tid; i < 2 * 64 * 16; i += NTHR) { const int m = i >> 10, r = (i >> 4) & 63, cch = i & 15;
            const u32x4 w = *(const u32x4*)((m ? RAWW : RAWA) + (size_t)(row0 + r) * 256 + 128 + cch * 8);
            *(LAS u32x4*)((m ? VW_l : VA_l) + r * VROW + cch * 16) = w; }
        const bool do_hy = lat || with_ctx;
        if (do_hy) {
            const int cg = F.tid & 63, c = 8 * cg, t0 = 8 * F.wave;
            u32x4 x1p[8];
#pragma unroll
            for (int g = 0; g < 3; ++g) {
                const int ch = g * 512 + c;
                float w0[8], w1[8], w2[8], bb[8];
                { const f32x4 a0 = *(const f32x4*)(hsw + ch), a1 = *(const f32x4*)(hsw + ch + 4), b0 = *(const f32x4*)(hsw + 1536 + ch), b1 = *(const f32x4*)(hsw + 1536 + ch + 4),
                              c0 = *(const f32x4*)(hsw + 3072 + ch), c1 = *(const f32x4*)(hsw + 3072 + ch + 4), d0 = *(const f32x4*)(hsb + ch), d1 = *(const f32x4*)(hsb + ch + 4);
                  w0[0] = a0.x; w0[1] = a0.y; w0[2] = a0.z; w0[3] = a0.w; w0[4] = a1.x; w0[5] = a1.y; w0[6] = a1.z; w0[7] = a1.w;
                  w1[0] = b0.x; w1[1] = b0.y; w1[2] = b0.z; w1[3] = b0.w; w1[4] = b1.x; w1[5] = b1.y; w1[6] = b1.z; w1[7] = b1.w;
                  w2[0] = c0.x; w2[1] = c0.y; w2[2] = c0.z; w2[3] = c0.w; w2[4] = c1.x; w2[5] = c1.y; w2[6] = c1.z; w2[7] = c1.w;
                  bb[0] = d0.x; bb[1] = d0.y; bb[2] = d0.z; bb[3] = d0.w; bb[4] = d1.x; bb[5] = d1.y; bb[6] = d1.z; bb[7] = d1.w; }
                u32x4 raw[10];
#pragma unroll
                for (int i = 0; i < 10; ++i) { const int pos = p0 + t0 - 1 + i;
                    if (pos < 0 || pos >= n) { const unsigned z = zero_u32(); raw[i] = (u32x4){z, z, z, z}; } else raw[i] = *(const u32x4*)(U + (size_t)(row0 - p0 + pos) * 1536 + ch); }
#pragma unroll
                for (int t = 0; t < 8; ++t) { float up[8], uc[8], un[8], o[8]; unpack8(raw[t], up); unpack8(raw[t + 1], uc); unpack8(raw[t + 2], un);
#pragma unroll
                    for (int i = 0; i < 8; ++i) o[i] = fmaf(w0[i], up[i], fmaf(w1[i], uc[i], fmaf(w2[i], un[i], bb[i])));
                    if (g == 0) *(u32x4*)(X0 + (size_t)(row0 + t0 + t) * 512 + c) = pack8(o);
                    else if (g == 1) x1p[t] = pack8(o);
                    else { float x1[8]; unpack8(x1p[t], x1);
#pragma unroll
                        for (int i = 0; i < 8; ++i) o[i] *= x1[i];
                        x1p[t] = pack8(o); } }
            }
#pragma unroll
            for (int i = 0; i < 8; ++i) { unsigned short ev[8];
#pragma unroll
                for (int t = 0; t < 8; ++t) { const unsigned wsel = (i >> 1) == 0 ? x1p[t].x : (i >> 1) == 1 ? x1p[t].y : (i >> 1) == 2 ? x1p[t].z : x1p[t].w; ev[t] = (unsigned short)((i & 1) ? (wsel >> 16) : (wsel & 0xffffu)); }
                u32x4 w; w.x = ev[0] | ((unsigned)ev[1] << 16); w.y = ev[2] | ((unsigned)ev[3] << 16); w.z = ev[4] | ((unsigned)ev[5] << 16); w.w = ev[6] | ((unsigned)ev[7] << 16);
                *(LAS u32x4*)(HT_l + (c + i) * HROW + t0 * 2) = w; }
        }
        __syncthreads();
        for (int i = F.tid; i < 2 * 128 * 8; i += NTHR) { const int m = i >> 10, rr = (i >> 3) & 127, c8 = i & 7;
            LAS unsigned char* T = m ? VW_l : VA_l; unsigned short e[8];
#pragma unroll
            for (int jj = 0; jj < 8; ++jj) { const int key = 16 * (c8 >> 1) + 8 * (jj >> 2) + 4 * (c8 & 1) + (jj & 3); e[jj] = *(const LAS bf16_t*)(T + key * VROW + rr * 2); }
            u32x4 w; w.x = e[0] | ((unsigned)e[1] << 16); w.y = e[2] | ((unsigned)e[3] << 16); w.z = e[4] | ((unsigned)e[5] << 16); w.w = e[6] | ((unsigned)e[7] << 16);
            *(u32x4*)((m ? VTW : VTA) + ((size_t)(b * 2 + (rr >> 6)) * 64 + (rr & 63)) * KEYS + j0 + c8 * 8) = w; }
        if (do_hy) { bf16_t* VTb = lat ? VT : VT + VT_CTX_OFF;
          for (int i = F.tid; i < 512 * 8; i += NTHR) { const int cch = i >> 3, c8 = i & 7;
              const u32x4 w = *(const LAS u32x4*)(HT_l + cch * HROW + c8 * 16);
              *(u32x4*)(VTb + ((size_t)cch * NB + b) * n + p0 + c8 * 8) = w; } }
    }
    __syncthreads();
}

__device__ __forceinline__ void hyena_final_phase(const Fr& F, const Args& a, int l, bool with_ctx) {
    constexpr int HROW = 144;
    LAS unsigned char* T = F.lds;
    const bf16_t* X0 = (const bf16_t*)(a.ws + WS_H); const bf16_t* VT = (const bf16_t*)(a.ws + WS_VT); const bf16_t* YT = (const bf16_t*)(a.ws + WS_YT);
    bf16_t* YH = (bf16_t*)(a.ws + WS_QA) + 512;
    const float* FN = (const float*)(a.ws + WS_FNORM) + l * 1024; const float* skip = a.in[I_HBIAS] + l * 512;
    const int nunits = with_ctx ? NB * 36 : NB * 32;
    for (int unit = F.bid; unit < nunits; unit += F.G) {
        const bool lat = unit < NB * 32;
        const int b = lat ? unit >> 5 : (unit - NB * 32) >> 2, p0 = lat ? (unit & 31) * 64 : ((unit - NB * 32) & 3) * 64;
        const int n = lat ? SEQ : CTX; const int row0 = lat ? b * SEQ + p0 : TL + b * CTX + p0;
        const bf16_t* Yb = lat ? YT : YT + VT_CTX_OFF; const bf16_t* Vb = lat ? VT : VT + VT_CTX_OFF; const float* inv = FN + (lat ? 0 : 512);
        __syncthreads();
        for (int i = F.tid; i < 512 * 8; i += NTHR) { const int cch = i >> 3, c8 = i & 7; const size_t off = ((size_t)cch * NB + b) * n + p0 + c8 * 8;
            const u32x4 y = *(const u32x4*)(Yb + off), v = *(const u32x4*)(Vb + off); const float s = inv[cch], k = skip[cch];
            u32x4 o;
            o.x = cvtpk(bflo(y.x) * s + k * bflo(v.x), bfhi(y.x) * s + k * bfhi(v.x)); o.y = cvtpk(bflo(y.y) * s + k * bflo(v.y), bfhi(y.y) * s + k * bfhi(v.y));
            o.z = cvtpk(bflo(y.z) * s + k * bflo(v.z), bfhi(y.z) * s + k * bfhi(v.z)); o.w = cvtpk(bflo(y.w) * s + k * bflo(v.w), bfhi(y.w) * s + k * bfhi(v.w));
            *(LAS u32x4*)(T + cch * HROW + c8 * 16) = o; }
        __syncthreads();
        { const int th = F.tid & 255, half = F.tid >> 8, c = 2 * th;
          for (int t = 32 * half; t < 32 * half + 32; ++t) {
              const unsigned x0 = *(const unsigned*)(X0 + (size_t)(row0 + t) * 512 + c);
              const float y0 = bf1(*(const LAS bf16_t*)(T + c * HROW + t * 2)), y1 = bf1(*(const LAS bf16_t*)(T + (c + 1) * HROW + t * 2));
              *(unsigned*)(YH + (size_t)(row0 + t) * 1536 + c) = cvtpk(bflo(x0) * y0, bfhi(x0) * y1); } }
    }
    __syncthreads();
}

#define MFMA32(a, b, c) __builtin_amdgcn_mfma_f32_32x32x16_bf16((a), (b), (c), 0, 0, 0)
#define MFMA16(a, b, c) __builtin_amdgcn_mfma_f32_16x16x32_bf16((a), (b), (c), 0, 0, 0)

__device__ __forceinline__ int tile_off(int row, int chunk) { return row * 128 + ((chunk ^ ((row >> 1) & 7)) << 4); }

template <bool WIN>
__device__ __forceinline__ void attn_unit(const Fr& F, bf16_t* Qw, const bf16_t* Kb, const bf16_t* VTb, int a0, int na, int b0, int nb, int qpos0, bool has_sink, float sink2, const float* g64, bool rope, const float* ct, const float* st) {
    LAS unsigned char* L = F.lds;
    const int r = F.lane & 31, h = F.lane >> 5;
    const int xaddr = (lane_id() ^ 32) << 2;
#define SWAP32(v) __builtin_bit_cast(float, __builtin_amdgcn_ds_bpermute(xaddr, __builtin_bit_cast(int, (v))))
    bf16x8 q[4];
    {
        float x[4][8]; float ss = 0.f;
#pragma unroll
        for (int kk = 0; kk < 4; ++kk) { const u32x4 w = *(const u32x4*)(Qw + (size_t)r * 1536 + 16 * kk + 8 * h); unpack8(w, x[kk]);
#pragma unroll
            for (int j = 0; j < 8; ++j) ss += x[kk][j] * x[kk][j]; }
        ss += SWAP32(ss);
        const float rn = (1.f / sqrtf(ss * (1.f / 64.f) + EPS)) * QSCALE;
#pragma unroll
        for (int kk = 0; kk < 4; ++kk) { const f32x4 g0 = *(const f32x4*)(g64 + 16 * kk + 8 * h), g1 = *(const f32x4*)(g64 + 16 * kk + 8 * h + 4);
            x[kk][0] *= rn * g0.x; x[kk][1] *= rn * g0.y; x[kk][2] *= rn * g0.z; x[kk][3] *= rn * g0.w; x[kk][4] *= rn * g1.x; x[kk][5] *= rn * g1.y; x[kk][6] *= rn * g1.z; x[kk][7] *= rn * g1.w; }
        if (rope) { const int pos = qpos0 + r;
#pragma unroll
            for (int ax = 0; ax < 2; ++ax) {
                const f32x4 c0 = *(const f32x4*)(ct + pos * 32 + ax * 16 + 8 * h), c1 = *(const f32x4*)(ct + pos * 32 + ax * 16 + 8 * h + 4);
                const f32x4 s0 = *(const f32x4*)(st + pos * 32 + ax * 16 + 8 * h), s1 = *(const f32x4*)(st + pos * 32 + ax * 16 + 8 * h + 4);
                const float cs[8] = {c0.x, c0.y, c0.z, c0.w, c1.x, c1.y, c1.z, c1.w}, sn[8] = {s0.x, s0.y, s0.z, s0.w, s1.x, s1.y, s1.z, s1.w};
#pragma unroll
                for (int j = 0; j < 8; ++j) { const float av = x[2 * ax][j], bv = x[2 * ax + 1][j]; x[2 * ax][j] = av * cs[j] - bv * sn[j]; x[2 * ax + 1][j] = bv * cs[j] + av * sn[j]; } } }
#pragma unroll
        for (int kk = 0; kk < 4; ++kk) q[kk] = __builtin_bit_cast(bf16x8, pack8(x[kk]));
    }
    f32x16 o0, o1;
#pragma unroll
    for (int i = 0; i < 16; ++i) { o0[i] = 0.f; o1[i] = 0.f; }
    float lsum = 0.f;
    const int ntile = na + nb;
    const int srow = F.tid >> 3, sch = F.tid & 7;
    const int soff = tile_off(srow, sch);
    int t4[4];
#pragma unroll
    for (int j = 0; j < 4; ++j) t4[j] = tile_off(r, 2 * j + h);
#define AT_KT(i) ((i) < na ? a0 + (i) : b0 + ((i) - na))
#define AT_LD(i, K0, K1, V0, V1) do { const int kt_ = AT_KT(i); \
        K0 = *(const u32x4*)(Kb + (size_t)(kt_ * 128 + srow) * 128 + sch * 8); K1 = *(const u32x4*)(Kb + (size_t)(kt_ * 128 + 64 + srow) * 128 + sch * 8); \
        V0 = *(const u32x4*)(VTb + (size_t)srow * KEYS + kt_ * 128 + sch * 8); V1 = *(const u32x4*)(VTb + (size_t)srow * KEYS + kt_ * 128 + 64 + sch * 8); } while (0)
#define AT_ST(buf, K0, K1, V0, V1) do { LAS unsigned char* B_ = L + (buf) * 32768 + soff; \
        *(LAS u32x4*)(B_) = K0; *(LAS u32x4*)(B_ + 8192) = K1; *(LAS u32x4*)(B_ + 16384) = V0; *(LAS u32x4*)(B_ + 24576) = V1; } while (0)
#define AT_QK(S0, S1, Kt) do { bf16x8 kf_[8]; \
        _Pragma("unroll") for (int kk = 0; kk < 4; ++kk) { kf_[2 * kk] = *(const LAS bf16x8*)(L + (Kt) + t4[kk]); kf_[2 * kk + 1] = *(const LAS bf16x8*)(L + (Kt) + t4[kk] + 4096); } \
        _Pragma("unroll") for (int i_ = 0; i_ < 16; ++i_) { S0[i_] = 0.f; S1[i_] = 0.f; } \
        _Pragma("unroll") for (int kk = 0; kk < 4; ++kk) { S0 = MFMA32(kf_[2 * kk], q[kk], S0); S1 = MFMA32(kf_[2 * kk + 1], q[kk], S1); } } while (0)
#define AT_EXP(S0, S1, P, kpos0) do { \
        if (WIN && (kpos0) >= 0) { const int kbase = (kpos0) + 4 * h, qp = qpos0 + r; \
            _Pragma("unroll") for (int i = 0; i < 16; ++i) { const int kr = (i & 3) + 8 * (i >> 2); const int d0 = kbase + kr - qp, d1 = d0 + 32; \
                if (d0 > 128 || d0 < -128) S0[i] = -1e30f; if (d1 > 128 || d1 < -128) S1[i] = -1e30f; } } \
        _Pragma("unroll") for (int i = 0; i < 16; ++i) { S0[i] = fast_exp2(S0[i]); S1[i] = fast_exp2(S1[i]); lsum += S0[i] + S1[i]; } \
        { u32x4 w; \
          w.x = cvtpk(S0[0], S0[1]); w.y = cvtpk(S0[2], S0[3]); w.z = cvtpk(S0[4], S0[5]); w.w = cvtpk(S0[6], S0[7]); P[0] = __builtin_bit_cast(bf16x8, w); \
          w.x = cvtpk(S0[8], S0[9]); w.y = cvtpk(S0[10], S0[11]); w.z = cvtpk(S0[12], S0[13]); w.w = cvtpk(S0[14], S0[15]); P[1] = __builtin_bit_cast(bf16x8, w); \
          w.x = cvtpk(S1[0], S1[1]); w.y = cvtpk(S1[2], S1[3]); w.z = cvtpk(S1[4], S1[5]); w.w = cvtpk(S1[6], S1[7]); P[2] = __builtin_bit_cast(bf16x8, w); \
          w.x = cvtpk(S1[8], S1[9]); w.y = cvtpk(S1[10], S1[11]); w.z = cvtpk(S1[12], S1[13]); w.w = cvtpk(S1[14], S1[15]); P[3] = __builtin_bit_cast(bf16x8, w); } } while (0)
#define AT_PV(P, Vt) do { bf16x8 vf_[8]; \
        _Pragma("unroll") for (int c = 0; c < 4; ++c) { vf_[2 * c] = *(const LAS bf16x8*)(L + (Vt) + t4[c]); vf_[2 * c + 1] = *(const LAS bf16x8*)(L + (Vt) + t4[c] + 4096); } \
        _Pragma("unroll") for (int c = 0; c < 4; ++c) { o0 = MFMA32(vf_[2 * c], P[c], o0); o1 = MFMA32(vf_[2 * c + 1], P[c], o1); } } while (0)
#define AT_BODY(it) do { \
        const int kt = AT_KT(it); \
        if ((it) + 1 < ntile) AT_LD((it) + 1, kA0, kA1, vA0, vA1); \
        const int Bc = ((it) & 1) * 32768;                                \
        const int kp = (WIN && kt >= 2) ? (kt - 2) * 128 : -1;            \
        { f32x16 sa0, sa1; bf16x8 pa[4]; \
          AT_QK(sa0, sa1, Bc); AT_EXP(sa0, sa1, pa, kp); AT_PV(pa, Bc + 16384); } \
        __builtin_amdgcn_sched_barrier(0); \
        { f32x16 sb0, sb1; bf16x8 pb_[4]; \
          AT_QK(sb0, sb1, Bc + 8192); AT_EXP(sb0, sb1, pb_, (kp < 0 ? -1 : kp + 64)); AT_PV(pb_, Bc + 24576); } \
        if ((it) + 1 < ntile) AT_ST(((it) + 1) & 1, kA0, kA1, vA0, vA1); \
        __syncthreads(); } while (0)
    u32x4 kA0, kA1, vA0, vA1;
    AT_LD(0, kA0, kA1, vA0, vA1);
    __syncthreads();
    AT_ST(0, kA0, kA1, vA0, vA1);
    __syncthreads();
    for (int it = 0; it < ntile; it += 2) {
        AT_BODY(it);
        if (it + 1 < ntile) AT_BODY(it + 1);
    }
#undef AT_BODY
#undef AT_QK
#undef AT_EXP
#undef AT_PV
#undef AT_ST
#undef AT_LD
#undef AT_KT
    float lt = lsum + SWAP32(lsum);
    if (has_sink) lt += fast_exp2(sink2);
    const float inv = 1.f / lt;
#pragma unroll
    for (int g = 0; g < 4; ++g) {
        u32x2 w0, w1;
        w0.x = cvtpk(o0[4 * g] * inv, o0[4 * g + 1] * inv); w0.y = cvtpk(o0[4 * g + 2] * inv, o0[4 * g + 3] * inv);
        w1.x = cvtpk(o1[4 * g] * inv, o1[4 * g + 1] * inv); w1.y = cvtpk(o1[4 * g + 2] * inv, o1[4 * g + 3] * inv);
        *(u32x2*)(Qw + (size_t)r * 1536 + 8 * g + 4 * h) = w0;
        *(u32x2*)(Qw + (size_t)r * 1536 + 32 + 8 * g + 4 * h) = w1; }
#undef SWAP32
}

__device__ __forceinline__ void hyena_unit_lat(const Fr& F, const bf16_t* Fg, const bf16_t* Vg, bf16_t* Yg) {
    constexpr int FREP = 8192 + 64, VPIT = 4096 + 16, VOFF = 8 * FREP;
    LAS unsigned char* L = F.lds;
    __syncthreads();
    { const int x = F.tid;
      const u32x4 lo = *(const u32x4*)(Fg + x * 8); u32x4 hi; if (x < 511) hi = *(const u32x4*)(Fg + x * 8 + 8); else { const unsigned z = zero_u32(); hi = (u32x4){z, z, z, z}; }
      const unsigned wv[8] = {lo.x, lo.y, lo.z, lo.w, hi.x, hi.y, hi.z, hi.w};
      *(LAS u32x4*)(L + x * 16) = lo;
#pragma unroll
      for (int rho = 1; rho < 8; ++rho) { u32x4 o;
          unsigned od[4];
#pragma unroll
          for (int d = 0; d < 4; ++d) { const int ob = 4 * d + 2 * rho, i = ob >> 2, s = ob & 3; od[d] = __builtin_amdgcn_alignbyte(wv[i + 1 < 8 ? i + 1 : 7], wv[i], s); }
          o.x = od[0]; o.y = od[1]; o.z = od[2]; o.w = od[3];
          *(LAS u32x4*)(L + rho * FREP + x * 16) = o; } }
    for (int i = F.tid; i < 16 * 256; i += NTHR) { const int b = i >> 8, x = i & 255; *(LAS u32x4*)(L + VOFF + b * VPIT + x * 16) = *(const u32x4*)(Vg + (size_t)b * SEQ + x * 8); }
    __syncthreads();
    const int i16 = F.lane & 15, q4 = F.lane >> 4, w = F.wave;
    const int base0 = 2047 - 256 * w - i16 + 8 * q4;
    const int rho = base0 & 7;
    LAS unsigned char* Ap = L + rho * FREP + (base0 - rho) * 2;
    LAS unsigned char* Bp = L + VOFF + i16 * VPIT + q4 * 16;
    bf16x8 A[16]; f32x4 acc[16];
#pragma unroll
    for (int rr = 0; rr < 16; ++rr) { A[rr] = *(const LAS bf16x8*)(Ap - 32 * rr); acc[rr] = (f32x4){0.f, 0.f, 0.f, 0.f}; }
    bf16x8 Bn = *(const LAS bf16x8*)(Bp);
    for (int o = 0; o < 8; ++o) {
#pragma unroll
        for (int u = 0; u < 8; ++u) {
            const int st = o * 8 + u;
            const bf16x8 Bf = Bn;
            if (st < 63) Bn = *(const LAS bf16x8*)(Bp + 64 * st + 64);
#pragma unroll
            for (int rr = 0; rr < 16; ++rr) acc[rr] = MFMA16(A[(rr - 2 * u) & 15], Bf, acc[rr]);
            if (st < 63) { A[(-2 * u - 2) & 15] = *(const LAS bf16x8*)(Ap + 64 * st + 64); A[(-2 * u - 1) & 15] = *(const LAS bf16x8*)(Ap + 64 * st + 32); }
        }
    }
#pragma unroll
    for (int rr = 0; rr < 16; ++rr) { u32x2 wv; wv.x = cvtpk(acc[rr].x, acc[rr].y); wv.y = cvtpk(acc[rr].z, acc[rr].w);
        *(u32x2*)(Yg + (size_t)i16 * SEQ + 256 * w + 16 * rr + 4 * q4) = wv; }
}
__device__ __forceinline__ void hyena_unit_ctx(const Fr& F, const bf16_t* Fg, const bf16_t* Vg, bf16_t* Yg) {
    constexpr int FREP = 1024 + 64, VPIT = 512 + 16, VOFF = 8 * FREP;
    LAS unsigned char* L = F.lds;
    __syncthreads();
    if (F.tid < 64) *(LAS u32x4*)(L + F.tid * 16) = *(const u32x4*)(Fg + F.tid * 8);
    if (F.tid >= 64 && F.tid < 68) { const unsigned z = zero_u32(); *(LAS u32x4*)(L + 1024 + (F.tid - 64) * 16) = (u32x4){z, z, z, z}; }
    { const int b = F.tid >> 5, x = F.tid & 31; *(LAS u32x4*)(L + VOFF + b * VPIT + x * 16) = *(const u32x4*)(Vg + (size_t)b * CTX + x * 8); }
    __syncthreads();
    for (int i = F.tid; i < 7 * 256; i += NTHR) { const int rho = 1 + i / 256, x2 = (i % 256) * 2; const int s0 = x2 + rho, s1 = x2 + 1 + rho;
        const unsigned e0 = s0 < 512 ? *(const LAS bf16_t*)(L + s0 * 2) : 0, e1 = s1 < 512 ? *(const LAS bf16_t*)(L + s1 * 2) : 0;
        *(LAS unsigned*)(L + rho * FREP + x2 * 2) = e0 | (e1 << 16); }
    __syncthreads();
    const int i16 = F.lane & 15, q4 = F.lane >> 4, w = F.wave;
    const int base0 = 255 - 32 * w - i16 + 8 * q4, rho = base0 & 7;
    LAS unsigned char* Ap = L + rho * FREP + (base0 - rho) * 2;
    LAS unsigned char* Bp = L + VOFF + i16 * VPIT + q4 * 16;
    f32x4 acc0 = (f32x4){0.f, 0.f, 0.f, 0.f}, acc1 = acc0;
#pragma unroll
    for (int st = 0; st < 8; ++st) { const bf16x8 Bf = *(const LAS bf16x8*)(Bp + 64 * st);
        const bf16x8 A0 = *(const LAS bf16x8*)(Ap + 64 * st), A1 = *(const LAS bf16x8*)(Ap + 64 * st - 32);
        acc0 = MFMA16(A0, Bf, acc0); acc1 = MFMA16(A1, Bf, acc1); }
    u32x2 wv; wv.x = cvtpk(acc0.x, acc0.y); wv.y = cvtpk(acc0.z, acc0.w); *(u32x2*)(Yg + (size_t)i16 * CTX + 32 * w + 4 * q4) = wv;
    wv.x = cvtpk(acc1.x, acc1.y); wv.y = cvtpk(acc1.z, acc1.w); *(u32x2*)(Yg + (size_t)i16 * CTX + 32 * w + 16 + 4 * q4) = wv;
}

__device__ __forceinline__ void mixer_phase(const Fr& F, const Args& a, int l, bool with_ctx, unsigned long long& sacc, const int swhich) {
#if defined(PROBE_P)
    unsigned long long st0 = __builtin_amdgcn_s_memrealtime();
#define SUBMARK(w) do { const unsigned long long t_ = __builtin_amdgcn_s_memrealtime(); if (swhich == (w)) sacc += t_ - st0; st0 = t_; } while (0)
#else
#define SUBMARK(w) do { } while (0)
#endif
    bf16_t* QA = (bf16_t*)(a.ws + WS_QA); bf16_t* QW = QA + 1024;
    const bf16_t* KA = (const bf16_t*)(a.ws + WS_KA); const bf16_t* KW = (const bf16_t*)(a.ws + WS_KW);
    const bf16_t* VTA = (const bf16_t*)(a.ws + WS_VTA); const bf16_t* VTW = (const bf16_t*)(a.ws + WS_VTW);
    const float* sinks = a.in[I_SINK] + l * 8; const float* qkg = a.in[I_QKG] + l * 256;
    const float* ct = (const float*)(a.ws + WS_ROPE); const float* st = ct + SEQ * 32;
    const int wq = F.wave >> 1, wh = F.wave & 1;
    const int ubid = (F.G % 8 == 0) ? (F.bid & 7) * (F.G >> 3) + (F.bid >> 3) : F.bid;
#define RELANE(FX) do { int t_ = F.wave * 64 + lane_id(); asm volatile("" : "+v"(t_)); FX.tid = t_; FX.lane = t_ & 63; } while (0)
    Fr FA = F; RELANE(FA);
    for (int unit = ubid; unit < NB * 2 * 32; unit += F.G) {
        const int b = unit >> 6, kvh = (unit >> 5) & 1, pb = unit & 31;
        bf16_t* Qw = QA + (size_t)(b * SEQ + pb * 64 + wh * 32) * 1536 + (kvh * 4 + wq) * 64;
        attn_unit<false>(FA, Qw, KA + (size_t)b * KEYS * 128 + kvh * 64, VTA + (size_t)(b * 2 + kvh) * 64 * KEYS, 0, KEYS / 128, 0, 0, pb * 64 + wh * 32, false, 0.f, qkg, true, ct, st);
    }
    SUBMARK(30);
    Fr FW = F; RELANE(FW);
    for (int unit = ubid; unit < NB * 2 * 32; unit += F.G) {
        const int b = unit >> 6, kvh = (unit >> 5) & 1, pb = unit & 31;
        bf16_t* Qw = QW + (size_t)(b * SEQ + pb * 64 + wh * 32) * 1536 + (kvh * 4 + wq) * 64;
        const int lo = pb < 2 ? 0 : (pb - 2) >> 1, hi = ((64 * pb + 191) >> 7) > 15 ? 15 : ((64 * pb + 191) >> 7);
        attn_unit<true>(FW, Qw, KW + (size_t)b * KEYS * 128 + kvh * 64, VTW + (size_t)(b * 2 + kvh) * 64 * KEYS, 0, 2, 2 + lo, hi - lo + 1, pb * 64 + wh * 32, true, sinks[kvh * 4 + wq] * LOG2E, qkg + 128, true, ct, st);
    }
    SUBMARK(31);
    Fr FC2 = F; RELANE(FC2);
    if (with_ctx) {
        for (int unit = ubid; unit < 2 * NB * 2 * 4; unit += F.G) {
            const int isw = unit >> 7, u2 = unit & 127, b = u2 >> 3, kvh = (u2 >> 2) & 1, pb = u2 & 3;
            bf16_t* Qw = (isw ? QW : QA) + (size_t)(TL + b * CTX + pb * 64 + wh * 32) * 1536 + (kvh * 4 + wq) * 64;
            attn_unit<false>(FC2, Qw, (isw ? KW : KA) + (size_t)b * KEYS * 128 + kvh * 64, (isw ? VTW : VTA) + (size_t)(b * 2 + kvh) * 64 * KEYS, 0, 2, 0, 0, 0, isw != 0, isw ? sinks[kvh * 4 + wq] * LOG2E : 0.f, qkg + (isw ? 128 : 0), false, ct, st);
        }
    }
    SUBMARK(32);
    const bf16_t* FL = (const bf16_t*)(a.ws + WS_FL) + (size_t)l * 512 * 4096; const bf16_t* FC = (const bf16_t*)(a.ws + WS_FC) + (size_t)l * 512 * 512;
    const bf16_t* VT = (const bf16_t*)(a.ws + WS_VT); bf16_t* YT = (bf16_t*)(a.ws + WS_YT);
    Fr FH = F; RELANE(FH);
    for (int c = F.bid; c < HYW; c += F.G) hyena_unit_lat(FH, FL + (size_t)c * 4096, VT + (size_t)c * NB * SEQ, YT + (size_t)c * NB * SEQ);
    if (with_ctx) for (int c = F.bid; c < HYW; c += F.G) hyena_unit_ctx(FH, FC + (size_t)c * 512, VT + VT_CTX_OFF + (size_t)c * NB * CTX, YT + VT_CTX_OFF + (size_t)c * NB * CTX);
    __syncthreads();
    SUBMARK(33);
#undef SUBMARK
#undef RELANE
}

__device__ __forceinline__ float gate_q(float x) { return fminf(256.f * sigmoid_f(x), 255.49f); }
__device__ __forceinline__ unsigned pack_u8x4(float a, float b, float c, float d) { return (unsigned)(int)a | ((unsigned)(int)b << 8) | ((unsigned)(int)c << 16) | ((unsigned)(int)d << 24); }
__device__ __forceinline__ float gq(unsigned w, int k) { return (float)((w >> (8 * k)) & 0xffu) + 0.5f; }
struct EpiInProj {
    static constexpr bool PERM = true, AFTER_DRAIN = false; static constexpr int NSEG = 1;
    unsigned char* ws; int pn_off;
    __device__ __forceinline__ void operator()(const pg8::f32x4 (&acc)[2][2][4][2], const pg8::Unit& u, int wr, int wc, int fr, int fq) const {
        asm volatile("" : "+v"(fr), "+v"(fq));
        const int pn = __builtin_amdgcn_readfirstlane(u.pn) + pn_off; unsigned long long boff; int ldc, colt; bool sig = false;
        if (pn < 2) { boff = WS_QA; ldc = 1536; colt = pn * 256; }
        else if (pn == 2) { boff = WS_RAWA; ldc = 256; colt = 0; }
        else if (pn < 9) { boff = WS_U; ldc = 1536; colt = (pn - 3) * 256; }
        else if (pn < 11) { boff = WS_QA; ldc = 1536; colt = 1024 + (pn - 9) * 256; }
        else if (pn == 11) { boff = WS_RAWW; ldc = 256; colt = 0; }
        else { boff = WS_G; ldc = 3072; colt = (pn - 12) * 256; sig = true; }
        bf16_t* base = (bf16_t*)(ws + boff); unsigned char* Gt = ws + boff;
        const int row0 = u.pm * 256 + wr * 64 + fr, col0 = colt + wc * 32 + 8 * fq;
        if (sig) {
            unsigned char* gb = (unsigned char*)Gt;
#pragma unroll
            for (int ai = 0; ai < 2; ++ai)
#pragma unroll
                for (int m = 0; m < 4; ++m) { unsigned char* rowp = gb + (size_t)(row0 + ai * 128 + m * 16) * 3072 + col0;
#pragma unroll
                    for (int bj = 0; bj < 2; ++bj) { const pg8::f32x4 v0 = acc[ai][bj][m][0], v1 = acc[ai][bj][m][1];
                        u32x2 w; w.x = pack_u8x4(gate_q(v0.x), gate_q(v0.y), gate_q(v0.z), gate_q(v0.w)); w.y = pack_u8x4(gate_q(v1.x), gate_q(v1.y), gate_q(v1.z), gate_q(v1.w));
                        *(u32x2*)(rowp + bj * 128) = w; } }
            return;
        }
#pragma unroll
        for (int ai = 0; ai < 2; ++ai)
#pragma unroll
            for (int m = 0; m < 4; ++m) { bf16_t* rowp = base + (size_t)(row0 + ai * 128 + m * 16) * ldc + col0;
#pragma unroll
                for (int bj = 0; bj < 2; ++bj) { const pg8::f32x4 v0 = acc[ai][bj][m][0], v1 = acc[ai][bj][m][1];
                    u32x4 w; w.x = cvtpk(v0.x, v0.y); w.y = cvtpk(v0.z, v0.w); w.z = cvtpk(v1.x, v1.y); w.w = cvtpk(v1.z, v1.w);
                    *(u32x4*)(rowp + bj * 128) = w; } }
    }
};
struct EpiGate {
    static constexpr bool PERM = true, AFTER_DRAIN = false; static constexpr int NSEG = 1;
    unsigned char* Gt;
    __device__ __forceinline__ void operator()(const pg8::f32x4 (&acc)[2][2][4][2], const pg8::Unit& u, int wr, int wc, int fr, int fq) const {
        asm volatile("" : "+v"(fr), "+v"(fq));
        const int row0 = u.pm * 256 + wr * 64 + fr, col0 = u.pn * 256 + wc * 32 + 8 * fq;
#pragma unroll
        for (int ai = 0; ai < 2; ++ai)
#pragma unroll
            for (int m = 0; m < 4; ++m) { unsigned char* rowp = Gt + (size_t)(row0 + ai * 128 + m * 16) * 3072 + col0;
#pragma unroll
                for (int bj = 0; bj < 2; ++bj) { const pg8::f32x4 v0 = acc[ai][bj][m][0], v1 = acc[ai][bj][m][1];
                    u32x2 w; w.x = pack_u8x4(gate_q(v0.x), gate_q(v0.y), gate_q(v0.z), gate_q(v0.w)); w.y = pack_u8x4(gate_q(v1.x), gate_q(v1.y), gate_q(v1.z), gate_q(v1.w));
                    *(u32x2*)(rowp + bj * 128) = w; } }
    }
};
struct EpiMerge {
    static constexpr bool PERM = true, AFTER_DRAIN = false; static constexpr int NSEG = 3;
    bf16_t* Mo; const unsigned char* Gt; unsigned* panel_cnt;
    __device__ __forceinline__ void rescale(pg8::f32x4 (&acc)[2][2][4][2], const pg8::Unit& u, int seg, int wr, int wc, int fr, int fq) const {
        asm volatile("" : "+v"(fr), "+v"(fq));
        const int row0 = u.pm * 256 + wr * 64 + fr, col0 = u.pn * 256 + wc * 32 + 8 * fq;
        const unsigned char* G0 = Gt + seg * 1024 + col0;
#pragma unroll
        for (int ai = 0; ai < 2; ++ai)
#pragma unroll
            for (int mh = 0; mh < 2; ++mh) {
                u32x2 ga[2][2], gb[2][2];
#pragma unroll
                for (int mm = 0; mm < 2; ++mm)
#pragma unroll
                    for (int bj = 0; bj < 2; ++bj) { const size_t row = (size_t)(row0 + ai * 128 + (2 * mh + mm) * 16);
                        ga[mm][bj] = *(const u32x2*)(G0 + row * 3072 + bj * 128); gb[mm][bj] = *(const u32x2*)(G0 + row * 3072 + 1024 + bj * 128); }
                __builtin_amdgcn_sched_barrier(0);
#pragma unroll
                for (int mm = 0; mm < 2; ++mm)
#pragma unroll
                    for (int bj = 0; bj < 2; ++bj) { const u32x2 a = ga[mm][bj], b = gb[mm][bj]; pg8::f32x4& v0 = acc[ai][bj][2 * mh + mm][0]; pg8::f32x4& v1 = acc[ai][bj][2 * mh + mm][1];
                        v0.x *= gq(a.x, 0) * fast_rcp(gq(b.x, 0)); v0.y *= gq(a.x, 1) * fast_rcp(gq(b.x, 1)); v0.z *= gq(a.x, 2) * fast_rcp(gq(b.x, 2)); v0.w *= gq(a.x, 3) * fast_rcp(gq(b.x, 3));
                        v1.x *= gq(a.y, 0) * fast_rcp(gq(b.y, 0)); v1.y *= gq(a.y, 1) * fast_rcp(gq(b.y, 1)); v1.z *= gq(a.y, 2) * fast_rcp(gq(b.y, 2)); v1.w *= gq(a.y, 3) * fast_rcp(gq(b.y, 3)); }
                __builtin_amdgcn_sched_barrier(0);
            }
    }
    __device__ __forceinline__ void operator()(const pg8::f32x4 (&acc)[2][2][4][2], const pg8::Unit& u, int wr, int wc, int fr, int fq) const {
        asm volatile("" : "+v"(fr), "+v"(fq));
        const int row0 = u.pm * 256 + wr * 64 + fr, col0 = u.pn * 256 + wc * 32 + 8 * fq;
        constexpr float S = 1.f / 256.f;
        const __amdgpu_buffer_rsrc_t rs = __builtin_amdgcn_make_buffer_rsrc((void*)Mo, 0, TT * 1024 * 2, 0x00020000);
#pragma unroll
        for (int ai = 0; ai < 2; ++ai) {
            u32x2 gv[4][2];
#pragma unroll
            for (int m = 0; m < 4; ++m)
#pragma unroll
                for (int bj = 0; bj < 2; ++bj) gv[m][bj] = *(const u32x2*)(Gt + (size_t)(row0 + ai * 128 + m * 16) * 3072 + 2048 + col0 + bj * 128);
            __builtin_amdgcn_sched_barrier(0);
#pragma unroll
            for (int m = 0; m < 4; ++m)
#pragma unroll
                for (int bj = 0; bj < 2; ++bj) { const pg8::f32x4 v0 = acc[ai][bj][m][0], v1 = acc[ai][bj][m][1]; const u32x2 g = gv[m][bj];
                    u32x4 w; w.x = cvtpk(v0.x * (gq(g.x, 0) * S), v0.y * (gq(g.x, 1) * S)); w.y = cvtpk(v0.z * (gq(g.x, 2) * S), v0.w * (gq(g.x, 3) * S));
                    w.z = cvtpk(v1.x * (gq(g.y, 0) * S), v1.y * (gq(g.y, 1) * S)); w.w = cvtpk(v1.z * (gq(g.y, 2) * S), v1.w * (gq(g.y, 3) * S));
                    if (panel_cnt) __builtin_amdgcn_raw_buffer_store_b128(w, rs, ((row0 + ai * 128 + m * 16) * 1024 + col0 + bj * 128) * 2, 0, 16);
                    else *(u32x4*)(Mo + (size_t)(row0 + ai * 128 + m * 16) * 1024 + col0 + bj * 128) = w; }
            __builtin_amdgcn_sched_barrier(0);
        }
        if (panel_cnt) {
            asm volatile("s_waitcnt vmcnt(0)" ::: "memory");
            if (lane_id() == 0) (void)__hip_atomic_fetch_add(panel_cnt + 64 * u.pm, 1u, __ATOMIC_RELAXED, __HIP_MEMORY_SCOPE_AGENT);
        }
    }
};
struct EpiOut {
    static constexpr bool PERM = true, AFTER_DRAIN = false; static constexpr int NSEG = 1;
    const float* xsL; const float* xsC; float* xdL; float* xdC; const float* MODl;
    __device__ __forceinline__ void operator()(const pg8::f32x4 (&acc)[2][2][4][2], const pg8::Unit& u, int wr, int wc, int fr, int fq) const {
        asm volatile("" : "+v"(fr), "+v"(fq));
        const int trow = u.pm * 256; const bool lat = trow < TL;
        const int row0 = trow + wr * 64 + fr, col0 = u.pn * 256 + wc * 32 + 8 * fq;
        const float* md = MODl + (size_t)mod_row(trow) * DIN + 2 * 1024 + col0;
        const float* xs = lat ? xsL + (size_t)row0 * D + col0 : xsC + (size_t)(row0 - TL) * D + col0; float* xd = lat ? xdL + (size_t)row0 * D + col0 : xdC + (size_t)(row0 - TL) * D + col0;
        f32x4 mv[2][2];
#pragma unroll
        for (int bj = 0; bj < 2; ++bj)
#pragma unroll
            for (int n = 0; n < 2; ++n) mv[bj][n] = *(const f32x4*)(md + bj * 128 + 4 * n);
#pragma unroll
        for (int ai = 0; ai < 2; ++ai)
#pragma unroll
            for (int mh = 0; mh < 2; ++mh) {
                f32x4 xv[2][2][2];
#pragma unroll
                for (int mm = 0; mm < 2; ++mm)
#pragma unroll
                    for (int bj = 0; bj < 2; ++bj)
#pragma unroll
                        for (int n = 0; n < 2; ++n) xv[mm][bj][n] = *(const f32x4*)(xs + (size_t)(ai * 128 + (2 * mh + mm) * 16) * D + bj * 128 + 4 * n);
                __builtin_amdgcn_sched_barrier(0);
#pragma unroll
                for (int mm = 0; mm < 2; ++mm)
#pragma unroll
                    for (int bj = 0; bj < 2; ++bj)
#pragma unroll
                        for (int n = 0; n < 2; ++n) { const pg8::f32x4 av = acc[ai][bj][2 * mh + mm][n]; const f32x4 x4 = xv[mm][bj][n], m4 = mv[bj][n];
                            f32x4 o; o.x = fmaf(m4.x, av.x, x4.x); o.y = fmaf(m4.y, av.y, x4.y); o.z = fmaf(m4.z, av.z, x4.z); o.w = fmaf(m4.w, av.w, x4.w);
                            *(f32x4*)(xd + (size_t)(ai * 128 + (2 * mh + mm) * 16) * D + bj * 128 + 4 * n) = o; }
                __builtin_amdgcn_sched_barrier(0);
            }
    }
};
struct EpiMoe1 {
    static constexpr bool PERM = true, AFTER_DRAIN = false; static constexpr int NSEG = 1;
    bf16_t* HM;
    __device__ __forceinline__ void operator()(const pg8::f32x4 (&acc)[2][2][4][2], const pg8::Unit& u, int wr, int wc, int fr, int fq) const {
        asm volatile("" : "+v"(fr), "+v"(fq));
        const int row0 = u.pm * 256 + wr * 64 + fr, hcol0 = (u.pn & 3) * 128 + wc * 16 + 4 * fq;
#pragma unroll
        for (int ai = 0; ai < 2; ++ai)
#pragma unroll
            for (int m = 0; m < 4; ++m) { bf16_t* rowp = HM + (size_t)(row0 + ai * 128 + m * 16) * 512 + hcol0;
#pragma unroll
                for (int bj = 0; bj < 2; ++bj) { const pg8::f32x4 x = acc[ai][bj][m][0], y = acc[ai][bj][m][1];
                    u32x2 w; w.x = cvtpk(x.x * sigmoid_f(x.x) * y.x, x.y * sigmoid_f(x.y) * y.y); w.y = cvtpk(x.z * sigmoid_f(x.z) * y.z, x.w * sigmoid_f(x.w) * y.w);
                    *(u32x2*)(rowp + bj * 64) = w; } }
    }
};
struct EpiMoe2 {
    static constexpr bool PERM = true, AFTER_DRAIN = false; static constexpr int NSEG = 1;
    bf16_t* Fo; const int* erow; const float* eroww; const LAS int* ebase; const LAS int* ecnt;
    __device__ __forceinline__ void operator()(const pg8::f32x4 (&acc)[2][2][4][2], const pg8::Unit& u, int wr, int wc, int fr, int fq) const {
        asm volatile("" : "+v"(fr), "+v"(fq));
        const int e = u.pn >> 2, cnt = __builtin_amdgcn_readfirstlane(ecnt[e]), pos0 = u.pm * 256 - __builtin_amdgcn_readfirstlane(ebase[e]) + wr * 64 + fr, col0 = (u.pn & 3) * 256 + wc * 32 + 8 * fq;
        const int* er = erow + (size_t)e * TT; const float* ew = eroww + (size_t)e * TT;
#pragma unroll
        for (int ai = 0; ai < 2; ++ai) {
            int rm[4]; float wg[4];
#pragma unroll
            for (int m = 0; m < 4; ++m) { const int pos = pos0 + ai * 128 + m * 16; const bool ok = pos < cnt; rm[m] = ok ? er[ok ? pos : 0] : -1; wg[m] = ew[ok ? pos : 0]; }
            __builtin_amdgcn_sched_barrier(0);
#pragma unroll
            for (int m = 0; m < 4; ++m) { const int r1 = rm[m];
                if (r1 >= 0) { const float wgt = wg[m]; bf16_t* rowp = Fo + ((size_t)(r1 & 1) * TT + (r1 >> 1)) * D + col0;
#pragma unroll
                    for (int bj = 0; bj < 2; ++bj) { const pg8::f32x4 v0 = acc[ai][bj][m][0], v1 = acc[ai][bj][m][1];
                        u32x4 w; w.x = cvtpk(v0.x * wgt, v0.y * wgt); w.y = cvtpk(v0.z * wgt, v0.w * wgt); w.z = cvtpk(v1.x * wgt, v1.y * wgt); w.w = cvtpk(v1.z * wgt, v1.w * wgt);
                        *(u32x4*)(rowp + bj * 128) = w; } } }
            __builtin_amdgcn_sched_barrier(0);
        }
    }
};
struct FusedOutOrder {
    int c, G, nun, wv; const unsigned* ready; unsigned* tmo;
    __device__ __forceinline__ bool next(int i, pg8::Unit& u) const {
        int q;
        if (!ready) { q = i * G + c; if (q >= nun) return false; }
        else if (G == 256 && nun == 576) { if (c < 64) { if (i > 0) return false; q = 512 + c; } else { q = i * 192 + (c - 64); if (q >= 512) return false; } }
        else { q = i * G + (G - 1 - c); if (q >= nun) return false; }
        u.pm = q >> 2; u.pn = q & 3; return true; }
    __device__ __forceinline__ void a_ready(const pg8::Unit& u) const {
        if (!ready) return;
        if (wv == 0) {
            const unsigned long long t0 = __builtin_amdgcn_s_memrealtime(); unsigned polls = 0;
            while ((unsigned)__builtin_amdgcn_readfirstlane(__hip_atomic_load(ready + 64 * u.pm, __ATOMIC_RELAXED, __HIP_MEMORY_SCOPE_AGENT)) < 32u) {
                if ((++polls & 255u) == 0u && __builtin_amdgcn_readfirstlane(__hip_atomic_load(tmo, __ATOMIC_RELAXED, __HIP_MEMORY_SCOPE_AGENT)) != 0u) break;
                if (__builtin_amdgcn_s_memrealtime() - t0 > 20000000ull) { if (lane_id() == 0) __hip_atomic_store(tmo, 1u, __ATOMIC_RELAXED, __HIP_MEMORY_SCOPE_AGENT); break; }
                __builtin_amdgcn_s_sleep(2); }
            __builtin_amdgcn_fence(__ATOMIC_ACQUIRE, "agent");
            asm volatile("s_waitcnt vmcnt(0)" ::: "memory");
        }
        asm volatile("" ::: "memory"); __builtin_amdgcn_s_barrier(); asm volatile("" ::: "memory");
    }
    __device__ __forceinline__ void done(const pg8::Unit&) const {}
};
struct LastInProjOrder {
    pg8::StaticOrder T; int nlat, G, c;
    __device__ __forceinline__ bool next(int i, pg8::Unit& u) const {
        const int L = i * G + c;
        if (L < nlat) return T.next(i, u);
        const int r = L - nlat; if (r >= 32) return false;
        u.pm = 128 + (r >> 1); u.pn = (r & 1) ? 11 : 2; return true; }
    __device__ __forceinline__ void a_ready(const pg8::Unit&) const {}
    __device__ __forceinline__ void done(const pg8::Unit&) const {}
};
struct MoeOrder {
    int nunits, G, c; const LAS int* tile_e;
    __device__ __forceinline__ bool next(int i, pg8::Unit& u) const {
        const int L0 = i * G + c; if (L0 >= nunits) return false;
        const int q = nunits / 8, r = nunits % 8, xcd = L0 % 8, off = L0 / 8; const int L = (xcd < r ? xcd * (q + 1) : r * (q + 1) + (xcd - r) * q) + off;
        const int pm = L >> 2; u.pm = pm; u.pn = __builtin_amdgcn_readfirstlane(tile_e[pm]) * 4 + (L & 3); return true; }
    __device__ __forceinline__ void a_ready(const pg8::Unit&) const {}
    __device__ __forceinline__ void done(const pg8::Unit&) const {}
};

__device__ __forceinline__ int moe_tables(const Fr& F, const Args& a, int l, LAS int* ebase  , LAS int* ecnt  , LAS int* tile_e  ) {
    const unsigned* CNT = (const unsigned*)(a.ws + WS_CTL) + CW_CNT + l * 256;
    __syncthreads();
    if (F.tid == 0) { int acc = 0;
#pragma unroll 1
        for (int e = 0; e < NE; ++e) { const int c = (int)__hip_atomic_load(&CNT[e * 16], __ATOMIC_RELAXED, __HIP_MEMORY_SCOPE_AGENT); ecnt[e] = c; ebase[e] = acc; const int nt = (c + 255) >> 8;
#pragma unroll 1
            for (int t = 0; t < nt; ++t) tile_e[(acc >> 8) + t] = e;
            acc += nt << 8; }
        ebase[NE] = acc; }
    __syncthreads();
    return ebase[NE] >> 8;
}

__device__ __forceinline__ void moe_gather_table(const Fr& F, const Args& a, const MoeOrder& S, const LAS int* ebase, const LAS int* ecnt, LAS int* gidx) {
    const int* EROW = (const int*)(a.ws + WS_EROW);
    for (int j = 0; j < 16; ++j) { pg8::Unit u; if (!S.next(j, u)) break;
        const int e = u.pn >> 2, pos0 = u.pm * 256 - ebase[e], cnt = ecnt[e];
        if (F.tid < 256) { const int pos = pos0 + F.tid; gidx[j * 256 + F.tid] = pos < cnt ? (EROW[(size_t)e * TT + pos] >> 1) : 0; } }
    __syncthreads();
}

#ifndef MK_PER_PHASE
#define MK_PER_PHASE 0
#endif
constexpr int PH_PER_LAYER = 10, PH_FINAL = 1 + NL * PH_PER_LAYER, N_PHASES = PH_FINAL + 1;

__global__ void __launch_bounds__(NTHR, 2) trunk_fwd(Args args) {
    extern __shared__ __attribute__((aligned(16))) unsigned char lds[];
    Fr F; F.lds = (LAS unsigned char*)lds; F.tid = threadIdx.x; F.lane = F.tid & 63; F.wave = __builtin_amdgcn_readfirstlane(F.tid >> 6); F.G = gridDim.x; F.bid = blockIdx.x;
    const int wave0 = F.wave;
    for (int u = F.tid; u < (LDS_BYTES - MISC_OFF) / 4; u += NTHR) ((LAS unsigned*)(F.lds + MISC_OFF))[u] = 0u;
    __syncthreads();
    const int lo = args.ph_lo, hi = args.ph_hi;
    unsigned* ctl = (unsigned*)(args.ws + WS_CTL);
    XcdBarrier bar; bar.bar = ctl + CW_BAR; bar.x = 0; bar.st = (volatile LAS unsigned*)(F.lds + MISC_OFF);
    if (hi - lo > 1) bar = xcd_barrier_post(ctl + CW_BAR, (volatile LAS unsigned*)(F.lds + MISC_OFF));
    bar.wv = (unsigned)wave0;
#ifndef DBG_ONLY
#define DBG_ONLY -1
#endif
#define SEL(p) (DBG_ONLY < 0 || DBG_ONLY == (p))
#define IN(k) (lo <= (k) && (k) < hi)
#define FRESH() do { int t_ = wave0 * 64 + lane_id(); asm volatile("" : "+v"(t_)); F.tid = t_; F.lane = t_ & 63; F.wave = wave0; } while (0)
#define SEAM(k) do { if (IN(k) && IN((k) + 1)) xcd_barrier(bar); } while (0)
#if !defined(PROBE_SUB)
#define PROBE_SUB -1
#endif
    unsigned long long pr_sub = 0ull;
#if defined(PROBE_P)
    unsigned long long pr_acc = 0ull, pr_t0 = __builtin_amdgcn_s_memrealtime();
#define PR_MARK(p) do { const unsigned long long t_ = __builtin_amdgcn_s_memrealtime(); if ((p) == PROBE_P) pr_acc += t_ - pr_t0; pr_t0 = t_; } while (0)
#else
#define PR_MARK(p) do { } while (0)
#endif
    unsigned char* ws = args.ws;
    LAS int* ebase = (LAS int*)(F.lds + MISC_OFF + 64); LAS int* ecnt = ebase + 20; LAS int* tile_e = (LAS int*)(F.lds + MISC_OFF + 512);

    #ifndef DBG_PRO
#define DBG_PRO 7
#endif
    if (SEL(100) && IN(0)) { FRESH(); if (DBG_PRO & 1) pro_mod(F, args); __syncthreads(); if (DBG_PRO & 2) pro_rope(F, args); if (DBG_PRO & 4) pro_filter(F, args); __syncthreads(); }
    SEAM(0); PR_MARK(100);
    for (int l = 0; l < NL; ++l) {
        const int pb = 1 + PH_PER_LAYER * l;
#define LVARS() int lq_ = l; asm volatile("" : "+s"(lq_)); const bool uc = lq_ < NL - 1; const int M2 = uc ? TT : TL; (void)M2; (void)uc
        if (SEL(0) && IN(pb + 0)) { LVARS(); FRESH(); if (l == 0) filter_norm_reduce(F, args); conv_small_weights(F, args, l, 7, 0); rows_p0(F, args, l, TT); __syncthreads(); }
        SEAM(pb + 0); PR_MARK(0);
        if (SEL(1) && IN(pb + 1)) { LVARS();
            { pg8::Gemm g{(const bf16_t*)(ws + WS_H), (const bf16_t*)(ws + WS_WIN), TT, 3072, 1024}; EpiInProj E{ws, 0};
              if (uc) { pg8::StaticOrder S; S.init(TT, 3072, F.G, F.bid); pg8::gemm_phase<EpiInProj, pg8::StaticOrder, true, true>(F.lds, g, S, E, wave0); }
              else { LastInProjOrder S; S.T.init(TL, 3072, F.G, F.bid); S.nlat = (TL / 256) * 12; S.G = F.G; S.c = F.bid; pg8::gemm_phase<EpiInProj, LastInProjOrder, true, true>(F.lds, g, S, E, wave0); } }
            { pg8::Gemm g{(const bf16_t*)(ws + WS_H8), (const bf16_t*)(ws + WS_WG8), M2, 3072, 512}; EpiGate E{ws + WS_G};
              pg8::StaticOrder S; S.init(M2, 3072, F.G, F.bid); pg8::gemm_phase<EpiGate, pg8::StaticOrder, true, true, false, true, -6>(F.lds, g, S, E, wave0); }
        }
        SEAM(pb + 1); PR_MARK(1);
        if (SEL(2) && IN(pb + 2)) { LVARS(); FRESH(); prep_phase(F, args, l, uc); }
        SEAM(pb + 2); PR_MARK(2);
        if (SEL(3) && IN(pb + 3)) { LVARS(); FRESH(); mixer_phase(F, args, l, uc, pr_sub, PROBE_SUB); }
        SEAM(pb + 3); PR_MARK(3);
        if (SEL(4) && IN(pb + 4)) { LVARS(); FRESH(); hyena_final_phase(F, args, l, uc); }
        SEAM(pb + 4); PR_MARK(4);
        if (SEL(5) && IN(pb + 5)) { LVARS();
            pg8::StaticOrder S; S.init(M2, 1024, F.G, F.bid);
            pg8::Gemm g{(const bf16_t*)(ws + WS_QA), (const bf16_t*)(ws + WS_WBR), M2, 1024, 1536}; EpiMerge E{(bf16_t*)(ws + WS_H), (const unsigned char*)(ws + WS_G), nullptr};
            pg8::gemm_phase<EpiMerge, pg8::StaticOrder, true, true>(F.lds, g, S, E, wave0);
            { FRESH(); __syncthreads(); const int nun = (M2 / 256) * 4, rem = nun % F.G; conv_expert_weights(F, args, l, rem, 0, CONV_E_ITEMS); __syncthreads(); }
        }
        SEAM(pb + 5); PR_MARK(5);
        if (SEL(6) && IN(pb + 6)) { LVARS();
            pg8::Gemm g{(const bf16_t*)(ws + WS_H), (const bf16_t*)(ws + WS_WOUT), M2, 1024, 1024}; pg8::StaticOrder S; S.init(M2, 1024, F.G, F.bid);
            EpiOut E{l == 0 ? args.in[I_X] : args.out, l == 0 ? args.in[I_CTX] : (const float*)(ws + WS_XC), args.out, (float*)(ws + WS_XC), (const float*)(ws + WS_MOD) + (size_t)l * NBM * DIN};
            pg8::gemm_phase<EpiOut, pg8::StaticOrder, true, true>(F.lds, g, S, E, wave0);
        }
        SEAM(pb + 6); PR_MARK(6);
        if (SEL(7) && IN(pb + 7)) { LVARS(); FRESH(); rows_p5(F, args, l, M2, pr_sub, PROBE_SUB); __syncthreads(); }
        SEAM(pb + 7); PR_MARK(7);
        if (SEL(8) && IN(pb + 8)) { LVARS(); FRESH();
            const int ntile = moe_tables(F, args, l, ebase, ecnt, tile_e);
            pg8::Gemm g{(const bf16_t*)(ws + WS_H), (const bf16_t*)(ws + WS_W13), ntile * 256, NE * 1024, 1024}; MoeOrder S{ntile * 4, F.G, F.bid, tile_e};
            LAS int* gidx = (LAS int*)(F.lds + 131072);
            moe_gather_table(F, args, S, ebase, ecnt, gidx);
            EpiMoe1 E{(bf16_t*)(ws + WS_U)};
            pg8::gemm_phase<EpiMoe1, MoeOrder, true, true, true>(F.lds, g, S, E, wave0, gidx);
        }
        SEAM(pb + 8); PR_MARK(8);
        if (SEL(9) && IN(pb + 9)) { LVARS(); FRESH();
            const int ntile = moe_tables(F, args, l, ebase, ecnt, tile_e);
            pg8::Gemm g{(const bf16_t*)(ws + WS_U), (const bf16_t*)(ws + WS_W2), ntile * 256, NE * 1024, 512}; MoeOrder S{ntile * 4, F.G, F.bid, tile_e};
            EpiMoe2 E{(bf16_t*)(ws + WS_F), (const int*)(ws + WS_EROW), (const float*)(ws + WS_EROWW), ebase, ecnt};
            pg8::gemm_phase<EpiMoe2, MoeOrder, true, true>(F.lds, g, S, E, wave0);
        }
        SEAM(pb + 9); PR_MARK(9);
    }
    if (SEL(101) && IN(PH_FINAL)) { FRESH(); rows_final(F, args); }
#if defined(PROBE_P)
    PR_MARK(101);
    pr_acc += pr_sub;
    if (blockIdx.x == 0 && F.wave == 0) { const unsigned long long t1 = __builtin_amdgcn_s_memrealtime() + 4ull * pr_acc; while (__builtin_amdgcn_s_memrealtime() < t1) __builtin_amdgcn_s_sleep(8); }
#endif
#undef IN
#undef SEAM
}

extern "C" void kernel_launch(void* const* d_in, const int* in_sizes, int n_in, void* d_out, int out_size, void* d_ws, size_t ws_size, hipStream_t stream) {
    static int grid = 0;
    if (grid == 0) {
        if (n_in != 29 || in_sizes[0] != TL * D || out_size != TL * D || ws_size < WS_END) { fprintf(stderr, "kernel_launch: unexpected shapes / workspace (n_in %d, ws %zu < %zu); nothing launched\n", n_in, ws_size, (size_t)WS_END); grid = -1; return; }
        int dev = 0, cus = 0, per_cu = 0;
        if (hipGetDevice(&dev) != hipSuccess || hipDeviceGetAttribute(&cus, hipDeviceAttributeMultiprocessorCount, dev) != hipSuccess) { grid = -1; return; }
        if (hipFuncSetAttribute((const void*)trunk_fwd, hipFuncAttributeMaxDynamicSharedMemorySize, LDS_BYTES) != hipSuccess) { fprintf(stderr, "kernel_launch: hipFuncSetAttribute failed\n"); grid = -1; return; }
        if (hipOccupancyMaxActiveBlocksPerMultiprocessor(&per_cu, (const void*)trunk_fwd, NTHR, LDS_BYTES) != hipSuccess || per_cu < 1) { fprintf(stderr, "kernel_launch: occupancy query reports %d\n", per_cu); }
        (void)hipGetLastError();
        grid = cus;
    }
    if (grid < 0) return;
    (void)hipMemsetAsync((char*)d_ws + WS_CTL, 0, CTL_ZERO_BYTES, stream);
    Args a{};
    for (int i = 0; i < 29; ++i) a.in[i] = (const float*)d_in[i];
    a.out = (float*)d_out; a.ws = (unsigned char*)d_ws;
#if MK_PER_PHASE
    for (int k = 0; k < N_PHASES; ++k) { a.ph_lo = k; a.ph_hi = k + 1; hipLaunchKernelGGL(trunk_fwd, dim3(grid), dim3(NTHR), LDS_BYTES, stream, a); }
#else
    a.ph_lo = 0; a.ph_hi = N_PHASES;
    hipLaunchKernelGGL(trunk_fwd, dim3(grid), dim3(NTHR), LDS_BYTES, stream, a);
#endif
}
```

```cpp
#include <hip/hip_runtime.h>
#include <cstdio>
#include <cstdint>

#define GAS __attribute__((address_space(1)))
#define LAS __attribute__((address_space(3)))
__device__ __forceinline__ int lane_id() { int l; asm volatile("v_mbcnt_lo_u32_b32 %0, -1, 0\n\tv_mbcnt_hi_u32_b32 %0, -1, %0" : "=v"(l)); return l; }
#define MK_PER_PHASE 0
namespace pg8 {
#define PG8_LAS __attribute__((address_space(3)))
typedef unsigned short bf16_t;
typedef short bf16x8 __attribute__((ext_vector_type(8)));
typedef float f32x4 __attribute__((ext_vector_type(4)));
typedef unsigned u32x4 __attribute__((ext_vector_type(4)));
constexpr int BM = 256, BK = 64, HALF = 128, HTB = HALF * BK * 2  , STAGE_BYTES = 8 * HTB, NXCD = 8, WGM = 8;

__host__ __device__ __forceinline__ int lds_byte(int r, int c) { const int st = (r >> 4) * 2 + (c >> 5), rr = r & 15, cc = c & 31, ob = rr * 64 + cc * 2; return st * 1024 + (ob ^ (((ob >> 9) & 1) << 5)); }
__host__ __device__ __forceinline__ void stage_rc(int b, int& R, int& C) { const int st = b / 1024, sb = b % 1024, swz = sb ^ (((sb >> 9) & 1) << 5); R = (st >> 1) * 16 + swz / 64; C = (st & 1) * 32 + (swz % 64) / 2; }
__host__ __device__ __forceinline__ int perm32(int rho) { const int n = rho >> 4, i = rho & 15; return 8 * (i >> 2) + 4 * n + (i & 3); }

struct Unit { int pm, pn; };
struct Gemm { const bf16_t* A; const bf16_t* Bt; int M, N, K; };

struct StaticOrder {
    int nM, nN, nwg, G, c;
    __host__ __device__ void init(int M, int N, int G_, int c_) { nM = M / BM; nN = N / BM; nwg = nM * nN; G = G_; c = c_; }
    __host__ __device__ bool next(int i, Unit& u) const {
        const long L = (long)i * G + c; if (L >= nwg) return false;
        int wgid = (int)L; { const int q = nwg / NXCD, r = nwg % NXCD, xcd = wgid % NXCD, off = wgid / NXCD; wgid = (xcd < r ? xcd * (q + 1) : r * (q + 1) + (xcd - r) * q) + off; }
        const int nig = WGM * nN, gid = wgid / nig, fm = gid * WGM, gsz = (nM - fm) < WGM ? (nM - fm) : WGM;
        u.pm = fm + ((wgid % nig) % gsz); u.pn = (wgid % nig) / gsz; return true;
    }
    __device__ __forceinline__ void a_ready(const Unit&) const {}
    __device__ __forceinline__ void done(const Unit&) const {}
};
__device__ __forceinline__ unsigned cvt_pk_bf16(float lo, float hi) { unsigned r; asm volatile("v_cvt_pk_bf16_f32 %0, %1, %2" : "=v"(r) : "v"(lo), "v"(hi)); return r; }
typedef float f32x2 __attribute__((ext_vector_type(2)));
template <class Epi, class Sched, bool ALIGN_EPI = false, bool SP2 = false, bool GATHER = false, bool F8 = false, int F8_SW = 0>
__device__ __forceinline__ void gemm_phase(PG8_LAS unsigned char* lds, const Gemm g, const Sched& S, const Epi& E, const int wave_id, const PG8_LAS int* gidx = nullptr) {
    static_assert(!GATHER || SP2, "GATHER is implemented for the SP2 loop only");
    int tid_ = wave_id * 64 + lane_id(); asm volatile("" : "+v"(tid_));
    const int tid = tid_, wid = __builtin_amdgcn_readfirstlane(tid >> 6), lane = tid & 63, wr = wid >> 2, wc = wid & 3, fr = lane & 15, fq = lane >> 4;
    const int K = g.K, nt = K / BK;
    unsigned voffA[2], voffB[2];
#pragma unroll
    for (int i = 0; i < 2; ++i) { int R, C; stage_rc(tid * 16 + i * 8192, R, C); const int Rb = Epi::PERM ? ((R & ~31) + perm32(R & 31)) : R;
        voffA[i] = (unsigned)(R * K + C) * 2u; voffB[i] = (unsigned)(Rb * K + C) * 2u; }
    unsigned goffA[2][2], goffN[2][2];
#define PG8_GOFF(dst, j) do { _Pragma("unroll") for (int _h = 0; _h < 2; ++_h) _Pragma("unroll") for (int _i = 0; _i < 2; ++_i) { int R_, C_; stage_rc(tid * 16 + _i * 8192, R_, C_); \
        dst[_h][_i] = ((unsigned)gidx[(j) * 256 + _h * 128 + R_] * (unsigned)K + (unsigned)C_) * 2u; } } while (0)
#define PG8_STAGE_A(bufoff, base, h, nx) do { if constexpr (GATHER) { unsigned o_[2] = {(nx) ? goffN[h][0] : goffA[h][0], (nx) ? goffN[h][1] : goffA[h][1]}; PG8_STAGE(bufoff, base, o_); } \
        else { PG8_STAGE(bufoff, (base) + ((h) ? hstep : 0), voffA); } } while (0)
    const size_t kstep = (size_t)(BK * 2);
    const size_t hstep = (size_t)HALF * K * 2;
    const size_t tstep = 2 * hstep;
    const unsigned ldsw = (unsigned)wid * 1024u;
    const int aoff = lds_byte(wr * 64 + fr, fq * 8), boff = lds_byte(wc * 32 + fr, fq * 8);
#define PG8_SA(b, h) (((b) * 2 + (h)) * HTB)
#define PG8_SB(b, h) ((4 + (b) * 2 + (h)) * HTB)
#define PG8_STAGE(bufoff, gbase, voff) do { _Pragma("unroll") for (int _i = 0; _i < 2; ++_i) \
        __builtin_amdgcn_global_load_lds((const unsigned*)((const char*)(gbase) + (voff)[_i]), (PG8_LAS unsigned*)(lds + (bufoff) + ldsw + _i * 8192), 16, 0, 0); } while (0)
#define PG8_LDA(dst, b, h) do { _Pragma("unroll") for (int m = 0; m < 4; ++m) _Pragma("unroll") for (int k = 0; k < 2; ++k) dst[m][k] = *(const PG8_LAS bf16x8*)(lds + PG8_SA(b, h) + aoff + m * 2048 + k * 1024); } while (0)
#define PG8_LDB(dst, b, h) do { _Pragma("unroll") for (int n = 0; n < 2; ++n) _Pragma("unroll") for (int k = 0; k < 2; ++k) dst[n][k] = *(const PG8_LAS bf16x8*)(lds + PG8_SB(b, h) + boff + n * 2048 + k * 1024); } while (0)
#define PG8_MMA(ai, bj, At, Bt) do { if constexpr (F8) __builtin_amdgcn_sched_barrier(0); __builtin_amdgcn_s_setprio(1); _Pragma("unroll") for (int m = 0; m < 4; ++m) _Pragma("unroll") for (int n = 0; n < 2; ++n) { \
        if constexpr (F8) { typedef int i32x4_ __attribute__((ext_vector_type(4))); typedef int i32x8_ __attribute__((ext_vector_type(8))); \
            const i32x8_ wf = __builtin_shufflevector(__builtin_bit_cast(i32x4_, Bt[n][0]), __builtin_bit_cast(i32x4_, Bt[n][1]), 0, 1, 2, 3, 4, 5, 6, 7); \
            const i32x8_ af = __builtin_shufflevector(__builtin_bit_cast(i32x4_, At[m][0]), __builtin_bit_cast(i32x4_, At[m][1]), 0, 1, 2, 3, 4, 5, 6, 7); \
              \
            asm volatile("v_mfma_scale_f32_16x16x128_f8f6f4 %0, %1, %2, %0, %3, %4 op_sel_hi:[0,0,0]" : "+v"(acc[ai][bj][m][n]) : "v"(wf), "v"(af), "v"(f8sw), "v"(f8sa)); } \
        else { _Pragma("unroll") for (int k = 0; k < 2; ++k) acc[ai][bj][m][n] = __builtin_amdgcn_mfma_f32_16x16x32_bf16(Bt[n][k], At[m][k], acc[ai][bj][m][n], 0, 0, 0); } } \
        __builtin_amdgcn_s_setprio(0); if constexpr (F8) __builtin_amdgcn_sched_barrier(0); } while (0)
#define PG8_WAIT_V(n) asm volatile("s_waitcnt vmcnt(" #n ")" ::: "memory")
#define PG8_WAIT_L(n) asm volatile("s_waitcnt lgkmcnt(" #n ")" ::: "memory")
#define PG8_BAR __builtin_amdgcn_s_barrier()
#define PG8_SCHED __builtin_amdgcn_sched_barrier(0)
    const int f8sw = 127 + F8_SW, f8sa = 127; (void)f8sw; (void)f8sa;
    Unit cur, nxt; int ui = 0;
    if (!S.next(0, cur)) return;
    f32x4 acc[2][2][4][2];
#pragma unroll
    for (int a = 0; a < 2; ++a)
#pragma unroll
        for (int b = 0; b < 2; ++b)
#pragma unroll
            for (int m = 0; m < 4; ++m)
#pragma unroll
                for (int n = 0; n < 2; ++n) acc[a][b][m][n] = (f32x4){0.f, 0.f, 0.f, 0.f};
    bf16x8 At[4][2], B0[2][2], B1[2][2];
    const char* cA = GATHER ? (const char*)g.A : (const char*)g.A + (size_t)cur.pm * tstep; const char* cB = (const char*)g.Bt + (size_t)cur.pn * tstep;
    if constexpr (GATHER) PG8_GOFF(goffA, 0);
    S.a_ready(cur);
    if constexpr (SP2) {
        PG8_STAGE(PG8_SB(0, 0), cB, voffB); PG8_STAGE(PG8_SB(0, 1), cB + hstep, voffB); PG8_STAGE_A(PG8_SA(0, 0), cA, 0, false); PG8_STAGE_A(PG8_SA(0, 1), cA, 1, false);
        if (wr == 1) PG8_BAR;
        PG8_WAIT_V(2); PG8_BAR;
        PG8_STAGE(PG8_SB(1, 0), cB + kstep, voffB); PG8_STAGE_A(PG8_SA(1, 0), cA + kstep, 0, false); PG8_STAGE(PG8_SB(1, 1), cB + hstep + kstep, voffB);
        PG8_WAIT_V(6); PG8_BAR;
    } else {
        PG8_STAGE(PG8_SB(0, 0), cB, voffB); PG8_STAGE(PG8_SA(0, 0), cA, voffA); PG8_STAGE(PG8_SB(0, 1), cB + hstep, voffB); PG8_STAGE(PG8_SA(0, 1), cA + hstep, voffA);
        if (wr == 1) PG8_BAR;
        PG8_WAIT_V(4); PG8_BAR;
        PG8_STAGE(PG8_SB(1, 0), cB + kstep, voffB); PG8_STAGE(PG8_SA(1, 0), cA + kstep, voffA); PG8_STAGE(PG8_SB(1, 1), cB + hstep + kstep, voffB);
        PG8_WAIT_V(6); PG8_BAR;
    }
    for (;;) {
        const bool has_next = S.next(ui + 1, nxt);
        if constexpr (GATHER) { if (has_next) PG8_GOFF(goffN, ui + 1); else { _Pragma("unroll") for (int _h = 0; _h < 2; ++_h) _Pragma("unroll") for (int _i = 0; _i < 2; ++_i) goffN[_h][_i] = goffA[_h][_i]; } }
        const char* nA = GATHER ? (const char*)g.A : has_next ? (const char*)g.A + (size_t)nxt.pm * tstep : cA; const char* nB = has_next ? (const char*)g.Bt + (size_t)nxt.pn * tstep : cB;
        for (int t = 0; t < nt; t += 2) {
            const bool last = (t == nt - 2);
            const char* a1 = cA + (size_t)(t + 1) * kstep;
            const char* a2 = last ? nA : cA + (size_t)(t + 2) * kstep; const char* b2 = last ? nB : cB + (size_t)(t + 2) * kstep;
            const char* a3 = a2 + kstep; const char* b3 = b2 + kstep;
            if (last && has_next) S.a_ready(nxt);
            if constexpr (SP2) {
            PG8_LDB(B0, 0, 0); PG8_LDB(B1, 0, 1); PG8_SCHED; PG8_LDA(At, 0, 0); PG8_STAGE_A(PG8_SA(1, 1), a1, 1, false);
            PG8_WAIT_V(8); PG8_WAIT_L(0); PG8_BAR; PG8_MMA(0, 0, At, B0); PG8_MMA(0, 1, At, B1); PG8_BAR; PG8_SCHED;
            PG8_LDA(At, 0, 1); PG8_STAGE(PG8_SB(0, 0), b2, voffB); PG8_STAGE(PG8_SB(0, 1), b2 + hstep, voffB); PG8_STAGE_A(PG8_SA(0, 0), a2, 0, last);
            PG8_WAIT_V(8); PG8_WAIT_L(0); PG8_BAR; PG8_MMA(1, 0, At, B0); PG8_MMA(1, 1, At, B1); PG8_BAR; PG8_SCHED;
            PG8_LDB(B0, 1, 0); PG8_LDB(B1, 1, 1); PG8_SCHED; PG8_LDA(At, 1, 0); PG8_STAGE_A(PG8_SA(0, 1), a2, 1, last);
            PG8_WAIT_V(8); PG8_WAIT_L(0); PG8_BAR; PG8_MMA(0, 0, At, B0); PG8_MMA(0, 1, At, B1); PG8_BAR; PG8_SCHED;
            PG8_LDA(At, 1, 1); PG8_STAGE(PG8_SB(1, 0), b3, voffB); PG8_STAGE(PG8_SB(1, 1), b3 + hstep, voffB); PG8_STAGE_A(PG8_SA(1, 0), a3, 0, last);
            PG8_WAIT_V(8); PG8_WAIT_L(0); PG8_BAR; PG8_MMA(1, 0, At, B0); PG8_MMA(1, 1, At, B1); PG8_BAR; PG8_SCHED;
            if constexpr (Epi::NSEG > 1) {
                if (t + 2 < nt && ((t + 2) & 7) == 0) E.rescale(acc, cur, (t + 2) / 8 - 1, wr, wc, fr, fq);
            }
            } else {
            PG8_LDB(B0, 0, 0); PG8_SCHED; PG8_LDA(At, 0, 0); PG8_STAGE(PG8_SA(1, 1), a1 + hstep, voffA);
            PG8_WAIT_L(8); PG8_BAR; PG8_WAIT_L(0); PG8_MMA(0, 0, At, B0); PG8_BAR; PG8_SCHED;
            PG8_LDB(B1, 0, 1); PG8_STAGE(PG8_SB(0, 0), b2, voffB);
            PG8_BAR; PG8_WAIT_L(0); PG8_MMA(0, 1, At, B1); PG8_BAR;
            PG8_LDA(At, 0, 1); PG8_STAGE(PG8_SA(0, 0), a2, voffA);
            PG8_BAR; PG8_WAIT_L(0); PG8_MMA(1, 0, At, B0); PG8_BAR; PG8_SCHED;
            PG8_STAGE(PG8_SB(0, 1), b2 + hstep, voffB);
            PG8_WAIT_V(6); PG8_BAR; PG8_MMA(1, 1, At, B1); PG8_BAR;
            PG8_LDB(B0, 1, 0); PG8_SCHED; PG8_LDA(At, 1, 0); PG8_STAGE(PG8_SA(0, 1), a2 + hstep, voffA);
            PG8_WAIT_L(8); PG8_BAR; PG8_WAIT_L(0); PG8_MMA(0, 0, At, B0); PG8_BAR; PG8_SCHED;
            PG8_LDB(B1, 1, 1); PG8_STAGE(PG8_SB(1, 0), b3, voffB);
            PG8_BAR; PG8_WAIT_L(0); PG8_MMA(0, 1, At, B1); PG8_BAR;
            PG8_LDA(At, 1, 1); PG8_STAGE(PG8_SA(1, 0), a3, voffA);
            PG8_BAR; PG8_WAIT_L(0); PG8_MMA(1, 0, At, B0); PG8_BAR; PG8_SCHED;
            PG8_STAGE(PG8_SB(1, 1), b3 + hstep, voffB);
            PG8_WAIT_V(6); PG8_BAR; PG8_MMA(1, 1, At, B1); PG8_BAR;
            }
        }
        if constexpr (ALIGN_EPI) { if (wr == 0) PG8_BAR; }
        if constexpr (F8) asm volatile("s_nop 15\n\ts_nop 15" ::: "memory");
        if constexpr (!Epi::AFTER_DRAIN) { E(acc, cur, wr, wc, fr, fq); S.done(cur); }
        if (!has_next) break;
#pragma unroll
        for (int a = 0; a < 2; ++a)
#pragma unroll
            for (int b = 0; b < 2; ++b)
#pragma unroll
                for (int m = 0; m < 4; ++m)
#pragma unroll
                    for (int n = 0; n < 2; ++n) acc[a][b][m][n] = (f32x4){0.f, 0.f, 0.f, 0.f};
        cur = nxt; cA = nA; cB = nB; ++ui;
        if constexpr (GATHER) { _Pragma("unroll") for (int _h = 0; _h < 2; ++_h) _Pragma("unroll") for (int _i = 0; _i < 2; ++_i) goffA[_h][_i] = goffN[_h][_i]; }
        if constexpr (ALIGN_EPI) { if (wr == 1) PG8_BAR; }
    }
    PG8_WAIT_V(0);
    if constexpr (!ALIGN_EPI) { if (wr == 0) PG8_BAR; }
    PG8_BAR;
    if constexpr (Epi::AFTER_DRAIN) { E.fused(acc, cur, wr, wc, fr, fq, lds, wid, lane); S.done(cur); }
#undef PG8_SA
#undef PG8_SB
#undef PG8_STAGE
#undef PG8_STAGE_A
#undef PG8_GOFF
#undef PG8_LDA
#undef PG8_LDB
#undef PG8_MMA
#undef PG8_WAIT_V
#undef PG8_WAIT_L
#undef PG8_BAR
#undef PG8_SCHED
}
}
#define XB_TMO      128
#define XB_XCNT(j)  (256  + 64 * (j))
#define XB_XSUB(j)  (1280 + 64 * (j))
#define XB_XGEN(j)  (2304 + 64 * (j))
#define XB_TOP      3328
#define XB_TOPGEN   3392
#define XCD_BAR_WORDS 3456
#define XB_SPIN_CAP (1u << 22)
#define LAS __attribute__((address_space(3)))

__device__ __forceinline__ unsigned xb_ld(unsigned* p)              { return __hip_atomic_load(p, __ATOMIC_RELAXED, __HIP_MEMORY_SCOPE_AGENT); }
__device__ __forceinline__ unsigned xb_add(unsigned* p, unsigned v) { asm volatile("" : "+v"(p));
    return __hip_atomic_fetch_add(p, v, __ATOMIC_RELAXED, __HIP_MEMORY_SCOPE_AGENT); }
__device__ __forceinline__ unsigned xb_xcc_id() { return (unsigned)__builtin_amdgcn_s_getreg((3 << 11) | 20) & 0xFu; }
#define XB_SPIN(cond, bar) do { unsigned _sp = 0; while (cond) { __builtin_amdgcn_s_sleep(1); \
    if ((++_sp & 255u) == 0u) { if (xb_ld(&(bar)[XB_TMO])) break; if (_sp > XB_SPIN_CAP) { xb_add(&(bar)[XB_TMO], 1u); break; } } } } while (0)

struct XcdBarrier {
    unsigned* bar; unsigned x; unsigned wv;
    volatile LAS unsigned* st;
};

__device__ __forceinline__ XcdBarrier xcd_barrier_post(unsigned* bar, volatile LAS unsigned* st) {
    XcdBarrier b; b.bar = bar; b.x = xb_xcc_id(); b.st = st;
    if (threadIdx.x == 0) (void)xb_add(&bar[XB_XCNT(b.x)], 1u);
    return b;
}
__device__ __forceinline__ void xcd_barrier_complete(unsigned* bar, unsigned x, unsigned& nloc, unsigned& nx) {
    const unsigned G = gridDim.x * gridDim.y * gridDim.z;
    unsigned sum, cnt, mine, sp = 0u;
    for (;;) {
        sum = 0u; cnt = 0u; mine = 0u;
#pragma unroll
        for (unsigned j = 0; j < 16; ++j) { const unsigned c = xb_ld(&bar[XB_XCNT(j)]); sum += c; cnt += (c > 0u) ? 1u : 0u; mine = (j == x) ? c : mine; }
        if (sum == G) break;
        __builtin_amdgcn_s_sleep(1);
        if ((++sp & 255u) == 0u) { if (xb_ld(&bar[XB_TMO])) break; if (sp > XB_SPIN_CAP) { xb_add(&bar[XB_TMO], 1u); break; } }
    }
    nloc = mine > 0u ? mine : 1u; nx = cnt > 0u ? cnt : 1u;
}

__device__ __forceinline__ void xcd_barrier(const XcdBarrier& b) {
    asm volatile("s_waitcnt vmcnt(0)" ::: "memory");
    __syncthreads();
    if (b.wv == 0u && lane_id() == 0) {
        unsigned* bar = b.bar;
        __builtin_amdgcn_s_waitcnt(0);
        unsigned nloc = b.st[0], nx = b.st[1];
        if (nloc == 0u) { xcd_barrier_complete(bar, b.x, nloc, nx); b.st[0] = nloc; b.st[1] = nx; }
        const unsigned old = xb_add(&bar[XB_XSUB(b.x)], 1u);
        const unsigned gen = old / nloc;
        if (old + 1u == (gen + 1u) * nloc) {
            __builtin_amdgcn_fence(__ATOMIC_RELEASE, "agent");
            asm volatile("s_waitcnt vmcnt(0)" ::: "memory");
            const unsigned og = xb_add(&bar[XB_TOP], 1u);
            const unsigned tg = og / nx;
            if (og + 1u == (tg + 1u) * nx) xb_add(&bar[XB_TOPGEN], 1u);
            else XB_SPIN(xb_ld(&bar[XB_TOPGEN]) == tg, bar);
            __builtin_amdgcn_fence(__ATOMIC_ACQUIRE, "agent");
            xb_add(&bar[XB_XGEN(b.x)], 1u);
            asm volatile("s_waitcnt vmcnt(0)" ::: "memory");
        } else {
            XB_SPIN(xb_ld(&bar[XB_XGEN(b.x)]) == gen, bar);
            __builtin_amdgcn_fence(__ATOMIC_ACQUIRE, "agent");
            asm volatile("s_waitcnt vmcnt(0)" ::: "memory");
        }
    }
    __syncthreads();
}

typedef unsigned short bf16_t;
typedef short bf16x8 __attribute__((ext_vector_type(8)));
typedef float f32x4 __attribute__((ext_vector_type(4)));
typedef float f32x16 __attribute__((ext_vector_type(16)));
typedef unsigned u32x4 __attribute__((ext_vector_type(4)));
typedef unsigned u32x2 __attribute__((ext_vector_type(2)));

constexpr int D = 1024, NB = 16, SEQ = 2048, CTX = 256, NL = 4;
constexpr int TL = NB * SEQ, TC = NB * CTX, TT = TL + TC;
constexpr int DIN = 6144, HYW = 512, NE = 16, DE = 512, KEYS = CTX + SEQ;
constexpr int NMOD = 6, NBM = NB + 1;
constexpr int APROWS = 2 * TT + NE * 256;
constexpr float EPS = 1e-6f, LOG2E = 1.4426950408889634f;
constexpr float QSCALE = 0.125f * LOG2E;

constexpr size_t MiB = 1u << 20;
constexpr size_t WS_CTL = 0, CTL_ZERO_BYTES = 1 * MiB;
constexpr size_t WS_MOD = 1 * MiB;
constexpr size_t WS_ROPE = 3 * MiB;
constexpr size_t WS_FL = 4 * MiB, WS_FC = 20 * MiB;
constexpr size_t WS_MISC = 22 * MiB;
constexpr size_t WS_FNORM = WS_MISC;
constexpr size_t WS_TOKE = WS_MISC + 64 * 1024, WS_TOKP = WS_MISC + 352 * 1024, WS_TOKW = WS_MISC + 640 * 1024;
constexpr size_t WS_ROWMAP = WS_MISC + 960 * 1024, WS_ROWW = WS_MISC + 1280 * 1024;
constexpr size_t WS_WIN = 24 * MiB, WS_WBR = 36 * MiB, WS_WOUT = 39 * MiB;
constexpr size_t WS_XC = 41 * MiB;
constexpr size_t WS_NP = WS_XC;
constexpr size_t WS_H = 57 * MiB;
constexpr size_t WS_KA = 129 * MiB, WS_VTA = 138 * MiB, WS_KW = 147 * MiB, WS_VTW = 156 * MiB;
constexpr size_t WS_QA = 165 * MiB, WS_QW = 201 * MiB, WS_YH = 237 * MiB, WS_VT = 273 * MiB, WS_YT = 309 * MiB;
constexpr size_t WS_RAWA = 309 * MiB, WS_RAWW = 327 * MiB;
constexpr size_t WS_F = 165 * MiB;
constexpr size_t WS_U = 345 * MiB;
constexpr size_t WS_G = 453 * MiB;
constexpr size_t WS_W13 = 605 * MiB, WS_W2 = 637 * MiB;
constexpr size_t WS_EROW = 669 * MiB, WS_EROWW = 672 * MiB;
constexpr size_t WS_H8 = 675 * MiB;
constexpr size_t WS_WG8 = WS_WIN;
constexpr size_t WS_END = 711 * MiB;
static_assert(WS_G + (size_t)APROWS * 2048 <= WS_W13 && WS_W2 + (size_t)16 * 1024 * 512 * 2 <= WS_END && WS_G + (size_t)TT * 3072 * 2 <= WS_END, "ws map");
static_assert(WS_U + (size_t)APROWS * 1024 <= WS_G && WS_F + (size_t)2 * TT * 2048 <= WS_YT, "ws map 2");
constexpr size_t VT_CTX_OFF = (size_t)HYW * NB * SEQ;

constexpr int CW_BAR = 4096, CW_CNT = 8192, CW_PANEL = 16384, CW_HTMO = 12288;
constexpr int LDS_BYTES = 151552, MISC_OFF = 147456;
constexpr int NWAVES = 8, NTHR = 512;

struct Args { const float* in[29]; float* out; unsigned char* ws; int ph_lo, ph_hi; };
enum { I_X = 0, I_C, I_CTX, I_CCTX, I_ADAW, I_ADAB, I_N1G, I_N2G, I_WIN, I_QKG, I_HSW, I_HSB, I_HW1, I_HB1, I_HFR, I_HW2, I_HB2, I_HW3, I_HBIAS, I_SINK, I_WBR, I_WOUT,
       I_RGW, I_RGB, I_REW, I_REB, I_EW1, I_EW3, I_EW2 };

#define LDS_WAIT() asm volatile("s_waitcnt lgkmcnt(0)" ::: "memory")
#define VM_WAIT() asm volatile("s_waitcnt vmcnt(0)" ::: "memory")

typedef float f32x2_t __attribute__((ext_vector_type(2)));
typedef __bf16 bf16x2_t __attribute__((ext_vector_type(2)));
__device__ __forceinline__ unsigned cvtpk(float lo, float hi) { f32x2_t v = {lo, hi}; bf16x2_t b = __builtin_convertvector(v, bf16x2_t); return __builtin_bit_cast(unsigned, b); }
__device__ __forceinline__ unsigned zero_u32() { unsigned z; asm volatile("v_mov_b32 %0, 0" : "=v"(z)); return z; }
__device__ __forceinline__ unsigned cvt4_fp8(float a, float b, float c, float d) { int r = __builtin_amdgcn_cvt_pk_fp8_f32(a, b, 0, false); r = __builtin_amdgcn_cvt_pk_fp8_f32(c, d, r, true); return (unsigned)r; }
__device__ __forceinline__ float bflo(unsigned u) { return __builtin_bit_cast(float, u << 16); }
__device__ __forceinline__ float bfhi(unsigned u) { return __builtin_bit_cast(float, u & 0xffff0000u); }
__device__ __forceinline__ float bf1(bf16_t u) { return __builtin_bit_cast(float, (unsigned)u << 16); }
__device__ __forceinline__ bf16_t f2bf(float f) { return (bf16_t)(cvtpk(f, 0.f) & 0xffffu); }
#define DPP_F(v, ctrl) __builtin_bit_cast(float, __builtin_amdgcn_update_dpp(0, __builtin_bit_cast(int, (v)), (ctrl), 0xf, 0xf, false))
__device__ __forceinline__ float row16_sum(float v) {
    v += DPP_F(v, 0xB1);
    v += DPP_F(v, 0x4E);
    v += DPP_F(v, 0x141);
    v += DPP_F(v, 0x140);
    return v;
}
__device__ __forceinline__ float wave_sum(float v) {
    v = row16_sum(v);
    const int iv = __builtin_bit_cast(int, v);
    float r = (__builtin_bit_cast(float, __builtin_amdgcn_readlane(iv, 0)) + __builtin_bit_cast(float, __builtin_amdgcn_readlane(iv, 16)))
            + (__builtin_bit_cast(float, __builtin_amdgcn_readlane(iv, 32)) + __builtin_bit_cast(float, __builtin_amdgcn_readlane(iv, 48)));
    asm volatile("" : "+v"(r));
    return r;
}
__device__ __forceinline__ float fast_exp2(float x) { return __builtin_amdgcn_exp2f(x); }
__device__ __forceinline__ float fast_rcp(float x) { return __builtin_amdgcn_rcpf(x); }
__device__ __forceinline__ float sigmoid_f(float x) { return fast_rcp(1.f + fast_exp2(-x * LOG2E)); }

__device__ __forceinline__ void sincos_acc(float x, float& s, float& c) {
    const float q = rintf(x * 0.636619772367581f);
    float y = fmaf(-q, 1.57079625129699707031f, x);
    y = fmaf(-q, 7.54978941586159635335e-08f, y);
    const float y2 = y * y;
    float sp = fmaf(y2, 2.7557314297e-06f, -1.9841270114e-04f); sp = fmaf(sp, y2, 8.3333337680e-03f); sp = fmaf(sp, y2, -1.6666667163e-01f); sp = fmaf(sp * y2, y, y);
    float cp = fmaf(y2, -2.7557314297e-07f, 2.4801587642e-05f); cp = fmaf(cp, y2, -1.3888889225e-03f); cp = fmaf(cp, y2, 4.1666667908e-02f); cp = fmaf(cp, y2, -0.5f); cp = fmaf(cp, y2, 1.0f);
    const int n = (int)q & 3;
    const float s1 = (n & 1) ? cp : sp, c1 = (n & 1) ? sp : cp;
    s = (n & 2) ? -s1 : s1;
    c = ((n + 1) & 2) ? -c1 : c1;
}

struct Fr { LAS unsigned char* lds; int tid, lane, wave, G, bid; };

__device__ __forceinline__ void pro_mod(const Fr& F, const Args& a) {
    LAS float* s = (LAS float*)F.lds;
    LAS float* red = (LAS float*)(F.lds + 69632);
    const float* c = a.in[I_C]; const float* cc = a.in[I_CCTX]; const float* W = a.in[I_ADAW]; const float* Bv = a.in[I_ADAB];
    float* MOD = (float*)(a.ws + WS_MOD);
    for (int i = F.tid; i < NBM * 1024; i += NTHR) { const int bb = i >> 10, k = i & 1023; const float v = (bb < NB) ? c[bb * 1024 + k] : cc[k]; s[i] = v / (1.f + __expf(-v)); }
    __syncthreads();
    const int col = F.tid & 63, ks = F.wave;
    for (int unit = F.G - 1 - F.bid; unit < NL * 96; unit += F.G) {
        const int l = unit / 96, j0 = (unit % 96) * 64;
        float acc[NBM];
#pragma unroll
        for (int bb = 0; bb < NBM; ++bb) acc[bb] = 0.f;
        const float* Wp = W + ((size_t)l * 1024 + ks * 128) * DIN + j0 + col;
#pragma unroll 2
        for (int k = 0; k < 128; k += 4) {
            const float w0 = Wp[(size_t)k * DIN], w1 = Wp[(size_t)(k + 1) * DIN], w2 = Wp[(size_t)(k + 2) * DIN], w3 = Wp[(size_t)(k + 3) * DIN];
#pragma unroll
            for (int bb = 0; bb < NBM; ++bb) { const f32x4 sv = *(const LAS f32x4*)(s + bb * 1024 + ks * 128 + k);
                acc[bb] = fmaf(sv.x, w0, acc[bb]); acc[bb] = fmaf(sv.y, w1, acc[bb]); acc[bb] = fmaf(sv.z, w2, acc[bb]); acc[bb] = fmaf(sv.w, w3, acc[bb]); } }
#pragma unroll
        for (int bb = 0; bb < NBM; ++bb) red[(ks * NBM + bb) * 64 + col] = acc[bb];
        __syncthreads();
        for (int o = F.tid; o < NBM * 64; o += NTHR) { const int bb = o >> 6, cx = o & 63; float sum = 0.f;
#pragma unroll
            for (int k2 = 0; k2 < 8; ++k2) sum += red[(k2 * NBM + bb) * 64 + cx];
            MOD[((size_t)l * NBM + bb) * DIN + j0 + cx] = sum + Bv[l * DIN + j0 + cx]; }
        __syncthreads();
    }
}

__device__ __forceinline__ void pro_rope(const Fr& F, const Args& a) {
    float* ct = (float*)(a.ws + WS_ROPE); float* st = ct + SEQ * 32;
    for (int i = F.bid * NTHR + F.tid; i < SEQ * 32; i += F.G * NTHR) {
        const int pos = i >> 5, ax = (i >> 4) & 1, f = i & 15;
        const float inv = exp2f(-(float)f * (13.287712379549449f / 16.f));
        const float ang = (float)(ax == 0 ? (pos >> 6) : (pos & 63)) * inv;
        float sv, cv; sincos_acc(ang, sv, cv); ct[i] = cv; st[i] = sv;
    }
}

__device__ __forceinline__ void pro_filter(const Fr& F, const Args& a) {
    LAS float* L = (LAS float*)F.lds;
    constexpr int oW1 = 0, oB1 = 2112, oFR = 2176, oB2 = 2240, oW2 = 2304, oZ = 6400, oH1 = 7552, oH2 = 9600, oW3 = 11648, oT = 19840;
    bf16_t* FL = (bf16_t*)(a.ws + WS_FL); bf16_t* FC = (bf16_t*)(a.ws + WS_FC); float* NP = (float*)(a.ws + WS_NP);
    const int p = F.tid >> 4, jj = F.tid & 15;
    for (int unit = F.bid; unit < NL * 72; unit += F.G) {
        const int l = unit / 72, ch = unit % 72; const bool lat = ch < 64; const int n = lat ? SEQ : CTX, pos0 = lat ? ch * 32 : (ch - 64) * 32;
        __syncthreads();
        for (int i = F.tid; i < 2112; i += NTHR) L[oW1 + i] = a.in[I_HW1][l * 2112 + i];
        for (int i = F.tid; i < 64; i += NTHR) { L[oB1 + i] = a.in[I_HB1][l * 64 + i]; L[oFR + i] = a.in[I_HFR][l * 64 + i]; L[oB2 + i] = a.in[I_HB2][l * 64 + i]; }
        for (int i = F.tid; i < 4096; i += NTHR) L[oW2 + i] = a.in[I_HW2][l * 4096 + i];
        const int pos = pos0 + p; const float t = (float)pos / (float)(n - 1);
        { const float band = 1e-4f + (float)jj * ((15.f - 1e-4f) / 15.f); const float ang = ((6.2831855f * band) * (float)pos) / (float)n;
          float sv, cv; sincos_acc(ang, sv, cv); L[oZ + p * 36 + 1 + jj] = cv; L[oZ + p * 36 + 17 + jj] = -sv; if (jj == 0) L[oZ + p * 36] = t; }
        __syncthreads();
        { f32x4 acc = *(const LAS f32x4*)(L + oB1 + 4 * jj);
#pragma unroll 3
          for (int i = 0; i < 33; ++i) { const float z = L[oZ + p * 36 + i]; const f32x4 w = *(const LAS f32x4*)(L + oW1 + i * 64 + 4 * jj); acc.x = fmaf(z, w.x, acc.x); acc.y = fmaf(z, w.y, acc.y); acc.z = fmaf(z, w.z, acc.z); acc.w = fmaf(z, w.w, acc.w); }
          const f32x4 fr = *(const LAS f32x4*)(L + oFR + 4 * jj); float sv, cv; f32x4 o;
          sincos_acc(fr.x * acc.x, sv, cv); o.x = sv; sincos_acc(fr.y * acc.y, sv, cv); o.y = sv; sincos_acc(fr.z * acc.z, sv, cv); o.z = sv; sincos_acc(fr.w * acc.w, sv, cv); o.w = sv;
          *(LAS f32x4*)(L + oH1 + p * 64 + 4 * jj) = o; }
        __syncthreads();
        { f32x4 acc = *(const LAS f32x4*)(L + oB2 + 4 * jj);
#pragma unroll 4
          for (int i = 0; i < 64; ++i) { const float z = L[oH1 + p * 64 + i]; const f32x4 w = *(const LAS f32x4*)(L + oW2 + i * 64 + 4 * jj); acc.x = fmaf(z, w.x, acc.x); acc.y = fmaf(z, w.y, acc.y); acc.z = fmaf(z, w.z, acc.z); acc.w = fmaf(z, w.w, acc.w); }
          const f32x4 fr = *(const LAS f32x4*)(L + oFR + 4 * jj); float sv, cv; f32x4 o;
          sincos_acc(fr.x * acc.x, sv, cv); o.x = sv; sincos_acc(fr.y * acc.y, sv, cv); o.y = sv; sincos_acc(fr.z * acc.z, sv, cv); o.z = sv; sincos_acc(fr.w * acc.w, sv, cv); o.w = sv;
          *(LAS f32x4*)(L + oH2 + p * 64 + 4 * jj) = o; }
        LAS bf16_t* T = (LAS bf16_t*)(L + oT);
#pragma unroll 1
        for (int mh = 0; mh < 1; ++mh) {
            f32x4 acc[16];
#pragma unroll
            for (int m = 0; m < 16; ++m) acc[m] = (f32x4){0.f, 0.f, 0.f, 0.f};
#pragma unroll 1
            for (int kc = 0; kc < 8; ++kc) {
                __syncthreads();
                for (int i = F.tid; i < 2048; i += NTHR) *(LAS f32x4*)(L + oW3 + i * 4) = *(const f32x4*)(a.in[I_HW3] + ((size_t)l * 64 + kc * 8) * 1024 + i * 4);
                __syncthreads();
#pragma unroll 1
                for (int k = 0; k < 8; ++k) { const float h = L[oH2 + p * 64 + kc * 8 + k];
#pragma unroll
                    for (int m = 0; m < 16; ++m) { const f32x4 w = *(const LAS f32x4*)(L + oW3 + k * 1024 + 64 * m + 4 * jj);
                        acc[m].x = fmaf(h, w.x, acc[m].x); acc[m].y = fmaf(h, w.y, acc[m].y); acc[m].z = fmaf(h, w.z, acc[m].z); acc[m].w = fmaf(h, w.w, acc[m].w); } }
            }
#pragma unroll
            for (int m = 0; m < 16; ++m) {
                const int colb = 64 * m + 4 * jj; const int dirb = m >> 3;
                const float v4[4] = {acc[m].x, acc[m].y, acc[m].z, acc[m].w};
#pragma unroll
                for (int e = 0; e < 4; ++e) { const int col = colb + e, c = col & 511;
                    const float dl = fabsf(-3.0701134573253943f + (-15.350567286626972f + 3.0701134573253943f) * ((float)c / 511.f));
                    float v = v4[e] * __expf(-t * dl); if (dirb == 1 && pos == 0) v = 0.f;
                    T[col * 32 + (dirb == 0 ? 31 - p : p)] = f2bf(v); }
            }
        }
        __syncthreads();
        for (int idx = F.tid; idx < 1024 * 32; idx += NTHR) { const int col = idx >> 5, i = idx & 31, dir = col >> 9, c = col & 511;
            const int u = (dir == 0) ? (n - 32 - pos0 + i) : ((pos0 + i == 0) ? 2 * n - 1 : n - 1 + pos0 + i);
            bf16_t* Fb = lat ? FL + ((size_t)l * 512 + c) * 4096 : FC + ((size_t)l * 512 + c) * 512;
            Fb[u] = T[col * 32 + i]; }
        for (int col = F.tid; col < 1024; col += NTHR) { float sum = 0.f;
#pragma unroll 8
            for (int i = 0; i < 32; ++i) sum += fabsf(bf1(T[col * 32 + i]));
            NP[((size_t)l * 72 + ch) * 1024 + col] = sum; }
    }
    __syncthreads();
}
__device__ __forceinline__ void filter_norm_reduce(const Fr& F, const Args& a) {
    const float* NP = (const float*)(a.ws + WS_NP); float* FN = (float*)(a.ws + WS_FNORM);
    for (int o = F.bid * NTHR + F.tid; o < NL * 2 * 512; o += F.G * NTHR) { const int l = o >> 10, isc = (o >> 9) & 1, c = o & 511;
        const int ch0 = isc ? 64 : 0, ch1 = isc ? 72 : 64; float sum = 0.f;
        for (int ch = ch0; ch < ch1; ++ch) sum += NP[((size_t)l * 72 + ch) * 1024 + c] + NP[((size_t)l * 72 + ch) * 1024 + 512 + c];
        FN[o] = 1.f / sum; }
}

template <int MODE>
__device__ __forceinline__ void transpose_item(const float* W, int K, int N, bf16_t* WT, int row_off, LAS float* scr, int item, int lane, int ldk = 0) {
    if (ldk == 0) ldk = K;
    const int nblk = N / 64, kb = item / nblk, nb = item % nblk, k0 = 64 * kb, n0 = 64 * nb;
    f32x4 v[16];
#pragma unroll
    for (int i = 0; i < 16; ++i) v[i] = *(const f32x4*)(W + (size_t)(k0 + 4 * i + (lane >> 4)) * N + n0 + (lane & 15) * 4);
#pragma unroll
    for (int i = 0; i < 16; ++i) *(LAS f32x4*)(scr + (4 * i + (lane >> 4)) * 68 + (lane & 15) * 4) = v[i];
    LDS_WAIT();
    const int c = lane & 7;
#pragma unroll
    for (int j = 0; j < 8; ++j) { const int n = (lane >> 3) + 8 * j; const LAS float* s = scr + (8 * c) * 68 + n;
        u32x4 o; o.x = cvtpk(s[0 * 68], s[1 * 68]); o.y = cvtpk(s[2 * 68], s[3 * 68]); o.z = cvtpk(s[4 * 68], s[5 * 68]); o.w = cvtpk(s[6 * 68], s[7 * 68]);
        const int nn = n0 + n; const int row = (MODE == 0) ? nn : ((nn >> 2) * 8 + (nn & 3) + (MODE == 2 ? 4 : 0));
        *(u32x4*)(WT + (size_t)(row_off + row) * ldk + k0 + 8 * c) = o; }
    LDS_WAIT();
}

__device__ __forceinline__ void transpose_item_f8(const float* W, bf16_t*  , unsigned char* WT, LAS float* scr, int item, int lane) {
    constexpr int K = 1024, N = DIN; const int nblk = 96, kb = item / nblk, nb = item % nblk, k0 = 64 * kb, n0 = 64 * nb;
    f32x4 v[16];
#pragma unroll
    for (int i = 0; i < 16; ++i) v[i] = *(const f32x4*)(W + (size_t)(k0 + 4 * i + (lane >> 4)) * N + n0 + (lane & 15) * 4);
#pragma unroll
    for (int i = 0; i < 16; ++i) *(LAS f32x4*)(scr + (4 * i + (lane >> 4)) * 68 + (lane & 15) * 4) = v[i];
    LDS_WAIT();
    const int c = lane & 7;
#pragma unroll
    for (int j = 0; j < 8; ++j) { const int n = (lane >> 3) + 8 * j; const LAS float* s = scr + (8 * c) * 68 + n;
        u32x2 o; o.x = cvt4_fp8(s[0 * 68] * 64.f, s[1 * 68] * 64.f, s[2 * 68] * 64.f, s[3 * 68] * 64.f); o.y = cvt4_fp8(s[4 * 68] * 64.f, s[5 * 68] * 64.f, s[6 * 68] * 64.f, s[7 * 68] * 64.f);
        *(u32x2*)(WT + (size_t)(n0 + n) * K + k0 + 8 * c) = o; }
    LDS_WAIT();
}
__device__ __forceinline__ void conv_small_weights(const Fr& F, const Args& a, int l, int mask, int b0) {
    if (F.bid < b0) return;
    LAS float* scr = (LAS float*)(F.lds + F.wave * 17408);
    const int gw = (F.bid - b0) * NWAVES + F.wave, NGW = (F.G - b0) * NWAVES;
    constexpr int I_IN = (1024 / 64) * (DIN / 64), I_BR = (512 / 64) * (1024 / 64), I_OUT = (1024 / 64) * (1024 / 64);
    if (mask & 1) for (int it = gw; it < I_IN; it += NGW) transpose_item_f8(a.in[I_WIN] + (size_t)l * 1024 * DIN, nullptr, a.ws + WS_WG8, scr, it, F.lane);
    if (mask & 2) for (int it = gw; it < 3 * I_BR; it += NGW) { const int b = it / I_BR; transpose_item<0>(a.in[I_WBR] + ((size_t)l * 3 + b) * 512 * 1024, 512, 1024, (bf16_t*)(a.ws + WS_WBR) + b * 512, 0, scr, it % I_BR, F.lane, 1536); }
    if (mask & 4) for (int it = gw; it < I_OUT; it += NGW) transpose_item<0>(a.in[I_WOUT] + (size_t)l * 1024 * 1024, 1024, 1024, (bf16_t*)(a.ws + WS_WOUT), 0, scr, it, F.lane);
}
__device__ __forceinline__ void conv_expert_weights(const Fr& F, const Args& a, int l, int b0, int it0, int it1) {
    if (F.bid < b0) return;
    LAS float* scr = (LAS float*)(F.lds + F.wave * 17408);
    const int gw = (F.bid - b0) * NWAVES + F.wave, NGW = (F.G - b0) * NWAVES;
    constexpr int I_1 = (1024 / 64) * (512 / 64), I_2 = (512 / 64) * (1024 / 64);
    for (int it = it0 + gw; it < it1; it += NGW) {
        const int e = it / (2 * I_1 + I_2); int r = it % (2 * I_1 + I_2);
        bf16_t* W13 = (bf16_t*)(a.ws + WS_W13); bf16_t* W2 = (bf16_t*)(a.ws + WS_W2);
        if (r < I_1) { transpose_item<1>(a.in[I_EW1] + ((size_t)l * NE + e) * 1024 * 512, 1024, 512, W13, e * 1024, scr, r, F.lane); continue; } r -= I_1;
        if (r < I_1) { transpose_item<2>(a.in[I_EW3] + ((size_t)l * NE + e) * 1024 * 512, 1024, 512, W13, e * 1024, scr, r, F.lane); continue; } r -= I_1;
        transpose_item<0>(a.in[I_EW2] + ((size_t)l * NE + e) * 512 * 1024, 512, 1024, W2, e * 1024, scr, r, F.lane);
    }
}
constexpr int CONV_E_ITEMS = NE * 384, CONV_E_SPLIT = CONV_E_ITEMS / 2;

__device__ __forceinline__ int mod_row(int row) { return row < TL ? (row >> 11) : NB; }

__device__ __forceinline__ void rows_p0(const Fr& F, const Args& a, int l, int nrows) {
    const int gw = F.bid * NWAVES + F.wave, NGW = F.G * NWAVES;
    const float* g1 = a.in[I_N1G] + l * 1024;
    const float* MODl = (const float*)(a.ws + WS_MOD) + (size_t)l * NBM * DIN;
    const float* MODp = (const float*)(a.ws + WS_MOD) + (size_t)(l > 0 ? l - 1 : 0) * NBM * DIN;
    const bf16_t* Fs = (const bf16_t*)(a.ws + WS_F);
    unsigned char* H8 = a.ws + WS_H8;
    const int per = 2 * ((nrows + 2 * NGW - 1) / (2 * NGW)), w0 = gw * per, w1 = (w0 + per < nrows) ? w0 + per : nrows;
    f32x4 gv[4], shv[4], scv[4], m5v[4]; int cur = -1;
#pragma unroll
    for (int j = 0; j < 4; ++j) { gv[j] = *(const f32x4*)(g1 + F.lane * 4 + 256 * j); shv[j] = gv[j]; scv[j] = gv[j]; m5v[j] = gv[j]; }
#define P0_LOAD(rb, V, F0, F1) do { _Pragma("unroll") for (int q = 0; q < 2; ++q) { const int row = (rb) + q; const bool lat = row < TL; \
            const float* xs = lat ? ((l == 0) ? a.in[I_X] + (size_t)row * D : a.out + (size_t)row * D) : ((l == 0) ? a.in[I_CTX] + (size_t)(row - TL) * D : (const float*)(a.ws + WS_XC) + (size_t)(row - TL) * D); \
            _Pragma("unroll") for (int j = 0; j < 4; ++j) { const int col = F.lane * 4 + 256 * j; V[q][j] = *(const f32x4*)(xs + col); \
                if (l > 0) { F0[q][j] = *(const u32x2*)(Fs + (size_t)row * D + col); F1[q][j] = *(const u32x2*)(Fs + ((size_t)TT + row) * D + col); } } } } while (0)
#define P0_PROC(rb, V, F0, F1) do { _Pragma("unroll") for (int q = 0; q < 2; ++q) { const int row = (rb) + q; const bool lat = row < TL; const int mr = mod_row(row); \
            if (mr != cur) { cur = mr; _Pragma("unroll") for (int j = 0; j < 4; ++j) { const int col = F.lane * 4 + 256 * j; \
                shv[j] = *(const f32x4*)(MODl + (size_t)mr * DIN + col); scv[j] = *(const f32x4*)(MODl + (size_t)mr * DIN + 1024 + col); m5v[j] = *(const f32x4*)(MODp + (size_t)mr * DIN + 5 * 1024 + col); } } \
            float* xd = lat ? a.out + (size_t)row * D : (float*)(a.ws + WS_XC) + (size_t)(row - TL) * D; float ss = 0.f; \
            if (l > 0) { _Pragma("unroll") for (int j = 0; j < 4; ++j) { const int col = F.lane * 4 + 256 * j; \
                    V[q][j].x += m5v[j].x * (bflo(F0[q][j].x) + bflo(F1[q][j].x)); V[q][j].y += m5v[j].y * (bfhi(F0[q][j].x) + bfhi(F1[q][j].x)); \
                    V[q][j].z += m5v[j].z * (bflo(F0[q][j].y) + bflo(F1[q][j].y)); V[q][j].w += m5v[j].w * (bfhi(F0[q][j].y) + bfhi(F1[q][j].y)); \
                    *(f32x4*)(xd + col) = V[q][j]; } } \
            _Pragma("unroll") for (int j = 0; j < 4; ++j) ss += (V[q][j].x * V[q][j].x + V[q][j].y * V[q][j].y) + (V[q][j].z * V[q][j].z + V[q][j].w * V[q][j].w); \
            const float r = 1.f / sqrtf(wave_sum(ss) * (1.f / D) + EPS); \
            _Pragma("unroll") for (int j = 0; j < 4; ++j) { const int col = F.lane * 4 + 256 * j; \
                const f32x4 o = (V[q][j] * r * gv[j]) * (scv[j] + 1.f) + shv[j]; \
                *(unsigned*)(H8 + (size_t)row * D + col) = cvt4_fp8(o.x, o.y, o.z, o.w); } } } while (0)
    f32x4 vA[2][4], vB[2][4]; u32x2 fA0[2][4], fA1[2][4], fB0[2][4], fB1[2][4];
    if (w0 < w1) P0_LOAD(w0, vA, fA0, fA1);
    for (int rb = w0; rb < w1; rb += 4) {
        if (rb + 2 < w1) P0_LOAD(rb + 2, vB, fB0, fB1);
        P0_PROC(rb, vA, fA0, fA1);
        if (rb + 2 < w1) { if (rb + 4 < w1) P0_LOAD(rb + 4, vA, fA0, fA1); P0_PROC(rb + 2, vB, fB0, fB1); }
    }
#undef P0_LOAD
#undef P0_PROC
}
__device__ __forceinline__ void rows_final(const Fr& F, const Args& a) {
    const int gw = F.bid * NWAVES + F.wave, NGW = F.G * NWAVES;
    const float* MODp = (const float*)(a.ws + WS_MOD) + (size_t)(NL - 1) * NBM * DIN;
    const bf16_t* Fs = (const bf16_t*)(a.ws + WS_F);
    for (int row = gw; row < TL; row += NGW) {
        const int mr = row >> 11; float* xd = a.out + (size_t)row * D;
#pragma unroll
        for (int j = 0; j < 4; ++j) { const int col = F.lane * 4 + 256 * j;
            f32x4 v = *(const f32x4*)(xd + col);
            const u32x2 f0 = *(const u32x2*)(Fs + (size_t)row * D + col), f1 = *(const u32x2*)(Fs + ((size_t)TT + row) * D + col);
            const f32x4 m5 = *(const f32x4*)(MODp + (size_t)mr * DIN + 5 * 1024 + col);
            v.x += m5.x * (bflo(f0.x) + bflo(f1.x)); v.y += m5.y * (bfhi(f0.x) + bfhi(f1.x)); v.z += m5.z * (bflo(f0.y) + bflo(f1.y)); v.w += m5.w * (bfhi(f0.y) + bfhi(f1.y));
            *(f32x4*)(xd + col) = v; }
    }
}

__device__ __forceinline__ void rows_p5(const Fr& F, const Args& a, int l, int nrows, unsigned long long& sacc, const int swhich) {
#if defined(PROBE_P)
    unsigned long long st0 = __builtin_amdgcn_s_memrealtime();
#define SUBMARK5(w) do { const unsigned long long t_ = __builtin_amdgcn_s_memrealtime(); if (swhich == (w)) sacc += t_ - st0; st0 = t_; } while (0)
#else
#define SUBMARK5(w) do { } while (0)
#endif
    typedef float f32x4v __attribute__((ext_vector_type(4)));
    LAS float* RW = (LAS float*)F.lds;
    constexpr int RWS = 1028;
    LAS float* RB = (LAS float*)(F.lds + 82304);
    LAS int* LC = (LAS int*)(F.lds + 82432);
    LAS int* TE = (LAS int*)(F.lds + 82560);
    LAS int* TP = TE + 256;
    LAS float* TW = (LAS float*)(TP + 256);
    LAS float* RN = (LAS float*)(F.lds + 86784);
    LAS float* LG = (LAS float*)(F.lds + 87424);
    LAS float* GM = (LAS float*)(F.lds + 99072);
    LAS float* BI = (LAS float*)(F.lds + 107264);
    const float* g2 = a.in[I_N2G] + l * 1024;
    const float* MODl = (const float*)(a.ws + WS_MOD) + (size_t)l * NBM * DIN;
    bf16_t* H = (bf16_t*)(a.ws + WS_H);
    int* EROW = (int*)(a.ws + WS_EROW); float* EROWW = (float*)(a.ws + WS_EROWW);
    unsigned* CNT = (unsigned*)(a.ws + WS_CTL) + CW_CNT + l * 256;
    for (int f = F.tid; f < 1024; f += NTHR) { const f32x4 v = *(const f32x4*)(a.in[I_RGW] + ((size_t)l * 1024 + f) * 4);
        RW[0 * RWS + f] = v.x; RW[1 * RWS + f] = v.y; RW[2 * RWS + f] = v.z; RW[3 * RWS + f] = v.w; }
    for (int f = F.tid; f < 4096; f += NTHR) { const int k = f >> 2, c4 = (f & 3) * 4; const f32x4 v = *(const f32x4*)(a.in[I_REW] + ((size_t)l * 1024 + k) * 16 + c4);
        RW[(4 + c4) * RWS + k] = v.x; RW[(5 + c4) * RWS + k] = v.y; RW[(6 + c4) * RWS + k] = v.z; RW[(7 + c4) * RWS + k] = v.w; }
    if (F.tid < 20) RB[F.tid] = (F.tid < 4) ? a.in[I_RGB][l * 4 + F.tid] : a.in[I_REB][l * 16 + F.tid - 4];
    constexpr int P5_CH = 144;
    const int nch = (nrows + P5_CH - 1) / P5_CH;
    SUBMARK5(40);
    for (int ch = F.bid; ch < nch; ch += F.G) {
    const int r0 = ch * P5_CH, r1 = (r0 + P5_CH < nrows) ? r0 + P5_CH : nrows;
    const int mb0 = mod_row(r0), mb1 = mod_row(r1 - 1);
    if (F.tid < 32) LC[F.tid] = 0;
    for (int i = F.tid; i < 2048; i += NTHR) { const int s = i >> 10, k = i & 1023; GM[i] = g2[k] * (1.f + MODl[(size_t)(s ? mb1 : mb0) * DIN + 4 * 1024 + k]); }
    __syncthreads();
    if (F.wave < 4) {
    for (int rowb = r0 + 2 * F.wave; rowb < r1; rowb += 2 * 4) {
        f32x4 v[2][4]; bool val[2];
#pragma unroll
        for (int q = 0; q < 2; ++q) { const int row = rowb + q; val[q] = row < r1; const int rr = val[q] ? row : rowb;
            const bool lat = rr < TL; const float* xs = lat ? a.out + (size_t)rr * D : (const float*)(a.ws + WS_XC) + (size_t)(rr - TL) * D;
#pragma unroll
            for (int j = 0; j < 4; ++j) v[q][j] = *(const f32x4*)(xs + F.lane * 4 + 256 * j); }
#pragma unroll
        for (int q = 0; q < 2; ++q) { const int rr = val[q] ? rowb + q : rowb; const int mr = mod_row(rr); float ss = 0.f;
#pragma unroll
            for (int j = 0; j < 4; ++j) ss += (v[q][j].x * v[q][j].x + v[q][j].y * v[q][j].y) + (v[q][j].z * v[q][j].z + v[q][j].w * v[q][j].w);
            const float r = 1.f / sqrtf(wave_sum(ss) * (1.f / D) + EPS);
            if (F.lane == 0 && val[q]) RN[rr - r0] = r;
#pragma unroll
            for (int j = 0; j < 4; ++j) { const int col = F.lane * 4 + 256 * j;
                const f32x4 g = *(const f32x4*)(g2 + col), sh = *(const f32x4*)(MODl + (size_t)mr * DIN + 3 * 1024 + col), sc = *(const f32x4*)(MODl + (size_t)mr * DIN + 4 * 1024 + col);
                const f32x4 t = (v[q][j] * r * g) * (sc + 1.f) + sh;
                u32x2 w; w.x = cvtpk(t.x, t.y); w.y = cvtpk(t.z, t.w);
                if (val[q]) *(u32x2*)(H + (size_t)rr * D + col) = w; } }
    }
    } else {
    if (F.wave < 6) { const int sl = F.wave - 4; const int mb = sl ? mb1 : mb0; f32x4 sh[4];
#pragma unroll
        for (int j = 0; j < 4; ++j) sh[j] = *(const f32x4*)(MODl + (size_t)mb * DIN + 3 * 1024 + F.lane * 4 + 256 * j);
#pragma unroll 4
        for (int cidx = 0; cidx < 20; ++cidx) { float p = 0.f;
#pragma unroll
            for (int j = 0; j < 4; ++j) { const f32x4 w = *(const LAS f32x4*)(RW + cidx * RWS + F.lane * 4 + 256 * j);
                p = fmaf(sh[j].x, w.x, p); p = fmaf(sh[j].y, w.y, p); p = fmaf(sh[j].z, w.z, p); p = fmaf(sh[j].w, w.w, p); }
            const float tot = wave_sum(p) + RB[cidx]; if (F.lane == 0) BI[sl * 20 + cidx] = tot; } }
    { const int i16 = F.lane & 15, kq = F.lane >> 4; const int ngrp = (r1 - r0 + 15) >> 4;
      for (int gi = F.wave - 4; gi < ngrp; gi += 4) {
        const int grow = r0 + 16 * gi; const int rowi = (grow + i16 < r1) ? grow + i16 : r1 - 1;
        const bool lat = rowi < TL; const float* xs = (lat ? a.out + (size_t)rowi * D : (const float*)(a.ws + WS_XC) + (size_t)(rowi - TL) * D) + 4 * kq;
        const int slot = (mod_row(grow) == mb0) ? 0 : 1;
        const LAS float* gmp = GM + slot * 1024 + 4 * kq; const LAS float* w0p = RW + i16 * RWS + 4 * kq; const LAS float* w1p = RW + (16 + (i16 & 3)) * RWS + 4 * kq;
        const float m1 = (i16 < 4) ? 1.f : 0.f;
        f32x4v acc0 = {0.f, 0.f, 0.f, 0.f}, acc1 = {0.f, 0.f, 0.f, 0.f};
#pragma unroll 16
        for (int s = 0; s < 64; ++s) {
            const f32x4 xv = *(const f32x4*)(xs + 16 * s); const f32x4 gv = *(const LAS f32x4*)(gmp + 16 * s);
            const f32x4 wa = *(const LAS f32x4*)(w0p + 16 * s), wb = *(const LAS f32x4*)(w1p + 16 * s);
            const f32x4 ba = wa * gv, bb = wb * gv * m1;
            acc0 = __builtin_amdgcn_mfma_f32_16x16x4f32(xv.x, ba.x, acc0, 0, 0, 0); acc1 = __builtin_amdgcn_mfma_f32_16x16x4f32(xv.x, bb.x, acc1, 0, 0, 0);
            acc0 = __builtin_amdgcn_mfma_f32_16x16x4f32(xv.y, ba.y, acc0, 0, 0, 0); acc1 = __builtin_amdgcn_mfma_f32_16x16x4f32(xv.y, bb.y, acc1, 0, 0, 0);
            acc0 = __builtin_amdgcn_mfma_f32_16x16x4f32(xv.z, ba.z, acc0, 0, 0, 0); acc1 = __builtin_amdgcn_mfma_f32_16x16x4f32(xv.z, bb.z, acc1, 0, 0, 0);
            acc0 = __builtin_amdgcn_mfma_f32_16x16x4f32(xv.w, ba.w, acc0, 0, 0, 0); acc1 = __builtin_amdgcn_mfma_f32_16x16x4f32(xv.w, bb.w, acc1, 0, 0, 0);
        }
#pragma unroll
        for (int rg = 0; rg < 4; ++rg) { const int lr = 16 * gi + 4 * kq + rg;
            if (r0 + lr < r1) { LG[lr * 20 + i16] = acc0[rg]; if (i16 < 4) LG[lr * 20 + 16 + i16] = acc1[rg]; } }
      } }
    }
    __syncthreads();
    SUBMARK5(42);
    for (int lr = F.tid; lr < r1 - r0; lr += NTHR) {
        float lg[20]; { const float rn = RN[lr]; const int sl = (mod_row(r0 + lr) == mb0) ? 0 : 1;
#pragma unroll
          for (int i = 0; i < 20; ++i) lg[i] = rn * LG[lr * 20 + i] + BI[sl * 20 + i]; }
        int gs = 0; float gmx = lg[0];
#pragma unroll
        for (int i = 1; i < 4; ++i) if (lg[i] > gmx) { gmx = lg[i]; gs = i; }
        float gsum = 0.f;
#pragma unroll
        for (int i = 0; i < 4; ++i) gsum += __expf(lg[i] - gmx);
        const float pg = 1.f / gsum;
        float le[4];
#pragma unroll
        for (int i = 0; i < 4; ++i) le[i] = (gs == 0) ? lg[4 + i] : (gs == 1) ? lg[8 + i] : (gs == 2) ? lg[12 + i] : lg[16 + i];
        int i0 = 0; float v0 = le[0];
#pragma unroll
        for (int i = 1; i < 4; ++i) if (le[i] > v0) { v0 = le[i]; i0 = i; }
        int i1 = -1; float v1 = -3.4e38f;
#pragma unroll
        for (int i = 0; i < 4; ++i) if (i != i0 && le[i] > v1) { v1 = le[i]; i1 = i; }
        const float e1 = __expf(v1 - v0), den = 1.f / (1.f + e1);
        const int ex0 = gs * 4 + i0, ex1 = gs * 4 + i1;
        const int lp0 = __hip_atomic_fetch_add(&LC[ex0], 1, __ATOMIC_RELAXED, __HIP_MEMORY_SCOPE_WORKGROUP), lp1 = __hip_atomic_fetch_add(&LC[ex1], 1, __ATOMIC_RELAXED, __HIP_MEMORY_SCOPE_WORKGROUP);
        TE[lr] = ex0 | (ex1 << 8); TP[lr] = lp0 | (lp1 << 16); TW[2 * lr] = den * pg; TW[2 * lr + 1] = e1 * den * pg;
    }
    __syncthreads();
    if (F.tid < NE) LC[16 + F.tid] = (int)atomicAdd(&CNT[F.tid * 16], (unsigned)LC[F.tid]);
    __syncthreads();
    for (int lr = F.tid; lr < r1 - r0; lr += NTHR) {
        const int te = TE[lr], tp = TP[lr], ex0 = te & 255, ex1 = te >> 8, row = r0 + lr;
        const int gp0 = LC[16 + ex0] + (tp & 0xffff), gp1 = LC[16 + ex1] + (tp >> 16);
        EROW[(size_t)ex0 * TT + gp0] = row * 2; EROWW[(size_t)ex0 * TT + gp0] = TW[2 * lr];
        EROW[(size_t)ex1 * TT + gp1] = row * 2 + 1; EROWW[(size_t)ex1 * TT + gp1] = TW[2 * lr + 1];
    }
    __syncthreads();
    SUBMARK5(43);
    }
    __syncthreads();
#undef SUBMARK5
}

__device__ __forceinline__ void normrope8(float (&x)[8], const float* g64, bool rope, int pos, const float* ct, const float* st, float scale, int lane) {
    float ss = 0.f;
#pragma unroll
    for (int i = 0; i < 8; ++i) ss += x[i] * x[i];
    ss += DPP_F(ss, 0xB1); ss += DPP_F(ss, 0x4E); ss += DPP_F(ss, 0x141);
    const float r = 1.f / sqrtf(ss * (1.f / 64.f) + EPS);
    const int ch = lane & 7;
    const f32x4 g0 = *(const f32x4*)(g64 + 8 * ch), g1 = *(const f32x4*)(g64 + 8 * ch + 4);
    x[0] *= r * g0.x; x[1] *= r * g0.y; x[2] *= r * g0.z; x[3] *= r * g0.w; x[4] *= r * g1.x; x[5] *= r * g1.y; x[6] *= r * g1.z; x[7] *= r * g1.w;
    if (rope) {
        const int ax = ch >> 2, half = (ch >> 1) & 1, f0 = 8 * (ch & 1);
        const f32x4 c0 = *(const f32x4*)(ct + pos * 32 + ax * 16 + f0), c1 = *(const f32x4*)(ct + pos * 32 + ax * 16 + f0 + 4);
        const f32x4 s0 = *(const f32x4*)(st + pos * 32 + ax * 16 + f0), s1 = *(const f32x4*)(st + pos * 32 + ax * 16 + f0 + 4);
        const float cs[8] = {c0.x, c0.y, c0.z, c0.w, c1.x, c1.y, c1.z, c1.w}, sn[8] = {s0.x, s0.y, s0.z, s0.w, s1.x, s1.y, s1.z, s1.w};
#pragma unroll
        for (int i = 0; i < 8; ++i) { const float p = DPP_F(x[i], 0x4E);
            x[i] = half ? (x[i] * cs[i] + p * sn[i]) : (x[i] * cs[i] - p * sn[i]); }
    }
#pragma unroll
    for (int i = 0; i < 8; ++i) x[i] *= scale;
}
__device__ __forceinline__ void unpack8(const u32x4 w, float (&x)[8]) { x[0] = bflo(w.x); x[1] = bfhi(w.x); x[2] = bflo(w.y); x[3] = bfhi(w.y); x[4] = bflo(w.z); x[5] = bfhi(w.z); x[6] = bflo(w.w); x[7] = bfhi(w.w); }
__device__ __forceinline__ u32x4 pack8(const float (&x)[8]) { u32x4 w; w.x = cvtpk(x[0], x[1]); w.y = cvtpk(x[2], x[3]); w.z = cvtpk(x[4], x[5]); w.w = cvtpk(x[6], x[7]); return w; }

__device__ __forceinline__ void prep_phase(const Fr& F, const Args& a, int l, bool with_ctx) {
    constexpr int VROW = 272;
    LAS unsigned char* VA_l = F.lds;
    LAS unsigned char* VW_l = F.lds + 17408;
    LAS unsigned char* HT_l = F.lds + 34816;
    constexpr int HROW = 144;
    const float* ct = (const float*)(a.ws + WS_ROPE); const float* st = ct + SEQ * 32;
    const float* qkg = a.in[I_QKG] + l * 256;
    const bf16_t* RAWA = (const bf16_t*)(a.ws + WS_RAWA); const bf16_t* RAWW = (const bf16_t*)(a.ws + WS_RAWW);
    bf16_t* KA = (bf16_t*)(a.ws + WS_KA); bf16_t* KW = (bf16_t*)(a.ws + WS_KW); bf16_t* VTA = (bf16_t*)(a.ws + WS_VTA); bf16_t* VTW = (bf16_t*)(a.ws + WS_VTW);
    const bf16_t* U = (const bf16_t*)(a.ws + WS_U); bf16_t* X0 = (bf16_t*)(a.ws + WS_H); bf16_t* VT = (bf16_t*)(a.ws + WS_VT);
    const float* hsw = a.in[I_HSW] + l * 3 * 1536; const float* hsb = a.in[I_HSB] + l * 1536;
    for (int unit = F.bid; unit < NB * 36; unit += F.G) {
        const bool lat = unit < NB * 32;
        const int b = lat ? unit >> 5 : (unit - NB * 32) >> 2, p0 = lat ? (unit & 31) * 64 : ((unit - NB * 32) & 3) * 64;
        const int n = lat ? SEQ : CTX;
        const int row0 = lat ? b * SEQ + p0 : TL + b * CTX + p0;
        const int j0 = lat ? CTX + p0 : p0;
        __syncthreads();
        {
            const bool isw = (F.lane & 16) != 0; const int l16 = F.lane & 15, half = F.lane >> 5;
            u32x4 kw[4];
#pragma unroll
            for (int ps = 0; ps < 4; ++ps) { const int tk = 8 * F.wave + 2 * ps + half; kw[ps] = *(const u32x4*)((isw ? RAWW : RAWA) + (size_t)(row0 + tk) * 256 + l16 * 8); }
#pragma unroll
            for (int ps = 0; ps < 4; ++ps) { const int tk = 8 * F.wave + 2 * ps + half; float x[8]; unpack8(kw[ps], x);
                normrope8(x, qkg + (isw ? 192 : 64), lat, p0 + tk, ct, st, 1.f, F.lane);
                *(u32x4*)((isw ? KW : KA) + ((size_t)b * KEYS + j0 + tk) * 128 + l16 * 8) = pack8(x); }
        }
        for (int i = F.tid; i < 2 * 64 * 16; i += NTHR) { const int m = i >> 10, r = (i >> 4) & 63, cch = i & 15;
            const u32x4 w = *(const u32x4*)((m ? RAWW : RAWA) + (size_t)(row0 + r) * 256 + 128 + cch * 8);
            *(LAS u32x4*)((m ? VW_l : VA_l) + r * VROW + cch * 16) = w; }
        const bool do_hy = lat || with_ctx;
        if (do_hy) {
            const int cg = F.tid & 63, c = 8 * cg, t0 = 8 * F.wave;
            u32x4 x1p[8];
#pragma unroll
            for (int g = 0; g < 3; ++g) {
                const int ch = g * 512 + c;
                float w0[8], w1[8], w2[8], bb[8];
                { const f32x4 a0 = *(const f32x4*)(hsw + ch), a1 = *(const f32x4*)(hsw + ch + 4), b0 = *(const f32x4*)(hsw + 1536 + ch), b1 = *(const f32x4*)(hsw + 1536 + ch + 4),
                              c0 = *(const f32x4*)(hsw + 3072 + ch), c1 = *(const f32x4*)(hsw + 3072 + ch + 4), d0 = *(const f32x4*)(hsb + ch), d1 = *(const f32x4*)(hsb + ch + 4);
                  w0[0] = a0.x; w0[1] = a0.y; w0[2] = a0.z; w0[3] = a0.w; w0[4] = a1.x; w0[5] = a1.y; w0[6] = a1.z; w0[7] = a1.w;
                  w1[0] = b0.x; w1[1] = b0.y; w1[2] = b0.z; w1[3] = b0.w; w1[4] = b1.x; w1[5] = b1.y; w1[6] = b1.z; w1[7] = b1.w;
                  w2[0] = c0.x; w2[1] = c0.y; w2[2] = c0.z; w2[3] = c0.w; w2[4] = c1.x; w2[5] = c1.y; w2[6] = c1.z; w2[7] = c1.w;
                  bb[0] = d0.x; bb[1] = d0.y; bb[2] = d0.z; bb[3] = d0.w; bb[4] = d1.x; bb[5] = d1.y; bb[6] = d1.z; bb[7] = d1.w; }
                u32x4 raw[10];
#pragma unroll
                for (int i = 0; i < 10; ++i) { const int pos = p0 + t0 - 1 + i;
                    if (pos < 0 || pos >= n) { const unsigned z = zero_u32(); raw[i] = (u32x4){z, z, z, z}; } else raw[i] = *(const u32x4*)(U + (size_t)(row0 - p0 + pos) * 1536 + ch); }
#pragma unroll
                for (int t = 0; t < 8; ++t) { float up[8], uc[8], un[8], o[8]; unpack8(raw[t], up); unpack8(raw[t + 1], uc); unpack8(raw[t + 2], un);
#pragma unroll
                    for (int i = 0; i < 8; ++i) o[i] = fmaf(w0[i], up[i], fmaf(w1[i], uc[i], fmaf(w2[i], un[i], bb[i])));
                    if (g == 0) *(u32x4*)(X0 + (size_t)(row0 + t0 + t) * 512 + c) = pack8(o);
                    else if (g == 1) x1p[t] = pack8(o);
                    else { float x1[8]; unpack8(x1p[t], x1);
#pragma unroll
                        for (int i = 0; i < 8; ++i) o[i] *= x1[i];
                        x1p[t] = pack8(o); } }
            }
#pragma unroll
            for (int i = 0; i < 8; ++i) { unsigned short ev[8];
#pragma unroll
                for (int t = 0; t < 8; ++t) { const unsigned wsel = (i >> 1) == 0 ? x1p[t].x : (i >> 1) == 1 ? x1p[t].y : (i >> 1) == 2 ? x1p[t].z : x1p[t].w; ev[t] = (unsigned short)((i & 1) ? (wsel >> 16) : (wsel & 0xffffu)); }
                u32x4 w; w.x = ev[0] | ((unsigned)ev[1] << 16); w.y = ev[2] | ((unsigned)ev[3] << 16); w.z = ev[4] | ((unsigned)ev[5] << 16); w.w = ev[6] | ((unsigned)ev[7] << 16);
                *(LAS u32x4*)(HT_l + (c + i) * HROW + t0 * 2) = w; }
        }
        __syncthreads();
        for (int i = F.tid; i < 2 * 128 * 8; i += NTHR) { const int m = i >> 10, rr = (i >> 3) & 127, c8 = i & 7;
            LAS unsigned char* T = m ? VW_l : VA_l; unsigned short e[8];
#pragma unroll
            for (int jj = 0; jj < 8; ++jj) { const int key = 16 * (c8 >> 1) + 8 * (jj >> 2) + 4 * (c8 & 1) + (jj & 3); e[jj] = *(const LAS bf16_t*)(T + key * VROW + rr * 2); }
            u32x4 w; w.x = e[0] | ((unsigned)e[1] << 16); w.y = e[2] | ((unsigned)e[3] << 16); w.z = e[4] | ((unsigned)e[5] << 16); w.w = e[6] | ((unsigned)e[7] << 16);
            *(u32x4*)((m ? VTW : VTA) + ((size_t)(b * 2 + (rr >> 6)) * 64 + (rr & 63)) * KEYS + j0 + c8 * 8) = w; }
        if (do_hy) { bf16_t* VTb = lat ? VT : VT + VT_CTX_OFF;
          for (int i = F.tid; i < 512 * 8; i += NTHR) { const int cch = i >> 3, c8 = i & 7;
              const u32x4 w = *(const LAS u32x4*)(HT_l + cch * HROW + c8 * 16);
              *(u32x4*)(VTb + ((size_t)cch * NB + b) * n + p0 + c8 * 8) = w; } }
    }
    __syncthreads();
}

__device__ __forceinline__ void hyena_final_phase(const Fr& F, const Args& a, int l, bool with_ctx) {
    constexpr int HROW = 144;
    LAS unsigned char* T = F.lds;
    const bf16_t* X0 = (const bf16_t*)(a.ws + WS_H); const bf16_t* VT = (const bf16_t*)(a.ws + WS_VT); const bf16_t* YT = (const bf16_t*)(a.ws + WS_YT);
    bf16_t* YH = (bf16_t*)(a.ws + WS_QA) + 512;
    const float* FN = (const float*)(a.ws + WS_FNORM) + l * 1024; const float* skip = a.in[I_HBIAS] + l * 512;
    const int nunits = with_ctx ? NB * 36 : NB * 32;
    for (int unit = F.bid; unit < nunits; unit += F.G) {
        const bool lat = unit < NB * 32;
        const int b = lat ? unit >> 5 : (unit - NB * 32) >> 2, p0 = lat ? (unit & 31) * 64 : ((unit - NB * 32) & 3) * 64;
        const int n = lat ? SEQ : CTX; const int row0 = lat ? b * SEQ + p0 : TL + b * CTX + p0;
        const bf16_t* Yb = lat ? YT : YT + VT_CTX_OFF; const bf16_t* Vb = lat ? VT : VT + VT_CTX_OFF; const float* inv = FN + (lat ? 0 : 512);
        __syncthreads();
        for (int i = F.tid; i < 512 * 8; i += NTHR) { const int cch = i >> 3, c8 = i & 7; const size_t off = ((size_t)cch * NB + b) * n + p0 + c8 * 8;
            const u32x4 y = *(const u32x4*)(Yb + off), v = *(const u32x4*)(Vb + off); const float s = inv[cch], k = skip[cch];
            u32x4 o;
            o.x = cvtpk(bflo(y.x) * s + k * bflo(v.x), bfhi(y.x) * s + k * bfhi(v.x)); o.y = cvtpk(bflo(y.y) * s + k * bflo(v.y), bfhi(y.y) * s + k * bfhi(v.y));
            o.z = cvtpk(bflo(y.z) * s + k * bflo(v.z), bfhi(y.z) * s + k * bfhi(v.z)); o.w = cvtpk(bflo(y.w) * s + k * bflo(v.w), bfhi(y.w) * s + k * bfhi(v.w));
            *(LAS u32x4*)(T + cch * HROW + c8 * 16) = o; }
        __syncthreads();
        { const int th = F.tid & 255, half = F.tid >> 8, c = 2 * th;
          for (int t = 32 * half; t < 32 * half + 32; ++t) {
              const unsigned x0 = *(const unsigned*)(X0 + (size_t)(row0 + t) * 512 + c);
              const float y0 = bf1(*(const LAS bf16_t*)(T + c * HROW + t * 2)), y1 = bf1(*(const LAS bf16_t*)(T + (c + 1) * HROW + t * 2));
              *(unsigned*)(YH + (size_t)(row0 + t) * 1536 + c) = cvtpk(bflo(x0) * y0, bfhi(x0) * y1); } }
    }
    __syncthreads();
}

#define MFMA32(a, b, c) __builtin_amdgcn_mfma_f32_32x32x16_bf16((a), (b), (c), 0, 0, 0)
#define MFMA16(a, b, c) __builtin_amdgcn_mfma_f32_16x16x32_bf16((a), (b), (c), 0, 0, 0)

__device__ __forceinline__ int tile_off(int row, int chunk) { return row * 128 + ((chunk ^ ((row >> 1) & 7)) << 4); }

template <bool WIN>
__device__ __forceinline__ void attn_unit(const Fr& F, bf16_t* Qw, const bf16_t* Kb, const bf16_t* VTb, int a0, int na, int b0, int nb, int qpos0, bool has_sink, float sink2, const float* g64, bool rope, const float* ct, const float* st) {
    LAS unsigned char* L = F.lds;
    const int r = F.lane & 31, h = F.lane >> 5;
    const int xaddr = (lane_id() ^ 32) << 2;
#define SWAP32(v) __builtin_bit_cast(float, __builtin_amdgcn_ds_bpermute(xaddr, __builtin_bit_cast(int, (v))))
    bf16x8 q[4];
    {
        float x[4][8]; float ss = 0.f;
#pragma unroll
        for (int kk = 0; kk < 4; ++kk) { const u32x4 w = *(const u32x4*)(Qw + (size_t)r * 1536 + 16 * kk + 8 * h); unpack8(w, x[kk]);
#pragma unroll
            for (int j = 0; j < 8; ++j) ss += x[kk][j] * x[kk][j]; }
        ss += SWAP32(ss);
        const float rn = (1.f / sqrtf(ss * (1.f / 64.f) + EPS)) * QSCALE;
#pragma unroll
        for (int kk = 0; kk < 4; ++kk) { const f32x4 g0 = *(const f32x4*)(g64 + 16 * kk + 8 * h), g1 = *(const f32x4*)(g64 + 16 * kk + 8 * h + 4);
            x[kk][0] *= rn * g0.x; x[kk][1] *= rn * g0.y; x[kk][2] *= rn * g0.z; x[kk][3] *= rn * g0.w; x[kk][4] *= rn * g1.x; x[kk][5] *= rn * g1.y; x[kk][6] *= rn * g1.z; x[kk][7] *= rn * g1.w; }
        if (rope) { const int pos = qpos0 + r;
#pragma unroll
            for (int ax = 0; ax < 2; ++ax) {
                const f32x4 c0 = *(const f32x4*)(ct + pos * 32 + ax * 16 + 8 * h), c1 = *(const f32x4*)(ct + pos * 32 + ax * 16 + 8 * h + 4);
                const f32x4 s0 = *(const f32x4*)(st + pos * 32 + ax * 16 + 8 * h), s1 = *(const f32x4*)(st + pos * 32 + ax * 16 + 8 * h + 4);
                const float cs[8] = {c0.x, c0.y, c0.z, c0.w, c1.x, c1.y, c1.z, c1.w}, sn[8] = {s0.x, s0.y, s0.z, s0.w, s1.x, s1.y, s1.z, s1.w};
#pragma unroll
                for (int j = 0; j < 8; ++j) { const float av = x[2 * ax][j], bv = x[2 * ax + 1][j]; x[2 * ax][j] = av * cs[j] - bv * sn[j]; x[2 * ax + 1][j] = bv * cs[j] + av * sn[j]; } } }
#pragma unroll
        for (int kk = 0; kk < 4; ++kk) q[kk] = __builtin_bit_cast(bf16x8, pack8(x[kk]));
    }
    f32x16 o0, o1;
#pragma unroll
    for (int i = 0; i < 16; ++i) { o0[i] = 0.f; o1[i] = 0.f; }
    float lsum = 0.f;
    const int ntile = na + nb;
    const int srow = F.tid >> 3, sch = F.tid & 7;
    const int soff = tile_off(srow, sch);
    int t4[4];
#pragma unroll
    for (int j = 0; j < 4; ++j) t4[j] = tile_off(r, 2 * j + h);
#define AT_KT(i) ((i) < na ? a0 + (i) : b0 + ((i) - na))
#define AT_LD(i, K0, K1, V0, V1) do { const int kt_ = AT_KT(i); \
        K0 = *(const u32x4*)(Kb + (size_t)(kt_ * 128 + srow) * 128 + sch * 8); K1 = *(const u32x4*)(Kb + (size_t)(kt_ * 128 + 64 + srow) * 128 + sch * 8); \
        V0 = *(const u32x4*)(VTb + (size_t)srow * KEYS + kt_ * 128 + sch * 8); V1 = *(const u32x4*)(VTb + (size_t)srow * KEYS + kt_ * 128 + 64 + sch * 8); } while (0)
#define AT_ST(buf, K0, K1, V0, V1) do { LAS unsigned char* B_ = L + (buf) * 32768 + soff; \
        *(LAS u32x4*)(B_) = K0; *(LAS u32x4*)(B_ + 8192) = K1; *(LAS u32x4*)(B_ + 16384) = V0; *(LAS u32x4*)(B_ + 24576) = V1; } while (0)
#define AT_QK(S0, S1, Kt) do { bf16x8 kf_[8]; \
        _Pragma("unroll") for (int kk = 0; kk < 4; ++kk) { kf_[2 * kk] = *(const LAS bf16x8*)(L + (Kt) + t4[kk]); kf_[2 * kk + 1] = *(const LAS bf16x8*)(L + (Kt) + t4[kk] + 4096); } \
        _Pragma("unroll") for (int i_ = 0; i_ < 16; ++i_) { S0[i_] = 0.f; S1[i_] = 0.f; } \
        _Pragma("unroll") for (int kk = 0; kk < 4; ++kk) { S0 = MFMA32(kf_[2 * kk], q[kk], S0); S1 = MFMA32(kf_[2 * kk + 1], q[kk], S1); } } while (0)
#define AT_EXP(S0, S1, P, kpos0) do { \
        if (WIN && (kpos0) >= 0) { const int kbase = (kpos0) + 4 * h, qp = qpos0 + r; \
            _Pragma("unroll") for (int i = 0; i < 16; ++i) { const int kr = (i & 3) + 8 * (i >> 2); const int d0 = kbase + kr - qp, d1 = d0 + 32; \
                if (d0 > 128 || d0 < -128) S0[i] = -1e30f; if (d1 > 128 || d1 < -128) S1[i] = -1e30f; } } \
        _Pragma("unroll") for (int i = 0; i < 16; ++i) { S0[i] = fast_exp2(S0[i]); S1[i] = fast_exp2(S1[i]); lsum += S0[i] + S1[i]; } \
        { u32x4 w; \
          w.x = cvtpk(S0[0], S0[1]); w.y = cvtpk(S0[2], S0[3]); w.z = cvtpk(S0[4], S0[5]); w.w = cvtpk(S0[6], S0[7]); P[0] = __builtin_bit_cast(bf16x8, w); \
          w.x = cvtpk(S0[8], S0[9]); w.y = cvtpk(S0[10], S0[11]); w.z = cvtpk(S0[12], S0[13]); w.w = cvtpk(S0[14], S0[15]); P[1] = __builtin_bit_cast(bf16x8, w); \
          w.x = cvtpk(S1[0], S1[1]); w.y = cvtpk(S1[2], S1[3]); w.z = cvtpk(S1[4], S1[5]); w.w = cvtpk(S1[6], S1[7]); P[2] = __builtin_bit_cast(bf16x8, w); \
          w.x = cvtpk(S1[8], S1[9]); w.y = cvtpk(S1[10], S1[11]); w.z = cvtpk(S1[12], S1[13]); w.w = cvtpk(S1[14], S1[15]); P[3] = __builtin_bit_cast(bf16x8, w); } } while (0)
#define AT_PV(P, Vt) do { bf16x8 vf_[8]; \
        _Pragma("unroll") for (int c = 0; c < 4; ++c) { vf_[2 * c] = *(const LAS bf16x8*)(L + (Vt) + t4[c]); vf_[2 * c + 1] = *(const LAS bf16x8*)(L + (Vt) + t4[c] + 4096); } \
        _Pragma("unroll") for (int c = 0; c < 4; ++c) { o0 = MFMA32(vf_[2 * c], P[c], o0); o1 = MFMA32(vf_[2 * c + 1], P[c], o1); } } while (0)
#define AT_BODY(it) do { \
        const int kt = AT_KT(it); \
        if ((it) + 1 < ntile) AT_LD((it) + 1, kA0, kA1, vA0, vA1); \
        const int Bc = ((it) & 1) * 32768;                                \
        const int kp = (WIN && kt >= 2) ? (kt - 2) * 128 : -1;            \
        { f32x16 sa0, sa1; bf16x8 pa[4]; \
          AT_QK(sa0, sa1, Bc); AT_EXP(sa0, sa1, pa, kp); AT_PV(pa, Bc + 16384); } \
        __builtin_amdgcn_sched_barrier(0); \
        { f32x16 sb0, sb1; bf16x8 pb_[4]; \
          AT_QK(sb0, sb1, Bc + 8192); AT_EXP(sb0, sb1, pb_, (kp < 0 ? -1 : kp + 64)); AT_PV(pb_, Bc + 24576); } \
        if ((it) + 1 < ntile) AT_ST(((it) + 1) & 1, kA0, kA1, vA0, vA1); \
        __syncthreads(); } while (0)
    u32x4 kA0, kA1, vA0, vA1;
    AT_LD(0, kA0, kA1, vA0, vA1);
    __syncthreads();
    AT_ST(0, kA0, kA1, vA0, vA1);
    __syncthreads();
    for (int it = 0; it < ntile; it += 2) {
        AT_BODY(it);
        if (it + 1 < ntile) AT_BODY(it + 1);
    }
#undef AT_BODY
#undef AT_QK
#undef AT_EXP
#undef AT_PV
#undef AT_ST
#undef AT_LD
#undef AT_KT
    float lt = lsum + SWAP32(lsum);
    if (has_sink) lt += fast_exp2(sink2);
    const float inv = 1.f / lt;
#pragma unroll
    for (int g = 0; g < 4; ++g) {
        u32x2 w0, w1;
        w0.x = cvtpk(o0[4 * g] * inv, o0[4 * g + 1] * inv); w0.y = cvtpk(o0[4 * g + 2] * inv, o0[4 * g + 3] * inv);
        w1.x = cvtpk(o1[4 * g] * inv, o1[4 * g + 1] * inv); w1.y = cvtpk(o1[4 * g + 2] * inv, o1[4 * g + 3] * inv);
        *(u32x2*)(Qw + (size_t)r * 1536 + 8 * g + 4 * h) = w0;
        *(u32x2*)(Qw + (size_t)r * 1536 + 32 + 8 * g + 4 * h) = w1; }
#undef SWAP32
}

__device__ __forceinline__ void hyena_unit_lat(const Fr& F, const bf16_t* Fg, const bf16_t* Vg, bf16_t* Yg) {
    constexpr int FREP = 8192 + 64, VPIT = 4096 + 16, VOFF = 8 * FREP;
    LAS unsigned char* L = F.lds;
    __syncthreads();
    { const int x = F.tid;
      const u32x4 lo = *(const u32x4*)(Fg + x * 8); u32x4 hi; if (x < 511) hi = *(const u32x4*)(Fg + x * 8 + 8); else { const unsigned z = zero_u32(); hi = (u32x4){z, z, z, z}; }
      const unsigned wv[8] = {lo.x, lo.y, lo.z, lo.w, hi.x, hi.y, hi.z, hi.w};
      *(LAS u32x4*)(L + x * 16) = lo;
#pragma unroll
      for (int rho = 1; rho < 8; ++rho) { u32x4 o;
          unsigned od[4];
#pragma unroll
          for (int d = 0; d < 4; ++d) { const int ob = 4 * d + 2 * rho, i = ob >> 2, s = ob & 3; od[d] = __builtin_amdgcn_alignbyte(wv[i + 1 < 8 ? i + 1 : 7], wv[i], s); }
          o.x = od[0]; o.y = od[1]; o.z = od[2]; o.w = od[3];
          *(LAS u32x4*)(L + rho * FREP + x * 16) = o; } }
    for (int i = F.tid; i < 16 * 256; i += NTHR) { const int b = i >> 8, x = i & 255; *(LAS u32x4*)(L + VOFF + b * VPIT + x * 16) = *(const u32x4*)(Vg + (size_t)b * SEQ + x * 8); }
    __syncthreads();
    const int i16 = F.lane & 15, q4 = F.lane >> 4, w = F.wave;
    const int base0 = 2047 - 256 * w - i16 + 8 * q4;
    const int rho = base0 & 7;
    LAS unsigned char* Ap = L + rho * FREP + (base0 - rho) * 2;
    LAS unsigned char* Bp = L + VOFF + i16 * VPIT + q4 * 16;
    bf16x8 A[16]; f32x4 acc[16];
#pragma unroll
    for (int rr = 0; rr < 16; ++rr) { A[rr] = *(const LAS bf16x8*)(Ap - 32 * rr); acc[rr] = (f32x4){0.f, 0.f, 0.f, 0.f}; }
    bf16x8 Bn = *(const LAS bf16x8*)(Bp);
    for (int o = 0; o < 8; ++o) {
#pragma unroll
        for (int u = 0; u < 8; ++u) {
            const int st = o * 8 + u;
            const bf16x8 Bf = Bn;
            if (st < 63) Bn = *(const LAS bf16x8*)(Bp + 64 * st + 64);
#pragma unroll
            for (int rr = 0; rr < 16; ++rr) acc[rr] = MFMA16(A[(rr - 2 * u) & 15], Bf, acc[rr]);
            if (st < 63) { A[(-2 * u - 2) & 15] = *(const LAS bf16x8*)(Ap + 64 * st + 64); A[(-2 * u - 1) & 15] = *(const LAS bf16x8*)(Ap + 64 * st + 32); }
        }
    }
#pragma unroll
    for (int rr = 0; rr < 16; ++rr) { u32x2 wv; wv.x = cvtpk(acc[rr].x, acc[rr].y); wv.y = cvtpk(acc[rr].z, acc[rr].w);
        *(u32x2*)(Yg + (size_t)i16 * SEQ + 256 * w + 16 * rr + 4 * q4) = wv; }
}
__device__ __forceinline__ void hyena_unit_ctx(const Fr& F, const bf16_t* Fg, const bf16_t* Vg, bf16_t* Yg) {
    constexpr int FREP = 1024 + 64, VPIT = 512 + 16, VOFF = 8 * FREP;
    LAS unsigned char* L = F.lds;
    __syncthreads();
    if (F.tid < 64) *(LAS u32x4*)(L + F.tid * 16) = *(const u32x4*)(Fg + F.tid * 8);
    if (F.tid >= 64 && F.tid < 68) { const unsigned z = zero_u32(); *(LAS u32x4*)(L + 1024 + (F.tid - 64) * 16) = (u32x4){z, z, z, z}; }
    { const int b = F.tid >> 5, x = F.tid & 31; *(LAS u32x4*)(L + VOFF + b * VPIT + x * 16) = *(const u32x4*)(Vg + (size_t)b * CTX + x * 8); }
    __syncthreads();
    for (int i = F.tid; i < 7 * 256; i += NTHR) { const int rho = 1 + i / 256, x2 = (i % 256) * 2; const int s0 = x2 + rho, s1 = x2 + 1 + rho;
        const unsigned e0 = s0 < 512 ? *(const LAS bf16_t*)(L + s0 * 2) : 0, e1 = s1 < 512 ? *(const LAS bf16_t*)(L + s1 * 2) : 0;
        *(LAS unsigned*)(L + rho * FREP + x2 * 2) = e0 | (e1 << 16); }
    __syncthreads();
    const int i16 = F.lane & 15, q4 = F.lane >> 4, w = F.wave;
    const int base0 = 255 - 32 * w - i16 + 8 * q4, rho = base0 & 7;
    LAS unsigned char* Ap = L + rho * FREP + (base0 - rho) * 2;
    LAS unsigned char* Bp = L + VOFF + i16 * VPIT + q4 * 16;
    f32x4 acc0 = (f32x4){0.f, 0.f, 0.f, 0.f}, acc1 = acc0;
#pragma unroll
    for (int st = 0; st < 8; ++st) { const bf16x8 Bf = *(const LAS bf16x8*)(Bp + 64 * st);
        const bf16x8 A0 = *(const LAS bf16x8*)(Ap + 64 * st), A1 = *(const LAS bf16x8*)(Ap + 64 * st - 32);
        acc0 = MFMA16(A0, Bf, acc0); acc1 = MFMA16(A1, Bf, acc1); }
    u32x2 wv; wv.x = cvtpk(acc0.x, acc0.y); wv.y = cvtpk(acc0.z, acc0.w); *(u32x2*)(Yg + (size_t)i16 * CTX + 32 * w + 4 * q4) = wv;
    wv.x = cvtpk(acc1.x, acc1.y); wv.y = cvtpk(acc1.z, acc1.w); *(u32x2*)(Yg + (size_t)i16 * CTX + 32 * w + 16 + 4 * q4) = wv;
}

__device__ __forceinline__ void mixer_phase(const Fr& F, const Args& a, int l, bool with_ctx, unsigned long long& sacc, const int swhich) {
#if defined(PROBE_P)
    unsigned long long st0 = __builtin_amdgcn_s_memrealtime();
#define SUBMARK(w) do { const unsigned long long t_ = __builtin_amdgcn_s_memrealtime(); if (swhich == (w)) sacc += t_ - st0; st0 = t_; } while (0)
#else
#define SUBMARK(w) do { } while (0)
#endif
    bf16_t* QA = (bf16_t*)(a.ws + WS_QA); bf16_t* QW = QA + 1024;
    const bf16_t* KA = (const bf16_t*)(a.ws + WS_KA); const bf16_t* KW = (const bf16_t*)(a.ws + WS_KW);
    const bf16_t* VTA = (const bf16_t*)(a.ws + WS_VTA); const bf16_t* VTW = (const bf16_t*)(a.ws + WS_VTW);
    const float* sinks = a.in[I_SINK] + l * 8; const float* qkg = a.in[I_QKG] + l * 256;
    const float* ct = (const float*)(a.ws + WS_ROPE); const float* st = ct + SEQ * 32;
    const int wq = F.wave >> 1, wh = F.wave & 1;
    const int ubid = (F.G % 8 == 0) ? (F.bid & 7) * (F.G >> 3) + (F.bid >> 3) : F.bid;
#define RELANE(FX) do { int t_ = F.wave * 64 + lane_id(); asm volatile("" : "+v"(t_)); FX.tid = t_; FX.lane = t_ & 63; } while (0)
    Fr FA = F; RELANE(FA);
    for (int unit = ubid; unit < NB * 2 * 32; unit += F.G) {
        const int b = unit >> 6, kvh = (unit >> 5) & 1, pb = unit & 31;
        bf16_t* Qw = QA + (size_t)(b * SEQ + pb * 64 + wh * 32) * 1536 + (kvh * 4 + wq) * 64;
        attn_unit<false>(FA, Qw, KA + (size_t)b * KEYS * 128 + kvh * 64, VTA + (size_t)(b * 2 + kvh) * 64 * KEYS, 0, KEYS / 128, 0, 0, pb * 64 + wh * 32, false, 0.f, qkg, true, ct, st);
    }
    SUBMARK(30);
    Fr FW = F; RELANE(FW);
    for (int unit = ubid; unit < NB * 2 * 32; unit += F.G) {
        const int b = unit >> 6, kvh = (unit >> 5) & 1, pb = unit & 31;
        bf16_t* Qw = QW + (size_t)(b * SEQ + pb * 64 + wh * 32) * 1536 + (kvh * 4 + wq) * 64;
        const int lo = pb < 2 ? 0 : (pb - 2) >> 1, hi = ((64 * pb + 191) >> 7) > 15 ? 15 : ((64 * pb + 191) >> 7);
        attn_unit<true>(FW, Qw, KW + (size_t)b * KEYS * 128 + kvh * 64, VTW + (size_t)(b * 2 + kvh) * 64 * KEYS, 0, 2, 2 + lo, hi - lo + 1, pb * 64 + wh * 32, true, sinks[kvh * 4 + wq] * LOG2E, qkg + 128, true, ct, st);
    }
    SUBMARK(31);
    Fr FC2 = F; RELANE(FC2);
    if (with_ctx) {
        for (int unit = ubid; unit < 2 * NB * 2 * 4; unit += F.G) {
            const int isw = unit >> 7, u2 = unit & 127, b = u2 >> 3, kvh = (u2 >> 2) & 1, pb = u2 & 3;
            bf16_t* Qw = (isw ? QW : QA) + (size_t)(TL + b * CTX + pb * 64 + wh * 32) * 1536 + (kvh * 4 + wq) * 64;
            attn_unit<false>(FC2, Qw, (isw ? KW : KA) + (size_t)b * KEYS * 128 + kvh * 64, (isw ? VTW : VTA) + (size_t)(b * 2 + kvh) * 64 * KEYS, 0, 2, 0, 0, 0, isw != 0, isw ? sinks[kvh * 4 + wq] * LOG2E : 0.f, qkg + (isw ? 128 : 0), false, ct, st);
        }
    }
    SUBMARK(32);
    const bf16_t* FL = (const bf16_t*)(a.ws + WS_FL) + (size_t)l * 512 * 4096; const bf16_t* FC = (const bf16_t*)(a.ws + WS_FC) + (size_t)l * 512 * 512;
    const bf16_t* VT = (const bf16_t*)(a.ws + WS_VT); bf16_t* YT = (bf16_t*)(a.ws + WS_YT);
    Fr FH = F; RELANE(FH);
    for (int c = F.bid; c < HYW; c += F.G) hyena_unit_lat(FH, FL + (size_t)c * 4096, VT + (size_t)c * NB * SEQ, YT + (size_t)c * NB * SEQ);
    if (with_ctx) for (int c = F.bid; c < HYW; c += F.G) hyena_unit_ctx(FH, FC + (size_t)c * 512, VT + VT_CTX_OFF + (size_t)c * NB * CTX, YT + VT_CTX_OFF + (size_t)c * NB * CTX);
    __syncthreads();
    SUBMARK(33);
#undef SUBMARK
#undef RELANE
}

__device__ __forceinline__ float gate_q(float x) { return fminf(256.f * sigmoid_f(x), 255.49f); }
__device__ __forceinline__ unsigned pack_u8x4(float a, float b, float c, float d) { return (unsigned)(int)a | ((unsigned)(int)b << 8) | ((unsigned)(int)c << 16) | ((unsigned)(int)d << 24); }
__device__ __forceinline__ float gq(unsigned w, int k) { return (float)((w >> (8 * k)) & 0xffu) + 0.5f; }
struct EpiInProj {
    static constexpr bool PERM = true, AFTER_DRAIN = false; static constexpr int NSEG = 1;
    unsigned char* ws; int pn_off;
    __device__ __forceinline__ void operator()(const pg8::f32x4 (&acc)[2][2][4][2], const pg8::Unit& u, int wr, int wc, int fr, int fq) const {
        asm volatile("" : "+v"(fr), "+v"(fq));
        const int pn = __builtin_amdgcn_readfirstlane(u.pn) + pn_off; unsigned long long boff; int ldc, colt; bool sig = false;
        if (pn < 2) { boff = WS_QA; ldc = 1536; colt = pn * 256; }
        else if (pn == 2) { boff = WS_RAWA; ldc = 256; colt = 0; }
        else if (pn < 9) { boff = WS_U; ldc = 1536; colt = (pn - 3) * 256; }
        else if (pn < 11) { boff = WS_QA; ldc = 1536; colt = 1024 + (pn - 9) * 256; }
        else if (pn == 11) { boff = WS_RAWW; ldc = 256; colt = 0; }
        else { boff = WS_G; ldc = 3072; colt = (pn - 12) * 256; sig = true; }
        bf16_t* base = (bf16_t*)(ws + boff); unsigned char* Gt = ws + boff;
        const int row0 = u.pm * 256 + wr * 64 + fr, col0 = colt + wc * 32 + 8 * fq;
        if (sig) {
            unsigned char* gb = (unsigned char*)Gt;
#pragma unroll
            for (int ai = 0; ai < 2; ++ai)
#pragma unroll
                for (int m = 0; m < 4; ++m) { unsigned char* rowp = gb + (size_t)(row0 + ai * 128 + m * 16) * 3072 + col0;
#pragma unroll
                    for (int bj = 0; bj < 2; ++bj) { const pg8::f32x4 v0 = acc[ai][bj][m][0], v1 = acc[ai][bj][m][1];
                        u32x2 w; w.x = pack_u8x4(gate_q(v0.x), gate_q(v0.y), gate_q(v0.z), gate_q(v0.w)); w.y = pack_u8x4(gate_q(v1.x), gate_q(v1.y), gate_q(v1.z), gate_q(v1.w));
                        *(u32x2*)(rowp + bj * 128) = w; } }
            return;
        }
#pragma unroll
        for (int ai = 0; ai < 2; ++ai)
#pragma unroll
            for (int m = 0; m < 4; ++m) { bf16_t* rowp = base + (size_t)(row0 + ai * 128 + m * 16) * ldc + col0;
#pragma unroll
                for (int bj = 0; bj < 2; ++bj) { const pg8::f32x4 v0 = acc[ai][bj][m][0], v1 = acc[ai][bj][m][1];
                    u32x4 w; w.x = cvtpk(v0.x, v0.y); w.y = cvtpk(v0.z, v0.w); w.z = cvtpk(v1.x, v1.y); w.w = cvtpk(v1.z, v1.w);
                    *(u32x4*)(rowp + bj * 128) = w; } }
    }
};
struct EpiGate {
    static constexpr bool PERM = true, AFTER_DRAIN = false; static constexpr int NSEG = 1;
    unsigned char* Gt;
    __device__ __forceinline__ void operator()(const pg8::f32x4 (&acc)[2][2][4][2], const pg8::Unit& u, int wr, int wc, int fr, int fq) const {
        asm volatile("" : "+v"(fr), "+v"(fq));
        const int row0 = u.pm * 256 + wr * 64 + fr, col0 = u.pn * 256 + wc * 32 + 8 * fq;
#pragma unroll
        for (int ai = 0; ai < 2; ++ai)
#pragma unroll
            for (int m = 0; m < 4; ++m) { unsigned char* rowp = Gt + (size_t)(row0 + ai * 128 + m * 16) * 3072 + col0;
#pragma unroll
                for (int bj = 0; bj < 2; ++bj) { const pg8::f32x4 v0 = acc[ai][bj][m][0], v1 = acc[ai][bj][m][1];
                    u32x2 w; w.x = pack_u8x4(gate_q(v0.x), gate_q(v0.y), gate_q(v0.z), gate_q(v0.w)); w.y = pack_u8x4(gate_q(v1.x), gate_q(v1.y), gate_q(v1.z), gate_q(v1.w));
                    *(u32x2*)(rowp + bj * 128) = w; } }
    }
};
struct EpiMerge {
    static constexpr bool PERM = true, AFTER_DRAIN = false; static constexpr int NSEG = 3;
    bf16_t* Mo; const unsigned char* Gt; unsigned* panel_cnt;
    __device__ __forceinline__ void rescale(pg8::f32x4 (&acc)[2][2][4][2], const pg8::Unit& u, int seg, int wr, int wc, int fr, int fq) const {
        asm volatile("" : "+v"(fr), "+v"(fq));
        const int row0 = u.pm * 256 + wr * 64 + fr, col0 = u.pn * 256 + wc * 32 + 8 * fq;
        const unsigned char* G0 = Gt + seg * 1024 + col0;
#pragma unroll
        for (int ai = 0; ai < 2; ++ai)
#pragma unroll
            for (int mh = 0; mh < 2; ++mh) {
                u32x2 ga[2][2], gb[2][2];
#pragma unroll
                for (int mm = 0; mm < 2; ++mm)
#pragma unroll
                    for (int bj = 0; bj < 2; ++bj) { const size_t row = (size_t)(row0 + ai * 128 + (2 * mh + mm) * 16);
                        ga[mm][bj] = *(const u32x2*)(G0 + row * 3072 + bj * 128); gb[mm][bj] = *(const u32x2*)(G0 + row * 3072 + 1024 + bj * 128); }
                __builtin_amdgcn_sched_barrier(0);
#pragma unroll
                for (int mm = 0; mm < 2; ++mm)
#pragma unroll
                    for (int bj = 0; bj < 2; ++bj) { const u32x2 a = ga[mm][bj], b = gb[mm][bj]; pg8::f32x4& v0 = acc[ai][bj][2 * mh + mm][0]; pg8::f32x4& v1 = acc[ai][bj][2 * mh + mm][1];
                        v0.x *= gq(a.x, 0) * fast_rcp(gq(b.x, 0)); v0.y *= gq(a.x, 1) * fast_rcp(gq(b.x, 1)); v0.z *= gq(a.x, 2) * fast_rcp(gq(b.x, 2)); v0.w *= gq(a.x, 3) * fast_rcp(gq(b.x, 3));
                        v1.x *= gq(a.y, 0) * fast_rcp(gq(b.y, 0)); v1.y *= gq(a.y, 1) * fast_rcp(gq(b.y, 1)); v1.z *= gq(a.y, 2) * fast_rcp(gq(b.y, 2)); v1.w *= gq(a.y, 3) * fast_rcp(gq(b.y, 3)); }
                __builtin_amdgcn_sched_barrier(0);
            }
    }
    __device__ __forceinline__ void operator()(const pg8::f32x4 (&acc)[2][2][4][2], const pg8::Unit& u, int wr, int wc, int fr, int fq) const {
        asm volatile("" : "+v"(fr), "+v"(fq));
        const int row0 = u.pm * 256 + wr * 64 + fr, col0 = u.pn * 256 + wc * 32 + 8 * fq;
        constexpr float S = 1.f / 256.f;
        const __amdgpu_buffer_rsrc_t rs = __builtin_amdgcn_make_buffer_rsrc((void*)Mo, 0, TT * 1024 * 2, 0x00020000);
#pragma unroll
        for (int ai = 0; ai < 2; ++ai) {
            u32x2 gv[4][2];
#pragma unroll
            for (int m = 0; m < 4; ++m)
#pragma unroll
                for (int bj = 0; bj < 2; ++bj) gv[m][bj] = *(const u32x2*)(Gt + (size_t)(row0 + ai * 128 + m * 16) * 3072 + 2048 + col0 + bj * 128);
            __builtin_amdgcn_sched_barrier(0);
#pragma unroll
            for (int m = 0; m < 4; ++m)
#pragma unroll
                for (int bj = 0; bj < 2; ++bj) { const pg8::f32x4 v0 = acc[ai][bj][m][0], v1 = acc[ai][bj][m][1]; const u32x2 g = gv[m][bj];
                    u32x4 w; w.x = cvtpk(v0.x * (gq(g.x, 0) * S), v0.y * (gq(g.x, 1) * S)); w.y = cvtpk(v0.z * (gq(g.x, 2) * S), v0.w * (gq(g.x, 3) * S));
                    w.z = cvtpk(v1.x * (gq(g.y, 0) * S), v1.y * (gq(g.y, 1) * S)); w.w = cvtpk(v1.z * (gq(g.y, 2) * S), v1.w * (gq(g.y, 3) * S));
                    if (panel_cnt) __builtin_amdgcn_raw_buffer_store_b128(w, rs, ((row0 + ai * 128 + m * 16) * 1024 + col0 + bj * 128) * 2, 0, 16);
                    else *(u32x4*)(Mo + (size_t)(row0 + ai * 128 + m * 16) * 1024 + col0 + bj * 128) = w; }
            __builtin_amdgcn_sched_barrier(0);
        }
        if (panel_cnt) {
            asm volatile("s_waitcnt vmcnt(0)" ::: "memory");
            if (lane_id() == 0) (void)__hip_atomic_fetch_add(panel_cnt + 64 * u.pm, 1u, __ATOMIC_RELAXED, __HIP_MEMORY_SCOPE_AGENT);
        }
    }
};
struct EpiOut {
    static constexpr bool PERM = true, AFTER_DRAIN = false; static constexpr int NSEG = 1;
    const float* xsL; const float* xsC; float* xdL; float* xdC; const float* MODl;
    __device__ __forceinline__ void operator()(const pg8::f32x4 (&acc)[2][2][4][2], const pg8::Unit& u, int wr, int wc, int fr, int fq) const {
        asm volatile("" : "+v"(fr), "+v"(fq));
        const int trow = u.pm * 256; const bool lat = trow < TL;
        const int row0 = trow + wr * 64 + fr, col0 = u.pn * 256 + wc * 32 + 8 * fq;
        const float* md = MODl + (size_t)mod_row(trow) * DIN + 2 * 1024 + col0;
        const float* xs = lat ? xsL + (size_t)row0 * D + col0 : xsC + (size_t)(row0 - TL) * D + col0; float* xd = lat ? xdL + (size_t)row0 * D + col0 : xdC + (size_t)(row0 - TL) * D + col0;
        f32x4 mv[2][2];
#pragma unroll
        for (int bj = 0; bj < 2; ++bj)
#pragma unroll
            for (int n = 0; n < 2; ++n) mv[bj][n] = *(const f32x4*)(md + bj * 128 + 4 * n);
#pragma unroll
        for (int ai = 0; ai < 2; ++ai)
#pragma unroll
            for (int mh = 0; mh < 2; ++mh) {
                f32x4 xv[2][2][2];
#pragma unroll
                for (int mm = 0; mm < 2; ++mm)
#pragma unroll
                    for (int bj = 0; bj < 2; ++bj)
#pragma unroll
                        for (int n = 0; n < 2; ++n) xv[mm][bj][n] = *(const f32x4*)(xs + (size_t)(ai * 128 + (2 * mh + mm) * 16) * D + bj * 128 + 4 * n);
                __builtin_amdgcn_sched_barrier(0);
#pragma unroll
                for (int mm = 0; mm < 2; ++mm)
#pragma unroll
                    for (int bj = 0; bj < 2; ++bj)
#pragma unroll
                        for (int n = 0; n < 2; ++n) { const pg8::f32x4 av = acc[ai][bj][2 * mh + mm][n]; const f32x4 x4 = xv[mm][bj][n], m4 = mv[bj][n];
                            f32x4 o; o.x = fmaf(m4.x, av.x, x4.x); o.y = fmaf(m4.y, av.y, x4.y); o.z = fmaf(m4.z, av.z, x4.z); o.w = fmaf(m4.w, av.w, x4.w);
                            *(f32x4*)(xd + (size_t)(ai * 128 + (2 * mh + mm) * 16) * D + bj * 128 + 4 * n) = o; }
                __builtin_amdgcn_sched_barrier(0);
            }
    }
};
struct EpiMoe1 {
    static constexpr bool PERM = true, AFTER_DRAIN = false; static constexpr int NSEG = 1;
    bf16_t* HM;
    __device__ __forceinline__ void operator()(const pg8::f32x4 (&acc)[2][2][4][2], const pg8::Unit& u, int wr, int wc, int fr, int fq) const {
        asm volatile("" : "+v"(fr), "+v"(fq));
        const int row0 = u.pm * 256 + wr * 64 + fr, hcol0 = (u.pn & 3) * 128 + wc * 16 + 4 * fq;
#pragma unroll
        for (int ai = 0; ai < 2; ++ai)
#pragma unroll
            for (int m = 0; m < 4; ++m) { bf16_t* rowp = HM + (size_t)(row0 + ai * 128 + m * 16) * 512 + hcol0;
#pragma unroll
                for (int bj = 0; bj < 2; ++bj) { const pg8::f32x4 x = acc[ai][bj][m][0], y = acc[ai][bj][m][1];
                    u32x2 w; w.x = cvtpk(x.x * sigmoid_f(x.x) * y.x, x.y * sigmoid_f(x.y) * y.y); w.y = cvtpk(x.z * sigmoid_f(x.z) * y.z, x.w * sigmoid_f(x.w) * y.w);
                    *(u32x2*)(rowp + bj * 64) = w; } }
    }
};
struct EpiMoe2 {
    static constexpr bool PERM = true, AFTER_DRAIN = false; static constexpr int NSEG = 1;
    bf16_t* Fo; const int* erow; const float* eroww; const LAS int* ebase; const LAS int* ecnt;
    __device__ __forceinline__ void operator()(const pg8::f32x4 (&acc)[2][2][4][2], const pg8::Unit& u, int wr, int wc, int fr, int fq) const {
        asm volatile("" : "+v"(fr), "+v"(fq));
        const int e = u.pn >> 2, cnt = __builtin_amdgcn_readfirstlane(ecnt[e]), pos0 = u.pm * 256 - __builtin_amdgcn_readfirstlane(ebase[e]) + wr * 64 + fr, col0 = (u.pn & 3) * 256 + wc * 32 + 8 * fq;
        const int* er = erow + (size_t)e * TT; const float* ew = eroww + (size_t)e * TT;
#pragma unroll
        for (int ai = 0; ai < 2; ++ai) {
            int rm[4]; float wg[4];
#pragma unroll
            for (int m = 0; m < 4; ++m) { const int pos = pos0 + ai * 128 + m * 16; const bool ok = pos < cnt; rm[m] = ok ? er[ok ? pos : 0] : -1; wg[m] = ew[ok ? pos : 0]; }
            __builtin_amdgcn_sched_barrier(0);
#pragma unroll
            for (int m = 0; m < 4; ++m) { const int r1 = rm[m];
                if (r1 >= 0) { const float wgt = wg[m]; bf16_t* rowp = Fo + ((size_t)(r1 & 1) * TT + (r1 >> 1)) * D + col0;
#pragma unroll
                    for (int bj = 0; bj < 2; ++bj) { const pg8::f32x4 v0 = acc[ai][bj][m][0], v1 = acc[ai][bj][m][1];
                        u32x4 w; w.x = cvtpk(v0.x * wgt, v0.y * wgt); w.y = cvtpk(v0.z * wgt, v0.w * wgt); w.z = cvtpk(v1.x * wgt, v1.y * wgt); w.w = cvtpk(v1.z * wgt, v1.w * wgt);
                        *(u32x4*)(rowp + bj * 128) = w; } } }
            __builtin_amdgcn_sched_barrier(0);
        }
    }
};
struct FusedOutOrder {
    int c, G, nun, wv; const unsigned* ready; unsigned* tmo;
    __device__ __forceinline__ bool next(int i, pg8::Unit& u) const {
        int q;
        if (!ready) { q = i * G + c; if (q >= nun) return false; }
        else if (G == 256 && nun == 576) { if (c < 64) { if (i > 0) return false; q = 512 + c; } else { q = i * 192 + (c - 64); if (q >= 512) return false; } }
        else { q = i * G + (G - 1 - c); if (q >= nun) return false; }
        u.pm = q >> 2; u.pn = q & 3; return true; }
    __device__ __forceinline__ void a_ready(const pg8::Unit& u) const {
        if (!ready) return;
        if (wv == 0) {
            const unsigned long long t0 = __builtin_amdgcn_s_memrealtime(); unsigned polls = 0;
            while ((unsigned)__builtin_amdgcn_readfirstlane(__hip_atomic_load(ready + 64 * u.pm, __ATOMIC_RELAXED, __HIP_MEMORY_SCOPE_AGENT)) < 32u) {
                if ((++polls & 255u) == 0u && __builtin_amdgcn_readfirstlane(__hip_atomic_load(tmo, __ATOMIC_RELAXED, __HIP_MEMORY_SCOPE_AGENT)) != 0u) break;
                if (__builtin_amdgcn_s_memrealtime() - t0 > 20000000ull) { if (lane_id() == 0) __hip_atomic_store(tmo, 1u, __ATOMIC_RELAXED, __HIP_MEMORY_SCOPE_AGENT); break; }
                __builtin_amdgcn_s_sleep(2); }
            __builtin_amdgcn_fence(__ATOMIC_ACQUIRE, "agent");
            asm volatile("s_waitcnt vmcnt(0)" ::: "memory");
        }
        asm volatile("" ::: "memory"); __builtin_amdgcn_s_barrier(); asm volatile("" ::: "memory");
    }
    __device__ __forceinline__ void done(const pg8::Unit&) const {}
};
struct LastInProjOrder {
    pg8::StaticOrder T; int nlat, G, c;
    __device__ __forceinline__ bool next(int i, pg8::Unit& u) const {
        const int L = i * G + c;
        if (L < nlat) return T.next(i, u);
        const int r = L - nlat; if (r >= 32) return false;
        u.pm = 128 + (r >> 1); u.pn = (r & 1) ? 11 : 2; return true; }
    __device__ __forceinline__ void a_ready(const pg8::Unit&) const {}
    __device__ __forceinline__ void done(const pg8::Unit&) const {}
};
struct MoeOrder {
    int nunits, G, c; const LAS int* tile_e;
    __device__ __forceinline__ bool next(int i, pg8::Unit& u) const {
        const int L0 = i * G + c; if (L0 >= nunits) return false;
        const int q = nunits / 8, r = nunits % 8, xcd = L0 % 8, off = L0 / 8; const int L = (xcd < r ? xcd * (q + 1) : r * (q + 1) + (xcd - r) * q) + off;
        const int pm = L >> 2; u.pm = pm; u.pn = __builtin_amdgcn_readfirstlane(tile_e[pm]) * 4 + (L & 3); return true; }
    __device__ __forceinline__ void a_ready(const pg8::Unit&) const {}
    __device__ __forceinline__ void done(const pg8::Unit&) const {}
};

__device__ __forceinline__ int moe_tables(const Fr& F, const Args& a, int l, LAS int* ebase  , LAS int* ecnt  , LAS int* tile_e  ) {
    const unsigned* CNT = (const unsigned*)(a.ws + WS_CTL) + CW_CNT + l * 256;
    __syncthreads();
    if (F.tid == 0) { int acc = 0;
#pragma unroll 1
        for (int e = 0; e < NE; ++e) { const int c = (int)__hip_atomic_load(&CNT[e * 16], __ATOMIC_RELAXED, __HIP_MEMORY_SCOPE_AGENT); ecnt[e] = c; ebase[e] = acc; const int nt = (c + 255) >> 8;
#pragma unroll 1
            for (int t = 0; t < nt; ++t) tile_e[(acc >> 8) + t] = e;
            acc += nt << 8; }
        ebase[NE] = acc; }
    __syncthreads();
    return ebase[NE] >> 8;
}

__device__ __forceinline__ void moe_gather_table(const Fr& F, const Args& a, const MoeOrder& S, const LAS int* ebase, const LAS int* ecnt, LAS int* gidx) {
    const int* EROW = (const int*)(a.ws + WS_EROW);
    for (int j = 0; j < 16; ++j) { pg8::Unit u; if (!S.next(j, u)) break;
        const int e = u.pn >> 2, pos0 = u.pm * 256 - ebase[e], cnt = ecnt[e];
        if (F.tid < 256) { const int pos = pos0 + F.tid; gidx[j * 256 + F.tid] = pos < cnt ? (EROW[(size_t)e * TT + pos] >> 1) : 0; } }
    __syncthreads();
}

#ifndef MK_PER_PHASE
#define MK_PER_PHASE 0
#endif
constexpr int PH_PER_LAYER = 10, PH_FINAL = 1 + NL * PH_PER_LAYER, N_PHASES = PH_FINAL + 1;

__global__ void __launch_bounds__(NTHR, 2) trunk_fwd(Args args) {
    extern __shared__ __attribute__((aligned(16))) unsigned char lds[];
    Fr F; F.lds = (LAS unsigned char*)lds; F.tid = threadIdx.x; F.lane = F.tid & 63; F.wave = __builtin_amdgcn_readfirstlane(F.tid >> 6); F.G = gridDim.x; F.bid = blockIdx.x;
    const int wave0 = F.wave;
    for (int u = F.tid; u < (LDS_BYTES - MISC_OFF) / 4; u += NTHR) ((LAS unsigned*)(F.lds + MISC_OFF))[u] = 0u;
    __syncthreads();
    const int lo = args.ph_lo, hi = args.ph_hi;
    unsigned* ctl = (unsigned*)(args.ws + WS_CTL);
    XcdBarrier bar; bar.bar = ctl + CW_BAR; bar.x = 0; bar.st = (volatile LAS unsigned*)(F.lds + MISC_OFF);
    if (hi - lo > 1) bar = xcd_barrier_post(ctl + CW_BAR, (volatile LAS unsigned*)(F.lds + MISC_OFF));
    bar.wv = (unsigned)wave0;
#ifndef DBG_ONLY
#define DBG_ONLY -1
#endif
#define SEL(p) (DBG_ONLY < 0 || DBG_ONLY == (p))
#define IN(k) (lo <= (k) && (k) < hi)
#define FRESH() do { int t_ = wave0 * 64 + lane_id(); asm volatile("" : "+v"(t_)); F.tid = t_; F.lane = t_ & 63; F.wave = wave0; } while (0)
#define SEAM(k) do { if (IN(k) && IN((k) + 1)) xcd_barrier(bar); } while (0)
#if !defined(PROBE_SUB)
#define PROBE_SUB -1
#endif
    unsigned long long pr_sub = 0ull;
#if defined(PROBE_P)
    unsigned long long pr_acc = 0ull, pr_t0 = __builtin_amdgcn_s_memrealtime();
#define PR_MARK(p) do { const unsigned long long t_ = __builtin_amdgcn_s_memrealtime(); if ((p) == PROBE_P) pr_acc += t_ - pr_t0; pr_t0 = t_; } while (0)
#else
#define PR_MARK(p) do { } while (0)
#endif
    unsigned char* ws = args.ws;
    LAS int* ebase = (LAS int*)(F.lds + MISC_OFF + 64); LAS int* ecnt = ebase + 20; LAS int* tile_e = (LAS int*)(F.lds + MISC_OFF + 512);

    #ifndef DBG_PRO
#define DBG_PRO 7
#endif
    if (SEL(100) && IN(0)) { FRESH(); if (DBG_PRO & 1) pro_mod(F, args); __syncthreads(); if (DBG_PRO & 2) pro_rope(F, args); if (DBG_PRO & 4) pro_filter(F, args); __syncthreads(); }
    SEAM(0); PR_MARK(100);
    for (int l = 0; l < NL; ++l) {
        const int pb = 1 + PH_PER_LAYER * l;
#define LVARS() int lq_ = l; asm volatile("" : "+s"(lq_)); const bool uc = lq_ < NL - 1; const int M2 = uc ? TT : TL; (void)M2; (void)uc
        if (SEL(0) && IN(pb + 0)) { LVARS(); FRESH(); if (l == 0) filter_norm_reduce(F, args); conv_small_weights(F, args, l, 7, 0); rows_p0(F, args, l, TT); __syncthreads(); }
        SEAM(pb + 0); PR_MARK(0);
        if (SEL(1) && IN(pb + 1)) { LVARS();
            pg8::Gemm g{(const bf16_t*)(ws + WS_H8), (const bf16_t*)(ws + WS_WG8), TT, DIN, 512}; EpiInProj E{ws, 0};
            if (uc) { pg8::StaticOrder S; S.init(TT, DIN, F.G, F.bid); pg8::gemm_phase<EpiInProj, pg8::StaticOrder, true, true, false, true, -6>(F.lds, g, S, E, wave0); }
            else { LastInProjOrder S; S.T.init(TL, DIN, F.G, F.bid); S.nlat = (TL / 256) * (DIN / 256); S.G = F.G; S.c = F.bid; pg8::gemm_phase<EpiInProj, LastInProjOrder, true, true, false, true, -6>(F.lds, g, S, E, wave0); }
        }
        SEAM(pb + 1); PR_MARK(1);
        if (SEL(2) && IN(pb + 2)) { LVARS(); FRESH(); prep_phase(F, args, l, uc); }
        SEAM(pb + 2); PR_MARK(2);
        if (SEL(3) && IN(pb + 3)) { LVARS(); FRESH(); mixer_phase(F, args, l, uc, pr_sub, PROBE_SUB); }
        SEAM(pb + 3); PR_MARK(3);
        if (SEL(4) && IN(pb + 4)) { LVARS(); FRESH(); hyena_final_phase(F, args, l, uc); }
        SEAM(pb + 4); PR_MARK(4);
        if (SEL(5) && IN(pb + 5)) { LVARS();
            pg8::StaticOrder S; S.init(M2, 1024, F.G, F.bid);
            pg8::Gemm g{(const bf16_t*)(ws + WS_QA), (const bf16_t*)(ws + WS_WBR), M2, 1024, 1536}; EpiMerge E{(bf16_t*)(ws + WS_H), (const unsigned char*)(ws + WS_G), nullptr};
            pg8::gemm_phase<EpiMerge, pg8::StaticOrder, true, true>(F.lds, g, S, E, wave0);
            { FRESH(); __syncthreads(); const int nun = (M2 / 256) * 4, rem = nun % F.G; conv_expert_weights(F, args, l, rem, 0, CONV_E_ITEMS); __syncthreads(); }
        }
        SEAM(pb + 5); PR_MARK(5);
        if (SEL(6) && IN(pb + 6)) { LVARS();
            pg8::Gemm g{(const bf16_t*)(ws + WS_H), (const bf16_t*)(ws + WS_WOUT), M2, 1024, 1024}; pg8::StaticOrder S; S.init(M2, 1024, F.G, F.bid);
            EpiOut E{l == 0 ? args.in[I_X] : args.out, l == 0 ? args.in[I_CTX] : (const float*)(ws + WS_XC), args.out, (float*)(ws + WS_XC), (const float*)(ws + WS_MOD) + (size_t)l * NBM * DIN};
            pg8::gemm_phase<EpiOut, pg8::StaticOrder, true, true>(F.lds, g, S, E, wave0);
        }
        SEAM(pb + 6); PR_MARK(6);
        if (SEL(7) && IN(pb + 7)) { LVARS(); FRESH(); rows_p5(F, args, l, M2, pr_sub, PROBE_SUB); __syncthreads(); }
        SEAM(pb + 7); PR_MARK(7);
        if (SEL(8) && IN(pb + 8)) { LVARS(); FRESH();
            const int ntile = moe_tables(F, args, l, ebase, ecnt, tile_e);
            pg8::Gemm g{(const bf16_t*)(ws + WS_H), (const bf16_t*)(ws + WS_W13), ntile * 256, NE * 1024, 1024}; MoeOrder S{ntile * 4, F.G, F.bid, tile_e};
            LAS int* gidx = (LAS int*)(F.lds + 131072);
            moe_gather_table(F, args, S, ebase, ecnt, gidx);
            EpiMoe1 E{(bf16_t*)(ws + WS_U)};
            pg8::gemm_phase<EpiMoe1, MoeOrder, true, true, true>(F.lds, g, S, E, wave0, gidx);
        }
        SEAM(pb + 8); PR_MARK(8);
        if (SEL(9) && IN(pb + 9)) { LVARS(); FRESH();
            const int ntile = moe_tables(F, args, l, ebase, ecnt, tile_e);
            pg8::Gemm g{(const bf16_t*)(ws + WS_U), (const bf16_t*)(ws + WS_W2), ntile * 256, NE * 1024, 512}; MoeOrder S{ntile * 4, F.G, F.bid, tile_e};
            EpiMoe2 E{(bf16_t*)(ws + WS_F), (const int*)(ws + WS_EROW), (const float*)(ws + WS_EROWW), ebase, ecnt};
            pg8::gemm_phase<EpiMoe2, MoeOrder, true, true>(F.lds, g, S, E, wave0);
        }
        SEAM(pb + 9); PR_MARK(9);
    }
    if (SEL(101) && IN(PH_FINAL)) { FRESH(); rows_final(F, args); }
#if defined(PROBE_P)
    PR_MARK(101);
    pr_acc += pr_sub;
    if (blockIdx.x == 0 && F.wave == 0) { const unsigned long long t1 = __builtin_amdgcn_s_memrealtime() + 4ull * pr_acc; while (__builtin_amdgcn_s_memrealtime() < t1) __builtin_amdgcn_s_sleep(8); }
#endif
#undef IN
#undef SEAM
}

extern "C" void kernel_launch(void* const* d_in, const int* in_sizes, int n_in, void* d_out, int out_size, void* d_ws, size_t ws_size, hipStream_t stream) {
    static int grid = 0;
    if (grid == 0) {
        if (n_in != 29 || in_sizes[0] != TL * D || out_size != TL * D || ws_size < WS_END) { fprintf(stderr, "kernel_launch: unexpected shapes / workspace (n_in %d, ws %zu < %zu); nothing launched\n", n_in, ws_size, (size_t)WS_END); grid = -1; return; }
        int dev = 0, cus = 0, per_cu = 0;
        if (hipGetDevice(&dev) != hipSuccess || hipDeviceGetAttribute(&cus, hipDeviceAttributeMultiprocessorCount, dev) != hipSuccess) { grid = -1; return; }
        if (hipFuncSetAttribute((const void*)trunk_fwd, hipFuncAttributeMaxDynamicSharedMemorySize, LDS_BYTES) != hipSuccess) { fprintf(stderr, "kernel_launch: hipFuncSetAttribute failed\n"); grid = -1; return; }
        if (hipOccupancyMaxActiveBlocksPerMultiprocessor(&per_cu, (const void*)trunk_fwd, NTHR, LDS_BYTES) != hipSuccess || per_cu < 1) { fprintf(stderr, "kernel_launch: occupancy query reports %d\n", per_cu); }
        (void)hipGetLastError();
        grid = cus;
    }
    if (grid < 0) return;
    (void)hipMemsetAsync((char*)d_ws + WS_CTL, 0, CTL_ZERO_BYTES, stream);
    Args a{};
    for (int i = 0; i < 29; ++i) a.in[i] = (const float*)d_in[i];
    a.out = (float*)d_out; a.ws = (unsigned char*)d_ws;
#if MK_PER_PHASE
    for (int k = 0; k < N_PHASES; ++k) { a.ph_lo = k; a.ph_hi = k + 1; hipLaunchKernelGGL(trunk_fwd, dim3(grid), dim3(NTHR), LDS_BYTES, stream, a); }
#else
    a.ph_lo = 0; a.ph_hi = N_PHASES;
    hipLaunchKernelGGL(trunk_fwd, dim3(grid), dim3(NTHR), LDS_BYTES, stream, a);
#endif
}
```

```cpp
#include <hip/hip_runtime.h>
#include <cstdio>
#include <cstdint>

#define GAS __attribute__((address_space(1)))
#define LAS __attribute__((address_space(3)))
__device__ __forceinline__ int lane_id() { int l; asm volatile("v_mbcnt_lo_u32_b32 %0, -1, 0\n\tv_mbcnt_hi_u32_b32 %0, -1, %0" : "=v"(l)); return l; }
#define MK_PER_PHASE 0
namespace pg8 {
#define PG8_LAS __attribute__((address_space(3)))
typedef unsigned short bf16_t;
typedef short bf16x8 __attribute__((ext_vector_type(8)));
typedef float f32x4 __attribute__((ext_vector_type(4)));
typedef unsigned u32x4 __attribute__((ext_vector_type(4)));
constexpr int BM = 256, BK = 64, HALF = 128, HTB = HALF * BK * 2  , STAGE_BYTES = 8 * HTB, NXCD = 8, WGM = 8;

__host__ __device__ __forceinline__ int lds_byte(int r, int c) { const int st = (r >> 4) * 2 + (c >> 5), rr = r & 15, cc = c & 31, ob = rr * 64 + cc * 2; return st * 1024 + (ob ^ (((ob >> 9) & 1) << 5)); }
__host__ __device__ __forceinline__ void stage_rc(int b, int& R, int& C) { const int st = b / 1024, sb = b % 1024, swz = sb ^ (((sb >> 9) & 1) << 5); R = (st >> 1) * 16 + swz / 64; C = (st & 1) * 32 + (swz % 64) / 2; }
__host__ __device__ __forceinline__ int perm32(int rho) { const int n = rho >> 4, i = rho & 15; return 8 * (i >> 2) + 4 * n + (i & 3); }

struct Unit { int pm, pn; };
struct Gemm { const bf16_t* A; const bf16_t* Bt; int M, N, K; };

struct StaticOrder {
    int nM, nN, nwg, G, c;
    __host__ __device__ void init(int M, int N, int G_, int c_) { nM = M / BM; nN = N / BM; nwg = nM * nN; G = G_; c = c_; }
    __host__ __device__ bool next(int i, Unit& u) const {
        const long L = (long)i * G + c; if (L >= nwg) return false;
        int wgid = (int)L; { const int q = nwg / NXCD, r = nwg % NXCD, xcd = wgid % NXCD, off = wgid / NXCD; wgid = (xcd < r ? xcd * (q + 1) : r * (q + 1) + (xcd - r) * q) + off; }
        const int nig = WGM * nN, gid = wgid / nig, fm = gid * WGM, gsz = (nM - fm) < WGM ? (nM - fm) : WGM;
        u.pm = fm + ((wgid % nig) % gsz); u.pn = (wgid % nig) / gsz; return true;
    }
    __device__ __forceinline__ void a_ready(const Unit&) const {}
    __device__ __forceinline__ void done(const Unit&) const {}
};
__device__ __forceinline__ unsigned cvt_pk_bf16(float lo, float hi) { unsigned r; asm volatile("v_cvt_pk_bf16_f32 %0, %1, %2" : "=v"(r) : "v"(lo), "v"(hi)); return r; }
typedef float f32x2 __attribute__((ext_vector_type(2)));
template <class Epi, class Sched, bool ALIGN_EPI = false, bool SP2 = false, bool GATHER = false, bool F8 = false, int F8_SW = 0>
__device__ __forceinline__ void gemm_phase(PG8_LAS unsigned char* lds, const Gemm g, const Sched& S, const Epi& E, const int wave_id, const PG8_LAS int* gidx = nullptr) {
    static_assert(!GATHER || SP2, "GATHER is implemented for the SP2 loop only");
    int tid_ = wave_id * 64 + lane_id(); asm volatile("" : "+v"(tid_));
    const int tid = tid_, wid = __builtin_amdgcn_readfirstlane(tid >> 6), lane = tid & 63, wr = wid >> 2, wc = wid & 3, fr = lane & 15, fq = lane >> 4;
    const int K = g.K, nt = K / BK;
    unsigned voffA[2], voffB[2];
#pragma unroll
    for (int i = 0; i < 2; ++i) { int R, C; stage_rc(tid * 16 + i * 8192, R, C); const int Rb = Epi::PERM ? ((R & ~31) + perm32(R & 31)) : R;
        voffA[i] = (unsigned)(R * K + C) * 2u; voffB[i] = (unsigned)(Rb * K + C) * 2u; }
    unsigned goffA[2][2], goffN[2][2];
#define PG8_GOFF(dst, j) do { _Pragma("unroll") for (int _h = 0; _h < 2; ++_h) _Pragma("unroll") for (int _i = 0; _i < 2; ++_i) { int R_, C_; stage_rc(tid * 16 + _i * 8192, R_, C_); \
        dst[_h][_i] = ((unsigned)gidx[(j) * 256 + _h * 128 + R_] * (unsigned)K + (unsigned)C_) * 2u; } } while (0)
#define PG8_STAGE_A(bufoff, base, h, nx) do { if constexpr (GATHER) { unsigned o_[2] = {(nx) ? goffN[h][0] : goffA[h][0], (nx) ? goffN[h][1] : goffA[h][1]}; PG8_STAGE(bufoff, base, o_); } \
        else { PG8_STAGE(bufoff, (base) + ((h) ? hstep : 0), voffA); } } while (0)
    const size_t kstep = (size_t)(BK * 2);
    const size_t hstep = (size_t)HALF * K * 2;
    const size_t tstep = 2 * hstep;
    const unsigned ldsw = (unsigned)wid * 1024u;
    const int aoff = lds_byte(wr * 64 + fr, fq * 8), boff = lds_byte(wc * 32 + fr, fq * 8);
#define PG8_SA(b, h) (((b) * 2 + (h)) * HTB)
#define PG8_SB(b, h) ((4 + (b) * 2 + (h)) * HTB)
#define PG8_STAGE(bufoff, gbase, voff) do { _Pragma("unroll") for (int _i = 0; _i < 2; ++_i) \
        __builtin_amdgcn_global_load_lds((const unsigned*)((const char*)(gbase) + (voff)[_i]), (PG8_LAS unsigned*)(lds + (bufoff) + ldsw + _i * 8192), 16, 0, 0); } while (0)
#define PG8_LDA(dst, b, h) do { _Pragma("unroll") for (int m = 0; m < 4; ++m) _Pragma("unroll") for (int k = 0; k < 2; ++k) dst[m][k] = *(const PG8_LAS bf16x8*)(lds + PG8_SA(b, h) + aoff + m * 2048 + k * 1024); } while (0)
#define PG8_LDB(dst, b, h) do { _Pragma("unroll") for (int n = 0; n < 2; ++n) _Pragma("unroll") for (int k = 0; k < 2; ++k) dst[n][k] = *(const PG8_LAS bf16x8*)(lds + PG8_SB(b, h) + boff + n * 2048 + k * 1024); } while (0)
#define PG8_MMA(ai, bj, At, Bt) do { if constexpr (F8) __builtin_amdgcn_sched_barrier(0); __builtin_amdgcn_s_setprio(1); _Pragma("unroll") for (int m = 0; m < 4; ++m) _Pragma("unroll") for (int n = 0; n < 2; ++n) { \
        if constexpr (F8) { typedef int i32x4_ __attribute__((ext_vector_type(4))); typedef int i32x8_ __attribute__((ext_vector_type(8))); \
            const i32x8_ wf = __builtin_shufflevector(__builtin_bit_cast(i32x4_, Bt[n][0]), __builtin_bit_cast(i32x4_, Bt[n][1]), 0, 1, 2, 3, 4, 5, 6, 7); \
            const i32x8_ af = __builtin_shufflevector(__builtin_bit_cast(i32x4_, At[m][0]), __builtin_bit_cast(i32x4_, At[m][1]), 0, 1, 2, 3, 4, 5, 6, 7); \
              \
            asm volatile("v_mfma_scale_f32_16x16x128_f8f6f4 %0, %1, %2, %0, %3, %4 op_sel_hi:[0,0,0]" : "+v"(acc[ai][bj][m][n]) : "v"(wf), "v"(af), "v"(f8sw), "v"(f8sa)); } \
        else { _Pragma("unroll") for (int k = 0; k < 2; ++k) acc[ai][bj][m][n] = __builtin_amdgcn_mfma_f32_16x16x32_bf16(Bt[n][k], At[m][k], acc[ai][bj][m][n], 0, 0, 0); } } \
        __builtin_amdgcn_s_setprio(0); if constexpr (F8) __builtin_amdgcn_sched_barrier(0); } while (0)
#define PG8_WAIT_V(n) asm volatile("s_waitcnt vmcnt(" #n ")" ::: "memory")
#define PG8_WAIT_L(n) asm volatile("s_waitcnt lgkmcnt(" #n ")" ::: "memory")
#define PG8_BAR __builtin_amdgcn_s_barrier()
#define PG8_SCHED __builtin_amdgcn_sched_barrier(0)
    const int f8sw = 127 + F8_SW, f8sa = 127; (void)f8sw; (void)f8sa;
    Unit cur, nxt; int ui = 0;
    if (!S.next(0, cur)) return;
    f32x4 acc[2][2][4][2];
#pragma unroll
    for (int a = 0; a < 2; ++a)
#pragma unroll
        for (int b = 0; b < 2; ++b)
#pragma unroll
            for (int m = 0; m < 4; ++m)
#pragma unroll
                for (int n = 0; n < 2; ++n) acc[a][b][m][n] = (f32x4){0.f, 0.f, 0.f, 0.f};
    bf16x8 At[4][2], B0[2][2], B1[2][2];
    const char* cA = GATHER ? (const char*)g.A : (const char*)g.A + (size_t)cur.pm * tstep; const char* cB = (const char*)g.Bt + (size_t)cur.pn * tstep;
    if constexpr (GATHER) PG8_GOFF(goffA, 0);
    S.a_ready(cur);
    if constexpr (SP2) {
        PG8_STAGE(PG8_SB(0, 0), cB, voffB); PG8_STAGE(PG8_SB(0, 1), cB + hstep, voffB); PG8_STAGE_A(PG8_SA(0, 0), cA, 0, false); PG8_STAGE_A(PG8_SA(0, 1), cA, 1, false);
        if (wr == 1) PG8_BAR;
        PG8_WAIT_V(2); PG8_BAR;
        PG8_STAGE(PG8_SB(1, 0), cB + kstep, voffB); PG8_STAGE_A(PG8_SA(1, 0), cA + kstep, 0, false); PG8_STAGE(PG8_SB(1, 1), cB + hstep + kstep, voffB);
        PG8_WAIT_V(6); PG8_BAR;
    } else {
        PG8_STAGE(PG8_SB(0, 0), cB, voffB); PG8_STAGE(PG8_SA(0, 0), cA, voffA); PG8_STAGE(PG8_SB(0, 1), cB + hstep, voffB); PG8_STAGE(PG8_SA(0, 1), cA + hstep, voffA);
        if (wr == 1) PG8_BAR;
        PG8_WAIT_V(4); PG8_BAR;
        PG8_STAGE(PG8_SB(1, 0), cB + kstep, voffB); PG8_STAGE(PG8_SA(1, 0), cA + kstep, voffA); PG8_STAGE(PG8_SB(1, 1), cB + hstep + kstep, voffB);
        PG8_WAIT_V(6); PG8_BAR;
    }
    for (;;) {
        const bool has_next = S.next(ui + 1, nxt);
        if constexpr (GATHER) { if (has_next) PG8_GOFF(goffN, ui + 1); else { _Pragma("unroll") for (int _h = 0; _h < 2; ++_h) _Pragma("unroll") for (int _i = 0; _i < 2; ++_i) goffN[_h][_i] = goffA[_h][_i]; } }
        const char* nA = GATHER ? (const char*)g.A : has_next ? (const char*)g.A + (size_t)nxt.pm * tstep : cA; const char* nB = has_next ? (const char*)g.Bt + (size_t)nxt.pn * tstep : cB;
        for (int t = 0; t < nt; t += 2) {
            const bool last = (t == nt - 2);
            const char* a1 = cA + (size_t)(t + 1) * kstep;
            const char* a2 = last ? nA : cA + (size_t)(t + 2) * kstep; const char* b2 = last ? nB : cB + (size_t)(t + 2) * kstep;
            const char* a3 = a2 + kstep; const char* b3 = b2 + kstep;
            if (last && has_next) S.a_ready(nxt);
            if constexpr (SP2) {
            PG8_LDB(B0, 0, 0); PG8_LDB(B1, 0, 1); PG8_SCHED; PG8_LDA(At, 0, 0); PG8_STAGE_A(PG8_SA(1, 1), a1, 1, false);
            PG8_WAIT_V(8); PG8_WAIT_L(0); PG8_BAR; PG8_MMA(0, 0, At, B0); PG8_MMA(0, 1, At, B1); PG8_BAR; PG8_SCHED;
            PG8_LDA(At, 0, 1); PG8_STAGE(PG8_SB(0, 0), b2, voffB); PG8_STAGE(PG8_SB(0, 1), b2 + hstep, voffB); PG8_STAGE_A(PG8_SA(0, 0), a2, 0, last);
            PG8_WAIT_V(8); PG8_WAIT_L(0); PG8_BAR; PG8_MMA(1, 0, At, B0); PG8_MMA(1, 1, At, B1); PG8_BAR; PG8_SCHED;
            PG8_LDB(B0, 1, 0); PG8_LDB(B1, 1, 1); PG8_SCHED; PG8_LDA(At, 1, 0); PG8_STAGE_A(PG8_SA(0, 1), a2, 1, last);
            PG8_WAIT_V(8); PG8_WAIT_L(0); PG8_BAR; PG8_MMA(0, 0, At, B0); PG8_MMA(0, 1, At, B1); PG8_BAR; PG8_SCHED;
            PG8_LDA(At, 1, 1); PG8_STAGE(PG8_SB(1, 0), b3, voffB); PG8_STAGE(PG8_SB(1, 1), b3 + hstep, voffB); PG8_STAGE_A(PG8_SA(1, 0), a3, 0, last);
            PG8_WAIT_V(8); PG8_WAIT_L(0); PG8_BAR; PG8_MMA(1, 0, At, B0); PG8_MMA(1, 1, At, B1); PG8_BAR; PG8_SCHED;
            if constexpr (Epi::NSEG > 1) {
                if (t + 2 < nt && ((t + 2) & 7) == 0) E.rescale(acc, cur, (t + 2) / 8 - 1, wr, wc, fr, fq);
            }
            } else {
            PG8_LDB(B0, 0, 0); PG8_SCHED; PG8_LDA(At, 0, 0); PG8_STAGE(PG8_SA(1, 1), a1 + hstep, voffA);
            PG8_WAIT_L(8); PG8_BAR; PG8_WAIT_L(0); PG8_MMA(0, 0, At, B0); PG8_BAR; PG8_SCHED;
            PG8_LDB(B1, 0, 1); PG8_STAGE(PG8_SB(0, 0), b2, voffB);
            PG8_BAR; PG8_WAIT_L(0); PG8_MMA(0, 1, At, B1); PG8_BAR;
            PG8_LDA(At, 0, 1); PG8_STAGE(PG8_SA(0, 0), a2, voffA);
            PG8_BAR; PG8_WAIT_L(0); PG8_MMA(1, 0, At, B0); PG8_BAR; PG8_SCHED;
            PG8_STAGE(PG8_SB(0, 1), b2 + hstep, voffB);
            PG8_WAIT_V(6); PG8_BAR; PG8_MMA(1, 1, At, B1); PG8_BAR;
            PG8_LDB(B0, 1, 0); PG8_SCHED; PG8_LDA(At, 1, 0); PG8_STAGE(PG8_SA(0, 1), a2 + hstep, voffA);
            PG8_WAIT_L(8); PG8_BAR; PG8_WAIT_L(0); PG8_MMA(0, 0, At, B0); PG8_BAR; PG8_SCHED;
            PG8_LDB(B1, 1, 1); PG8_STAGE(PG8_SB(1, 0), b3, voffB);
            PG8_BAR; PG8_WAIT_L(0); PG8_MMA(0, 1, At, B1); PG8_BAR;
            PG8_LDA(At, 1, 1); PG8_STAGE(PG8_SA(1, 0), a3, voffA);
            PG8_BAR; PG8_WAIT_L(0); PG8_MMA(1, 0, At, B0); PG8_BAR; PG8_SCHED;
            PG8_STAGE(PG8_SB(1, 1), b3 + hstep, voffB);
            PG8_WAIT_V(6); PG8_BAR; PG8_MMA(1, 1, At, B1); PG8_BAR;
            }
        }
        if constexpr (ALIGN_EPI) { if (wr == 0) PG8_BAR; }
        if constexpr (F8) asm volatile("s_nop 15\n\ts_nop 15" ::: "memory");
        if constexpr (!Epi::AFTER_DRAIN) { E(acc, cur, wr, wc, fr, fq); S.done(cur); }
        if (!has_next) break;
#pragma unroll
        for (int a = 0; a < 2; ++a)
#pragma unroll
            for (int b = 0; b < 2; ++b)
#pragma unroll
                for (int m = 0; m < 4; ++m)
#pragma unroll
                    for (int n = 0; n < 2; ++n) acc[a][b][m][n] = (f32x4){0.f, 0.f, 0.f, 0.f};
        cur = nxt; cA = nA; cB = nB; ++ui;
        if constexpr (GATHER) { _Pragma("unroll") for (int _h = 0; _h < 2; ++_h) _Pragma("unroll") for (int _i = 0; _i < 2; ++_i) goffA[_h][_i] = goffN[_h][_i]; }
        if constexpr (ALIGN_EPI) { if (wr == 1) PG8_BAR; }
    }
    PG8_WAIT_V(0);
    if constexpr (!ALIGN_EPI) { if (wr == 0) PG8_BAR; }
    PG8_BAR;
    if constexpr (Epi::AFTER_DRAIN) { E.fused(acc, cur, wr, wc, fr, fq, lds, wid, lane); S.done(cur); }
#undef PG8_SA
#undef PG8_SB
#undef PG8_STAGE
#undef PG8_STAGE_A
#undef PG8_GOFF
#undef PG8_LDA
#undef PG8_LDB
#undef PG8_MMA
#undef PG8_WAIT_V
#undef PG8_WAIT_L
#undef PG8_BAR
#undef PG8_SCHED
}
}
#define XB_TMO      128
#define XB_XCNT(j)  (256  + 64 * (j))
#define XB_XSUB(j)  (1280 + 64 * (j))
#define XB_XGEN(j)  (2304 + 64 * (j))
#define XB_TOP      3328
#define XB_TOPGEN   3392
#define XCD_BAR_WORDS 3456
#define XB_SPIN_CAP (1u << 22)
#define LAS __attribute__((address_space(3)))

__device__ __forceinline__ unsigned xb_ld(unsigned* p)              { return __hip_atomic_load(p, __ATOMIC_RELAXED, __HIP_MEMORY_SCOPE_AGENT); }
__device__ __forceinline__ unsigned xb_add(unsigned* p, unsigned v) { asm volatile("" : "+v"(p));
    return __hip_atomic_fetch_add(p, v, __ATOMIC_RELAXED, __HIP_MEMORY_SCOPE_AGENT); }
__device__ __forceinline__ unsigned xb_xcc_id() { return (unsigned)__builtin_amdgcn_s_getreg((3 << 11) | 20) & 0xFu; }
#define XB_SPIN(cond, bar) do { unsigned _sp = 0; while (cond) { __builtin_amdgcn_s_sleep(1); \
    if ((++_sp & 255u) == 0u) { if (xb_ld(&(bar)[XB_TMO])) break; if (_sp > XB_SPIN_CAP) { xb_add(&(bar)[XB_TMO], 1u); break; } } } } while (0)

struct XcdBarrier {
    unsigned* bar; unsigned x; unsigned wv;
    volatile LAS unsigned* st;
};

__device__ __forceinline__ XcdBarrier xcd_barrier_post(unsigned* bar, volatile LAS unsigned* st) {
    XcdBarrier b; b.bar = bar; b.x = xb_xcc_id(); b.st = st;
    if (threadIdx.x == 0) (void)xb_add(&bar[XB_XCNT(b.x)], 1u);
    return b;
}
__device__ __forceinline__ void xcd_barrier_complete(unsigned* bar, unsigned x, unsigned& nloc, unsigned& nx) {
    const unsigned G = gridDim.x * gridDim.y * gridDim.z;
    unsigned sum, cnt, mine, sp = 0u;
    for (;;) {
        sum = 0u; cnt = 0u; mine = 0u;
#pragma unroll
        for (unsigned j = 0; j < 16; ++j) { const unsigned c = xb_ld(&bar[XB_XCNT(j)]); sum += c; cnt += (c > 0u) ? 1u : 0u; mine = (j == x) ? c : mine; }
        if (sum == G) break;
        __builtin_amdgcn_s_sleep(1);
        if ((++sp & 255u) == 0u) { if (xb_ld(&bar[XB_TMO])) break; if (sp > XB_SPIN_CAP) { xb_add(&bar[XB_TMO], 1u); break; } }
    }
    nloc = mine > 0u ? mine : 1u; nx = cnt > 0u ? cnt : 1u;
}

__device__ __forceinline__ void xcd_barrier(const XcdBarrier& b) {
    asm volatile("s_waitcnt vmcnt(0)" ::: "memory");
    __syncthreads();
    if (b.wv == 0u && lane_id() == 0) {
        unsigned* bar = b.bar;
        __builtin_amdgcn_s_waitcnt(0);
        unsigned nloc = b.st[0], nx = b.st[1];
        if (nloc == 0u) { xcd_barrier_complete(bar, b.x, nloc, nx); b.st[0] = nloc; b.st[1] = nx; }
        const unsigned old = xb_add(&bar[XB_XSUB(b.x)], 1u);
        const unsigned gen = old / nloc;
        if (old + 1u == (gen + 1u) * nloc) {
            __builtin_amdgcn_fence(__ATOMIC_RELEASE, "agent");
            asm volatile("s_waitcnt vmcnt(0)" ::: "memory");
            const unsigned og = xb_add(&bar[XB_TOP], 1u);
            const unsigned tg = og / nx;
            if (og + 1u == (tg + 1u) * nx) xb_add(&bar[XB_TOPGEN], 1u);
            else XB_SPIN(xb_ld(&bar[XB_TOPGEN]) == tg, bar);
            __builtin_amdgcn_fence(__ATOMIC_ACQUIRE, "agent");
            xb_add(&bar[XB_XGEN(b.x)], 1u);
            asm volatile("s_waitcnt vmcnt(0)" ::: "memory");
        } else {
            XB_SPIN(xb_ld(&bar[XB_XGEN(b.x)]) == gen, bar);
            __builtin_amdgcn_fence(__ATOMIC_ACQUIRE, "agent");
            asm volatile("s_waitcnt vmcnt(0)" ::: "memory");
        }
    }
    __syncthreads();
}

typedef unsigned short bf16_t;
typedef short bf16x8 __attribute__((ext_vector_type(8)));
typedef float f32x4 __attribute__((ext_vector_type(4)));
typedef float f32x16 __attribute__((ext_vector_type(16)));
typedef unsigned u32x4 __attribute__((ext_vector_type(4)));
typedef unsigned u32x2 __attribute__((ext_vector_type(2)));

constexpr int D = 1024, NB = 16, SEQ = 2048, CTX = 256, NL = 4;
constexpr int TL = NB * SEQ, TC = NB * CTX, TT = TL + TC;
constexpr int DIN = 6144, HYW = 512, NE = 16, DE = 512, KEYS = CTX + SEQ;
constexpr int NMOD = 6, NBM = NB + 1;
constexpr int APROWS = 2 * TT + NE * 256;
constexpr float EPS = 1e-6f, LOG2E = 1.4426950408889634f;
constexpr float QSCALE = 0.125f * LOG2E;

constexpr size_t MiB = 1u << 20;
constexpr size_t WS_CTL = 0, CTL_ZERO_BYTES = 1 * MiB;
constexpr size_t WS_MOD = 1 * MiB;
constexpr size_t WS_ROPE = 3 * MiB;
constexpr size_t WS_FL = 4 * MiB, WS_FC = 20 * MiB;
constexpr size_t WS_MISC = 22 * MiB;
constexpr size_t WS_FNORM = WS_MISC;
constexpr size_t WS_TOKE = WS_MISC + 64 * 1024, WS_TOKP = WS_MISC + 352 * 1024, WS_TOKW = WS_MISC + 640 * 1024;
constexpr size_t WS_ROWMAP = WS_MISC + 960 * 1024, WS_ROWW = WS_MISC + 1280 * 1024;
constexpr size_t WS_WIN = 24 * MiB, WS_WBR = 36 * MiB, WS_WOUT = 39 * MiB;
constexpr size_t WS_XC = 41 * MiB;
constexpr size_t WS_NP = WS_XC;
constexpr size_t WS_H = 57 * MiB;
constexpr size_t WS_KA = 129 * MiB, WS_VTA = 138 * MiB, WS_KW = 147 * MiB, WS_VTW = 156 * MiB;
constexpr size_t WS_QA = 165 * MiB, WS_QW = 201 * MiB, WS_YH = 237 * MiB, WS_VT = 273 * MiB, WS_YT = 309 * MiB;
constexpr size_t WS_RAWA = 309 * MiB, WS_RAWW = 327 * MiB;
constexpr size_t WS_F = 165 * MiB;
constexpr size_t WS_U = 345 * MiB;
constexpr size_t WS_G = 453 * MiB;
constexpr size_t WS_W13 = 605 * MiB, WS_W2 = 637 * MiB;
constexpr size_t WS_EROW = 669 * MiB, WS_EROWW = 672 * MiB;
constexpr size_t WS_H8 = 675 * MiB;
constexpr size_t WS_WG8 = WS_WIN;
constexpr size_t WS_END = 711 * MiB;
static_assert(WS_G + (size_t)APROWS * 2048 <= WS_W13 && WS_W2 + (size_t)16 * 1024 * 512 * 2 <= WS_END && WS_G + (size_t)TT * 3072 * 2 <= WS_END, "ws map");
static_assert(WS_U + (size_t)APROWS * 1024 <= WS_G && WS_F + (size_t)2 * TT * 2048 <= WS_YT, "ws map 2");
constexpr size_t VT_CTX_OFF = (size_t)HYW * NB * SEQ;

constexpr int CW_BAR = 4096, CW_CNT = 8192, CW_PANEL = 16384, CW_HTMO = 12288;
constexpr int LDS_BYTES = 151552, MISC_OFF = 147456;
constexpr int NWAVES = 8, NTHR = 512;

struct Args { const float* in[29]; float* out; unsigned char* ws; int ph_lo, ph_hi; };
enum { I_X = 0, I_C, I_CTX, I_CCTX, I_ADAW, I_ADAB, I_N1G, I_N2G, I_WIN, I_QKG, I_HSW, I_HSB, I_HW1, I_HB1, I_HFR, I_HW2, I_HB2, I_HW3, I_HBIAS, I_SINK, I_WBR, I_WOUT,
       I_RGW, I_RGB, I_REW, I_REB, I_EW1, I_EW3, I_EW2 };

#define LDS_WAIT() asm volatile("s_waitcnt lgkmcnt(0)" ::: "memory")
#define VM_WAIT() asm volatile("s_waitcnt vmcnt(0)" ::: "memory")

typedef float f32x2_t __attribute__((ext_vector_type(2)));
typedef __bf16 bf16x2_t __attribute__((ext_vector_type(2)));
__device__ __forceinline__ unsigned cvtpk(float lo, float hi) { f32x2_t v = {lo, hi}; bf16x2_t b = __builtin_convertvector(v, bf16x2_t); return __builtin_bit_cast(unsigned, b); }
__device__ __forceinline__ unsigned zero_u32() { unsigned z; asm volatile("v_mov_b32 %0, 0" : "=v"(z)); return z; }
__device__ __forceinline__ unsigned cvt4_fp8(float a, float b, float c, float d) { int r = __builtin_amdgcn_cvt_pk_fp8_f32(a, b, 0, false); r = __builtin_amdgcn_cvt_pk_fp8_f32(c, d, r, true); return (unsigned)r; }
__device__ __forceinline__ float bflo(unsigned u) { return __builtin_bit_cast(float, u << 16); }
__device__ __forceinline__ float bfhi(unsigned u) { return __builtin_bit_cast(float, u & 0xffff0000u); }
__device__ __forceinline__ float bf1(bf16_t u) { return __builtin_bit_cast(float, (unsigned)u << 16); }
__device__ __forceinline__ bf16_t f2bf(float f) { return (bf16_t)(cvtpk(f, 0.f) & 0xffffu); }
#define DPP_F(v, ctrl) __builtin_bit_cast(float, __builtin_amdgcn_update_dpp(0, __builtin_bit_cast(int, (v)), (ctrl), 0xf, 0xf, false))
__device__ __forceinline__ float row16_sum(float v) {
    v += DPP_F(v, 0xB1);
    v += DPP_F(v, 0x4E);
    v += DPP_F(v, 0x141);
    v += DPP_F(v, 0x140);
    return v;
}
__device__ __forceinline__ float wave_sum(float v) {
    v = row16_sum(v);
    const int iv = __builtin_bit_cast(int, v);
    float r = (__builtin_bit_cast(float, __builtin_amdgcn_readlane(iv, 0)) + __builtin_bit_cast(float, __builtin_amdgcn_readlane(iv, 16)))
            + (__builtin_bit_cast(float, __builtin_amdgcn_readlane(iv, 32)) + __builtin_bit_cast(float, __builtin_amdgcn_readlane(iv, 48)));
    asm volatile("" : "+v"(r));
    return r;
}
__device__ __forceinline__ float fast_exp2(float x) { return __builtin_amdgcn_exp2f(x); }
__device__ __forceinline__ float fast_rcp(float x) { return __builtin_amdgcn_rcpf(x); }
__device__ __forceinline__ float sigmoid_f(float x) { return fast_rcp(1.f + fast_exp2(-x * LOG2E)); }

__device__ __forceinline__ void sincos_acc(float x, float& s, float& c) {
    const float q = rintf(x * 0.636619772367581f);
    float y = fmaf(-q, 1.57079625129699707031f, x);
    y = fmaf(-q, 7.54978941586159635335e-08f, y);
    const float y2 = y * y;
    float sp = fmaf(y2, 2.7557314297e-06f, -1.9841270114e-04f); sp = fmaf(sp, y2, 8.3333337680e-03f); sp = fmaf(sp, y2, -1.6666667163e-01f); sp = fmaf(sp * y2, y, y);
    float cp = fmaf(y2, -2.7557314297e-07f, 2.4801587642e-05f); cp = fmaf(cp, y2, -1.3888889225e-03f); cp = fmaf(cp, y2, 4.1666667908e-02f); cp = fmaf(cp, y2, -0.5f); cp = fmaf(cp, y2, 1.0f);
    const int n = (int)q & 3;
    const float s1 = (n & 1) ? cp : sp, c1 = (n & 1) ? sp : cp;
    s = (n & 2) ? -s1 : s1;
    c = ((n + 1) & 2) ? -c1 : c1;
}

struct Fr { LAS unsigned char* lds; int tid, lane, wave, G, bid; };

__device__ __forceinline__ void pro_mod(const Fr& F, const Args& a) {
    LAS float* s = (LAS float*)F.lds;
    LAS float* red = (LAS float*)(F.lds + 69632);
    const float* c = a.in[I_C]; const float* cc = a.in[I_CCTX]; const float* W = a.in[I_ADAW]; const float* Bv = a.in[I_ADAB];
    float* MOD = (float*)(a.ws + WS_MOD);
    for (int i = F.tid; i < NBM * 1024; i += NTHR) { const int bb = i >> 10, k = i & 1023; const float v = (bb < NB) ? c[bb * 1024 + k] : cc[k]; s[i] = v / (1.f + __expf(-v)); }
    __syncthreads();
    const int col = F.tid & 63, ks = F.wave;
    for (int unit = F.G - 1 - F.bid; unit < NL * 96; unit += F.G) {
        const int l = unit / 96, j0 = (unit % 96) * 64;
        float acc[NBM];
#pragma unroll
        for (int bb = 0; bb < NBM; ++bb) acc[bb] = 0.f;
        const float* Wp = W + ((size_t)l * 1024 + ks * 128) * DIN + j0 + col;
#pragma unroll 2
        for (int k = 0; k < 128; k += 4) {
            const float w0 = Wp[(size_t)k * DIN], w1 = Wp[(size_t)(k + 1) * DIN], w2 = Wp[(size_t)(k + 2) * DIN], w3 = Wp[(size_t)(k + 3) * DIN];
#pragma unroll
            for (int bb = 0; bb < NBM; ++bb) { const f32x4 sv = *(const LAS f32x4*)(s + bb * 1024 + ks * 128 + k);
                acc[bb] = fmaf(sv.x, w0, acc[bb]); acc[bb] = fmaf(sv.y, w1, acc[bb]); acc[bb] = fmaf(sv.z, w2, acc[bb]); acc[bb] = fmaf(sv.w, w3, acc[bb]); } }
#pragma unroll
        for (int bb = 0; bb < NBM; ++bb) red[(ks * NBM + bb) * 64 + col] = acc[bb];
        __syncthreads();
        for (int o = F.tid; o < NBM * 64; o += NTHR) { const int bb = o >> 6, cx = o & 63; float sum = 0.f;
#pragma unroll
            for (int k2 = 0; k2 < 8; ++k2) sum += red[(k2 * NBM + bb) * 64 + cx];
            MOD[((size_t)l * NBM + bb) * DIN + j0 + cx] = sum + Bv[l * DIN + j0 + cx]; }
        __syncthreads();
    }
}

__device__ __forceinline__ void pro_rope(const Fr& F, const Args& a) {
    float* ct = (float*)(a.ws + WS_ROPE); float* st = ct + SEQ * 32;
    for (int i = F.bid * NTHR + F.tid; i < SEQ * 32; i += F.G * NTHR) {
        const int pos = i >> 5, ax = (i >> 4) & 1, f = i & 15;
        const float inv = exp2f(-(float)f * (13.287712379549449f / 16.f));
        const float ang = (float)(ax == 0 ? (pos >> 6) : (pos & 63)) * inv;
        float sv, cv; sincos_acc(ang, sv, cv); ct[i] = cv; st[i] = sv;
    }
}

__device__ __forceinline__ void pro_filter(const Fr& F, const Args& a) {
    LAS float* L = (LAS float*)F.lds;
    constexpr int oW1 = 0, oB1 = 2112, oFR = 2176, oB2 = 2240, oW2 = 2304, oZ = 6400, oH1 = 7552, oH2 = 9600, oW3 = 11648, oT = 19840;
    bf16_t* FL = (bf16_t*)(a.ws + WS_FL); bf16_t* FC = (bf16_t*)(a.ws + WS_FC); float* NP = (float*)(a.ws + WS_NP);
    const int p = F.tid >> 4, jj = F.tid & 15;
    for (int unit = F.bid; unit < NL * 72; unit += F.G) {
        const int l = unit / 72, ch = unit % 72; const bool lat = ch < 64; const int n = lat ? SEQ : CTX, pos0 = lat ? ch * 32 : (ch - 64) * 32;
        __syncthreads();
        for (int i = F.tid; i < 2112; i += NTHR) L[oW1 + i] = a.in[I_HW1][l * 2112 + i];
        for (int i = F.tid; i < 64; i += NTHR) { L[oB1 + i] = a.in[I_HB1][l * 64 + i]; L[oFR + i] = a.in[I_HFR][l * 64 + i]; L[oB2 + i] = a.in[I_HB2][l * 64 + i]; }
        for (int i = F.tid; i < 4096; i += NTHR) L[oW2 + i] = a.in[I_HW2][l * 4096 + i];
        const int pos = pos0 + p; const float t = (float)pos / (float)(n - 1);
        { const float band = 1e-4f + (float)jj * ((15.f - 1e-4f) / 15.f); const float ang = ((6.2831855f * band) * (float)pos) / (float)n;
          float sv, cv; sincos_acc(ang, sv, cv); L[oZ + p * 36 + 1 + jj] = cv; L[oZ + p * 36 + 17 + jj] = -sv; if (jj == 0) L[oZ + p * 36] = t; }
        __syncthreads();
        { f32x4 acc = *(const LAS f32x4*)(L + oB1 + 4 * jj);
#pragma unroll 3
          for (int i = 0; i < 33; ++i) { const float z = L[oZ + p * 36 + i]; const f32x4 w = *(const LAS f32x4*)(L + oW1 + i * 64 + 4 * jj); acc.x = fmaf(z, w.x, acc.x); acc.y = fmaf(z, w.y, acc.y); acc.z = fmaf(z, w.z, acc.z); acc.w = fmaf(z, w.w, acc.w); }
          const f32x4 fr = *(const LAS f32x4*)(L + oFR + 4 * jj); float sv, cv; f32x4 o;
          sincos_acc(fr.x * acc.x, sv, cv); o.x = sv; sincos_acc(fr.y * acc.y, sv, cv); o.y = sv; sincos_acc(fr.z * acc.z, sv, cv); o.z = sv; sincos_acc(fr.w * acc.w, sv, cv); o.w = sv;
          *(LAS f32x4*)(L + oH1 + p * 64 + 4 * jj) = o; }
        __syncthreads();
        { f32x4 acc = *(const LAS f32x4*)(L + oB2 + 4 * jj);
#pragma unroll 4
          for (int i = 0; i < 64; ++i) { const float z = L[oH1 + p * 64 + i]; const f32x4 w = *(const LAS f32x4*)(L + oW2 + i * 64 + 4 * jj); acc.x = fmaf(z, w.x, acc.x); acc.y = fmaf(z, w.y, acc.y); acc.z = fmaf(z, w.z, acc.z); acc.w = fmaf(z, w.w, acc.w); }
          const f32x4 fr = *(const LAS f32x4*)(L + oFR + 4 * jj); float sv, cv; f32x4 o;
          sincos_acc(fr.x * acc.x, sv, cv); o.x = sv; sincos_acc(fr.y * acc.y, sv, cv); o.y = sv; sincos_acc(fr.z * acc.z, sv, cv); o.z = sv; sincos_acc(fr.w * acc.w, sv, cv); o.w = sv;
          *(LAS f32x4*)(L + oH2 + p * 64 + 4 * jj) = o; }
        LAS bf16_t* T = (LAS bf16_t*)(L + oT);
#pragma unroll 1
        for (int mh = 0; mh < 1; ++mh) {
            f32x4 acc[16];
#pragma unroll
            for (int m = 0; m < 16; ++m) acc[m] = (f32x4){0.f, 0.f, 0.f, 0.f};
#pragma unroll 1
            for (int kc = 0; kc < 8; ++kc) {
                __syncthreads();
                for (int i = F.tid; i < 2048; i += NTHR) *(LAS f32x4*)(L + oW3 + i * 4) = *(const f32x4*)(a.in[I_HW3] + ((size_t)l * 64 + kc * 8) * 1024 + i * 4);
                __syncthreads();
#pragma unroll 1
                for (int k = 0; k < 8; ++k) { const float h = L[oH2 + p * 64 + kc * 8 + k];
#pragma unroll
                    for (int m = 0; m < 16; ++m) { const f32x4 w = *(const LAS f32x4*)(L + oW3 + k * 1024 + 64 * m + 4 * jj);
                        acc[m].x = fmaf(h, w.x, acc[m].x); acc[m].y = fmaf(h, w.y, acc[m].y); acc[m].z = fmaf(h, w.z, acc[m].z); acc[m].w = fmaf(h, w.w, acc[m].w); } }
            }
#pragma unroll
            for (int m = 0; m < 16; ++m) {
                const int colb = 64 * m + 4 * jj; const int dirb = m >> 3;
                const float v4[4] = {acc[m].x, acc[m].y, acc[m].z, acc[m].w};
#pragma unroll
                for (int e = 0; e < 4; ++e) { const int col = colb + e, c = col & 511;
                    const float dl = fabsf(-3.0701134573253943f + (-15.350567286626972f + 3.0701134573253943f) * ((float)c / 511.f));
                    float v = v4[e] * __expf(-t * dl); if (dirb == 1 && pos == 0) v = 0.f;
                    T[col * 32 + (dirb == 0 ? 31 - p : p)] = f2bf(v); }
            }
        }
        __syncthreads();
        for (int idx = F.tid; idx < 1024 * 32; idx += NTHR) { const int col = idx >> 5, i = idx & 31, dir = col >> 9, c = col & 511;
            const int u = (dir == 0) ? (n - 32 - pos0 + i) : ((pos0 + i == 0) ? 2 * n - 1 : n - 1 + pos0 + i);
            bf16_t* Fb = lat ? FL + ((size_t)l * 512 + c) * 4096 : FC + ((size_t)l * 512 + c) * 512;
            Fb[u] = T[col * 32 + i]; }
        for (int col = F.tid; col < 1024; col += NTHR) { float sum = 0.f;
#pragma unroll 8
            for (int i = 0; i < 32; ++i) sum += fabsf(bf1(T[col * 32 + i]));
            NP[((size_t)l * 72 + ch) * 1024 + col] = sum; }
    }
    __syncthreads();
}
__device__ __forceinline__ void filter_norm_reduce(const Fr& F, const Args& a) {
    const float* NP = (const float*)(a.ws + WS_NP); float* FN = (float*)(a.ws + WS_FNORM);
    for (int o = F.bid * NTHR + F.tid; o < NL * 2 * 512; o += F.G * NTHR) { const int l = o >> 10, isc = (o >> 9) & 1, c = o & 511;
        const int ch0 = isc ? 64 : 0, ch1 = isc ? 72 : 64; float sum = 0.f;
        for (int ch = ch0; ch < ch1; ++ch) sum += NP[((size_t)l * 72 + ch) * 1024 + c] + NP[((size_t)l * 72 + ch) * 1024 + 512 + c];
        FN[o] = 1.f / sum; }
}

template <int MODE>
__device__ __forceinline__ void transpose_item(const float* W, int K, int N, bf16_t* WT, int row_off, LAS float* scr, int item, int lane, int ldk = 0) {
    if (ldk == 0) ldk = K;
    const int nblk = N / 64, kb = item / nblk, nb = item % nblk, k0 = 64 * kb, n0 = 64 * nb;
    f32x4 v[16];
#pragma unroll
    for (int i = 0; i < 16; ++i) v[i] = *(const f32x4*)(W + (size_t)(k0 + 4 * i + (lane >> 4)) * N + n0 + (lane & 15) * 4);
#pragma unroll
    for (int i = 0; i < 16; ++i) *(LAS f32x4*)(scr + (4 * i + (lane >> 4)) * 68 + (lane & 15) * 4) = v[i];
    LDS_WAIT();
    const int c = lane & 7;
#pragma unroll
    for (int j = 0; j < 8; ++j) { const int n = (lane >> 3) + 8 * j; const LAS float* s = scr + (8 * c) * 68 + n;
        u32x4 o; o.x = cvtpk(s[0 * 68], s[1 * 68]); o.y = cvtpk(s[2 * 68], s[3 * 68]); o.z = cvtpk(s[4 * 68], s[5 * 68]); o.w = cvtpk(s[6 * 68], s[7 * 68]);
        const int nn = n0 + n; const int row = (MODE == 0) ? nn : ((nn >> 2) * 8 + (nn & 3) + (MODE == 2 ? 4 : 0));
        *(u32x4*)(WT + (size_t)(row_off + row) * ldk + k0 + 8 * c) = o; }
    LDS_WAIT();
}

template <int MODE>
__device__ __forceinline__ void transpose_item_f8(const float* W, int K, int N, unsigned char* WT, int row_off, LAS float* scr, int item, int lane, int ldk = 0) {
    if (ldk == 0) ldk = K;
    const int nblk = N / 64, kb = item / nblk, nb = item % nblk, k0 = 64 * kb, n0 = 64 * nb;
    f32x4 v[16];
#pragma unroll
    for (int i = 0; i < 16; ++i) v[i] = *(const f32x4*)(W + (size_t)(k0 + 4 * i + (lane >> 4)) * N + n0 + (lane & 15) * 4);
#pragma unroll
    for (int i = 0; i < 16; ++i) *(LAS f32x4*)(scr + (4 * i + (lane >> 4)) * 68 + (lane & 15) * 4) = v[i];
    LDS_WAIT();
    const int c = lane & 7;
#pragma unroll
    for (int j = 0; j < 8; ++j) { const int n = (lane >> 3) + 8 * j; const LAS float* s = scr + (8 * c) * 68 + n;
        u32x2 o; o.x = cvt4_fp8(s[0 * 68] * 64.f, s[1 * 68] * 64.f, s[2 * 68] * 64.f, s[3 * 68] * 64.f); o.y = cvt4_fp8(s[4 * 68] * 64.f, s[5 * 68] * 64.f, s[6 * 68] * 64.f, s[7 * 68] * 64.f);
        const int nn = n0 + n; const int row = (MODE == 0) ? nn : ((nn >> 2) * 8 + (nn & 3) + (MODE == 2 ? 4 : 0));
        *(u32x2*)(WT + (size_t)(row_off + row) * ldk + k0 + 8 * c) = o; }
    LDS_WAIT();
}
__device__ __forceinline__ void conv_small_weights(const Fr& F, const Args& a, int l, int mask, int b0) {
    if (F.bid < b0) return;
    LAS float* scr = (LAS float*)(F.lds + F.wave * 17408);
    const int gw = (F.bid - b0) * NWAVES + F.wave, NGW = (F.G - b0) * NWAVES;
    constexpr int I_IN = (1024 / 64) * (DIN / 64), I_BR = (512 / 64) * (1024 / 64), I_OUT = (1024 / 64) * (1024 / 64);
    if (mask & 1) for (int it = gw; it < I_IN; it += NGW) transpose_item_f8<0>(a.in[I_WIN] + (size_t)l * 1024 * DIN, 1024, DIN, a.ws + WS_WG8, 0, scr, it, F.lane);
    if (mask & 2) for (int it = gw; it < 3 * I_BR; it += NGW) { const int b = it / I_BR; transpose_item<0>(a.in[I_WBR] + ((size_t)l * 3 + b) * 512 * 1024, 512, 1024, (bf16_t*)(a.ws + WS_WBR) + b * 512, 0, scr, it % I_BR, F.lane, 1536); }
    if (mask & 4) for (int it = gw; it < I_OUT; it += NGW) transpose_item<0>(a.in[I_WOUT] + (size_t)l * 1024 * 1024, 1024, 1024, (bf16_t*)(a.ws + WS_WOUT), 0, scr, it, F.lane);
}
__device__ __forceinline__ void conv_expert_weights(const Fr& F, const Args& a, int l, int b0, int it0, int it1) {
    if (F.bid < b0) return;
    LAS float* scr = (LAS float*)(F.lds + F.wave * 17408);
    const int gw = (F.bid - b0) * NWAVES + F.wave, NGW = (F.G - b0) * NWAVES;
    constexpr int I_1 = (1024 / 64) * (512 / 64), I_2 = (512 / 64) * (1024 / 64);
    for (int it = it0 + gw; it < it1; it += NGW) {
        const int e = it / (2 * I_1 + I_2); int r = it % (2 * I_1 + I_2);
        unsigned char* W13 = a.ws + WS_W13; unsigned char* W2 = a.ws + WS_W2;
        if (r < I_1) { transpose_item_f8<1>(a.in[I_EW1] + ((size_t)l * NE + e) * 1024 * 512, 1024, 512, W13, e * 1024, scr, r, F.lane); continue; } r -= I_1;
        if (r < I_1) { transpose_item_f8<2>(a.in[I_EW3] + ((size_t)l * NE + e) * 1024 * 512, 1024, 512, W13, e * 1024, scr, r, F.lane); continue; } r -= I_1;
        transpose_item_f8<0>(a.in[I_EW2] + ((size_t)l * NE + e) * 512 * 1024, 512, 1024, W2, e * 1024, scr, r, F.lane);
    }
}
constexpr int CONV_E_ITEMS = NE * 384, CONV_E_SPLIT = CONV_E_ITEMS / 2;

__device__ __forceinline__ int mod_row(int row) { return row < TL ? (row >> 11) : NB; }

__device__ __forceinline__ void rows_p0(const Fr& F, const Args& a, int l, int nrows) {
    const int gw = F.bid * NWAVES + F.wave, NGW = F.G * NWAVES;
    const float* g1 = a.in[I_N1G] + l * 1024;
    const float* MODl = (const float*)(a.ws + WS_MOD) + (size_t)l * NBM * DIN;
    const float* MODp = (const float*)(a.ws + WS_MOD) + (size_t)(l > 0 ? l - 1 : 0) * NBM * DIN;
    const bf16_t* Fs = (const bf16_t*)(a.ws + WS_F);
    unsigned char* H8 = a.ws + WS_H8;
    const int per = 2 * ((nrows + 2 * NGW - 1) / (2 * NGW)), w0 = gw * per, w1 = (w0 + per < nrows) ? w0 + per : nrows;
    f32x4 gv[4], shv[4], scv[4], m5v[4]; int cur = -1;
#pragma unroll
    for (int j = 0; j < 4; ++j) { gv[j] = *(const f32x4*)(g1 + F.lane * 4 + 256 * j); shv[j] = gv[j]; scv[j] = gv[j]; m5v[j] = gv[j]; }
#define P0_LOAD(rb, V, F0, F1) do { _Pragma("unroll") for (int q = 0; q < 2; ++q) { const int row = (rb) + q; const bool lat = row < TL; \
            const float* xs = lat ? ((l == 0) ? a.in[I_X] + (size_t)row * D : a.out + (size_t)row * D) : ((l == 0) ? a.in[I_CTX] + (size_t)(row - TL) * D : (const float*)(a.ws + WS_XC) + (size_t)(row - TL) * D); \
            _Pragma("unroll") for (int j = 0; j < 4; ++j) { const int col = F.lane * 4 + 256 * j; V[q][j] = *(const f32x4*)(xs + col); \
                if (l > 0) { F0[q][j] = *(const u32x2*)(Fs + (size_t)row * D + col); F1[q][j] = *(const u32x2*)(Fs + ((size_t)TT + row) * D + col); } } } } while (0)
#define P0_PROC(rb, V, F0, F1) do { _Pragma("unroll") for (int q = 0; q < 2; ++q) { const int row = (rb) + q; const bool lat = row < TL; const int mr = mod_row(row); \
            if (mr != cur) { cur = mr; _Pragma("unroll") for (int j = 0; j < 4; ++j) { const int col = F.lane * 4 + 256 * j; \
                shv[j] = *(const f32x4*)(MODl + (size_t)mr * DIN + col); scv[j] = *(const f32x4*)(MODl + (size_t)mr * DIN + 1024 + col); m5v[j] = *(const f32x4*)(MODp + (size_t)mr * DIN + 5 * 1024 + col); } } \
            float* xd = lat ? a.out + (size_t)row * D : (float*)(a.ws + WS_XC) + (size_t)(row - TL) * D; float ss = 0.f; \
            if (l > 0) { _Pragma("unroll") for (int j = 0; j < 4; ++j) { const int col = F.lane * 4 + 256 * j; \
                    V[q][j].x += m5v[j].x * (bflo(F0[q][j].x) + bflo(F1[q][j].x)); V[q][j].y += m5v[j].y * (bfhi(F0[q][j].x) + bfhi(F1[q][j].x)); \
                    V[q][j].z += m5v[j].z * (bflo(F0[q][j].y) + bflo(F1[q][j].y)); V[q][j].w += m5v[j].w * (bfhi(F0[q][j].y) + bfhi(F1[q][j].y)); \
                    *(f32x4*)(xd + col) = V[q][j]; } } \
            _Pragma("unroll") for (int j = 0; j < 4; ++j) ss += (V[q][j].x * V[q][j].x + V[q][j].y * V[q][j].y) + (V[q][j].z * V[q][j].z + V[q][j].w * V[q][j].w); \
            const float r = 1.f / sqrtf(wave_sum(ss) * (1.f / D) + EPS); \
            _Pragma("unroll") for (int j = 0; j < 4; ++j) { const int col = F.lane * 4 + 256 * j; \
                const f32x4 o = (V[q][j] * r * gv[j]) * (scv[j] + 1.f) + shv[j]; \
                *(unsigned*)(H8 + (size_t)row * D + col) = cvt4_fp8(o.x, o.y, o.z, o.w); } } } while (0)
    f32x4 vA[2][4], vB[2][4]; u32x2 fA0[2][4], fA1[2][4], fB0[2][4], fB1[2][4];
    if (w0 < w1) P0_LOAD(w0, vA, fA0, fA1);
    for (int rb = w0; rb < w1; rb += 4) {
        if (rb + 2 < w1) P0_LOAD(rb + 2, vB, fB0, fB1);
        P0_PROC(rb, vA, fA0, fA1);
        if (rb + 2 < w1) { if (rb + 4 < w1) P0_LOAD(rb + 4, vA, fA0, fA1); P0_PROC(rb + 2, vB, fB0, fB1); }
    }
#undef P0_LOAD
#undef P0_PROC
}
__device__ __forceinline__ void rows_final(const Fr& F, const Args& a) {
    const int gw = F.bid * NWAVES + F.wave, NGW = F.G * NWAVES;
    const float* MODp = (const float*)(a.ws + WS_MOD) + (size_t)(NL - 1) * NBM * DIN;
    const bf16_t* Fs = (const bf16_t*)(a.ws + WS_F);
    for (int row = gw; row < TL; row += NGW) {
        const int mr = row >> 11; float* xd = a.out + (size_t)row * D;
#pragma unroll
        for (int j = 0; j < 4; ++j) { const int col = F.lane * 4 + 256 * j;
            f32x4 v = *(const f32x4*)(xd + col);
            const u32x2 f0 = *(const u32x2*)(Fs + (size_t)row * D + col), f1 = *(const u32x2*)(Fs + ((size_t)TT + row) * D + col);
            const f32x4 m5 = *(const f32x4*)(MODp + (size_t)mr * DIN + 5 * 1024 + col);
            v.x += m5.x * (bflo(f0.x) + bflo(f1.x)); v.y += m5.y * (bfhi(f0.x) + bfhi(f1.x)); v.z += m5.z * (bflo(f0.y) + bflo(f1.y)); v.w += m5.w * (bfhi(f0.y) + bfhi(f1.y));
            *(f32x4*)(xd + col) = v; }
    }
}

__device__ __forceinline__ void rows_p5(const Fr& F, const Args& a, int l, int nrows, unsigned long long& sacc, const int swhich) {
#if defined(PROBE_P)
    unsigned long long st0 = __builtin_amdgcn_s_memrealtime();
#define SUBMARK5(w) do { const unsigned long long t_ = __builtin_amdgcn_s_memrealtime(); if (swhich == (w)) sacc += t_ - st0; st0 = t_; } while (0)
#else
#define SUBMARK5(w) do { } while (0)
#endif
    typedef float f32x4v __attribute__((ext_vector_type(4)));
    LAS float* RW = (LAS float*)F.lds;
    constexpr int RWS = 1028;
    LAS float* RB = (LAS float*)(F.lds + 82304);
    LAS int* LC = (LAS int*)(F.lds + 82432);
    LAS int* TE = (LAS int*)(F.lds + 82560);
    LAS int* TP = TE + 256;
    LAS float* TW = (LAS float*)(TP + 256);
    LAS float* RN = (LAS float*)(F.lds + 86784);
    LAS float* LG = (LAS float*)(F.lds + 87424);
    LAS float* GM = (LAS float*)(F.lds + 99072);
    LAS float* BI = (LAS float*)(F.lds + 107264);
    const float* g2 = a.in[I_N2G] + l * 1024;
    const float* MODl = (const float*)(a.ws + WS_MOD) + (size_t)l * NBM * DIN;
    unsigned char* H8 = a.ws + WS_H;
    int* EROW = (int*)(a.ws + WS_EROW); float* EROWW = (float*)(a.ws + WS_EROWW);
    unsigned* CNT = (unsigned*)(a.ws + WS_CTL) + CW_CNT + l * 256;
    for (int f = F.tid; f < 1024; f += NTHR) { const f32x4 v = *(const f32x4*)(a.in[I_RGW] + ((size_t)l * 1024 + f) * 4);
        RW[0 * RWS + f] = v.x; RW[1 * RWS + f] = v.y; RW[2 * RWS + f] = v.z; RW[3 * RWS + f] = v.w; }
    for (int f = F.tid; f < 4096; f += NTHR) { const int k = f >> 2, c4 = (f & 3) * 4; const f32x4 v = *(const f32x4*)(a.in[I_REW] + ((size_t)l * 1024 + k) * 16 + c4);
        RW[(4 + c4) * RWS + k] = v.x; RW[(5 + c4) * RWS + k] = v.y; RW[(6 + c4) * RWS + k] = v.z; RW[(7 + c4) * RWS + k] = v.w; }
    if (F.tid < 20) RB[F.tid] = (F.tid < 4) ? a.in[I_RGB][l * 4 + F.tid] : a.in[I_REB][l * 16 + F.tid - 4];
    constexpr int P5_CH = 144;
    const int nch = (nrows + P5_CH - 1) / P5_CH;
    SUBMARK5(40);
    for (int ch = F.bid; ch < nch; ch += F.G) {
    const int r0 = ch * P5_CH, r1 = (r0 + P5_CH < nrows) ? r0 + P5_CH : nrows;
    const int mb0 = mod_row(r0), mb1 = mod_row(r1 - 1);
    if (F.tid < 32) LC[F.tid] = 0;
    for (int i = F.tid; i < 2048; i += NTHR) { const int s = i >> 10, k = i & 1023; GM[i] = g2[k] * (1.f + MODl[(size_t)(s ? mb1 : mb0) * DIN + 4 * 1024 + k]); }
    __syncthreads();
    if (F.wave < 4) {
    for (int rowb = r0 + 2 * F.wave; rowb < r1; rowb += 2 * 4) {
        f32x4 v[2][4]; bool val[2];
#pragma unroll
        for (int q = 0; q < 2; ++q) { const int row = rowb + q; val[q] = row < r1; const int rr = val[q] ? row : rowb;
            const bool lat = rr < TL; const float* xs = lat ? a.out + (size_t)rr * D : (const float*)(a.ws + WS_XC) + (size_t)(rr - TL) * D;
#pragma unroll
            for (int j = 0; j < 4; ++j) v[q][j] = *(const f32x4*)(xs + F.lane * 4 + 256 * j); }
#pragma unroll
        for (int q = 0; q < 2; ++q) { const int rr = val[q] ? rowb + q : rowb; const int mr = mod_row(rr); float ss = 0.f;
#pragma unroll
            for (int j = 0; j < 4; ++j) ss += (v[q][j].x * v[q][j].x + v[q][j].y * v[q][j].y) + (v[q][j].z * v[q][j].z + v[q][j].w * v[q][j].w);
            const float r = 1.f / sqrtf(wave_sum(ss) * (1.f / D) + EPS);
            if (F.lane == 0 && val[q]) RN[rr - r0] = r;
#pragma unroll
            for (int j = 0; j < 4; ++j) { const int col = F.lane * 4 + 256 * j;
                const f32x4 g = *(const f32x4*)(g2 + col), sh = *(const f32x4*)(MODl + (size_t)mr * DIN + 3 * 1024 + col), sc = *(const f32x4*)(MODl + (size_t)mr * DIN + 4 * 1024 + col);
                const f32x4 t = (v[q][j] * r * g) * (sc + 1.f) + sh;
                if (val[q]) *(unsigned*)(H8 + (size_t)rr * D + col) = cvt4_fp8(t.x, t.y, t.z, t.w); } }
    }
    } else {
    if (F.wave < 6) { const int sl = F.wave - 4; const int mb = sl ? mb1 : mb0; f32x4 sh[4];
#pragma unroll
        for (int j = 0; j < 4; ++j) sh[j] = *(const f32x4*)(MODl + (size_t)mb * DIN + 3 * 1024 + F.lane * 4 + 256 * j);
#pragma unroll 4
        for (int cidx = 0; cidx < 20; ++cidx) { float p = 0.f;
#pragma unroll
            for (int j = 0; j < 4; ++j) { const f32x4 w = *(const LAS f32x4*)(RW + cidx * RWS + F.lane * 4 + 256 * j);
                p = fmaf(sh[j].x, w.x, p); p = fmaf(sh[j].y, w.y, p); p = fmaf(sh[j].z, w.z, p); p = fmaf(sh[j].w, w.w, p); }
            const float tot = wave_sum(p) + RB[cidx]; if (F.lane == 0) BI[sl * 20 + cidx] = tot; } }
    { const int i16 = F.lane & 15, kq = F.lane >> 4; const int ngrp = (r1 - r0 + 15) >> 4;
      for (int gi = F.wave - 4; gi < ngrp; gi += 4) {
        const int grow = r0 + 16 * gi; const int rowi = (grow + i16 < r1) ? grow + i16 : r1 - 1;
        const bool lat = rowi < TL; const float* xs = (lat ? a.out + (size_t)rowi * D : (const float*)(a.ws + WS_XC) + (size_t)(rowi - TL) * D) + 4 * kq;
        const int slot = (mod_row(grow) == mb0) ? 0 : 1;
        const LAS float* gmp = GM + slot * 1024 + 4 * kq; const LAS float* w0p = RW + i16 * RWS + 4 * kq; const LAS float* w1p = RW + (16 + (i16 & 3)) * RWS + 4 * kq;
        const float m1 = (i16 < 4) ? 1.f : 0.f;
        f32x4v acc0 = {0.f, 0.f, 0.f, 0.f}, acc1 = {0.f, 0.f, 0.f, 0.f};
#pragma unroll 16
        for (int s = 0; s < 64; ++s) {
            const f32x4 xv = *(const f32x4*)(xs + 16 * s); const f32x4 gv = *(const LAS f32x4*)(gmp + 16 * s);
            const f32x4 wa = *(const LAS f32x4*)(w0p + 16 * s), wb = *(const LAS f32x4*)(w1p + 16 * s);
            const f32x4 ba = wa * gv, bb = wb * gv * m1;
            acc0 = __builtin_amdgcn_mfma_f32_16x16x4f32(xv.x, ba.x, acc0, 0, 0, 0); acc1 = __builtin_amdgcn_mfma_f32_16x16x4f32(xv.x, bb.x, acc1, 0, 0, 0);
            acc0 = __builtin_amdgcn_mfma_f32_16x16x4f32(xv.y, ba.y, acc0, 0, 0, 0); acc1 = __builtin_amdgcn_mfma_f32_16x16x4f32(xv.y, bb.y, acc1, 0, 0, 0);
            acc0 = __builtin_amdgcn_mfma_f32_16x16x4f32(xv.z, ba.z, acc0, 0, 0, 0); acc1 = __builtin_amdgcn_mfma_f32_16x16x4f32(xv.z, bb.z, acc1, 0, 0, 0);
            acc0 = __builtin_amdgcn_mfma_f32_16x16x4f32(xv.w, ba.w, acc0, 0, 0, 0); acc1 = __builtin_amdgcn_mfma_f32_16x16x4f32(xv.w, bb.w, acc1, 0, 0, 0);
        }
#pragma unroll
        for (int rg = 0; rg < 4; ++rg) { const int lr = 16 * gi + 4 * kq + rg;
            if (r0 + lr < r1) { LG[lr * 20 + i16] = acc0[rg]; if (i16 < 4) LG[lr * 20 + 16 + i16] = acc1[rg]; } }
      } }
    }
    __syncthreads();
    SUBMARK5(42);
    for (int lr = F.tid; lr < r1 - r0; lr += NTHR) {
        float lg[20]; { const float rn = RN[lr]; const int sl = (mod_row(r0 + lr) == mb0) ? 0 : 1;
#pragma unroll
          for (int i = 0; i < 20; ++i) lg[i] = rn * LG[lr * 20 + i] + BI[sl * 20 + i]; }
        int gs = 0; float gmx = lg[0];
#pragma unroll
        for (int i = 1; i < 4; ++i) if (lg[i] > gmx) { gmx = lg[i]; gs = i; }
        float gsum = 0.f;
#pragma unroll
        for (int i = 0; i < 4; ++i) gsum += __expf(lg[i] - gmx);
        const float pg = 1.f / gsum;
        float le[4];
#pragma unroll
        for (int i = 0; i < 4; ++i) le[i] = (gs == 0) ? lg[4 + i] : (gs == 1) ? lg[8 + i] : (gs == 2) ? lg[12 + i] : lg[16 + i];
        int i0 = 0; float v0 = le[0];
#pragma unroll
        for (int i = 1; i < 4; ++i) if (le[i] > v0) { v0 = le[i]; i0 = i; }
        int i1 = -1; float v1 = -3.4e38f;
#pragma unroll
        for (int i = 0; i < 4; ++i) if (i != i0 && le[i] > v1) { v1 = le[i]; i1 = i; }
        const float e1 = __expf(v1 - v0), den = 1.f / (1.f + e1);
        const int ex0 = gs * 4 + i0, ex1 = gs * 4 + i1;
        const int lp0 = __hip_atomic_fetch_add(&LC[ex0], 1, __ATOMIC_RELAXED, __HIP_MEMORY_SCOPE_WORKGROUP), lp1 = __hip_atomic_fetch_add(&LC[ex1], 1, __ATOMIC_RELAXED, __HIP_MEMORY_SCOPE_WORKGROUP);
        TE[lr] = ex0 | (ex1 << 8); TP[lr] = lp0 | (lp1 << 16); TW[2 * lr] = den * pg; TW[2 * lr + 1] = e1 * den * pg;
    }
    __syncthreads();
    if (F.tid < NE) LC[16 + F.tid] = (int)atomicAdd(&CNT[F.tid * 16], (unsigned)LC[F.tid]);
    __syncthreads();
    for (int lr = F.tid; lr < r1 - r0; lr += NTHR) {
        const int te = TE[lr], tp = TP[lr], ex0 = te & 255, ex1 = te >> 8, row = r0 + lr;
        const int gp0 = LC[16 + ex0] + (tp & 0xffff), gp1 = LC[16 + ex1] + (tp >> 16);
        EROW[(size_t)ex0 * TT + gp0] = row * 2; EROWW[(size_t)ex0 * TT + gp0] = TW[2 * lr];
        EROW[(size_t)ex1 * TT + gp1] = row * 2 + 1; EROWW[(size_t)ex1 * TT + gp1] = TW[2 * lr + 1];
    }
    __syncthreads();
    SUBMARK5(43);
    }
    __syncthreads();
#undef SUBMARK5
}

__device__ __forceinline__ void normrope8(float (&x)[8], const float* g64, bool rope, int pos, const float* ct, const float* st, float scale, int lane) {
    float ss = 0.f;
#pragma unroll
    for (int i = 0; i < 8; ++i) ss += x[i] * x[i];
    ss += DPP_F(ss, 0xB1); ss += DPP_F(ss, 0x4E); ss += DPP_F(ss, 0x141);
    const float r = 1.f / sqrtf(ss * (1.f / 64.f) + EPS);
    const int ch = lane & 7;
    const f32x4 g0 = *(const f32x4*)(g64 + 8 * ch), g1 = *(const f32x4*)(g64 + 8 * ch + 4);
    x[0] *= r * g0.x; x[1] *= r * g0.y; x[2] *= r * g0.z; x[3] *= r * g0.w; x[4] *= r * g1.x; x[5] *= r * g1.y; x[6] *= r * g1.z; x[7] *= r * g1.w;
    if (rope) {
        const int ax = ch >> 2, half = (ch >> 1) & 1, f0 = 8 * (ch & 1);
        const f32x4 c0 = *(const f32x4*)(ct + pos * 32 + ax * 16 + f0), c1 = *(const f32x4*)(ct + pos * 32 + ax * 16 + f0 + 4);
        const f32x4 s0 = *(const f32x4*)(st + pos * 32 + ax * 16 + f0), s1 = *(const f32x4*)(st + pos * 32 + ax * 16 + f0 + 4);
        const float cs[8] = {c0.x, c0.y, c0.z, c0.w, c1.x, c1.y, c1.z, c1.w}, sn[8] = {s0.x, s0.y, s0.z, s0.w, s1.x, s1.y, s1.z, s1.w};
#pragma unroll
        for (int i = 0; i < 8; ++i) { const float p = DPP_F(x[i], 0x4E);
            x[i] = half ? (x[i] * cs[i] + p * sn[i]) : (x[i] * cs[i] - p * sn[i]); }
    }
#pragma unroll
    for (int i = 0; i < 8; ++i) x[i] *= scale;
}
__device__ __forceinline__ void unpack8(const u32x4 w, float (&x)[8]) { x[0] = bflo(w.x); x[1] = bfhi(w.x); x[2] = bflo(w.y); x[3] = bfhi(w.y); x[4] = bflo(w.z); x[5] = bfhi(w.z); x[6] = bflo(w.w); x[7] = bfhi(w.w); }
__device__ __forceinline__ u32x4 pack8(const float (&x)[8]) { u32x4 w; w.x = cvtpk(x[0], x[1]); w.y = cvtpk(x[2], x[3]); w.z = cvtpk(x[4], x[5]); w.w = cvtpk(x[6], x[7]); return w; }

__device__ __forceinline__ void prep_phase(const Fr& F, const Args& a, int l, bool with_ctx) {
    constexpr int VROW = 272;
    LAS unsigned char* VA_l = F.lds;
    LAS unsigned char* VW_l = F.lds + 17408;
    LAS unsigned char* HT_l = F.lds + 34816;
    constexpr int HROW = 144;
    const float* ct = (const float*)(a.ws + WS_ROPE); const float* st = ct + SEQ * 32;
    const float* qkg = a.in[I_QKG] + l * 256;
    const bf16_t* RAWA = (const bf16_t*)(a.ws + WS_RAWA); const bf16_t* RAWW = (const bf16_t*)(a.ws + WS_RAWW);
    bf16_t* KA = (bf16_t*)(a.ws + WS_KA); bf16_t* KW = (bf16_t*)(a.ws + WS_KW); bf16_t* VTA = (bf16_t*)(a.ws + WS_VTA); bf16_t* VTW = (bf16_t*)(a.ws + WS_VTW);
    const bf16_t* U = (const bf16_t*)(a.ws + WS_U); bf16_t* X0 = (bf16_t*)(a.ws + WS_H); bf16_t* VT = (bf16_t*)(a.ws + WS_VT);
    const float* hsw = a.in[I_HSW] + l * 3 * 1536; const float* hsb = a.in[I_HSB] + l * 1536;
    for (int unit = F.bid; unit < NB * 36; unit += F.G) {
        const bool lat = unit < NB * 32;
        const int b = lat ? unit >> 5 : (unit - NB * 32) >> 2, p0 = lat ? (unit & 31) * 64 : ((unit - NB * 32) & 3) * 64;
        const int n = lat ? SEQ : CTX;
        const int row0 = lat ? b * SEQ + p0 : TL + b * CTX + p0;
        const int j0 = lat ? CTX + p0 : p0;
        __syncthreads();
        {
            const bool isw = (F.lane & 16) != 0; const int l16 = F.lane & 15, half = F.lane >> 5;
            u32x4 kw[4];
#pragma unroll
            for (int ps = 0; ps < 4; ++ps) { const int tk = 8 * F.wave + 2 * ps + half; kw[ps] = *(const u32x4*)((isw ? RAWW : RAWA) + (size_t)(row0 + tk) * 256 + l16 * 8); }
#pragma unroll
            for (int ps = 0; ps < 4; ++ps) { const int tk = 8 * F.wave + 2 * ps + half; float x[8]; unpack8(kw[ps], x);
                normrope8(x, qkg + (isw ? 192 : 64), lat, p0 + tk, ct, st, 1.f, F.lane);
                *(u32x4*)((isw ? KW : KA) + ((size_t)b * KEYS + j0 + tk) * 128 + l16 * 8) = pack8(x); }
        }
        for (int i = F.tid; i < 2 * 64 * 16; i += NTHR) { const int m = i >> 10, r = (i >> 4) & 63, cch = i & 15;
            const u32x4 w = *(const u32x4*)((m ? RAWW : RAWA) + (size_t)(row0 + r) * 256 + 128 + cch * 8);
            *(LAS u32x4*)((m ? VW_l : VA_l) + r * VROW + cch * 16) = w; }
        const bool do_hy = lat || with_ctx;
        if (do_hy) {
            const int cg = F.tid & 63, c = 8 * cg, t0 = 8 * F.wave;
            u32x4 x1p[8];
#pragma unroll
            for (int g = 0; g < 3; ++g) {
                const int ch = g * 512 + c;
                float w0[8], w1[8], w2[8], bb[8];
                { const f32x4 a0 = *(const f32x4*)(hsw + ch), a1 = *(const f32x4*)(hsw + ch + 4), b0 = *(const f32x4*)(hsw + 1536 + ch), b1 = *(const f32x4*)(hsw + 1536 + ch + 4),
                              c0 = *(const f32x4*)(hsw + 3072 + ch), c1 = *(const f32x4*)(hsw + 3072 + ch + 4), d0 = *(const f32x4*)(hsb + ch), d1 = *(const f32x4*)(hsb + ch + 4);
                  w0[0] = a0.x; w0[1] = a0.y; w0[2] = a0.z; w0[3] = a0.w; w0[4] = a1.x; w0[5] = a1.y; w0[6] = a1.z; w0[7] = a1.w;
                  w1[0] = b0.x; w1[1] = b0.y; w1[2] = b0.z; w1[3] = b0.w; w1[4] = b1.x; w1[5] = b1.y; w1[6] = b1.z; w1[7] = b1.w;
                  w2[0] = c0.x; w2[1] = c0.y; w2[2] = c0.z; w2[3] = c0.w; w2[4] = c1.x; w2[5] = c1.y; w2[6] = c1.z; w2[7] = c1.w;
                  bb[0] = d0.x; bb[1] = d0.y; bb[2] = d0.z; bb[3] = d0.w; bb[4] = d1.x; bb[5] = d1.y; bb[6] = d1.z; bb[7] = d1.w; }
                u32x4 raw[10];
#pragma unroll
                for (int i = 0; i < 10; ++i) { const int pos = p0 + t0 - 1 + i;
                    if (pos < 0 || pos >= n) { const unsigned z = zero_u32(); raw[i] = (u32x4){z, z, z, z}; } else raw[i] = *(const u32x4*)(U + (size_t)(row0 - p0 + pos) * 1536 + ch); }
#pragma unroll
                for (int t = 0; t < 8; ++t) { float up[8], uc[8], un[8], o[8]; unpack8(raw[t], up); unpack8(raw[t + 1], uc); unpack8(raw[t + 2], un);
#pragma unroll
                    for (int i = 0; i < 8; ++i) o[i] = fmaf(w0[i], up[i], fmaf(w1[i], uc[i], fmaf(w2[i], un[i], bb[i])));
                    if (g == 0) *(u32x4*)(X0 + (size_t)(row0 + t0 + t) * 512 + c) = pack8(o);
                    else if (g == 1) x1p[t] = pack8(o);
                    else { float x1[8]; unpack8(x1p[t], x1);
#pragma unroll
                        for (int i = 0; i < 8; ++i) o[i] *= x1[i];
                        x1p[t] = pack8(o); } }
            }
#pragma unroll
            for (int i = 0; i < 8; ++i) { unsigned short ev[8];
#pragma unroll
                for (int t = 0; t < 8; ++t) { const unsigned wsel = (i >> 1) == 0 ? x1p[t].x : (i >> 1) == 1 ? x1p[t].y : (i >> 1) == 2 ? x1p[t].z : x1p[t].w; ev[t] = (unsigned short)((i & 1) ? (wsel >> 16) : (wsel & 0xffffu)); }
                u32x4 w; w.x = ev[0] | ((unsigned)ev[1] << 16); w.y = ev[2] | ((unsigned)ev[3] << 16); w.z = ev[4] | ((unsigned)ev[5] << 16); w.w = ev[6] | ((unsigned)ev[7] << 16);
                *(LAS u32x4*)(HT_l + (c + i) * HROW + t0 * 2) = w; }
        }
        __syncthreads();
        for (int i = F.tid; i < 2 * 128 * 8; i += NTHR) { const int m = i >> 10, rr = (i >> 3) & 127, c8 = i & 7;
            LAS unsigned char* T = m ? VW_l : VA_l; unsigned short e[8];
#pragma unroll
            for (int jj = 0; jj < 8; ++jj) { const int key = 16 * (c8 >> 1) + 8 * (jj >> 2) + 4 * (c8 & 1) + (jj & 3); e[jj] = *(const LAS bf16_t*)(T + key * VROW + rr * 2); }
            u32x4 w; w.x = e[0] | ((unsigned)e[1] << 16); w.y = e[2] | ((unsigned)e[3] << 16); w.z = e[4] | ((unsigned)e[5] << 16); w.w = e[6] | ((unsigned)e[7] << 16);
            *(u32x4*)((m ? VTW : VTA) + ((size_t)(b * 2 + (rr >> 6)) * 64 + (rr & 63)) * KEYS + j0 + c8 * 8) = w; }
        if (do_hy) { bf16_t* VTb = lat ? VT : VT + VT_CTX_OFF;
          for (int i = F.tid; i < 512 * 8; i += NTHR) { const int cch = i >> 3, c8 = i & 7;
              const u32x4 w = *(const LAS u32x4*)(HT_l + cch * HROW + c8 * 16);
              *(u32x4*)(VTb + ((size_t)cch * NB + b) * n + p0 + c8 * 8) = w; } }
    }
    __syncthreads();
}

__device__ __forceinline__ void hyena_final_phase(const Fr& F, const Args& a, int l, bool with_ctx) {
    constexpr int HROW = 144;
    LAS unsigned char* T = F.lds;
    const bf16_t* X0 = (const bf16_t*)(a.ws + WS_H); const bf16_t* VT = (const bf16_t*)(a.ws + WS_VT); const bf16_t* YT = (const bf16_t*)(a.ws + WS_YT);
    bf16_t* YH = (bf16_t*)(a.ws + WS_QA) + 512;
    const float* FN = (const float*)(a.ws + WS_FNORM) + l * 1024; const float* skip = a.in[I_HBIAS] + l * 512;
    const int nunits = with_ctx ? NB * 36 : NB * 32;
    for (int unit = F.bid; unit < nunits; unit += F.G) {
        const bool lat = unit < NB * 32;
        const int b = lat ? unit >> 5 : (unit - NB * 32) >> 2, p0 = lat ? (unit & 31) * 64 : ((unit - NB * 32) & 3) * 64;
        const int n = lat ? SEQ : CTX; const int row0 = lat ? b * SEQ + p0 : TL + b * CTX + p0;
        const bf16_t* Yb = lat ? YT : YT + VT_CTX_OFF; const bf16_t* Vb = lat ? VT : VT + VT_CTX_OFF; const float* inv = FN + (lat ? 0 : 512);
        __syncthreads();
        for (int i = F.tid; i < 512 * 8; i += NTHR) { const int cch = i >> 3, c8 = i & 7; const size_t off = ((size_t)cch * NB + b) * n + p0 + c8 * 8;
            const u32x4 y = *(const u32x4*)(Yb + off), v = *(const u32x4*)(Vb + off); const float s = inv[cch], k = skip[cch];
            u32x4 o;
            o.x = cvtpk(bflo(y.x) * s + k * bflo(v.x), bfhi(y.x) * s + k * bfhi(v.x)); o.y = cvtpk(bflo(y.y) * s + k * bflo(v.y), bfhi(y.y) * s + k * bfhi(v.y));
            o.z = cvtpk(bflo(y.z) * s + k * bflo(v.z), bfhi(y.z) * s + k * bfhi(v.z)); o.w = cvtpk(bflo(y.w) * s + k * bflo(v.w), bfhi(y.w) * s + k * bfhi(v.w));
            *(LAS u32x4*)(T + cch * HROW + c8 * 16) = o; }
        __syncthreads();
        { const int th = F.tid & 255, half = F.tid >> 8, c = 2 * th;
          for (int t = 32 * half; t < 32 * half + 32; ++t) {
              const unsigned x0 = *(const unsigned*)(X0 + (size_t)(row0 + t) * 512 + c);
              const float y0 = bf1(*(const LAS bf16_t*)(T + c * HROW + t * 2)), y1 = bf1(*(const LAS bf16_t*)(T + (c + 1) * HROW + t * 2));
              *(unsigned*)(YH + (size_t)(row0 + t) * 1536 + c) = cvtpk(bflo(x0) * y0, bfhi(x0) * y1); } }
    }
    __syncthreads();
}

#define MFMA32(a, b, c) __builtin_amdgcn_mfma_f32_32x32x16_bf16((a), (b), (c), 0, 0, 0)
#define MFMA16(a, b, c) __builtin_amdgcn_mfma_f32_16x16x32_bf16((a), (b), (c), 0, 0, 0)

__device__ __forceinline__ int tile_off(int row, int chunk) { return row * 128 + ((chunk ^ ((row >> 1) & 7)) << 4); }

template <bool WIN>
__device__ __forceinline__ void attn_unit(const Fr& F, bf16_t* Qw, const bf16_t* Kb, const bf16_t* VTb, int a0, int na, int b0, int nb, int qpos0, bool has_sink, float sink2, const float* g64, bool rope, const float* ct, const float* st) {
    LAS unsigned char* L = F.lds;
    const int r = F.lane & 31, h = F.lane >> 5;
    const int xaddr = (lane_id() ^ 32) << 2;
#define SWAP32(v) __builtin_bit_cast(float, __builtin_amdgcn_ds_bpermute(xaddr, __builtin_bit_cast(int, (v))))
    bf16x8 q[4];
    {
        float x[4][8]; float ss = 0.f;
#pragma unroll
        for (int kk = 0; kk < 4; ++kk) { const u32x4 w = *(const u32x4*)(Qw + (size_t)r * 1536 + 16 * kk + 8 * h); unpack8(w, x[kk]);
#pragma unroll
            for (int j = 0; j < 8; ++j) ss += x[kk][j] * x[kk][j]; }
        ss += SWAP32(ss);
        const float rn = (1.f / sqrtf(ss * (1.f / 64.f) + EPS)) * QSCALE;
#pragma unroll
        for (int kk = 0; kk < 4; ++kk) { const f32x4 g0 = *(const f32x4*)(g64 + 16 * kk + 8 * h), g1 = *(const f32x4*)(g64 + 16 * kk + 8 * h + 4);
            x[kk][0] *= rn * g0.x; x[kk][1] *= rn * g0.y; x[kk][2] *= rn * g0.z; x[kk][3] *= rn * g0.w; x[kk][4] *= rn * g1.x; x[kk][5] *= rn * g1.y; x[kk][6] *= rn * g1.z; x[kk][7] *= rn * g1.w; }
        if (rope) { const int pos = qpos0 + r;
#pragma unroll
            for (int ax = 0; ax < 2; ++ax) {
                const f32x4 c0 = *(const f32x4*)(ct + pos * 32 + ax * 16 + 8 * h), c1 = *(const f32x4*)(ct + pos * 32 + ax * 16 + 8 * h + 4);
                const f32x4 s0 = *(const f32x4*)(st + pos * 32 + ax * 16 + 8 * h), s1 = *(const f32x4*)(st + pos * 32 + ax * 16 + 8 * h + 4);
                const float cs[8] = {c0.x, c0.y, c0.z, c0.w, c1.x, c1.y, c1.z, c1.w}, sn[8] = {s0.x, s0.y, s0.z, s0.w, s1.x, s1.y, s1.z, s1.w};
#pragma unroll
                for (int j = 0; j < 8; ++j) { const float av = x[2 * ax][j], bv = x[2 * ax + 1][j]; x[2 * ax][j] = av * cs[j] - bv * sn[j]; x[2 * ax + 1][j] = bv * cs[j] + av * sn[j]; } } }
#pragma unroll
        for (int kk = 0; kk < 4; ++kk) q[kk] = __builtin_bit_cast(bf16x8, pack8(x[kk]));
    }
    f32x16 o0, o1;
#pragma unroll
    for (int i = 0; i < 16; ++i) { o0[i] = 0.f; o1[i] = 0.f; }
    float lsum = 0.f;
    const int ntile = na + nb;
    const int srow = F.tid >> 3, sch = F.tid & 7;
    const int soff = tile_off(srow, sch);
    int t4[4];
#pragma unroll
    for (int j = 0; j < 4; ++j) t4[j] = tile_off(r, 2 * j + h);
#define AT_KT(i) ((i) < na ? a0 + (i) : b0 + ((i) - na))
#define AT_LD(i, K0, K1, V0, V1) do { const int kt_ = AT_KT(i); \
        K0 = *(const u32x4*)(Kb + (size_t)(kt_ * 128 + srow) * 128 + sch * 8); K1 = *(const u32x4*)(Kb + (size_t)(kt_ * 128 + 64 + srow) * 128 + sch * 8); \
        V0 = *(const u32x4*)(VTb + (size_t)srow * KEYS + kt_ * 128 + sch * 8); V1 = *(const u32x4*)(VTb + (size_t)srow * KEYS + kt_ * 128 + 64 + sch * 8); } while (0)
#define AT_ST(buf, K0, K1, V0, V1) do { LAS unsigned char* B_ = L + (buf) * 32768 + soff; \
        *(LAS u32x4*)(B_) = K0; *(LAS u32x4*)(B_ + 8192) = K1; *(LAS u32x4*)(B_ + 16384) = V0; *(LAS u32x4*)(B_ + 24576) = V1; } while (0)
#define AT_QK(S0, S1, Kt) do { bf16x8 kf_[8]; \
        _Pragma("unroll") for (int kk = 0; kk < 4; ++kk) { kf_[2 * kk] = *(const LAS bf16x8*)(L + (Kt) + t4[kk]); kf_[2 * kk + 1] = *(const LAS bf16x8*)(L + (Kt) + t4[kk] + 4096); } \
        _Pragma("unroll") for (int i_ = 0; i_ < 16; ++i_) { S0[i_] = 0.f; S1[i_] = 0.f; } \
        _Pragma("unroll") for (int kk = 0; kk < 4; ++kk) { S0 = MFMA32(kf_[2 * kk], q[kk], S0); S1 = MFMA32(kf_[2 * kk + 1], q[kk], S1); } } while (0)
#define AT_EXP(S0, S1, P, kpos0) do { \
        if (WIN && (kpos0) >= 0) { const int kbase = (kpos0) + 4 * h, qp = qpos0 + r; \
            _Pragma("unroll") for (int i = 0; i < 16; ++i) { const int kr = (i & 3) + 8 * (i >> 2); const int d0 = kbase + kr - qp, d1 = d0 + 32; \
                if (d0 > 128 || d0 < -128) S0[i] = -1e30f; if (d1 > 128 || d1 < -128) S1[i] = -1e30f; } } \
        _Pragma("unroll") for (int i = 0; i < 16; ++i) { S0[i] = fast_exp2(S0[i]); S1[i] = fast_exp2(S1[i]); lsum += S0[i] + S1[i]; } \
        { u32x4 w; \
          w.x = cvtpk(S0[0], S0[1]); w.y = cvtpk(S0[2], S0[3]); w.z = cvtpk(S0[4], S0[5]); w.w = cvtpk(S0[6], S0[7]); P[0] = __builtin_bit_cast(bf16x8, w); \
          w.x = cvtpk(S0[8], S0[9]); w.y = cvtpk(S0[10], S0[11]); w.z = cvtpk(S0[12], S0[13]); w.w = cvtpk(S0[14], S0[15]); P[1] = __builtin_bit_cast(bf16x8, w); \
          w.x = cvtpk(S1[0], S1[1]); w.y = cvtpk(S1[2], S1[3]); w.z = cvtpk(S1[4], S1[5]); w.w = cvtpk(S1[6], S1[7]); P[2] = __builtin_bit_cast(bf16x8, w); \
          w.x = cvtpk(S1[8], S1[9]); w.y = cvtpk(S1[10], S1[11]); w.z = cvtpk(S1[12], S1[13]); w.w = cvtpk(S1[14], S1[15]); P[3] = __builtin_bit_cast(bf16x8, w); } } while (0)
#define AT_PV(P, Vt) do { bf16x8 vf_[8]; \
        _Pragma("unroll") for (int c = 0; c < 4; ++c) { vf_[2 * c] = *(const LAS bf16x8*)(L + (Vt) + t4[c]); vf_[2 * c + 1] = *(const LAS bf16x8*)(L + (Vt) + t4[c] + 4096); } \
        _Pragma("unroll") for (int c = 0; c < 4; ++c) { o0 = MFMA32(vf_[2 * c], P[c], o0); o1 = MFMA32(vf_[2 * c + 1], P[c], o1); } } while (0)
#define AT_BODY(it) do { \
        const int kt = AT_KT(it); \
        if ((it) + 1 < ntile) AT_LD((it) + 1, kA0, kA1, vA0, vA1); \
        const int Bc = ((it) & 1) * 32768;                                \
        const int kp = (WIN && kt >= 2) ? (kt - 2) * 128 : -1;            \
        { f32x16 sa0, sa1; bf16x8 pa[4]; \
          AT_QK(sa0, sa1, Bc); AT_EXP(sa0, sa1, pa, kp); AT_PV(pa, Bc + 16384); } \
        __builtin_amdgcn_sched_barrier(0); \
        { f32x16 sb0, sb1; bf16x8 pb_[4]; \
          AT_QK(sb0, sb1, Bc + 8192); AT_EXP(sb0, sb1, pb_, (kp < 0 ? -1 : kp + 64)); AT_PV(pb_, Bc + 24576); } \
        if ((it) + 1 < ntile) AT_ST(((it) + 1) & 1, kA0, kA1, vA0, vA1); \
        __syncthreads(); } while (0)
    u32x4 kA0, kA1, vA0, vA1;
    AT_LD(0, kA0, kA1, vA0, vA1);
    __syncthreads();
    AT_ST(0, kA0, kA1, vA0, vA1);
    __syncthreads();
    for (int it = 0; it < ntile; it += 2) {
        AT_BODY(it);
        if (it + 1 < ntile) AT_BODY(it + 1);
    }
#undef AT_BODY
#undef AT_QK
#undef AT_EXP
#undef AT_PV
#undef AT_ST
#undef AT_LD
#undef AT_KT
    float lt = lsum + SWAP32(lsum);
    if (has_sink) lt += fast_exp2(sink2);
    const float inv = 1.f / lt;
#pragma unroll
    for (int g = 0; g < 4; ++g) {
        u32x2 w0, w1;
        w0.x = cvtpk(o0[4 * g] * inv, o0[4 * g + 1] * inv); w0.y = cvtpk(o0[4 * g + 2] * inv, o0[4 * g + 3] * inv);
        w1.x = cvtpk(o1[4 * g] * inv, o1[4 * g + 1] * inv); w1.y = cvtpk(o1[4 * g + 2] * inv, o1[4 * g + 3] * inv);
        *(u32x2*)(Qw + (size_t)r * 1536 + 8 * g + 4 * h) = w0;
        *(u32x2*)(Qw + (size_t)r * 1536 + 32 + 8 * g + 4 * h) = w1; }
#undef SWAP32
}

__device__ __forceinline__ void hyena_unit_lat(const Fr& F, const bf16_t* Fg, const bf16_t* Vg, bf16_t* Yg) {
    constexpr int FREP = 8192 + 64, VPIT = 4096 + 16, VOFF = 8 * FREP;
    LAS unsigned char* L = F.lds;
    __syncthreads();
    { const int x = F.tid;
      const u32x4 lo = *(const u32x4*)(Fg + x * 8); u32x4 hi; if (x < 511) hi = *(const u32x4*)(Fg + x * 8 + 8); else { const unsigned z = zero_u32(); hi = (u32x4){z, z, z, z}; }
      const unsigned wv[8] = {lo.x, lo.y, lo.z, lo.w, hi.x, hi.y, hi.z, hi.w};
      *(LAS u32x4*)(L + x * 16) = lo;
#pragma unroll
      for (int rho = 1; rho < 8; ++rho) { u32x4 o;
          unsigned od[4];
#pragma unroll
          for (int d = 0; d < 4; ++d) { const int ob = 4 * d + 2 * rho, i = ob >> 2, s = ob & 3; od[d] = __builtin_amdgcn_alignbyte(wv[i + 1 < 8 ? i + 1 : 7], wv[i], s); }
          o.x = od[0]; o.y = od[1]; o.z = od[2]; o.w = od[3];
          *(LAS u32x4*)(L + rho * FREP + x * 16) = o; } }
    for (int i = F.tid; i < 16 * 256; i += NTHR) { const int b = i >> 8, x = i & 255; *(LAS u32x4*)(L + VOFF + b * VPIT + x * 16) = *(const u32x4*)(Vg + (size_t)b * SEQ + x * 8); }
    __syncthreads();
    const int i16 = F.lane & 15, q4 = F.lane >> 4, w = F.wave;
    const int base0 = 2047 - 256 * w - i16 + 8 * q4;
    const int rho = base0 & 7;
    LAS unsigned char* Ap = L + rho * FREP + (base0 - rho) * 2;
    LAS unsigned char* Bp = L + VOFF + i16 * VPIT + q4 * 16;
    bf16x8 A[16]; f32x4 acc[16];
#pragma unroll
    for (int rr = 0; rr < 16; ++rr) { A[rr] = *(const LAS bf16x8*)(Ap - 32 * rr); acc[rr] = (f32x4){0.f, 0.f, 0.f, 0.f}; }
    bf16x8 Bn = *(const LAS bf16x8*)(Bp);
    for (int o = 0; o < 8; ++o) {
#pragma unroll
        for (int u = 0; u < 8; ++u) {
            const int st = o * 8 + u;
            const bf16x8 Bf = Bn;
            if (st < 63) Bn = *(const LAS bf16x8*)(Bp + 64 * st + 64);
#pragma unroll
            for (int rr = 0; rr < 16; ++rr) acc[rr] = MFMA16(A[(rr - 2 * u) & 15], Bf, acc[rr]);
            if (st < 63) { A[(-2 * u - 2) & 15] = *(const LAS bf16x8*)(Ap + 64 * st + 64); A[(-2 * u - 1) & 15] = *(const LAS bf16x8*)(Ap + 64 * st + 32); }
        }
    }
#pragma unroll
    for (int rr = 0; rr < 16; ++rr) { u32x2 wv; wv.x = cvtpk(acc[rr].x, acc[rr].y); wv.y = cvtpk(acc[rr].z, acc[rr].w);
        *(u32x2*)(Yg + (size_t)i16 * SEQ + 256 * w + 16 * rr + 4 * q4) = wv; }
}
__device__ __forceinline__ void hyena_unit_ctx(const Fr& F, const bf16_t* Fg, const bf16_t* Vg, bf16_t* Yg) {
    constexpr int FREP = 1024 + 64, VPIT = 512 + 16, VOFF = 8 * FREP;
    LAS unsigned char* L = F.lds;
    __syncthreads();
    if (F.tid < 64) *(LAS u32x4*)(L + F.tid * 16) = *(const u32x4*)(Fg + F.tid * 8);
    if (F.tid >= 64 && F.tid < 68) { const unsigned z = zero_u32(); *(LAS u32x4*)(L + 1024 + (F.tid - 64) * 16) = (u32x4){z, z, z, z}; }
    { const int b = F.tid >> 5, x = F.tid & 31; *(LAS u32x4*)(L + VOFF + b * VPIT + x * 16) = *(const u32x4*)(Vg + (size_t)b * CTX + x * 8); }
    __syncthreads();
    for (int i = F.tid; i < 7 * 256; i += NTHR) { const int rho = 1 + i / 256, x2 = (i % 256) * 2; const int s0 = x2 + rho, s1 = x2 + 1 + rho;
        const unsigned e0 = s0 < 512 ? *(const LAS bf16_t*)(L + s0 * 2) : 0, e1 = s1 < 512 ? *(const LAS bf16_t*)(L + s1 * 2) : 0;
        *(LAS unsigned*)(L + rho * FREP + x2 * 2) = e0 | (e1 << 16); }
    __syncthreads();
    const int i16 = F.lane & 15, q4 = F.lane >> 4, w = F.wave;
    const int base0 = 255 - 32 * w - i16 + 8 * q4, rho = base0 & 7;
    LAS unsigned char* Ap = L + rho * FREP + (base0 - rho) * 2;
    LAS unsigned char* Bp = L + VOFF + i16 * VPIT + q4 * 16;
    f32x4 acc0 = (f32x4){0.f, 0.f, 0.f, 0.f}, acc1 = acc0;
#pragma unroll
    for (int st = 0; st < 8; ++st) { const bf16x8 Bf = *(const LAS bf16x8*)(Bp + 64 * st);
        const bf16x8 A0 = *(const LAS bf16x8*)(Ap + 64 * st), A1 = *(const LAS bf16x8*)(Ap + 64 * st - 32);
        acc0 = MFMA16(A0, Bf, acc0); acc1 = MFMA16(A1, Bf, acc1); }
    u32x2 wv; wv.x = cvtpk(acc0.x, acc0.y); wv.y = cvtpk(acc0.z, acc0.w); *(u32x2*)(Yg + (size_t)i16 * CTX + 32 * w + 4 * q4) = wv;
    wv.x = cvtpk(acc1.x, acc1.y); wv.y = cvtpk(acc1.z, acc1.w); *(u32x2*)(Yg + (size_t)i16 * CTX + 32 * w + 16 + 4 * q4) = wv;
}

__device__ __forceinline__ void mixer_phase(const Fr& F, const Args& a, int l, bool with_ctx, unsigned long long& sacc, const int swhich) {
#if defined(PROBE_P)
    unsigned long long st0 = __builtin_amdgcn_s_memrealtime();
#define SUBMARK(w) do { const unsigned long long t_ = __builtin_amdgcn_s_memrealtime(); if (swhich == (w)) sacc += t_ - st0; st0 = t_; } while (0)
#else
#define SUBMARK(w) do { } while (0)
#endif
    bf16_t* QA = (bf16_t*)(a.ws + WS_QA); bf16_t* QW = QA + 1024;
    const bf16_t* KA = (const bf16_t*)(a.ws + WS_KA); const bf16_t* KW = (const bf16_t*)(a.ws + WS_KW);
    const bf16_t* VTA = (const bf16_t*)(a.ws + WS_VTA); const bf16_t* VTW = (const bf16_t*)(a.ws + WS_VTW);
    const float* sinks = a.in[I_SINK] + l * 8; const float* qkg = a.in[I_QKG] + l * 256;
    const float* ct = (const float*)(a.ws + WS_ROPE); const float* st = ct + SEQ * 32;
    const int wq = F.wave >> 1, wh = F.wave & 1;
    const int ubid = (F.G % 8 == 0) ? (F.bid & 7) * (F.G >> 3) + (F.bid >> 3) : F.bid;
#define RELANE(FX) do { int t_ = F.wave * 64 + lane_id(); asm volatile("" : "+v"(t_)); FX.tid = t_; FX.lane = t_ & 63; } while (0)
    Fr FA = F; RELANE(FA);
    for (int unit = ubid; unit < NB * 2 * 32; unit += F.G) {
        const int b = unit >> 6, kvh = (unit >> 5) & 1, pb = unit & 31;
        bf16_t* Qw = QA + (size_t)(b * SEQ + pb * 64 + wh * 32) * 1536 + (kvh * 4 + wq) * 64;
        attn_unit<false>(FA, Qw, KA + (size_t)b * KEYS * 128 + kvh * 64, VTA + (size_t)(b * 2 + kvh) * 64 * KEYS, 0, KEYS / 128, 0, 0, pb * 64 + wh * 32, false, 0.f, qkg, true, ct, st);
    }
    SUBMARK(30);
    Fr FW = F; RELANE(FW);
    for (int unit = ubid; unit < NB * 2 * 32; unit += F.G) {
        const int b = unit >> 6, kvh = (unit >> 5) & 1, pb = unit & 31;
        bf16_t* Qw = QW + (size_t)(b * SEQ + pb * 64 + wh * 32) * 1536 + (kvh * 4 + wq) * 64;
        const int lo = pb < 2 ? 0 : (pb - 2) >> 1, hi = ((64 * pb + 191) >> 7) > 15 ? 15 : ((64 * pb + 191) >> 7);
        attn_unit<true>(FW, Qw, KW + (size_t)b * KEYS * 128 + kvh * 64, VTW + (size_t)(b * 2 + kvh) * 64 * KEYS, 0, 2, 2 + lo, hi - lo + 1, pb * 64 + wh * 32, true, sinks[kvh * 4 + wq] * LOG2E, qkg + 128, true, ct, st);
    }
    SUBMARK(31);
    Fr FC2 = F; RELANE(FC2);
    if (with_ctx) {
        for (int unit = ubid; unit < 2 * NB * 2 * 4; unit += F.G) {
            const int isw = unit >> 7, u2 = unit & 127, b = u2 >> 3, kvh = (u2 >> 2) & 1, pb = u2 & 3;
            bf16_t* Qw = (isw ? QW : QA) + (size_t)(TL + b * CTX + pb * 64 + wh * 32) * 1536 + (kvh * 4 + wq) * 64;
            attn_unit<false>(FC2, Qw, (isw ? KW : KA) + (size_t)b * KEYS * 128 + kvh * 64, (isw ? VTW : VTA) + (size_t)(b * 2 + kvh) * 64 * KEYS, 0, 2, 0, 0, 0, isw != 0, isw ? sinks[kvh * 4 + wq] * LOG2E : 0.f, qkg + (isw ? 128 : 0), false, ct, st);
        }
    }
    SUBMARK(32);
    const bf16_t* FL = (const bf16_t*)(a.ws + WS_FL) + (size_t)l * 512 * 4096; const bf16_t* FC = (const bf16_t*)(a.ws + WS_FC) + (size_t)l * 512 * 512;
    const bf16_t* VT = (const bf16_t*)(a.ws + WS_VT); bf16_t* YT = (bf16_t*)(a.ws + WS_YT);
    Fr FH = F; RELANE(FH);
    for (int c = F.bid; c < HYW; c += F.G) hyena_unit_lat(FH, FL + (size_t)c * 4096, VT + (size_t)c * NB * SEQ, YT + (size_t)c * NB * SEQ);
    if (with_ctx) for (int c = F.bid; c < HYW; c += F.G) hyena_unit_ctx(FH, FC + (size_t)c * 512, VT + VT_CTX_OFF + (size_t)c * NB * CTX, YT + VT_CTX_OFF + (size_t)c * NB * CTX);
    __syncthreads();
    SUBMARK(33);
#undef SUBMARK
#undef RELANE
}

__device__ __forceinline__ float gate_q(float x) { return fminf(256.f * sigmoid_f(x), 255.49f); }
__device__ __forceinline__ unsigned pack_u8x4(float a, float b, float c, float d) { return (unsigned)(int)a | ((unsigned)(int)b << 8) | ((unsigned)(int)c << 16) | ((unsigned)(int)d << 24); }
__device__ __forceinline__ float gq(unsigned w, int k) { return (float)((w >> (8 * k)) & 0xffu) + 0.5f; }
struct EpiInProj {
    static constexpr bool PERM = true, AFTER_DRAIN = false; static constexpr int NSEG = 1;
    unsigned char* ws; int pn_off;
    __device__ __forceinline__ void operator()(const pg8::f32x4 (&acc)[2][2][4][2], const pg8::Unit& u, int wr, int wc, int fr, int fq) const {
        asm volatile("" : "+v"(fr), "+v"(fq));
        const int pn = __builtin_amdgcn_readfirstlane(u.pn) + pn_off; unsigned long long boff; int ldc, colt; bool sig = false;
        if (pn < 2) { boff = WS_QA; ldc = 1536; colt = pn * 256; }
        else if (pn == 2) { boff = WS_RAWA; ldc = 256; colt = 0; }
        else if (pn < 9) { boff = WS_U; ldc = 1536; colt = (pn - 3) * 256; }
        else if (pn < 11) { boff = WS_QA; ldc = 1536; colt = 1024 + (pn - 9) * 256; }
        else if (pn == 11) { boff = WS_RAWW; ldc = 256; colt = 0; }
        else { boff = WS_G; ldc = 3072; colt = (pn - 12) * 256; sig = true; }
        bf16_t* base = (bf16_t*)(ws + boff); unsigned char* Gt = ws + boff;
        const int row0 = u.pm * 256 + wr * 64 + fr, col0 = colt + wc * 32 + 8 * fq;
        if (sig) {
            unsigned char* gb = (unsigned char*)Gt;
#pragma unroll
            for (int ai = 0; ai < 2; ++ai)
#pragma unroll
                for (int m = 0; m < 4; ++m) { unsigned char* rowp = gb + (size_t)(row0 + ai * 128 + m * 16) * 3072 + col0;
#pragma unroll
                    for (int bj = 0; bj < 2; ++bj) { const pg8::f32x4 v0 = acc[ai][bj][m][0], v1 = acc[ai][bj][m][1];
                        u32x2 w; w.x = pack_u8x4(gate_q(v0.x), gate_q(v0.y), gate_q(v0.z), gate_q(v0.w)); w.y = pack_u8x4(gate_q(v1.x), gate_q(v1.y), gate_q(v1.z), gate_q(v1.w));
                        *(u32x2*)(rowp + bj * 128) = w; } }
            return;
        }
#pragma unroll
        for (int ai = 0; ai < 2; ++ai)
#pragma unroll
            for (int m = 0; m < 4; ++m) { bf16_t* rowp = base + (size_t)(row0 + ai * 128 + m * 16) * ldc + col0;
#pragma unroll
                for (int bj = 0; bj < 2; ++bj) { const pg8::f32x4 v0 = acc[ai][bj][m][0], v1 = acc[ai][bj][m][1];
                    u32x4 w; w.x = cvtpk(v0.x, v0.y); w.y = cvtpk(v0.z, v0.w); w.z = cvtpk(v1.x, v1.y); w.w = cvtpk(v1.z, v1.w);
                    *(u32x4*)(rowp + bj * 128) = w; } }
    }
};
struct EpiGate {
    static constexpr bool PERM = true, AFTER_DRAIN = false; static constexpr int NSEG = 1;
    unsigned char* Gt;
    __device__ __forceinline__ void operator()(const pg8::f32x4 (&acc)[2][2][4][2], const pg8::Unit& u, int wr, int wc, int fr, int fq) const {
        asm volatile("" : "+v"(fr), "+v"(fq));
        const int row0 = u.pm * 256 + wr * 64 + fr, col0 = u.pn * 256 + wc * 32 + 8 * fq;
#pragma unroll
        for (int ai = 0; ai < 2; ++ai)
#pragma unroll
            for (int m = 0; m < 4; ++m) { unsigned char* rowp = Gt + (size_t)(row0 + ai * 128 + m * 16) * 3072 + col0;
#pragma unroll
                for (int bj = 0; bj < 2; ++bj) { const pg8::f32x4 v0 = acc[ai][bj][m][0], v1 = acc[ai][bj][m][1];
                    u32x2 w; w.x = pack_u8x4(gate_q(v0.x), gate_q(v0.y), gate_q(v0.z), gate_q(v0.w)); w.y = pack_u8x4(gate_q(v1.x), gate_q(v1.y), gate_q(v1.z), gate_q(v1.w));
                    *(u32x2*)(rowp + bj * 128) = w; } }
    }
};
struct EpiMerge {
    static constexpr bool PERM = true, AFTER_DRAIN = false; static constexpr int NSEG = 3;
    bf16_t* Mo; const unsigned char* Gt; unsigned* panel_cnt;
    __device__ __forceinline__ void rescale(pg8::f32x4 (&acc)[2][2][4][2], const pg8::Unit& u, int seg, int wr, int wc, int fr, int fq) const {
        asm volatile("" : "+v"(fr), "+v"(fq));
        const int row0 = u.pm * 256 + wr * 64 + fr, col0 = u.pn * 256 + wc * 32 + 8 * fq;
        const unsigned char* G0 = Gt + seg * 1024 + col0;
#pragma unroll
        for (int ai = 0; ai < 2; ++ai)
#pragma unroll
            for (int mh = 0; mh < 2; ++mh) {
                u32x2 ga[2][2], gb[2][2];
#pragma unroll
                for (int mm = 0; mm < 2; ++mm)
#pragma unroll
                    for (int bj = 0; bj < 2; ++bj) { const size_t row = (size_t)(row0 + ai * 128 + (2 * mh + mm) * 16);
                        ga[mm][bj] = *(const u32x2*)(G0 + row * 3072 + bj * 128); gb[mm][bj] = *(const u32x2*)(G0 + row * 3072 + 1024 + bj * 128); }
                __builtin_amdgcn_sched_barrier(0);
#pragma unroll
                for (int mm = 0; mm < 2; ++mm)
#pragma unroll
                    for (int bj = 0; bj < 2; ++bj) { const u32x2 a = ga[mm][bj], b = gb[mm][bj]; pg8::f32x4& v0 = acc[ai][bj][2 * mh + mm][0]; pg8::f32x4& v1 = acc[ai][bj][2 * mh + mm][1];
                        v0.x *= gq(a.x, 0) * fast_rcp(gq(b.x, 0)); v0.y *= gq(a.x, 1) * fast_rcp(gq(b.x, 1)); v0.z *= gq(a.x, 2) * fast_rcp(gq(b.x, 2)); v0.w *= gq(a.x, 3) * fast_rcp(gq(b.x, 3));
                        v1.x *= gq(a.y, 0) * fast_rcp(gq(b.y, 0)); v1.y *= gq(a.y, 1) * fast_rcp(gq(b.y, 1)); v1.z *= gq(a.y, 2) * fast_rcp(gq(b.y, 2)); v1.w *= gq(a.y, 3) * fast_rcp(gq(b.y, 3)); }
                __builtin_amdgcn_sched_barrier(0);
            }
    }
    __device__ __forceinline__ void operator()(const pg8::f32x4 (&acc)[2][2][4][2], const pg8::Unit& u, int wr, int wc, int fr, int fq) const {
        asm volatile("" : "+v"(fr), "+v"(fq));
        const int row0 = u.pm * 256 + wr * 64 + fr, col0 = u.pn * 256 + wc * 32 + 8 * fq;
        constexpr float S = 1.f / 256.f;
        const __amdgpu_buffer_rsrc_t rs = __builtin_amdgcn_make_buffer_rsrc((void*)Mo, 0, TT * 1024 * 2, 0x00020000);
#pragma unroll
        for (int ai = 0; ai < 2; ++ai) {
            u32x2 gv[4][2];
#pragma unroll
            for (int m = 0; m < 4; ++m)
#pragma unroll
                for (int bj = 0; bj < 2; ++bj) gv[m][bj] = *(const u32x2*)(Gt + (size_t)(row0 + ai * 128 + m * 16) * 3072 + 2048 + col0 + bj * 128);
            __builtin_amdgcn_sched_barrier(0);
#pragma unroll
            for (int m = 0; m < 4; ++m)
#pragma unroll
                for (int bj = 0; bj < 2; ++bj) { const pg8::f32x4 v0 = acc[ai][bj][m][0], v1 = acc[ai][bj][m][1]; const u32x2 g = gv[m][bj];
                    u32x4 w; w.x = cvtpk(v0.x * (gq(g.x, 0) * S), v0.y * (gq(g.x, 1) * S)); w.y = cvtpk(v0.z * (gq(g.x, 2) * S), v0.w * (gq(g.x, 3) * S));
                    w.z = cvtpk(v1.x * (gq(g.y, 0) * S), v1.y * (gq(g.y, 1) * S)); w.w = cvtpk(v1.z * (gq(g.y, 2) * S), v1.w * (gq(g.y, 3) * S));
                    if (panel_cnt) __builtin_amdgcn_raw_buffer_store_b128(w, rs, ((row0 + ai * 128 + m * 16) * 1024 + col0 + bj * 128) * 2, 0, 16);
                    else *(u32x4*)(Mo + (size_t)(row0 + ai * 128 + m * 16) * 1024 + col0 + bj * 128) = w; }
            __builtin_amdgcn_sched_barrier(0);
        }
        if (panel_cnt) {
            asm volatile("s_waitcnt vmcnt(0)" ::: "memory");
            if (lane_id() == 0) (void)__hip_atomic_fetch_add(panel_cnt + 64 * u.pm, 1u, __ATOMIC_RELAXED, __HIP_MEMORY_SCOPE_AGENT);
        }
    }
};
struct EpiOut {
    static constexpr bool PERM = true, AFTER_DRAIN = false; static constexpr int NSEG = 1;
    const float* xsL; const float* xsC; float* xdL; float* xdC; const float* MODl;
    __device__ __forceinline__ void operator()(const pg8::f32x4 (&acc)[2][2][4][2], const pg8::Unit& u, int wr, int wc, int fr, int fq) const {
        asm volatile("" : "+v"(fr), "+v"(fq));
        const int trow = u.pm * 256; const bool lat = trow < TL;
        const int row0 = trow + wr * 64 + fr, col0 = u.pn * 256 + wc * 32 + 8 * fq;
        const float* md = MODl + (size_t)mod_row(trow) * DIN + 2 * 1024 + col0;
        const float* xs = lat ? xsL + (size_t)row0 * D + col0 : xsC + (size_t)(row0 - TL) * D + col0; float* xd = lat ? xdL + (size_t)row0 * D + col0 : xdC + (size_t)(row0 - TL) * D + col0;
        f32x4 mv[2][2];
#pragma unroll
        for (int bj = 0; bj < 2; ++bj)
#pragma unroll
            for (int n = 0; n < 2; ++n) mv[bj][n] = *(const f32x4*)(md + bj * 128 + 4 * n);
#pragma unroll
        for (int ai = 0; ai < 2; ++ai)
#pragma unroll
            for (int mh = 0; mh < 2; ++mh) {
                f32x4 xv[2][2][2];
#pragma unroll
                for (int mm = 0; mm < 2; ++mm)
#pragma unroll
                    for (int bj = 0; bj < 2; ++bj)
#pragma unroll
                        for (int n = 0; n < 2; ++n) xv[mm][bj][n] = *(const f32x4*)(xs + (size_t)(ai * 128 + (2 * mh + mm) * 16) * D + bj * 128 + 4 * n);
                __builtin_amdgcn_sched_barrier(0);
#pragma unroll
                for (int mm = 0; mm < 2; ++mm)
#pragma unroll
                    for (int bj = 0; bj < 2; ++bj)
#pragma unroll
                        for (int n = 0; n < 2; ++n) { const pg8::f32x4 av = acc[ai][bj][2 * mh + mm][n]; const f32x4 x4 = xv[mm][bj][n], m4 = mv[bj][n];
                            f32x4 o; o.x = fmaf(m4.x, av.x, x4.x); o.y = fmaf(m4.y, av.y, x4.y); o.z = fmaf(m4.z, av.z, x4.z); o.w = fmaf(m4.w, av.w, x4.w);
                            *(f32x4*)(xd + (size_t)(ai * 128 + (2 * mh + mm) * 16) * D + bj * 128 + 4 * n) = o; }
                __builtin_amdgcn_sched_barrier(0);
            }
    }
};
struct EpiMoe1 {
    static constexpr bool PERM = true, AFTER_DRAIN = false; static constexpr int NSEG = 1;
    unsigned char* HM;
    __device__ __forceinline__ void operator()(const pg8::f32x4 (&acc)[2][2][4][2], const pg8::Unit& u, int wr, int wc, int fr, int fq) const {
        asm volatile("" : "+v"(fr), "+v"(fq));
        const int row0 = u.pm * 256 + wr * 64 + fr, hcol0 = (u.pn & 3) * 128 + wc * 16 + 4 * fq;
#pragma unroll
        for (int ai = 0; ai < 2; ++ai)
#pragma unroll
            for (int m = 0; m < 4; ++m) { unsigned char* rowp = HM + (size_t)(row0 + ai * 128 + m * 16) * 512 + hcol0;
#pragma unroll
                for (int bj = 0; bj < 2; ++bj) { const pg8::f32x4 x = acc[ai][bj][m][0], y = acc[ai][bj][m][1] * 8.f;
                    *(unsigned*)(rowp + bj * 64) = cvt4_fp8(x.x * sigmoid_f(x.x) * y.x, x.y * sigmoid_f(x.y) * y.y, x.z * sigmoid_f(x.z) * y.z, x.w * sigmoid_f(x.w) * y.w); } }
    }
};
struct EpiMoe2 {
    static constexpr bool PERM = true, AFTER_DRAIN = false; static constexpr int NSEG = 1;
    bf16_t* Fo; const int* erow; const float* eroww; const LAS int* ebase; const LAS int* ecnt;
    __device__ __forceinline__ void operator()(const pg8::f32x4 (&acc)[2][2][4][2], const pg8::Unit& u, int wr, int wc, int fr, int fq) const {
        asm volatile("" : "+v"(fr), "+v"(fq));
        const int e = u.pn >> 2, cnt = __builtin_amdgcn_readfirstlane(ecnt[e]), pos0 = u.pm * 256 - __builtin_amdgcn_readfirstlane(ebase[e]) + wr * 64 + fr, col0 = (u.pn & 3) * 256 + wc * 32 + 8 * fq;
        const int* er = erow + (size_t)e * TT; const float* ew = eroww + (size_t)e * TT;
#pragma unroll
        for (int ai = 0; ai < 2; ++ai) {
            int rm[4]; float wg[4];
#pragma unroll
            for (int m = 0; m < 4; ++m) { const int pos = pos0 + ai * 128 + m * 16; const bool ok = pos < cnt; rm[m] = ok ? er[ok ? pos : 0] : -1; wg[m] = ew[ok ? pos : 0]; }
            __builtin_amdgcn_sched_barrier(0);
#pragma unroll
            for (int m = 0; m < 4; ++m) { const int r1 = rm[m];
                if (r1 >= 0) { const float wgt = wg[m]; bf16_t* rowp = Fo + ((size_t)(r1 & 1) * TT + (r1 >> 1)) * D + col0;
#pragma unroll
                    for (int bj = 0; bj < 2; ++bj) { const pg8::f32x4 v0 = acc[ai][bj][m][0], v1 = acc[ai][bj][m][1];
                        u32x4 w; w.x = cvtpk(v0.x * wgt, v0.y * wgt); w.y = cvtpk(v0.z * wgt, v0.w * wgt); w.z = cvtpk(v1.x * wgt, v1.y * wgt); w.w = cvtpk(v1.z * wgt, v1.w * wgt);
                        *(u32x4*)(rowp + bj * 128) = w; } } }
            __builtin_amdgcn_sched_barrier(0);
        }
    }
};
struct FusedOutOrder {
    int c, G, nun, wv; const unsigned* ready; unsigned* tmo;
    __device__ __forceinline__ bool next(int i, pg8::Unit& u) const {
        int q;
        if (!ready) { q = i * G + c; if (q >= nun) return false; }
        else if (G == 256 && nun == 576) { if (c < 64) { if (i > 0) return false; q = 512 + c; } else { q = i * 192 + (c - 64); if (q >= 512) return false; } }
        else { q = i * G + (G - 1 - c); if (q >= nun) return false; }
        u.pm = q >> 2; u.pn = q & 3; return true; }
    __device__ __forceinline__ void a_ready(const pg8::Unit& u) const {
        if (!ready) return;
        if (wv == 0) {
            const unsigned long long t0 = __builtin_amdgcn_s_memrealtime(); unsigned polls = 0;
            while ((unsigned)__builtin_amdgcn_readfirstlane(__hip_atomic_load(ready + 64 * u.pm, __ATOMIC_RELAXED, __HIP_MEMORY_SCOPE_AGENT)) < 32u) {
                if ((++polls & 255u) == 0u && __builtin_amdgcn_readfirstlane(__hip_atomic_load(tmo, __ATOMIC_RELAXED, __HIP_MEMORY_SCOPE_AGENT)) != 0u) break;
                if (__builtin_amdgcn_s_memrealtime() - t0 > 20000000ull) { if (lane_id() == 0) __hip_atomic_store(tmo, 1u, __ATOMIC_RELAXED, __HIP_MEMORY_SCOPE_AGENT); break; }
                __builtin_amdgcn_s_sleep(2); }
            __builtin_amdgcn_fence(__ATOMIC_ACQUIRE, "agent");
            asm volatile("s_waitcnt vmcnt(0)" ::: "memory");
        }
        asm volatile("" ::: "memory"); __builtin_amdgcn_s_barrier(); asm volatile("" ::: "memory");
    }
    __device__ __forceinline__ void done(const pg8::Unit&) const {}
};
struct LastInProjOrder {
    pg8::StaticOrder T; int nlat, G, c;
    __device__ __forceinline__ bool next(int i, pg8::Unit& u) const {
        const int L = i * G + c;
        if (L < nlat) return T.next(i, u);
        const int r = L - nlat; if (r >= 32) return false;
        u.pm = 128 + (r >> 1); u.pn = (r & 1) ? 11 : 2; return true; }
    __device__ __forceinline__ void a_ready(const pg8::Unit&) const {}
    __device__ __forceinline__ void done(const pg8::Unit&) const {}
};
struct MoeOrder {
    int nunits, G, c; const LAS int* tile_e;
    __device__ __forceinline__ bool next(int i, pg8::Unit& u) const {
        const int L0 = i * G + c; if (L0 >= nunits) return false;
        const int q = nunits / 8, r = nunits % 8, xcd = L0 % 8, off = L0 / 8; const int L = (xcd < r ? xcd * (q + 1) : r * (q + 1) + (xcd - r) * q) + off;
        const int pm = L >> 2; u.pm = pm; u.pn = __builtin_amdgcn_readfirstlane(tile_e[pm]) * 4 + (L & 3); return true; }
    __device__ __forceinline__ void a_ready(const pg8::Unit&) const {}
    __device__ __forceinline__ void done(const pg8::Unit&) const {}
};

__device__ __forceinline__ int moe_tables(const Fr& F, const Args& a, int l, LAS int* ebase  , LAS int* ecnt  , LAS int* tile_e  ) {
    const unsigned* CNT = (const unsigned*)(a.ws + WS_CTL) + CW_CNT + l * 256;
    __syncthreads();
    if (F.tid == 0) { int acc = 0;
#pragma unroll 1
        for (int e = 0; e < NE; ++e) { const int c = (int)__hip_atomic_load(&CNT[e * 16], __ATOMIC_RELAXED, __HIP_MEMORY_SCOPE_AGENT); ecnt[e] = c; ebase[e] = acc; const int nt = (c + 255) >> 8;
#pragma unroll 1
            for (int t = 0; t < nt; ++t) tile_e[(acc >> 8) + t] = e;
            acc += nt << 8; }
        ebase[NE] = acc; }
    __syncthreads();
    return ebase[NE] >> 8;
}

__device__ __forceinline__ void moe_gather_table(const Fr& F, const Args& a, const MoeOrder& S, const LAS int* ebase, const LAS int* ecnt, LAS int* gidx) {
    const int* EROW = (const int*)(a.ws + WS_EROW);
    for (int j = 0; j < 16; ++j) { pg8::Unit u; if (!S.next(j, u)) break;
        const int e = u.pn >> 2, pos0 = u.pm * 256 - ebase[e], cnt = ecnt[e];
        if (F.tid < 256) { const int pos = pos0 + F.tid; gidx[j * 256 + F.tid] = pos < cnt ? (EROW[(size_t)e * TT + pos] >> 1) : 0; } }
    __syncthreads();
}

#ifndef MK_PER_PHASE
#define MK_PER_PHASE 0
#endif
constexpr int PH_PER_LAYER = 10, PH_FINAL = 1 + NL * PH_PER_LAYER, N_PHASES = PH_FINAL + 1;

__global__ void __launch_bounds__(NTHR, 2) trunk_fwd(Args args) {
    extern __shared__ __attribute__((aligned(16))) unsigned char lds[];
    Fr F; F.lds = (LAS unsigned char*)lds; F.tid = threadIdx.x; F.lane = F.tid & 63; F.wave = __builtin_amdgcn_readfirstlane(F.tid >> 6); F.G = gridDim.x; F.bid = blockIdx.x;
    const int wave0 = F.wave;
    for (int u = F.tid; u < (LDS_BYTES - MISC_OFF) / 4; u += NTHR) ((LAS unsigned*)(F.lds + MISC_OFF))[u] = 0u;
    __syncthreads();
    const int lo = args.ph_lo, hi = args.ph_hi;
    unsigned* ctl = (unsigned*)(args.ws + WS_CTL);
    XcdBarrier bar; bar.bar = ctl + CW_BAR; bar.x = 0; bar.st = (volatile LAS unsigned*)(F.lds + MISC_OFF);
    if (hi - lo > 1) bar = xcd_barrier_post(ctl + CW_BAR, (volatile LAS unsigned*)(F.lds + MISC_OFF));
    bar.wv = (unsigned)wave0;
#ifndef DBG_ONLY
#define DBG_ONLY -1
#endif
#define SEL(p) (DBG_ONLY < 0 || DBG_ONLY == (p))
#define IN(k) (lo <= (k) && (k) < hi)
#define FRESH() do { int t_ = wave0 * 64 + lane_id(); asm volatile("" : "+v"(t_)); F.tid = t_; F.lane = t_ & 63; F.wave = wave0; } while (0)
#define SEAM(k) do { if (IN(k) && IN((k) + 1)) xcd_barrier(bar); } while (0)
#if !defined(PROBE_SUB)
#define PROBE_SUB -1
#endif
    unsigned long long pr_sub = 0ull;
#if defined(PROBE_P)
    unsigned long long pr_acc = 0ull, pr_t0 = __builtin_amdgcn_s_memrealtime();
#define PR_MARK(p) do { const unsigned long long t_ = __builtin_amdgcn_s_memrealtime(); if ((p) == PROBE_P) pr_acc += t_ - pr_t0; pr_t0 = t_; } while (0)
#else
#define PR_MARK(p) do { } while (0)
#endif
    unsigned char* ws = args.ws;
    LAS int* ebase = (LAS int*)(F.lds + MISC_OFF + 64); LAS int* ecnt = ebase + 20; LAS int* tile_e = (LAS int*)(F.lds + MISC_OFF + 512);

    #ifndef DBG_PRO
#define DBG_PRO 7
#endif
    if (SEL(100) && IN(0)) { FRESH(); if (DBG_PRO & 1) pro_mod(F, args); __syncthreads(); if (DBG_PRO & 2) pro_rope(F, args); if (DBG_PRO & 4) pro_filter(F, args); __syncthreads(); }
    SEAM(0); PR_MARK(100);
    for (int l = 0; l < NL; ++l) {
        const int pb = 1 + PH_PER_LAYER * l;
#define LVARS() int lq_ = l; asm volatile("" : "+s"(lq_)); const bool uc = lq_ < NL - 1; const int M2 = uc ? TT : TL; (void)M2; (void)uc
        if (SEL(0) && IN(pb + 0)) { LVARS(); FRESH(); if (l == 0) filter_norm_reduce(F, args); conv_small_weights(F, args, l, 7, 0); rows_p0(F, args, l, TT); __syncthreads(); }
        SEAM(pb + 0); PR_MARK(0);
        if (SEL(1) && IN(pb + 1)) { LVARS();
            pg8::Gemm g{(const bf16_t*)(ws + WS_H8), (const bf16_t*)(ws + WS_WG8), TT, DIN, 512}; EpiInProj E{ws, 0};
            if (uc) { pg8::StaticOrder S; S.init(TT, DIN, F.G, F.bid); pg8::gemm_phase<EpiInProj, pg8::StaticOrder, true, true, false, true, -6>(F.lds, g, S, E, wave0); }
            else { LastInProjOrder S; S.T.init(TL, DIN, F.G, F.bid); S.nlat = (TL / 256) * (DIN / 256); S.G = F.G; S.c = F.bid; pg8::gemm_phase<EpiInProj, LastInProjOrder, true, true, false, true, -6>(F.lds, g, S, E, wave0); }
        }
        SEAM(pb + 1); PR_MARK(1);
        if (SEL(2) && IN(pb + 2)) { LVARS(); FRESH(); prep_phase(F, args, l, uc); }
        SEAM(pb + 2); PR_MARK(2);
        if (SEL(3) && IN(pb + 3)) { LVARS(); FRESH(); mixer_phase(F, args, l, uc, pr_sub, PROBE_SUB); }
        SEAM(pb + 3); PR_MARK(3);
        if (SEL(4) && IN(pb + 4)) { LVARS(); FRESH(); hyena_final_phase(F, args, l, uc); }
        SEAM(pb + 4); PR_MARK(4);
        if (SEL(5) && IN(pb + 5)) { LVARS();
            pg8::StaticOrder S; S.init(M2, 1024, F.G, F.bid);
            pg8::Gemm g{(const bf16_t*)(ws + WS_QA), (const bf16_t*)(ws + WS_WBR), M2, 1024, 1536}; EpiMerge E{(bf16_t*)(ws + WS_H), (const unsigned char*)(ws + WS_G), nullptr};
            pg8::gemm_phase<EpiMerge, pg8::StaticOrder, true, true>(F.lds, g, S, E, wave0);
            { FRESH(); __syncthreads(); const int nun = (M2 / 256) * 4, rem = nun % F.G; conv_expert_weights(F, args, l, rem, 0, CONV_E_ITEMS); __syncthreads(); }
        }
        SEAM(pb + 5); PR_MARK(5);
        if (SEL(6) && IN(pb + 6)) { LVARS();
            pg8::Gemm g{(const bf16_t*)(ws + WS_H), (const bf16_t*)(ws + WS_WOUT), M2, 1024, 1024}; pg8::StaticOrder S; S.init(M2, 1024, F.G, F.bid);
            EpiOut E{l == 0 ? args.in[I_X] : args.out, l == 0 ? args.in[I_CTX] : (const float*)(ws + WS_XC), args.out, (float*)(ws + WS_XC), (const float*)(ws + WS_MOD) + (size_t)l * NBM * DIN};
            pg8::gemm_phase<EpiOut, pg8::StaticOrder, true, true>(F.lds, g, S, E, wave0);
        }
        SEAM(pb + 6); PR_MARK(6);
        if (SEL(7) && IN(pb + 7)) { LVARS(); FRESH(); rows_p5(F, args, l, M2, pr_sub, PROBE_SUB); __syncthreads(); }
        SEAM(pb + 7); PR_MARK(7);
        if (SEL(8) && IN(pb + 8)) { LVARS(); FRESH();
            const int ntile = moe_tables(F, args, l, ebase, ecnt, tile_e);
            pg8::Gemm g{(const bf16_t*)(ws + WS_H), (const bf16_t*)(ws + WS_W13), ntile * 256, NE * 1024, 512}; MoeOrder S{ntile * 4, F.G, F.bid, tile_e};
            LAS int* gidx = (LAS int*)(F.lds + 131072);
            moe_gather_table(F, args, S, ebase, ecnt, gidx);
            EpiMoe1 E{ws + WS_U};
            pg8::gemm_phase<EpiMoe1, MoeOrder, true, true, true, true, -6>(F.lds, g, S, E, wave0, gidx);
        }
        SEAM(pb + 8); PR_MARK(8);
        if (SEL(9) && IN(pb + 9)) { LVARS(); FRESH();
            const int ntile = moe_tables(F, args, l, ebase, ecnt, tile_e);
            pg8::Gemm g{(const bf16_t*)(ws + WS_U), (const bf16_t*)(ws + WS_W2), ntile * 256, NE * 1024, 256}; MoeOrder S{ntile * 4, F.G, F.bid, tile_e};
            EpiMoe2 E{(bf16_t*)(ws + WS_F), (const int*)(ws + WS_EROW), (const float*)(ws + WS_EROWW), ebase, ecnt};
            pg8::gemm_phase<EpiMoe2, MoeOrder, true, true, false, true, -9>(F.lds, g, S, E, wave0);
        }
        SEAM(pb + 9); PR_MARK(9);
    }
    if (SEL(101) && IN(PH_FINAL)) { FRESH(); rows_final(F, args); }
#if defined(PROBE_P)
    PR_MARK(101);
    pr_acc += pr_sub;
    if (blockIdx.x == 0 && F.wave == 0) { const unsigned long long t1 = __builtin_amdgcn_s_memrealtime() + 4ull * pr_acc; while (__builtin_amdgcn_s_memrealtime() < t1) __builtin_amdgcn_s_sleep(8); }
#endif
#undef IN
#undef SEAM
}

extern "C" void kernel_launch(void* const* d_in, const int* in_sizes, int n_in, void* d_out, int out_size, void* d_ws, size_t ws_size, hipStream_t stream) {
    static int grid = 0;
    if (grid == 0) {
        if (n_in != 29 || in_sizes[0] != TL * D || out_size != TL * D || ws_size < WS_END) { fprintf(stderr, "kernel_launch: unexpected shapes / workspace (n_in %d, ws %zu < %zu); nothing launched\n", n_in, ws_size, (size_t)WS_END); grid = -1; return; }
        int dev = 0, cus = 0, per_cu = 0;
        if (hipGetDevice(&dev) != hipSuccess || hipDeviceGetAttribute(&cus, hipDeviceAttributeMultiprocessorCount, dev) != hipSuccess) { grid = -1; return; }
        if (hipFuncSetAttribute((const void*)trunk_fwd, hipFuncAttributeMaxDynamicSharedMemorySize, LDS_BYTES) != hipSuccess) { fprintf(stderr, "kernel_launch: hipFuncSetAttribute failed\n"); grid = -1; return; }
        if (hipOccupancyMaxActiveBlocksPerMultiprocessor(&per_cu, (const void*)trunk_fwd, NTHR, LDS_BYTES) != hipSuccess || per_cu < 1) { fprintf(stderr, "kernel_launch: occupancy query reports %d\n", per_cu); }
        (void)hipGetLastError();
        grid = cus;
    }
    if (grid < 0) return;
    (void)hipMemsetAsync((char*)d_ws + WS_CTL, 0, CTL_ZERO_BYTES, stream);
    Args a{};
    for (int i = 0; i < 29; ++i) a.in[i] = (const float*)d_in[i];
    a.out = (float*)d_out; a.ws = (unsigned char*)d_ws;
#if MK_PER_PHASE
    for (int k = 0; k < N_PHASES; ++k) { a.ph_lo = k; a.ph_hi = k + 1; hipLaunchKernelGGL(trunk_fwd, dim3(grid), dim3(NTHR), LDS_BYTES, stream, a); }
#else
    a.ph_lo = 0; a.ph_hi = N_PHASES;
    hipLaunchKernelGGL(trunk_fwd, dim3(grid), dim3(NTHR), LDS_BYTES, stream, a);
#endif
}
```

```cpp
#include <hip/hip_runtime.h>
#include <cstdio>
#include <cstdint>

#define GAS __attribute__((address_space(1)))
#define LAS __attribute__((address_space(3)))
__device__ __forceinline__ int lane_id() { int l; asm volatile("v_mbcnt_lo_u32_b32 %0, -1, 0\n\tv_mbcnt_hi_u32_b32 %0, -1, %0" : "=v"(l)); return l; }
#define MK_PER_PHASE 0
namespace pg8 {
#define PG8_LAS __attribute__((address_space(3)))
typedef unsigned short bf16_t;
typedef short bf16x8 __attribute__((ext_vector_type(8)));
typedef float f32x4 __attribute__((ext_vector_type(4)));
typedef unsigned u32x4 __attribute__((ext_vector_type(4)));
constexpr int BM = 256, BK = 64, HALF = 128, HTB = HALF * BK * 2  , STAGE_BYTES = 8 * HTB, NXCD = 8, WGM = 8;

__host__ __device__ __forceinline__ int lds_byte(int r, int c) { const int st = (r >> 4) * 2 + (c >> 5), rr = r & 15, cc = c & 31, ob = rr * 64 + cc * 2; return st * 1024 + (ob ^ (((ob >> 9) & 1) << 5)); }
__host__ __device__ __forceinline__ void stage_rc(int b, int& R, int& C) { const int st = b / 1024, sb = b % 1024, swz = sb ^ (((sb >> 9) & 1) << 5); R = (st >> 1) * 16 + swz / 64; C = (st & 1) * 32 + (swz % 64) / 2; }
__host__ __device__ __forceinline__ int perm32(int rho) { const int n = rho >> 4, i = rho & 15; return 8 * (i >> 2) + 4 * n + (i & 3); }

struct Unit { int pm, pn; };
struct Gemm { const bf16_t* A; const bf16_t* Bt; int M, N, K; };

struct StaticOrder {
    int nM, nN, nwg, G, c;
    __host__ __device__ void init(int M, int N, int G_, int c_) { nM = M / BM; nN = N / BM; nwg = nM * nN; G = G_; c = c_; }
    __host__ __device__ bool next(int i, Unit& u) const {
        const long L = (long)i * G + c; if (L >= nwg) return false;
        int wgid = (int)L; { const int q = nwg / NXCD, r = nwg % NXCD, xcd = wgid % NXCD, off = wgid / NXCD; wgid = (xcd < r ? xcd * (q + 1) : r * (q + 1) + (xcd - r) * q) + off; }
        const int nig = WGM * nN, gid = wgid / nig, fm = gid * WGM, gsz = (nM - fm) < WGM ? (nM - fm) : WGM;
        u.pm = fm + ((wgid % nig) % gsz); u.pn = (wgid % nig) / gsz; return true;
    }
    __device__ __forceinline__ void a_ready(const Unit&) const {}
    __device__ __forceinline__ void done(const Unit&) const {}
};
__device__ __forceinline__ unsigned cvt_pk_bf16(float lo, float hi) { unsigned r; asm volatile("v_cvt_pk_bf16_f32 %0, %1, %2" : "=v"(r) : "v"(lo), "v"(hi)); return r; }
typedef float f32x2 __attribute__((ext_vector_type(2)));
template <class Epi, class Sched, bool ALIGN_EPI = false, bool SP2 = false, bool GATHER = false, bool F8 = false, int F8_SW = 0>
__device__ __forceinline__ void gemm_phase(PG8_LAS unsigned char* lds, const Gemm g, const Sched& S, const Epi& E, const int wave_id, const PG8_LAS int* gidx = nullptr) {
    static_assert(!GATHER || SP2, "GATHER is implemented for the SP2 loop only");
    int tid_ = wave_id * 64 + lane_id(); asm volatile("" : "+v"(tid_));
    const int tid = tid_, wid = __builtin_amdgcn_readfirstlane(tid >> 6), lane = tid & 63, wr = wid >> 2, wc = wid & 3, fr = lane & 15, fq = lane >> 4;
    const int K = g.K, nt = K / BK;
    unsigned voffA[2], voffB[2];
#pragma unroll
    for (int i = 0; i < 2; ++i) { int R, C; stage_rc(tid * 16 + i * 8192, R, C); const int Rb = Epi::PERM ? ((R & ~31) + perm32(R & 31)) : R;
        voffA[i] = (unsigned)(R * K + C) * 2u; voffB[i] = (unsigned)(Rb * K + C) * 2u; }
    unsigned goffA[2][2], goffN[2][2];
#define PG8_GOFF(dst, j) do { _Pragma("unroll") for (int _h = 0; _h < 2; ++_h) _Pragma("unroll") for (int _i = 0; _i < 2; ++_i) { int R_, C_; stage_rc(tid * 16 + _i * 8192, R_, C_); \
        dst[_h][_i] = ((unsigned)gidx[(j) * 256 + _h * 128 + R_] * (unsigned)K + (unsigned)C_) * 2u; } } while (0)
#define PG8_STAGE_A(bufoff, base, h, nx) do { if constexpr (GATHER) { unsigned o_[2] = {(nx) ? goffN[h][0] : goffA[h][0], (nx) ? goffN[h][1] : goffA[h][1]}; PG8_STAGE(bufoff, base, o_); } \
        else { PG8_STAGE(bufoff, (base) + ((h) ? hstep : 0), voffA); } } while (0)
    const size_t kstep = (size_t)(BK * 2);
    const size_t hstep = (size_t)HALF * K * 2;
    const size_t tstep = 2 * hstep;
    const unsigned ldsw = (unsigned)wid * 1024u;
    const int aoff = lds_byte(wr * 64 + fr, fq * 8), boff = lds_byte(wc * 32 + fr, fq * 8);
#define PG8_SA(b, h) (((b) * 2 + (h)) * HTB)
#define PG8_SB(b, h) ((4 + (b) * 2 + (h)) * HTB)
#define PG8_STAGE(bufoff, gbase, voff) do { _Pragma("unroll") for (int _i = 0; _i < 2; ++_i) \
        __builtin_amdgcn_global_load_lds((const unsigned*)((const char*)(gbase) + (voff)[_i]), (PG8_LAS unsigned*)(lds + (bufoff) + ldsw + _i * 8192), 16, 0, 0); } while (0)
#define PG8_LDA(dst, b, h) do { _Pragma("unroll") for (int m = 0; m < 4; ++m) _Pragma("unroll") for (int k = 0; k < 2; ++k) dst[m][k] = *(const PG8_LAS bf16x8*)(lds + PG8_SA(b, h) + aoff + m * 2048 + k * 1024); } while (0)
#define PG8_LDB(dst, b, h) do { _Pragma("unroll") for (int n = 0; n < 2; ++n) _Pragma("unroll") for (int k = 0; k < 2; ++k) dst[n][k] = *(const PG8_LAS bf16x8*)(lds + PG8_SB(b, h) + boff + n * 2048 + k * 1024); } while (0)
#define PG8_MMA(ai, bj, At, Bt) do { if constexpr (F8) __builtin_amdgcn_sched_barrier(0); __builtin_amdgcn_s_setprio(1); _Pragma("unroll") for (int m = 0; m < 4; ++m) _Pragma("unroll") for (int n = 0; n < 2; ++n) { \
        if constexpr (F8) { typedef int i32x4_ __attribute__((ext_vector_type(4))); typedef int i32x8_ __attribute__((ext_vector_type(8))); \
            const i32x8_ wf = __builtin_shufflevector(__builtin_bit_cast(i32x4_, Bt[n][0]), __builtin_bit_cast(i32x4_, Bt[n][1]), 0, 1, 2, 3, 4, 5, 6, 7); \
            const i32x8_ af = __builtin_shufflevector(__builtin_bit_cast(i32x4_, At[m][0]), __builtin_bit_cast(i32x4_, At[m][1]), 0, 1, 2, 3, 4, 5, 6, 7); \
              \
            asm volatile("v_mfma_scale_f32_16x16x128_f8f6f4 %0, %1, %2, %0, %3, %4 op_sel_hi:[0,0,0]" : "+v"(acc[ai][bj][m][n]) : "v"(wf), "v"(af), "v"(f8sw), "v"(f8sa)); } \
        else { _Pragma("unroll") for (int k = 0; k < 2; ++k) acc[ai][bj][m][n] = __builtin_amdgcn_mfma_f32_16x16x32_bf16(Bt[n][k], At[m][k], acc[ai][bj][m][n], 0, 0, 0); } } \
        __builtin_amdgcn_s_setprio(0); if constexpr (F8) __builtin_amdgcn_sched_barrier(0); } while (0)
#define PG8_WAIT_V(n) asm volatile("s_waitcnt vmcnt(" #n ")" ::: "memory")
#define PG8_WAIT_L(n) asm volatile("s_waitcnt lgkmcnt(" #n ")" ::: "memory")
#define PG8_BAR __builtin_amdgcn_s_barrier()
#define PG8_SCHED __builtin_amdgcn_sched_barrier(0)
    const int f8sw = 127 + F8_SW, f8sa = 127; (void)f8sw; (void)f8sa;
    Unit cur, nxt; int ui = 0;
    if (!S.next(0, cur)) return;
    f32x4 acc[2][2][4][2];
#pragma unroll
    for (int a = 0; a < 2; ++a)
#pragma unroll
        for (int b = 0; b < 2; ++b)
#pragma unroll
            for (int m = 0; m < 4; ++m)
#pragma unroll
                for (int n = 0; n < 2; ++n) acc[a][b][m][n] = (f32x4){0.f, 0.f, 0.f, 0.f};
    bf16x8 At[4][2], B0[2][2], B1[2][2];
    const char* cA = GATHER ? (const char*)g.A : (const char*)g.A + (size_t)cur.pm * tstep; const char* cB = (const char*)g.Bt + (size_t)cur.pn * tstep;
    if constexpr (GATHER) PG8_GOFF(goffA, 0);
    S.a_ready(cur);
    if constexpr (SP2) {
        PG8_STAGE(PG8_SB(0, 0), cB, voffB); PG8_STAGE(PG8_SB(0, 1), cB + hstep, voffB); PG8_STAGE_A(PG8_SA(0, 0), cA, 0, false); PG8_STAGE_A(PG8_SA(0, 1), cA, 1, false);
        if (wr == 1) PG8_BAR;
        PG8_WAIT_V(2); PG8_BAR;
        PG8_STAGE(PG8_SB(1, 0), cB + kstep, voffB); PG8_STAGE_A(PG8_SA(1, 0), cA + kstep, 0, false); PG8_STAGE(PG8_SB(1, 1), cB + hstep + kstep, voffB);
        PG8_WAIT_V(6); PG8_BAR;
    } else {
        PG8_STAGE(PG8_SB(0, 0), cB, voffB); PG8_STAGE(PG8_SA(0, 0), cA, voffA); PG8_STAGE(PG8_SB(0, 1), cB + hstep, voffB); PG8_STAGE(PG8_SA(0, 1), cA + hstep, voffA);
        if (wr == 1) PG8_BAR;
        PG8_WAIT_V(4); PG8_BAR;
        PG8_STAGE(PG8_SB(1, 0), cB + kstep, voffB); PG8_STAGE(PG8_SA(1, 0), cA + kstep, voffA); PG8_STAGE(PG8_SB(1, 1), cB + hstep + kstep, voffB);
        PG8_WAIT_V(6); PG8_BAR;
    }
    for (;;) {
        const bool has_next = S.next(ui + 1, nxt);
        if constexpr (GATHER) { if (has_next) PG8_GOFF(goffN, ui + 1); else { _Pragma("unroll") for (int _h = 0; _h < 2; ++_h) _Pragma("unroll") for (int _i = 0; _i < 2; ++_i) goffN[_h][_i] = goffA[_h][_i]; } }
        const char* nA = GATHER ? (const char*)g.A : has_next ? (const char*)g.A + (size_t)nxt.pm * tstep : cA; const char* nB = has_next ? (const char*)g.Bt + (size_t)nxt.pn * tstep : cB;
        for (int t = 0; t < nt; t += 2) {
            const bool last = (t == nt - 2);
            const char* a1 = cA + (size_t)(t + 1) * kstep;
            const char* a2 = last ? nA : cA + (size_t)(t + 2) * kstep; const char* b2 = last ? nB : cB + (size_t)(t + 2) * kstep;
            const char* a3 = a2 + kstep; const char* b3 = b2 + kstep;
            if (last && has_next) S.a_ready(nxt);
            if constexpr (SP2) {
            PG8_LDB(B0, 0, 0); PG8_LDB(B1, 0, 1); PG8_SCHED; PG8_LDA(At, 0, 0); PG8_STAGE_A(PG8_SA(1, 1), a1, 1, false);
            PG8_WAIT_V(8); PG8_WAIT_L(0); PG8_BAR; PG8_MMA(0, 0, At, B0); PG8_MMA(0, 1, At, B1); PG8_BAR; PG8_SCHED;
            PG8_LDA(At, 0, 1); PG8_STAGE(PG8_SB(0, 0), b2, voffB); PG8_STAGE(PG8_SB(0, 1), b2 + hstep, voffB); PG8_STAGE_A(PG8_SA(0, 0), a2, 0, last);
            PG8_WAIT_V(8); PG8_WAIT_L(0); PG8_BAR; PG8_MMA(1, 0, At, B0); PG8_MMA(1, 1, At, B1); PG8_BAR; PG8_SCHED;
            PG8_LDB(B0, 1, 0); PG8_LDB(B1, 1, 1); PG8_SCHED; PG8_LDA(At, 1, 0); PG8_STAGE_A(PG8_SA(0, 1), a2, 1, last);
            PG8_WAIT_V(8); PG8_WAIT_L(0); PG8_BAR; PG8_MMA(0, 0, At, B0); PG8_MMA(0, 1, At, B1); PG8_BAR; PG8_SCHED;
            PG8_LDA(At, 1, 1); PG8_STAGE(PG8_SB(1, 0), b3, voffB); PG8_STAGE(PG8_SB(1, 1), b3 + hstep, voffB); PG8_STAGE_A(PG8_SA(1, 0), a3, 0, last);
            PG8_WAIT_V(8); PG8_WAIT_L(0); PG8_BAR; PG8_MMA(1, 0, At, B0); PG8_MMA(1, 1, At, B1); PG8_BAR; PG8_SCHED;
            if constexpr (Epi::NSEG > 1) {
                constexpr int SEGT = F8 ? 4 : 8;
                if (t + 2 < nt && ((t + 2) & (SEGT - 1)) == 0) { if constexpr (F8) asm volatile("s_nop 15\n\ts_nop 15" ::: "memory"); E.rescale(acc, cur, (t + 2) / SEGT - 1, wr, wc, fr, fq); }
            }
            } else {
            PG8_LDB(B0, 0, 0); PG8_SCHED; PG8_LDA(At, 0, 0); PG8_STAGE(PG8_SA(1, 1), a1 + hstep, voffA);
            PG8_WAIT_L(8); PG8_BAR; PG8_WAIT_L(0); PG8_MMA(0, 0, At, B0); PG8_BAR; PG8_SCHED;
            PG8_LDB(B1, 0, 1); PG8_STAGE(PG8_SB(0, 0), b2, voffB);
            PG8_BAR; PG8_WAIT_L(0); PG8_MMA(0, 1, At, B1); PG8_BAR;
            PG8_LDA(At, 0, 1); PG8_STAGE(PG8_SA(0, 0), a2, voffA);
            PG8_BAR; PG8_WAIT_L(0); PG8_MMA(1, 0, At, B0); PG8_BAR; PG8_SCHED;
            PG8_STAGE(PG8_SB(0, 1), b2 + hstep, voffB);
            PG8_WAIT_V(6); PG8_BAR; PG8_MMA(1, 1, At, B1); PG8_BAR;
            PG8_LDB(B0, 1, 0); PG8_SCHED; PG8_LDA(At, 1, 0); PG8_STAGE(PG8_SA(0, 1), a2 + hstep, voffA);
            PG8_WAIT_L(8); PG8_BAR; PG8_WAIT_L(0); PG8_MMA(0, 0, At, B0); PG8_BAR; PG8_SCHED;
            PG8_LDB(B1, 1, 1); PG8_STAGE(PG8_SB(1, 0), b3, voffB);
            PG8_BAR; PG8_WAIT_L(0); PG8_MMA(0, 1, At, B1); PG8_BAR;
            PG8_LDA(At, 1, 1); PG8_STAGE(PG8_SA(1, 0), a3, voffA);
            PG8_BAR; PG8_WAIT_L(0); PG8_MMA(1, 0, At, B0); PG8_BAR; PG8_SCHED;
            PG8_STAGE(PG8_SB(1, 1), b3 + hstep, voffB);
            PG8_WAIT_V(6); PG8_BAR; PG8_MMA(1, 1, At, B1); PG8_BAR;
            }
        }
        if constexpr (ALIGN_EPI) { if (wr == 0) PG8_BAR; }
        if constexpr (F8) asm volatile("s_nop 15\n\ts_nop 15" ::: "memory");
        if constexpr (!Epi::AFTER_DRAIN) { E(acc, cur, wr, wc, fr, fq); S.done(cur); }
        if (!has_next) break;
#pragma unroll
        for (int a = 0; a < 2; ++a)
#pragma unroll
            for (int b = 0; b < 2; ++b)
#pragma unroll
                for (int m = 0; m < 4; ++m)
#pragma unroll
                    for (int n = 0; n < 2; ++n) acc[a][b][m][n] = (f32x4){0.f, 0.f, 0.f, 0.f};
        cur = nxt; cA = nA; cB = nB; ++ui;
        if constexpr (GATHER) { _Pragma("unroll") for (int _h = 0; _h < 2; ++_h) _Pragma("unroll") for (int _i = 0; _i < 2; ++_i) goffA[_h][_i] = goffN[_h][_i]; }
        if constexpr (ALIGN_EPI) { if (wr == 1) PG8_BAR; }
    }
    PG8_WAIT_V(0);
    if constexpr (!ALIGN_EPI) { if (wr == 0) PG8_BAR; }
    PG8_BAR;
    if constexpr (Epi::AFTER_DRAIN) { E.fused(acc, cur, wr, wc, fr, fq, lds, wid, lane); S.done(cur); }
#undef PG8_SA
#undef PG8_SB
#undef PG8_STAGE
#undef PG8_STAGE_A
#undef PG8_GOFF
#undef PG8_LDA
#undef PG8_LDB
#undef PG8_MMA
#undef PG8_WAIT_V
#undef PG8_WAIT_L
#undef PG8_BAR
#undef PG8_SCHED
}
}
#define XB_TMO      128
#define XB_XCNT(j)  (256  + 64 * (j))
#define XB_XSUB(j)  (1280 + 64 * (j))
#define XB_XGEN(j)  (2304 + 64 * (j))
#define XB_TOP      3328
#define XB_TOPGEN   3392
#define XCD_BAR_WORDS 3456
#define XB_SPIN_CAP (1u << 22)
#define LAS __attribute__((address_space(3)))

__device__ __forceinline__ unsigned xb_ld(unsigned* p)              { return __hip_atomic_load(p, __ATOMIC_RELAXED, __HIP_MEMORY_SCOPE_AGENT); }
__device__ __forceinline__ unsigned xb_add(unsigned* p, unsigned v) { asm volatile("" : "+v"(p));
    return __hip_atomic_fetch_add(p, v, __ATOMIC_RELAXED, __HIP_MEMORY_SCOPE_AGENT); }
__device__ __forceinline__ unsigned xb_xcc_id() { return (unsigned)__builtin_amdgcn_s_getreg((3 << 11) | 20) & 0xFu; }
#define XB_SPIN(cond, bar) do { unsigned _sp = 0; while (cond) { __builtin_amdgcn_s_sleep(1); \
    if ((++_sp & 255u) == 0u) { if (xb_ld(&(bar)[XB_TMO])) break; if (_sp > XB_SPIN_CAP) { xb_add(&(bar)[XB_TMO], 1u); break; } } } } while (0)

struct XcdBarrier {
    unsigned* bar; unsigned x; unsigned wv;
    volatile LAS unsigned* st;
};

__device__ __forceinline__ XcdBarrier xcd_barrier_post(unsigned* bar, volatile LAS unsigned* st) {
    XcdBarrier b; b.bar = bar; b.x = xb_xcc_id(); b.st = st;
    if (threadIdx.x == 0) (void)xb_add(&bar[XB_XCNT(b.x)], 1u);
    return b;
}
__device__ __forceinline__ void xcd_barrier_complete(unsigned* bar, unsigned x, unsigned& nloc, unsigned& nx) {
    const unsigned G = gridDim.x * gridDim.y * gridDim.z;
    unsigned sum, cnt, mine, sp = 0u;
    for (;;) {
        sum = 0u; cnt = 0u; mine = 0u;
#pragma unroll
        for (unsigned j = 0; j < 16; ++j) { const unsigned c = xb_ld(&bar[XB_XCNT(j)]); sum += c; cnt += (c > 0u) ? 1u : 0u; mine = (j == x) ? c : mine; }
        if (sum == G) break;
        __builtin_amdgcn_s_sleep(1);
        if ((++sp & 255u) == 0u) { if (xb_ld(&bar[XB_TMO])) break; if (sp > XB_SPIN_CAP) { xb_add(&bar[XB_TMO], 1u); break; } }
    }
    nloc = mine > 0u ? mine : 1u; nx = cnt > 0u ? cnt : 1u;
}

__device__ __forceinline__ void xcd_barrier(const XcdBarrier& b) {
    asm volatile("s_waitcnt vmcnt(0)" ::: "memory");
    __syncthreads();
    if (b.wv == 0u && lane_id() == 0) {
        unsigned* bar = b.bar;
        __builtin_amdgcn_s_waitcnt(0);
        unsigned nloc = b.st[0], nx = b.st[1];
        if (nloc == 0u) { xcd_barrier_complete(bar, b.x, nloc, nx); b.st[0] = nloc; b.st[1] = nx; }
        const unsigned old = xb_add(&bar[XB_XSUB(b.x)], 1u);
        const unsigned gen = old / nloc;
        if (old + 1u == (gen + 1u) * nloc) {
            __builtin_amdgcn_fence(__ATOMIC_RELEASE, "agent");
            asm volatile("s_waitcnt vmcnt(0)" ::: "memory");
            const unsigned og = xb_add(&bar[XB_TOP], 1u);
            const unsigned tg = og / nx;
            if (og + 1u == (tg + 1u) * nx) xb_add(&bar[XB_TOPGEN], 1u);
            else XB_SPIN(xb_ld(&bar[XB_TOPGEN]) == tg, bar);
            __builtin_amdgcn_fence(__ATOMIC_ACQUIRE, "agent");
            xb_add(&bar[XB_XGEN(b.x)], 1u);
            asm volatile("s_waitcnt vmcnt(0)" ::: "memory");
        } else {
            XB_SPIN(xb_ld(&bar[XB_XGEN(b.x)]) == gen, bar);
            __builtin_amdgcn_fence(__ATOMIC_ACQUIRE, "agent");
            asm volatile("s_waitcnt vmcnt(0)" ::: "memory");
        }
    }
    __syncthreads();
}

typedef unsigned short bf16_t;
typedef short bf16x8 __attribute__((ext_vector_type(8)));
typedef float f32x4 __attribute__((ext_vector_type(4)));
typedef float f32x16 __attribute__((ext_vector_type(16)));
typedef unsigned u32x4 __attribute__((ext_vector_type(4)));
typedef unsigned u32x2 __attribute__((ext_vector_type(2)));

constexpr int D = 1024, NB = 16, SEQ = 2048, CTX = 256, NL = 4;
constexpr int TL = NB * SEQ, TC = NB * CTX, TT = TL + TC;
constexpr int DIN = 6144, HYW = 512, NE = 16, DE = 512, KEYS = CTX + SEQ;
constexpr int NMOD = 6, NBM = NB + 1;
constexpr int APROWS = 2 * TT + NE * 256;
constexpr float EPS = 1e-6f, LOG2E = 1.4426950408889634f;
constexpr float QSCALE = 0.125f * LOG2E;

constexpr size_t MiB = 1u << 20;
constexpr size_t WS_CTL = 0, CTL_ZERO_BYTES = 1 * MiB;
constexpr size_t WS_MOD = 1 * MiB;
constexpr size_t WS_ROPE = 3 * MiB;
constexpr size_t WS_FL = 4 * MiB, WS_FC = 20 * MiB;
constexpr size_t WS_MISC = 22 * MiB;
constexpr size_t WS_FNORM = WS_MISC;
constexpr size_t WS_TOKE = WS_MISC + 64 * 1024, WS_TOKP = WS_MISC + 352 * 1024, WS_TOKW = WS_MISC + 640 * 1024;
constexpr size_t WS_ROWMAP = WS_MISC + 960 * 1024, WS_ROWW = WS_MISC + 1280 * 1024;
constexpr size_t WS_WIN = 24 * MiB, WS_WBR = 36 * MiB, WS_WOUT = 39 * MiB;
constexpr size_t WS_XC = 41 * MiB;
constexpr size_t WS_NP = WS_XC;
constexpr size_t WS_H = 57 * MiB;
constexpr size_t WS_KA = 129 * MiB, WS_VTA = 138 * MiB, WS_KW = 147 * MiB, WS_VTW = 156 * MiB;
constexpr size_t WS_QA = 165 * MiB, WS_QW = 201 * MiB, WS_YH = 237 * MiB, WS_VT = 273 * MiB, WS_YT = 309 * MiB;
constexpr size_t WS_RAWA = 309 * MiB, WS_RAWW = 327 * MiB;
constexpr size_t WS_F = 165 * MiB;
constexpr size_t WS_U = 345 * MiB;
constexpr size_t WS_G = 453 * MiB;
constexpr size_t WS_Y8 = 561 * MiB;
constexpr size_t WS_W13 = 621 * MiB, WS_W2 = 637 * MiB;
constexpr size_t WS_EROW = 669 * MiB, WS_EROWW = 672 * MiB;
constexpr size_t WS_H8 = 675 * MiB;
constexpr size_t WS_WG8 = WS_WIN;
constexpr size_t WS_END = 711 * MiB;
static_assert(WS_G + (size_t)TT * 3072 <= WS_Y8 && WS_Y8 + (size_t)TT * 1536 <= WS_W13 && WS_W13 + (size_t)16 * 1024 * 1024 <= WS_W2 && WS_W2 + (size_t)16 * 1024 * 512 <= WS_EROW, "ws map");
static_assert(WS_U + (size_t)APROWS * 1024 <= WS_G && WS_F + (size_t)2 * TT * 2048 <= WS_YT, "ws map 2");
constexpr size_t VT_CTX_OFF = (size_t)HYW * NB * SEQ;

constexpr int CW_BAR = 4096, CW_CNT = 8192, CW_PANEL = 16384, CW_HTMO = 12288;
constexpr int LDS_BYTES = 151552, MISC_OFF = 147456;
constexpr int NWAVES = 8, NTHR = 512;

struct Args { const float* in[29]; float* out; unsigned char* ws; int ph_lo, ph_hi; };
enum { I_X = 0, I_C, I_CTX, I_CCTX, I_ADAW, I_ADAB, I_N1G, I_N2G, I_WIN, I_QKG, I_HSW, I_HSB, I_HW1, I_HB1, I_HFR, I_HW2, I_HB2, I_HW3, I_HBIAS, I_SINK, I_WBR, I_WOUT,
       I_RGW, I_RGB, I_REW, I_REB, I_EW1, I_EW3, I_EW2 };

#define LDS_WAIT() asm volatile("s_waitcnt lgkmcnt(0)" ::: "memory")
#define VM_WAIT() asm volatile("s_waitcnt vmcnt(0)" ::: "memory")

typedef float f32x2_t __attribute__((ext_vector_type(2)));
typedef __bf16 bf16x2_t __attribute__((ext_vector_type(2)));
__device__ __forceinline__ unsigned cvtpk(float lo, float hi) { f32x2_t v = {lo, hi}; bf16x2_t b = __builtin_convertvector(v, bf16x2_t); return __builtin_bit_cast(unsigned, b); }
__device__ __forceinline__ unsigned zero_u32() { unsigned z; asm volatile("v_mov_b32 %0, 0" : "=v"(z)); return z; }
__device__ __forceinline__ unsigned cvt4_fp8(float a, float b, float c, float d) { int r = __builtin_amdgcn_cvt_pk_fp8_f32(a, b, 0, false); r = __builtin_amdgcn_cvt_pk_fp8_f32(c, d, r, true); return (unsigned)r; }
__device__ __forceinline__ float bflo(unsigned u) { return __builtin_bit_cast(float, u << 16); }
__device__ __forceinline__ float bfhi(unsigned u) { return __builtin_bit_cast(float, u & 0xffff0000u); }
__device__ __forceinline__ float bf1(bf16_t u) { return __builtin_bit_cast(float, (unsigned)u << 16); }
__device__ __forceinline__ bf16_t f2bf(float f) { return (bf16_t)(cvtpk(f, 0.f) & 0xffffu); }
#define DPP_F(v, ctrl) __builtin_bit_cast(float, __builtin_amdgcn_update_dpp(0, __builtin_bit_cast(int, (v)), (ctrl), 0xf, 0xf, false))
__device__ __forceinline__ float row16_sum(float v) {
    v += DPP_F(v, 0xB1);
    v += DPP_F(v, 0x4E);
    v += DPP_F(v, 0x141);
    v += DPP_F(v, 0x140);
    return v;
}
__device__ __forceinline__ float wave_sum(float v) {
    v = row16_sum(v);
    const int iv = __builtin_bit_cast(int, v);
    float r = (__builtin_bit_cast(float, __builtin_amdgcn_readlane(iv, 0)) + __builtin_bit_cast(float, __builtin_amdgcn_readlane(iv, 16)))
            + (__builtin_bit_cast(float, __builtin_amdgcn_readlane(iv, 32)) + __builtin_bit_cast(float, __builtin_amdgcn_readlane(iv, 48)));
    asm volatile("" : "+v"(r));
    return r;
}
__device__ __forceinline__ float fast_exp2(float x) { return __builtin_amdgcn_exp2f(x); }
__device__ __forceinline__ float fast_rcp(float x) { return __builtin_amdgcn_rcpf(x); }
__device__ __forceinline__ float sigmoid_f(float x) { return fast_rcp(1.f + fast_exp2(-x * LOG2E)); }

__device__ __forceinline__ void sincos_acc(float x, float& s, float& c) {
    const float q = rintf(x * 0.636619772367581f);
    float y = fmaf(-q, 1.57079625129699707031f, x);
    y = fmaf(-q, 7.54978941586159635335e-08f, y);
    const float y2 = y * y;
    float sp = fmaf(y2, 2.7557314297e-06f, -1.9841270114e-04f); sp = fmaf(sp, y2, 8.3333337680e-03f); sp = fmaf(sp, y2, -1.6666667163e-01f); sp = fmaf(sp * y2, y, y);
    float cp = fmaf(y2, -2.7557314297e-07f, 2.4801587642e-05f); cp = fmaf(cp, y2, -1.3888889225e-03f); cp = fmaf(cp, y2, 4.1666667908e-02f); cp = fmaf(cp, y2, -0.5f); cp = fmaf(cp, y2, 1.0f);
    const int n = (int)q & 3;
    const float s1 = (n & 1) ? cp : sp, c1 = (n & 1) ? sp : cp;
    s = (n & 2) ? -s1 : s1;
    c = ((n + 1) & 2) ? -c1 : c1;
}

struct Fr { LAS unsigned char* lds; int tid, lane, wave, G, bid; };

__device__ __forceinline__ void pro_mod(const Fr& F, const Args& a) {
    LAS float* s = (LAS float*)F.lds;
    LAS float* red = (LAS float*)(F.lds + 69632);
    const float* c = a.in[I_C]; const float* cc = a.in[I_CCTX]; const float* W = a.in[I_ADAW]; const float* Bv = a.in[I_ADAB];
    float* MOD = (float*)(a.ws + WS_MOD);
    for (int i = F.tid; i < NBM * 1024; i += NTHR) { const int bb = i >> 10, k = i & 1023; const float v = (bb < NB) ? c[bb * 1024 + k] : cc[k]; s[i] = v / (1.f + __expf(-v)); }
    __syncthreads();
    const int col = F.tid & 63, ks = F.wave;
    for (int unit = F.G - 1 - F.bid; unit < NL * 96; unit += F.G) {
        const int l = unit / 96, j0 = (unit % 96) * 64;
        float acc[NBM];
#pragma unroll
        for (int bb = 0; bb < NBM; ++bb) acc[bb] = 0.f;
        const float* Wp = W + ((size_t)l * 1024 + ks * 128) * DIN + j0 + col;
#pragma unroll 2
        for (int k = 0; k < 128; k += 4) {
            const float w0 = Wp[(size_t)k * DIN], w1 = Wp[(size_t)(k + 1) * DIN], w2 = Wp[(size_t)(k + 2) * DIN], w3 = Wp[(size_t)(k + 3) * DIN];
#pragma unroll
            for (int bb = 0; bb < NBM; ++bb) { const f32x4 sv = *(const LAS f32x4*)(s + bb * 1024 + ks * 128 + k);
                acc[bb] = fmaf(sv.x, w0, acc[bb]); acc[bb] = fmaf(sv.y, w1, acc[bb]); acc[bb] = fmaf(sv.z, w2, acc[bb]); acc[bb] = fmaf(sv.w, w3, acc[bb]); } }
#pragma unroll
        for (int bb = 0; bb < NBM; ++bb) red[(ks * NBM + bb) * 64 + col] = acc[bb];
        __syncthreads();
        for (int o = F.tid; o < NBM * 64; o += NTHR) { const int bb = o >> 6, cx = o & 63; float sum = 0.f;
#pragma unroll
            for (int k2 = 0; k2 < 8; ++k2) sum += red[(k2 * NBM + bb) * 64 + cx];
            MOD[((size_t)l * NBM + bb) * DIN + j0 + cx] = sum + Bv[l * DIN + j0 + cx]; }
        __syncthreads();
    }
}

__device__ __forceinline__ void pro_rope(const Fr& F, const Args& a) {
    float* ct = (float*)(a.ws + WS_ROPE); float* st = ct + SEQ * 32;
    for (int i = F.bid * NTHR + F.tid; i < SEQ * 32; i += F.G * NTHR) {
        const int pos = i >> 5, ax = (i >> 4) & 1, f = i & 15;
        const float inv = exp2f(-(float)f * (13.287712379549449f / 16.f));
        const float ang = (float)(ax == 0 ? (pos >> 6) : (pos & 63)) * inv;
        float sv, cv; sincos_acc(ang, sv, cv); ct[i] = cv; st[i] = sv;
    }
}

__device__ __forceinline__ void pro_filter(const Fr& F, const Args& a) {
    LAS float* L = (LAS float*)F.lds;
    constexpr int oW1 = 0, oB1 = 2112, oFR = 2176, oB2 = 2240, oW2 = 2304, oZ = 6400, oH1 = 7552, oH2 = 9600, oW3 = 11648, oT = 19840;
    bf16_t* FL = (bf16_t*)(a.ws + WS_FL); bf16_t* FC = (bf16_t*)(a.ws + WS_FC); float* NP = (float*)(a.ws + WS_NP);
    const int p = F.tid >> 4, jj = F.tid & 15;
    for (int unit = F.bid; unit < NL * 72; unit += F.G) {
        const int l = unit / 72, ch = unit % 72; const bool lat = ch < 64; const int n = lat ? SEQ : CTX, pos0 = lat ? ch * 32 : (ch - 64) * 32;
        __syncthreads();
        for (int i = F.tid; i < 2112; i += NTHR) L[oW1 + i] = a.in[I_HW1][l * 2112 + i];
        for (int i = F.tid; i < 64; i += NTHR) { L[oB1 + i] = a.in[I_HB1][l * 64 + i]; L[oFR + i] = a.in[I_HFR][l * 64 + i]; L[oB2 + i] = a.in[I_HB2][l * 64 + i]; }
        for (int i = F.tid; i < 4096; i += NTHR) L[oW2 + i] = a.in[I_HW2][l * 4096 + i];
        const int pos = pos0 + p; const float t = (float)pos / (float)(n - 1);
        { const float band = 1e-4f + (float)jj * ((15.f - 1e-4f) / 15.f); const float ang = ((6.2831855f * band) * (float)pos) / (float)n;
          float sv, cv; sincos_acc(ang, sv, cv); L[oZ + p * 36 + 1 + jj] = cv; L[oZ + p * 36 + 17 + jj] = -sv; if (jj == 0) L[oZ + p * 36] = t; }
        __syncthreads();
        { f32x4 acc = *(const LAS f32x4*)(L + oB1 + 4 * jj);
#pragma unroll 3
          for (int i = 0; i < 33; ++i) { const float z = L[oZ + p * 36 + i]; const f32x4 w = *(const LAS f32x4*)(L + oW1 + i * 64 + 4 * jj); acc.x = fmaf(z, w.x, acc.x); acc.y = fmaf(z, w.y, acc.y); acc.z = fmaf(z, w.z, acc.z); acc.w = fmaf(z, w.w, acc.w); }
          const f32x4 fr = *(const LAS f32x4*)(L + oFR + 4 * jj); float sv, cv; f32x4 o;
          sincos_acc(fr.x * acc.x, sv, cv); o.x = sv; sincos_acc(fr.y * acc.y, sv, cv); o.y = sv; sincos_acc(fr.z * acc.z, sv, cv); o.z = sv; sincos_acc(fr.w * acc.w, sv, cv); o.w = sv;
          *(LAS f32x4*)(L + oH1 + p * 64 + 4 * jj) = o; }
        __syncthreads();
        { f32x4 acc = *(const LAS f32x4*)(L + oB2 + 4 * jj);
#pragma unroll 4
          for (int i = 0; i < 64; ++i) { const float z = L[oH1 + p * 64 + i]; const f32x4 w = *(const LAS f32x4*)(L + oW2 + i * 64 + 4 * jj); acc.x = fmaf(z, w.x, acc.x); acc.y = fmaf(z, w.y, acc.y); acc.z = fmaf(z, w.z, acc.z); acc.w = fmaf(z, w.w, acc.w); }
          const f32x4 fr = *(const LAS f32x4*)(L + oFR + 4 * jj); float sv, cv; f32x4 o;
          sincos_acc(fr.x * acc.x, sv, cv); o.x = sv; sincos_acc(fr.y * acc.y, sv, cv); o.y = sv; sincos_acc(fr.z * acc.z, sv, cv); o.z = sv; sincos_acc(fr.w * acc.w, sv, cv); o.w = sv;
          *(LAS f32x4*)(L + oH2 + p * 64 + 4 * jj) = o; }
        LAS bf16_t* T = (LAS bf16_t*)(L + oT);
#pragma unroll 1
        for (int mh = 0; mh < 1; ++mh) {
            f32x4 acc[16];
#pragma unroll
            for (int m = 0; m < 16; ++m) acc[m] = (f32x4){0.f, 0.f, 0.f, 0.f};
#pragma unroll 1
            for (int kc = 0; kc < 8; ++kc) {
                __syncthreads();
                for (int i = F.tid; i < 2048; i += NTHR) *(LAS f32x4*)(L + oW3 + i * 4) = *(const f32x4*)(a.in[I_HW3] + ((size_t)l * 64 + kc * 8) * 1024 + i * 4);
                __syncthreads();
#pragma unroll 1
                for (int k = 0; k < 8; ++k) { const float h = L[oH2 + p * 64 + kc * 8 + k];
#pragma unroll
                    for (int m = 0; m < 16; ++m) { const f32x4 w = *(const LAS f32x4*)(L + oW3 + k * 1024 + 64 * m + 4 * jj);
                        acc[m].x = fmaf(h, w.x, acc[m].x); acc[m].y = fmaf(h, w.y, acc[m].y); acc[m].z = fmaf(h, w.z, acc[m].z); acc[m].w = fmaf(h, w.w, acc[m].w); } }
            }
#pragma unroll
            for (int m = 0; m < 16; ++m) {
                const int colb = 64 * m + 4 * jj; const int dirb = m >> 3;
                const float v4[4] = {acc[m].x, acc[m].y, acc[m].z, acc[m].w};
#pragma unroll
                for (int e = 0; e < 4; ++e) { const int col = colb + e, c = col & 511;
                    const float dl = fabsf(-3.0701134573253943f + (-15.350567286626972f + 3.0701134573253943f) * ((float)c / 511.f));
                    float v = v4[e] * __expf(-t * dl); if (dirb == 1 && pos == 0) v = 0.f;
                    T[col * 32 + (dirb == 0 ? 31 - p : p)] = f2bf(v); }
            }
        }
        __syncthreads();
        for (int idx = F.tid; idx < 1024 * 32; idx += NTHR) { const int col = idx >> 5, i = idx & 31, dir = col >> 9, c = col & 511;
            const int u = (dir == 0) ? (n - 32 - pos0 + i) : ((pos0 + i == 0) ? 2 * n - 1 : n - 1 + pos0 + i);
            bf16_t* Fb = lat ? FL + ((size_t)l * 512 + c) * 4096 : FC + ((size_t)l * 512 + c) * 512;
            Fb[u] = T[col * 32 + i]; }
        for (int col = F.tid; col < 1024; col += NTHR) { float sum = 0.f;
#pragma unroll 8
            for (int i = 0; i < 32; ++i) sum += fabsf(bf1(T[col * 32 + i]));
            NP[((size_t)l * 72 + ch) * 1024 + col] = sum; }
    }
    __syncthreads();
}
__device__ __forceinline__ void filter_norm_reduce(const Fr& F, const Args& a) {
    const float* NP = (const float*)(a.ws + WS_NP); float* FN = (float*)(a.ws + WS_FNORM);
    for (int o = F.bid * NTHR + F.tid; o < NL * 2 * 512; o += F.G * NTHR) { const int l = o >> 10, isc = (o >> 9) & 1, c = o & 511;
        const int ch0 = isc ? 64 : 0, ch1 = isc ? 72 : 64; float sum = 0.f;
        for (int ch = ch0; ch < ch1; ++ch) sum += NP[((size_t)l * 72 + ch) * 1024 + c] + NP[((size_t)l * 72 + ch) * 1024 + 512 + c];
        FN[o] = 1.f / sum; }
}

template <int MODE>
__device__ __forceinline__ void transpose_item(const float* W, int K, int N, bf16_t* WT, int row_off, LAS float* scr, int item, int lane, int ldk = 0) {
    if (ldk == 0) ldk = K;
    const int nblk = N / 64, kb = item / nblk, nb = item % nblk, k0 = 64 * kb, n0 = 64 * nb;
    f32x4 v[16];
#pragma unroll
    for (int i = 0; i < 16; ++i) v[i] = *(const f32x4*)(W + (size_t)(k0 + 4 * i + (lane >> 4)) * N + n0 + (lane & 15) * 4);
#pragma unroll
    for (int i = 0; i < 16; ++i) *(LAS f32x4*)(scr + (4 * i + (lane >> 4)) * 68 + (lane & 15) * 4) = v[i];
    LDS_WAIT();
    const int c = lane & 7;
#pragma unroll
    for (int j = 0; j < 8; ++j) { const int n = (lane >> 3) + 8 * j; const LAS float* s = scr + (8 * c) * 68 + n;
        u32x4 o; o.x = cvtpk(s[0 * 68], s[1 * 68]); o.y = cvtpk(s[2 * 68], s[3 * 68]); o.z = cvtpk(s[4 * 68], s[5 * 68]); o.w = cvtpk(s[6 * 68], s[7 * 68]);
        const int nn = n0 + n; const int row = (MODE == 0) ? nn : ((nn >> 2) * 8 + (nn & 3) + (MODE == 2 ? 4 : 0));
        *(u32x4*)(WT + (size_t)(row_off + row) * ldk + k0 + 8 * c) = o; }
    LDS_WAIT();
}

template <int MODE>
__device__ __forceinline__ void transpose_item_f8(const float* W, int K, int N, unsigned char* WT, int row_off, LAS float* scr, int item, int lane, int ldk = 0) {
    if (ldk == 0) ldk = K;
    const int nblk = N / 64, kb = item / nblk, nb = item % nblk, k0 = 64 * kb, n0 = 64 * nb;
    f32x4 v[16];
#pragma unroll
    for (int i = 0; i < 16; ++i) v[i] = *(const f32x4*)(W + (size_t)(k0 + 4 * i + (lane >> 4)) * N + n0 + (lane & 15) * 4);
#pragma unroll
    for (int i = 0; i < 16; ++i) *(LAS f32x4*)(scr + (4 * i + (lane >> 4)) * 68 + (lane & 15) * 4) = v[i];
    LDS_WAIT();
    const int c = lane & 7;
#pragma unroll
    for (int j = 0; j < 8; ++j) { const int n = (lane >> 3) + 8 * j; const LAS float* s = scr + (8 * c) * 68 + n;
        u32x2 o; o.x = cvt4_fp8(s[0 * 68] * 64.f, s[1 * 68] * 64.f, s[2 * 68] * 64.f, s[3 * 68] * 64.f); o.y = cvt4_fp8(s[4 * 68] * 64.f, s[5 * 68] * 64.f, s[6 * 68] * 64.f, s[7 * 68] * 64.f);
        const int nn = n0 + n; const int row = (MODE == 0) ? nn : ((nn >> 2) * 8 + (nn & 3) + (MODE == 2 ? 4 : 0));
        *(u32x2*)(WT + (size_t)(row_off + row) * ldk + k0 + 8 * c) = o; }
    LDS_WAIT();
}
__device__ __forceinline__ void conv_small_weights(const Fr& F, const Args& a, int l, int mask, int b0) {
    if (F.bid < b0) return;
    LAS float* scr = (LAS float*)(F.lds + F.wave * 17408);
    const int gw = (F.bid - b0) * NWAVES + F.wave, NGW = (F.G - b0) * NWAVES;
    constexpr int I_IN = (1024 / 64) * (DIN / 64), I_BR = (512 / 64) * (1024 / 64), I_OUT = (1024 / 64) * (1024 / 64);
    if (mask & 1) for (int it = gw; it < I_IN; it += NGW) transpose_item_f8<0>(a.in[I_WIN] + (size_t)l * 1024 * DIN, 1024, DIN, a.ws + WS_WG8, 0, scr, it, F.lane);
    if (mask & 2) for (int it = gw; it < 3 * I_BR; it += NGW) { const int b = it / I_BR; transpose_item_f8<0>(a.in[I_WBR] + ((size_t)l * 3 + b) * 512 * 1024, 512, 1024, a.ws + WS_WBR + b * 512, 0, scr, it % I_BR, F.lane, 1536); }
    if (mask & 4) for (int it = gw; it < I_OUT; it += NGW) transpose_item_f8<0>(a.in[I_WOUT] + (size_t)l * 1024 * 1024, 1024, 1024, a.ws + WS_WOUT, 0, scr, it, F.lane);
}
__device__ __forceinline__ void conv_expert_weights(const Fr& F, const Args& a, int l, int b0, int it0, int it1) {
    if (F.bid < b0) return;
    LAS float* scr = (LAS float*)(F.lds + F.wave * 17408);
    const int gw = (F.bid - b0) * NWAVES + F.wave, NGW = (F.G - b0) * NWAVES;
    constexpr int I_1 = (1024 / 64) * (512 / 64), I_2 = (512 / 64) * (1024 / 64);
    for (int it = it0 + gw; it < it1; it += NGW) {
        const int e = it / (2 * I_1 + I_2); int r = it % (2 * I_1 + I_2);
        unsigned char* W13 = a.ws + WS_W13; unsigned char* W2 = a.ws + WS_W2;
        if (r < I_1) { transpose_item_f8<1>(a.in[I_EW1] + ((size_t)l * NE + e) * 1024 * 512, 1024, 512, W13, e * 1024, scr, r, F.lane); continue; } r -= I_1;
        if (r < I_1) { transpose_item_f8<2>(a.in[I_EW3] + ((size_t)l * NE + e) * 1024 * 512, 1024, 512, W13, e * 1024, scr, r, F.lane); continue; } r -= I_1;
        transpose_item_f8<0>(a.in[I_EW2] + ((size_t)l * NE + e) * 512 * 1024, 512, 1024, W2, e * 1024, scr, r, F.lane);
    }
}
constexpr int CONV_E_ITEMS = NE * 384, CONV_E_SPLIT = CONV_E_ITEMS / 2;

__device__ __forceinline__ int mod_row(int row) { return row < TL ? (row >> 11) : NB; }

__device__ __forceinline__ void rows_p0(const Fr& F, const Args& a, int l, int nrows) {
    const int gw = F.bid * NWAVES + F.wave, NGW = F.G * NWAVES;
    const float* g1 = a.in[I_N1G] + l * 1024;
    const float* MODl = (const float*)(a.ws + WS_MOD) + (size_t)l * NBM * DIN;
    const float* MODp = (const float*)(a.ws + WS_MOD) + (size_t)(l > 0 ? l - 1 : 0) * NBM * DIN;
    const bf16_t* Fs = (const bf16_t*)(a.ws + WS_F);
    unsigned char* H8 = a.ws + WS_H8;
    const int per = 2 * ((nrows + 2 * NGW - 1) / (2 * NGW)), w0 = gw * per, w1 = (w0 + per < nrows) ? w0 + per : nrows;
    f32x4 gv[4], shv[4], scv[4], m5v[4]; int cur = -1;
#pragma unroll
    for (int j = 0; j < 4; ++j) { gv[j] = *(const f32x4*)(g1 + F.lane * 4 + 256 * j); shv[j] = gv[j]; scv[j] = gv[j]; m5v[j] = gv[j]; }
#define P0_LOAD(rb, V, F0, F1) do { _Pragma("unroll") for (int q = 0; q < 2; ++q) { const int row = (rb) + q; const bool lat = row < TL; \
            const float* xs = lat ? ((l == 0) ? a.in[I_X] + (size_t)row * D : a.out + (size_t)row * D) : ((l == 0) ? a.in[I_CTX] + (size_t)(row - TL) * D : (const float*)(a.ws + WS_XC) + (size_t)(row - TL) * D); \
            _Pragma("unroll") for (int j = 0; j < 4; ++j) { const int col = F.lane * 4 + 256 * j; V[q][j] = *(const f32x4*)(xs + col); \
                if (l > 0) { F0[q][j] = *(const u32x2*)(Fs + (size_t)row * D + col); F1[q][j] = *(const u32x2*)(Fs + ((size_t)TT + row) * D + col); } } } } while (0)
#define P0_PROC(rb, V, F0, F1) do { _Pragma("unroll") for (int q = 0; q < 2; ++q) { const int row = (rb) + q; const bool lat = row < TL; const int mr = mod_row(row); \
            if (mr != cur) { cur = mr; _Pragma("unroll") for (int j = 0; j < 4; ++j) { const int col = F.lane * 4 + 256 * j; \
                shv[j] = *(const f32x4*)(MODl + (size_t)mr * DIN + col); scv[j] = *(const f32x4*)(MODl + (size_t)mr * DIN + 1024 + col); m5v[j] = *(const f32x4*)(MODp + (size_t)mr * DIN + 5 * 1024 + col); } } \
            float* xd = lat ? a.out + (size_t)row * D : (float*)(a.ws + WS_XC) + (size_t)(row - TL) * D; float ss = 0.f; \
            if (l > 0) { _Pragma("unroll") for (int j = 0; j < 4; ++j) { const int col = F.lane * 4 + 256 * j; \
                    V[q][j].x += m5v[j].x * (bflo(F0[q][j].x) + bflo(F1[q][j].x)); V[q][j].y += m5v[j].y * (bfhi(F0[q][j].x) + bfhi(F1[q][j].x)); \
                    V[q][j].z += m5v[j].z * (bflo(F0[q][j].y) + bflo(F1[q][j].y)); V[q][j].w += m5v[j].w * (bfhi(F0[q][j].y) + bfhi(F1[q][j].y)); \
                    *(f32x4*)(xd + col) = V[q][j]; } } \
            _Pragma("unroll") for (int j = 0; j < 4; ++j) ss += (V[q][j].x * V[q][j].x + V[q][j].y * V[q][j].y) + (V[q][j].z * V[q][j].z + V[q][j].w * V[q][j].w); \
            const float r = 1.f / sqrtf(wave_sum(ss) * (1.f / D) + EPS); \
            _Pragma("unroll") for (int j = 0; j < 4; ++j) { const int col = F.lane * 4 + 256 * j; \
                const f32x4 o = (V[q][j] * r * gv[j]) * (scv[j] + 1.f) + shv[j]; \
                *(unsigned*)(H8 + (size_t)row * D + col) = cvt4_fp8(o.x, o.y, o.z, o.w); } } } while (0)
    f32x4 vA[2][4], vB[2][4]; u32x2 fA0[2][4], fA1[2][4], fB0[2][4], fB1[2][4];
    if (w0 < w1) P0_LOAD(w0, vA, fA0, fA1);
    for (int rb = w0; rb < w1; rb += 4) {
        if (rb + 2 < w1) P0_LOAD(rb + 2, vB, fB0, fB1);
        P0_PROC(rb, vA, fA0, fA1);
        if (rb + 2 < w1) { if (rb + 4 < w1) P0_LOAD(rb + 4, vA, fA0, fA1); P0_PROC(rb + 2, vB, fB0, fB1); }
    }
#undef P0_LOAD
#undef P0_PROC
}
__device__ __forceinline__ void rows_final(const Fr& F, const Args& a) {
    const int gw = F.bid * NWAVES + F.wave, NGW = F.G * NWAVES;
    const float* MODp = (const float*)(a.ws + WS_MOD) + (size_t)(NL - 1) * NBM * DIN;
    const bf16_t* Fs = (const bf16_t*)(a.ws + WS_F);
    for (int row = gw; row < TL; row += NGW) {
        const int mr = row >> 11; float* xd = a.out + (size_t)row * D;
#pragma unroll
        for (int j = 0; j < 4; ++j) { const int col = F.lane * 4 + 256 * j;
            f32x4 v = *(const f32x4*)(xd + col);
            const u32x2 f0 = *(const u32x2*)(Fs + (size_t)row * D + col), f1 = *(const u32x2*)(Fs + ((size_t)TT + row) * D + col);
            const f32x4 m5 = *(const f32x4*)(MODp + (size_t)mr * DIN + 5 * 1024 + col);
            v.x += m5.x * (bflo(f0.x) + bflo(f1.x)); v.y += m5.y * (bfhi(f0.x) + bfhi(f1.x)); v.z += m5.z * (bflo(f0.y) + bflo(f1.y)); v.w += m5.w * (bfhi(f0.y) + bfhi(f1.y));
            *(f32x4*)(xd + col) = v; }
    }
}

__device__ __forceinline__ void rows_p5(const Fr& F, const Args& a, int l, int nrows, unsigned long long& sacc, const int swhich) {
#if defined(PROBE_P)
    unsigned long long st0 = __builtin_amdgcn_s_memrealtime();
#define SUBMARK5(w) do { const unsigned long long t_ = __builtin_amdgcn_s_memrealtime(); if (swhich == (w)) sacc += t_ - st0; st0 = t_; } while (0)
#else
#define SUBMARK5(w) do { } while (0)
#endif
    typedef float f32x4v __attribute__((ext_vector_type(4)));
    LAS float* RW = (LAS float*)F.lds;
    constexpr int RWS = 1028;
    LAS float* RB = (LAS float*)(F.lds + 82304);
    LAS int* LC = (LAS int*)(F.lds + 82432);
    LAS int* TE = (LAS int*)(F.lds + 82560);
    LAS int* TP = TE + 256;
    LAS float* TW = (LAS float*)(TP + 256);
    LAS float* RN = (LAS float*)(F.lds + 86784);
    LAS float* LG = (LAS float*)(F.lds + 87424);
    LAS float* GM = (LAS float*)(F.lds + 99072);
    LAS float* BI = (LAS float*)(F.lds + 107264);
    const float* g2 = a.in[I_N2G] + l * 1024;
    const float* MODl = (const float*)(a.ws + WS_MOD) + (size_t)l * NBM * DIN;
    unsigned char* H8 = a.ws + WS_H;
    int* EROW = (int*)(a.ws + WS_EROW); float* EROWW = (float*)(a.ws + WS_EROWW);
    unsigned* CNT = (unsigned*)(a.ws + WS_CTL) + CW_CNT + l * 256;
    for (int f = F.tid; f < 1024; f += NTHR) { const f32x4 v = *(const f32x4*)(a.in[I_RGW] + ((size_t)l * 1024 + f) * 4);
        RW[0 * RWS + f] = v.x; RW[1 * RWS + f] = v.y; RW[2 * RWS + f] = v.z; RW[3 * RWS + f] = v.w; }
    for (int f = F.tid; f < 4096; f += NTHR) { const int k = f >> 2, c4 = (f & 3) * 4; const f32x4 v = *(const f32x4*)(a.in[I_REW] + ((size_t)l * 1024 + k) * 16 + c4);
        RW[(4 + c4) * RWS + k] = v.x; RW[(5 + c4) * RWS + k] = v.y; RW[(6 + c4) * RWS + k] = v.z; RW[(7 + c4) * RWS + k] = v.w; }
    if (F.tid < 20) RB[F.tid] = (F.tid < 4) ? a.in[I_RGB][l * 4 + F.tid] : a.in[I_REB][l * 16 + F.tid - 4];
    constexpr int P5_CH = 144;
    const int nch = (nrows + P5_CH - 1) / P5_CH;
    SUBMARK5(40);
    for (int ch = F.bid; ch < nch; ch += F.G) {
    const int r0 = ch * P5_CH, r1 = (r0 + P5_CH < nrows) ? r0 + P5_CH : nrows;
    const int mb0 = mod_row(r0), mb1 = mod_row(r1 - 1);
    if (F.tid < 32) LC[F.tid] = 0;
    for (int i = F.tid; i < 2048; i += NTHR) { const int s = i >> 10, k = i & 1023; GM[i] = g2[k] * (1.f + MODl[(size_t)(s ? mb1 : mb0) * DIN + 4 * 1024 + k]); }
    __syncthreads();
    if (F.wave < 4) {
    for (int rowb = r0 + 2 * F.wave; rowb < r1; rowb += 2 * 4) {
        f32x4 v[2][4]; bool val[2];
#pragma unroll
        for (int q = 0; q < 2; ++q) { const int row = rowb + q; val[q] = row < r1; const int rr = val[q] ? row : rowb;
            const bool lat = rr < TL; const float* xs = lat ? a.out + (size_t)rr * D : (const float*)(a.ws + WS_XC) + (size_t)(rr - TL) * D;
#pragma unroll
            for (int j = 0; j < 4; ++j) v[q][j] = *(const f32x4*)(xs + F.lane * 4 + 256 * j); }
#pragma unroll
        for (int q = 0; q < 2; ++q) { const int rr = val[q] ? rowb + q : rowb; const int mr = mod_row(rr); float ss = 0.f;
#pragma unroll
            for (int j = 0; j < 4; ++j) ss += (v[q][j].x * v[q][j].x + v[q][j].y * v[q][j].y) + (v[q][j].z * v[q][j].z + v[q][j].w * v[q][j].w);
            const float r = 1.f / sqrtf(wave_sum(ss) * (1.f / D) + EPS);
            if (F.lane == 0 && val[q]) RN[rr - r0] = r;
#pragma unroll
            for (int j = 0; j < 4; ++j) { const int col = F.lane * 4 + 256 * j;
                const f32x4 g = *(const f32x4*)(g2 + col), sh = *(const f32x4*)(MODl + (size_t)mr * DIN + 3 * 1024 + col), sc = *(const f32x4*)(MODl + (size_t)mr * DIN + 4 * 1024 + col);
                const f32x4 t = (v[q][j] * r * g) * (sc + 1.f) + sh;
                if (val[q]) *(unsigned*)(H8 + (size_t)rr * D + col) = cvt4_fp8(t.x, t.y, t.z, t.w); } }
    }
    } else {
    if (F.wave < 6) { const int sl = F.wave - 4; const int mb = sl ? mb1 : mb0; f32x4 sh[4];
#pragma unroll
        for (int j = 0; j < 4; ++j) sh[j] = *(const f32x4*)(MODl + (size_t)mb * DIN + 3 * 1024 + F.lane * 4 + 256 * j);
#pragma unroll 4
        for (int cidx = 0; cidx < 20; ++cidx) { float p = 0.f;
#pragma unroll
            for (int j = 0; j < 4; ++j) { const f32x4 w = *(const LAS f32x4*)(RW + cidx * RWS + F.lane * 4 + 256 * j);
                p = fmaf(sh[j].x, w.x, p); p = fmaf(sh[j].y, w.y, p); p = fmaf(sh[j].z, w.z, p); p = fmaf(sh[j].w, w.w, p); }
            const float tot = wave_sum(p) + RB[cidx]; if (F.lane == 0) BI[sl * 20 + cidx] = tot; } }
    { const int i16 = F.lane & 15, kq = F.lane >> 4; const int ngrp = (r1 - r0 + 15) >> 4;
      for (int gi = F.wave - 4; gi < ngrp; gi += 4) {
        const int grow = r0 + 16 * gi; const int rowi = (grow + i16 < r1) ? grow + i16 : r1 - 1;
        const bool lat = rowi < TL; const float* xs = (lat ? a.out + (size_t)rowi * D : (const float*)(a.ws + WS_XC) + (size_t)(rowi - TL) * D) + 4 * kq;
        const int slot = (mod_row(grow) == mb0) ? 0 : 1;
        const LAS float* gmp = GM + slot * 1024 + 4 * kq; const LAS float* w0p = RW + i16 * RWS + 4 * kq; const LAS float* w1p = RW + (16 + (i16 & 3)) * RWS + 4 * kq;
        const float m1 = (i16 < 4) ? 1.f : 0.f;
        f32x4v acc0 = {0.f, 0.f, 0.f, 0.f}, acc1 = {0.f, 0.f, 0.f, 0.f};
#pragma unroll 16
        for (int s = 0; s < 64; ++s) {
            const f32x4 xv = *(const f32x4*)(xs + 16 * s); const f32x4 gv = *(const LAS f32x4*)(gmp + 16 * s);
            const f32x4 wa = *(const LAS f32x4*)(w0p + 16 * s), wb = *(const LAS f32x4*)(w1p + 16 * s);
            const f32x4 ba = wa * gv, bb = wb * gv * m1;
            acc0 = __builtin_amdgcn_mfma_f32_16x16x4f32(xv.x, ba.x, acc0, 0, 0, 0); acc1 = __builtin_amdgcn_mfma_f32_16x16x4f32(xv.x, bb.x, acc1, 0, 0, 0);
            acc0 = __builtin_amdgcn_mfma_f32_16x16x4f32(xv.y, ba.y, acc0, 0, 0, 0); acc1 = __builtin_amdgcn_mfma_f32_16x16x4f32(xv.y, bb.y, acc1, 0, 0, 0);
            acc0 = __builtin_amdgcn_mfma_f32_16x16x4f32(xv.z, ba.z, acc0, 0, 0, 0); acc1 = __builtin_amdgcn_mfma_f32_16x16x4f32(xv.z, bb.z, acc1, 0, 0, 0);
            acc0 = __builtin_amdgcn_mfma_f32_16x16x4f32(xv.w, ba.w, acc0, 0, 0, 0); acc1 = __builtin_amdgcn_mfma_f32_16x16x4f32(xv.w, bb.w, acc1, 0, 0, 0);
        }
#pragma unroll
        for (int rg = 0; rg < 4; ++rg) { const int lr = 16 * gi + 4 * kq + rg;
            if (r0 + lr < r1) { LG[lr * 20 + i16] = acc0[rg]; if (i16 < 4) LG[lr * 20 + 16 + i16] = acc1[rg]; } }
      } }
    }
    __syncthreads();
    SUBMARK5(42);
    for (int lr = F.tid; lr < r1 - r0; lr += NTHR) {
        float lg[20]; { const float rn = RN[lr]; const int sl = (mod_row(r0 + lr) == mb0) ? 0 : 1;
#pragma unroll
          for (int i = 0; i < 20; ++i) lg[i] = rn * LG[lr * 20 + i] + BI[sl * 20 + i]; }
        int gs = 0; float gmx = lg[0];
#pragma unroll
        for (int i = 1; i < 4; ++i) if (lg[i] > gmx) { gmx = lg[i]; gs = i; }
        float gsum = 0.f;
#pragma unroll
        for (int i = 0; i < 4; ++i) gsum += __expf(lg[i] - gmx);
        const float pg = 1.f / gsum;
        float le[4];
#pragma unroll
        for (int i = 0; i < 4; ++i) le[i] = (gs == 0) ? lg[4 + i] : (gs == 1) ? lg[8 + i] : (gs == 2) ? lg[12 + i] : lg[16 + i];
        int i0 = 0; float v0 = le[0];
#pragma unroll
        for (int i = 1; i < 4; ++i) if (le[i] > v0) { v0 = le[i]; i0 = i; }
        int i1 = -1; float v1 = -3.4e38f;
#pragma unroll
        for (int i = 0; i < 4; ++i) if (i != i0 && le[i] > v1) { v1 = le[i]; i1 = i; }
        const float e1 = __expf(v1 - v0), den = 1.f / (1.f + e1);
        const int ex0 = gs * 4 + i0, ex1 = gs * 4 + i1;
        const int lp0 = __hip_atomic_fetch_add(&LC[ex0], 1, __ATOMIC_RELAXED, __HIP_MEMORY_SCOPE_WORKGROUP), lp1 = __hip_atomic_fetch_add(&LC[ex1], 1, __ATOMIC_RELAXED, __HIP_MEMORY_SCOPE_WORKGROUP);
        TE[lr] = ex0 | (ex1 << 8); TP[lr] = lp0 | (lp1 << 16); TW[2 * lr] = den * pg; TW[2 * lr + 1] = e1 * den * pg;
    }
    __syncthreads();
    if (F.tid < NE) LC[16 + F.tid] = (int)atomicAdd(&CNT[F.tid * 16], (unsigned)LC[F.tid]);
    __syncthreads();
    for (int lr = F.tid; lr < r1 - r0; lr += NTHR) {
        const int te = TE[lr], tp = TP[lr], ex0 = te & 255, ex1 = te >> 8, row = r0 + lr;
        const int gp0 = LC[16 + ex0] + (tp & 0xffff), gp1 = LC[16 + ex1] + (tp >> 16);
        EROW[(size_t)ex0 * TT + gp0] = row * 2; EROWW[(size_t)ex0 * TT + gp0] = TW[2 * lr];
        EROW[(size_t)ex1 * TT + gp1] = row * 2 + 1; EROWW[(size_t)ex1 * TT + gp1] = TW[2 * lr + 1];
    }
    __syncthreads();
    SUBMARK5(43);
    }
    __syncthreads();
#undef SUBMARK5
}

__device__ __forceinline__ void normrope8(float (&x)[8], const float* g64, bool rope, int pos, const float* ct, const float* st, float scale, int lane) {
    float ss = 0.f;
#pragma unroll
    for (int i = 0; i < 8; ++i) ss += x[i] * x[i];
    ss += DPP_F(ss, 0xB1); ss += DPP_F(ss, 0x4E); ss += DPP_F(ss, 0x141);
    const float r = 1.f / sqrtf(ss * (1.f / 64.f) + EPS);
    const int ch = lane & 7;
    const f32x4 g0 = *(const f32x4*)(g64 + 8 * ch), g1 = *(const f32x4*)(g64 + 8 * ch + 4);
    x[0] *= r * g0.x; x[1] *= r * g0.y; x[2] *= r * g0.z; x[3] *= r * g0.w; x[4] *= r * g1.x; x[5] *= r * g1.y; x[6] *= r * g1.z; x[7] *= r * g1.w;
    if (rope) {
        const int ax = ch >> 2, half = (ch >> 1) & 1, f0 = 8 * (ch & 1);
        const f32x4 c0 = *(const f32x4*)(ct + pos * 32 + ax * 16 + f0), c1 = *(const f32x4*)(ct + pos * 32 + ax * 16 + f0 + 4);
        const f32x4 s0 = *(const f32x4*)(st + pos * 32 + ax * 16 + f0), s1 = *(const f32x4*)(st + pos * 32 + ax * 16 + f0 + 4);
        const float cs[8] = {c0.x, c0.y, c0.z, c0.w, c1.x, c1.y, c1.z, c1.w}, sn[8] = {s0.x, s0.y, s0.z, s0.w, s1.x, s1.y, s1.z, s1.w};
#pragma unroll
        for (int i = 0; i < 8; ++i) { const float p = DPP_F(x[i], 0x4E);
            x[i] = half ? (x[i] * cs[i] + p * sn[i]) : (x[i] * cs[i] - p * sn[i]); }
    }
#pragma unroll
    for (int i = 0; i < 8; ++i) x[i] *= scale;
}
__device__ __forceinline__ void unpack8(const u32x4 w, float (&x)[8]) { x[0] = bflo(w.x); x[1] = bfhi(w.x); x[2] = bflo(w.y); x[3] = bfhi(w.y); x[4] = bflo(w.z); x[5] = bfhi(w.z); x[6] = bflo(w.w); x[7] = bfhi(w.w); }
__device__ __forceinline__ u32x4 pack8(const float (&x)[8]) { u32x4 w; w.x = cvtpk(x[0], x[1]); w.y = cvtpk(x[2], x[3]); w.z = cvtpk(x[4], x[5]); w.w = cvtpk(x[6], x[7]); return w; }

__device__ __forceinline__ void prep_phase(const Fr& F, const Args& a, int l, bool with_ctx) {
    constexpr int VROW = 272;
    LAS unsigned char* VA_l = F.lds;
    LAS unsigned char* VW_l = F.lds + 17408;
    LAS unsigned char* HT_l = F.lds + 34816;
    constexpr int HROW = 144;
    const float* ct = (const float*)(a.ws + WS_ROPE); const float* st = ct + SEQ * 32;
    const float* qkg = a.in[I_QKG] + l * 256;
    const bf16_t* RAWA = (const bf16_t*)(a.ws + WS_RAWA); const bf16_t* RAWW = (const bf16_t*)(a.ws + WS_RAWW);
    bf16_t* KA = (bf16_t*)(a.ws + WS_KA); bf16_t* KW = (bf16_t*)(a.ws + WS_KW); bf16_t* VTA = (bf16_t*)(a.ws + WS_VTA); bf16_t* VTW = (bf16_t*)(a.ws + WS_VTW);
    const bf16_t* U = (const bf16_t*)(a.ws + WS_U); bf16_t* X0 = (bf16_t*)(a.ws + WS_H); bf16_t* VT = (bf16_t*)(a.ws + WS_VT);
    const float* hsw = a.in[I_HSW] + l * 3 * 1536; const float* hsb = a.in[I_HSB] + l * 1536;
    for (int unit = F.bid; unit < NB * 36; unit += F.G) {
        const bool lat = unit < NB * 32;
        const int b = lat ? unit >> 5 : (unit - NB * 32) >> 2, p0 = lat ? (unit & 31) * 64 : ((unit - NB * 32) & 3) * 64;
        const int n = lat ? SEQ : CTX;
        const int row0 = lat ? b * SEQ + p0 : TL + b * CTX + p0;
        const int j0 = lat ? CTX + p0 : p0;
        __syncthreads();
        {
            const bool isw = (F.lane & 16) != 0; const int l16 = F.lane & 15, half = F.lane >> 5;
            u32x4 kw[4];
#pragma unroll
            for (int ps = 0; ps < 4; ++ps) { const int tk = 8 * F.wave + 2 * ps + half; kw[ps] = *(const u32x4*)((isw ? RAWW : RAWA) + (size_t)(row0 + tk) * 256 + l16 * 8); }
#pragma unroll
            for (int ps = 0; ps < 4; ++ps) { const int tk = 8 * F.wave + 2 * ps + half; float x[8]; unpack8(kw[ps], x);
                normrope8(x, qkg + (isw ? 192 : 64), lat, p0 + tk, ct, st, 1.f, F.lane);
                *(u32x4*)((isw ? KW : KA) + ((size_t)b * KEYS + j0 + tk) * 128 + l16 * 8) = pack8(x); }
        }
        for (int i = F.tid; i < 2 * 64 * 16; i += NTHR) { const int m = i >> 10, r = (i >> 4) & 63, cch = i & 15;
            const u32x4 w = *(const u32x4*)((m ? RAWW : RAWA) + (size_t)(row0 + r) * 256 + 128 + cch * 8);
            *(LAS u32x4*)((m ? VW_l : VA_l) + r * VROW + cch * 16) = w; }
        const bool do_hy = lat || with_ctx;
        if (do_hy) {
            const int cg = F.tid & 63, c = 8 * cg, t0 = 8 * F.wave;
            u32x4 x1p[8];
#pragma unroll
            for (int g = 0; g < 3; ++g) {
                const int ch = g * 512 + c;
                float w0[8], w1[8], w2[8], bb[8];
                { const f32x4 a0 = *(const f32x4*)(hsw + ch), a1 = *(const f32x4*)(hsw + ch + 4), b0 = *(const f32x4*)(hsw + 1536 + ch), b1 = *(const f32x4*)(hsw + 1536 + ch + 4),
                              c0 = *(const f32x4*)(hsw + 3072 + ch), c1 = *(const f32x4*)(hsw + 3072 + ch + 4), d0 = *(const f32x4*)(hsb + ch), d1 = *(const f32x4*)(hsb + ch + 4);
                  w0[0] = a0.x; w0[1] = a0.y; w0[2] = a0.z; w0[3] = a0.w; w0[4] = a1.x; w0[5] = a1.y; w0[6] = a1.z; w0[7] = a1.w;
                  w1[0] = b0.x; w1[1] = b0.y; w1[2] = b0.z; w1[3] = b0.w; w1[4] = b1.x; w1[5] = b1.y; w1[6] = b1.z; w1[7] = b1.w;
                  w2[0] = c0.x; w2[1] = c0.y; w2[2] = c0.z; w2[3] = c0.w; w2[4] = c1.x; w2[5] = c1.y; w2[6] = c1.z; w2[7] = c1.w;
                  bb[0] = d0.x; bb[1] = d0.y; bb[2] = d0.z; bb[3] = d0.w; bb[4] = d1.x; bb[5] = d1.y; bb[6] = d1.z; bb[7] = d1.w; }
                u32x4 raw[10];
#pragma unroll
                for (int i = 0; i < 10; ++i) { const int pos = p0 + t0 - 1 + i;
                    if (pos < 0 || pos >= n) { const unsigned z = zero_u32(); raw[i] = (u32x4){z, z, z, z}; } else raw[i] = *(const u32x4*)(U + (size_t)(row0 - p0 + pos) * 1536 + ch); }
#pragma unroll
                for (int t = 0; t < 8; ++t) { float up[8], uc[8], un[8], o[8]; unpack8(raw[t], up); unpack8(raw[t + 1], uc); unpack8(raw[t + 2], un);
#pragma unroll
                    for (int i = 0; i < 8; ++i) o[i] = fmaf(w0[i], up[i], fmaf(w1[i], uc[i], fmaf(w2[i], un[i], bb[i])));
                    if (g == 0) *(u32x4*)(X0 + (size_t)(row0 + t0 + t) * 512 + c) = pack8(o);
                    else if (g == 1) x1p[t] = pack8(o);
                    else { float x1[8]; unpack8(x1p[t], x1);
#pragma unroll
                        for (int i = 0; i < 8; ++i) o[i] *= x1[i];
                        x1p[t] = pack8(o); } }
            }
#pragma unroll
            for (int i = 0; i < 8; ++i) { unsigned short ev[8];
#pragma unroll
                for (int t = 0; t < 8; ++t) { const unsigned wsel = (i >> 1) == 0 ? x1p[t].x : (i >> 1) == 1 ? x1p[t].y : (i >> 1) == 2 ? x1p[t].z : x1p[t].w; ev[t] = (unsigned short)((i & 1) ? (wsel >> 16) : (wsel & 0xffffu)); }
                u32x4 w; w.x = ev[0] | ((unsigned)ev[1] << 16); w.y = ev[2] | ((unsigned)ev[3] << 16); w.z = ev[4] | ((unsigned)ev[5] << 16); w.w = ev[6] | ((unsigned)ev[7] << 16);
                *(LAS u32x4*)(HT_l + (c + i) * HROW + t0 * 2) = w; }
        }
        __syncthreads();
        for (int i = F.tid; i < 2 * 128 * 8; i += NTHR) { const int m = i >> 10, rr = (i >> 3) & 127, c8 = i & 7;
            LAS unsigned char* T = m ? VW_l : VA_l; unsigned short e[8];
#pragma unroll
            for (int jj = 0; jj < 8; ++jj) { const int key = 16 * (c8 >> 1) + 8 * (jj >> 2) + 4 * (c8 & 1) + (jj & 3); e[jj] = *(const LAS bf16_t*)(T + key * VROW + rr * 2); }
            u32x4 w; w.x = e[0] | ((unsigned)e[1] << 16); w.y = e[2] | ((unsigned)e[3] << 16); w.z = e[4] | ((unsigned)e[5] << 16); w.w = e[6] | ((unsigned)e[7] << 16);
            *(u32x4*)((m ? VTW : VTA) + ((size_t)(b * 2 + (rr >> 6)) * 64 + (rr & 63)) * KEYS + j0 + c8 * 8) = w; }
        if (do_hy) { bf16_t* VTb = lat ? VT : VT + VT_CTX_OFF;
          for (int i = F.tid; i < 512 * 8; i += NTHR) { const int cch = i >> 3, c8 = i & 7;
              const u32x4 w = *(const LAS u32x4*)(HT_l + cch * HROW + c8 * 16);
              *(u32x4*)(VTb + ((size_t)cch * NB + b) * n + p0 + c8 * 8) = w; } }
    }
    __syncthreads();
}

__device__ __forceinline__ void hyena_final_phase(const Fr& F, const Args& a, int l, bool with_ctx) {
    constexpr int HROW = 144;
    LAS unsigned char* T = F.lds;
    const bf16_t* X0 = (const bf16_t*)(a.ws + WS_H); const bf16_t* VT = (const bf16_t*)(a.ws + WS_VT); const bf16_t* YT = (const bf16_t*)(a.ws + WS_YT);
    unsigned char* YH = a.ws + WS_Y8 + 512;
    const float* FN = (const float*)(a.ws + WS_FNORM) + l * 1024; const float* skip = a.in[I_HBIAS] + l * 512;
    const int nunits = with_ctx ? NB * 36 : NB * 32;
    for (int unit = F.bid; unit < nunits; unit += F.G) {
        const bool lat = unit < NB * 32;
        const int b = lat ? unit >> 5 : (unit - NB * 32) >> 2, p0 = lat ? (unit & 31) * 64 : ((unit - NB * 32) & 3) * 64;
        const int n = lat ? SEQ : CTX; const int row0 = lat ? b * SEQ + p0 : TL + b * CTX + p0;
        const bf16_t* Yb = lat ? YT : YT + VT_CTX_OFF; const bf16_t* Vb = lat ? VT : VT + VT_CTX_OFF; const float* inv = FN + (lat ? 0 : 512);
        __syncthreads();
        for (int i = F.tid; i < 512 * 8; i += NTHR) { const int cch = i >> 3, c8 = i & 7; const size_t off = ((size_t)cch * NB + b) * n + p0 + c8 * 8;
            const u32x4 y = *(const u32x4*)(Yb + off), v = *(const u32x4*)(Vb + off); const float s = inv[cch], k = skip[cch];
            u32x4 o;
            o.x = cvtpk(bflo(y.x) * s + k * bflo(v.x), bfhi(y.x) * s + k * bfhi(v.x)); o.y = cvtpk(bflo(y.y) * s + k * bflo(v.y), bfhi(y.y) * s + k * bfhi(v.y));
            o.z = cvtpk(bflo(y.z) * s + k * bflo(v.z), bfhi(y.z) * s + k * bfhi(v.z)); o.w = cvtpk(bflo(y.w) * s + k * bflo(v.w), bfhi(y.w) * s + k * bfhi(v.w));
            *(LAS u32x4*)(T + cch * HROW + c8 * 16) = o; }
        __syncthreads();
        { const int th = F.tid & 255, half = F.tid >> 8, c = 2 * th;
          for (int t = 32 * half; t < 32 * half + 32; ++t) {
              const unsigned x0 = *(const unsigned*)(X0 + (size_t)(row0 + t) * 512 + c);
              const float y0 = bf1(*(const LAS bf16_t*)(T + c * HROW + t * 2)), y1 = bf1(*(const LAS bf16_t*)(T + (c + 1) * HROW + t * 2));
              *(unsigned short*)(YH + (size_t)(row0 + t) * 1536 + c) = (unsigned short)__builtin_amdgcn_cvt_pk_fp8_f32(bflo(x0) * y0 * 16.f, bfhi(x0) * y1 * 16.f, 0, false); } }
    }
    __syncthreads();
}

#define MFMA32(a, b, c) __builtin_amdgcn_mfma_f32_32x32x16_bf16((a), (b), (c), 0, 0, 0)
#define MFMA16(a, b, c) __builtin_amdgcn_mfma_f32_16x16x32_bf16((a), (b), (c), 0, 0, 0)

__device__ __forceinline__ int tile_off(int row, int chunk) { return row * 128 + ((chunk ^ ((row >> 1) & 7)) << 4); }

template <bool WIN>
__device__ __forceinline__ void attn_unit(const Fr& F, const bf16_t* Qw, unsigned char* Yw, const bf16_t* Kb, const bf16_t* VTb, int a0, int na, int b0, int nb, int qpos0, bool has_sink, float sink2, const float* g64, bool rope, const float* ct, const float* st) {
    LAS unsigned char* L = F.lds;
    const int r = F.lane & 31, h = F.lane >> 5;
    const int xaddr = (lane_id() ^ 32) << 2;
#define SWAP32(v) __builtin_bit_cast(float, __builtin_amdgcn_ds_bpermute(xaddr, __builtin_bit_cast(int, (v))))
    bf16x8 q[4];
    {
        float x[4][8]; float ss = 0.f;
#pragma unroll
        for (int kk = 0; kk < 4; ++kk) { const u32x4 w = *(const u32x4*)(Qw + (size_t)r * 1536 + 16 * kk + 8 * h); unpack8(w, x[kk]);
#pragma unroll
            for (int j = 0; j < 8; ++j) ss += x[kk][j] * x[kk][j]; }
        ss += SWAP32(ss);
        const float rn = (1.f / sqrtf(ss * (1.f / 64.f) + EPS)) * QSCALE;
#pragma unroll
        for (int kk = 0; kk < 4; ++kk) { const f32x4 g0 = *(const f32x4*)(g64 + 16 * kk + 8 * h), g1 = *(const f32x4*)(g64 + 16 * kk + 8 * h + 4);
            x[kk][0] *= rn * g0.x; x[kk][1] *= rn * g0.y; x[kk][2] *= rn * g0.z; x[kk][3] *= rn * g0.w; x[kk][4] *= rn * g1.x; x[kk][5] *= rn * g1.y; x[kk][6] *= rn * g1.z; x[kk][7] *= rn * g1.w; }
        if (rope) { const int pos = qpos0 + r;
#pragma unroll
            for (int ax = 0; ax < 2; ++ax) {
                const f32x4 c0 = *(const f32x4*)(ct + pos * 32 + ax * 16 + 8 * h), c1 = *(const f32x4*)(ct + pos * 32 + ax * 16 + 8 * h + 4);
                const f32x4 s0 = *(const f32x4*)(st + pos * 32 + ax * 16 + 8 * h), s1 = *(const f32x4*)(st + pos * 32 + ax * 16 + 8 * h + 4);
                const float cs[8] = {c0.x, c0.y, c0.z, c0.w, c1.x, c1.y, c1.z, c1.w}, sn[8] = {s0.x, s0.y, s0.z, s0.w, s1.x, s1.y, s1.z, s1.w};
#pragma unroll
                for (int j = 0; j < 8; ++j) { const float av = x[2 * ax][j], bv = x[2 * ax + 1][j]; x[2 * ax][j] = av * cs[j] - bv * sn[j]; x[2 * ax + 1][j] = bv * cs[j] + av * sn[j]; } } }
#pragma unroll
        for (int kk = 0; kk < 4; ++kk) q[kk] = __builtin_bit_cast(bf16x8, pack8(x[kk]));
    }
    f32x16 o0, o1;
#pragma unroll
    for (int i = 0; i < 16; ++i) { o0[i] = 0.f; o1[i] = 0.f; }
    float lsum = 0.f;
    const int ntile = na + nb;
    const int srow = F.tid >> 3, sch = F.tid & 7;
    const int soff = tile_off(srow, sch);
    int t4[4];
#pragma unroll
    for (int j = 0; j < 4; ++j) t4[j] = tile_off(r, 2 * j + h);
#define AT_KT(i) ((i) < na ? a0 + (i) : b0 + ((i) - na))
#define AT_LD(i, K0, K1, V0, V1) do { const int kt_ = AT_KT(i); \
        K0 = *(const u32x4*)(Kb + (size_t)(kt_ * 128 + srow) * 128 + sch * 8); K1 = *(const u32x4*)(Kb + (size_t)(kt_ * 128 + 64 + srow) * 128 + sch * 8); \
        V0 = *(const u32x4*)(VTb + (size_t)srow * KEYS + kt_ * 128 + sch * 8); V1 = *(const u32x4*)(VTb + (size_t)srow * KEYS + kt_ * 128 + 64 + sch * 8); } while (0)
#define AT_ST(buf, K0, K1, V0, V1) do { LAS unsigned char* B_ = L + (buf) * 32768 + soff; \
        *(LAS u32x4*)(B_) = K0; *(LAS u32x4*)(B_ + 8192) = K1; *(LAS u32x4*)(B_ + 16384) = V0; *(LAS u32x4*)(B_ + 24576) = V1; } while (0)
#define AT_QK(S0, S1, Kt) do { bf16x8 kf_[8]; \
        _Pragma("unroll") for (int kk = 0; kk < 4; ++kk) { kf_[2 * kk] = *(const LAS bf16x8*)(L + (Kt) + t4[kk]); kf_[2 * kk + 1] = *(const LAS bf16x8*)(L + (Kt) + t4[kk] + 4096); } \
        _Pragma("unroll") for (int i_ = 0; i_ < 16; ++i_) { S0[i_] = 0.f; S1[i_] = 0.f; } \
        _Pragma("unroll") for (int kk = 0; kk < 4; ++kk) { S0 = MFMA32(kf_[2 * kk], q[kk], S0); S1 = MFMA32(kf_[2 * kk + 1], q[kk], S1); } } while (0)
#define AT_EXP(S0, S1, P, kpos0) do { \
        if (WIN && (kpos0) >= 0) { const int kbase = (kpos0) + 4 * h, qp = qpos0 + r; \
            _Pragma("unroll") for (int i = 0; i < 16; ++i) { const int kr = (i & 3) + 8 * (i >> 2); const int d0 = kbase + kr - qp, d1 = d0 + 32; \
                if (d0 > 128 || d0 < -128) S0[i] = -1e30f; if (d1 > 128 || d1 < -128) S1[i] = -1e30f; } } \
        _Pragma("unroll") for (int i = 0; i < 16; ++i) { S0[i] = fast_exp2(S0[i]); S1[i] = fast_exp2(S1[i]); lsum += S0[i] + S1[i]; } \
        { u32x4 w; \
          w.x = cvtpk(S0[0], S0[1]); w.y = cvtpk(S0[2], S0[3]); w.z = cvtpk(S0[4], S0[5]); w.w = cvtpk(S0[6], S0[7]); P[0] = __builtin_bit_cast(bf16x8, w); \
          w.x = cvtpk(S0[8], S0[9]); w.y = cvtpk(S0[10], S0[11]); w.z = cvtpk(S0[12], S0[13]); w.w = cvtpk(S0[14], S0[15]); P[1] = __builtin_bit_cast(bf16x8, w); \
          w.x = cvtpk(S1[0], S1[1]); w.y = cvtpk(S1[2], S1[3]); w.z = cvtpk(S1[4], S1[5]); w.w = cvtpk(S1[6], S1[7]); P[2] = __builtin_bit_cast(bf16x8, w); \
          w.x = cvtpk(S1[8], S1[9]); w.y = cvtpk(S1[10], S1[11]); w.z = cvtpk(S1[12], S1[13]); w.w = cvtpk(S1[14], S1[15]); P[3] = __builtin_bit_cast(bf16x8, w); } } while (0)
#define AT_PV(P, Vt) do { bf16x8 vf_[8]; \
        _Pragma("unroll") for (int c = 0; c < 4; ++c) { vf_[2 * c] = *(const LAS bf16x8*)(L + (Vt) + t4[c]); vf_[2 * c + 1] = *(const LAS bf16x8*)(L + (Vt) + t4[c] + 4096); } \
        _Pragma("unroll") for (int c = 0; c < 4; ++c) { o0 = MFMA32(vf_[2 * c], P[c], o0); o1 = MFMA32(vf_[2 * c + 1], P[c], o1); } } while (0)
#define AT_BODY(it) do { \
        const int kt = AT_KT(it); \
        if ((it) + 1 < ntile) AT_LD((it) + 1, kA0, kA1, vA0, vA1); \
        const int Bc = ((it) & 1) * 32768;                                \
        const int kp = (WIN && kt >= 2) ? (kt - 2) * 128 : -1;            \
        { f32x16 sa0, sa1; bf16x8 pa[4]; \
          AT_QK(sa0, sa1, Bc); AT_EXP(sa0, sa1, pa, kp); AT_PV(pa, Bc + 16384); } \
        __builtin_amdgcn_sched_barrier(0); \
        { f32x16 sb0, sb1; bf16x8 pb_[4]; \
          AT_QK(sb0, sb1, Bc + 8192); AT_EXP(sb0, sb1, pb_, (kp < 0 ? -1 : kp + 64)); AT_PV(pb_, Bc + 24576); } \
        if ((it) + 1 < ntile) AT_ST(((it) + 1) & 1, kA0, kA1, vA0, vA1); \
        __syncthreads(); } while (0)
    u32x4 kA0, kA1, vA0, vA1;
    AT_LD(0, kA0, kA1, vA0, vA1);
    __syncthreads();
    AT_ST(0, kA0, kA1, vA0, vA1);
    __syncthreads();
    for (int it = 0; it < ntile; it += 2) {
        AT_BODY(it);
        if (it + 1 < ntile) AT_BODY(it + 1);
    }
#undef AT_BODY
#undef AT_QK
#undef AT_EXP
#undef AT_PV
#undef AT_ST
#undef AT_LD
#undef AT_KT
    float lt = lsum + SWAP32(lsum);
    if (has_sink) lt += fast_exp2(sink2);
    const float inv = 1.f / lt;
#pragma unroll
    for (int g = 0; g < 4; ++g) { const float i16 = inv * 16.f;
        *(unsigned*)(Yw + (size_t)r * 1536 + 8 * g + 4 * h) = cvt4_fp8(o0[4 * g] * i16, o0[4 * g + 1] * i16, o0[4 * g + 2] * i16, o0[4 * g + 3] * i16);
        *(unsigned*)(Yw + (size_t)r * 1536 + 32 + 8 * g + 4 * h) = cvt4_fp8(o1[4 * g] * i16, o1[4 * g + 1] * i16, o1[4 * g + 2] * i16, o1[4 * g + 3] * i16); }
#undef SWAP32
}

__device__ __forceinline__ void hyena_unit_lat(const Fr& F, const bf16_t* Fg, const bf16_t* Vg, bf16_t* Yg) {
    constexpr int FREP = 8192 + 64, VPIT = 4096 + 16, VOFF = 8 * FREP;
    LAS unsigned char* L = F.lds;
    __syncthreads();
    { const int x = F.tid;
      const u32x4 lo = *(const u32x4*)(Fg + x * 8); u32x4 hi; if (x < 511) hi = *(const u32x4*)(Fg + x * 8 + 8); else { const unsigned z = zero_u32(); hi = (u32x4){z, z, z, z}; }
      const unsigned wv[8] = {lo.x, lo.y, lo.z, lo.w, hi.x, hi.y, hi.z, hi.w};
      *(LAS u32x4*)(L + x * 16) = lo;
#pragma unroll
      for (int rho = 1; rho < 8; ++rho) { u32x4 o;
          unsigned od[4];
#pragma unroll
          for (int d = 0; d < 4; ++d) { const int ob = 4 * d + 2 * rho, i = ob >> 2, s = ob & 3; od[d] = __builtin_amdgcn_alignbyte(wv[i + 1 < 8 ? i + 1 : 7], wv[i], s); }
          o.x = od[0]; o.y = od[1]; o.z = od[2]; o.w = od[3];
          *(LAS u32x4*)(L + rho * FREP + x * 16) = o; } }
    for (int i = F.tid; i < 16 * 256; i += NTHR) { const int b = i >> 8, x = i & 255; *(LAS u32x4*)(L + VOFF + b * VPIT + x * 16) = *(const u32x4*)(Vg + (size_t)b * SEQ + x * 8); }
    __syncthreads();
    const int i16 = F.lane & 15, q4 = F.lane >> 4, w = F.wave;
    const int base0 = 2047 - 256 * w - i16 + 8 * q4;
    const int rho = base0 & 7;
    LAS unsigned char* Ap = L + rho * FREP + (base0 - rho) * 2;
    LAS unsigned char* Bp = L + VOFF + i16 * VPIT + q4 * 16;
    bf16x8 A[16]; f32x4 acc[16];
#pragma unroll
    for (int rr = 0; rr < 16; ++rr) { A[rr] = *(const LAS bf16x8*)(Ap - 32 * rr); acc[rr] = (f32x4){0.f, 0.f, 0.f, 0.f}; }
    bf16x8 Bn = *(const LAS bf16x8*)(Bp);
    for (int o = 0; o < 8; ++o) {
#pragma unroll
        for (int u = 0; u < 8; ++u) {
            const int st = o * 8 + u;
            const bf16x8 Bf = Bn;
            if (st < 63) Bn = *(const LAS bf16x8*)(Bp + 64 * st + 64);
#pragma unroll
            for (int rr = 0; rr < 16; ++rr) acc[rr] = MFMA16(A[(rr - 2 * u) & 15], Bf, acc[rr]);
            if (st < 63) { A[(-2 * u - 2) & 15] = *(const LAS bf16x8*)(Ap + 64 * st + 64); A[(-2 * u - 1) & 15] = *(const LAS bf16x8*)(Ap + 64 * st + 32); }
        }
    }
#pragma unroll
    for (int rr = 0; rr < 16; ++rr) { u32x2 wv; wv.x = cvtpk(acc[rr].x, acc[rr].y); wv.y = cvtpk(acc[rr].z, acc[rr].w);
        *(u32x2*)(Yg + (size_t)i16 * SEQ + 256 * w + 16 * rr + 4 * q4) = wv; }
}
__device__ __forceinline__ void hyena_unit_ctx(const Fr& F, const bf16_t* Fg, const bf16_t* Vg, bf16_t* Yg) {
    constexpr int FREP = 1024 + 64, VPIT = 512 + 16, VOFF = 8 * FREP;
    LAS unsigned char* L = F.lds;
    __syncthreads();
    if (F.tid < 64) *(LAS u32x4*)(L + F.tid * 16) = *(const u32x4*)(Fg + F.tid * 8);
    if (F.tid >= 64 && F.tid < 68) { const unsigned z = zero_u32(); *(LAS u32x4*)(L + 1024 + (F.tid - 64) * 16) = (u32x4){z, z, z, z}; }
    { const int b = F.tid >> 5, x = F.tid & 31; *(LAS u32x4*)(L + VOFF + b * VPIT + x * 16) = *(const u32x4*)(Vg + (size_t)b * CTX + x * 8); }
    __syncthreads();
    for (int i = F.tid; i < 7 * 256; i += NTHR) { const int rho = 1 + i / 256, x2 = (i % 256) * 2; const int s0 = x2 + rho, s1 = x2 + 1 + rho;
        const unsigned e0 = s0 < 512 ? *(const LAS bf16_t*)(L + s0 * 2) : 0, e1 = s1 < 512 ? *(const LAS bf16_t*)(L + s1 * 2) : 0;
        *(LAS unsigned*)(L + rho * FREP + x2 * 2) = e0 | (e1 << 16); }
    __syncthreads();
    const int i16 = F.lane & 15, q4 = F.lane >> 4, w = F.wave;
    const int base0 = 255 - 32 * w - i16 + 8 * q4, rho = base0 & 7;
    LAS unsigned char* Ap = L + rho * FREP + (base0 - rho) * 2;
    LAS unsigned char* Bp = L + VOFF + i16 * VPIT + q4 * 16;
    f32x4 acc0 = (f32x4){0.f, 0.f, 0.f, 0.f}, acc1 = acc0;
#pragma unroll
    for (int st = 0; st < 8; ++st) { const bf16x8 Bf = *(const LAS bf16x8*)(Bp + 64 * st);
        const bf16x8 A0 = *(const LAS bf16x8*)(Ap + 64 * st), A1 = *(const LAS bf16x8*)(Ap + 64 * st - 32);
        acc0 = MFMA16(A0, Bf, acc0); acc1 = MFMA16(A1, Bf, acc1); }
    u32x2 wv; wv.x = cvtpk(acc0.x, acc0.y); wv.y = cvtpk(acc0.z, acc0.w); *(u32x2*)(Yg + (size_t)i16 * CTX + 32 * w + 4 * q4) = wv;
    wv.x = cvtpk(acc1.x, acc1.y); wv.y = cvtpk(acc1.z, acc1.w); *(u32x2*)(Yg + (size_t)i16 * CTX + 32 * w + 16 + 4 * q4) = wv;
}

__device__ __forceinline__ void mixer_phase(const Fr& F, const Args& a, int l, bool with_ctx, unsigned long long& sacc, const int swhich) {
#if defined(PROBE_P)
    unsigned long long st0 = __builtin_amdgcn_s_memrealtime();
#define SUBMARK(w) do { const unsigned long long t_ = __builtin_amdgcn_s_memrealtime(); if (swhich == (w)) sacc += t_ - st0; st0 = t_; } while (0)
#else
#define SUBMARK(w) do { } while (0)
#endif
    const bf16_t* QA = (const bf16_t*)(a.ws + WS_QA); const bf16_t* QW = QA + 1024;
    unsigned char* Y8 = a.ws + WS_Y8;
    const bf16_t* KA = (const bf16_t*)(a.ws + WS_KA); const bf16_t* KW = (const bf16_t*)(a.ws + WS_KW);
    const bf16_t* VTA = (const bf16_t*)(a.ws + WS_VTA); const bf16_t* VTW = (const bf16_t*)(a.ws + WS_VTW);
    const float* sinks = a.in[I_SINK] + l * 8; const float* qkg = a.in[I_QKG] + l * 256;
    const float* ct = (const float*)(a.ws + WS_ROPE); const float* st = ct + SEQ * 32;
    const int wq = F.wave >> 1, wh = F.wave & 1;
    const int ubid = (F.G % 8 == 0) ? (F.bid & 7) * (F.G >> 3) + (F.bid >> 3) : F.bid;
#define RELANE(FX) do { int t_ = F.wave * 64 + lane_id(); asm volatile("" : "+v"(t_)); FX.tid = t_; FX.lane = t_ & 63; } while (0)
    Fr FA = F; RELANE(FA);
    for (int unit = ubid; unit < NB * 2 * 32; unit += F.G) {
        const int b = unit >> 6, kvh = (unit >> 5) & 1, pb = unit & 31;
        const size_t qo = (size_t)(b * SEQ + pb * 64 + wh * 32) * 1536 + (kvh * 4 + wq) * 64;
        attn_unit<false>(FA, QA + qo, Y8 + qo, KA + (size_t)b * KEYS * 128 + kvh * 64, VTA + (size_t)(b * 2 + kvh) * 64 * KEYS, 0, KEYS / 128, 0, 0, pb * 64 + wh * 32, false, 0.f, qkg, true, ct, st);
    }
    SUBMARK(30);
    Fr FW = F; RELANE(FW);
    for (int unit = ubid; unit < NB * 2 * 32; unit += F.G) {
        const int b = unit >> 6, kvh = (unit >> 5) & 1, pb = unit & 31;
        const size_t qo = (size_t)(b * SEQ + pb * 64 + wh * 32) * 1536 + (kvh * 4 + wq) * 64 + 1024;
        const int lo = pb < 2 ? 0 : (pb - 2) >> 1, hi = ((64 * pb + 191) >> 7) > 15 ? 15 : ((64 * pb + 191) >> 7);
        attn_unit<true>(FW, QA + qo, Y8 + qo, KW + (size_t)b * KEYS * 128 + kvh * 64, VTW + (size_t)(b * 2 + kvh) * 64 * KEYS, 0, 2, 2 + lo, hi - lo + 1, pb * 64 + wh * 32, true, sinks[kvh * 4 + wq] * LOG2E, qkg + 128, true, ct, st);
    }
    SUBMARK(31);
    Fr FC2 = F; RELANE(FC2);
    if (with_ctx) {
        for (int unit = ubid; unit < 2 * NB * 2 * 4; unit += F.G) {
            const int isw = unit >> 7, u2 = unit & 127, b = u2 >> 3, kvh = (u2 >> 2) & 1, pb = u2 & 3;
            const size_t qo = (size_t)(TL + b * CTX + pb * 64 + wh * 32) * 1536 + (kvh * 4 + wq) * 64 + (isw ? 1024 : 0);
            attn_unit<false>(FC2, QA + qo, Y8 + qo, (isw ? KW : KA) + (size_t)b * KEYS * 128 + kvh * 64, (isw ? VTW : VTA) + (size_t)(b * 2 + kvh) * 64 * KEYS, 0, 2, 0, 0, 0, isw != 0, isw ? sinks[kvh * 4 + wq] * LOG2E : 0.f, qkg + (isw ? 128 : 0), false, ct, st);
        }
    }
    SUBMARK(32);
    const bf16_t* FL = (const bf16_t*)(a.ws + WS_FL) + (size_t)l * 512 * 4096; const bf16_t* FC = (const bf16_t*)(a.ws + WS_FC) + (size_t)l * 512 * 512;
    const bf16_t* VT = (const bf16_t*)(a.ws + WS_VT); bf16_t* YT = (bf16_t*)(a.ws + WS_YT);
    Fr FH = F; RELANE(FH);
    for (int c = F.bid; c < HYW; c += F.G) hyena_unit_lat(FH, FL + (size_t)c * 4096, VT + (size_t)c * NB * SEQ, YT + (size_t)c * NB * SEQ);
    if (with_ctx) for (int c = F.bid; c < HYW; c += F.G) hyena_unit_ctx(FH, FC + (size_t)c * 512, VT + VT_CTX_OFF + (size_t)c * NB * CTX, YT + VT_CTX_OFF + (size_t)c * NB * CTX);
    __syncthreads();
    SUBMARK(33);
#undef SUBMARK
#undef RELANE
}

__device__ __forceinline__ float gate_q(float x) { return fminf(256.f * sigmoid_f(x), 255.49f); }
__device__ __forceinline__ unsigned pack_u8x4(float a, float b, float c, float d) { return (unsigned)(int)a | ((unsigned)(int)b << 8) | ((unsigned)(int)c << 16) | ((unsigned)(int)d << 24); }
__device__ __forceinline__ float gq(unsigned w, int k) { return (float)((w >> (8 * k)) & 0xffu) + 0.5f; }
struct EpiInProj {
    static constexpr bool PERM = true, AFTER_DRAIN = false; static constexpr int NSEG = 1;
    unsigned char* ws; int pn_off;
    __device__ __forceinline__ void operator()(const pg8::f32x4 (&acc)[2][2][4][2], const pg8::Unit& u, int wr, int wc, int fr, int fq) const {
        asm volatile("" : "+v"(fr), "+v"(fq));
        const int pn = __builtin_amdgcn_readfirstlane(u.pn) + pn_off; unsigned long long boff; int ldc, colt; bool sig = false;
        if (pn < 2) { boff = WS_QA; ldc = 1536; colt = pn * 256; }
        else if (pn == 2) { boff = WS_RAWA; ldc = 256; colt = 0; }
        else if (pn < 9) { boff = WS_U; ldc = 1536; colt = (pn - 3) * 256; }
        else if (pn < 11) { boff = WS_QA; ldc = 1536; colt = 1024 + (pn - 9) * 256; }
        else if (pn == 11) { boff = WS_RAWW; ldc = 256; colt = 0; }
        else { boff = WS_G; ldc = 3072; colt = (pn - 12) * 256; sig = true; }
        bf16_t* base = (bf16_t*)(ws + boff); unsigned char* Gt = ws + boff;
        const int row0 = u.pm * 256 + wr * 64 + fr, col0 = colt + wc * 32 + 8 * fq;
        if (sig) {
            unsigned char* gb = (unsigned char*)Gt;
#pragma unroll
            for (int ai = 0; ai < 2; ++ai)
#pragma unroll
                for (int m = 0; m < 4; ++m) { unsigned char* rowp = gb + (size_t)(row0 + ai * 128 + m * 16) * 3072 + col0;
#pragma unroll
                    for (int bj = 0; bj < 2; ++bj) { const pg8::f32x4 v0 = acc[ai][bj][m][0], v1 = acc[ai][bj][m][1];
                        u32x2 w; w.x = pack_u8x4(gate_q(v0.x), gate_q(v0.y), gate_q(v0.z), gate_q(v0.w)); w.y = pack_u8x4(gate_q(v1.x), gate_q(v1.y), gate_q(v1.z), gate_q(v1.w));
                        *(u32x2*)(rowp + bj * 128) = w; } }
            return;
        }
#pragma unroll
        for (int ai = 0; ai < 2; ++ai)
#pragma unroll
            for (int m = 0; m < 4; ++m) { bf16_t* rowp = base + (size_t)(row0 + ai * 128 + m * 16) * ldc + col0;
#pragma unroll
                for (int bj = 0; bj < 2; ++bj) { const pg8::f32x4 v0 = acc[ai][bj][m][0], v1 = acc[ai][bj][m][1];
                    u32x4 w; w.x = cvtpk(v0.x, v0.y); w.y = cvtpk(v0.z, v0.w); w.z = cvtpk(v1.x, v1.y); w.w = cvtpk(v1.z, v1.w);
                    *(u32x4*)(rowp + bj * 128) = w; } }
    }
};
struct EpiGate {
    static constexpr bool PERM = true, AFTER_DRAIN = false; static constexpr int NSEG = 1;
    unsigned char* Gt;
    __device__ __forceinline__ void operator()(const pg8::f32x4 (&acc)[2][2][4][2], const pg8::Unit& u, int wr, int wc, int fr, int fq) const {
        asm volatile("" : "+v"(fr), "+v"(fq));
        const int row0 = u.pm * 256 + wr * 64 + fr, col0 = u.pn * 256 + wc * 32 + 8 * fq;
#pragma unroll
        for (int ai = 0; ai < 2; ++ai)
#pragma unroll
            for (int m = 0; m < 4; ++m) { unsigned char* rowp = Gt + (size_t)(row0 + ai * 128 + m * 16) * 3072 + col0;
#pragma unroll
                for (int bj = 0; bj < 2; ++bj) { const pg8::f32x4 v0 = acc[ai][bj][m][0], v1 = acc[ai][bj][m][1];
                    u32x2 w; w.x = pack_u8x4(gate_q(v0.x), gate_q(v0.y), gate_q(v0.z), gate_q(v0.w)); w.y = pack_u8x4(gate_q(v1.x), gate_q(v1.y), gate_q(v1.z), gate_q(v1.w));
                    *(u32x2*)(rowp + bj * 128) = w; } }
    }
};
struct EpiMerge {
    static constexpr bool PERM = true, AFTER_DRAIN = false; static constexpr int NSEG = 3;
    unsigned char* Mo; const unsigned char* Gt;
    __device__ __forceinline__ void rescale(pg8::f32x4 (&acc)[2][2][4][2], const pg8::Unit& u, int seg, int wr, int wc, int fr, int fq) const {
        asm volatile("" : "+v"(fr), "+v"(fq));
        const int row0 = u.pm * 256 + wr * 64 + fr, col0 = u.pn * 256 + wc * 32 + 8 * fq;
        const unsigned char* G0 = Gt + seg * 1024 + col0;
#pragma unroll
        for (int ai = 0; ai < 2; ++ai)
#pragma unroll
            for (int mh = 0; mh < 2; ++mh) {
                u32x2 ga[2][2], gb[2][2];
#pragma unroll
                for (int mm = 0; mm < 2; ++mm)
#pragma unroll
                    for (int bj = 0; bj < 2; ++bj) { const size_t row = (size_t)(row0 + ai * 128 + (2 * mh + mm) * 16);
                        ga[mm][bj] = *(const u32x2*)(G0 + row * 3072 + bj * 128); gb[mm][bj] = *(const u32x2*)(G0 + row * 3072 + 1024 + bj * 128); }
                __builtin_amdgcn_sched_barrier(0);
#pragma unroll
                for (int mm = 0; mm < 2; ++mm)
#pragma unroll
                    for (int bj = 0; bj < 2; ++bj) { const u32x2 a = ga[mm][bj], b = gb[mm][bj]; pg8::f32x4& v0 = acc[ai][bj][2 * mh + mm][0]; pg8::f32x4& v1 = acc[ai][bj][2 * mh + mm][1];
                        v0.x *= gq(a.x, 0) * fast_rcp(gq(b.x, 0)); v0.y *= gq(a.x, 1) * fast_rcp(gq(b.x, 1)); v0.z *= gq(a.x, 2) * fast_rcp(gq(b.x, 2)); v0.w *= gq(a.x, 3) * fast_rcp(gq(b.x, 3));
                        v1.x *= gq(a.y, 0) * fast_rcp(gq(b.y, 0)); v1.y *= gq(a.y, 1) * fast_rcp(gq(b.y, 1)); v1.z *= gq(a.y, 2) * fast_rcp(gq(b.y, 2)); v1.w *= gq(a.y, 3) * fast_rcp(gq(b.y, 3)); }
                __builtin_amdgcn_sched_barrier(0);
            }
    }
    __device__ __forceinline__ void operator()(const pg8::f32x4 (&acc)[2][2][4][2], const pg8::Unit& u, int wr, int wc, int fr, int fq) const {
        asm volatile("" : "+v"(fr), "+v"(fq));
        const int row0 = u.pm * 256 + wr * 64 + fr, col0 = u.pn * 256 + wc * 32 + 8 * fq;
        constexpr float S = 16.f / 256.f;
#pragma unroll
        for (int ai = 0; ai < 2; ++ai) {
            u32x2 gv[4][2];
#pragma unroll
            for (int m = 0; m < 4; ++m)
#pragma unroll
                for (int bj = 0; bj < 2; ++bj) gv[m][bj] = *(const u32x2*)(Gt + (size_t)(row0 + ai * 128 + m * 16) * 3072 + 2048 + col0 + bj * 128);
            __builtin_amdgcn_sched_barrier(0);
#pragma unroll
            for (int m = 0; m < 4; ++m)
#pragma unroll
                for (int bj = 0; bj < 2; ++bj) { const pg8::f32x4 v0 = acc[ai][bj][m][0], v1 = acc[ai][bj][m][1]; const u32x2 g = gv[m][bj];
                    u32x2 w; w.x = cvt4_fp8(v0.x * (gq(g.x, 0) * S), v0.y * (gq(g.x, 1) * S), v0.z * (gq(g.x, 2) * S), v0.w * (gq(g.x, 3) * S));
                    w.y = cvt4_fp8(v1.x * (gq(g.y, 0) * S), v1.y * (gq(g.y, 1) * S), v1.z * (gq(g.y, 2) * S), v1.w * (gq(g.y, 3) * S));
                    *(u32x2*)(Mo + (size_t)(row0 + ai * 128 + m * 16) * 1024 + col0 + bj * 128) = w; }
            __builtin_amdgcn_sched_barrier(0);
        }
    }
};
struct EpiOut {
    static constexpr bool PERM = true, AFTER_DRAIN = false; static constexpr int NSEG = 1;
    const float* xsL; const float* xsC; float* xdL; float* xdC; const float* MODl;
    __device__ __forceinline__ void operator()(const pg8::f32x4 (&acc)[2][2][4][2], const pg8::Unit& u, int wr, int wc, int fr, int fq) const {
        asm volatile("" : "+v"(fr), "+v"(fq));
        const int trow = u.pm * 256; const bool lat = trow < TL;
        const int row0 = trow + wr * 64 + fr, col0 = u.pn * 256 + wc * 32 + 8 * fq;
        const float* md = MODl + (size_t)mod_row(trow) * DIN + 2 * 1024 + col0;
        const float* xs = lat ? xsL + (size_t)row0 * D + col0 : xsC + (size_t)(row0 - TL) * D + col0; float* xd = lat ? xdL + (size_t)row0 * D + col0 : xdC + (size_t)(row0 - TL) * D + col0;
        f32x4 mv[2][2];
#pragma unroll
        for (int bj = 0; bj < 2; ++bj)
#pragma unroll
            for (int n = 0; n < 2; ++n) mv[bj][n] = *(const f32x4*)(md + bj * 128 + 4 * n);
#pragma unroll
        for (int ai = 0; ai < 2; ++ai)
#pragma unroll
            for (int mh = 0; mh < 2; ++mh) {
                f32x4 xv[2][2][2];
#pragma unroll
                for (int mm = 0; mm < 2; ++mm)
#pragma unroll
                    for (int bj = 0; bj < 2; ++bj)
#pragma unroll
                        for (int n = 0; n < 2; ++n) xv[mm][bj][n] = *(const f32x4*)(xs + (size_t)(ai * 128 + (2 * mh + mm) * 16) * D + bj * 128 + 4 * n);
                __builtin_amdgcn_sched_barrier(0);
#pragma unroll
                for (int mm = 0; mm < 2; ++mm)
#pragma unroll
                    for (int bj = 0; bj < 2; ++bj)
#pragma unroll
                        for (int n = 0; n < 2; ++n) { const pg8::f32x4 av = acc[ai][bj][2 * mh + mm][n]; const f32x4 x4 = xv[mm][bj][n], m4 = mv[bj][n];
                            f32x4 o; o.x = fmaf(m4.x, av.x, x4.x); o.y = fmaf(m4.y, av.y, x4.y); o.z = fmaf(m4.z, av.z, x4.z); o.w = fmaf(m4.w, av.w, x4.w);
                            *(f32x4*)(xd + (size_t)(ai * 128 + (2 * mh + mm) * 16) * D + bj * 128 + 4 * n) = o; }
                __builtin_amdgcn_sched_barrier(0);
            }
    }
};
struct EpiMoe1 {
    static constexpr bool PERM = true, AFTER_DRAIN = false; static constexpr int NSEG = 1;
    unsigned char* HM;
    __device__ __forceinline__ void operator()(const pg8::f32x4 (&acc)[2][2][4][2], const pg8::Unit& u, int wr, int wc, int fr, int fq) const {
        asm volatile("" : "+v"(fr), "+v"(fq));
        const int row0 = u.pm * 256 + wr * 64 + fr, hcol0 = (u.pn & 3) * 128 + wc * 16 + 4 * fq;
#pragma unroll
        for (int ai = 0; ai < 2; ++ai)
#pragma unroll
            for (int m = 0; m < 4; ++m) { unsigned char* rowp = HM + (size_t)(row0 + ai * 128 + m * 16) * 512 + hcol0;
#pragma unroll
                for (int bj = 0; bj < 2; ++bj) { const pg8::f32x4 x = acc[ai][bj][m][0], y = acc[ai][bj][m][1] * 8.f;
                    *(unsigned*)(rowp + bj * 64) = cvt4_fp8(x.x * sigmoid_f(x.x) * y.x, x.y * sigmoid_f(x.y) * y.y, x.z * sigmoid_f(x.z) * y.z, x.w * sigmoid_f(x.w) * y.w); } }
    }
};
struct EpiMoe2 {
    static constexpr bool PERM = true, AFTER_DRAIN = false; static constexpr int NSEG = 1;
    bf16_t* Fo; const int* erow; const float* eroww; const LAS int* ebase; const LAS int* ecnt;
    __device__ __forceinline__ void operator()(const pg8::f32x4 (&acc)[2][2][4][2], const pg8::Unit& u, int wr, int wc, int fr, int fq) const {
        asm volatile("" : "+v"(fr), "+v"(fq));
        const int e = u.pn >> 2, cnt = __builtin_amdgcn_readfirstlane(ecnt[e]), pos0 = u.pm * 256 - __builtin_amdgcn_readfirstlane(ebase[e]) + wr * 64 + fr, col0 = (u.pn & 3) * 256 + wc * 32 + 8 * fq;
        const int* er = erow + (size_t)e * TT; const float* ew = eroww + (size_t)e * TT;
#pragma unroll
        for (int ai = 0; ai < 2; ++ai) {
            int rm[4]; float wg[4];
#pragma unroll
            for (int m = 0; m < 4; ++m) { const int pos = pos0 + ai * 128 + m * 16; const bool ok = pos < cnt; rm[m] = ok ? er[ok ? pos : 0] : -1; wg[m] = ew[ok ? pos : 0]; }
            __builtin_amdgcn_sched_barrier(0);
#pragma unroll
            for (int m = 0; m < 4; ++m) { const int r1 = rm[m];
                if (r1 >= 0) { const float wgt = wg[m]; bf16_t* rowp = Fo + ((size_t)(r1 & 1) * TT + (r1 >> 1)) * D + col0;
#pragma unroll
                    for (int bj = 0; bj < 2; ++bj) { const pg8::f32x4 v0 = acc[ai][bj][m][0], v1 = acc[ai][bj][m][1];
                        u32x4 w; w.x = cvtpk(v0.x * wgt, v0.y * wgt); w.y = cvtpk(v0.z * wgt, v0.w * wgt); w.z = cvtpk(v1.x * wgt, v1.y * wgt); w.w = cvtpk(v1.z * wgt, v1.w * wgt);
                        *(u32x4*)(rowp + bj * 128) = w; } } }
            __builtin_amdgcn_sched_barrier(0);
        }
    }
};
struct FusedOutOrder {
    int c, G, nun, wv; const unsigned* ready; unsigned* tmo;
    __device__ __forceinline__ bool next(int i, pg8::Unit& u) const {
        int q;
        if (!ready) { q = i * G + c; if (q >= nun) return false; }
        else if (G == 256 && nun == 576) { if (c < 64) { if (i > 0) return false; q = 512 + c; } else { q = i * 192 + (c - 64); if (q >= 512) return false; } }
        else { q = i * G + (G - 1 - c); if (q >= nun) return false; }
        u.pm = q >> 2; u.pn = q & 3; return true; }
    __device__ __forceinline__ void a_ready(const pg8::Unit& u) const {
        if (!ready) return;
        if (wv == 0) {
            const unsigned long long t0 = __builtin_amdgcn_s_memrealtime(); unsigned polls = 0;
            while ((unsigned)__builtin_amdgcn_readfirstlane(__hip_atomic_load(ready + 64 * u.pm, __ATOMIC_RELAXED, __HIP_MEMORY_SCOPE_AGENT)) < 32u) {
                if ((++polls & 255u) == 0u && __builtin_amdgcn_readfirstlane(__hip_atomic_load(tmo, __ATOMIC_RELAXED, __HIP_MEMORY_SCOPE_AGENT)) != 0u) break;
                if (__builtin_amdgcn_s_memrealtime() - t0 > 20000000ull) { if (lane_id() == 0) __hip_atomic_store(tmo, 1u, __ATOMIC_RELAXED, __HIP_MEMORY_SCOPE_AGENT); break; }
                __builtin_amdgcn_s_sleep(2); }
            __builtin_amdgcn_fence(__ATOMIC_ACQUIRE, "agent");
            asm volatile("s_waitcnt vmcnt(0)" ::: "memory");
        }
        asm volatile("" ::: "memory"); __builtin_amdgcn_s_barrier(); asm volatile("" ::: "memory");
    }
    __device__ __forceinline__ void done(const pg8::Unit&) const {}
};
struct LastInProjOrder {
    pg8::StaticOrder T; int nlat, G, c;
    __device__ __forceinline__ bool next(int i, pg8::Unit& u) const {
        const int L = i * G + c;
        if (L < nlat) return T.next(i, u);
        const int r = L - nlat; if (r >= 32) return false;
        u.pm = 128 + (r >> 1); u.pn = (r & 1) ? 11 : 2; return true; }
    __device__ __forceinline__ void a_ready(const pg8::Unit&) const {}
    __device__ __forceinline__ void done(const pg8::Unit&) const {}
};
struct MoeOrder {
    int nunits, G, c; const LAS int* tile_e;
    __device__ __forceinline__ bool next(int i, pg8::Unit& u) const {
        const int L0 = i * G + c; if (L0 >= nunits) return false;
        const int q = nunits / 8, r = nunits % 8, xcd = L0 % 8, off = L0 / 8; const int L = (xcd < r ? xcd * (q + 1) : r * (q + 1) + (xcd - r) * q) + off;
        const int pm = L >> 2; u.pm = pm; u.pn = __builtin_amdgcn_readfirstlane(tile_e[pm]) * 4 + (L & 3); return true; }
    __device__ __forceinline__ void a_ready(const pg8::Unit&) const {}
    __device__ __forceinline__ void done(const pg8::Unit&) const {}
};

__device__ __forceinline__ int moe_tables(const Fr& F, const Args& a, int l, LAS int* ebase  , LAS int* ecnt  , LAS int* tile_e  ) {
    const unsigned* CNT = (const unsigned*)(a.ws + WS_CTL) + CW_CNT + l * 256;
    __syncthreads();
    if (F.tid == 0) { int acc = 0;
#pragma unroll 1
        for (int e = 0; e < NE; ++e) { const int c = (int)__hip_atomic_load(&CNT[e * 16], __ATOMIC_RELAXED, __HIP_MEMORY_SCOPE_AGENT); ecnt[e] = c; ebase[e] = acc; const int nt = (c + 255) >> 8;
#pragma unroll 1
            for (int t = 0; t < nt; ++t) tile_e[(acc >> 8) + t] = e;
            acc += nt << 8; }
        ebase[NE] = acc; }
    __syncthreads();
    return ebase[NE] >> 8;
}

__device__ __forceinline__ void moe_gather_table(const Fr& F, const Args& a, const MoeOrder& S, const LAS int* ebase, const LAS int* ecnt, LAS int* gidx) {
    const int* EROW = (const int*)(a.ws + WS_EROW);
    for (int j = 0; j < 16; ++j) { pg8::Unit u; if (!S.next(j, u)) break;
        const int e = u.pn >> 2, pos0 = u.pm * 256 - ebase[e], cnt = ecnt[e];
        if (F.tid < 256) { const int pos = pos0 + F.tid; gidx[j * 256 + F.tid] = pos < cnt ? (EROW[(size_t)e * TT + pos] >> 1) : 0; } }
    __syncthreads();
}

#ifndef MK_PER_PHASE
#define MK_PER_PHASE 0
#endif
constexpr int PH_PER_LAYER = 10, PH_FINAL = 1 + NL * PH_PER_LAYER, N_PHASES = PH_FINAL + 1;

__global__ void __launch_bounds__(NTHR, 2) trunk_fwd(Args args) {
    extern __shared__ __attribute__((aligned(16))) unsigned char lds[];
    Fr F; F.lds = (LAS unsigned char*)lds; F.tid = threadIdx.x; F.lane = F.tid & 63; F.wave = __builtin_amdgcn_readfirstlane(F.tid >> 6); F.G = gridDim.x; F.bid = blockIdx.x;
    const int wave0 = F.wave;
    for (int u = F.tid; u < (LDS_BYTES - MISC_OFF) / 4; u += NTHR) ((LAS unsigned*)(F.lds + MISC_OFF))[u] = 0u;
    __syncthreads();
    const int lo = args.ph_lo, hi = args.ph_hi;
    unsigned* ctl = (unsigned*)(args.ws + WS_CTL);
    XcdBarrier bar; bar.bar = ctl + CW_BAR; bar.x = 0; bar.st = (volatile LAS unsigned*)(F.lds + MISC_OFF);
    if (hi - lo > 1) bar = xcd_barrier_post(ctl + CW_BAR, (volatile LAS unsigned*)(F.lds + MISC_OFF));
    bar.wv = (unsigned)wave0;
#ifndef DBG_ONLY
#define DBG_ONLY -1
#endif
#define SEL(p) (DBG_ONLY < 0 || DBG_ONLY == (p))
#define IN(k) (lo <= (k) && (k) < hi)
#define FRESH() do { int t_ = wave0 * 64 + lane_id(); asm volatile("" : "+v"(t_)); F.tid = t_; F.lane = t_ & 63; F.wave = wave0; } while (0)
#define SEAM(k) do { if (IN(k) && IN((k) + 1)) xcd_barrier(bar); } while (0)
#if !defined(PROBE_SUB)
#define PROBE_SUB -1
#endif
    unsigned long long pr_sub = 0ull;
#if defined(PROBE_P)
    unsigned long long pr_acc = 0ull, pr_t0 = __builtin_amdgcn_s_memrealtime();
#define PR_MARK(p) do { const unsigned long long t_ = __builtin_amdgcn_s_memrealtime(); if ((p) == PROBE_P) pr_acc += t_ - pr_t0; pr_t0 = t_; } while (0)
#else
#define PR_MARK(p) do { } while (0)
#endif
    unsigned char* ws = args.ws;
    LAS int* ebase = (LAS int*)(F.lds + MISC_OFF + 64); LAS int* ecnt = ebase + 20; LAS int* tile_e = (LAS int*)(F.lds + MISC_OFF + 512);

    #ifndef DBG_PRO
#define DBG_PRO 7
#endif
    if (SEL(100) && IN(0)) { FRESH(); if (DBG_PRO & 1) pro_mod(F, args); __syncthreads(); if (DBG_PRO & 2) pro_rope(F, args); if (DBG_PRO & 4) pro_filter(F, args); __syncthreads(); }
    SEAM(0); PR_MARK(100);
    for (int l = 0; l < NL; ++l) {
        const int pb = 1 + PH_PER_LAYER * l;
#define LVARS() int lq_ = l; asm volatile("" : "+s"(lq_)); const bool uc = lq_ < NL - 1; const int M2 = uc ? TT : TL; (void)M2; (void)uc
        if (SEL(0) && IN(pb + 0)) { LVARS(); FRESH(); if (l == 0) filter_norm_reduce(F, args); conv_small_weights(F, args, l, 7, 0); rows_p0(F, args, l, TT); __syncthreads(); }
        SEAM(pb + 0); PR_MARK(0);
        if (SEL(1) && IN(pb + 1)) { LVARS();
            pg8::Gemm g{(const bf16_t*)(ws + WS_H8), (const bf16_t*)(ws + WS_WG8), TT, DIN, 512}; EpiInProj E{ws, 0};
            if (uc) { pg8::StaticOrder S; S.init(TT, DIN, F.G, F.bid); pg8::gemm_phase<EpiInProj, pg8::StaticOrder, true, true, false, true, -6>(F.lds, g, S, E, wave0); }
            else { LastInProjOrder S; S.T.init(TL, DIN, F.G, F.bid); S.nlat = (TL / 256) * (DIN / 256); S.G = F.G; S.c = F.bid; pg8::gemm_phase<EpiInProj, LastInProjOrder, true, true, false, true, -6>(F.lds, g, S, E, wave0); }
        }
        SEAM(pb + 1); PR_MARK(1);
        if (SEL(2) && IN(pb + 2)) { LVARS(); FRESH(); prep_phase(F, args, l, uc); }
        SEAM(pb + 2); PR_MARK(2);
        if (SEL(3) && IN(pb + 3)) { LVARS(); FRESH(); mixer_phase(F, args, l, uc, pr_sub, PROBE_SUB); }
        SEAM(pb + 3); PR_MARK(3);
        if (SEL(4) && IN(pb + 4)) { LVARS(); FRESH(); hyena_final_phase(F, args, l, uc); }
        SEAM(pb + 4); PR_MARK(4);
        if (SEL(5) && IN(pb + 5)) { LVARS();
            pg8::StaticOrder S; S.init(M2, 1024, F.G, F.bid);
            pg8::Gemm g{(const bf16_t*)(ws + WS_Y8), (const bf16_t*)(ws + WS_WBR), M2, 1024, 768}; EpiMerge E{ws + WS_H, (const unsigned char*)(ws + WS_G)};
            pg8::gemm_phase<EpiMerge, pg8::StaticOrder, true, true, false, true, -10>(F.lds, g, S, E, wave0);
            { FRESH(); __syncthreads(); const int nun = (M2 / 256) * 4, rem = nun % F.G; conv_expert_weights(F, args, l, rem, 0, CONV_E_ITEMS); __syncthreads(); }
        }
        SEAM(pb + 5); PR_MARK(5);
        if (SEL(6) && IN(pb + 6)) { LVARS();
            pg8::Gemm g{(const bf16_t*)(ws + WS_H), (const bf16_t*)(ws + WS_WOUT), M2, 1024, 512}; pg8::StaticOrder S; S.init(M2, 1024, F.G, F.bid);
            EpiOut E{l == 0 ? args.in[I_X] : args.out, l == 0 ? args.in[I_CTX] : (const float*)(ws + WS_XC), args.out, (float*)(ws + WS_XC), (const float*)(ws + WS_MOD) + (size_t)l * NBM * DIN};
            pg8::gemm_phase<EpiOut, pg8::StaticOrder, true, true, false, true, -10>(F.lds, g, S, E, wave0);
        }
        SEAM(pb + 6); PR_MARK(6);
        if (SEL(7) && IN(pb + 7)) { LVARS(); FRESH(); rows_p5(F, args, l, M2, pr_sub, PROBE_SUB); __syncthreads(); }
        SEAM(pb + 7); PR_MARK(7);
        if (SEL(8) && IN(pb + 8)) { LVARS(); FRESH();
            const int ntile = moe_tables(F, args, l, ebase, ecnt, tile_e);
            pg8::Gemm g{(const bf16_t*)(ws + WS_H), (const bf16_t*)(ws + WS_W13), ntile * 256, NE * 1024, 512}; MoeOrder S{ntile * 4, F.G, F.bid, tile_e};
            LAS int* gidx = (LAS int*)(F.lds + 131072);
            moe_gather_table(F, args, S, ebase, ecnt, gidx);
            EpiMoe1 E{ws + WS_U};
            pg8::gemm_phase<EpiMoe1, MoeOrder, true, true, true, true, -6>(F.lds, g, S, E, wave0, gidx);
        }
        SEAM(pb + 8); PR_MARK(8);
        if (SEL(9) && IN(pb + 9)) { LVARS(); FRESH();
            const int ntile = moe_tables(F, args, l, ebase, ecnt, tile_e);
            pg8::Gemm g{(const bf16_t*)(ws + WS_U), (const bf16_t*)(ws + WS_W2), ntile * 256, NE * 1024, 256}; MoeOrder S{ntile * 4, F.G, F.bid, tile_e};
            EpiMoe2 E{(bf16_t*)(ws + WS_F), (const int*)(ws + WS_EROW), (const float*)(ws + WS_EROWW), ebase, ecnt};
            pg8::gemm_phase<EpiMoe2, MoeOrder, true, true, false, true, -9>(F.lds, g, S, E, wave0);
        }
        SEAM(pb + 9); PR_MARK(9);
    }
    if (SEL(101) && IN(PH_FINAL)) { FRESH(); rows_final(F, args); }
#if defined(PROBE_P)
    PR_MARK(101);
    pr_acc += pr_sub;
    if (blockIdx.x == 0 && F.wave == 0) { const unsigned long long t1 = __builtin_amdgcn_s_memrealtime() + 4ull * pr_acc; while (__builtin_amdgcn_s_memrealtime() < t1) __builtin_amdgcn_s_sleep(8); }
#endif
#undef IN
#undef SEAM
}

extern "C" void kernel_launch(void* const* d_in, const int* in_sizes, int n_in, void* d_out, int out_size, void* d_ws, size_t ws_size, hipStream_t stream) {
    static int grid = 0;
    if (grid == 0) {
        if (n_in != 29 || in_sizes[0] != TL * D || out_size != TL * D || ws_size < WS_END) { fprintf(stderr, "kernel_launch: unexpected shapes / workspace (n_in %d, ws %zu < %zu); nothing launched\n", n_in, ws_size, (size_t)WS_END); grid = -1; return; }
        int dev = 0, cus = 0, per_cu = 0;
        if (hipGetDevice(&dev) != hipSuccess || hipDeviceGetAttribute(&cus, hipDeviceAttributeMultiprocessorCount, dev) != hipSuccess) { grid = -1; return; }
        if (hipFuncSetAttribute((const void*)trunk_fwd, hipFuncAttributeMaxDynamicSharedMemorySize, LDS_BYTES) != hipSuccess) { fprintf(stderr, "kernel_launch: hipFuncSetAttribute failed\n"); grid = -1; return; }
        if (hipOccupancyMaxActiveBlocksPerMultiprocessor(&per_cu, (const void*)trunk_fwd, NTHR, LDS_BYTES) != hipSuccess || per_cu < 1) { fprintf(stderr, "kernel_launch: occupancy query reports %d\n", per_cu); }
        (void)hipGetLastError();
        grid = cus;
    }
    if (grid < 0) return;
    (void)hipMemsetAsync((char*)d_ws + WS_CTL, 0, CTL_ZERO_BYTES, stream);
    Args a{};
    for (int i = 0; i < 29; ++i) a.in[i] = (const float*)d_in[i];
    a.out = (float*)d_out; a.ws = (unsigned char*)d_ws;
#if MK_PER_PHASE
    for (int k = 0; k < N_PHASES; ++k) { a.ph_lo = k; a.ph_hi = k + 1; hipLaunchKernelGGL(trunk_fwd, dim3(grid), dim3(NTHR), LDS_BYTES, stream, a); }
#else
    a.ph_lo = 0; a.ph_hi = N_PHASES;
    hipLaunchKernelGGL(trunk_fwd, dim3(grid), dim3(NTHR), LDS_BYTES, stream, a);
#endif
}
```

```cpp
#include <hip/hip_runtime.h>
#include <cstdio>
#include <cstdint>

#define GAS __attribute__((address_space(1)))
#define LAS __attribute__((address_space(3)))
__device__ __forceinline__ int lane_id() { int l; asm volatile("v_mbcnt_lo_u32_b32 %0, -1, 0\n\tv_mbcnt_hi_u32_b32 %0, -1, %0" : "=v"(l)); return l; }
#define MK_PER_PHASE 0
namespace pg8 {
#define PG8_LAS __attribute__((address_space(3)))
typedef unsigned short bf16_t;
typedef short bf16x8 __attribute__((ext_vector_type(8)));
typedef float f32x4 __attribute__((ext_vector_type(4)));
typedef unsigned u32x4 __attribute__((ext_vector_type(4)));
constexpr int BM = 256, BK = 64, HALF = 128, HTB = HALF * BK * 2  , STAGE_BYTES = 8 * HTB, NXCD = 8, WGM = 8;

__host__ __device__ __forceinline__ int lds_byte(int r, int c) { const int st = (r >> 4) * 2 + (c >> 5), rr = r & 15, cc = c & 31, ob = rr * 64 + cc * 2; return st * 1024 + (ob ^ (((ob >> 9) & 1) << 5)); }
__host__ __device__ __forceinline__ void stage_rc(int b, int& R, int& C) { const int st = b / 1024, sb = b % 1024, swz = sb ^ (((sb >> 9) & 1) << 5); R = (st >> 1) * 16 + swz / 64; C = (st & 1) * 32 + (swz % 64) / 2; }
__host__ __device__ __forceinline__ int perm32(int rho) { const int n = rho >> 4, i = rho & 15; return 8 * (i >> 2) + 4 * n + (i & 3); }

struct Unit { int pm, pn; };
struct Gemm { const bf16_t* A; const bf16_t* Bt; int M, N, K; };

struct StaticOrder {
    int nM, nN, nwg, G, c;
    __host__ __device__ void init(int M, int N, int G_, int c_) { nM = M / BM; nN = N / BM; nwg = nM * nN; G = G_; c = c_; }
    __host__ __device__ bool next(int i, Unit& u) const {
        const long L = (long)i * G + c; if (L >= nwg) return false;
        int wgid = (int)L; { const int q = nwg / NXCD, r = nwg % NXCD, xcd = wgid % NXCD, off = wgid / NXCD; wgid = (xcd < r ? xcd * (q + 1) : r * (q + 1) + (xcd - r) * q) + off; }
        const int nig = WGM * nN, gid = wgid / nig, fm = gid * WGM, gsz = (nM - fm) < WGM ? (nM - fm) : WGM;
        u.pm = fm + ((wgid % nig) % gsz); u.pn = (wgid % nig) / gsz; return true;
    }
    __device__ __forceinline__ void a_ready(const Unit&) const {}
    __device__ __forceinline__ void done(const Unit&) const {}
};
__device__ __forceinline__ unsigned cvt_pk_bf16(float lo, float hi) { unsigned r; asm volatile("v_cvt_pk_bf16_f32 %0, %1, %2" : "=v"(r) : "v"(lo), "v"(hi)); return r; }
typedef float f32x2 __attribute__((ext_vector_type(2)));
template <class Epi, class Sched, bool ALIGN_EPI = false, bool SP2 = false, bool GATHER = false, bool F8 = false, int F8_SW = 0>
__device__ __forceinline__ void gemm_phase(PG8_LAS unsigned char* lds, const Gemm g, const Sched& S, const Epi& E, const int wave_id, const PG8_LAS int* gidx = nullptr) {
    static_assert(!GATHER || SP2, "GATHER is implemented for the SP2 loop only");
    int tid_ = wave_id * 64 + lane_id(); asm volatile("" : "+v"(tid_));
    const int tid = tid_, wid = __builtin_amdgcn_readfirstlane(tid >> 6), lane = tid & 63, wr = wid >> 2, wc = wid & 3, fr = lane & 15, fq = lane >> 4;
    const int K = g.K, nt = K / BK;
    unsigned voffA[2], voffB[2];
#pragma unroll
    for (int i = 0; i < 2; ++i) { int R, C; stage_rc(tid * 16 + i * 8192, R, C); const int Rb = Epi::PERM ? ((R & ~31) + perm32(R & 31)) : R;
        voffA[i] = (unsigned)(R * K + C) * 2u; voffB[i] = (unsigned)(Rb * K + C) * 2u; }
    unsigned goffA[2][2], goffN[2][2];
#define PG8_GOFF(dst, j) do { _Pragma("unroll") for (int _h = 0; _h < 2; ++_h) _Pragma("unroll") for (int _i = 0; _i < 2; ++_i) { int R_, C_; stage_rc(tid * 16 + _i * 8192, R_, C_); \
        dst[_h][_i] = ((unsigned)gidx[(j) * 256 + _h * 128 + R_] * (unsigned)K + (unsigned)C_) * 2u; } } while (0)
#define PG8_STAGE_A(bufoff, base, h, nx) do { if constexpr (GATHER) { unsigned o_[2] = {(nx) ? goffN[h][0] : goffA[h][0], (nx) ? goffN[h][1] : goffA[h][1]}; PG8_STAGE(bufoff, base, o_); } \
        else { PG8_STAGE(bufoff, (base) + ((h) ? hstep : 0), voffA); } } while (0)
    const size_t kstep = (size_t)(BK * 2);
    const size_t hstep = (size_t)HALF * K * 2;
    const size_t tstep = 2 * hstep;
    const unsigned ldsw = (unsigned)wid * 1024u;
    const int aoff = lds_byte(wr * 64 + fr, fq * 8), boff = lds_byte(wc * 32 + fr, fq * 8);
#define PG8_SA(b, h) (((b) * 2 + (h)) * HTB)
#define PG8_SB(b, h) ((4 + (b) * 2 + (h)) * HTB)
#define PG8_STAGE(bufoff, gbase, voff) do { _Pragma("unroll") for (int _i = 0; _i < 2; ++_i) \
        __builtin_amdgcn_global_load_lds((const unsigned*)((const char*)(gbase) + (voff)[_i]), (PG8_LAS unsigned*)(lds + (bufoff) + ldsw + _i * 8192), 16, 0, 0); } while (0)
#define PG8_LDA(dst, b, h) do { _Pragma("unroll") for (int m = 0; m < 4; ++m) _Pragma("unroll") for (int k = 0; k < 2; ++k) dst[m][k] = *(const PG8_LAS bf16x8*)(lds + PG8_SA(b, h) + aoff + m * 2048 + k * 1024); } while (0)
#define PG8_LDB(dst, b, h) do { _Pragma("unroll") for (int n = 0; n < 2; ++n) _Pragma("unroll") for (int k = 0; k < 2; ++k) dst[n][k] = *(const PG8_LAS bf16x8*)(lds + PG8_SB(b, h) + boff + n * 2048 + k * 1024); } while (0)
#define PG8_MMA(ai, bj, At, Bt) do { if constexpr (F8) __builtin_amdgcn_sched_barrier(0); __builtin_amdgcn_s_setprio(1); _Pragma("unroll") for (int m = 0; m < 4; ++m) _Pragma("unroll") for (int n = 0; n < 2; ++n) { \
        if constexpr (F8) { typedef int i32x4_ __attribute__((ext_vector_type(4))); typedef int i32x8_ __attribute__((ext_vector_type(8))); \
            const i32x8_ wf = __builtin_shufflevector(__builtin_bit_cast(i32x4_, Bt[n][0]), __builtin_bit_cast(i32x4_, Bt[n][1]), 0, 1, 2, 3, 4, 5, 6, 7); \
            const i32x8_ af = __builtin_shufflevector(__builtin_bit_cast(i32x4_, At[m][0]), __builtin_bit_cast(i32x4_, At[m][1]), 0, 1, 2, 3, 4, 5, 6, 7); \
              \
            asm volatile("v_mfma_scale_f32_16x16x128_f8f6f4 %0, %1, %2, %0, %3, %4 op_sel_hi:[0,0,0]" : "+v"(acc[ai][bj][m][n]) : "v"(wf), "v"(af), "v"(f8sw), "v"(f8sa)); } \
        else { _Pragma("unroll") for (int k = 0; k < 2; ++k) acc[ai][bj][m][n] = __builtin_amdgcn_mfma_f32_16x16x32_bf16(Bt[n][k], At[m][k], acc[ai][bj][m][n], 0, 0, 0); } } \
        __builtin_amdgcn_s_setprio(0); if constexpr (F8) __builtin_amdgcn_sched_barrier(0); } while (0)
#define PG8_WAIT_V(n) asm volatile("s_waitcnt vmcnt(" #n ")" ::: "memory")
#define PG8_WAIT_L(n) asm volatile("s_waitcnt lgkmcnt(" #n ")" ::: "memory")
#define PG8_BAR __builtin_amdgcn_s_barrier()
#define PG8_SCHED __builtin_amdgcn_sched_barrier(0)
    const int f8sw = 127 + F8_SW, f8sa = 127; (void)f8sw; (void)f8sa;
    Unit cur, nxt; int ui = 0;
    if (!S.next(0, cur)) return;
    f32x4 acc[2][2][4][2];
#pragma unroll
    for (int a = 0; a < 2; ++a)
#pragma unroll
        for (int b = 0; b < 2; ++b)
#pragma unroll
            for (int m = 0; m < 4; ++m)
#pragma unroll
                for (int n = 0; n < 2; ++n) acc[a][b][m][n] = (f32x4){0.f, 0.f, 0.f, 0.f};
    bf16x8 At[4][2], B0[2][2], B1[2][2];
    const char* cA = GATHER ? (const char*)g.A : (const char*)g.A + (size_t)cur.pm * tstep; const char* cB = (const char*)g.Bt + (size_t)cur.pn * tstep;
    if constexpr (GATHER) PG8_GOFF(goffA, 0);
    S.a_ready(cur);
    if constexpr (SP2) {
        PG8_STAGE(PG8_SB(0, 0), cB, voffB); PG8_STAGE(PG8_SB(0, 1), cB + hstep, voffB); PG8_STAGE_A(PG8_SA(0, 0), cA, 0, false); PG8_STAGE_A(PG8_SA(0, 1), cA, 1, false);
        if (wr == 1) PG8_BAR;
        PG8_WAIT_V(2); PG8_BAR;
        PG8_STAGE(PG8_SB(1, 0), cB + kstep, voffB); PG8_STAGE_A(PG8_SA(1, 0), cA + kstep, 0, false); PG8_STAGE(PG8_SB(1, 1), cB + hstep + kstep, voffB);
        PG8_WAIT_V(6); PG8_BAR;
    } else {
        PG8_STAGE(PG8_SB(0, 0), cB, voffB); PG8_STAGE(PG8_SA(0, 0), cA, voffA); PG8_STAGE(PG8_SB(0, 1), cB + hstep, voffB); PG8_STAGE(PG8_SA(0, 1), cA + hstep, voffA);
        if (wr == 1) PG8_BAR;
        PG8_WAIT_V(4); PG8_BAR;
        PG8_STAGE(PG8_SB(1, 0), cB + kstep, voffB); PG8_STAGE(PG8_SA(1, 0), cA + kstep, voffA); PG8_STAGE(PG8_SB(1, 1), cB + hstep + kstep, voffB);
        PG8_WAIT_V(6); PG8_BAR;
    }
    for (;;) {
        const bool has_next = S.next(ui + 1, nxt);
        if constexpr (GATHER) { if (has_next) PG8_GOFF(goffN, ui + 1); else { _Pragma("unroll") for (int _h = 0; _h < 2; ++_h) _Pragma("unroll") for (int _i = 0; _i < 2; ++_i) goffN[_h][_i] = goffA[_h][_i]; } }
        const char* nA = GATHER ? (const char*)g.A : has_next ? (const char*)g.A + (size_t)nxt.pm * tstep : cA; const char* nB = has_next ? (const char*)g.Bt + (size_t)nxt.pn * tstep : cB;
        for (int t = 0; t < nt; t += 2) {
            const bool last = (t == nt - 2);
            const char* a1 = cA + (size_t)(t + 1) * kstep;
            const char* a2 = last ? nA : cA + (size_t)(t + 2) * kstep; const char* b2 = last ? nB : cB + (size_t)(t + 2) * kstep;
            const char* a3 = a2 + kstep; const char* b3 = b2 + kstep;
            if (last && has_next) S.a_ready(nxt);
            if constexpr (SP2) {
            PG8_LDB(B0, 0, 0); PG8_LDB(B1, 0, 1); PG8_SCHED; PG8_LDA(At, 0, 0); PG8_STAGE_A(PG8_SA(1, 1), a1, 1, false);
            PG8_WAIT_V(8); PG8_WAIT_L(0); PG8_BAR; PG8_MMA(0, 0, At, B0); PG8_MMA(0, 1, At, B1); PG8_BAR; PG8_SCHED;
            PG8_LDA(At, 0, 1); PG8_STAGE(PG8_SB(0, 0), b2, voffB); PG8_STAGE(PG8_SB(0, 1), b2 + hstep, voffB); PG8_STAGE_A(PG8_SA(0, 0), a2, 0, last);
            PG8_WAIT_V(8); PG8_WAIT_L(0); PG8_BAR; PG8_MMA(1, 0, At, B0); PG8_MMA(1, 1, At, B1); PG8_BAR; PG8_SCHED;
            PG8_LDB(B0, 1, 0); PG8_LDB(B1, 1, 1); PG8_SCHED; PG8_LDA(At, 1, 0); PG8_STAGE_A(PG8_SA(0, 1), a2, 1, last);
            PG8_WAIT_V(8); PG8_WAIT_L(0); PG8_BAR; PG8_MMA(0, 0, At, B0); PG8_MMA(0, 1, At, B1); PG8_BAR; PG8_SCHED;
            PG8_LDA(At, 1, 1); PG8_STAGE(PG8_SB(1, 0), b3, voffB); PG8_STAGE(PG8_SB(1, 1), b3 + hstep, voffB); PG8_STAGE_A(PG8_SA(1, 0), a3, 0, last);
            PG8_WAIT_V(8); PG8_WAIT_L(0); PG8_BAR; PG8_MMA(1, 0, At, B0); PG8_MMA(1, 1, At, B1); PG8_BAR; PG8_SCHED;
            if constexpr (Epi::NSEG > 1) {
                constexpr int SEGT = F8 ? 4 : 8;
                if (t + 2 < nt && ((t + 2) & (SEGT - 1)) == 0) { if constexpr (F8) asm volatile("s_nop 15\n\ts_nop 15" ::: "memory"); E.rescale(acc, cur, (t + 2) / SEGT - 1, wr, wc, fr, fq); }
            }
            } else {
            PG8_LDB(B0, 0, 0); PG8_SCHED; PG8_LDA(At, 0, 0); PG8_STAGE(PG8_SA(1, 1), a1 + hstep, voffA);
            PG8_WAIT_L(8); PG8_BAR; PG8_WAIT_L(0); PG8_MMA(0, 0, At, B0); PG8_BAR; PG8_SCHED;
            PG8_LDB(B1, 0, 1); PG8_STAGE(PG8_SB(0, 0), b2, voffB);
            PG8_BAR; PG8_WAIT_L(0); PG8_MMA(0, 1, At, B1); PG8_BAR;
            PG8_LDA(At, 0, 1); PG8_STAGE(PG8_SA(0, 0), a2, voffA);
            PG8_BAR; PG8_WAIT_L(0); PG8_MMA(1, 0, At, B0); PG8_BAR; PG8_SCHED;
            PG8_STAGE(PG8_SB(0, 1), b2 + hstep, voffB);
            PG8_WAIT_V(6); PG8_BAR; PG8_MMA(1, 1, At, B1); PG8_BAR;
            PG8_LDB(B0, 1, 0); PG8_SCHED; PG8_LDA(At, 1, 0); PG8_STAGE(PG8_SA(0, 1), a2 + hstep, voffA);
            PG8_WAIT_L(8); PG8_BAR; PG8_WAIT_L(0); PG8_MMA(0, 0, At, B0); PG8_BAR; PG8_SCHED;
            PG8_LDB(B1, 1, 1); PG8_STAGE(PG8_SB(1, 0), b3, voffB);
            PG8_BAR; PG8_WAIT_L(0); PG8_MMA(0, 1, At, B1); PG8_BAR;
            PG8_LDA(At, 1, 1); PG8_STAGE(PG8_SA(1, 0), a3, voffA);
            PG8_BAR; PG8_WAIT_L(0); PG8_MMA(1, 0, At, B0); PG8_BAR; PG8_SCHED;
            PG8_STAGE(PG8_SB(1, 1), b3 + hstep, voffB);
            PG8_WAIT_V(6); PG8_BAR; PG8_MMA(1, 1, At, B1); PG8_BAR;
            }
        }
        if constexpr (ALIGN_EPI) { if (wr == 0) PG8_BAR; }
        if constexpr (F8) asm volatile("s_nop 15\n\ts_nop 15" ::: "memory");
        if constexpr (!Epi::AFTER_DRAIN) { E(acc, cur, wr, wc, fr, fq); S.done(cur); }
        if (!has_next) break;
#pragma unroll
        for (int a = 0; a < 2; ++a)
#pragma unroll
            for (int b = 0; b < 2; ++b)
#pragma unroll
                for (int m = 0; m < 4; ++m)
#pragma unroll
                    for (int n = 0; n < 2; ++n) acc[a][b][m][n] = (f32x4){0.f, 0.f, 0.f, 0.f};
        cur = nxt; cA = nA; cB = nB; ++ui;
        if constexpr (GATHER) { _Pragma("unroll") for (int _h = 0; _h < 2; ++_h) _Pragma("unroll") for (int _i = 0; _i < 2; ++_i) goffA[_h][_i] = goffN[_h][_i]; }
        if constexpr (ALIGN_EPI) { if (wr == 1) PG8_BAR; }
    }
    PG8_WAIT_V(0);
    if constexpr (!ALIGN_EPI) { if (wr == 0) PG8_BAR; }
    PG8_BAR;
    if constexpr (Epi::AFTER_DRAIN) { E.fused(acc, cur, wr, wc, fr, fq, lds, wid, lane); S.done(cur); }
#undef PG8_SA
#undef PG8_SB
#undef PG8_STAGE
#undef PG8_STAGE_A
#undef PG8_GOFF
#undef PG8_LDA
#undef PG8_LDB
#undef PG8_MMA
#undef PG8_WAIT_V
#undef PG8_WAIT_L
#undef PG8_BAR
#undef PG8_SCHED
}
}
#define XB_TMO      128
#define XB_XCNT(j)  (256  + 64 * (j))
#define XB_XSUB(j)  (1280 + 64 * (j))
#define XB_XGEN(j)  (2304 + 64 * (j))
#define XB_TOP      3328
#define XB_TOPGEN   3392
#define XCD_BAR_WORDS 3456
#define XB_SPIN_CAP (1u << 22)
#define LAS __attribute__((address_space(3)))

__device__ __forceinline__ unsigned xb_ld(unsigned* p)              { return __hip_atomic_load(p, __ATOMIC_RELAXED, __HIP_MEMORY_SCOPE_AGENT); }
__device__ __forceinline__ unsigned xb_add(unsigned* p, unsigned v) { asm volatile("" : "+v"(p));
    return __hip_atomic_fetch_add(p, v, __ATOMIC_RELAXED, __HIP_MEMORY_SCOPE_AGENT); }
__device__ __forceinline__ unsigned xb_xcc_id() { return (unsigned)__builtin_amdgcn_s_getreg((3 << 11) | 20) & 0xFu; }
#define XB_SPIN(cond, bar) do { unsigned _sp = 0; while (cond) { __builtin_amdgcn_s_sleep(1); \
    if ((++_sp & 255u) == 0u) { if (xb_ld(&(bar)[XB_TMO])) break; if (_sp > XB_SPIN_CAP) { xb_add(&(bar)[XB_TMO], 1u); break; } } } } while (0)

struct XcdBarrier {
    unsigned* bar; unsigned x; unsigned wv;
    volatile LAS unsigned* st;
};

__device__ __forceinline__ XcdBarrier xcd_barrier_post(unsigned* bar, volatile LAS unsigned* st) {
    XcdBarrier b; b.bar = bar; b.x = xb_xcc_id(); b.st = st;
    if (threadIdx.x == 0) (void)xb_add(&bar[XB_XCNT(b.x)], 1u);
    return b;
}
__device__ __forceinline__ void xcd_barrier_complete(unsigned* bar, unsigned x, unsigned& nloc, unsigned& nx) {
    const unsigned G = gridDim.x * gridDim.y * gridDim.z;
    unsigned sum, cnt, mine, sp = 0u;
    for (;;) {
        sum = 0u; cnt = 0u; mine = 0u;
#pragma unroll
        for (unsigned j = 0; j < 16; ++j) { const unsigned c = xb_ld(&bar[XB_XCNT(j)]); sum += c; cnt += (c > 0u) ? 1u : 0u; mine = (j == x) ? c : mine; }
        if (sum == G) break;
        __builtin_amdgcn_s_sleep(1);
        if ((++sp & 255u) == 0u) { if (xb_ld(&bar[XB_TMO])) break; if (sp > XB_SPIN_CAP) { xb_add(&bar[XB_TMO], 1u); break; } }
    }
    nloc = mine > 0u ? mine : 1u; nx = cnt > 0u ? cnt : 1u;
}

__device__ __forceinline__ void xcd_barrier(const XcdBarrier& b) {
    asm volatile("s_waitcnt vmcnt(0)" ::: "memory");
    __syncthreads();
    if (b.wv == 0u && lane_id() == 0) {
        unsigned* bar = b.bar;
        __builtin_amdgcn_s_waitcnt(0);
        unsigned nloc = b.st[0], nx = b.st[1];
        if (nloc == 0u) { xcd_barrier_complete(bar, b.x, nloc, nx); b.st[0] = nloc; b.st[1] = nx; }
        const unsigned old = xb_add(&bar[XB_XSUB(b.x)], 1u);
        const unsigned gen = old / nloc;
        if (old + 1u == (gen + 1u) * nloc) {
            __builtin_amdgcn_fence(__ATOMIC_RELEASE, "agent");
            asm volatile("s_waitcnt vmcnt(0)" ::: "memory");
            const unsigned og = xb_add(&bar[XB_TOP], 1u);
            const unsigned tg = og / nx;
            if (og + 1u == (tg + 1u) * nx) xb_add(&bar[XB_TOPGEN], 1u);
            else XB_SPIN(xb_ld(&bar[XB_TOPGEN]) == tg, bar);
            __builtin_amdgcn_fence(__ATOMIC_ACQUIRE, "agent");
            xb_add(&bar[XB_XGEN(b.x)], 1u);
            asm volatile("s_waitcnt vmcnt(0)" ::: "memory");
        } else {
            XB_SPIN(xb_ld(&bar[XB_XGEN(b.x)]) == gen, bar);
            __builtin_amdgcn_fence(__ATOMIC_ACQUIRE, "agent");
            asm volatile("s_waitcnt vmcnt(0)" ::: "memory");
        }
    }
    __syncthreads();
}

typedef unsigned short bf16_t;
typedef short bf16x8 __attribute__((ext_vector_type(8)));
typedef float f32x4 __attribute__((ext_vector_type(4)));
typedef float f32x16 __attribute__((ext_vector_type(16)));
typedef unsigned u32x4 __attribute__((ext_vector_type(4)));
typedef unsigned u32x2 __attribute__((ext_vector_type(2)));

constexpr int D = 1024, NB = 16, SEQ = 2048, CTX = 256, NL = 4;
constexpr int TL = NB * SEQ, TC = NB * CTX, TT = TL + TC;
constexpr int DIN = 6144, HYW = 512, NE = 16, DE = 512, KEYS = CTX + SEQ;
constexpr int NMOD = 6, NBM = NB + 1;
constexpr int APROWS = 2 * TT + NE * 256;
constexpr float EPS = 1e-6f, LOG2E = 1.4426950408889634f;
constexpr float QSCALE = 0.125f * LOG2E;

constexpr size_t MiB = 1u << 20;
constexpr size_t WS_CTL = 0, CTL_ZERO_BYTES = 1 * MiB;
constexpr size_t WS_MOD = 1 * MiB;
constexpr size_t WS_ROPE = 3 * MiB;
constexpr size_t WS_FL = 4 * MiB, WS_FC = 20 * MiB;
constexpr size_t WS_MISC = 22 * MiB;
constexpr size_t WS_FNORM = WS_MISC;
constexpr size_t WS_TOKE = WS_MISC + 64 * 1024, WS_TOKP = WS_MISC + 352 * 1024, WS_TOKW = WS_MISC + 640 * 1024;
constexpr size_t WS_ROWMAP = WS_MISC + 960 * 1024, WS_ROWW = WS_MISC + 1280 * 1024;
constexpr size_t WS_WIN = 24 * MiB, WS_WBR = 36 * MiB, WS_WOUT = 39 * MiB;
constexpr size_t WS_XC = 41 * MiB;
constexpr size_t WS_NP = WS_XC;
constexpr size_t WS_H = 57 * MiB;
constexpr size_t WS_KA = 129 * MiB, WS_VTA = 138 * MiB, WS_KW = 147 * MiB, WS_VTW = 156 * MiB;
constexpr size_t WS_QA = 165 * MiB, WS_QW = 201 * MiB, WS_YH = 237 * MiB, WS_VT = 273 * MiB, WS_YT = 309 * MiB;
constexpr size_t WS_RAWA = 309 * MiB, WS_RAWW = 327 * MiB;
constexpr size_t WS_F = 165 * MiB;
constexpr size_t WS_U = 345 * MiB;
constexpr size_t WS_G = 453 * MiB;
constexpr size_t WS_Y8 = 561 * MiB;
constexpr size_t WS_W13 = 621 * MiB, WS_W2 = 637 * MiB;
constexpr size_t WS_EROW = 669 * MiB, WS_EROWW = 672 * MiB;
constexpr size_t WS_H8 = 675 * MiB;
constexpr size_t WS_WG8 = WS_WIN;
constexpr size_t WS_END = 711 * MiB;
static_assert(WS_G + (size_t)TT * 3072 <= WS_Y8 && WS_Y8 + (size_t)TT * 1536 <= WS_W13 && WS_W13 + (size_t)16 * 1024 * 1024 <= WS_W2 && WS_W2 + (size_t)16 * 1024 * 512 <= WS_EROW, "ws map");
static_assert(WS_U + (size_t)APROWS * 1024 <= WS_G && WS_F + (size_t)2 * TT * 2048 <= WS_YT, "ws map 2");
constexpr size_t VT_CTX_OFF = (size_t)HYW * NB * SEQ;

constexpr int CW_BAR = 4096, CW_CNT = 8192, CW_PANEL = 16384, CW_HTMO = 12288;
constexpr int LDS_BYTES = 151552, MISC_OFF = 147456;
constexpr int NWAVES = 8, NTHR = 512;

struct Args { const float* in[29]; float* out; unsigned char* ws; int ph_lo, ph_hi; };
enum { I_X = 0, I_C, I_CTX, I_CCTX, I_ADAW, I_ADAB, I_N1G, I_N2G, I_WIN, I_QKG, I_HSW, I_HSB, I_HW1, I_HB1, I_HFR, I_HW2, I_HB2, I_HW3, I_HBIAS, I_SINK, I_WBR, I_WOUT,
       I_RGW, I_RGB, I_REW, I_REB, I_EW1, I_EW3, I_EW2 };

#define LDS_WAIT() asm volatile("s_waitcnt lgkmcnt(0)" ::: "memory")
#define VM_WAIT() asm volatile("s_waitcnt vmcnt(0)" ::: "memory")

typedef float f32x2_t __attribute__((ext_vector_type(2)));
typedef __bf16 bf16x2_t __attribute__((ext_vector_type(2)));
__device__ __forceinline__ unsigned cvtpk(float lo, float hi) { f32x2_t v = {lo, hi}; bf16x2_t b = __builtin_convertvector(v, bf16x2_t); return __builtin_bit_cast(unsigned, b); }
__device__ __forceinline__ unsigned zero_u32() { unsigned z; asm volatile("v_mov_b32 %0, 0" : "=v"(z)); return z; }
__device__ __forceinline__ float clamp_fp8(float x) { return __builtin_amdgcn_fmed3f(x, -448.f, 448.f); }
__device__ __forceinline__ unsigned cvt4_fp8(float a, float b, float c, float d) { int r = __builtin_amdgcn_cvt_pk_fp8_f32(a, b, 0, false); r = __builtin_amdgcn_cvt_pk_fp8_f32(c, d, r, true); return (unsigned)r; }
__device__ __forceinline__ unsigned cvt4_fp8c(float a, float b, float c, float d) { return cvt4_fp8(clamp_fp8(a), clamp_fp8(b), clamp_fp8(c), clamp_fp8(d)); }
__device__ __forceinline__ float bflo(unsigned u) { return __builtin_bit_cast(float, u << 16); }
__device__ __forceinline__ float bfhi(unsigned u) { return __builtin_bit_cast(float, u & 0xffff0000u); }
__device__ __forceinline__ float bf1(bf16_t u) { return __builtin_bit_cast(float, (unsigned)u << 16); }
__device__ __forceinline__ bf16_t f2bf(float f) { return (bf16_t)(cvtpk(f, 0.f) & 0xffffu); }
#define DPP_F(v, ctrl) __builtin_bit_cast(float, __builtin_amdgcn_update_dpp(0, __builtin_bit_cast(int, (v)), (ctrl), 0xf, 0xf, false))
__device__ __forceinline__ float row16_sum(float v) {
    v += DPP_F(v, 0xB1);
    v += DPP_F(v, 0x4E);
    v += DPP_F(v, 0x141);
    v += DPP_F(v, 0x140);
    return v;
}
__device__ __forceinline__ float wave_sum(float v) {
    v = row16_sum(v);
    const int iv = __builtin_bit_cast(int, v);
    float r = (__builtin_bit_cast(float, __builtin_amdgcn_readlane(iv, 0)) + __builtin_bit_cast(float, __builtin_amdgcn_readlane(iv, 16)))
            + (__builtin_bit_cast(float, __builtin_amdgcn_readlane(iv, 32)) + __builtin_bit_cast(float, __builtin_amdgcn_readlane(iv, 48)));
    asm volatile("" : "+v"(r));
    return r;
}
__device__ __forceinline__ float fast_exp2(float x) { return __builtin_amdgcn_exp2f(x); }
__device__ __forceinline__ float fast_rcp(float x) { return __builtin_amdgcn_rcpf(x); }
__device__ __forceinline__ float sigmoid_f(float x) { return fast_rcp(1.f + fast_exp2(-x * LOG2E)); }

__device__ __forceinline__ void sincos_acc(float x, float& s, float& c) {
    const float q = rintf(x * 0.636619772367581f);
    float y = fmaf(-q, 1.57079625129699707031f, x);
    y = fmaf(-q, 7.54978941586159635335e-08f, y);
    const float y2 = y * y;
    float sp = fmaf(y2, 2.7557314297e-06f, -1.9841270114e-04f); sp = fmaf(sp, y2, 8.3333337680e-03f); sp = fmaf(sp, y2, -1.6666667163e-01f); sp = fmaf(sp * y2, y, y);
    float cp = fmaf(y2, -2.7557314297e-07f, 2.4801587642e-05f); cp = fmaf(cp, y2, -1.3888889225e-03f); cp = fmaf(cp, y2, 4.1666667908e-02f); cp = fmaf(cp, y2, -0.5f); cp = fmaf(cp, y2, 1.0f);
    const int n = (int)q & 3;
    const float s1 = (n & 1) ? cp : sp, c1 = (n & 1) ? sp : cp;
    s = (n & 2) ? -s1 : s1;
    c = ((n + 1) & 2) ? -c1 : c1;
}

struct Fr { LAS unsigned char* lds; int tid, lane, wave, G, bid; };

__device__ __forceinline__ void pro_mod(const Fr& F, const Args& a) {
    LAS float* s = (LAS float*)F.lds;
    LAS float* red = (LAS float*)(F.lds + 69632);
    const float* c = a.in[I_C]; const float* cc = a.in[I_CCTX]; const float* W = a.in[I_ADAW]; const float* Bv = a.in[I_ADAB];
    float* MOD = (float*)(a.ws + WS_MOD);
    for (int i = F.tid; i < NBM * 1024; i += NTHR) { const int bb = i >> 10, k = i & 1023; const float v = (bb < NB) ? c[bb * 1024 + k] : cc[k]; s[i] = v / (1.f + __expf(-v)); }
    __syncthreads();
    const int col = F.tid & 63, ks = F.wave;
    for (int unit = F.G - 1 - F.bid; unit < NL * 96; unit += F.G) {
        const int l = unit / 96, j0 = (unit % 96) * 64;
        float acc[NBM];
#pragma unroll
        for (int bb = 0; bb < NBM; ++bb) acc[bb] = 0.f;
        const float* Wp = W + ((size_t)l * 1024 + ks * 128) * DIN + j0 + col;
#pragma unroll 2
        for (int k = 0; k < 128; k += 4) {
            const float w0 = Wp[(size_t)k * DIN], w1 = Wp[(size_t)(k + 1) * DIN], w2 = Wp[(size_t)(k + 2) * DIN], w3 = Wp[(size_t)(k + 3) * DIN];
#pragma unroll
            for (int bb = 0; bb < NBM; ++bb) { const f32x4 sv = *(const LAS f32x4*)(s + bb * 1024 + ks * 128 + k);
                acc[bb] = fmaf(sv.x, w0, acc[bb]); acc[bb] = fmaf(sv.y, w1, acc[bb]); acc[bb] = fmaf(sv.z, w2, acc[bb]); acc[bb] = fmaf(sv.w, w3, acc[bb]); } }
#pragma unroll
        for (int bb = 0; bb < NBM; ++bb) red[(ks * NBM + bb) * 64 + col] = acc[bb];
        __syncthreads();
        for (int o = F.tid; o < NBM * 64; o += NTHR) { const int bb = o >> 6, cx = o & 63; float sum = 0.f;
#pragma unroll
            for (int k2 = 0; k2 < 8; ++k2) sum += red[(k2 * NBM + bb) * 64 + cx];
            MOD[((size_t)l * NBM + bb) * DIN + j0 + cx] = sum + Bv[l * DIN + j0 + cx]; }
        __syncthreads();
    }
}

__device__ __forceinline__ void pro_rope(const Fr& F, const Args& a) {
    float* ct = (float*)(a.ws + WS_ROPE); float* st = ct + SEQ * 32;
    for (int i = F.bid * NTHR + F.tid; i < SEQ * 32; i += F.G * NTHR) {
        const int pos = i >> 5, ax = (i >> 4) & 1, f = i & 15;
        const float inv = exp2f(-(float)f * (13.287712379549449f / 16.f));
        const float ang = (float)(ax == 0 ? (pos >> 6) : (pos & 63)) * inv;
        float sv, cv; sincos_acc(ang, sv, cv); ct[i] = cv; st[i] = sv;
    }
}

__device__ __forceinline__ void pro_filter(const Fr& F, const Args& a) {
    LAS float* L = (LAS float*)F.lds;
    constexpr int oW1 = 0, oB1 = 2112, oFR = 2176, oB2 = 2240, oW2 = 2304, oZ = 6400, oH1 = 7552, oH2 = 9600, oW3 = 11648, oT = 19840;
    bf16_t* FL = (bf16_t*)(a.ws + WS_FL); bf16_t* FC = (bf16_t*)(a.ws + WS_FC); float* NP = (float*)(a.ws + WS_NP);
    const int p = F.tid >> 4, jj = F.tid & 15;
    for (int unit = F.bid; unit < NL * 72; unit += F.G) {
        const int l = unit / 72, ch = unit % 72; const bool lat = ch < 64; const int n = lat ? SEQ : CTX, pos0 = lat ? ch * 32 : (ch - 64) * 32;
        __syncthreads();
        for (int i = F.tid; i < 2112; i += NTHR) L[oW1 + i] = a.in[I_HW1][l * 2112 + i];
        for (int i = F.tid; i < 64; i += NTHR) { L[oB1 + i] = a.in[I_HB1][l * 64 + i]; L[oFR + i] = a.in[I_HFR][l * 64 + i]; L[oB2 + i] = a.in[I_HB2][l * 64 + i]; }
        for (int i = F.tid; i < 4096; i += NTHR) L[oW2 + i] = a.in[I_HW2][l * 4096 + i];
        const int pos = pos0 + p; const float t = (float)pos / (float)(n - 1);
        { const float band = 1e-4f + (float)jj * ((15.f - 1e-4f) / 15.f); const float ang = ((6.2831855f * band) * (float)pos) / (float)n;
          float sv, cv; sincos_acc(ang, sv, cv); L[oZ + p * 36 + 1 + jj] = cv; L[oZ + p * 36 + 17 + jj] = -sv; if (jj == 0) L[oZ + p * 36] = t; }
        __syncthreads();
        { f32x4 acc = *(const LAS f32x4*)(L + oB1 + 4 * jj);
#pragma unroll 3
          for (int i = 0; i < 33; ++i) { const float z = L[oZ + p * 36 + i]; const f32x4 w = *(const LAS f32x4*)(L + oW1 + i * 64 + 4 * jj); acc.x = fmaf(z, w.x, acc.x); acc.y = fmaf(z, w.y, acc.y); acc.z = fmaf(z, w.z, acc.z); acc.w = fmaf(z, w.w, acc.w); }
          const f32x4 fr = *(const LAS f32x4*)(L + oFR + 4 * jj); float sv, cv; f32x4 o;
          sincos_acc(fr.x * acc.x, sv, cv); o.x = sv; sincos_acc(fr.y * acc.y, sv, cv); o.y = sv; sincos_acc(fr.z * acc.z, sv, cv); o.z = sv; sincos_acc(fr.w * acc.w, sv, cv); o.w = sv;
          *(LAS f32x4*)(L + oH1 + p * 64 + 4 * jj) = o; }
        __syncthreads();
        { f32x4 acc = *(const LAS f32x4*)(L + oB2 + 4 * jj);
#pragma unroll 4
          for (int i = 0; i < 64; ++i) { const float z = L[oH1 + p * 64 + i]; const f32x4 w = *(const LAS f32x4*)(L + oW2 + i * 64 + 4 * jj); acc.x = fmaf(z, w.x, acc.x); acc.y = fmaf(z, w.y, acc.y); acc.z = fmaf(z, w.z, acc.z); acc.w = fmaf(z, w.w, acc.w); }
          const f32x4 fr = *(const LAS f32x4*)(L + oFR + 4 * jj); float sv, cv; f32x4 o;
          sincos_acc(fr.x * acc.x, sv, cv); o.x = sv; sincos_acc(fr.y * acc.y, sv, cv); o.y = sv; sincos_acc(fr.z * acc.z, sv, cv); o.z = sv; sincos_acc(fr.w * acc.w, sv, cv); o.w = sv;
          *(LAS f32x4*)(L + oH2 + p * 64 + 4 * jj) = o; }
        LAS bf16_t* T = (LAS bf16_t*)(L + oT);
#pragma unroll 1
        for (int mh = 0; mh < 1; ++mh) {
            f32x4 acc[16];
#pragma unroll
            for (int m = 0; m < 16; ++m) acc[m] = (f32x4){0.f, 0.f, 0.f, 0.f};
#pragma unroll 1
            for (int kc = 0; kc < 8; ++kc) {
                __syncthreads();
                for (int i = F.tid; i < 2048; i += NTHR) *(LAS f32x4*)(L + oW3 + i * 4) = *(const f32x4*)(a.in[I_HW3] + ((size_t)l * 64 + kc * 8) * 1024 + i * 4);
                __syncthreads();
#pragma unroll 1
                for (int k = 0; k < 8; ++k) { const float h = L[oH2 + p * 64 + kc * 8 + k];
#pragma unroll
                    for (int m = 0; m < 16; ++m) { const f32x4 w = *(const LAS f32x4*)(L + oW3 + k * 1024 + 64 * m + 4 * jj);
                        acc[m].x = fmaf(h, w.x, acc[m].x); acc[m].y = fmaf(h, w.y, acc[m].y); acc[m].z = fmaf(h, w.z, acc[m].z); acc[m].w = fmaf(h, w.w, acc[m].w); } }
            }
#pragma unroll
            for (int m = 0; m < 16; ++m) {
                const int colb = 64 * m + 4 * jj; const int dirb = m >> 3;
                const float v4[4] = {acc[m].x, acc[m].y, acc[m].z, acc[m].w};
#pragma unroll
                for (int e = 0; e < 4; ++e) { const int col = colb + e, c = col & 511;
                    const float dl = fabsf(-3.0701134573253943f + (-15.350567286626972f + 3.0701134573253943f) * ((float)c / 511.f));
                    float v = v4[e] * __expf(-t * dl); if (dirb == 1 && pos == 0) v = 0.f;
                    T[col * 32 + (dirb == 0 ? 31 - p : p)] = f2bf(v); }
            }
        }
        __syncthreads();
        for (int idx = F.tid; idx < 1024 * 32; idx += NTHR) { const int col = idx >> 5, i = idx & 31, dir = col >> 9, c = col & 511;
            const int u = (dir == 0) ? (n - 32 - pos0 + i) : ((pos0 + i == 0) ? 2 * n - 1 : n - 1 + pos0 + i);
            bf16_t* Fb = lat ? FL + ((size_t)l * 512 + c) * 4096 : FC + ((size_t)l * 512 + c) * 512;
            Fb[u] = T[col * 32 + i]; }
        for (int col = F.tid; col < 1024; col += NTHR) { float sum = 0.f;
#pragma unroll 8
            for (int i = 0; i < 32; ++i) sum += fabsf(bf1(T[col * 32 + i]));
            NP[((size_t)l * 72 + ch) * 1024 + col] = sum; }
    }
    __syncthreads();
}
__device__ __forceinline__ void filter_norm_reduce(const Fr& F, const Args& a) {
    const float* NP = (const float*)(a.ws + WS_NP); float* FN = (float*)(a.ws + WS_FNORM);
    for (int o = F.bid * NTHR + F.tid; o < NL * 2 * 512; o += F.G * NTHR) { const int l = o >> 10, isc = (o >> 9) & 1, c = o & 511;
        const int ch0 = isc ? 64 : 0, ch1 = isc ? 72 : 64; float sum = 0.f;
        for (int ch = ch0; ch < ch1; ++ch) sum += NP[((size_t)l * 72 + ch) * 1024 + c] + NP[((size_t)l * 72 + ch) * 1024 + 512 + c];
        FN[o] = 1.f / sum; }
}

template <int MODE>
__device__ __forceinline__ void transpose_item(const float* W, int K, int N, bf16_t* WT, int row_off, LAS float* scr, int item, int lane, int ldk = 0) {
    if (ldk == 0) ldk = K;
    const int nblk = N / 64, kb = item / nblk, nb = item % nblk, k0 = 64 * kb, n0 = 64 * nb;
    f32x4 v[16];
#pragma unroll
    for (int i = 0; i < 16; ++i) v[i] = *(const f32x4*)(W + (size_t)(k0 + 4 * i + (lane >> 4)) * N + n0 + (lane & 15) * 4);
#pragma unroll
    for (int i = 0; i < 16; ++i) *(LAS f32x4*)(scr + (4 * i + (lane >> 4)) * 68 + (lane & 15) * 4) = v[i];
    LDS_WAIT();
    const int c = lane & 7;
#pragma unroll
    for (int j = 0; j < 8; ++j) { const int n = (lane >> 3) + 8 * j; const LAS float* s = scr + (8 * c) * 68 + n;
        u32x4 o; o.x = cvtpk(s[0 * 68], s[1 * 68]); o.y = cvtpk(s[2 * 68], s[3 * 68]); o.z = cvtpk(s[4 * 68], s[5 * 68]); o.w = cvtpk(s[6 * 68], s[7 * 68]);
        const int nn = n0 + n; const int row = (MODE == 0) ? nn : ((nn >> 2) * 8 + (nn & 3) + (MODE == 2 ? 4 : 0));
        *(u32x4*)(WT + (size_t)(row_off + row) * ldk + k0 + 8 * c) = o; }
    LDS_WAIT();
}

template <int MODE>
__device__ __forceinline__ void transpose_item_f8(const float* W, int K, int N, unsigned char* WT, int row_off, LAS float* scr, int item, int lane, int ldk = 0) {
    if (ldk == 0) ldk = K;
    const int nblk = N / 64, kb = item / nblk, nb = item % nblk, k0 = 64 * kb, n0 = 64 * nb;
    f32x4 v[16];
#pragma unroll
    for (int i = 0; i < 16; ++i) v[i] = *(const f32x4*)(W + (size_t)(k0 + 4 * i + (lane >> 4)) * N + n0 + (lane & 15) * 4);
#pragma unroll
    for (int i = 0; i < 16; ++i) *(LAS f32x4*)(scr + (4 * i + (lane >> 4)) * 68 + (lane & 15) * 4) = v[i];
    LDS_WAIT();
    const int c = lane & 7;
#pragma unroll
    for (int j = 0; j < 8; ++j) { const int n = (lane >> 3) + 8 * j; const LAS float* s = scr + (8 * c) * 68 + n;
        u32x2 o; o.x = cvt4_fp8(s[0 * 68] * 64.f, s[1 * 68] * 64.f, s[2 * 68] * 64.f, s[3 * 68] * 64.f); o.y = cvt4_fp8(s[4 * 68] * 64.f, s[5 * 68] * 64.f, s[6 * 68] * 64.f, s[7 * 68] * 64.f);
        const int nn = n0 + n; const int row = (MODE == 0) ? nn : ((nn >> 2) * 8 + (nn & 3) + (MODE == 2 ? 4 : 0));
        *(u32x2*)(WT + (size_t)(row_off + row) * ldk + k0 + 8 * c) = o; }
    LDS_WAIT();
}
__device__ __forceinline__ void conv_small_weights(const Fr& F, const Args& a, int l, int mask, int b0) {
    if (F.bid < b0) return;
    LAS float* scr = (LAS float*)(F.lds + F.wave * 17408);
    const int gw = (F.bid - b0) * NWAVES + F.wave, NGW = (F.G - b0) * NWAVES;
    constexpr int I_IN = (1024 / 64) * (DIN / 64), I_BR = (512 / 64) * (1024 / 64), I_OUT = (1024 / 64) * (1024 / 64);
    if (mask & 1) for (int it = gw; it < I_IN; it += NGW) transpose_item_f8<0>(a.in[I_WIN] + (size_t)l * 1024 * DIN, 1024, DIN, a.ws + WS_WG8, 0, scr, it, F.lane);
    if (mask & 2) for (int it = gw; it < 3 * I_BR; it += NGW) { const int b = it / I_BR; transpose_item_f8<0>(a.in[I_WBR] + ((size_t)l * 3 + b) * 512 * 1024, 512, 1024, a.ws + WS_WBR + b * 512, 0, scr, it % I_BR, F.lane, 1536); }
    if (mask & 4) for (int it = gw; it < I_OUT; it += NGW) transpose_item_f8<0>(a.in[I_WOUT] + (size_t)l * 1024 * 1024, 1024, 1024, a.ws + WS_WOUT, 0, scr, it, F.lane);
}
__device__ __forceinline__ void conv_expert_weights(const Fr& F, const Args& a, int l, int b0, int it0, int it1) {
    if (F.bid < b0) return;
    LAS float* scr = (LAS float*)(F.lds + F.wave * 17408);
    const int gw = (F.bid - b0) * NWAVES + F.wave, NGW = (F.G - b0) * NWAVES;
    constexpr int I_1 = (1024 / 64) * (512 / 64), I_2 = (512 / 64) * (1024 / 64);
    for (int it = it0 + gw; it < it1; it += NGW) {
        const int e = it / (2 * I_1 + I_2); int r = it % (2 * I_1 + I_2);
        unsigned char* W13 = a.ws + WS_W13; unsigned char* W2 = a.ws + WS_W2;
        if (r < I_1) { transpose_item_f8<1>(a.in[I_EW1] + ((size_t)l * NE + e) * 1024 * 512, 1024, 512, W13, e * 1024, scr, r, F.lane); continue; } r -= I_1;
        if (r < I_1) { transpose_item_f8<2>(a.in[I_EW3] + ((size_t)l * NE + e) * 1024 * 512, 1024, 512, W13, e * 1024, scr, r, F.lane); continue; } r -= I_1;
        transpose_item_f8<0>(a.in[I_EW2] + ((size_t)l * NE + e) * 512 * 1024, 512, 1024, W2, e * 1024, scr, r, F.lane);
    }
}
constexpr int CONV_E_ITEMS = NE * 384, CONV_E_SPLIT = CONV_E_ITEMS / 2;

__device__ __forceinline__ int mod_row(int row) { return row < TL ? (row >> 11) : NB; }

__device__ __forceinline__ void rows_p0(const Fr& F, const Args& a, int l, int nrows) {
    const int gw = F.bid * NWAVES + F.wave, NGW = F.G * NWAVES;
    const float* g1 = a.in[I_N1G] + l * 1024;
    const float* MODl = (const float*)(a.ws + WS_MOD) + (size_t)l * NBM * DIN;
    const float* MODp = (const float*)(a.ws + WS_MOD) + (size_t)(l > 0 ? l - 1 : 0) * NBM * DIN;
    const bf16_t* Fs = (const bf16_t*)(a.ws + WS_F);
    unsigned char* H8 = a.ws + WS_H8;
    const int per = 2 * ((nrows + 2 * NGW - 1) / (2 * NGW)), w0 = gw * per, w1 = (w0 + per < nrows) ? w0 + per : nrows;
    f32x4 gv[4], shv[4], scv[4], m5v[4]; int cur = -1;
#pragma unroll
    for (int j = 0; j < 4; ++j) { gv[j] = *(const f32x4*)(g1 + F.lane * 4 + 256 * j); shv[j] = gv[j]; scv[j] = gv[j]; m5v[j] = gv[j]; }
#define P0_LOAD(rb, V, F0, F1) do { _Pragma("unroll") for (int q = 0; q < 2; ++q) { const int row = (rb) + q; const bool lat = row < TL; \
            const float* xs = lat ? ((l == 0) ? a.in[I_X] + (size_t)row * D : a.out + (size_t)row * D) : ((l == 0) ? a.in[I_CTX] + (size_t)(row - TL) * D : (const float*)(a.ws + WS_XC) + (size_t)(row - TL) * D); \
            _Pragma("unroll") for (int j = 0; j < 4; ++j) { const int col = F.lane * 4 + 256 * j; V[q][j] = *(const f32x4*)(xs + col); \
                if (l > 0) { F0[q][j] = *(const u32x2*)(Fs + (size_t)row * D + col); F1[q][j] = *(const u32x2*)(Fs + ((size_t)TT + row) * D + col); } } } } while (0)
#define P0_PROC(rb, V, F0, F1) do { _Pragma("unroll") for (int q = 0; q < 2; ++q) { const int row = (rb) + q; const bool lat = row < TL; const int mr = mod_row(row); \
            if (mr != cur) { cur = mr; _Pragma("unroll") for (int j = 0; j < 4; ++j) { const int col = F.lane * 4 + 256 * j; \
                shv[j] = *(const f32x4*)(MODl + (size_t)mr * DIN + col); scv[j] = *(const f32x4*)(MODl + (size_t)mr * DIN + 1024 + col); m5v[j] = *(const f32x4*)(MODp + (size_t)mr * DIN + 5 * 1024 + col); } } \
            float* xd = lat ? a.out + (size_t)row * D : (float*)(a.ws + WS_XC) + (size_t)(row - TL) * D; float ss = 0.f; \
            if (l > 0) { _Pragma("unroll") for (int j = 0; j < 4; ++j) { const int col = F.lane * 4 + 256 * j; \
                    V[q][j].x += m5v[j].x * (bflo(F0[q][j].x) + bflo(F1[q][j].x)); V[q][j].y += m5v[j].y * (bfhi(F0[q][j].x) + bfhi(F1[q][j].x)); \
                    V[q][j].z += m5v[j].z * (bflo(F0[q][j].y) + bflo(F1[q][j].y)); V[q][j].w += m5v[j].w * (bfhi(F0[q][j].y) + bfhi(F1[q][j].y)); \
                    *(f32x4*)(xd + col) = V[q][j]; } } \
            _Pragma("unroll") for (int j = 0; j < 4; ++j) ss += (V[q][j].x * V[q][j].x + V[q][j].y * V[q][j].y) + (V[q][j].z * V[q][j].z + V[q][j].w * V[q][j].w); \
            const float r = 1.f / sqrtf(wave_sum(ss) * (1.f / D) + EPS); \
            _Pragma("unroll") for (int j = 0; j < 4; ++j) { const int col = F.lane * 4 + 256 * j; \
                const f32x4 o = (V[q][j] * r * gv[j]) * (scv[j] + 1.f) + shv[j]; \
                *(unsigned*)(H8 + (size_t)row * D + col) = cvt4_fp8(o.x, o.y, o.z, o.w); } } } while (0)
    f32x4 vA[2][4], vB[2][4]; u32x2 fA0[2][4], fA1[2][4], fB0[2][4], fB1[2][4];
    if (w0 < w1) P0_LOAD(w0, vA, fA0, fA1);
    for (int rb = w0; rb < w1; rb += 4) {
        if (rb + 2 < w1) P0_LOAD(rb + 2, vB, fB0, fB1);
        P0_PROC(rb, vA, fA0, fA1);
        if (rb + 2 < w1) { if (rb + 4 < w1) P0_LOAD(rb + 4, vA, fA0, fA1); P0_PROC(rb + 2, vB, fB0, fB1); }
    }
#undef P0_LOAD
#undef P0_PROC
}
__device__ __forceinline__ void rows_final(const Fr& F, const Args& a) {
    const int gw = F.bid * NWAVES + F.wave, NGW = F.G * NWAVES;
    const float* MODp = (const float*)(a.ws + WS_MOD) + (size_t)(NL - 1) * NBM * DIN;
    const bf16_t* Fs = (const bf16_t*)(a.ws + WS_F);
    for (int row = gw; row < TL; row += NGW) {
        const int mr = row >> 11; float* xd = a.out + (size_t)row * D;
#pragma unroll
        for (int j = 0; j < 4; ++j) { const int col = F.lane * 4 + 256 * j;
            f32x4 v = *(const f32x4*)(xd + col);
            const u32x2 f0 = *(const u32x2*)(Fs + (size_t)row * D + col), f1 = *(const u32x2*)(Fs + ((size_t)TT + row) * D + col);
            const f32x4 m5 = *(const f32x4*)(MODp + (size_t)mr * DIN + 5 * 1024 + col);
            v.x += m5.x * (bflo(f0.x) + bflo(f1.x)); v.y += m5.y * (bfhi(f0.x) + bfhi(f1.x)); v.z += m5.z * (bflo(f0.y) + bflo(f1.y)); v.w += m5.w * (bfhi(f0.y) + bfhi(f1.y));
            *(f32x4*)(xd + col) = v; }
    }
}

__device__ __forceinline__ void rows_p5(const Fr& F, const Args& a, int l, int nrows, unsigned long long& sacc, const int swhich) {
#if defined(PROBE_P)
    unsigned long long st0 = __builtin_amdgcn_s_memrealtime();
#define SUBMARK5(w) do { const unsigned long long t_ = __builtin_amdgcn_s_memrealtime(); if (swhich == (w)) sacc += t_ - st0; st0 = t_; } while (0)
#else
#define SUBMARK5(w) do { } while (0)
#endif
    typedef float f32x4v __attribute__((ext_vector_type(4)));
    LAS float* RW = (LAS float*)F.lds;
    constexpr int RWS = 1028;
    LAS float* RB = (LAS float*)(F.lds + 82304);
    LAS int* LC = (LAS int*)(F.lds + 82432);
    LAS int* TE = (LAS int*)(F.lds + 82560);
    LAS int* TP = TE + 256;
    LAS float* TW = (LAS float*)(TP + 256);
    LAS float* RN = (LAS float*)(F.lds + 86784);
    LAS float* LG = (LAS float*)(F.lds + 87424);
    LAS float* GM = (LAS float*)(F.lds + 99072);
    LAS float* BI = (LAS float*)(F.lds + 107264);
    const float* g2 = a.in[I_N2G] + l * 1024;
    const float* MODl = (const float*)(a.ws + WS_MOD) + (size_t)l * NBM * DIN;
    unsigned char* H8 = a.ws + WS_H;
    int* EROW = (int*)(a.ws + WS_EROW); float* EROWW = (float*)(a.ws + WS_EROWW);
    unsigned* CNT = (unsigned*)(a.ws + WS_CTL) + CW_CNT + l * 256;
    for (int f = F.tid; f < 1024; f += NTHR) { const f32x4 v = *(const f32x4*)(a.in[I_RGW] + ((size_t)l * 1024 + f) * 4);
        RW[0 * RWS + f] = v.x; RW[1 * RWS + f] = v.y; RW[2 * RWS + f] = v.z; RW[3 * RWS + f] = v.w; }
    for (int f = F.tid; f < 4096; f += NTHR) { const int k = f >> 2, c4 = (f & 3) * 4; const f32x4 v = *(const f32x4*)(a.in[I_REW] + ((size_t)l * 1024 + k) * 16 + c4);
        RW[(4 + c4) * RWS + k] = v.x; RW[(5 + c4) * RWS + k] = v.y; RW[(6 + c4) * RWS + k] = v.z; RW[(7 + c4) * RWS + k] = v.w; }
    if (F.tid < 20) RB[F.tid] = (F.tid < 4) ? a.in[I_RGB][l * 4 + F.tid] : a.in[I_REB][l * 16 + F.tid - 4];
    constexpr int P5_CH = 144;
    const int nch = (nrows + P5_CH - 1) / P5_CH;
    SUBMARK5(40);
    for (int ch = F.bid; ch < nch; ch += F.G) {
    const int r0 = ch * P5_CH, r1 = (r0 + P5_CH < nrows) ? r0 + P5_CH : nrows;
    const int mb0 = mod_row(r0), mb1 = mod_row(r1 - 1);
    if (F.tid < 32) LC[F.tid] = 0;
    for (int i = F.tid; i < 2048; i += NTHR) { const int s = i >> 10, k = i & 1023; GM[i] = g2[k] * (1.f + MODl[(size_t)(s ? mb1 : mb0) * DIN + 4 * 1024 + k]); }
    __syncthreads();
    if (F.wave < 4) {
    for (int rowb = r0 + 2 * F.wave; rowb < r1; rowb += 2 * 4) {
        f32x4 v[2][4]; bool val[2];
#pragma unroll
        for (int q = 0; q < 2; ++q) { const int row = rowb + q; val[q] = row < r1; const int rr = val[q] ? row : rowb;
            const bool lat = rr < TL; const float* xs = lat ? a.out + (size_t)rr * D : (const float*)(a.ws + WS_XC) + (size_t)(rr - TL) * D;
#pragma unroll
            for (int j = 0; j < 4; ++j) v[q][j] = *(const f32x4*)(xs + F.lane * 4 + 256 * j); }
#pragma unroll
        for (int q = 0; q < 2; ++q) { const int rr = val[q] ? rowb + q : rowb; const int mr = mod_row(rr); float ss = 0.f;
#pragma unroll
            for (int j = 0; j < 4; ++j) ss += (v[q][j].x * v[q][j].x + v[q][j].y * v[q][j].y) + (v[q][j].z * v[q][j].z + v[q][j].w * v[q][j].w);
            const float r = 1.f / sqrtf(wave_sum(ss) * (1.f / D) + EPS);
            if (F.lane == 0 && val[q]) RN[rr - r0] = r;
#pragma unroll
            for (int j = 0; j < 4; ++j) { const int col = F.lane * 4 + 256 * j;
                const f32x4 g = *(const f32x4*)(g2 + col), sh = *(const f32x4*)(MODl + (size_t)mr * DIN + 3 * 1024 + col), sc = *(const f32x4*)(MODl + (size_t)mr * DIN + 4 * 1024 + col);
                const f32x4 t = (v[q][j] * r * g) * (sc + 1.f) + sh;
                if (val[q]) *(unsigned*)(H8 + (size_t)rr * D + col) = cvt4_fp8(t.x, t.y, t.z, t.w); } }
    }
    } else {
    if (F.wave < 6) { const int sl = F.wave - 4; const int mb = sl ? mb1 : mb0; f32x4 sh[4];
#pragma unroll
        for (int j = 0; j < 4; ++j) sh[j] = *(const f32x4*)(MODl + (size_t)mb * DIN + 3 * 1024 + F.lane * 4 + 256 * j);
#pragma unroll 4
        for (int cidx = 0; cidx < 20; ++cidx) { float p = 0.f;
#pragma unroll
            for (int j = 0; j < 4; ++j) { const f32x4 w = *(const LAS f32x4*)(RW + cidx * RWS + F.lane * 4 + 256 * j);
                p = fmaf(sh[j].x, w.x, p); p = fmaf(sh[j].y, w.y, p); p = fmaf(sh[j].z, w.z, p); p = fmaf(sh[j].w, w.w, p); }
            const float tot = wave_sum(p) + RB[cidx]; if (F.lane == 0) BI[sl * 20 + cidx] = tot; } }
    { const int i16 = F.lane & 15, kq = F.lane >> 4; const int ngrp = (r1 - r0 + 15) >> 4;
      for (int gi = F.wave - 4; gi < ngrp; gi += 4) {
        const int grow = r0 + 16 * gi; const int rowi = (grow + i16 < r1) ? grow + i16 : r1 - 1;
        const bool lat = rowi < TL; const float* xs = (lat ? a.out + (size_t)rowi * D : (const float*)(a.ws + WS_XC) + (size_t)(rowi - TL) * D) + 4 * kq;
        const int slot = (mod_row(grow) == mb0) ? 0 : 1;
        const LAS float* gmp = GM + slot * 1024 + 4 * kq; const LAS float* w0p = RW + i16 * RWS + 4 * kq; const LAS float* w1p = RW + (16 + (i16 & 3)) * RWS + 4 * kq;
        const float m1 = (i16 < 4) ? 1.f : 0.f;
        f32x4v acc0 = {0.f, 0.f, 0.f, 0.f}, acc1 = {0.f, 0.f, 0.f, 0.f};
#pragma unroll 16
        for (int s = 0; s < 64; ++s) {
            const f32x4 xv = *(const f32x4*)(xs + 16 * s); const f32x4 gv = *(const LAS f32x4*)(gmp + 16 * s);
            const f32x4 wa = *(const LAS f32x4*)(w0p + 16 * s), wb = *(const LAS f32x4*)(w1p + 16 * s);
            const f32x4 ba = wa * gv, bb = wb * gv * m1;
            acc0 = __builtin_amdgcn_mfma_f32_16x16x4f32(xv.x, ba.x, acc0, 0, 0, 0); acc1 = __builtin_amdgcn_mfma_f32_16x16x4f32(xv.x, bb.x, acc1, 0, 0, 0);
            acc0 = __builtin_amdgcn_mfma_f32_16x16x4f32(xv.y, ba.y, acc0, 0, 0, 0); acc1 = __builtin_amdgcn_mfma_f32_16x16x4f32(xv.y, bb.y, acc1, 0, 0, 0);
            acc0 = __builtin_amdgcn_mfma_f32_16x16x4f32(xv.z, ba.z, acc0, 0, 0, 0); acc1 = __builtin_amdgcn_mfma_f32_16x16x4f32(xv.z, bb.z, acc1, 0, 0, 0);
            acc0 = __builtin_amdgcn_mfma_f32_16x16x4f32(xv.w, ba.w, acc0, 0, 0, 0); acc1 = __builtin_amdgcn_mfma_f32_16x16x4f32(xv.w, bb.w, acc1, 0, 0, 0);
        }
#pragma unroll
        for (int rg = 0; rg < 4; ++rg) { const int lr = 16 * gi + 4 * kq + rg;
            if (r0 + lr < r1) { LG[lr * 20 + i16] = acc0[rg]; if (i16 < 4) LG[lr * 20 + 16 + i16] = acc1[rg]; } }
      } }
    }
    __syncthreads();
    SUBMARK5(42);
    for (int lr = F.tid; lr < r1 - r0; lr += NTHR) {
        float lg[20]; { const float rn = RN[lr]; const int sl = (mod_row(r0 + lr) == mb0) ? 0 : 1;
#pragma unroll
          for (int i = 0; i < 20; ++i) lg[i] = rn * LG[lr * 20 + i] + BI[sl * 20 + i]; }
        int gs = 0; float gmx = lg[0];
#pragma unroll
        for (int i = 1; i < 4; ++i) if (lg[i] > gmx) { gmx = lg[i]; gs = i; }
        float gsum = 0.f;
#pragma unroll
        for (int i = 0; i < 4; ++i) gsum += __expf(lg[i] - gmx);
        const float pg = 1.f / gsum;
        float le[4];
#pragma unroll
        for (int i = 0; i < 4; ++i) le[i] = (gs == 0) ? lg[4 + i] : (gs == 1) ? lg[8 + i] : (gs == 2) ? lg[12 + i] : lg[16 + i];
        int i0 = 0; float v0 = le[0];
#pragma unroll
        for (int i = 1; i < 4; ++i) if (le[i] > v0) { v0 = le[i]; i0 = i; }
        int i1 = -1; float v1 = -3.4e38f;
#pragma unroll
        for (int i = 0; i < 4; ++i) if (i != i0 && le[i] > v1) { v1 = le[i]; i1 = i; }
        const float e1 = __expf(v1 - v0), den = 1.f / (1.f + e1);
        const int ex0 = gs * 4 + i0, ex1 = gs * 4 + i1;
        const int lp0 = __hip_atomic_fetch_add(&LC[ex0], 1, __ATOMIC_RELAXED, __HIP_MEMORY_SCOPE_WORKGROUP), lp1 = __hip_atomic_fetch_add(&LC[ex1], 1, __ATOMIC_RELAXED, __HIP_MEMORY_SCOPE_WORKGROUP);
        TE[lr] = ex0 | (ex1 << 8); TP[lr] = lp0 | (lp1 << 16); TW[2 * lr] = den * pg; TW[2 * lr + 1] = e1 * den * pg;
    }
    __syncthreads();
    if (F.tid < NE) LC[16 + F.tid] = (int)atomicAdd(&CNT[F.tid * 16], (unsigned)LC[F.tid]);
    __syncthreads();
    for (int lr = F.tid; lr < r1 - r0; lr += NTHR) {
        const int te = TE[lr], tp = TP[lr], ex0 = te & 255, ex1 = te >> 8, row = r0 + lr;
        const int gp0 = LC[16 + ex0] + (tp & 0xffff), gp1 = LC[16 + ex1] + (tp >> 16);
        EROW[(size_t)ex0 * TT + gp0] = row * 2; EROWW[(size_t)ex0 * TT + gp0] = TW[2 * lr];
        EROW[(size_t)ex1 * TT + gp1] = row * 2 + 1; EROWW[(size_t)ex1 * TT + gp1] = TW[2 * lr + 1];
    }
    __syncthreads();
    SUBMARK5(43);
    }
    __syncthreads();
#undef SUBMARK5
}

__device__ __forceinline__ void normrope8(float (&x)[8], const float* g64, bool rope, int pos, const float* ct, const float* st, float scale, int lane) {
    float ss = 0.f;
#pragma unroll
    for (int i = 0; i < 8; ++i) ss += x[i] * x[i];
    ss += DPP_F(ss, 0xB1); ss += DPP_F(ss, 0x4E); ss += DPP_F(ss, 0x141);
    const float r = 1.f / sqrtf(ss * (1.f / 64.f) + EPS);
    const int ch = lane & 7;
    const f32x4 g0 = *(const f32x4*)(g64 + 8 * ch), g1 = *(const f32x4*)(g64 + 8 * ch + 4);
    x[0] *= r * g0.x; x[1] *= r * g0.y; x[2] *= r * g0.z; x[3] *= r * g0.w; x[4] *= r * g1.x; x[5] *= r * g1.y; x[6] *= r * g1.z; x[7] *= r * g1.w;
    if (rope) {
        const int ax = ch >> 2, half = (ch >> 1) & 1, f0 = 8 * (ch & 1);
        const f32x4 c0 = *(const f32x4*)(ct + pos * 32 + ax * 16 + f0), c1 = *(const f32x4*)(ct + pos * 32 + ax * 16 + f0 + 4);
        const f32x4 s0 = *(const f32x4*)(st + pos * 32 + ax * 16 + f0), s1 = *(const f32x4*)(st + pos * 32 + ax * 16 + f0 + 4);
        const float cs[8] = {c0.x, c0.y, c0.z, c0.w, c1.x, c1.y, c1.z, c1.w}, sn[8] = {s0.x, s0.y, s0.z, s0.w, s1.x, s1.y, s1.z, s1.w};
#pragma unroll
        for (int i = 0; i < 8; ++i) { const float p = DPP_F(x[i], 0x4E);
            x[i] = half ? (x[i] * cs[i] + p * sn[i]) : (x[i] * cs[i] - p * sn[i]); }
    }
#pragma unroll
    for (int i = 0; i < 8; ++i) x[i] *= scale;
}
__device__ __forceinline__ void unpack8(const u32x4 w, float (&x)[8]) { x[0] = bflo(w.x); x[1] = bfhi(w.x); x[2] = bflo(w.y); x[3] = bfhi(w.y); x[4] = bflo(w.z); x[5] = bfhi(w.z); x[6] = bflo(w.w); x[7] = bfhi(w.w); }
__device__ __forceinline__ u32x4 pack8(const float (&x)[8]) { u32x4 w; w.x = cvtpk(x[0], x[1]); w.y = cvtpk(x[2], x[3]); w.z = cvtpk(x[4], x[5]); w.w = cvtpk(x[6], x[7]); return w; }

__device__ __forceinline__ void prep_phase(const Fr& F, const Args& a, int l, bool with_ctx) {
    constexpr int VROW = 272;
    LAS unsigned char* VA_l = F.lds;
    LAS unsigned char* VW_l = F.lds + 17408;
    LAS unsigned char* HT_l = F.lds + 34816;
    constexpr int HROW = 144;
    const float* ct = (const float*)(a.ws + WS_ROPE); const float* st = ct + SEQ * 32;
    const float* qkg = a.in[I_QKG] + l * 256;
    const bf16_t* RAWA = (const bf16_t*)(a.ws + WS_RAWA); const bf16_t* RAWW = (const bf16_t*)(a.ws + WS_RAWW);
    bf16_t* KA = (bf16_t*)(a.ws + WS_KA); bf16_t* KW = (bf16_t*)(a.ws + WS_KW); bf16_t* VTA = (bf16_t*)(a.ws + WS_VTA); bf16_t* VTW = (bf16_t*)(a.ws + WS_VTW);
    const bf16_t* U = (const bf16_t*)(a.ws + WS_U); bf16_t* X0 = (bf16_t*)(a.ws + WS_H); bf16_t* VT = (bf16_t*)(a.ws + WS_VT);
    const float* hsw = a.in[I_HSW] + l * 3 * 1536; const float* hsb = a.in[I_HSB] + l * 1536;
    for (int unit = F.bid; unit < NB * 36; unit += F.G) {
        const bool lat = unit < NB * 32;
        const int b = lat ? unit >> 5 : (unit - NB * 32) >> 2, p0 = lat ? (unit & 31) * 64 : ((unit - NB * 32) & 3) * 64;
        const int n = lat ? SEQ : CTX;
        const int row0 = lat ? b * SEQ + p0 : TL + b * CTX + p0;
        const int j0 = lat ? CTX + p0 : p0;
        __syncthreads();
        {
            const bool isw = (F.lane & 16) != 0; const int l16 = F.lane & 15, half = F.lane >> 5;
            u32x4 kw[4];
#pragma unroll
            for (int ps = 0; ps < 4; ++ps) { const int tk = 8 * F.wave + 2 * ps + half; kw[ps] = *(const u32x4*)((isw ? RAWW : RAWA) + (size_t)(row0 + tk) * 256 + l16 * 8); }
#pragma unroll
            for (int ps = 0; ps < 4; ++ps) { const int tk = 8 * F.wave + 2 * ps + half; float x[8]; unpack8(kw[ps], x);
                normrope8(x, qkg + (isw ? 192 : 64), lat, p0 + tk, ct, st, 1.f, F.lane);
                *(u32x4*)((isw ? KW : KA) + ((size_t)b * KEYS + j0 + tk) * 128 + l16 * 8) = pack8(x); }
        }
        for (int i = F.tid; i < 2 * 64 * 16; i += NTHR) { const int m = i >> 10, r = (i >> 4) & 63, cch = i & 15;
            const u32x4 w = *(const u32x4*)((m ? RAWW : RAWA) + (size_t)(row0 + r) * 256 + 128 + cch * 8);
            *(LAS u32x4*)((m ? VW_l : VA_l) + r * VROW + cch * 16) = w; }
        const bool do_hy = lat || with_ctx;
        if (do_hy) {
            const int cg = F.tid & 63, c = 8 * cg, t0 = 8 * F.wave;
            u32x4 x1p[8];
#pragma unroll
            for (int g = 0; g < 3; ++g) {
                const int ch = g * 512 + c;
                float w0[8], w1[8], w2[8], bb[8];
                { const f32x4 a0 = *(const f32x4*)(hsw + ch), a1 = *(const f32x4*)(hsw + ch + 4), b0 = *(const f32x4*)(hsw + 1536 + ch), b1 = *(const f32x4*)(hsw + 1536 + ch + 4),
                              c0 = *(const f32x4*)(hsw + 3072 + ch), c1 = *(const f32x4*)(hsw + 3072 + ch + 4), d0 = *(const f32x4*)(hsb + ch), d1 = *(const f32x4*)(hsb + ch + 4);
                  w0[0] = a0.x; w0[1] = a0.y; w0[2] = a0.z; w0[3] = a0.w; w0[4] = a1.x; w0[5] = a1.y; w0[6] = a1.z; w0[7] = a1.w;
                  w1[0] = b0.x; w1[1] = b0.y; w1[2] = b0.z; w1[3] = b0.w; w1[4] = b1.x; w1[5] = b1.y; w1[6] = b1.z; w1[7] = b1.w;
                  w2[0] = c0.x; w2[1] = c0.y; w2[2] = c0.z; w2[3] = c0.w; w2[4] = c1.x; w2[5] = c1.y; w2[6] = c1.z; w2[7] = c1.w;
                  bb[0] = d0.x; bb[1] = d0.y; bb[2] = d0.z; bb[3] = d0.w; bb[4] = d1.x; bb[5] = d1.y; bb[6] = d1.z; bb[7] = d1.w; }
                u32x4 raw[10];
#pragma unroll
                for (int i = 0; i < 10; ++i) { const int pos = p0 + t0 - 1 + i;
                    if (pos < 0 || pos >= n) { const unsigned z = zero_u32(); raw[i] = (u32x4){z, z, z, z}; } else raw[i] = *(const u32x4*)(U + (size_t)(row0 - p0 + pos) * 1536 + ch); }
#pragma unroll
                for (int t = 0; t < 8; ++t) { float up[8], uc[8], un[8], o[8]; unpack8(raw[t], up); unpack8(raw[t + 1], uc); unpack8(raw[t + 2], un);
#pragma unroll
                    for (int i = 0; i < 8; ++i) o[i] = fmaf(w0[i], up[i], fmaf(w1[i], uc[i], fmaf(w2[i], un[i], bb[i])));
                    if (g == 0) *(u32x4*)(X0 + (size_t)(row0 + t0 + t) * 512 + c) = pack8(o);
                    else if (g == 1) x1p[t] = pack8(o);
                    else { float x1[8]; unpack8(x1p[t], x1);
#pragma unroll
                        for (int i = 0; i < 8; ++i) o[i] *= x1[i];
                        x1p[t] = pack8(o); } }
            }
#pragma unroll
            for (int i = 0; i < 8; ++i) { unsigned short ev[8];
#pragma unroll
                for (int t = 0; t < 8; ++t) { const unsigned wsel = (i >> 1) == 0 ? x1p[t].x : (i >> 1) == 1 ? x1p[t].y : (i >> 1) == 2 ? x1p[t].z : x1p[t].w; ev[t] = (unsigned short)((i & 1) ? (wsel >> 16) : (wsel & 0xffffu)); }
                u32x4 w; w.x = ev[0] | ((unsigned)ev[1] << 16); w.y = ev[2] | ((unsigned)ev[3] << 16); w.z = ev[4] | ((unsigned)ev[5] << 16); w.w = ev[6] | ((unsigned)ev[7] << 16);
                *(LAS u32x4*)(HT_l + (c + i) * HROW + t0 * 2) = w; }
        }
        __syncthreads();
        for (int i = F.tid; i < 2 * 128 * 8; i += NTHR) { const int m = i >> 10, rr = (i >> 3) & 127, c8 = i & 7;
            LAS unsigned char* T = m ? VW_l : VA_l; unsigned short e[8];
#pragma unroll
            for (int jj = 0; jj < 8; ++jj) { const int key = 16 * (c8 >> 1) + 8 * (jj >> 2) + 4 * (c8 & 1) + (jj & 3); e[jj] = *(const LAS bf16_t*)(T + key * VROW + rr * 2); }
            u32x4 w; w.x = e[0] | ((unsigned)e[1] << 16); w.y = e[2] | ((unsigned)e[3] << 16); w.z = e[4] | ((unsigned)e[5] << 16); w.w = e[6] | ((unsigned)e[7] << 16);
            *(u32x4*)((m ? VTW : VTA) + ((size_t)(b * 2 + (rr >> 6)) * 64 + (rr & 63)) * KEYS + j0 + c8 * 8) = w; }
        if (do_hy) { bf16_t* VTb = lat ? VT : VT + VT_CTX_OFF;
          for (int i = F.tid; i < 512 * 8; i += NTHR) { const int cch = i >> 3, c8 = i & 7;
              const u32x4 w = *(const LAS u32x4*)(HT_l + cch * HROW + c8 * 16);
              *(u32x4*)(VTb + ((size_t)cch * NB + b) * n + p0 + c8 * 8) = w; } }
    }
    __syncthreads();
}

__device__ __forceinline__ void hyena_final_phase(const Fr& F, const Args& a, int l, bool with_ctx) {
    constexpr int HROW = 144;
    LAS unsigned char* T = F.lds;
    const bf16_t* X0 = (const bf16_t*)(a.ws + WS_H); const bf16_t* VT = (const bf16_t*)(a.ws + WS_VT); const bf16_t* YT = (const bf16_t*)(a.ws + WS_YT);
    unsigned char* YH = a.ws + WS_Y8 + 512;
    const float* FN = (const float*)(a.ws + WS_FNORM) + l * 1024; const float* skip = a.in[I_HBIAS] + l * 512;
    const int nunits = with_ctx ? NB * 36 : NB * 32;
    for (int unit = F.bid; unit < nunits; unit += F.G) {
        const bool lat = unit < NB * 32;
        const int b = lat ? unit >> 5 : (unit - NB * 32) >> 2, p0 = lat ? (unit & 31) * 64 : ((unit - NB * 32) & 3) * 64;
        const int n = lat ? SEQ : CTX; const int row0 = lat ? b * SEQ + p0 : TL + b * CTX + p0;
        const bf16_t* Yb = lat ? YT : YT + VT_CTX_OFF; const bf16_t* Vb = lat ? VT : VT + VT_CTX_OFF; const float* inv = FN + (lat ? 0 : 512);
        __syncthreads();
        for (int i = F.tid; i < 512 * 8; i += NTHR) { const int cch = i >> 3, c8 = i & 7; const size_t off = ((size_t)cch * NB + b) * n + p0 + c8 * 8;
            const u32x4 y = *(const u32x4*)(Yb + off), v = *(const u32x4*)(Vb + off); const float s = inv[cch], k = skip[cch];
            u32x4 o;
            o.x = cvtpk(bflo(y.x) * s + k * bflo(v.x), bfhi(y.x) * s + k * bfhi(v.x)); o.y = cvtpk(bflo(y.y) * s + k * bflo(v.y), bfhi(y.y) * s + k * bfhi(v.y));
            o.z = cvtpk(bflo(y.z) * s + k * bflo(v.z), bfhi(y.z) * s + k * bfhi(v.z)); o.w = cvtpk(bflo(y.w) * s + k * bflo(v.w), bfhi(y.w) * s + k * bfhi(v.w));
            *(LAS u32x4*)(T + cch * HROW + c8 * 16) = o; }
        __syncthreads();
        { const int th = F.tid & 255, half = F.tid >> 8, c = 2 * th;
          for (int t = 32 * half; t < 32 * half + 32; ++t) {
              const unsigned x0 = *(const unsigned*)(X0 + (size_t)(row0 + t) * 512 + c);
              const float y0 = bf1(*(const LAS bf16_t*)(T + c * HROW + t * 2)), y1 = bf1(*(const LAS bf16_t*)(T + (c + 1) * HROW + t * 2));
              *(unsigned short*)(YH + (size_t)(row0 + t) * 1536 + c) = (unsigned short)__builtin_amdgcn_cvt_pk_fp8_f32(clamp_fp8(bflo(x0) * y0 * 16.f), clamp_fp8(bfhi(x0) * y1 * 16.f), 0, false); } }
    }
    __syncthreads();
}

#define MFMA32(a, b, c) __builtin_amdgcn_mfma_f32_32x32x16_bf16((a), (b), (c), 0, 0, 0)
#define MFMA16(a, b, c) __builtin_amdgcn_mfma_f32_16x16x32_bf16((a), (b), (c), 0, 0, 0)

__device__ __forceinline__ int tile_off(int row, int chunk) { return row * 128 + ((chunk ^ ((row >> 1) & 7)) << 4); }

template <bool WIN>
__device__ __forceinline__ void attn_unit(const Fr& F, const bf16_t* Qw, unsigned char* Yw, const bf16_t* Kb, const bf16_t* VTb, int a0, int na, int b0, int nb, int qpos0, bool has_sink, float sink2, const float* g64, bool rope, const float* ct, const float* st) {
    LAS unsigned char* L = F.lds;
    const int r = F.lane & 31, h = F.lane >> 5;
    const int xaddr = (lane_id() ^ 32) << 2;
#define SWAP32(v) __builtin_bit_cast(float, __builtin_amdgcn_ds_bpermute(xaddr, __builtin_bit_cast(int, (v))))
    bf16x8 q[4];
    {
        float x[4][8]; float ss = 0.f;
#pragma unroll
        for (int kk = 0; kk < 4; ++kk) { const u32x4 w = *(const u32x4*)(Qw + (size_t)r * 1536 + 16 * kk + 8 * h); unpack8(w, x[kk]);
#pragma unroll
            for (int j = 0; j < 8; ++j) ss += x[kk][j] * x[kk][j]; }
        ss += SWAP32(ss);
        const float rn = (1.f / sqrtf(ss * (1.f / 64.f) + EPS)) * QSCALE;
#pragma unroll
        for (int kk = 0; kk < 4; ++kk) { const f32x4 g0 = *(const f32x4*)(g64 + 16 * kk + 8 * h), g1 = *(const f32x4*)(g64 + 16 * kk + 8 * h + 4);
            x[kk][0] *= rn * g0.x; x[kk][1] *= rn * g0.y; x[kk][2] *= rn * g0.z; x[kk][3] *= rn * g0.w; x[kk][4] *= rn * g1.x; x[kk][5] *= rn * g1.y; x[kk][6] *= rn * g1.z; x[kk][7] *= rn * g1.w; }
        if (rope) { const int pos = qpos0 + r;
#pragma unroll
            for (int ax = 0; ax < 2; ++ax) {
                const f32x4 c0 = *(const f32x4*)(ct + pos * 32 + ax * 16 + 8 * h), c1 = *(const f32x4*)(ct + pos * 32 + ax * 16 + 8 * h + 4);
                const f32x4 s0 = *(const f32x4*)(st + pos * 32 + ax * 16 + 8 * h), s1 = *(const f32x4*)(st + pos * 32 + ax * 16 + 8 * h + 4);
                const float cs[8] = {c0.x, c0.y, c0.z, c0.w, c1.x, c1.y, c1.z, c1.w}, sn[8] = {s0.x, s0.y, s0.z, s0.w, s1.x, s1.y, s1.z, s1.w};
#pragma unroll
                for (int j = 0; j < 8; ++j) { const float av = x[2 * ax][j], bv = x[2 * ax + 1][j]; x[2 * ax][j] = av * cs[j] - bv * sn[j]; x[2 * ax + 1][j] = bv * cs[j] + av * sn[j]; } } }
#pragma unroll
        for (int kk = 0; kk < 4; ++kk) q[kk] = __builtin_bit_cast(bf16x8, pack8(x[kk]));
    }
    f32x16 o0, o1;
#pragma unroll
    for (int i = 0; i < 16; ++i) { o0[i] = 0.f; o1[i] = 0.f; }
    float lsum = 0.f;
    const int ntile = na + nb;
    const int srow = F.tid >> 3, sch = F.tid & 7;
    const int soff = tile_off(srow, sch);
    int t4[4];
#pragma unroll
    for (int j = 0; j < 4; ++j) t4[j] = tile_off(r, 2 * j + h);
#define AT_KT(i) ((i) < na ? a0 + (i) : b0 + ((i) - na))
#define AT_LD(i, K0, K1, V0, V1) do { const int kt_ = AT_KT(i); \
        K0 = *(const u32x4*)(Kb + (size_t)(kt_ * 128 + srow) * 128 + sch * 8); K1 = *(const u32x4*)(Kb + (size_t)(kt_ * 128 + 64 + srow) * 128 + sch * 8); \
        V0 = *(const u32x4*)(VTb + (size_t)srow * KEYS + kt_ * 128 + sch * 8); V1 = *(const u32x4*)(VTb + (size_t)srow * KEYS + kt_ * 128 + 64 + sch * 8); } while (0)
#define AT_ST(buf, K0, K1, V0, V1) do { LAS unsigned char* B_ = L + (buf) * 32768 + soff; \
        *(LAS u32x4*)(B_) = K0; *(LAS u32x4*)(B_ + 8192) = K1; *(LAS u32x4*)(B_ + 16384) = V0; *(LAS u32x4*)(B_ + 24576) = V1; } while (0)
#define AT_QK(S0, S1, Kt) do { bf16x8 kf_[8]; \
        _Pragma("unroll") for (int kk = 0; kk < 4; ++kk) { kf_[2 * kk] = *(const LAS bf16x8*)(L + (Kt) + t4[kk]); kf_[2 * kk + 1] = *(const LAS bf16x8*)(L + (Kt) + t4[kk] + 4096); } \
        _Pragma("unroll") for (int i_ = 0; i_ < 16; ++i_) { S0[i_] = 0.f; S1[i_] = 0.f; } \
        _Pragma("unroll") for (int kk = 0; kk < 4; ++kk) { S0 = MFMA32(kf_[2 * kk], q[kk], S0); S1 = MFMA32(kf_[2 * kk + 1], q[kk], S1); } } while (0)
#define AT_EXP(S0, S1, P, kpos0) do { \
        if (WIN && (kpos0) >= 0) { const int kbase = (kpos0) + 4 * h, qp = qpos0 + r; \
            _Pragma("unroll") for (int i = 0; i < 16; ++i) { const int kr = (i & 3) + 8 * (i >> 2); const int d0 = kbase + kr - qp, d1 = d0 + 32; \
                if (d0 > 128 || d0 < -128) S0[i] = -1e30f; if (d1 > 128 || d1 < -128) S1[i] = -1e30f; } } \
        _Pragma("unroll") for (int i = 0; i < 16; ++i) { S0[i] = fast_exp2(S0[i]); S1[i] = fast_exp2(S1[i]); lsum += S0[i] + S1[i]; } \
        { u32x4 w; \
          w.x = cvtpk(S0[0], S0[1]); w.y = cvtpk(S0[2], S0[3]); w.z = cvtpk(S0[4], S0[5]); w.w = cvtpk(S0[6], S0[7]); P[0] = __builtin_bit_cast(bf16x8, w); \
          w.x = cvtpk(S0[8], S0[9]); w.y = cvtpk(S0[10], S0[11]); w.z = cvtpk(S0[12], S0[13]); w.w = cvtpk(S0[14], S0[15]); P[1] = __builtin_bit_cast(bf16x8, w); \
          w.x = cvtpk(S1[0], S1[1]); w.y = cvtpk(S1[2], S1[3]); w.z = cvtpk(S1[4], S1[5]); w.w = cvtpk(S1[6], S1[7]); P[2] = __builtin_bit_cast(bf16x8, w); \
          w.x = cvtpk(S1[8], S1[9]); w.y = cvtpk(S1[10], S1[11]); w.z = cvtpk(S1[12], S1[13]); w.w = cvtpk(S1[14], S1[15]); P[3] = __builtin_bit_cast(bf16x8, w); } } while (0)
#define AT_PV(P, Vt) do { bf16x8 vf_[8]; \
        _Pragma("unroll") for (int c = 0; c < 4; ++c) { vf_[2 * c] = *(const LAS bf16x8*)(L + (Vt) + t4[c]); vf_[2 * c + 1] = *(const LAS bf16x8*)(L + (Vt) + t4[c] + 4096); } \
        _Pragma("unroll") for (int c = 0; c < 4; ++c) { o0 = MFMA32(vf_[2 * c], P[c], o0); o1 = MFMA32(vf_[2 * c + 1], P[c], o1); } } while (0)
#define AT_BODY(it) do { \
        const int kt = AT_KT(it); \
        if ((it) + 1 < ntile) AT_LD((it) + 1, kA0, kA1, vA0, vA1); \
        const int Bc = ((it) & 1) * 32768;                                \
        const int kp = (WIN && kt >= 2) ? (kt - 2) * 128 : -1;            \
        { f32x16 sa0, sa1; bf16x8 pa[4]; \
          AT_QK(sa0, sa1, Bc); AT_EXP(sa0, sa1, pa, kp); AT_PV(pa, Bc + 16384); } \
        __builtin_amdgcn_sched_barrier(0); \
        { f32x16 sb0, sb1; bf16x8 pb_[4]; \
          AT_QK(sb0, sb1, Bc + 8192); AT_EXP(sb0, sb1, pb_, (kp < 0 ? -1 : kp + 64)); AT_PV(pb_, Bc + 24576); } \
        if ((it) + 1 < ntile) AT_ST(((it) + 1) & 1, kA0, kA1, vA0, vA1); \
        __syncthreads(); } while (0)
    u32x4 kA0, kA1, vA0, vA1;
    AT_LD(0, kA0, kA1, vA0, vA1);
    __syncthreads();
    AT_ST(0, kA0, kA1, vA0, vA1);
    __syncthreads();
    for (int it = 0; it < ntile; it += 2) {
        AT_BODY(it);
        if (it + 1 < ntile) AT_BODY(it + 1);
    }
#undef AT_BODY
#undef AT_QK
#undef AT_EXP
#undef AT_PV
#undef AT_ST
#undef AT_LD
#undef AT_KT
    float lt = lsum + SWAP32(lsum);
    if (has_sink) lt += fast_exp2(sink2);
    const float inv = 1.f / lt;
#pragma unroll
    for (int g = 0; g < 4; ++g) { const float i16 = inv * 16.f;
        *(unsigned*)(Yw + (size_t)r * 1536 + 8 * g + 4 * h) = cvt4_fp8(o0[4 * g] * i16, o0[4 * g + 1] * i16, o0[4 * g + 2] * i16, o0[4 * g + 3] * i16);
        *(unsigned*)(Yw + (size_t)r * 1536 + 32 + 8 * g + 4 * h) = cvt4_fp8(o1[4 * g] * i16, o1[4 * g + 1] * i16, o1[4 * g + 2] * i16, o1[4 * g + 3] * i16); }
#undef SWAP32
}

__device__ __forceinline__ void hyena_unit_lat(const Fr& F, const bf16_t* Fg, const bf16_t* Vg, bf16_t* Yg) {
    constexpr int FREP = 8192 + 64, VPIT = 4096 + 16, VOFF = 8 * FREP;
    LAS unsigned char* L = F.lds;
    __syncthreads();
    { const int x = F.tid;
      const u32x4 lo = *(const u32x4*)(Fg + x * 8); u32x4 hi; if (x < 511) hi = *(const u32x4*)(Fg + x * 8 + 8); else { const unsigned z = zero_u32(); hi = (u32x4){z, z, z, z}; }
      const unsigned wv[8] = {lo.x, lo.y, lo.z, lo.w, hi.x, hi.y, hi.z, hi.w};
      *(LAS u32x4*)(L + x * 16) = lo;
#pragma unroll
      for (int rho = 1; rho < 8; ++rho) { u32x4 o;
          unsigned od[4];
#pragma unroll
          for (int d = 0; d < 4; ++d) { const int ob = 4 * d + 2 * rho, i = ob >> 2, s = ob & 3; od[d] = __builtin_amdgcn_alignbyte(wv[i + 1 < 8 ? i + 1 : 7], wv[i], s); }
          o.x = od[0]; o.y = od[1]; o.z = od[2]; o.w = od[3];
          *(LAS u32x4*)(L + rho * FREP + x * 16) = o; } }
    for (int i = F.tid; i < 16 * 256; i += NTHR) { const int b = i >> 8, x = i & 255; *(LAS u32x4*)(L + VOFF + b * VPIT + x * 16) = *(const u32x4*)(Vg + (size_t)b * SEQ + x * 8); }
    __syncthreads();
    const int i16 = F.lane & 15, q4 = F.lane >> 4, w = F.wave;
    const int base0 = 2047 - 256 * w - i16 + 8 * q4;
    const int rho = base0 & 7;
    LAS unsigned char* Ap = L + rho * FREP + (base0 - rho) * 2;
    LAS unsigned char* Bp = L + VOFF + i16 * VPIT + q4 * 16;
    bf16x8 A[16]; f32x4 acc[16];
#pragma unroll
    for (int rr = 0; rr < 16; ++rr) { A[rr] = *(const LAS bf16x8*)(Ap - 32 * rr); acc[rr] = (f32x4){0.f, 0.f, 0.f, 0.f}; }
    bf16x8 Bn = *(const LAS bf16x8*)(Bp);
    for (int o = 0; o < 8; ++o) {
#pragma unroll
        for (int u = 0; u < 8; ++u) {
            const int st = o * 8 + u;
            const bf16x8 Bf = Bn;
            if (st < 63) Bn = *(const LAS bf16x8*)(Bp + 64 * st + 64);
#pragma unroll
            for (int rr = 0; rr < 16; ++rr) acc[rr] = MFMA16(A[(rr - 2 * u) & 15], Bf, acc[rr]);
            if (st < 63) { A[(-2 * u - 2) & 15] = *(const LAS bf16x8*)(Ap + 64 * st + 64); A[(-2 * u - 1) & 15] = *(const LAS bf16x8*)(Ap + 64 * st + 32); }
        }
    }
#pragma unroll
    for (int rr = 0; rr < 16; ++rr) { u32x2 wv; wv.x = cvtpk(acc[rr].x, acc[rr].y); wv.y = cvtpk(acc[rr].z, acc[rr].w);
        *(u32x2*)(Yg + (size_t)i16 * SEQ + 256 * w + 16 * rr + 4 * q4) = wv; }
}
__device__ __forceinline__ void hyena_unit_ctx(const Fr& F, const bf16_t* Fg, const bf16_t* Vg, bf16_t* Yg) {
    constexpr int FREP = 1024 + 64, VPIT = 512 + 16, VOFF = 8 * FREP;
    LAS unsigned char* L = F.lds;
    __syncthreads();
    if (F.tid < 64) *(LAS u32x4*)(L + F.tid * 16) = *(const u32x4*)(Fg + F.tid * 8);
    if (F.tid >= 64 && F.tid < 68) { const unsigned z = zero_u32(); *(LAS u32x4*)(L + 1024 + (F.tid - 64) * 16) = (u32x4){z, z, z, z}; }
    { const int b = F.tid >> 5, x = F.tid & 31; *(LAS u32x4*)(L + VOFF + b * VPIT + x * 16) = *(const u32x4*)(Vg + (size_t)b * CTX + x * 8); }
    __syncthreads();
    for (int i = F.tid; i < 7 * 256; i += NTHR) { const int rho = 1 + i / 256, x2 = (i % 256) * 2; const int s0 = x2 + rho, s1 = x2 + 1 + rho;
        const unsigned e0 = s0 < 512 ? *(const LAS bf16_t*)(L + s0 * 2) : 0, e1 = s1 < 512 ? *(const LAS bf16_t*)(L + s1 * 2) : 0;
        *(LAS unsigned*)(L + rho * FREP + x2 * 2) = e0 | (e1 << 16); }
    __syncthreads();
    const int i16 = F.lane & 15, q4 = F.lane >> 4, w = F.wave;
    const int base0 = 255 - 32 * w - i16 + 8 * q4, rho = base0 & 7;
    LAS unsigned char* Ap = L + rho * FREP + (base0 - rho) * 2;
    LAS unsigned char* Bp = L + VOFF + i16 * VPIT + q4 * 16;
    f32x4 acc0 = (f32x4){0.f, 0.f, 0.f, 0.f}, acc1 = acc0;
#pragma unroll
    for (int st = 0; st < 8; ++st) { const bf16x8 Bf = *(const LAS bf16x8*)(Bp + 64 * st);
        const bf16x8 A0 = *(const LAS bf16x8*)(Ap + 64 * st), A1 = *(const LAS bf16x8*)(Ap + 64 * st - 32);
        acc0 = MFMA16(A0, Bf, acc0); acc1 = MFMA16(A1, Bf, acc1); }
    u32x2 wv; wv.x = cvtpk(acc0.x, acc0.y); wv.y = cvtpk(acc0.z, acc0.w); *(u32x2*)(Yg + (size_t)i16 * CTX + 32 * w + 4 * q4) = wv;
    wv.x = cvtpk(acc1.x, acc1.y); wv.y = cvtpk(acc1.z, acc1.w); *(u32x2*)(Yg + (size_t)i16 * CTX + 32 * w + 16 + 4 * q4) = wv;
}

__device__ __forceinline__ void mixer_phase(const Fr& F, const Args& a, int l, bool with_ctx, unsigned long long& sacc, const int swhich) {
#if defined(PROBE_P)
    unsigned long long st0 = __builtin_amdgcn_s_memrealtime();
#define SUBMARK(w) do { const unsigned long long t_ = __builtin_amdgcn_s_memrealtime(); if (swhich == (w)) sacc += t_ - st0; st0 = t_; } while (0)
#else
#define SUBMARK(w) do { } while (0)
#endif
    const bf16_t* QA = (const bf16_t*)(a.ws + WS_QA); const bf16_t* QW = QA + 1024;
    unsigned char* Y8 = a.ws + WS_Y8;
    const bf16_t* KA = (const bf16_t*)(a.ws + WS_KA); const bf16_t* KW = (const bf16_t*)(a.ws + WS_KW);
    const bf16_t* VTA = (const bf16_t*)(a.ws + WS_VTA); const bf16_t* VTW = (const bf16_t*)(a.ws + WS_VTW);
    const float* sinks = a.in[I_SINK] + l * 8; const float* qkg = a.in[I_QKG] + l * 256;
    const float* ct = (const float*)(a.ws + WS_ROPE); const float* st = ct + SEQ * 32;
    const int wq = F.wave >> 1, wh = F.wave & 1;
    const int ubid = (F.G % 8 == 0) ? (F.bid & 7) * (F.G >> 3) + (F.bid >> 3) : F.bid;
#define RELANE(FX) do { int t_ = F.wave * 64 + lane_id(); asm volatile("" : "+v"(t_)); FX.tid = t_; FX.lane = t_ & 63; } while (0)
    Fr FA = F; RELANE(FA);
    for (int unit = ubid; unit < NB * 2 * 32; unit += F.G) {
        const int b = unit >> 6, kvh = (unit >> 5) & 1, pb = unit & 31;
        const size_t qo = (size_t)(b * SEQ + pb * 64 + wh * 32) * 1536 + (kvh * 4 + wq) * 64;
        attn_unit<false>(FA, QA + qo, Y8 + qo, KA + (size_t)b * KEYS * 128 + kvh * 64, VTA + (size_t)(b * 2 + kvh) * 64 * KEYS, 0, KEYS / 128, 0, 0, pb * 64 + wh * 32, false, 0.f, qkg, true, ct, st);
    }
    SUBMARK(30);
    Fr FW = F; RELANE(FW);
    for (int unit = ubid; unit < NB * 2 * 32; unit += F.G) {
        const int b = unit >> 6, kvh = (unit >> 5) & 1, pb = unit & 31;
        const size_t qo = (size_t)(b * SEQ + pb * 64 + wh * 32) * 1536 + (kvh * 4 + wq) * 64 + 1024;
        const int lo = pb < 2 ? 0 : (pb - 2) >> 1, hi = ((64 * pb + 191) >> 7) > 15 ? 15 : ((64 * pb + 191) >> 7);
        attn_unit<true>(FW, QA + qo, Y8 + qo, KW + (size_t)b * KEYS * 128 + kvh * 64, VTW + (size_t)(b * 2 + kvh) * 64 * KEYS, 0, 2, 2 + lo, hi - lo + 1, pb * 64 + wh * 32, true, sinks[kvh * 4 + wq] * LOG2E, qkg + 128, true, ct, st);
    }
    SUBMARK(31);
    Fr FC2 = F; RELANE(FC2);
    if (with_ctx) {
        for (int unit = ubid; unit < 2 * NB * 2 * 4; unit += F.G) {
            const int isw = unit >> 7, u2 = unit & 127, b = u2 >> 3, kvh = (u2 >> 2) & 1, pb = u2 & 3;
            const size_t qo = (size_t)(TL + b * CTX + pb * 64 + wh * 32) * 1536 + (kvh * 4 + wq) * 64 + (isw ? 1024 : 0);
            attn_unit<false>(FC2, QA + qo, Y8 + qo, (isw ? KW : KA) + (size_t)b * KEYS * 128 + kvh * 64, (isw ? VTW : VTA) + (size_t)(b * 2 + kvh) * 64 * KEYS, 0, 2, 0, 0, 0, isw != 0, isw ? sinks[kvh * 4 + wq] * LOG2E : 0.f, qkg + (isw ? 128 : 0), false, ct, st);
        }
    }
    SUBMARK(32);
    const bf16_t* FL = (const bf16_t*)(a.ws + WS_FL) + (size_t)l * 512 * 4096; const bf16_t* FC = (const bf16_t*)(a.ws + WS_FC) + (size_t)l * 512 * 512;
    const bf16_t* VT = (const bf16_t*)(a.ws + WS_VT); bf16_t* YT = (bf16_t*)(a.ws + WS_YT);
    Fr FH = F; RELANE(FH);
    for (int c = F.bid; c < HYW; c += F.G) hyena_unit_lat(FH, FL + (size_t)c * 4096, VT + (size_t)c * NB * SEQ, YT + (size_t)c * NB * SEQ);
    if (with_ctx) for (int c = F.bid; c < HYW; c += F.G) hyena_unit_ctx(FH, FC + (size_t)c * 512, VT + VT_CTX_OFF + (size_t)c * NB * CTX, YT + VT_CTX_OFF + (size_t)c * NB * CTX);
    __syncthreads();
    SUBMARK(33);
#undef SUBMARK
#undef RELANE
}

__device__ __forceinline__ float gate_q(float x) { return fminf(256.f * sigmoid_f(x), 255.49f); }
__device__ __forceinline__ unsigned pack_u8x4(float a, float b, float c, float d) { return (unsigned)(int)a | ((unsigned)(int)b << 8) | ((unsigned)(int)c << 16) | ((unsigned)(int)d << 24); }
__device__ __forceinline__ float gq(unsigned w, int k) { return (float)((w >> (8 * k)) & 0xffu) + 0.5f; }
struct EpiInProj {
    static constexpr bool PERM = true, AFTER_DRAIN = false; static constexpr int NSEG = 1;
    unsigned char* ws; int pn_off;
    __device__ __forceinline__ void operator()(const pg8::f32x4 (&acc)[2][2][4][2], const pg8::Unit& u, int wr, int wc, int fr, int fq) const {
        asm volatile("" : "+v"(fr), "+v"(fq));
        const int pn = __builtin_amdgcn_readfirstlane(u.pn) + pn_off; unsigned long long boff; int ldc, colt; bool sig = false;
        if (pn < 2) { boff = WS_QA; ldc = 1536; colt = pn * 256; }
        else if (pn == 2) { boff = WS_RAWA; ldc = 256; colt = 0; }
        else if (pn < 9) { boff = WS_U; ldc = 1536; colt = (pn - 3) * 256; }
        else if (pn < 11) { boff = WS_QA; ldc = 1536; colt = 1024 + (pn - 9) * 256; }
        else if (pn == 11) { boff = WS_RAWW; ldc = 256; colt = 0; }
        else { boff = WS_G; ldc = 3072; colt = (pn - 12) * 256; sig = true; }
        bf16_t* base = (bf16_t*)(ws + boff); unsigned char* Gt = ws + boff;
        const int row0 = u.pm * 256 + wr * 64 + fr, col0 = colt + wc * 32 + 8 * fq;
        if (sig) {
            unsigned char* gb = (unsigned char*)Gt;
#pragma unroll
            for (int ai = 0; ai < 2; ++ai)
#pragma unroll
                for (int m = 0; m < 4; ++m) { unsigned char* rowp = gb + (size_t)(row0 + ai * 128 + m * 16) * 3072 + col0;
#pragma unroll
                    for (int bj = 0; bj < 2; ++bj) { const pg8::f32x4 v0 = acc[ai][bj][m][0], v1 = acc[ai][bj][m][1];
                        u32x2 w; w.x = pack_u8x4(gate_q(v0.x), gate_q(v0.y), gate_q(v0.z), gate_q(v0.w)); w.y = pack_u8x4(gate_q(v1.x), gate_q(v1.y), gate_q(v1.z), gate_q(v1.w));
                        *(u32x2*)(rowp + bj * 128) = w; } }
            return;
        }
#pragma unroll
        for (int ai = 0; ai < 2; ++ai)
#pragma unroll
            for (int m = 0; m < 4; ++m) { bf16_t* rowp = base + (size_t)(row0 + ai * 128 + m * 16) * ldc + col0;
#pragma unroll
                for (int bj = 0; bj < 2; ++bj) { const pg8::f32x4 v0 = acc[ai][bj][m][0], v1 = acc[ai][bj][m][1];
                    u32x4 w; w.x = cvtpk(v0.x, v0.y); w.y = cvtpk(v0.z, v0.w); w.z = cvtpk(v1.x, v1.y); w.w = cvtpk(v1.z, v1.w);
                    *(u32x4*)(rowp + bj * 128) = w; } }
    }
};
struct EpiGate {
    static constexpr bool PERM = true, AFTER_DRAIN = false; static constexpr int NSEG = 1;
    unsigned char* Gt;
    __device__ __forceinline__ void operator()(const pg8::f32x4 (&acc)[2][2][4][2], const pg8::Unit& u, int wr, int wc, int fr, int fq) const {
        asm volatile("" : "+v"(fr), "+v"(fq));
        const int row0 = u.pm * 256 + wr * 64 + fr, col0 = u.pn * 256 + wc * 32 + 8 * fq;
#pragma unroll
        for (int ai = 0; ai < 2; ++ai)
#pragma unroll
            for (int m = 0; m < 4; ++m) { unsigned char* rowp = Gt + (size_t)(row0 + ai * 128 + m * 16) * 3072 + col0;
#pragma unroll
                for (int bj = 0; bj < 2; ++bj) { const pg8::f32x4 v0 = acc[ai][bj][m][0], v1 = acc[ai][bj][m][1];
                    u32x2 w; w.x = pack_u8x4(gate_q(v0.x), gate_q(v0.y), gate_q(v0.z), gate_q(v0.w)); w.y = pack_u8x4(gate_q(v1.x), gate_q(v1.y), gate_q(v1.z), gate_q(v1.w));
                    *(u32x2*)(rowp + bj * 128) = w; } }
    }
};
struct EpiMerge {
    static constexpr bool PERM = true, AFTER_DRAIN = false; static constexpr int NSEG = 3;
    unsigned char* Mo; const unsigned char* Gt;
    __device__ __forceinline__ void rescale(pg8::f32x4 (&acc)[2][2][4][2], const pg8::Unit& u, int seg, int wr, int wc, int fr, int fq) const {
        asm volatile("" : "+v"(fr), "+v"(fq));
        const int row0 = u.pm * 256 + wr * 64 + fr, col0 = u.pn * 256 + wc * 32 + 8 * fq;
        const unsigned char* G0 = Gt + seg * 1024 + col0;
#pragma unroll
        for (int ai = 0; ai < 2; ++ai)
#pragma unroll
            for (int mh = 0; mh < 2; ++mh) {
                u32x2 ga[2][2], gb[2][2];
#pragma unroll
                for (int mm = 0; mm < 2; ++mm)
#pragma unroll
                    for (int bj = 0; bj < 2; ++bj) { const size_t row = (size_t)(row0 + ai * 128 + (2 * mh + mm) * 16);
                        ga[mm][bj] = *(const u32x2*)(G0 + row * 3072 + bj * 128); gb[mm][bj] = *(const u32x2*)(G0 + row * 3072 + 1024 + bj * 128); }
                __builtin_amdgcn_sched_barrier(0);
#pragma unroll
                for (int mm = 0; mm < 2; ++mm)
#pragma unroll
                    for (int bj = 0; bj < 2; ++bj) { const u32x2 a = ga[mm][bj], b = gb[mm][bj]; pg8::f32x4& v0 = acc[ai][bj][2 * mh + mm][0]; pg8::f32x4& v1 = acc[ai][bj][2 * mh + mm][1];
                        v0.x *= gq(a.x, 0) * fast_rcp(gq(b.x, 0)); v0.y *= gq(a.x, 1) * fast_rcp(gq(b.x, 1)); v0.z *= gq(a.x, 2) * fast_rcp(gq(b.x, 2)); v0.w *= gq(a.x, 3) * fast_rcp(gq(b.x, 3));
                        v1.x *= gq(a.y, 0) * fast_rcp(gq(b.y, 0)); v1.y *= gq(a.y, 1) * fast_rcp(gq(b.y, 1)); v1.z *= gq(a.y, 2) * fast_rcp(gq(b.y, 2)); v1.w *= gq(a.y, 3) * fast_rcp(gq(b.y, 3)); }
                __builtin_amdgcn_sched_barrier(0);
            }
    }
    __device__ __forceinline__ void operator()(const pg8::f32x4 (&acc)[2][2][4][2], const pg8::Unit& u, int wr, int wc, int fr, int fq) const {
        asm volatile("" : "+v"(fr), "+v"(fq));
        const int row0 = u.pm * 256 + wr * 64 + fr, col0 = u.pn * 256 + wc * 32 + 8 * fq;
        constexpr float S = 16.f / 256.f;
#pragma unroll
        for (int ai = 0; ai < 2; ++ai) {
            u32x2 gv[4][2];
#pragma unroll
            for (int m = 0; m < 4; ++m)
#pragma unroll
                for (int bj = 0; bj < 2; ++bj) gv[m][bj] = *(const u32x2*)(Gt + (size_t)(row0 + ai * 128 + m * 16) * 3072 + 2048 + col0 + bj * 128);
            __builtin_amdgcn_sched_barrier(0);
#pragma unroll
            for (int m = 0; m < 4; ++m)
#pragma unroll
                for (int bj = 0; bj < 2; ++bj) { const pg8::f32x4 v0 = acc[ai][bj][m][0], v1 = acc[ai][bj][m][1]; const u32x2 g = gv[m][bj];
                    u32x2 w; w.x = cvt4_fp8(v0.x * (gq(g.x, 0) * S), v0.y * (gq(g.x, 1) * S), v0.z * (gq(g.x, 2) * S), v0.w * (gq(g.x, 3) * S));
                    w.y = cvt4_fp8(v1.x * (gq(g.y, 0) * S), v1.y * (gq(g.y, 1) * S), v1.z * (gq(g.y, 2) * S), v1.w * (gq(g.y, 3) * S));
                    *(u32x2*)(Mo + (size_t)(row0 + ai * 128 + m * 16) * 1024 + col0 + bj * 128) = w; }
            __builtin_amdgcn_sched_barrier(0);
        }
    }
};
struct EpiOut {
    static constexpr bool PERM = true, AFTER_DRAIN = false; static constexpr int NSEG = 1;
    const float* xsL; const float* xsC; float* xdL; float* xdC; const float* MODl;
    __device__ __forceinline__ void operator()(const pg8::f32x4 (&acc)[2][2][4][2], const pg8::Unit& u, int wr, int wc, int fr, int fq) const {
        asm volatile("" : "+v"(fr), "+v"(fq));
        const int trow = u.pm * 256; const bool lat = trow < TL;
        const int row0 = trow + wr * 64 + fr, col0 = u.pn * 256 + wc * 32 + 8 * fq;
        const float* md = MODl + (size_t)mod_row(trow) * DIN + 2 * 1024 + col0;
        const float* xs = lat ? xsL + (size_t)row0 * D + col0 : xsC + (size_t)(row0 - TL) * D + col0; float* xd = lat ? xdL + (size_t)row0 * D + col0 : xdC + (size_t)(row0 - TL) * D + col0;
        f32x4 mv[2][2];
#pragma unroll
        for (int bj = 0; bj < 2; ++bj)
#pragma unroll
            for (int n = 0; n < 2; ++n) mv[bj][n] = *(const f32x4*)(md + bj * 128 + 4 * n);
#pragma unroll
        for (int ai = 0; ai < 2; ++ai)
#pragma unroll
            for (int mh = 0; mh < 2; ++mh) {
                f32x4 xv[2][2][2];
#pragma unroll
                for (int mm = 0; mm < 2; ++mm)
#pragma unroll
                    for (int bj = 0; bj < 2; ++bj)
#pragma unroll
                        for (int n = 0; n < 2; ++n) xv[mm][bj][n] = *(const f32x4*)(xs + (size_t)(ai * 128 + (2 * mh + mm) * 16) * D + bj * 128 + 4 * n);
                __builtin_amdgcn_sched_barrier(0);
#pragma unroll
                for (int mm = 0; mm < 2; ++mm)
#pragma unroll
                    for (int bj = 0; bj < 2; ++bj)
#pragma unroll
                        for (int n = 0; n < 2; ++n) { const pg8::f32x4 av = acc[ai][bj][2 * mh + mm][n]; const f32x4 x4 = xv[mm][bj][n], m4 = mv[bj][n];
                            f32x4 o; o.x = fmaf(m4.x, av.x, x4.x); o.y = fmaf(m4.y, av.y, x4.y); o.z = fmaf(m4.z, av.z, x4.z); o.w = fmaf(m4.w, av.w, x4.w);
                            *(f32x4*)(xd + (size_t)(ai * 128 + (2 * mh + mm) * 16) * D + bj * 128 + 4 * n) = o; }
                __builtin_amdgcn_sched_barrier(0);
            }
    }
};
struct EpiMoe1 {
    static constexpr bool PERM = true, AFTER_DRAIN = false; static constexpr int NSEG = 1;
    unsigned char* HM;
    __device__ __forceinline__ void operator()(const pg8::f32x4 (&acc)[2][2][4][2], const pg8::Unit& u, int wr, int wc, int fr, int fq) const {
        asm volatile("" : "+v"(fr), "+v"(fq));
        const int row0 = u.pm * 256 + wr * 64 + fr, hcol0 = (u.pn & 3) * 128 + wc * 16 + 4 * fq;
#pragma unroll
        for (int ai = 0; ai < 2; ++ai)
#pragma unroll
            for (int m = 0; m < 4; ++m) { unsigned char* rowp = HM + (size_t)(row0 + ai * 128 + m * 16) * 512 + hcol0;
#pragma unroll
                for (int bj = 0; bj < 2; ++bj) { const pg8::f32x4 x = acc[ai][bj][m][0], y = acc[ai][bj][m][1] * 8.f;
                    *(unsigned*)(rowp + bj * 64) = cvt4_fp8(x.x * sigmoid_f(x.x) * y.x, x.y * sigmoid_f(x.y) * y.y, x.z * sigmoid_f(x.z) * y.z, x.w * sigmoid_f(x.w) * y.w); } }
    }
};
struct EpiMoe2 {
    static constexpr bool PERM = true, AFTER_DRAIN = false; static constexpr int NSEG = 1;
    bf16_t* Fo; const int* erow; const float* eroww; const LAS int* ebase; const LAS int* ecnt;
    __device__ __forceinline__ void operator()(const pg8::f32x4 (&acc)[2][2][4][2], const pg8::Unit& u, int wr, int wc, int fr, int fq) const {
        asm volatile("" : "+v"(fr), "+v"(fq));
        const int e = u.pn >> 2, cnt = __builtin_amdgcn_readfirstlane(ecnt[e]), pos0 = u.pm * 256 - __builtin_amdgcn_readfirstlane(ebase[e]) + wr * 64 + fr, col0 = (u.pn & 3) * 256 + wc * 32 + 8 * fq;
        const int* er = erow + (size_t)e * TT; const float* ew = eroww + (size_t)e * TT;
#pragma unroll
        for (int ai = 0; ai < 2; ++ai) {
            int rm[4]; float wg[4];
#pragma unroll
            for (int m = 0; m < 4; ++m) { const int pos = pos0 + ai * 128 + m * 16; const bool ok = pos < cnt; rm[m] = ok ? er[ok ? pos : 0] : -1; wg[m] = ew[ok ? pos : 0]; }
            __builtin_amdgcn_sched_barrier(0);
#pragma unroll
            for (int m = 0; m < 4; ++m) { const int r1 = rm[m];
                if (r1 >= 0) { const float wgt = wg[m]; bf16_t* rowp = Fo + ((size_t)(r1 & 1) * TT + (r1 >> 1)) * D + col0;
#pragma unroll
                    for (int bj = 0; bj < 2; ++bj) { const pg8::f32x4 v0 = acc[ai][bj][m][0], v1 = acc[ai][bj][m][1];
                        u32x4 w; w.x = cvtpk(v0.x * wgt, v0.y * wgt); w.y = cvtpk(v0.z * wgt, v0.w * wgt); w.z = cvtpk(v1.x * wgt, v1.y * wgt); w.w = cvtpk(v1.z * wgt, v1.w * wgt);
                        *(u32x4*)(rowp + bj * 128) = w; } } }
            __builtin_amdgcn_sched_barrier(0);
        }
    }
};
struct FusedOutOrder {
    int c, G, nun, wv; const unsigned* ready; unsigned* tmo;
    __device__ __forceinline__ bool next(int i, pg8::Unit& u) const {
        int q;
        if (!ready) { q = i * G + c; if (q >= nun) return false; }
        else if (G == 256 && nun == 576) { if (c < 64) { if (i > 0) return false; q = 512 + c; } else { q = i * 192 + (c - 64); if (q >= 512) return false; } }
        else { q = i * G + (G - 1 - c); if (q >= nun) return false; }
        u.pm = q >> 2; u.pn = q & 3; return true; }
    __device__ __forceinline__ void a_ready(const pg8::Unit& u) const {
        if (!ready) return;
        if (wv == 0) {
            const unsigned long long t0 = __builtin_amdgcn_s_memrealtime(); unsigned polls = 0;
            while ((unsigned)__builtin_amdgcn_readfirstlane(__hip_atomic_load(ready + 64 * u.pm, __ATOMIC_RELAXED, __HIP_MEMORY_SCOPE_AGENT)) < 32u) {
                if ((++polls & 255u) == 0u && __builtin_amdgcn_readfirstlane(__hip_atomic_load(tmo, __ATOMIC_RELAXED, __HIP_MEMORY_SCOPE_AGENT)) != 0u) break;
                if (__builtin_amdgcn_s_memrealtime() - t0 > 20000000ull) { if (lane_id() == 0) __hip_atomic_store(tmo, 1u, __ATOMIC_RELAXED, __HIP_MEMORY_SCOPE_AGENT); break; }
                __builtin_amdgcn_s_sleep(2); }
            __builtin_amdgcn_fence(__ATOMIC_ACQUIRE, "agent");
            asm volatile("s_waitcnt vmcnt(0)" ::: "memory");
        }
        asm volatile("" ::: "memory"); __builtin_amdgcn_s_barrier(); asm volatile("" ::: "memory");
    }
    __device__ __forceinline__ void done(const pg8::Unit&) const {}
};
struct LastInProjOrder {
    pg8::StaticOrder T; int nlat, G, c;
    __device__ __forceinline__ bool next(int i, pg8::Unit& u) const {
        const int L = i * G + c;
        if (L < nlat) return T.next(i, u);
        const int r = L - nlat; if (r >= 32) return false;
        u.pm = 128 + (r >> 1); u.pn = (r & 1) ? 11 : 2; return true; }
    __device__ __forceinline__ void a_ready(const pg8::Unit&) const {}
    __device__ __forceinline__ void done(const pg8::Unit&) const {}
};
struct MoeOrder {
    int nunits, G, c; const LAS int* tile_e;
    __device__ __forceinline__ bool next(int i, pg8::Unit& u) const {
        const int L0 = i * G + c; if (L0 >= nunits) return false;
        const int q = nunits / 8, r = nunits % 8, xcd = L0 % 8, off = L0 / 8; const int L = (xcd < r ? xcd * (q + 1) : r * (q + 1) + (xcd - r) * q) + off;
        const int pm = L >> 2; u.pm = pm; u.pn = __builtin_amdgcn_readfirstlane(tile_e[pm]) * 4 + (L & 3); return true; }
    __device__ __forceinline__ void a_ready(const pg8::Unit&) const {}
    __device__ __forceinline__ void done(const pg8::Unit&) const {}
};

__device__ __forceinline__ int moe_tables(const Fr& F, const Args& a, int l, LAS int* ebase  , LAS int* ecnt  , LAS int* tile_e  ) {
    const unsigned* CNT = (const unsigned*)(a.ws + WS_CTL) + CW_CNT + l * 256;
    __syncthreads();
    if (F.tid == 0) { int acc = 0;
#pragma unroll 1
        for (int e = 0; e < NE; ++e) { const int c = (int)__hip_atomic_load(&CNT[e * 16], __ATOMIC_RELAXED, __HIP_MEMORY_SCOPE_AGENT); ecnt[e] = c; ebase[e] = acc; const int nt = (c + 255) >> 8;
#pragma unroll 1
            for (int t = 0; t < nt; ++t) tile_e[(acc >> 8) + t] = e;
            acc += nt << 8; }
        ebase[NE] = acc; }
    __syncthreads();
    return ebase[NE] >> 8;
}

__device__ __forceinline__ void moe_gather_table(const Fr& F, const Args& a, const MoeOrder& S, const LAS int* ebase, const LAS int* ecnt, LAS int* gidx) {
    const int* EROW = (const int*)(a.ws + WS_EROW);
    for (int j = 0; j < 16; ++j) { pg8::Unit u; if (!S.next(j, u)) break;
        const int e = u.pn >> 2, pos0 = u.pm * 256 - ebase[e], cnt = ecnt[e];
        if (F.tid < 256) { const int pos = pos0 + F.tid; gidx[j * 256 + F.tid] = pos < cnt ? (EROW[(size_t)e * TT + pos] >> 1) : 0; } }
    __syncthreads();
}

#ifndef MK_PER_PHASE
#define MK_PER_PHASE 0
#endif
constexpr int PH_PER_LAYER = 10, PH_FINAL = 1 + NL * PH_PER_LAYER, N_PHASES = PH_FINAL + 1;

__global__ void __launch_bounds__(NTHR, 2) trunk_fwd(Args args) {
    extern __shared__ __attribute__((aligned(16))) unsigned char lds[];
    Fr F; F.lds = (LAS unsigned char*)lds; F.tid = threadIdx.x; F.lane = F.tid & 63; F.wave = __builtin_amdgcn_readfirstlane(F.tid >> 6); F.G = gridDim.x; F.bid = blockIdx.x;
    const int wave0 = F.wave;
    for (int u = F.tid; u < (LDS_BYTES - MISC_OFF) / 4; u += NTHR) ((LAS unsigned*)(F.lds + MISC_OFF))[u] = 0u;
    __syncthreads();
    const int lo = args.ph_lo, hi = args.ph_hi;
    unsigned* ctl = (unsigned*)(args.ws + WS_CTL);
    XcdBarrier bar; bar.bar = ctl + CW_BAR; bar.x = 0; bar.st = (volatile LAS unsigned*)(F.lds + MISC_OFF);
    if (hi - lo > 1) bar = xcd_barrier_post(ctl + CW_BAR, (volatile LAS unsigned*)(F.lds + MISC_OFF));
    bar.wv = (unsigned)wave0;
#ifndef DBG_ONLY
#define DBG_ONLY -1
#endif
#define SEL(p) (DBG_ONLY < 0 || DBG_ONLY == (p))
#define IN(k) (lo <= (k) && (k) < hi)
#define FRESH() do { int t_ = wave0 * 64 + lane_id(); asm volatile("" : "+v"(t_)); F.tid = t_; F.lane = t_ & 63; F.wave = wave0; } while (0)
#define SEAM(k) do { if (IN(k) && IN((k) + 1)) xcd_barrier(bar); } while (0)
#if !defined(PROBE_SUB)
#define PROBE_SUB -1
#endif
    unsigned long long pr_sub = 0ull;
#if defined(PROBE_P)
    unsigned long long pr_acc = 0ull, pr_t0 = __builtin_amdgcn_s_memrealtime();
#define PR_MARK(p) do { const unsigned long long t_ = __builtin_amdgcn_s_memrealtime(); if ((p) == PROBE_P) pr_acc += t_ - pr_t0; pr_t0 = t_; } while (0)
#else
#define PR_MARK(p) do { } while (0)
#endif
    unsigned char* ws = args.ws;
    LAS int* ebase = (LAS int*)(F.lds + MISC_OFF + 64); LAS int* ecnt = ebase + 20; LAS int* tile_e = (LAS int*)(F.lds + MISC_OFF + 512);

    #ifndef DBG_PRO
#define DBG_PRO 7
#endif
    if (SEL(100) && IN(0)) { FRESH(); if (DBG_PRO & 1) pro_mod(F, args); __syncthreads(); if (DBG_PRO & 2) pro_rope(F, args); if (DBG_PRO & 4) pro_filter(F, args); __syncthreads(); }
    SEAM(0); PR_MARK(100);
    for (int l = 0; l < NL; ++l) {
        const int pb = 1 + PH_PER_LAYER * l;
#define LVARS() int lq_ = l; asm volatile("" : "+s"(lq_)); const bool uc = lq_ < NL - 1; const int M2 = uc ? TT : TL; (void)M2; (void)uc
        if (SEL(0) && IN(pb + 0)) { LVARS(); FRESH(); if (l == 0) filter_norm_reduce(F, args); conv_small_weights(F, args, l, 7, 0); rows_p0(F, args, l, TT); __syncthreads(); }
        SEAM(pb + 0); PR_MARK(0);
        if (SEL(1) && IN(pb + 1)) { LVARS();
            pg8::Gemm g{(const bf16_t*)(ws + WS_H8), (const bf16_t*)(ws + WS_WG8), TT, DIN, 512}; EpiInProj E{ws, 0};
            if (uc) { pg8::StaticOrder S; S.init(TT, DIN, F.G, F.bid); pg8::gemm_phase<EpiInProj, pg8::StaticOrder, true, true, false, true, -6>(F.lds, g, S, E, wave0); }
            else { LastInProjOrder S; S.T.init(TL, DIN, F.G, F.bid); S.nlat = (TL / 256) * (DIN / 256); S.G = F.G; S.c = F.bid; pg8::gemm_phase<EpiInProj, LastInProjOrder, true, true, false, true, -6>(F.lds, g, S, E, wave0); }
        }
        SEAM(pb + 1); PR_MARK(1);
        if (SEL(2) && IN(pb + 2)) { LVARS(); FRESH(); prep_phase(F, args, l, uc); }
        SEAM(pb + 2); PR_MARK(2);
        if (SEL(3) && IN(pb + 3)) { LVARS(); FRESH(); mixer_phase(F, args, l, uc, pr_sub, PROBE_SUB); }
        SEAM(pb + 3); PR_MARK(3);
        if (SEL(4) && IN(pb + 4)) { LVARS(); FRESH(); hyena_final_phase(F, args, l, uc); }
        SEAM(pb + 4); PR_MARK(4);
        if (SEL(5) && IN(pb + 5)) { LVARS();
            pg8::StaticOrder S; S.init(M2, 1024, F.G, F.bid);
            pg8::Gemm g{(const bf16_t*)(ws + WS_Y8), (const bf16_t*)(ws + WS_WBR), M2, 1024, 768}; EpiMerge E{ws + WS_H, (const unsigned char*)(ws + WS_G)};
            pg8::gemm_phase<EpiMerge, pg8::StaticOrder, true, true, false, true, -10>(F.lds, g, S, E, wave0);
            { FRESH(); __syncthreads(); const int nun = (M2 / 256) * 4, rem = nun % F.G; conv_expert_weights(F, args, l, rem, 0, CONV_E_ITEMS); __syncthreads(); }
        }
        SEAM(pb + 5); PR_MARK(5);
        if (SEL(6) && IN(pb + 6)) { LVARS();
            pg8::Gemm g{(const bf16_t*)(ws + WS_H), (const bf16_t*)(ws + WS_WOUT), M2, 1024, 512}; pg8::StaticOrder S; S.init(M2, 1024, F.G, F.bid);
            EpiOut E{l == 0 ? args.in[I_X] : args.out, l == 0 ? args.in[I_CTX] : (const float*)(ws + WS_XC), args.out, (float*)(ws + WS_XC), (const float*)(ws + WS_MOD) + (size_t)l * NBM * DIN};
            pg8::gemm_phase<EpiOut, pg8::StaticOrder, true, true, false, true, -10>(F.lds, g, S, E, wave0);
        }
        SEAM(pb + 6); PR_MARK(6);
        if (SEL(7) && IN(pb + 7)) { LVARS(); FRESH(); rows_p5(F, args, l, M2, pr_sub, PROBE_SUB); __syncthreads(); }
        SEAM(pb + 7); PR_MARK(7);
        if (SEL(8) && IN(pb + 8)) { LVARS(); FRESH();
            const int ntile = moe_tables(F, args, l, ebase, ecnt, tile_e);
            pg8::Gemm g{(const bf16_t*)(ws + WS_H), (const bf16_t*)(ws + WS_W13), ntile * 256, NE * 1024, 512}; MoeOrder S{ntile * 4, F.G, F.bid, tile_e};
            LAS int* gidx = (LAS int*)(F.lds + 131072);
            moe_gather_table(F, args, S, ebase, ecnt, gidx);
            EpiMoe1 E{ws + WS_U};
            pg8::gemm_phase<EpiMoe1, MoeOrder, true, true, true, true, -6>(F.lds, g, S, E, wave0, gidx);
        }
        SEAM(pb + 8); PR_MARK(8);
        if (SEL(9) && IN(pb + 9)) { LVARS(); FRESH();
            const int ntile = moe_tables(F, args, l, ebase, ecnt, tile_e);
            pg8::Gemm g{(const bf16_t*)(ws + WS_U), (const bf16_t*)(ws + WS_W2), ntile * 256, NE * 1024, 256}; MoeOrder S{ntile * 4, F.G, F.bid, tile_e};
            EpiMoe2 E{(bf16_t*)(ws + WS_F), (const int*)(ws + WS_EROW), (const float*)(ws + WS_EROWW), ebase, ecnt};
            pg8::gemm_phase<EpiMoe2, MoeOrder, true, true, false, true, -9>(F.lds, g, S, E, wave0);
        }
        SEAM(pb + 9); PR_MARK(9);
    }
    if (SEL(101) && IN(PH_FINAL)) { FRESH(); rows_final(F, args); }
#if defined(PROBE_P)
    PR_MARK(101);
    pr_acc += pr_sub;
    if (blockIdx.x == 0 && F.wave == 0) { const unsigned long long t1 = __builtin_amdgcn_s_memrealtime() + 4ull * pr_acc; while (__builtin_amdgcn_s_memrealtime() < t1) __builtin_amdgcn_s_sleep(8); }
#endif
#undef IN
#undef SEAM
}

extern "C" void kernel_launch(void* const* d_in, const int* in_sizes, int n_in, void* d_out, int out_size, void* d_ws, size_t ws_size, hipStream_t stream) {
    static int grid = 0;
    if (grid == 0) {
        if (n_in != 29 || in_sizes[0] != TL * D || out_size != TL * D || ws_size < WS_END) { fprintf(stderr, "kernel_launch: unexpected shapes / workspace (n_in %d, ws %zu < %zu); nothing launched\n", n_in, ws_size, (size_t)WS_END); grid = -1; return; }
        int dev = 0, cus = 0, per_cu = 0;
        if (hipGetDevice(&dev) != hipSuccess || hipDeviceGetAttribute(&cus, hipDeviceAttributeMultiprocessorCount, dev) != hipSuccess) { grid = -1; return; }
        if (hipFuncSetAttribute((const void*)trunk_fwd, hipFuncAttributeMaxDynamicSharedMemorySize, LDS_BYTES) != hipSuccess) { fprintf(stderr, "kernel_launch: hipFuncSetAttribute failed\n"); grid = -1; return; }
        if (hipOccupancyMaxActiveBlocksPerMultiprocessor(&per_cu, (const void*)trunk_fwd, NTHR, LDS_BYTES) != hipSuccess || per_cu < 1) { fprintf(stderr, "kernel_launch: occupancy query reports %d\n", per_cu); }
        (void)hipGetLastError();
        grid = cus;
    }
    if (grid < 0) return;
    (void)hipMemsetAsync((char*)d_ws + WS_CTL, 0, CTL_ZERO_BYTES, stream);
    Args a{};
    for (int i = 0; i < 29; ++i) a.in[i] = (const float*)d_in[i];
    a.out = (float*)d_out; a.ws = (unsigned char*)d_ws;
#if MK_PER_PHASE
    for (int k = 0; k < N_PHASES; ++k) { a.ph_lo = k; a.ph_hi = k + 1; hipLaunchKernelGGL(trunk_fwd, dim3(grid), dim3(NTHR), LDS_BYTES, stream, a); }
#else
    a.ph_lo = 0; a.ph_hi = N_PHASES;
    hipLaunchKernelGGL(trunk_fwd, dim3(grid), dim3(NTHR), LDS_BYTES, stream, a);
#endif
}
```

```cpp
#include <hip/hip_runtime.h>
#include <cstdio>
#include <cstdint>

#define GAS __attribute__((address_space(1)))
#define LAS __attribute__((address_space(3)))
__device__ __forceinline__ int lane_id() { int l; asm volatile("v_mbcnt_lo_u32_b32 %0, -1, 0\n\tv_mbcnt_hi_u32_b32 %0, -1, %0" : "=v"(l)); return l; }
#define MK_PER_PHASE 0
namespace pg8 {
#define PG8_LAS __attribute__((address_space(3)))
typedef unsigned short bf16_t;
typedef short bf16x8 __attribute__((ext_vector_type(8)));
typedef float f32x4 __attribute__((ext_vector_type(4)));
typedef unsigned u32x4 __attribute__((ext_vector_type(4)));
constexpr int BM = 256, BK = 64, HALF = 128, HTB = HALF * BK * 2  , STAGE_BYTES = 8 * HTB, NXCD = 8, WGM = 8;

__host__ __device__ __forceinline__ int lds_byte(int r, int c) { const int st = (r >> 4) * 2 + (c >> 5), rr = r & 15, cc = c & 31, ob = rr * 64 + cc * 2; return st * 1024 + (ob ^ (((ob >> 9) & 1) << 5)); }
__host__ __device__ __forceinline__ void stage_rc(int b, int& R, int& C) { const int st = b / 1024, sb = b % 1024, swz = sb ^ (((sb >> 9) & 1) << 5); R = (st >> 1) * 16 + swz / 64; C = (st & 1) * 32 + (swz % 64) / 2; }
__host__ __device__ __forceinline__ int perm32(int rho) { const int n = rho >> 4, i = rho & 15; return 8 * (i >> 2) + 4 * n + (i & 3); }

struct Unit { int pm, pn; };
struct Gemm { const bf16_t* A; const bf16_t* Bt; int M, N, K; };

struct StaticOrder {
    int nM, nN, nwg, G, c;
    __host__ __device__ void init(int M, int N, int G_, int c_) { nM = M / BM; nN = N / BM; nwg = nM * nN; G = G_; c = c_; }
    __host__ __device__ bool next(int i, Unit& u) const {
        const long L = (long)i * G + c; if (L >= nwg) return false;
        int wgid = (int)L; { const int q = nwg / NXCD, r = nwg % NXCD, xcd = wgid % NXCD, off = wgid / NXCD; wgid = (xcd < r ? xcd * (q + 1) : r * (q + 1) + (xcd - r) * q) + off; }
        const int nig = WGM * nN, gid = wgid / nig, fm = gid * WGM, gsz = (nM - fm) < WGM ? (nM - fm) : WGM;
        u.pm = fm + ((wgid % nig) % gsz); u.pn = (wgid % nig) / gsz; return true;
    }
    __device__ __forceinline__ void a_ready(const Unit&) const {}
    __device__ __forceinline__ void done(const Unit&) const {}
};
__device__ __forceinline__ unsigned cvt_pk_bf16(float lo, float hi) { unsigned r; asm volatile("v_cvt_pk_bf16_f32 %0, %1, %2" : "=v"(r) : "v"(lo), "v"(hi)); return r; }
typedef float f32x2 __attribute__((ext_vector_type(2)));
template <class Epi, class Sched, bool ALIGN_EPI = false, bool SP2 = false, bool GATHER = false, bool F8 = false, int F8_SW = 0>
__device__ __forceinline__ void gemm_phase(PG8_LAS unsigned char* lds, const Gemm g, const Sched& S, const Epi& E, const int wave_id, const PG8_LAS int* gidx = nullptr) {
    static_assert(!GATHER || SP2, "GATHER is implemented for the SP2 loop only");
    int tid_ = wave_id * 64 + lane_id(); asm volatile("" : "+v"(tid_));
    const int tid = tid_, wid = __builtin_amdgcn_readfirstlane(tid >> 6), lane = tid & 63, wr = wid >> 2, wc = wid & 3, fr = lane & 15, fq = lane >> 4;
    const int K = g.K, nt = K / BK;
    unsigned voffA[2], voffB[2];
#pragma unroll
    for (int i = 0; i < 2; ++i) { int R, C; stage_rc(tid * 16 + i * 8192, R, C); const int Rb = Epi::PERM ? ((R & ~31) + perm32(R & 31)) : R;
        voffA[i] = (unsigned)(R * K + C) * 2u; voffB[i] = (unsigned)(Rb * K + C) * 2u; }
    unsigned goffA[2][2], goffN[2][2];
#define PG8_GOFF(dst, j) do { _Pragma("unroll") for (int _h = 0; _h < 2; ++_h) _Pragma("unroll") for (int _i = 0; _i < 2; ++_i) { int R_, C_; stage_rc(tid * 16 + _i * 8192, R_, C_); \
        dst[_h][_i] = ((unsigned)gidx[(j) * 256 + _h * 128 + R_] * (unsigned)K + (unsigned)C_) * 2u; } } while (0)
#define PG8_STAGE_A(bufoff, base, h, nx) do { if constexpr (GATHER) { unsigned o_[2] = {(nx) ? goffN[h][0] : goffA[h][0], (nx) ? goffN[h][1] : goffA[h][1]}; PG8_STAGE(bufoff, base, o_); } \
        else { PG8_STAGE(bufoff, (base) + ((h) ? hstep : 0), voffA); } } while (0)
    const size_t kstep = (size_t)(BK * 2);
    const size_t hstep = (size_t)HALF * K * 2;
    const size_t tstep = 2 * hstep;
    const unsigned ldsw = (unsigned)wid * 1024u;
    const int aoff = lds_byte(wr * 64 + fr, fq * 8), boff = lds_byte(wc * 32 + fr, fq * 8);
#define PG8_SA(b, h) (((b) * 2 + (h)) * HTB)
#define PG8_SB(b, h) ((4 + (b) * 2 + (h)) * HTB)
#define PG8_STAGE(bufoff, gbase, voff) do { _Pragma("unroll") for (int _i = 0; _i < 2; ++_i) \
        __builtin_amdgcn_global_load_lds((const unsigned*)((const char*)(gbase) + (voff)[_i]), (PG8_LAS unsigned*)(lds + (bufoff) + ldsw + _i * 8192), 16, 0, 0); } while (0)
#define PG8_LDA(dst, b, h) do { _Pragma("unroll") for (int m = 0; m < 4; ++m) _Pragma("unroll") for (int k = 0; k < 2; ++k) dst[m][k] = *(const PG8_LAS bf16x8*)(lds + PG8_SA(b, h) + aoff + m * 2048 + k * 1024); } while (0)
#define PG8_LDB(dst, b, h) do { _Pragma("unroll") for (int n = 0; n < 2; ++n) _Pragma("unroll") for (int k = 0; k < 2; ++k) dst[n][k] = *(const PG8_LAS bf16x8*)(lds + PG8_SB(b, h) + boff + n * 2048 + k * 1024); } while (0)
#define PG8_MMA(ai, bj, At, Bt) do { if constexpr (F8) __builtin_amdgcn_sched_barrier(0); __builtin_amdgcn_s_setprio(1); _Pragma("unroll") for (int m = 0; m < 4; ++m) _Pragma("unroll") for (int n = 0; n < 2; ++n) { \
        if constexpr (F8) { typedef int i32x4_ __attribute__((ext_vector_type(4))); typedef int i32x8_ __attribute__((ext_vector_type(8))); \
            const i32x8_ wf = __builtin_shufflevector(__builtin_bit_cast(i32x4_, Bt[n][0]), __builtin_bit_cast(i32x4_, Bt[n][1]), 0, 1, 2, 3, 4, 5, 6, 7); \
            const i32x8_ af = __builtin_shufflevector(__builtin_bit_cast(i32x4_, At[m][0]), __builtin_bit_cast(i32x4_, At[m][1]), 0, 1, 2, 3, 4, 5, 6, 7); \
              \
            asm volatile("v_mfma_scale_f32_16x16x128_f8f6f4 %0, %1, %2, %0, %3, %4 op_sel_hi:[0,0,0]" : "+v"(acc[ai][bj][m][n]) : "v"(wf), "v"(af), "v"(f8sw), "v"(f8sa)); } \
        else { _Pragma("unroll") for (int k = 0; k < 2; ++k) acc[ai][bj][m][n] = __builtin_amdgcn_mfma_f32_16x16x32_bf16(Bt[n][k], At[m][k], acc[ai][bj][m][n], 0, 0, 0); } } \
        __builtin_amdgcn_s_setprio(0); if constexpr (F8) __builtin_amdgcn_sched_barrier(0); } while (0)
#define PG8_WAIT_V(n) asm volatile("s_waitcnt vmcnt(" #n ")" ::: "memory")
#define PG8_WAIT_L(n) asm volatile("s_waitcnt lgkmcnt(" #n ")" ::: "memory")
#define PG8_BAR __builtin_amdgcn_s_barrier()
#define PG8_SCHED __builtin_amdgcn_sched_barrier(0)
    const int f8sw = 127 + F8_SW, f8sa = 127; (void)f8sw; (void)f8sa;
    Unit cur, nxt; int ui = 0;
    if (!S.next(0, cur)) return;
    f32x4 acc[2][2][4][2];
#pragma unroll
    for (int a = 0; a < 2; ++a)
#pragma unroll
        for (int b = 0; b < 2; ++b)
#pragma unroll
            for (int m = 0; m < 4; ++m)
#pragma unroll
                for (int n = 0; n < 2; ++n) acc[a][b][m][n] = (f32x4){0.f, 0.f, 0.f, 0.f};
    bf16x8 At[4][2], B0[2][2], B1[2][2];
    const char* cA = GATHER ? (const char*)g.A : (const char*)g.A + (size_t)cur.pm * tstep; const char* cB = (const char*)g.Bt + (size_t)cur.pn * tstep;
    if constexpr (GATHER) PG8_GOFF(goffA, 0);
    S.a_ready(cur);
    if constexpr (SP2) {
        PG8_STAGE(PG8_SB(0, 0), cB, voffB); PG8_STAGE(PG8_SB(0, 1), cB + hstep, voffB); PG8_STAGE_A(PG8_SA(0, 0), cA, 0, false); PG8_STAGE_A(PG8_SA(0, 1), cA, 1, false);
        if (wr == 1) PG8_BAR;
        PG8_WAIT_V(2); PG8_BAR;
        PG8_STAGE(PG8_SB(1, 0), cB + kstep, voffB); PG8_STAGE_A(PG8_SA(1, 0), cA + kstep, 0, false); PG8_STAGE(PG8_SB(1, 1), cB + hstep + kstep, voffB);
        PG8_WAIT_V(6); PG8_BAR;
    } else {
        PG8_STAGE(PG8_SB(0, 0), cB, voffB); PG8_STAGE(PG8_SA(0, 0), cA, voffA); PG8_STAGE(PG8_SB(0, 1), cB + hstep, voffB); PG8_STAGE(PG8_SA(0, 1), cA + hstep, voffA);
        if (wr == 1) PG8_BAR;
        PG8_WAIT_V(4); PG8_BAR;
        PG8_STAGE(PG8_SB(1, 0), cB + kstep, voffB); PG8_STAGE(PG8_SA(1, 0), cA + kstep, voffA); PG8_STAGE(PG8_SB(1, 1), cB + hstep + kstep, voffB);
        PG8_WAIT_V(6); PG8_BAR;
    }
    for (;;) {
        const bool has_next = S.next(ui + 1, nxt);
        if constexpr (GATHER) { if (has_next) PG8_GOFF(goffN, ui + 1); else { _Pragma("unroll") for (int _h = 0; _h < 2; ++_h) _Pragma("unroll") for (int _i = 0; _i < 2; ++_i) goffN[_h][_i] = goffA[_h][_i]; } }
        const char* nA = GATHER ? (const char*)g.A : has_next ? (const char*)g.A + (size_t)nxt.pm * tstep : cA; const char* nB = has_next ? (const char*)g.Bt + (size_t)nxt.pn * tstep : cB;
        for (int t = 0; t < nt; t += 2) {
            const bool last = (t == nt - 2);
            const char* a1 = cA + (size_t)(t + 1) * kstep;
            const char* a2 = last ? nA : cA + (size_t)(t + 2) * kstep; const char* b2 = last ? nB : cB + (size_t)(t + 2) * kstep;
            const char* a3 = a2 + kstep; const char* b3 = b2 + kstep;
            if (last && has_next) S.a_ready(nxt);
            if constexpr (SP2) {
            PG8_LDB(B0, 0, 0); PG8_LDB(B1, 0, 1); PG8_SCHED; PG8_LDA(At, 0, 0); PG8_STAGE_A(PG8_SA(1, 1), a1, 1, false);
            PG8_WAIT_V(8); PG8_WAIT_L(0); PG8_BAR; PG8_MMA(0, 0, At, B0); PG8_MMA(0, 1, At, B1); PG8_BAR; PG8_SCHED;
            PG8_LDA(At, 0, 1); PG8_STAGE(PG8_SB(0, 0), b2, voffB); PG8_STAGE(PG8_SB(0, 1), b2 + hstep, voffB); PG8_STAGE_A(PG8_SA(0, 0), a2, 0, last);
            PG8_WAIT_V(8); PG8_WAIT_L(0); PG8_BAR; PG8_MMA(1, 0, At, B0); PG8_MMA(1, 1, At, B1); PG8_BAR; PG8_SCHED;
            PG8_LDB(B0, 1, 0); PG8_LDB(B1, 1, 1); PG8_SCHED; PG8_LDA(At, 1, 0); PG8_STAGE_A(PG8_SA(0, 1), a2, 1, last);
            PG8_WAIT_V(8); PG8_WAIT_L(0); PG8_BAR; PG8_MMA(0, 0, At, B0); PG8_MMA(0, 1, At, B1); PG8_BAR; PG8_SCHED;
            PG8_LDA(At, 1, 1); PG8_STAGE(PG8_SB(1, 0), b3, voffB); PG8_STAGE(PG8_SB(1, 1), b3 + hstep, voffB); PG8_STAGE_A(PG8_SA(1, 0), a3, 0, last);
            PG8_WAIT_V(8); PG8_WAIT_L(0); PG8_BAR; PG8_MMA(1, 0, At, B0); PG8_MMA(1, 1, At, B1); PG8_BAR; PG8_SCHED;
            if constexpr (Epi::NSEG > 1) {
                constexpr int SEGT = F8 ? 4 : 8;
                if (t + 2 < nt && ((t + 2) & (SEGT - 1)) == 0) { if constexpr (F8) asm volatile("s_nop 15\n\ts_nop 15" ::: "memory"); E.rescale(acc, cur, (t + 2) / SEGT - 1, wr, wc, fr, fq); }
            }
            } else {
            PG8_LDB(B0, 0, 0); PG8_SCHED; PG8_LDA(At, 0, 0); PG8_STAGE(PG8_SA(1, 1), a1 + hstep, voffA);
            PG8_WAIT_L(8); PG8_BAR; PG8_WAIT_L(0); PG8_MMA(0, 0, At, B0); PG8_BAR; PG8_SCHED;
            PG8_LDB(B1, 0, 1); PG8_STAGE(PG8_SB(0, 0), b2, voffB);
            PG8_BAR; PG8_WAIT_L(0); PG8_MMA(0, 1, At, B1); PG8_BAR;
            PG8_LDA(At, 0, 1); PG8_STAGE(PG8_SA(0, 0), a2, voffA);
            PG8_BAR; PG8_WAIT_L(0); PG8_MMA(1, 0, At, B0); PG8_BAR; PG8_SCHED;
            PG8_STAGE(PG8_SB(0, 1), b2 + hstep, voffB);
            PG8_WAIT_V(6); PG8_BAR; PG8_MMA(1, 1, At, B1); PG8_BAR;
            PG8_LDB(B0, 1, 0); PG8_SCHED; PG8_LDA(At, 1, 0); PG8_STAGE(PG8_SA(0, 1), a2 + hstep, voffA);
            PG8_WAIT_L(8); PG8_BAR; PG8_WAIT_L(0); PG8_MMA(0, 0, At, B0); PG8_BAR; PG8_SCHED;
            PG8_LDB(B1, 1, 1); PG8_STAGE(PG8_SB(1, 0), b3, voffB);
            PG8_BAR; PG8_WAIT_L(0); PG8_MMA(0, 1, At, B1); PG8_BAR;
            PG8_LDA(At, 1, 1); PG8_STAGE(PG8_SA(1, 0), a3, voffA);
            PG8_BAR; PG8_WAIT_L(0); PG8_MMA(1, 0, At, B0); PG8_BAR; PG8_SCHED;
            PG8_STAGE(PG8_SB(1, 1), b3 + hstep, voffB);
            PG8_WAIT_V(6); PG8_BAR; PG8_MMA(1, 1, At, B1); PG8_BAR;
            }
        }
        if constexpr (ALIGN_EPI) { if (wr == 0) PG8_BAR; }
        if constexpr (F8) asm volatile("s_nop 15\n\ts_nop 15" ::: "memory");
        if constexpr (!Epi::AFTER_DRAIN) { E(acc, cur, wr, wc, fr, fq); S.done(cur); }
        if (!has_next) break;
#pragma unroll
        for (int a = 0; a < 2; ++a)
#pragma unroll
            for (int b = 0; b < 2; ++b)
#pragma unroll
                for (int m = 0; m < 4; ++m)
#pragma unroll
                    for (int n = 0; n < 2; ++n) acc[a][b][m][n] = (f32x4){0.f, 0.f, 0.f, 0.f};
        cur = nxt; cA = nA; cB = nB; ++ui;
        if constexpr (GATHER) { _Pragma("unroll") for (int _h = 0; _h < 2; ++_h) _Pragma("unroll") for (int _i = 0; _i < 2; ++_i) goffA[_h][_i] = goffN[_h][_i]; }
        if constexpr (ALIGN_EPI) { if (wr == 1) PG8_BAR; }
    }
    PG8_WAIT_V(0);
    if constexpr (!ALIGN_EPI) { if (wr == 0) PG8_BAR; }
    PG8_BAR;
    if constexpr (Epi::AFTER_DRAIN) { E.fused(acc, cur, wr, wc, fr, fq, lds, wid, lane); S.done(cur); }
#undef PG8_SA
#undef PG8_SB
#undef PG8_STAGE
#undef PG8_STAGE_A
#undef PG8_GOFF
#undef PG8_LDA
#undef PG8_LDB
#undef PG8_MMA
#undef PG8_WAIT_V
#undef PG8_WAIT_L
#undef PG8_BAR
#undef PG8_SCHED
}
}
#define XB_TMO      128
#define XB_XCNT(j)  (256  + 64 * (j))
#define XB_XSUB(j)  (1280 + 64 * (j))
#define XB_XGEN(j)  (2304 + 64 * (j))
#define XB_TOP      3328
#define XB_TOPGEN   3392
#define XCD_BAR_WORDS 3456
#define XB_SPIN_CAP (1u << 22)
#define LAS __attribute__((address_space(3)))

__device__ __forceinline__ unsigned xb_ld(unsigned* p)              { return __hip_atomic_load(p, __ATOMIC_RELAXED, __HIP_MEMORY_SCOPE_AGENT); }
__device__ __forceinline__ unsigned xb_add(unsigned* p, unsigned v) { asm volatile("" : "+v"(p));
    return __hip_atomic_fetch_add(p, v, __ATOMIC_RELAXED, __HIP_MEMORY_SCOPE_AGENT); }
__device__ __forceinline__ unsigned xb_xcc_id() { return (unsigned)__builtin_amdgcn_s_getreg((3 << 11) | 20) & 0xFu; }
#define XB_SPIN(cond, bar) do { unsigned _sp = 0; while (cond) { __builtin_amdgcn_s_sleep(1); \
    if ((++_sp & 255u) == 0u) { if (xb_ld(&(bar)[XB_TMO])) break; if (_sp > XB_SPIN_CAP) { xb_add(&(bar)[XB_TMO], 1u); break; } } } } while (0)

struct XcdBarrier {
    unsigned* bar; unsigned x; unsigned wv;
    volatile LAS unsigned* st;
};

__device__ __forceinline__ XcdBarrier xcd_barrier_post(unsigned* bar, volatile LAS unsigned* st) {
    XcdBarrier b; b.bar = bar; b.x = xb_xcc_id(); b.st = st;
    if (threadIdx.x == 0) (void)xb_add(&bar[XB_XCNT(b.x)], 1u);
    return b;
}
__device__ __forceinline__ void xcd_barrier_complete(unsigned* bar, unsigned x, unsigned& nloc, unsigned& nx) {
    const unsigned G = gridDim.x * gridDim.y * gridDim.z;
    unsigned sum, cnt, mine, sp = 0u;
    for (;;) {
        sum = 0u; cnt = 0u; mine = 0u;
#pragma unroll
        for (unsigned j = 0; j < 16; ++j) { const unsigned c = xb_ld(&bar[XB_XCNT(j)]); sum += c; cnt += (c > 0u) ? 1u : 0u; mine = (j == x) ? c : mine; }
        if (sum == G) break;
        __builtin_amdgcn_s_sleep(1);
        if ((++sp & 255u) == 0u) { if (xb_ld(&bar[XB_TMO])) break; if (sp > XB_SPIN_CAP) { xb_add(&bar[XB_TMO], 1u); break; } }
    }
    nloc = mine > 0u ? mine : 1u; nx = cnt > 0u ? cnt : 1u;
}

__device__ __forceinline__ void xcd_barrier(const XcdBarrier& b) {
    asm volatile("s_waitcnt vmcnt(0)" ::: "memory");
    __syncthreads();
    if (b.wv == 0u && lane_id() == 0) {
        unsigned* bar = b.bar;
        __builtin_amdgcn_s_waitcnt(0);
        unsigned nloc = b.st[0], nx = b.st[1];
        if (nloc == 0u) { xcd_barrier_complete(bar, b.x, nloc, nx); b.st[0] = nloc; b.st[1] = nx; }
        const unsigned old = xb_add(&bar[XB_XSUB(b.x)], 1u);
        const unsigned gen = old / nloc;
        if (old + 1u == (gen + 1u) * nloc) {
            __builtin_amdgcn_fence(__ATOMIC_RELEASE, "agent");
            asm volatile("s_waitcnt vmcnt(0)" ::: "memory");
            const unsigned og = xb_add(&bar[XB_TOP], 1u);
            const unsigned tg = og / nx;
            if (og + 1u == (tg + 1u) * nx) xb_add(&bar[XB_TOPGEN], 1u);
            else XB_SPIN(xb_ld(&bar[XB_TOPGEN]) == tg, bar);
            __builtin_amdgcn_fence(__ATOMIC_ACQUIRE, "agent");
            xb_add(&bar[XB_XGEN(b.x)], 1u);
            asm volatile("s_waitcnt vmcnt(0)" ::: "memory");
        } else {
            XB_SPIN(xb_ld(&bar[XB_XGEN(b.x)]) == gen, bar);
            __builtin_amdgcn_fence(__ATOMIC_ACQUIRE, "agent");
            asm volatile("s_waitcnt vmcnt(0)" ::: "memory");
        }
    }
    __syncthreads();
}

typedef unsigned short bf16_t;
typedef short bf16x8 __attribute__((ext_vector_type(8)));
typedef float f32x4 __attribute__((ext_vector_type(4)));
typedef float f32x16 __attribute__((ext_vector_type(16)));
typedef unsigned u32x4 __attribute__((ext_vector_type(4)));
typedef unsigned u32x2 __attribute__((ext_vector_type(2)));

constexpr int D = 1024, NB = 16, SEQ = 2048, CTX = 256, NL = 4;
constexpr int TL = NB * SEQ, TC = NB * CTX, TT = TL + TC;
constexpr int DIN = 6144, HYW = 512, NE = 16, DE = 512, KEYS = CTX + SEQ;
constexpr int NMOD = 6, NBM = NB + 1;
constexpr int APROWS = 2 * TT + NE * 256;
constexpr float EPS = 1e-6f, LOG2E = 1.4426950408889634f;
constexpr float QSCALE = 0.125f * LOG2E;

constexpr size_t MiB = 1u << 20;
constexpr size_t WS_CTL = 0, CTL_ZERO_BYTES = 1 * MiB;
constexpr size_t WS_MOD = 1 * MiB;
constexpr size_t WS_ROPE = 3 * MiB;
constexpr size_t WS_FL = 4 * MiB, WS_FC = 20 * MiB;
constexpr size_t WS_MISC = 22 * MiB;
constexpr size_t WS_FNORM = WS_MISC;
constexpr size_t WS_TOKE = WS_MISC + 64 * 1024, WS_TOKP = WS_MISC + 352 * 1024, WS_TOKW = WS_MISC + 640 * 1024;
constexpr size_t WS_ROWMAP = WS_MISC + 960 * 1024, WS_ROWW = WS_MISC + 1280 * 1024;
constexpr size_t WS_WIN = 24 * MiB, WS_WBR = 36 * MiB, WS_WOUT = 39 * MiB;
constexpr size_t WS_XC = 41 * MiB;
constexpr size_t WS_NP = WS_XC;
constexpr size_t WS_H = 57 * MiB;
constexpr size_t WS_KA = 129 * MiB, WS_VTA = 138 * MiB, WS_KW = 147 * MiB, WS_VTW = 156 * MiB;
constexpr size_t WS_QA = 165 * MiB, WS_QW = 201 * MiB, WS_YH = 237 * MiB, WS_VT = 273 * MiB, WS_YT = 309 * MiB;
constexpr size_t WS_RAWA = 309 * MiB, WS_RAWW = 327 * MiB;
constexpr size_t WS_F = 165 * MiB;
constexpr size_t WS_U = 345 * MiB;
constexpr size_t WS_G = 453 * MiB;
constexpr size_t WS_Y8 = 561 * MiB;
constexpr size_t WS_W13 = 621 * MiB, WS_W2 = 637 * MiB;
constexpr size_t WS_EROW = 669 * MiB, WS_EROWW = 672 * MiB;
constexpr size_t WS_H8 = 675 * MiB;
constexpr size_t WS_WG8 = WS_WIN;
constexpr size_t WS_END = 711 * MiB;
static_assert(WS_G + (size_t)TT * 3072 <= WS_Y8 && WS_Y8 + (size_t)TT * 1536 <= WS_W13 && WS_W13 + (size_t)16 * 1024 * 1024 <= WS_W2 && WS_W2 + (size_t)16 * 1024 * 512 <= WS_EROW, "ws map");
static_assert(WS_U + (size_t)APROWS * 1024 <= WS_G && WS_F + (size_t)2 * TT * 2048 <= WS_YT, "ws map 2");
constexpr size_t VT_CTX_OFF = (size_t)HYW * NB * SEQ;

constexpr int CW_BAR = 4096, CW_CNT = 8192, CW_PANEL = 16384, CW_HTMO = 12288;
constexpr int LDS_BYTES = 151552, MISC_OFF = 147456;
constexpr int NWAVES = 8, NTHR = 512;

struct Args { const float* in[29]; float* out; unsigned char* ws; int ph_lo, ph_hi; };
enum { I_X = 0, I_C, I_CTX, I_CCTX, I_ADAW, I_ADAB, I_N1G, I_N2G, I_WIN, I_QKG, I_HSW, I_HSB, I_HW1, I_HB1, I_HFR, I_HW2, I_HB2, I_HW3, I_HBIAS, I_SINK, I_WBR, I_WOUT,
       I_RGW, I_RGB, I_REW, I_REB, I_EW1, I_EW3, I_EW2 };

#define LDS_WAIT() asm volatile("s_waitcnt lgkmcnt(0)" ::: "memory")
#define VM_WAIT() asm volatile("s_waitcnt vmcnt(0)" ::: "memory")

typedef float f32x2_t __attribute__((ext_vector_type(2)));
typedef __bf16 bf16x2_t __attribute__((ext_vector_type(2)));
__device__ __forceinline__ unsigned cvtpk(float lo, float hi) { f32x2_t v = {lo, hi}; bf16x2_t b = __builtin_convertvector(v, bf16x2_t); return __builtin_bit_cast(unsigned, b); }
__device__ __forceinline__ unsigned zero_u32() { unsigned z; asm volatile("v_mov_b32 %0, 0" : "=v"(z)); return z; }
__device__ __forceinline__ float clamp_fp8(float x) { return __builtin_amdgcn_fmed3f(x, -448.f, 448.f); }
__device__ __forceinline__ unsigned cvt4_fp8(float a, float b, float c, float d) { int r = __builtin_amdgcn_cvt_pk_fp8_f32(a, b, 0, false); r = __builtin_amdgcn_cvt_pk_fp8_f32(c, d, r, true); return (unsigned)r; }
__device__ __forceinline__ unsigned cvt4_fp8c(float a, float b, float c, float d) { return cvt4_fp8(clamp_fp8(a), clamp_fp8(b), clamp_fp8(c), clamp_fp8(d)); }
__device__ __forceinline__ float bflo(unsigned u) { return __builtin_bit_cast(float, u << 16); }
__device__ __forceinline__ float bfhi(unsigned u) { return __builtin_bit_cast(float, u & 0xffff0000u); }
__device__ __forceinline__ float bf1(bf16_t u) { return __builtin_bit_cast(float, (unsigned)u << 16); }
__device__ __forceinline__ bf16_t f2bf(float f) { return (bf16_t)(cvtpk(f, 0.f) & 0xffffu); }
#define DPP_F(v, ctrl) __builtin_bit_cast(float, __builtin_amdgcn_update_dpp(0, __builtin_bit_cast(int, (v)), (ctrl), 0xf, 0xf, false))
__device__ __forceinline__ float row16_sum(float v) {
    v += DPP_F(v, 0xB1);
    v += DPP_F(v, 0x4E);
    v += DPP_F(v, 0x141);
    v += DPP_F(v, 0x140);
    return v;
}
__device__ __forceinline__ float wave_sum(float v) {
    v = row16_sum(v);
    const int iv = __builtin_bit_cast(int, v);
    float r = (__builtin_bit_cast(float, __builtin_amdgcn_readlane(iv, 0)) + __builtin_bit_cast(float, __builtin_amdgcn_readlane(iv, 16)))
            + (__builtin_bit_cast(float, __builtin_amdgcn_readlane(iv, 32)) + __builtin_bit_cast(float, __builtin_amdgcn_readlane(iv, 48)));
    asm volatile("" : "+v"(r));
    return r;
}
__device__ __forceinline__ float fast_exp2(float x) { return __builtin_amdgcn_exp2f(x); }
__device__ __forceinline__ float fast_rcp(float x) { return __builtin_amdgcn_rcpf(x); }
__device__ __forceinline__ float sigmoid_f(float x) { return fast_rcp(1.f + fast_exp2(-x * LOG2E)); }

__device__ __forceinline__ void sincos_acc(float x, float& s, float& c) {
    const float q = rintf(x * 0.636619772367581f);
    float y = fmaf(-q, 1.57079625129699707031f, x);
    y = fmaf(-q, 7.54978941586159635335e-08f, y);
    const float y2 = y * y;
    float sp = fmaf(y2, 2.7557314297e-06f, -1.9841270114e-04f); sp = fmaf(sp, y2, 8.3333337680e-03f); sp = fmaf(sp, y2, -1.6666667163e-01f); sp = fmaf(sp * y2, y, y);
    float cp = fmaf(y2, -2.7557314297e-07f, 2.4801587642e-05f); cp = fmaf(cp, y2, -1.3888889225e-03f); cp = fmaf(cp, y2, 4.1666667908e-02f); cp = fmaf(cp, y2, -0.5f); cp = fmaf(cp, y2, 1.0f);
    const int n = (int)q & 3;
    const float s1 = (n & 1) ? cp : sp, c1 = (n & 1) ? sp : cp;
    s = (n & 2) ? -s1 : s1;
    c = ((n + 1) & 2) ? -c1 : c1;
}

struct Fr { LAS unsigned char* lds; int tid, lane, wave, G, bid; };

__device__ __forceinline__ void pro_mod(const Fr& F, const Args& a) {
    LAS float* s = (LAS float*)F.lds;
    LAS float* red = (LAS float*)(F.lds + 69632);
    const float* c = a.in[I_C]; const float* cc = a.in[I_CCTX]; const float* W = a.in[I_ADAW]; const float* Bv = a.in[I_ADAB];
    float* MOD = (float*)(a.ws + WS_MOD);
    for (int i = F.tid; i < NBM * 1024; i += NTHR) { const int bb = i >> 10, k = i & 1023; const float v = (bb < NB) ? c[bb * 1024 + k] : cc[k]; s[i] = v / (1.f + __expf(-v)); }
    __syncthreads();
    const int col = F.tid & 63, ks = F.wave;
    for (int unit = F.G - 1 - F.bid; unit < NL * 96; unit += F.G) {
        const int l = unit / 96, j0 = (unit % 96) * 64;
        float acc[NBM];
#pragma unroll
        for (int bb = 0; bb < NBM; ++bb) acc[bb] = 0.f;
        const float* Wp = W + ((size_t)l * 1024 + ks * 128) * DIN + j0 + col;
#pragma unroll 2
        for (int k = 0; k < 128; k += 4) {
            const float w0 = Wp[(size_t)k * DIN], w1 = Wp[(size_t)(k + 1) * DIN], w2 = Wp[(size_t)(k + 2) * DIN], w3 = Wp[(size_t)(k + 3) * DIN];
#pragma unroll
            for (int bb = 0; bb < NBM; ++bb) { const f32x4 sv = *(const LAS f32x4*)(s + bb * 1024 + ks * 128 + k);
                acc[bb] = fmaf(sv.x, w0, acc[bb]); acc[bb] = fmaf(sv.y, w1, acc[bb]); acc[bb] = fmaf(sv.z, w2, acc[bb]); acc[bb] = fmaf(sv.w, w3, acc[bb]); } }
#pragma unroll
        for (int bb = 0; bb < NBM; ++bb) red[(ks * NBM + bb) * 64 + col] = acc[bb];
        __syncthreads();
        for (int o = F.tid; o < NBM * 64; o += NTHR) { const int bb = o >> 6, cx = o & 63; float sum = 0.f;
#pragma unroll
            for (int k2 = 0; k2 < 8; ++k2) sum += red[(k2 * NBM + bb) * 64 + cx];
            MOD[((size_t)l * NBM + bb) * DIN + j0 + cx] = sum + Bv[l * DIN + j0 + cx]; }
        __syncthreads();
    }
}

__device__ __forceinline__ void pro_rope(const Fr& F, const Args& a) {
    float* ct = (float*)(a.ws + WS_ROPE); float* st = ct + SEQ * 32;
    for (int i = F.bid * NTHR + F.tid; i < SEQ * 32; i += F.G * NTHR) {
        const int pos = i >> 5, ax = (i >> 4) & 1, f = i & 15;
        const float inv = exp2f(-(float)f * (13.287712379549449f / 16.f));
        const float ang = (float)(ax == 0 ? (pos >> 6) : (pos & 63)) * inv;
        float sv, cv; sincos_acc(ang, sv, cv); ct[i] = cv; st[i] = sv;
    }
}

__device__ __forceinline__ void pro_filter(const Fr& F, const Args& a) {
    LAS float* L = (LAS float*)F.lds;
    constexpr int oW1 = 0, oB1 = 2112, oFR = 2176, oB2 = 2240, oW2 = 2304, oZ = 6400, oH1 = 7552, oH2 = 9600, oW3 = 11648, oT = 19840;
    bf16_t* FL = (bf16_t*)(a.ws + WS_FL); bf16_t* FC = (bf16_t*)(a.ws + WS_FC); float* NP = (float*)(a.ws + WS_NP);
    const int p = F.tid >> 4, jj = F.tid & 15;
    for (int unit = F.bid; unit < NL * 72; unit += F.G) {
        const int l = unit / 72, ch = unit % 72; const bool lat = ch < 64; const int n = lat ? SEQ : CTX, pos0 = lat ? ch * 32 : (ch - 64) * 32;
        __syncthreads();
        for (int i = F.tid; i < 2112; i += NTHR) L[oW1 + i] = a.in[I_HW1][l * 2112 + i];
        for (int i = F.tid; i < 64; i += NTHR) { L[oB1 + i] = a.in[I_HB1][l * 64 + i]; L[oFR + i] = a.in[I_HFR][l * 64 + i]; L[oB2 + i] = a.in[I_HB2][l * 64 + i]; }
        for (int i = F.tid; i < 4096; i += NTHR) L[oW2 + i] = a.in[I_HW2][l * 4096 + i];
        const int pos = pos0 + p; const float t = (float)pos / (float)(n - 1);
        { const float band = 1e-4f + (float)jj * ((15.f - 1e-4f) / 15.f); const float ang = ((6.2831855f * band) * (float)pos) / (float)n;
          float sv, cv; sincos_acc(ang, sv, cv); L[oZ + p * 36 + 1 + jj] = cv; L[oZ + p * 36 + 17 + jj] = -sv; if (jj == 0) L[oZ + p * 36] = t; }
        __syncthreads();
        { f32x4 acc = *(const LAS f32x4*)(L + oB1 + 4 * jj);
#pragma unroll 3
          for (int i = 0; i < 33; ++i) { const float z = L[oZ + p * 36 + i]; const f32x4 w = *(const LAS f32x4*)(L + oW1 + i * 64 + 4 * jj); acc.x = fmaf(z, w.x, acc.x); acc.y = fmaf(z, w.y, acc.y); acc.z = fmaf(z, w.z, acc.z); acc.w = fmaf(z, w.w, acc.w); }
          const f32x4 fr = *(const LAS f32x4*)(L + oFR + 4 * jj); float sv, cv; f32x4 o;
          sincos_acc(fr.x * acc.x, sv, cv); o.x = sv; sincos_acc(fr.y * acc.y, sv, cv); o.y = sv; sincos_acc(fr.z * acc.z, sv, cv); o.z = sv; sincos_acc(fr.w * acc.w, sv, cv); o.w = sv;
          *(LAS f32x4*)(L + oH1 + p * 64 + 4 * jj) = o; }
        __syncthreads();
        { f32x4 acc = *(const LAS f32x4*)(L + oB2 + 4 * jj);
#pragma unroll 4
          for (int i = 0; i < 64; ++i) { const float z = L[oH1 + p * 64 + i]; const f32x4 w = *(const LAS f32x4*)(L + oW2 + i * 64 + 4 * jj); acc.x = fmaf(z, w.x, acc.x); acc.y = fmaf(z, w.y, acc.y); acc.z = fmaf(z, w.z, acc.z); acc.w = fmaf(z, w.w, acc.w); }
          const f32x4 fr = *(const LAS f32x4*)(L + oFR + 4 * jj); float sv, cv; f32x4 o;
          sincos_acc(fr.x * acc.x, sv, cv); o.x = sv; sincos_acc(fr.y * acc.y, sv, cv); o.y = sv; sincos_acc(fr.z * acc.z, sv, cv); o.z = sv; sincos_acc(fr.w * acc.w, sv, cv); o.w = sv;
          *(LAS f32x4*)(L + oH2 + p * 64 + 4 * jj) = o; }
        LAS bf16_t* T = (LAS bf16_t*)(L + oT);
#pragma unroll 1
        for (int mh = 0; mh < 1; ++mh) {
            f32x4 acc[16];
#pragma unroll
            for (int m = 0; m < 16; ++m) acc[m] = (f32x4){0.f, 0.f, 0.f, 0.f};
#pragma unroll 1
            for (int kc = 0; kc < 8; ++kc) {
                __syncthreads();
                for (int i = F.tid; i < 2048; i += NTHR) *(LAS f32x4*)(L + oW3 + i * 4) = *(const f32x4*)(a.in[I_HW3] + ((size_t)l * 64 + kc * 8) * 1024 + i * 4);
                __syncthreads();
#pragma unroll 1
                for (int k = 0; k < 8; ++k) { const float h = L[oH2 + p * 64 + kc * 8 + k];
#pragma unroll
                    for (int m = 0; m < 16; ++m) { const f32x4 w = *(const LAS f32x4*)(L + oW3 + k * 1024 + 64 * m + 4 * jj);
                        acc[m].x = fmaf(h, w.x, acc[m].x); acc[m].y = fmaf(h, w.y, acc[m].y); acc[m].z = fmaf(h, w.z, acc[m].z); acc[m].w = fmaf(h, w.w, acc[m].w); } }
            }
#pragma unroll
            for (int m = 0; m < 16; ++m) {
                const int colb = 64 * m + 4 * jj; const int dirb = m >> 3;
                const float v4[4] = {acc[m].x, acc[m].y, acc[m].z, acc[m].w};
#pragma unroll
                for (int e = 0; e < 4; ++e) { const int col = colb + e, c = col & 511;
                    const float dl = fabsf(-3.0701134573253943f + (-15.350567286626972f + 3.0701134573253943f) * ((float)c / 511.f));
                    float v = v4[e] * __expf(-t * dl); if (dirb == 1 && pos == 0) v = 0.f;
                    T[col * 32 + (dirb == 0 ? 31 - p : p)] = f2bf(v); }
            }
        }
        __syncthreads();
        for (int idx = F.tid; idx < 1024 * 32; idx += NTHR) { const int col = idx >> 5, i = idx & 31, dir = col >> 9, c = col & 511;
            const int u = (dir == 0) ? (n - 32 - pos0 + i) : ((pos0 + i == 0) ? 2 * n - 1 : n - 1 + pos0 + i);
            bf16_t* Fb = lat ? FL + ((size_t)l * 512 + c) * 4096 : FC + ((size_t)l * 512 + c) * 512;
            Fb[u] = T[col * 32 + i]; }
        for (int col = F.tid; col < 1024; col += NTHR) { float sum = 0.f;
#pragma unroll 8
            for (int i = 0; i < 32; ++i) sum += fabsf(bf1(T[col * 32 + i]));
            NP[((size_t)l * 72 + ch) * 1024 + col] = sum; }
    }
    __syncthreads();
}
__device__ __forceinline__ void filter_norm_reduce(const Fr& F, const Args& a) {
    const float* NP = (const float*)(a.ws + WS_NP); float* FN = (float*)(a.ws + WS_FNORM);
    for (int o = F.bid * NTHR + F.tid; o < NL * 2 * 512; o += F.G * NTHR) { const int l = o >> 10, isc = (o >> 9) & 1, c = o & 511;
        const int ch0 = isc ? 64 : 0, ch1 = isc ? 72 : 64; float sum = 0.f;
        for (int ch = ch0; ch < ch1; ++ch) sum += NP[((size_t)l * 72 + ch) * 1024 + c] + NP[((size_t)l * 72 + ch) * 1024 + 512 + c];
        FN[o] = 1.f / sum; }
}

template <int MODE>
__device__ __forceinline__ void transpose_item(const float* W, int K, int N, bf16_t* WT, int row_off, LAS float* scr, int item, int lane, int ldk = 0) {
    if (ldk == 0) ldk = K;
    const int nblk = N / 64, kb = item / nblk, nb = item % nblk, k0 = 64 * kb, n0 = 64 * nb;
    f32x4 v[16];
#pragma unroll
    for (int i = 0; i < 16; ++i) v[i] = *(const f32x4*)(W + (size_t)(k0 + 4 * i + (lane >> 4)) * N + n0 + (lane & 15) * 4);
#pragma unroll
    for (int i = 0; i < 16; ++i) *(LAS f32x4*)(scr + (4 * i + (lane >> 4)) * 68 + (lane & 15) * 4) = v[i];
    LDS_WAIT();
    const int c = lane & 7;
#pragma unroll
    for (int j = 0; j < 8; ++j) { const int n = (lane >> 3) + 8 * j; const LAS float* s = scr + (8 * c) * 68 + n;
        u32x4 o; o.x = cvtpk(s[0 * 68], s[1 * 68]); o.y = cvtpk(s[2 * 68], s[3 * 68]); o.z = cvtpk(s[4 * 68], s[5 * 68]); o.w = cvtpk(s[6 * 68], s[7 * 68]);
        const int nn = n0 + n; const int row = (MODE == 0) ? nn : ((nn >> 2) * 8 + (nn & 3) + (MODE == 2 ? 4 : 0));
        *(u32x4*)(WT + (size_t)(row_off + row) * ldk + k0 + 8 * c) = o; }
    LDS_WAIT();
}

template <int MODE>
__device__ __forceinline__ void transpose_item_f8(const float* W, int K, int N, unsigned char* WT, int row_off, LAS float* scr, int item, int lane, int ldk = 0) {
    if (ldk == 0) ldk = K;
    const int nblk = N / 64, kb = item / nblk, nb = item % nblk, k0 = 64 * kb, n0 = 64 * nb;
    f32x4 v[16];
#pragma unroll
    for (int i = 0; i < 16; ++i) v[i] = *(const f32x4*)(W + (size_t)(k0 + 4 * i + (lane >> 4)) * N + n0 + (lane & 15) * 4);
#pragma unroll
    for (int i = 0; i < 16; ++i) *(LAS f32x4*)(scr + (4 * i + (lane >> 4)) * 68 + (lane & 15) * 4) = v[i];
    LDS_WAIT();
    const int c = lane & 7;
#pragma unroll
    for (int j = 0; j < 8; ++j) { const int n = (lane >> 3) + 8 * j; const LAS float* s = scr + (8 * c) * 68 + n;
        u32x2 o; o.x = cvt4_fp8(s[0 * 68] * 64.f, s[1 * 68] * 64.f, s[2 * 68] * 64.f, s[3 * 68] * 64.f); o.y = cvt4_fp8(s[4 * 68] * 64.f, s[5 * 68] * 64.f, s[6 * 68] * 64.f, s[7 * 68] * 64.f);
        const int nn = n0 + n; const int row = (MODE == 0) ? nn : ((nn >> 2) * 8 + (nn & 3) + (MODE == 2 ? 4 : 0));
        *(u32x2*)(WT + (size_t)(row_off + row) * ldk + k0 + 8 * c) = o; }
    LDS_WAIT();
}
__device__ __forceinline__ void conv_small_weights(const Fr& F, const Args& a, int l, int mask, int b0) {
    if (F.bid < b0) return;
    LAS float* scr = (LAS float*)(F.lds + F.wave * 17408);
    const int gw = (F.bid - b0) * NWAVES + F.wave, NGW = (F.G - b0) * NWAVES;
    constexpr int I_IN = (1024 / 64) * (DIN / 64), I_BR = (512 / 64) * (1024 / 64), I_OUT = (1024 / 64) * (1024 / 64);
    if (mask & 1) for (int it = gw; it < I_IN; it += NGW) transpose_item_f8<0>(a.in[I_WIN] + (size_t)l * 1024 * DIN, 1024, DIN, a.ws + WS_WG8, 0, scr, it, F.lane);
    if (mask & 2) for (int it = gw; it < 3 * I_BR; it += NGW) { const int b = it / I_BR; transpose_item_f8<0>(a.in[I_WBR] + ((size_t)l * 3 + b) * 512 * 1024, 512, 1024, a.ws + WS_WBR + b * 512, 0, scr, it % I_BR, F.lane, 1536); }
    if (mask & 4) for (int it = gw; it < I_OUT; it += NGW) transpose_item_f8<0>(a.in[I_WOUT] + (size_t)l * 1024 * 1024, 1024, 1024, a.ws + WS_WOUT, 0, scr, it, F.lane);
}
__device__ __forceinline__ void conv_expert_weights(const Fr& F, const Args& a, int l, int b0, int it0, int it1) {
    if (F.bid < b0) return;
    LAS float* scr = (LAS float*)(F.lds + F.wave * 17408);
    const int gw = (F.bid - b0) * NWAVES + F.wave, NGW = (F.G - b0) * NWAVES;
    constexpr int I_1 = (1024 / 64) * (512 / 64), I_2 = (512 / 64) * (1024 / 64);
    for (int it = it0 + gw; it < it1; it += NGW) {
        const int e = it / (2 * I_1 + I_2); int r = it % (2 * I_1 + I_2);
        unsigned char* W13 = a.ws + WS_W13; unsigned char* W2 = a.ws + WS_W2;
        if (r < I_1) { transpose_item_f8<1>(a.in[I_EW1] + ((size_t)l * NE + e) * 1024 * 512, 1024, 512, W13, e * 1024, scr, r, F.lane); continue; } r -= I_1;
        if (r < I_1) { transpose_item_f8<2>(a.in[I_EW3] + ((size_t)l * NE + e) * 1024 * 512, 1024, 512, W13, e * 1024, scr, r, F.lane); continue; } r -= I_1;
        transpose_item_f8<0>(a.in[I_EW2] + ((size_t)l * NE + e) * 512 * 1024, 512, 1024, W2, e * 1024, scr, r, F.lane);
    }
}
constexpr int CONV_E_ITEMS = NE * 384, CONV_E_SPLIT = CONV_E_ITEMS / 2;

__device__ __forceinline__ int mod_row(int row) { return row < TL ? (row >> 11) : NB; }

__device__ __forceinline__ void rows_p0(const Fr& F, const Args& a, int l, int nrows) {
    const int gw = F.bid * NWAVES + F.wave, NGW = F.G * NWAVES;
    const float* g1 = a.in[I_N1G] + l * 1024;
    const float* MODl = (const float*)(a.ws + WS_MOD) + (size_t)l * NBM * DIN;
    const float* MODp = (const float*)(a.ws + WS_MOD) + (size_t)(l > 0 ? l - 1 : 0) * NBM * DIN;
    const bf16_t* Fs = (const bf16_t*)(a.ws + WS_F);
    unsigned char* H8 = a.ws + WS_H8;
    const int per = 2 * ((nrows + 2 * NGW - 1) / (2 * NGW)), w0 = gw * per, w1 = (w0 + per < nrows) ? w0 + per : nrows;
    f32x4 gv[4], shv[4], scv[4], m5v[4]; int cur = -1;
#pragma unroll
    for (int j = 0; j < 4; ++j) { gv[j] = *(const f32x4*)(g1 + F.lane * 4 + 256 * j); shv[j] = gv[j]; scv[j] = gv[j]; m5v[j] = gv[j]; }
#define P0_LOAD(rb, V, F0, F1) do { _Pragma("unroll") for (int q = 0; q < 2; ++q) { const int row = (rb) + q; const bool lat = row < TL; \
            const float* xs = lat ? ((l == 0) ? a.in[I_X] + (size_t)row * D : a.out + (size_t)row * D) : ((l == 0) ? a.in[I_CTX] + (size_t)(row - TL) * D : (const float*)(a.ws + WS_XC) + (size_t)(row - TL) * D); \
            _Pragma("unroll") for (int j = 0; j < 4; ++j) { const int col = F.lane * 4 + 256 * j; V[q][j] = *(const f32x4*)(xs + col); \
                if (l > 0) { F0[q][j] = *(const u32x2*)(Fs + (size_t)row * D + col); F1[q][j] = *(const u32x2*)(Fs + ((size_t)TT + row) * D + col); } } } } while (0)
#define P0_PROC(rb, V, F0, F1) do { _Pragma("unroll") for (int q = 0; q < 2; ++q) { const int row = (rb) + q; const bool lat = row < TL; const int mr = mod_row(row); \
            if (mr != cur) { cur = mr; _Pragma("unroll") for (int j = 0; j < 4; ++j) { const int col = F.lane * 4 + 256 * j; \
                shv[j] = *(const f32x4*)(MODl + (size_t)mr * DIN + col); scv[j] = *(const f32x4*)(MODl + (size_t)mr * DIN + 1024 + col); m5v[j] = *(const f32x4*)(MODp + (size_t)mr * DIN + 5 * 1024 + col); } } \
            float* xd = lat ? a.out + (size_t)row * D : (float*)(a.ws + WS_XC) + (size_t)(row - TL) * D; float ss = 0.f; \
            if (l > 0) { _Pragma("unroll") for (int j = 0; j < 4; ++j) { const int col = F.lane * 4 + 256 * j; \
                    V[q][j].x += m5v[j].x * (bflo(F0[q][j].x) + bflo(F1[q][j].x)); V[q][j].y += m5v[j].y * (bfhi(F0[q][j].x) + bfhi(F1[q][j].x)); \
                    V[q][j].z += m5v[j].z * (bflo(F0[q][j].y) + bflo(F1[q][j].y)); V[q][j].w += m5v[j].w * (bfhi(F0[q][j].y) + bfhi(F1[q][j].y)); \
                    *(f32x4*)(xd + col) = V[q][j]; } } \
            _Pragma("unroll") for (int j = 0; j < 4; ++j) ss += (V[q][j].x * V[q][j].x + V[q][j].y * V[q][j].y) + (V[q][j].z * V[q][j].z + V[q][j].w * V[q][j].w); \
            const float r = 1.f / sqrtf(wave_sum(ss) * (1.f / D) + EPS); \
            _Pragma("unroll") for (int j = 0; j < 4; ++j) { const int col = F.lane * 4 + 256 * j; \
                const f32x4 o = (V[q][j] * r * gv[j]) * (scv[j] + 1.f) + shv[j]; \
                *(unsigned*)(H8 + (size_t)row * D + col) = cvt4_fp8(o.x, o.y, o.z, o.w); } } } while (0)
    f32x4 vA[2][4], vB[2][4]; u32x2 fA0[2][4], fA1[2][4], fB0[2][4], fB1[2][4];
    if (w0 < w1) P0_LOAD(w0, vA, fA0, fA1);
    for (int rb = w0; rb < w1; rb += 4) {
        if (rb + 2 < w1) P0_LOAD(rb + 2, vB, fB0, fB1);
        P0_PROC(rb, vA, fA0, fA1);
        if (rb + 2 < w1) { if (rb + 4 < w1) P0_LOAD(rb + 4, vA, fA0, fA1); P0_PROC(rb + 2, vB, fB0, fB1); }
    }
#undef P0_LOAD
#undef P0_PROC
}
__device__ __forceinline__ void rows_final(const Fr& F, const Args& a) {
    const int gw = F.bid * NWAVES + F.wave, NGW = F.G * NWAVES;
    const float* MODp = (const float*)(a.ws + WS_MOD) + (size_t)(NL - 1) * NBM * DIN;
    const bf16_t* Fs = (const bf16_t*)(a.ws + WS_F);
    for (int row = gw; row < TL; row += NGW) {
        const int mr = row >> 11; float* xd = a.out + (size_t)row * D;
#pragma unroll
        for (int j = 0; j < 4; ++j) { const int col = F.lane * 4 + 256 * j;
            f32x4 v = *(const f32x4*)(xd + col);
            const u32x2 f0 = *(const u32x2*)(Fs + (size_t)row * D + col), f1 = *(const u32x2*)(Fs + ((size_t)TT + row) * D + col);
            const f32x4 m5 = *(const f32x4*)(MODp + (size_t)mr * DIN + 5 * 1024 + col);
            v.x += m5.x * (bflo(f0.x) + bflo(f1.x)); v.y += m5.y * (bfhi(f0.x) + bfhi(f1.x)); v.z += m5.z * (bflo(f0.y) + bflo(f1.y)); v.w += m5.w * (bfhi(f0.y) + bfhi(f1.y));
            *(f32x4*)(xd + col) = v; }
    }
}

__device__ __forceinline__ void rows_p5(const Fr& F, const Args& a, int l, int nrows, unsigned long long& sacc, const int swhich) {
#if defined(PROBE_P)
    unsigned long long st0 = __builtin_amdgcn_s_memrealtime();
#define SUBMARK5(w) do { const unsigned long long t_ = __builtin_amdgcn_s_memrealtime(); if (swhich == (w)) sacc += t_ - st0; st0 = t_; } while (0)
#else
#define SUBMARK5(w) do { } while (0)
#endif
    typedef float f32x4v __attribute__((ext_vector_type(4)));
    LAS float* RW = (LAS float*)F.lds;
    constexpr int RWS = 1028;
    LAS float* RB = (LAS float*)(F.lds + 82304);
    LAS int* LC = (LAS int*)(F.lds + 82432);
    LAS int* TE = (LAS int*)(F.lds + 82560);
    LAS int* TP = TE + 256;
    LAS float* TW = (LAS float*)(TP + 256);
    LAS float* RN = (LAS float*)(F.lds + 86784);
    LAS float* LG = (LAS float*)(F.lds + 87424);
    LAS float* GM = (LAS float*)(F.lds + 99072);
    LAS float* BI = (LAS float*)(F.lds + 107264);
    const float* g2 = a.in[I_N2G] + l * 1024;
    const float* MODl = (const float*)(a.ws + WS_MOD) + (size_t)l * NBM * DIN;
    unsigned char* H8 = a.ws + WS_H;
    int* EROW = (int*)(a.ws + WS_EROW); float* EROWW = (float*)(a.ws + WS_EROWW);
    unsigned* CNT = (unsigned*)(a.ws + WS_CTL) + CW_CNT + l * 256;
    for (int f = F.tid; f < 1024; f += NTHR) { const f32x4 v = *(const f32x4*)(a.in[I_RGW] + ((size_t)l * 1024 + f) * 4);
        RW[0 * RWS + f] = v.x; RW[1 * RWS + f] = v.y; RW[2 * RWS + f] = v.z; RW[3 * RWS + f] = v.w; }
    for (int f = F.tid; f < 4096; f += NTHR) { const int k = f >> 2, c4 = (f & 3) * 4; const f32x4 v = *(const f32x4*)(a.in[I_REW] + ((size_t)l * 1024 + k) * 16 + c4);
        RW[(4 + c4) * RWS + k] = v.x; RW[(5 + c4) * RWS + k] = v.y; RW[(6 + c4) * RWS + k] = v.z; RW[(7 + c4) * RWS + k] = v.w; }
    if (F.tid < 20) RB[F.tid] = (F.tid < 4) ? a.in[I_RGB][l * 4 + F.tid] : a.in[I_REB][l * 16 + F.tid - 4];
    constexpr int P5_CH = 144;
    const int nch = (nrows + P5_CH - 1) / P5_CH;
    SUBMARK5(40);
    for (int ch = F.bid; ch < nch; ch += F.G) {
    const int r0 = ch * P5_CH, r1 = (r0 + P5_CH < nrows) ? r0 + P5_CH : nrows;
    const int mb0 = mod_row(r0), mb1 = mod_row(r1 - 1);
    if (F.tid < 32) LC[F.tid] = 0;
    for (int i = F.tid; i < 2048; i += NTHR) { const int s = i >> 10, k = i & 1023; GM[i] = g2[k] * (1.f + MODl[(size_t)(s ? mb1 : mb0) * DIN + 4 * 1024 + k]); }
    __syncthreads();
    if (F.wave < 4) {
    for (int rowb = r0 + 2 * F.wave; rowb < r1; rowb += 2 * 4) {
        f32x4 v[2][4]; bool val[2];
#pragma unroll
        for (int q = 0; q < 2; ++q) { const int row = rowb + q; val[q] = row < r1; const int rr = val[q] ? row : rowb;
            const bool lat = rr < TL; const float* xs = lat ? a.out + (size_t)rr * D : (const float*)(a.ws + WS_XC) + (size_t)(rr - TL) * D;
#pragma unroll
            for (int j = 0; j < 4; ++j) v[q][j] = *(const f32x4*)(xs + F.lane * 4 + 256 * j); }
#pragma unroll
        for (int q = 0; q < 2; ++q) { const int rr = val[q] ? rowb + q : rowb; const int mr = mod_row(rr); float ss = 0.f;
#pragma unroll
            for (int j = 0; j < 4; ++j) ss += (v[q][j].x * v[q][j].x + v[q][j].y * v[q][j].y) + (v[q][j].z * v[q][j].z + v[q][j].w * v[q][j].w);
            const float r = 1.f / sqrtf(wave_sum(ss) * (1.f / D) + EPS);
            if (F.lane == 0 && val[q]) RN[rr - r0] = r;
#pragma unroll
            for (int j = 0; j < 4; ++j) { const int col = F.lane * 4 + 256 * j;
                const f32x4 g = *(const f32x4*)(g2 + col), sh = *(const f32x4*)(MODl + (size_t)mr * DIN + 3 * 1024 + col), sc = *(const f32x4*)(MODl + (size_t)mr * DIN + 4 * 1024 + col);
                const f32x4 t = (v[q][j] * r * g) * (sc + 1.f) + sh;
                if (val[q]) *(unsigned*)(H8 + (size_t)rr * D + col) = cvt4_fp8(t.x, t.y, t.z, t.w); } }
    }
    } else {
    if (F.wave < 6) { const int sl = F.wave - 4; const int mb = sl ? mb1 : mb0; f32x4 sh[4];
#pragma unroll
        for (int j = 0; j < 4; ++j) sh[j] = *(const f32x4*)(MODl + (size_t)mb * DIN + 3 * 1024 + F.lane * 4 + 256 * j);
#pragma unroll 4
        for (int cidx = 0; cidx < 20; ++cidx) { float p = 0.f;
#pragma unroll
            for (int j = 0; j < 4; ++j) { const f32x4 w = *(const LAS f32x4*)(RW + cidx * RWS + F.lane * 4 + 256 * j);
                p = fmaf(sh[j].x, w.x, p); p = fmaf(sh[j].y, w.y, p); p = fmaf(sh[j].z, w.z, p); p = fmaf(sh[j].w, w.w, p); }
            const float tot = wave_sum(p) + RB[cidx]; if (F.lane == 0) BI[sl * 20 + cidx] = tot; } }
    { const int i16 = F.lane & 15, kq = F.lane >> 4; const int ngrp = (r1 - r0 + 15) >> 4;
      for (int gi = F.wave - 4; gi < ngrp; gi += 4) {
        const int grow = r0 + 16 * gi; const int rowi = (grow + i16 < r1) ? grow + i16 : r1 - 1;
        const bool lat = rowi < TL; const float* xs = (lat ? a.out + (size_t)rowi * D : (const float*)(a.ws + WS_XC) + (size_t)(rowi - TL) * D) + 4 * kq;
        const int slot = (mod_row(grow) == mb0) ? 0 : 1;
        const LAS float* gmp = GM + slot * 1024 + 4 * kq; const LAS float* w0p = RW + i16 * RWS + 4 * kq; const LAS float* w1p = RW + (16 + (i16 & 3)) * RWS + 4 * kq;
        const float m1 = (i16 < 4) ? 1.f : 0.f;
        f32x4v acc0 = {0.f, 0.f, 0.f, 0.f}, acc1 = {0.f, 0.f, 0.f, 0.f};
#pragma unroll 16
        for (int s = 0; s < 64; ++s) {
            const f32x4 xv = *(const f32x4*)(xs + 16 * s); const f32x4 gv = *(const LAS f32x4*)(gmp + 16 * s);
            const f32x4 wa = *(const LAS f32x4*)(w0p + 16 * s), wb = *(const LAS f32x4*)(w1p + 16 * s);
            const f32x4 ba = wa * gv, bb = wb * gv * m1;
            acc0 = __builtin_amdgcn_mfma_f32_16x16x4f32(xv.x, ba.x, acc0, 0, 0, 0); acc1 = __builtin_amdgcn_mfma_f32_16x16x4f32(xv.x, bb.x, acc1, 0, 0, 0);
            acc0 = __builtin_amdgcn_mfma_f32_16x16x4f32(xv.y, ba.y, acc0, 0, 0, 0); acc1 = __builtin_amdgcn_mfma_f32_16x16x4f32(xv.y, bb.y, acc1, 0, 0, 0);
            acc0 = __builtin_amdgcn_mfma_f32_16x16x4f32(xv.z, ba.z, acc0, 0, 0, 0); acc1 = __builtin_amdgcn_mfma_f32_16x16x4f32(xv.z, bb.z, acc1, 0, 0, 0);
            acc0 = __builtin_amdgcn_mfma_f32_16x16x4f32(xv.w, ba.w, acc0, 0, 0, 0); acc1 = __builtin_amdgcn_mfma_f32_16x16x4f32(xv.w, bb.w, acc1, 0, 0, 0);
        }
#pragma unroll
        for (int rg = 0; rg < 4; ++rg) { const int lr = 16 * gi + 4 * kq + rg;
            if (r0 + lr < r1) { LG[lr * 20 + i16] = acc0[rg]; if (i16 < 4) LG[lr * 20 + 16 + i16] = acc1[rg]; } }
      } }
    }
    __syncthreads();
    SUBMARK5(42);
    for (int lr = F.tid; lr < r1 - r0; lr += NTHR) {
        float lg[20]; { const float rn = RN[lr]; const int sl = (mod_row(r0 + lr) == mb0) ? 0 : 1;
#pragma unroll
          for (int i = 0; i < 20; ++i) lg[i] = rn * LG[lr * 20 + i] + BI[sl * 20 + i]; }
        int gs = 0; float gmx = lg[0];
#pragma unroll
        for (int i = 1; i < 4; ++i) if (lg[i] > gmx) { gmx = lg[i]; gs = i; }
        float gsum = 0.f;
#pragma unroll
        for (int i = 0; i < 4; ++i) gsum += __expf(lg[i] - gmx);
        const float pg = 1.f / gsum;
        float le[4];
#pragma unroll
        for (int i = 0; i < 4; ++i) le[i] = (gs == 0) ? lg[4 + i] : (gs == 1) ? lg[8 + i] : (gs == 2) ? lg[12 + i] : lg[16 + i];
        int i0 = 0; float v0 = le[0];
#pragma unroll
        for (int i = 1; i < 4; ++i) if (le[i] > v0) { v0 = le[i]; i0 = i; }
        int i1 = -1; float v1 = -3.4e38f;
#pragma unroll
        for (int i = 0; i < 4; ++i) if (i != i0 && le[i] > v1) { v1 = le[i]; i1 = i; }
        const float e1 = __expf(v1 - v0), den = 1.f / (1.f + e1);
        const int ex0 = gs * 4 + i0, ex1 = gs * 4 + i1;
        const int lp0 = __hip_atomic_fetch_add(&LC[ex0], 1, __ATOMIC_RELAXED, __HIP_MEMORY_SCOPE_WORKGROUP), lp1 = __hip_atomic_fetch_add(&LC[ex1], 1, __ATOMIC_RELAXED, __HIP_MEMORY_SCOPE_WORKGROUP);
        TE[lr] = ex0 | (ex1 << 8); TP[lr] = lp0 | (lp1 << 16); TW[2 * lr] = den * pg; TW[2 * lr + 1] = e1 * den * pg;
    }
    __syncthreads();
    if (F.tid < NE) LC[16 + F.tid] = (int)atomicAdd(&CNT[F.tid * 16], (unsigned)LC[F.tid]);
    __syncthreads();
    for (int lr = F.tid; lr < r1 - r0; lr += NTHR) {
        const int te = TE[lr], tp = TP[lr], ex0 = te & 255, ex1 = te >> 8, row = r0 + lr;
        const int gp0 = LC[16 + ex0] + (tp & 0xffff), gp1 = LC[16 + ex1] + (tp >> 16);
        EROW[(size_t)ex0 * TT + gp0] = row * 2; EROWW[(size_t)ex0 * TT + gp0] = TW[2 * lr];
        EROW[(size_t)ex1 * TT + gp1] = row * 2 + 1; EROWW[(size_t)ex1 * TT + gp1] = TW[2 * lr + 1];
    }
    __syncthreads();
    SUBMARK5(43);
    }
    __syncthreads();
#undef SUBMARK5
}

__device__ __forceinline__ void normrope8(float (&x)[8], const float* g64, bool rope, int pos, const float* ct, const float* st, float scale, int lane) {
    float ss = 0.f;
#pragma unroll
    for (int i = 0; i < 8; ++i) ss += x[i] * x[i];
    ss += DPP_F(ss, 0xB1); ss += DPP_F(ss, 0x4E); ss += DPP_F(ss, 0x141);
    const float r = 1.f / sqrtf(ss * (1.f / 64.f) + EPS);
    const int ch = lane & 7;
    const f32x4 g0 = *(const f32x4*)(g64 + 8 * ch), g1 = *(const f32x4*)(g64 + 8 * ch + 4);
    x[0] *= r * g0.x; x[1] *= r * g0.y; x[2] *= r * g0.z; x[3] *= r * g0.w; x[4] *= r * g1.x; x[5] *= r * g1.y; x[6] *= r * g1.z; x[7] *= r * g1.w;
    if (rope) {
        const int ax = ch >> 2, half = (ch >> 1) & 1, f0 = 8 * (ch & 1);
        const f32x4 c0 = *(const f32x4*)(ct + pos * 32 + ax * 16 + f0), c1 = *(const f32x4*)(ct + pos * 32 + ax * 16 + f0 + 4);
        const f32x4 s0 = *(const f32x4*)(st + pos * 32 + ax * 16 + f0), s1 = *(const f32x4*)(st + pos * 32 + ax * 16 + f0 + 4);
        const float cs[8] = {c0.x, c0.y, c0.z, c0.w, c1.x, c1.y, c1.z, c1.w}, sn[8] = {s0.x, s0.y, s0.z, s0.w, s1.x, s1.y, s1.z, s1.w};
#pragma unroll
        for (int i = 0; i < 8; ++i) { const float p = DPP_F(x[i], 0x4E);
            x[i] = half ? (x[i] * cs[i] + p * sn[i]) : (x[i] * cs[i] - p * sn[i]); }
    }
#pragma unroll
    for (int i = 0; i < 8; ++i) x[i] *= scale;
}
__device__ __forceinline__ void unpack8(const u32x4 w, float (&x)[8]) { x[0] = bflo(w.x); x[1] = bfhi(w.x); x[2] = bflo(w.y); x[3] = bfhi(w.y); x[4] = bflo(w.z); x[5] = bfhi(w.z); x[6] = bflo(w.w); x[7] = bfhi(w.w); }
__device__ __forceinline__ u32x4 pack8(const float (&x)[8]) { u32x4 w; w.x = cvtpk(x[0], x[1]); w.y = cvtpk(x[2], x[3]); w.z = cvtpk(x[4], x[5]); w.w = cvtpk(x[6], x[7]); return w; }

__device__ __forceinline__ void prep_phase(const Fr& F, const Args& a, int l, bool with_ctx) {
    constexpr int VROW = 272;
    LAS unsigned char* VA_l = F.lds;
    LAS unsigned char* VW_l = F.lds + 17408;
    LAS unsigned char* HT_l = F.lds + 34816;
    constexpr int HROW = 144;
    const float* ct = (const float*)(a.ws + WS_ROPE); const float* st = ct + SEQ * 32;
    const float* qkg = a.in[I_QKG] + l * 256;
    const bf16_t* RAWA = (const bf16_t*)(a.ws + WS_RAWA); const bf16_t* RAWW = (const bf16_t*)(a.ws + WS_RAWW);
    bf16_t* KA = (bf16_t*)(a.ws + WS_KA); bf16_t* KW = (bf16_t*)(a.ws + WS_KW); bf16_t* VTA = (bf16_t*)(a.ws + WS_VTA); bf16_t* VTW = (bf16_t*)(a.ws + WS_VTW);
    const bf16_t* U = (const bf16_t*)(a.ws + WS_U); bf16_t* X0 = (bf16_t*)(a.ws + WS_H); bf16_t* VT = (bf16_t*)(a.ws + WS_VT);
    const float* hsw = a.in[I_HSW] + l * 3 * 1536; const float* hsb = a.in[I_HSB] + l * 1536;
    for (int unit = F.bid; unit < NB * 36; unit += F.G) {
        const bool lat = unit < NB * 32;
        const int b = lat ? unit >> 5 : (unit - NB * 32) >> 2, p0 = lat ? (unit & 31) * 64 : ((unit - NB * 32) & 3) * 64;
        const int n = lat ? SEQ : CTX;
        const int row0 = lat ? b * SEQ + p0 : TL + b * CTX + p0;
        const int j0 = lat ? CTX + p0 : p0;
        __syncthreads();
        {
            const bool isw = (F.lane & 16) != 0; const int l16 = F.lane & 15, half = F.lane >> 5;
            u32x4 kw[4];
#pragma unroll
            for (int ps = 0; ps < 4; ++ps) { const int tk = 8 * F.wave + 2 * ps + half; kw[ps] = *(const u32x4*)((isw ? RAWW : RAWA) + (size_t)(row0 + tk) * 256 + l16 * 8); }
#pragma unroll
            for (int ps = 0; ps < 4; ++ps) { const int tk = 8 * F.wave + 2 * ps + half; float x[8]; unpack8(kw[ps], x);
                normrope8(x, qkg + (isw ? 192 : 64), lat, p0 + tk, ct, st, 1.f, F.lane);
                *(u32x4*)((isw ? KW : KA) + ((size_t)b * KEYS + j0 + tk) * 128 + l16 * 8) = pack8(x); }
        }
        for (int i = F.tid; i < 2 * 64 * 16; i += NTHR) { const int m = i >> 10, r = (i >> 4) & 63, cch = i & 15;
            const u32x4 w = *(const u32x4*)((m ? RAWW : RAWA) + (size_t)(row0 + r) * 256 + 128 + cch * 8);
            *(LAS u32x4*)((m ? VW_l : VA_l) + r * VROW + cch * 16) = w; }
        const bool do_hy = lat || with_ctx;
        if (do_hy) {
            const int cg = F.tid & 63, c = 8 * cg, t0 = 8 * F.wave;
            u32x4 x1p[8];
#pragma unroll
            for (int g = 0; g < 3; ++g) {
                const int ch = g * 512 + c;
                float w0[8], w1[8], w2[8], bb[8];
                { const f32x4 a0 = *(const f32x4*)(hsw + ch), a1 = *(const f32x4*)(hsw + ch + 4), b0 = *(const f32x4*)(hsw + 1536 + ch), b1 = *(const f32x4*)(hsw + 1536 + ch + 4),
                              c0 = *(const f32x4*)(hsw + 3072 + ch), c1 = *(const f32x4*)(hsw + 3072 + ch + 4), d0 = *(const f32x4*)(hsb + ch), d1 = *(const f32x4*)(hsb + ch + 4);
                  w0[0] = a0.x; w0[1] = a0.y; w0[2] = a0.z; w0[3] = a0.w; w0[4] = a1.x; w0[5] = a1.y; w0[6] = a1.z; w0[7] = a1.w;
                  w1[0] = b0.x; w1[1] = b0.y; w1[2] = b0.z; w1[3] = b0.w; w1[4] = b1.x; w1[5] = b1.y; w1[6] = b1.z; w1[7] = b1.w;
                  w2[0] = c0.x; w2[1] = c0.y; w2[2] = c0.z; w2[3] = c0.w; w2[4] = c1.x; w2[5] = c1.y; w2[6] = c1.z; w2[7] = c1.w;
                  bb[0] = d0.x; bb[1] = d0.y; bb[2] = d0.z; bb[3] = d0.w; bb[4] = d1.x; bb[5] = d1.y; bb[6] = d1.z; bb[7] = d1.w; }
                u32x4 raw[10];
#pragma unroll
                for (int i = 0; i < 10; ++i) { const int pos = p0 + t0 - 1 + i;
                    if (pos < 0 || pos >= n) { const unsigned z = zero_u32(); raw[i] = (u32x4){z, z, z, z}; } else raw[i] = *(const u32x4*)(U + (size_t)(row0 - p0 + pos) * 1536 + ch); }
#pragma unroll
                for (int t = 0; t < 8; ++t) { float up[8], uc[8], un[8], o[8]; unpack8(raw[t], up); unpack8(raw[t + 1], uc); unpack8(raw[t + 2], un);
#pragma unroll
                    for (int i = 0; i < 8; ++i) o[i] = fmaf(w0[i], up[i], fmaf(w1[i], uc[i], fmaf(w2[i], un[i], bb[i])));
                    if (g == 0) *(u32x4*)(X0 + (size_t)(row0 + t0 + t) * 512 + c) = pack8(o);
                    else if (g == 1) x1p[t] = pack8(o);
                    else { float x1[8]; unpack8(x1p[t], x1);
#pragma unroll
                        for (int i = 0; i < 8; ++i) o[i] *= x1[i];
                        x1p[t] = pack8(o); } }
            }
#pragma unroll
            for (int i = 0; i < 8; ++i) { unsigned short ev[8];
#pragma unroll
                for (int t = 0; t < 8; ++t) { const unsigned wsel = (i >> 1) == 0 ? x1p[t].x : (i >> 1) == 1 ? x1p[t].y : (i >> 1) == 2 ? x1p[t].z : x1p[t].w; ev[t] = (unsigned short)((i & 1) ? (wsel >> 16) : (wsel & 0xffffu)); }
                u32x4 w; w.x = ev[0] | ((unsigned)ev[1] << 16); w.y = ev[2] | ((unsigned)ev[3] << 16); w.z = ev[4] | ((unsigned)ev[5] << 16); w.w = ev[6] | ((unsigned)ev[7] << 16);
                *(LAS u32x4*)(HT_l + (c + i) * HROW + t0 * 2) = w; }
        }
        __syncthreads();
        for (int i = F.tid; i < 2 * 128 * 8; i += NTHR) { const int m = i >> 10, rr = (i >> 3) & 127, c8 = i & 7;
            LAS unsigned char* T = m ? VW_l : VA_l; unsigned short e[8];
#pragma unroll
            for (int jj = 0; jj < 8; ++jj) { const int key = 16 * (c8 >> 1) + 8 * (jj >> 2) + 4 * (c8 & 1) + (jj & 3); e[jj] = *(const LAS bf16_t*)(T + key * VROW + rr * 2); }
            u32x4 w; w.x = e[0] | ((unsigned)e[1] << 16); w.y = e[2] | ((unsigned)e[3] << 16); w.z = e[4] | ((unsigned)e[5] << 16); w.w = e[6] | ((unsigned)e[7] << 16);
            *(u32x4*)((m ? VTW : VTA) + ((size_t)(b * 2 + (rr >> 6)) * 64 + (rr & 63)) * KEYS + j0 + c8 * 8) = w; }
        if (do_hy) { bf16_t* VTb = lat ? VT : VT + VT_CTX_OFF;
          for (int i = F.tid; i < 512 * 8; i += NTHR) { const int cch = i >> 3, c8 = i & 7;
              const u32x4 w = *(const LAS u32x4*)(HT_l + cch * HROW + c8 * 16);
              *(u32x4*)(VTb + ((size_t)cch * NB + b) * n + p0 + c8 * 8) = w; } }
    }
    __syncthreads();
}

__device__ __forceinline__ void hyena_final_phase(const Fr& F, const Args& a, int l, bool with_ctx) {
    constexpr int HROW = 144;
    LAS unsigned char* T = F.lds;
    const bf16_t* X0 = (const bf16_t*)(a.ws + WS_H); const bf16_t* VT = (const bf16_t*)(a.ws + WS_VT); const bf16_t* YT = (const bf16_t*)(a.ws + WS_YT);
    unsigned char* YH = a.ws + WS_Y8 + 512;
    const float* FN = (const float*)(a.ws + WS_FNORM) + l * 1024; const float* skip = a.in[I_HBIAS] + l * 512;
    const int nunits = with_ctx ? NB * 36 : NB * 32;
    for (int unit = F.bid; unit < nunits; unit += F.G) {
        const bool lat = unit < NB * 32;
        const int b = lat ? unit >> 5 : (unit - NB * 32) >> 2, p0 = lat ? (unit & 31) * 64 : ((unit - NB * 32) & 3) * 64;
        const int n = lat ? SEQ : CTX; const int row0 = lat ? b * SEQ + p0 : TL + b * CTX + p0;
        const bf16_t* Yb = lat ? YT : YT + VT_CTX_OFF; const bf16_t* Vb = lat ? VT : VT + VT_CTX_OFF; const float* inv = FN + (lat ? 0 : 512);
        __syncthreads();
        for (int i = F.tid; i < 512 * 8; i += NTHR) { const int cch = i >> 3, c8 = i & 7; const size_t off = ((size_t)cch * NB + b) * n + p0 + c8 * 8;
            const u32x4 y = *(const u32x4*)(Yb + off), v = *(const u32x4*)(Vb + off); const float s = inv[cch], k = skip[cch];
            u32x4 o;
            o.x = cvtpk(bflo(y.x) * s + k * bflo(v.x), bfhi(y.x) * s + k * bfhi(v.x)); o.y = cvtpk(bflo(y.y) * s + k * bflo(v.y), bfhi(y.y) * s + k * bfhi(v.y));
            o.z = cvtpk(bflo(y.z) * s + k * bflo(v.z), bfhi(y.z) * s + k * bfhi(v.z)); o.w = cvtpk(bflo(y.w) * s + k * bflo(v.w), bfhi(y.w) * s + k * bfhi(v.w));
            *(LAS u32x4*)(T + cch * HROW + c8 * 16) = o; }
        __syncthreads();
        { const int th = F.tid & 255, half = F.tid >> 8, c = 2 * th;
          for (int t = 32 * half; t < 32 * half + 32; ++t) {
              const unsigned x0 = *(const unsigned*)(X0 + (size_t)(row0 + t) * 512 + c);
              const float y0 = bf1(*(const LAS bf16_t*)(T + c * HROW + t * 2)), y1 = bf1(*(const LAS bf16_t*)(T + (c + 1) * HROW + t * 2));
              *(unsigned short*)(YH + (size_t)(row0 + t) * 1536 + c) = (unsigned short)__builtin_amdgcn_cvt_pk_fp8_f32(clamp_fp8(bflo(x0) * y0 * 16.f), clamp_fp8(bfhi(x0) * y1 * 16.f), 0, false); } }
    }
    __syncthreads();
}

#define MFMA32(a, b, c) __builtin_amdgcn_mfma_f32_32x32x16_bf16((a), (b), (c), 0, 0, 0)
#define MFMA16(a, b, c) __builtin_amdgcn_mfma_f32_16x16x32_bf16((a), (b), (c), 0, 0, 0)

__device__ __forceinline__ int tile_off(int row, int chunk) { return row * 128 + ((chunk ^ ((row >> 1) & 7)) << 4); }

template <bool WIN>
__device__ __forceinline__ void attn_unit(const Fr& F, const bf16_t* Qw, unsigned char* Yw, const bf16_t* Kb, const bf16_t* VTb, int a0, int na, int b0, int nb, int qpos0, bool has_sink, float sink2, const float* g64, bool rope, const float* ct, const float* st) {
    LAS unsigned char* L = F.lds;
    const int r = F.lane & 31, h = F.lane >> 5;
    const int xaddr = (lane_id() ^ 32) << 2;
#define SWAP32(v) __builtin_bit_cast(float, __builtin_amdgcn_ds_bpermute(xaddr, __builtin_bit_cast(int, (v))))
    bf16x8 q[4];
    {
        float x[4][8]; float ss = 0.f;
#pragma unroll
        for (int kk = 0; kk < 4; ++kk) { const u32x4 w = *(const u32x4*)(Qw + (size_t)r * 1536 + 16 * kk + 8 * h); unpack8(w, x[kk]);
#pragma unroll
            for (int j = 0; j < 8; ++j) ss += x[kk][j] * x[kk][j]; }
        ss += SWAP32(ss);
        const float rn = (1.f / sqrtf(ss * (1.f / 64.f) + EPS)) * QSCALE;
#pragma unroll
        for (int kk = 0; kk < 4; ++kk) { const f32x4 g0 = *(const f32x4*)(g64 + 16 * kk + 8 * h), g1 = *(const f32x4*)(g64 + 16 * kk + 8 * h + 4);
            x[kk][0] *= rn * g0.x; x[kk][1] *= rn * g0.y; x[kk][2] *= rn * g0.z; x[kk][3] *= rn * g0.w; x[kk][4] *= rn * g1.x; x[kk][5] *= rn * g1.y; x[kk][6] *= rn * g1.z; x[kk][7] *= rn * g1.w; }
        if (rope) { const int pos = qpos0 + r;
#pragma unroll
            for (int ax = 0; ax < 2; ++ax) {
                const f32x4 c0 = *(const f32x4*)(ct + pos * 32 + ax * 16 + 8 * h), c1 = *(const f32x4*)(ct + pos * 32 + ax * 16 + 8 * h + 4);
                const f32x4 s0 = *(const f32x4*)(st + pos * 32 + ax * 16 + 8 * h), s1 = *(const f32x4*)(st + pos * 32 + ax * 16 + 8 * h + 4);
                const float cs[8] = {c0.x, c0.y, c0.z, c0.w, c1.x, c1.y, c1.z, c1.w}, sn[8] = {s0.x, s0.y, s0.z, s0.w, s1.x, s1.y, s1.z, s1.w};
#pragma unroll
                for (int j = 0; j < 8; ++j) { const float av = x[2 * ax][j], bv = x[2 * ax + 1][j]; x[2 * ax][j] = av * cs[j] - bv * sn[j]; x[2 * ax + 1][j] = bv * cs[j] + av * sn[j]; } } }
#pragma unroll
        for (int kk = 0; kk < 4; ++kk) q[kk] = __builtin_bit_cast(bf16x8, pack8(x[kk]));
    }
    f32x16 o0, o1;
#pragma unroll
    for (int i = 0; i < 16; ++i) { o0[i] = 0.f; o1[i] = 0.f; }
    float lsum = 0.f;
    const int ntile = na + nb;
    const int srow = F.tid >> 3, sch = F.tid & 7;
    const int soff = tile_off(srow, sch);
    int t4[4];
#pragma unroll
    for (int j = 0; j < 4; ++j) t4[j] = tile_off(r, 2 * j + h);
#define AT_KT(i) ((i) < na ? a0 + (i) : b0 + ((i) - na))
#define AT_LD(i, K0, K1, V0, V1) do { const int kt_ = AT_KT(i); \
        K0 = *(const u32x4*)(Kb + (size_t)(kt_ * 128 + srow) * 128 + sch * 8); K1 = *(const u32x4*)(Kb + (size_t)(kt_ * 128 + 64 + srow) * 128 + sch * 8); \
        V0 = *(const u32x4*)(VTb + (size_t)srow * KEYS + kt_ * 128 + sch * 8); V1 = *(const u32x4*)(VTb + (size_t)srow * KEYS + kt_ * 128 + 64 + sch * 8); } while (0)
#define AT_ST(buf, K0, K1, V0, V1) do { LAS unsigned char* B_ = L + (buf) * 32768 + soff; \
        *(LAS u32x4*)(B_) = K0; *(LAS u32x4*)(B_ + 8192) = K1; *(LAS u32x4*)(B_ + 16384) = V0; *(LAS u32x4*)(B_ + 24576) = V1; } while (0)
#define AT_QK(S0, S1, Kt) do { bf16x8 kf_[8]; \
        _Pragma("unroll") for (int kk = 0; kk < 4; ++kk) { kf_[2 * kk] = *(const LAS bf16x8*)(L + (Kt) + t4[kk]); kf_[2 * kk + 1] = *(const LAS bf16x8*)(L + (Kt) + t4[kk] + 4096); } \
        _Pragma("unroll") for (int i_ = 0; i_ < 16; ++i_) { S0[i_] = 0.f; S1[i_] = 0.f; } \
        _Pragma("unroll") for (int kk = 0; kk < 4; ++kk) { S0 = MFMA32(kf_[2 * kk], q[kk], S0); S1 = MFMA32(kf_[2 * kk + 1], q[kk], S1); } } while (0)
#define AT_EXP(S0, S1, P, kpos0) do { \
        if (WIN && (kpos0) >= 0) { const int kbase = (kpos0) + 4 * h, qp = qpos0 + r; \
            _Pragma("unroll") for (int i = 0; i < 16; ++i) { const int kr = (i & 3) + 8 * (i >> 2); const int d0 = kbase + kr - qp, d1 = d0 + 32; \
                if (d0 > 128 || d0 < -128) S0[i] = -1e30f; if (d1 > 128 || d1 < -128) S1[i] = -1e30f; } } \
        _Pragma("unroll") for (int i = 0; i < 16; ++i) { S0[i] = fast_exp2(S0[i]); S1[i] = fast_exp2(S1[i]); lsum += S0[i] + S1[i]; } \
        { u32x4 w; \
          w.x = cvtpk(S0[0], S0[1]); w.y = cvtpk(S0[2], S0[3]); w.z = cvtpk(S0[4], S0[5]); w.w = cvtpk(S0[6], S0[7]); P[0] = __builtin_bit_cast(bf16x8, w); \
          w.x = cvtpk(S0[8], S0[9]); w.y = cvtpk(S0[10], S0[11]); w.z = cvtpk(S0[12], S0[13]); w.w = cvtpk(S0[14], S0[15]); P[1] = __builtin_bit_cast(bf16x8, w); \
          w.x = cvtpk(S1[0], S1[1]); w.y = cvtpk(S1[2], S1[3]); w.z = cvtpk(S1[4], S1[5]); w.w = cvtpk(S1[6], S1[7]); P[2] = __builtin_bit_cast(bf16x8, w); \
          w.x = cvtpk(S1[8], S1[9]); w.y = cvtpk(S1[10], S1[11]); w.z = cvtpk(S1[12], S1[13]); w.w = cvtpk(S1[14], S1[15]); P[3] = __builtin_bit_cast(bf16x8, w); } } while (0)
#define AT_PV(P, Vt) do { bf16x8 vf_[8]; \
        _Pragma("unroll") for (int c = 0; c < 4; ++c) { vf_[2 * c] = *(const LAS bf16x8*)(L + (Vt) + t4[c]); vf_[2 * c + 1] = *(const LAS bf16x8*)(L + (Vt) + t4[c] + 4096); } \
        _Pragma("unroll") for (int c = 0; c < 4; ++c) { o0 = MFMA32(vf_[2 * c], P[c], o0); o1 = MFMA32(vf_[2 * c + 1], P[c], o1); } } while (0)
#define AT_BODY(it) do { \
        const int kt = AT_KT(it); \
        if ((it) + 1 < ntile) AT_LD((it) + 1, kA0, kA1, vA0, vA1); \
        const int Bc = ((it) & 1) * 32768;                                \
        const int kp = (WIN && kt >= 2) ? (kt - 2) * 128 : -1;            \
        { f32x16 sa0, sa1; bf16x8 pa[4]; \
          AT_QK(sa0, sa1, Bc); AT_EXP(sa0, sa1, pa, kp); AT_PV(pa, Bc + 16384); } \
        __builtin_amdgcn_sched_barrier(0); \
        { f32x16 sb0, sb1; bf16x8 pb_[4]; \
          AT_QK(sb0, sb1, Bc + 8192); AT_EXP(sb0, sb1, pb_, (kp < 0 ? -1 : kp + 64)); AT_PV(pb_, Bc + 24576); } \
        if ((it) + 1 < ntile) AT_ST(((it) + 1) & 1, kA0, kA1, vA0, vA1); \
        __syncthreads(); } while (0)
    u32x4 kA0, kA1, vA0, vA1;
    AT_LD(0, kA0, kA1, vA0, vA1);
    __syncthreads();
    AT_ST(0, kA0, kA1, vA0, vA1);
    __syncthreads();
    for (int it = 0; it < ntile; it += 2) {
        AT_BODY(it);
        if (it + 1 < ntile) AT_BODY(it + 1);
    }
#undef AT_BODY
#undef AT_QK
#undef AT_EXP
#undef AT_PV
#undef AT_ST
#undef AT_LD
#undef AT_KT
    float lt = lsum + SWAP32(lsum);
    if (has_sink) lt += fast_exp2(sink2);
    const float inv = 1.f / lt;
#pragma unroll
    for (int g = 0; g < 4; ++g) { const float i16 = inv * 16.f;
        *(unsigned*)(Yw + (size_t)r * 1536 + 8 * g + 4 * h) = cvt4_fp8(o0[4 * g] * i16, o0[4 * g + 1] * i16, o0[4 * g + 2] * i16, o0[4 * g + 3] * i16);
        *(unsigned*)(Yw + (size_t)r * 1536 + 32 + 8 * g + 4 * h) = cvt4_fp8(o1[4 * g] * i16, o1[4 * g + 1] * i16, o1[4 * g + 2] * i16, o1[4 * g + 3] * i16); }
#undef SWAP32
}

__device__ __forceinline__ void hyena_unit_lat(const Fr& F, const bf16_t* Fg, const bf16_t* Vg, bf16_t* Yg) {
    constexpr int FREP = 8192 + 64, VPIT = 4096 + 16, VOFF = 8 * FREP;
    LAS unsigned char* L = F.lds;
    __syncthreads();
    { const int x = F.tid;
      const u32x4 lo = *(const u32x4*)(Fg + x * 8); u32x4 hi; if (x < 511) hi = *(const u32x4*)(Fg + x * 8 + 8); else { const unsigned z = zero_u32(); hi = (u32x4){z, z, z, z}; }
      const unsigned wv[8] = {lo.x, lo.y, lo.z, lo.w, hi.x, hi.y, hi.z, hi.w};
      *(LAS u32x4*)(L + x * 16) = lo;
#pragma unroll
      for (int rho = 1; rho < 8; ++rho) { u32x4 o;
          unsigned od[4];
#pragma unroll
          for (int d = 0; d < 4; ++d) { const int ob = 4 * d + 2 * rho, i = ob >> 2, s = ob & 3; od[d] = __builtin_amdgcn_alignbyte(wv[i + 1 < 8 ? i + 1 : 7], wv[i], s); }
          o.x = od[0]; o.y = od[1]; o.z = od[2]; o.w = od[3];
          *(LAS u32x4*)(L + rho * FREP + x * 16) = o; } }
    for (int i = F.tid; i < 16 * 256; i += NTHR) { const int b = i >> 8, x = i & 255; *(LAS u32x4*)(L + VOFF + b * VPIT + x * 16) = *(const u32x4*)(Vg + (size_t)b * SEQ + x * 8); }
    __syncthreads();
    const int i16 = F.lane & 15, q4 = F.lane >> 4, w = F.wave;
    const int base0 = 2047 - 256 * w - i16 + 8 * q4;
    const int rho = base0 & 7;
    LAS unsigned char* Ap = L + rho * FREP + (base0 - rho) * 2;
    LAS unsigned char* Bp = L + VOFF + i16 * VPIT + q4 * 16;
    bf16x8 A[16]; f32x4 acc[16];
#pragma unroll
    for (int rr = 0; rr < 16; ++rr) { A[rr] = *(const LAS bf16x8*)(Ap - 32 * rr); acc[rr] = (f32x4){0.f, 0.f, 0.f, 0.f}; }
    bf16x8 Bn = *(const LAS bf16x8*)(Bp);
    for (int o = 0; o < 8; ++o) {
#pragma unroll
        for (int u = 0; u < 8; ++u) {
            const int st = o * 8 + u;
            const bf16x8 Bf = Bn;
            if (st < 63) Bn = *(const LAS bf16x8*)(Bp + 64 * st + 64);
#pragma unroll
            for (int rr = 0; rr < 16; ++rr) acc[rr] = MFMA16(A[(rr - 2 * u) & 15], Bf, acc[rr]);
            if (st < 63) { A[(-2 * u - 2) & 15] = *(const LAS bf16x8*)(Ap + 64 * st + 64); A[(-2 * u - 1) & 15] = *(const LAS bf16x8*)(Ap + 64 * st + 32); }
        }
    }
#pragma unroll
    for (int rr = 0; rr < 16; ++rr) { u32x2 wv; wv.x = cvtpk(acc[rr].x, acc[rr].y); wv.y = cvtpk(acc[rr].z, acc[rr].w);
        *(u32x2*)(Yg + (size_t)i16 * SEQ + 256 * w + 16 * rr + 4 * q4) = wv; }
}
__device__ __forceinline__ void hyena_unit_ctx(const Fr& F, const bf16_t* Fg, const bf16_t* Vg, bf16_t* Yg) {
    constexpr int FREP = 1024 + 64, VPIT = 512 + 16, VOFF = 8 * FREP;
    LAS unsigned char* L = F.lds;
    __syncthreads();
    if (F.tid < 64) *(LAS u32x4*)(L + F.tid * 16) = *(const u32x4*)(Fg + F.tid * 8);
    if (F.tid >= 64 && F.tid < 68) { const unsigned z = zero_u32(); *(LAS u32x4*)(L + 1024 + (F.tid - 64) * 16) = (u32x4){z, z, z, z}; }
    { const int b = F.tid >> 5, x = F.tid & 31; *(LAS u32x4*)(L + VOFF + b * VPIT + x * 16) = *(const u32x4*)(Vg + (size_t)b * CTX + x * 8); }
    __syncthreads();
    for (int i = F.tid; i < 7 * 256; i += NTHR) { const int rho = 1 + i / 256, x2 = (i % 256) * 2; const int s0 = x2 + rho, s1 = x2 + 1 + rho;
        const unsigned e0 = s0 < 512 ? *(const LAS bf16_t*)(L + s0 * 2) : 0, e1 = s1 < 512 ? *(const LAS bf16_t*)(L + s1 * 2) : 0;
        *(LAS unsigned*)(L + rho * FREP + x2 * 2) = e0 | (e1 << 16); }
    __syncthreads();
    const int i16 = F.lane & 15, q4 = F.lane >> 4, w = F.wave;
    const int base0 = 255 - 32 * w - i16 + 8 * q4, rho = base0 & 7;
    LAS unsigned char* Ap = L + rho * FREP + (base0 - rho) * 2;
    LAS unsigned char* Bp = L + VOFF + i16 * VPIT + q4 * 16;
    f32x4 acc0 = (f32x4){0.f, 0.f, 0.f, 0.f}, acc1 = acc0;
#pragma unroll
    for (int st = 0; st < 8; ++st) { const bf16x8 Bf = *(const LAS bf16x8*)(Bp + 64 * st);
        const bf16x8 A0 = *(const LAS bf16x8*)(Ap + 64 * st), A1 = *(const LAS bf16x8*)(Ap + 64 * st - 32);
        acc0 = MFMA16(A0, Bf, acc0); acc1 = MFMA16(A1, Bf, acc1); }
    u32x2 wv; wv.x = cvtpk(acc0.x, acc0.y); wv.y = cvtpk(acc0.z, acc0.w); *(u32x2*)(Yg + (size_t)i16 * CTX + 32 * w + 4 * q4) = wv;
    wv.x = cvtpk(acc1.x, acc1.y); wv.y = cvtpk(acc1.z, acc1.w); *(u32x2*)(Yg + (size_t)i16 * CTX + 32 * w + 16 + 4 * q4) = wv;
}

__device__ __forceinline__ void mixer_phase(const Fr& F, const Args& a, int l, bool with_ctx, unsigned long long& sacc, const int swhich) {
#if defined(PROBE_P)
    unsigned long long st0 = __builtin_amdgcn_s_memrealtime();
#define SUBMARK(w) do { const unsigned long long t_ = __builtin_amdgcn_s_memrealtime(); if (swhich == (w)) sacc += t_ - st0; st0 = t_; } while (0)
#else
#define SUBMARK(w) do { } while (0)
#endif
    const bf16_t* QA = (const bf16_t*)(a.ws + WS_QA); const bf16_t* QW = QA + 1024;
    unsigned char* Y8 = a.ws + WS_Y8;
    const bf16_t* KA = (const bf16_t*)(a.ws + WS_KA); const bf16_t* KW = (const bf16_t*)(a.ws + WS_KW);
    const bf16_t* VTA = (const bf16_t*)(a.ws + WS_VTA); const bf16_t* VTW = (const bf16_t*)(a.ws + WS_VTW);
    const float* sinks = a.in[I_SINK] + l * 8; const float* qkg = a.in[I_QKG] + l * 256;
    const float* ct = (const float*)(a.ws + WS_ROPE); const float* st = ct + SEQ * 32;
    const int wq = F.wave >> 1, wh = F.wave & 1;
    const int ubid = (F.G % 8 == 0) ? (F.bid & 7) * (F.G >> 3) + (F.bid >> 3) : F.bid;
#define RELANE(FX) do { int t_ = F.wave * 64 + lane_id(); asm volatile("" : "+v"(t_)); FX.tid = t_; FX.lane = t_ & 63; } while (0)
    Fr FA = F; RELANE(FA);
    for (int unit = ubid; unit < NB * 2 * 32; unit += F.G) {
        const int b = unit >> 6, kvh = (unit >> 5) & 1, pb = unit & 31;
        const size_t qo = (size_t)(b * SEQ + pb * 64 + wh * 32) * 1536 + (kvh * 4 + wq) * 64;
        attn_unit<false>(FA, QA + qo, Y8 + qo, KA + (size_t)b * KEYS * 128 + kvh * 64, VTA + (size_t)(b * 2 + kvh) * 64 * KEYS, 0, KEYS / 128, 0, 0, pb * 64 + wh * 32, false, 0.f, qkg, true, ct, st);
    }
    SUBMARK(30);
    Fr FW = F; RELANE(FW);
    for (int unit = ubid; unit < NB * 2 * 32; unit += F.G) {
        const int b = unit >> 6, kvh = (unit >> 5) & 1, pb = unit & 31;
        const size_t qo = (size_t)(b * SEQ + pb * 64 + wh * 32) * 1536 + (kvh * 4 + wq) * 64 + 1024;
        const int lo = pb < 2 ? 0 : (pb - 2) >> 1, hi = ((64 * pb + 191) >> 7) > 15 ? 15 : ((64 * pb + 191) >> 7);
        attn_unit<true>(FW, QA + qo, Y8 + qo, KW + (size_t)b * KEYS * 128 + kvh * 64, VTW + (size_t)(b * 2 + kvh) * 64 * KEYS, 0, 2, 2 + lo, hi - lo + 1, pb * 64 + wh * 32, true, sinks[kvh * 4 + wq] * LOG2E, qkg + 128, true, ct, st);
    }
    SUBMARK(31);
    Fr FC2 = F; RELANE(FC2);
    if (with_ctx) {
        for (int unit = ubid; unit < 2 * NB * 2 * 4; unit += F.G) {
            const int isw = unit >> 7, u2 = unit & 127, b = u2 >> 3, kvh = (u2 >> 2) & 1, pb = u2 & 3;
            const size_t qo = (size_t)(TL + b * CTX + pb * 64 + wh * 32) * 1536 + (kvh * 4 + wq) * 64 + (isw ? 1024 : 0);
            attn_unit<false>(FC2, QA + qo, Y8 + qo, (isw ? KW : KA) + (size_t)b * KEYS * 128 + kvh * 64, (isw ? VTW : VTA) + (size_t)(b * 2 + kvh) * 64 * KEYS, 0, 2, 0, 0, 0, isw != 0, isw ? sinks[kvh * 4 + wq] * LOG2E : 0.f, qkg + (isw ? 128 : 0), false, ct, st);
        }
    }
    SUBMARK(32);
    const bf16_t* FL = (const bf16_t*)(a.ws + WS_FL) + (size_t)l * 512 * 4096; const bf16_t* FC = (const bf16_t*)(a.ws + WS_FC) + (size_t)l * 512 * 512;
    const bf16_t* VT = (const bf16_t*)(a.ws + WS_VT); bf16_t* YT = (bf16_t*)(a.ws + WS_YT);
    Fr FH = F; RELANE(FH);
    for (int c = F.bid; c < HYW; c += F.G) hyena_unit_lat(FH, FL + (size_t)c * 4096, VT + (size_t)c * NB * SEQ, YT + (size_t)c * NB * SEQ);
    if (with_ctx) for (int c = F.bid; c < HYW; c += F.G) hyena_unit_ctx(FH, FC + (size_t)c * 512, VT + VT_CTX_OFF + (size_t)c * NB * CTX, YT + VT_CTX_OFF + (size_t)c * NB * CTX);
    __syncthreads();
    SUBMARK(33);
#undef SUBMARK
#undef RELANE
}

__device__ __forceinline__ float gate_q(float x) { return fminf(256.f * sigmoid_f(x), 255.49f); }
__device__ __forceinline__ unsigned pack_u8x4(float a, float b, float c, float d) { return (unsigned)(int)a | ((unsigned)(int)b << 8) | ((unsigned)(int)c << 16) | ((unsigned)(int)d << 24); }
__device__ __forceinline__ float gq(unsigned w, int k) { return (float)((w >> (8 * k)) & 0xffu) + 0.5f; }
struct EpiInProj {
    static constexpr bool PERM = true, AFTER_DRAIN = false; static constexpr int NSEG = 1;
    unsigned char* ws; int pn_off;
    __device__ __forceinline__ void operator()(const pg8::f32x4 (&acc)[2][2][4][2], const pg8::Unit& u, int wr, int wc, int fr, int fq) const {
        asm volatile("" : "+v"(fr), "+v"(fq));
        const int pn = __builtin_amdgcn_readfirstlane(u.pn) + pn_off; unsigned long long boff; int ldc, colt; bool sig = false;
        if (pn < 2) { boff = WS_QA; ldc = 1536; colt = pn * 256; }
        else if (pn == 2) { boff = WS_RAWA; ldc = 256; colt = 0; }
        else if (pn < 9) { boff = WS_U; ldc = 1536; colt = (pn - 3) * 256; }
        else if (pn < 11) { boff = WS_QA; ldc = 1536; colt = 1024 + (pn - 9) * 256; }
        else if (pn == 11) { boff = WS_RAWW; ldc = 256; colt = 0; }
        else { boff = WS_G; ldc = 3072; colt = (pn - 12) * 256; sig = true; }
        bf16_t* base = (bf16_t*)(ws + boff); unsigned char* Gt = ws + boff;
        const int row0 = u.pm * 256 + wr * 64 + fr, col0 = colt + wc * 32 + 8 * fq;
        if (sig) {
            unsigned char* gb = (unsigned char*)Gt;
#pragma unroll
            for (int ai = 0; ai < 2; ++ai)
#pragma unroll
                for (int m = 0; m < 4; ++m) { unsigned char* rowp = gb + (size_t)(row0 + ai * 128 + m * 16) * 3072 + col0;
#pragma unroll
                    for (int bj = 0; bj < 2; ++bj) { const pg8::f32x4 v0 = acc[ai][bj][m][0], v1 = acc[ai][bj][m][1];
                        u32x2 w; w.x = pack_u8x4(gate_q(v0.x), gate_q(v0.y), gate_q(v0.z), gate_q(v0.w)); w.y = pack_u8x4(gate_q(v1.x), gate_q(v1.y), gate_q(v1.z), gate_q(v1.w));
                        *(u32x2*)(rowp + bj * 128) = w; } }
            return;
        }
#pragma unroll
        for (int ai = 0; ai < 2; ++ai)
#pragma unroll
            for (int m = 0; m < 4; ++m) { bf16_t* rowp = base + (size_t)(row0 + ai * 128 + m * 16) * ldc + col0;
#pragma unroll
                for (int bj = 0; bj < 2; ++bj) { const pg8::f32x4 v0 = acc[ai][bj][m][0], v1 = acc[ai][bj][m][1];
                    u32x4 w; w.x = cvtpk(v0.x, v0.y); w.y = cvtpk(v0.z, v0.w); w.z = cvtpk(v1.x, v1.y); w.w = cvtpk(v1.z, v1.w);
                    *(u32x4*)(rowp + bj * 128) = w; } }
    }
};
struct EpiGate {
    static constexpr bool PERM = true, AFTER_DRAIN = false; static constexpr int NSEG = 1;
    unsigned char* Gt;
    __device__ __forceinline__ void operator()(const pg8::f32x4 (&acc)[2][2][4][2], const pg8::Unit& u, int wr, int wc, int fr, int fq) const {
        asm volatile("" : "+v"(fr), "+v"(fq));
        const int row0 = u.pm * 256 + wr * 64 + fr, col0 = u.pn * 256 + wc * 32 + 8 * fq;
#pragma unroll
        for (int ai = 0; ai < 2; ++ai)
#pragma unroll
            for (int m = 0; m < 4; ++m) { unsigned char* rowp = Gt + (size_t)(row0 + ai * 128 + m * 16) * 3072 + col0;
#pragma unroll
                for (int bj = 0; bj < 2; ++bj) { const pg8::f32x4 v0 = acc[ai][bj][m][0], v1 = acc[ai][bj][m][1];
                    u32x2 w; w.x = pack_u8x4(gate_q(v0.x), gate_q(v0.y), gate_q(v0.z), gate_q(v0.w)); w.y = pack_u8x4(gate_q(v1.x), gate_q(v1.y), gate_q(v1.z), gate_q(v1.w));
                    *(u32x2*)(rowp + bj * 128) = w; } }
    }
};
struct EpiMerge {
    static constexpr bool PERM = true, AFTER_DRAIN = false; static constexpr int NSEG = 3;
    unsigned char* Mo; const unsigned char* Gt;
    __device__ __forceinline__ void rescale(pg8::f32x4 (&acc)[2][2][4][2], const pg8::Unit& u, int seg, int wr, int wc, int fr, int fq) const {
        asm volatile("" : "+v"(fr), "+v"(fq));
        const int row0 = u.pm * 256 + wr * 64 + fr, col0 = u.pn * 256 + wc * 32 + 8 * fq;
        const unsigned char* G0 = Gt + seg * 1024 + col0;
        u32x2 ga[2][4][2], gb[2][4][2];
#pragma unroll
        for (int ai = 0; ai < 2; ++ai)
#pragma unroll
            for (int m = 0; m < 4; ++m)
#pragma unroll
                for (int bj = 0; bj < 2; ++bj) { const size_t row = (size_t)(row0 + ai * 128 + m * 16);
                    ga[ai][m][bj] = *(const u32x2*)(G0 + row * 3072 + bj * 128); gb[ai][m][bj] = *(const u32x2*)(G0 + row * 3072 + 1024 + bj * 128); }
        __builtin_amdgcn_sched_barrier(0);
#pragma unroll
        for (int ai = 0; ai < 2; ++ai)
#pragma unroll
            for (int m = 0; m < 4; ++m)
#pragma unroll
                for (int bj = 0; bj < 2; ++bj) { const u32x2 a = ga[ai][m][bj], b = gb[ai][m][bj]; pg8::f32x4& v0 = acc[ai][bj][m][0]; pg8::f32x4& v1 = acc[ai][bj][m][1];
                    v0.x *= gq(a.x, 0) * fast_rcp(gq(b.x, 0)); v0.y *= gq(a.x, 1) * fast_rcp(gq(b.x, 1)); v0.z *= gq(a.x, 2) * fast_rcp(gq(b.x, 2)); v0.w *= gq(a.x, 3) * fast_rcp(gq(b.x, 3));
                    v1.x *= gq(a.y, 0) * fast_rcp(gq(b.y, 0)); v1.y *= gq(a.y, 1) * fast_rcp(gq(b.y, 1)); v1.z *= gq(a.y, 2) * fast_rcp(gq(b.y, 2)); v1.w *= gq(a.y, 3) * fast_rcp(gq(b.y, 3)); }
        __builtin_amdgcn_sched_barrier(0);
    }
    __device__ __forceinline__ void operator()(const pg8::f32x4 (&acc)[2][2][4][2], const pg8::Unit& u, int wr, int wc, int fr, int fq) const {
        asm volatile("" : "+v"(fr), "+v"(fq));
        const int row0 = u.pm * 256 + wr * 64 + fr, col0 = u.pn * 256 + wc * 32 + 8 * fq;
        constexpr float S = 16.f / 256.f;
        u32x2 gv[2][4][2];
#pragma unroll
        for (int ai = 0; ai < 2; ++ai)
#pragma unroll
            for (int m = 0; m < 4; ++m)
#pragma unroll
                for (int bj = 0; bj < 2; ++bj) gv[ai][m][bj] = *(const u32x2*)(Gt + (size_t)(row0 + ai * 128 + m * 16) * 3072 + 2048 + col0 + bj * 128);
        __builtin_amdgcn_sched_barrier(0);
#pragma unroll
        for (int ai = 0; ai < 2; ++ai) {
#pragma unroll
            for (int m = 0; m < 4; ++m)
#pragma unroll
                for (int bj = 0; bj < 2; ++bj) { const pg8::f32x4 v0 = acc[ai][bj][m][0], v1 = acc[ai][bj][m][1]; const u32x2 g = gv[ai][m][bj];
                    u32x2 w; w.x = cvt4_fp8(v0.x * (gq(g.x, 0) * S), v0.y * (gq(g.x, 1) * S), v0.z * (gq(g.x, 2) * S), v0.w * (gq(g.x, 3) * S));
                    w.y = cvt4_fp8(v1.x * (gq(g.y, 0) * S), v1.y * (gq(g.y, 1) * S), v1.z * (gq(g.y, 2) * S), v1.w * (gq(g.y, 3) * S));
                    *(u32x2*)(Mo + (size_t)(row0 + ai * 128 + m * 16) * 1024 + col0 + bj * 128) = w; }
            __builtin_amdgcn_sched_barrier(0);
        }
    }
};
struct EpiOut {
    static constexpr bool PERM = true, AFTER_DRAIN = false; static constexpr int NSEG = 1;
    const float* xsL; const float* xsC; float* xdL; float* xdC; const float* MODl;
    __device__ __forceinline__ void operator()(const pg8::f32x4 (&acc)[2][2][4][2], const pg8::Unit& u, int wr, int wc, int fr, int fq) const {
        asm volatile("" : "+v"(fr), "+v"(fq));
        const int trow = u.pm * 256; const bool lat = trow < TL;
        const int row0 = trow + wr * 64 + fr, col0 = u.pn * 256 + wc * 32 + 8 * fq;
        const float* md = MODl + (size_t)mod_row(trow) * DIN + 2 * 1024 + col0;
        const float* xs = lat ? xsL + (size_t)row0 * D + col0 : xsC + (size_t)(row0 - TL) * D + col0; float* xd = lat ? xdL + (size_t)row0 * D + col0 : xdC + (size_t)(row0 - TL) * D + col0;
        f32x4 mv[2][2];
#pragma unroll
        for (int bj = 0; bj < 2; ++bj)
#pragma unroll
            for (int n = 0; n < 2; ++n) mv[bj][n] = *(const f32x4*)(md + bj * 128 + 4 * n);
#pragma unroll
        for (int ai = 0; ai < 2; ++ai)
#pragma unroll
            for (int mh = 0; mh < 2; ++mh) {
                f32x4 xv[2][2][2];
#pragma unroll
                for (int mm = 0; mm < 2; ++mm)
#pragma unroll
                    for (int bj = 0; bj < 2; ++bj)
#pragma unroll
                        for (int n = 0; n < 2; ++n) xv[mm][bj][n] = *(const f32x4*)(xs + (size_t)(ai * 128 + (2 * mh + mm) * 16) * D + bj * 128 + 4 * n);
                __builtin_amdgcn_sched_barrier(0);
#pragma unroll
                for (int mm = 0; mm < 2; ++mm)
#pragma unroll
                    for (int bj = 0; bj < 2; ++bj)
#pragma unroll
                        for (int n = 0; n < 2; ++n) { const pg8::f32x4 av = acc[ai][bj][2 * mh + mm][n]; const f32x4 x4 = xv[mm][bj][n], m4 = mv[bj][n];
                            f32x4 o; o.x = fmaf(m4.x, av.x, x4.x); o.y = fmaf(m4.y, av.y, x4.y); o.z = fmaf(m4.z, av.z, x4.z); o.w = fmaf(m4.w, av.w, x4.w);
                            *(f32x4*)(xd + (size_t)(ai * 128 + (2 * mh + mm) * 16) * D + bj * 128 + 4 * n) = o; }
                __builtin_amdgcn_sched_barrier(0);
            }
    }
};
struct EpiMoe1 {
    static constexpr bool PERM = true, AFTER_DRAIN = false; static constexpr int NSEG = 1;
    unsigned char* HM;
    __device__ __forceinline__ void operator()(const pg8::f32x4 (&acc)[2][2][4][2], const pg8::Unit& u, int wr, int wc, int fr, int fq) const {
        asm volatile("" : "+v"(fr), "+v"(fq));
        const int row0 = u.pm * 256 + wr * 64 + fr, hcol0 = (u.pn & 3) * 128 + wc * 16 + 4 * fq;
#pragma unroll
        for (int ai = 0; ai < 2; ++ai)
#pragma unroll
            for (int m = 0; m < 4; ++m) { unsigned char* rowp = HM + (size_t)(row0 + ai * 128 + m * 16) * 512 + hcol0;
#pragma unroll
                for (int bj = 0; bj < 2; ++bj) { const pg8::f32x4 x = acc[ai][bj][m][0], y = acc[ai][bj][m][1] * 8.f;
                    *(unsigned*)(rowp + bj * 64) = cvt4_fp8(x.x * sigmoid_f(x.x) * y.x, x.y * sigmoid_f(x.y) * y.y, x.z * sigmoid_f(x.z) * y.z, x.w * sigmoid_f(x.w) * y.w); } }
    }
};
struct EpiMoe2 {
    static constexpr bool PERM = true, AFTER_DRAIN = false; static constexpr int NSEG = 1;
    bf16_t* Fo; const int* erow; const float* eroww; const LAS int* ebase; const LAS int* ecnt;
    __device__ __forceinline__ void operator()(const pg8::f32x4 (&acc)[2][2][4][2], const pg8::Unit& u, int wr, int wc, int fr, int fq) const {
        asm volatile("" : "+v"(fr), "+v"(fq));
        const int e = u.pn >> 2, cnt = __builtin_amdgcn_readfirstlane(ecnt[e]), pos0 = u.pm * 256 - __builtin_amdgcn_readfirstlane(ebase[e]) + wr * 64 + fr, col0 = (u.pn & 3) * 256 + wc * 32 + 8 * fq;
        const int* er = erow + (size_t)e * TT; const float* ew = eroww + (size_t)e * TT;
#pragma unroll
        for (int ai = 0; ai < 2; ++ai) {
            int rm[4]; float wg[4];
#pragma unroll
            for (int m = 0; m < 4; ++m) { const int pos = pos0 + ai * 128 + m * 16; const bool ok = pos < cnt; rm[m] = ok ? er[ok ? pos : 0] : -1; wg[m] = ew[ok ? pos : 0]; }
            __builtin_amdgcn_sched_barrier(0);
#pragma unroll
            for (int m = 0; m < 4; ++m) { const int r1 = rm[m];
                if (r1 >= 0) { const float wgt = wg[m]; bf16_t* rowp = Fo + ((size_t)(r1 & 1) * TT + (r1 >> 1)) * D + col0;
#pragma unroll
                    for (int bj = 0; bj < 2; ++bj) { const pg8::f32x4 v0 = acc[ai][bj][m][0], v1 = acc[ai][bj][m][1];
                        u32x4 w; w.x = cvtpk(v0.x * wgt, v0.y * wgt); w.y = cvtpk(v0.z * wgt, v0.w * wgt); w.z = cvtpk(v1.x * wgt, v1.y * wgt); w.w = cvtpk(v1.z * wgt, v1.w * wgt);
                        *(u32x4*)(rowp + bj * 128) = w; } } }
            __builtin_amdgcn_sched_barrier(0);
        }
    }
};
struct FusedOutOrder {
    int c, G, nun, wv; const unsigned* ready; unsigned* tmo;
    __device__ __forceinline__ bool next(int i, pg8::Unit& u) const {
        int q;
        if (!ready) { q = i * G + c; if (q >= nun) return false; }
        else if (G == 256 && nun == 576) { if (c < 64) { if (i > 0) return false; q = 512 + c; } else { q = i * 192 + (c - 64); if (q >= 512) return false; } }
        else { q = i * G + (G - 1 - c); if (q >= nun) return false; }
        u.pm = q >> 2; u.pn = q & 3; return true; }
    __device__ __forceinline__ void a_ready(const pg8::Unit& u) const {
        if (!ready) return;
        if (wv == 0) {
            const unsigned long long t0 = __builtin_amdgcn_s_memrealtime(); unsigned polls = 0;
            while ((unsigned)__builtin_amdgcn_readfirstlane(__hip_atomic_load(ready + 64 * u.pm, __ATOMIC_RELAXED, __HIP_MEMORY_SCOPE_AGENT)) < 32u) {
                if ((++polls & 255u) == 0u && __builtin_amdgcn_readfirstlane(__hip_atomic_load(tmo, __ATOMIC_RELAXED, __HIP_MEMORY_SCOPE_AGENT)) != 0u) break;
                if (__builtin_amdgcn_s_memrealtime() - t0 > 20000000ull) { if (lane_id() == 0) __hip_atomic_store(tmo, 1u, __ATOMIC_RELAXED, __HIP_MEMORY_SCOPE_AGENT); break; }
                __builtin_amdgcn_s_sleep(2); }
            __builtin_amdgcn_fence(__ATOMIC_ACQUIRE, "agent");
            asm volatile("s_waitcnt vmcnt(0)" ::: "memory");
        }
        asm volatile("" ::: "memory"); __builtin_amdgcn_s_barrier(); asm volatile("" ::: "memory");
    }
    __device__ __forceinline__ void done(const pg8::Unit&) const {}
};
struct LastInProjOrder {
    pg8::StaticOrder T; int nlat, G, c;
    __device__ __forceinline__ bool next(int i, pg8::Unit& u) const {
        const int L = i * G + c;
        if (L < nlat) return T.next(i, u);
        const int r = L - nlat; if (r >= 32) return false;
        u.pm = 128 + (r >> 1); u.pn = (r & 1) ? 11 : 2; return true; }
    __device__ __forceinline__ void a_ready(const pg8::Unit&) const {}
    __device__ __forceinline__ void done(const pg8::Unit&) const {}
};
struct MoeOrder {
    int nunits, G, c; const LAS int* tile_e;
    __device__ __forceinline__ bool next(int i, pg8::Unit& u) const {
        const int L0 = i * G + c; if (L0 >= nunits) return false;
        const int q = nunits / 8, r = nunits % 8, xcd = L0 % 8, off = L0 / 8; const int L = (xcd < r ? xcd * (q + 1) : r * (q + 1) + (xcd - r) * q) + off;
        const int pm = L >> 2; u.pm = pm; u.pn = __builtin_amdgcn_readfirstlane(tile_e[pm]) * 4 + (L & 3); return true; }
    __device__ __forceinline__ void a_ready(const pg8::Unit&) const {}
    __device__ __forceinline__ void done(const pg8::Unit&) const {}
};

__device__ __forceinline__ int moe_tables(const Fr& F, const Args& a, int l, LAS int* ebase  , LAS int* ecnt  , LAS int* tile_e  ) {
    const unsigned* CNT = (const unsigned*)(a.ws + WS_CTL) + CW_CNT + l * 256;
    __syncthreads();
    if (F.tid == 0) { int acc = 0;
#pragma unroll 1
        for (int e = 0; e < NE; ++e) { const int c = (int)__hip_atomic_load(&CNT[e * 16], __ATOMIC_RELAXED, __HIP_MEMORY_SCOPE_AGENT); ecnt[e] = c; ebase[e] = acc; const int nt = (c + 255) >> 8;
#pragma unroll 1
            for (int t = 0; t < nt; ++t) tile_e[(acc >> 8) + t] = e;
            acc += nt << 8; }
        ebase[NE] = acc; }
    __syncthreads();
    return ebase[NE] >> 8;
}

__device__ __forceinline__ void moe_gather_table(const Fr& F, const Args& a, const MoeOrder& S, const LAS int* ebase, const LAS int* ecnt, LAS int* gidx) {
    const int* EROW = (const int*)(a.ws + WS_EROW);
    for (int j = 0; j < 16; ++j) { pg8::Unit u; if (!S.next(j, u)) break;
        const int e = u.pn >> 2, pos0 = u.pm * 256 - ebase[e], cnt = ecnt[e];
        if (F.tid < 256) { const int pos = pos0 + F.tid; gidx[j * 256 + F.tid] = pos < cnt ? (EROW[(size_t)e * TT + pos] >> 1) : 0; } }
    __syncthreads();
}

#ifndef MK_PER_PHASE
#define MK_PER_PHASE 0
#endif
constexpr int PH_PER_LAYER = 10, PH_FINAL = 1 + NL * PH_PER_LAYER, N_PHASES = PH_FINAL + 1;

__global__ void __launch_bounds__(NTHR, 2) trunk_fwd(Args args) {
    extern __shared__ __attribute__((aligned(16))) unsigned char lds[];
    Fr F; F.lds = (LAS unsigned char*)lds; F.tid = threadIdx.x; F.lane = F.tid & 63; F.wave = __builtin_amdgcn_readfirstlane(F.tid >> 6); F.G = gridDim.x; F.bid = blockIdx.x;
    const int wave0 = F.wave;
    for (int u = F.tid; u < (LDS_BYTES - MISC_OFF) / 4; u += NTHR) ((LAS unsigned*)(F.lds + MISC_OFF))[u] = 0u;
    __syncthreads();
    const int lo = args.ph_lo, hi = args.ph_hi;
    unsigned* ctl = (unsigned*)(args.ws + WS_CTL);
    XcdBarrier bar; bar.bar = ctl + CW_BAR; bar.x = 0; bar.st = (volatile LAS unsigned*)(F.lds + MISC_OFF);
    if (hi - lo > 1) bar = xcd_barrier_post(ctl + CW_BAR, (volatile LAS unsigned*)(F.lds + MISC_OFF));
    bar.wv = (unsigned)wave0;
#ifndef DBG_ONLY
#define DBG_ONLY -1
#endif
#define SEL(p) (DBG_ONLY < 0 || DBG_ONLY == (p))
#define IN(k) (lo <= (k) && (k) < hi)
#define FRESH() do { int t_ = wave0 * 64 + lane_id(); asm volatile("" : "+v"(t_)); F.tid = t_; F.lane = t_ & 63; F.wave = wave0; } while (0)
#define SEAM(k) do { if (IN(k) && IN((k) + 1)) xcd_barrier(bar); } while (0)
#if !defined(PROBE_SUB)
#define PROBE_SUB -1
#endif
    unsigned long long pr_sub = 0ull;
#if defined(PROBE_P)
    unsigned long long pr_acc = 0ull, pr_t0 = __builtin_amdgcn_s_memrealtime();
#define PR_MARK(p) do { const unsigned long long t_ = __builtin_amdgcn_s_memrealtime(); if ((p) == PROBE_P) pr_acc += t_ - pr_t0; pr_t0 = t_; } while (0)
#else
#define PR_MARK(p) do { } while (0)
#endif
    unsigned char* ws = args.ws;
    LAS int* ebase = (LAS int*)(F.lds + MISC_OFF + 64); LAS int* ecnt = ebase + 20; LAS int* tile_e = (LAS int*)(F.lds + MISC_OFF + 512);

    #ifndef DBG_PRO
#define DBG_PRO 7
#endif
    if (SEL(100) && IN(0)) { FRESH(); if (DBG_PRO & 1) pro_mod(F, args); __syncthreads(); if (DBG_PRO & 2) pro_rope(F, args); if (DBG_PRO & 4) pro_filter(F, args); __syncthreads(); }
    SEAM(0); PR_MARK(100);
    for (int l = 0; l < NL; ++l) {
        const int pb = 1 + PH_PER_LAYER * l;
#define LVARS() int lq_ = l; asm volatile("" : "+s"(lq_)); const bool uc = lq_ < NL - 1; const int M2 = uc ? TT : TL; (void)M2; (void)uc
        if (SEL(0) && IN(pb + 0)) { LVARS(); FRESH(); if (l == 0) filter_norm_reduce(F, args); conv_small_weights(F, args, l, 7, 0); rows_p0(F, args, l, TT); __syncthreads(); }
        SEAM(pb + 0); PR_MARK(0);
        if (SEL(1) && IN(pb + 1)) { LVARS();
            pg8::Gemm g{(const bf16_t*)(ws + WS_H8), (const bf16_t*)(ws + WS_WG8), TT, DIN, 512}; EpiInProj E{ws, 0};
            if (uc) { pg8::StaticOrder S; S.init(TT, DIN, F.G, F.bid); pg8::gemm_phase<EpiInProj, pg8::StaticOrder, true, true, false, true, -6>(F.lds, g, S, E, wave0); }
            else { LastInProjOrder S; S.T.init(TL, DIN, F.G, F.bid); S.nlat = (TL / 256) * (DIN / 256); S.G = F.G; S.c = F.bid; pg8::gemm_phase<EpiInProj, LastInProjOrder, true, true, false, true, -6>(F.lds, g, S, E, wave0); }
        }
        SEAM(pb + 1); PR_MARK(1);
        if (SEL(2) && IN(pb + 2)) { LVARS(); FRESH(); prep_phase(F, args, l, uc); }
        SEAM(pb + 2); PR_MARK(2);
        if (SEL(3) && IN(pb + 3)) { LVARS(); FRESH(); mixer_phase(F, args, l, uc, pr_sub, PROBE_SUB); }
        SEAM(pb + 3); PR_MARK(3);
        if (SEL(4) && IN(pb + 4)) { LVARS(); FRESH(); hyena_final_phase(F, args, l, uc); }
        SEAM(pb + 4); PR_MARK(4);
        if (SEL(5) && IN(pb + 5)) { LVARS();
            pg8::StaticOrder S; S.init(M2, 1024, F.G, F.bid);
            pg8::Gemm g{(const bf16_t*)(ws + WS_Y8), (const bf16_t*)(ws + WS_WBR), M2, 1024, 768}; EpiMerge E{ws + WS_H, (const unsigned char*)(ws + WS_G)};
            pg8::gemm_phase<EpiMerge, pg8::StaticOrder, true, true, false, true, -10>(F.lds, g, S, E, wave0);
            { FRESH(); __syncthreads(); const int nun = (M2 / 256) * 4, rem = nun % F.G; conv_expert_weights(F, args, l, rem, 0, CONV_E_ITEMS); __syncthreads(); }
        }
        SEAM(pb + 5); PR_MARK(5);
        if (SEL(6) && IN(pb + 6)) { LVARS();
            pg8::Gemm g{(const bf16_t*)(ws + WS_H), (const bf16_t*)(ws + WS_WOUT), M2, 1024, 512}; pg8::StaticOrder S; S.init(M2, 1024, F.G, F.bid);
            EpiOut E{l == 0 ? args.in[I_X] : args.out, l == 0 ? args.in[I_CTX] : (const float*)(ws + WS_XC), args.out, (float*)(ws + WS_XC), (const float*)(ws + WS_MOD) + (size_t)l * NBM * DIN};
            pg8::gemm_phase<EpiOut, pg8::StaticOrder, true, true, false, true, -10>(F.lds, g, S, E, wave0);
        }
        SEAM(pb + 6); PR_MARK(6);
        if (SEL(7) && IN(pb + 7)) { LVARS(); FRESH(); rows_p5(F, args, l, M2, pr_sub, PROBE_SUB); __syncthreads(); }
        SEAM(pb + 7); PR_MARK(7);
        if (SEL(8) && IN(pb + 8)) { LVARS(); FRESH();
            const int ntile = moe_tables(F, args, l, ebase, ecnt, tile_e);
            pg8::Gemm g{(const bf16_t*)(ws + WS_H), (const bf16_t*)(ws + WS_W13), ntile * 256, NE * 1024, 512}; MoeOrder S{ntile * 4, F.G, F.bid, tile_e};
            LAS int* gidx = (LAS int*)(F.lds + 131072);
            moe_gather_table(F, args, S, ebase, ecnt, gidx);
            EpiMoe1 E{ws + WS_U};
            pg8::gemm_phase<EpiMoe1, MoeOrder, true, true, true, true, -6>(F.lds, g, S, E, wave0, gidx);
        }
        SEAM(pb + 8); PR_MARK(8);
        if (SEL(9) && IN(pb + 9)) { LVARS(); FRESH();
            const int ntile = moe_tables(F, args, l, ebase, ecnt, tile_e);
            pg8::Gemm g{(const bf16_t*)(ws + WS_U), (const bf16_t*)(ws + WS_W2), ntile * 256, NE * 1024, 256}; MoeOrder S{ntile * 4, F.G, F.bid, tile_e};
            EpiMoe2 E{(bf16_t*)(ws + WS_F), (const int*)(ws + WS_EROW), (const float*)(ws + WS_EROWW), ebase, ecnt};
            pg8::gemm_phase<EpiMoe2, MoeOrder, true, true, false, true, -9>(F.lds, g, S, E, wave0);
        }
        SEAM(pb + 9); PR_MARK(9);
    }
    if (SEL(101) && IN(PH_FINAL)) { FRESH(); rows_final(F, args); }
#if defined(PROBE_P)
    PR_MARK(101);
    pr_acc += pr_sub;
    if (blockIdx.x == 0 && F.wave == 0) { const unsigned long long t1 = __builtin_amdgcn_s_memrealtime() + 4ull * pr_acc; while (__builtin_amdgcn_s_memrealtime() < t1) __builtin_amdgcn_s_sleep(8); }
#endif
#undef IN
#undef SEAM
}

extern "C" void kernel_launch(void* const* d_in, const int* in_sizes, int n_in, void* d_out, int out_size, void* d_ws, size_t ws_size, hipStream_t stream) {
    static int grid = 0;
    if (grid == 0) {
        if (n_in != 29 || in_sizes[0] != TL * D || out_size != TL * D || ws_size < WS_END) { fprintf(stderr, "kernel_launch: unexpected shapes / workspace (n_in %d, ws %zu < %zu); nothing launched\n", n_in, ws_size, (size_t)WS_END); grid = -1; return; }
        int dev = 0, cus = 0, per_cu = 0;
        if (hipGetDevice(&dev) != hipSuccess || hipDeviceGetAttribute(&cus, hipDeviceAttributeMultiprocessorCount, dev) != hipSuccess) { grid = -1; return; }
        if (hipFuncSetAttribute((const void*)trunk_fwd, hipFuncAttributeMaxDynamicSharedMemorySize, LDS_BYTES) != hipSuccess) { fprintf(stderr, "kernel_launch: hipFuncSetAttribute failed\n"); grid = -1; return; }
        if (hipOccupancyMaxActiveBlocksPerMultiprocessor(&per_cu, (const void*)trunk_fwd, NTHR, LDS_BYTES) != hipSuccess || per_cu < 1) { fprintf(stderr, "kernel_launch: occupancy query reports %d\n", per_cu); }
        (void)hipGetLastError();
        grid = cus;
    }
    if (grid < 0) return;
    (void)hipMemsetAsync((char*)d_ws + WS_CTL, 0, CTL_ZERO_BYTES, stream);
    Args a{};
    for (int i = 0; i < 29; ++i) a.in[i] = (const float*)d_in[i];
    a.out = (float*)d_out; a.ws = (unsigned char*)d_ws;
#if MK_PER_PHASE
    for (int k = 0; k < N_PHASES; ++k) { a.ph_lo = k; a.ph_hi = k + 1; hipLaunchKernelGGL(trunk_fwd, dim3(grid), dim3(NTHR), LDS_BYTES, stream, a); }
#else
    a.ph_lo = 0; a.ph_hi = N_PHASES;
    hipLaunchKernelGGL(trunk_fwd, dim3(grid), dim3(NTHR), LDS_BYTES, stream, a);
#endif
}
```

```cpp
#include <hip/hip_runtime.h>
#include <cstdio>
#include <cstdint>

#define GAS __attribute__((address_space(1)))
#define LAS __attribute__((address_space(3)))
__device__ __forceinline__ int lane_id() { int l; asm volatile("v_mbcnt_lo_u32_b32 %0, -1, 0\n\tv_mbcnt_hi_u32_b32 %0, -1, %0" : "=v"(l)); return l; }
#define MK_PER_PHASE 0
namespace pg8 {
#define PG8_LAS __attribute__((address_space(3)))
typedef unsigned short bf16_t;
typedef short bf16x8 __attribute__((ext_vector_type(8)));
typedef float f32x4 __attribute__((ext_vector_type(4)));
typedef unsigned u32x4 __attribute__((ext_vector_type(4)));
constexpr int BM = 256, BK = 64, HALF = 128, HTB = HALF * BK * 2  , STAGE_BYTES = 8 * HTB, NXCD = 8, WGM = 8;

__host__ __device__ __forceinline__ int lds_byte(int r, int c) { const int st = (r >> 4) * 2 + (c >> 5), rr = r & 15, cc = c & 31, ob = rr * 64 + cc * 2; return st * 1024 + (ob ^ (((ob >> 9) & 1) << 5)); }
__host__ __device__ __forceinline__ void stage_rc(int b, int& R, int& C) { const int st = b / 1024, sb = b % 1024, swz = sb ^ (((sb >> 9) & 1) << 5); R = (st >> 1) * 16 + swz / 64; C = (st & 1) * 32 + (swz % 64) / 2; }
__host__ __device__ __forceinline__ int perm32(int rho) { const int n = rho >> 4, i = rho & 15; return 8 * (i >> 2) + 4 * n + (i & 3); }

struct Unit { int pm, pn; };
struct Gemm { const bf16_t* A; const bf16_t* Bt; int M, N, K; };

struct StaticOrder {
    int nM, nN, nwg, G, c;
    __host__ __device__ void init(int M, int N, int G_, int c_) { nM = M / BM; nN = N / BM; nwg = nM * nN; G = G_; c = c_; }
    __host__ __device__ bool next(int i, Unit& u) const {
        const long L = (long)i * G + c; if (L >= nwg) return false;
        int wgid = (int)L; { const int q = nwg / NXCD, r = nwg % NXCD, xcd = wgid % NXCD, off = wgid / NXCD; wgid = (xcd < r ? xcd * (q + 1) : r * (q + 1) + (xcd - r) * q) + off; }
        const int nig = WGM * nN, gid = wgid / nig, fm = gid * WGM, gsz = (nM - fm) < WGM ? (nM - fm) : WGM;
        u.pm = fm + ((wgid % nig) % gsz); u.pn = (wgid % nig) / gsz; return true;
    }
    __device__ __forceinline__ void a_ready(const Unit&) const {}
    __device__ __forceinline__ void done(const Unit&) const {}
};
__device__ __forceinline__ unsigned cvt_pk_bf16(float lo, float hi) { unsigned r; asm volatile("v_cvt_pk_bf16_f32 %0, %1, %2" : "=v"(r) : "v"(lo), "v"(hi)); return r; }
typedef float f32x2 __attribute__((ext_vector_type(2)));
template <class Epi, class Sched, bool ALIGN_EPI = false, bool SP2 = false, bool GATHER = false, bool F8 = false, int F8_SW = 0>
__device__ __forceinline__ void gemm_phase(PG8_LAS unsigned char* lds, const Gemm g, const Sched& S, const Epi& E, const int wave_id, const PG8_LAS int* gidx = nullptr) {
    static_assert(!GATHER || SP2, "GATHER is implemented for the SP2 loop only");
    int tid_ = wave_id * 64 + lane_id(); asm volatile("" : "+v"(tid_));
    const int tid = tid_, wid = __builtin_amdgcn_readfirstlane(tid >> 6), lane = tid & 63, wr = wid >> 2, wc = wid & 3, fr = lane & 15, fq = lane >> 4;
    const int K = g.K, nt = K / BK;
    unsigned voffA[2], voffB[2];
#pragma unroll
    for (int i = 0; i < 2; ++i) { int R, C; stage_rc(tid * 16 + i * 8192, R, C); const int Rb = Epi::PERM ? ((R & ~31) + perm32(R & 31)) : R;
        voffA[i] = (unsigned)(R * K + C) * 2u; voffB[i] = (unsigned)(Rb * K + C) * 2u; }
    unsigned goffA[2][2], goffN[2][2];
#define PG8_GOFF(dst, j) do { _Pragma("unroll") for (int _h = 0; _h < 2; ++_h) _Pragma("unroll") for (int _i = 0; _i < 2; ++_i) { int R_, C_; stage_rc(tid * 16 + _i * 8192, R_, C_); \
        dst[_h][_i] = ((unsigned)gidx[(j) * 256 + _h * 128 + R_] * (unsigned)K + (unsigned)C_) * 2u; } } while (0)
#define PG8_STAGE_A(bufoff, base, h, nx) do { if constexpr (GATHER) { unsigned o_[2] = {(nx) ? goffN[h][0] : goffA[h][0], (nx) ? goffN[h][1] : goffA[h][1]}; PG8_STAGE(bufoff, base, o_); } \
        else { PG8_STAGE(bufoff, (base) + ((h) ? hstep : 0), voffA); } } while (0)
    const size_t kstep = (size_t)(BK * 2);
    const size_t hstep = (size_t)HALF * K * 2;
    const size_t tstep = 2 * hstep;
    const unsigned ldsw = (unsigned)wid * 1024u;
    const int aoff = lds_byte(wr * 64 + fr, fq * 8), boff = lds_byte(wc * 32 + fr, fq * 8);
#define PG8_SA(b, h) (((b) * 2 + (h)) * HTB)
#define PG8_SB(b, h) ((4 + (b) * 2 + (h)) * HTB)
#define PG8_STAGE(bufoff, gbase, voff) do { _Pragma("unroll") for (int _i = 0; _i < 2; ++_i) \
        __builtin_amdgcn_global_load_lds((const unsigned*)((const char*)(gbase) + (voff)[_i]), (PG8_LAS unsigned*)(lds + (bufoff) + ldsw + _i * 8192), 16, 0, 0); } while (0)
#define PG8_LDA(dst, b, h) do { _Pragma("unroll") for (int m = 0; m < 4; ++m) _Pragma("unroll") for (int k = 0; k < 2; ++k) dst[m][k] = *(const PG8_LAS bf16x8*)(lds + PG8_SA(b, h) + aoff + m * 2048 + k * 1024); } while (0)
#define PG8_LDB(dst, b, h) do { _Pragma("unroll") for (int n = 0; n < 2; ++n) _Pragma("unroll") for (int k = 0; k < 2; ++k) dst[n][k] = *(const PG8_LAS bf16x8*)(lds + PG8_SB(b, h) + boff + n * 2048 + k * 1024); } while (0)
#define PG8_MMA(ai, bj, At, Bt) do { if constexpr (F8) __builtin_amdgcn_sched_barrier(0); __builtin_amdgcn_s_setprio(1); _Pragma("unroll") for (int m = 0; m < 4; ++m) _Pragma("unroll") for (int n = 0; n < 2; ++n) { \
        if constexpr (F8) { typedef int i32x4_ __attribute__((ext_vector_type(4))); typedef int i32x8_ __attribute__((ext_vector_type(8))); \
            const i32x8_ wf = __builtin_shufflevector(__builtin_bit_cast(i32x4_, Bt[n][0]), __builtin_bit_cast(i32x4_, Bt[n][1]), 0, 1, 2, 3, 4, 5, 6, 7); \
            const i32x8_ af = __builtin_shufflevector(__builtin_bit_cast(i32x4_, At[m][0]), __builtin_bit_cast(i32x4_, At[m][1]), 0, 1, 2, 3, 4, 5, 6, 7); \
              \
            asm volatile("v_mfma_scale_f32_16x16x128_f8f6f4 %0, %1, %2, %0, %3, %4 op_sel_hi:[0,0,0]" : "+v"(acc[ai][bj][m][n]) : "v"(wf), "v"(af), "v"(f8sw), "v"(f8sa)); } \
        else { _Pragma("unroll") for (int k = 0; k < 2; ++k) acc[ai][bj][m][n] = __builtin_amdgcn_mfma_f32_16x16x32_bf16(Bt[n][k], At[m][k], acc[ai][bj][m][n], 0, 0, 0); } } \
        __builtin_amdgcn_s_setprio(0); if constexpr (F8) __builtin_amdgcn_sched_barrier(0); } while (0)
#define PG8_WAIT_V(n) asm volatile("s_waitcnt vmcnt(" #n ")" ::: "memory")
#define PG8_WAIT_L(n) asm volatile("s_waitcnt lgkmcnt(" #n ")" ::: "memory")
#define PG8_BAR __builtin_amdgcn_s_barrier()
#define PG8_SCHED __builtin_amdgcn_sched_barrier(0)
    const int f8sw = 127 + F8_SW, f8sa = 127; (void)f8sw; (void)f8sa;
    Unit cur, nxt; int ui = 0;
    if (!S.next(0, cur)) return;
    f32x4 acc[2][2][4][2];
#pragma unroll
    for (int a = 0; a < 2; ++a)
#pragma unroll
        for (int b = 0; b < 2; ++b)
#pragma unroll
            for (int m = 0; m < 4; ++m)
#pragma unroll
                for (int n = 0; n < 2; ++n) acc[a][b][m][n] = (f32x4){0.f, 0.f, 0.f, 0.f};
    bf16x8 At[4][2], B0[2][2], B1[2][2];
    const char* cA = GATHER ? (const char*)g.A : (const char*)g.A + (size_t)cur.pm * tstep; const char* cB = (const char*)g.Bt + (size_t)cur.pn * tstep;
    if constexpr (GATHER) PG8_GOFF(goffA, 0);
    S.a_ready(cur);
    if constexpr (SP2) {
        PG8_STAGE(PG8_SB(0, 0), cB, voffB); PG8_STAGE(PG8_SB(0, 1), cB + hstep, voffB); PG8_STAGE_A(PG8_SA(0, 0), cA, 0, false); PG8_STAGE_A(PG8_SA(0, 1), cA, 1, false);
        if (wr == 1) PG8_BAR;
        PG8_WAIT_V(2); PG8_BAR;
        PG8_STAGE(PG8_SB(1, 0), cB + kstep, voffB); PG8_STAGE_A(PG8_SA(1, 0), cA + kstep, 0, false); PG8_STAGE(PG8_SB(1, 1), cB + hstep + kstep, voffB);
        PG8_WAIT_V(6); PG8_BAR;
    } else {
        PG8_STAGE(PG8_SB(0, 0), cB, voffB); PG8_STAGE(PG8_SA(0, 0), cA, voffA); PG8_STAGE(PG8_SB(0, 1), cB + hstep, voffB); PG8_STAGE(PG8_SA(0, 1), cA + hstep, voffA);
        if (wr == 1) PG8_BAR;
        PG8_WAIT_V(4); PG8_BAR;
        PG8_STAGE(PG8_SB(1, 0), cB + kstep, voffB); PG8_STAGE(PG8_SA(1, 0), cA + kstep, voffA); PG8_STAGE(PG8_SB(1, 1), cB + hstep + kstep, voffB);
        PG8_WAIT_V(6); PG8_BAR;
    }
    for (;;) {
        const bool has_next = S.next(ui + 1, nxt);
        if constexpr (GATHER) { if (has_next) PG8_GOFF(goffN, ui + 1); else { _Pragma("unroll") for (int _h = 0; _h < 2; ++_h) _Pragma("unroll") for (int _i = 0; _i < 2; ++_i) goffN[_h][_i] = goffA[_h][_i]; } }
        const char* nA = GATHER ? (const char*)g.A : has_next ? (const char*)g.A + (size_t)nxt.pm * tstep : cA; const char* nB = has_next ? (const char*)g.Bt + (size_t)nxt.pn * tstep : cB;
        for (int t = 0; t < nt; t += 2) {
            const bool last = (t == nt - 2);
            const char* a1 = cA + (size_t)(t + 1) * kstep;
            const char* a2 = last ? nA : cA + (size_t)(t + 2) * kstep; const char* b2 = last ? nB : cB + (size_t)(t + 2) * kstep;
            const char* a3 = a2 + kstep; const char* b3 = b2 + kstep;
            if (last && has_next) S.a_ready(nxt);
            if constexpr (SP2) {
            PG8_LDB(B0, 0, 0); PG8_LDB(B1, 0, 1); PG8_SCHED; PG8_LDA(At, 0, 0); PG8_STAGE_A(PG8_SA(1, 1), a1, 1, false);
            PG8_WAIT_V(8); PG8_WAIT_L(0); PG8_BAR; PG8_MMA(0, 0, At, B0); PG8_MMA(0, 1, At, B1); PG8_BAR; PG8_SCHED;
            PG8_LDA(At, 0, 1); PG8_STAGE(PG8_SB(0, 0), b2, voffB); PG8_STAGE(PG8_SB(0, 1), b2 + hstep, voffB); PG8_STAGE_A(PG8_SA(0, 0), a2, 0, last);
            PG8_WAIT_V(8); PG8_WAIT_L(0); PG8_BAR; PG8_MMA(1, 0, At, B0); PG8_MMA(1, 1, At, B1); PG8_BAR; PG8_SCHED;
            PG8_LDB(B0, 1, 0); PG8_LDB(B1, 1, 1); PG8_SCHED; PG8_LDA(At, 1, 0); PG8_STAGE_A(PG8_SA(0, 1), a2, 1, last);
            PG8_WAIT_V(8); PG8_WAIT_L(0); PG8_BAR; PG8_MMA(0, 0, At, B0); PG8_MMA(0, 1, At, B1); PG8_BAR; PG8_SCHED;
            PG8_LDA(At, 1, 1); PG8_STAGE(PG8_SB(1, 0), b3, voffB); PG8_STAGE(PG8_SB(1, 1), b3 + hstep, voffB); PG8_STAGE_A(PG8_SA(1, 0), a3, 0, last);
            PG8_WAIT_V(8); PG8_WAIT_L(0); PG8_BAR; PG8_MMA(1, 0, At, B0); PG8_MMA(1, 1, At, B1); PG8_BAR; PG8_SCHED;
            if constexpr (Epi::NSEG > 1) {
                constexpr int SEGT = F8 ? 4 : 8;
                if (t + 2 < nt && ((t + 2) & (SEGT - 1)) == 0) { if constexpr (F8) asm volatile("s_nop 15\n\ts_nop 15" ::: "memory"); E.rescale(acc, cur, (t + 2) / SEGT - 1, wr, wc, fr, fq); }
            }
            } else {
            PG8_LDB(B0, 0, 0); PG8_SCHED; PG8_LDA(At, 0, 0); PG8_STAGE(PG8_SA(1, 1), a1 + hstep, voffA);
            PG8_WAIT_L(8); PG8_BAR; PG8_WAIT_L(0); PG8_MMA(0, 0, At, B0); PG8_BAR; PG8_SCHED;
            PG8_LDB(B1, 0, 1); PG8_STAGE(PG8_SB(0, 0), b2, voffB);
            PG8_BAR; PG8_WAIT_L(0); PG8_MMA(0, 1, At, B1); PG8_BAR;
            PG8_LDA(At, 0, 1); PG8_STAGE(PG8_SA(0, 0), a2, voffA);
            PG8_BAR; PG8_WAIT_L(0); PG8_MMA(1, 0, At, B0); PG8_BAR; PG8_SCHED;
            PG8_STAGE(PG8_SB(0, 1), b2 + hstep, voffB);
            PG8_WAIT_V(6); PG8_BAR; PG8_MMA(1, 1, At, B1); PG8_BAR;
            PG8_LDB(B0, 1, 0); PG8_SCHED; PG8_LDA(At, 1, 0); PG8_STAGE(PG8_SA(0, 1), a2 + hstep, voffA);
            PG8_WAIT_L(8); PG8_BAR; PG8_WAIT_L(0); PG8_MMA(0, 0, At, B0); PG8_BAR; PG8_SCHED;
            PG8_LDB(B1, 1, 1); PG8_STAGE(PG8_SB(1, 0), b3, voffB);
            PG8_BAR; PG8_WAIT_L(0); PG8_MMA(0, 1, At, B1); PG8_BAR;
            PG8_LDA(At, 1, 1); PG8_STAGE(PG8_SA(1, 0), a3, voffA);
            PG8_BAR; PG8_WAIT_L(0); PG8_MMA(1, 0, At, B0); PG8_BAR; PG8_SCHED;
            PG8_STAGE(PG8_SB(1, 1), b3 + hstep, voffB);
            PG8_WAIT_V(6); PG8_BAR; PG8_MMA(1, 1, At, B1); PG8_BAR;
            }
        }
        if constexpr (ALIGN_EPI) { if (wr == 0) PG8_BAR; }
        if constexpr (F8) asm volatile("s_nop 15\n\ts_nop 15" ::: "memory");
        if constexpr (!Epi::AFTER_DRAIN) { E(acc, cur, wr, wc, fr, fq); S.done(cur); }
        if (!has_next) break;
#pragma unroll
        for (int a = 0; a < 2; ++a)
#pragma unroll
            for (int b = 0; b < 2; ++b)
#pragma unroll
                for (int m = 0; m < 4; ++m)
#pragma unroll
                    for (int n = 0; n < 2; ++n) acc[a][b][m][n] = (f32x4){0.f, 0.f, 0.f, 0.f};
        cur = nxt; cA = nA; cB = nB; ++ui;
        if constexpr (GATHER) { _Pragma("unroll") for (int _h = 0; _h < 2; ++_h) _Pragma("unroll") for (int _i = 0; _i < 2; ++_i) goffA[_h][_i] = goffN[_h][_i]; }
        if constexpr (ALIGN_EPI) { if (wr == 1) PG8_BAR; }
    }
    PG8_WAIT_V(0);
    if constexpr (!ALIGN_EPI) { if (wr == 0) PG8_BAR; }
    PG8_BAR;
    if constexpr (Epi::AFTER_DRAIN) { E.fused(acc, cur, wr, wc, fr, fq, lds, wid, lane); S.done(cur); }
#undef PG8_SA
#undef PG8_SB
#undef PG8_STAGE
#undef PG8_STAGE_A
#undef PG8_GOFF
#undef PG8_LDA
#undef PG8_LDB
#undef PG8_MMA
#undef PG8_WAIT_V
#undef PG8_WAIT_L
#undef PG8_BAR
#undef PG8_SCHED
}
}
#define XB_TMO      128
#define XB_XCNT(j)  (256  + 64 * (j))
#define XB_XSUB(j)  (1280 + 64 * (j))
#define XB_XGEN(j)  (2304 + 64 * (j))
#define XB_TOP      3328
#define XB_TOPGEN   3392
#define XCD_BAR_WORDS 3456
#define XB_SPIN_CAP (1u << 22)
#define LAS __attribute__((address_space(3)))

__device__ __forceinline__ unsigned xb_ld(unsigned* p)              { return __hip_atomic_load(p, __ATOMIC_RELAXED, __HIP_MEMORY_SCOPE_AGENT); }
__device__ __forceinline__ unsigned xb_add(unsigned* p, unsigned v) { asm volatile("" : "+v"(p));
    return __hip_atomic_fetch_add(p, v, __ATOMIC_RELAXED, __HIP_MEMORY_SCOPE_AGENT); }
__device__ __forceinline__ unsigned xb_xcc_id() { return (unsigned)__builtin_amdgcn_s_getreg((3 << 11) | 20) & 0xFu; }
#define XB_SPIN(cond, bar) do { unsigned _sp = 0; while (cond) { __builtin_amdgcn_s_sleep(1); \
    if ((++_sp & 255u) == 0u) { if (xb_ld(&(bar)[XB_TMO])) break; if (_sp > XB_SPIN_CAP) { xb_add(&(bar)[XB_TMO], 1u); break; } } } } while (0)

struct XcdBarrier {
    unsigned* bar; unsigned x; unsigned wv;
    volatile LAS unsigned* st;
};

__device__ __forceinline__ XcdBarrier xcd_barrier_post(unsigned* bar, volatile LAS unsigned* st) {
    XcdBarrier b; b.bar = bar; b.x = xb_xcc_id(); b.st = st;
    if (threadIdx.x == 0) (void)xb_add(&bar[XB_XCNT(b.x)], 1u);
    return b;
}
__device__ __forceinline__ void xcd_barrier_complete(unsigned* bar, unsigned x, unsigned& nloc, unsigned& nx) {
    const unsigned G = gridDim.x * gridDim.y * gridDim.z;
    unsigned sum, cnt, mine, sp = 0u;
    for (;;) {
        sum = 0u; cnt = 0u; mine = 0u;
#pragma unroll
        for (unsigned j = 0; j < 16; ++j) { const unsigned c = xb_ld(&bar[XB_XCNT(j)]); sum += c; cnt += (c > 0u) ? 1u : 0u; mine = (j == x) ? c : mine; }
        if (sum == G) break;
        __builtin_amdgcn_s_sleep(1);
        if ((++sp & 255u) == 0u) { if (xb_ld(&bar[XB_TMO])) break; if (sp > XB_SPIN_CAP) { xb_add(&bar[XB_TMO], 1u); break; } }
    }
    nloc = mine > 0u ? mine : 1u; nx = cnt > 0u ? cnt : 1u;
}

__device__ __forceinline__ void xcd_barrier(const XcdBarrier& b) {
    asm volatile("s_waitcnt vmcnt(0)" ::: "memory");
    __syncthreads();
    if (b.wv == 0u && lane_id() == 0) {
        unsigned* bar = b.bar;
        __builtin_amdgcn_s_waitcnt(0);
        unsigned nloc = b.st[0], nx = b.st[1];
        if (nloc == 0u) { xcd_barrier_complete(bar, b.x, nloc, nx); b.st[0] = nloc; b.st[1] = nx; }
        const unsigned old = xb_add(&bar[XB_XSUB(b.x)], 1u);
        const unsigned gen = old / nloc;
        if (old + 1u == (gen + 1u) * nloc) {
            __builtin_amdgcn_fence(__ATOMIC_RELEASE, "agent");
            asm volatile("s_waitcnt vmcnt(0)" ::: "memory");
            const unsigned og = xb_add(&bar[XB_TOP], 1u);
            const unsigned tg = og / nx;
            if (og + 1u == (tg + 1u) * nx) xb_add(&bar[XB_TOPGEN], 1u);
            else XB_SPIN(xb_ld(&bar[XB_TOPGEN]) == tg, bar);
            __builtin_amdgcn_fence(__ATOMIC_ACQUIRE, "agent");
            xb_add(&bar[XB_XGEN(b.x)], 1u);
            asm volatile("s_waitcnt vmcnt(0)" ::: "memory");
        } else {
            XB_SPIN(xb_ld(&bar[XB_XGEN(b.x)]) == gen, bar);
            __builtin_amdgcn_fence(__ATOMIC_ACQUIRE, "agent");
            asm volatile("s_waitcnt vmcnt(0)" ::: "memory");
        }
    }
    __syncthreads();
}

typedef unsigned short bf16_t;
typedef short bf16x8 __attribute__((ext_vector_type(8)));
typedef float f32x4 __attribute__((ext_vector_type(4)));
typedef float f32x16 __attribute__((ext_vector_type(16)));
typedef unsigned u32x4 __attribute__((ext_vector_type(4)));
typedef unsigned u32x2 __attribute__((ext_vector_type(2)));

constexpr int D = 1024, NB = 16, SEQ = 2048, CTX = 256, NL = 4;
constexpr int TL = NB * SEQ, TC = NB * CTX, TT = TL + TC;
constexpr int DIN = 6144, HYW = 512, NE = 16, DE = 512, KEYS = CTX + SEQ;
constexpr int NMOD = 6, NBM = NB + 1;
constexpr int APROWS = 2 * TT + NE * 256;
constexpr float EPS = 1e-6f, LOG2E = 1.4426950408889634f;
constexpr float QSCALE = 0.125f * LOG2E;

constexpr size_t MiB = 1u << 20;
constexpr size_t WS_CTL = 0, CTL_ZERO_BYTES = 1 * MiB;
constexpr size_t WS_MOD = 1 * MiB;
constexpr size_t WS_ROPE = 3 * MiB;
constexpr size_t WS_FL = 4 * MiB, WS_FC = 20 * MiB;
constexpr size_t WS_MISC = 22 * MiB;
constexpr size_t WS_FNORM = WS_MISC;
constexpr size_t WS_TOKE = WS_MISC + 64 * 1024, WS_TOKP = WS_MISC + 352 * 1024, WS_TOKW = WS_MISC + 640 * 1024;
constexpr size_t WS_ROWMAP = WS_MISC + 960 * 1024, WS_ROWW = WS_MISC + 1280 * 1024;
constexpr size_t WS_WIN = 24 * MiB, WS_WBR = 36 * MiB, WS_WOUT = 39 * MiB;
constexpr size_t WS_XC = 41 * MiB;
constexpr size_t WS_NP = WS_XC;
constexpr size_t WS_H = 57 * MiB;
constexpr size_t WS_KA = 129 * MiB, WS_VTA = 138 * MiB, WS_KW = 147 * MiB, WS_VTW = 156 * MiB;
constexpr size_t WS_QA = 165 * MiB, WS_QW = 201 * MiB, WS_YH = 237 * MiB, WS_VT = 273 * MiB, WS_YT = 309 * MiB;
constexpr size_t WS_RAWA = 309 * MiB, WS_RAWW = 327 * MiB;
constexpr size_t WS_F = 165 * MiB;
constexpr size_t WS_U = 345 * MiB;
constexpr size_t WS_G = 453 * MiB;
constexpr size_t WS_Y8 = 561 * MiB;
constexpr size_t WS_W13 = 621 * MiB, WS_W2 = 637 * MiB;
constexpr size_t WS_EROW = 669 * MiB, WS_EROWW = 672 * MiB;
constexpr size_t WS_H8 = 675 * MiB;
constexpr size_t WS_WG8 = WS_WIN;
constexpr size_t WS_END = 711 * MiB;
static_assert(WS_G + (size_t)TT * 3072 <= WS_Y8 && WS_Y8 + (size_t)TT * 1536 <= WS_W13 && WS_W13 + (size_t)16 * 1024 * 1024 <= WS_W2 && WS_W2 + (size_t)16 * 1024 * 512 <= WS_EROW, "ws map");
static_assert(WS_U + (size_t)APROWS * 1024 <= WS_G && WS_F + (size_t)2 * TT * 2048 <= WS_YT, "ws map 2");
constexpr size_t VT_CTX_OFF = (size_t)HYW * NB * SEQ;

constexpr int CW_BAR = 4096, CW_CNT = 8192, CW_PANEL = 16384, CW_HTMO = 12288;
constexpr int LDS_BYTES = 151552, MISC_OFF = 147456;
constexpr int NWAVES = 8, NTHR = 512;

struct Args { const float* in[29]; float* out; unsigned char* ws; int ph_lo, ph_hi; };
enum { I_X = 0, I_C, I_CTX, I_CCTX, I_ADAW, I_ADAB, I_N1G, I_N2G, I_WIN, I_QKG, I_HSW, I_HSB, I_HW1, I_HB1, I_HFR, I_HW2, I_HB2, I_HW3, I_HBIAS, I_SINK, I_WBR, I_WOUT,
       I_RGW, I_RGB, I_REW, I_REB, I_EW1, I_EW3, I_EW2 };

#define LDS_WAIT() asm volatile("s_waitcnt lgkmcnt(0)" ::: "memory")
#define VM_WAIT() asm volatile("s_waitcnt vmcnt(0)" ::: "memory")

typedef float f32x2_t __attribute__((ext_vector_type(2)));
typedef __bf16 bf16x2_t __attribute__((ext_vector_type(2)));
__device__ __forceinline__ unsigned cvtpk(float lo, float hi) { f32x2_t v = {lo, hi}; bf16x2_t b = __builtin_convertvector(v, bf16x2_t); return __builtin_bit_cast(unsigned, b); }
__device__ __forceinline__ unsigned zero_u32() { unsigned z; asm volatile("v_mov_b32 %0, 0" : "=v"(z)); return z; }
__device__ __forceinline__ float clamp_fp8(float x) { return __builtin_amdgcn_fmed3f(x, -448.f, 448.f); }
__device__ __forceinline__ unsigned cvt4_fp8(float a, float b, float c, float d) { int r = __builtin_amdgcn_cvt_pk_fp8_f32(a, b, 0, false); r = __builtin_amdgcn_cvt_pk_fp8_f32(c, d, r, true); return (unsigned)r; }
__device__ __forceinline__ unsigned cvt4_fp8c(float a, float b, float c, float d) { return cvt4_fp8(clamp_fp8(a), clamp_fp8(b), clamp_fp8(c), clamp_fp8(d)); }
__device__ __forceinline__ float bflo(unsigned u) { return __builtin_bit_cast(float, u << 16); }
__device__ __forceinline__ float bfhi(unsigned u) { return __builtin_bit_cast(float, u & 0xffff0000u); }
__device__ __forceinline__ float bf1(bf16_t u) { return __builtin_bit_cast(float, (unsigned)u << 16); }
__device__ __forceinline__ bf16_t f2bf(float f) { return (bf16_t)(cvtpk(f, 0.f) & 0xffffu); }
#define DPP_F(v, ctrl) __builtin_bit_cast(float, __builtin_amdgcn_update_dpp(0, __builtin_bit_cast(int, (v)), (ctrl), 0xf, 0xf, false))
__device__ __forceinline__ float row16_sum(float v) {
    v += DPP_F(v, 0xB1);
    v += DPP_F(v, 0x4E);
    v += DPP_F(v, 0x141);
    v += DPP_F(v, 0x140);
    return v;
}
__device__ __forceinline__ float wave_sum(float v) {
    v = row16_sum(v);
    const int iv = __builtin_bit_cast(int, v);
    float r = (__builtin_bit_cast(float, __builtin_amdgcn_readlane(iv, 0)) + __builtin_bit_cast(float, __builtin_amdgcn_readlane(iv, 16)))
            + (__builtin_bit_cast(float, __builtin_amdgcn_readlane(iv, 32)) + __builtin_bit_cast(float, __builtin_amdgcn_readlane(iv, 48)));
    asm volatile("" : "+v"(r));
    return r;
}
__device__ __forceinline__ float fast_exp2(float x) { return __builtin_amdgcn_exp2f(x); }
__device__ __forceinline__ float fast_rcp(float x) { return __builtin_amdgcn_rcpf(x); }
__device__ __forceinline__ float sigmoid_f(float x) { return fast_rcp(1.f + fast_exp2(-x * LOG2E)); }

__device__ __forceinline__ void sincos_acc(float x, float& s, float& c) {
    const float q = rintf(x * 0.636619772367581f);
    float y = fmaf(-q, 1.57079625129699707031f, x);
    y = fmaf(-q, 7.54978941586159635335e-08f, y);
    const float y2 = y * y;
    float sp = fmaf(y2, 2.7557314297e-06f, -1.9841270114e-04f); sp = fmaf(sp, y2, 8.3333337680e-03f); sp = fmaf(sp, y2, -1.6666667163e-01f); sp = fmaf(sp * y2, y, y);
    float cp = fmaf(y2, -2.7557314297e-07f, 2.4801587642e-05f); cp = fmaf(cp, y2, -1.3888889225e-03f); cp = fmaf(cp, y2, 4.1666667908e-02f); cp = fmaf(cp, y2, -0.5f); cp = fmaf(cp, y2, 1.0f);
    const int n = (int)q & 3;
    const float s1 = (n & 1) ? cp : sp, c1 = (n & 1) ? sp : cp;
    s = (n & 2) ? -s1 : s1;
    c = ((n + 1) & 2) ? -c1 : c1;
}

struct Fr { LAS unsigned char* lds; int tid, lane, wave, G, bid; };

__device__ __forceinline__ void pro_mod(const Fr& F, const Args& a) {
    LAS float* s = (LAS float*)F.lds;
    LAS float* red = (LAS float*)(F.lds + 69632);
    const float* c = a.in[I_C]; const float* cc = a.in[I_CCTX]; const float* W = a.in[I_ADAW]; const float* Bv = a.in[I_ADAB];
    float* MOD = (float*)(a.ws + WS_MOD);
    for (int i = F.tid; i < NBM * 1024; i += NTHR) { const int bb = i >> 10, k = i & 1023; const float v = (bb < NB) ? c[bb * 1024 + k] : cc[k]; s[i] = v / (1.f + __expf(-v)); }
    __syncthreads();
    const int col = F.tid & 63, ks = F.wave;
    for (int unit = F.G - 1 - F.bid; unit < NL * 96; unit += F.G) {
        const int l = unit / 96, j0 = (unit % 96) * 64;
        float acc[NBM];
#pragma unroll
        for (int bb = 0; bb < NBM; ++bb) acc[bb] = 0.f;
        const float* Wp = W + ((size_t)l * 1024 + ks * 128) * DIN + j0 + col;
#pragma unroll 2
        for (int k = 0; k < 128; k += 4) {
            const float w0 = Wp[(size_t)k * DIN], w1 = Wp[(size_t)(k + 1) * DIN], w2 = Wp[(size_t)(k + 2) * DIN], w3 = Wp[(size_t)(k + 3) * DIN];
#pragma unroll
            for (int bb = 0; bb < NBM; ++bb) { const f32x4 sv = *(const LAS f32x4*)(s + bb * 1024 + ks * 128 + k);
                acc[bb] = fmaf(sv.x, w0, acc[bb]); acc[bb] = fmaf(sv.y, w1, acc[bb]); acc[bb] = fmaf(sv.z, w2, acc[bb]); acc[bb] = fmaf(sv.w, w3, acc[bb]); } }
#pragma unroll
        for (int bb = 0; bb < NBM; ++bb) red[(ks * NBM + bb) * 64 + col] = acc[bb];
        __syncthreads();
        for (int o = F.tid; o < NBM * 64; o += NTHR) { const int bb = o >> 6, cx = o & 63; float sum = 0.f;
#pragma unroll
            for (int k2 = 0; k2 < 8; ++k2) sum += red[(k2 * NBM + bb) * 64 + cx];
            MOD[((size_t)l * NBM + bb) * DIN + j0 + cx] = sum + Bv[l * DIN + j0 + cx]; }
        __syncthreads();
    }
}

__device__ __forceinline__ void pro_rope(const Fr& F, const Args& a) {
    float* ct = (float*)(a.ws + WS_ROPE); float* st = ct + SEQ * 32;
    for (int i = F.bid * NTHR + F.tid; i < SEQ * 32; i += F.G * NTHR) {
        const int pos = i >> 5, ax = (i >> 4) & 1, f = i & 15;
        const float inv = exp2f(-(float)f * (13.287712379549449f / 16.f));
        const float ang = (float)(ax == 0 ? (pos >> 6) : (pos & 63)) * inv;
        float sv, cv; sincos_acc(ang, sv, cv); ct[i] = cv; st[i] = sv;
    }
}

__device__ __forceinline__ void pro_filter(const Fr& F, const Args& a) {
    LAS float* L = (LAS float*)F.lds;
    constexpr int oW1 = 0, oB1 = 2112, oFR = 2176, oB2 = 2240, oW2 = 2304, oZ = 6400, oH1 = 7552, oH2 = 9600, H2P = 68, oT = 11776, TP = 36;
    bf16_t* FL = (bf16_t*)(a.ws + WS_FL); bf16_t* FC = (bf16_t*)(a.ws + WS_FC); float* NP = (float*)(a.ws + WS_NP);
    const int p = F.tid >> 4, jj = F.tid & 15;
    for (int unit = F.bid; unit < NL * 72; unit += F.G) {
        const int l = unit / 72, ch = unit % 72; const bool lat = ch < 64; const int n = lat ? SEQ : CTX, pos0 = lat ? ch * 32 : (ch - 64) * 32;
        __syncthreads();
        for (int i = F.tid; i < 2112; i += NTHR) L[oW1 + i] = a.in[I_HW1][l * 2112 + i];
        for (int i = F.tid; i < 64; i += NTHR) { L[oB1 + i] = a.in[I_HB1][l * 64 + i]; L[oFR + i] = a.in[I_HFR][l * 64 + i]; L[oB2 + i] = a.in[I_HB2][l * 64 + i]; }
        for (int i = F.tid; i < 4096; i += NTHR) L[oW2 + i] = a.in[I_HW2][l * 4096 + i];
        const int pos = pos0 + p; const float t = (float)pos / (float)(n - 1);
        { const float band = 1e-4f + (float)jj * ((15.f - 1e-4f) / 15.f); const float ang = ((6.2831855f * band) * (float)pos) / (float)n;
          float sv, cv; sincos_acc(ang, sv, cv); L[oZ + p * 36 + 1 + jj] = cv; L[oZ + p * 36 + 17 + jj] = -sv; if (jj == 0) L[oZ + p * 36] = t; }
        __syncthreads();
        { f32x4 acc = *(const LAS f32x4*)(L + oB1 + 4 * jj);
#pragma unroll 3
          for (int i = 0; i < 33; ++i) { const float z = L[oZ + p * 36 + i]; const f32x4 w = *(const LAS f32x4*)(L + oW1 + i * 64 + 4 * jj); acc.x = fmaf(z, w.x, acc.x); acc.y = fmaf(z, w.y, acc.y); acc.z = fmaf(z, w.z, acc.z); acc.w = fmaf(z, w.w, acc.w); }
          const f32x4 fr = *(const LAS f32x4*)(L + oFR + 4 * jj); float sv, cv; f32x4 o;
          sincos_acc(fr.x * acc.x, sv, cv); o.x = sv; sincos_acc(fr.y * acc.y, sv, cv); o.y = sv; sincos_acc(fr.z * acc.z, sv, cv); o.z = sv; sincos_acc(fr.w * acc.w, sv, cv); o.w = sv;
          *(LAS f32x4*)(L + oH1 + p * 64 + 4 * jj) = o; }
        __syncthreads();
        { f32x4 acc = *(const LAS f32x4*)(L + oB2 + 4 * jj);
#pragma unroll 4
          for (int i = 0; i < 64; ++i) { const float z = L[oH1 + p * 64 + i]; const f32x4 w = *(const LAS f32x4*)(L + oW2 + i * 64 + 4 * jj); acc.x = fmaf(z, w.x, acc.x); acc.y = fmaf(z, w.y, acc.y); acc.z = fmaf(z, w.z, acc.z); acc.w = fmaf(z, w.w, acc.w); }
          const f32x4 fr = *(const LAS f32x4*)(L + oFR + 4 * jj); float sv, cv; f32x4 o;
          sincos_acc(fr.x * acc.x, sv, cv); o.x = sv; sincos_acc(fr.y * acc.y, sv, cv); o.y = sv; sincos_acc(fr.z * acc.z, sv, cv); o.z = sv; sincos_acc(fr.w * acc.w, sv, cv); o.w = sv;
          *(LAS f32x4*)(L + oH2 + p * H2P + 4 * jj) = o; }
        LAS bf16_t* T = (LAS bf16_t*)(L + oT);
        __syncthreads();
        {
            const int j16 = F.lane & 15, kq = F.lane >> 4;
            const float* W3p = a.in[I_HW3] + ((size_t)l * 64 + 4 * kq) * 1024 + 128 * F.wave + 4 * j16;
            f32x4 acc[2][4][2];
#pragma unroll
            for (int h = 0; h < 2; ++h)
#pragma unroll
                for (int cb = 0; cb < 4; ++cb)
#pragma unroll
                    for (int rb = 0; rb < 2; ++rb) acc[h][cb][rb] = (f32x4){0.f, 0.f, 0.f, 0.f};
            f32x4 bw[2][4][2];
#define PF_LDW(buf, s) do { _Pragma("unroll") for (int j = 0; j < 4; ++j) _Pragma("unroll") for (int h = 0; h < 2; ++h) bw[buf][j][h] = *(const f32x4*)(W3p + (size_t)(16 * (s) + j) * 1024 + 64 * h); } while (0)
            PF_LDW(0, 0);
#pragma unroll
            for (int s = 0; s < 4; ++s) {
                if (s + 1 < 4) PF_LDW((s + 1) & 1, s + 1);
                f32x4 av[2];
#pragma unroll
                for (int rb = 0; rb < 2; ++rb) av[rb] = *(const LAS f32x4*)(L + oH2 + (rb * 16 + j16) * H2P + 16 * s + 4 * kq);
#pragma unroll
                for (int j = 0; j < 4; ++j)
#pragma unroll
                    for (int h = 0; h < 2; ++h)
#pragma unroll
                        for (int cb = 0; cb < 4; ++cb)
#pragma unroll
                            for (int rb = 0; rb < 2; ++rb) acc[h][cb][rb] = __builtin_amdgcn_mfma_f32_16x16x4f32(av[rb][j], bw[s & 1][j][h][cb], acc[h][cb][rb], 0, 0, 0);
            }
#undef PF_LDW
            const int dir = F.wave >> 2;
            float tt[2][4];
#pragma unroll
            for (int rb = 0; rb < 2; ++rb)
#pragma unroll
                for (int r = 0; r < 4; ++r) tt[rb][r] = (float)(pos0 + rb * 16 + 4 * kq + r) / (float)(n - 1);
#pragma unroll
            for (int h = 0; h < 2; ++h)
#pragma unroll
                for (int cb = 0; cb < 4; ++cb) { const int col = 128 * F.wave + 64 * h + 4 * j16 + cb, c = col & 511;
                    const float dl = fabsf(-3.0701134573253943f + (-15.350567286626972f + 3.0701134573253943f) * ((float)c / 511.f));
#pragma unroll
                    for (int rb = 0; rb < 2; ++rb) { const int p0 = rb * 16 + 4 * kq; float v[4];
#pragma unroll
                        for (int r = 0; r < 4; ++r) { v[r] = acc[h][cb][rb][r] * __expf(-tt[rb][r] * dl); if (dir == 1 && pos0 + p0 + r == 0) v[r] = 0.f; }
                        u32x2 w;
                        if (dir == 0) { w.x = cvtpk(v[3], v[2]); w.y = cvtpk(v[1], v[0]); *(LAS u32x2*)(T + col * TP + 28 - p0) = w; }
                        else { w.x = cvtpk(v[0], v[1]); w.y = cvtpk(v[2], v[3]); *(LAS u32x2*)(T + col * TP + p0) = w; } } }
        }
        __syncthreads();
        for (int idx = F.tid; idx < 1024 * 32; idx += NTHR) { const int col = idx >> 5, i = idx & 31, dir = col >> 9, c = col & 511;
            const int u = (dir == 0) ? (n - 32 - pos0 + i) : ((pos0 + i == 0) ? 2 * n - 1 : n - 1 + pos0 + i);
            bf16_t* Fb = lat ? FL + ((size_t)l * 512 + c) * 4096 : FC + ((size_t)l * 512 + c) * 512;
            Fb[u] = T[col * TP + i]; }
        for (int col = F.tid; col < 1024; col += NTHR) { float sum = 0.f;
#pragma unroll 8
            for (int i = 0; i < 32; ++i) sum += fabsf(bf1(T[col * TP + i]));
            NP[((size_t)l * 72 + ch) * 1024 + col] = sum; }
    }
    __syncthreads();
}
__device__ __forceinline__ void filter_norm_reduce(const Fr& F, const Args& a) {
    const float* NP = (const float*)(a.ws + WS_NP); float* FN = (float*)(a.ws + WS_FNORM);
    for (int o = F.bid * NTHR + F.tid; o < NL * 2 * 512; o += F.G * NTHR) { const int l = o >> 10, isc = (o >> 9) & 1, c = o & 511;
        const int ch0 = isc ? 64 : 0, ch1 = isc ? 72 : 64; float sum = 0.f;
        for (int ch = ch0; ch < ch1; ++ch) sum += NP[((size_t)l * 72 + ch) * 1024 + c] + NP[((size_t)l * 72 + ch) * 1024 + 512 + c];
        FN[o] = 1.f / sum; }
}

template <int MODE>
__device__ __forceinline__ void transpose_item(const float* W, int K, int N, bf16_t* WT, int row_off, LAS float* scr, int item, int lane, int ldk = 0) {
    if (ldk == 0) ldk = K;
    const int nblk = N / 64, kb = item / nblk, nb = item % nblk, k0 = 64 * kb, n0 = 64 * nb;
    f32x4 v[16];
#pragma unroll
    for (int i = 0; i < 16; ++i) v[i] = *(const f32x4*)(W + (size_t)(k0 + 4 * i + (lane >> 4)) * N + n0 + (lane & 15) * 4);
#pragma unroll
    for (int i = 0; i < 16; ++i) *(LAS f32x4*)(scr + (4 * i + (lane >> 4)) * 68 + (lane & 15) * 4) = v[i];
    LDS_WAIT();
    const int c = lane & 7;
#pragma unroll
    for (int j = 0; j < 8; ++j) { const int n = (lane >> 3) + 8 * j; const LAS float* s = scr + (8 * c) * 68 + n;
        u32x4 o; o.x = cvtpk(s[0 * 68], s[1 * 68]); o.y = cvtpk(s[2 * 68], s[3 * 68]); o.z = cvtpk(s[4 * 68], s[5 * 68]); o.w = cvtpk(s[6 * 68], s[7 * 68]);
        const int nn = n0 + n; const int row = (MODE == 0) ? nn : ((nn >> 2) * 8 + (nn & 3) + (MODE == 2 ? 4 : 0));
        *(u32x4*)(WT + (size_t)(row_off + row) * ldk + k0 + 8 * c) = o; }
    LDS_WAIT();
}

template <int MODE>
__device__ __forceinline__ void transpose_item_f8(const float* W, int K, int N, unsigned char* WT, int row_off, LAS float* scr, int item, int lane, int ldk = 0) {
    if (ldk == 0) ldk = K;
    const int nblk = N / 64, kb = item / nblk, nb = item % nblk, k0 = 64 * kb, n0 = 64 * nb;
    f32x4 v[16];
#pragma unroll
    for (int i = 0; i < 16; ++i) v[i] = *(const f32x4*)(W + (size_t)(k0 + 4 * i + (lane >> 4)) * N + n0 + (lane & 15) * 4);
#pragma unroll
    for (int i = 0; i < 16; ++i) *(LAS f32x4*)(scr + (4 * i + (lane >> 4)) * 68 + (lane & 15) * 4) = v[i];
    LDS_WAIT();
    const int c = lane & 7;
#pragma unroll
    for (int j = 0; j < 8; ++j) { const int n = (lane >> 3) + 8 * j; const LAS float* s = scr + (8 * c) * 68 + n;
        u32x2 o; o.x = cvt4_fp8(s[0 * 68] * 64.f, s[1 * 68] * 64.f, s[2 * 68] * 64.f, s[3 * 68] * 64.f); o.y = cvt4_fp8(s[4 * 68] * 64.f, s[5 * 68] * 64.f, s[6 * 68] * 64.f, s[7 * 68] * 64.f);
        const int nn = n0 + n; const int row = (MODE == 0) ? nn : ((nn >> 2) * 8 + (nn & 3) + (MODE == 2 ? 4 : 0));
        *(u32x2*)(WT + (size_t)(row_off + row) * ldk + k0 + 8 * c) = o; }
    LDS_WAIT();
}
__device__ __forceinline__ void conv_small_weights(const Fr& F, const Args& a, int l, int mask, int b0) {
    if (F.bid < b0) return;
    LAS float* scr = (LAS float*)(F.lds + F.wave * 17408);
    const int gw = (F.bid - b0) * NWAVES + F.wave, NGW = (F.G - b0) * NWAVES;
    constexpr int I_IN = (1024 / 64) * (DIN / 64), I_BR = (512 / 64) * (1024 / 64), I_OUT = (1024 / 64) * (1024 / 64);
    if (mask & 1) for (int it = gw; it < I_IN; it += NGW) transpose_item_f8<0>(a.in[I_WIN] + (size_t)l * 1024 * DIN, 1024, DIN, a.ws + WS_WG8, 0, scr, it, F.lane);
    if (mask & 2) for (int it = gw; it < 3 * I_BR; it += NGW) { const int b = it / I_BR; transpose_item_f8<0>(a.in[I_WBR] + ((size_t)l * 3 + b) * 512 * 1024, 512, 1024, a.ws + WS_WBR + b * 512, 0, scr, it % I_BR, F.lane, 1536); }
    if (mask & 4) for (int it = gw; it < I_OUT; it += NGW) transpose_item_f8<0>(a.in[I_WOUT] + (size_t)l * 1024 * 1024, 1024, 1024, a.ws + WS_WOUT, 0, scr, it, F.lane);
}
__device__ __forceinline__ void conv_expert_weights(const Fr& F, const Args& a, int l, int b0, int it0, int it1) {
    if (F.bid < b0) return;
    LAS float* scr = (LAS float*)(F.lds + F.wave * 17408);
    const int gw = (F.bid - b0) * NWAVES + F.wave, NGW = (F.G - b0) * NWAVES;
    constexpr int I_1 = (1024 / 64) * (512 / 64), I_2 = (512 / 64) * (1024 / 64);
    for (int it = it0 + gw; it < it1; it += NGW) {
        const int e = it / (2 * I_1 + I_2); int r = it % (2 * I_1 + I_2);
        unsigned char* W13 = a.ws + WS_W13; unsigned char* W2 = a.ws + WS_W2;
        if (r < I_1) { transpose_item_f8<1>(a.in[I_EW1] + ((size_t)l * NE + e) * 1024 * 512, 1024, 512, W13, e * 1024, scr, r, F.lane); continue; } r -= I_1;
        if (r < I_1) { transpose_item_f8<2>(a.in[I_EW3] + ((size_t)l * NE + e) * 1024 * 512, 1024, 512, W13, e * 1024, scr, r, F.lane); continue; } r -= I_1;
        transpose_item_f8<0>(a.in[I_EW2] + ((size_t)l * NE + e) * 512 * 1024, 512, 1024, W2, e * 1024, scr, r, F.lane);
    }
}
constexpr int CONV_E_ITEMS = NE * 384, CONV_E_SPLIT = CONV_E_ITEMS / 2;

__device__ __forceinline__ int mod_row(int row) { return row < TL ? (row >> 11) : NB; }

__device__ __forceinline__ void rows_p0(const Fr& F, const Args& a, int l, int nrows) {
    const int gw = F.bid * NWAVES + F.wave, NGW = F.G * NWAVES;
    const float* g1 = a.in[I_N1G] + l * 1024;
    const float* MODl = (const float*)(a.ws + WS_MOD) + (size_t)l * NBM * DIN;
    const float* MODp = (const float*)(a.ws + WS_MOD) + (size_t)(l > 0 ? l - 1 : 0) * NBM * DIN;
    const bf16_t* Fs = (const bf16_t*)(a.ws + WS_F);
    unsigned char* H8 = a.ws + WS_H8;
    const int per = 2 * ((nrows + 2 * NGW - 1) / (2 * NGW)), w0 = gw * per, w1 = (w0 + per < nrows) ? w0 + per : nrows;
    f32x4 gv[4], shv[4], scv[4], m5v[4]; int cur = -1;
#pragma unroll
    for (int j = 0; j < 4; ++j) { gv[j] = *(const f32x4*)(g1 + F.lane * 4 + 256 * j); shv[j] = gv[j]; scv[j] = gv[j]; m5v[j] = gv[j]; }
#define P0_LOAD(rb, V, F0, F1) do { _Pragma("unroll") for (int q = 0; q < 2; ++q) { const int row = (rb) + q; const bool lat = row < TL; \
            const float* xs = lat ? ((l == 0) ? a.in[I_X] + (size_t)row * D : a.out + (size_t)row * D) : ((l == 0) ? a.in[I_CTX] + (size_t)(row - TL) * D : (const float*)(a.ws + WS_XC) + (size_t)(row - TL) * D); \
            _Pragma("unroll") for (int j = 0; j < 4; ++j) { const int col = F.lane * 4 + 256 * j; V[q][j] = *(const f32x4*)(xs + col); \
                if (l > 0) { F0[q][j] = *(const u32x2*)(Fs + (size_t)row * D + col); F1[q][j] = *(const u32x2*)(Fs + ((size_t)TT + row) * D + col); } } } } while (0)
#define P0_PROC(rb, V, F0, F1) do { _Pragma("unroll") for (int q = 0; q < 2; ++q) { const int row = (rb) + q; const bool lat = row < TL; const int mr = mod_row(row); \
            if (mr != cur) { cur = mr; _Pragma("unroll") for (int j = 0; j < 4; ++j) { const int col = F.lane * 4 + 256 * j; \
                shv[j] = *(const f32x4*)(MODl + (size_t)mr * DIN + col); scv[j] = *(const f32x4*)(MODl + (size_t)mr * DIN + 1024 + col); m5v[j] = *(const f32x4*)(MODp + (size_t)mr * DIN + 5 * 1024 + col); } } \
            float* xd = lat ? a.out + (size_t)row * D : (float*)(a.ws + WS_XC) + (size_t)(row - TL) * D; float ss = 0.f; \
            if (l > 0) { _Pragma("unroll") for (int j = 0; j < 4; ++j) { const int col = F.lane * 4 + 256 * j; \
                    V[q][j].x += m5v[j].x * (bflo(F0[q][j].x) + bflo(F1[q][j].x)); V[q][j].y += m5v[j].y * (bfhi(F0[q][j].x) + bfhi(F1[q][j].x)); \
                    V[q][j].z += m5v[j].z * (bflo(F0[q][j].y) + bflo(F1[q][j].y)); V[q][j].w += m5v[j].w * (bfhi(F0[q][j].y) + bfhi(F1[q][j].y)); \
                    *(f32x4*)(xd + col) = V[q][j]; } } \
            _Pragma("unroll") for (int j = 0; j < 4; ++j) ss += (V[q][j].x * V[q][j].x + V[q][j].y * V[q][j].y) + (V[q][j].z * V[q][j].z + V[q][j].w * V[q][j].w); \
            const float r = 1.f / sqrtf(wave_sum(ss) * (1.f / D) + EPS); \
            _Pragma("unroll") for (int j = 0; j < 4; ++j) { const int col = F.lane * 4 + 256 * j; \
                const f32x4 o = (V[q][j] * r * gv[j]) * (scv[j] + 1.f) + shv[j]; \
                *(unsigned*)(H8 + (size_t)row * D + col) = cvt4_fp8(o.x, o.y, o.z, o.w); } } } while (0)
    f32x4 vA[2][4], vB[2][4]; u32x2 fA0[2][4], fA1[2][4], fB0[2][4], fB1[2][4];
    if (w0 < w1) P0_LOAD(w0, vA, fA0, fA1);
    for (int rb = w0; rb < w1; rb += 4) {
        if (rb + 2 < w1) P0_LOAD(rb + 2, vB, fB0, fB1);
        P0_PROC(rb, vA, fA0, fA1);
        if (rb + 2 < w1) { if (rb + 4 < w1) P0_LOAD(rb + 4, vA, fA0, fA1); P0_PROC(rb + 2, vB, fB0, fB1); }
    }
#undef P0_LOAD
#undef P0_PROC
}
__device__ __forceinline__ void rows_final(const Fr& F, const Args& a) {
    const int gw = F.bid * NWAVES + F.wave, NGW = F.G * NWAVES;
    const float* MODp = (const float*)(a.ws + WS_MOD) + (size_t)(NL - 1) * NBM * DIN;
    const bf16_t* Fs = (const bf16_t*)(a.ws + WS_F);
    for (int row = gw; row < TL; row += NGW) {
        const int mr = row >> 11; float* xd = a.out + (size_t)row * D;
#pragma unroll
        for (int j = 0; j < 4; ++j) { const int col = F.lane * 4 + 256 * j;
            f32x4 v = *(const f32x4*)(xd + col);
            const u32x2 f0 = *(const u32x2*)(Fs + (size_t)row * D + col), f1 = *(const u32x2*)(Fs + ((size_t)TT + row) * D + col);
            const f32x4 m5 = *(const f32x4*)(MODp + (size_t)mr * DIN + 5 * 1024 + col);
            v.x += m5.x * (bflo(f0.x) + bflo(f1.x)); v.y += m5.y * (bfhi(f0.x) + bfhi(f1.x)); v.z += m5.z * (bflo(f0.y) + bflo(f1.y)); v.w += m5.w * (bfhi(f0.y) + bfhi(f1.y));
            *(f32x4*)(xd + col) = v; }
    }
}

__device__ __forceinline__ void rows_p5(const Fr& F, const Args& a, int l, int nrows, unsigned long long& sacc, const int swhich) {
#if defined(PROBE_P)
    unsigned long long st0 = __builtin_amdgcn_s_memrealtime();
#define SUBMARK5(w) do { const unsigned long long t_ = __builtin_amdgcn_s_memrealtime(); if (swhich == (w)) sacc += t_ - st0; st0 = t_; } while (0)
#else
#define SUBMARK5(w) do { } while (0)
#endif
    typedef float f32x4v __attribute__((ext_vector_type(4)));
    LAS float* RW = (LAS float*)F.lds;
    constexpr int RWS = 1028;
    LAS float* RB = (LAS float*)(F.lds + 82304);
    LAS int* LC = (LAS int*)(F.lds + 82432);
    LAS int* TE = (LAS int*)(F.lds + 82560);
    LAS int* TP = TE + 256;
    LAS float* TW = (LAS float*)(TP + 256);
    LAS float* RN = (LAS float*)(F.lds + 86784);
    LAS float* LG = (LAS float*)(F.lds + 87424);
    LAS float* GM = (LAS float*)(F.lds + 99072);
    LAS float* BI = (LAS float*)(F.lds + 107264);
    const float* g2 = a.in[I_N2G] + l * 1024;
    const float* MODl = (const float*)(a.ws + WS_MOD) + (size_t)l * NBM * DIN;
    unsigned char* H8 = a.ws + WS_H;
    int* EROW = (int*)(a.ws + WS_EROW); float* EROWW = (float*)(a.ws + WS_EROWW);
    unsigned* CNT = (unsigned*)(a.ws + WS_CTL) + CW_CNT + l * 256;
    for (int f = F.tid; f < 1024; f += NTHR) { const f32x4 v = *(const f32x4*)(a.in[I_RGW] + ((size_t)l * 1024 + f) * 4);
        RW[0 * RWS + f] = v.x; RW[1 * RWS + f] = v.y; RW[2 * RWS + f] = v.z; RW[3 * RWS + f] = v.w; }
    for (int f = F.tid; f < 4096; f += NTHR) { const int k = f >> 2, c4 = (f & 3) * 4; const f32x4 v = *(const f32x4*)(a.in[I_REW] + ((size_t)l * 1024 + k) * 16 + c4);
        RW[(4 + c4) * RWS + k] = v.x; RW[(5 + c4) * RWS + k] = v.y; RW[(6 + c4) * RWS + k] = v.z; RW[(7 + c4) * RWS + k] = v.w; }
    if (F.tid < 20) RB[F.tid] = (F.tid < 4) ? a.in[I_RGB][l * 4 + F.tid] : a.in[I_REB][l * 16 + F.tid - 4];
    constexpr int P5_CH = 144;
    const int nch = (nrows + P5_CH - 1) / P5_CH;
    SUBMARK5(40);
    for (int ch = F.bid; ch < nch; ch += F.G) {
    const int r0 = ch * P5_CH, r1 = (r0 + P5_CH < nrows) ? r0 + P5_CH : nrows;
    const int mb0 = mod_row(r0), mb1 = mod_row(r1 - 1);
    if (F.tid < 32) LC[F.tid] = 0;
    for (int i = F.tid; i < 2048; i += NTHR) { const int s = i >> 10, k = i & 1023; GM[i] = g2[k] * (1.f + MODl[(size_t)(s ? mb1 : mb0) * DIN + 4 * 1024 + k]); }
    __syncthreads();
    if (F.wave < 4) {
    for (int rowb = r0 + 2 * F.wave; rowb < r1; rowb += 2 * 4) {
        f32x4 v[2][4]; bool val[2];
#pragma unroll
        for (int q = 0; q < 2; ++q) { const int row = rowb + q; val[q] = row < r1; const int rr = val[q] ? row : rowb;
            const bool lat = rr < TL; const float* xs = lat ? a.out + (size_t)rr * D : (const float*)(a.ws + WS_XC) + (size_t)(rr - TL) * D;
#pragma unroll
            for (int j = 0; j < 4; ++j) v[q][j] = *(const f32x4*)(xs + F.lane * 4 + 256 * j); }
#pragma unroll
        for (int q = 0; q < 2; ++q) { const int rr = val[q] ? rowb + q : rowb; const int mr = mod_row(rr); float ss = 0.f;
#pragma unroll
            for (int j = 0; j < 4; ++j) ss += (v[q][j].x * v[q][j].x + v[q][j].y * v[q][j].y) + (v[q][j].z * v[q][j].z + v[q][j].w * v[q][j].w);
            const float r = 1.f / sqrtf(wave_sum(ss) * (1.f / D) + EPS);
            if (F.lane == 0 && val[q]) RN[rr - r0] = r;
#pragma unroll
            for (int j = 0; j < 4; ++j) { const int col = F.lane * 4 + 256 * j;
                const f32x4 g = *(const f32x4*)(g2 + col), sh = *(const f32x4*)(MODl + (size_t)mr * DIN + 3 * 1024 + col), sc = *(const f32x4*)(MODl + (size_t)mr * DIN + 4 * 1024 + col);
                const f32x4 t = (v[q][j] * r * g) * (sc + 1.f) + sh;
                if (val[q]) *(unsigned*)(H8 + (size_t)rr * D + col) = cvt4_fp8(t.x, t.y, t.z, t.w); } }
    }
    } else {
    if (F.wave < 6) { const int sl = F.wave - 4; const int mb = sl ? mb1 : mb0; f32x4 sh[4];
#pragma unroll
        for (int j = 0; j < 4; ++j) sh[j] = *(const f32x4*)(MODl + (size_t)mb * DIN + 3 * 1024 + F.lane * 4 + 256 * j);
#pragma unroll 4
        for (int cidx = 0; cidx < 20; ++cidx) { float p = 0.f;
#pragma unroll
            for (int j = 0; j < 4; ++j) { const f32x4 w = *(const LAS f32x4*)(RW + cidx * RWS + F.lane * 4 + 256 * j);
                p = fmaf(sh[j].x, w.x, p); p = fmaf(sh[j].y, w.y, p); p = fmaf(sh[j].z, w.z, p); p = fmaf(sh[j].w, w.w, p); }
            const float tot = wave_sum(p) + RB[cidx]; if (F.lane == 0) BI[sl * 20 + cidx] = tot; } }
    { const int i16 = F.lane & 15, kq = F.lane >> 4; const int ngrp = (r1 - r0 + 15) >> 4;
      for (int gi = F.wave - 4; gi < ngrp; gi += 4) {
        const int grow = r0 + 16 * gi; const int rowi = (grow + i16 < r1) ? grow + i16 : r1 - 1;
        const bool lat = rowi < TL; const float* xs = (lat ? a.out + (size_t)rowi * D : (const float*)(a.ws + WS_XC) + (size_t)(rowi - TL) * D) + 4 * kq;
        const int slot = (mod_row(grow) == mb0) ? 0 : 1;
        const LAS float* gmp = GM + slot * 1024 + 4 * kq; const LAS float* w0p = RW + i16 * RWS + 4 * kq; const LAS float* w1p = RW + (16 + (i16 & 3)) * RWS + 4 * kq;
        const float m1 = (i16 < 4) ? 1.f : 0.f;
        f32x4v acc0 = {0.f, 0.f, 0.f, 0.f}, acc1 = {0.f, 0.f, 0.f, 0.f};
#pragma unroll 16
        for (int s = 0; s < 64; ++s) {
            const f32x4 xv = *(const f32x4*)(xs + 16 * s); const f32x4 gv = *(const LAS f32x4*)(gmp + 16 * s);
            const f32x4 wa = *(const LAS f32x4*)(w0p + 16 * s), wb = *(const LAS f32x4*)(w1p + 16 * s);
            const f32x4 ba = wa * gv, bb = wb * gv * m1;
            acc0 = __builtin_amdgcn_mfma_f32_16x16x4f32(xv.x, ba.x, acc0, 0, 0, 0); acc1 = __builtin_amdgcn_mfma_f32_16x16x4f32(xv.x, bb.x, acc1, 0, 0, 0);
            acc0 = __builtin_amdgcn_mfma_f32_16x16x4f32(xv.y, ba.y, acc0, 0, 0, 0); acc1 = __builtin_amdgcn_mfma_f32_16x16x4f32(xv.y, bb.y, acc1, 0, 0, 0);
            acc0 = __builtin_amdgcn_mfma_f32_16x16x4f32(xv.z, ba.z, acc0, 0, 0, 0); acc1 = __builtin_amdgcn_mfma_f32_16x16x4f32(xv.z, bb.z, acc1, 0, 0, 0);
            acc0 = __builtin_amdgcn_mfma_f32_16x16x4f32(xv.w, ba.w, acc0, 0, 0, 0); acc1 = __builtin_amdgcn_mfma_f32_16x16x4f32(xv.w, bb.w, acc1, 0, 0, 0);
        }
#pragma unroll
        for (int rg = 0; rg < 4; ++rg) { const int lr = 16 * gi + 4 * kq + rg;
            if (r0 + lr < r1) { LG[lr * 20 + i16] = acc0[rg]; if (i16 < 4) LG[lr * 20 + 16 + i16] = acc1[rg]; } }
      } }
    }
    __syncthreads();
    SUBMARK5(42);
    for (int lr = F.tid; lr < r1 - r0; lr += NTHR) {
        float lg[20]; { const float rn = RN[lr]; const int sl = (mod_row(r0 + lr) == mb0) ? 0 : 1;
#pragma unroll
          for (int i = 0; i < 20; ++i) lg[i] = rn * LG[lr * 20 + i] + BI[sl * 20 + i]; }
        int gs = 0; float gmx = lg[0];
#pragma unroll
        for (int i = 1; i < 4; ++i) if (lg[i] > gmx) { gmx = lg[i]; gs = i; }
        float gsum = 0.f;
#pragma unroll
        for (int i = 0; i < 4; ++i) gsum += __expf(lg[i] - gmx);
        const float pg = 1.f / gsum;
        float le[4];
#pragma unroll
        for (int i = 0; i < 4; ++i) le[i] = (gs == 0) ? lg[4 + i] : (gs == 1) ? lg[8 + i] : (gs == 2) ? lg[12 + i] : lg[16 + i];
        int i0 = 0; float v0 = le[0];
#pragma unroll
        for (int i = 1; i < 4; ++i) if (le[i] > v0) { v0 = le[i]; i0 = i; }
        int i1 = -1; float v1 = -3.4e38f;
#pragma unroll
        for (int i = 0; i < 4; ++i) if (i != i0 && le[i] > v1) { v1 = le[i]; i1 = i; }
        const float e1 = __expf(v1 - v0), den = 1.f / (1.f + e1);
        const int ex0 = gs * 4 + i0, ex1 = gs * 4 + i1;
        const int lp0 = __hip_atomic_fetch_add(&LC[ex0], 1, __ATOMIC_RELAXED, __HIP_MEMORY_SCOPE_WORKGROUP), lp1 = __hip_atomic_fetch_add(&LC[ex1], 1, __ATOMIC_RELAXED, __HIP_MEMORY_SCOPE_WORKGROUP);
        TE[lr] = ex0 | (ex1 << 8); TP[lr] = lp0 | (lp1 << 16); TW[2 * lr] = den * pg; TW[2 * lr + 1] = e1 * den * pg;
    }
    __syncthreads();
    if (F.tid < NE) LC[16 + F.tid] = (int)atomicAdd(&CNT[F.tid * 16], (unsigned)LC[F.tid]);
    __syncthreads();
    for (int lr = F.tid; lr < r1 - r0; lr += NTHR) {
        const int te = TE[lr], tp = TP[lr], ex0 = te & 255, ex1 = te >> 8, row = r0 + lr;
        const int gp0 = LC[16 + ex0] + (tp & 0xffff), gp1 = LC[16 + ex1] + (tp >> 16);
        EROW[(size_t)ex0 * TT + gp0] = row * 2; EROWW[(size_t)ex0 * TT + gp0] = TW[2 * lr];
        EROW[(size_t)ex1 * TT + gp1] = row * 2 + 1; EROWW[(size_t)ex1 * TT + gp1] = TW[2 * lr + 1];
    }
    __syncthreads();
    SUBMARK5(43);
    }
    __syncthreads();
#undef SUBMARK5
}

__device__ __forceinline__ void normrope8(float (&x)[8], const float* g64, bool rope, int pos, const float* ct, const float* st, float scale, int lane) {
    float ss = 0.f;
#pragma unroll
    for (int i = 0; i < 8; ++i) ss += x[i] * x[i];
    ss += DPP_F(ss, 0xB1); ss += DPP_F(ss, 0x4E); ss += DPP_F(ss, 0x141);
    const float r = 1.f / sqrtf(ss * (1.f / 64.f) + EPS);
    const int ch = lane & 7;
    const f32x4 g0 = *(const f32x4*)(g64 + 8 * ch), g1 = *(const f32x4*)(g64 + 8 * ch + 4);
    x[0] *= r * g0.x; x[1] *= r * g0.y; x[2] *= r * g0.z; x[3] *= r * g0.w; x[4] *= r * g1.x; x[5] *= r * g1.y; x[6] *= r * g1.z; x[7] *= r * g1.w;
    if (rope) {
        const int ax = ch >> 2, half = (ch >> 1) & 1, f0 = 8 * (ch & 1);
        const f32x4 c0 = *(const f32x4*)(ct + pos * 32 + ax * 16 + f0), c1 = *(const f32x4*)(ct + pos * 32 + ax * 16 + f0 + 4);
        const f32x4 s0 = *(const f32x4*)(st + pos * 32 + ax * 16 + f0), s1 = *(const f32x4*)(st + pos * 32 + ax * 16 + f0 + 4);
        const float cs[8] = {c0.x, c0.y, c0.z, c0.w, c1.x, c1.y, c1.z, c1.w}, sn[8] = {s0.x, s0.y, s0.z, s0.w, s1.x, s1.y, s1.z, s1.w};
#pragma unroll
        for (int i = 0; i < 8; ++i) { const float p = DPP_F(x[i], 0x4E);
            x[i] = half ? (x[i] * cs[i] + p * sn[i]) : (x[i] * cs[i] - p * sn[i]); }
    }
#pragma unroll
    for (int i = 0; i < 8; ++i) x[i] *= scale;
}
__device__ __forceinline__ void unpack8(const u32x4 w, float (&x)[8]) { x[0] = bflo(w.x); x[1] = bfhi(w.x); x[2] = bflo(w.y); x[3] = bfhi(w.y); x[4] = bflo(w.z); x[5] = bfhi(w.z); x[6] = bflo(w.w); x[7] = bfhi(w.w); }
__device__ __forceinline__ u32x4 pack8(const float (&x)[8]) { u32x4 w; w.x = cvtpk(x[0], x[1]); w.y = cvtpk(x[2], x[3]); w.z = cvtpk(x[4], x[5]); w.w = cvtpk(x[6], x[7]); return w; }

__device__ __forceinline__ void prep_phase(const Fr& F, const Args& a, int l, bool with_ctx) {
    constexpr int VROW = 272;
    LAS unsigned char* VA_l = F.lds;
    LAS unsigned char* VW_l = F.lds + 17408;
    LAS unsigned char* HT_l = F.lds + 34816;
    constexpr int HROW = 144;
    const float* ct = (const float*)(a.ws + WS_ROPE); const float* st = ct + SEQ * 32;
    const float* qkg = a.in[I_QKG] + l * 256;
    const bf16_t* RAWA = (const bf16_t*)(a.ws + WS_RAWA); const bf16_t* RAWW = (const bf16_t*)(a.ws + WS_RAWW);
    bf16_t* KA = (bf16_t*)(a.ws + WS_KA); bf16_t* KW = (bf16_t*)(a.ws + WS_KW); bf16_t* VTA = (bf16_t*)(a.ws + WS_VTA); bf16_t* VTW = (bf16_t*)(a.ws + WS_VTW);
    const bf16_t* U = (const bf16_t*)(a.ws + WS_U); bf16_t* X0 = (bf16_t*)(a.ws + WS_H); bf16_t* VT = (bf16_t*)(a.ws + WS_VT);
    const float* hsw = a.in[I_HSW] + l * 3 * 1536; const float* hsb = a.in[I_HSB] + l * 1536;
    for (int unit = F.bid; unit < NB * 36; unit += F.G) {
        const bool lat = unit < NB * 32;
        const int b = lat ? unit >> 5 : (unit - NB * 32) >> 2, p0 = lat ? (unit & 31) * 64 : ((unit - NB * 32) & 3) * 64;
        const int n = lat ? SEQ : CTX;
        const int row0 = lat ? b * SEQ + p0 : TL + b * CTX + p0;
        const int j0 = lat ? CTX + p0 : p0;
        __syncthreads();
        {
            const bool isw = (F.lane & 16) != 0; const int l16 = F.lane & 15, half = F.lane >> 5;
            u32x4 kw[4];
#pragma unroll
            for (int ps = 0; ps < 4; ++ps) { const int tk = 8 * F.wave + 2 * ps + half; kw[ps] = *(const u32x4*)((isw ? RAWW : RAWA) + (size_t)(row0 + tk) * 256 + l16 * 8); }
#pragma unroll
            for (int ps = 0; ps < 4; ++ps) { const int tk = 8 * F.wave + 2 * ps + half; float x[8]; unpack8(kw[ps], x);
                normrope8(x, qkg + (isw ? 192 : 64), lat, p0 + tk, ct, st, 1.f, F.lane);
                *(u32x4*)((isw ? KW : KA) + ((size_t)b * KEYS + j0 + tk) * 128 + l16 * 8) = pack8(x); }
        }
        for (int i = F.tid; i < 2 * 64 * 16; i += NTHR) { const int m = i >> 10, r = (i >> 4) & 63, cch = i & 15;
            const u32x4 w = *(const u32x4*)((m ? RAWW : RAWA) + (size_t)(row0 + r) * 256 + 128 + cch * 8);
            *(LAS u32x4*)((m ? VW_l : VA_l) + r * VROW + cch * 16) = w; }
        const bool do_hy = lat || with_ctx;
        if (do_hy) {
            const int cg = F.tid & 63, c = 8 * cg, t0 = 8 * F.wave;
            u32x4 x1p[8];
#pragma unroll
            for (int g = 0; g < 3; ++g) {
                const int ch = g * 512 + c;
                float w0[8], w1[8], w2[8], bb[8];
                { const f32x4 a0 = *(const f32x4*)(hsw + ch), a1 = *(const f32x4*)(hsw + ch + 4), b0 = *(const f32x4*)(hsw + 1536 + ch), b1 = *(const f32x4*)(hsw + 1536 + ch + 4),
                              c0 = *(const f32x4*)(hsw + 3072 + ch), c1 = *(const f32x4*)(hsw + 3072 + ch + 4), d0 = *(const f32x4*)(hsb + ch), d1 = *(const f32x4*)(hsb + ch + 4);
                  w0[0] = a0.x; w0[1] = a0.y; w0[2] = a0.z; w0[3] = a0.w; w0[4] = a1.x; w0[5] = a1.y; w0[6] = a1.z; w0[7] = a1.w;
                  w1[0] = b0.x; w1[1] = b0.y; w1[2] = b0.z; w1[3] = b0.w; w1[4] = b1.x; w1[5] = b1.y; w1[6] = b1.z; w1[7] = b1.w;
                  w2[0] = c0.x; w2[1] = c0.y; w2[2] = c0.z; w2[3] = c0.w; w2[4] = c1.x; w2[5] = c1.y; w2[6] = c1.z; w2[7] = c1.w;
                  bb[0] = d0.x; bb[1] = d0.y; bb[2] = d0.z; bb[3] = d0.w; bb[4] = d1.x; bb[5] = d1.y; bb[6] = d1.z; bb[7] = d1.w; }
                u32x4 raw[10];
#pragma unroll
                for (int i = 0; i < 10; ++i) { const int pos = p0 + t0 - 1 + i;
                    if (pos < 0 || pos >= n) { const unsigned z = zero_u32(); raw[i] = (u32x4){z, z, z, z}; } else raw[i] = *(const u32x4*)(U + (size_t)(row0 - p0 + pos) * 1536 + ch); }
#pragma unroll
                for (int t = 0; t < 8; ++t) { float up[8], uc[8], un[8], o[8]; unpack8(raw[t], up); unpack8(raw[t + 1], uc); unpack8(raw[t + 2], un);
#pragma unroll
                    for (int i = 0; i < 8; ++i) o[i] = fmaf(w0[i], up[i], fmaf(w1[i], uc[i], fmaf(w2[i], un[i], bb[i])));
                    if (g == 0) *(u32x4*)(X0 + (size_t)(row0 + t0 + t) * 512 + c) = pack8(o);
                    else if (g == 1) x1p[t] = pack8(o);
                    else { float x1[8]; unpack8(x1p[t], x1);
#pragma unroll
                        for (int i = 0; i < 8; ++i) o[i] *= x1[i];
                        x1p[t] = pack8(o); } }
            }
#pragma unroll
            for (int i = 0; i < 8; ++i) { unsigned short ev[8];
#pragma unroll
                for (int t = 0; t < 8; ++t) { const unsigned wsel = (i >> 1) == 0 ? x1p[t].x : (i >> 1) == 1 ? x1p[t].y : (i >> 1) == 2 ? x1p[t].z : x1p[t].w; ev[t] = (unsigned short)((i & 1) ? (wsel >> 16) : (wsel & 0xffffu)); }
                u32x4 w; w.x = ev[0] | ((unsigned)ev[1] << 16); w.y = ev[2] | ((unsigned)ev[3] << 16); w.z = ev[4] | ((unsigned)ev[5] << 16); w.w = ev[6] | ((unsigned)ev[7] << 16);
                *(LAS u32x4*)(HT_l + (c + i) * HROW + t0 * 2) = w; }
        }
        __syncthreads();
        for (int i = F.tid; i < 2 * 128 * 8; i += NTHR) { const int m = i >> 10, rr = (i >> 3) & 127, c8 = i & 7;
            LAS unsigned char* T = m ? VW_l : VA_l; unsigned short e[8];
#pragma unroll
            for (int jj = 0; jj < 8; ++jj) { const int key = 16 * (c8 >> 1) + 8 * (jj >> 2) + 4 * (c8 & 1) + (jj & 3); e[jj] = *(const LAS bf16_t*)(T + key * VROW + rr * 2); }
            u32x4 w; w.x = e[0] | ((unsigned)e[1] << 16); w.y = e[2] | ((unsigned)e[3] << 16); w.z = e[4] | ((unsigned)e[5] << 16); w.w = e[6] | ((unsigned)e[7] << 16);
            *(u32x4*)((m ? VTW : VTA) + ((size_t)(b * 2 + (rr >> 6)) * 64 + (rr & 63)) * KEYS + j0 + c8 * 8) = w; }
        if (do_hy) { bf16_t* VTb = lat ? VT : VT + VT_CTX_OFF;
          for (int i = F.tid; i < 512 * 8; i += NTHR) { const int cch = i >> 3, c8 = i & 7;
              const u32x4 w = *(const LAS u32x4*)(HT_l + cch * HROW + c8 * 16);
              *(u32x4*)(VTb + ((size_t)cch * NB + b) * n + p0 + c8 * 8) = w; } }
    }
    __syncthreads();
}

__device__ __forceinline__ void hyena_final_phase(const Fr& F, const Args& a, int l, bool with_ctx) {
    constexpr int HROW = 144;
    LAS unsigned char* T = F.lds;
    const bf16_t* X0 = (const bf16_t*)(a.ws + WS_H); const bf16_t* VT = (const bf16_t*)(a.ws + WS_VT); const bf16_t* YT = (const bf16_t*)(a.ws + WS_YT);
    unsigned char* YH = a.ws + WS_Y8 + 512;
    const float* FN = (const float*)(a.ws + WS_FNORM) + l * 1024; const float* skip = a.in[I_HBIAS] + l * 512;
    const int nunits = with_ctx ? NB * 36 : NB * 32;
    for (int unit = F.bid; unit < nunits; unit += F.G) {
        const bool lat = unit < NB * 32;
        const int b = lat ? unit >> 5 : (unit - NB * 32) >> 2, p0 = lat ? (unit & 31) * 64 : ((unit - NB * 32) & 3) * 64;
        const int n = lat ? SEQ : CTX; const int row0 = lat ? b * SEQ + p0 : TL + b * CTX + p0;
        const bf16_t* Yb = lat ? YT : YT + VT_CTX_OFF; const bf16_t* Vb = lat ? VT : VT + VT_CTX_OFF; const float* inv = FN + (lat ? 0 : 512);
        __syncthreads();
        for (int i = F.tid; i < 512 * 8; i += NTHR) { const int cch = i >> 3, c8 = i & 7; const size_t off = ((size_t)cch * NB + b) * n + p0 + c8 * 8;
            const u32x4 y = *(const u32x4*)(Yb + off), v = *(const u32x4*)(Vb + off); const float s = inv[cch], k = skip[cch];
            u32x4 o;
            o.x = cvtpk(bflo(y.x) * s + k * bflo(v.x), bfhi(y.x) * s + k * bfhi(v.x)); o.y = cvtpk(bflo(y.y) * s + k * bflo(v.y), bfhi(y.y) * s + k * bfhi(v.y));
            o.z = cvtpk(bflo(y.z) * s + k * bflo(v.z), bfhi(y.z) * s + k * bfhi(v.z)); o.w = cvtpk(bflo(y.w) * s + k * bflo(v.w), bfhi(y.w) * s + k * bfhi(v.w));
            *(LAS u32x4*)(T + cch * HROW + c8 * 16) = o; }
        __syncthreads();
        { const int th = F.tid & 255, half = F.tid >> 8, c = 2 * th;
          for (int t = 32 * half; t < 32 * half + 32; ++t) {
              const unsigned x0 = *(const unsigned*)(X0 + (size_t)(row0 + t) * 512 + c);
              const float y0 = bf1(*(const LAS bf16_t*)(T + c * HROW + t * 2)), y1 = bf1(*(const LAS bf16_t*)(T + (c + 1) * HROW + t * 2));
              *(unsigned short*)(YH + (size_t)(row0 + t) * 1536 + c) = (unsigned short)__builtin_amdgcn_cvt_pk_fp8_f32(clamp_fp8(bflo(x0) * y0 * 16.f), clamp_fp8(bfhi(x0) * y1 * 16.f), 0, false); } }
    }
    __syncthreads();
}

#define MFMA32(a, b, c) __builtin_amdgcn_mfma_f32_32x32x16_bf16((a), (b), (c), 0, 0, 0)
#define MFMA16(a, b, c) __builtin_amdgcn_mfma_f32_16x16x32_bf16((a), (b), (c), 0, 0, 0)

__device__ __forceinline__ int tile_off(int row, int chunk) { return row * 128 + ((chunk ^ ((row >> 1) & 7)) << 4); }

template <bool WIN>
__device__ __forceinline__ void attn_unit(const Fr& F, const bf16_t* Qw, unsigned char* Yw, const bf16_t* Kb, const bf16_t* VTb, int a0, int na, int b0, int nb, int qpos0, bool has_sink, float sink2, const float* g64, bool rope, const float* ct, const float* st) {
    LAS unsigned char* L = F.lds;
    const int r = F.lane & 31, h = F.lane >> 5;
    const int xaddr = (lane_id() ^ 32) << 2;
#define SWAP32(v) __builtin_bit_cast(float, __builtin_amdgcn_ds_bpermute(xaddr, __builtin_bit_cast(int, (v))))
    bf16x8 q[4];
    {
        float x[4][8]; float ss = 0.f;
#pragma unroll
        for (int kk = 0; kk < 4; ++kk) { const u32x4 w = *(const u32x4*)(Qw + (size_t)r * 1536 + 16 * kk + 8 * h); unpack8(w, x[kk]);
#pragma unroll
            for (int j = 0; j < 8; ++j) ss += x[kk][j] * x[kk][j]; }
        ss += SWAP32(ss);
        const float rn = (1.f / sqrtf(ss * (1.f / 64.f) + EPS)) * QSCALE;
#pragma unroll
        for (int kk = 0; kk < 4; ++kk) { const f32x4 g0 = *(const f32x4*)(g64 + 16 * kk + 8 * h), g1 = *(const f32x4*)(g64 + 16 * kk + 8 * h + 4);
            x[kk][0] *= rn * g0.x; x[kk][1] *= rn * g0.y; x[kk][2] *= rn * g0.z; x[kk][3] *= rn * g0.w; x[kk][4] *= rn * g1.x; x[kk][5] *= rn * g1.y; x[kk][6] *= rn * g1.z; x[kk][7] *= rn * g1.w; }
        if (rope) { const int pos = qpos0 + r;
#pragma unroll
            for (int ax = 0; ax < 2; ++ax) {
                const f32x4 c0 = *(const f32x4*)(ct + pos * 32 + ax * 16 + 8 * h), c1 = *(const f32x4*)(ct + pos * 32 + ax * 16 + 8 * h + 4);
                const f32x4 s0 = *(const f32x4*)(st + pos * 32 + ax * 16 + 8 * h), s1 = *(const f32x4*)(st + pos * 32 + ax * 16 + 8 * h + 4);
                const float cs[8] = {c0.x, c0.y, c0.z, c0.w, c1.x, c1.y, c1.z, c1.w}, sn[8] = {s0.x, s0.y, s0.z, s0.w, s1.x, s1.y, s1.z, s1.w};
#pragma unroll
                for (int j = 0; j < 8; ++j) { const float av = x[2 * ax][j], bv = x[2 * ax + 1][j]; x[2 * ax][j] = av * cs[j] - bv * sn[j]; x[2 * ax + 1][j] = bv * cs[j] + av * sn[j]; } } }
#pragma unroll
        for (int kk = 0; kk < 4; ++kk) q[kk] = __builtin_bit_cast(bf16x8, pack8(x[kk]));
    }
    f32x16 o0, o1;
#pragma unroll
    for (int i = 0; i < 16; ++i) { o0[i] = 0.f; o1[i] = 0.f; }
    float lsum = 0.f;
    const int ntile = na + nb;
    const int srow = F.tid >> 3, sch = F.tid & 7;
    const int soff = tile_off(srow, sch);
    int t4[4];
#pragma unroll
    for (int j = 0; j < 4; ++j) t4[j] = tile_off(r, 2 * j + h);
#define AT_KT(i) ((i) < na ? a0 + (i) : b0 + ((i) - na))
#define AT_LD(i, K0, K1, V0, V1) do { const int kt_ = AT_KT(i); \
        K0 = *(const u32x4*)(Kb + (size_t)(kt_ * 128 + srow) * 128 + sch * 8); K1 = *(const u32x4*)(Kb + (size_t)(kt_ * 128 + 64 + srow) * 128 + sch * 8); \
        V0 = *(const u32x4*)(VTb + (size_t)srow * KEYS + kt_ * 128 + sch * 8); V1 = *(const u32x4*)(VTb + (size_t)srow * KEYS + kt_ * 128 + 64 + sch * 8); } while (0)
#define AT_ST(buf, K0, K1, V0, V1) do { LAS unsigned char* B_ = L + (buf) * 32768 + soff; \
        *(LAS u32x4*)(B_) = K0; *(LAS u32x4*)(B_ + 8192) = K1; *(LAS u32x4*)(B_ + 16384) = V0; *(LAS u32x4*)(B_ + 24576) = V1; } while (0)
#define AT_QK(S0, S1, Kt) do { bf16x8 kf_[8]; \
        _Pragma("unroll") for (int kk = 0; kk < 4; ++kk) { kf_[2 * kk] = *(const LAS bf16x8*)(L + (Kt) + t4[kk]); kf_[2 * kk + 1] = *(const LAS bf16x8*)(L + (Kt) + t4[kk] + 4096); } \
        _Pragma("unroll") for (int i_ = 0; i_ < 16; ++i_) { S0[i_] = 0.f; S1[i_] = 0.f; } \
        _Pragma("unroll") for (int kk = 0; kk < 4; ++kk) { S0 = MFMA32(kf_[2 * kk], q[kk], S0); S1 = MFMA32(kf_[2 * kk + 1], q[kk], S1); } } while (0)
#define AT_EXP(S0, S1, P, kpos0) do { \
        if (WIN && (kpos0) >= 0) { const int kbase = (kpos0) + 4 * h, qp = qpos0 + r; \
            _Pragma("unroll") for (int i = 0; i < 16; ++i) { const int kr = (i & 3) + 8 * (i >> 2); const int d0 = kbase + kr - qp, d1 = d0 + 32; \
                if (d0 > 128 || d0 < -128) S0[i] = -1e30f; if (d1 > 128 || d1 < -128) S1[i] = -1e30f; } } \
        _Pragma("unroll") for (int i = 0; i < 16; ++i) { S0[i] = fast_exp2(S0[i]); S1[i] = fast_exp2(S1[i]); lsum += S0[i] + S1[i]; } \
        { u32x4 w; \
          w.x = cvtpk(S0[0], S0[1]); w.y = cvtpk(S0[2], S0[3]); w.z = cvtpk(S0[4], S0[5]); w.w = cvtpk(S0[6], S0[7]); P[0] = __builtin_bit_cast(bf16x8, w); \
          w.x = cvtpk(S0[8], S0[9]); w.y = cvtpk(S0[10], S0[11]); w.z = cvtpk(S0[12], S0[13]); w.w = cvtpk(S0[14], S0[15]); P[1] = __builtin_bit_cast(bf16x8, w); \
          w.x = cvtpk(S1[0], S1[1]); w.y = cvtpk(S1[2], S1[3]); w.z = cvtpk(S1[4], S1[5]); w.w = cvtpk(S1[6], S1[7]); P[2] = __builtin_bit_cast(bf16x8, w); \
          w.x = cvtpk(S1[8], S1[9]); w.y = cvtpk(S1[10], S1[11]); w.z = cvtpk(S1[12], S1[13]); w.w = cvtpk(S1[14], S1[15]); P[3] = __builtin_bit_cast(bf16x8, w); } } while (0)
#define AT_PV(P, Vt) do { bf16x8 vf_[8]; \
        _Pragma("unroll") for (int c = 0; c < 4; ++c) { vf_[2 * c] = *(const LAS bf16x8*)(L + (Vt) + t4[c]); vf_[2 * c + 1] = *(const LAS bf16x8*)(L + (Vt) + t4[c] + 4096); } \
        _Pragma("unroll") for (int c = 0; c < 4; ++c) { o0 = MFMA32(vf_[2 * c], P[c], o0); o1 = MFMA32(vf_[2 * c + 1], P[c], o1); } } while (0)
#define AT_BODY(it) do { \
        const int kt = AT_KT(it); \
        if ((it) + 1 < ntile) AT_LD((it) + 1, kA0, kA1, vA0, vA1); \
        const int Bc = ((it) & 1) * 32768;                                \
        const int kp = (WIN && kt >= 2) ? (kt - 2) * 128 : -1;            \
        { f32x16 sa0, sa1; bf16x8 pa[4]; \
          AT_QK(sa0, sa1, Bc); AT_EXP(sa0, sa1, pa, kp); AT_PV(pa, Bc + 16384); } \
        __builtin_amdgcn_sched_barrier(0); \
        { f32x16 sb0, sb1; bf16x8 pb_[4]; \
          AT_QK(sb0, sb1, Bc + 8192); AT_EXP(sb0, sb1, pb_, (kp < 0 ? -1 : kp + 64)); AT_PV(pb_, Bc + 24576); } \
        if ((it) + 1 < ntile) AT_ST(((it) + 1) & 1, kA0, kA1, vA0, vA1); \
        __syncthreads(); } while (0)
    u32x4 kA0, kA1, vA0, vA1;
    AT_LD(0, kA0, kA1, vA0, vA1);
    __syncthreads();
    AT_ST(0, kA0, kA1, vA0, vA1);
    __syncthreads();
    for (int it = 0; it < ntile; it += 2) {
        AT_BODY(it);
        if (it + 1 < ntile) AT_BODY(it + 1);
    }
#undef AT_BODY
#undef AT_QK
#undef AT_EXP
#undef AT_PV
#undef AT_ST
#undef AT_LD
#undef AT_KT
    float lt = lsum + SWAP32(lsum);
    if (has_sink) lt += fast_exp2(sink2);
    const float inv = 1.f / lt;
#pragma unroll
    for (int g = 0; g < 4; ++g) { const float i16 = inv * 16.f;
        *(unsigned*)(Yw + (size_t)r * 1536 + 8 * g + 4 * h) = cvt4_fp8(o0[4 * g] * i16, o0[4 * g + 1] * i16, o0[4 * g + 2] * i16, o0[4 * g + 3] * i16);
        *(unsigned*)(Yw + (size_t)r * 1536 + 32 + 8 * g + 4 * h) = cvt4_fp8(o1[4 * g] * i16, o1[4 * g + 1] * i16, o1[4 * g + 2] * i16, o1[4 * g + 3] * i16); }
#undef SWAP32
}

__device__ __forceinline__ void hyena_unit_lat(const Fr& F, const bf16_t* Fg, const bf16_t* Vg, bf16_t* Yg) {
    constexpr int FREP = 8192 + 64, VPIT = 4096 + 16, VOFF = 8 * FREP;
    LAS unsigned char* L = F.lds;
    __syncthreads();
    { const int x = F.tid;
      const u32x4 lo = *(const u32x4*)(Fg + x * 8); u32x4 hi; if (x < 511) hi = *(const u32x4*)(Fg + x * 8 + 8); else { const unsigned z = zero_u32(); hi = (u32x4){z, z, z, z}; }
      const unsigned wv[8] = {lo.x, lo.y, lo.z, lo.w, hi.x, hi.y, hi.z, hi.w};
      *(LAS u32x4*)(L + x * 16) = lo;
#pragma unroll
      for (int rho = 1; rho < 8; ++rho) { u32x4 o;
          unsigned od[4];
#pragma unroll
          for (int d = 0; d < 4; ++d) { const int ob = 4 * d + 2 * rho, i = ob >> 2, s = ob & 3; od[d] = __builtin_amdgcn_alignbyte(wv[i + 1 < 8 ? i + 1 : 7], wv[i], s); }
          o.x = od[0]; o.y = od[1]; o.z = od[2]; o.w = od[3];
          *(LAS u32x4*)(L + rho * FREP + x * 16) = o; } }
    for (int i = F.tid; i < 16 * 256; i += NTHR) { const int b = i >> 8, x = i & 255; *(LAS u32x4*)(L + VOFF + b * VPIT + x * 16) = *(const u32x4*)(Vg + (size_t)b * SEQ + x * 8); }
    __syncthreads();
    const int i16 = F.lane & 15, q4 = F.lane >> 4, w = F.wave;
    const int base0 = 2047 - 256 * w - i16 + 8 * q4;
    const int rho = base0 & 7;
    LAS unsigned char* Ap = L + rho * FREP + (base0 - rho) * 2;
    LAS unsigned char* Bp = L + VOFF + i16 * VPIT + q4 * 16;
    bf16x8 A[16]; f32x4 acc[16];
#pragma unroll
    for (int rr = 0; rr < 16; ++rr) { A[rr] = *(const LAS bf16x8*)(Ap - 32 * rr); acc[rr] = (f32x4){0.f, 0.f, 0.f, 0.f}; }
    bf16x8 Bn = *(const LAS bf16x8*)(Bp);
    for (int o = 0; o < 8; ++o) {
#pragma unroll
        for (int u = 0; u < 8; ++u) {
            const int st = o * 8 + u;
            const bf16x8 Bf = Bn;
            if (st < 63) Bn = *(const LAS bf16x8*)(Bp + 64 * st + 64);
#pragma unroll
            for (int rr = 0; rr < 16; ++rr) acc[rr] = MFMA16(A[(rr - 2 * u) & 15], Bf, acc[rr]);
            if (st < 63) { A[(-2 * u - 2) & 15] = *(const LAS bf16x8*)(Ap + 64 * st + 64); A[(-2 * u - 1) & 15] = *(const LAS bf16x8*)(Ap + 64 * st + 32); }
        }
    }
#pragma unroll
    for (int rr = 0; rr < 16; ++rr) { u32x2 wv; wv.x = cvtpk(acc[rr].x, acc[rr].y); wv.y = cvtpk(acc[rr].z, acc[rr].w);
        *(u32x2*)(Yg + (size_t)i16 * SEQ + 256 * w + 16 * rr + 4 * q4) = wv; }
}
__device__ __forceinline__ void hyena_unit_ctx(const Fr& F, const bf16_t* Fg, const bf16_t* Vg, bf16_t* Yg) {
    constexpr int FREP = 1024 + 64, VPIT = 512 + 16, VOFF = 8 * FREP;
    LAS unsigned char* L = F.lds;
    __syncthreads();
    if (F.tid < 64) *(LAS u32x4*)(L + F.tid * 16) = *(const u32x4*)(Fg + F.tid * 8);
    if (F.tid >= 64 && F.tid < 68) { const unsigned z = zero_u32(); *(LAS u32x4*)(L + 1024 + (F.tid - 64) * 16) = (u32x4){z, z, z, z}; }
    { const int b = F.tid >> 5, x = F.tid & 31; *(LAS u32x4*)(L + VOFF + b * VPIT + x * 16) = *(const u32x4*)(Vg + (size_t)b * CTX + x * 8); }
    __syncthreads();
    for (int i = F.tid; i < 7 * 256; i += NTHR) { const int rho = 1 + i / 256, x2 = (i % 256) * 2; const int s0 = x2 + rho, s1 = x2 + 1 + rho;
        const unsigned e0 = s0 < 512 ? *(const LAS bf16_t*)(L + s0 * 2) : 0, e1 = s1 < 512 ? *(const LAS bf16_t*)(L + s1 * 2) : 0;
        *(LAS unsigned*)(L + rho * FREP + x2 * 2) = e0 | (e1 << 16); }
    __syncthreads();
    const int i16 = F.lane & 15, q4 = F.lane >> 4, w = F.wave;
    const int base0 = 255 - 32 * w - i16 + 8 * q4, rho = base0 & 7;
    LAS unsigned char* Ap = L + rho * FREP + (base0 - rho) * 2;
    LAS unsigned char* Bp = L + VOFF + i16 * VPIT + q4 * 16;
    f32x4 acc0 = (f32x4){0.f, 0.f, 0.f, 0.f}, acc1 = acc0;
#pragma unroll
    for (int st = 0; st < 8; ++st) { const bf16x8 Bf = *(const LAS bf16x8*)(Bp + 64 * st);
        const bf16x8 A0 = *(const LAS bf16x8*)(Ap + 64 * st), A1 = *(const LAS bf16x8*)(Ap + 64 * st - 32);
        acc0 = MFMA16(A0, Bf, acc0); acc1 = MFMA16(A1, Bf, acc1); }
    u32x2 wv; wv.x = cvtpk(acc0.x, acc0.y); wv.y = cvtpk(acc0.z, acc0.w); *(u32x2*)(Yg + (size_t)i16 * CTX + 32 * w + 4 * q4) = wv;
    wv.x = cvtpk(acc1.x, acc1.y); wv.y = cvtpk(acc1.z, acc1.w); *(u32x2*)(Yg + (size_t)i16 * CTX + 32 * w + 16 + 4 * q4) = wv;
}

__device__ __forceinline__ void mixer_phase(const Fr& F, const Args& a, int l, bool with_ctx, unsigned long long& sacc, const int swhich) {
#if defined(PROBE_P)
    unsigned long long st0 = __builtin_amdgcn_s_memrealtime();
#define SUBMARK(w) do { const unsigned long long t_ = __builtin_amdgcn_s_memrealtime(); if (swhich == (w)) sacc += t_ - st0; st0 = t_; } while (0)
#else
#define SUBMARK(w) do { } while (0)
#endif
    const bf16_t* QA = (const bf16_t*)(a.ws + WS_QA); const bf16_t* QW = QA + 1024;
    unsigned char* Y8 = a.ws + WS_Y8;
    const bf16_t* KA = (const bf16_t*)(a.ws + WS_KA); const bf16_t* KW = (const bf16_t*)(a.ws + WS_KW);
    const bf16_t* VTA = (const bf16_t*)(a.ws + WS_VTA); const bf16_t* VTW = (const bf16_t*)(a.ws + WS_VTW);
    const float* sinks = a.in[I_SINK] + l * 8; const float* qkg = a.in[I_QKG] + l * 256;
    const float* ct = (const float*)(a.ws + WS_ROPE); const float* st = ct + SEQ * 32;
    const int wq = F.wave >> 1, wh = F.wave & 1;
    const int ubid = (F.G % 8 == 0) ? (F.bid & 7) * (F.G >> 3) + (F.bid >> 3) : F.bid;
#define RELANE(FX) do { int t_ = F.wave * 64 + lane_id(); asm volatile("" : "+v"(t_)); FX.tid = t_; FX.lane = t_ & 63; } while (0)
    Fr FA = F; RELANE(FA);
    for (int unit = ubid; unit < NB * 2 * 32; unit += F.G) {
        const int b = unit >> 6, kvh = (unit >> 5) & 1, pb = unit & 31;
        const size_t qo = (size_t)(b * SEQ + pb * 64 + wh * 32) * 1536 + (kvh * 4 + wq) * 64;
        attn_unit<false>(FA, QA + qo, Y8 + qo, KA + (size_t)b * KEYS * 128 + kvh * 64, VTA + (size_t)(b * 2 + kvh) * 64 * KEYS, 0, KEYS / 128, 0, 0, pb * 64 + wh * 32, false, 0.f, qkg, true, ct, st);
    }
    SUBMARK(30);
    Fr FW = F; RELANE(FW);
    for (int unit = ubid; unit < NB * 2 * 32; unit += F.G) {
        const int b = unit >> 6, kvh = (unit >> 5) & 1, pb = unit & 31;
        const size_t qo = (size_t)(b * SEQ + pb * 64 + wh * 32) * 1536 + (kvh * 4 + wq) * 64 + 1024;
        const int lo = pb < 2 ? 0 : (pb - 2) >> 1, hi = ((64 * pb + 191) >> 7) > 15 ? 15 : ((64 * pb + 191) >> 7);
        attn_unit<true>(FW, QA + qo, Y8 + qo, KW + (size_t)b * KEYS * 128 + kvh * 64, VTW + (size_t)(b * 2 + kvh) * 64 * KEYS, 0, 2, 2 + lo, hi - lo + 1, pb * 64 + wh * 32, true, sinks[kvh * 4 + wq] * LOG2E, qkg + 128, true, ct, st);
    }
    SUBMARK(31);
    Fr FC2 = F; RELANE(FC2);
    if (with_ctx) {
        for (int unit = ubid; unit < 2 * NB * 2 * 4; unit += F.G) {
            const int isw = unit >> 7, u2 = unit & 127, b = u2 >> 3, kvh = (u2 >> 2) & 1, pb = u2 & 3;
            const size_t qo = (size_t)(TL + b * CTX + pb * 64 + wh * 32) * 1536 + (kvh * 4 + wq) * 64 + (isw ? 1024 : 0);
            attn_unit<false>(FC2, QA + qo, Y8 + qo, (isw ? KW : KA) + (size_t)b * KEYS * 128 + kvh * 64, (isw ? VTW : VTA) + (size_t)(b * 2 + kvh) * 64 * KEYS, 0, 2, 0, 0, 0, isw != 0, isw ? sinks[kvh * 4 + wq] * LOG2E : 0.f, qkg + (isw ? 128 : 0), false, ct, st);
        }
    }
    SUBMARK(32);
    const bf16_t* FL = (const bf16_t*)(a.ws + WS_FL) + (size_t)l * 512 * 4096; const bf16_t* FC = (const bf16_t*)(a.ws + WS_FC) + (size_t)l * 512 * 512;
    const bf16_t* VT = (const bf16_t*)(a.ws + WS_VT); bf16_t* YT = (bf16_t*)(a.ws + WS_YT);
    Fr FH = F; RELANE(FH);
    for (int c = F.bid; c < HYW; c += F.G) hyena_unit_lat(FH, FL + (size_t)c * 4096, VT + (size_t)c * NB * SEQ, YT + (size_t)c * NB * SEQ);
    if (with_ctx) for (int c = F.bid; c < HYW; c += F.G) hyena_unit_ctx(FH, FC + (size_t)c * 512, VT + VT_CTX_OFF + (size_t)c * NB * CTX, YT + VT_CTX_OFF + (size_t)c * NB * CTX);
    __syncthreads();
    SUBMARK(33);
#undef SUBMARK
#undef RELANE
}

__device__ __forceinline__ float gate_q(float x) { return fminf(256.f * sigmoid_f(x), 255.49f); }
__device__ __forceinline__ unsigned pack_u8x4(float a, float b, float c, float d) { return (unsigned)(int)a | ((unsigned)(int)b << 8) | ((unsigned)(int)c << 16) | ((unsigned)(int)d << 24); }
__device__ __forceinline__ float gq(unsigned w, int k) { return (float)((w >> (8 * k)) & 0xffu) + 0.5f; }
struct EpiInProj {
    static constexpr bool PERM = true, AFTER_DRAIN = false; static constexpr int NSEG = 1;
    unsigned char* ws; int pn_off;
    __device__ __forceinline__ void operator()(const pg8::f32x4 (&acc)[2][2][4][2], const pg8::Unit& u, int wr, int wc, int fr, int fq) const {
        asm volatile("" : "+v"(fr), "+v"(fq));
        const int pn = __builtin_amdgcn_readfirstlane(u.pn) + pn_off; unsigned long long boff; int ldc, colt; bool sig = false;
        if (pn < 2) { boff = WS_QA; ldc = 1536; colt = pn * 256; }
        else if (pn == 2) { boff = WS_RAWA; ldc = 256; colt = 0; }
        else if (pn < 9) { boff = WS_U; ldc = 1536; colt = (pn - 3) * 256; }
        else if (pn < 11) { boff = WS_QA; ldc = 1536; colt = 1024 + (pn - 9) * 256; }
        else if (pn == 11) { boff = WS_RAWW; ldc = 256; colt = 0; }
        else { boff = WS_G; ldc = 3072; colt = (pn - 12) * 256; sig = true; }
        bf16_t* base = (bf16_t*)(ws + boff); unsigned char* Gt = ws + boff;
        const int row0 = u.pm * 256 + wr * 64 + fr, col0 = colt + wc * 32 + 8 * fq;
        if (sig) {
            unsigned char* gb = (unsigned char*)Gt;
#pragma unroll
            for (int ai = 0; ai < 2; ++ai)
#pragma unroll
                for (int m = 0; m < 4; ++m) { unsigned char* rowp = gb + (size_t)(row0 + ai * 128 + m * 16) * 3072 + col0;
#pragma unroll
                    for (int bj = 0; bj < 2; ++bj) { const pg8::f32x4 v0 = acc[ai][bj][m][0], v1 = acc[ai][bj][m][1];
                        u32x2 w; w.x = pack_u8x4(gate_q(v0.x), gate_q(v0.y), gate_q(v0.z), gate_q(v0.w)); w.y = pack_u8x4(gate_q(v1.x), gate_q(v1.y), gate_q(v1.z), gate_q(v1.w));
                        *(u32x2*)(rowp + bj * 128) = w; } }
            return;
        }
#pragma unroll
        for (int ai = 0; ai < 2; ++ai)
#pragma unroll
            for (int m = 0; m < 4; ++m) { bf16_t* rowp = base + (size_t)(row0 + ai * 128 + m * 16) * ldc + col0;
#pragma unroll
                for (int bj = 0; bj < 2; ++bj) { const pg8::f32x4 v0 = acc[ai][bj][m][0], v1 = acc[ai][bj][m][1];
                    u32x4 w; w.x = cvtpk(v0.x, v0.y); w.y = cvtpk(v0.z, v0.w); w.z = cvtpk(v1.x, v1.y); w.w = cvtpk(v1.z, v1.w);
                    *(u32x4*)(rowp + bj * 128) = w; } }
    }
};
struct EpiGate {
    static constexpr bool PERM = true, AFTER_DRAIN = false; static constexpr int NSEG = 1;
    unsigned char* Gt;
    __device__ __forceinline__ void operator()(const pg8::f32x4 (&acc)[2][2][4][2], const pg8::Unit& u, int wr, int wc, int fr, int fq) const {
        asm volatile("" : "+v"(fr), "+v"(fq));
        const int row0 = u.pm * 256 + wr * 64 + fr, col0 = u.pn * 256 + wc * 32 + 8 * fq;
#pragma unroll
        for (int ai = 0; ai < 2; ++ai)
#pragma unroll
            for (int m = 0; m < 4; ++m) { unsigned char* rowp = Gt + (size_t)(row0 + ai * 128 + m * 16) * 3072 + col0;
#pragma unroll
                for (int bj = 0; bj < 2; ++bj) { const pg8::f32x4 v0 = acc[ai][bj][m][0], v1 = acc[ai][bj][m][1];
                    u32x2 w; w.x = pack_u8x4(gate_q(v0.x), gate_q(v0.y), gate_q(v0.z), gate_q(v0.w)); w.y = pack_u8x4(gate_q(v1.x), gate_q(v1.y), gate_q(v1.z), gate_q(v1.w));
                    *(u32x2*)(rowp + bj * 128) = w; } }
    }
};
struct EpiMerge {
    static constexpr bool PERM = true, AFTER_DRAIN = false; static constexpr int NSEG = 3;
    unsigned char* Mo; const unsigned char* Gt;
    __device__ __forceinline__ void rescale(pg8::f32x4 (&acc)[2][2][4][2], const pg8::Unit& u, int seg, int wr, int wc, int fr, int fq) const {
        asm volatile("" : "+v"(fr), "+v"(fq));
        const int row0 = u.pm * 256 + wr * 64 + fr, col0 = u.pn * 256 + wc * 32 + 8 * fq;
        const unsigned char* G0 = Gt + seg * 1024 + col0;
        u32x2 ga[2][4][2], gb[2][4][2];
#pragma unroll
        for (int ai = 0; ai < 2; ++ai)
#pragma unroll
            for (int m = 0; m < 4; ++m)
#pragma unroll
                for (int bj = 0; bj < 2; ++bj) { const size_t row = (size_t)(row0 + ai * 128 + m * 16);
                    ga[ai][m][bj] = *(const u32x2*)(G0 + row * 3072 + bj * 128); gb[ai][m][bj] = *(const u32x2*)(G0 + row * 3072 + 1024 + bj * 128); }
        __builtin_amdgcn_sched_barrier(0);
#pragma unroll
        for (int ai = 0; ai < 2; ++ai)
#pragma unroll
            for (int m = 0; m < 4; ++m)
#pragma unroll
                for (int bj = 0; bj < 2; ++bj) { const u32x2 a = ga[ai][m][bj], b = gb[ai][m][bj]; pg8::f32x4& v0 = acc[ai][bj][m][0]; pg8::f32x4& v1 = acc[ai][bj][m][1];
                    v0.x *= gq(a.x, 0) * fast_rcp(gq(b.x, 0)); v0.y *= gq(a.x, 1) * fast_rcp(gq(b.x, 1)); v0.z *= gq(a.x, 2) * fast_rcp(gq(b.x, 2)); v0.w *= gq(a.x, 3) * fast_rcp(gq(b.x, 3));
                    v1.x *= gq(a.y, 0) * fast_rcp(gq(b.y, 0)); v1.y *= gq(a.y, 1) * fast_rcp(gq(b.y, 1)); v1.z *= gq(a.y, 2) * fast_rcp(gq(b.y, 2)); v1.w *= gq(a.y, 3) * fast_rcp(gq(b.y, 3)); }
        __builtin_amdgcn_sched_barrier(0);
    }
    __device__ __forceinline__ void operator()(const pg8::f32x4 (&acc)[2][2][4][2], const pg8::Unit& u, int wr, int wc, int fr, int fq) const {
        asm volatile("" : "+v"(fr), "+v"(fq));
        const int row0 = u.pm * 256 + wr * 64 + fr, col0 = u.pn * 256 + wc * 32 + 8 * fq;
        constexpr float S = 16.f / 256.f;
        u32x2 gv[2][4][2];
#pragma unroll
        for (int ai = 0; ai < 2; ++ai)
#pragma unroll
            for (int m = 0; m < 4; ++m)
#pragma unroll
                for (int bj = 0; bj < 2; ++bj) gv[ai][m][bj] = *(const u32x2*)(Gt + (size_t)(row0 + ai * 128 + m * 16) * 3072 + 2048 + col0 + bj * 128);
        __builtin_amdgcn_sched_barrier(0);
#pragma unroll
        for (int ai = 0; ai < 2; ++ai) {
#pragma unroll
            for (int m = 0; m < 4; ++m)
#pragma unroll
                for (int bj = 0; bj < 2; ++bj) { const pg8::f32x4 v0 = acc[ai][bj][m][0], v1 = acc[ai][bj][m][1]; const u32x2 g = gv[ai][m][bj];
                    u32x2 w; w.x = cvt4_fp8(v0.x * (gq(g.x, 0) * S), v0.y * (gq(g.x, 1) * S), v0.z * (gq(g.x, 2) * S), v0.w * (gq(g.x, 3) * S));
                    w.y = cvt4_fp8(v1.x * (gq(g.y, 0) * S), v1.y * (gq(g.y, 1) * S), v1.z * (gq(g.y, 2) * S), v1.w * (gq(g.y, 3) * S));
                    *(u32x2*)(Mo + (size_t)(row0 + ai * 128 + m * 16) * 1024 + col0 + bj * 128) = w; }
            __builtin_amdgcn_sched_barrier(0);
        }
    }
};
struct EpiOut {
    static constexpr bool PERM = true, AFTER_DRAIN = false; static constexpr int NSEG = 1;
    const float* xsL; const float* xsC; float* xdL; float* xdC; const float* MODl;
    __device__ __forceinline__ void operator()(const pg8::f32x4 (&acc)[2][2][4][2], const pg8::Unit& u, int wr, int wc, int fr, int fq) const {
        asm volatile("" : "+v"(fr), "+v"(fq));
        const int trow = u.pm * 256; const bool lat = trow < TL;
        const int row0 = trow + wr * 64 + fr, col0 = u.pn * 256 + wc * 32 + 8 * fq;
        const float* md = MODl + (size_t)mod_row(trow) * DIN + 2 * 1024 + col0;
        const float* xs = lat ? xsL + (size_t)row0 * D + col0 : xsC + (size_t)(row0 - TL) * D + col0; float* xd = lat ? xdL + (size_t)row0 * D + col0 : xdC + (size_t)(row0 - TL) * D + col0;
        f32x4 mv[2][2];
#pragma unroll
        for (int bj = 0; bj < 2; ++bj)
#pragma unroll
            for (int n = 0; n < 2; ++n) mv[bj][n] = *(const f32x4*)(md + bj * 128 + 4 * n);
#pragma unroll
        for (int ai = 0; ai < 2; ++ai)
#pragma unroll
            for (int mh = 0; mh < 2; ++mh) {
                f32x4 xv[2][2][2];
#pragma unroll
                for (int mm = 0; mm < 2; ++mm)
#pragma unroll
                    for (int bj = 0; bj < 2; ++bj)
#pragma unroll
                        for (int n = 0; n < 2; ++n) xv[mm][bj][n] = *(const f32x4*)(xs + (size_t)(ai * 128 + (2 * mh + mm) * 16) * D + bj * 128 + 4 * n);
                __builtin_amdgcn_sched_barrier(0);
#pragma unroll
                for (int mm = 0; mm < 2; ++mm)
#pragma unroll
                    for (int bj = 0; bj < 2; ++bj)
#pragma unroll
                        for (int n = 0; n < 2; ++n) { const pg8::f32x4 av = acc[ai][bj][2 * mh + mm][n]; const f32x4 x4 = xv[mm][bj][n], m4 = mv[bj][n];
                            f32x4 o; o.x = fmaf(m4.x, av.x, x4.x); o.y = fmaf(m4.y, av.y, x4.y); o.z = fmaf(m4.z, av.z, x4.z); o.w = fmaf(m4.w, av.w, x4.w);
                            *(f32x4*)(xd + (size_t)(ai * 128 + (2 * mh + mm) * 16) * D + bj * 128 + 4 * n) = o; }
                __builtin_amdgcn_sched_barrier(0);
            }
    }
};
struct EpiMoe1 {
    static constexpr bool PERM = true, AFTER_DRAIN = false; static constexpr int NSEG = 1;
    unsigned char* HM;
    __device__ __forceinline__ void operator()(const pg8::f32x4 (&acc)[2][2][4][2], const pg8::Unit& u, int wr, int wc, int fr, int fq) const {
        asm volatile("" : "+v"(fr), "+v"(fq));
        const int row0 = u.pm * 256 + wr * 64 + fr, hcol0 = (u.pn & 3) * 128 + wc * 16 + 4 * fq;
#pragma unroll
        for (int ai = 0; ai < 2; ++ai)
#pragma unroll
            for (int m = 0; m < 4; ++m) { unsigned char* rowp = HM + (size_t)(row0 + ai * 128 + m * 16) * 512 + hcol0;
#pragma unroll
                for (int bj = 0; bj < 2; ++bj) { const pg8::f32x4 x = acc[ai][bj][m][0], y = acc[ai][bj][m][1] * 8.f;
                    *(unsigned*)(rowp + bj * 64) = cvt4_fp8(x.x * sigmoid_f(x.x) * y.x, x.y * sigmoid_f(x.y) * y.y, x.z * sigmoid_f(x.z) * y.z, x.w * sigmoid_f(x.w) * y.w); } }
    }
};
struct EpiMoe2 {
    static constexpr bool PERM = true, AFTER_DRAIN = false; static constexpr int NSEG = 1;
    bf16_t* Fo; const int* erow; const float* eroww; const LAS int* ebase; const LAS int* ecnt;
    __device__ __forceinline__ void operator()(const pg8::f32x4 (&acc)[2][2][4][2], const pg8::Unit& u, int wr, int wc, int fr, int fq) const {
        asm volatile("" : "+v"(fr), "+v"(fq));
        const int e = u.pn >> 2, cnt = __builtin_amdgcn_readfirstlane(ecnt[e]), pos0 = u.pm * 256 - __builtin_amdgcn_readfirstlane(ebase[e]) + wr * 64 + fr, col0 = (u.pn & 3) * 256 + wc * 32 + 8 * fq;
        const int* er = erow + (size_t)e * TT; const float* ew = eroww + (size_t)e * TT;
#pragma unroll
        for (int ai = 0; ai < 2; ++ai) {
            int rm[4]; float wg[4];
#pragma unroll
            for (int m = 0; m < 4; ++m) { const int pos = pos0 + ai * 128 + m * 16; const bool ok = pos < cnt; rm[m] = ok ? er[ok ? pos : 0] : -1; wg[m] = ew[ok ? pos : 0]; }
            __builtin_amdgcn_sched_barrier(0);
#pragma unroll
            for (int m = 0; m < 4; ++m) { const int r1 = rm[m];
                if (r1 >= 0) { const float wgt = wg[m]; bf16_t* rowp = Fo + ((size_t)(r1 & 1) * TT + (r1 >> 1)) * D + col0;
#pragma unroll
                    for (int bj = 0; bj < 2; ++bj) { const pg8::f32x4 v0 = acc[ai][bj][m][0], v1 = acc[ai][bj][m][1];
                        u32x4 w; w.x = cvtpk(v0.x * wgt, v0.y * wgt); w.y = cvtpk(v0.z * wgt, v0.w * wgt); w.z = cvtpk(v1.x * wgt, v1.y * wgt); w.w = cvtpk(v1.z * wgt, v1.w * wgt);
                        *(u32x4*)(rowp + bj * 128) = w; } } }
            __builtin_amdgcn_sched_barrier(0);
        }
    }
};
struct FusedOutOrder {
    int c, G, nun, wv; const unsigned* ready; unsigned* tmo;
    __device__ __forceinline__ bool next(int i, pg8::Unit& u) const {
        int q;
        if (!ready) { q = i * G + c; if (q >= nun) return false; }
        else if (G == 256 && nun == 576) { if (c < 64) { if (i > 0) return false; q = 512 + c; } else { q = i * 192 + (c - 64); if (q >= 512) return false; } }
        else { q = i * G + (G - 1 - c); if (q >= nun) return false; }
        u.pm = q >> 2; u.pn = q & 3; return true; }
    __device__ __forceinline__ void a_ready(const pg8::Unit& u) const {
        if (!ready) return;
        if (wv == 0) {
            const unsigned long long t0 = __builtin_amdgcn_s_memrealtime(); unsigned polls = 0;
            while ((unsigned)__builtin_amdgcn_readfirstlane(__hip_atomic_load(ready + 64 * u.pm, __ATOMIC_RELAXED, __HIP_MEMORY_SCOPE_AGENT)) < 32u) {
                if ((++polls & 255u) == 0u && __builtin_amdgcn_readfirstlane(__hip_atomic_load(tmo, __ATOMIC_RELAXED, __HIP_MEMORY_SCOPE_AGENT)) != 0u) break;
                if (__builtin_amdgcn_s_memrealtime() - t0 > 20000000ull) { if (lane_id() == 0) __hip_atomic_store(tmo, 1u, __ATOMIC_RELAXED, __HIP_MEMORY_SCOPE_AGENT); break; }
                __builtin_amdgcn_s_sleep(2); }
            __builtin_amdgcn_fence(__ATOMIC_ACQUIRE, "agent");
            asm volatile("s_waitcnt vmcnt(0)" ::: "memory");
        }
        asm volatile("" ::: "memory"); __builtin_amdgcn_s_barrier(); asm volatile("" ::: "memory");
    }
    __device__ __forceinline__ void done(const pg8::Unit&) const {}
};
struct LastInProjOrder {
    pg8::StaticOrder T; int nlat, G, c;
    __device__ __forceinline__ bool next(int i, pg8::Unit& u) const {
        const int L = i * G + c;
        if (L < nlat) return T.next(i, u);
        const int r = L - nlat; if (r >= 32) return false;
        u.pm = 128 + (r >> 1); u.pn = (r & 1) ? 11 : 2; return true; }
    __device__ __forceinline__ void a_ready(const pg8::Unit&) const {}
    __device__ __forceinline__ void done(const pg8::Unit&) const {}
};
struct MoeOrder {
    int nunits, G, c; const LAS int* tile_e;
    __device__ __forceinline__ bool next(int i, pg8::Unit& u) const {
        const int L0 = i * G + c; if (L0 >= nunits) return false;
        const int q = nunits / 8, r = nunits % 8, xcd = L0 % 8, off = L0 / 8; const int L = (xcd < r ? xcd * (q + 1) : r * (q + 1) + (xcd - r) * q) + off;
        const int pm = L >> 2; u.pm = pm; u.pn = __builtin_amdgcn_readfirstlane(tile_e[pm]) * 4 + (L & 3); return true; }
    __device__ __forceinline__ void a_ready(const pg8::Unit&) const {}
    __device__ __forceinline__ void done(const pg8::Unit&) const {}
};

__device__ __forceinline__ int moe_tables(const Fr& F, const Args& a, int l, LAS int* ebase  , LAS int* ecnt  , LAS int* tile_e  ) {
    const unsigned* CNT = (const unsigned*)(a.ws + WS_CTL) + CW_CNT + l * 256;
    __syncthreads();
    if (F.tid == 0) { int acc = 0;
#pragma unroll 1
        for (int e = 0; e < NE; ++e) { const int c = (int)__hip_atomic_load(&CNT[e * 16], __ATOMIC_RELAXED, __HIP_MEMORY_SCOPE_AGENT); ecnt[e] = c; ebase[e] = acc; const int nt = (c + 255) >> 8;
#pragma unroll 1
            for (int t = 0; t < nt; ++t) tile_e[(acc >> 8) + t] = e;
            acc += nt << 8; }
        ebase[NE] = acc; }
    __syncthreads();
    return ebase[NE] >> 8;
}

__device__ __forceinline__ void moe_gather_table(const Fr& F, const Args& a, const MoeOrder& S, const LAS int* ebase, const LAS int* ecnt, LAS int* gidx) {
    const int* EROW = (const int*)(a.ws + WS_EROW);
    for (int j = 0; j < 16; ++j) { pg8::Unit u; if (!S.next(j, u)) break;
        const int e = u.pn >> 2, pos0 = u.pm * 256 - ebase[e], cnt = ecnt[e];
        if (F.tid < 256) { const int pos = pos0 + F.tid; gidx[j * 256 + F.tid] = pos < cnt ? (EROW[(size_t)e * TT + pos] >> 1) : 0; } }
    __syncthreads();
}

#ifndef MK_PER_PHASE
#define MK_PER_PHASE 0
#endif
constexpr int PH_PER_LAYER = 10, PH_FINAL = 1 + NL * PH_PER_LAYER, N_PHASES = PH_FINAL + 1;

__global__ void __launch_bounds__(NTHR, 2) trunk_fwd(Args args) {
    extern __shared__ __attribute__((aligned(16))) unsigned char lds[];
    Fr F; F.lds = (LAS unsigned char*)lds; F.tid = threadIdx.x; F.lane = F.tid & 63; F.wave = __builtin_amdgcn_readfirstlane(F.tid >> 6); F.G = gridDim.x; F.bid = blockIdx.x;
    const int wave0 = F.wave;
    for (int u = F.tid; u < (LDS_BYTES - MISC_OFF) / 4; u += NTHR) ((LAS unsigned*)(F.lds + MISC_OFF))[u] = 0u;
    __syncthreads();
    const int lo = args.ph_lo, hi = args.ph_hi;
    unsigned* ctl = (unsigned*)(args.ws + WS_CTL);
    XcdBarrier bar; bar.bar = ctl + CW_BAR; bar.x = 0; bar.st = (volatile LAS unsigned*)(F.lds + MISC_OFF);
    if (hi - lo > 1) bar = xcd_barrier_post(ctl + CW_BAR, (volatile LAS unsigned*)(F.lds + MISC_OFF));
    bar.wv = (unsigned)wave0;
#ifndef DBG_ONLY
#define DBG_ONLY -1
#endif
#define SEL(p) (DBG_ONLY < 0 || DBG_ONLY == (p))
#define IN(k) (lo <= (k) && (k) < hi)
#define FRESH() do { int t_ = wave0 * 64 + lane_id(); asm volatile("" : "+v"(t_)); F.tid = t_; F.lane = t_ & 63; F.wave = wave0; } while (0)
#define SEAM(k) do { if (IN(k) && IN((k) + 1)) xcd_barrier(bar); } while (0)
#if !defined(PROBE_SUB)
#define PROBE_SUB -1
#endif
    unsigned long long pr_sub = 0ull;
#if defined(PROBE_P)
    unsigned long long pr_acc = 0ull, pr_t0 = __builtin_amdgcn_s_memrealtime();
#define PR_MARK(p) do { const unsigned long long t_ = __builtin_amdgcn_s_memrealtime(); if ((p) == PROBE_P) pr_acc += t_ - pr_t0; pr_t0 = t_; } while (0)
#else
#define PR_MARK(p) do { } while (0)
#endif
    unsigned char* ws = args.ws;
    LAS int* ebase = (LAS int*)(F.lds + MISC_OFF + 64); LAS int* ecnt = ebase + 20; LAS int* tile_e = (LAS int*)(F.lds + MISC_OFF + 512);

    #ifndef DBG_PRO
#define DBG_PRO 7
#endif
#if defined(PROBE_P)
    if (SEL(100) && IN(0)) { FRESH(); const unsigned long long tq0_ = __builtin_amdgcn_s_memrealtime(); pro_mod(F, args); __syncthreads(); const unsigned long long tq1_ = __builtin_amdgcn_s_memrealtime(); pro_rope(F, args); pro_filter(F, args); __syncthreads();
        const unsigned long long tq2_ = __builtin_amdgcn_s_memrealtime(); if (PROBE_SUB == 60) pr_sub += tq1_ - tq0_; if (PROBE_SUB == 61) pr_sub += tq2_ - tq1_; }
#else
    if (SEL(100) && IN(0)) { FRESH(); if (DBG_PRO & 1) pro_mod(F, args); __syncthreads(); if (DBG_PRO & 2) pro_rope(F, args); if (DBG_PRO & 4) pro_filter(F, args); __syncthreads(); }
#endif
    SEAM(0); PR_MARK(100);
    for (int l = 0; l < NL; ++l) {
        const int pb = 1 + PH_PER_LAYER * l;
#define LVARS() int lq_ = l; asm volatile("" : "+s"(lq_)); const bool uc = lq_ < NL - 1; const int M2 = uc ? TT : TL; (void)M2; (void)uc
        if (SEL(0) && IN(pb + 0)) { LVARS(); FRESH(); if (l == 0) filter_norm_reduce(F, args); conv_small_weights(F, args, l, 7, 0); rows_p0(F, args, l, TT); __syncthreads(); }
        SEAM(pb + 0); PR_MARK(0);
        if (SEL(1) && IN(pb + 1)) { LVARS();
            pg8::Gemm g{(const bf16_t*)(ws + WS_H8), (const bf16_t*)(ws + WS_WG8), TT, DIN, 512}; EpiInProj E{ws, 0};
            if (uc) { pg8::StaticOrder S; S.init(TT, DIN, F.G, F.bid); pg8::gemm_phase<EpiInProj, pg8::StaticOrder, true, true, false, true, -6>(F.lds, g, S, E, wave0); }
            else { LastInProjOrder S; S.T.init(TL, DIN, F.G, F.bid); S.nlat = (TL / 256) * (DIN / 256); S.G = F.G; S.c = F.bid; pg8::gemm_phase<EpiInProj, LastInProjOrder, true, true, false, true, -6>(F.lds, g, S, E, wave0); }
        }
        SEAM(pb + 1); PR_MARK(1);
        if (SEL(2) && IN(pb + 2)) { LVARS(); FRESH(); prep_phase(F, args, l, uc); }
        SEAM(pb + 2); PR_MARK(2);
        if (SEL(3) && IN(pb + 3)) { LVARS(); FRESH(); mixer_phase(F, args, l, uc, pr_sub, PROBE_SUB); }
        SEAM(pb + 3); PR_MARK(3);
        if (SEL(4) && IN(pb + 4)) { LVARS(); FRESH(); hyena_final_phase(F, args, l, uc); }
        SEAM(pb + 4); PR_MARK(4);
        if (SEL(5) && IN(pb + 5)) { LVARS();
            pg8::StaticOrder S; S.init(M2, 1024, F.G, F.bid);
            pg8::Gemm g{(const bf16_t*)(ws + WS_Y8), (const bf16_t*)(ws + WS_WBR), M2, 1024, 768}; EpiMerge E{ws + WS_H, (const unsigned char*)(ws + WS_G)};
            pg8::gemm_phase<EpiMerge, pg8::StaticOrder, true, true, false, true, -10>(F.lds, g, S, E, wave0);
            { FRESH(); __syncthreads(); const int nun = (M2 / 256) * 4, rem = nun % F.G; conv_expert_weights(F, args, l, rem, 0, CONV_E_ITEMS); __syncthreads(); }
        }
        SEAM(pb + 5); PR_MARK(5);
        if (SEL(6) && IN(pb + 6)) { LVARS();
            pg8::Gemm g{(const bf16_t*)(ws + WS_H), (const bf16_t*)(ws + WS_WOUT), M2, 1024, 512}; pg8::StaticOrder S; S.init(M2, 1024, F.G, F.bid);
            EpiOut E{l == 0 ? args.in[I_X] : args.out, l == 0 ? args.in[I_CTX] : (const float*)(ws + WS_XC), args.out, (float*)(ws + WS_XC), (const float*)(ws + WS_MOD) + (size_t)l * NBM * DIN};
            pg8::gemm_phase<EpiOut, pg8::StaticOrder, true, true, false, true, -10>(F.lds, g, S, E, wave0);
        }
        SEAM(pb + 6); PR_MARK(6);
        if (SEL(7) && IN(pb + 7)) { LVARS(); FRESH(); rows_p5(F, args, l, M2, pr_sub, PROBE_SUB); __syncthreads(); }
        SEAM(pb + 7); PR_MARK(7);
        if (SEL(8) && IN(pb + 8)) { LVARS(); FRESH();
            const int ntile = moe_tables(F, args, l, ebase, ecnt, tile_e);
            pg8::Gemm g{(const bf16_t*)(ws + WS_H), (const bf16_t*)(ws + WS_W13), ntile * 256, NE * 1024, 512}; MoeOrder S{ntile * 4, F.G, F.bid, tile_e};
            LAS int* gidx = (LAS int*)(F.lds + 131072);
            moe_gather_table(F, args, S, ebase, ecnt, gidx);
            EpiMoe1 E{ws + WS_U};
            pg8::gemm_phase<EpiMoe1, MoeOrder, true, true, true, true, -6>(F.lds, g, S, E, wave0, gidx);
        }
        SEAM(pb + 8); PR_MARK(8);
        if (SEL(9) && IN(pb + 9)) { LVARS(); FRESH();
            const int ntile = moe_tables(F, args, l, ebase, ecnt, tile_e);
            pg8::Gemm g{(const bf16_t*)(ws + WS_U), (const bf16_t*)(ws + WS_W2), ntile * 256, NE * 1024, 256}; MoeOrder S{ntile * 4, F.G, F.bid, tile_e};
            EpiMoe2 E{(bf16_t*)(ws + WS_F), (const int*)(ws + WS_EROW), (const float*)(ws + WS_EROWW), ebase, ecnt};
            pg8::gemm_phase<EpiMoe2, MoeOrder, true, true, false, true, -9>(F.lds, g, S, E, wave0);
        }
        SEAM(pb + 9); PR_MARK(9);
    }
    if (SEL(101) && IN(PH_FINAL)) { FRESH(); rows_final(F, args); }
#if defined(PROBE_P)
    PR_MARK(101);
    pr_acc += pr_sub;
#if !defined(PROBE_BLK)
#define PROBE_BLK 0
#endif
    if (blockIdx.x == PROBE_BLK && F.wave == 0) { const unsigned long long t1 = __builtin_amdgcn_s_memrealtime() + 4ull * pr_acc; while (__builtin_amdgcn_s_memrealtime() < t1) __builtin_amdgcn_s_sleep(8); }
#endif
#undef IN
#undef SEAM
}

extern "C" void kernel_launch(void* const* d_in, const int* in_sizes, int n_in, void* d_out, int out_size, void* d_ws, size_t ws_size, hipStream_t stream) {
    static int grid = 0;
    if (grid == 0) {
        if (n_in != 29 || in_sizes[0] != TL * D || out_size != TL * D || ws_size < WS_END) { fprintf(stderr, "kernel_launch: unexpected shapes / workspace (n_in %d, ws %zu < %zu); nothing launched\n", n_in, ws_size, (size_t)WS_END); grid = -1; return; }
        int dev = 0, cus = 0, per_cu = 0;
        if (hipGetDevice(&dev) != hipSuccess || hipDeviceGetAttribute(&cus, hipDeviceAttributeMultiprocessorCount, dev) != hipSuccess) { grid = -1; return; }
        if (hipFuncSetAttribute((const void*)trunk_fwd, hipFuncAttributeMaxDynamicSharedMemorySize, LDS_BYTES) != hipSuccess) { fprintf(stderr, "kernel_launch: hipFuncSetAttribute failed\n"); grid = -1; return; }
        if (hipOccupancyMaxActiveBlocksPerMultiprocessor(&per_cu, (const void*)trunk_fwd, NTHR, LDS_BYTES) != hipSuccess || per_cu < 1) { fprintf(stderr, "kernel_launch: occupancy query reports %d\n", per_cu); }
        (void)hipGetLastError();
        grid = cus;
    }
    if (grid < 0) return;
    (void)hipMemsetAsync((char*)d_ws + WS_CTL, 0, CTL_ZERO_BYTES, stream);
    Args a{};
    for (int i = 0; i < 29; ++i) a.in[i] = (const float*)d_in[i];
    a.out = (float*)d_out; a.ws = (unsigned char*)d_ws;
#if MK_PER_PHASE
    for (int k = 0; k < N_PHASES; ++k) { a.ph_lo = k; a.ph_hi = k + 1; hipLaunchKernelGGL(trunk_fwd, dim3(grid), dim3(NTHR), LDS_BYTES, stream, a); }
#else
    a.ph_lo = 0; a.ph_hi = N_PHASES;
    hipLaunchKernelGGL(trunk_fwd, dim3(grid), dim3(NTHR), LDS_BYTES, stream, a);
#endif
}
```

```cpp
#include <hip/hip_runtime.h>
#include <cstdio>
#include <cstdint>

#define GAS __attribute__((address_space(1)))
#define LAS __attribute__((address_space(3)))
__device__ __forceinline__ int lane_id() { int l; asm volatile("v_mbcnt_lo_u32_b32 %0, -1, 0\n\tv_mbcnt_hi_u32_b32 %0, -1, %0" : "=v"(l)); return l; }
#define MK_PER_PHASE 0
namespace pg8 {
#define PG8_LAS __attribute__((address_space(3)))
typedef unsigned short bf16_t;
typedef short bf16x8 __attribute__((ext_vector_type(8)));
typedef float f32x4 __attribute__((ext_vector_type(4)));
typedef unsigned u32x4 __attribute__((ext_vector_type(4)));
constexpr int BM = 256, BK = 64, HALF = 128, HTB = HALF * BK * 2  , STAGE_BYTES = 8 * HTB, NXCD = 8, WGM = 8;

__host__ __device__ __forceinline__ int lds_byte(int r, int c) { const int st = (r >> 4) * 2 + (c >> 5), rr = r & 15, cc = c & 31, ob = rr * 64 + cc * 2; return st * 1024 + (ob ^ (((ob >> 9) & 1) << 5)); }
__host__ __device__ __forceinline__ void stage_rc(int b, int& R, int& C) { const int st = b / 1024, sb = b % 1024, swz = sb ^ (((sb >> 9) & 1) << 5); R = (st >> 1) * 16 + swz / 64; C = (st & 1) * 32 + (swz % 64) / 2; }
__host__ __device__ __forceinline__ int perm32(int rho) { const int n = rho >> 4, i = rho & 15; return 8 * (i >> 2) + 4 * n + (i & 3); }

struct Unit { int pm, pn; };
struct Gemm { const bf16_t* A; const bf16_t* Bt; int M, N, K; };

struct StaticOrder {
    int nM, nN, nwg, G, c;
    __host__ __device__ void init(int M, int N, int G_, int c_) { nM = M / BM; nN = N / BM; nwg = nM * nN; G = G_; c = c_; }
    __host__ __device__ bool next(int i, Unit& u) const {
        const long L = (long)i * G + c; if (L >= nwg) return false;
        int wgid = (int)L; { const int q = nwg / NXCD, r = nwg % NXCD, xcd = wgid % NXCD, off = wgid / NXCD; wgid = (xcd < r ? xcd * (q + 1) : r * (q + 1) + (xcd - r) * q) + off; }
        const int nig = WGM * nN, gid = wgid / nig, fm = gid * WGM, gsz = (nM - fm) < WGM ? (nM - fm) : WGM;
        u.pm = fm + ((wgid % nig) % gsz); u.pn = (wgid % nig) / gsz; return true;
    }
    __device__ __forceinline__ void a_ready(const Unit&) const {}
    __device__ __forceinline__ void done(const Unit&) const {}
};
__device__ __forceinline__ unsigned cvt_pk_bf16(float lo, float hi) { unsigned r; asm volatile("v_cvt_pk_bf16_f32 %0, %1, %2" : "=v"(r) : "v"(lo), "v"(hi)); return r; }
typedef float f32x2 __attribute__((ext_vector_type(2)));
template <class Epi, class Sched, bool ALIGN_EPI = false, bool SP2 = false, bool GATHER = false, bool F8 = false, int F8_SW = 0>
__device__ __forceinline__ void gemm_phase(PG8_LAS unsigned char* lds, const Gemm g, const Sched& S, const Epi& E, const int wave_id, const PG8_LAS int* gidx = nullptr) {
    static_assert(!GATHER || SP2, "GATHER is implemented for the SP2 loop only");
    int tid_ = wave_id * 64 + lane_id(); asm volatile("" : "+v"(tid_));
    const int tid = tid_, wid = __builtin_amdgcn_readfirstlane(tid >> 6), lane = tid & 63, wr = wid >> 2, wc = wid & 3, fr = lane & 15, fq = lane >> 4;
    const int K = g.K, nt = K / BK;
    unsigned voffA[2], voffB[2];
#pragma unroll
    for (int i = 0; i < 2; ++i) { int R, C; stage_rc(tid * 16 + i * 8192, R, C); const int Rb = Epi::PERM ? ((R & ~31) + perm32(R & 31)) : R;
        voffA[i] = (unsigned)(R * K + C) * 2u; voffB[i] = (unsigned)(Rb * K + C) * 2u; }
    unsigned goffA[2][2], goffN[2][2];
#define PG8_GOFF(dst, j) do { _Pragma("unroll") for (int _h = 0; _h < 2; ++_h) _Pragma("unroll") for (int _i = 0; _i < 2; ++_i) { int R_, C_; stage_rc(tid * 16 + _i * 8192, R_, C_); \
        dst[_h][_i] = ((unsigned)gidx[(j) * 256 + _h * 128 + R_] * (unsigned)K + (unsigned)C_) * 2u; } } while (0)
#define PG8_STAGE_A(bufoff, base, h, nx) do { if constexpr (GATHER) { unsigned o_[2] = {(nx) ? goffN[h][0] : goffA[h][0], (nx) ? goffN[h][1] : goffA[h][1]}; PG8_STAGE(bufoff, base, o_); } \
        else { PG8_STAGE(bufoff, (base) + ((h) ? hstep : 0), voffA); } } while (0)
    const size_t kstep = (size_t)(BK * 2);
    const size_t hstep = (size_t)HALF * K * 2;
    const size_t tstep = 2 * hstep;
    const unsigned ldsw = (unsigned)wid * 1024u;
    const int aoff = lds_byte(wr * 64 + fr, fq * 8), boff = lds_byte(wc * 32 + fr, fq * 8);
#define PG8_SA(b, h) (((b) * 2 + (h)) * HTB)
#define PG8_SB(b, h) ((4 + (b) * 2 + (h)) * HTB)
#define PG8_STAGE(bufoff, gbase, voff) do { _Pragma("unroll") for (int _i = 0; _i < 2; ++_i) \
        __builtin_amdgcn_global_load_lds((const unsigned*)((const char*)(gbase) + (voff)[_i]), (PG8_LAS unsigned*)(lds + (bufoff) + ldsw + _i * 8192), 16, 0, 0); } while (0)
#define PG8_LDA(dst, b, h) do { _Pragma("unroll") for (int m = 0; m < 4; ++m) _Pragma("unroll") for (int k = 0; k < 2; ++k) dst[m][k] = *(const PG8_LAS bf16x8*)(lds + PG8_SA(b, h) + aoff + m * 2048 + k * 1024); } while (0)
#define PG8_LDB(dst, b, h) do { _Pragma("unroll") for (int n = 0; n < 2; ++n) _Pragma("unroll") for (int k = 0; k < 2; ++k) dst[n][k] = *(const PG8_LAS bf16x8*)(lds + PG8_SB(b, h) + boff + n * 2048 + k * 1024); } while (0)
#define PG8_MMA(ai, bj, At, Bt) do { if constexpr (F8) __builtin_amdgcn_sched_barrier(0); __builtin_amdgcn_s_setprio(1); _Pragma("unroll") for (int m = 0; m < 4; ++m) _Pragma("unroll") for (int n = 0; n < 2; ++n) { \
        if constexpr (F8) { typedef int i32x4_ __attribute__((ext_vector_type(4))); typedef int i32x8_ __attribute__((ext_vector_type(8))); \
            const i32x8_ wf = __builtin_shufflevector(__builtin_bit_cast(i32x4_, Bt[n][0]), __builtin_bit_cast(i32x4_, Bt[n][1]), 0, 1, 2, 3, 4, 5, 6, 7); \
            const i32x8_ af = __builtin_shufflevector(__builtin_bit_cast(i32x4_, At[m][0]), __builtin_bit_cast(i32x4_, At[m][1]), 0, 1, 2, 3, 4, 5, 6, 7); \
              \
            asm volatile("v_mfma_scale_f32_16x16x128_f8f6f4 %0, %1, %2, %0, %3, %4 op_sel_hi:[0,0,0]" : "+v"(acc[ai][bj][m][n]) : "v"(wf), "v"(af), "v"(f8sw), "v"(f8sa)); } \
        else { _Pragma("unroll") for (int k = 0; k < 2; ++k) acc[ai][bj][m][n] = __builtin_amdgcn_mfma_f32_16x16x32_bf16(Bt[n][k], At[m][k], acc[ai][bj][m][n], 0, 0, 0); } } \
        __builtin_amdgcn_s_setprio(0); if constexpr (F8) __builtin_amdgcn_sched_barrier(0); } while (0)
#define PG8_WAIT_V(n) asm volatile("s_waitcnt vmcnt(" #n ")" ::: "memory")
#define PG8_WAIT_L(n) asm volatile("s_waitcnt lgkmcnt(" #n ")" ::: "memory")
#define PG8_BAR __builtin_amdgcn_s_barrier()
#define PG8_SCHED __builtin_amdgcn_sched_barrier(0)
    const int f8sw = 127 + F8_SW, f8sa = 127; (void)f8sw; (void)f8sa;
    Unit cur, nxt; int ui = 0;
    if (!S.next(0, cur)) return;
    f32x4 acc[2][2][4][2];
#pragma unroll
    for (int a = 0; a < 2; ++a)
#pragma unroll
        for (int b = 0; b < 2; ++b)
#pragma unroll
            for (int m = 0; m < 4; ++m)
#pragma unroll
                for (int n = 0; n < 2; ++n) acc[a][b][m][n] = (f32x4){0.f, 0.f, 0.f, 0.f};
    bf16x8 At[4][2], B0[2][2], B1[2][2];
    const char* cA = GATHER ? (const char*)g.A : (const char*)g.A + (size_t)cur.pm * tstep; const char* cB = (const char*)g.Bt + (size_t)cur.pn * tstep;
    if constexpr (GATHER) PG8_GOFF(goffA, 0);
    S.a_ready(cur);
    if constexpr (SP2) {
        PG8_STAGE(PG8_SB(0, 0), cB, voffB); PG8_STAGE(PG8_SB(0, 1), cB + hstep, voffB); PG8_STAGE_A(PG8_SA(0, 0), cA, 0, false); PG8_STAGE_A(PG8_SA(0, 1), cA, 1, false);
        if (wr == 1) PG8_BAR;
        PG8_WAIT_V(2); PG8_BAR;
        PG8_STAGE(PG8_SB(1, 0), cB + kstep, voffB); PG8_STAGE_A(PG8_SA(1, 0), cA + kstep, 0, false); PG8_STAGE(PG8_SB(1, 1), cB + hstep + kstep, voffB);
        PG8_WAIT_V(6); PG8_BAR;
    } else {
        PG8_STAGE(PG8_SB(0, 0), cB, voffB); PG8_STAGE(PG8_SA(0, 0), cA, voffA); PG8_STAGE(PG8_SB(0, 1), cB + hstep, voffB); PG8_STAGE(PG8_SA(0, 1), cA + hstep, voffA);
        if (wr == 1) PG8_BAR;
        PG8_WAIT_V(4); PG8_BAR;
        PG8_STAGE(PG8_SB(1, 0), cB + kstep, voffB); PG8_STAGE(PG8_SA(1, 0), cA + kstep, voffA); PG8_STAGE(PG8_SB(1, 1), cB + hstep + kstep, voffB);
        PG8_WAIT_V(6); PG8_BAR;
    }
    for (;;) {
        const bool has_next = S.next(ui + 1, nxt);
        if constexpr (GATHER) { if (has_next) PG8_GOFF(goffN, ui + 1); else { _Pragma("unroll") for (int _h = 0; _h < 2; ++_h) _Pragma("unroll") for (int _i = 0; _i < 2; ++_i) goffN[_h][_i] = goffA[_h][_i]; } }
        const char* nA = GATHER ? (const char*)g.A : has_next ? (const char*)g.A + (size_t)nxt.pm * tstep : cA; const char* nB = has_next ? (const char*)g.Bt + (size_t)nxt.pn * tstep : cB;
        for (int t = 0; t < nt; t += 2) {
            const bool last = (t == nt - 2);
            const char* a1 = cA + (size_t)(t + 1) * kstep;
            const char* a2 = last ? nA : cA + (size_t)(t + 2) * kstep; const char* b2 = last ? nB : cB + (size_t)(t + 2) * kstep;
            const char* a3 = a2 + kstep; const char* b3 = b2 + kstep;
            if (last && has_next) S.a_ready(nxt);
            if constexpr (SP2) {
            PG8_LDB(B0, 0, 0); PG8_LDB(B1, 0, 1); PG8_SCHED; PG8_LDA(At, 0, 0); PG8_STAGE_A(PG8_SA(1, 1), a1, 1, false);
            PG8_WAIT_V(8); PG8_WAIT_L(0); PG8_BAR; PG8_MMA(0, 0, At, B0); PG8_MMA(0, 1, At, B1); PG8_BAR; PG8_SCHED;
            PG8_LDA(At, 0, 1); PG8_STAGE(PG8_SB(0, 0), b2, voffB); PG8_STAGE(PG8_SB(0, 1), b2 + hstep, voffB); PG8_STAGE_A(PG8_SA(0, 0), a2, 0, last);
            PG8_WAIT_V(8); PG8_WAIT_L(0); PG8_BAR; PG8_MMA(1, 0, At, B0); PG8_MMA(1, 1, At, B1); PG8_BAR; PG8_SCHED;
            PG8_LDB(B0, 1, 0); PG8_LDB(B1, 1, 1); PG8_SCHED; PG8_LDA(At, 1, 0); PG8_STAGE_A(PG8_SA(0, 1), a2, 1, last);
            PG8_WAIT_V(8); PG8_WAIT_L(0); PG8_BAR; PG8_MMA(0, 0, At, B0); PG8_MMA(0, 1, At, B1); PG8_BAR; PG8_SCHED;
            PG8_LDA(At, 1, 1); PG8_STAGE(PG8_SB(1, 0), b3, voffB); PG8_STAGE(PG8_SB(1, 1), b3 + hstep, voffB); PG8_STAGE_A(PG8_SA(1, 0), a3, 0, last);
            PG8_WAIT_V(8); PG8_WAIT_L(0); PG8_BAR; PG8_MMA(1, 0, At, B0); PG8_MMA(1, 1, At, B1); PG8_BAR; PG8_SCHED;
            if constexpr (Epi::NSEG > 1) {
                constexpr int SEGT = F8 ? 4 : 8;
                if (t + 2 < nt && ((t + 2) & (SEGT - 1)) == 0) { if constexpr (F8) asm volatile("s_nop 15\n\ts_nop 15" ::: "memory"); E.rescale(acc, cur, (t + 2) / SEGT - 1, wr, wc, fr, fq); }
            }
            } else {
            PG8_LDB(B0, 0, 0); PG8_SCHED; PG8_LDA(At, 0, 0); PG8_STAGE(PG8_SA(1, 1), a1 + hstep, voffA);
            PG8_WAIT_L(8); PG8_BAR; PG8_WAIT_L(0); PG8_MMA(0, 0, At, B0); PG8_BAR; PG8_SCHED;
            PG8_LDB(B1, 0, 1); PG8_STAGE(PG8_SB(0, 0), b2, voffB);
            PG8_BAR; PG8_WAIT_L(0); PG8_MMA(0, 1, At, B1); PG8_BAR;
            PG8_LDA(At, 0, 1); PG8_STAGE(PG8_SA(0, 0), a2, voffA);
            PG8_BAR; PG8_WAIT_L(0); PG8_MMA(1, 0, At, B0); PG8_BAR; PG8_SCHED;
            PG8_STAGE(PG8_SB(0, 1), b2 + hstep, voffB);
            PG8_WAIT_V(6); PG8_BAR; PG8_MMA(1, 1, At, B1); PG8_BAR;
            PG8_LDB(B0, 1, 0); PG8_SCHED; PG8_LDA(At, 1, 0); PG8_STAGE(PG8_SA(0, 1), a2 + hstep, voffA);
            PG8_WAIT_L(8); PG8_BAR; PG8_WAIT_L(0); PG8_MMA(0, 0, At, B0); PG8_BAR; PG8_SCHED;
            PG8_LDB(B1, 1, 1); PG8_STAGE(PG8_SB(1, 0), b3, voffB);
            PG8_BAR; PG8_WAIT_L(0); PG8_MMA(0, 1, At, B1); PG8_BAR;
            PG8_LDA(At, 1, 1); PG8_STAGE(PG8_SA(1, 0), a3, voffA);
            PG8_BAR; PG8_WAIT_L(0); PG8_MMA(1, 0, At, B0); PG8_BAR; PG8_SCHED;
            PG8_STAGE(PG8_SB(1, 1), b3 + hstep, voffB);
            PG8_WAIT_V(6); PG8_BAR; PG8_MMA(1, 1, At, B1); PG8_BAR;
            }
        }
        if constexpr (ALIGN_EPI) { if (wr == 0) PG8_BAR; }
        if constexpr (F8) asm volatile("s_nop 15\n\ts_nop 15" ::: "memory");
        if constexpr (!Epi::AFTER_DRAIN) { E(acc, cur, wr, wc, fr, fq); S.done(cur); }
        if (!has_next) break;
#pragma unroll
        for (int a = 0; a < 2; ++a)
#pragma unroll
            for (int b = 0; b < 2; ++b)
#pragma unroll
                for (int m = 0; m < 4; ++m)
#pragma unroll
                    for (int n = 0; n < 2; ++n) acc[a][b][m][n] = (f32x4){0.f, 0.f, 0.f, 0.f};
        cur = nxt; cA = nA; cB = nB; ++ui;
        if constexpr (GATHER) { _Pragma("unroll") for (int _h = 0; _h < 2; ++_h) _Pragma("unroll") for (int _i = 0; _i < 2; ++_i) goffA[_h][_i] = goffN[_h][_i]; }
        if constexpr (ALIGN_EPI) { if (wr == 1) PG8_BAR; }
    }
    PG8_WAIT_V(0);
    if constexpr (!ALIGN_EPI) { if (wr == 0) PG8_BAR; }
    PG8_BAR;
    if constexpr (Epi::AFTER_DRAIN) { E.fused(acc, cur, wr, wc, fr, fq, lds, wid, lane); S.done(cur); }
#undef PG8_SA
#undef PG8_SB
#undef PG8_STAGE
#undef PG8_STAGE_A
#undef PG8_GOFF
#undef PG8_LDA
#undef PG8_LDB
#undef PG8_MMA
#undef PG8_WAIT_V
#undef PG8_WAIT_L
#undef PG8_BAR
#undef PG8_SCHED
}
}
#define XB_TMO      128
#define XB_XCNT(j)  (256  + 64 * (j))
#define XB_XSUB(j)  (1280 + 64 * (j))
#define XB_XGEN(j)  (2304 + 64 * (j))
#define XB_TOP      3328
#define XB_TOPGEN   3392
#define XCD_BAR_WORDS 3456
#define XB_SPIN_CAP (1u << 22)
#define LAS __attribute__((address_space(3)))

__device__ __forceinline__ unsigned xb_ld(unsigned* p)              { return __hip_atomic_load(p, __ATOMIC_RELAXED, __HIP_MEMORY_SCOPE_AGENT); }
__device__ __forceinline__ unsigned xb_add(unsigned* p, unsigned v) { asm volatile("" : "+v"(p));
    return __hip_atomic_fetch_add(p, v, __ATOMIC_RELAXED, __HIP_MEMORY_SCOPE_AGENT); }
__device__ __forceinline__ unsigned xb_xcc_id() { return (unsigned)__builtin_amdgcn_s_getreg((3 << 11) | 20) & 0xFu; }
#define XB_SPIN(cond, bar) do { unsigned _sp = 0; while (cond) { __builtin_amdgcn_s_sleep(1); \
    if ((++_sp & 255u) == 0u) { if (xb_ld(&(bar)[XB_TMO])) break; if (_sp > XB_SPIN_CAP) { xb_add(&(bar)[XB_TMO], 1u); break; } } } } while (0)

struct XcdBarrier {
    unsigned* bar; unsigned x; unsigned wv;
    volatile LAS unsigned* st;
};

__device__ __forceinline__ XcdBarrier xcd_barrier_post(unsigned* bar, volatile LAS unsigned* st) {
    XcdBarrier b; b.bar = bar; b.x = xb_xcc_id(); b.st = st;
    if (threadIdx.x == 0) (void)xb_add(&bar[XB_XCNT(b.x)], 1u);
    return b;
}
__device__ __forceinline__ void xcd_barrier_complete(unsigned* bar, unsigned x, unsigned& nloc, unsigned& nx) {
    const unsigned G = gridDim.x * gridDim.y * gridDim.z;
    unsigned sum, cnt, mine, sp = 0u;
    for (;;) {
        sum = 0u; cnt = 0u; mine = 0u;
#pragma unroll
        for (unsigned j = 0; j < 16; ++j) { const unsigned c = xb_ld(&bar[XB_XCNT(j)]); sum += c; cnt += (c > 0u) ? 1u : 0u; mine = (j == x) ? c : mine; }
        if (sum == G) break;
        __builtin_amdgcn_s_sleep(1);
        if ((++sp & 255u) == 0u) { if (xb_ld(&bar[XB_TMO])) break; if (sp > XB_SPIN_CAP) { xb_add(&bar[XB_TMO], 1u); break; } }
    }
    nloc = mine > 0u ? mine : 1u; nx = cnt > 0u ? cnt : 1u;
}

__device__ __forceinline__ void xcd_barrier(const XcdBarrier& b) {
    asm volatile("s_waitcnt vmcnt(0)" ::: "memory");
    __syncthreads();
    if (b.wv == 0u && lane_id() == 0) {
        unsigned* bar = b.bar;
        __builtin_amdgcn_s_waitcnt(0);
        unsigned nloc = b.st[0], nx = b.st[1];
        if (nloc == 0u) { xcd_barrier_complete(bar, b.x, nloc, nx); b.st[0] = nloc; b.st[1] = nx; }
        const unsigned old = xb_add(&bar[XB_XSUB(b.x)], 1u);
        const unsigned gen = old / nloc;
        if (old + 1u == (gen + 1u) * nloc) {
            __builtin_amdgcn_fence(__ATOMIC_RELEASE, "agent");
            asm volatile("s_waitcnt vmcnt(0)" ::: "memory");
            const unsigned og = xb_add(&bar[XB_TOP], 1u);
            const unsigned tg = og / nx;
            if (og + 1u == (tg + 1u) * nx) xb_add(&bar[XB_TOPGEN], 1u);
            else XB_SPIN(xb_ld(&bar[XB_TOPGEN]) == tg, bar);
            __builtin_amdgcn_fence(__ATOMIC_ACQUIRE, "agent");
            xb_add(&bar[XB_XGEN(b.x)], 1u);
            asm volatile("s_waitcnt vmcnt(0)" ::: "memory");
        } else {
            XB_SPIN(xb_ld(&bar[XB_XGEN(b.x)]) == gen, bar);
            __builtin_amdgcn_fence(__ATOMIC_ACQUIRE, "agent");
            asm volatile("s_waitcnt vmcnt(0)" ::: "memory");
        }
    }
    __syncthreads();
}

typedef unsigned short bf16_t;
typedef short bf16x8 __attribute__((ext_vector_type(8)));
typedef float f32x4 __attribute__((ext_vector_type(4)));
typedef float f32x16 __attribute__((ext_vector_type(16)));
typedef unsigned u32x4 __attribute__((ext_vector_type(4)));
typedef unsigned u32x2 __attribute__((ext_vector_type(2)));

constexpr int D = 1024, NB = 16, SEQ = 2048, CTX = 256, NL = 4;
constexpr int TL = NB * SEQ, TC = NB * CTX, TT = TL + TC;
constexpr int DIN = 6144, HYW = 512, NE = 16, DE = 512, KEYS = CTX + SEQ;
constexpr int NMOD = 6, NBM = NB + 1;
constexpr int APROWS = 2 * TT + NE * 256;
constexpr float EPS = 1e-6f, LOG2E = 1.4426950408889634f;
constexpr float QSCALE = 0.125f * LOG2E;

constexpr size_t MiB = 1u << 20;
constexpr size_t WS_CTL = 0, CTL_ZERO_BYTES = 1 * MiB;
constexpr size_t WS_MOD = 1 * MiB;
constexpr size_t WS_ROPE = 3 * MiB;
constexpr size_t WS_FL = 4 * MiB, WS_FC = 20 * MiB;
constexpr size_t WS_MISC = 22 * MiB;
constexpr size_t WS_FNORM = WS_MISC;
constexpr size_t WS_TOKE = WS_MISC + 64 * 1024, WS_TOKP = WS_MISC + 352 * 1024, WS_TOKW = WS_MISC + 640 * 1024;
constexpr size_t WS_ROWMAP = WS_MISC + 960 * 1024, WS_ROWW = WS_MISC + 1280 * 1024;
constexpr size_t WS_WIN = 24 * MiB, WS_WBR = 36 * MiB, WS_WOUT = 39 * MiB;
constexpr size_t WS_XC = 41 * MiB;
constexpr size_t WS_NP = WS_XC;
constexpr size_t WS_H = 57 * MiB;
constexpr size_t WS_KA = 129 * MiB, WS_VTA = 138 * MiB, WS_KW = 147 * MiB, WS_VTW = 156 * MiB;
constexpr size_t WS_QA = 165 * MiB, WS_QW = 201 * MiB, WS_YH = 237 * MiB, WS_VT = 273 * MiB, WS_YT = 309 * MiB;
constexpr size_t WS_RAWA = 309 * MiB, WS_RAWW = 327 * MiB;
constexpr size_t WS_F = 165 * MiB;
constexpr size_t WS_U = 345 * MiB;
constexpr size_t WS_G = 453 * MiB;
constexpr size_t WS_Y8 = 561 * MiB;
constexpr size_t WS_W13 = 621 * MiB, WS_W2 = 637 * MiB;
constexpr size_t WS_EROW = 669 * MiB, WS_EROWW = 672 * MiB;
constexpr size_t WS_H8 = 675 * MiB;
constexpr size_t WS_WG8 = WS_WIN;
constexpr size_t WS_END = 711 * MiB;
static_assert(WS_G + (size_t)TT * 3072 <= WS_Y8 && WS_Y8 + (size_t)TT * 1536 <= WS_W13 && WS_W13 + (size_t)16 * 1024 * 1024 <= WS_W2 && WS_W2 + (size_t)16 * 1024 * 512 <= WS_EROW, "ws map");
static_assert(WS_U + (size_t)APROWS * 1024 <= WS_G && WS_F + (size_t)2 * TT * 2048 <= WS_YT, "ws map 2");
constexpr size_t VT_CTX_OFF = (size_t)HYW * NB * SEQ;

constexpr int CW_BAR = 4096, CW_CNT = 8192, CW_PANEL = 16384, CW_HTMO = 12288;
constexpr int LDS_BYTES = 151552, MISC_OFF = 147456;
constexpr int NWAVES = 8, NTHR = 512;

struct Args { const float* in[29]; float* out; unsigned char* ws; int ph_lo, ph_hi; };
enum { I_X = 0, I_C, I_CTX, I_CCTX, I_ADAW, I_ADAB, I_N1G, I_N2G, I_WIN, I_QKG, I_HSW, I_HSB, I_HW1, I_HB1, I_HFR, I_HW2, I_HB2, I_HW3, I_HBIAS, I_SINK, I_WBR, I_WOUT,
       I_RGW, I_RGB, I_REW, I_REB, I_EW1, I_EW3, I_EW2 };

#define LDS_WAIT() asm volatile("s_waitcnt lgkmcnt(0)" ::: "memory")
#define VM_WAIT() asm volatile("s_waitcnt vmcnt(0)" ::: "memory")

typedef float f32x2_t __attribute__((ext_vector_type(2)));
typedef __bf16 bf16x2_t __attribute__((ext_vector_type(2)));
__device__ __forceinline__ unsigned cvtpk(float lo, float hi) { f32x2_t v = {lo, hi}; bf16x2_t b = __builtin_convertvector(v, bf16x2_t); return __builtin_bit_cast(unsigned, b); }
__device__ __forceinline__ unsigned zero_u32() { unsigned z; asm volatile("v_mov_b32 %0, 0" : "=v"(z)); return z; }
__device__ __forceinline__ float clamp_fp8(float x) { return __builtin_amdgcn_fmed3f(x, -448.f, 448.f); }
__device__ __forceinline__ unsigned cvt4_fp8(float a, float b, float c, float d) { int r = __builtin_amdgcn_cvt_pk_fp8_f32(a, b, 0, false); r = __builtin_amdgcn_cvt_pk_fp8_f32(c, d, r, true); return (unsigned)r; }
__device__ __forceinline__ unsigned cvt4_fp8c(float a, float b, float c, float d) { return cvt4_fp8(clamp_fp8(a), clamp_fp8(b), clamp_fp8(c), clamp_fp8(d)); }
__device__ __forceinline__ float bflo(unsigned u) { return __builtin_bit_cast(float, u << 16); }
__device__ __forceinline__ float bfhi(unsigned u) { return __builtin_bit_cast(float, u & 0xffff0000u); }
__device__ __forceinline__ float bf1(bf16_t u) { return __builtin_bit_cast(float, (unsigned)u << 16); }
__device__ __forceinline__ bf16_t f2bf(float f) { return (bf16_t)(cvtpk(f, 0.f) & 0xffffu); }
#define DPP_F(v, ctrl) __builtin_bit_cast(float, __builtin_amdgcn_update_dpp(0, __builtin_bit_cast(int, (v)), (ctrl), 0xf, 0xf, false))
__device__ __forceinline__ float row16_sum(float v) {
    v += DPP_F(v, 0xB1);
    v += DPP_F(v, 0x4E);
    v += DPP_F(v, 0x141);
    v += DPP_F(v, 0x140);
    return v;
}
__device__ __forceinline__ float wave_sum(float v) {
    v = row16_sum(v);
    const int iv = __builtin_bit_cast(int, v);
    float r = (__builtin_bit_cast(float, __builtin_amdgcn_readlane(iv, 0)) + __builtin_bit_cast(float, __builtin_amdgcn_readlane(iv, 16)))
            + (__builtin_bit_cast(float, __builtin_amdgcn_readlane(iv, 32)) + __builtin_bit_cast(float, __builtin_amdgcn_readlane(iv, 48)));
    asm volatile("" : "+v"(r));
    return r;
}
__device__ __forceinline__ float fast_exp2(float x) { return __builtin_amdgcn_exp2f(x); }
__device__ __forceinline__ float fast_rcp(float x) { return __builtin_amdgcn_rcpf(x); }
__device__ __forceinline__ float sigmoid_f(float x) { return fast_rcp(1.f + fast_exp2(-x * LOG2E)); }

__device__ __forceinline__ void sincos_acc(float x, float& s, float& c) {
    const float q = rintf(x * 0.636619772367581f);
    float y = fmaf(-q, 1.57079625129699707031f, x);
    y = fmaf(-q, 7.54978941586159635335e-08f, y);
    const float y2 = y * y;
    float sp = fmaf(y2, 2.7557314297e-06f, -1.9841270114e-04f); sp = fmaf(sp, y2, 8.3333337680e-03f); sp = fmaf(sp, y2, -1.6666667163e-01f); sp = fmaf(sp * y2, y, y);
    float cp = fmaf(y2, -2.7557314297e-07f, 2.4801587642e-05f); cp = fmaf(cp, y2, -1.3888889225e-03f); cp = fmaf(cp, y2, 4.1666667908e-02f); cp = fmaf(cp, y2, -0.5f); cp = fmaf(cp, y2, 1.0f);
    const int n = (int)q & 3;
    const float s1 = (n & 1) ? cp : sp, c1 = (n & 1) ? sp : cp;
    s = (n & 2) ? -s1 : s1;
    c = ((n + 1) & 2) ? -c1 : c1;
}

struct Fr { LAS unsigned char* lds; int tid, lane, wave, G, bid; };

__device__ __forceinline__ void pro_mod(const Fr& F, const Args& a) {
    LAS float* s = (LAS float*)F.lds;
    LAS float* red = (LAS float*)(F.lds + 69632);
    const float* c = a.in[I_C]; const float* cc = a.in[I_CCTX]; const float* W = a.in[I_ADAW]; const float* Bv = a.in[I_ADAB];
    float* MOD = (float*)(a.ws + WS_MOD);
    for (int i = F.tid; i < NBM * 1024; i += NTHR) { const int bb = i >> 10, k = i & 1023; const float v = (bb < NB) ? c[bb * 1024 + k] : cc[k]; s[i] = v / (1.f + __expf(-v)); }
    __syncthreads();
    const int col = F.tid & 63, ks = F.wave;
    for (int unit = F.G - 1 - F.bid; unit < NL * 96; unit += F.G) {
        const int l = unit / 96, j0 = (unit % 96) * 64;
        float acc[NBM];
#pragma unroll
        for (int bb = 0; bb < NBM; ++bb) acc[bb] = 0.f;
        const float* Wp = W + ((size_t)l * 1024 + ks * 128) * DIN + j0 + col;
#pragma unroll 2
        for (int k = 0; k < 128; k += 4) {
            const float w0 = Wp[(size_t)k * DIN], w1 = Wp[(size_t)(k + 1) * DIN], w2 = Wp[(size_t)(k + 2) * DIN], w3 = Wp[(size_t)(k + 3) * DIN];
#pragma unroll
            for (int bb = 0; bb < NBM; ++bb) { const f32x4 sv = *(const LAS f32x4*)(s + bb * 1024 + ks * 128 + k);
                acc[bb] = fmaf(sv.x, w0, acc[bb]); acc[bb] = fmaf(sv.y, w1, acc[bb]); acc[bb] = fmaf(sv.z, w2, acc[bb]); acc[bb] = fmaf(sv.w, w3, acc[bb]); } }
#pragma unroll
        for (int bb = 0; bb < NBM; ++bb) red[(ks * NBM + bb) * 64 + col] = acc[bb];
        __syncthreads();
        for (int o = F.tid; o < NBM * 64; o += NTHR) { const int bb = o >> 6, cx = o & 63; float sum = 0.f;
#pragma unroll
            for (int k2 = 0; k2 < 8; ++k2) sum += red[(k2 * NBM + bb) * 64 + cx];
            MOD[((size_t)l * NBM + bb) * DIN + j0 + cx] = sum + Bv[l * DIN + j0 + cx]; }
        __syncthreads();
    }
}

__device__ __forceinline__ void pro_rope(const Fr& F, const Args& a) {
    float* ct = (float*)(a.ws + WS_ROPE); float* st = ct + SEQ * 32;
    for (int i = F.bid * NTHR + F.tid; i < SEQ * 32; i += F.G * NTHR) {
        const int pos = i >> 5, ax = (i >> 4) & 1, f = i & 15;
        const float inv = exp2f(-(float)f * (13.287712379549449f / 16.f));
        const float ang = (float)(ax == 0 ? (pos >> 6) : (pos & 63)) * inv;
        float sv, cv; sincos_acc(ang, sv, cv); ct[i] = cv; st[i] = sv;
    }
}

__device__ __forceinline__ void pro_filter(const Fr& F, const Args& a) {
    LAS float* L = (LAS float*)F.lds;
    constexpr int oW1 = 0, oB1 = 2112, oFR = 2176, oB2 = 2240, oW2 = 2304, oZ = 6400, oH1 = 7552, oH2 = 9600, H2P = 68, oT = 11776, TP = 36;
    bf16_t* FL = (bf16_t*)(a.ws + WS_FL); bf16_t* FC = (bf16_t*)(a.ws + WS_FC); float* NP = (float*)(a.ws + WS_NP);
    const int p = F.tid >> 4, jj = F.tid & 15;
    for (int unit = F.bid; unit < NL * 72; unit += F.G) {
        const int l = unit / 72, ch = unit % 72; const bool lat = ch < 64; const int n = lat ? SEQ : CTX, pos0 = lat ? ch * 32 : (ch - 64) * 32;
        __syncthreads();
        for (int i = F.tid; i < 2112; i += NTHR) L[oW1 + i] = a.in[I_HW1][l * 2112 + i];
        for (int i = F.tid; i < 64; i += NTHR) { L[oB1 + i] = a.in[I_HB1][l * 64 + i]; L[oFR + i] = a.in[I_HFR][l * 64 + i]; L[oB2 + i] = a.in[I_HB2][l * 64 + i]; }
        for (int i = F.tid; i < 4096; i += NTHR) L[oW2 + i] = a.in[I_HW2][l * 4096 + i];
        const int pos = pos0 + p; const float t = (float)pos / (float)(n - 1);
        { const float band = 1e-4f + (float)jj * ((15.f - 1e-4f) / 15.f); const float ang = ((6.2831855f * band) * (float)pos) / (float)n;
          float sv, cv; sincos_acc(ang, sv, cv); L[oZ + p * 36 + 1 + jj] = cv; L[oZ + p * 36 + 17 + jj] = -sv; if (jj == 0) L[oZ + p * 36] = t; }
        __syncthreads();
        { f32x4 acc = *(const LAS f32x4*)(L + oB1 + 4 * jj);
#pragma unroll 3
          for (int i = 0; i < 33; ++i) { const float z = L[oZ + p * 36 + i]; const f32x4 w = *(const LAS f32x4*)(L + oW1 + i * 64 + 4 * jj); acc.x = fmaf(z, w.x, acc.x); acc.y = fmaf(z, w.y, acc.y); acc.z = fmaf(z, w.z, acc.z); acc.w = fmaf(z, w.w, acc.w); }
          const f32x4 fr = *(const LAS f32x4*)(L + oFR + 4 * jj); float sv, cv; f32x4 o;
          sincos_acc(fr.x * acc.x, sv, cv); o.x = sv; sincos_acc(fr.y * acc.y, sv, cv); o.y = sv; sincos_acc(fr.z * acc.z, sv, cv); o.z = sv; sincos_acc(fr.w * acc.w, sv, cv); o.w = sv;
          *(LAS f32x4*)(L + oH1 + p * 64 + 4 * jj) = o; }
        __syncthreads();
        { f32x4 acc = *(const LAS f32x4*)(L + oB2 + 4 * jj);
#pragma unroll 4
          for (int i = 0; i < 64; ++i) { const float z = L[oH1 + p * 64 + i]; const f32x4 w = *(const LAS f32x4*)(L + oW2 + i * 64 + 4 * jj); acc.x = fmaf(z, w.x, acc.x); acc.y = fmaf(z, w.y, acc.y); acc.z = fmaf(z, w.z, acc.z); acc.w = fmaf(z, w.w, acc.w); }
          const f32x4 fr = *(const LAS f32x4*)(L + oFR + 4 * jj); float sv, cv; f32x4 o;
          sincos_acc(fr.x * acc.x, sv, cv); o.x = sv; sincos_acc(fr.y * acc.y, sv, cv); o.y = sv; sincos_acc(fr.z * acc.z, sv, cv); o.z = sv; sincos_acc(fr.w * acc.w, sv, cv); o.w = sv;
          *(LAS f32x4*)(L + oH2 + p * H2P + 4 * jj) = o; }
        LAS bf16_t* T = (LAS bf16_t*)(L + oT);
        __syncthreads();
        {
            const int j16 = F.lane & 15, kq = F.lane >> 4;
            const float* W3p = a.in[I_HW3] + ((size_t)l * 64 + 4 * kq) * 1024 + 128 * F.wave + 4 * j16;
            f32x4 acc[2][4][2];
#pragma unroll
            for (int h = 0; h < 2; ++h)
#pragma unroll
                for (int cb = 0; cb < 4; ++cb)
#pragma unroll
                    for (int rb = 0; rb < 2; ++rb) acc[h][cb][rb] = (f32x4){0.f, 0.f, 0.f, 0.f};
            f32x4 bw[2][4][2];
#define PF_LDW(buf, s) do { _Pragma("unroll") for (int j = 0; j < 4; ++j) _Pragma("unroll") for (int h = 0; h < 2; ++h) bw[buf][j][h] = *(const f32x4*)(W3p + (size_t)(16 * (s) + j) * 1024 + 64 * h); } while (0)
            PF_LDW(0, 0);
#pragma unroll
            for (int s = 0; s < 4; ++s) {
                if (s + 1 < 4) PF_LDW((s + 1) & 1, s + 1);
                f32x4 av[2];
#pragma unroll
                for (int rb = 0; rb < 2; ++rb) av[rb] = *(const LAS f32x4*)(L + oH2 + (rb * 16 + j16) * H2P + 16 * s + 4 * kq);
#pragma unroll
                for (int j = 0; j < 4; ++j)
#pragma unroll
                    for (int h = 0; h < 2; ++h)
#pragma unroll
                        for (int cb = 0; cb < 4; ++cb)
#pragma unroll
                            for (int rb = 0; rb < 2; ++rb) acc[h][cb][rb] = __builtin_amdgcn_mfma_f32_16x16x4f32(av[rb][j], bw[s & 1][j][h][cb], acc[h][cb][rb], 0, 0, 0);
            }
#undef PF_LDW
            const int dir = F.wave >> 2;
            float tt[2][4];
#pragma unroll
            for (int rb = 0; rb < 2; ++rb)
#pragma unroll
                for (int r = 0; r < 4; ++r) tt[rb][r] = (float)(pos0 + rb * 16 + 4 * kq + r) / (float)(n - 1);
#pragma unroll
            for (int h = 0; h < 2; ++h)
#pragma unroll
                for (int cb = 0; cb < 4; ++cb) { const int col = 128 * F.wave + 64 * h + 4 * j16 + cb, c = col & 511;
                    const float dl = fabsf(-3.0701134573253943f + (-15.350567286626972f + 3.0701134573253943f) * ((float)c / 511.f));
#pragma unroll
                    for (int rb = 0; rb < 2; ++rb) { const int p0 = rb * 16 + 4 * kq; float v[4];
#pragma unroll
                        for (int r = 0; r < 4; ++r) { v[r] = acc[h][cb][rb][r] * __expf(-tt[rb][r] * dl); if (dir == 1 && pos0 + p0 + r == 0) v[r] = 0.f; }
                        u32x2 w;
                        if (dir == 0) { w.x = cvtpk(v[3], v[2]); w.y = cvtpk(v[1], v[0]); *(LAS u32x2*)(T + col * TP + 28 - p0) = w; }
                        else { w.x = cvtpk(v[0], v[1]); w.y = cvtpk(v[2], v[3]); *(LAS u32x2*)(T + col * TP + p0) = w; } } }
        }
        __syncthreads();
        for (int idx = F.tid; idx < 1024 * 32; idx += NTHR) { const int col = idx >> 5, i = idx & 31, dir = col >> 9, c = col & 511;
            const int u = (dir == 0) ? (n - 32 - pos0 + i) : ((pos0 + i == 0) ? 2 * n - 1 : n - 1 + pos0 + i);
            bf16_t* Fb = lat ? FL + ((size_t)l * 512 + c) * 4096 : FC + ((size_t)l * 512 + c) * 512;
            Fb[u] = T[col * TP + i]; }
        for (int col = F.tid; col < 1024; col += NTHR) { float sum = 0.f;
#pragma unroll 8
            for (int i = 0; i < 32; ++i) sum += fabsf(bf1(T[col * TP + i]));
            NP[((size_t)l * 72 + ch) * 1024 + col] = sum; }
    }
    __syncthreads();
}
__device__ __forceinline__ void filter_norm_reduce(const Fr& F, const Args& a) {
    const float* NP = (const float*)(a.ws + WS_NP); float* FN = (float*)(a.ws + WS_FNORM);
    for (int o = F.bid * NTHR + F.tid; o < NL * 2 * 512; o += F.G * NTHR) { const int l = o >> 10, isc = (o >> 9) & 1, c = o & 511;
        const int ch0 = isc ? 64 : 0, ch1 = isc ? 72 : 64; float sum = 0.f;
        for (int ch = ch0; ch < ch1; ++ch) sum += NP[((size_t)l * 72 + ch) * 1024 + c] + NP[((size_t)l * 72 + ch) * 1024 + 512 + c];
        FN[o] = 1.f / sum; }
}

template <int MODE>
__device__ __forceinline__ void transpose_item(const float* W, int K, int N, bf16_t* WT, int row_off, LAS float* scr, int item, int lane, int ldk = 0) {
    if (ldk == 0) ldk = K;
    const int nblk = N / 64, kb = item / nblk, nb = item % nblk, k0 = 64 * kb, n0 = 64 * nb;
    f32x4 v[16];
#pragma unroll
    for (int i = 0; i < 16; ++i) v[i] = *(const f32x4*)(W + (size_t)(k0 + 4 * i + (lane >> 4)) * N + n0 + (lane & 15) * 4);
#pragma unroll
    for (int i = 0; i < 16; ++i) *(LAS f32x4*)(scr + (4 * i + (lane >> 4)) * 68 + (lane & 15) * 4) = v[i];
    LDS_WAIT();
    const int c = lane & 7;
#pragma unroll
    for (int j = 0; j < 8; ++j) { const int n = (lane >> 3) + 8 * j; const LAS float* s = scr + (8 * c) * 68 + n;
        u32x4 o; o.x = cvtpk(s[0 * 68], s[1 * 68]); o.y = cvtpk(s[2 * 68], s[3 * 68]); o.z = cvtpk(s[4 * 68], s[5 * 68]); o.w = cvtpk(s[6 * 68], s[7 * 68]);
        const int nn = n0 + n; const int row = (MODE == 0) ? nn : ((nn >> 2) * 8 + (nn & 3) + (MODE == 2 ? 4 : 0));
        *(u32x4*)(WT + (size_t)(row_off + row) * ldk + k0 + 8 * c) = o; }
    LDS_WAIT();
}

template <int MODE>
__device__ __forceinline__ void transpose_item_f8(const float* W, int K, int N, unsigned char* WT, int row_off, LAS float* scr, int item, int lane, int ldk = 0) {
    if (ldk == 0) ldk = K;
    const int nblk = N / 64, kb = item / nblk, nb = item % nblk, k0 = 64 * kb, n0 = 64 * nb;
    f32x4 v[16];
#pragma unroll
    for (int i = 0; i < 16; ++i) v[i] = *(const f32x4*)(W + (size_t)(k0 + 4 * i + (lane >> 4)) * N + n0 + (lane & 15) * 4);
#pragma unroll
    for (int i = 0; i < 16; ++i) *(LAS f32x4*)(scr + (4 * i + (lane >> 4)) * 68 + (lane & 15) * 4) = v[i];
    LDS_WAIT();
    const int c = lane & 7;
#pragma unroll
    for (int j = 0; j < 8; ++j) { const int n = (lane >> 3) + 8 * j; const LAS float* s = scr + (8 * c) * 68 + n;
        u32x2 o; o.x = cvt4_fp8(s[0 * 68] * 64.f, s[1 * 68] * 64.f, s[2 * 68] * 64.f, s[3 * 68] * 64.f); o.y = cvt4_fp8(s[4 * 68] * 64.f, s[5 * 68] * 64.f, s[6 * 68] * 64.f, s[7 * 68] * 64.f);
        const int nn = n0 + n; const int row = (MODE == 0) ? nn : ((nn >> 2) * 8 + (nn & 3) + (MODE == 2 ? 4 : 0));
        *(u32x2*)(WT + (size_t)(row_off + row) * ldk + k0 + 8 * c) = o; }
    LDS_WAIT();
}
__device__ __forceinline__ void conv_small_weights(const Fr& F, const Args& a, int l, int mask, int b0) {
    if (F.bid < b0) return;
    LAS float* scr = (LAS float*)(F.lds + F.wave * 17408);
    const int gw = (F.bid - b0) * NWAVES + F.wave, NGW = (F.G - b0) * NWAVES;
    constexpr int I_IN = (1024 / 64) * (DIN / 64), I_BR = (512 / 64) * (1024 / 64), I_OUT = (1024 / 64) * (1024 / 64);
    if (mask & 1) for (int it = gw; it < I_IN; it += NGW) transpose_item_f8<0>(a.in[I_WIN] + (size_t)l * 1024 * DIN, 1024, DIN, a.ws + WS_WG8, 0, scr, it, F.lane);
    if (mask & 2) for (int it = gw; it < 3 * I_BR; it += NGW) { const int b = it / I_BR; transpose_item_f8<0>(a.in[I_WBR] + ((size_t)l * 3 + b) * 512 * 1024, 512, 1024, a.ws + WS_WBR + b * 512, 0, scr, it % I_BR, F.lane, 1536); }
    if (mask & 4) for (int it = gw; it < I_OUT; it += NGW) transpose_item_f8<0>(a.in[I_WOUT] + (size_t)l * 1024 * 1024, 1024, 1024, a.ws + WS_WOUT, 0, scr, it, F.lane);
}
__device__ __forceinline__ void conv_expert_weights(const Fr& F, const Args& a, int l, int b0, int it0, int it1) {
    if (F.bid < b0) return;
    LAS float* scr = (LAS float*)(F.lds + F.wave * 17408);
    const int gw = (F.bid - b0) * NWAVES + F.wave, NGW = (F.G - b0) * NWAVES;
    constexpr int I_1 = (1024 / 64) * (512 / 64), I_2 = (512 / 64) * (1024 / 64);
    for (int it = it0 + gw; it < it1; it += NGW) {
        const int e = it / (2 * I_1 + I_2); int r = it % (2 * I_1 + I_2);
        unsigned char* W13 = a.ws + WS_W13; unsigned char* W2 = a.ws + WS_W2;
        if (r < I_1) { transpose_item_f8<1>(a.in[I_EW1] + ((size_t)l * NE + e) * 1024 * 512, 1024, 512, W13, e * 1024, scr, r, F.lane); continue; } r -= I_1;
        if (r < I_1) { transpose_item_f8<2>(a.in[I_EW3] + ((size_t)l * NE + e) * 1024 * 512, 1024, 512, W13, e * 1024, scr, r, F.lane); continue; } r -= I_1;
        transpose_item_f8<0>(a.in[I_EW2] + ((size_t)l * NE + e) * 512 * 1024, 512, 1024, W2, e * 1024, scr, r, F.lane);
    }
}
constexpr int CONV_E_ITEMS = NE * 384, CONV_E_SPLIT = CONV_E_ITEMS / 2;

__device__ __forceinline__ int mod_row(int row) { return row < TL ? (row >> 11) : NB; }

__device__ __forceinline__ void rows_p0(const Fr& F, const Args& a, int l, int nrows) {
    const int gw = F.bid * NWAVES + F.wave, NGW = F.G * NWAVES;
    const float* g1 = a.in[I_N1G] + l * 1024;
    const float* MODl = (const float*)(a.ws + WS_MOD) + (size_t)l * NBM * DIN;
    const float* MODp = (const float*)(a.ws + WS_MOD) + (size_t)(l > 0 ? l - 1 : 0) * NBM * DIN;
    const bf16_t* Fs = (const bf16_t*)(a.ws + WS_F);
    unsigned char* H8 = a.ws + WS_H8;
    const int per = 2 * ((nrows + 2 * NGW - 1) / (2 * NGW)), w0 = gw * per, w1 = (w0 + per < nrows) ? w0 + per : nrows;
    f32x4 gv[4], shv[4], scv[4], m5v[4]; int cur = -1;
#pragma unroll
    for (int j = 0; j < 4; ++j) { gv[j] = *(const f32x4*)(g1 + F.lane * 4 + 256 * j); shv[j] = gv[j]; scv[j] = gv[j]; m5v[j] = gv[j]; }
#define P0_LOAD(rb, V, F0, F1) do { _Pragma("unroll") for (int q = 0; q < 2; ++q) { const int row = (rb) + q; const bool lat = row < TL; \
            const float* xs = lat ? ((l == 0) ? a.in[I_X] + (size_t)row * D : a.out + (size_t)row * D) : ((l == 0) ? a.in[I_CTX] + (size_t)(row - TL) * D : (const float*)(a.ws + WS_XC) + (size_t)(row - TL) * D); \
            _Pragma("unroll") for (int j = 0; j < 4; ++j) { const int col = F.lane * 4 + 256 * j; V[q][j] = *(const f32x4*)(xs + col); \
                if (l > 0) { F0[q][j] = *(const u32x2*)(Fs + (size_t)row * D + col); F1[q][j] = *(const u32x2*)(Fs + ((size_t)TT + row) * D + col); } } } } while (0)
#define P0_PROC(rb, V, F0, F1) do { _Pragma("unroll") for (int q = 0; q < 2; ++q) { const int row = (rb) + q; const bool lat = row < TL; const int mr = mod_row(row); \
            if (mr != cur) { cur = mr; _Pragma("unroll") for (int j = 0; j < 4; ++j) { const int col = F.lane * 4 + 256 * j; \
                shv[j] = *(const f32x4*)(MODl + (size_t)mr * DIN + col); scv[j] = *(const f32x4*)(MODl + (size_t)mr * DIN + 1024 + col); m5v[j] = *(const f32x4*)(MODp + (size_t)mr * DIN + 5 * 1024 + col); } } \
            float* xd = lat ? a.out + (size_t)row * D : (float*)(a.ws + WS_XC) + (size_t)(row - TL) * D; float ss = 0.f; \
            if (l > 0) { _Pragma("unroll") for (int j = 0; j < 4; ++j) { const int col = F.lane * 4 + 256 * j; \
                    V[q][j].x += m5v[j].x * (bflo(F0[q][j].x) + bflo(F1[q][j].x)); V[q][j].y += m5v[j].y * (bfhi(F0[q][j].x) + bfhi(F1[q][j].x)); \
                    V[q][j].z += m5v[j].z * (bflo(F0[q][j].y) + bflo(F1[q][j].y)); V[q][j].w += m5v[j].w * (bfhi(F0[q][j].y) + bfhi(F1[q][j].y)); \
                    *(f32x4*)(xd + col) = V[q][j]; } } \
            _Pragma("unroll") for (int j = 0; j < 4; ++j) ss += (V[q][j].x * V[q][j].x + V[q][j].y * V[q][j].y) + (V[q][j].z * V[q][j].z + V[q][j].w * V[q][j].w); \
            const float r = 1.f / sqrtf(wave_sum(ss) * (1.f / D) + EPS); \
            _Pragma("unroll") for (int j = 0; j < 4; ++j) { const int col = F.lane * 4 + 256 * j; \
                const f32x4 o = (V[q][j] * r * gv[j]) * (scv[j] + 1.f) + shv[j]; \
                *(unsigned*)(H8 + (size_t)row * D + col) = cvt4_fp8(o.x, o.y, o.z, o.w); } } } while (0)
    f32x4 vA[2][4], vB[2][4]; u32x2 fA0[2][4], fA1[2][4], fB0[2][4], fB1[2][4];
    if (w0 < w1) P0_LOAD(w0, vA, fA0, fA1);
    for (int rb = w0; rb < w1; rb += 4) {
        if (rb + 2 < w1) P0_LOAD(rb + 2, vB, fB0, fB1);
        P0_PROC(rb, vA, fA0, fA1);
        if (rb + 2 < w1) { if (rb + 4 < w1) P0_LOAD(rb + 4, vA, fA0, fA1); P0_PROC(rb + 2, vB, fB0, fB1); }
    }
#undef P0_LOAD
#undef P0_PROC
}
__device__ __forceinline__ void rows_final(const Fr& F, const Args& a) {
    const int gw = F.bid * NWAVES + F.wave, NGW = F.G * NWAVES;
    const float* MODp = (const float*)(a.ws + WS_MOD) + (size_t)(NL - 1) * NBM * DIN;
    const bf16_t* Fs = (const bf16_t*)(a.ws + WS_F);
    for (int row = gw; row < TL; row += NGW) {
        const int mr = row >> 11; float* xd = a.out + (size_t)row * D;
#pragma unroll
        for (int j = 0; j < 4; ++j) { const int col = F.lane * 4 + 256 * j;
            f32x4 v = *(const f32x4*)(xd + col);
            const u32x2 f0 = *(const u32x2*)(Fs + (size_t)row * D + col), f1 = *(const u32x2*)(Fs + ((size_t)TT + row) * D + col);
            const f32x4 m5 = *(const f32x4*)(MODp + (size_t)mr * DIN + 5 * 1024 + col);
            v.x += m5.x * (bflo(f0.x) + bflo(f1.x)); v.y += m5.y * (bfhi(f0.x) + bfhi(f1.x)); v.z += m5.z * (bflo(f0.y) + bflo(f1.y)); v.w += m5.w * (bfhi(f0.y) + bfhi(f1.y));
            *(f32x4*)(xd + col) = v; }
    }
}

__device__ __forceinline__ void rows_p5(const Fr& F, const Args& a, int l, int nrows, unsigned long long& sacc, const int swhich) {
#if defined(PROBE_P)
    unsigned long long st0 = __builtin_amdgcn_s_memrealtime();
#define SUBMARK5(w) do { const unsigned long long t_ = __builtin_amdgcn_s_memrealtime(); if (swhich == (w)) sacc += t_ - st0; st0 = t_; } while (0)
#else
#define SUBMARK5(w) do { } while (0)
#endif
    typedef float f32x4v __attribute__((ext_vector_type(4)));
    LAS float* RW = (LAS float*)F.lds;
    constexpr int RWS = 1028;
    LAS float* RB = (LAS float*)(F.lds + 82304);
    LAS int* LC = (LAS int*)(F.lds + 82432);
    LAS int* TE = (LAS int*)(F.lds + 82560);
    LAS int* TP = TE + 256;
    LAS float* TW = (LAS float*)(TP + 256);
    LAS float* RN = (LAS float*)(F.lds + 86784);
    LAS float* LG = (LAS float*)(F.lds + 87424);
    LAS float* GM = (LAS float*)(F.lds + 99072);
    LAS float* BI = (LAS float*)(F.lds + 107264);
    const float* g2 = a.in[I_N2G] + l * 1024;
    const float* MODl = (const float*)(a.ws + WS_MOD) + (size_t)l * NBM * DIN;
    unsigned char* H8 = a.ws + WS_H;
    int* EROW = (int*)(a.ws + WS_EROW); float* EROWW = (float*)(a.ws + WS_EROWW);
    unsigned* CNT = (unsigned*)(a.ws + WS_CTL) + CW_CNT + l * 256;
    for (int f = F.tid; f < 1024; f += NTHR) { const f32x4 v = *(const f32x4*)(a.in[I_RGW] + ((size_t)l * 1024 + f) * 4);
        RW[0 * RWS + f] = v.x; RW[1 * RWS + f] = v.y; RW[2 * RWS + f] = v.z; RW[3 * RWS + f] = v.w; }
    for (int f = F.tid; f < 4096; f += NTHR) { const int k = f >> 2, c4 = (f & 3) * 4; const f32x4 v = *(const f32x4*)(a.in[I_REW] + ((size_t)l * 1024 + k) * 16 + c4);
        RW[(4 + c4) * RWS + k] = v.x; RW[(5 + c4) * RWS + k] = v.y; RW[(6 + c4) * RWS + k] = v.z; RW[(7 + c4) * RWS + k] = v.w; }
    if (F.tid < 20) RB[F.tid] = (F.tid < 4) ? a.in[I_RGB][l * 4 + F.tid] : a.in[I_REB][l * 16 + F.tid - 4];
    constexpr int P5_CH = 144;
    const int nch = (nrows + P5_CH - 1) / P5_CH;
    SUBMARK5(40);
    for (int ch = F.bid; ch < nch; ch += F.G) {
    const int r0 = ch * P5_CH, r1 = (r0 + P5_CH < nrows) ? r0 + P5_CH : nrows;
    const int mb0 = mod_row(r0), mb1 = mod_row(r1 - 1);
    if (F.tid < 32) LC[F.tid] = 0;
    for (int i = F.tid; i < 2048; i += NTHR) { const int s = i >> 10, k = i & 1023; GM[i] = g2[k] * (1.f + MODl[(size_t)(s ? mb1 : mb0) * DIN + 4 * 1024 + k]); }
    __syncthreads();
    if (F.wave < 4) {
    for (int rowb = r0 + 2 * F.wave; rowb < r1; rowb += 2 * 4) {
        f32x4 v[2][4]; bool val[2];
#pragma unroll
        for (int q = 0; q < 2; ++q) { const int row = rowb + q; val[q] = row < r1; const int rr = val[q] ? row : rowb;
            const bool lat = rr < TL; const float* xs = lat ? a.out + (size_t)rr * D : (const float*)(a.ws + WS_XC) + (size_t)(rr - TL) * D;
#pragma unroll
            for (int j = 0; j < 4; ++j) v[q][j] = *(const f32x4*)(xs + F.lane * 4 + 256 * j); }
#pragma unroll
        for (int q = 0; q < 2; ++q) { const int rr = val[q] ? rowb + q : rowb; const int mr = mod_row(rr); float ss = 0.f;
#pragma unroll
            for (int j = 0; j < 4; ++j) ss += (v[q][j].x * v[q][j].x + v[q][j].y * v[q][j].y) + (v[q][j].z * v[q][j].z + v[q][j].w * v[q][j].w);
            const float r = 1.f / sqrtf(wave_sum(ss) * (1.f / D) + EPS);
            if (F.lane == 0 && val[q]) RN[rr - r0] = r;
#pragma unroll
            for (int j = 0; j < 4; ++j) { const int col = F.lane * 4 + 256 * j;
                const f32x4 g = *(const f32x4*)(g2 + col), sh = *(const f32x4*)(MODl + (size_t)mr * DIN + 3 * 1024 + col), sc = *(const f32x4*)(MODl + (size_t)mr * DIN + 4 * 1024 + col);
                const f32x4 t = (v[q][j] * r * g) * (sc + 1.f) + sh;
                if (val[q]) *(unsigned*)(H8 + (size_t)rr * D + col) = cvt4_fp8(t.x, t.y, t.z, t.w); } }
    }
    } else {
    if (F.wave < 6) { const int sl = F.wave - 4; const int mb = sl ? mb1 : mb0; f32x4 sh[4];
#pragma unroll
        for (int j = 0; j < 4; ++j) sh[j] = *(const f32x4*)(MODl + (size_t)mb * DIN + 3 * 1024 + F.lane * 4 + 256 * j);
#pragma unroll 4
        for (int cidx = 0; cidx < 20; ++cidx) { float p = 0.f;
#pragma unroll
            for (int j = 0; j < 4; ++j) { const f32x4 w = *(const LAS f32x4*)(RW + cidx * RWS + F.lane * 4 + 256 * j);
                p = fmaf(sh[j].x, w.x, p); p = fmaf(sh[j].y, w.y, p); p = fmaf(sh[j].z, w.z, p); p = fmaf(sh[j].w, w.w, p); }
            const float tot = wave_sum(p) + RB[cidx]; if (F.lane == 0) BI[sl * 20 + cidx] = tot; } }
    { const int i16 = F.lane & 15, kq = F.lane >> 4; const int ngrp = (r1 - r0 + 15) >> 4;
      for (int gi = F.wave - 4; gi < ngrp; gi += 4) {
        const int grow = r0 + 16 * gi; const int rowi = (grow + i16 < r1) ? grow + i16 : r1 - 1;
        const bool lat = rowi < TL; const float* xs = (lat ? a.out + (size_t)rowi * D : (const float*)(a.ws + WS_XC) + (size_t)(rowi - TL) * D) + 4 * kq;
        const int slot = (mod_row(grow) == mb0) ? 0 : 1;
        const LAS float* gmp = GM + slot * 1024 + 4 * kq; const LAS float* w0p = RW + i16 * RWS + 4 * kq; const LAS float* w1p = RW + (16 + (i16 & 3)) * RWS + 4 * kq;
        const float m1 = (i16 < 4) ? 1.f : 0.f;
        f32x4v acc0 = {0.f, 0.f, 0.f, 0.f}, acc1 = {0.f, 0.f, 0.f, 0.f};
#pragma unroll 16
        for (int s = 0; s < 64; ++s) {
            const f32x4 xv = *(const f32x4*)(xs + 16 * s); const f32x4 gv = *(const LAS f32x4*)(gmp + 16 * s);
            const f32x4 wa = *(const LAS f32x4*)(w0p + 16 * s), wb = *(const LAS f32x4*)(w1p + 16 * s);
            const f32x4 ba = wa * gv, bb = wb * gv * m1;
            acc0 = __builtin_amdgcn_mfma_f32_16x16x4f32(xv.x, ba.x, acc0, 0, 0, 0); acc1 = __builtin_amdgcn_mfma_f32_16x16x4f32(xv.x, bb.x, acc1, 0, 0, 0);
            acc0 = __builtin_amdgcn_mfma_f32_16x16x4f32(xv.y, ba.y, acc0, 0, 0, 0); acc1 = __builtin_amdgcn_mfma_f32_16x16x4f32(xv.y, bb.y, acc1, 0, 0, 0);
            acc0 = __builtin_amdgcn_mfma_f32_16x16x4f32(xv.z, ba.z, acc0, 0, 0, 0); acc1 = __builtin_amdgcn_mfma_f32_16x16x4f32(xv.z, bb.z, acc1, 0, 0, 0);
            acc0 = __builtin_amdgcn_mfma_f32_16x16x4f32(xv.w, ba.w, acc0, 0, 0, 0); acc1 = __builtin_amdgcn_mfma_f32_16x16x4f32(xv.w, bb.w, acc1, 0, 0, 0);
        }
#pragma unroll
        for (int rg = 0; rg < 4; ++rg) { const int lr = 16 * gi + 4 * kq + rg;
            if (r0 + lr < r1) { LG[lr * 20 + i16] = acc0[rg]; if (i16 < 4) LG[lr * 20 + 16 + i16] = acc1[rg]; } }
      } }
    }
    __syncthreads();
    SUBMARK5(42);
    for (int lr = F.tid; lr < r1 - r0; lr += NTHR) {
        float lg[20]; { const float rn = RN[lr]; const int sl = (mod_row(r0 + lr) == mb0) ? 0 : 1;
#pragma unroll
          for (int i = 0; i < 20; ++i) lg[i] = rn * LG[lr * 20 + i] + BI[sl * 20 + i]; }
        int gs = 0; float gmx = lg[0];
#pragma unroll
        for (int i = 1; i < 4; ++i) if (lg[i] > gmx) { gmx = lg[i]; gs = i; }
        float gsum = 0.f;
#pragma unroll
        for (int i = 0; i < 4; ++i) gsum += __expf(lg[i] - gmx);
        const float pg = 1.f / gsum;
        float le[4];
#pragma unroll
        for (int i = 0; i < 4; ++i) le[i] = (gs == 0) ? lg[4 + i] : (gs == 1) ? lg[8 + i] : (gs == 2) ? lg[12 + i] : lg[16 + i];
        int i0 = 0; float v0 = le[0];
#pragma unroll
        for (int i = 1; i < 4; ++i) if (le[i] > v0) { v0 = le[i]; i0 = i; }
        int i1 = -1; float v1 = -3.4e38f;
#pragma unroll
        for (int i = 0; i < 4; ++i) if (i != i0 && le[i] > v1) { v1 = le[i]; i1 = i; }
        const float e1 = __expf(v1 - v0), den = 1.f / (1.f + e1);
        const int ex0 = gs * 4 + i0, ex1 = gs * 4 + i1;
        const int lp0 = __hip_atomic_fetch_add(&LC[ex0], 1, __ATOMIC_RELAXED, __HIP_MEMORY_SCOPE_WORKGROUP), lp1 = __hip_atomic_fetch_add(&LC[ex1], 1, __ATOMIC_RELAXED, __HIP_MEMORY_SCOPE_WORKGROUP);
        TE[lr] = ex0 | (ex1 << 8); TP[lr] = lp0 | (lp1 << 16); TW[2 * lr] = den * pg; TW[2 * lr + 1] = e1 * den * pg;
    }
    __syncthreads();
    if (F.tid < NE) LC[16 + F.tid] = (int)atomicAdd(&CNT[F.tid * 16], (unsigned)LC[F.tid]);
    __syncthreads();
    for (int lr = F.tid; lr < r1 - r0; lr += NTHR) {
        const int te = TE[lr], tp = TP[lr], ex0 = te & 255, ex1 = te >> 8, row = r0 + lr;
        const int gp0 = LC[16 + ex0] + (tp & 0xffff), gp1 = LC[16 + ex1] + (tp >> 16);
        EROW[(size_t)ex0 * TT + gp0] = row * 2; EROWW[(size_t)ex0 * TT + gp0] = TW[2 * lr];
        EROW[(size_t)ex1 * TT + gp1] = row * 2 + 1; EROWW[(size_t)ex1 * TT + gp1] = TW[2 * lr + 1];
    }
    __syncthreads();
    SUBMARK5(43);
    }
    __syncthreads();
#undef SUBMARK5
}

__device__ __forceinline__ void normrope8(float (&x)[8], const float* g64, bool rope, int pos, const float* ct, const float* st, float scale, int lane) {
    float ss = 0.f;
#pragma unroll
    for (int i = 0; i < 8; ++i) ss += x[i] * x[i];
    ss += DPP_F(ss, 0xB1); ss += DPP_F(ss, 0x4E); ss += DPP_F(ss, 0x141);
    const float r = 1.f / sqrtf(ss * (1.f / 64.f) + EPS);
    const int ch = lane & 7;
    const f32x4 g0 = *(const f32x4*)(g64 + 8 * ch), g1 = *(const f32x4*)(g64 + 8 * ch + 4);
    x[0] *= r * g0.x; x[1] *= r * g0.y; x[2] *= r * g0.z; x[3] *= r * g0.w; x[4] *= r * g1.x; x[5] *= r * g1.y; x[6] *= r * g1.z; x[7] *= r * g1.w;
    if (rope) {
        const int ax = ch >> 2, half = (ch >> 1) & 1, f0 = 8 * (ch & 1);
        const f32x4 c0 = *(const f32x4*)(ct + pos * 32 + ax * 16 + f0), c1 = *(const f32x4*)(ct + pos * 32 + ax * 16 + f0 + 4);
        const f32x4 s0 = *(const f32x4*)(st + pos * 32 + ax * 16 + f0), s1 = *(const f32x4*)(st + pos * 32 + ax * 16 + f0 + 4);
        const float cs[8] = {c0.x, c0.y, c0.z, c0.w, c1.x, c1.y, c1.z, c1.w}, sn[8] = {s0.x, s0.y, s0.z, s0.w, s1.x, s1.y, s1.z, s1.w};
#pragma unroll
        for (int i = 0; i < 8; ++i) { const float p = DPP_F(x[i], 0x4E);
            x[i] = half ? (x[i] * cs[i] + p * sn[i]) : (x[i] * cs[i] - p * sn[i]); }
    }
#pragma unroll
    for (int i = 0; i < 8; ++i) x[i] *= scale;
}
__device__ __forceinline__ void unpack8(const u32x4 w, float (&x)[8]) { x[0] = bflo(w.x); x[1] = bfhi(w.x); x[2] = bflo(w.y); x[3] = bfhi(w.y); x[4] = bflo(w.z); x[5] = bfhi(w.z); x[6] = bflo(w.w); x[7] = bfhi(w.w); }
__device__ __forceinline__ u32x4 pack8(const float (&x)[8]) { u32x4 w; w.x = cvtpk(x[0], x[1]); w.y = cvtpk(x[2], x[3]); w.z = cvtpk(x[4], x[5]); w.w = cvtpk(x[6], x[7]); return w; }

__device__ __forceinline__ void prep_phase(const Fr& F, const Args& a, int l, bool with_ctx) {
    constexpr int VROW = 272;
    LAS unsigned char* VA_l = F.lds;
    LAS unsigned char* VW_l = F.lds + 17408;
    LAS unsigned char* HT_l = F.lds + 34816;
    constexpr int HROW = 144;
    const float* ct = (const float*)(a.ws + WS_ROPE); const float* st = ct + SEQ * 32;
    const float* qkg = a.in[I_QKG] + l * 256;
    const bf16_t* RAWA = (const bf16_t*)(a.ws + WS_RAWA); const bf16_t* RAWW = (const bf16_t*)(a.ws + WS_RAWW);
    bf16_t* KA = (bf16_t*)(a.ws + WS_KA); bf16_t* KW = (bf16_t*)(a.ws + WS_KW); bf16_t* VTA = (bf16_t*)(a.ws + WS_VTA); bf16_t* VTW = (bf16_t*)(a.ws + WS_VTW);
    const bf16_t* U = (const bf16_t*)(a.ws + WS_U); bf16_t* X0 = (bf16_t*)(a.ws + WS_H); bf16_t* VT = (bf16_t*)(a.ws + WS_VT);
    const float* hsw = a.in[I_HSW] + l * 3 * 1536; const float* hsb = a.in[I_HSB] + l * 1536;
    for (int unit = F.bid; unit < NB * 36; unit += F.G) {
        const bool lat = unit < NB * 32;
        const int b = lat ? unit >> 5 : (unit - NB * 32) >> 2, p0 = lat ? (unit & 31) * 64 : ((unit - NB * 32) & 3) * 64;
        const int n = lat ? SEQ : CTX;
        const int row0 = lat ? b * SEQ + p0 : TL + b * CTX + p0;
        const int j0 = lat ? CTX + p0 : p0;
        __syncthreads();
        {
            const bool isw = (F.lane & 16) != 0; const int l16 = F.lane & 15, half = F.lane >> 5;
            u32x4 kw[4];
#pragma unroll
            for (int ps = 0; ps < 4; ++ps) { const int tk = 8 * F.wave + 2 * ps + half; kw[ps] = *(const u32x4*)((isw ? RAWW : RAWA) + (size_t)(row0 + tk) * 256 + l16 * 8); }
#pragma unroll
            for (int ps = 0; ps < 4; ++ps) { const int tk = 8 * F.wave + 2 * ps + half; float x[8]; unpack8(kw[ps], x);
                normrope8(x, qkg + (isw ? 192 : 64), lat, p0 + tk, ct, st, 1.f, F.lane);
                *(u32x4*)((isw ? KW : KA) + ((size_t)b * KEYS + j0 + tk) * 128 + l16 * 8) = pack8(x); }
        }
        for (int i = F.tid; i < 2 * 64 * 16; i += NTHR) { const int m = i >> 10, r = (i >> 4) & 63, cch = i & 15;
            const u32x4 w = *(const u32x4*)((m ? RAWW : RAWA) + (size_t)(row0 + r) * 256 + 128 + cch * 8);
            *(LAS u32x4*)((m ? VW_l : VA_l) + r * VROW + cch * 16) = w; }
        const bool do_hy = lat || with_ctx;
        if (do_hy) {
            const int cg = F.tid & 63, c = 8 * cg, t0 = 8 * F.wave;
            u32x4 x1p[8];
#pragma unroll
            for (int g = 0; g < 3; ++g) {
                const int ch = g * 512 + c;
                float w0[8], w1[8], w2[8], bb[8];
                { const f32x4 a0 = *(const f32x4*)(hsw + ch), a1 = *(const f32x4*)(hsw + ch + 4), b0 = *(const f32x4*)(hsw + 1536 + ch), b1 = *(const f32x4*)(hsw + 1536 + ch + 4),
                              c0 = *(const f32x4*)(hsw + 3072 + ch), c1 = *(const f32x4*)(hsw + 3072 + ch + 4), d0 = *(const f32x4*)(hsb + ch), d1 = *(const f32x4*)(hsb + ch + 4);
                  w0[0] = a0.x; w0[1] = a0.y; w0[2] = a0.z; w0[3] = a0.w; w0[4] = a1.x; w0[5] = a1.y; w0[6] = a1.z; w0[7] = a1.w;
                  w1[0] = b0.x; w1[1] = b0.y; w1[2] = b0.z; w1[3] = b0.w; w1[4] = b1.x; w1[5] = b1.y; w1[6] = b1.z; w1[7] = b1.w;
                  w2[0] = c0.x; w2[1] = c0.y; w2[2] = c0.z; w2[3] = c0.w; w2[4] = c1.x; w2[5] = c1.y; w2[6] = c1.z; w2[7] = c1.w;
                  bb[0] = d0.x; bb[1] = d0.y; bb[2] = d0.z; bb[3] = d0.w; bb[4] = d1.x; bb[5] = d1.y; bb[6] = d1.z; bb[7] = d1.w; }
                u32x4 raw[10];
#pragma unroll
                for (int i = 0; i < 10; ++i) { const int pos = p0 + t0 - 1 + i;
                    if (pos < 0 || pos >= n) { const unsigned z = zero_u32(); raw[i] = (u32x4){z, z, z, z}; } else raw[i] = *(const u32x4*)(U + (size_t)(row0 - p0 + pos) * 1536 + ch); }
#pragma unroll
                for (int t = 0; t < 8; ++t) { float up[8], uc[8], un[8], o[8]; unpack8(raw[t], up); unpack8(raw[t + 1], uc); unpack8(raw[t + 2], un);
#pragma unroll
                    for (int i = 0; i < 8; ++i) o[i] = fmaf(w0[i], up[i], fmaf(w1[i], uc[i], fmaf(w2[i], un[i], bb[i])));
                    if (g == 0) *(u32x4*)(X0 + (size_t)(row0 + t0 + t) * 512 + c) = pack8(o);
                    else if (g == 1) x1p[t] = pack8(o);
                    else { float x1[8]; unpack8(x1p[t], x1);
#pragma unroll
                        for (int i = 0; i < 8; ++i) o[i] *= x1[i];
                        x1p[t] = pack8(o); } }
            }
#pragma unroll
            for (int i = 0; i < 8; ++i) { unsigned short ev[8];
#pragma unroll
                for (int t = 0; t < 8; ++t) { const unsigned wsel = (i >> 1) == 0 ? x1p[t].x : (i >> 1) == 1 ? x1p[t].y : (i >> 1) == 2 ? x1p[t].z : x1p[t].w; ev[t] = (unsigned short)((i & 1) ? (wsel >> 16) : (wsel & 0xffffu)); }
                u32x4 w; w.x = ev[0] | ((unsigned)ev[1] << 16); w.y = ev[2] | ((unsigned)ev[3] << 16); w.z = ev[4] | ((unsigned)ev[5] << 16); w.w = ev[6] | ((unsigned)ev[7] << 16);
                *(LAS u32x4*)(HT_l + (c + i) * HROW + t0 * 2) = w; }
        }
        __syncthreads();
        for (int i = F.tid; i < 2 * 128 * 8; i += NTHR) { const int m = i >> 10, rr = (i >> 3) & 127, c8 = i & 7;
            LAS unsigned char* T = m ? VW_l : VA_l; unsigned short e[8];
#pragma unroll
            for (int jj = 0; jj < 8; ++jj) { const int key = 16 * (c8 >> 1) + 8 * (jj >> 2) + 4 * (c8 & 1) + (jj & 3); e[jj] = *(const LAS bf16_t*)(T + key * VROW + rr * 2); }
            u32x4 w; w.x = e[0] | ((unsigned)e[1] << 16); w.y = e[2] | ((unsigned)e[3] << 16); w.z = e[4] | ((unsigned)e[5] << 16); w.w = e[6] | ((unsigned)e[7] << 16);
            *(u32x4*)((m ? VTW : VTA) + ((size_t)(b * 2 + (rr >> 6)) * 64 + (rr & 63)) * KEYS + j0 + c8 * 8) = w; }
        if (do_hy) { bf16_t* VTb = lat ? VT : VT + VT_CTX_OFF;
          for (int i = F.tid; i < 512 * 8; i += NTHR) { const int cch = i >> 3, c8 = i & 7;
              const u32x4 w = *(const LAS u32x4*)(HT_l + cch * HROW + c8 * 16);
              *(u32x4*)(VTb + ((size_t)cch * NB + b) * n + p0 + c8 * 8) = w; } }
    }
    __syncthreads();
}

__device__ __forceinline__ void hyena_final_phase(const Fr& F, const Args& a, int l, bool with_ctx) {
    constexpr int HROW = 144;
    LAS unsigned char* T = F.lds;
    const bf16_t* X0 = (const bf16_t*)(a.ws + WS_H); const bf16_t* VT = (const bf16_t*)(a.ws + WS_VT); const bf16_t* YT = (const bf16_t*)(a.ws + WS_YT);
    unsigned char* YH = a.ws + WS_Y8 + 512;
    const float* FN = (const float*)(a.ws + WS_FNORM) + l * 1024; const float* skip = a.in[I_HBIAS] + l * 512;
    const int nunits = with_ctx ? NB * 36 : NB * 32;
    for (int unit = F.bid; unit < nunits; unit += F.G) {
        const bool lat = unit < NB * 32;
        const int b = lat ? unit >> 5 : (unit - NB * 32) >> 2, p0 = lat ? (unit & 31) * 64 : ((unit - NB * 32) & 3) * 64;
        const int n = lat ? SEQ : CTX; const int row0 = lat ? b * SEQ + p0 : TL + b * CTX + p0;
        const bf16_t* Yb = lat ? YT : YT + VT_CTX_OFF; const bf16_t* Vb = lat ? VT : VT + VT_CTX_OFF; const float* inv = FN + (lat ? 0 : 512);
        __syncthreads();
        for (int i = F.tid; i < 512 * 8; i += NTHR) { const int cch = i >> 3, c8 = i & 7; const size_t off = ((size_t)cch * NB + b) * n + p0 + c8 * 8;
            const u32x4 y = *(const u32x4*)(Yb + off), v = *(const u32x4*)(Vb + off); const float s = inv[cch], k = skip[cch];
            u32x4 o;
            o.x = cvtpk(bflo(y.x) * s + k * bflo(v.x), bfhi(y.x) * s + k * bfhi(v.x)); o.y = cvtpk(bflo(y.y) * s + k * bflo(v.y), bfhi(y.y) * s + k * bfhi(v.y));
            o.z = cvtpk(bflo(y.z) * s + k * bflo(v.z), bfhi(y.z) * s + k * bfhi(v.z)); o.w = cvtpk(bflo(y.w) * s + k * bflo(v.w), bfhi(y.w) * s + k * bfhi(v.w));
            *(LAS u32x4*)(T + cch * HROW + c8 * 16) = o; }
        __syncthreads();
        { const int th = F.tid & 255, half = F.tid >> 8, c = 2 * th;
          for (int t = 32 * half; t < 32 * half + 32; ++t) {
              const unsigned x0 = *(const unsigned*)(X0 + (size_t)(row0 + t) * 512 + c);
              const float y0 = bf1(*(const LAS bf16_t*)(T + c * HROW + t * 2)), y1 = bf1(*(const LAS bf16_t*)(T + (c + 1) * HROW + t * 2));
              *(unsigned short*)(YH + (size_t)(row0 + t) * 1536 + c) = (unsigned short)__builtin_amdgcn_cvt_pk_fp8_f32(clamp_fp8(bflo(x0) * y0 * 16.f), clamp_fp8(bfhi(x0) * y1 * 16.f), 0, false); } }
    }
    __syncthreads();
}

#define MFMA32(a, b, c) __builtin_amdgcn_mfma_f32_32x32x16_bf16((a), (b), (c), 0, 0, 0)
#define MFMA16(a, b, c) __builtin_amdgcn_mfma_f32_16x16x32_bf16((a), (b), (c), 0, 0, 0)

__device__ __forceinline__ int tile_off(int row, int chunk) { return row * 128 + ((chunk ^ ((row >> 1) & 7)) << 4); }

template <bool WIN>
__device__ __forceinline__ void attn_unit(const Fr& F, const bf16_t* Qw, unsigned char* Yw, const bf16_t* Kb, const bf16_t* VTb, int a0, int na, int b0, int nb, int qpos0, bool has_sink, float sink2, const float* g64, bool rope, const float* ct, const float* st) {
    LAS unsigned char* L = F.lds;
    const int r = F.lane & 31, h = F.lane >> 5;
    const int xaddr = (lane_id() ^ 32) << 2;
#define SWAP32(v) __builtin_bit_cast(float, __builtin_amdgcn_ds_bpermute(xaddr, __builtin_bit_cast(int, (v))))
    bf16x8 q[4];
    {
        float x[4][8]; float ss = 0.f;
#pragma unroll
        for (int kk = 0; kk < 4; ++kk) { const u32x4 w = *(const u32x4*)(Qw + (size_t)r * 1536 + 16 * kk + 8 * h); unpack8(w, x[kk]);
#pragma unroll
            for (int j = 0; j < 8; ++j) ss += x[kk][j] * x[kk][j]; }
        ss += SWAP32(ss);
        const float rn = (1.f / sqrtf(ss * (1.f / 64.f) + EPS)) * QSCALE;
#pragma unroll
        for (int kk = 0; kk < 4; ++kk) { const f32x4 g0 = *(const f32x4*)(g64 + 16 * kk + 8 * h), g1 = *(const f32x4*)(g64 + 16 * kk + 8 * h + 4);
            x[kk][0] *= rn * g0.x; x[kk][1] *= rn * g0.y; x[kk][2] *= rn * g0.z; x[kk][3] *= rn * g0.w; x[kk][4] *= rn * g1.x; x[kk][5] *= rn * g1.y; x[kk][6] *= rn * g1.z; x[kk][7] *= rn * g1.w; }
        if (rope) { const int pos = qpos0 + r;
#pragma unroll
            for (int ax = 0; ax < 2; ++ax) {
                const f32x4 c0 = *(const f32x4*)(ct + pos * 32 + ax * 16 + 8 * h), c1 = *(const f32x4*)(ct + pos * 32 + ax * 16 + 8 * h + 4);
                const f32x4 s0 = *(const f32x4*)(st + pos * 32 + ax * 16 + 8 * h), s1 = *(const f32x4*)(st + pos * 32 + ax * 16 + 8 * h + 4);
                const float cs[8] = {c0.x, c0.y, c0.z, c0.w, c1.x, c1.y, c1.z, c1.w}, sn[8] = {s0.x, s0.y, s0.z, s0.w, s1.x, s1.y, s1.z, s1.w};
#pragma unroll
                for (int j = 0; j < 8; ++j) { const float av = x[2 * ax][j], bv = x[2 * ax + 1][j]; x[2 * ax][j] = av * cs[j] - bv * sn[j]; x[2 * ax + 1][j] = bv * cs[j] + av * sn[j]; } } }
#pragma unroll
        for (int kk = 0; kk < 4; ++kk) q[kk] = __builtin_bit_cast(bf16x8, pack8(x[kk]));
    }
    f32x16 o0, o1;
#pragma unroll
    for (int i = 0; i < 16; ++i) { o0[i] = 0.f; o1[i] = 0.f; }
    float lsum = 0.f;
    const int ntile = na + nb;
    const int srow = F.tid >> 3, sch = F.tid & 7;
    const int soff = tile_off(srow, sch);
    int t4[4];
#pragma unroll
    for (int j = 0; j < 4; ++j) t4[j] = tile_off(r, 2 * j + h);
#define AT_KT(i) ((i) < na ? a0 + (i) : b0 + ((i) - na))
#define AT_LD(i, K0, K1, V0, V1) do { const int kt_ = AT_KT(i); \
        K0 = *(const u32x4*)(Kb + (size_t)(kt_ * 128 + srow) * 128 + sch * 8); K1 = *(const u32x4*)(Kb + (size_t)(kt_ * 128 + 64 + srow) * 128 + sch * 8); \
        V0 = *(const u32x4*)(VTb + (size_t)srow * KEYS + kt_ * 128 + sch * 8); V1 = *(const u32x4*)(VTb + (size_t)srow * KEYS + kt_ * 128 + 64 + sch * 8); } while (0)
#define AT_ST(buf, K0, K1, V0, V1) do { LAS unsigned char* B_ = L + (buf) * 32768 + soff; \
        *(LAS u32x4*)(B_) = K0; *(LAS u32x4*)(B_ + 8192) = K1; *(LAS u32x4*)(B_ + 16384) = V0; *(LAS u32x4*)(B_ + 24576) = V1; } while (0)
#define AT_QK(S0, S1, Kt) do { bf16x8 kf_[8]; \
        _Pragma("unroll") for (int kk = 0; kk < 4; ++kk) { kf_[2 * kk] = *(const LAS bf16x8*)(L + (Kt) + t4[kk]); kf_[2 * kk + 1] = *(const LAS bf16x8*)(L + (Kt) + t4[kk] + 4096); } \
        _Pragma("unroll") for (int i_ = 0; i_ < 16; ++i_) { S0[i_] = 0.f; S1[i_] = 0.f; } \
        _Pragma("unroll") for (int kk = 0; kk < 4; ++kk) { S0 = MFMA32(kf_[2 * kk], q[kk], S0); S1 = MFMA32(kf_[2 * kk + 1], q[kk], S1); } } while (0)
#define AT_EXP(S0, S1, P, kpos0) do { \
        if (WIN && (kpos0) >= 0) { const int kbase = (kpos0) + 4 * h, qp = qpos0 + r; \
            _Pragma("unroll") for (int i = 0; i < 16; ++i) { const int kr = (i & 3) + 8 * (i >> 2); const int d0 = kbase + kr - qp, d1 = d0 + 32; \
                if (d0 > 128 || d0 < -128) S0[i] = -1e30f; if (d1 > 128 || d1 < -128) S1[i] = -1e30f; } } \
        _Pragma("unroll") for (int i = 0; i < 16; ++i) { S0[i] = fast_exp2(S0[i]); S1[i] = fast_exp2(S1[i]); lsum += S0[i] + S1[i]; } \
        { u32x4 w; \
          w.x = cvtpk(S0[0], S0[1]); w.y = cvtpk(S0[2], S0[3]); w.z = cvtpk(S0[4], S0[5]); w.w = cvtpk(S0[6], S0[7]); P[0] = __builtin_bit_cast(bf16x8, w); \
          w.x = cvtpk(S0[8], S0[9]); w.y = cvtpk(S0[10], S0[11]); w.z = cvtpk(S0[12], S0[13]); w.w = cvtpk(S0[14], S0[15]); P[1] = __builtin_bit_cast(bf16x8, w); \
          w.x = cvtpk(S1[0], S1[1]); w.y = cvtpk(S1[2], S1[3]); w.z = cvtpk(S1[4], S1[5]); w.w = cvtpk(S1[6], S1[7]); P[2] = __builtin_bit_cast(bf16x8, w); \
          w.x = cvtpk(S1[8], S1[9]); w.y = cvtpk(S1[10], S1[11]); w.z = cvtpk(S1[12], S1[13]); w.w = cvtpk(S1[14], S1[15]); P[3] = __builtin_bit_cast(bf16x8, w); } } while (0)
#define AT_PV(P, Vt) do { bf16x8 vf_[8]; \
        _Pragma("unroll") for (int c = 0; c < 4; ++c) { vf_[2 * c] = *(const LAS bf16x8*)(L + (Vt) + t4[c]); vf_[2 * c + 1] = *(const LAS bf16x8*)(L + (Vt) + t4[c] + 4096); } \
        _Pragma("unroll") for (int c = 0; c < 4; ++c) { o0 = MFMA32(vf_[2 * c], P[c], o0); o1 = MFMA32(vf_[2 * c + 1], P[c], o1); } } while (0)
#define AT_BODY(it) do { \
        const int kt = AT_KT(it); \
        if ((it) + 1 < ntile) AT_LD((it) + 1, kA0, kA1, vA0, vA1); \
        const int Bc = ((it) & 1) * 32768;                                \
        const int kp = (WIN && kt >= 2) ? (kt - 2) * 128 : -1;            \
        { f32x16 sa0, sa1; bf16x8 pa[4]; \
          AT_QK(sa0, sa1, Bc); AT_EXP(sa0, sa1, pa, kp); AT_PV(pa, Bc + 16384); } \
        __builtin_amdgcn_sched_barrier(0); \
        { f32x16 sb0, sb1; bf16x8 pb_[4]; \
          AT_QK(sb0, sb1, Bc + 8192); AT_EXP(sb0, sb1, pb_, (kp < 0 ? -1 : kp + 64)); AT_PV(pb_, Bc + 24576); } \
        if ((it) + 1 < ntile) AT_ST(((it) + 1) & 1, kA0, kA1, vA0, vA1); \
        __syncthreads(); } while (0)
    u32x4 kA0, kA1, vA0, vA1;
    AT_LD(0, kA0, kA1, vA0, vA1);
    __syncthreads();
    AT_ST(0, kA0, kA1, vA0, vA1);
    __syncthreads();
    for (int it = 0; it < ntile; it += 2) {
        AT_BODY(it);
        if (it + 1 < ntile) AT_BODY(it + 1);
    }
#undef AT_BODY
#undef AT_QK
#undef AT_EXP
#undef AT_PV
#undef AT_ST
#undef AT_LD
#undef AT_KT
    float lt = lsum + SWAP32(lsum);
    if (has_sink) lt += fast_exp2(sink2);
    const float inv = 1.f / lt;
#pragma unroll
    for (int g = 0; g < 4; ++g) { const float i16 = inv * 16.f;
        *(unsigned*)(Yw + (size_t)r * 1536 + 8 * g + 4 * h) = cvt4_fp8(o0[4 * g] * i16, o0[4 * g + 1] * i16, o0[4 * g + 2] * i16, o0[4 * g + 3] * i16);
        *(unsigned*)(Yw + (size_t)r * 1536 + 32 + 8 * g + 4 * h) = cvt4_fp8(o1[4 * g] * i16, o1[4 * g + 1] * i16, o1[4 * g + 2] * i16, o1[4 * g + 3] * i16); }
#undef SWAP32
}

__device__ __forceinline__ void hyena_unit_lat(const Fr& F, const bf16_t* Fg, const bf16_t* Vg, bf16_t* Yg) {
    constexpr int FREP = 8192 + 64, VPIT = 4096 + 16, VOFF = 8 * FREP;
    LAS unsigned char* L = F.lds;
    __syncthreads();
    { const int x = F.tid;
      const u32x4 lo = *(const u32x4*)(Fg + x * 8); u32x4 hi; if (x < 511) hi = *(const u32x4*)(Fg + x * 8 + 8); else { const unsigned z = zero_u32(); hi = (u32x4){z, z, z, z}; }
      const unsigned wv[8] = {lo.x, lo.y, lo.z, lo.w, hi.x, hi.y, hi.z, hi.w};
      *(LAS u32x4*)(L + x * 16) = lo;
#pragma unroll
      for (int rho = 1; rho < 8; ++rho) { u32x4 o;
          unsigned od[4];
#pragma unroll
          for (int d = 0; d < 4; ++d) { const int ob = 4 * d + 2 * rho, i = ob >> 2, s = ob & 3; od[d] = __builtin_amdgcn_alignbyte(wv[i + 1 < 8 ? i + 1 : 7], wv[i], s); }
          o.x = od[0]; o.y = od[1]; o.z = od[2]; o.w = od[3];
          *(LAS u32x4*)(L + rho * FREP + x * 16) = o; } }
    for (int i = F.tid; i < 16 * 256; i += NTHR) { const int b = i >> 8, x = i & 255; *(LAS u32x4*)(L + VOFF + b * VPIT + x * 16) = *(const u32x4*)(Vg + (size_t)b * SEQ + x * 8); }
    __syncthreads();
    const int i16 = F.lane & 15, q4 = F.lane >> 4, w = F.wave;
    const int base0 = 2047 - 256 * w - i16 + 8 * q4;
    const int rho = base0 & 7;
    LAS unsigned char* Ap = L + rho * FREP + (base0 - rho) * 2;
    LAS unsigned char* Bp = L + VOFF + i16 * VPIT + q4 * 16;
    bf16x8 A[16]; f32x4 acc[16];
#pragma unroll
    for (int rr = 0; rr < 16; ++rr) { A[rr] = *(const LAS bf16x8*)(Ap - 32 * rr); acc[rr] = (f32x4){0.f, 0.f, 0.f, 0.f}; }
    bf16x8 Bn = *(const LAS bf16x8*)(Bp);
    for (int o = 0; o < 8; ++o) {
#pragma unroll
        for (int u = 0; u < 8; ++u) {
            const int st = o * 8 + u;
            const bf16x8 Bf = Bn;
            if (st < 63) Bn = *(const LAS bf16x8*)(Bp + 64 * st + 64);
#pragma unroll
            for (int rr = 0; rr < 16; ++rr) acc[rr] = MFMA16(A[(rr - 2 * u) & 15], Bf, acc[rr]);
            if (st < 63) { A[(-2 * u - 2) & 15] = *(const LAS bf16x8*)(Ap + 64 * st + 64); A[(-2 * u - 1) & 15] = *(const LAS bf16x8*)(Ap + 64 * st + 32); }
        }
    }
#pragma unroll
    for (int rr = 0; rr < 16; ++rr) { u32x2 wv; wv.x = cvtpk(acc[rr].x, acc[rr].y); wv.y = cvtpk(acc[rr].z, acc[rr].w);
        *(u32x2*)(Yg + (size_t)i16 * SEQ + 256 * w + 16 * rr + 4 * q4) = wv; }
}
__device__ __forceinline__ void hyena_unit_ctx(const Fr& F, const bf16_t* Fg, const bf16_t* Vg, bf16_t* Yg) {
    constexpr int FREP = 1024 + 64, VPIT = 512 + 16, VOFF = 8 * FREP;
    LAS unsigned char* L = F.lds;
    __syncthreads();
    if (F.tid < 64) *(LAS u32x4*)(L + F.tid * 16) = *(const u32x4*)(Fg + F.tid * 8);
    if (F.tid >= 64 && F.tid < 68) { const unsigned z = zero_u32(); *(LAS u32x4*)(L + 1024 + (F.tid - 64) * 16) = (u32x4){z, z, z, z}; }
    { const int b = F.tid >> 5, x = F.tid & 31; *(LAS u32x4*)(L + VOFF + b * VPIT + x * 16) = *(const u32x4*)(Vg + (size_t)b * CTX + x * 8); }
    __syncthreads();
    for (int i = F.tid; i < 7 * 256; i += NTHR) { const int rho = 1 + i / 256, x2 = (i % 256) * 2; const int s0 = x2 + rho, s1 = x2 + 1 + rho;
        const unsigned e0 = s0 < 512 ? *(const LAS bf16_t*)(L + s0 * 2) : 0, e1 = s1 < 512 ? *(const LAS bf16_t*)(L + s1 * 2) : 0;
        *(LAS unsigned*)(L + rho * FREP + x2 * 2) = e0 | (e1 << 16); }
    __syncthreads();
    const int i16 = F.lane & 15, q4 = F.lane >> 4, w = F.wave;
    const int base0 = 255 - 32 * w - i16 + 8 * q4, rho = base0 & 7;
    LAS unsigned char* Ap = L + rho * FREP + (base0 - rho) * 2;
    LAS unsigned char* Bp = L + VOFF + i16 * VPIT + q4 * 16;
    f32x4 acc0 = (f32x4){0.f, 0.f, 0.f, 0.f}, acc1 = acc0;
#pragma unroll
    for (int st = 0; st < 8; ++st) { const bf16x8 Bf = *(const LAS bf16x8*)(Bp + 64 * st);
        const bf16x8 A0 = *(const LAS bf16x8*)(Ap + 64 * st), A1 = *(const LAS bf16x8*)(Ap + 64 * st - 32);
        acc0 = MFMA16(A0, Bf, acc0); acc1 = MFMA16(A1, Bf, acc1); }
    u32x2 wv; wv.x = cvtpk(acc0.x, acc0.y); wv.y = cvtpk(acc0.z, acc0.w); *(u32x2*)(Yg + (size_t)i16 * CTX + 32 * w + 4 * q4) = wv;
    wv.x = cvtpk(acc1.x, acc1.y); wv.y = cvtpk(acc1.z, acc1.w); *(u32x2*)(Yg + (size_t)i16 * CTX + 32 * w + 16 + 4 * q4) = wv;
}

__device__ __forceinline__ void mixer_phase(const Fr& F, const Args& a, int l, bool with_ctx, unsigned long long& sacc, const int swhich) {
#if defined(PROBE_P)
    unsigned long long st0 = __builtin_amdgcn_s_memrealtime();
#define SUBMARK(w) do { const unsigned long long t_ = __builtin_amdgcn_s_memrealtime(); if (swhich == (w)) sacc += t_ - st0; st0 = t_; } while (0)
#else
#define SUBMARK(w) do { } while (0)
#endif
    const bf16_t* QA = (const bf16_t*)(a.ws + WS_QA); const bf16_t* QW = QA + 1024;
    unsigned char* Y8 = a.ws + WS_Y8;
    const bf16_t* KA = (const bf16_t*)(a.ws + WS_KA); const bf16_t* KW = (const bf16_t*)(a.ws + WS_KW);
    const bf16_t* VTA = (const bf16_t*)(a.ws + WS_VTA); const bf16_t* VTW = (const bf16_t*)(a.ws + WS_VTW);
    const float* sinks = a.in[I_SINK] + l * 8; const float* qkg = a.in[I_QKG] + l * 256;
    const float* ct = (const float*)(a.ws + WS_ROPE); const float* st = ct + SEQ * 32;
    const int wq = F.wave >> 1, wh = F.wave & 1;
    const int ubid = (F.G % 8 == 0) ? (F.bid & 7) * (F.G >> 3) + (F.bid >> 3) : F.bid;
#define RELANE(FX) do { int t_ = F.wave * 64 + lane_id(); asm volatile("" : "+v"(t_)); FX.tid = t_; FX.lane = t_ & 63; } while (0)
    Fr FA = F; RELANE(FA);
    for (int unit = ubid; unit < NB * 2 * 32; unit += F.G) {
        const int b = unit >> 6, kvh = (unit >> 5) & 1, pb = unit & 31;
        const size_t qo = (size_t)(b * SEQ + pb * 64 + wh * 32) * 1536 + (kvh * 4 + wq) * 64;
        attn_unit<false>(FA, QA + qo, Y8 + qo, KA + (size_t)b * KEYS * 128 + kvh * 64, VTA + (size_t)(b * 2 + kvh) * 64 * KEYS, 0, KEYS / 128, 0, 0, pb * 64 + wh * 32, false, 0.f, qkg, true, ct, st);
    }
    SUBMARK(30);
    Fr FW = F; RELANE(FW);
    for (int unit = ubid; unit < NB * 2 * 32; unit += F.G) {
        const int b = unit >> 6, kvh = (unit >> 5) & 1, pb = unit & 31;
        const size_t qo = (size_t)(b * SEQ + pb * 64 + wh * 32) * 1536 + (kvh * 4 + wq) * 64 + 1024;
        const int lo = pb < 2 ? 0 : (pb - 2) >> 1, hi = ((64 * pb + 191) >> 7) > 15 ? 15 : ((64 * pb + 191) >> 7);
        attn_unit<true>(FW, QA + qo, Y8 + qo, KW + (size_t)b * KEYS * 128 + kvh * 64, VTW + (size_t)(b * 2 + kvh) * 64 * KEYS, 0, 2, 2 + lo, hi - lo + 1, pb * 64 + wh * 32, true, sinks[kvh * 4 + wq] * LOG2E, qkg + 128, true, ct, st);
    }
    SUBMARK(31);
    Fr FC2 = F; RELANE(FC2);
    if (with_ctx) {
        for (int unit = ubid; unit < 2 * NB * 2 * 4; unit += F.G) {
            const int isw = unit >> 7, u2 = unit & 127, b = u2 >> 3, kvh = (u2 >> 2) & 1, pb = u2 & 3;
            const size_t qo = (size_t)(TL + b * CTX + pb * 64 + wh * 32) * 1536 + (kvh * 4 + wq) * 64 + (isw ? 1024 : 0);
            attn_unit<false>(FC2, QA + qo, Y8 + qo, (isw ? KW : KA) + (size_t)b * KEYS * 128 + kvh * 64, (isw ? VTW : VTA) + (size_t)(b * 2 + kvh) * 64 * KEYS, 0, 2, 0, 0, 0, isw != 0, isw ? sinks[kvh * 4 + wq] * LOG2E : 0.f, qkg + (isw ? 128 : 0), false, ct, st);
        }
    }
    SUBMARK(32);
    const bf16_t* FL = (const bf16_t*)(a.ws + WS_FL) + (size_t)l * 512 * 4096; const bf16_t* FC = (const bf16_t*)(a.ws + WS_FC) + (size_t)l * 512 * 512;
    const bf16_t* VT = (const bf16_t*)(a.ws + WS_VT); bf16_t* YT = (bf16_t*)(a.ws + WS_YT);
    Fr FH = F; RELANE(FH);
    for (int c = F.bid; c < HYW; c += F.G) hyena_unit_lat(FH, FL + (size_t)c * 4096, VT + (size_t)c * NB * SEQ, YT + (size_t)c * NB * SEQ);
    if (with_ctx) for (int c = F.bid; c < HYW; c += F.G) hyena_unit_ctx(FH, FC + (size_t)c * 512, VT + VT_CTX_OFF + (size_t)c * NB * CTX, YT + VT_CTX_OFF + (size_t)c * NB * CTX);
    __syncthreads();
    SUBMARK(33);
#undef SUBMARK
#undef RELANE
}

__device__ __forceinline__ float gate_q(float x) { return fminf(256.f * sigmoid_f(x), 255.49f); }
__device__ __forceinline__ unsigned pack_u8x4(float a, float b, float c, float d) { return (unsigned)(int)a | ((unsigned)(int)b << 8) | ((unsigned)(int)c << 16) | ((unsigned)(int)d << 24); }
__device__ __forceinline__ float gq(unsigned w, int k) { return (float)((w >> (8 * k)) & 0xffu) + 0.5f; }
struct EpiInProj {
    static constexpr bool PERM = true, AFTER_DRAIN = false; static constexpr int NSEG = 1;
    unsigned char* ws; int pn_off;
    __device__ __forceinline__ void operator()(const pg8::f32x4 (&acc)[2][2][4][2], const pg8::Unit& u, int wr, int wc, int fr, int fq) const {
        asm volatile("" : "+v"(fr), "+v"(fq));
        const int pn = __builtin_amdgcn_readfirstlane(u.pn) + pn_off; unsigned long long boff; int ldc, colt; bool sig = false;
        if (pn < 2) { boff = WS_QA; ldc = 1536; colt = pn * 256; }
        else if (pn == 2) { boff = WS_RAWA; ldc = 256; colt = 0; }
        else if (pn < 9) { boff = WS_U; ldc = 1536; colt = (pn - 3) * 256; }
        else if (pn < 11) { boff = WS_QA; ldc = 1536; colt = 1024 + (pn - 9) * 256; }
        else if (pn == 11) { boff = WS_RAWW; ldc = 256; colt = 0; }
        else { boff = WS_G; ldc = 3072; colt = (pn - 12) * 256; sig = true; }
        bf16_t* base = (bf16_t*)(ws + boff); unsigned char* Gt = ws + boff;
        const int row0 = u.pm * 256 + wr * 64 + fr, col0 = colt + wc * 32 + 8 * fq;
        if (sig) {
            unsigned char* gb = (unsigned char*)Gt;
#pragma unroll
            for (int ai = 0; ai < 2; ++ai)
#pragma unroll
                for (int m = 0; m < 4; ++m) { unsigned char* rowp = gb + (size_t)(row0 + ai * 128 + m * 16) * 3072 + col0;
#pragma unroll
                    for (int bj = 0; bj < 2; ++bj) { const pg8::f32x4 v0 = acc[ai][bj][m][0], v1 = acc[ai][bj][m][1];
                        u32x2 w; w.x = pack_u8x4(gate_q(v0.x), gate_q(v0.y), gate_q(v0.z), gate_q(v0.w)); w.y = pack_u8x4(gate_q(v1.x), gate_q(v1.y), gate_q(v1.z), gate_q(v1.w));
                        *(u32x2*)(rowp + bj * 128) = w; } }
            return;
        }
#pragma unroll
        for (int ai = 0; ai < 2; ++ai)
#pragma unroll
            for (int m = 0; m < 4; ++m) { bf16_t* rowp = base + (size_t)(row0 + ai * 128 + m * 16) * ldc + col0;
#pragma unroll
                for (int bj = 0; bj < 2; ++bj) { const pg8::f32x4 v0 = acc[ai][bj][m][0], v1 = acc[ai][bj][m][1];
                    u32x4 w; w.x = cvtpk(v0.x, v0.y); w.y = cvtpk(v0.z, v0.w); w.z = cvtpk(v1.x, v1.y); w.w = cvtpk(v1.z, v1.w);
                    *(u32x4*)(rowp + bj * 128) = w; } }
    }
};
struct EpiGate {
    static constexpr bool PERM = true, AFTER_DRAIN = false; static constexpr int NSEG = 1;
    unsigned char* Gt;
    __device__ __forceinline__ void operator()(const pg8::f32x4 (&acc)[2][2][4][2], const pg8::Unit& u, int wr, int wc, int fr, int fq) const {
        asm volatile("" : "+v"(fr), "+v"(fq));
        const int row0 = u.pm * 256 + wr * 64 + fr, col0 = u.pn * 256 + wc * 32 + 8 * fq;
#pragma unroll
        for (int ai = 0; ai < 2; ++ai)
#pragma unroll
            for (int m = 0; m < 4; ++m) { unsigned char* rowp = Gt + (size_t)(row0 + ai * 128 + m * 16) * 3072 + col0;
#pragma unroll
                for (int bj = 0; bj < 2; ++bj) { const pg8::f32x4 v0 = acc[ai][bj][m][0], v1 = acc[ai][bj][m][1];
                    u32x2 w; w.x = pack_u8x4(gate_q(v0.x), gate_q(v0.y), gate_q(v0.z), gate_q(v0.w)); w.y = pack_u8x4(gate_q(v1.x), gate_q(v1.y), gate_q(v1.z), gate_q(v1.w));
                    *(u32x2*)(rowp + bj * 128) = w; } }
    }
};
struct EpiMerge {
    static constexpr bool PERM = true, AFTER_DRAIN = false; static constexpr int NSEG = 3;
    unsigned char* Mo; const unsigned char* Gt;
    __device__ __forceinline__ void rescale(pg8::f32x4 (&acc)[2][2][4][2], const pg8::Unit& u, int seg, int wr, int wc, int fr, int fq) const {
        asm volatile("" : "+v"(fr), "+v"(fq));
        const int row0 = u.pm * 256 + wr * 64 + fr, col0 = u.pn * 256 + wc * 32 + 8 * fq;
        const unsigned char* G0 = Gt + seg * 1024 + col0;
        u32x2 ga[2][4][2], gb[2][4][2];
#pragma unroll
        for (int ai = 0; ai < 2; ++ai)
#pragma unroll
            for (int m = 0; m < 4; ++m)
#pragma unroll
                for (int bj = 0; bj < 2; ++bj) { const size_t row = (size_t)(row0 + ai * 128 + m * 16);
                    ga[ai][m][bj] = *(const u32x2*)(G0 + row * 3072 + bj * 128); gb[ai][m][bj] = *(const u32x2*)(G0 + row * 3072 + 1024 + bj * 128); }
        __builtin_amdgcn_sched_barrier(0);
#pragma unroll
        for (int ai = 0; ai < 2; ++ai)
#pragma unroll
            for (int m = 0; m < 4; ++m)
#pragma unroll
                for (int bj = 0; bj < 2; ++bj) { const u32x2 a = ga[ai][m][bj], b = gb[ai][m][bj]; pg8::f32x4& v0 = acc[ai][bj][m][0]; pg8::f32x4& v1 = acc[ai][bj][m][1];
                    v0.x *= gq(a.x, 0) * fast_rcp(gq(b.x, 0)); v0.y *= gq(a.x, 1) * fast_rcp(gq(b.x, 1)); v0.z *= gq(a.x, 2) * fast_rcp(gq(b.x, 2)); v0.w *= gq(a.x, 3) * fast_rcp(gq(b.x, 3));
                    v1.x *= gq(a.y, 0) * fast_rcp(gq(b.y, 0)); v1.y *= gq(a.y, 1) * fast_rcp(gq(b.y, 1)); v1.z *= gq(a.y, 2) * fast_rcp(gq(b.y, 2)); v1.w *= gq(a.y, 3) * fast_rcp(gq(b.y, 3)); }
        __builtin_amdgcn_sched_barrier(0);
    }
    __device__ __forceinline__ void operator()(const pg8::f32x4 (&acc)[2][2][4][2], const pg8::Unit& u, int wr, int wc, int fr, int fq) const {
        asm volatile("" : "+v"(fr), "+v"(fq));
        const int row0 = u.pm * 256 + wr * 64 + fr, col0 = u.pn * 256 + wc * 32 + 8 * fq;
        constexpr float S = 16.f / 256.f;
        u32x2 gv[2][4][2];
#pragma unroll
        for (int ai = 0; ai < 2; ++ai)
#pragma unroll
            for (int m = 0; m < 4; ++m)
#pragma unroll
                for (int bj = 0; bj < 2; ++bj) gv[ai][m][bj] = *(const u32x2*)(Gt + (size_t)(row0 + ai * 128 + m * 16) * 3072 + 2048 + col0 + bj * 128);
        __builtin_amdgcn_sched_barrier(0);
#pragma unroll
        for (int ai = 0; ai < 2; ++ai) {
#pragma unroll
            for (int m = 0; m < 4; ++m)
#pragma unroll
                for (int bj = 0; bj < 2; ++bj) { const pg8::f32x4 v0 = acc[ai][bj][m][0], v1 = acc[ai][bj][m][1]; const u32x2 g = gv[ai][m][bj];
                    u32x2 w; w.x = cvt4_fp8(v0.x * (gq(g.x, 0) * S), v0.y * (gq(g.x, 1) * S), v0.z * (gq(g.x, 2) * S), v0.w * (gq(g.x, 3) * S));
                    w.y = cvt4_fp8(v1.x * (gq(g.y, 0) * S), v1.y * (gq(g.y, 1) * S), v1.z * (gq(g.y, 2) * S), v1.w * (gq(g.y, 3) * S));
                    *(u32x2*)(Mo + (size_t)(row0 + ai * 128 + m * 16) * 1024 + col0 + bj * 128) = w; }
            __builtin_amdgcn_sched_barrier(0);
        }
    }
};
struct EpiOut {
    static constexpr bool PERM = true, AFTER_DRAIN = false; static constexpr int NSEG = 1;
    const float* xsL; const float* xsC; float* xdL; float* xdC; const float* MODl;
    __device__ __forceinline__ void operator()(const pg8::f32x4 (&acc)[2][2][4][2], const pg8::Unit& u, int wr, int wc, int fr, int fq) const {
        asm volatile("" : "+v"(fr), "+v"(fq));
        const int trow = u.pm * 256; const bool lat = trow < TL;
        const int row0 = trow + wr * 64 + fr, col0 = u.pn * 256 + wc * 32 + 8 * fq;
        const float* md = MODl + (size_t)mod_row(trow) * DIN + 2 * 1024 + col0;
        const float* xs = lat ? xsL + (size_t)row0 * D + col0 : xsC + (size_t)(row0 - TL) * D + col0; float* xd = lat ? xdL + (size_t)row0 * D + col0 : xdC + (size_t)(row0 - TL) * D + col0;
        f32x4 mv[2][2];
#pragma unroll
        for (int bj = 0; bj < 2; ++bj)
#pragma unroll
            for (int n = 0; n < 2; ++n) mv[bj][n] = *(const f32x4*)(md + bj * 128 + 4 * n);
#pragma unroll
        for (int ai = 0; ai < 2; ++ai) {
                f32x4 xv[4][2][2];
#pragma unroll
                for (int m = 0; m < 4; ++m)
#pragma unroll
                    for (int bj = 0; bj < 2; ++bj)
#pragma unroll
                        for (int n = 0; n < 2; ++n) xv[m][bj][n] = *(const f32x4*)(xs + (size_t)(ai * 128 + m * 16) * D + bj * 128 + 4 * n);
                __builtin_amdgcn_sched_barrier(0);
#pragma unroll
                for (int m = 0; m < 4; ++m)
#pragma unroll
                    for (int bj = 0; bj < 2; ++bj)
#pragma unroll
                        for (int n = 0; n < 2; ++n) { const pg8::f32x4 av = acc[ai][bj][m][n]; const f32x4 x4 = xv[m][bj][n], m4 = mv[bj][n];
                            f32x4 o; o.x = fmaf(m4.x, av.x, x4.x); o.y = fmaf(m4.y, av.y, x4.y); o.z = fmaf(m4.z, av.z, x4.z); o.w = fmaf(m4.w, av.w, x4.w);
                            *(f32x4*)(xd + (size_t)(ai * 128 + m * 16) * D + bj * 128 + 4 * n) = o; }
                __builtin_amdgcn_sched_barrier(0);
            }
    }
};
struct EpiMoe1 {
    static constexpr bool PERM = true, AFTER_DRAIN = false; static constexpr int NSEG = 1;
    unsigned char* HM;
    __device__ __forceinline__ void operator()(const pg8::f32x4 (&acc)[2][2][4][2], const pg8::Unit& u, int wr, int wc, int fr, int fq) const {
        asm volatile("" : "+v"(fr), "+v"(fq));
        const int row0 = u.pm * 256 + wr * 64 + fr, hcol0 = (u.pn & 3) * 128 + wc * 16 + 4 * fq;
#pragma unroll
        for (int ai = 0; ai < 2; ++ai)
#pragma unroll
            for (int m = 0; m < 4; ++m) { unsigned char* rowp = HM + (size_t)(row0 + ai * 128 + m * 16) * 512 + hcol0;
#pragma unroll
                for (int bj = 0; bj < 2; ++bj) { const pg8::f32x4 x = acc[ai][bj][m][0], y = acc[ai][bj][m][1] * 8.f;
                    *(unsigned*)(rowp + bj * 64) = cvt4_fp8(x.x * sigmoid_f(x.x) * y.x, x.y * sigmoid_f(x.y) * y.y, x.z * sigmoid_f(x.z) * y.z, x.w * sigmoid_f(x.w) * y.w); } }
    }
};
struct EpiMoe2 {
    static constexpr bool PERM = true, AFTER_DRAIN = false; static constexpr int NSEG = 1;
    bf16_t* Fo; const int* erow; const float* eroww; const LAS int* ebase; const LAS int* ecnt;
    __device__ __forceinline__ void operator()(const pg8::f32x4 (&acc)[2][2][4][2], const pg8::Unit& u, int wr, int wc, int fr, int fq) const {
        asm volatile("" : "+v"(fr), "+v"(fq));
        const int e = u.pn >> 2, cnt = __builtin_amdgcn_readfirstlane(ecnt[e]), pos0 = u.pm * 256 - __builtin_amdgcn_readfirstlane(ebase[e]) + wr * 64 + fr, col0 = (u.pn & 3) * 256 + wc * 32 + 8 * fq;
        const int* er = erow + (size_t)e * TT; const float* ew = eroww + (size_t)e * TT;
        int rma[2][4]; float wga[2][4];
#pragma unroll
        for (int ai = 0; ai < 2; ++ai)
#pragma unroll
            for (int m = 0; m < 4; ++m) { const int pos = pos0 + ai * 128 + m * 16; const bool ok = pos < cnt; rma[ai][m] = ok ? er[ok ? pos : 0] : -1; wga[ai][m] = ew[ok ? pos : 0]; }
        __builtin_amdgcn_sched_barrier(0);
#pragma unroll
        for (int ai = 0; ai < 2; ++ai) {
#pragma unroll
            for (int m = 0; m < 4; ++m) { const int r1 = rma[ai][m];
                if (r1 >= 0) { const float wgt = wga[ai][m]; bf16_t* rowp = Fo + ((size_t)(r1 & 1) * TT + (r1 >> 1)) * D + col0;
#pragma unroll
                    for (int bj = 0; bj < 2; ++bj) { const pg8::f32x4 v0 = acc[ai][bj][m][0], v1 = acc[ai][bj][m][1];
                        u32x4 w; w.x = cvtpk(v0.x * wgt, v0.y * wgt); w.y = cvtpk(v0.z * wgt, v0.w * wgt); w.z = cvtpk(v1.x * wgt, v1.y * wgt); w.w = cvtpk(v1.z * wgt, v1.w * wgt);
                        *(u32x4*)(rowp + bj * 128) = w; } } }
            __builtin_amdgcn_sched_barrier(0);
        }
    }
};
struct FusedOutOrder {
    int c, G, nun, wv; const unsigned* ready; unsigned* tmo;
    __device__ __forceinline__ bool next(int i, pg8::Unit& u) const {
        int q;
        if (!ready) { q = i * G + c; if (q >= nun) return false; }
        else if (G == 256 && nun == 576) { if (c < 64) { if (i > 0) return false; q = 512 + c; } else { q = i * 192 + (c - 64); if (q >= 512) return false; } }
        else { q = i * G + (G - 1 - c); if (q >= nun) return false; }
        u.pm = q >> 2; u.pn = q & 3; return true; }
    __device__ __forceinline__ void a_ready(const pg8::Unit& u) const {
        if (!ready) return;
        if (wv == 0) {
            const unsigned long long t0 = __builtin_amdgcn_s_memrealtime(); unsigned polls = 0;
            while ((unsigned)__builtin_amdgcn_readfirstlane(__hip_atomic_load(ready + 64 * u.pm, __ATOMIC_RELAXED, __HIP_MEMORY_SCOPE_AGENT)) < 32u) {
                if ((++polls & 255u) == 0u && __builtin_amdgcn_readfirstlane(__hip_atomic_load(tmo, __ATOMIC_RELAXED, __HIP_MEMORY_SCOPE_AGENT)) != 0u) break;
                if (__builtin_amdgcn_s_memrealtime() - t0 > 20000000ull) { if (lane_id() == 0) __hip_atomic_store(tmo, 1u, __ATOMIC_RELAXED, __HIP_MEMORY_SCOPE_AGENT); break; }
                __builtin_amdgcn_s_sleep(2); }
            __builtin_amdgcn_fence(__ATOMIC_ACQUIRE, "agent");
            asm volatile("s_waitcnt vmcnt(0)" ::: "memory");
        }
        asm volatile("" ::: "memory"); __builtin_amdgcn_s_barrier(); asm volatile("" ::: "memory");
    }
    __device__ __forceinline__ void done(const pg8::Unit&) const {}
};
struct LastInProjOrder {
    pg8::StaticOrder T; int nlat, G, c;
    __device__ __forceinline__ bool next(int i, pg8::Unit& u) const {
        const int L = i * G + c;
        if (L < nlat) return T.next(i, u);
        const int r = L - nlat; if (r >= 32) return false;
        u.pm = 128 + (r >> 1); u.pn = (r & 1) ? 11 : 2; return true; }
    __device__ __forceinline__ void a_ready(const pg8::Unit&) const {}
    __device__ __forceinline__ void done(const pg8::Unit&) const {}
};
struct MoeOrder {
    int nunits, G, c; const LAS int* tile_e;
    __device__ __forceinline__ bool next(int i, pg8::Unit& u) const {
        const int L0 = i * G + c; if (L0 >= nunits) return false;
        const int q = nunits / 8, r = nunits % 8, xcd = L0 % 8, off = L0 / 8; const int L = (xcd < r ? xcd * (q + 1) : r * (q + 1) + (xcd - r) * q) + off;
        const int pm = L >> 2; u.pm = pm; u.pn = __builtin_amdgcn_readfirstlane(tile_e[pm]) * 4 + (L & 3); return true; }
    __device__ __forceinline__ void a_ready(const pg8::Unit&) const {}
    __device__ __forceinline__ void done(const pg8::Unit&) const {}
};

__device__ __forceinline__ int moe_tables(const Fr& F, const Args& a, int l, LAS int* ebase  , LAS int* ecnt  , LAS int* tile_e  ) {
    const unsigned* CNT = (const unsigned*)(a.ws + WS_CTL) + CW_CNT + l * 256;
    __syncthreads();
    if (F.tid == 0) { int acc = 0;
#pragma unroll 1
        for (int e = 0; e < NE; ++e) { const int c = (int)__hip_atomic_load(&CNT[e * 16], __ATOMIC_RELAXED, __HIP_MEMORY_SCOPE_AGENT); ecnt[e] = c; ebase[e] = acc; const int nt = (c + 255) >> 8;
#pragma unroll 1
            for (int t = 0; t < nt; ++t) tile_e[(acc >> 8) + t] = e;
            acc += nt << 8; }
        ebase[NE] = acc; }
    __syncthreads();
    return ebase[NE] >> 8;
}

__device__ __forceinline__ void moe_gather_table(const Fr& F, const Args& a, const MoeOrder& S, const LAS int* ebase, const LAS int* ecnt, LAS int* gidx) {
    const int* EROW = (const int*)(a.ws + WS_EROW);
    for (int j = 0; j < 16; ++j) { pg8::Unit u; if (!S.next(j, u)) break;
        const int e = u.pn >> 2, pos0 = u.pm * 256 - ebase[e], cnt = ecnt[e];
        if (F.tid < 256) { const int pos = pos0 + F.tid; gidx[j * 256 + F.tid] = pos < cnt ? (EROW[(size_t)e * TT + pos] >> 1) : 0; } }
    __syncthreads();
}

#ifndef MK_PER_PHASE
#define MK_PER_PHASE 0
#endif
constexpr int PH_PER_LAYER = 10, PH_FINAL = 1 + NL * PH_PER_LAYER, N_PHASES = PH_FINAL + 1;

__global__ void __launch_bounds__(NTHR, 2) trunk_fwd(Args args) {
    extern __shared__ __attribute__((aligned(16))) unsigned char lds[];
    Fr F; F.lds = (LAS unsigned char*)lds; F.tid = threadIdx.x; F.lane = F.tid & 63; F.wave = __builtin_amdgcn_readfirstlane(F.tid >> 6); F.G = gridDim.x; F.bid = blockIdx.x;
    const int wave0 = F.wave;
    for (int u = F.tid; u < (LDS_BYTES - MISC_OFF) / 4; u += NTHR) ((LAS unsigned*)(F.lds + MISC_OFF))[u] = 0u;
    __syncthreads();
    const int lo = args.ph_lo, hi = args.ph_hi;
    unsigned* ctl = (unsigned*)(args.ws + WS_CTL);
    XcdBarrier bar; bar.bar = ctl + CW_BAR; bar.x = 0; bar.st = (volatile LAS unsigned*)(F.lds + MISC_OFF);
    if (hi - lo > 1) bar = xcd_barrier_post(ctl + CW_BAR, (volatile LAS unsigned*)(F.lds + MISC_OFF));
    bar.wv = (unsigned)wave0;
#ifndef DBG_ONLY
#define DBG_ONLY -1
#endif
#define SEL(p) (DBG_ONLY < 0 || DBG_ONLY == (p))
#define IN(k) (lo <= (k) && (k) < hi)
#define FRESH() do { int t_ = wave0 * 64 + lane_id(); asm volatile("" : "+v"(t_)); F.tid = t_; F.lane = t_ & 63; F.wave = wave0; } while (0)
#define SEAM(k) do { if (IN(k) && IN((k) + 1)) xcd_barrier(bar); } while (0)
#if !defined(PROBE_SUB)
#define PROBE_SUB -1
#endif
    unsigned long long pr_sub = 0ull;
#if defined(PROBE_P)
    unsigned long long pr_acc = 0ull, pr_t0 = __builtin_amdgcn_s_memrealtime();
#define PR_MARK(p) do { const unsigned long long t_ = __builtin_amdgcn_s_memrealtime(); if ((p) == PROBE_P) pr_acc += t_ - pr_t0; pr_t0 = t_; } while (0)
#else
#define PR_MARK(p) do { } while (0)
#endif
    unsigned char* ws = args.ws;
    LAS int* ebase = (LAS int*)(F.lds + MISC_OFF + 64); LAS int* ecnt = ebase + 20; LAS int* tile_e = (LAS int*)(F.lds + MISC_OFF + 512);

    #ifndef DBG_PRO
#define DBG_PRO 7
#endif
#if defined(PROBE_P)
    if (SEL(100) && IN(0)) { FRESH(); const unsigned long long tq0_ = __builtin_amdgcn_s_memrealtime(); pro_mod(F, args); __syncthreads(); const unsigned long long tq1_ = __builtin_amdgcn_s_memrealtime(); pro_rope(F, args); pro_filter(F, args); __syncthreads();
        const unsigned long long tq2_ = __builtin_amdgcn_s_memrealtime(); if (PROBE_SUB == 60) pr_sub += tq1_ - tq0_; if (PROBE_SUB == 61) pr_sub += tq2_ - tq1_; }
#else
    if (SEL(100) && IN(0)) { FRESH(); if (DBG_PRO & 1) pro_mod(F, args); __syncthreads(); if (DBG_PRO & 2) pro_rope(F, args); if (DBG_PRO & 4) pro_filter(F, args); __syncthreads(); }
#endif
    SEAM(0); PR_MARK(100);
    for (int l = 0; l < NL; ++l) {
        const int pb = 1 + PH_PER_LAYER * l;
#define LVARS() int lq_ = l; asm volatile("" : "+s"(lq_)); const bool uc = lq_ < NL - 1; const int M2 = uc ? TT : TL; (void)M2; (void)uc
        if (SEL(0) && IN(pb + 0)) { LVARS(); FRESH(); if (l == 0) filter_norm_reduce(F, args); conv_small_weights(F, args, l, 7, 0); rows_p0(F, args, l, TT); __syncthreads(); }
        SEAM(pb + 0); PR_MARK(0);
        if (SEL(1) && IN(pb + 1)) { LVARS();
            pg8::Gemm g{(const bf16_t*)(ws + WS_H8), (const bf16_t*)(ws + WS_WG8), TT, DIN, 512}; EpiInProj E{ws, 0};
            if (uc) { pg8::StaticOrder S; S.init(TT, DIN, F.G, F.bid); pg8::gemm_phase<EpiInProj, pg8::StaticOrder, true, true, false, true, -6>(F.lds, g, S, E, wave0); }
            else { LastInProjOrder S; S.T.init(TL, DIN, F.G, F.bid); S.nlat = (TL / 256) * (DIN / 256); S.G = F.G; S.c = F.bid; pg8::gemm_phase<EpiInProj, LastInProjOrder, true, true, false, true, -6>(F.lds, g, S, E, wave0); }
        }
        SEAM(pb + 1); PR_MARK(1);
        if (SEL(2) && IN(pb + 2)) { LVARS(); FRESH(); prep_phase(F, args, l, uc); }
        SEAM(pb + 2); PR_MARK(2);
        if (SEL(3) && IN(pb + 3)) { LVARS(); FRESH(); mixer_phase(F, args, l, uc, pr_sub, PROBE_SUB); }
        SEAM(pb + 3); PR_MARK(3);
        if (SEL(4) && IN(pb + 4)) { LVARS(); FRESH(); hyena_final_phase(F, args, l, uc); }
        SEAM(pb + 4); PR_MARK(4);
        if (SEL(5) && IN(pb + 5)) { LVARS();
            pg8::StaticOrder S; S.init(M2, 1024, F.G, F.bid);
            pg8::Gemm g{(const bf16_t*)(ws + WS_Y8), (const bf16_t*)(ws + WS_WBR), M2, 1024, 768}; EpiMerge E{ws + WS_H, (const unsigned char*)(ws + WS_G)};
            pg8::gemm_phase<EpiMerge, pg8::StaticOrder, true, true, false, true, -10>(F.lds, g, S, E, wave0);
            { FRESH(); __syncthreads(); const int nun = (M2 / 256) * 4, rem = nun % F.G; conv_expert_weights(F, args, l, rem, 0, CONV_E_ITEMS); __syncthreads(); }
        }
        SEAM(pb + 5); PR_MARK(5);
        if (SEL(6) && IN(pb + 6)) { LVARS();
            pg8::Gemm g{(const bf16_t*)(ws + WS_H), (const bf16_t*)(ws + WS_WOUT), M2, 1024, 512}; pg8::StaticOrder S; S.init(M2, 1024, F.G, F.bid);
            EpiOut E{l == 0 ? args.in[I_X] : args.out, l == 0 ? args.in[I_CTX] : (const float*)(ws + WS_XC), args.out, (float*)(ws + WS_XC), (const float*)(ws + WS_MOD) + (size_t)l * NBM * DIN};
            pg8::gemm_phase<EpiOut, pg8::StaticOrder, true, true, false, true, -10>(F.lds, g, S, E, wave0);
        }
        SEAM(pb + 6); PR_MARK(6);
        if (SEL(7) && IN(pb + 7)) { LVARS(); FRESH(); rows_p5(F, args, l, M2, pr_sub, PROBE_SUB); __syncthreads(); }
        SEAM(pb + 7); PR_MARK(7);
        if (SEL(8) && IN(pb + 8)) { LVARS(); FRESH();
            const int ntile = moe_tables(F, args, l, ebase, ecnt, tile_e);
            pg8::Gemm g{(const bf16_t*)(ws + WS_H), (const bf16_t*)(ws + WS_W13), ntile * 256, NE * 1024, 512}; MoeOrder S{ntile * 4, F.G, F.bid, tile_e};
            LAS int* gidx = (LAS int*)(F.lds + 131072);
            moe_gather_table(F, args, S, ebase, ecnt, gidx);
            EpiMoe1 E{ws + WS_U};
            pg8::gemm_phase<EpiMoe1, MoeOrder, true, true, true, true, -6>(F.lds, g, S, E, wave0, gidx);
        }
        SEAM(pb + 8); PR_MARK(8);
        if (SEL(9) && IN(pb + 9)) { LVARS(); FRESH();
            const int ntile = moe_tables(F, args, l, ebase, ecnt, tile_e);
            pg8::Gemm g{(const bf16_t*)(ws + WS_U), (const bf16_t*)(ws + WS_W2), ntile * 256, NE * 1024, 256}; MoeOrder S{ntile * 4, F.G, F.bid, tile_e};
            EpiMoe2 E{(bf16_t*)(ws + WS_F), (const int*)(ws + WS_EROW), (const float*)(ws + WS_EROWW), ebase, ecnt};
            pg8::gemm_phase<EpiMoe2, MoeOrder, true, true, false, true, -9>(F.lds, g, S, E, wave0);
        }
        SEAM(pb + 9); PR_MARK(9);
    }
    if (SEL(101) && IN(PH_FINAL)) { FRESH(); rows_final(F, args); }
#if defined(PROBE_P)
    PR_MARK(101);
    pr_acc += pr_sub;
#if !defined(PROBE_BLK)
#define PROBE_BLK 0
#endif
    if (blockIdx.x == PROBE_BLK && F.wave == 0) { const unsigned long long t1 = __builtin_amdgcn_s_memrealtime() + 4ull * pr_acc; while (__builtin_amdgcn_s_memrealtime() < t1) __builtin_amdgcn_s_sleep(8); }
#endif
#undef IN
#undef SEAM
}

extern "C" void kernel_launch(void* const* d_in, const int* in_sizes, int n_in, void* d_out, int out_size, void* d_ws, size_t ws_size, hipStream_t stream) {
    static int grid = 0;
    if (grid == 0) {
        if (n_in != 29 || in_sizes[0] != TL * D || out_size != TL * D || ws_size < WS_END) { fprintf(stderr, "kernel_launch: unexpected shapes / workspace (n_in %d, ws %zu < %zu); nothing launched\n", n_in, ws_size, (size_t)WS_END); grid = -1; return; }
        int dev = 0, cus = 0, per_cu = 0;
        if (hipGetDevice(&dev) != hipSuccess || hipDeviceGetAttribute(&cus, hipDeviceAttributeMultiprocessorCount, dev) != hipSuccess) { grid = -1; return; }
        if (hipFuncSetAttribute((const void*)trunk_fwd, hipFuncAttributeMaxDynamicSharedMemorySize, LDS_BYTES) != hipSuccess) { fprintf(stderr, "kernel_launch: hipFuncSetAttribute failed\n"); grid = -1; return; }
        if (hipOccupancyMaxActiveBlocksPerMultiprocessor(&per_cu, (const void*)trunk_fwd, NTHR, LDS_BYTES) != hipSuccess || per_cu < 1) { fprintf(stderr, "kernel_launch: occupancy query reports %d\n", per_cu); }
        (void)hipGetLastError();
        grid = cus;
    }
    if (grid < 0) return;
    (void)hipMemsetAsync((char*)d_ws + WS_CTL, 0, CTL_ZERO_BYTES, stream);
    Args a{};
    for (int i = 0; i < 29; ++i) a.in[i] = (const float*)d_in[i];
    a.out = (float*)d_out; a.ws = (unsigned char*)d_ws;
#if MK_PER_PHASE
    for (int k = 0; k < N_PHASES; ++k) { a.ph_lo = k; a.ph_hi = k + 1; hipLaunchKernelGGL(trunk_fwd, dim3(grid), dim3(NTHR), LDS_BYTES, stream, a); }
#else
    a.ph_lo = 0; a.ph_hi = N_PHASES;
    hipLaunchKernelGGL(trunk_fwd, dim3(grid), dim3(NTHR), LDS_BYTES, stream, a);
#endif
}
```

```cpp
#include <hip/hip_runtime.h>
#include <cstdio>
#include <cstdint>

#define GAS __attribute__((address_space(1)))
#define LAS __attribute__((address_space(3)))
__device__ __forceinline__ int lane_id() { int l; asm volatile("v_mbcnt_lo_u32_b32 %0, -1, 0\n\tv_mbcnt_hi_u32_b32 %0, -1, %0" : "=v"(l)); return l; }
#define MK_PER_PHASE 0
namespace pg8 {
#define PG8_LAS __attribute__((address_space(3)))
typedef unsigned short bf16_t;
typedef short bf16x8 __attribute__((ext_vector_type(8)));
typedef float f32x4 __attribute__((ext_vector_type(4)));
typedef unsigned u32x4 __attribute__((ext_vector_type(4)));
constexpr int BM = 256, BK = 64, HALF = 128, HTB = HALF * BK * 2  , STAGE_BYTES = 8 * HTB, NXCD = 8, WGM = 8;

__host__ __device__ __forceinline__ int lds_byte(int r, int c) { const int st = (r >> 4) * 2 + (c >> 5), rr = r & 15, cc = c & 31, ob = rr * 64 + cc * 2; return st * 1024 + (ob ^ (((ob >> 9) & 1) << 5)); }
__host__ __device__ __forceinline__ void stage_rc(int b, int& R, int& C) { const int st = b / 1024, sb = b % 1024, swz = sb ^ (((sb >> 9) & 1) << 5); R = (st >> 1) * 16 + swz / 64; C = (st & 1) * 32 + (swz % 64) / 2; }
__host__ __device__ __forceinline__ int perm32(int rho) { const int n = rho >> 4, i = rho & 15; return 8 * (i >> 2) + 4 * n + (i & 3); }

struct Unit { int pm, pn; };
struct Gemm { const bf16_t* A; const bf16_t* Bt; int M, N, K; };

struct StaticOrder {
    int nM, nN, nwg, G, c;
    __host__ __device__ void init(int M, int N, int G_, int c_) { nM = M / BM; nN = N / BM; nwg = nM * nN; G = G_; c = c_; }
    __host__ __device__ bool next(int i, Unit& u) const {
        const long L = (long)i * G + c; if (L >= nwg) return false;
        int wgid = (int)L; { const int q = nwg / NXCD, r = nwg % NXCD, xcd = wgid % NXCD, off = wgid / NXCD; wgid = (xcd < r ? xcd * (q + 1) : r * (q + 1) + (xcd - r) * q) + off; }
        const int nig = WGM * nN, gid = wgid / nig, fm = gid * WGM, gsz = (nM - fm) < WGM ? (nM - fm) : WGM;
        u.pm = fm + ((wgid % nig) % gsz); u.pn = (wgid % nig) / gsz; return true;
    }
    __device__ __forceinline__ void a_ready(const Unit&) const {}
    __device__ __forceinline__ void done(const Unit&) const {}
};
__device__ __forceinline__ unsigned cvt_pk_bf16(float lo, float hi) { unsigned r; asm volatile("v_cvt_pk_bf16_f32 %0, %1, %2" : "=v"(r) : "v"(lo), "v"(hi)); return r; }
typedef float f32x2 __attribute__((ext_vector_type(2)));
template <class Epi, class Sched, bool ALIGN_EPI = false, bool SP2 = false, bool GATHER = false, bool F8 = false, int F8_SW = 0>
__device__ __forceinline__ void gemm_phase(PG8_LAS unsigned char* lds, const Gemm g, const Sched& S, const Epi& E, const int wave_id, const PG8_LAS int* gidx = nullptr) {
    static_assert(!GATHER || SP2, "GATHER is implemented for the SP2 loop only");
    int tid_ = wave_id * 64 + lane_id(); asm volatile("" : "+v"(tid_));
    const int tid = tid_, wid = __builtin_amdgcn_readfirstlane(tid >> 6), lane = tid & 63, wr = wid >> 2, wc = wid & 3, fr = lane & 15, fq = lane >> 4;
    const int K = g.K, nt = K / BK;
    unsigned voffA[2], voffB[2];
#pragma unroll
    for (int i = 0; i < 2; ++i) { int R, C; stage_rc(tid * 16 + i * 8192, R, C); const int Rb = Epi::PERM ? ((R & ~31) + perm32(R & 31)) : R;
        voffA[i] = (unsigned)(R * K + C) * 2u; voffB[i] = (unsigned)(Rb * K + C) * 2u; }
    unsigned goffA[2][2], goffN[2][2];
#define PG8_GOFF(dst, j) do { _Pragma("unroll") for (int _h = 0; _h < 2; ++_h) _Pragma("unroll") for (int _i = 0; _i < 2; ++_i) { int R_, C_; stage_rc(tid * 16 + _i * 8192, R_, C_); \
        dst[_h][_i] = ((unsigned)gidx[(j) * 256 + _h * 128 + R_] * (unsigned)K + (unsigned)C_) * 2u; } } while (0)
#define PG8_STAGE_A(bufoff, base, h, nx) do { if constexpr (GATHER) { unsigned o_[2] = {(nx) ? goffN[h][0] : goffA[h][0], (nx) ? goffN[h][1] : goffA[h][1]}; PG8_STAGE(bufoff, base, o_); } \
        else { PG8_STAGE(bufoff, (base) + ((h) ? hstep : 0), voffA); } } while (0)
    const size_t kstep = (size_t)(BK * 2);
    const size_t hstep = (size_t)HALF * K * 2;
    const size_t tstep = 2 * hstep;
    const unsigned ldsw = (unsigned)wid * 1024u;
    const int aoff = lds_byte(wr * 64 + fr, fq * 8), boff = lds_byte(wc * 32 + fr, fq * 8);
#define PG8_SA(b, h) (((b) * 2 + (h)) * HTB)
#define PG8_SB(b, h) ((4 + (b) * 2 + (h)) * HTB)
#define PG8_STAGE(bufoff, gbase, voff) do { _Pragma("unroll") for (int _i = 0; _i < 2; ++_i) \
        __builtin_amdgcn_global_load_lds((const unsigned*)((const char*)(gbase) + (voff)[_i]), (PG8_LAS unsigned*)(lds + (bufoff) + ldsw + _i * 8192), 16, 0, 0); } while (0)
#define PG8_LDA(dst, b, h) do { _Pragma("unroll") for (int m = 0; m < 4; ++m) _Pragma("unroll") for (int k = 0; k < 2; ++k) dst[m][k] = *(const PG8_LAS bf16x8*)(lds + PG8_SA(b, h) + aoff + m * 2048 + k * 1024); } while (0)
#define PG8_LDB(dst, b, h) do { _Pragma("unroll") for (int n = 0; n < 2; ++n) _Pragma("unroll") for (int k = 0; k < 2; ++k) dst[n][k] = *(const PG8_LAS bf16x8*)(lds + PG8_SB(b, h) + boff + n * 2048 + k * 1024); } while (0)
#define PG8_MMA(ai, bj, At, Bt) do { if constexpr (F8) __builtin_amdgcn_sched_barrier(0); __builtin_amdgcn_s_setprio(1); _Pragma("unroll") for (int m = 0; m < 4; ++m) _Pragma("unroll") for (int n = 0; n < 2; ++n) { \
        if constexpr (F8) { typedef int i32x4_ __attribute__((ext_vector_type(4))); typedef int i32x8_ __attribute__((ext_vector_type(8))); \
            const i32x8_ wf = __builtin_shufflevector(__builtin_bit_cast(i32x4_, Bt[n][0]), __builtin_bit_cast(i32x4_, Bt[n][1]), 0, 1, 2, 3, 4, 5, 6, 7); \
            const i32x8_ af = __builtin_shufflevector(__builtin_bit_cast(i32x4_, At[m][0]), __builtin_bit_cast(i32x4_, At[m][1]), 0, 1, 2, 3, 4, 5, 6, 7); \
              \
            asm volatile("v_mfma_scale_f32_16x16x128_f8f6f4 %0, %1, %2, %0, %3, %4 op_sel_hi:[0,0,0]" : "+v"(acc[ai][bj][m][n]) : "v"(wf), "v"(af), "v"(f8sw), "v"(f8sa)); } \
        else { _Pragma("unroll") for (int k = 0; k < 2; ++k) acc[ai][bj][m][n] = __builtin_amdgcn_mfma_f32_16x16x32_bf16(Bt[n][k], At[m][k], acc[ai][bj][m][n], 0, 0, 0); } } \
        __builtin_amdgcn_s_setprio(0); if constexpr (F8) __builtin_amdgcn_sched_barrier(0); } while (0)
#define PG8_WAIT_V(n) asm volatile("s_waitcnt vmcnt(" #n ")" ::: "memory")
#define PG8_WAIT_L(n) asm volatile("s_waitcnt lgkmcnt(" #n ")" ::: "memory")
#define PG8_BAR __builtin_amdgcn_s_barrier()
#define PG8_SCHED __builtin_amdgcn_sched_barrier(0)
    const int f8sw = 127 + F8_SW, f8sa = 127; (void)f8sw; (void)f8sa;
    Unit cur, nxt; int ui = 0;
    if (!S.next(0, cur)) return;
    f32x4 acc[2][2][4][2];
#pragma unroll
    for (int a = 0; a < 2; ++a)
#pragma unroll
        for (int b = 0; b < 2; ++b)
#pragma unroll
            for (int m = 0; m < 4; ++m)
#pragma unroll
                for (int n = 0; n < 2; ++n) acc[a][b][m][n] = (f32x4){0.f, 0.f, 0.f, 0.f};
    bf16x8 At[4][2], B0[2][2], B1[2][2];
    const char* cA = GATHER ? (const char*)g.A : (const char*)g.A + (size_t)cur.pm * tstep; const char* cB = (const char*)g.Bt + (size_t)cur.pn * tstep;
    if constexpr (GATHER) PG8_GOFF(goffA, 0);
    S.a_ready(cur);
    if constexpr (SP2) {
        PG8_STAGE(PG8_SB(0, 0), cB, voffB); PG8_STAGE(PG8_SB(0, 1), cB + hstep, voffB); PG8_STAGE_A(PG8_SA(0, 0), cA, 0, false); PG8_STAGE_A(PG8_SA(0, 1), cA, 1, false);
        if (wr == 1) PG8_BAR;
        PG8_WAIT_V(2); PG8_BAR;
        PG8_STAGE(PG8_SB(1, 0), cB + kstep, voffB); PG8_STAGE_A(PG8_SA(1, 0), cA + kstep, 0, false); PG8_STAGE(PG8_SB(1, 1), cB + hstep + kstep, voffB);
        PG8_WAIT_V(6); PG8_BAR;
    } else {
        PG8_STAGE(PG8_SB(0, 0), cB, voffB); PG8_STAGE(PG8_SA(0, 0), cA, voffA); PG8_STAGE(PG8_SB(0, 1), cB + hstep, voffB); PG8_STAGE(PG8_SA(0, 1), cA + hstep, voffA);
        if (wr == 1) PG8_BAR;
        PG8_WAIT_V(4); PG8_BAR;
        PG8_STAGE(PG8_SB(1, 0), cB + kstep, voffB); PG8_STAGE(PG8_SA(1, 0), cA + kstep, voffA); PG8_STAGE(PG8_SB(1, 1), cB + hstep + kstep, voffB);
        PG8_WAIT_V(6); PG8_BAR;
    }
    for (;;) {
        const bool has_next = S.next(ui + 1, nxt);
        if constexpr (GATHER) { if (has_next) PG8_GOFF(goffN, ui + 1); else { _Pragma("unroll") for (int _h = 0; _h < 2; ++_h) _Pragma("unroll") for (int _i = 0; _i < 2; ++_i) goffN[_h][_i] = goffA[_h][_i]; } }
        const char* nA = GATHER ? (const char*)g.A : has_next ? (const char*)g.A + (size_t)nxt.pm * tstep : cA; const char* nB = has_next ? (const char*)g.Bt + (size_t)nxt.pn * tstep : cB;
        for (int t = 0; t < nt; t += 2) {
            const bool last = (t == nt - 2);
            const char* a1 = cA + (size_t)(t + 1) * kstep;
            const char* a2 = last ? nA : cA + (size_t)(t + 2) * kstep; const char* b2 = last ? nB : cB + (size_t)(t + 2) * kstep;
            const char* a3 = a2 + kstep; const char* b3 = b2 + kstep;
            if (last && has_next) S.a_ready(nxt);
            if constexpr (SP2) {
            PG8_LDB(B0, 0, 0); PG8_LDB(B1, 0, 1); PG8_SCHED; PG8_LDA(At, 0, 0); PG8_STAGE_A(PG8_SA(1, 1), a1, 1, false);
            PG8_WAIT_V(8); PG8_WAIT_L(0); PG8_BAR; PG8_MMA(0, 0, At, B0); PG8_MMA(0, 1, At, B1); PG8_BAR; PG8_SCHED;
            PG8_LDA(At, 0, 1); PG8_STAGE(PG8_SB(0, 0), b2, voffB); PG8_STAGE(PG8_SB(0, 1), b2 + hstep, voffB); PG8_STAGE_A(PG8_SA(0, 0), a2, 0, last);
            PG8_WAIT_V(8); PG8_WAIT_L(0); PG8_BAR; PG8_MMA(1, 0, At, B0); PG8_MMA(1, 1, At, B1); PG8_BAR; PG8_SCHED;
            PG8_LDB(B0, 1, 0); PG8_LDB(B1, 1, 1); PG8_SCHED; PG8_LDA(At, 1, 0); PG8_STAGE_A(PG8_SA(0, 1), a2, 1, last);
            PG8_WAIT_V(8); PG8_WAIT_L(0); PG8_BAR; PG8_MMA(0, 0, At, B0); PG8_MMA(0, 1, At, B1); PG8_BAR; PG8_SCHED;
            PG8_LDA(At, 1, 1); PG8_STAGE(PG8_SB(1, 0), b3, voffB); PG8_STAGE(PG8_SB(1, 1), b3 + hstep, voffB); PG8_STAGE_A(PG8_SA(1, 0), a3, 0, last);
            PG8_WAIT_V(8); PG8_WAIT_L(0); PG8_BAR; PG8_MMA(1, 0, At, B0); PG8_MMA(1, 1, At, B1); PG8_BAR; PG8_SCHED;
            if constexpr (Epi::NSEG > 1) {
                constexpr int SEGT = F8 ? 4 : 8;
                if (t + 2 < nt && ((t + 2) & (SEGT - 1)) == 0) { if constexpr (F8) asm volatile("s_nop 15\n\ts_nop 15" ::: "memory"); E.rescale(acc, cur, (t + 2) / SEGT - 1, wr, wc, fr, fq); }
            }
            } else {
            PG8_LDB(B0, 0, 0); PG8_SCHED; PG8_LDA(At, 0, 0); PG8_STAGE(PG8_SA(1, 1), a1 + hstep, voffA);
            PG8_WAIT_L(8); PG8_BAR; PG8_WAIT_L(0); PG8_MMA(0, 0, At, B0); PG8_BAR; PG8_SCHED;
            PG8_LDB(B1, 0, 1); PG8_STAGE(PG8_SB(0, 0), b2, voffB);
            PG8_BAR; PG8_WAIT_L(0); PG8_MMA(0, 1, At, B1); PG8_BAR;
            PG8_LDA(At, 0, 1); PG8_STAGE(PG8_SA(0, 0), a2, voffA);
            PG8_BAR; PG8_WAIT_L(0); PG8_MMA(1, 0, At, B0); PG8_BAR; PG8_SCHED;
            PG8_STAGE(PG8_SB(0, 1), b2 + hstep, voffB);
            PG8_WAIT_V(6); PG8_BAR; PG8_MMA(1, 1, At, B1); PG8_BAR;
            PG8_LDB(B0, 1, 0); PG8_SCHED; PG8_LDA(At, 1, 0); PG8_STAGE(PG8_SA(0, 1), a2 + hstep, voffA);
            PG8_WAIT_L(8); PG8_BAR; PG8_WAIT_L(0); PG8_MMA(0, 0, At, B0); PG8_BAR; PG8_SCHED;
            PG8_LDB(B1, 1, 1); PG8_STAGE(PG8_SB(1, 0), b3, voffB);
            PG8_BAR; PG8_WAIT_L(0); PG8_MMA(0, 1, At, B1); PG8_BAR;
            PG8_LDA(At, 1, 1); PG8_STAGE(PG8_SA(1, 0), a3, voffA);
            PG8_BAR; PG8_WAIT_L(0); PG8_MMA(1, 0, At, B0); PG8_BAR; PG8_SCHED;
            PG8_STAGE(PG8_SB(1, 1), b3 + hstep, voffB);
            PG8_WAIT_V(6); PG8_BAR; PG8_MMA(1, 1, At, B1); PG8_BAR;
            }
        }
        if constexpr (ALIGN_EPI) { if (wr == 0) PG8_BAR; }
        if constexpr (F8) asm volatile("s_nop 15\n\ts_nop 15" ::: "memory");
        if constexpr (!Epi::AFTER_DRAIN) { E(acc, cur, wr, wc, fr, fq); S.done(cur); }
        if (!has_next) break;
#pragma unroll
        for (int a = 0; a < 2; ++a)
#pragma unroll
            for (int b = 0; b < 2; ++b)
#pragma unroll
                for (int m = 0; m < 4; ++m)
#pragma unroll
                    for (int n = 0; n < 2; ++n) acc[a][b][m][n] = (f32x4){0.f, 0.f, 0.f, 0.f};
        cur = nxt; cA = nA; cB = nB; ++ui;
        if constexpr (GATHER) { _Pragma("unroll") for (int _h = 0; _h < 2; ++_h) _Pragma("unroll") for (int _i = 0; _i < 2; ++_i) goffA[_h][_i] = goffN[_h][_i]; }
        if constexpr (ALIGN_EPI) { if (wr == 1) PG8_BAR; }
    }
    PG8_WAIT_V(0);
    if constexpr (!ALIGN_EPI) { if (wr == 0) PG8_BAR; }
    PG8_BAR;
    if constexpr (Epi::AFTER_DRAIN) { E.fused(acc, cur, wr, wc, fr, fq, lds, wid, lane); S.done(cur); }
#undef PG8_SA
#undef PG8_SB
#undef PG8_STAGE
#undef PG8_STAGE_A
#undef PG8_GOFF
#undef PG8_LDA
#undef PG8_LDB
#undef PG8_MMA
#undef PG8_WAIT_V
#undef PG8_WAIT_L
#undef PG8_BAR
#undef PG8_SCHED
}
}
#define XB_TMO      128
#define XB_XCNT(j)  (256  + 64 * (j))
#define XB_XSUB(j)  (1280 + 64 * (j))
#define XB_XGEN(j)  (2304 + 64 * (j))
#define XB_TOP      3328
#define XB_TOPGEN   3392
#define XCD_BAR_WORDS 3456
#define XB_SPIN_CAP (1u << 22)
#define LAS __attribute__((address_space(3)))

__device__ __forceinline__ unsigned xb_ld(unsigned* p)              { return __hip_atomic_load(p, __ATOMIC_RELAXED, __HIP_MEMORY_SCOPE_AGENT); }
__device__ __forceinline__ unsigned xb_add(unsigned* p, unsigned v) { asm volatile("" : "+v"(p));
    return __hip_atomic_fetch_add(p, v, __ATOMIC_RELAXED, __HIP_MEMORY_SCOPE_AGENT); }
__device__ __forceinline__ unsigned xb_xcc_id() { return (unsigned)__builtin_amdgcn_s_getreg((3 << 11) | 20) & 0xFu; }
#define XB_SPIN(cond, bar) do { unsigned _sp = 0; while (cond) { __builtin_amdgcn_s_sleep(1); \
    if ((++_sp & 255u) == 0u) { if (xb_ld(&(bar)[XB_TMO])) break; if (_sp > XB_SPIN_CAP) { xb_add(&(bar)[XB_TMO], 1u); break; } } } } while (0)

struct XcdBarrier {
    unsigned* bar; unsigned x; unsigned wv;
    volatile LAS unsigned* st;
};

__device__ __forceinline__ XcdBarrier xcd_barrier_post(unsigned* bar, volatile LAS unsigned* st) {
    XcdBarrier b; b.bar = bar; b.x = xb_xcc_id(); b.st = st;
    if (threadIdx.x == 0) (void)xb_add(&bar[XB_XCNT(b.x)], 1u);
    return b;
}
__device__ __forceinline__ void xcd_barrier_complete(unsigned* bar, unsigned x, unsigned& nloc, unsigned& nx) {
    const unsigned G = gridDim.x * gridDim.y * gridDim.z;
    unsigned sum, cnt, mine, sp = 0u;
    for (;;) {
        sum = 0u; cnt = 0u; mine = 0u;
#pragma unroll
        for (unsigned j = 0; j < 16; ++j) { const unsigned c = xb_ld(&bar[XB_XCNT(j)]); sum += c; cnt += (c > 0u) ? 1u : 0u; mine = (j == x) ? c : mine; }
        if (sum == G) break;
        __builtin_amdgcn_s_sleep(1);
        if ((++sp & 255u) == 0u) { if (xb_ld(&bar[XB_TMO])) break; if (sp > XB_SPIN_CAP) { xb_add(&bar[XB_TMO], 1u); break; } }
    }
    nloc = mine > 0u ? mine : 1u; nx = cnt > 0u ? cnt : 1u;
}

__device__ __forceinline__ void xcd_barrier(const XcdBarrier& b) {
    asm volatile("s_waitcnt vmcnt(0)" ::: "memory");
    __syncthreads();
    if (b.wv == 0u && lane_id() == 0) {
        unsigned* bar = b.bar;
        __builtin_amdgcn_s_waitcnt(0);
        unsigned nloc = b.st[0], nx = b.st[1];
        if (nloc == 0u) { xcd_barrier_complete(bar, b.x, nloc, nx); b.st[0] = nloc; b.st[1] = nx; }
        const unsigned old = xb_add(&bar[XB_XSUB(b.x)], 1u);
        const unsigned gen = old / nloc;
        if (old + 1u == (gen + 1u) * nloc) {
            __builtin_amdgcn_fence(__ATOMIC_RELEASE, "agent");
            asm volatile("s_waitcnt vmcnt(0)" ::: "memory");
            const unsigned og = xb_add(&bar[XB_TOP], 1u);
            const unsigned tg = og / nx;
            if (og + 1u == (tg + 1u) * nx) xb_add(&bar[XB_TOPGEN], 1u);
            else XB_SPIN(xb_ld(&bar[XB_TOPGEN]) == tg, bar);
            __builtin_amdgcn_fence(__ATOMIC_ACQUIRE, "agent");
            xb_add(&bar[XB_XGEN(b.x)], 1u);
            asm volatile("s_waitcnt vmcnt(0)" ::: "memory");
        } else {
            XB_SPIN(xb_ld(&bar[XB_XGEN(b.x)]) == gen, bar);
            __builtin_amdgcn_fence(__ATOMIC_ACQUIRE, "agent");
            asm volatile("s_waitcnt vmcnt(0)" ::: "memory");
        }
    }
    __syncthreads();
}

typedef unsigned short bf16_t;
typedef short bf16x8 __attribute__((ext_vector_type(8)));
typedef float f32x4 __attribute__((ext_vector_type(4)));
typedef float f32x16 __attribute__((ext_vector_type(16)));
typedef unsigned u32x4 __attribute__((ext_vector_type(4)));
typedef unsigned u32x2 __attribute__((ext_vector_type(2)));

constexpr int D = 1024, NB = 16, SEQ = 2048, CTX = 256, NL = 4;
constexpr int TL = NB * SEQ, TC = NB * CTX, TT = TL + TC;
constexpr int DIN = 6144, HYW = 512, NE = 16, DE = 512, KEYS = CTX + SEQ;
constexpr int NMOD = 6, NBM = NB + 1;
constexpr int APROWS = 2 * TT + NE * 256;
constexpr float EPS = 1e-6f, LOG2E = 1.4426950408889634f;
constexpr float QSCALE = 0.125f * LOG2E;

constexpr size_t MiB = 1u << 20;
constexpr size_t WS_CTL = 0, CTL_ZERO_BYTES = 1 * MiB;
constexpr size_t WS_MOD = 1 * MiB;
constexpr size_t WS_ROPE = 3 * MiB;
constexpr size_t WS_FL = 4 * MiB, WS_FC = 20 * MiB;
constexpr size_t WS_MISC = 22 * MiB;
constexpr size_t WS_FNORM = WS_MISC;
constexpr size_t WS_TOKE = WS_MISC + 64 * 1024, WS_TOKP = WS_MISC + 352 * 1024, WS_TOKW = WS_MISC + 640 * 1024;
constexpr size_t WS_ROWMAP = WS_MISC + 960 * 1024, WS_ROWW = WS_MISC + 1280 * 1024;
constexpr size_t WS_WIN = 24 * MiB, WS_WBR = 36 * MiB, WS_WOUT = 39 * MiB;
constexpr size_t WS_NP = 41 * MiB;
constexpr size_t WS_H = 57 * MiB;
constexpr size_t WS_KA = 129 * MiB, WS_VTA = 138 * MiB, WS_KW = 147 * MiB, WS_VTW = 156 * MiB;
constexpr size_t WS_QA = 165 * MiB, WS_QW = 201 * MiB, WS_YH = 237 * MiB, WS_VT = 273 * MiB, WS_YT = 309 * MiB;
constexpr size_t WS_RAWA = 309 * MiB, WS_RAWW = 327 * MiB;
constexpr size_t WS_F = 165 * MiB;
constexpr size_t WS_U = 345 * MiB;
constexpr size_t WS_G = 453 * MiB;
constexpr size_t WS_Y8 = 561 * MiB;
constexpr size_t WS_W13 = 615 * MiB, WS_W2 = 631 * MiB;
constexpr size_t WS_EROW = 30 * MiB, WS_EROWW = 33 * MiB;
constexpr size_t WS_H8 = 93 * MiB;
constexpr size_t WS_WG8 = WS_WIN;
constexpr size_t WS_XB = 639 * MiB;
constexpr size_t WS_END = 711 * MiB;
static_assert(WS_G + (size_t)TT * 3072 <= WS_Y8 && WS_Y8 + (size_t)TT * 1536 <= WS_W13 && WS_W13 + (size_t)16 * 1024 * 1024 <= WS_W2 && WS_W2 + (size_t)16 * 1024 * 512 <= WS_XB && WS_XB + (size_t)TT * 2048 <= WS_END && WS_H8 + (size_t)TT * 1024 <= WS_KA && WS_EROWW + (size_t)16 * TT * 4 <= WS_WBR, "ws map");
static_assert(WS_U + (size_t)APROWS * 1024 <= WS_G && WS_F + (size_t)2 * TT * 2048 <= WS_YT, "ws map 2");
constexpr size_t VT_CTX_OFF = (size_t)HYW * NB * SEQ;

constexpr int CW_BAR = 4096, CW_CNT = 8192, CW_PANEL = 16384, CW_HTMO = 12288;
constexpr int LDS_BYTES = 151552, MISC_OFF = 147456;
constexpr int NWAVES = 8, NTHR = 512;

struct Args { const float* in[29]; float* out; unsigned char* ws; int ph_lo, ph_hi; };
enum { I_X = 0, I_C, I_CTX, I_CCTX, I_ADAW, I_ADAB, I_N1G, I_N2G, I_WIN, I_QKG, I_HSW, I_HSB, I_HW1, I_HB1, I_HFR, I_HW2, I_HB2, I_HW3, I_HBIAS, I_SINK, I_WBR, I_WOUT,
       I_RGW, I_RGB, I_REW, I_REB, I_EW1, I_EW3, I_EW2 };

#define LDS_WAIT() asm volatile("s_waitcnt lgkmcnt(0)" ::: "memory")
#define VM_WAIT() asm volatile("s_waitcnt vmcnt(0)" ::: "memory")

typedef float f32x2_t __attribute__((ext_vector_type(2)));
typedef __bf16 bf16x2_t __attribute__((ext_vector_type(2)));
__device__ __forceinline__ unsigned cvtpk(float lo, float hi) { f32x2_t v = {lo, hi}; bf16x2_t b = __builtin_convertvector(v, bf16x2_t); return __builtin_bit_cast(unsigned, b); }
__device__ __forceinline__ unsigned zero_u32() { unsigned z; asm volatile("v_mov_b32 %0, 0" : "=v"(z)); return z; }
__device__ __forceinline__ float clamp_fp8(float x) { return __builtin_amdgcn_fmed3f(x, -448.f, 448.f); }
__device__ __forceinline__ unsigned cvt4_fp8(float a, float b, float c, float d) { int r = __builtin_amdgcn_cvt_pk_fp8_f32(a, b, 0, false); r = __builtin_amdgcn_cvt_pk_fp8_f32(c, d, r, true); return (unsigned)r; }
__device__ __forceinline__ unsigned cvt4_fp8c(float a, float b, float c, float d) { return cvt4_fp8(clamp_fp8(a), clamp_fp8(b), clamp_fp8(c), clamp_fp8(d)); }
__device__ __forceinline__ float bflo(unsigned u) { return __builtin_bit_cast(float, u << 16); }
__device__ __forceinline__ float bfhi(unsigned u) { return __builtin_bit_cast(float, u & 0xffff0000u); }
__device__ __forceinline__ float bf1(bf16_t u) { return __builtin_bit_cast(float, (unsigned)u << 16); }
__device__ __forceinline__ bf16_t f2bf(float f) { return (bf16_t)(cvtpk(f, 0.f) & 0xffffu); }
#define DPP_F(v, ctrl) __builtin_bit_cast(float, __builtin_amdgcn_update_dpp(0, __builtin_bit_cast(int, (v)), (ctrl), 0xf, 0xf, false))
__device__ __forceinline__ float row16_sum(float v) {
    v += DPP_F(v, 0xB1);
    v += DPP_F(v, 0x4E);
    v += DPP_F(v, 0x141);
    v += DPP_F(v, 0x140);
    return v;
}
__device__ __forceinline__ float wave_sum(float v) {
    v = row16_sum(v);
    const int iv = __builtin_bit_cast(int, v);
    float r = (__builtin_bit_cast(float, __builtin_amdgcn_readlane(iv, 0)) + __builtin_bit_cast(float, __builtin_amdgcn_readlane(iv, 16)))
            + (__builtin_bit_cast(float, __builtin_amdgcn_readlane(iv, 32)) + __builtin_bit_cast(float, __builtin_amdgcn_readlane(iv, 48)));
    asm volatile("" : "+v"(r));
    return r;
}
__device__ __forceinline__ float fast_exp2(float x) { return __builtin_amdgcn_exp2f(x); }
__device__ __forceinline__ float fast_rcp(float x) { return __builtin_amdgcn_rcpf(x); }
__device__ __forceinline__ float sigmoid_f(float x) { return fast_rcp(1.f + fast_exp2(-x * LOG2E)); }

__device__ __forceinline__ void sincos_acc(float x, float& s, float& c) {
    const float q = rintf(x * 0.636619772367581f);
    float y = fmaf(-q, 1.57079625129699707031f, x);
    y = fmaf(-q, 7.54978941586159635335e-08f, y);
    const float y2 = y * y;
    float sp = fmaf(y2, 2.7557314297e-06f, -1.9841270114e-04f); sp = fmaf(sp, y2, 8.3333337680e-03f); sp = fmaf(sp, y2, -1.6666667163e-01f); sp = fmaf(sp * y2, y, y);
    float cp = fmaf(y2, -2.7557314297e-07f, 2.4801587642e-05f); cp = fmaf(cp, y2, -1.3888889225e-03f); cp = fmaf(cp, y2, 4.1666667908e-02f); cp = fmaf(cp, y2, -0.5f); cp = fmaf(cp, y2, 1.0f);
    const int n = (int)q & 3;
    const float s1 = (n & 1) ? cp : sp, c1 = (n & 1) ? sp : cp;
    s = (n & 2) ? -s1 : s1;
    c = ((n + 1) & 2) ? -c1 : c1;
}

struct Fr { LAS unsigned char* lds; int tid, lane, wave, G, bid; };

__device__ __forceinline__ void pro_mod(const Fr& F, const Args& a) {
    LAS float* s = (LAS float*)F.lds;
    LAS float* red = (LAS float*)(F.lds + 69632);
    const float* c = a.in[I_C]; const float* cc = a.in[I_CCTX]; const float* W = a.in[I_ADAW]; const float* Bv = a.in[I_ADAB];
    float* MOD = (float*)(a.ws + WS_MOD);
    for (int i = F.tid; i < NBM * 1024; i += NTHR) { const int bb = i >> 10, k = i & 1023; const float v = (bb < NB) ? c[bb * 1024 + k] : cc[k]; s[i] = v / (1.f + __expf(-v)); }
    __syncthreads();
    const int col = F.tid & 63, ks = F.wave;
    for (int unit = F.G - 1 - F.bid; unit < NL * 96; unit += F.G) {
        const int l = unit / 96, j0 = (unit % 96) * 64;
        float acc[NBM];
#pragma unroll
        for (int bb = 0; bb < NBM; ++bb) acc[bb] = 0.f;
        const float* Wp = W + ((size_t)l * 1024 + ks * 128) * DIN + j0 + col;
#pragma unroll 2
        for (int k = 0; k < 128; k += 4) {
            const float w0 = Wp[(size_t)k * DIN], w1 = Wp[(size_t)(k + 1) * DIN], w2 = Wp[(size_t)(k + 2) * DIN], w3 = Wp[(size_t)(k + 3) * DIN];
#pragma unroll
            for (int bb = 0; bb < NBM; ++bb) { const f32x4 sv = *(const LAS f32x4*)(s + bb * 1024 + ks * 128 + k);
                acc[bb] = fmaf(sv.x, w0, acc[bb]); acc[bb] = fmaf(sv.y, w1, acc[bb]); acc[bb] = fmaf(sv.z, w2, acc[bb]); acc[bb] = fmaf(sv.w, w3, acc[bb]); } }
#pragma unroll
        for (int bb = 0; bb < NBM; ++bb) red[(ks * NBM + bb) * 64 + col] = acc[bb];
        __syncthreads();
        for (int o = F.tid; o < NBM * 64; o += NTHR) { const int bb = o >> 6, cx = o & 63; float sum = 0.f;
#pragma unroll
            for (int k2 = 0; k2 < 8; ++k2) sum += red[(k2 * NBM + bb) * 64 + cx];
            MOD[((size_t)l * NBM + bb) * DIN + j0 + cx] = sum + Bv[l * DIN + j0 + cx]; }
        __syncthreads();
    }
}

__device__ __forceinline__ void pro_rope(const Fr& F, const Args& a) {
    float* ct = (float*)(a.ws + WS_ROPE); float* st = ct + SEQ * 32;
    for (int i = F.bid * NTHR + F.tid; i < SEQ * 32; i += F.G * NTHR) {
        const int pos = i >> 5, ax = (i >> 4) & 1, f = i & 15;
        const float inv = exp2f(-(float)f * (13.287712379549449f / 16.f));
        const float ang = (float)(ax == 0 ? (pos >> 6) : (pos & 63)) * inv;
        float sv, cv; sincos_acc(ang, sv, cv); ct[i] = cv; st[i] = sv;
    }
}

__device__ __forceinline__ void pro_filter(const Fr& F, const Args& a) {
    LAS float* L = (LAS float*)F.lds;
    constexpr int oW1 = 0, oB1 = 2112, oFR = 2176, oB2 = 2240, oW2 = 2304, oZ = 6400, oH1 = 7552, oH2 = 9600, H2P = 68, oT = 11776, TP = 36;
    bf16_t* FL = (bf16_t*)(a.ws + WS_FL); bf16_t* FC = (bf16_t*)(a.ws + WS_FC); float* NP = (float*)(a.ws + WS_NP);
    const int p = F.tid >> 4, jj = F.tid & 15;
    for (int unit = F.bid; unit < NL * 72; unit += F.G) {
        const int l = unit / 72, ch = unit % 72; const bool lat = ch < 64; const int n = lat ? SEQ : CTX, pos0 = lat ? ch * 32 : (ch - 64) * 32;
        __syncthreads();
        for (int i = F.tid; i < 2112; i += NTHR) L[oW1 + i] = a.in[I_HW1][l * 2112 + i];
        for (int i = F.tid; i < 64; i += NTHR) { L[oB1 + i] = a.in[I_HB1][l * 64 + i]; L[oFR + i] = a.in[I_HFR][l * 64 + i]; L[oB2 + i] = a.in[I_HB2][l * 64 + i]; }
        for (int i = F.tid; i < 4096; i += NTHR) L[oW2 + i] = a.in[I_HW2][l * 4096 + i];
        const int pos = pos0 + p; const float t = (float)pos / (float)(n - 1);
        { const float band = 1e-4f + (float)jj * ((15.f - 1e-4f) / 15.f); const float ang = ((6.2831855f * band) * (float)pos) / (float)n;
          float sv, cv; sincos_acc(ang, sv, cv); L[oZ + p * 36 + 1 + jj] = cv; L[oZ + p * 36 + 17 + jj] = -sv; if (jj == 0) L[oZ + p * 36] = t; }
        __syncthreads();
        { f32x4 acc = *(const LAS f32x4*)(L + oB1 + 4 * jj);
#pragma unroll 3
          for (int i = 0; i < 33; ++i) { const float z = L[oZ + p * 36 + i]; const f32x4 w = *(const LAS f32x4*)(L + oW1 + i * 64 + 4 * jj); acc.x = fmaf(z, w.x, acc.x); acc.y = fmaf(z, w.y, acc.y); acc.z = fmaf(z, w.z, acc.z); acc.w = fmaf(z, w.w, acc.w); }
          const f32x4 fr = *(const LAS f32x4*)(L + oFR + 4 * jj); float sv, cv; f32x4 o;
          sincos_acc(fr.x * acc.x, sv, cv); o.x = sv; sincos_acc(fr.y * acc.y, sv, cv); o.y = sv; sincos_acc(fr.z * acc.z, sv, cv); o.z = sv; sincos_acc(fr.w * acc.w, sv, cv); o.w = sv;
          *(LAS f32x4*)(L + oH1 + p * 64 + 4 * jj) = o; }
        __syncthreads();
        { f32x4 acc = *(const LAS f32x4*)(L + oB2 + 4 * jj);
#pragma unroll 4
          for (int i = 0; i < 64; ++i) { const float z = L[oH1 + p * 64 + i]; const f32x4 w = *(const LAS f32x4*)(L + oW2 + i * 64 + 4 * jj); acc.x = fmaf(z, w.x, acc.x); acc.y = fmaf(z, w.y, acc.y); acc.z = fmaf(z, w.z, acc.z); acc.w = fmaf(z, w.w, acc.w); }
          const f32x4 fr = *(const LAS f32x4*)(L + oFR + 4 * jj); float sv, cv; f32x4 o;
          sincos_acc(fr.x * acc.x, sv, cv); o.x = sv; sincos_acc(fr.y * acc.y, sv, cv); o.y = sv; sincos_acc(fr.z * acc.z, sv, cv); o.z = sv; sincos_acc(fr.w * acc.w, sv, cv); o.w = sv;
          *(LAS f32x4*)(L + oH2 + p * H2P + 4 * jj) = o; }
        LAS bf16_t* T = (LAS bf16_t*)(L + oT);
        __syncthreads();
        {
            const int j16 = F.lane & 15, kq = F.lane >> 4;
            const float* W3p = a.in[I_HW3] + ((size_t)l * 64 + 4 * kq) * 1024 + 128 * F.wave + 4 * j16;
            f32x4 acc[2][4][2];
#pragma unroll
            for (int h = 0; h < 2; ++h)
#pragma unroll
                for (int cb = 0; cb < 4; ++cb)
#pragma unroll
                    for (int rb = 0; rb < 2; ++rb) acc[h][cb][rb] = (f32x4){0.f, 0.f, 0.f, 0.f};
            f32x4 bw[2][4][2];
#define PF_LDW(buf, s) do { _Pragma("unroll") for (int j = 0; j < 4; ++j) _Pragma("unroll") for (int h = 0; h < 2; ++h) bw[buf][j][h] = *(const f32x4*)(W3p + (size_t)(16 * (s) + j) * 1024 + 64 * h); } while (0)
            PF_LDW(0, 0);
#pragma unroll
            for (int s = 0; s < 4; ++s) {
                if (s + 1 < 4) PF_LDW((s + 1) & 1, s + 1);
                f32x4 av[2];
#pragma unroll
                for (int rb = 0; rb < 2; ++rb) av[rb] = *(const LAS f32x4*)(L + oH2 + (rb * 16 + j16) * H2P + 16 * s + 4 * kq);
#pragma unroll
                for (int j = 0; j < 4; ++j)
#pragma unroll
                    for (int h = 0; h < 2; ++h)
#pragma unroll
                        for (int cb = 0; cb < 4; ++cb)
#pragma unroll
                            for (int rb = 0; rb < 2; ++rb) acc[h][cb][rb] = __builtin_amdgcn_mfma_f32_16x16x4f32(av[rb][j], bw[s & 1][j][h][cb], acc[h][cb][rb], 0, 0, 0);
            }
#undef PF_LDW
            const int dir = F.wave >> 2;
            float tt[2][4];
#pragma unroll
            for (int rb = 0; rb < 2; ++rb)
#pragma unroll
                for (int r = 0; r < 4; ++r) tt[rb][r] = (float)(pos0 + rb * 16 + 4 * kq + r) / (float)(n - 1);
#pragma unroll
            for (int h = 0; h < 2; ++h)
#pragma unroll
                for (int cb = 0; cb < 4; ++cb) { const int col = 128 * F.wave + 64 * h + 4 * j16 + cb, c = col & 511;
                    const float dl = fabsf(-3.0701134573253943f + (-15.350567286626972f + 3.0701134573253943f) * ((float)c / 511.f));
#pragma unroll
                    for (int rb = 0; rb < 2; ++rb) { const int p0 = rb * 16 + 4 * kq; float v[4];
#pragma unroll
                        for (int r = 0; r < 4; ++r) { v[r] = acc[h][cb][rb][r] * __expf(-tt[rb][r] * dl); if (dir == 1 && pos0 + p0 + r == 0) v[r] = 0.f; }
                        u32x2 w;
                        if (dir == 0) { w.x = cvtpk(v[3], v[2]); w.y = cvtpk(v[1], v[0]); *(LAS u32x2*)(T + col * TP + 28 - p0) = w; }
                        else { w.x = cvtpk(v[0], v[1]); w.y = cvtpk(v[2], v[3]); *(LAS u32x2*)(T + col * TP + p0) = w; } } }
        }
        __syncthreads();
        for (int idx = F.tid; idx < 1024 * 32; idx += NTHR) { const int col = idx >> 5, i = idx & 31, dir = col >> 9, c = col & 511;
            const int u = (dir == 0) ? (n - 32 - pos0 + i) : ((pos0 + i == 0) ? 2 * n - 1 : n - 1 + pos0 + i);
            bf16_t* Fb = lat ? FL + ((size_t)l * 512 + c) * 4096 : FC + ((size_t)l * 512 + c) * 512;
            Fb[u] = T[col * TP + i]; }
        for (int col = F.tid; col < 1024; col += NTHR) { float sum = 0.f;
#pragma unroll 8
            for (int i = 0; i < 32; ++i) sum += fabsf(bf1(T[col * TP + i]));
            NP[((size_t)l * 72 + ch) * 1024 + col] = sum; }
    }
    __syncthreads();
}
__device__ __forceinline__ void filter_norm_reduce(const Fr& F, const Args& a) {
    const float* NP = (const float*)(a.ws + WS_NP); float* FN = (float*)(a.ws + WS_FNORM);
    for (int o = F.bid * NTHR + F.tid; o < NL * 2 * 512; o += F.G * NTHR) { const int l = o >> 10, isc = (o >> 9) & 1, c = o & 511;
        const int ch0 = isc ? 64 : 0, ch1 = isc ? 72 : 64; float sum = 0.f;
        for (int ch = ch0; ch < ch1; ++ch) sum += NP[((size_t)l * 72 + ch) * 1024 + c] + NP[((size_t)l * 72 + ch) * 1024 + 512 + c];
        FN[o] = 1.f / sum; }
}

template <int MODE>
__device__ __forceinline__ void transpose_item(const float* W, int K, int N, bf16_t* WT, int row_off, LAS float* scr, int item, int lane, int ldk = 0) {
    if (ldk == 0) ldk = K;
    const int nblk = N / 64, kb = item / nblk, nb = item % nblk, k0 = 64 * kb, n0 = 64 * nb;
    f32x4 v[16];
#pragma unroll
    for (int i = 0; i < 16; ++i) v[i] = *(const f32x4*)(W + (size_t)(k0 + 4 * i + (lane >> 4)) * N + n0 + (lane & 15) * 4);
#pragma unroll
    for (int i = 0; i < 16; ++i) *(LAS f32x4*)(scr + (4 * i + (lane >> 4)) * 68 + (lane & 15) * 4) = v[i];
    LDS_WAIT();
    const int c = lane & 7;
#pragma unroll
    for (int j = 0; j < 8; ++j) { const int n = (lane >> 3) + 8 * j; const LAS float* s = scr + (8 * c) * 68 + n;
        u32x4 o; o.x = cvtpk(s[0 * 68], s[1 * 68]); o.y = cvtpk(s[2 * 68], s[3 * 68]); o.z = cvtpk(s[4 * 68], s[5 * 68]); o.w = cvtpk(s[6 * 68], s[7 * 68]);
        const int nn = n0 + n; const int row = (MODE == 0) ? nn : ((nn >> 2) * 8 + (nn & 3) + (MODE == 2 ? 4 : 0));
        *(u32x4*)(WT + (size_t)(row_off + row) * ldk + k0 + 8 * c) = o; }
    LDS_WAIT();
}

template <int MODE>
__device__ __forceinline__ void transpose_item_f8(const float* W, int K, int N, unsigned char* WT, int row_off, LAS float* scr, int item, int lane, int ldk = 0) {
    if (ldk == 0) ldk = K;
    const int nblk = N / 64, kb = item / nblk, nb = item % nblk, k0 = 64 * kb, n0 = 64 * nb;
    f32x4 v[16];
#pragma unroll
    for (int i = 0; i < 16; ++i) v[i] = *(const f32x4*)(W + (size_t)(k0 + 4 * i + (lane >> 4)) * N + n0 + (lane & 15) * 4);
#pragma unroll
    for (int i = 0; i < 16; ++i) *(LAS f32x4*)(scr + (4 * i + (lane >> 4)) * 68 + (lane & 15) * 4) = v[i];
    LDS_WAIT();
    const int c = lane & 7;
#pragma unroll
    for (int j = 0; j < 8; ++j) { const int n = (lane >> 3) + 8 * j; const LAS float* s = scr + (8 * c) * 68 + n;
        u32x2 o; o.x = cvt4_fp8(s[0 * 68] * 64.f, s[1 * 68] * 64.f, s[2 * 68] * 64.f, s[3 * 68] * 64.f); o.y = cvt4_fp8(s[4 * 68] * 64.f, s[5 * 68] * 64.f, s[6 * 68] * 64.f, s[7 * 68] * 64.f);
        const int nn = n0 + n; const int row = (MODE == 0) ? nn : ((nn >> 2) * 8 + (nn & 3) + (MODE == 2 ? 4 : 0));
        *(u32x2*)(WT + (size_t)(row_off + row) * ldk + k0 + 8 * c) = o; }
    LDS_WAIT();
}
__device__ __forceinline__ void conv_small_weights(const Fr& F, const Args& a, int l, int mask, int b0) {
    if (F.bid < b0) return;
    LAS float* scr = (LAS float*)(F.lds + F.wave * 17408);
    const int gw = (F.bid - b0) * NWAVES + F.wave, NGW = (F.G - b0) * NWAVES;
    constexpr int I_IN = (1024 / 64) * (DIN / 64), I_BR = (512 / 64) * (1024 / 64), I_OUT = (1024 / 64) * (1024 / 64);
    if (mask & 1) for (int it = gw; it < I_IN; it += NGW) transpose_item_f8<0>(a.in[I_WIN] + (size_t)l * 1024 * DIN, 1024, DIN, a.ws + WS_WG8, 0, scr, it, F.lane);
    if (mask & 2) for (int it = gw; it < 3 * I_BR; it += NGW) { const int b = it / I_BR; transpose_item_f8<0>(a.in[I_WBR] + ((size_t)l * 3 + b) * 512 * 1024, 512, 1024, a.ws + WS_WBR + b * 512, 0, scr, it % I_BR, F.lane, 1536); }
    if (mask & 4) for (int it = gw; it < I_OUT; it += NGW) transpose_item_f8<0>(a.in[I_WOUT] + (size_t)l * 1024 * 1024, 1024, 1024, a.ws + WS_WOUT, 0, scr, it, F.lane);
}
__device__ __forceinline__ void conv_expert_weights(const Fr& F, const Args& a, int l, int b0, int it0, int it1) {
    if (F.bid < b0) return;
    LAS float* scr = (LAS float*)(F.lds + F.wave * 17408);
    const int gw = (F.bid - b0) * NWAVES + F.wave, NGW = (F.G - b0) * NWAVES;
    constexpr int I_1 = (1024 / 64) * (512 / 64), I_2 = (512 / 64) * (1024 / 64);
    for (int it = it0 + gw; it < it1; it += NGW) {
        const int e = it / (2 * I_1 + I_2); int r = it % (2 * I_1 + I_2);
        unsigned char* W13 = a.ws + WS_W13; unsigned char* W2 = a.ws + WS_W2;
        if (r < I_1) { transpose_item_f8<1>(a.in[I_EW1] + ((size_t)l * NE + e) * 1024 * 512, 1024, 512, W13, e * 1024, scr, r, F.lane); continue; } r -= I_1;
        if (r < I_1) { transpose_item_f8<2>(a.in[I_EW3] + ((size_t)l * NE + e) * 1024 * 512, 1024, 512, W13, e * 1024, scr, r, F.lane); continue; } r -= I_1;
        transpose_item_f8<0>(a.in[I_EW2] + ((size_t)l * NE + e) * 512 * 1024, 512, 1024, W2, e * 1024, scr, r, F.lane);
    }
}
constexpr int CONV_E_ITEMS = NE * 384, CONV_E_SPLIT = CONV_E_ITEMS / 2;

__device__ __forceinline__ int mod_row(int row) { return row < TL ? (row >> 11) : NB; }

__device__ __forceinline__ void rows_p0(const Fr& F, const Args& a, int l, int nrows) {
    const int gw = F.bid * NWAVES + F.wave, NGW = F.G * NWAVES;
    const float* g1 = a.in[I_N1G] + l * 1024;
    const float* MODl = (const float*)(a.ws + WS_MOD) + (size_t)l * NBM * DIN;
    const float* MODp = (const float*)(a.ws + WS_MOD) + (size_t)(l > 0 ? l - 1 : 0) * NBM * DIN;
    const bf16_t* Fs = (const bf16_t*)(a.ws + WS_F);
    unsigned char* H8 = a.ws + WS_H8; bf16_t* XB = (bf16_t*)(a.ws + WS_XB);
    const int per = 2 * ((nrows + 2 * NGW - 1) / (2 * NGW)), w0 = gw * per, w1 = (w0 + per < nrows) ? w0 + per : nrows;
    f32x4 gv[4], shv[4], scv[4], m5v[4]; int cur = -1;
#pragma unroll
    for (int j = 0; j < 4; ++j) { gv[j] = *(const f32x4*)(g1 + F.lane * 4 + 256 * j); shv[j] = gv[j]; scv[j] = gv[j]; m5v[j] = gv[j]; }
#define P0_LOAD(rb, V, F0, F1) do { _Pragma("unroll") for (int q = 0; q < 2; ++q) { const int row = (rb) + q; const bool lat = row < TL; \
            const float* xs = lat ? a.in[I_X] + (size_t)row * D : a.in[I_CTX] + (size_t)(row - TL) * D; \
            _Pragma("unroll") for (int j = 0; j < 4; ++j) { const int col = F.lane * 4 + 256 * j; \
                if (l == 0) V[q][j] = *(const u32x4*)(xs + col); \
                else { const u32x2 t_ = *(const u32x2*)(XB + (size_t)row * D + col); V[q][j].x = t_.x; V[q][j].y = t_.y; \
                    F0[q][j] = *(const u32x2*)(Fs + (size_t)row * D + col); F1[q][j] = *(const u32x2*)(Fs + ((size_t)TT + row) * D + col); } } } } while (0)
#define P0_PROC(rb, V, F0, F1) do { _Pragma("unroll") for (int q = 0; q < 2; ++q) { const int row = (rb) + q; const int mr = mod_row(row); \
            if (mr != cur) { cur = mr; _Pragma("unroll") for (int j = 0; j < 4; ++j) { const int col = F.lane * 4 + 256 * j; \
                shv[j] = *(const f32x4*)(MODl + (size_t)mr * DIN + col); scv[j] = *(const f32x4*)(MODl + (size_t)mr * DIN + 1024 + col); m5v[j] = *(const f32x4*)(MODp + (size_t)mr * DIN + 5 * 1024 + col); } } \
            float ss = 0.f; f32x4 X[4]; \
            _Pragma("unroll") for (int j = 0; j < 4; ++j) { const u32x4 w_ = V[q][j]; \
                if (l == 0) X[j] = __builtin_bit_cast(f32x4, w_); \
                else { X[j].x = bflo(w_.x) + m5v[j].x * (bflo(F0[q][j].x) + bflo(F1[q][j].x)); X[j].y = bfhi(w_.x) + m5v[j].y * (bfhi(F0[q][j].x) + bfhi(F1[q][j].x)); \
                       X[j].z = bflo(w_.y) + m5v[j].z * (bflo(F0[q][j].y) + bflo(F1[q][j].y)); X[j].w = bfhi(w_.y) + m5v[j].w * (bfhi(F0[q][j].y) + bfhi(F1[q][j].y)); } } \
            _Pragma("unroll") for (int j = 0; j < 4; ++j) { const int col = F.lane * 4 + 256 * j; u32x2 xw_; xw_.x = cvtpk(X[j].x, X[j].y); xw_.y = cvtpk(X[j].z, X[j].w); \
                *(u32x2*)(XB + (size_t)row * D + col) = xw_; } \
            _Pragma("unroll") for (int j = 0; j < 4; ++j) ss += (X[j].x * X[j].x + X[j].y * X[j].y) + (X[j].z * X[j].z + X[j].w * X[j].w); \
            const float r = 1.f / sqrtf(wave_sum(ss) * (1.f / D) + EPS); \
            _Pragma("unroll") for (int j = 0; j < 4; ++j) { const int col = F.lane * 4 + 256 * j; \
                const f32x4 o = (X[j] * r * gv[j]) * (scv[j] + 1.f) + shv[j]; \
                *(unsigned*)(H8 + (size_t)row * D + col) = cvt4_fp8(o.x, o.y, o.z, o.w); } } } while (0)
    u32x4 vA[2][4], vB[2][4]; u32x2 fA0[2][4], fA1[2][4], fB0[2][4], fB1[2][4];
    if (w0 < w1) P0_LOAD(w0, vA, fA0, fA1);
    for (int rb = w0; rb < w1; rb += 4) {
        if (rb + 2 < w1) P0_LOAD(rb + 2, vB, fB0, fB1);
        P0_PROC(rb, vA, fA0, fA1);
        if (rb + 2 < w1) { if (rb + 4 < w1) P0_LOAD(rb + 4, vA, fA0, fA1); P0_PROC(rb + 2, vB, fB0, fB1); }
    }
#undef P0_LOAD
#undef P0_PROC
}
__device__ __forceinline__ void rows_final(const Fr& F, const Args& a) {
    const int gw = F.bid * NWAVES + F.wave, NGW = F.G * NWAVES;
    const float* MODp = (const float*)(a.ws + WS_MOD) + (size_t)(NL - 1) * NBM * DIN;
    const bf16_t* Fs = (const bf16_t*)(a.ws + WS_F);
    const bf16_t* XB = (const bf16_t*)(a.ws + WS_XB);
    for (int row = gw; row < TL; row += NGW) {
        const int mr = row >> 11; float* xd = a.out + (size_t)row * D;
#pragma unroll
        for (int j = 0; j < 4; ++j) { const int col = F.lane * 4 + 256 * j;
            const u32x2 xw = *(const u32x2*)(XB + (size_t)row * D + col);
            const u32x2 f0 = *(const u32x2*)(Fs + (size_t)row * D + col), f1 = *(const u32x2*)(Fs + ((size_t)TT + row) * D + col);
            const f32x4 m5 = *(const f32x4*)(MODp + (size_t)mr * DIN + 5 * 1024 + col);
            f32x4 v; v.x = bflo(xw.x) + m5.x * (bflo(f0.x) + bflo(f1.x)); v.y = bfhi(xw.x) + m5.y * (bfhi(f0.x) + bfhi(f1.x)); v.z = bflo(xw.y) + m5.z * (bflo(f0.y) + bflo(f1.y)); v.w = bfhi(xw.y) + m5.w * (bfhi(f0.y) + bfhi(f1.y));
            *(f32x4*)(xd + col) = v; }
    }
}

__device__ __forceinline__ void rows_p5(const Fr& F, const Args& a, int l, int nrows, unsigned long long& sacc, const int swhich) {
#if defined(PROBE_P)
    unsigned long long st0 = __builtin_amdgcn_s_memrealtime();
#define SUBMARK5(w) do { const unsigned long long t_ = __builtin_amdgcn_s_memrealtime(); if (swhich == (w)) sacc += t_ - st0; st0 = t_; } while (0)
#else
#define SUBMARK5(w) do { } while (0)
#endif
    typedef float f32x4v __attribute__((ext_vector_type(4)));
    LAS float* RW = (LAS float*)F.lds;
    constexpr int RWS = 1028;
    LAS float* RB = (LAS float*)(F.lds + 82304);
    LAS int* LC = (LAS int*)(F.lds + 82432);
    LAS int* TE = (LAS int*)(F.lds + 82560);
    LAS int* TP = TE + 256;
    LAS float* TW = (LAS float*)(TP + 256);
    LAS float* RN = (LAS float*)(F.lds + 86784);
    LAS float* LG = (LAS float*)(F.lds + 87424);
    LAS float* GM = (LAS float*)(F.lds + 99072);
    LAS float* BI = (LAS float*)(F.lds + 107264);
    const float* g2 = a.in[I_N2G] + l * 1024;
    const float* MODl = (const float*)(a.ws + WS_MOD) + (size_t)l * NBM * DIN;
    unsigned char* H8 = a.ws + WS_H;
    const bf16_t* XB = (const bf16_t*)(a.ws + WS_XB);
    int* EROW = (int*)(a.ws + WS_EROW); float* EROWW = (float*)(a.ws + WS_EROWW);
    unsigned* CNT = (unsigned*)(a.ws + WS_CTL) + CW_CNT + l * 256;
    for (int f = F.tid; f < 1024; f += NTHR) { const f32x4 v = *(const f32x4*)(a.in[I_RGW] + ((size_t)l * 1024 + f) * 4);
        RW[0 * RWS + f] = v.x; RW[1 * RWS + f] = v.y; RW[2 * RWS + f] = v.z; RW[3 * RWS + f] = v.w; }
    for (int f = F.tid; f < 4096; f += NTHR) { const int k = f >> 2, c4 = (f & 3) * 4; const f32x4 v = *(const f32x4*)(a.in[I_REW] + ((size_t)l * 1024 + k) * 16 + c4);
        RW[(4 + c4) * RWS + k] = v.x; RW[(5 + c4) * RWS + k] = v.y; RW[(6 + c4) * RWS + k] = v.z; RW[(7 + c4) * RWS + k] = v.w; }
    if (F.tid < 20) RB[F.tid] = (F.tid < 4) ? a.in[I_RGB][l * 4 + F.tid] : a.in[I_REB][l * 16 + F.tid - 4];
    constexpr int P5_CH = 144;
    const int nch = (nrows + P5_CH - 1) / P5_CH;
    SUBMARK5(40);
    for (int ch = F.bid; ch < nch; ch += F.G) {
    const int r0 = ch * P5_CH, r1 = (r0 + P5_CH < nrows) ? r0 + P5_CH : nrows;
    const int mb0 = mod_row(r0), mb1 = mod_row(r1 - 1);
    if (F.tid < 32) LC[F.tid] = 0;
    for (int i = F.tid; i < 2048; i += NTHR) { const int s = i >> 10, k = i & 1023; GM[i] = g2[k] * (1.f + MODl[(size_t)(s ? mb1 : mb0) * DIN + 4 * 1024 + k]); }
    __syncthreads();
    if (F.wave < 4) {
    for (int rowb = r0 + 2 * F.wave; rowb < r1; rowb += 2 * 4) {
        f32x4 v[2][4]; bool val[2];
#pragma unroll
        for (int q = 0; q < 2; ++q) { const int row = rowb + q; val[q] = row < r1; const int rr = val[q] ? row : rowb;
            u32x2 xw[4];
#pragma unroll
            for (int j = 0; j < 4; ++j) xw[j] = *(const u32x2*)(XB + (size_t)rr * D + F.lane * 4 + 256 * j);
#pragma unroll
            for (int j = 0; j < 4; ++j) { v[q][j].x = bflo(xw[j].x); v[q][j].y = bfhi(xw[j].x); v[q][j].z = bflo(xw[j].y); v[q][j].w = bfhi(xw[j].y); } }
#pragma unroll
        for (int q = 0; q < 2; ++q) { const int rr = val[q] ? rowb + q : rowb; const int mr = mod_row(rr); float ss = 0.f;
#pragma unroll
            for (int j = 0; j < 4; ++j) ss += (v[q][j].x * v[q][j].x + v[q][j].y * v[q][j].y) + (v[q][j].z * v[q][j].z + v[q][j].w * v[q][j].w);
            const float r = 1.f / sqrtf(wave_sum(ss) * (1.f / D) + EPS);
            if (F.lane == 0 && val[q]) RN[rr - r0] = r;
#pragma unroll
            for (int j = 0; j < 4; ++j) { const int col = F.lane * 4 + 256 * j;
                const f32x4 g = *(const f32x4*)(g2 + col), sh = *(const f32x4*)(MODl + (size_t)mr * DIN + 3 * 1024 + col), sc = *(const f32x4*)(MODl + (size_t)mr * DIN + 4 * 1024 + col);
                const f32x4 t = (v[q][j] * r * g) * (sc + 1.f) + sh;
                if (val[q]) *(unsigned*)(H8 + (size_t)rr * D + col) = cvt4_fp8(t.x, t.y, t.z, t.w); } }
    }
    } else {
    if (F.wave < 6) { const int sl = F.wave - 4; const int mb = sl ? mb1 : mb0; f32x4 sh[4];
#pragma unroll
        for (int j = 0; j < 4; ++j) sh[j] = *(const f32x4*)(MODl + (size_t)mb * DIN + 3 * 1024 + F.lane * 4 + 256 * j);
#pragma unroll 4
        for (int cidx = 0; cidx < 20; ++cidx) { float p = 0.f;
#pragma unroll
            for (int j = 0; j < 4; ++j) { const f32x4 w = *(const LAS f32x4*)(RW + cidx * RWS + F.lane * 4 + 256 * j);
                p = fmaf(sh[j].x, w.x, p); p = fmaf(sh[j].y, w.y, p); p = fmaf(sh[j].z, w.z, p); p = fmaf(sh[j].w, w.w, p); }
            const float tot = wave_sum(p) + RB[cidx]; if (F.lane == 0) BI[sl * 20 + cidx] = tot; } }
    { const int i16 = F.lane & 15, kq = F.lane >> 4; const int ngrp = (r1 - r0 + 15) >> 4;
      for (int gi = F.wave - 4; gi < ngrp; gi += 4) {
        const int grow = r0 + 16 * gi; const int rowi = (grow + i16 < r1) ? grow + i16 : r1 - 1;
        const bf16_t* xs = XB + (size_t)rowi * D + 4 * kq;
        const int slot = (mod_row(grow) == mb0) ? 0 : 1;
        const LAS float* gmp = GM + slot * 1024 + 4 * kq; const LAS float* w0p = RW + i16 * RWS + 4 * kq; const LAS float* w1p = RW + (16 + (i16 & 3)) * RWS + 4 * kq;
        const float m1 = (i16 < 4) ? 1.f : 0.f;
        f32x4v acc0 = {0.f, 0.f, 0.f, 0.f}, acc1 = {0.f, 0.f, 0.f, 0.f};
#pragma unroll 16
        for (int s = 0; s < 64; ++s) {
            const u32x2 xw = *(const u32x2*)(xs + 16 * s); const f32x4 gv = *(const LAS f32x4*)(gmp + 16 * s);
            const f32x4 wa = *(const LAS f32x4*)(w0p + 16 * s), wb = *(const LAS f32x4*)(w1p + 16 * s);
            const f32x4 ba = wa * gv, bb = wb * gv * m1;
            acc0 = __builtin_amdgcn_mfma_f32_16x16x4f32(bflo(xw.x), ba.x, acc0, 0, 0, 0); acc1 = __builtin_amdgcn_mfma_f32_16x16x4f32(bflo(xw.x), bb.x, acc1, 0, 0, 0);
            acc0 = __builtin_amdgcn_mfma_f32_16x16x4f32(bfhi(xw.x), ba.y, acc0, 0, 0, 0); acc1 = __builtin_amdgcn_mfma_f32_16x16x4f32(bfhi(xw.x), bb.y, acc1, 0, 0, 0);
            acc0 = __builtin_amdgcn_mfma_f32_16x16x4f32(bflo(xw.y), ba.z, acc0, 0, 0, 0); acc1 = __builtin_amdgcn_mfma_f32_16x16x4f32(bflo(xw.y), bb.z, acc1, 0, 0, 0);
            acc0 = __builtin_amdgcn_mfma_f32_16x16x4f32(bfhi(xw.y), ba.w, acc0, 0, 0, 0); acc1 = __builtin_amdgcn_mfma_f32_16x16x4f32(bfhi(xw.y), bb.w, acc1, 0, 0, 0);
        }
#pragma unroll
        for (int rg = 0; rg < 4; ++rg) { const int lr = 16 * gi + 4 * kq + rg;
            if (r0 + lr < r1) { LG[lr * 20 + i16] = acc0[rg]; if (i16 < 4) LG[lr * 20 + 16 + i16] = acc1[rg]; } }
      } }
    }
    __syncthreads();
    SUBMARK5(42);
    for (int lr = F.tid; lr < r1 - r0; lr += NTHR) {
        float lg[20]; { const float rn = RN[lr]; const int sl = (mod_row(r0 + lr) == mb0) ? 0 : 1;
#pragma unroll
          for (int i = 0; i < 20; ++i) lg[i] = rn * LG[lr * 20 + i] + BI[sl * 20 + i]; }
        int gs = 0; float gmx = lg[0];
#pragma unroll
        for (int i = 1; i < 4; ++i) if (lg[i] > gmx) { gmx = lg[i]; gs = i; }
        float gsum = 0.f;
#pragma unroll
        for (int i = 0; i < 4; ++i) gsum += __expf(lg[i] - gmx);
        const float pg = 1.f / gsum;
        float le[4];
#pragma unroll
        for (int i = 0; i < 4; ++i) le[i] = (gs == 0) ? lg[4 + i] : (gs == 1) ? lg[8 + i] : (gs == 2) ? lg[12 + i] : lg[16 + i];
        int i0 = 0; float v0 = le[0];
#pragma unroll
        for (int i = 1; i < 4; ++i) if (le[i] > v0) { v0 = le[i]; i0 = i; }
        int i1 = -1; float v1 = -3.4e38f;
#pragma unroll
        for (int i = 0; i < 4; ++i) if (i != i0 && le[i] > v1) { v1 = le[i]; i1 = i; }
        const float e1 = __expf(v1 - v0), den = 1.f / (1.f + e1);
        const int ex0 = gs * 4 + i0, ex1 = gs * 4 + i1;
        const int lp0 = __hip_atomic_fetch_add(&LC[ex0], 1, __ATOMIC_RELAXED, __HIP_MEMORY_SCOPE_WORKGROUP), lp1 = __hip_atomic_fetch_add(&LC[ex1], 1, __ATOMIC_RELAXED, __HIP_MEMORY_SCOPE_WORKGROUP);
        TE[lr] = ex0 | (ex1 << 8); TP[lr] = lp0 | (lp1 << 16); TW[2 * lr] = den * pg; TW[2 * lr + 1] = e1 * den * pg;
    }
    __syncthreads();
    if (F.tid < NE) LC[16 + F.tid] = (int)atomicAdd(&CNT[F.tid * 16], (unsigned)LC[F.tid]);
    __syncthreads();
    for (int lr = F.tid; lr < r1 - r0; lr += NTHR) {
        const int te = TE[lr], tp = TP[lr], ex0 = te & 255, ex1 = te >> 8, row = r0 + lr;
        const int gp0 = LC[16 + ex0] + (tp & 0xffff), gp1 = LC[16 + ex1] + (tp >> 16);
        EROW[(size_t)ex0 * TT + gp0] = row * 2; EROWW[(size_t)ex0 * TT + gp0] = TW[2 * lr];
        EROW[(size_t)ex1 * TT + gp1] = row * 2 + 1; EROWW[(size_t)ex1 * TT + gp1] = TW[2 * lr + 1];
    }
    __syncthreads();
    SUBMARK5(43);
    }
    __syncthreads();
#undef SUBMARK5
}

__device__ __forceinline__ void normrope8(float (&x)[8], const float* g64, bool rope, int pos, const float* ct, const float* st, float scale, int lane) {
    float ss = 0.f;
#pragma unroll
    for (int i = 0; i < 8; ++i) ss += x[i] * x[i];
    ss += DPP_F(ss, 0xB1); ss += DPP_F(ss, 0x4E); ss += DPP_F(ss, 0x141);
    const float r = 1.f / sqrtf(ss * (1.f / 64.f) + EPS);
    const int ch = lane & 7;
    const f32x4 g0 = *(const f32x4*)(g64 + 8 * ch), g1 = *(const f32x4*)(g64 + 8 * ch + 4);
    x[0] *= r * g0.x; x[1] *= r * g0.y; x[2] *= r * g0.z; x[3] *= r * g0.w; x[4] *= r * g1.x; x[5] *= r * g1.y; x[6] *= r * g1.z; x[7] *= r * g1.w;
    if (rope) {
        const int ax = ch >> 2, half = (ch >> 1) & 1, f0 = 8 * (ch & 1);
        const f32x4 c0 = *(const f32x4*)(ct + pos * 32 + ax * 16 + f0), c1 = *(const f32x4*)(ct + pos * 32 + ax * 16 + f0 + 4);
        const f32x4 s0 = *(const f32x4*)(st + pos * 32 + ax * 16 + f0), s1 = *(const f32x4*)(st + pos * 32 + ax * 16 + f0 + 4);
        const float cs[8] = {c0.x, c0.y, c0.z, c0.w, c1.x, c1.y, c1.z, c1.w}, sn[8] = {s0.x, s0.y, s0.z, s0.w, s1.x, s1.y, s1.z, s1.w};
#pragma unroll
        for (int i = 0; i < 8; ++i) { const float p = DPP_F(x[i], 0x4E);
            x[i] = half ? (x[i] * cs[i] + p * sn[i]) : (x[i] * cs[i] - p * sn[i]); }
    }
#pragma unroll
    for (int i = 0; i < 8; ++i) x[i] *= scale;
}
__device__ __forceinline__ void unpack8(const u32x4 w, float (&x)[8]) { x[0] = bflo(w.x); x[1] = bfhi(w.x); x[2] = bflo(w.y); x[3] = bfhi(w.y); x[4] = bflo(w.z); x[5] = bfhi(w.z); x[6] = bflo(w.w); x[7] = bfhi(w.w); }
__device__ __forceinline__ u32x4 pack8(const float (&x)[8]) { u32x4 w; w.x = cvtpk(x[0], x[1]); w.y = cvtpk(x[2], x[3]); w.z = cvtpk(x[4], x[5]); w.w = cvtpk(x[6], x[7]); return w; }

__device__ __forceinline__ void prep_phase(const Fr& F, const Args& a, int l, bool with_ctx) {
    constexpr int VROW = 272;
    LAS unsigned char* VA_l = F.lds;
    LAS unsigned char* VW_l = F.lds + 17408;
    LAS unsigned char* HT_l = F.lds + 34816;
    constexpr int HROW = 144;
    const float* ct = (const float*)(a.ws + WS_ROPE); const float* st = ct + SEQ * 32;
    const float* qkg = a.in[I_QKG] + l * 256;
    const bf16_t* RAWA = (const bf16_t*)(a.ws + WS_RAWA); const bf16_t* RAWW = (const bf16_t*)(a.ws + WS_RAWW);
    bf16_t* KA = (bf16_t*)(a.ws + WS_KA); bf16_t* KW = (bf16_t*)(a.ws + WS_KW); bf16_t* VTA = (bf16_t*)(a.ws + WS_VTA); bf16_t* VTW = (bf16_t*)(a.ws + WS_VTW);
    const bf16_t* U = (const bf16_t*)(a.ws + WS_U); bf16_t* X0 = (bf16_t*)(a.ws + WS_H); bf16_t* VT = (bf16_t*)(a.ws + WS_VT);
    const float* hsw = a.in[I_HSW] + l * 3 * 1536; const float* hsb = a.in[I_HSB] + l * 1536;
    for (int unit = F.bid; unit < NB * 36; unit += F.G) {
        const bool lat = unit < NB * 32;
        const int b = lat ? unit >> 5 : (unit - NB * 32) >> 2, p0 = lat ? (unit & 31) * 64 : ((unit - NB * 32) & 3) * 64;
        const int n = lat ? SEQ : CTX;
        const int row0 = lat ? b * SEQ + p0 : TL + b * CTX + p0;
        const int j0 = lat ? CTX + p0 : p0;
        __syncthreads();
        {
            const bool isw = (F.lane & 16) != 0; const int l16 = F.lane & 15, half = F.lane >> 5;
            u32x4 kw[4];
#pragma unroll
            for (int ps = 0; ps < 4; ++ps) { const int tk = 8 * F.wave + 2 * ps + half; kw[ps] = *(const u32x4*)((isw ? RAWW : RAWA) + (size_t)(row0 + tk) * 256 + l16 * 8); }
#pragma unroll
            for (int ps = 0; ps < 4; ++ps) { const int tk = 8 * F.wave + 2 * ps + half; float x[8]; unpack8(kw[ps], x);
                normrope8(x, qkg + (isw ? 192 : 64), lat, p0 + tk, ct, st, 1.f, F.lane);
                *(u32x4*)((isw ? KW : KA) + ((size_t)b * KEYS + j0 + tk) * 128 + l16 * 8) = pack8(x); }
        }
        for (int i = F.tid; i < 2 * 64 * 16; i += NTHR) { const int m = i >> 10, r = (i >> 4) & 63, cch = i & 15;
            const u32x4 w = *(const u32x4*)((m ? RAWW : RAWA) + (size_t)(row0 + r) * 256 + 128 + cch * 8);
            *(LAS u32x4*)((m ? VW_l : VA_l) + r * VROW + cch * 16) = w; }
        const bool do_hy = lat || with_ctx;
        if (do_hy) {
            int tq_ = F.tid; asm volatile("" : "+v"(tq_));
            const int cg = tq_ & 63, c = 8 * cg, t0 = 8 * F.wave;
            u32x4 x1p[8];
#pragma unroll
            for (int g = 0; g < 3; ++g) {
                const int ch = g * 512 + c;
                float w0[8], w1[8], w2[8], bb[8];
                { const f32x4 a0 = *(const f32x4*)(hsw + ch), a1 = *(const f32x4*)(hsw + ch + 4), b0 = *(const f32x4*)(hsw + 1536 + ch), b1 = *(const f32x4*)(hsw + 1536 + ch + 4),
                              c0 = *(const f32x4*)(hsw + 3072 + ch), c1 = *(const f32x4*)(hsw + 3072 + ch + 4), d0 = *(const f32x4*)(hsb + ch), d1 = *(const f32x4*)(hsb + ch + 4);
                  w0[0] = a0.x; w0[1] = a0.y; w0[2] = a0.z; w0[3] = a0.w; w0[4] = a1.x; w0[5] = a1.y; w0[6] = a1.z; w0[7] = a1.w;
                  w1[0] = b0.x; w1[1] = b0.y; w1[2] = b0.z; w1[3] = b0.w; w1[4] = b1.x; w1[5] = b1.y; w1[6] = b1.z; w1[7] = b1.w;
                  w2[0] = c0.x; w2[1] = c0.y; w2[2] = c0.z; w2[3] = c0.w; w2[4] = c1.x; w2[5] = c1.y; w2[6] = c1.z; w2[7] = c1.w;
                  bb[0] = d0.x; bb[1] = d0.y; bb[2] = d0.z; bb[3] = d0.w; bb[4] = d1.x; bb[5] = d1.y; bb[6] = d1.z; bb[7] = d1.w; }
                u32x4 raw[10];
#pragma unroll
                for (int i = 0; i < 10; ++i) { const int pos = p0 + t0 - 1 + i;
                    if (pos < 0 || pos >= n) { const unsigned z = zero_u32(); raw[i] = (u32x4){z, z, z, z}; } else raw[i] = *(const u32x4*)(U + (size_t)(row0 - p0 + pos) * 1536 + ch); }
#pragma unroll
                for (int t = 0; t < 8; ++t) { float up[8], uc[8], un[8], o[8]; unpack8(raw[t], up); unpack8(raw[t + 1], uc); unpack8(raw[t + 2], un);
#pragma unroll
                    for (int i = 0; i < 8; ++i) o[i] = fmaf(w0[i], up[i], fmaf(w1[i], uc[i], fmaf(w2[i], un[i], bb[i])));
                    if (g == 0) *(u32x4*)(X0 + (size_t)(row0 + t0 + t) * 512 + c) = pack8(o);
                    else if (g == 1) x1p[t] = pack8(o);
                    else { float x1[8]; unpack8(x1p[t], x1);
#pragma unroll
                        for (int i = 0; i < 8; ++i) o[i] *= x1[i];
                        x1p[t] = pack8(o); } }
            }
#pragma unroll
            for (int i = 0; i < 8; ++i) { unsigned short ev[8];
#pragma unroll
                for (int t = 0; t < 8; ++t) { const unsigned wsel = (i >> 1) == 0 ? x1p[t].x : (i >> 1) == 1 ? x1p[t].y : (i >> 1) == 2 ? x1p[t].z : x1p[t].w; ev[t] = (unsigned short)((i & 1) ? (wsel >> 16) : (wsel & 0xffffu)); }
                u32x4 w; w.x = ev[0] | ((unsigned)ev[1] << 16); w.y = ev[2] | ((unsigned)ev[3] << 16); w.z = ev[4] | ((unsigned)ev[5] << 16); w.w = ev[6] | ((unsigned)ev[7] << 16);
                *(LAS u32x4*)(HT_l + (c + i) * HROW + t0 * 2) = w; }
        }
        __syncthreads();
        for (int i = F.tid; i < 2 * 128 * 8; i += NTHR) { const int m = i >> 10, rr = (i >> 3) & 127, c8 = i & 7;
            LAS unsigned char* T = m ? VW_l : VA_l; unsigned short e[8];
#pragma unroll
            for (int jj = 0; jj < 8; ++jj) { const int key = 16 * (c8 >> 1) + 8 * (jj >> 2) + 4 * (c8 & 1) + (jj & 3); e[jj] = *(const LAS bf16_t*)(T + key * VROW + rr * 2); }
            u32x4 w; w.x = e[0] | ((unsigned)e[1] << 16); w.y = e[2] | ((unsigned)e[3] << 16); w.z = e[4] | ((unsigned)e[5] << 16); w.w = e[6] | ((unsigned)e[7] << 16);
            *(u32x4*)((m ? VTW : VTA) + ((size_t)(b * 2 + (rr >> 6)) * 64 + (rr & 63)) * KEYS + j0 + c8 * 8) = w; }
        if (do_hy) { bf16_t* VTb = lat ? VT : VT + VT_CTX_OFF;
          for (int i = F.tid; i < 512 * 8; i += NTHR) { const int cch = i >> 3, c8 = i & 7;
              const u32x4 w = *(const LAS u32x4*)(HT_l + cch * HROW + c8 * 16);
              *(u32x4*)(VTb + ((size_t)cch * NB + b) * n + p0 + c8 * 8) = w; } }
    }
    __syncthreads();
}

__device__ __forceinline__ void hyena_final_phase(const Fr& F, const Args& a, int l, bool with_ctx) {
    constexpr int HROW = 144;
    LAS unsigned char* T = F.lds;
    const bf16_t* X0 = (const bf16_t*)(a.ws + WS_H); const bf16_t* VT = (const bf16_t*)(a.ws + WS_VT); const bf16_t* YT = (const bf16_t*)(a.ws + WS_YT);
    unsigned char* YH = a.ws + WS_Y8 + 512;
    const float* FN = (const float*)(a.ws + WS_FNORM) + l * 1024; const float* skip = a.in[I_HBIAS] + l * 512;
    const int nunits = with_ctx ? NB * 36 : NB * 32;
    for (int unit = F.bid; unit < nunits; unit += F.G) {
        const bool lat = unit < NB * 32;
        const int b = lat ? unit >> 5 : (unit - NB * 32) >> 2, p0 = lat ? (unit & 31) * 64 : ((unit - NB * 32) & 3) * 64;
        const int n = lat ? SEQ : CTX; const int row0 = lat ? b * SEQ + p0 : TL + b * CTX + p0;
        const bf16_t* Yb = lat ? YT : YT + VT_CTX_OFF; const bf16_t* Vb = lat ? VT : VT + VT_CTX_OFF; const float* inv = FN + (lat ? 0 : 512);
        __syncthreads();
        for (int i = F.tid; i < 512 * 8; i += NTHR) { const int cch = i >> 3, c8 = i & 7; const size_t off = ((size_t)cch * NB + b) * n + p0 + c8 * 8;
            const u32x4 y = *(const u32x4*)(Yb + off), v = *(const u32x4*)(Vb + off); const float s = inv[cch], k = skip[cch];
            u32x4 o;
            o.x = cvtpk(bflo(y.x) * s + k * bflo(v.x), bfhi(y.x) * s + k * bfhi(v.x)); o.y = cvtpk(bflo(y.y) * s + k * bflo(v.y), bfhi(y.y) * s + k * bfhi(v.y));
            o.z = cvtpk(bflo(y.z) * s + k * bflo(v.z), bfhi(y.z) * s + k * bfhi(v.z)); o.w = cvtpk(bflo(y.w) * s + k * bflo(v.w), bfhi(y.w) * s + k * bfhi(v.w));
            *(LAS u32x4*)(T + cch * HROW + c8 * 16) = o; }
        __syncthreads();
        { const int th = F.tid & 255, half = F.tid >> 8, c = 2 * th;
          for (int t = 32 * half; t < 32 * half + 32; ++t) {
              const unsigned x0 = *(const unsigned*)(X0 + (size_t)(row0 + t) * 512 + c);
              const float y0 = bf1(*(const LAS bf16_t*)(T + c * HROW + t * 2)), y1 = bf1(*(const LAS bf16_t*)(T + (c + 1) * HROW + t * 2));
              *(unsigned short*)(YH + (size_t)(row0 + t) * 1536 + c) = (unsigned short)__builtin_amdgcn_cvt_pk_fp8_f32(clamp_fp8(bflo(x0) * y0 * 16.f), clamp_fp8(bfhi(x0) * y1 * 16.f), 0, false); } }
    }
    __syncthreads();
}

#define MFMA32(a, b, c) __builtin_amdgcn_mfma_f32_32x32x16_bf16((a), (b), (c), 0, 0, 0)
#define MFMA16(a, b, c) __builtin_amdgcn_mfma_f32_16x16x32_bf16((a), (b), (c), 0, 0, 0)

__device__ __forceinline__ int tile_off(int row, int chunk) { return row * 128 + ((chunk ^ ((row >> 1) & 7)) << 4); }

template <bool WIN>
__device__ __forceinline__ void attn_unit(const Fr& F, const bf16_t* Qw, unsigned char* Yw, const bf16_t* Kb, const bf16_t* VTb, int a0, int na, int b0, int nb, int qpos0, bool has_sink, float sink2, const float* g64, bool rope, const float* ct, const float* st) {
    LAS unsigned char* L = F.lds;
    const int r = F.lane & 31, h = F.lane >> 5;
    const int xaddr = (lane_id() ^ 32) << 2;
#define SWAP32(v) __builtin_bit_cast(float, __builtin_amdgcn_ds_bpermute(xaddr, __builtin_bit_cast(int, (v))))
    bf16x8 q[4];
    {
        float x[4][8]; float ss = 0.f;
#pragma unroll
        for (int kk = 0; kk < 4; ++kk) { const u32x4 w = *(const u32x4*)(Qw + (size_t)r * 1536 + 16 * kk + 8 * h); unpack8(w, x[kk]);
#pragma unroll
            for (int j = 0; j < 8; ++j) ss += x[kk][j] * x[kk][j]; }
        ss += SWAP32(ss);
        const float rn = (1.f / sqrtf(ss * (1.f / 64.f) + EPS)) * QSCALE;
#pragma unroll
        for (int kk = 0; kk < 4; ++kk) { const f32x4 g0 = *(const f32x4*)(g64 + 16 * kk + 8 * h), g1 = *(const f32x4*)(g64 + 16 * kk + 8 * h + 4);
            x[kk][0] *= rn * g0.x; x[kk][1] *= rn * g0.y; x[kk][2] *= rn * g0.z; x[kk][3] *= rn * g0.w; x[kk][4] *= rn * g1.x; x[kk][5] *= rn * g1.y; x[kk][6] *= rn * g1.z; x[kk][7] *= rn * g1.w; }
        if (rope) { const int pos = qpos0 + r;
#pragma unroll
            for (int ax = 0; ax < 2; ++ax) {
                const f32x4 c0 = *(const f32x4*)(ct + pos * 32 + ax * 16 + 8 * h), c1 = *(const f32x4*)(ct + pos * 32 + ax * 16 + 8 * h + 4);
                const f32x4 s0 = *(const f32x4*)(st + pos * 32 + ax * 16 + 8 * h), s1 = *(const f32x4*)(st + pos * 32 + ax * 16 + 8 * h + 4);
                const float cs[8] = {c0.x, c0.y, c0.z, c0.w, c1.x, c1.y, c1.z, c1.w}, sn[8] = {s0.x, s0.y, s0.z, s0.w, s1.x, s1.y, s1.z, s1.w};
#pragma unroll
                for (int j = 0; j < 8; ++j) { const float av = x[2 * ax][j], bv = x[2 * ax + 1][j]; x[2 * ax][j] = av * cs[j] - bv * sn[j]; x[2 * ax + 1][j] = bv * cs[j] + av * sn[j]; } } }
#pragma unroll
        for (int kk = 0; kk < 4; ++kk) q[kk] = __builtin_bit_cast(bf16x8, pack8(x[kk]));
    }
    f32x16 o0, o1;
#pragma unroll
    for (int i = 0; i < 16; ++i) { o0[i] = 0.f; o1[i] = 0.f; }
    float lsum = 0.f;
    const int ntile = na + nb;
    const int srow = F.tid >> 3, sch = F.tid & 7;
    const int soff = tile_off(srow, sch);
    int t4[4];
#pragma unroll
    for (int j = 0; j < 4; ++j) t4[j] = tile_off(r, 2 * j + h);
#define AT_KT(i) ((i) < na ? a0 + (i) : b0 + ((i) - na))
#define AT_LD(i, K0, K1, V0, V1) do { const int kt_ = AT_KT(i); \
        K0 = *(const u32x4*)(Kb + (size_t)(kt_ * 128 + srow) * 128 + sch * 8); K1 = *(const u32x4*)(Kb + (size_t)(kt_ * 128 + 64 + srow) * 128 + sch * 8); \
        V0 = *(const u32x4*)(VTb + (size_t)srow * KEYS + kt_ * 128 + sch * 8); V1 = *(const u32x4*)(VTb + (size_t)srow * KEYS + kt_ * 128 + 64 + sch * 8); } while (0)
#define AT_ST(buf, K0, K1, V0, V1) do { LAS unsigned char* B_ = L + (buf) * 32768 + soff; \
        *(LAS u32x4*)(B_) = K0; *(LAS u32x4*)(B_ + 8192) = K1; *(LAS u32x4*)(B_ + 16384) = V0; *(LAS u32x4*)(B_ + 24576) = V1; } while (0)
#define AT_QK(S0, S1, Kt) do { bf16x8 kf_[8]; \
        _Pragma("unroll") for (int kk = 0; kk < 4; ++kk) { kf_[2 * kk] = *(const LAS bf16x8*)(L + (Kt) + t4[kk]); kf_[2 * kk + 1] = *(const LAS bf16x8*)(L + (Kt) + t4[kk] + 4096); } \
        _Pragma("unroll") for (int i_ = 0; i_ < 16; ++i_) { S0[i_] = 0.f; S1[i_] = 0.f; } \
        _Pragma("unroll") for (int kk = 0; kk < 4; ++kk) { S0 = MFMA32(kf_[2 * kk], q[kk], S0); S1 = MFMA32(kf_[2 * kk + 1], q[kk], S1); } } while (0)
#define AT_EXP(S0, S1, P, kpos0) do { \
        if (WIN && (kpos0) >= 0) { const int kbase = (kpos0) + 4 * h, qp = qpos0 + r; \
            _Pragma("unroll") for (int i = 0; i < 16; ++i) { const int kr = (i & 3) + 8 * (i >> 2); const int d0 = kbase + kr - qp, d1 = d0 + 32; \
                if (d0 > 128 || d0 < -128) S0[i] = -1e30f; if (d1 > 128 || d1 < -128) S1[i] = -1e30f; } } \
        _Pragma("unroll") for (int i = 0; i < 16; ++i) { S0[i] = fast_exp2(S0[i]); S1[i] = fast_exp2(S1[i]); lsum += S0[i] + S1[i]; } \
        { u32x4 w; \
          w.x = cvtpk(S0[0], S0[1]); w.y = cvtpk(S0[2], S0[3]); w.z = cvtpk(S0[4], S0[5]); w.w = cvtpk(S0[6], S0[7]); P[0] = __builtin_bit_cast(bf16x8, w); \
          w.x = cvtpk(S0[8], S0[9]); w.y = cvtpk(S0[10], S0[11]); w.z = cvtpk(S0[12], S0[13]); w.w = cvtpk(S0[14], S0[15]); P[1] = __builtin_bit_cast(bf16x8, w); \
          w.x = cvtpk(S1[0], S1[1]); w.y = cvtpk(S1[2], S1[3]); w.z = cvtpk(S1[4], S1[5]); w.w = cvtpk(S1[6], S1[7]); P[2] = __builtin_bit_cast(bf16x8, w); \
          w.x = cvtpk(S1[8], S1[9]); w.y = cvtpk(S1[10], S1[11]); w.z = cvtpk(S1[12], S1[13]); w.w = cvtpk(S1[14], S1[15]); P[3] = __builtin_bit_cast(bf16x8, w); } } while (0)
#define AT_PV(P, Vt) do { bf16x8 vf_[8]; \
        _Pragma("unroll") for (int c = 0; c < 4; ++c) { vf_[2 * c] = *(const LAS bf16x8*)(L + (Vt) + t4[c]); vf_[2 * c + 1] = *(const LAS bf16x8*)(L + (Vt) + t4[c] + 4096); } \
        _Pragma("unroll") for (int c = 0; c < 4; ++c) { o0 = MFMA32(vf_[2 * c], P[c], o0); o1 = MFMA32(vf_[2 * c + 1], P[c], o1); } } while (0)
#define AT_BODY(it) do { \
        const int kt = AT_KT(it); \
        if ((it) + 1 < ntile) AT_LD((it) + 1, kA0, kA1, vA0, vA1); \
        const int Bc = ((it) & 1) * 32768;                                \
        const int kp = (WIN && kt >= 2) ? (kt - 2) * 128 : -1;            \
        { f32x16 sa0, sa1; bf16x8 pa[4]; \
          AT_QK(sa0, sa1, Bc); AT_EXP(sa0, sa1, pa, kp); AT_PV(pa, Bc + 16384); } \
        __builtin_amdgcn_sched_barrier(0); \
        { f32x16 sb0, sb1; bf16x8 pb_[4]; \
          AT_QK(sb0, sb1, Bc + 8192); AT_EXP(sb0, sb1, pb_, (kp < 0 ? -1 : kp + 64)); AT_PV(pb_, Bc + 24576); } \
        if ((it) + 1 < ntile) AT_ST(((it) + 1) & 1, kA0, kA1, vA0, vA1); \
        __syncthreads(); } while (0)
    u32x4 kA0, kA1, vA0, vA1;
    AT_LD(0, kA0, kA1, vA0, vA1);
    __syncthreads();
    AT_ST(0, kA0, kA1, vA0, vA1);
    __syncthreads();
    for (int it = 0; it < ntile; it += 2) {
        AT_BODY(it);
        if (it + 1 < ntile) AT_BODY(it + 1);
    }
#undef AT_BODY
#undef AT_QK
#undef AT_EXP
#undef AT_PV
#undef AT_ST
#undef AT_LD
#undef AT_KT
    float lt = lsum + SWAP32(lsum);
    if (has_sink) lt += fast_exp2(sink2);
    const float inv = 1.f / lt;
#pragma unroll
    for (int g = 0; g < 4; ++g) { const float i16 = inv * 16.f;
        *(unsigned*)(Yw + (size_t)r * 1536 + 8 * g + 4 * h) = cvt4_fp8(o0[4 * g] * i16, o0[4 * g + 1] * i16, o0[4 * g + 2] * i16, o0[4 * g + 3] * i16);
        *(unsigned*)(Yw + (size_t)r * 1536 + 32 + 8 * g + 4 * h) = cvt4_fp8(o1[4 * g] * i16, o1[4 * g + 1] * i16, o1[4 * g + 2] * i16, o1[4 * g + 3] * i16); }
#undef SWAP32
}

__device__ __forceinline__ void hyena_unit_lat(const Fr& F, const bf16_t* Fg, const bf16_t* Vg, bf16_t* Yg) {
    constexpr int FREP = 8192 + 64, VPIT = 4096 + 16, VOFF = 8 * FREP;
    LAS unsigned char* L = F.lds;
    __syncthreads();
    { const int x = F.tid;
      const u32x4 lo = *(const u32x4*)(Fg + x * 8); u32x4 hi; if (x < 511) hi = *(const u32x4*)(Fg + x * 8 + 8); else { const unsigned z = zero_u32(); hi = (u32x4){z, z, z, z}; }
      const unsigned wv[8] = {lo.x, lo.y, lo.z, lo.w, hi.x, hi.y, hi.z, hi.w};
      *(LAS u32x4*)(L + x * 16) = lo;
#pragma unroll
      for (int rho = 1; rho < 8; ++rho) { u32x4 o;
          unsigned od[4];
#pragma unroll
          for (int d = 0; d < 4; ++d) { const int ob = 4 * d + 2 * rho, i = ob >> 2, s = ob & 3; od[d] = __builtin_amdgcn_alignbyte(wv[i + 1 < 8 ? i + 1 : 7], wv[i], s); }
          o.x = od[0]; o.y = od[1]; o.z = od[2]; o.w = od[3];
          *(LAS u32x4*)(L + rho * FREP + x * 16) = o; } }
    for (int i = F.tid; i < 16 * 256; i += NTHR) { const int b = i >> 8, x = i & 255; *(LAS u32x4*)(L + VOFF + b * VPIT + x * 16) = *(const u32x4*)(Vg + (size_t)b * SEQ + x * 8); }
    __syncthreads();
    const int i16 = F.lane & 15, q4 = F.lane >> 4, w = F.wave;
    const int base0 = 2047 - 256 * w - i16 + 8 * q4;
    const int rho = base0 & 7;
    LAS unsigned char* Ap = L + rho * FREP + (base0 - rho) * 2;
    LAS unsigned char* Bp = L + VOFF + i16 * VPIT + q4 * 16;
    bf16x8 A[16]; f32x4 acc[16];
#pragma unroll
    for (int rr = 0; rr < 16; ++rr) { A[rr] = *(const LAS bf16x8*)(Ap - 32 * rr); acc[rr] = (f32x4){0.f, 0.f, 0.f, 0.f}; }
    bf16x8 Bn = *(const LAS bf16x8*)(Bp);
    for (int o = 0; o < 8; ++o) {
#pragma unroll
        for (int u = 0; u < 8; ++u) {
            const int st = o * 8 + u;
            const bf16x8 Bf = Bn;
            if (st < 63) Bn = *(const LAS bf16x8*)(Bp + 64 * st + 64);
#pragma unroll
            for (int rr = 0; rr < 16; ++rr) acc[rr] = MFMA16(A[(rr - 2 * u) & 15], Bf, acc[rr]);
            if (st < 63) { A[(-2 * u - 2) & 15] = *(const LAS bf16x8*)(Ap + 64 * st + 64); A[(-2 * u - 1) & 15] = *(const LAS bf16x8*)(Ap + 64 * st + 32); }
        }
    }
#pragma unroll
    for (int rr = 0; rr < 16; ++rr) { u32x2 wv; wv.x = cvtpk(acc[rr].x, acc[rr].y); wv.y = cvtpk(acc[rr].z, acc[rr].w);
        *(u32x2*)(Yg + (size_t)i16 * SEQ + 256 * w + 16 * rr + 4 * q4) = wv; }
}
__device__ __forceinline__ void hyena_unit_ctx(const Fr& F, const bf16_t* Fg, const bf16_t* Vg, bf16_t* Yg) {
    constexpr int FREP = 1024 + 64, VPIT = 512 + 16, VOFF = 8 * FREP;
    LAS unsigned char* L = F.lds;
    __syncthreads();
    if (F.tid < 64) *(LAS u32x4*)(L + F.tid * 16) = *(const u32x4*)(Fg + F.tid * 8);
    if (F.tid >= 64 && F.tid < 68) { const unsigned z = zero_u32(); *(LAS u32x4*)(L + 1024 + (F.tid - 64) * 16) = (u32x4){z, z, z, z}; }
    { const int b = F.tid >> 5, x = F.tid & 31; *(LAS u32x4*)(L + VOFF + b * VPIT + x * 16) = *(const u32x4*)(Vg + (size_t)b * CTX + x * 8); }
    __syncthreads();
    for (int i = F.tid; i < 7 * 256; i += NTHR) { const int rho = 1 + i / 256, x2 = (i % 256) * 2; const int s0 = x2 + rho, s1 = x2 + 1 + rho;
        const unsigned e0 = s0 < 512 ? *(const LAS bf16_t*)(L + s0 * 2) : 0, e1 = s1 < 512 ? *(const LAS bf16_t*)(L + s1 * 2) : 0;
        *(LAS unsigned*)(L + rho * FREP + x2 * 2) = e0 | (e1 << 16); }
    __syncthreads();
    const int i16 = F.lane & 15, q4 = F.lane >> 4, w = F.wave;
    const int base0 = 255 - 32 * w - i16 + 8 * q4, rho = base0 & 7;
    LAS unsigned char* Ap = L + rho * FREP + (base0 - rho) * 2;
    LAS unsigned char* Bp = L + VOFF + i16 * VPIT + q4 * 16;
    f32x4 acc0 = (f32x4){0.f, 0.f, 0.f, 0.f}, acc1 = acc0;
#pragma unroll
    for (int st = 0; st < 8; ++st) { const bf16x8 Bf = *(const LAS bf16x8*)(Bp + 64 * st);
        const bf16x8 A0 = *(const LAS bf16x8*)(Ap + 64 * st), A1 = *(const LAS bf16x8*)(Ap + 64 * st - 32);
        acc0 = MFMA16(A0, Bf, acc0); acc1 = MFMA16(A1, Bf, acc1); }
    u32x2 wv; wv.x = cvtpk(acc0.x, acc0.y); wv.y = cvtpk(acc0.z, acc0.w); *(u32x2*)(Yg + (size_t)i16 * CTX + 32 * w + 4 * q4) = wv;
    wv.x = cvtpk(acc1.x, acc1.y); wv.y = cvtpk(acc1.z, acc1.w); *(u32x2*)(Yg + (size_t)i16 * CTX + 32 * w + 16 + 4 * q4) = wv;
}

__device__ __forceinline__ void mixer_phase(const Fr& F, const Args& a, int l, bool with_ctx, unsigned long long& sacc, const int swhich) {
#if defined(PROBE_P)
    unsigned long long st0 = __builtin_amdgcn_s_memrealtime();
#define SUBMARK(w) do { const unsigned long long t_ = __builtin_amdgcn_s_memrealtime(); if (swhich == (w)) sacc += t_ - st0; st0 = t_; } while (0)
#else
#define SUBMARK(w) do { } while (0)
#endif
    const bf16_t* QA = (const bf16_t*)(a.ws + WS_QA); const bf16_t* QW = QA + 1024;
    unsigned char* Y8 = a.ws + WS_Y8;
    const bf16_t* KA = (const bf16_t*)(a.ws + WS_KA); const bf16_t* KW = (const bf16_t*)(a.ws + WS_KW);
    const bf16_t* VTA = (const bf16_t*)(a.ws + WS_VTA); const bf16_t* VTW = (const bf16_t*)(a.ws + WS_VTW);
    const float* sinks = a.in[I_SINK] + l * 8; const float* qkg = a.in[I_QKG] + l * 256;
    const float* ct = (const float*)(a.ws + WS_ROPE); const float* st = ct + SEQ * 32;
    const int wq = F.wave >> 1, wh = F.wave & 1;
    const int ubid = (F.G % 8 == 0) ? (F.bid & 7) * (F.G >> 3) + (F.bid >> 3) : F.bid;
#define RELANE(FX) do { int t_ = F.wave * 64 + lane_id(); asm volatile("" : "+v"(t_)); FX.tid = t_; FX.lane = t_ & 63; } while (0)
    Fr FA = F; RELANE(FA);
    for (int unit = ubid; unit < NB * 2 * 32; unit += F.G) {
        const int b = unit >> 6, kvh = (unit >> 5) & 1, pb = unit & 31;
        const size_t qo = (size_t)(b * SEQ + pb * 64 + wh * 32) * 1536 + (kvh * 4 + wq) * 64;
        attn_unit<false>(FA, QA + qo, Y8 + qo, KA + (size_t)b * KEYS * 128 + kvh * 64, VTA + (size_t)(b * 2 + kvh) * 64 * KEYS, 0, KEYS / 128, 0, 0, pb * 64 + wh * 32, false, 0.f, qkg, true, ct, st);
    }
    SUBMARK(30);
    Fr FW = F; RELANE(FW);
    for (int unit = ubid; unit < NB * 2 * 32; unit += F.G) {
        const int b = unit >> 6, kvh = (unit >> 5) & 1, pb = unit & 31;
        const size_t qo = (size_t)(b * SEQ + pb * 64 + wh * 32) * 1536 + (kvh * 4 + wq) * 64 + 1024;
        const int lo = pb < 2 ? 0 : (pb - 2) >> 1, hi = ((64 * pb + 191) >> 7) > 15 ? 15 : ((64 * pb + 191) >> 7);
        attn_unit<true>(FW, QA + qo, Y8 + qo, KW + (size_t)b * KEYS * 128 + kvh * 64, VTW + (size_t)(b * 2 + kvh) * 64 * KEYS, 0, 2, 2 + lo, hi - lo + 1, pb * 64 + wh * 32, true, sinks[kvh * 4 + wq] * LOG2E, qkg + 128, true, ct, st);
    }
    SUBMARK(31);
    Fr FC2 = F; RELANE(FC2);
    if (with_ctx) {
        for (int unit = ubid; unit < 2 * NB * 2 * 4; unit += F.G) {
            const int isw = unit >> 7, u2 = unit & 127, b = u2 >> 3, kvh = (u2 >> 2) & 1, pb = u2 & 3;
            const size_t qo = (size_t)(TL + b * CTX + pb * 64 + wh * 32) * 1536 + (kvh * 4 + wq) * 64 + (isw ? 1024 : 0);
            attn_unit<false>(FC2, QA + qo, Y8 + qo, (isw ? KW : KA) + (size_t)b * KEYS * 128 + kvh * 64, (isw ? VTW : VTA) + (size_t)(b * 2 + kvh) * 64 * KEYS, 0, 2, 0, 0, 0, isw != 0, isw ? sinks[kvh * 4 + wq] * LOG2E : 0.f, qkg + (isw ? 128 : 0), false, ct, st);
        }
    }
    SUBMARK(32);
    const bf16_t* FL = (const bf16_t*)(a.ws + WS_FL) + (size_t)l * 512 * 4096; const bf16_t* FC = (const bf16_t*)(a.ws + WS_FC) + (size_t)l * 512 * 512;
    const bf16_t* VT = (const bf16_t*)(a.ws + WS_VT); bf16_t* YT = (bf16_t*)(a.ws + WS_YT);
    Fr FH = F; RELANE(FH);
    for (int c = F.bid; c < HYW; c += F.G) hyena_unit_lat(FH, FL + (size_t)c * 4096, VT + (size_t)c * NB * SEQ, YT + (size_t)c * NB * SEQ);
    if (with_ctx) for (int c = F.bid; c < HYW; c += F.G) hyena_unit_ctx(FH, FC + (size_t)c * 512, VT + VT_CTX_OFF + (size_t)c * NB * CTX, YT + VT_CTX_OFF + (size_t)c * NB * CTX);
    __syncthreads();
    SUBMARK(33);
#undef SUBMARK
#undef RELANE
}

__device__ __forceinline__ float gate_q(float x) { return fminf(256.f * sigmoid_f(x), 255.49f); }
__device__ __forceinline__ unsigned pack_u8x4(float a, float b, float c, float d) { return (unsigned)(int)a | ((unsigned)(int)b << 8) | ((unsigned)(int)c << 16) | ((unsigned)(int)d << 24); }
__device__ __forceinline__ float gq(unsigned w, int k) { return (float)((w >> (8 * k)) & 0xffu) + 0.5f; }
struct EpiInProj {
    static constexpr bool PERM = true, AFTER_DRAIN = false; static constexpr int NSEG = 1;
    unsigned char* ws; int pn_off;
    __device__ __forceinline__ void operator()(const pg8::f32x4 (&acc)[2][2][4][2], const pg8::Unit& u, int wr, int wc, int fr, int fq) const {
        asm volatile("" : "+v"(fr), "+v"(fq));
        const int pn = __builtin_amdgcn_readfirstlane(u.pn) + pn_off; unsigned long long boff; int ldc, colt; bool sig = false;
        if (pn < 2) { boff = WS_QA; ldc = 1536; colt = pn * 256; }
        else if (pn == 2) { boff = WS_RAWA; ldc = 256; colt = 0; }
        else if (pn < 9) { boff = WS_U; ldc = 1536; colt = (pn - 3) * 256; }
        else if (pn < 11) { boff = WS_QA; ldc = 1536; colt = 1024 + (pn - 9) * 256; }
        else if (pn == 11) { boff = WS_RAWW; ldc = 256; colt = 0; }
        else { boff = WS_G; ldc = 3072; colt = (pn - 12) * 256; sig = true; }
        bf16_t* base = (bf16_t*)(ws + boff); unsigned char* Gt = ws + boff;
        const int row0 = u.pm * 256 + wr * 64 + fr, col0 = colt + wc * 32 + 8 * fq;
        if (sig) {
            unsigned char* gb = (unsigned char*)Gt;
#pragma unroll
            for (int ai = 0; ai < 2; ++ai)
#pragma unroll
                for (int m = 0; m < 4; ++m) { unsigned char* rowp = gb + (size_t)(row0 + ai * 128 + m * 16) * 3072 + col0;
#pragma unroll
                    for (int bj = 0; bj < 2; ++bj) { const pg8::f32x4 v0 = acc[ai][bj][m][0], v1 = acc[ai][bj][m][1];
                        u32x2 w; w.x = pack_u8x4(gate_q(v0.x), gate_q(v0.y), gate_q(v0.z), gate_q(v0.w)); w.y = pack_u8x4(gate_q(v1.x), gate_q(v1.y), gate_q(v1.z), gate_q(v1.w));
                        *(u32x2*)(rowp + bj * 128) = w; } }
            return;
        }
#pragma unroll
        for (int ai = 0; ai < 2; ++ai)
#pragma unroll
            for (int m = 0; m < 4; ++m) { bf16_t* rowp = base + (size_t)(row0 + ai * 128 + m * 16) * ldc + col0;
#pragma unroll
                for (int bj = 0; bj < 2; ++bj) { const pg8::f32x4 v0 = acc[ai][bj][m][0], v1 = acc[ai][bj][m][1];
                    u32x4 w; w.x = cvtpk(v0.x, v0.y); w.y = cvtpk(v0.z, v0.w); w.z = cvtpk(v1.x, v1.y); w.w = cvtpk(v1.z, v1.w);
                    *(u32x4*)(rowp + bj * 128) = w; } }
    }
};
struct EpiGate {
    static constexpr bool PERM = true, AFTER_DRAIN = false; static constexpr int NSEG = 1;
    unsigned char* Gt;
    __device__ __forceinline__ void operator()(const pg8::f32x4 (&acc)[2][2][4][2], const pg8::Unit& u, int wr, int wc, int fr, int fq) const {
        asm volatile("" : "+v"(fr), "+v"(fq));
        const int row0 = u.pm * 256 + wr * 64 + fr, col0 = u.pn * 256 + wc * 32 + 8 * fq;
#pragma unroll
        for (int ai = 0; ai < 2; ++ai)
#pragma unroll
            for (int m = 0; m < 4; ++m) { unsigned char* rowp = Gt + (size_t)(row0 + ai * 128 + m * 16) * 3072 + col0;
#pragma unroll
                for (int bj = 0; bj < 2; ++bj) { const pg8::f32x4 v0 = acc[ai][bj][m][0], v1 = acc[ai][bj][m][1];
                    u32x2 w; w.x = pack_u8x4(gate_q(v0.x), gate_q(v0.y), gate_q(v0.z), gate_q(v0.w)); w.y = pack_u8x4(gate_q(v1.x), gate_q(v1.y), gate_q(v1.z), gate_q(v1.w));
                    *(u32x2*)(rowp + bj * 128) = w; } }
    }
};
struct EpiMerge {
    static constexpr bool PERM = true, AFTER_DRAIN = false; static constexpr int NSEG = 3;
    unsigned char* Mo; const unsigned char* Gt;
    __device__ __forceinline__ void rescale(pg8::f32x4 (&acc)[2][2][4][2], const pg8::Unit& u, int seg, int wr, int wc, int fr, int fq) const {
        asm volatile("" : "+v"(fr), "+v"(fq));
        const int row0 = u.pm * 256 + wr * 64 + fr, col0 = u.pn * 256 + wc * 32 + 8 * fq;
        const unsigned char* G0 = Gt + seg * 1024 + col0;
        u32x2 ga[2][4][2], gb[2][4][2];
#pragma unroll
        for (int ai = 0; ai < 2; ++ai)
#pragma unroll
            for (int m = 0; m < 4; ++m)
#pragma unroll
                for (int bj = 0; bj < 2; ++bj) { const size_t row = (size_t)(row0 + ai * 128 + m * 16);
                    ga[ai][m][bj] = *(const u32x2*)(G0 + row * 3072 + bj * 128); gb[ai][m][bj] = *(const u32x2*)(G0 + row * 3072 + 1024 + bj * 128); }
        __builtin_amdgcn_sched_barrier(0);
#pragma unroll
        for (int ai = 0; ai < 2; ++ai)
#pragma unroll
            for (int m = 0; m < 4; ++m)
#pragma unroll
                for (int bj = 0; bj < 2; ++bj) { const u32x2 a = ga[ai][m][bj], b = gb[ai][m][bj]; pg8::f32x4& v0 = acc[ai][bj][m][0]; pg8::f32x4& v1 = acc[ai][bj][m][1];
                    v0.x *= gq(a.x, 0) * fast_rcp(gq(b.x, 0)); v0.y *= gq(a.x, 1) * fast_rcp(gq(b.x, 1)); v0.z *= gq(a.x, 2) * fast_rcp(gq(b.x, 2)); v0.w *= gq(a.x, 3) * fast_rcp(gq(b.x, 3));
                    v1.x *= gq(a.y, 0) * fast_rcp(gq(b.y, 0)); v1.y *= gq(a.y, 1) * fast_rcp(gq(b.y, 1)); v1.z *= gq(a.y, 2) * fast_rcp(gq(b.y, 2)); v1.w *= gq(a.y, 3) * fast_rcp(gq(b.y, 3)); }
        __builtin_amdgcn_sched_barrier(0);
    }
    __device__ __forceinline__ void operator()(const pg8::f32x4 (&acc)[2][2][4][2], const pg8::Unit& u, int wr, int wc, int fr, int fq) const {
        asm volatile("" : "+v"(fr), "+v"(fq));
        const int row0 = u.pm * 256 + wr * 64 + fr, col0 = u.pn * 256 + wc * 32 + 8 * fq;
        constexpr float S = 16.f / 256.f;
        u32x2 gv[2][4][2];
#pragma unroll
        for (int ai = 0; ai < 2; ++ai)
#pragma unroll
            for (int m = 0; m < 4; ++m)
#pragma unroll
                for (int bj = 0; bj < 2; ++bj) gv[ai][m][bj] = *(const u32x2*)(Gt + (size_t)(row0 + ai * 128 + m * 16) * 3072 + 2048 + col0 + bj * 128);
        __builtin_amdgcn_sched_barrier(0);
#pragma unroll
        for (int ai = 0; ai < 2; ++ai) {
#pragma unroll
            for (int m = 0; m < 4; ++m)
#pragma unroll
                for (int bj = 0; bj < 2; ++bj) { const pg8::f32x4 v0 = acc[ai][bj][m][0], v1 = acc[ai][bj][m][1]; const u32x2 g = gv[ai][m][bj];
                    u32x2 w; w.x = cvt4_fp8(v0.x * (gq(g.x, 0) * S), v0.y * (gq(g.x, 1) * S), v0.z * (gq(g.x, 2) * S), v0.w * (gq(g.x, 3) * S));
                    w.y = cvt4_fp8(v1.x * (gq(g.y, 0) * S), v1.y * (gq(g.y, 1) * S), v1.z * (gq(g.y, 2) * S), v1.w * (gq(g.y, 3) * S));
                    *(u32x2*)(Mo + (size_t)(row0 + ai * 128 + m * 16) * 1024 + col0 + bj * 128) = w; }
            __builtin_amdgcn_sched_barrier(0);
        }
    }
};
struct EpiOut {
    static constexpr bool PERM = true, AFTER_DRAIN = false; static constexpr int NSEG = 1;
    bf16_t* XB; const float* MODl;
    __device__ __forceinline__ void operator()(const pg8::f32x4 (&acc)[2][2][4][2], const pg8::Unit& u, int wr, int wc, int fr, int fq) const {
        asm volatile("" : "+v"(fr), "+v"(fq));
        const int trow = u.pm * 256;
        const int row0 = trow + wr * 64 + fr, col0 = u.pn * 256 + wc * 32 + 8 * fq;
        const float* md = MODl + (size_t)mod_row(trow) * DIN + 2 * 1024 + col0;
        bf16_t* xp = XB + (size_t)row0 * D + col0;
        f32x4 mv[2][2];
#pragma unroll
        for (int bj = 0; bj < 2; ++bj)
#pragma unroll
            for (int n = 0; n < 2; ++n) mv[bj][n] = *(const f32x4*)(md + bj * 128 + 4 * n);
#pragma unroll
        for (int ai = 0; ai < 2; ++ai) {
            u32x4 xv[4][2];
#pragma unroll
            for (int m = 0; m < 4; ++m)
#pragma unroll
                for (int bj = 0; bj < 2; ++bj) xv[m][bj] = *(const u32x4*)(xp + (size_t)(ai * 128 + m * 16) * D + bj * 128);
            __builtin_amdgcn_sched_barrier(0);
#pragma unroll
            for (int m = 0; m < 4; ++m)
#pragma unroll
                for (int bj = 0; bj < 2; ++bj) { const pg8::f32x4 a0 = acc[ai][bj][m][0], a1 = acc[ai][bj][m][1]; const u32x4 x8 = xv[m][bj]; const f32x4 m0 = mv[bj][0], m1 = mv[bj][1];
                    u32x4 o; o.x = cvtpk(fmaf(m0.x, a0.x, bflo(x8.x)), fmaf(m0.y, a0.y, bfhi(x8.x))); o.y = cvtpk(fmaf(m0.z, a0.z, bflo(x8.y)), fmaf(m0.w, a0.w, bfhi(x8.y)));
                    o.z = cvtpk(fmaf(m1.x, a1.x, bflo(x8.z)), fmaf(m1.y, a1.y, bfhi(x8.z))); o.w = cvtpk(fmaf(m1.z, a1.z, bflo(x8.w)), fmaf(m1.w, a1.w, bfhi(x8.w)));
                    *(u32x4*)(xp + (size_t)(ai * 128 + m * 16) * D + bj * 128) = o; }
            __builtin_amdgcn_sched_barrier(0);
        }
    }
};
struct EpiMoe1 {
    static constexpr bool PERM = true, AFTER_DRAIN = false; static constexpr int NSEG = 1;
    unsigned char* HM;
    __device__ __forceinline__ void operator()(const pg8::f32x4 (&acc)[2][2][4][2], const pg8::Unit& u, int wr, int wc, int fr, int fq) const {
        asm volatile("" : "+v"(fr), "+v"(fq));
        const int row0 = u.pm * 256 + wr * 64 + fr, hcol0 = (u.pn & 3) * 128 + wc * 16 + 4 * fq;
#pragma unroll
        for (int ai = 0; ai < 2; ++ai)
#pragma unroll
            for (int m = 0; m < 4; ++m) { unsigned char* rowp = HM + (size_t)(row0 + ai * 128 + m * 16) * 512 + hcol0;
#pragma unroll
                for (int bj = 0; bj < 2; ++bj) { const pg8::f32x4 x = acc[ai][bj][m][0], y = acc[ai][bj][m][1] * 8.f;
                    *(unsigned*)(rowp + bj * 64) = cvt4_fp8(x.x * sigmoid_f(x.x) * y.x, x.y * sigmoid_f(x.y) * y.y, x.z * sigmoid_f(x.z) * y.z, x.w * sigmoid_f(x.w) * y.w); } }
    }
};
struct EpiMoe2 {
    static constexpr bool PERM = true, AFTER_DRAIN = false; static constexpr int NSEG = 1;
    bf16_t* Fo; const int* erow; const float* eroww; const LAS int* ebase; const LAS int* ecnt;
    __device__ __forceinline__ void operator()(const pg8::f32x4 (&acc)[2][2][4][2], const pg8::Unit& u, int wr, int wc, int fr, int fq) const {
        asm volatile("" : "+v"(fr), "+v"(fq));
        const int e = u.pn >> 2, cnt = __builtin_amdgcn_readfirstlane(ecnt[e]), pos0 = u.pm * 256 - __builtin_amdgcn_readfirstlane(ebase[e]) + wr * 64 + fr, col0 = (u.pn & 3) * 256 + wc * 32 + 8 * fq;
        const int* er = erow + (size_t)e * TT; const float* ew = eroww + (size_t)e * TT;
        int rma[2][4]; float wga[2][4];
#pragma unroll
        for (int ai = 0; ai < 2; ++ai)
#pragma unroll
            for (int m = 0; m < 4; ++m) { const int pos = pos0 + ai * 128 + m * 16; const bool ok = pos < cnt; rma[ai][m] = ok ? er[ok ? pos : 0] : -1; wga[ai][m] = ew[ok ? pos : 0]; }
        __builtin_amdgcn_sched_barrier(0);
#pragma unroll
        for (int ai = 0; ai < 2; ++ai) {
#pragma unroll
            for (int m = 0; m < 4; ++m) { const int r1 = rma[ai][m];
                if (r1 >= 0) { const float wgt = wga[ai][m]; bf16_t* rowp = Fo + ((size_t)(r1 & 1) * TT + (r1 >> 1)) * D + col0;
#pragma unroll
                    for (int bj = 0; bj < 2; ++bj) { const pg8::f32x4 v0 = acc[ai][bj][m][0], v1 = acc[ai][bj][m][1];
                        u32x4 w; w.x = cvtpk(v0.x * wgt, v0.y * wgt); w.y = cvtpk(v0.z * wgt, v0.w * wgt); w.z = cvtpk(v1.x * wgt, v1.y * wgt); w.w = cvtpk(v1.z * wgt, v1.w * wgt);
                        *(u32x4*)(rowp + bj * 128) = w; } } }
            __builtin_amdgcn_sched_barrier(0);
        }
    }
};
struct FusedOutOrder {
    int c, G, nun, wv; const unsigned* ready; unsigned* tmo;
    __device__ __forceinline__ bool next(int i, pg8::Unit& u) const {
        int q;
        if (!ready) { q = i * G + c; if (q >= nun) return false; }
        else if (G == 256 && nun == 576) { if (c < 64) { if (i > 0) return false; q = 512 + c; } else { q = i * 192 + (c - 64); if (q >= 512) return false; } }
        else { q = i * G + (G - 1 - c); if (q >= nun) return false; }
        u.pm = q >> 2; u.pn = q & 3; return true; }
    __device__ __forceinline__ void a_ready(const pg8::Unit& u) const {
        if (!ready) return;
        if (wv == 0) {
            const unsigned long long t0 = __builtin_amdgcn_s_memrealtime(); unsigned polls = 0;
            while ((unsigned)__builtin_amdgcn_readfirstlane(__hip_atomic_load(ready + 64 * u.pm, __ATOMIC_RELAXED, __HIP_MEMORY_SCOPE_AGENT)) < 32u) {
                if ((++polls & 255u) == 0u && __builtin_amdgcn_readfirstlane(__hip_atomic_load(tmo, __ATOMIC_RELAXED, __HIP_MEMORY_SCOPE_AGENT)) != 0u) break;
                if (__builtin_amdgcn_s_memrealtime() - t0 > 20000000ull) { if (lane_id() == 0) __hip_atomic_store(tmo, 1u, __ATOMIC_RELAXED, __HIP_MEMORY_SCOPE_AGENT); break; }
                __builtin_amdgcn_s_sleep(2); }
            __builtin_amdgcn_fence(__ATOMIC_ACQUIRE, "agent");
            asm volatile("s_waitcnt vmcnt(0)" ::: "memory");
        }
        asm volatile("" ::: "memory"); __builtin_amdgcn_s_barrier(); asm volatile("" ::: "memory");
    }
    __device__ __forceinline__ void done(const pg8::Unit&) const {}
};
struct LastInProjOrder {
    pg8::StaticOrder T; int nlat, G, c;
    __device__ __forceinline__ bool next(int i, pg8::Unit& u) const {
        const int L = i * G + c;
        if (L < nlat) return T.next(i, u);
        const int r = L - nlat; if (r >= 32) return false;
        u.pm = 128 + (r >> 1); u.pn = (r & 1) ? 11 : 2; return true; }
    __device__ __forceinline__ void a_ready(const pg8::Unit&) const {}
    __device__ __forceinline__ void done(const pg8::Unit&) const {}
};
struct MoeOrder {
    int nunits, G, c; const LAS int* tile_e;
    __device__ __forceinline__ bool next(int i, pg8::Unit& u) const {
        const int L0 = i * G + c; if (L0 >= nunits) return false;
        const int q = nunits / 8, r = nunits % 8, xcd = L0 % 8, off = L0 / 8; const int L = (xcd < r ? xcd * (q + 1) : r * (q + 1) + (xcd - r) * q) + off;
        const int pm = L >> 2; u.pm = pm; u.pn = __builtin_amdgcn_readfirstlane(tile_e[pm]) * 4 + (L & 3); return true; }
    __device__ __forceinline__ void a_ready(const pg8::Unit&) const {}
    __device__ __forceinline__ void done(const pg8::Unit&) const {}
};

__device__ __forceinline__ int moe_tables(const Fr& F, const Args& a, int l, LAS int* ebase  , LAS int* ecnt  , LAS int* tile_e  ) {
    const unsigned* CNT = (const unsigned*)(a.ws + WS_CTL) + CW_CNT + l * 256;
    __syncthreads();
    if (F.tid == 0) { int acc = 0;
#pragma unroll 1
        for (int e = 0; e < NE; ++e) { const int c = (int)__hip_atomic_load(&CNT[e * 16], __ATOMIC_RELAXED, __HIP_MEMORY_SCOPE_AGENT); ecnt[e] = c; ebase[e] = acc; const int nt = (c + 255) >> 8;
#pragma unroll 1
            for (int t = 0; t < nt; ++t) tile_e[(acc >> 8) + t] = e;
            acc += nt << 8; }
        ebase[NE] = acc; }
    __syncthreads();
    return ebase[NE] >> 8;
}

__device__ __forceinline__ void moe_gather_table(const Fr& F, const Args& a, const MoeOrder& S, const LAS int* ebase, const LAS int* ecnt, LAS int* gidx) {
    const int* EROW = (const int*)(a.ws + WS_EROW);
    for (int j = 0; j < 16; ++j) { pg8::Unit u; if (!S.next(j, u)) break;
        const int e = u.pn >> 2, pos0 = u.pm * 256 - ebase[e], cnt = ecnt[e];
        if (F.tid < 256) { const int pos = pos0 + F.tid; gidx[j * 256 + F.tid] = pos < cnt ? (EROW[(size_t)e * TT + pos] >> 1) : 0; } }
    __syncthreads();
}

#ifndef MK_PER_PHASE
#define MK_PER_PHASE 0
#endif
constexpr int PH_PER_LAYER = 10, PH_FINAL = 1 + NL * PH_PER_LAYER, N_PHASES = PH_FINAL + 1;

__global__ void __launch_bounds__(NTHR, 2) trunk_fwd(Args args) {
    extern __shared__ __attribute__((aligned(16))) unsigned char lds[];
    Fr F; F.lds = (LAS unsigned char*)lds; F.tid = threadIdx.x; F.lane = F.tid & 63; F.wave = __builtin_amdgcn_readfirstlane(F.tid >> 6); F.G = gridDim.x; F.bid = blockIdx.x;
    const int wave0 = F.wave;
    for (int u = F.tid; u < (LDS_BYTES - MISC_OFF) / 4; u += NTHR) ((LAS unsigned*)(F.lds + MISC_OFF))[u] = 0u;
    __syncthreads();
    const int lo = args.ph_lo, hi = args.ph_hi;
    unsigned* ctl = (unsigned*)(args.ws + WS_CTL);
    XcdBarrier bar; bar.bar = ctl + CW_BAR; bar.x = 0; bar.st = (volatile LAS unsigned*)(F.lds + MISC_OFF);
    if (hi - lo > 1) bar = xcd_barrier_post(ctl + CW_BAR, (volatile LAS unsigned*)(F.lds + MISC_OFF));
    bar.wv = (unsigned)wave0;
#ifndef DBG_ONLY
#define DBG_ONLY -1
#endif
#define SEL(p) (DBG_ONLY < 0 || DBG_ONLY == (p))
#define IN(k) (lo <= (k) && (k) < hi)
#define FRESH() do { int t_ = wave0 * 64 + lane_id(); asm volatile("" : "+v"(t_)); F.tid = t_; F.lane = t_ & 63; F.wave = wave0; } while (0)
#define SEAM(k) do { if (IN(k) && IN((k) + 1)) xcd_barrier(bar); } while (0)
#if !defined(PROBE_SUB)
#define PROBE_SUB -1
#endif
    unsigned long long pr_sub = 0ull;
#if defined(PROBE_P)
    unsigned long long pr_acc = 0ull, pr_t0 = __builtin_amdgcn_s_memrealtime();
#define PR_MARK(p) do { const unsigned long long t_ = __builtin_amdgcn_s_memrealtime(); if ((p) == PROBE_P) pr_acc += t_ - pr_t0; pr_t0 = t_; } while (0)
#else
#define PR_MARK(p) do { } while (0)
#endif
    unsigned char* ws = args.ws;
    LAS int* ebase = (LAS int*)(F.lds + MISC_OFF + 64); LAS int* ecnt = ebase + 20; LAS int* tile_e = (LAS int*)(F.lds + MISC_OFF + 512);

    #ifndef DBG_PRO
#define DBG_PRO 7
#endif
#if defined(PROBE_P)
    if (SEL(100) && IN(0)) { FRESH(); const unsigned long long tq0_ = __builtin_amdgcn_s_memrealtime(); pro_mod(F, args); __syncthreads(); const unsigned long long tq1_ = __builtin_amdgcn_s_memrealtime(); pro_rope(F, args); pro_filter(F, args); __syncthreads();
        const unsigned long long tq2_ = __builtin_amdgcn_s_memrealtime(); if (PROBE_SUB == 60) pr_sub += tq1_ - tq0_; if (PROBE_SUB == 61) pr_sub += tq2_ - tq1_; }
#else
    if (SEL(100) && IN(0)) { FRESH(); if (DBG_PRO & 1) pro_mod(F, args); __syncthreads(); if (DBG_PRO & 2) pro_rope(F, args); if (DBG_PRO & 4) pro_filter(F, args); __syncthreads(); }
#endif
    SEAM(0); PR_MARK(100);
    for (int l = 0; l < NL; ++l) {
        const int pb = 1 + PH_PER_LAYER * l;
#define LVARS() int lq_ = l; asm volatile("" : "+s"(lq_)); const bool uc = lq_ < NL - 1; const int M2 = uc ? TT : TL; (void)M2; (void)uc
        if (SEL(0) && IN(pb + 0)) { LVARS(); FRESH(); if (l == 0) filter_norm_reduce(F, args); conv_small_weights(F, args, l, 7, 0); rows_p0(F, args, l, TT); __syncthreads(); }
        SEAM(pb + 0); PR_MARK(0);
        if (SEL(1) && IN(pb + 1)) { LVARS();
            pg8::Gemm g{(const bf16_t*)(ws + WS_H8), (const bf16_t*)(ws + WS_WG8), TT, DIN, 512}; EpiInProj E{ws, 0};
            if (uc) { pg8::StaticOrder S; S.init(TT, DIN, F.G, F.bid); pg8::gemm_phase<EpiInProj, pg8::StaticOrder, true, true, false, true, -6>(F.lds, g, S, E, wave0); }
            else { LastInProjOrder S; S.T.init(TL, DIN, F.G, F.bid); S.nlat = (TL / 256) * (DIN / 256); S.G = F.G; S.c = F.bid; pg8::gemm_phase<EpiInProj, LastInProjOrder, true, true, false, true, -6>(F.lds, g, S, E, wave0); }
        }
        SEAM(pb + 1); PR_MARK(1);
        if (SEL(2) && IN(pb + 2)) { LVARS(); FRESH(); prep_phase(F, args, l, uc); }
        SEAM(pb + 2); PR_MARK(2);
        if (SEL(3) && IN(pb + 3)) { LVARS(); FRESH(); mixer_phase(F, args, l, uc, pr_sub, PROBE_SUB); }
        SEAM(pb + 3); PR_MARK(3);
        if (SEL(4) && IN(pb + 4)) { LVARS(); FRESH(); hyena_final_phase(F, args, l, uc); }
        SEAM(pb + 4); PR_MARK(4);
        if (SEL(5) && IN(pb + 5)) { LVARS();
            pg8::StaticOrder S; S.init(M2, 1024, F.G, F.bid);
            pg8::Gemm g{(const bf16_t*)(ws + WS_Y8), (const bf16_t*)(ws + WS_WBR), M2, 1024, 768}; EpiMerge E{ws + WS_H, (const unsigned char*)(ws + WS_G)};
            pg8::gemm_phase<EpiMerge, pg8::StaticOrder, true, true, false, true, -10>(F.lds, g, S, E, wave0);
            { FRESH(); __syncthreads(); const int nun = (M2 / 256) * 4, rem = nun % F.G; conv_expert_weights(F, args, l, rem, 0, CONV_E_ITEMS); __syncthreads(); }
        }
        SEAM(pb + 5); PR_MARK(5);
        if (SEL(6) && IN(pb + 6)) { LVARS();
            pg8::Gemm g{(const bf16_t*)(ws + WS_H), (const bf16_t*)(ws + WS_WOUT), M2, 1024, 512}; pg8::StaticOrder S; S.init(M2, 1024, F.G, F.bid);
            EpiOut E{(bf16_t*)(ws + WS_XB), (const float*)(ws + WS_MOD) + (size_t)l * NBM * DIN};
            pg8::gemm_phase<EpiOut, pg8::StaticOrder, true, true, false, true, -10>(F.lds, g, S, E, wave0);
        }
        SEAM(pb + 6); PR_MARK(6);
        if (SEL(7) && IN(pb + 7)) { LVARS(); FRESH(); rows_p5(F, args, l, M2, pr_sub, PROBE_SUB); __syncthreads(); }
        SEAM(pb + 7); PR_MARK(7);
        if (SEL(8) && IN(pb + 8)) { LVARS(); FRESH();
            const int ntile = moe_tables(F, args, l, ebase, ecnt, tile_e);
            pg8::Gemm g{(const bf16_t*)(ws + WS_H), (const bf16_t*)(ws + WS_W13), ntile * 256, NE * 1024, 512}; MoeOrder S{ntile * 4, F.G, F.bid, tile_e};
            LAS int* gidx = (LAS int*)(F.lds + 131072);
            moe_gather_table(F, args, S, ebase, ecnt, gidx);
            EpiMoe1 E{ws + WS_U};
            pg8::gemm_phase<EpiMoe1, MoeOrder, true, true, true, true, -6>(F.lds, g, S, E, wave0, gidx);
        }
        SEAM(pb + 8); PR_MARK(8);
        if (SEL(9) && IN(pb + 9)) { LVARS(); FRESH();
            const int ntile = moe_tables(F, args, l, ebase, ecnt, tile_e);
            pg8::Gemm g{(const bf16_t*)(ws + WS_U), (const bf16_t*)(ws + WS_W2), ntile * 256, NE * 1024, 256}; MoeOrder S{ntile * 4, F.G, F.bid, tile_e};
            EpiMoe2 E{(bf16_t*)(ws + WS_F), (const int*)(ws + WS_EROW), (const float*)(ws + WS_EROWW), ebase, ecnt};
            pg8::gemm_phase<EpiMoe2, MoeOrder, true, true, false, true, -9>(F.lds, g, S, E, wave0);
        }
        SEAM(pb + 9); PR_MARK(9);
    }
    if (SEL(101) && IN(PH_FINAL)) { FRESH(); rows_final(F, args); }
#if defined(PROBE_P)
    PR_MARK(101);
    pr_acc += pr_sub;
#if !defined(PROBE_BLK)
#define PROBE_BLK 0
#endif
    if (blockIdx.x == PROBE_BLK && F.wave == 0) { const unsigned long long t1 = __builtin_amdgcn_s_memrealtime() + 4ull * pr_acc; while (__builtin_amdgcn_s_memrealtime() < t1) __builtin_amdgcn_s_sleep(8); }
#endif
#undef IN
#undef SEAM
}

extern "C" void kernel_launch(void* const* d_in, const int* in_sizes, int n_in, void* d_out, int out_size, void* d_ws, size_t ws_size, hipStream_t stream) {
    static int grid = 0;
    if (grid == 0) {
        if (n_in != 29 || in_sizes[0] != TL * D || out_size != TL * D || ws_size < WS_END) { fprintf(stderr, "kernel_launch: unexpected shapes / workspace (n_in %d, ws %zu < %zu); nothing launched\n", n_in, ws_size, (size_t)WS_END); grid = -1; return; }
        int dev = 0, cus = 0, per_cu = 0;
        if (hipGetDevice(&dev) != hipSuccess || hipDeviceGetAttribute(&cus, hipDeviceAttributeMultiprocessorCount, dev) != hipSuccess) { grid = -1; return; }
        if (hipFuncSetAttribute((const void*)trunk_fwd, hipFuncAttributeMaxDynamicSharedMemorySize, LDS_BYTES) != hipSuccess) { fprintf(stderr, "kernel_launch: hipFuncSetAttribute failed\n"); grid = -1; return; }
        if (hipOccupancyMaxActiveBlocksPerMultiprocessor(&per_cu, (const void*)trunk_fwd, NTHR, LDS_BYTES) != hipSuccess || per_cu < 1) { fprintf(stderr, "kernel_launch: occupancy query reports %d\n", per_cu); }
        (void)hipGetLastError();
        grid = cus;
    }
    if (grid < 0) return;
    (void)hipMemsetAsync((char*)d_ws + WS_CTL, 0, CTL_ZERO_BYTES, stream);
    Args a{};
    for (int i = 0; i < 29; ++i) a.in[i] = (const float*)d_in[i];
    a.out = (float*)d_out; a.ws = (unsigned char*)d_ws;
#if MK_PER_PHASE
    for (int k = 0; k < N_PHASES; ++k) { a.ph_lo = k; a.ph_hi = k + 1; hipLaunchKernelGGL(trunk_fwd, dim3(grid), dim3(NTHR), LDS_BYTES, stream, a); }
#else
    a.ph_lo = 0; a.ph_hi = N_PHASES;
    hipLaunchKernelGGL(trunk_fwd, dim3(grid), dim3(NTHR), LDS_BYTES, stream, a);
#endif
}
```

```cpp
#include <hip/hip_runtime.h>
#include <cstdio>
#include <cstdint>

#define GAS __attribute__((address_space(1)))
#define LAS __attribute__((address_space(3)))
__device__ __forceinline__ int lane_id() { int l; asm volatile("v_mbcnt_lo_u32_b32 %0, -1, 0\n\tv_mbcnt_hi_u32_b32 %0, -1, %0" : "=v"(l)); return l; }
#define MK_PER_PHASE 0
namespace pg8 {
#define PG8_LAS __attribute__((address_space(3)))
typedef unsigned short bf16_t;
typedef short bf16x8 __attribute__((ext_vector_type(8)));
typedef float f32x4 __attribute__((ext_vector_type(4)));
typedef unsigned u32x4 __attribute__((ext_vector_type(4)));
constexpr int BM = 256, BK = 64, HALF = 128, HTB = HALF * BK * 2  , STAGE_BYTES = 8 * HTB, NXCD = 8, WGM = 8;

__host__ __device__ __forceinline__ int lds_byte(int r, int c) { const int st = (r >> 4) * 2 + (c >> 5), rr = r & 15, cc = c & 31, ob = rr * 64 + cc * 2; return st * 1024 + (ob ^ (((ob >> 9) & 1) << 5)); }
__host__ __device__ __forceinline__ void stage_rc(int b, int& R, int& C) { const int st = b / 1024, sb = b % 1024, swz = sb ^ (((sb >> 9) & 1) << 5); R = (st >> 1) * 16 + swz / 64; C = (st & 1) * 32 + (swz % 64) / 2; }
__host__ __device__ __forceinline__ int perm32(int rho) { const int n = rho >> 4, i = rho & 15; return 8 * (i >> 2) + 4 * n + (i & 3); }

struct Unit { int pm, pn; };
struct Gemm { const bf16_t* A; const bf16_t* Bt; int M, N, K; };

struct StaticOrder {
    int nM, nN, nwg, G, c;
    __host__ __device__ void init(int M, int N, int G_, int c_) { nM = M / BM; nN = N / BM; nwg = nM * nN; G = G_; c = c_; }
    __host__ __device__ bool next(int i, Unit& u) const {
        const long L = (long)i * G + c; if (L >= nwg) return false;
        int wgid = (int)L; { const int q = nwg / NXCD, r = nwg % NXCD, xcd = wgid % NXCD, off = wgid / NXCD; wgid = (xcd < r ? xcd * (q + 1) : r * (q + 1) + (xcd - r) * q) + off; }
        const int nig = WGM * nN, gid = wgid / nig, fm = gid * WGM, gsz = (nM - fm) < WGM ? (nM - fm) : WGM;
        u.pm = fm + ((wgid % nig) % gsz); u.pn = (wgid % nig) / gsz; return true;
    }
    __device__ __forceinline__ void a_ready(const Unit&) const {}
    __device__ __forceinline__ void done(const Unit&) const {}
};
__device__ __forceinline__ unsigned cvt_pk_bf16(float lo, float hi) { unsigned r; asm volatile("v_cvt_pk_bf16_f32 %0, %1, %2" : "=v"(r) : "v"(lo), "v"(hi)); return r; }
typedef float f32x2 __attribute__((ext_vector_type(2)));
template <class Epi, class Sched, bool ALIGN_EPI = false, bool SP2 = false, bool GATHER = false, bool F8 = false, int F8_SW = 0>
__device__ __forceinline__ void gemm_phase(PG8_LAS unsigned char* lds, const Gemm g, const Sched& S, const Epi& E, const int wave_id, const PG8_LAS int* gidx = nullptr) {
    static_assert(!GATHER || SP2, "GATHER is implemented for the SP2 loop only");
    int tid_ = wave_id * 64 + lane_id(); asm volatile("" : "+v"(tid_));
    const int tid = tid_, wid = __builtin_amdgcn_readfirstlane(tid >> 6), lane = tid & 63, wr = wid >> 2, wc = wid & 3, fr = lane & 15, fq = lane >> 4;
    const int K = g.K, nt = K / BK;
    unsigned voffA[2], voffB[2];
#pragma unroll
    for (int i = 0; i < 2; ++i) { int R, C; stage_rc(tid * 16 + i * 8192, R, C); const int Rb = Epi::PERM ? ((R & ~31) + perm32(R & 31)) : R;
        voffA[i] = (unsigned)(R * K + C) * 2u; voffB[i] = (unsigned)(Rb * K + C) * 2u; }
    unsigned goffA[2][2], goffN[2][2];
#define PG8_GOFF(dst, j) do { _Pragma("unroll") for (int _h = 0; _h < 2; ++_h) _Pragma("unroll") for (int _i = 0; _i < 2; ++_i) { int R_, C_; stage_rc(tid * 16 + _i * 8192, R_, C_); \
        dst[_h][_i] = ((unsigned)gidx[(j) * 256 + _h * 128 + R_] * (unsigned)K + (unsigned)C_) * 2u; } } while (0)
#define PG8_STAGE_A(bufoff, base, h, nx) do { if constexpr (GATHER) { unsigned o_[2] = {(nx) ? goffN[h][0] : goffA[h][0], (nx) ? goffN[h][1] : goffA[h][1]}; PG8_STAGE(bufoff, base, o_); } \
        else { PG8_STAGE(bufoff, (base) + ((h) ? hstep : 0), voffA); } } while (0)
    const size_t kstep = (size_t)(BK * 2);
    const size_t hstep = (size_t)HALF * K * 2;
    const size_t tstep = 2 * hstep;
    const unsigned ldsw = (unsigned)wid * 1024u;
    const int aoff = lds_byte(wr * 64 + fr, fq * 8), boff = lds_byte(wc * 32 + fr, fq * 8);
#define PG8_SA(b, h) (((b) * 2 + (h)) * HTB)
#define PG8_SB(b, h) ((4 + (b) * 2 + (h)) * HTB)
#define PG8_STAGE(bufoff, gbase, voff) do { _Pragma("unroll") for (int _i = 0; _i < 2; ++_i) \
        __builtin_amdgcn_global_load_lds((const unsigned*)((const char*)(gbase) + (voff)[_i]), (PG8_LAS unsigned*)(lds + (bufoff) + ldsw + _i * 8192), 16, 0, 0); } while (0)
#define PG8_LDA(dst, b, h) do { _Pragma("unroll") for (int m = 0; m < 4; ++m) _Pragma("unroll") for (int k = 0; k < 2; ++k) dst[m][k] = *(const PG8_LAS bf16x8*)(lds + PG8_SA(b, h) + aoff + m * 2048 + k * 1024); } while (0)
#define PG8_LDB(dst, b, h) do { _Pragma("unroll") for (int n = 0; n < 2; ++n) _Pragma("unroll") for (int k = 0; k < 2; ++k) dst[n][k] = *(const PG8_LAS bf16x8*)(lds + PG8_SB(b, h) + boff + n * 2048 + k * 1024); } while (0)
#define PG8_MMA(ai, bj, At, Bt) do { if constexpr (F8) __builtin_amdgcn_sched_barrier(0); __builtin_amdgcn_s_setprio(1); _Pragma("unroll") for (int m = 0; m < 4; ++m) _Pragma("unroll") for (int n = 0; n < 2; ++n) { \
        if constexpr (F8) { typedef int i32x4_ __attribute__((ext_vector_type(4))); typedef int i32x8_ __attribute__((ext_vector_type(8))); \
            const i32x8_ wf = __builtin_shufflevector(__builtin_bit_cast(i32x4_, Bt[n][0]), __builtin_bit_cast(i32x4_, Bt[n][1]), 0, 1, 2, 3, 4, 5, 6, 7); \
            const i32x8_ af = __builtin_shufflevector(__builtin_bit_cast(i32x4_, At[m][0]), __builtin_bit_cast(i32x4_, At[m][1]), 0, 1, 2, 3, 4, 5, 6, 7); \
              \
            asm volatile("v_mfma_scale_f32_16x16x128_f8f6f4 %0, %1, %2, %0, %3, %4 op_sel_hi:[0,0,0]" : "+v"(acc[ai][bj][m][n]) : "v"(wf), "v"(af), "v"(f8sw), "v"(f8sa)); } \
        else { _Pragma("unroll") for (int k = 0; k < 2; ++k) acc[ai][bj][m][n] = __builtin_amdgcn_mfma_f32_16x16x32_bf16(Bt[n][k], At[m][k], acc[ai][bj][m][n], 0, 0, 0); } } \
        __builtin_amdgcn_s_setprio(0); if constexpr (F8) __builtin_amdgcn_sched_barrier(0); } while (0)
#define PG8_WAIT_V(n) asm volatile("s_waitcnt vmcnt(" #n ")" ::: "memory")
#define PG8_WAIT_L(n) asm volatile("s_waitcnt lgkmcnt(" #n ")" ::: "memory")
#define PG8_BAR __builtin_amdgcn_s_barrier()
#define PG8_SCHED __builtin_amdgcn_sched_barrier(0)
    const int f8sw = 127 + F8_SW, f8sa = 127; (void)f8sw; (void)f8sa;
    Unit cur, nxt; int ui = 0;
    if (!S.next(0, cur)) return;
    f32x4 acc[2][2][4][2];
#pragma unroll
    for (int a = 0; a < 2; ++a)
#pragma unroll
        for (int b = 0; b < 2; ++b)
#pragma unroll
            for (int m = 0; m < 4; ++m)
#pragma unroll
                for (int n = 0; n < 2; ++n) acc[a][b][m][n] = (f32x4){0.f, 0.f, 0.f, 0.f};
    bf16x8 At[4][2], B0[2][2], B1[2][2];
    const char* cA = GATHER ? (const char*)g.A : (const char*)g.A + (size_t)cur.pm * tstep; const char* cB = (const char*)g.Bt + (size_t)cur.pn * tstep;
    if constexpr (GATHER) PG8_GOFF(goffA, 0);
    S.a_ready(cur);
    if constexpr (SP2) {
        PG8_STAGE(PG8_SB(0, 0), cB, voffB); PG8_STAGE(PG8_SB(0, 1), cB + hstep, voffB); PG8_STAGE_A(PG8_SA(0, 0), cA, 0, false); PG8_STAGE_A(PG8_SA(0, 1), cA, 1, false);
        if (wr == 1) PG8_BAR;
        PG8_WAIT_V(2); PG8_BAR;
        PG8_STAGE(PG8_SB(1, 0), cB + kstep, voffB); PG8_STAGE_A(PG8_SA(1, 0), cA + kstep, 0, false); PG8_STAGE(PG8_SB(1, 1), cB + hstep + kstep, voffB);
        PG8_WAIT_V(6); PG8_BAR;
    } else {
        PG8_STAGE(PG8_SB(0, 0), cB, voffB); PG8_STAGE(PG8_SA(0, 0), cA, voffA); PG8_STAGE(PG8_SB(0, 1), cB + hstep, voffB); PG8_STAGE(PG8_SA(0, 1), cA + hstep, voffA);
        if (wr == 1) PG8_BAR;
        PG8_WAIT_V(4); PG8_BAR;
        PG8_STAGE(PG8_SB(1, 0), cB + kstep, voffB); PG8_STAGE(PG8_SA(1, 0), cA + kstep, voffA); PG8_STAGE(PG8_SB(1, 1), cB + hstep + kstep, voffB);
        PG8_WAIT_V(6); PG8_BAR;
    }
    for (;;) {
        const bool has_next = S.next(ui + 1, nxt);
        if constexpr (GATHER) { if (has_next) PG8_GOFF(goffN, ui + 1); else { _Pragma("unroll") for (int _h = 0; _h < 2; ++_h) _Pragma("unroll") for (int _i = 0; _i < 2; ++_i) goffN[_h][_i] = goffA[_h][_i]; } }
        const char* nA = GATHER ? (const char*)g.A : has_next ? (const char*)g.A + (size_t)nxt.pm * tstep : cA; const char* nB = has_next ? (const char*)g.Bt + (size_t)nxt.pn * tstep : cB;
        for (int t = 0; t < nt; t += 2) {
            const bool last = (t == nt - 2);
            const char* a1 = cA + (size_t)(t + 1) * kstep;
            const char* a2 = last ? nA : cA + (size_t)(t + 2) * kstep; const char* b2 = last ? nB : cB + (size_t)(t + 2) * kstep;
            const char* a3 = a2 + kstep; const char* b3 = b2 + kstep;
            if (last && has_next) S.a_ready(nxt);
            if constexpr (SP2) {
            PG8_LDB(B0, 0, 0); PG8_LDB(B1, 0, 1); PG8_SCHED; PG8_LDA(At, 0, 0); PG8_STAGE_A(PG8_SA(1, 1), a1, 1, false);
            PG8_WAIT_V(8); PG8_WAIT_L(0); PG8_BAR; PG8_MMA(0, 0, At, B0); PG8_MMA(0, 1, At, B1); PG8_BAR; PG8_SCHED;
            PG8_LDA(At, 0, 1); PG8_STAGE(PG8_SB(0, 0), b2, voffB); PG8_STAGE(PG8_SB(0, 1), b2 + hstep, voffB); PG8_STAGE_A(PG8_SA(0, 0), a2, 0, last);
            PG8_WAIT_V(8); PG8_WAIT_L(0); PG8_BAR; PG8_MMA(1, 0, At, B0); PG8_MMA(1, 1, At, B1); PG8_BAR; PG8_SCHED;
            PG8_LDB(B0, 1, 0); PG8_LDB(B1, 1, 1); PG8_SCHED; PG8_LDA(At, 1, 0); PG8_STAGE_A(PG8_SA(0, 1), a2, 1, last);
            PG8_WAIT_V(8); PG8_WAIT_L(0); PG8_BAR; PG8_MMA(0, 0, At, B0); PG8_MMA(0, 1, At, B1); PG8_BAR; PG8_SCHED;
            PG8_LDA(At, 1, 1); PG8_STAGE(PG8_SB(1, 0), b3, voffB); PG8_STAGE(PG8_SB(1, 1), b3 + hstep, voffB); PG8_STAGE_A(PG8_SA(1, 0), a3, 0, last);
            PG8_WAIT_V(8); PG8_WAIT_L(0); PG8_BAR; PG8_MMA(1, 0, At, B0); PG8_MMA(1, 1, At, B1); PG8_BAR; PG8_SCHED;
            if constexpr (Epi::NSEG > 1) {
                constexpr int SEGT = F8 ? 4 : 8;
                if (t + 2 < nt && ((t + 2) & (SEGT - 1)) == 0) { if constexpr (F8) asm volatile("s_nop 15\n\ts_nop 15" ::: "memory"); E.rescale(acc, cur, (t + 2) / SEGT - 1, wr, wc, fr, fq); }
            }
            } else {
            PG8_LDB(B0, 0, 0); PG8_SCHED; PG8_LDA(At, 0, 0); PG8_STAGE(PG8_SA(1, 1), a1 + hstep, voffA);
            PG8_WAIT_L(8); PG8_BAR; PG8_WAIT_L(0); PG8_MMA(0, 0, At, B0); PG8_BAR; PG8_SCHED;
            PG8_LDB(B1, 0, 1); PG8_STAGE(PG8_SB(0, 0), b2, voffB);
            PG8_BAR; PG8_WAIT_L(0); PG8_MMA(0, 1, At, B1); PG8_BAR;
            PG8_LDA(At, 0, 1); PG8_STAGE(PG8_SA(0, 0), a2, voffA);
            PG8_BAR; PG8_WAIT_L(0); PG8_MMA(1, 0, At, B0); PG8_BAR; PG8_SCHED;
            PG8_STAGE(PG8_SB(0, 1), b2 + hstep, voffB);
            PG8_WAIT_V(6); PG8_BAR; PG8_MMA(1, 1, At, B1); PG8_BAR;
            PG8_LDB(B0, 1, 0); PG8_SCHED; PG8_LDA(At, 1, 0); PG8_STAGE(PG8_SA(0, 1), a2 + hstep, voffA);
            PG8_WAIT_L(8); PG8_BAR; PG8_WAIT_L(0); PG8_MMA(0, 0, At, B0); PG8_BAR; PG8_SCHED;
            PG8_LDB(B1, 1, 1); PG8_STAGE(PG8_SB(1, 0), b3, voffB);
            PG8_BAR; PG8_WAIT_L(0); PG8_MMA(0, 1, At, B1); PG8_BAR;
            PG8_LDA(At, 1, 1); PG8_STAGE(PG8_SA(1, 0), a3, voffA);
            PG8_BAR; PG8_WAIT_L(0); PG8_MMA(1, 0, At, B0); PG8_BAR; PG8_SCHED;
            PG8_STAGE(PG8_SB(1, 1), b3 + hstep, voffB);
            PG8_WAIT_V(6); PG8_BAR; PG8_MMA(1, 1, At, B1); PG8_BAR;
            }
        }
        if constexpr (ALIGN_EPI) { if (wr == 0) PG8_BAR; }
        if constexpr (F8) asm volatile("s_nop 15\n\ts_nop 15" ::: "memory");
        if constexpr (!Epi::AFTER_DRAIN) { E(acc, cur, wr, wc, fr, fq); S.done(cur); }
        if (!has_next) break;
#pragma unroll
        for (int a = 0; a < 2; ++a)
#pragma unroll
            for (int b = 0; b < 2; ++b)
#pragma unroll
                for (int m = 0; m < 4; ++m)
#pragma unroll
                    for (int n = 0; n < 2; ++n) acc[a][b][m][n] = (f32x4){0.f, 0.f, 0.f, 0.f};
        cur = nxt; cA = nA; cB = nB; ++ui;
        if constexpr (GATHER) { _Pragma("unroll") for (int _h = 0; _h < 2; ++_h) _Pragma("unroll") for (int _i = 0; _i < 2; ++_i) goffA[_h][_i] = goffN[_h][_i]; }
        if constexpr (ALIGN_EPI) { if (wr == 1) PG8_BAR; }
    }
    PG8_WAIT_V(0);
    if constexpr (!ALIGN_EPI) { if (wr == 0) PG8_BAR; }
    PG8_BAR;
    if constexpr (Epi::AFTER_DRAIN) { E.fused(acc, cur, wr, wc, fr, fq, lds, wid, lane); S.done(cur); }
#undef PG8_SA
#undef PG8_SB
#undef PG8_STAGE
#undef PG8_STAGE_A
#undef PG8_GOFF
#undef PG8_LDA
#undef PG8_LDB
#undef PG8_MMA
#undef PG8_WAIT_V
#undef PG8_WAIT_L
#undef PG8_BAR
#undef PG8_SCHED
}
}
#define XB_TMO      128
#define XB_XCNT(j)  (256  + 64 * (j))
#define XB_XSUB(j)  (1280 + 64 * (j))
#define XB_XGEN(j)  (2304 + 64 * (j))
#define XB_TOP      3328
#define XB_TOPGEN   3392
#define XCD_BAR_WORDS 3456
#define XB_SPIN_CAP (1u << 22)
#define LAS __attribute__((address_space(3)))

__device__ __forceinline__ unsigned xb_ld(unsigned* p)              { return __hip_atomic_load(p, __ATOMIC_RELAXED, __HIP_MEMORY_SCOPE_AGENT); }
__device__ __forceinline__ unsigned xb_add(unsigned* p, unsigned v) { asm volatile("" : "+v"(p));
    return __hip_atomic_fetch_add(p, v, __ATOMIC_RELAXED, __HIP_MEMORY_SCOPE_AGENT); }
__device__ __forceinline__ unsigned xb_xcc_id() { return (unsigned)__builtin_amdgcn_s_getreg((3 << 11) | 20) & 0xFu; }
#define XB_SPIN(cond, bar) do { unsigned _sp = 0; while (cond) { __builtin_amdgcn_s_sleep(1); \
    if ((++_sp & 255u) == 0u) { if (xb_ld(&(bar)[XB_TMO])) break; if (_sp > XB_SPIN_CAP) { xb_add(&(bar)[XB_TMO], 1u); break; } } } } while (0)

struct XcdBarrier {
    unsigned* bar; unsigned x; unsigned wv;
    volatile LAS unsigned* st;
};

__device__ __forceinline__ XcdBarrier xcd_barrier_post(unsigned* bar, volatile LAS unsigned* st) {
    XcdBarrier b; b.bar = bar; b.x = xb_xcc_id(); b.st = st;
    if (threadIdx.x == 0) (void)xb_add(&bar[XB_XCNT(b.x)], 1u);
    return b;
}
__device__ __forceinline__ void xcd_barrier_complete(unsigned* bar, unsigned x, unsigned& nloc, unsigned& nx) {
    const unsigned G = gridDim.x * gridDim.y * gridDim.z;
    unsigned sum, cnt, mine, sp = 0u;
    for (;;) {
        sum = 0u; cnt = 0u; mine = 0u;
#pragma unroll
        for (unsigned j = 0; j < 16; ++j) { const unsigned c = xb_ld(&bar[XB_XCNT(j)]); sum += c; cnt += (c > 0u) ? 1u : 0u; mine = (j == x) ? c : mine; }
        if (sum == G) break;
        __builtin_amdgcn_s_sleep(1);
        if ((++sp & 255u) == 0u) { if (xb_ld(&bar[XB_TMO])) break; if (sp > XB_SPIN_CAP) { xb_add(&bar[XB_TMO], 1u); break; } }
    }
    nloc = mine > 0u ? mine : 1u; nx = cnt > 0u ? cnt : 1u;
}

__device__ __forceinline__ void xcd_barrier(const XcdBarrier& b) {
    asm volatile("s_waitcnt vmcnt(0)" ::: "memory");
    __syncthreads();
    if (b.wv == 0u && lane_id() == 0) {
        unsigned* bar = b.bar;
        __builtin_amdgcn_s_waitcnt(0);
        unsigned nloc = b.st[0], nx = b.st[1];
        if (nloc == 0u) { xcd_barrier_complete(bar, b.x, nloc, nx); b.st[0] = nloc; b.st[1] = nx; }
        const unsigned old = xb_add(&bar[XB_XSUB(b.x)], 1u);
        const unsigned gen = old / nloc;
        if (old + 1u == (gen + 1u) * nloc) {
            __builtin_amdgcn_fence(__ATOMIC_RELEASE, "agent");
            asm volatile("s_waitcnt vmcnt(0)" ::: "memory");
            const unsigned og = xb_add(&bar[XB_TOP], 1u);
            const unsigned tg = og / nx;
            if (og + 1u == (tg + 1u) * nx) xb_add(&bar[XB_TOPGEN], 1u);
            else XB_SPIN(xb_ld(&bar[XB_TOPGEN]) == tg, bar);
            __builtin_amdgcn_fence(__ATOMIC_ACQUIRE, "agent");
            xb_add(&bar[XB_XGEN(b.x)], 1u);
            asm volatile("s_waitcnt vmcnt(0)" ::: "memory");
        } else {
            XB_SPIN(xb_ld(&bar[XB_XGEN(b.x)]) == gen, bar);
            __builtin_amdgcn_fence(__ATOMIC_ACQUIRE, "agent");
            asm volatile("s_waitcnt vmcnt(0)" ::: "memory");
        }
    }
    __syncthreads();
}

typedef unsigned short bf16_t;
typedef short bf16x8 __attribute__((ext_vector_type(8)));
typedef float f32x4 __attribute__((ext_vector_type(4)));
typedef float f32x16 __attribute__((ext_vector_type(16)));
typedef unsigned u32x4 __attribute__((ext_vector_type(4)));
typedef unsigned u32x2 __attribute__((ext_vector_type(2)));

constexpr int D = 1024, NB = 16, SEQ = 2048, CTX = 256, NL = 4;
constexpr int TL = NB * SEQ, TC = NB * CTX, TT = TL + TC;
constexpr int DIN = 6144, HYW = 512, NE = 16, DE = 512, KEYS = CTX + SEQ;
constexpr int NMOD = 6, NBM = NB + 1;
constexpr int APROWS = 2 * TT + NE * 256;
constexpr float EPS = 1e-6f, LOG2E = 1.4426950408889634f;
constexpr float QSCALE = 0.125f * LOG2E;

constexpr size_t MiB = 1u << 20;
constexpr size_t WS_CTL = 0, CTL_ZERO_BYTES = 1 * MiB;
constexpr size_t WS_MOD = 1 * MiB;
constexpr size_t WS_ROPE = 3 * MiB;
constexpr size_t WS_FL = 4 * MiB, WS_FC = 20 * MiB;
constexpr size_t WS_MISC = 22 * MiB;
constexpr size_t WS_FNORM = WS_MISC;
constexpr size_t WS_TOKE = WS_MISC + 64 * 1024, WS_TOKP = WS_MISC + 352 * 1024, WS_TOKW = WS_MISC + 640 * 1024;
constexpr size_t WS_ROWMAP = WS_MISC + 960 * 1024, WS_ROWW = WS_MISC + 1280 * 1024;
constexpr size_t WS_WIN = 24 * MiB, WS_WBR = 36 * MiB, WS_WOUT = 39 * MiB;
constexpr size_t WS_NP = 41 * MiB;
constexpr size_t WS_H = 57 * MiB;
constexpr size_t WS_KA = 129 * MiB, WS_VTA = 138 * MiB, WS_KW = 147 * MiB, WS_VTW = 156 * MiB;
constexpr size_t WS_QA = 165 * MiB, WS_QW = 201 * MiB, WS_YH = 237 * MiB, WS_VT = 273 * MiB, WS_YT = 309 * MiB;
constexpr size_t WS_RAWA = 309 * MiB, WS_RAWW = 327 * MiB;
constexpr size_t WS_F = 165 * MiB;
constexpr size_t WS_U = 345 * MiB;
constexpr size_t WS_G = 453 * MiB;
constexpr size_t WS_Y8 = 561 * MiB;
constexpr size_t WS_W13 = 615 * MiB, WS_W2 = 631 * MiB;
constexpr size_t WS_EROW = 30 * MiB, WS_EROWW = 33 * MiB;
constexpr size_t WS_H8 = 93 * MiB;
constexpr size_t WS_WG8 = WS_WIN;
constexpr size_t WS_XB = 639 * MiB;
constexpr size_t WS_END = 711 * MiB;
static_assert(WS_G + (size_t)TT * 3072 <= WS_Y8 && WS_Y8 + (size_t)TT * 1536 <= WS_W13 && WS_W13 + (size_t)16 * 1024 * 1024 <= WS_W2 && WS_W2 + (size_t)16 * 1024 * 512 <= WS_XB && WS_XB + (size_t)TT * 2048 <= WS_END && WS_H8 + (size_t)TT * 1024 <= WS_KA && WS_EROWW + (size_t)16 * TT * 4 <= WS_WBR, "ws map");
static_assert(WS_U + (size_t)APROWS * 1024 <= WS_G && WS_F + (size_t)2 * TT * 2048 <= WS_YT, "ws map 2");
constexpr size_t VT_CTX_OFF = (size_t)HYW * NB * SEQ;

constexpr int CW_BAR = 4096, CW_CNT = 8192, CW_PANEL = 16384, CW_HTMO = 12288;
constexpr int LDS_BYTES = 151552, MISC_OFF = 147456;
constexpr int NWAVES = 8, NTHR = 512;

struct Args { const float* in[29]; float* out; unsigned char* ws; int ph_lo, ph_hi; };
enum { I_X = 0, I_C, I_CTX, I_CCTX, I_ADAW, I_ADAB, I_N1G, I_N2G, I_WIN, I_QKG, I_HSW, I_HSB, I_HW1, I_HB1, I_HFR, I_HW2, I_HB2, I_HW3, I_HBIAS, I_SINK, I_WBR, I_WOUT,
       I_RGW, I_RGB, I_REW, I_REB, I_EW1, I_EW3, I_EW2 };

#define LDS_WAIT() asm volatile("s_waitcnt lgkmcnt(0)" ::: "memory")
#define VM_WAIT() asm volatile("s_waitcnt vmcnt(0)" ::: "memory")

typedef float f32x2_t __attribute__((ext_vector_type(2)));
typedef __bf16 bf16x2_t __attribute__((ext_vector_type(2)));
__device__ __forceinline__ unsigned cvtpk(float lo, float hi) { f32x2_t v = {lo, hi}; bf16x2_t b = __builtin_convertvector(v, bf16x2_t); return __builtin_bit_cast(unsigned, b); }
__device__ __forceinline__ unsigned zero_u32() { unsigned z; asm volatile("v_mov_b32 %0, 0" : "=v"(z)); return z; }
__device__ __forceinline__ float clamp_fp8(float x) { return __builtin_amdgcn_fmed3f(x, -448.f, 448.f); }
__device__ __forceinline__ unsigned cvt4_fp8(float a, float b, float c, float d) { int r = __builtin_amdgcn_cvt_pk_fp8_f32(a, b, 0, false); r = __builtin_amdgcn_cvt_pk_fp8_f32(c, d, r, true); return (unsigned)r; }
__device__ __forceinline__ unsigned cvt4_fp8c(float a, float b, float c, float d) { return cvt4_fp8(clamp_fp8(a), clamp_fp8(b), clamp_fp8(c), clamp_fp8(d)); }
__device__ __forceinline__ float bflo(unsigned u) { return __builtin_bit_cast(float, u << 16); }
__device__ __forceinline__ float bfhi(unsigned u) { return __builtin_bit_cast(float, u & 0xffff0000u); }
__device__ __forceinline__ float bf1(bf16_t u) { return __builtin_bit_cast(float, (unsigned)u << 16); }
__device__ __forceinline__ bf16_t f2bf(float f) { return (bf16_t)(cvtpk(f, 0.f) & 0xffffu); }
#define DPP_F(v, ctrl) __builtin_bit_cast(float, __builtin_amdgcn_update_dpp(0, __builtin_bit_cast(int, (v)), (ctrl), 0xf, 0xf, false))
__device__ __forceinline__ float row16_sum(float v) {
    v += DPP_F(v, 0xB1);
    v += DPP_F(v, 0x4E);
    v += DPP_F(v, 0x141);
    v += DPP_F(v, 0x140);
    return v;
}
__device__ __forceinline__ float wave_sum(float v) {
    v = row16_sum(v);
    const int iv = __builtin_bit_cast(int, v);
    float r = (__builtin_bit_cast(float, __builtin_amdgcn_readlane(iv, 0)) + __builtin_bit_cast(float, __builtin_amdgcn_readlane(iv, 16)))
            + (__builtin_bit_cast(float, __builtin_amdgcn_readlane(iv, 32)) + __builtin_bit_cast(float, __builtin_amdgcn_readlane(iv, 48)));
    asm volatile("" : "+v"(r));
    return r;
}
__device__ __forceinline__ float fast_exp2(float x) { return __builtin_amdgcn_exp2f(x); }
__device__ __forceinline__ float fast_rcp(float x) { return __builtin_amdgcn_rcpf(x); }
__device__ __forceinline__ float sigmoid_f(float x) { return fast_rcp(1.f + fast_exp2(-x * LOG2E)); }

__device__ __forceinline__ void sincos_acc(float x, float& s, float& c) {
    const float q = rintf(x * 0.636619772367581f);
    float y = fmaf(-q, 1.57079625129699707031f, x);
    y = fmaf(-q, 7.54978941586159635335e-08f, y);
    const float y2 = y * y;
    float sp = fmaf(y2, 2.7557314297e-06f, -1.9841270114e-04f); sp = fmaf(sp, y2, 8.3333337680e-03f); sp = fmaf(sp, y2, -1.6666667163e-01f); sp = fmaf(sp * y2, y, y);
    float cp = fmaf(y2, -2.7557314297e-07f, 2.4801587642e-05f); cp = fmaf(cp, y2, -1.3888889225e-03f); cp = fmaf(cp, y2, 4.1666667908e-02f); cp = fmaf(cp, y2, -0.5f); cp = fmaf(cp, y2, 1.0f);
    const int n = (int)q & 3;
    const float s1 = (n & 1) ? cp : sp, c1 = (n & 1) ? sp : cp;
    s = (n & 2) ? -s1 : s1;
    c = ((n + 1) & 2) ? -c1 : c1;
}

struct Fr { LAS unsigned char* lds; int tid, lane, wave, G, bid; };

__device__ __forceinline__ void pro_mod(const Fr& F, const Args& a) {
    LAS float* s = (LAS float*)F.lds;
    LAS float* red = (LAS float*)(F.lds + 69632);
    const float* c = a.in[I_C]; const float* cc = a.in[I_CCTX]; const float* W = a.in[I_ADAW]; const float* Bv = a.in[I_ADAB];
    float* MOD = (float*)(a.ws + WS_MOD);
    for (int i = F.tid; i < NBM * 1024; i += NTHR) { const int bb = i >> 10, k = i & 1023; const float v = (bb < NB) ? c[bb * 1024 + k] : cc[k]; s[i] = v / (1.f + __expf(-v)); }
    __syncthreads();
    const int col = F.tid & 63, ks = F.wave;
    for (int unit = F.G - 1 - F.bid; unit < NL * 96; unit += F.G) {
        const int l = unit / 96, j0 = (unit % 96) * 64;
        float acc[NBM];
#pragma unroll
        for (int bb = 0; bb < NBM; ++bb) acc[bb] = 0.f;
        const float* Wp = W + ((size_t)l * 1024 + ks * 128) * DIN + j0 + col;
#pragma unroll 2
        for (int k = 0; k < 128; k += 4) {
            const float w0 = Wp[(size_t)k * DIN], w1 = Wp[(size_t)(k + 1) * DIN], w2 = Wp[(size_t)(k + 2) * DIN], w3 = Wp[(size_t)(k + 3) * DIN];
#pragma unroll
            for (int bb = 0; bb < NBM; ++bb) { const f32x4 sv = *(const LAS f32x4*)(s + bb * 1024 + ks * 128 + k);
                acc[bb] = fmaf(sv.x, w0, acc[bb]); acc[bb] = fmaf(sv.y, w1, acc[bb]); acc[bb] = fmaf(sv.z, w2, acc[bb]); acc[bb] = fmaf(sv.w, w3, acc[bb]); } }
#pragma unroll
        for (int bb = 0; bb < NBM; ++bb) red[(ks * NBM + bb) * 64 + col] = acc[bb];
        __syncthreads();
        for (int o = F.tid; o < NBM * 64; o += NTHR) { const int bb = o >> 6, cx = o & 63; float sum = 0.f;
#pragma unroll
            for (int k2 = 0; k2 < 8; ++k2) sum += red[(k2 * NBM + bb) * 64 + cx];
            MOD[((size_t)l * NBM + bb) * DIN + j0 + cx] = sum + Bv[l * DIN + j0 + cx]; }
        __syncthreads();
    }
}

__device__ __forceinline__ void pro_rope(const Fr& F, const Args& a) {
    float* ct = (float*)(a.ws + WS_ROPE); float* st = ct + SEQ * 32;
    for (int i = F.bid * NTHR + F.tid; i < SEQ * 32; i += F.G * NTHR) {
        const int pos = i >> 5, ax = (i >> 4) & 1, f = i & 15;
        const float inv = exp2f(-(float)f * (13.287712379549449f / 16.f));
        const float ang = (float)(ax == 0 ? (pos >> 6) : (pos & 63)) * inv;
        float sv, cv; sincos_acc(ang, sv, cv); ct[i] = cv; st[i] = sv;
    }
}

__device__ __forceinline__ void pro_filter(const Fr& F, const Args& a) {
    LAS float* L = (LAS float*)F.lds;
    constexpr int oW1 = 0, oB1 = 2112, oFR = 2176, oB2 = 2240, oW2 = 2304, oZ = 6400, oH1 = 7552, oH2 = 9600, H2P = 68, oT = 11776, TP = 36;
    bf16_t* FL = (bf16_t*)(a.ws + WS_FL); bf16_t* FC = (bf16_t*)(a.ws + WS_FC); float* NP = (float*)(a.ws + WS_NP);
    const int p = F.tid >> 4, jj = F.tid & 15;
    for (int unit = F.bid; unit < NL * 72; unit += F.G) {
        const int l = unit / 72, ch = unit % 72; const bool lat = ch < 64; const int n = lat ? SEQ : CTX, pos0 = lat ? ch * 32 : (ch - 64) * 32;
        __syncthreads();
        for (int i = F.tid; i < 2112; i += NTHR) L[oW1 + i] = a.in[I_HW1][l * 2112 + i];
        for (int i = F.tid; i < 64; i += NTHR) { L[oB1 + i] = a.in[I_HB1][l * 64 + i]; L[oFR + i] = a.in[I_HFR][l * 64 + i]; L[oB2 + i] = a.in[I_HB2][l * 64 + i]; }
        for (int i = F.tid; i < 4096; i += NTHR) L[oW2 + i] = a.in[I_HW2][l * 4096 + i];
        const int pos = pos0 + p; const float t = (float)pos / (float)(n - 1);
        { const float band = 1e-4f + (float)jj * ((15.f - 1e-4f) / 15.f); const float ang = ((6.2831855f * band) * (float)pos) / (float)n;
          float sv, cv; sincos_acc(ang, sv, cv); L[oZ + p * 36 + 1 + jj] = cv; L[oZ + p * 36 + 17 + jj] = -sv; if (jj == 0) L[oZ + p * 36] = t; }
        __syncthreads();
        { f32x4 acc = *(const LAS f32x4*)(L + oB1 + 4 * jj);
#pragma unroll 3
          for (int i = 0; i < 33; ++i) { const float z = L[oZ + p * 36 + i]; const f32x4 w = *(const LAS f32x4*)(L + oW1 + i * 64 + 4 * jj); acc.x = fmaf(z, w.x, acc.x); acc.y = fmaf(z, w.y, acc.y); acc.z = fmaf(z, w.z, acc.z); acc.w = fmaf(z, w.w, acc.w); }
          const f32x4 fr = *(const LAS f32x4*)(L + oFR + 4 * jj); float sv, cv; f32x4 o;
          sincos_acc(fr.x * acc.x, sv, cv); o.x = sv; sincos_acc(fr.y * acc.y, sv, cv); o.y = sv; sincos_acc(fr.z * acc.z, sv, cv); o.z = sv; sincos_acc(fr.w * acc.w, sv, cv); o.w = sv;
          *(LAS f32x4*)(L + oH1 + p * 64 + 4 * jj) = o; }
        __syncthreads();
        { f32x4 acc = *(const LAS f32x4*)(L + oB2 + 4 * jj);
#pragma unroll 4
          for (int i = 0; i < 64; ++i) { const float z = L[oH1 + p * 64 + i]; const f32x4 w = *(const LAS f32x4*)(L + oW2 + i * 64 + 4 * jj); acc.x = fmaf(z, w.x, acc.x); acc.y = fmaf(z, w.y, acc.y); acc.z = fmaf(z, w.z, acc.z); acc.w = fmaf(z, w.w, acc.w); }
          const f32x4 fr = *(const LAS f32x4*)(L + oFR + 4 * jj); float sv, cv; f32x4 o;
          sincos_acc(fr.x * acc.x, sv, cv); o.x = sv; sincos_acc(fr.y * acc.y, sv, cv); o.y = sv; sincos_acc(fr.z * acc.z, sv, cv); o.z = sv; sincos_acc(fr.w * acc.w, sv, cv); o.w = sv;
          *(LAS f32x4*)(L + oH2 + p * H2P + 4 * jj) = o; }
        LAS bf16_t* T = (LAS bf16_t*)(L + oT);
        __syncthreads();
        {
            const int j16 = F.lane & 15, kq = F.lane >> 4;
            const float* W3p = a.in[I_HW3] + ((size_t)l * 64 + 4 * kq) * 1024 + 128 * F.wave + 4 * j16;
            f32x4 acc[2][4][2];
#pragma unroll
            for (int h = 0; h < 2; ++h)
#pragma unroll
                for (int cb = 0; cb < 4; ++cb)
#pragma unroll
                    for (int rb = 0; rb < 2; ++rb) acc[h][cb][rb] = (f32x4){0.f, 0.f, 0.f, 0.f};
            f32x4 bw[2][4][2];
#define PF_LDW(buf, s) do { _Pragma("unroll") for (int j = 0; j < 4; ++j) _Pragma("unroll") for (int h = 0; h < 2; ++h) bw[buf][j][h] = *(const f32x4*)(W3p + (size_t)(16 * (s) + j) * 1024 + 64 * h); } while (0)
            PF_LDW(0, 0);
#pragma unroll
            for (int s = 0; s < 4; ++s) {
                if (s + 1 < 4) PF_LDW((s + 1) & 1, s + 1);
                f32x4 av[2];
#pragma unroll
                for (int rb = 0; rb < 2; ++rb) av[rb] = *(const LAS f32x4*)(L + oH2 + (rb * 16 + j16) * H2P + 16 * s + 4 * kq);
#pragma unroll
                for (int j = 0; j < 4; ++j)
#pragma unroll
                    for (int h = 0; h < 2; ++h)
#pragma unroll
                        for (int cb = 0; cb < 4; ++cb)
#pragma unroll
                            for (int rb = 0; rb < 2; ++rb) acc[h][cb][rb] = __builtin_amdgcn_mfma_f32_16x16x4f32(av[rb][j], bw[s & 1][j][h][cb], acc[h][cb][rb], 0, 0, 0);
            }
#undef PF_LDW
            const int dir = F.wave >> 2;
            float tt[2][4];
#pragma unroll
            for (int rb = 0; rb < 2; ++rb)
#pragma unroll
                for (int r = 0; r < 4; ++r) tt[rb][r] = (float)(pos0 + rb * 16 + 4 * kq + r) / (float)(n - 1);
#pragma unroll
            for (int h = 0; h < 2; ++h)
#pragma unroll
                for (int cb = 0; cb < 4; ++cb) { const int col = 128 * F.wave + 64 * h + 4 * j16 + cb, c = col & 511;
                    const float dl = fabsf(-3.0701134573253943f + (-15.350567286626972f + 3.0701134573253943f) * ((float)c / 511.f));
#pragma unroll
                    for (int rb = 0; rb < 2; ++rb) { const int p0 = rb * 16 + 4 * kq; float v[4];
#pragma unroll
                        for (int r = 0; r < 4; ++r) { v[r] = acc[h][cb][rb][r] * __expf(-tt[rb][r] * dl); if (dir == 1 && pos0 + p0 + r == 0) v[r] = 0.f; }
                        u32x2 w;
                        if (dir == 0) { w.x = cvtpk(v[3], v[2]); w.y = cvtpk(v[1], v[0]); *(LAS u32x2*)(T + col * TP + 28 - p0) = w; }
                        else { w.x = cvtpk(v[0], v[1]); w.y = cvtpk(v[2], v[3]); *(LAS u32x2*)(T + col * TP + p0) = w; } } }
        }
        __syncthreads();
        for (int idx = F.tid; idx < 1024 * 32; idx += NTHR) { const int col = idx >> 5, i = idx & 31, dir = col >> 9, c = col & 511;
            const int u = (dir == 0) ? (n - 32 - pos0 + i) : ((pos0 + i == 0) ? 2 * n - 1 : n - 1 + pos0 + i);
            bf16_t* Fb = lat ? FL + ((size_t)l * 512 + c) * 4096 : FC + ((size_t)l * 512 + c) * 512;
            Fb[u] = T[col * TP + i]; }
        for (int col = F.tid; col < 1024; col += NTHR) { float sum = 0.f;
#pragma unroll 8
            for (int i = 0; i < 32; ++i) sum += fabsf(bf1(T[col * TP + i]));
            NP[((size_t)l * 72 + ch) * 1024 + col] = sum; }
    }
    __syncthreads();
}
__device__ __forceinline__ void filter_norm_reduce(const Fr& F, const Args& a) {
    const float* NP = (const float*)(a.ws + WS_NP); float* FN = (float*)(a.ws + WS_FNORM);
    for (int o = F.bid * NTHR + F.tid; o < NL * 2 * 512; o += F.G * NTHR) { const int l = o >> 10, isc = (o >> 9) & 1, c = o & 511;
        const int ch0 = isc ? 64 : 0, ch1 = isc ? 72 : 64; float sum = 0.f;
        for (int ch = ch0; ch < ch1; ++ch) sum += NP[((size_t)l * 72 + ch) * 1024 + c] + NP[((size_t)l * 72 + ch) * 1024 + 512 + c];
        FN[o] = 1.f / sum; }
}

template <int MODE>
__device__ __forceinline__ void transpose_item(const float* W, int K, int N, bf16_t* WT, int row_off, LAS float* scr, int item, int lane, int ldk = 0) {
    if (ldk == 0) ldk = K;
    const int nblk = N / 64, kb = item / nblk, nb = item % nblk, k0 = 64 * kb, n0 = 64 * nb;
    f32x4 v[16];
#pragma unroll
    for (int i = 0; i < 16; ++i) v[i] = *(const f32x4*)(W + (size_t)(k0 + 4 * i + (lane >> 4)) * N + n0 + (lane & 15) * 4);
#pragma unroll
    for (int i = 0; i < 16; ++i) *(LAS f32x4*)(scr + (4 * i + (lane >> 4)) * 68 + (lane & 15) * 4) = v[i];
    LDS_WAIT();
    const int c = lane & 7;
#pragma unroll
    for (int j = 0; j < 8; ++j) { const int n = (lane >> 3) + 8 * j; const LAS float* s = scr + (8 * c) * 68 + n;
        u32x4 o; o.x = cvtpk(s[0 * 68], s[1 * 68]); o.y = cvtpk(s[2 * 68], s[3 * 68]); o.z = cvtpk(s[4 * 68], s[5 * 68]); o.w = cvtpk(s[6 * 68], s[7 * 68]);
        const int nn = n0 + n; const int row = (MODE == 0) ? nn : ((nn >> 2) * 8 + (nn & 3) + (MODE == 2 ? 4 : 0));
        *(u32x4*)(WT + (size_t)(row_off + row) * ldk + k0 + 8 * c) = o; }
    LDS_WAIT();
}

template <int MODE>
__device__ __forceinline__ void transpose_item_f8(const float* W, int K, int N, unsigned char* WT, int row_off, LAS float* scr, int item, int lane, int ldk = 0) {
    if (ldk == 0) ldk = K;
    const int nblk = N / 64, kb = item / nblk, nb = item % nblk, k0 = 64 * kb, n0 = 64 * nb;
    f32x4 v[16];
#pragma unroll
    for (int i = 0; i < 16; ++i) v[i] = *(const f32x4*)(W + (size_t)(k0 + 4 * i + (lane >> 4)) * N + n0 + (lane & 15) * 4);
#pragma unroll
    for (int i = 0; i < 16; ++i) *(LAS f32x4*)(scr + (4 * i + (lane >> 4)) * 68 + (lane & 15) * 4) = v[i];
    LDS_WAIT();
    const int c = lane & 7;
#pragma unroll
    for (int j = 0; j < 8; ++j) { const int n = (lane >> 3) + 8 * j; const LAS float* s = scr + (8 * c) * 68 + n;
        u32x2 o; o.x = cvt4_fp8(s[0 * 68] * 64.f, s[1 * 68] * 64.f, s[2 * 68] * 64.f, s[3 * 68] * 64.f); o.y = cvt4_fp8(s[4 * 68] * 64.f, s[5 * 68] * 64.f, s[6 * 68] * 64.f, s[7 * 68] * 64.f);
        const int nn = n0 + n; const int row = (MODE == 0) ? nn : ((nn >> 2) * 8 + (nn & 3) + (MODE == 2 ? 4 : 0));
        *(u32x2*)(WT + (size_t)(row_off + row) * ldk + k0 + 8 * c) = o; }
    LDS_WAIT();
}
__device__ __forceinline__ void conv_small_weights(const Fr& F, const Args& a, int l, int mask, int b0) {
    if (F.bid < b0) return;
    LAS float* scr = (LAS float*)(F.lds + F.wave * 17408);
    const int gw = (F.bid - b0) * NWAVES + F.wave, NGW = (F.G - b0) * NWAVES;
    constexpr int I_IN = (1024 / 64) * (DIN / 64), I_BR = (512 / 64) * (1024 / 64), I_OUT = (1024 / 64) * (1024 / 64);
    if (mask & 1) for (int it = gw; it < I_IN; it += NGW) transpose_item_f8<0>(a.in[I_WIN] + (size_t)l * 1024 * DIN, 1024, DIN, a.ws + WS_WG8, 0, scr, it, F.lane);
    if (mask & 2) for (int it = gw; it < 3 * I_BR; it += NGW) { const int b = it / I_BR; transpose_item_f8<0>(a.in[I_WBR] + ((size_t)l * 3 + b) * 512 * 1024, 512, 1024, a.ws + WS_WBR + b * 512, 0, scr, it % I_BR, F.lane, 1536); }
    if (mask & 4) for (int it = gw; it < I_OUT; it += NGW) transpose_item_f8<0>(a.in[I_WOUT] + (size_t)l * 1024 * 1024, 1024, 1024, a.ws + WS_WOUT, 0, scr, it, F.lane);
}
__device__ __forceinline__ void conv_expert_weights(const Fr& F, const Args& a, int l, int b0, int it0, int it1) {
    if (F.bid < b0) return;
    LAS float* scr = (LAS float*)(F.lds + F.wave * 17408);
    const int gw = (F.bid - b0) * NWAVES + F.wave, NGW = (F.G - b0) * NWAVES;
    constexpr int I_1 = (1024 / 64) * (512 / 64), I_2 = (512 / 64) * (1024 / 64);
    for (int it = it0 + gw; it < it1; it += NGW) {
        const int e = it / (2 * I_1 + I_2); int r = it % (2 * I_1 + I_2);
        unsigned char* W13 = a.ws + WS_W13; unsigned char* W2 = a.ws + WS_W2;
        if (r < I_1) { transpose_item_f8<1>(a.in[I_EW1] + ((size_t)l * NE + e) * 1024 * 512, 1024, 512, W13, e * 1024, scr, r, F.lane); continue; } r -= I_1;
        if (r < I_1) { transpose_item_f8<2>(a.in[I_EW3] + ((size_t)l * NE + e) * 1024 * 512, 1024, 512, W13, e * 1024, scr, r, F.lane); continue; } r -= I_1;
        transpose_item_f8<0>(a.in[I_EW2] + ((size_t)l * NE + e) * 512 * 1024, 512, 1024, W2, e * 1024, scr, r, F.lane);
    }
}
constexpr int CONV_E_ITEMS = NE * 384, CONV_E_SPLIT = CONV_E_ITEMS / 2;

__device__ __forceinline__ int mod_row(int row) { return row < TL ? (row >> 11) : NB; }

__device__ __forceinline__ void rows_p0(const Fr& F, const Args& a, int l, int nrows) {
    const int gw = F.bid * NWAVES + F.wave, NGW = F.G * NWAVES;
    const float* g1 = a.in[I_N1G] + l * 1024;
    const float* MODl = (const float*)(a.ws + WS_MOD) + (size_t)l * NBM * DIN;
    const float* MODp = (const float*)(a.ws + WS_MOD) + (size_t)(l > 0 ? l - 1 : 0) * NBM * DIN;
    const bf16_t* Fs = (const bf16_t*)(a.ws + WS_F);
    unsigned char* H8 = a.ws + WS_H8; bf16_t* XB = (bf16_t*)(a.ws + WS_XB);
    const int per = 2 * ((nrows + 2 * NGW - 1) / (2 * NGW)), w0 = gw * per, w1 = (w0 + per < nrows) ? w0 + per : nrows;
    f32x4 gv[4], shv[4], scv[4], m5v[4]; int cur = -1;
#pragma unroll
    for (int j = 0; j < 4; ++j) { gv[j] = *(const f32x4*)(g1 + F.lane * 4 + 256 * j); shv[j] = gv[j]; scv[j] = gv[j]; m5v[j] = gv[j]; }
#define P0_LOAD(rb, V, F0, F1) do { _Pragma("unroll") for (int q = 0; q < 2; ++q) { const int row = (rb) + q; const bool lat = row < TL; \
            const float* xs = lat ? a.in[I_X] + (size_t)row * D : a.in[I_CTX] + (size_t)(row - TL) * D; \
            _Pragma("unroll") for (int j = 0; j < 4; ++j) { const int col = F.lane * 4 + 256 * j; \
                if (l == 0) V[q][j] = *(const u32x4*)(xs + col); \
                else { const u32x2 t_ = *(const u32x2*)(XB + (size_t)row * D + col); V[q][j].x = t_.x; V[q][j].y = t_.y; \
                    F0[q][j] = *(const u32x2*)(Fs + (size_t)row * D + col); F1[q][j] = *(const u32x2*)(Fs + ((size_t)TT + row) * D + col); } } } } while (0)
#define P0_PROC(rb, V, F0, F1) do { _Pragma("unroll") for (int q = 0; q < 2; ++q) { const int row = (rb) + q; const int mr = mod_row(row); \
            if (mr != cur) { cur = mr; _Pragma("unroll") for (int j = 0; j < 4; ++j) { const int col = F.lane * 4 + 256 * j; \
                shv[j] = *(const f32x4*)(MODl + (size_t)mr * DIN + col); scv[j] = *(const f32x4*)(MODl + (size_t)mr * DIN + 1024 + col); m5v[j] = *(const f32x4*)(MODp + (size_t)mr * DIN + 5 * 1024 + col); } } \
            float ss = 0.f; f32x4 X[4]; \
            _Pragma("unroll") for (int j = 0; j < 4; ++j) { const u32x4 w_ = V[q][j]; \
                if (l == 0) X[j] = __builtin_bit_cast(f32x4, w_); \
                else { X[j].x = bflo(w_.x) + m5v[j].x * (bflo(F0[q][j].x) + bflo(F1[q][j].x)); X[j].y = bfhi(w_.x) + m5v[j].y * (bfhi(F0[q][j].x) + bfhi(F1[q][j].x)); \
                       X[j].z = bflo(w_.y) + m5v[j].z * (bflo(F0[q][j].y) + bflo(F1[q][j].y)); X[j].w = bfhi(w_.y) + m5v[j].w * (bfhi(F0[q][j].y) + bfhi(F1[q][j].y)); } } \
            _Pragma("unroll") for (int j = 0; j < 4; ++j) { const int col = F.lane * 4 + 256 * j; u32x2 xw_; xw_.x = cvtpk(X[j].x, X[j].y); xw_.y = cvtpk(X[j].z, X[j].w); \
                *(u32x2*)(XB + (size_t)row * D + col) = xw_; } \
            _Pragma("unroll") for (int j = 0; j < 4; ++j) ss += (X[j].x * X[j].x + X[j].y * X[j].y) + (X[j].z * X[j].z + X[j].w * X[j].w); \
            const float r = 1.f / sqrtf(wave_sum(ss) * (1.f / D) + EPS); \
            _Pragma("unroll") for (int j = 0; j < 4; ++j) { const int col = F.lane * 4 + 256 * j; \
                const f32x4 o = (X[j] * r * gv[j]) * (scv[j] + 1.f) + shv[j]; \
                *(unsigned*)(H8 + (size_t)row * D + col) = cvt4_fp8(o.x, o.y, o.z, o.w); } } } while (0)
    u32x4 vA[2][4], vB[2][4]; u32x2 fA0[2][4], fA1[2][4], fB0[2][4], fB1[2][4];
    if (w0 < w1) P0_LOAD(w0, vA, fA0, fA1);
    for (int rb = w0; rb < w1; rb += 4) {
        if (rb + 2 < w1) P0_LOAD(rb + 2, vB, fB0, fB1);
        P0_PROC(rb, vA, fA0, fA1);
        if (rb + 2 < w1) { if (rb + 4 < w1) P0_LOAD(rb + 4, vA, fA0, fA1); P0_PROC(rb + 2, vB, fB0, fB1); }
    }
#undef P0_LOAD
#undef P0_PROC
}
__device__ __forceinline__ void rows_final(const Fr& F, const Args& a) {
    const int gw = F.bid * NWAVES + F.wave, NGW = F.G * NWAVES;
    const float* MODp = (const float*)(a.ws + WS_MOD) + (size_t)(NL - 1) * NBM * DIN;
    const bf16_t* Fs = (const bf16_t*)(a.ws + WS_F);
    const bf16_t* XB = (const bf16_t*)(a.ws + WS_XB);
    for (int row = gw; row < TL; row += NGW) {
        const int mr = row >> 11; float* xd = a.out + (size_t)row * D;
#pragma unroll
        for (int j = 0; j < 4; ++j) { const int col = F.lane * 4 + 256 * j;
            const u32x2 xw = *(const u32x2*)(XB + (size_t)row * D + col);
            const u32x2 f0 = *(const u32x2*)(Fs + (size_t)row * D + col), f1 = *(const u32x2*)(Fs + ((size_t)TT + row) * D + col);
            const f32x4 m5 = *(const f32x4*)(MODp + (size_t)mr * DIN + 5 * 1024 + col);
            f32x4 v; v.x = bflo(xw.x) + m5.x * (bflo(f0.x) + bflo(f1.x)); v.y = bfhi(xw.x) + m5.y * (bfhi(f0.x) + bfhi(f1.x)); v.z = bflo(xw.y) + m5.z * (bflo(f0.y) + bflo(f1.y)); v.w = bfhi(xw.y) + m5.w * (bfhi(f0.y) + bfhi(f1.y));
            *(f32x4*)(xd + col) = v; }
    }
}

__device__ __forceinline__ void rows_p5(const Fr& F, const Args& a, int l, int nrows, unsigned long long& sacc, const int swhich) {
#if defined(PROBE_P)
    unsigned long long st0 = __builtin_amdgcn_s_memrealtime();
#define SUBMARK5(w) do { const unsigned long long t_ = __builtin_amdgcn_s_memrealtime(); if (swhich == (w)) sacc += t_ - st0; st0 = t_; } while (0)
#else
#define SUBMARK5(w) do { } while (0)
#endif
    typedef float f32x4v __attribute__((ext_vector_type(4)));
    LAS float* RW = (LAS float*)F.lds;
    constexpr int RWS = 1028;
    LAS float* RB = (LAS float*)(F.lds + 82304);
    LAS int* LC = (LAS int*)(F.lds + 82432);
    LAS int* TE = (LAS int*)(F.lds + 82560);
    LAS int* TP = TE + 256;
    LAS float* TW = (LAS float*)(TP + 256);
    LAS float* RN = (LAS float*)(F.lds + 86784);
    LAS float* LG = (LAS float*)(F.lds + 87424);
    LAS float* GM = (LAS float*)(F.lds + 99072);
    LAS float* BI = (LAS float*)(F.lds + 107264);
    const float* g2 = a.in[I_N2G] + l * 1024;
    const float* MODl = (const float*)(a.ws + WS_MOD) + (size_t)l * NBM * DIN;
    unsigned char* H8 = a.ws + WS_H;
    const bf16_t* XB = (const bf16_t*)(a.ws + WS_XB);
    int* EROW = (int*)(a.ws + WS_EROW); float* EROWW = (float*)(a.ws + WS_EROWW);
    unsigned* CNT = (unsigned*)(a.ws + WS_CTL) + CW_CNT + l * 256;
    for (int f = F.tid; f < 1024; f += NTHR) { const f32x4 v = *(const f32x4*)(a.in[I_RGW] + ((size_t)l * 1024 + f) * 4);
        RW[0 * RWS + f] = v.x; RW[1 * RWS + f] = v.y; RW[2 * RWS + f] = v.z; RW[3 * RWS + f] = v.w; }
    for (int f = F.tid; f < 4096; f += NTHR) { const int k = f >> 2, c4 = (f & 3) * 4; const f32x4 v = *(const f32x4*)(a.in[I_REW] + ((size_t)l * 1024 + k) * 16 + c4);
        RW[(4 + c4) * RWS + k] = v.x; RW[(5 + c4) * RWS + k] = v.y; RW[(6 + c4) * RWS + k] = v.z; RW[(7 + c4) * RWS + k] = v.w; }
    if (F.tid < 20) RB[F.tid] = (F.tid < 4) ? a.in[I_RGB][l * 4 + F.tid] : a.in[I_REB][l * 16 + F.tid - 4];
    constexpr int P5_CH = 144;
    const int nch = (nrows + P5_CH - 1) / P5_CH;
    SUBMARK5(40);
    for (int ch = F.bid; ch < nch; ch += F.G) {
    const int r0 = ch * P5_CH, r1 = (r0 + P5_CH < nrows) ? r0 + P5_CH : nrows;
    const int mb0 = mod_row(r0), mb1 = mod_row(r1 - 1);
    if (F.tid < 32) LC[F.tid] = 0;
    for (int i = F.tid; i < 2048; i += NTHR) { const int s = i >> 10, k = i & 1023; GM[i] = g2[k] * (1.f + MODl[(size_t)(s ? mb1 : mb0) * DIN + 4 * 1024 + k]); }
    __syncthreads();
    if (F.wave < 4) {
    for (int rowb = r0 + 2 * F.wave; rowb < r1; rowb += 2 * 4) {
        f32x4 v[2][4]; bool val[2];
#pragma unroll
        for (int q = 0; q < 2; ++q) { const int row = rowb + q; val[q] = row < r1; const int rr = val[q] ? row : rowb;
            u32x2 xw[4];
#pragma unroll
            for (int j = 0; j < 4; ++j) xw[j] = *(const u32x2*)(XB + (size_t)rr * D + F.lane * 4 + 256 * j);
#pragma unroll
            for (int j = 0; j < 4; ++j) { v[q][j].x = bflo(xw[j].x); v[q][j].y = bfhi(xw[j].x); v[q][j].z = bflo(xw[j].y); v[q][j].w = bfhi(xw[j].y); } }
#pragma unroll
        for (int q = 0; q < 2; ++q) { const int rr = val[q] ? rowb + q : rowb; const int mr = mod_row(rr); float ss = 0.f;
#pragma unroll
            for (int j = 0; j < 4; ++j) ss += (v[q][j].x * v[q][j].x + v[q][j].y * v[q][j].y) + (v[q][j].z * v[q][j].z + v[q][j].w * v[q][j].w);
            const float r = 1.f / sqrtf(wave_sum(ss) * (1.f / D) + EPS);
            if (F.lane == 0 && val[q]) RN[rr - r0] = r;
#pragma unroll
            for (int j = 0; j < 4; ++j) { const int col = F.lane * 4 + 256 * j;
                const f32x4 g = *(const f32x4*)(g2 + col), sh = *(const f32x4*)(MODl + (size_t)mr * DIN + 3 * 1024 + col), sc = *(const f32x4*)(MODl + (size_t)mr * DIN + 4 * 1024 + col);
                const f32x4 t = (v[q][j] * r * g) * (sc + 1.f) + sh;
                if (val[q]) *(unsigned*)(H8 + (size_t)rr * D + col) = cvt4_fp8(t.x, t.y, t.z, t.w); } }
    }
    } else {
    if (F.wave < 6) { const int sl = F.wave - 4; const int mb = sl ? mb1 : mb0; f32x4 sh[4];
#pragma unroll
        for (int j = 0; j < 4; ++j) sh[j] = *(const f32x4*)(MODl + (size_t)mb * DIN + 3 * 1024 + F.lane * 4 + 256 * j);
#pragma unroll 4
        for (int cidx = 0; cidx < 20; ++cidx) { float p = 0.f;
#pragma unroll
            for (int j = 0; j < 4; ++j) { const f32x4 w = *(const LAS f32x4*)(RW + cidx * RWS + F.lane * 4 + 256 * j);
                p = fmaf(sh[j].x, w.x, p); p = fmaf(sh[j].y, w.y, p); p = fmaf(sh[j].z, w.z, p); p = fmaf(sh[j].w, w.w, p); }
            const float tot = wave_sum(p) + RB[cidx]; if (F.lane == 0) BI[sl * 20 + cidx] = tot; } }
    { const int i16 = F.lane & 15, kq = F.lane >> 4; const int ngrp = (r1 - r0 + 15) >> 4;
      for (int gi = F.wave - 4; gi < ngrp; gi += 4) {
        const int grow = r0 + 16 * gi; const int rowi = (grow + i16 < r1) ? grow + i16 : r1 - 1;
        const bf16_t* xs = XB + (size_t)rowi * D + 4 * kq;
        const int slot = (mod_row(grow) == mb0) ? 0 : 1;
        const LAS float* gmp = GM + slot * 1024 + 4 * kq; const LAS float* w0p = RW + i16 * RWS + 4 * kq; const LAS float* w1p = RW + (16 + (i16 & 3)) * RWS + 4 * kq;
        const float m1 = (i16 < 4) ? 1.f : 0.f;
        f32x4v acc0 = {0.f, 0.f, 0.f, 0.f}, acc1 = {0.f, 0.f, 0.f, 0.f};
#pragma unroll 16
        for (int s = 0; s < 64; ++s) {
            const u32x2 xw = *(const u32x2*)(xs + 16 * s); const f32x4 gv = *(const LAS f32x4*)(gmp + 16 * s);
            const f32x4 wa = *(const LAS f32x4*)(w0p + 16 * s), wb = *(const LAS f32x4*)(w1p + 16 * s);
            const f32x4 ba = wa * gv, bb = wb * gv * m1;
            acc0 = __builtin_amdgcn_mfma_f32_16x16x4f32(bflo(xw.x), ba.x, acc0, 0, 0, 0); acc1 = __builtin_amdgcn_mfma_f32_16x16x4f32(bflo(xw.x), bb.x, acc1, 0, 0, 0);
            acc0 = __builtin_amdgcn_mfma_f32_16x16x4f32(bfhi(xw.x), ba.y, acc0, 0, 0, 0); acc1 = __builtin_amdgcn_mfma_f32_16x16x4f32(bfhi(xw.x), bb.y, acc1, 0, 0, 0);
            acc0 = __builtin_amdgcn_mfma_f32_16x16x4f32(bflo(xw.y), ba.z, acc0, 0, 0, 0); acc1 = __builtin_amdgcn_mfma_f32_16x16x4f32(bflo(xw.y), bb.z, acc1, 0, 0, 0);
            acc0 = __builtin_amdgcn_mfma_f32_16x16x4f32(bfhi(xw.y), ba.w, acc0, 0, 0, 0); acc1 = __builtin_amdgcn_mfma_f32_16x16x4f32(bfhi(xw.y), bb.w, acc1, 0, 0, 0);
        }
#pragma unroll
        for (int rg = 0; rg < 4; ++rg) { const int lr = 16 * gi + 4 * kq + rg;
            if (r0 + lr < r1) { LG[lr * 20 + i16] = acc0[rg]; if (i16 < 4) LG[lr * 20 + 16 + i16] = acc1[rg]; } }
      } }
    }
    __syncthreads();
    SUBMARK5(42);
    for (int lr = F.tid; lr < r1 - r0; lr += NTHR) {
        float lg[20]; { const float rn = RN[lr]; const int sl = (mod_row(r0 + lr) == mb0) ? 0 : 1;
#pragma unroll
          for (int i = 0; i < 20; ++i) lg[i] = rn * LG[lr * 20 + i] + BI[sl * 20 + i]; }
        int gs = 0; float gmx = lg[0];
#pragma unroll
        for (int i = 1; i < 4; ++i) if (lg[i] > gmx) { gmx = lg[i]; gs = i; }
        float gsum = 0.f;
#pragma unroll
        for (int i = 0; i < 4; ++i) gsum += __expf(lg[i] - gmx);
        const float pg = 1.f / gsum;
        float le[4];
#pragma unroll
        for (int i = 0; i < 4; ++i) le[i] = (gs == 0) ? lg[4 + i] : (gs == 1) ? lg[8 + i] : (gs == 2) ? lg[12 + i] : lg[16 + i];
        int i0 = 0; float v0 = le[0];
#pragma unroll
        for (int i = 1; i < 4; ++i) if (le[i] > v0) { v0 = le[i]; i0 = i; }
        int i1 = -1; float v1 = -3.4e38f;
#pragma unroll
        for (int i = 0; i < 4; ++i) if (i != i0 && le[i] > v1) { v1 = le[i]; i1 = i; }
        const float e1 = __expf(v1 - v0), den = 1.f / (1.f + e1);
        const int ex0 = gs * 4 + i0, ex1 = gs * 4 + i1;
        const int lp0 = __hip_atomic_fetch_add(&LC[ex0], 1, __ATOMIC_RELAXED, __HIP_MEMORY_SCOPE_WORKGROUP), lp1 = __hip_atomic_fetch_add(&LC[ex1], 1, __ATOMIC_RELAXED, __HIP_MEMORY_SCOPE_WORKGROUP);
        TE[lr] = ex0 | (ex1 << 8); TP[lr] = lp0 | (lp1 << 16); TW[2 * lr] = den * pg; TW[2 * lr + 1] = e1 * den * pg;
    }
    __syncthreads();
    if (F.tid < NE) LC[16 + F.tid] = (int)atomicAdd(&CNT[F.tid * 16], (unsigned)LC[F.tid]);
    __syncthreads();
    for (int lr = F.tid; lr < r1 - r0; lr += NTHR) {
        const int te = TE[lr], tp = TP[lr], ex0 = te & 255, ex1 = te >> 8, row = r0 + lr;
        const int gp0 = LC[16 + ex0] + (tp & 0xffff), gp1 = LC[16 + ex1] + (tp >> 16);
        EROW[(size_t)ex0 * TT + gp0] = row * 2; EROWW[(size_t)ex0 * TT + gp0] = TW[2 * lr];
        EROW[(size_t)ex1 * TT + gp1] = row * 2 + 1; EROWW[(size_t)ex1 * TT + gp1] = TW[2 * lr + 1];
    }
    __syncthreads();
    SUBMARK5(43);
    }
    __syncthreads();
#undef SUBMARK5
}

__device__ __forceinline__ void normrope8(float (&x)[8], const float* g64, bool rope, int pos, const float* ct, const float* st, float scale, int lane) {
    float ss = 0.f;
#pragma unroll
    for (int i = 0; i < 8; ++i) ss += x[i] * x[i];
    ss += DPP_F(ss, 0xB1); ss += DPP_F(ss, 0x4E); ss += DPP_F(ss, 0x141);
    const float r = 1.f / sqrtf(ss * (1.f / 64.f) + EPS);
    const int ch = lane & 7;
    const f32x4 g0 = *(const f32x4*)(g64 + 8 * ch), g1 = *(const f32x4*)(g64 + 8 * ch + 4);
    x[0] *= r * g0.x; x[1] *= r * g0.y; x[2] *= r * g0.z; x[3] *= r * g0.w; x[4] *= r * g1.x; x[5] *= r * g1.y; x[6] *= r * g1.z; x[7] *= r * g1.w;
    if (rope) {
        const int ax = ch >> 2, half = (ch >> 1) & 1, f0 = 8 * (ch & 1);
        const f32x4 c0 = *(const f32x4*)(ct + pos * 32 + ax * 16 + f0), c1 = *(const f32x4*)(ct + pos * 32 + ax * 16 + f0 + 4);
        const f32x4 s0 = *(const f32x4*)(st + pos * 32 + ax * 16 + f0), s1 = *(const f32x4*)(st + pos * 32 + ax * 16 + f0 + 4);
        const float cs[8] = {c0.x, c0.y, c0.z, c0.w, c1.x, c1.y, c1.z, c1.w}, sn[8] = {s0.x, s0.y, s0.z, s0.w, s1.x, s1.y, s1.z, s1.w};
#pragma unroll
        for (int i = 0; i < 8; ++i) { const float p = DPP_F(x[i], 0x4E);
            x[i] = half ? (x[i] * cs[i] + p * sn[i]) : (x[i] * cs[i] - p * sn[i]); }
    }
#pragma unroll
    for (int i = 0; i < 8; ++i) x[i] *= scale;
}
__device__ __forceinline__ void unpack8(const u32x4 w, float (&x)[8]) { x[0] = bflo(w.x); x[1] = bfhi(w.x); x[2] = bflo(w.y); x[3] = bfhi(w.y); x[4] = bflo(w.z); x[5] = bfhi(w.z); x[6] = bflo(w.w); x[7] = bfhi(w.w); }
__device__ __forceinline__ u32x4 pack8(const float (&x)[8]) { u32x4 w; w.x = cvtpk(x[0], x[1]); w.y = cvtpk(x[2], x[3]); w.z = cvtpk(x[4], x[5]); w.w = cvtpk(x[6], x[7]); return w; }

__device__ __forceinline__ void prep_phase(const Fr& F, const Args& a, int l, bool with_ctx) {
    constexpr int VROW = 272;
    LAS unsigned char* VA_l = F.lds;
    LAS unsigned char* VW_l = F.lds + 17408;
    LAS unsigned char* HT_l = F.lds + 34816;
    constexpr int HROW = 144;
    const float* ct = (const float*)(a.ws + WS_ROPE); const float* st = ct + SEQ * 32;
    const float* qkg = a.in[I_QKG] + l * 256;
    const bf16_t* RAWA = (const bf16_t*)(a.ws + WS_RAWA); const bf16_t* RAWW = (const bf16_t*)(a.ws + WS_RAWW);
    bf16_t* KA = (bf16_t*)(a.ws + WS_KA); bf16_t* KW = (bf16_t*)(a.ws + WS_KW); bf16_t* VTA = (bf16_t*)(a.ws + WS_VTA); bf16_t* VTW = (bf16_t*)(a.ws + WS_VTW);
    const bf16_t* U = (const bf16_t*)(a.ws + WS_U); bf16_t* X0 = (bf16_t*)(a.ws + WS_H); bf16_t* VT = (bf16_t*)(a.ws + WS_VT);
    const float* hsw = a.in[I_HSW] + l * 3 * 1536; const float* hsb = a.in[I_HSB] + l * 1536;
    for (int unit = F.bid; unit < NB * 36; unit += F.G) {
        const bool lat = unit < NB * 32;
        const int b = lat ? unit >> 5 : (unit - NB * 32) >> 2, p0 = lat ? (unit & 31) * 64 : ((unit - NB * 32) & 3) * 64;
        const int n = lat ? SEQ : CTX;
        const int row0 = lat ? b * SEQ + p0 : TL + b * CTX + p0;
        const int j0 = lat ? CTX + p0 : p0;
        __syncthreads();
        {
            const bool isw = (F.lane & 16) != 0; const int l16 = F.lane & 15, half = F.lane >> 5;
            u32x4 kw[4];
#pragma unroll
            for (int ps = 0; ps < 4; ++ps) { const int tk = 8 * F.wave + 2 * ps + half; kw[ps] = *(const u32x4*)((isw ? RAWW : RAWA) + (size_t)(row0 + tk) * 256 + l16 * 8); }
#pragma unroll
            for (int ps = 0; ps < 4; ++ps) { const int tk = 8 * F.wave + 2 * ps + half; float x[8]; unpack8(kw[ps], x);
                normrope8(x, qkg + (isw ? 192 : 64), lat, p0 + tk, ct, st, 1.f, F.lane);
                *(u32x4*)((isw ? KW : KA) + ((size_t)b * KEYS + j0 + tk) * 128 + l16 * 8) = pack8(x); }
        }
        for (int i = F.tid; i < 2 * 64 * 16; i += NTHR) { const int m = i >> 10, r = (i >> 4) & 63, cch = i & 15;
            const u32x4 w = *(const u32x4*)((m ? RAWW : RAWA) + (size_t)(row0 + r) * 256 + 128 + cch * 8);
            *(LAS u32x4*)((m ? VW_l : VA_l) + r * VROW + cch * 16) = w; }
        const bool do_hy = lat || with_ctx;
        if (do_hy) {
            int tq_ = F.tid; asm volatile("" : "+v"(tq_));
            const int cg = tq_ & 63, c = 8 * cg, t0 = 8 * F.wave;
            u32x4 x1p[8];
#pragma unroll
            for (int g = 0; g < 3; ++g) {
                const int ch = g * 512 + c;
                float w0[8], w1[8], w2[8], bb[8];
                { const f32x4 a0 = *(const f32x4*)(hsw + ch), a1 = *(const f32x4*)(hsw + ch + 4), b0 = *(const f32x4*)(hsw + 1536 + ch), b1 = *(const f32x4*)(hsw + 1536 + ch + 4),
                              c0 = *(const f32x4*)(hsw + 3072 + ch), c1 = *(const f32x4*)(hsw + 3072 + ch + 4), d0 = *(const f32x4*)(hsb + ch), d1 = *(const f32x4*)(hsb + ch + 4);
                  w0[0] = a0.x; w0[1] = a0.y; w0[2] = a0.z; w0[3] = a0.w; w0[4] = a1.x; w0[5] = a1.y; w0[6] = a1.z; w0[7] = a1.w;
                  w1[0] = b0.x; w1[1] = b0.y; w1[2] = b0.z; w1[3] = b0.w; w1[4] = b1.x; w1[5] = b1.y; w1[6] = b1.z; w1[7] = b1.w;
                  w2[0] = c0.x; w2[1] = c0.y; w2[2] = c0.z; w2[3] = c0.w; w2[4] = c1.x; w2[5] = c1.y; w2[6] = c1.z; w2[7] = c1.w;
                  bb[0] = d0.x; bb[1] = d0.y; bb[2] = d0.z; bb[3] = d0.w; bb[4] = d1.x; bb[5] = d1.y; bb[6] = d1.z; bb[7] = d1.w; }
                u32x4 raw[10];
#pragma unroll
                for (int i = 0; i < 10; ++i) { const int pos = p0 + t0 - 1 + i;
                    if (pos < 0 || pos >= n) { const unsigned z = zero_u32(); raw[i] = (u32x4){z, z, z, z}; } else raw[i] = *(const u32x4*)(U + (size_t)(row0 - p0 + pos) * 1536 + ch); }
#pragma unroll
                for (int t = 0; t < 8; ++t) { float up[8], uc[8], un[8], o[8]; unpack8(raw[t], up); unpack8(raw[t + 1], uc); unpack8(raw[t + 2], un);
#pragma unroll
                    for (int i = 0; i < 8; ++i) o[i] = fmaf(w0[i], up[i], fmaf(w1[i], uc[i], fmaf(w2[i], un[i], bb[i])));
                    if (g == 0) *(u32x4*)(X0 + (size_t)(row0 + t0 + t) * 512 + c) = pack8(o);
                    else if (g == 1) x1p[t] = pack8(o);
                    else { float x1[8]; unpack8(x1p[t], x1);
#pragma unroll
                        for (int i = 0; i < 8; ++i) o[i] *= x1[i];
                        x1p[t] = pack8(o); } }
            }
#pragma unroll
            for (int i = 0; i < 8; ++i) { unsigned short ev[8];
#pragma unroll
                for (int t = 0; t < 8; ++t) { const unsigned wsel = (i >> 1) == 0 ? x1p[t].x : (i >> 1) == 1 ? x1p[t].y : (i >> 1) == 2 ? x1p[t].z : x1p[t].w; ev[t] = (unsigned short)((i & 1) ? (wsel >> 16) : (wsel & 0xffffu)); }
                u32x4 w; w.x = ev[0] | ((unsigned)ev[1] << 16); w.y = ev[2] | ((unsigned)ev[3] << 16); w.z = ev[4] | ((unsigned)ev[5] << 16); w.w = ev[6] | ((unsigned)ev[7] << 16);
                *(LAS u32x4*)(HT_l + (c + i) * HROW + t0 * 2) = w; }
        }
        __syncthreads();
        for (int i = F.tid; i < 2 * 128 * 8; i += NTHR) { const int m = i >> 10, rr = (i >> 3) & 127, c8 = i & 7;
            LAS unsigned char* T = m ? VW_l : VA_l; unsigned short e[8];
#pragma unroll
            for (int jj = 0; jj < 8; ++jj) { const int key = 16 * (c8 >> 1) + 8 * (jj >> 2) + 4 * (c8 & 1) + (jj & 3); e[jj] = *(const LAS bf16_t*)(T + key * VROW + rr * 2); }
            u32x4 w; w.x = e[0] | ((unsigned)e[1] << 16); w.y = e[2] | ((unsigned)e[3] << 16); w.z = e[4] | ((unsigned)e[5] << 16); w.w = e[6] | ((unsigned)e[7] << 16);
            *(u32x4*)((m ? VTW : VTA) + ((size_t)(b * 2 + (rr >> 6)) * 64 + (rr & 63)) * KEYS + j0 + c8 * 8) = w; }
        if (do_hy) { bf16_t* VTb = lat ? VT : VT + VT_CTX_OFF;
          for (int i = F.tid; i < 512 * 8; i += NTHR) { const int cch = i >> 3, c8 = i & 7;
              const u32x4 w = *(const LAS u32x4*)(HT_l + cch * HROW + c8 * 16);
              *(u32x4*)(VTb + ((size_t)cch * NB + b) * n + p0 + c8 * 8) = w; } }
    }
    __syncthreads();
}

__device__ __forceinline__ void hyena_final_phase(const Fr& F, const Args& a, int l, bool with_ctx) {
    constexpr int HROW = 144;
    LAS unsigned char* T = F.lds;
    const bf16_t* X0 = (const bf16_t*)(a.ws + WS_H); const bf16_t* VT = (const bf16_t*)(a.ws + WS_VT); const bf16_t* YT = (const bf16_t*)(a.ws + WS_YT);
    unsigned char* YH = a.ws + WS_Y8 + 512;
    const float* FN = (const float*)(a.ws + WS_FNORM) + l * 1024; const float* skip = a.in[I_HBIAS] + l * 512;
    const int nunits = with_ctx ? NB * 36 : NB * 32;
    for (int unit = F.bid; unit < nunits; unit += F.G) {
        const bool lat = unit < NB * 32;
        const int b = lat ? unit >> 5 : (unit - NB * 32) >> 2, p0 = lat ? (unit & 31) * 64 : ((unit - NB * 32) & 3) * 64;
        const int n = lat ? SEQ : CTX; const int row0 = lat ? b * SEQ + p0 : TL + b * CTX + p0;
        const bf16_t* Yb = lat ? YT : YT + VT_CTX_OFF; const bf16_t* Vb = lat ? VT : VT + VT_CTX_OFF; const float* inv = FN + (lat ? 0 : 512);
        __syncthreads();
        for (int i = F.tid; i < 512 * 8; i += NTHR) { const int cch = i >> 3, c8 = i & 7; const size_t off = ((size_t)cch * NB + b) * n + p0 + c8 * 8;
            const u32x4 y = *(const u32x4*)(Yb + off), v = *(const u32x4*)(Vb + off); const float s = inv[cch], k = skip[cch];
            u32x4 o;
            o.x = cvtpk(bflo(y.x) * s + k * bflo(v.x), bfhi(y.x) * s + k * bfhi(v.x)); o.y = cvtpk(bflo(y.y) * s + k * bflo(v.y), bfhi(y.y) * s + k * bfhi(v.y));
            o.z = cvtpk(bflo(y.z) * s + k * bflo(v.z), bfhi(y.z) * s + k * bfhi(v.z)); o.w = cvtpk(bflo(y.w) * s + k * bflo(v.w), bfhi(y.w) * s + k * bfhi(v.w));
            *(LAS u32x4*)(T + cch * HROW + c8 * 16) = o; }
        __syncthreads();
        { const int th = F.tid & 255, half = F.tid >> 8, c = 2 * th;
          for (int t = 32 * half; t < 32 * half + 32; ++t) {
              const unsigned x0 = *(const unsigned*)(X0 + (size_t)(row0 + t) * 512 + c);
              const float y0 = bf1(*(const LAS bf16_t*)(T + c * HROW + t * 2)), y1 = bf1(*(const LAS bf16_t*)(T + (c + 1) * HROW + t * 2));
              *(unsigned short*)(YH + (size_t)(row0 + t) * 1536 + c) = (unsigned short)__builtin_amdgcn_cvt_pk_fp8_f32(clamp_fp8(bflo(x0) * y0 * 16.f), clamp_fp8(bfhi(x0) * y1 * 16.f), 0, false); } }
    }
    __syncthreads();
}

#define MFMA32(a, b, c) __builtin_amdgcn_mfma_f32_32x32x16_bf16((a), (b), (c), 0, 0, 0)
#define MFMA16(a, b, c) __builtin_amdgcn_mfma_f32_16x16x32_bf16((a), (b), (c), 0, 0, 0)

__device__ __forceinline__ int tile_off(int row, int chunk) { return row * 128 + ((chunk ^ ((row >> 1) & 7)) << 4); }

template <bool WIN>
__device__ __forceinline__ void attn_unit(const Fr& F, const bf16_t* Qw, unsigned char* Yw, const bf16_t* Kb, const bf16_t* VTb, int a0, int na, int b0, int nb, int qpos0, bool has_sink, float sink2, const float* g64, bool rope, const float* ct, const float* st) {
    LAS unsigned char* L = F.lds;
    const int r = F.lane & 31, h = F.lane >> 5;
    const int xaddr = (lane_id() ^ 32) << 2;
#define SWAP32(v) __builtin_bit_cast(float, __builtin_amdgcn_ds_bpermute(xaddr, __builtin_bit_cast(int, (v))))
    bf16x8 q[4];
    {
        float x[4][8]; float ss = 0.f;
#pragma unroll
        for (int kk = 0; kk < 4; ++kk) { const u32x4 w = *(const u32x4*)(Qw + (size_t)r * 1536 + 16 * kk + 8 * h); unpack8(w, x[kk]);
#pragma unroll
            for (int j = 0; j < 8; ++j) ss += x[kk][j] * x[kk][j]; }
        ss += SWAP32(ss);
        const float rn = (1.f / sqrtf(ss * (1.f / 64.f) + EPS)) * QSCALE;
#pragma unroll
        for (int kk = 0; kk < 4; ++kk) { const f32x4 g0 = *(const f32x4*)(g64 + 16 * kk + 8 * h), g1 = *(const f32x4*)(g64 + 16 * kk + 8 * h + 4);
            x[kk][0] *= rn * g0.x; x[kk][1] *= rn * g0.y; x[kk][2] *= rn * g0.z; x[kk][3] *= rn * g0.w; x[kk][4] *= rn * g1.x; x[kk][5] *= rn * g1.y; x[kk][6] *= rn * g1.z; x[kk][7] *= rn * g1.w; }
        if (rope) { const int pos = qpos0 + r;
#pragma unroll
            for (int ax = 0; ax < 2; ++ax) {
                const f32x4 c0 = *(const f32x4*)(ct + pos * 32 + ax * 16 + 8 * h), c1 = *(const f32x4*)(ct + pos * 32 + ax * 16 + 8 * h + 4);
                const f32x4 s0 = *(const f32x4*)(st + pos * 32 + ax * 16 + 8 * h), s1 = *(const f32x4*)(st + pos * 32 + ax * 16 + 8 * h + 4);
                const float cs[8] = {c0.x, c0.y, c0.z, c0.w, c1.x, c1.y, c1.z, c1.w}, sn[8] = {s0.x, s0.y, s0.z, s0.w, s1.x, s1.y, s1.z, s1.w};
#pragma unroll
                for (int j = 0; j < 8; ++j) { const float av = x[2 * ax][j], bv = x[2 * ax + 1][j]; x[2 * ax][j] = av * cs[j] - bv * sn[j]; x[2 * ax + 1][j] = bv * cs[j] + av * sn[j]; } } }
#pragma unroll
        for (int kk = 0; kk < 4; ++kk) q[kk] = __builtin_bit_cast(bf16x8, pack8(x[kk]));
    }
    f32x16 o0, o1;
#pragma unroll
    for (int i = 0; i < 16; ++i) { o0[i] = 0.f; o1[i] = 0.f; }
    float lsum = 0.f;
    const int ntile = na + nb;
    const int srow = F.tid >> 3, sch = F.tid & 7;
    const int soff = tile_off(srow, sch);
    int t4[4];
#pragma unroll
    for (int j = 0; j < 4; ++j) t4[j] = tile_off(r, 2 * j + h);
#define AT_KT(i) ((i) < na ? a0 + (i) : b0 + ((i) - na))
#define AT_LD(i, K0, K1, V0, V1) do { const int kt_ = AT_KT(i); \
        K0 = *(const u32x4*)(Kb + (size_t)(kt_ * 128 + srow) * 128 + sch * 8); K1 = *(const u32x4*)(Kb + (size_t)(kt_ * 128 + 64 + srow) * 128 + sch * 8); \
        V0 = *(const u32x4*)(VTb + (size_t)srow * KEYS + kt_ * 128 + sch * 8); V1 = *(const u32x4*)(VTb + (size_t)srow * KEYS + kt_ * 128 + 64 + sch * 8); } while (0)
#define AT_ST(buf, K0, K1, V0, V1) do { LAS unsigned char* B_ = L + (buf) * 32768 + soff; \
        *(LAS u32x4*)(B_) = K0; *(LAS u32x4*)(B_ + 8192) = K1; *(LAS u32x4*)(B_ + 16384) = V0; *(LAS u32x4*)(B_ + 24576) = V1; } while (0)
#define AT_QK(S0, S1, Kt) do { bf16x8 kf_[8]; \
        _Pragma("unroll") for (int kk = 0; kk < 4; ++kk) { kf_[2 * kk] = *(const LAS bf16x8*)(L + (Kt) + t4[kk]); kf_[2 * kk + 1] = *(const LAS bf16x8*)(L + (Kt) + t4[kk] + 4096); } \
        _Pragma("unroll") for (int i_ = 0; i_ < 16; ++i_) { S0[i_] = 0.f; S1[i_] = 0.f; } \
        _Pragma("unroll") for (int kk = 0; kk < 4; ++kk) { S0 = MFMA32(kf_[2 * kk], q[kk], S0); S1 = MFMA32(kf_[2 * kk + 1], q[kk], S1); } } while (0)
#define AT_EXP(S0, S1, P, kpos0) do { \
        if (WIN && (kpos0) >= 0) { const int kbase = (kpos0) + 4 * h, qp = qpos0 + r; \
            _Pragma("unroll") for (int i = 0; i < 16; ++i) { const int kr = (i & 3) + 8 * (i >> 2); const int d0 = kbase + kr - qp, d1 = d0 + 32; \
                if (d0 > 128 || d0 < -128) S0[i] = -1e30f; if (d1 > 128 || d1 < -128) S1[i] = -1e30f; } } \
        _Pragma("unroll") for (int i = 0; i < 16; ++i) { S0[i] = fast_exp2(S0[i]); S1[i] = fast_exp2(S1[i]); lsum += S0[i] + S1[i]; } \
        { u32x4 w; \
          w.x = cvtpk(S0[0], S0[1]); w.y = cvtpk(S0[2], S0[3]); w.z = cvtpk(S0[4], S0[5]); w.w = cvtpk(S0[6], S0[7]); P[0] = __builtin_bit_cast(bf16x8, w); \
          w.x = cvtpk(S0[8], S0[9]); w.y = cvtpk(S0[10], S0[11]); w.z = cvtpk(S0[12], S0[13]); w.w = cvtpk(S0[14], S0[15]); P[1] = __builtin_bit_cast(bf16x8, w); \
          w.x = cvtpk(S1[0], S1[1]); w.y = cvtpk(S1[2], S1[3]); w.z = cvtpk(S1[4], S1[5]); w.w = cvtpk(S1[6], S1[7]); P[2] = __builtin_bit_cast(bf16x8, w); \
          w.x = cvtpk(S1[8], S1[9]); w.y = cvtpk(S1[10], S1[11]); w.z = cvtpk(S1[12], S1[13]); w.w = cvtpk(S1[14], S1[15]); P[3] = __builtin_bit_cast(bf16x8, w); } } while (0)
#define AT_PV(P, Vt) do { bf16x8 vf_[8]; \
        _Pragma("unroll") for (int c = 0; c < 4; ++c) { vf_[2 * c] = *(const LAS bf16x8*)(L + (Vt) + t4[c]); vf_[2 * c + 1] = *(const LAS bf16x8*)(L + (Vt) + t4[c] + 4096); } \
        _Pragma("unroll") for (int c = 0; c < 4; ++c) { o0 = MFMA32(vf_[2 * c], P[c], o0); o1 = MFMA32(vf_[2 * c + 1], P[c], o1); } } while (0)
#define AT_BODY(it) do { \
        const int kt = AT_KT(it); \
        if ((it) + 1 < ntile) AT_LD((it) + 1, kA0, kA1, vA0, vA1); \
        const int Bc = ((it) & 1) * 32768;                                \
        const int kp = (WIN && kt >= 2) ? (kt - 2) * 128 : -1;            \
        { f32x16 sa0, sa1; bf16x8 pa[4]; \
          AT_QK(sa0, sa1, Bc); AT_EXP(sa0, sa1, pa, kp); AT_PV(pa, Bc + 16384); } \
        __builtin_amdgcn_sched_barrier(0); \
        { f32x16 sb0, sb1; bf16x8 pb_[4]; \
          AT_QK(sb0, sb1, Bc + 8192); AT_EXP(sb0, sb1, pb_, (kp < 0 ? -1 : kp + 64)); AT_PV(pb_, Bc + 24576); } \
        if ((it) + 1 < ntile) AT_ST(((it) + 1) & 1, kA0, kA1, vA0, vA1); \
        __syncthreads(); } while (0)
    u32x4 kA0, kA1, vA0, vA1;
    AT_LD(0, kA0, kA1, vA0, vA1);
    __syncthreads();
    AT_ST(0, kA0, kA1, vA0, vA1);
    __syncthreads();
    for (int it = 0; it < ntile; it += 2) {
        AT_BODY(it);
        if (it + 1 < ntile) AT_BODY(it + 1);
    }
#undef AT_BODY
#undef AT_QK
#undef AT_EXP
#undef AT_PV
#undef AT_ST
#undef AT_LD
#undef AT_KT
    float lt = lsum + SWAP32(lsum);
    if (has_sink) lt += fast_exp2(sink2);
    const float inv = 1.f / lt;
#pragma unroll
    for (int g = 0; g < 4; ++g) { const float i16 = inv * 16.f;
        *(unsigned*)(Yw + (size_t)r * 1536 + 8 * g + 4 * h) = cvt4_fp8(o0[4 * g] * i16, o0[4 * g + 1] * i16, o0[4 * g + 2] * i16, o0[4 * g + 3] * i16);
        *(unsigned*)(Yw + (size_t)r * 1536 + 32 + 8 * g + 4 * h) = cvt4_fp8(o1[4 * g] * i16, o1[4 * g + 1] * i16, o1[4 * g + 2] * i16, o1[4 * g + 3] * i16); }
#undef SWAP32
}

__device__ __forceinline__ void hyena_unit_lat(const Fr& F, const bf16_t* Fg, const bf16_t* Vg, bf16_t* Yg) {
    constexpr int FREP = 8192 + 64, VPIT = 4096 + 16, VOFF = 8 * FREP;
    LAS unsigned char* L = F.lds;
    __syncthreads();
    { const int x = F.tid;
      const u32x4 lo = *(const u32x4*)(Fg + x * 8); u32x4 hi; if (x < 511) hi = *(const u32x4*)(Fg + x * 8 + 8); else { const unsigned z = zero_u32(); hi = (u32x4){z, z, z, z}; }
      const unsigned wv[8] = {lo.x, lo.y, lo.z, lo.w, hi.x, hi.y, hi.z, hi.w};
      *(LAS u32x4*)(L + x * 16) = lo;
#pragma unroll
      for (int rho = 1; rho < 8; ++rho) { u32x4 o;
          unsigned od[4];
#pragma unroll
          for (int d = 0; d < 4; ++d) { const int ob = 4 * d + 2 * rho, i = ob >> 2, s = ob & 3; od[d] = __builtin_amdgcn_alignbyte(wv[i + 1 < 8 ? i + 1 : 7], wv[i], s); }
          o.x = od[0]; o.y = od[1]; o.z = od[2]; o.w = od[3];
          *(LAS u32x4*)(L + rho * FREP + x * 16) = o; } }
    for (int i = F.tid; i < 16 * 256; i += NTHR) { const int b = i >> 8, x = i & 255; *(LAS u32x4*)(L + VOFF + b * VPIT + x * 16) = *(const u32x4*)(Vg + (size_t)b * SEQ + x * 8); }
    __syncthreads();
    const int i16 = F.lane & 15, q4 = F.lane >> 4, w = F.wave;
    const int base0 = 2047 - 256 * w - i16 + 8 * q4;
    const int rho = base0 & 7;
    LAS unsigned char* Ap = L + rho * FREP + (base0 - rho) * 2;
    LAS unsigned char* Bp = L + VOFF + i16 * VPIT + q4 * 16;
    bf16x8 A[16]; f32x4 acc[16];
#pragma unroll
    for (int rr = 0; rr < 16; ++rr) { A[rr] = *(const LAS bf16x8*)(Ap - 32 * rr); acc[rr] = (f32x4){0.f, 0.f, 0.f, 0.f}; }
    bf16x8 Bn = *(const LAS bf16x8*)(Bp);
    for (int o = 0; o < 8; ++o) {
#pragma unroll
        for (int u = 0; u < 8; ++u) {
            const int st = o * 8 + u;
            const bf16x8 Bf = Bn;
            if (st < 63) Bn = *(const LAS bf16x8*)(Bp + 64 * st + 64);
#pragma unroll
            for (int rr = 0; rr < 16; ++rr) acc[rr] = MFMA16(A[(rr - 2 * u) & 15], Bf, acc[rr]);
            if (st < 63) { A[(-2 * u - 2) & 15] = *(const LAS bf16x8*)(Ap + 64 * st + 64); A[(-2 * u - 1) & 15] = *(const LAS bf16x8*)(Ap + 64 * st + 32); }
        }
    }
#pragma unroll
    for (int rr = 0; rr < 16; ++rr) { u32x2 wv; wv.x = cvtpk(acc[rr].x, acc[rr].y); wv.y = cvtpk(acc[rr].z, acc[rr].w);
        *(u32x2*)(Yg + (size_t)i16 * SEQ + 256 * w + 16 * rr + 4 * q4) = wv; }
}
__device__ __forceinline__ void hyena_unit_ctx(const Fr& F, const bf16_t* Fg, const bf16_t* Vg, bf16_t* Yg) {
    constexpr int FREP = 1024 + 64, VPIT = 512 + 16, VOFF = 8 * FREP;
    LAS unsigned char* L = F.lds;
    __syncthreads();
    if (F.tid < 64) *(LAS u32x4*)(L + F.tid * 16) = *(const u32x4*)(Fg + F.tid * 8);
    if (F.tid >= 64 && F.tid < 68) { const unsigned z = zero_u32(); *(LAS u32x4*)(L + 1024 + (F.tid - 64) * 16) = (u32x4){z, z, z, z}; }
    { const int b = F.tid >> 5, x = F.tid & 31; *(LAS u32x4*)(L + VOFF + b * VPIT + x * 16) = *(const u32x4*)(Vg + (size_t)b * CTX + x * 8); }
    __syncthreads();
    for (int i = F.tid; i < 7 * 256; i += NTHR) { const int rho = 1 + i / 256, x2 = (i % 256) * 2; const int s0 = x2 + rho, s1 = x2 + 1 + rho;
        const unsigned e0 = s0 < 512 ? *(const LAS bf16_t*)(L + s0 * 2) : 0, e1 = s1 < 512 ? *(const LAS bf16_t*)(L + s1 * 2) : 0;
        *(LAS unsigned*)(L + rho * FREP + x2 * 2) = e0 | (e1 << 16); }
    __syncthreads();
    const int i16 = F.lane & 15, q4 = F.lane >> 4, w = F.wave;
    const int base0 = 255 - 32 * w - i16 + 8 * q4, rho = base0 & 7;
    LAS unsigned char* Ap = L + rho * FREP + (base0 - rho) * 2;
    LAS unsigned char* Bp = L + VOFF + i16 * VPIT + q4 * 16;
    f32x4 acc0 = (f32x4){0.f, 0.f, 0.f, 0.f}, acc1 = acc0;
#pragma unroll
    for (int st = 0; st < 8; ++st) { const bf16x8 Bf = *(const LAS bf16x8*)(Bp + 64 * st);
        const bf16x8 A0 = *(const LAS bf16x8*)(Ap + 64 * st), A1 = *(const LAS bf16x8*)(Ap + 64 * st - 32);
        acc0 = MFMA16(A0, Bf, acc0); acc1 = MFMA16(A1, Bf, acc1); }
    u32x2 wv; wv.x = cvtpk(acc0.x, acc0.y); wv.y = cvtpk(acc0.z, acc0.w); *(u32x2*)(Yg + (size_t)i16 * CTX + 32 * w + 4 * q4) = wv;
    wv.x = cvtpk(acc1.x, acc1.y); wv.y = cvtpk(acc1.z, acc1.w); *(u32x2*)(Yg + (size_t)i16 * CTX + 32 * w + 16 + 4 * q4) = wv;
}

__device__ __forceinline__ void mixer_phase(const Fr& F, const Args& a, int l, bool with_ctx, unsigned long long& sacc, const int swhich) {
#if defined(PROBE_P)
    unsigned long long st0 = __builtin_amdgcn_s_memrealtime();
#define SUBMARK(w) do { const unsigned long long t_ = __builtin_amdgcn_s_memrealtime(); if (swhich == (w)) sacc += t_ - st0; st0 = t_; } while (0)
#else
#define SUBMARK(w) do { } while (0)
#endif
    const bf16_t* QA = (const bf16_t*)(a.ws + WS_QA);
    unsigned char* Y8 = a.ws + WS_Y8;
    const bf16_t* KA = (const bf16_t*)(a.ws + WS_KA); const bf16_t* KW = (const bf16_t*)(a.ws + WS_KW);
    const bf16_t* VTA = (const bf16_t*)(a.ws + WS_VTA); const bf16_t* VTW = (const bf16_t*)(a.ws + WS_VTW);
    const float* sinks = a.in[I_SINK] + l * 8; const float* qkg = a.in[I_QKG] + l * 256;
    const float* ct = (const float*)(a.ws + WS_ROPE); const float* st = ct + SEQ * 32;
    const int wq = F.wave >> 1, wh = F.wave & 1;
    const int ubid = (F.G % 8 == 0) ? (F.bid & 7) * (F.G >> 3) + (F.bid >> 3) : F.bid;
#define RELANE(FX) do { int t_ = F.wave * 64 + lane_id(); asm volatile("" : "+v"(t_)); FX.tid = t_; FX.lane = t_ & 63; } while (0)
    Fr FA = F; RELANE(FA);
    const int nctx = with_ctx ? NB * 2 * 4 : 0;
    for (int unit = ubid; unit < NB * 2 * 32 + nctx; unit += F.G) {
        const bool isc = unit >= NB * 2 * 32; const int u2 = unit - NB * 2 * 32;
        const int b = isc ? u2 >> 3 : unit >> 6, kvh = isc ? (u2 >> 2) & 1 : (unit >> 5) & 1, pb = isc ? u2 & 3 : unit & 31;
        const size_t qo = (size_t)((isc ? TL + b * CTX : b * SEQ) + pb * 64 + wh * 32) * 1536 + (kvh * 4 + wq) * 64;
        attn_unit<false>(FA, QA + qo, Y8 + qo, KA + (size_t)b * KEYS * 128 + kvh * 64, VTA + (size_t)(b * 2 + kvh) * 64 * KEYS, 0, isc ? 2 : KEYS / 128, 0, 0, isc ? 0 : pb * 64 + wh * 32, false, 0.f, qkg, !isc, ct, st);
    }
    SUBMARK(30);
    Fr FW = F; RELANE(FW);
    for (int unit = ubid; unit < NB * 2 * 32 + nctx; unit += F.G) {
        const bool isc = unit >= NB * 2 * 32; const int u2 = unit - NB * 2 * 32;
        const int b = isc ? u2 >> 3 : unit >> 6, kvh = isc ? (u2 >> 2) & 1 : (unit >> 5) & 1, pb = isc ? u2 & 3 : unit & 31;
        const size_t qo = (size_t)((isc ? TL + b * CTX : b * SEQ) + pb * 64 + wh * 32) * 1536 + (kvh * 4 + wq) * 64 + 1024;
        const int lo = pb < 2 ? 0 : (pb - 2) >> 1, hi = ((64 * pb + 191) >> 7) > 15 ? 15 : ((64 * pb + 191) >> 7);
        attn_unit<true>(FW, QA + qo, Y8 + qo, KW + (size_t)b * KEYS * 128 + kvh * 64, VTW + (size_t)(b * 2 + kvh) * 64 * KEYS, 0, 2, isc ? 0 : 2 + lo, isc ? 0 : hi - lo + 1, isc ? 0 : pb * 64 + wh * 32, true, sinks[kvh * 4 + wq] * LOG2E, qkg + 128, !isc, ct, st);
    }
    SUBMARK(31);
    SUBMARK(32);
    const bf16_t* FL = (const bf16_t*)(a.ws + WS_FL) + (size_t)l * 512 * 4096; const bf16_t* FC = (const bf16_t*)(a.ws + WS_FC) + (size_t)l * 512 * 512;
    const bf16_t* VT = (const bf16_t*)(a.ws + WS_VT); bf16_t* YT = (bf16_t*)(a.ws + WS_YT);
    Fr FH = F; RELANE(FH);
    for (int c = F.bid; c < HYW; c += F.G) hyena_unit_lat(FH, FL + (size_t)c * 4096, VT + (size_t)c * NB * SEQ, YT + (size_t)c * NB * SEQ);
    if (with_ctx) for (int c = F.bid; c < HYW; c += F.G) hyena_unit_ctx(FH, FC + (size_t)c * 512, VT + VT_CTX_OFF + (size_t)c * NB * CTX, YT + VT_CTX_OFF + (size_t)c * NB * CTX);
    __syncthreads();
    SUBMARK(33);
#undef SUBMARK
#undef RELANE
}

__device__ __forceinline__ float gate_q(float x) { return fminf(256.f * sigmoid_f(x), 255.49f); }
__device__ __forceinline__ unsigned pack_u8x4(float a, float b, float c, float d) { return (unsigned)(int)a | ((unsigned)(int)b << 8) | ((unsigned)(int)c << 16) | ((unsigned)(int)d << 24); }
__device__ __forceinline__ float gq(unsigned w, int k) { return (float)((w >> (8 * k)) & 0xffu) + 0.5f; }
struct EpiInProj {
    static constexpr bool PERM = true, AFTER_DRAIN = false; static constexpr int NSEG = 1;
    unsigned char* ws; int pn_off;
    __device__ __forceinline__ void operator()(const pg8::f32x4 (&acc)[2][2][4][2], const pg8::Unit& u, int wr, int wc, int fr, int fq) const {
        asm volatile("" : "+v"(fr), "+v"(fq));
        const int pn = __builtin_amdgcn_readfirstlane(u.pn) + pn_off; unsigned long long boff; int ldc, colt; bool sig = false;
        if (pn < 2) { boff = WS_QA; ldc = 1536; colt = pn * 256; }
        else if (pn == 2) { boff = WS_RAWA; ldc = 256; colt = 0; }
        else if (pn < 9) { boff = WS_U; ldc = 1536; colt = (pn - 3) * 256; }
        else if (pn < 11) { boff = WS_QA; ldc = 1536; colt = 1024 + (pn - 9) * 256; }
        else if (pn == 11) { boff = WS_RAWW; ldc = 256; colt = 0; }
        else { boff = WS_G; ldc = 3072; colt = (pn - 12) * 256; sig = true; }
        bf16_t* base = (bf16_t*)(ws + boff); unsigned char* Gt = ws + boff;
        const int row0 = u.pm * 256 + wr * 64 + fr, col0 = colt + wc * 32 + 8 * fq;
        if (sig) {
            unsigned char* gb = (unsigned char*)Gt;
#pragma unroll
            for (int ai = 0; ai < 2; ++ai)
#pragma unroll
                for (int m = 0; m < 4; ++m) { unsigned char* rowp = gb + (size_t)(row0 + ai * 128 + m * 16) * 3072 + col0;
#pragma unroll
                    for (int bj = 0; bj < 2; ++bj) { const pg8::f32x4 v0 = acc[ai][bj][m][0], v1 = acc[ai][bj][m][1];
                        u32x2 w; w.x = pack_u8x4(gate_q(v0.x), gate_q(v0.y), gate_q(v0.z), gate_q(v0.w)); w.y = pack_u8x4(gate_q(v1.x), gate_q(v1.y), gate_q(v1.z), gate_q(v1.w));
                        *(u32x2*)(rowp + bj * 128) = w; } }
            return;
        }
#pragma unroll
        for (int ai = 0; ai < 2; ++ai)
#pragma unroll
            for (int m = 0; m < 4; ++m) { bf16_t* rowp = base + (size_t)(row0 + ai * 128 + m * 16) * ldc + col0;
#pragma unroll
                for (int bj = 0; bj < 2; ++bj) { const pg8::f32x4 v0 = acc[ai][bj][m][0], v1 = acc[ai][bj][m][1];
                    u32x4 w; w.x = cvtpk(v0.x, v0.y); w.y = cvtpk(v0.z, v0.w); w.z = cvtpk(v1.x, v1.y); w.w = cvtpk(v1.z, v1.w);
                    *(u32x4*)(rowp + bj * 128) = w; } }
    }
};
struct EpiGate {
    static constexpr bool PERM = true, AFTER_DRAIN = false; static constexpr int NSEG = 1;
    unsigned char* Gt;
    __device__ __forceinline__ void operator()(const pg8::f32x4 (&acc)[2][2][4][2], const pg8::Unit& u, int wr, int wc, int fr, int fq) const {
        asm volatile("" : "+v"(fr), "+v"(fq));
        const int row0 = u.pm * 256 + wr * 64 + fr, col0 = u.pn * 256 + wc * 32 + 8 * fq;
#pragma unroll
        for (int ai = 0; ai < 2; ++ai)
#pragma unroll
            for (int m = 0; m < 4; ++m) { unsigned char* rowp = Gt + (size_t)(row0 + ai * 128 + m * 16) * 3072 + col0;
#pragma unroll
                for (int bj = 0; bj < 2; ++bj) { const pg8::f32x4 v0 = acc[ai][bj][m][0], v1 = acc[ai][bj][m][1];
                    u32x2 w; w.x = pack_u8x4(gate_q(v0.x), gate_q(v0.y), gate_q(v0.z), gate_q(v0.w)); w.y = pack_u8x4(gate_q(v1.x), gate_q(v1.y), gate_q(v1.z), gate_q(v1.w));
                    *(u32x2*)(rowp + bj * 128) = w; } }
    }
};
struct EpiMerge {
    static constexpr bool PERM = true, AFTER_DRAIN = false; static constexpr int NSEG = 3;
    unsigned char* Mo; const unsigned char* Gt;
    __device__ __forceinline__ void rescale(pg8::f32x4 (&acc)[2][2][4][2], const pg8::Unit& u, int seg, int wr, int wc, int fr, int fq) const {
        asm volatile("" : "+v"(fr), "+v"(fq));
        const int row0 = u.pm * 256 + wr * 64 + fr, col0 = u.pn * 256 + wc * 32 + 8 * fq;
        const unsigned char* G0 = Gt + seg * 1024 + col0;
        u32x2 ga[2][4][2], gb[2][4][2];
#pragma unroll
        for (int ai = 0; ai < 2; ++ai)
#pragma unroll
            for (int m = 0; m < 4; ++m)
#pragma unroll
                for (int bj = 0; bj < 2; ++bj) { const size_t row = (size_t)(row0 + ai * 128 + m * 16);
                    ga[ai][m][bj] = *(const u32x2*)(G0 + row * 3072 + bj * 128); gb[ai][m][bj] = *(const u32x2*)(G0 + row * 3072 + 1024 + bj * 128); }
        __builtin_amdgcn_sched_barrier(0);
#pragma unroll
        for (int ai = 0; ai < 2; ++ai)
#pragma unroll
            for (int m = 0; m < 4; ++m)
#pragma unroll
                for (int bj = 0; bj < 2; ++bj) { const u32x2 a = ga[ai][m][bj], b = gb[ai][m][bj]; pg8::f32x4& v0 = acc[ai][bj][m][0]; pg8::f32x4& v1 = acc[ai][bj][m][1];
                    v0.x *= gq(a.x, 0) * fast_rcp(gq(b.x, 0)); v0.y *= gq(a.x, 1) * fast_rcp(gq(b.x, 1)); v0.z *= gq(a.x, 2) * fast_rcp(gq(b.x, 2)); v0.w *= gq(a.x, 3) * fast_rcp(gq(b.x, 3));
                    v1.x *= gq(a.y, 0) * fast_rcp(gq(b.y, 0)); v1.y *= gq(a.y, 1) * fast_rcp(gq(b.y, 1)); v1.z *= gq(a.y, 2) * fast_rcp(gq(b.y, 2)); v1.w *= gq(a.y, 3) * fast_rcp(gq(b.y, 3)); }
        __builtin_amdgcn_sched_barrier(0);
    }
    __device__ __forceinline__ void operator()(const pg8::f32x4 (&acc)[2][2][4][2], const pg8::Unit& u, int wr, int wc, int fr, int fq) const {
        asm volatile("" : "+v"(fr), "+v"(fq));
        const int row0 = u.pm * 256 + wr * 64 + fr, col0 = u.pn * 256 + wc * 32 + 8 * fq;
        constexpr float S = 16.f / 256.f;
        u32x2 gv[2][4][2];
#pragma unroll
        for (int ai = 0; ai < 2; ++ai)
#pragma unroll
            for (int m = 0; m < 4; ++m)
#pragma unroll
                for (int bj = 0; bj < 2; ++bj) gv[ai][m][bj] = *(const u32x2*)(Gt + (size_t)(row0 + ai * 128 + m * 16) * 3072 + 2048 + col0 + bj * 128);
        __builtin_amdgcn_sched_barrier(0);
#pragma unroll
        for (int ai = 0; ai < 2; ++ai) {
#pragma unroll
            for (int m = 0; m < 4; ++m)
#pragma unroll
                for (int bj = 0; bj < 2; ++bj) { const pg8::f32x4 v0 = acc[ai][bj][m][0], v1 = acc[ai][bj][m][1]; const u32x2 g = gv[ai][m][bj];
                    u32x2 w; w.x = cvt4_fp8(v0.x * (gq(g.x, 0) * S), v0.y * (gq(g.x, 1) * S), v0.z * (gq(g.x, 2) * S), v0.w * (gq(g.x, 3) * S));
                    w.y = cvt4_fp8(v1.x * (gq(g.y, 0) * S), v1.y * (gq(g.y, 1) * S), v1.z * (gq(g.y, 2) * S), v1.w * (gq(g.y, 3) * S));
                    *(u32x2*)(Mo + (size_t)(row0 + ai * 128 + m * 16) * 1024 + col0 + bj * 128) = w; }
            __builtin_amdgcn_sched_barrier(0);
        }
    }
};
struct EpiOut {
    static constexpr bool PERM = true, AFTER_DRAIN = false; static constexpr int NSEG = 1;
    bf16_t* XB; const float* MODl;
    __device__ __forceinline__ void operator()(const pg8::f32x4 (&acc)[2][2][4][2], const pg8::Unit& u, int wr, int wc, int fr, int fq) const {
        asm volatile("" : "+v"(fr), "+v"(fq));
        const int trow = u.pm * 256;
        const int row0 = trow + wr * 64 + fr, col0 = u.pn * 256 + wc * 32 + 8 * fq;
        const float* md = MODl + (size_t)mod_row(trow) * DIN + 2 * 1024 + col0;
        bf16_t* xp = XB + (size_t)row0 * D + col0;
        f32x4 mv[2][2];
#pragma unroll
        for (int bj = 0; bj < 2; ++bj)
#pragma unroll
            for (int n = 0; n < 2; ++n) mv[bj][n] = *(const f32x4*)(md + bj * 128 + 4 * n);
#pragma unroll
        for (int ai = 0; ai < 2; ++ai) {
            u32x4 xv[4][2];
#pragma unroll
            for (int m = 0; m < 4; ++m)
#pragma unroll
                for (int bj = 0; bj < 2; ++bj) xv[m][bj] = *(const u32x4*)(xp + (size_t)(ai * 128 + m * 16) * D + bj * 128);
            __builtin_amdgcn_sched_barrier(0);
#pragma unroll
            for (int m = 0; m < 4; ++m)
#pragma unroll
                for (int bj = 0; bj < 2; ++bj) { const pg8::f32x4 a0 = acc[ai][bj][m][0], a1 = acc[ai][bj][m][1]; const u32x4 x8 = xv[m][bj]; const f32x4 m0 = mv[bj][0], m1 = mv[bj][1];
                    u32x4 o; o.x = cvtpk(fmaf(m0.x, a0.x, bflo(x8.x)), fmaf(m0.y, a0.y, bfhi(x8.x))); o.y = cvtpk(fmaf(m0.z, a0.z, bflo(x8.y)), fmaf(m0.w, a0.w, bfhi(x8.y)));
                    o.z = cvtpk(fmaf(m1.x, a1.x, bflo(x8.z)), fmaf(m1.y, a1.y, bfhi(x8.z))); o.w = cvtpk(fmaf(m1.z, a1.z, bflo(x8.w)), fmaf(m1.w, a1.w, bfhi(x8.w)));
                    *(u32x4*)(xp + (size_t)(ai * 128 + m * 16) * D + bj * 128) = o; }
            __builtin_amdgcn_sched_barrier(0);
        }
    }
};
struct EpiMoe1 {
    static constexpr bool PERM = true, AFTER_DRAIN = false; static constexpr int NSEG = 1;
    unsigned char* HM;
    __device__ __forceinline__ void operator()(const pg8::f32x4 (&acc)[2][2][4][2], const pg8::Unit& u, int wr, int wc, int fr, int fq) const {
        asm volatile("" : "+v"(fr), "+v"(fq));
        const int row0 = u.pm * 256 + wr * 64 + fr, hcol0 = (u.pn & 3) * 128 + wc * 16 + 4 * fq;
#pragma unroll
        for (int ai = 0; ai < 2; ++ai)
#pragma unroll
            for (int m = 0; m < 4; ++m) { unsigned char* rowp = HM + (size_t)(row0 + ai * 128 + m * 16) * 512 + hcol0;
#pragma unroll
                for (int bj = 0; bj < 2; ++bj) { const pg8::f32x4 x = acc[ai][bj][m][0], y = acc[ai][bj][m][1] * 8.f;
                    *(unsigned*)(rowp + bj * 64) = cvt4_fp8(x.x * sigmoid_f(x.x) * y.x, x.y * sigmoid_f(x.y) * y.y, x.z * sigmoid_f(x.z) * y.z, x.w * sigmoid_f(x.w) * y.w); } }
    }
};
struct EpiMoe2 {
    static constexpr bool PERM = true, AFTER_DRAIN = false; static constexpr int NSEG = 1;
    bf16_t* Fo; const int* erow; const float* eroww; const LAS int* ebase; const LAS int* ecnt;
    __device__ __forceinline__ void operator()(const pg8::f32x4 (&acc)[2][2][4][2], const pg8::Unit& u, int wr, int wc, int fr, int fq) const {
        asm volatile("" : "+v"(fr), "+v"(fq));
        const int e = u.pn >> 2, cnt = __builtin_amdgcn_readfirstlane(ecnt[e]), pos0 = u.pm * 256 - __builtin_amdgcn_readfirstlane(ebase[e]) + wr * 64 + fr, col0 = (u.pn & 3) * 256 + wc * 32 + 8 * fq;
        const int* er = erow + (size_t)e * TT; const float* ew = eroww + (size_t)e * TT;
        int rma[2][4]; float wga[2][4];
#pragma unroll
        for (int ai = 0; ai < 2; ++ai)
#pragma unroll
            for (int m = 0; m < 4; ++m) { const int pos = pos0 + ai * 128 + m * 16; const bool ok = pos < cnt; rma[ai][m] = ok ? er[ok ? pos : 0] : -1; wga[ai][m] = ew[ok ? pos : 0]; }
        __builtin_amdgcn_sched_barrier(0);
#pragma unroll
        for (int ai = 0; ai < 2; ++ai) {
#pragma unroll
            for (int m = 0; m < 4; ++m) { const int r1 = rma[ai][m];
                if (r1 >= 0) { const float wgt = wga[ai][m]; bf16_t* rowp = Fo + ((size_t)(r1 & 1) * TT + (r1 >> 1)) * D + col0;
#pragma unroll
                    for (int bj = 0; bj < 2; ++bj) { const pg8::f32x4 v0 = acc[ai][bj][m][0], v1 = acc[ai][bj][m][1];
                        u32x4 w; w.x = cvtpk(v0.x * wgt, v0.y * wgt); w.y = cvtpk(v0.z * wgt, v0.w * wgt); w.z = cvtpk(v1.x * wgt, v1.y * wgt); w.w = cvtpk(v1.z * wgt, v1.w * wgt);
                        *(u32x4*)(rowp + bj * 128) = w; } } }
            __builtin_amdgcn_sched_barrier(0);
        }
    }
};
struct FusedOutOrder {
    int c, G, nun, wv; const unsigned* ready; unsigned* tmo;
    __device__ __forceinline__ bool next(int i, pg8::Unit& u) const {
        int q;
        if (!ready) { q = i * G + c; if (q >= nun) return false; }
        else if (G == 256 && nun == 576) { if (c < 64) { if (i > 0) return false; q = 512 + c; } else { q = i * 192 + (c - 64); if (q >= 512) return false; } }
        else { q = i * G + (G - 1 - c); if (q >= nun) return false; }
        u.pm = q >> 2; u.pn = q & 3; return true; }
    __device__ __forceinline__ void a_ready(const pg8::Unit& u) const {
        if (!ready) return;
        if (wv == 0) {
            const unsigned long long t0 = __builtin_amdgcn_s_memrealtime(); unsigned polls = 0;
            while ((unsigned)__builtin_amdgcn_readfirstlane(__hip_atomic_load(ready + 64 * u.pm, __ATOMIC_RELAXED, __HIP_MEMORY_SCOPE_AGENT)) < 32u) {
                if ((++polls & 255u) == 0u && __builtin_amdgcn_readfirstlane(__hip_atomic_load(tmo, __ATOMIC_RELAXED, __HIP_MEMORY_SCOPE_AGENT)) != 0u) break;
                if (__builtin_amdgcn_s_memrealtime() - t0 > 20000000ull) { if (lane_id() == 0) __hip_atomic_store(tmo, 1u, __ATOMIC_RELAXED, __HIP_MEMORY_SCOPE_AGENT); break; }
                __builtin_amdgcn_s_sleep(2); }
            __builtin_amdgcn_fence(__ATOMIC_ACQUIRE, "agent");
            asm volatile("s_waitcnt vmcnt(0)" ::: "memory");
        }
        asm volatile("" ::: "memory"); __builtin_amdgcn_s_barrier(); asm volatile("" ::: "memory");
    }
    __device__ __forceinline__ void done(const pg8::Unit&) const {}
};
struct LastInProjOrder {
    pg8::StaticOrder T; int nlat, G, c;
    __device__ __forceinline__ bool next(int i, pg8::Unit& u) const {
        const int L = i * G + c;
        if (L < nlat) return T.next(i, u);
        const int r = L - nlat; if (r >= 32) return false;
        u.pm = 128 + (r >> 1); u.pn = (r & 1) ? 11 : 2; return true; }
    __device__ __forceinline__ void a_ready(const pg8::Unit&) const {}
    __device__ __forceinline__ void done(const pg8::Unit&) const {}
};
struct MoeOrder {
    int nunits, G, c; const LAS int* tile_e;
    __device__ __forceinline__ bool next(int i, pg8::Unit& u) const {
        const int L0 = i * G + c; if (L0 >= nunits) return false;
        const int q = nunits / 8, r = nunits % 8, xcd = L0 % 8, off = L0 / 8; const int L = (xcd < r ? xcd * (q + 1) : r * (q + 1) + (xcd - r) * q) + off;
        const int pm = L >> 2; u.pm = pm; u.pn = __builtin_amdgcn_readfirstlane(tile_e[pm]) * 4 + (L & 3); return true; }
    __device__ __forceinline__ void a_ready(const pg8::Unit&) const {}
    __device__ __forceinline__ void done(const pg8::Unit&) const {}
};

__device__ __forceinline__ int moe_tables(const Fr& F, const Args& a, int l, LAS int* ebase  , LAS int* ecnt  , LAS int* tile_e  ) {
    const unsigned* CNT = (const unsigned*)(a.ws + WS_CTL) + CW_CNT + l * 256;
    __syncthreads();
    if (F.tid == 0) { int acc = 0;
#pragma unroll 1
        for (int e = 0; e < NE; ++e) { const int c = (int)__hip_atomic_load(&CNT[e * 16], __ATOMIC_RELAXED, __HIP_MEMORY_SCOPE_AGENT); ecnt[e] = c; ebase[e] = acc; const int nt = (c + 255) >> 8;
#pragma unroll 1
            for (int t = 0; t < nt; ++t) tile_e[(acc >> 8) + t] = e;
            acc += nt << 8; }
        ebase[NE] = acc; }
    __syncthreads();
    return ebase[NE] >> 8;
}

__device__ __forceinline__ void moe_gather_table(const Fr& F, const Args& a, const MoeOrder& S, const LAS int* ebase, const LAS int* ecnt, LAS int* gidx) {
    const int* EROW = (const int*)(a.ws + WS_EROW);
    for (int j = 0; j < 16; ++j) { pg8::Unit u; if (!S.next(j, u)) break;
        const int e = u.pn >> 2, pos0 = u.pm * 256 - ebase[e], cnt = ecnt[e];
        if (F.tid < 256) { const int pos = pos0 + F.tid; gidx[j * 256 + F.tid] = pos < cnt ? (EROW[(size_t)e * TT + pos] >> 1) : 0; } }
    __syncthreads();
}

#ifndef MK_PER_PHASE
#define MK_PER_PHASE 0
#endif
constexpr int PH_PER_LAYER = 10, PH_FINAL = 1 + NL * PH_PER_LAYER, N_PHASES = PH_FINAL + 1;

__global__ void __launch_bounds__(NTHR, 2) trunk_fwd(Args args) {
    extern __shared__ __attribute__((aligned(16))) unsigned char lds[];
    Fr F; F.lds = (LAS unsigned char*)lds; F.tid = threadIdx.x; F.lane = F.tid & 63; F.wave = __builtin_amdgcn_readfirstlane(F.tid >> 6); F.G = gridDim.x; F.bid = blockIdx.x;
    const int wave0 = F.wave;
    for (int u = F.tid; u < (LDS_BYTES - MISC_OFF) / 4; u += NTHR) ((LAS unsigned*)(F.lds + MISC_OFF))[u] = 0u;
    __syncthreads();
    const int lo = args.ph_lo, hi = args.ph_hi;
    unsigned* ctl = (unsigned*)(args.ws + WS_CTL);
    XcdBarrier bar; bar.bar = ctl + CW_BAR; bar.x = 0; bar.st = (volatile LAS unsigned*)(F.lds + MISC_OFF);
    if (hi - lo > 1) bar = xcd_barrier_post(ctl + CW_BAR, (volatile LAS unsigned*)(F.lds + MISC_OFF));
    bar.wv = (unsigned)wave0;
#ifndef DBG_ONLY
#define DBG_ONLY -1
#endif
#define SEL(p) (DBG_ONLY < 0 || DBG_ONLY == (p))
#define IN(k) (lo <= (k) && (k) < hi)
#define FRESH() do { int t_ = wave0 * 64 + lane_id(); asm volatile("" : "+v"(t_)); F.tid = t_; F.lane = t_ & 63; F.wave = wave0; } while (0)
#define SEAM(k) do { if (IN(k) && IN((k) + 1)) xcd_barrier(bar); } while (0)
#if !defined(PROBE_SUB)
#define PROBE_SUB -1
#endif
    unsigned long long pr_sub = 0ull;
#if defined(PROBE_P)
    unsigned long long pr_acc = 0ull, pr_t0 = __builtin_amdgcn_s_memrealtime();
#define PR_MARK(p) do { const unsigned long long t_ = __builtin_amdgcn_s_memrealtime(); if ((p) == PROBE_P) pr_acc += t_ - pr_t0; pr_t0 = t_; } while (0)
#else
#define PR_MARK(p) do { } while (0)
#endif
    unsigned char* ws = args.ws;
    LAS int* ebase = (LAS int*)(F.lds + MISC_OFF + 64); LAS int* ecnt = ebase + 20; LAS int* tile_e = (LAS int*)(F.lds + MISC_OFF + 512);

    #ifndef DBG_PRO
#define DBG_PRO 7
#endif
#if defined(PROBE_P)
    if (SEL(100) && IN(0)) { FRESH(); const unsigned long long tq0_ = __builtin_amdgcn_s_memrealtime(); pro_mod(F, args); __syncthreads(); const unsigned long long tq1_ = __builtin_amdgcn_s_memrealtime(); pro_rope(F, args); pro_filter(F, args); __syncthreads();
        const unsigned long long tq2_ = __builtin_amdgcn_s_memrealtime(); if (PROBE_SUB == 60) pr_sub += tq1_ - tq0_; if (PROBE_SUB == 61) pr_sub += tq2_ - tq1_; }
#else
    if (SEL(100) && IN(0)) { FRESH(); if (DBG_PRO & 1) pro_mod(F, args); __syncthreads(); if (DBG_PRO & 2) pro_rope(F, args); if (DBG_PRO & 4) pro_filter(F, args); __syncthreads(); }
#endif
    SEAM(0); PR_MARK(100);
    for (int l = 0; l < NL; ++l) {
        const int pb = 1 + PH_PER_LAYER * l;
#define LVARS() int lq_ = l; asm volatile("" : "+s"(lq_)); const bool uc = lq_ < NL - 1; const int M2 = uc ? TT : TL; (void)M2; (void)uc
        if (SEL(0) && IN(pb + 0)) { LVARS(); FRESH(); if (l == 0) filter_norm_reduce(F, args); conv_small_weights(F, args, l, 7, 0); rows_p0(F, args, l, TT); __syncthreads(); }
        SEAM(pb + 0); PR_MARK(0);
        if (SEL(1) && IN(pb + 1)) { LVARS();
            pg8::Gemm g{(const bf16_t*)(ws + WS_H8), (const bf16_t*)(ws + WS_WG8), TT, DIN, 512}; EpiInProj E{ws, 0};
            if (uc) { pg8::StaticOrder S; S.init(TT, DIN, F.G, F.bid); pg8::gemm_phase<EpiInProj, pg8::StaticOrder, true, true, false, true, -6>(F.lds, g, S, E, wave0); }
            else { LastInProjOrder S; S.T.init(TL, DIN, F.G, F.bid); S.nlat = (TL / 256) * (DIN / 256); S.G = F.G; S.c = F.bid; pg8::gemm_phase<EpiInProj, LastInProjOrder, true, true, false, true, -6>(F.lds, g, S, E, wave0); }
        }
        SEAM(pb + 1); PR_MARK(1);
        if (SEL(2) && IN(pb + 2)) { LVARS(); FRESH(); prep_phase(F, args, l, uc); }
        SEAM(pb + 2); PR_MARK(2);
        if (SEL(3) && IN(pb + 3)) { LVARS(); FRESH(); mixer_phase(F, args, l, uc, pr_sub, PROBE_SUB); }
        SEAM(pb + 3); PR_MARK(3);
        if (SEL(4) && IN(pb + 4)) { LVARS(); FRESH(); hyena_final_phase(F, args, l, uc); }
        SEAM(pb + 4); PR_MARK(4);
        if (SEL(5) && IN(pb + 5)) { LVARS();
            pg8::StaticOrder S; S.init(M2, 1024, F.G, F.bid);
            pg8::Gemm g{(const bf16_t*)(ws + WS_Y8), (const bf16_t*)(ws + WS_WBR), M2, 1024, 768}; EpiMerge E{ws + WS_H, (const unsigned char*)(ws + WS_G)};
            pg8::gemm_phase<EpiMerge, pg8::StaticOrder, true, true, false, true, -10>(F.lds, g, S, E, wave0);
            { FRESH(); __syncthreads(); const int nun = (M2 / 256) * 4, rem = nun % F.G; conv_expert_weights(F, args, l, rem, 0, CONV_E_ITEMS); __syncthreads(); }
        }
        SEAM(pb + 5); PR_MARK(5);
        if (SEL(6) && IN(pb + 6)) { LVARS();
            pg8::Gemm g{(const bf16_t*)(ws + WS_H), (const bf16_t*)(ws + WS_WOUT), M2, 1024, 512}; pg8::StaticOrder S; S.init(M2, 1024, F.G, F.bid);
            EpiOut E{(bf16_t*)(ws + WS_XB), (const float*)(ws + WS_MOD) + (size_t)l * NBM * DIN};
            pg8::gemm_phase<EpiOut, pg8::StaticOrder, true, true, false, true, -10>(F.lds, g, S, E, wave0);
        }
        SEAM(pb + 6); PR_MARK(6);
        if (SEL(7) && IN(pb + 7)) { LVARS(); FRESH(); rows_p5(F, args, l, M2, pr_sub, PROBE_SUB); __syncthreads(); }
        SEAM(pb + 7); PR_MARK(7);
        if (SEL(8) && IN(pb + 8)) { LVARS(); FRESH();
            const int ntile = moe_tables(F, args, l, ebase, ecnt, tile_e);
            pg8::Gemm g{(const bf16_t*)(ws + WS_H), (const bf16_t*)(ws + WS_W13), ntile * 256, NE * 1024, 512}; MoeOrder S{ntile * 4, F.G, F.bid, tile_e};
            LAS int* gidx = (LAS int*)(F.lds + 131072);
            moe_gather_table(F, args, S, ebase, ecnt, gidx);
            EpiMoe1 E{ws + WS_U};
            pg8::gemm_phase<EpiMoe1, MoeOrder, true, true, true, true, -6>(F.lds, g, S, E, wave0, gidx);
        }
        SEAM(pb + 8); PR_MARK(8);
        if (SEL(9) && IN(pb + 9)) { LVARS(); FRESH();
            const int ntile = moe_tables(F, args, l, ebase, ecnt, tile_e);
            pg8::Gemm g{(const bf16_t*)(ws + WS_U), (const bf16_t*)(ws + WS_W2), ntile * 256, NE * 1024, 256}; MoeOrder S{ntile * 4, F.G, F.bid, tile_e};
            EpiMoe2 E{(bf16_t*)(ws + WS_F), (const int*)(ws + WS_EROW), (const float*)(ws + WS_EROWW), ebase, ecnt};
            pg8::gemm_phase<EpiMoe2, MoeOrder, true, true, false, true, -9>(F.lds, g, S, E, wave0);
        }
        SEAM(pb + 9); PR_MARK(9);
    }
    if (SEL(101) && IN(PH_FINAL)) { FRESH(); rows_final(F, args); }
#if defined(PROBE_P)
    PR_MARK(101);
    pr_acc += pr_sub;
#if !defined(PROBE_BLK)
#define PROBE_BLK 0
#endif
    if (blockIdx.x == PROBE_BLK && F.wave == 0) { const unsigned long long t1 = __builtin_amdgcn_s_memrealtime() + 4ull * pr_acc; while (__builtin_amdgcn_s_memrealtime() < t1) __builtin_amdgcn_s_sleep(8); }
#endif
#undef IN
#undef SEAM
}

extern "C" void kernel_launch(void* const* d_in, const int* in_sizes, int n_in, void* d_out, int out_size, void* d_ws, size_t ws_size, hipStream_t stream) {
    static int grid = 0;
    if (grid == 0) {
        if (n_in != 29 || in_sizes[0] != TL * D || out_size != TL * D || ws_size < WS_END) { fprintf(stderr, "kernel_launch: unexpected shapes / workspace (n_in %d, ws %zu < %zu); nothing launched\n", n_in, ws_size, (size_t)WS_END); grid = -1; return; }
        int dev = 0, cus = 0, per_cu = 0;
        if (hipGetDevice(&dev) != hipSuccess || hipDeviceGetAttribute(&cus, hipDeviceAttributeMultiprocessorCount, dev) != hipSuccess) { grid = -1; return; }
        if (hipFuncSetAttribute((const void*)trunk_fwd, hipFuncAttributeMaxDynamicSharedMemorySize, LDS_BYTES) != hipSuccess) { fprintf(stderr, "kernel_launch: hipFuncSetAttribute failed\n"); grid = -1; return; }
        if (hipOccupancyMaxActiveBlocksPerMultiprocessor(&per_cu, (const void*)trunk_fwd, NTHR, LDS_BYTES) != hipSuccess || per_cu < 1) { fprintf(stderr, "kernel_launch: occupancy query reports %d\n", per_cu); }
        (void)hipGetLastError();
        grid = cus;
    }
    if (grid < 0) return;
    (void)hipMemsetAsync((char*)d_ws + WS_CTL, 0, CTL_ZERO_BYTES, stream);
    Args a{};
    for (int i = 0; i < 29; ++i) a.in[i] = (const float*)d_in[i];
    a.out = (float*)d_out; a.ws = (unsigned char*)d_ws;
#if MK_PER_PHASE
    for (int k = 0; k < N_PHASES; ++k) { a.ph_lo = k; a.ph_hi = k + 1; hipLaunchKernelGGL(trunk_fwd, dim3(grid), dim3(NTHR), LDS_BYTES, stream, a); }
#else
    a.ph_lo = 0; a.ph_hi = N_PHASES;
    hipLaunchKernelGGL(trunk_fwd, dim3(grid), dim3(NTHR), LDS_BYTES, stream, a);
#endif
}
```

```cpp
#include <hip/hip_runtime.h>
#include <cstdio>
#include <cstdint>

#define GAS __attribute__((address_space(1)))
#define LAS __attribute__((address_space(3)))
__device__ __forceinline__ int lane_id() { int l; asm volatile("v_mbcnt_lo_u32_b32 %0, -1, 0\n\tv_mbcnt_hi_u32_b32 %0, -1, %0" : "=v"(l)); return l; }
#define MK_PER_PHASE 0
namespace pg8 {
#define PG8_LAS __attribute__((address_space(3)))
typedef unsigned short bf16_t;
typedef short bf16x8 __attribute__((ext_vector_type(8)));
typedef float f32x4 __attribute__((ext_vector_type(4)));
typedef unsigned u32x4 __attribute__((ext_vector_type(4)));
constexpr int BM = 256, BK = 64, HALF = 128, HTB = HALF * BK * 2  , STAGE_BYTES = 8 * HTB, NXCD = 8, WGM = 8;

__host__ __device__ __forceinline__ int lds_byte(int r, int c) { const int st = (r >> 4) * 2 + (c >> 5), rr = r & 15, cc = c & 31, ob = rr * 64 + cc * 2; return st * 1024 + (ob ^ (((ob >> 9) & 1) << 5)); }
__host__ __device__ __forceinline__ void stage_rc(int b, int& R, int& C) { const int st = b / 1024, sb = b % 1024, swz = sb ^ (((sb >> 9) & 1) << 5); R = (st >> 1) * 16 + swz / 64; C = (st & 1) * 32 + (swz % 64) / 2; }
__host__ __device__ __forceinline__ int perm32(int rho) { const int n = rho >> 4, i = rho & 15; return 8 * (i >> 2) + 4 * n + (i & 3); }

struct Unit { int pm, pn; };
struct Gemm { const bf16_t* A; const bf16_t* Bt; int M, N, K; };

struct StaticOrder {
    int nM, nN, nwg, G, c;
    __host__ __device__ void init(int M, int N, int G_, int c_) { nM = M / BM; nN = N / BM; nwg = nM * nN; G = G_; c = c_; }
    __host__ __device__ bool next(int i, Unit& u) const {
        const long L = (long)i * G + c; if (L >= nwg) return false;
        int wgid = (int)L; { const int q = nwg / NXCD, r = nwg % NXCD, xcd = wgid % NXCD, off = wgid / NXCD; wgid = (xcd < r ? xcd * (q + 1) : r * (q + 1) + (xcd - r) * q) + off; }
        const int nig = WGM * nN, gid = wgid / nig, fm = gid * WGM, gsz = (nM - fm) < WGM ? (nM - fm) : WGM;
        u.pm = fm + ((wgid % nig) % gsz); u.pn = (wgid % nig) / gsz; return true;
    }
    __device__ __forceinline__ void a_ready(const Unit&) const {}
    __device__ __forceinline__ void done(const Unit&) const {}
};
__device__ __forceinline__ unsigned cvt_pk_bf16(float lo, float hi) { unsigned r; asm volatile("v_cvt_pk_bf16_f32 %0, %1, %2" : "=v"(r) : "v"(lo), "v"(hi)); return r; }
typedef float f32x2 __attribute__((ext_vector_type(2)));
template <class Epi, class Sched, bool ALIGN_EPI = false, bool SP2 = false, bool GATHER = false, bool F8 = false, int F8_SW = 0>
__device__ __forceinline__ void gemm_phase(PG8_LAS unsigned char* lds, const Gemm g, const Sched& S, const Epi& E, const int wave_id, const PG8_LAS int* gidx = nullptr) {
    static_assert(!GATHER || SP2, "GATHER is implemented for the SP2 loop only");
    int tid_ = wave_id * 64 + lane_id(); asm volatile("" : "+v"(tid_));
    const int tid = tid_, wid = __builtin_amdgcn_readfirstlane(tid >> 6), lane = tid & 63, wr = wid >> 2, wc = wid & 3, fr = lane & 15, fq = lane >> 4;
    const int K = g.K, nt = K / BK;
    unsigned voffA[2], voffB[2];
#pragma unroll
    for (int i = 0; i < 2; ++i) { int R, C; stage_rc(tid * 16 + i * 8192, R, C); const int Rb = Epi::PERM ? ((R & ~31) + perm32(R & 31)) : R;
        voffA[i] = (unsigned)(R * K + C) * 2u; voffB[i] = (unsigned)(Rb * K + C) * 2u; }
    unsigned goffA[2][2], goffN[2][2];
#define PG8_GOFF(dst, j) do { _Pragma("unroll") for (int _h = 0; _h < 2; ++_h) _Pragma("unroll") for (int _i = 0; _i < 2; ++_i) { int R_, C_; stage_rc(tid * 16 + _i * 8192, R_, C_); \
        dst[_h][_i] = ((unsigned)gidx[(j) * 256 + _h * 128 + R_] * (unsigned)K + (unsigned)C_) * 2u; } } while (0)
#define PG8_STAGE_A(bufoff, base, h, nx) do { if constexpr (GATHER) { unsigned o_[2] = {(nx) ? goffN[h][0] : goffA[h][0], (nx) ? goffN[h][1] : goffA[h][1]}; PG8_STAGE(bufoff, base, o_); } \
        else { PG8_STAGE(bufoff, (base) + ((h) ? hstep : 0), voffA); } } while (0)
    const size_t kstep = (size_t)(BK * 2);
    const size_t hstep = (size_t)HALF * K * 2;
    const size_t tstep = 2 * hstep;
    const unsigned ldsw = (unsigned)wid * 1024u;
    const int aoff = lds_byte(wr * 64 + fr, fq * 8), boff = lds_byte(wc * 32 + fr, fq * 8);
#define PG8_SA(b, h) (((b) * 2 + (h)) * HTB)
#define PG8_SB(b, h) ((4 + (b) * 2 + (h)) * HTB)
#define PG8_STAGE(bufoff, gbase, voff) do { _Pragma("unroll") for (int _i = 0; _i < 2; ++_i) \
        __builtin_amdgcn_global_load_lds((const unsigned*)((const char*)(gbase) + (voff)[_i]), (PG8_LAS unsigned*)(lds + (bufoff) + ldsw + _i * 8192), 16, 0, 0); } while (0)
#define PG8_LDA(dst, b, h) do { _Pragma("unroll") for (int m = 0; m < 4; ++m) _Pragma("unroll") for (int k = 0; k < 2; ++k) dst[m][k] = *(const PG8_LAS bf16x8*)(lds + PG8_SA(b, h) + aoff + m * 2048 + k * 1024); } while (0)
#define PG8_LDB(dst, b, h) do { _Pragma("unroll") for (int n = 0; n < 2; ++n) _Pragma("unroll") for (int k = 0; k < 2; ++k) dst[n][k] = *(const PG8_LAS bf16x8*)(lds + PG8_SB(b, h) + boff + n * 2048 + k * 1024); } while (0)
#define PG8_MMA(ai, bj, At, Bt) do { if constexpr (F8) __builtin_amdgcn_sched_barrier(0); __builtin_amdgcn_s_setprio(1); _Pragma("unroll") for (int m = 0; m < 4; ++m) _Pragma("unroll") for (int n = 0; n < 2; ++n) { \
        if constexpr (F8) { typedef int i32x4_ __attribute__((ext_vector_type(4))); typedef int i32x8_ __attribute__((ext_vector_type(8))); \
            const i32x8_ wf = __builtin_shufflevector(__builtin_bit_cast(i32x4_, Bt[n][0]), __builtin_bit_cast(i32x4_, Bt[n][1]), 0, 1, 2, 3, 4, 5, 6, 7); \
            const i32x8_ af = __builtin_shufflevector(__builtin_bit_cast(i32x4_, At[m][0]), __builtin_bit_cast(i32x4_, At[m][1]), 0, 1, 2, 3, 4, 5, 6, 7); \
              \
            asm volatile("v_mfma_scale_f32_16x16x128_f8f6f4 %0, %1, %2, %0, %3, %4 op_sel_hi:[0,0,0]" : "+v"(acc[ai][bj][m][n]) : "v"(wf), "v"(af), "v"(f8sw), "v"(f8sa)); } \
        else { _Pragma("unroll") for (int k = 0; k < 2; ++k) acc[ai][bj][m][n] = __builtin_amdgcn_mfma_f32_16x16x32_bf16(Bt[n][k], At[m][k], acc[ai][bj][m][n], 0, 0, 0); } } \
        __builtin_amdgcn_s_setprio(0); if constexpr (F8) __builtin_amdgcn_sched_barrier(0); } while (0)
#define PG8_WAIT_V(n) asm volatile("s_waitcnt vmcnt(" #n ")" ::: "memory")
#define PG8_WAIT_L(n) asm volatile("s_waitcnt lgkmcnt(" #n ")" ::: "memory")
#define PG8_BAR __builtin_amdgcn_s_barrier()
#define PG8_SCHED __builtin_amdgcn_sched_barrier(0)
    const int f8sw = 127 + F8_SW, f8sa = 127; (void)f8sw; (void)f8sa;
    Unit cur, nxt; int ui = 0;
    if (!S.next(0, cur)) return;
    f32x4 acc[2][2][4][2];
#pragma unroll
    for (int a = 0; a < 2; ++a)
#pragma unroll
        for (int b = 0; b < 2; ++b)
#pragma unroll
            for (int m = 0; m < 4; ++m)
#pragma unroll
                for (int n = 0; n < 2; ++n) acc[a][b][m][n] = (f32x4){0.f, 0.f, 0.f, 0.f};
    bf16x8 At[4][2], B0[2][2], B1[2][2];
    const char* cA = GATHER ? (const char*)g.A : (const char*)g.A + (size_t)cur.pm * tstep; const char* cB = (const char*)g.Bt + (size_t)cur.pn * tstep;
    if constexpr (GATHER) PG8_GOFF(goffA, 0);
    S.a_ready(cur);
    if constexpr (SP2) {
        PG8_STAGE(PG8_SB(0, 0), cB, voffB); PG8_STAGE(PG8_SB(0, 1), cB + hstep, voffB); PG8_STAGE_A(PG8_SA(0, 0), cA, 0, false); PG8_STAGE_A(PG8_SA(0, 1), cA, 1, false);
        if (wr == 1) PG8_BAR;
        PG8_WAIT_V(2); PG8_BAR;
        PG8_STAGE(PG8_SB(1, 0), cB + kstep, voffB); PG8_STAGE_A(PG8_SA(1, 0), cA + kstep, 0, false); PG8_STAGE(PG8_SB(1, 1), cB + hstep + kstep, voffB);
        PG8_WAIT_V(6); PG8_BAR;
    } else {
        PG8_STAGE(PG8_SB(0, 0), cB, voffB); PG8_STAGE(PG8_SA(0, 0), cA, voffA); PG8_STAGE(PG8_SB(0, 1), cB + hstep, voffB); PG8_STAGE(PG8_SA(0, 1), cA + hstep, voffA);
        if (wr == 1) PG8_BAR;
        PG8_WAIT_V(4); PG8_BAR;
        PG8_STAGE(PG8_SB(1, 0), cB + kstep, voffB); PG8_STAGE(PG8_SA(1, 0), cA + kstep, voffA); PG8_STAGE(PG8_SB(1, 1), cB + hstep + kstep, voffB);
        PG8_WAIT_V(6); PG8_BAR;
    }
    for (;;) {
        const bool has_next = S.next(ui + 1, nxt);
        if constexpr (GATHER) { if (has_next) PG8_GOFF(goffN, ui + 1); else { _Pragma("unroll") for (int _h = 0; _h < 2; ++_h) _Pragma("unroll") for (int _i = 0; _i < 2; ++_i) goffN[_h][_i] = goffA[_h][_i]; } }
        const char* nA = GATHER ? (const char*)g.A : has_next ? (const char*)g.A + (size_t)nxt.pm * tstep : cA; const char* nB = has_next ? (const char*)g.Bt + (size_t)nxt.pn * tstep : cB;
        for (int t = 0; t < nt; t += 2) {
            const bool last = (t == nt - 2);
            const char* a1 = cA + (size_t)(t + 1) * kstep;
            const char* a2 = last ? nA : cA + (size_t)(t + 2) * kstep; const char* b2 = last ? nB : cB + (size_t)(t + 2) * kstep;
            const char* a3 = a2 + kstep; const char* b3 = b2 + kstep;
            if (last && has_next) S.a_ready(nxt);
            if constexpr (SP2) {
            PG8_LDB(B0, 0, 0); PG8_LDB(B1, 0, 1); PG8_SCHED; PG8_LDA(At, 0, 0); PG8_STAGE_A(PG8_SA(1, 1), a1, 1, false);
            PG8_WAIT_V(8); PG8_WAIT_L(0); PG8_BAR; PG8_MMA(0, 0, At, B0); PG8_MMA(0, 1, At, B1); PG8_BAR; PG8_SCHED;
            PG8_LDA(At, 0, 1); PG8_STAGE(PG8_SB(0, 0), b2, voffB); PG8_STAGE(PG8_SB(0, 1), b2 + hstep, voffB); PG8_STAGE_A(PG8_SA(0, 0), a2, 0, last);
            PG8_WAIT_V(8); PG8_WAIT_L(0); PG8_BAR; PG8_MMA(1, 0, At, B0); PG8_MMA(1, 1, At, B1); PG8_BAR; PG8_SCHED;
            PG8_LDB(B0, 1, 0); PG8_LDB(B1, 1, 1); PG8_SCHED; PG8_LDA(At, 1, 0); PG8_STAGE_A(PG8_SA(0, 1), a2, 1, last);
            PG8_WAIT_V(8); PG8_WAIT_L(0); PG8_BAR; PG8_MMA(0, 0, At, B0); PG8_MMA(0, 1, At, B1); PG8_BAR; PG8_SCHED;
            PG8_LDA(At, 1, 1); PG8_STAGE(PG8_SB(1, 0), b3, voffB); PG8_STAGE(PG8_SB(1, 1), b3 + hstep, voffB); PG8_STAGE_A(PG8_SA(1, 0), a3, 0, last);
            PG8_WAIT_V(8); PG8_WAIT_L(0); PG8_BAR; PG8_MMA(1, 0, At, B0); PG8_MMA(1, 1, At, B1); PG8_BAR; PG8_SCHED;
            if constexpr (Epi::NSEG > 1) {
                constexpr int SEGT = F8 ? 4 : 8;
                if (t + 2 < nt && ((t + 2) & (SEGT - 1)) == 0) { if constexpr (F8) asm volatile("s_nop 15\n\ts_nop 15" ::: "memory"); E.rescale(acc, cur, (t + 2) / SEGT - 1, wr, wc, fr, fq); }
            }
            } else {
            PG8_LDB(B0, 0, 0); PG8_SCHED; PG8_LDA(At, 0, 0); PG8_STAGE(PG8_SA(1, 1), a1 + hstep, voffA);
            PG8_WAIT_L(8); PG8_BAR; PG8_WAIT_L(0); PG8_MMA(0, 0, At, B0); PG8_BAR; PG8_SCHED;
            PG8_LDB(B1, 0, 1); PG8_STAGE(PG8_SB(0, 0), b2, voffB);
            PG8_BAR; PG8_WAIT_L(0); PG8_MMA(0, 1, At, B1); PG8_BAR;
            PG8_LDA(At, 0, 1); PG8_STAGE(PG8_SA(0, 0), a2, voffA);
            PG8_BAR; PG8_WAIT_L(0); PG8_MMA(1, 0, At, B0); PG8_BAR; PG8_SCHED;
            PG8_STAGE(PG8_SB(0, 1), b2 + hstep, voffB);
            PG8_WAIT_V(6); PG8_BAR; PG8_MMA(1, 1, At, B1); PG8_BAR;
            PG8_LDB(B0, 1, 0); PG8_SCHED; PG8_LDA(At, 1, 0); PG8_STAGE(PG8_SA(0, 1), a2 + hstep, voffA);
            PG8_WAIT_L(8); PG8_BAR; PG8_WAIT_L(0); PG8_MMA(0, 0, At, B0); PG8_BAR; PG8_SCHED;
            PG8_LDB(B1, 1, 1); PG8_STAGE(PG8_SB(1, 0), b3, voffB);
            PG8_BAR; PG8_WAIT_L(0); PG8_MMA(0, 1, At, B1); PG8_BAR;
            PG8_LDA(At, 1, 1); PG8_STAGE(PG8_SA(1, 0), a3, voffA);
            PG8_BAR; PG8_WAIT_L(0); PG8_MMA(1, 0, At, B0); PG8_BAR; PG8_SCHED;
            PG8_STAGE(PG8_SB(1, 1), b3 + hstep, voffB);
            PG8_WAIT_V(6); PG8_BAR; PG8_MMA(1, 1, At, B1); PG8_BAR;
            }
        }
        if constexpr (ALIGN_EPI) { if (wr == 0) PG8_BAR; }
        if constexpr (F8) asm volatile("s_nop 15\n\ts_nop 15" ::: "memory");
        if constexpr (!Epi::AFTER_DRAIN) { E(acc, cur, wr, wc, fr, fq); S.done(cur); }
        if (!has_next) break;
#pragma unroll
        for (int a = 0; a < 2; ++a)
#pragma unroll
            for (int b = 0; b < 2; ++b)
#pragma unroll
                for (int m = 0; m < 4; ++m)
#pragma unroll
                    for (int n = 0; n < 2; ++n) acc[a][b][m][n] = (f32x4){0.f, 0.f, 0.f, 0.f};
        cur = nxt; cA = nA; cB = nB; ++ui;
        if constexpr (GATHER) { _Pragma("unroll") for (int _h = 0; _h < 2; ++_h) _Pragma("unroll") for (int _i = 0; _i < 2; ++_i) goffA[_h][_i] = goffN[_h][_i]; }
        if constexpr (ALIGN_EPI) { if (wr == 1) PG8_BAR; }
    }
    PG8_WAIT_V(0);
    if constexpr (!ALIGN_EPI) { if (wr == 0) PG8_BAR; }
    PG8_BAR;
    if constexpr (Epi::AFTER_DRAIN) { E.fused(acc, cur, wr, wc, fr, fq, lds, wid, lane); S.done(cur); }
#undef PG8_SA
#undef PG8_SB
#undef PG8_STAGE
#undef PG8_STAGE_A
#undef PG8_GOFF
#undef PG8_LDA
#undef PG8_LDB
#undef PG8_MMA
#undef PG8_WAIT_V
#undef PG8_WAIT_L
#undef PG8_BAR
#undef PG8_SCHED
}
}
#define XB_TMO      128
#define XB_XCNT(j)  (256  + 64 * (j))
#define XB_XSUB(j)  (1280 + 64 * (j))
#define XB_XGEN(j)  (2304 + 64 * (j))
#define XB_TOP      3328
#define XB_TOPGEN   3392
#define XCD_BAR_WORDS 3456
#define XB_SPIN_CAP (1u << 22)
#define LAS __attribute__((address_space(3)))

__device__ __forceinline__ unsigned xb_ld(unsigned* p)              { return __hip_atomic_load(p, __ATOMIC_RELAXED, __HIP_MEMORY_SCOPE_AGENT); }
__device__ __forceinline__ unsigned xb_add(unsigned* p, unsigned v) { asm volatile("" : "+v"(p));
    return __hip_atomic_fetch_add(p, v, __ATOMIC_RELAXED, __HIP_MEMORY_SCOPE_AGENT); }
__device__ __forceinline__ unsigned xb_xcc_id() { return (unsigned)__builtin_amdgcn_s_getreg((3 << 11) | 20) & 0xFu; }
#define XB_SPIN(cond, bar) do { unsigned _sp = 0; while (cond) { __builtin_amdgcn_s_sleep(1); \
    if ((++_sp & 255u) == 0u) { if (xb_ld(&(bar)[XB_TMO])) break; if (_sp > XB_SPIN_CAP) { xb_add(&(bar)[XB_TMO], 1u); break; } } } } while (0)

struct XcdBarrier {
    unsigned* bar; unsigned x; unsigned wv;
    volatile LAS unsigned* st;
};

__device__ __forceinline__ XcdBarrier xcd_barrier_post(unsigned* bar, volatile LAS unsigned* st) {
    XcdBarrier b; b.bar = bar; b.x = xb_xcc_id(); b.st = st;
    if (threadIdx.x == 0) (void)xb_add(&bar[XB_XCNT(b.x)], 1u);
    return b;
}
__device__ __forceinline__ void xcd_barrier_complete(unsigned* bar, unsigned x, unsigned& nloc, unsigned& nx) {
    const unsigned G = gridDim.x * gridDim.y * gridDim.z;
    unsigned sum, cnt, mine, sp = 0u;
    for (;;) {
        sum = 0u; cnt = 0u; mine = 0u;
#pragma unroll
        for (unsigned j = 0; j < 16; ++j) { const unsigned c = xb_ld(&bar[XB_XCNT(j)]); sum += c; cnt += (c > 0u) ? 1u : 0u; mine = (j == x) ? c : mine; }
        if (sum == G) break;
        __builtin_amdgcn_s_sleep(1);
        if ((++sp & 255u) == 0u) { if (xb_ld(&bar[XB_TMO])) break; if (sp > XB_SPIN_CAP) { xb_add(&bar[XB_TMO], 1u); break; } }
    }
    nloc = mine > 0u ? mine : 1u; nx = cnt > 0u ? cnt : 1u;
}

__device__ __forceinline__ void xcd_barrier(const XcdBarrier& b) {
    asm volatile("s_waitcnt vmcnt(0)" ::: "memory");
    __syncthreads();
    if (b.wv == 0u && lane_id() == 0) {
        unsigned* bar = b.bar;
        __builtin_amdgcn_s_waitcnt(0);
        unsigned nloc = b.st[0], nx = b.st[1];
        if (nloc == 0u) { xcd_barrier_complete(bar, b.x, nloc, nx); b.st[0] = nloc; b.st[1] = nx; }
        const unsigned old = xb_add(&bar[XB_XSUB(b.x)], 1u);
        const unsigned gen = old / nloc;
        if (old + 1u == (gen + 1u) * nloc) {
            __builtin_amdgcn_fence(__ATOMIC_RELEASE, "agent");
            asm volatile("s_waitcnt vmcnt(0)" ::: "memory");
            const unsigned og = xb_add(&bar[XB_TOP], 1u);
            const unsigned tg = og / nx;
            if (og + 1u == (tg + 1u) * nx) xb_add(&bar[XB_TOPGEN], 1u);
            else XB_SPIN(xb_ld(&bar[XB_TOPGEN]) == tg, bar);
            __builtin_amdgcn_fence(__ATOMIC_ACQUIRE, "agent");
            xb_add(&bar[XB_XGEN(b.x)], 1u);
            asm volatile("s_waitcnt vmcnt(0)" ::: "memory");
        } else {
            XB_SPIN(xb_ld(&bar[XB_XGEN(b.x)]) == gen, bar);
            __builtin_amdgcn_fence(__ATOMIC_ACQUIRE, "agent");
            asm volatile("s_waitcnt vmcnt(0)" ::: "memory");
        }
    }
    __syncthreads();
}

typedef unsigned short bf16_t;
typedef short bf16x8 __attribute__((ext_vector_type(8)));
typedef float f32x4 __attribute__((ext_vector_type(4)));
typedef float f32x16 __attribute__((ext_vector_type(16)));
typedef unsigned u32x4 __attribute__((ext_vector_type(4)));
typedef unsigned u32x2 __attribute__((ext_vector_type(2)));

constexpr int D = 1024, NB = 16, SEQ = 2048, CTX = 256, NL = 4;
constexpr int TL = NB * SEQ, TC = NB * CTX, TT = TL + TC;
constexpr int DIN = 6144, HYW = 512, NE = 16, DE = 512, KEYS = CTX + SEQ;
constexpr int NMOD = 6, NBM = NB + 1;
constexpr int APROWS = 2 * TT + NE * 256;
constexpr float EPS = 1e-6f, LOG2E = 1.4426950408889634f;
constexpr float QSCALE = 0.125f * LOG2E;

constexpr size_t MiB = 1u << 20;
constexpr size_t WS_CTL = 0, CTL_ZERO_BYTES = 1 * MiB;
constexpr size_t WS_MOD = 1 * MiB;
constexpr size_t WS_ROPE = 3 * MiB;
constexpr size_t WS_FL = 4 * MiB, WS_FC = 20 * MiB;
constexpr size_t WS_MISC = 22 * MiB;
constexpr size_t WS_FNORM = WS_MISC;
constexpr size_t WS_TOKE = WS_MISC + 64 * 1024, WS_TOKP = WS_MISC + 352 * 1024, WS_TOKW = WS_MISC + 640 * 1024;
constexpr size_t WS_ROWMAP = WS_MISC + 960 * 1024, WS_ROWW = WS_MISC + 1280 * 1024;
constexpr size_t WS_WIN = 24 * MiB, WS_WBR = 36 * MiB, WS_WOUT = 39 * MiB;
constexpr size_t WS_NP = 41 * MiB;
constexpr size_t WS_H = 57 * MiB;
constexpr size_t WS_KA = 129 * MiB, WS_VTA = 138 * MiB, WS_KW = 147 * MiB, WS_VTW = 156 * MiB;
constexpr size_t WS_QA = 165 * MiB, WS_QW = 201 * MiB, WS_YH = 237 * MiB, WS_VT = 273 * MiB, WS_YT = 309 * MiB;
constexpr size_t WS_RAWA = 309 * MiB, WS_RAWW = 327 * MiB;
constexpr size_t WS_F = 165 * MiB;
constexpr size_t WS_U = 345 * MiB;
constexpr size_t WS_G = 453 * MiB;
constexpr size_t WS_Y8 = 561 * MiB;
constexpr size_t WS_W13 = 615 * MiB, WS_W2 = 631 * MiB;
constexpr size_t WS_EROW = 30 * MiB, WS_EROWW = 33 * MiB;
constexpr size_t WS_H8 = 93 * MiB;
constexpr size_t WS_WG8 = WS_WIN;
constexpr size_t WS_XB = 639 * MiB;
constexpr size_t WS_END = 711 * MiB;
static_assert(WS_G + (size_t)TT * 3072 <= WS_Y8 && WS_Y8 + (size_t)TT * 1536 <= WS_W13 && WS_W13 + (size_t)16 * 1024 * 1024 <= WS_W2 && WS_W2 + (size_t)16 * 1024 * 512 <= WS_XB && WS_XB + (size_t)TT * 2048 <= WS_END && WS_H8 + (size_t)TT * 1024 <= WS_KA && WS_EROWW + (size_t)16 * TT * 4 <= WS_WBR, "ws map");
static_assert(WS_U + (size_t)APROWS * 1024 <= WS_G && WS_F + (size_t)2 * TT * 2048 <= WS_YT, "ws map 2");
constexpr size_t VT_CTX_OFF = (size_t)HYW * NB * SEQ;

constexpr int CW_BAR = 4096, CW_CNT = 8192, CW_PANEL = 16384, CW_HTMO = 12288;
constexpr int LDS_BYTES = 151552, MISC_OFF = 147456;
constexpr int NWAVES = 8, NTHR = 512;

struct Args { const float* in[29]; float* out; unsigned char* ws; int ph_lo, ph_hi; };
enum { I_X = 0, I_C, I_CTX, I_CCTX, I_ADAW, I_ADAB, I_N1G, I_N2G, I_WIN, I_QKG, I_HSW, I_HSB, I_HW1, I_HB1, I_HFR, I_HW2, I_HB2, I_HW3, I_HBIAS, I_SINK, I_WBR, I_WOUT,
       I_RGW, I_RGB, I_REW, I_REB, I_EW1, I_EW3, I_EW2 };

#define LDS_WAIT() asm volatile("s_waitcnt lgkmcnt(0)" ::: "memory")
#define VM_WAIT() asm volatile("s_waitcnt vmcnt(0)" ::: "memory")

typedef float f32x2_t __attribute__((ext_vector_type(2)));
typedef __bf16 bf16x2_t __attribute__((ext_vector_type(2)));
__device__ __forceinline__ unsigned cvtpk(float lo, float hi) { f32x2_t v = {lo, hi}; bf16x2_t b = __builtin_convertvector(v, bf16x2_t); return __builtin_bit_cast(unsigned, b); }
__device__ __forceinline__ unsigned zero_u32() { unsigned z; asm volatile("v_mov_b32 %0, 0" : "=v"(z)); return z; }
__device__ __forceinline__ float clamp_fp8(float x) { return __builtin_amdgcn_fmed3f(x, -448.f, 448.f); }
__device__ __forceinline__ unsigned cvt4_fp8(float a, float b, float c, float d) { int r = __builtin_amdgcn_cvt_pk_fp8_f32(a, b, 0, false); r = __builtin_amdgcn_cvt_pk_fp8_f32(c, d, r, true); return (unsigned)r; }
__device__ __forceinline__ unsigned cvt4_fp8c(float a, float b, float c, float d) { return cvt4_fp8(clamp_fp8(a), clamp_fp8(b), clamp_fp8(c), clamp_fp8(d)); }
__device__ __forceinline__ float bflo(unsigned u) { return __builtin_bit_cast(float, u << 16); }
__device__ __forceinline__ float bfhi(unsigned u) { return __builtin_bit_cast(float, u & 0xffff0000u); }
__device__ __forceinline__ float bf1(bf16_t u) { return __builtin_bit_cast(float, (unsigned)u << 16); }
__device__ __forceinline__ bf16_t f2bf(float f) { return (bf16_t)(cvtpk(f, 0.f) & 0xffffu); }
#define DPP_F(v, ctrl) __builtin_bit_cast(float, __builtin_amdgcn_update_dpp(0, __builtin_bit_cast(int, (v)), (ctrl), 0xf, 0xf, false))
__device__ __forceinline__ float row16_sum(float v) {
    v += DPP_F(v, 0xB1);
    v += DPP_F(v, 0x4E);
    v += DPP_F(v, 0x141);
    v += DPP_F(v, 0x140);
    return v;
}
__device__ __forceinline__ float wave_sum(float v) {
    v = row16_sum(v);
    const int iv = __builtin_bit_cast(int, v);
    float r = (__builtin_bit_cast(float, __builtin_amdgcn_readlane(iv, 0)) + __builtin_bit_cast(float, __builtin_amdgcn_readlane(iv, 16)))
            + (__builtin_bit_cast(float, __builtin_amdgcn_readlane(iv, 32)) + __builtin_bit_cast(float, __builtin_amdgcn_readlane(iv, 48)));
    asm volatile("" : "+v"(r));
    return r;
}
__device__ __forceinline__ float fast_exp2(float x) { return __builtin_amdgcn_exp2f(x); }
__device__ __forceinline__ float fast_rcp(float x) { return __builtin_amdgcn_rcpf(x); }
__device__ __forceinline__ float sigmoid_f(float x) { return fast_rcp(1.f + fast_exp2(-x * LOG2E)); }

__device__ __forceinline__ void sincos_acc(float x, float& s, float& c) {
    const float q = rintf(x * 0.636619772367581f);
    float y = fmaf(-q, 1.57079625129699707031f, x);
    y = fmaf(-q, 7.54978941586159635335e-08f, y);
    const float y2 = y * y;
    float sp = fmaf(y2, 2.7557314297e-06f, -1.9841270114e-04f); sp = fmaf(sp, y2, 8.3333337680e-03f); sp = fmaf(sp, y2, -1.6666667163e-01f); sp = fmaf(sp * y2, y, y);
    float cp = fmaf(y2, -2.7557314297e-07f, 2.4801587642e-05f); cp = fmaf(cp, y2, -1.3888889225e-03f); cp = fmaf(cp, y2, 4.1666667908e-02f); cp = fmaf(cp, y2, -0.5f); cp = fmaf(cp, y2, 1.0f);
    const int n = (int)q & 3;
    const float s1 = (n & 1) ? cp : sp, c1 = (n & 1) ? sp : cp;
    s = (n & 2) ? -s1 : s1;
    c = ((n + 1) & 2) ? -c1 : c1;
}

struct Fr { LAS unsigned char* lds; int tid, lane, wave, G, bid; };

__device__ __forceinline__ void pro_mod(const Fr& F, const Args& a) {
    LAS float* s = (LAS float*)F.lds;
    LAS float* red = (LAS float*)(F.lds + 69632);
    const float* c = a.in[I_C]; const float* cc = a.in[I_CCTX]; const float* W = a.in[I_ADAW]; const float* Bv = a.in[I_ADAB];
    float* MOD = (float*)(a.ws + WS_MOD);
    for (int i = F.tid; i < NBM * 1024; i += NTHR) { const int bb = i >> 10, k = i & 1023; const float v = (bb < NB) ? c[bb * 1024 + k] : cc[k]; s[i] = v / (1.f + __expf(-v)); }
    __syncthreads();
    const int col = F.tid & 63, ks = F.wave;
    for (int unit = F.G - 1 - F.bid; unit < NL * 96; unit += F.G) {
        const int l = unit / 96, j0 = (unit % 96) * 64;
        float acc[NBM];
#pragma unroll
        for (int bb = 0; bb < NBM; ++bb) acc[bb] = 0.f;
        const float* Wp = W + ((size_t)l * 1024 + ks * 128) * DIN + j0 + col;
#pragma unroll 2
        for (int k = 0; k < 128; k += 4) {
            const float w0 = Wp[(size_t)k * DIN], w1 = Wp[(size_t)(k + 1) * DIN], w2 = Wp[(size_t)(k + 2) * DIN], w3 = Wp[(size_t)(k + 3) * DIN];
#pragma unroll
            for (int bb = 0; bb < NBM; ++bb) { const f32x4 sv = *(const LAS f32x4*)(s + bb * 1024 + ks * 128 + k);
                acc[bb] = fmaf(sv.x, w0, acc[bb]); acc[bb] = fmaf(sv.y, w1, acc[bb]); acc[bb] = fmaf(sv.z, w2, acc[bb]); acc[bb] = fmaf(sv.w, w3, acc[bb]); } }
#pragma unroll
        for (int bb = 0; bb < NBM; ++bb) red[(ks * NBM + bb) * 64 + col] = acc[bb];
        __syncthreads();
        for (int o = F.tid; o < NBM * 64; o += NTHR) { const int bb = o >> 6, cx = o & 63; float sum = 0.f;
#pragma unroll
            for (int k2 = 0; k2 < 8; ++k2) sum += red[(k2 * NBM + bb) * 64 + cx];
            MOD[((size_t)l * NBM + bb) * DIN + j0 + cx] = sum + Bv[l * DIN + j0 + cx]; }
        __syncthreads();
    }
}

__device__ __forceinline__ void pro_rope(const Fr& F, const Args& a) {
    float* ct = (float*)(a.ws + WS_ROPE); float* st = ct + SEQ * 32;
    for (int i = F.bid * NTHR + F.tid; i < SEQ * 32; i += F.G * NTHR) {
        const int pos = i >> 5, ax = (i >> 4) & 1, f = i & 15;
        const float inv = exp2f(-(float)f * (13.287712379549449f / 16.f));
        const float ang = (float)(ax == 0 ? (pos >> 6) : (pos & 63)) * inv;
        float sv, cv; sincos_acc(ang, sv, cv); ct[i] = cv; st[i] = sv;
    }
}

__device__ __forceinline__ void pro_filter(const Fr& F, const Args& a) {
    LAS float* L = (LAS float*)F.lds;
    constexpr int oW1 = 0, oB1 = 2112, oFR = 2176, oB2 = 2240, oW2 = 2304, oZ = 6400, oH1 = 7552, oH2 = 9600, H2P = 68, oT = 11776, TP = 36;
    bf16_t* FL = (bf16_t*)(a.ws + WS_FL); bf16_t* FC = (bf16_t*)(a.ws + WS_FC); float* NP = (float*)(a.ws + WS_NP);
    const int p = F.tid >> 4, jj = F.tid & 15;
    for (int unit = F.bid; unit < NL * 72; unit += F.G) {
        const int l = unit / 72, ch = unit % 72; const bool lat = ch < 64; const int n = lat ? SEQ : CTX, pos0 = lat ? ch * 32 : (ch - 64) * 32;
        __syncthreads();
        for (int i = F.tid; i < 2112; i += NTHR) L[oW1 + i] = a.in[I_HW1][l * 2112 + i];
        for (int i = F.tid; i < 64; i += NTHR) { L[oB1 + i] = a.in[I_HB1][l * 64 + i]; L[oFR + i] = a.in[I_HFR][l * 64 + i]; L[oB2 + i] = a.in[I_HB2][l * 64 + i]; }
        for (int i = F.tid; i < 4096; i += NTHR) L[oW2 + i] = a.in[I_HW2][l * 4096 + i];
        const int pos = pos0 + p; const float t = (float)pos / (float)(n - 1);
        { const float band = 1e-4f + (float)jj * ((15.f - 1e-4f) / 15.f); const float ang = ((6.2831855f * band) * (float)pos) / (float)n;
          float sv, cv; sincos_acc(ang, sv, cv); L[oZ + p * 36 + 1 + jj] = cv; L[oZ + p * 36 + 17 + jj] = -sv; if (jj == 0) L[oZ + p * 36] = t; }
        __syncthreads();
        { f32x4 acc = *(const LAS f32x4*)(L + oB1 + 4 * jj);
#pragma unroll 3
          for (int i = 0; i < 33; ++i) { const float z = L[oZ + p * 36 + i]; const f32x4 w = *(const LAS f32x4*)(L + oW1 + i * 64 + 4 * jj); acc.x = fmaf(z, w.x, acc.x); acc.y = fmaf(z, w.y, acc.y); acc.z = fmaf(z, w.z, acc.z); acc.w = fmaf(z, w.w, acc.w); }
          const f32x4 fr = *(const LAS f32x4*)(L + oFR + 4 * jj); float sv, cv; f32x4 o;
          sincos_acc(fr.x * acc.x, sv, cv); o.x = sv; sincos_acc(fr.y * acc.y, sv, cv); o.y = sv; sincos_acc(fr.z * acc.z, sv, cv); o.z = sv; sincos_acc(fr.w * acc.w, sv, cv); o.w = sv;
          *(LAS f32x4*)(L + oH1 + p * 64 + 4 * jj) = o; }
        __syncthreads();
        { f32x4 acc = *(const LAS f32x4*)(L + oB2 + 4 * jj);
#pragma unroll 4
          for (int i = 0; i < 64; ++i) { const float z = L[oH1 + p * 64 + i]; const f32x4 w = *(const LAS f32x4*)(L + oW2 + i * 64 + 4 * jj); acc.x = fmaf(z, w.x, acc.x); acc.y = fmaf(z, w.y, acc.y); acc.z = fmaf(z, w.z, acc.z); acc.w = fmaf(z, w.w, acc.w); }
          const f32x4 fr = *(const LAS f32x4*)(L + oFR + 4 * jj); float sv, cv; f32x4 o;
          sincos_acc(fr.x * acc.x, sv, cv); o.x = sv; sincos_acc(fr.y * acc.y, sv, cv); o.y = sv; sincos_acc(fr.z * acc.z, sv, cv); o.z = sv; sincos_acc(fr.w * acc.w, sv, cv); o.w = sv;
          *(LAS f32x4*)(L + oH2 + p * H2P + 4 * jj) = o; }
        LAS bf16_t* T = (LAS bf16_t*)(L + oT);
        __syncthreads();
        {
            const int j16 = F.lane & 15, kq = F.lane >> 4;
            const float* W3p = a.in[I_HW3] + ((size_t)l * 64 + 4 * kq) * 1024 + 128 * F.wave + 4 * j16;
            f32x4 acc[2][4][2];
#pragma unroll
            for (int h = 0; h < 2; ++h)
#pragma unroll
                for (int cb = 0; cb < 4; ++cb)
#pragma unroll
                    for (int rb = 0; rb < 2; ++rb) acc[h][cb][rb] = (f32x4){0.f, 0.f, 0.f, 0.f};
            f32x4 bw[2][4][2];
#define PF_LDW(buf, s) do { _Pragma("unroll") for (int j = 0; j < 4; ++j) _Pragma("unroll") for (int h = 0; h < 2; ++h) bw[buf][j][h] = *(const f32x4*)(W3p + (size_t)(16 * (s) + j) * 1024 + 64 * h); } while (0)
            PF_LDW(0, 0);
#pragma unroll
            for (int s = 0; s < 4; ++s) {
                if (s + 1 < 4) PF_LDW((s + 1) & 1, s + 1);
                f32x4 av[2];
#pragma unroll
                for (int rb = 0; rb < 2; ++rb) av[rb] = *(const LAS f32x4*)(L + oH2 + (rb * 16 + j16) * H2P + 16 * s + 4 * kq);
#pragma unroll
                for (int j = 0; j < 4; ++j)
#pragma unroll
                    for (int h = 0; h < 2; ++h)
#pragma unroll
                        for (int cb = 0; cb < 4; ++cb)
#pragma unroll
                            for (int rb = 0; rb < 2; ++rb) acc[h][cb][rb] = __builtin_amdgcn_mfma_f32_16x16x4f32(av[rb][j], bw[s & 1][j][h][cb], acc[h][cb][rb], 0, 0, 0);
            }
#undef PF_LDW
            const int dir = F.wave >> 2;
            float tt[2][4];
#pragma unroll
            for (int rb = 0; rb < 2; ++rb)
#pragma unroll
                for (int r = 0; r < 4; ++r) tt[rb][r] = (float)(pos0 + rb * 16 + 4 * kq + r) / (float)(n - 1);
#pragma unroll
            for (int h = 0; h < 2; ++h)
#pragma unroll
                for (int cb = 0; cb < 4; ++cb) { const int col = 128 * F.wave + 64 * h + 4 * j16 + cb, c = col & 511;
                    const float dl = fabsf(-3.0701134573253943f + (-15.350567286626972f + 3.0701134573253943f) * ((float)c / 511.f));
#pragma unroll
                    for (int rb = 0; rb < 2; ++rb) { const int p0 = rb * 16 + 4 * kq; float v[4];
#pragma unroll
                        for (int r = 0; r < 4; ++r) { v[r] = acc[h][cb][rb][r] * __expf(-tt[rb][r] * dl); if (dir == 1 && pos0 + p0 + r == 0) v[r] = 0.f; }
                        u32x2 w;
                        if (dir == 0) { w.x = cvtpk(v[3], v[2]); w.y = cvtpk(v[1], v[0]); *(LAS u32x2*)(T + col * TP + 28 - p0) = w; }
                        else { w.x = cvtpk(v[0], v[1]); w.y = cvtpk(v[2], v[3]); *(LAS u32x2*)(T + col * TP + p0) = w; } } }
        }
        __syncthreads();
        for (int idx = F.tid; idx < 1024 * 32; idx += NTHR) { const int col = idx >> 5, i = idx & 31, dir = col >> 9, c = col & 511;
            const int u = (dir == 0) ? (n - 32 - pos0 + i) : ((pos0 + i == 0) ? 2 * n - 1 : n - 1 + pos0 + i);
            bf16_t* Fb = lat ? FL + ((size_t)l * 512 + c) * 4096 : FC + ((size_t)l * 512 + c) * 512;
            Fb[u] = T[col * TP + i]; }
        for (int col = F.tid; col < 1024; col += NTHR) { float sum = 0.f;
#pragma unroll 8
            for (int i = 0; i < 32; ++i) sum += fabsf(bf1(T[col * TP + i]));
            NP[((size_t)l * 72 + ch) * 1024 + col] = sum; }
    }
    __syncthreads();
}
__device__ __forceinline__ void filter_norm_reduce(const Fr& F, const Args& a) {
    const float* NP = (const float*)(a.ws + WS_NP); float* FN = (float*)(a.ws + WS_FNORM);
    for (int o = F.bid * NTHR + F.tid; o < NL * 2 * 512; o += F.G * NTHR) { const int l = o >> 10, isc = (o >> 9) & 1, c = o & 511;
        const int ch0 = isc ? 64 : 0, ch1 = isc ? 72 : 64; float sum = 0.f;
        for (int ch = ch0; ch < ch1; ++ch) sum += NP[((size_t)l * 72 + ch) * 1024 + c] + NP[((size_t)l * 72 + ch) * 1024 + 512 + c];
        FN[o] = 1.f / sum; }
}

template <int MODE>
__device__ __forceinline__ void transpose_item(const float* W, int K, int N, bf16_t* WT, int row_off, LAS float* scr, int item, int lane, int ldk = 0) {
    if (ldk == 0) ldk = K;
    const int nblk = N / 64, kb = item / nblk, nb = item % nblk, k0 = 64 * kb, n0 = 64 * nb;
    f32x4 v[16];
#pragma unroll
    for (int i = 0; i < 16; ++i) v[i] = *(const f32x4*)(W + (size_t)(k0 + 4 * i + (lane >> 4)) * N + n0 + (lane & 15) * 4);
#pragma unroll
    for (int i = 0; i < 16; ++i) *(LAS f32x4*)(scr + (4 * i + (lane >> 4)) * 68 + (lane & 15) * 4) = v[i];
    LDS_WAIT();
    const int c = lane & 7;
#pragma unroll
    for (int j = 0; j < 8; ++j) { const int n = (lane >> 3) + 8 * j; const LAS float* s = scr + (8 * c) * 68 + n;
        u32x4 o; o.x = cvtpk(s[0 * 68], s[1 * 68]); o.y = cvtpk(s[2 * 68], s[3 * 68]); o.z = cvtpk(s[4 * 68], s[5 * 68]); o.w = cvtpk(s[6 * 68], s[7 * 68]);
        const int nn = n0 + n; const int row = (MODE == 0) ? nn : ((nn >> 2) * 8 + (nn & 3) + (MODE == 2 ? 4 : 0));
        *(u32x4*)(WT + (size_t)(row_off + row) * ldk + k0 + 8 * c) = o; }
    LDS_WAIT();
}

template <int MODE>
__device__ __forceinline__ void transpose_item_f8(const float* W, int K, int N, unsigned char* WT, int row_off, LAS float* scr, int item, int lane, int ldk = 0) {
    if (ldk == 0) ldk = K;
    const int nblk = N / 64, kb = item / nblk, nb = item % nblk, k0 = 64 * kb, n0 = 64 * nb;
    f32x4 v[16];
#pragma unroll
    for (int i = 0; i < 16; ++i) v[i] = *(const f32x4*)(W + (size_t)(k0 + 4 * i + (lane >> 4)) * N + n0 + (lane & 15) * 4);
#pragma unroll
    for (int i = 0; i < 16; ++i) *(LAS f32x4*)(scr + (4 * i + (lane >> 4)) * 68 + (lane & 15) * 4) = v[i];
    LDS_WAIT();
    const int c = lane & 7;
#pragma unroll
    for (int j = 0; j < 8; ++j) { const int n = (lane >> 3) + 8 * j; const LAS float* s = scr + (8 * c) * 68 + n;
        u32x2 o; o.x = cvt4_fp8(s[0 * 68] * 64.f, s[1 * 68] * 64.f, s[2 * 68] * 64.f, s[3 * 68] * 64.f); o.y = cvt4_fp8(s[4 * 68] * 64.f, s[5 * 68] * 64.f, s[6 * 68] * 64.f, s[7 * 68] * 64.f);
        const int nn = n0 + n; const int row = (MODE == 0) ? nn : ((nn >> 2) * 8 + (nn & 3) + (MODE == 2 ? 4 : 0));
        *(u32x2*)(WT + (size_t)(row_off + row) * ldk + k0 + 8 * c) = o; }
    LDS_WAIT();
}
__device__ __forceinline__ void conv_small_weights(const Fr& F, const Args& a, int l, int mask, int b0) {
    if (F.bid < b0) return;
    LAS float* scr = (LAS float*)(F.lds + F.wave * 17408);
    const int gw = (F.bid - b0) * NWAVES + F.wave, NGW = (F.G - b0) * NWAVES;
    constexpr int I_IN = (1024 / 64) * (DIN / 64), I_BR = (512 / 64) * (1024 / 64), I_OUT = (1024 / 64) * (1024 / 64);
    if (mask & 1) for (int it = gw; it < I_IN; it += NGW) transpose_item_f8<0>(a.in[I_WIN] + (size_t)l * 1024 * DIN, 1024, DIN, a.ws + WS_WG8, 0, scr, it, F.lane);
    if (mask & 2) for (int it = gw; it < 3 * I_BR; it += NGW) { const int b = it / I_BR; transpose_item_f8<0>(a.in[I_WBR] + ((size_t)l * 3 + b) * 512 * 1024, 512, 1024, a.ws + WS_WBR + b * 512, 0, scr, it % I_BR, F.lane, 1536); }
    if (mask & 4) for (int it = gw; it < I_OUT; it += NGW) transpose_item_f8<0>(a.in[I_WOUT] + (size_t)l * 1024 * 1024, 1024, 1024, a.ws + WS_WOUT, 0, scr, it, F.lane);
}
__device__ __forceinline__ void conv_expert_weights(const Fr& F, const Args& a, int l, int b0, int it0, int it1) {
    if (F.bid < b0) return;
    LAS float* scr = (LAS float*)(F.lds + F.wave * 17408);
    const int gw = (F.bid - b0) * NWAVES + F.wave, NGW = (F.G - b0) * NWAVES;
    constexpr int I_1 = (1024 / 64) * (512 / 64), I_2 = (512 / 64) * (1024 / 64);
    for (int it = it0 + gw; it < it1; it += NGW) {
        const int e = it / (2 * I_1 + I_2); int r = it % (2 * I_1 + I_2);
        unsigned char* W13 = a.ws + WS_W13; unsigned char* W2 = a.ws + WS_W2;
        if (r < I_1) { transpose_item_f8<1>(a.in[I_EW1] + ((size_t)l * NE + e) * 1024 * 512, 1024, 512, W13, e * 1024, scr, r, F.lane); continue; } r -= I_1;
        if (r < I_1) { transpose_item_f8<2>(a.in[I_EW3] + ((size_t)l * NE + e) * 1024 * 512, 1024, 512, W13, e * 1024, scr, r, F.lane); continue; } r -= I_1;
        transpose_item_f8<0>(a.in[I_EW2] + ((size_t)l * NE + e) * 512 * 1024, 512, 1024, W2, e * 1024, scr, r, F.lane);
    }
}
constexpr int CONV_E_ITEMS = NE * 384, CONV_E_SPLIT = CONV_E_ITEMS / 2;

__device__ __forceinline__ int mod_row(int row) { return row < TL ? (row >> 11) : NB; }

__device__ __forceinline__ void rows_p0(const Fr& F, const Args& a, int l, int nrows) {
    const int gw = F.bid * NWAVES + F.wave, NGW = F.G * NWAVES;
    const float* g1 = a.in[I_N1G] + l * 1024;
    const float* MODl = (const float*)(a.ws + WS_MOD) + (size_t)l * NBM * DIN;
    const float* MODp = (const float*)(a.ws + WS_MOD) + (size_t)(l > 0 ? l - 1 : 0) * NBM * DIN;
    const bf16_t* Fs = (const bf16_t*)(a.ws + WS_F);
    unsigned char* H8 = a.ws + WS_H8; bf16_t* XB = (bf16_t*)(a.ws + WS_XB);
    const int per = 2 * ((nrows + 2 * NGW - 1) / (2 * NGW)), w0 = gw * per, w1 = (w0 + per < nrows) ? w0 + per : nrows;
    f32x4 gv[4], shv[4], scv[4], m5v[4]; int cur = -1;
#pragma unroll
    for (int j = 0; j < 4; ++j) { gv[j] = *(const f32x4*)(g1 + F.lane * 4 + 256 * j); shv[j] = gv[j]; scv[j] = gv[j]; m5v[j] = gv[j]; }
#define P0_LOAD(rb, V, F0, F1) do { _Pragma("unroll") for (int q = 0; q < 2; ++q) { const int row = (rb) + q; const bool lat = row < TL; \
            const float* xs = lat ? a.in[I_X] + (size_t)row * D : a.in[I_CTX] + (size_t)(row - TL) * D; \
            _Pragma("unroll") for (int j = 0; j < 4; ++j) { const int col = F.lane * 4 + 256 * j; \
                if (l == 0) V[q][j] = *(const u32x4*)(xs + col); \
                else { const u32x2 t_ = *(const u32x2*)(XB + (size_t)row * D + col); V[q][j].x = t_.x; V[q][j].y = t_.y; \
                    F0[q][j] = *(const u32x2*)(Fs + (size_t)row * D + col); F1[q][j] = *(const u32x2*)(Fs + ((size_t)TT + row) * D + col); } } } } while (0)
#define P0_PROC(rb, V, F0, F1) do { _Pragma("unroll") for (int q = 0; q < 2; ++q) { const int row = (rb) + q; const int mr = mod_row(row); \
            if (mr != cur) { cur = mr; _Pragma("unroll") for (int j = 0; j < 4; ++j) { const int col = F.lane * 4 + 256 * j; \
                shv[j] = *(const f32x4*)(MODl + (size_t)mr * DIN + col); scv[j] = *(const f32x4*)(MODl + (size_t)mr * DIN + 1024 + col); m5v[j] = *(const f32x4*)(MODp + (size_t)mr * DIN + 5 * 1024 + col); } } \
            float ss = 0.f; f32x4 X[4]; \
            _Pragma("unroll") for (int j = 0; j < 4; ++j) { const u32x4 w_ = V[q][j]; \
                if (l == 0) X[j] = __builtin_bit_cast(f32x4, w_); \
                else { X[j].x = bflo(w_.x) + m5v[j].x * (bflo(F0[q][j].x) + bflo(F1[q][j].x)); X[j].y = bfhi(w_.x) + m5v[j].y * (bfhi(F0[q][j].x) + bfhi(F1[q][j].x)); \
                       X[j].z = bflo(w_.y) + m5v[j].z * (bflo(F0[q][j].y) + bflo(F1[q][j].y)); X[j].w = bfhi(w_.y) + m5v[j].w * (bfhi(F0[q][j].y) + bfhi(F1[q][j].y)); } } \
            _Pragma("unroll") for (int j = 0; j < 4; ++j) { const int col = F.lane * 4 + 256 * j; u32x2 xw_; xw_.x = cvtpk(X[j].x, X[j].y); xw_.y = cvtpk(X[j].z, X[j].w); \
                *(u32x2*)(XB + (size_t)row * D + col) = xw_; } \
            _Pragma("unroll") for (int j = 0; j < 4; ++j) ss += (X[j].x * X[j].x + X[j].y * X[j].y) + (X[j].z * X[j].z + X[j].w * X[j].w); \
            const float r = 1.f / sqrtf(wave_sum(ss) * (1.f / D) + EPS); \
            _Pragma("unroll") for (int j = 0; j < 4; ++j) { const int col = F.lane * 4 + 256 * j; \
                const f32x4 o = (X[j] * r * gv[j]) * (scv[j] + 1.f) + shv[j]; \
                *(unsigned*)(H8 + (size_t)row * D + col) = cvt4_fp8(o.x, o.y, o.z, o.w); } } } while (0)
    u32x4 vA[2][4], vB[2][4]; u32x2 fA0[2][4], fA1[2][4], fB0[2][4], fB1[2][4];
    if (w0 < w1) P0_LOAD(w0, vA, fA0, fA1);
    for (int rb = w0; rb < w1; rb += 4) {
        if (rb + 2 < w1) P0_LOAD(rb + 2, vB, fB0, fB1);
        P0_PROC(rb, vA, fA0, fA1);
        if (rb + 2 < w1) { if (rb + 4 < w1) P0_LOAD(rb + 4, vA, fA0, fA1); P0_PROC(rb + 2, vB, fB0, fB1); }
    }
#undef P0_LOAD
#undef P0_PROC
}
__device__ __forceinline__ void rows_final(const Fr& F, const Args& a) {
    const int gw = F.bid * NWAVES + F.wave, NGW = F.G * NWAVES;
    const float* MODp = (const float*)(a.ws + WS_MOD) + (size_t)(NL - 1) * NBM * DIN;
    const bf16_t* Fs = (const bf16_t*)(a.ws + WS_F);
    const bf16_t* XB = (const bf16_t*)(a.ws + WS_XB);
    for (int row = gw; row < TL; row += NGW) {
        const int mr = row >> 11; float* xd = a.out + (size_t)row * D;
#pragma unroll
        for (int j = 0; j < 4; ++j) { const int col = F.lane * 4 + 256 * j;
            const u32x2 xw = *(const u32x2*)(XB + (size_t)row * D + col);
            const u32x2 f0 = *(const u32x2*)(Fs + (size_t)row * D + col), f1 = *(const u32x2*)(Fs + ((size_t)TT + row) * D + col);
            const f32x4 m5 = *(const f32x4*)(MODp + (size_t)mr * DIN + 5 * 1024 + col);
            f32x4 v; v.x = bflo(xw.x) + m5.x * (bflo(f0.x) + bflo(f1.x)); v.y = bfhi(xw.x) + m5.y * (bfhi(f0.x) + bfhi(f1.x)); v.z = bflo(xw.y) + m5.z * (bflo(f0.y) + bflo(f1.y)); v.w = bfhi(xw.y) + m5.w * (bfhi(f0.y) + bfhi(f1.y));
            *(f32x4*)(xd + col) = v; }
    }
}

__device__ __forceinline__ void rows_p5(const Fr& F, const Args& a, int l, int nrows, unsigned long long& sacc, const int swhich) {
#if defined(PROBE_P)
    unsigned long long st0 = __builtin_amdgcn_s_memrealtime();
#define SUBMARK5(w) do { const unsigned long long t_ = __builtin_amdgcn_s_memrealtime(); if (swhich == (w)) sacc += t_ - st0; st0 = t_; } while (0)
#else
#define SUBMARK5(w) do { } while (0)
#endif
    typedef float f32x4v __attribute__((ext_vector_type(4)));
    LAS float* RW = (LAS float*)F.lds;
    constexpr int RWS = 1028;
    LAS float* RB = (LAS float*)(F.lds + 82304);
    LAS int* LC = (LAS int*)(F.lds + 82432);
    LAS int* TE = (LAS int*)(F.lds + 82560);
    LAS int* TP = TE + 256;
    LAS float* TW = (LAS float*)(TP + 256);
    LAS float* RN = (LAS float*)(F.lds + 86784);
    LAS float* LG = (LAS float*)(F.lds + 87424);
    LAS float* GM = (LAS float*)(F.lds + 99072);
    LAS float* BI = (LAS float*)(F.lds + 107264);
    const float* g2 = a.in[I_N2G] + l * 1024;
    const float* MODl = (const float*)(a.ws + WS_MOD) + (size_t)l * NBM * DIN;
    unsigned char* H8 = a.ws + WS_H;
    const bf16_t* XB = (const bf16_t*)(a.ws + WS_XB);
    int* EROW = (int*)(a.ws + WS_EROW); float* EROWW = (float*)(a.ws + WS_EROWW);
    unsigned* CNT = (unsigned*)(a.ws + WS_CTL) + CW_CNT + l * 256;
    for (int f = F.tid; f < 1024; f += NTHR) { const f32x4 v = *(const f32x4*)(a.in[I_RGW] + ((size_t)l * 1024 + f) * 4);
        RW[0 * RWS + f] = v.x; RW[1 * RWS + f] = v.y; RW[2 * RWS + f] = v.z; RW[3 * RWS + f] = v.w; }
    for (int f = F.tid; f < 4096; f += NTHR) { const int k = f >> 2, c4 = (f & 3) * 4; const f32x4 v = *(const f32x4*)(a.in[I_REW] + ((size_t)l * 1024 + k) * 16 + c4);
        RW[(4 + c4) * RWS + k] = v.x; RW[(5 + c4) * RWS + k] = v.y; RW[(6 + c4) * RWS + k] = v.z; RW[(7 + c4) * RWS + k] = v.w; }
    if (F.tid < 20) RB[F.tid] = (F.tid < 4) ? a.in[I_RGB][l * 4 + F.tid] : a.in[I_REB][l * 16 + F.tid - 4];
    constexpr int P5_CH = 144;
    const int nch = (nrows + P5_CH - 1) / P5_CH;
    SUBMARK5(40);
    for (int ch = F.bid; ch < nch; ch += F.G) {
    const int r0 = ch * P5_CH, r1 = (r0 + P5_CH < nrows) ? r0 + P5_CH : nrows;
    const int mb0 = mod_row(r0), mb1 = mod_row(r1 - 1);
    if (F.tid < 32) LC[F.tid] = 0;
    for (int i = F.tid; i < 2048; i += NTHR) { const int s = i >> 10, k = i & 1023; GM[i] = g2[k] * (1.f + MODl[(size_t)(s ? mb1 : mb0) * DIN + 4 * 1024 + k]); }
    __syncthreads();
    if (F.wave < 4) {
    for (int rowb = r0 + 2 * F.wave; rowb < r1; rowb += 2 * 4) {
        f32x4 v[2][4]; bool val[2];
#pragma unroll
        for (int q = 0; q < 2; ++q) { const int row = rowb + q; val[q] = row < r1; const int rr = val[q] ? row : rowb;
            u32x2 xw[4];
#pragma unroll
            for (int j = 0; j < 4; ++j) xw[j] = *(const u32x2*)(XB + (size_t)rr * D + F.lane * 4 + 256 * j);
#pragma unroll
            for (int j = 0; j < 4; ++j) { v[q][j].x = bflo(xw[j].x); v[q][j].y = bfhi(xw[j].x); v[q][j].z = bflo(xw[j].y); v[q][j].w = bfhi(xw[j].y); } }
#pragma unroll
        for (int q = 0; q < 2; ++q) { const int rr = val[q] ? rowb + q : rowb; const int mr = mod_row(rr); float ss = 0.f;
#pragma unroll
            for (int j = 0; j < 4; ++j) ss += (v[q][j].x * v[q][j].x + v[q][j].y * v[q][j].y) + (v[q][j].z * v[q][j].z + v[q][j].w * v[q][j].w);
            const float r = 1.f / sqrtf(wave_sum(ss) * (1.f / D) + EPS);
            if (F.lane == 0 && val[q]) RN[rr - r0] = r;
#pragma unroll
            for (int j = 0; j < 4; ++j) { const int col = F.lane * 4 + 256 * j;
                const f32x4 g = *(const f32x4*)(g2 + col), sh = *(const f32x4*)(MODl + (size_t)mr * DIN + 3 * 1024 + col), sc = *(const f32x4*)(MODl + (size_t)mr * DIN + 4 * 1024 + col);
                const f32x4 t = (v[q][j] * r * g) * (sc + 1.f) + sh;
                if (val[q]) *(unsigned*)(H8 + (size_t)rr * D + col) = cvt4_fp8(t.x, t.y, t.z, t.w); } }
    }
    } else {
    if (F.wave < 6) { const int sl = F.wave - 4; const int mb = sl ? mb1 : mb0; f32x4 sh[4];
#pragma unroll
        for (int j = 0; j < 4; ++j) sh[j] = *(const f32x4*)(MODl + (size_t)mb * DIN + 3 * 1024 + F.lane * 4 + 256 * j);
#pragma unroll 4
        for (int cidx = 0; cidx < 20; ++cidx) { float p = 0.f;
#pragma unroll
            for (int j = 0; j < 4; ++j) { const f32x4 w = *(const LAS f32x4*)(RW + cidx * RWS + F.lane * 4 + 256 * j);
                p = fmaf(sh[j].x, w.x, p); p = fmaf(sh[j].y, w.y, p); p = fmaf(sh[j].z, w.z, p); p = fmaf(sh[j].w, w.w, p); }
            const float tot = wave_sum(p) + RB[cidx]; if (F.lane == 0) BI[sl * 20 + cidx] = tot; } }
    { const int i16 = F.lane & 15, kq = F.lane >> 4; const int ngrp = (r1 - r0 + 15) >> 4;
      for (int gi = F.wave - 4; gi < ngrp; gi += 4) {
        const int grow = r0 + 16 * gi; const int rowi = (grow + i16 < r1) ? grow + i16 : r1 - 1;
        const bf16_t* xs = XB + (size_t)rowi * D + 4 * kq;
        const int slot = (mod_row(grow) == mb0) ? 0 : 1;
        const LAS float* gmp = GM + slot * 1024 + 4 * kq; const LAS float* w0p = RW + i16 * RWS + 4 * kq; const LAS float* w1p = RW + (16 + (i16 & 3)) * RWS + 4 * kq;
        const float m1 = (i16 < 4) ? 1.f : 0.f;
        f32x4v acc0 = {0.f, 0.f, 0.f, 0.f}, acc1 = {0.f, 0.f, 0.f, 0.f};
#pragma unroll 16
        for (int s = 0; s < 64; ++s) {
            const u32x2 xw = *(const u32x2*)(xs + 16 * s); const f32x4 gv = *(const LAS f32x4*)(gmp + 16 * s);
            const f32x4 wa = *(const LAS f32x4*)(w0p + 16 * s), wb = *(const LAS f32x4*)(w1p + 16 * s);
            const f32x4 ba = wa * gv, bb = wb * gv * m1;
            acc0 = __builtin_amdgcn_mfma_f32_16x16x4f32(bflo(xw.x), ba.x, acc0, 0, 0, 0); acc1 = __builtin_amdgcn_mfma_f32_16x16x4f32(bflo(xw.x), bb.x, acc1, 0, 0, 0);
            acc0 = __builtin_amdgcn_mfma_f32_16x16x4f32(bfhi(xw.x), ba.y, acc0, 0, 0, 0); acc1 = __builtin_amdgcn_mfma_f32_16x16x4f32(bfhi(xw.x), bb.y, acc1, 0, 0, 0);
            acc0 = __builtin_amdgcn_mfma_f32_16x16x4f32(bflo(xw.y), ba.z, acc0, 0, 0, 0); acc1 = __builtin_amdgcn_mfma_f32_16x16x4f32(bflo(xw.y), bb.z, acc1, 0, 0, 0);
            acc0 = __builtin_amdgcn_mfma_f32_16x16x4f32(bfhi(xw.y), ba.w, acc0, 0, 0, 0); acc1 = __builtin_amdgcn_mfma_f32_16x16x4f32(bfhi(xw.y), bb.w, acc1, 0, 0, 0);
        }
#pragma unroll
        for (int rg = 0; rg < 4; ++rg) { const int lr = 16 * gi + 4 * kq + rg;
            if (r0 + lr < r1) { LG[lr * 20 + i16] = acc0[rg]; if (i16 < 4) LG[lr * 20 + 16 + i16] = acc1[rg]; } }
      } }
    }
    __syncthreads();
    SUBMARK5(42);
    for (int lr = F.tid; lr < r1 - r0; lr += NTHR) {
        float lg[20]; { const float rn = RN[lr]; const int sl = (mod_row(r0 + lr) == mb0) ? 0 : 1;
#pragma unroll
          for (int i = 0; i < 20; ++i) lg[i] = rn * LG[lr * 20 + i] + BI[sl * 20 + i]; }
        int gs = 0; float gmx = lg[0];
#pragma unroll
        for (int i = 1; i < 4; ++i) if (lg[i] > gmx) { gmx = lg[i]; gs = i; }
        float gsum = 0.f;
#pragma unroll
        for (int i = 0; i < 4; ++i) gsum += __expf(lg[i] - gmx);
        const float pg = 1.f / gsum;
        float le[4];
#pragma unroll
        for (int i = 0; i < 4; ++i) le[i] = (gs == 0) ? lg[4 + i] : (gs == 1) ? lg[8 + i] : (gs == 2) ? lg[12 + i] : lg[16 + i];
        int i0 = 0; float v0 = le[0];
#pragma unroll
        for (int i = 1; i < 4; ++i) if (le[i] > v0) { v0 = le[i]; i0 = i; }
        int i1 = -1; float v1 = -3.4e38f;
#pragma unroll
        for (int i = 0; i < 4; ++i) if (i != i0 && le[i] > v1) { v1 = le[i]; i1 = i; }
        const float e1 = __expf(v1 - v0), den = 1.f / (1.f + e1);
        const int ex0 = gs * 4 + i0, ex1 = gs * 4 + i1;
        const int lp0 = __hip_atomic_fetch_add(&LC[ex0], 1, __ATOMIC_RELAXED, __HIP_MEMORY_SCOPE_WORKGROUP), lp1 = __hip_atomic_fetch_add(&LC[ex1], 1, __ATOMIC_RELAXED, __HIP_MEMORY_SCOPE_WORKGROUP);
        TE[lr] = ex0 | (ex1 << 8); TP[lr] = lp0 | (lp1 << 16); TW[2 * lr] = den * pg; TW[2 * lr + 1] = e1 * den * pg;
    }
    __syncthreads();
    if (F.tid < NE) LC[16 + F.tid] = (int)atomicAdd(&CNT[F.tid * 16], (unsigned)LC[F.tid]);
    __syncthreads();
    for (int lr = F.tid; lr < r1 - r0; lr += NTHR) {
        const int te = TE[lr], tp = TP[lr], ex0 = te & 255, ex1 = te >> 8, row = r0 + lr;
        const int gp0 = LC[16 + ex0] + (tp & 0xffff), gp1 = LC[16 + ex1] + (tp >> 16);
        EROW[(size_t)ex0 * TT + gp0] = row * 2; EROWW[(size_t)ex0 * TT + gp0] = TW[2 * lr];
        EROW[(size_t)ex1 * TT + gp1] = row * 2 + 1; EROWW[(size_t)ex1 * TT + gp1] = TW[2 * lr + 1];
    }
    __syncthreads();
    SUBMARK5(43);
    }
    __syncthreads();
#undef SUBMARK5
}

__device__ __forceinline__ void normrope8(float (&x)[8], const float* g64, bool rope, int pos, const float* ct, const float* st, float scale, int lane) {
    float ss = 0.f;
#pragma unroll
    for (int i = 0; i < 8; ++i) ss += x[i] * x[i];
    ss += DPP_F(ss, 0xB1); ss += DPP_F(ss, 0x4E); ss += DPP_F(ss, 0x141);
    const float r = 1.f / sqrtf(ss * (1.f / 64.f) + EPS);
    const int ch = lane & 7;
    const f32x4 g0 = *(const f32x4*)(g64 + 8 * ch), g1 = *(const f32x4*)(g64 + 8 * ch + 4);
    x[0] *= r * g0.x; x[1] *= r * g0.y; x[2] *= r * g0.z; x[3] *= r * g0.w; x[4] *= r * g1.x; x[5] *= r * g1.y; x[6] *= r * g1.z; x[7] *= r * g1.w;
    if (rope) {
        const int ax = ch >> 2, half = (ch >> 1) & 1, f0 = 8 * (ch & 1);
        const f32x4 c0 = *(const f32x4*)(ct + pos * 32 + ax * 16 + f0), c1 = *(const f32x4*)(ct + pos * 32 + ax * 16 + f0 + 4);
        const f32x4 s0 = *(const f32x4*)(st + pos * 32 + ax * 16 + f0), s1 = *(const f32x4*)(st + pos * 32 + ax * 16 + f0 + 4);
        const float cs[8] = {c0.x, c0.y, c0.z, c0.w, c1.x, c1.y, c1.z, c1.w}, sn[8] = {s0.x, s0.y, s0.z, s0.w, s1.x, s1.y, s1.z, s1.w};
#pragma unroll
        for (int i = 0; i < 8; ++i) { const float p = DPP_F(x[i], 0x4E);
            x[i] = half ? (x[i] * cs[i] + p * sn[i]) : (x[i] * cs[i] - p * sn[i]); }
    }
#pragma unroll
    for (int i = 0; i < 8; ++i) x[i] *= scale;
}
__device__ __forceinline__ void unpack8(const u32x4 w, float (&x)[8]) { x[0] = bflo(w.x); x[1] = bfhi(w.x); x[2] = bflo(w.y); x[3] = bfhi(w.y); x[4] = bflo(w.z); x[5] = bfhi(w.z); x[6] = bflo(w.w); x[7] = bfhi(w.w); }
__device__ __forceinline__ u32x4 pack8(const float (&x)[8]) { u32x4 w; w.x = cvtpk(x[0], x[1]); w.y = cvtpk(x[2], x[3]); w.z = cvtpk(x[4], x[5]); w.w = cvtpk(x[6], x[7]); return w; }

__device__ __forceinline__ void prep_phase(const Fr& F, const Args& a, int l, bool with_ctx) {
    constexpr int VROW = 272;
    LAS unsigned char* VA_l = F.lds;
    LAS unsigned char* VW_l = F.lds + 17408;
    LAS unsigned char* HT_l = F.lds + 34816;
    constexpr int HROW = 144;
    const float* ct = (const float*)(a.ws + WS_ROPE); const float* st = ct + SEQ * 32;
    const float* qkg = a.in[I_QKG] + l * 256;
    const bf16_t* RAWA = (const bf16_t*)(a.ws + WS_RAWA); const bf16_t* RAWW = (const bf16_t*)(a.ws + WS_RAWW);
    bf16_t* KA = (bf16_t*)(a.ws + WS_KA); bf16_t* KW = (bf16_t*)(a.ws + WS_KW); bf16_t* VTA = (bf16_t*)(a.ws + WS_VTA); bf16_t* VTW = (bf16_t*)(a.ws + WS_VTW);
    const bf16_t* U = (const bf16_t*)(a.ws + WS_U); bf16_t* X0 = (bf16_t*)(a.ws + WS_H); bf16_t* VT = (bf16_t*)(a.ws + WS_VT);
    const float* hsw = a.in[I_HSW] + l * 3 * 1536; const float* hsb = a.in[I_HSB] + l * 1536;
    for (int unit = F.bid; unit < NB * 36; unit += F.G) {
        const bool lat = unit < NB * 32;
        const int b = lat ? unit >> 5 : (unit - NB * 32) >> 2, p0 = lat ? (unit & 31) * 64 : ((unit - NB * 32) & 3) * 64;
        const int n = lat ? SEQ : CTX;
        const int row0 = lat ? b * SEQ + p0 : TL + b * CTX + p0;
        const int j0 = lat ? CTX + p0 : p0;
        __syncthreads();
        {
            const bool isw = (F.lane & 16) != 0; const int l16 = F.lane & 15, half = F.lane >> 5;
            u32x4 kw[4];
#pragma unroll
            for (int ps = 0; ps < 4; ++ps) { const int tk = 8 * F.wave + 2 * ps + half; kw[ps] = *(const u32x4*)((isw ? RAWW : RAWA) + (size_t)(row0 + tk) * 256 + l16 * 8); }
#pragma unroll
            for (int ps = 0; ps < 4; ++ps) { const int tk = 8 * F.wave + 2 * ps + half; float x[8]; unpack8(kw[ps], x);
                normrope8(x, qkg + (isw ? 192 : 64), lat, p0 + tk, ct, st, 1.f, F.lane);
                *(u32x4*)((isw ? KW : KA) + ((size_t)b * KEYS + j0 + tk) * 128 + l16 * 8) = pack8(x); }
        }
        for (int i = F.tid; i < 2 * 64 * 16; i += NTHR) { const int m = i >> 10, r = (i >> 4) & 63, cch = i & 15;
            const u32x4 w = *(const u32x4*)((m ? RAWW : RAWA) + (size_t)(row0 + r) * 256 + 128 + cch * 8);
            *(LAS u32x4*)((m ? VW_l : VA_l) + r * VROW + cch * 16) = w; }
        const bool do_hy = lat || with_ctx;
        if (do_hy) {
            int tq_ = F.tid; asm volatile("" : "+v"(tq_));
            const int cg = tq_ & 63, c = 8 * cg, t0 = 8 * F.wave;
            u32x4 x1p[8];
#pragma unroll
            for (int g = 0; g < 3; ++g) {
                const int ch = g * 512 + c;
                float w0[8], w1[8], w2[8], bb[8];
                { const f32x4 a0 = *(const f32x4*)(hsw + ch), a1 = *(const f32x4*)(hsw + ch + 4), b0 = *(const f32x4*)(hsw + 1536 + ch), b1 = *(const f32x4*)(hsw + 1536 + ch + 4),
                              c0 = *(const f32x4*)(hsw + 3072 + ch), c1 = *(const f32x4*)(hsw + 3072 + ch + 4), d0 = *(const f32x4*)(hsb + ch), d1 = *(const f32x4*)(hsb + ch + 4);
                  w0[0] = a0.x; w0[1] = a0.y; w0[2] = a0.z; w0[3] = a0.w; w0[4] = a1.x; w0[5] = a1.y; w0[6] = a1.z; w0[7] = a1.w;
                  w1[0] = b0.x; w1[1] = b0.y; w1[2] = b0.z; w1[3] = b0.w; w1[4] = b1.x; w1[5] = b1.y; w1[6] = b1.z; w1[7] = b1.w;
                  w2[0] = c0.x; w2[1] = c0.y; w2[2] = c0.z; w2[3] = c0.w; w2[4] = c1.x; w2[5] = c1.y; w2[6] = c1.z; w2[7] = c1.w;
                  bb[0] = d0.x; bb[1] = d0.y; bb[2] = d0.z; bb[3] = d0.w; bb[4] = d1.x; bb[5] = d1.y; bb[6] = d1.z; bb[7] = d1.w; }
                u32x4 raw[10];
#pragma unroll
                for (int i = 0; i < 10; ++i) { const int pos = p0 + t0 - 1 + i;
                    if (pos < 0 || pos >= n) { const unsigned z = zero_u32(); raw[i] = (u32x4){z, z, z, z}; } else raw[i] = *(const u32x4*)(U + (size_t)(row0 - p0 + pos) * 1536 + ch); }
#pragma unroll
                for (int t = 0; t < 8; ++t) { float up[8], uc[8], un[8], o[8]; unpack8(raw[t], up); unpack8(raw[t + 1], uc); unpack8(raw[t + 2], un);
#pragma unroll
                    for (int i = 0; i < 8; ++i) o[i] = fmaf(w0[i], up[i], fmaf(w1[i], uc[i], fmaf(w2[i], un[i], bb[i])));
                    if (g == 0) *(u32x4*)(X0 + (size_t)(row0 + t0 + t) * 512 + c) = pack8(o);
                    else if (g == 1) x1p[t] = pack8(o);
                    else { float x1[8]; unpack8(x1p[t], x1);
#pragma unroll
                        for (int i = 0; i < 8; ++i) o[i] *= x1[i];
                        x1p[t] = pack8(o); } }
            }
#pragma unroll
            for (int i = 0; i < 8; ++i) { unsigned short ev[8];
#pragma unroll
                for (int t = 0; t < 8; ++t) { const unsigned wsel = (i >> 1) == 0 ? x1p[t].x : (i >> 1) == 1 ? x1p[t].y : (i >> 1) == 2 ? x1p[t].z : x1p[t].w; ev[t] = (unsigned short)((i & 1) ? (wsel >> 16) : (wsel & 0xffffu)); }
                u32x4 w; w.x = ev[0] | ((unsigned)ev[1] << 16); w.y = ev[2] | ((unsigned)ev[3] << 16); w.z = ev[4] | ((unsigned)ev[5] << 16); w.w = ev[6] | ((unsigned)ev[7] << 16);
                *(LAS u32x4*)(HT_l + (c + i) * HROW + t0 * 2) = w; }
        }
        __syncthreads();
        for (int i = F.tid; i < 2 * 128 * 8; i += NTHR) { const int m = i >> 10, rr = (i >> 3) & 127, c8 = i & 7;
            LAS unsigned char* T = m ? VW_l : VA_l; unsigned short e[8];
#pragma unroll
            for (int jj = 0; jj < 8; ++jj) { const int key = 16 * (c8 >> 1) + 8 * (jj >> 2) + 4 * (c8 & 1) + (jj & 3); e[jj] = *(const LAS bf16_t*)(T + key * VROW + rr * 2); }
            u32x4 w; w.x = e[0] | ((unsigned)e[1] << 16); w.y = e[2] | ((unsigned)e[3] << 16); w.z = e[4] | ((unsigned)e[5] << 16); w.w = e[6] | ((unsigned)e[7] << 16);
            *(u32x4*)((m ? VTW : VTA) + ((size_t)(b * 2 + (rr >> 6)) * 64 + (rr & 63)) * KEYS + j0 + c8 * 8) = w; }
        if (do_hy) { bf16_t* VTb = lat ? VT : VT + VT_CTX_OFF;
          for (int i = F.tid; i < 512 * 8; i += NTHR) { const int cch = i >> 3, c8 = i & 7;
              const u32x4 w = *(const LAS u32x4*)(HT_l + cch * HROW + c8 * 16);
              *(u32x4*)(VTb + ((size_t)cch * NB + b) * n + p0 + c8 * 8) = w; } }
    }
    __syncthreads();
}

__device__ __forceinline__ void hyena_final_phase(const Fr& F, const Args& a, int l, bool with_ctx) {
    constexpr int HROW = 144;
    LAS unsigned char* T = F.lds;
    const bf16_t* X0 = (const bf16_t*)(a.ws + WS_H); const bf16_t* VT = (const bf16_t*)(a.ws + WS_VT); const bf16_t* YT = (const bf16_t*)(a.ws + WS_YT);
    unsigned char* YH = a.ws + WS_Y8 + 512;
    const float* FN = (const float*)(a.ws + WS_FNORM) + l * 1024; const float* skip = a.in[I_HBIAS] + l * 512;
    const int nunits = with_ctx ? NB * 32 + NB * 16 : NB * 32;
    for (int unit = F.bid; unit < nunits; unit += F.G) {
        const bool lat = unit < NB * 32; const int u2 = unit - NB * 32;
        const int b = lat ? unit >> 5 : u2 >> 4, p0 = lat ? (unit & 31) * 64 : (u2 & 15) * 16;
        const int ul = lat ? 64 : 16, ncs = lat ? 3 : 1;
        const int n = lat ? SEQ : CTX; const int row0 = lat ? b * SEQ + p0 : TL + b * CTX + p0;
        const bf16_t* Yb = lat ? YT : YT + VT_CTX_OFF; const bf16_t* Vb = lat ? VT : VT + VT_CTX_OFF; const float* inv = FN + (lat ? 0 : 512);
        __syncthreads();
        for (int i = F.tid; i < (512 << ncs); i += NTHR) { const int cch = i >> ncs, c8 = i & ((1 << ncs) - 1); const size_t off = ((size_t)cch * NB + b) * n + p0 + c8 * 8;
            const u32x4 y = *(const u32x4*)(Yb + off), v = *(const u32x4*)(Vb + off); const float s = inv[cch], k = skip[cch];
            u32x4 o;
            o.x = cvtpk(bflo(y.x) * s + k * bflo(v.x), bfhi(y.x) * s + k * bfhi(v.x)); o.y = cvtpk(bflo(y.y) * s + k * bflo(v.y), bfhi(y.y) * s + k * bfhi(v.y));
            o.z = cvtpk(bflo(y.z) * s + k * bflo(v.z), bfhi(y.z) * s + k * bfhi(v.z)); o.w = cvtpk(bflo(y.w) * s + k * bflo(v.w), bfhi(y.w) * s + k * bfhi(v.w));
            *(LAS u32x4*)(T + cch * HROW + c8 * 16) = o; }
        __syncthreads();
        { const int th = F.tid & 255, half = F.tid >> 8, c = 2 * th, hl = ul >> 1;
          for (int t = hl * half; t < hl * half + hl; ++t) {
              const unsigned x0 = *(const unsigned*)(X0 + (size_t)(row0 + t) * 512 + c);
              const float y0 = bf1(*(const LAS bf16_t*)(T + c * HROW + t * 2)), y1 = bf1(*(const LAS bf16_t*)(T + (c + 1) * HROW + t * 2));
              *(unsigned short*)(YH + (size_t)(row0 + t) * 1536 + c) = (unsigned short)__builtin_amdgcn_cvt_pk_fp8_f32(clamp_fp8(bflo(x0) * y0 * 16.f), clamp_fp8(bfhi(x0) * y1 * 16.f), 0, false); } }
    }
    __syncthreads();
}

#define MFMA32(a, b, c) __builtin_amdgcn_mfma_f32_32x32x16_bf16((a), (b), (c), 0, 0, 0)
#define MFMA16(a, b, c) __builtin_amdgcn_mfma_f32_16x16x32_bf16((a), (b), (c), 0, 0, 0)

__device__ __forceinline__ int tile_off(int row, int chunk) { return row * 128 + ((chunk ^ ((row >> 1) & 7)) << 4); }

template <bool WIN>
__device__ __forceinline__ void attn_unit(const Fr& F, const bf16_t* Qw, unsigned char* Yw, const bf16_t* Kb, const bf16_t* VTb, int a0, int na, int b0, int nb, int qpos0, bool has_sink, float sink2, const float* g64, bool rope, const float* ct, const float* st) {
    LAS unsigned char* L = F.lds;
    const int r = F.lane & 31, h = F.lane >> 5;
    const int xaddr = (lane_id() ^ 32) << 2;
#define SWAP32(v) __builtin_bit_cast(float, __builtin_amdgcn_ds_bpermute(xaddr, __builtin_bit_cast(int, (v))))
    bf16x8 q[4];
    {
        float x[4][8]; float ss = 0.f;
#pragma unroll
        for (int kk = 0; kk < 4; ++kk) { const u32x4 w = *(const u32x4*)(Qw + (size_t)r * 1536 + 16 * kk + 8 * h); unpack8(w, x[kk]);
#pragma unroll
            for (int j = 0; j < 8; ++j) ss += x[kk][j] * x[kk][j]; }
        ss += SWAP32(ss);
        const float rn = (1.f / sqrtf(ss * (1.f / 64.f) + EPS)) * QSCALE;
#pragma unroll
        for (int kk = 0; kk < 4; ++kk) { const f32x4 g0 = *(const f32x4*)(g64 + 16 * kk + 8 * h), g1 = *(const f32x4*)(g64 + 16 * kk + 8 * h + 4);
            x[kk][0] *= rn * g0.x; x[kk][1] *= rn * g0.y; x[kk][2] *= rn * g0.z; x[kk][3] *= rn * g0.w; x[kk][4] *= rn * g1.x; x[kk][5] *= rn * g1.y; x[kk][6] *= rn * g1.z; x[kk][7] *= rn * g1.w; }
        if (rope) { const int pos = qpos0 + r;
#pragma unroll
            for (int ax = 0; ax < 2; ++ax) {
                const f32x4 c0 = *(const f32x4*)(ct + pos * 32 + ax * 16 + 8 * h), c1 = *(const f32x4*)(ct + pos * 32 + ax * 16 + 8 * h + 4);
                const f32x4 s0 = *(const f32x4*)(st + pos * 32 + ax * 16 + 8 * h), s1 = *(const f32x4*)(st + pos * 32 + ax * 16 + 8 * h + 4);
                const float cs[8] = {c0.x, c0.y, c0.z, c0.w, c1.x, c1.y, c1.z, c1.w}, sn[8] = {s0.x, s0.y, s0.z, s0.w, s1.x, s1.y, s1.z, s1.w};
#pragma unroll
                for (int j = 0; j < 8; ++j) { const float av = x[2 * ax][j], bv = x[2 * ax + 1][j]; x[2 * ax][j] = av * cs[j] - bv * sn[j]; x[2 * ax + 1][j] = bv * cs[j] + av * sn[j]; } } }
#pragma unroll
        for (int kk = 0; kk < 4; ++kk) q[kk] = __builtin_bit_cast(bf16x8, pack8(x[kk]));
    }
    f32x16 o0, o1;
#pragma unroll
    for (int i = 0; i < 16; ++i) { o0[i] = 0.f; o1[i] = 0.f; }
    float lsum = 0.f;
    const int ntile = na + nb;
    const int srow = F.tid >> 3, sch = F.tid & 7;
    const int soff = tile_off(srow, sch);
    int t4[4];
#pragma unroll
    for (int j = 0; j < 4; ++j) t4[j] = tile_off(r, 2 * j + h);
#define AT_KT(i) ((i) < na ? a0 + (i) : b0 + ((i) - na))
#define AT_LD(i, K0, K1, V0, V1) do { const int kt_ = AT_KT(i); \
        K0 = *(const u32x4*)(Kb + (size_t)(kt_ * 128 + srow) * 128 + sch * 8); K1 = *(const u32x4*)(Kb + (size_t)(kt_ * 128 + 64 + srow) * 128 + sch * 8); \
        V0 = *(const u32x4*)(VTb + (size_t)srow * KEYS + kt_ * 128 + sch * 8); V1 = *(const u32x4*)(VTb + (size_t)srow * KEYS + kt_ * 128 + 64 + sch * 8); } while (0)
#define AT_ST(buf, K0, K1, V0, V1) do { LAS unsigned char* B_ = L + (buf) * 32768 + soff; \
        *(LAS u32x4*)(B_) = K0; *(LAS u32x4*)(B_ + 8192) = K1; *(LAS u32x4*)(B_ + 16384) = V0; *(LAS u32x4*)(B_ + 24576) = V1; } while (0)
#define AT_QK(S0, S1, Kt) do { bf16x8 kf_[8]; \
        _Pragma("unroll") for (int kk = 0; kk < 4; ++kk) { kf_[2 * kk] = *(const LAS bf16x8*)(L + (Kt) + t4[kk]); kf_[2 * kk + 1] = *(const LAS bf16x8*)(L + (Kt) + t4[kk] + 4096); } \
        _Pragma("unroll") for (int i_ = 0; i_ < 16; ++i_) { S0[i_] = 0.f; S1[i_] = 0.f; } \
        _Pragma("unroll") for (int kk = 0; kk < 4; ++kk) { S0 = MFMA32(kf_[2 * kk], q[kk], S0); S1 = MFMA32(kf_[2 * kk + 1], q[kk], S1); } } while (0)
#define AT_EXP(S0, S1, P, kpos0) do { \
        if (WIN && (kpos0) >= 0) { const int kbase = (kpos0) + 4 * h, qp = qpos0 + r; \
            _Pragma("unroll") for (int i = 0; i < 16; ++i) { const int kr = (i & 3) + 8 * (i >> 2); const int d0 = kbase + kr - qp, d1 = d0 + 32; \
                if (d0 > 128 || d0 < -128) S0[i] = -1e30f; if (d1 > 128 || d1 < -128) S1[i] = -1e30f; } } \
        _Pragma("unroll") for (int i = 0; i < 16; ++i) { S0[i] = fast_exp2(S0[i]); S1[i] = fast_exp2(S1[i]); lsum += S0[i] + S1[i]; } \
        { u32x4 w; \
          w.x = cvtpk(S0[0], S0[1]); w.y = cvtpk(S0[2], S0[3]); w.z = cvtpk(S0[4], S0[5]); w.w = cvtpk(S0[6], S0[7]); P[0] = __builtin_bit_cast(bf16x8, w); \
          w.x = cvtpk(S0[8], S0[9]); w.y = cvtpk(S0[10], S0[11]); w.z = cvtpk(S0[12], S0[13]); w.w = cvtpk(S0[14], S0[15]); P[1] = __builtin_bit_cast(bf16x8, w); \
          w.x = cvtpk(S1[0], S1[1]); w.y = cvtpk(S1[2], S1[3]); w.z = cvtpk(S1[4], S1[5]); w.w = cvtpk(S1[6], S1[7]); P[2] = __builtin_bit_cast(bf16x8, w); \
          w.x = cvtpk(S1[8], S1[9]); w.y = cvtpk(S1[10], S1[11]); w.z = cvtpk(S1[12], S1[13]); w.w = cvtpk(S1[14], S1[15]); P[3] = __builtin_bit_cast(bf16x8, w); } } while (0)
#define AT_PV(P, Vt) do { bf16x8 vf_[8]; \
        _Pragma("unroll") for (int c = 0; c < 4; ++c) { vf_[2 * c] = *(const LAS bf16x8*)(L + (Vt) + t4[c]); vf_[2 * c + 1] = *(const LAS bf16x8*)(L + (Vt) + t4[c] + 4096); } \
        _Pragma("unroll") for (int c = 0; c < 4; ++c) { o0 = MFMA32(vf_[2 * c], P[c], o0); o1 = MFMA32(vf_[2 * c + 1], P[c], o1); } } while (0)
#define AT_BODY(it) do { \
        const int kt = AT_KT(it); \
        if ((it) + 1 < ntile) AT_LD((it) + 1, kA0, kA1, vA0, vA1); \
        const int Bc = ((it) & 1) * 32768;                                \
        const int kp = (WIN && kt >= 2) ? (kt - 2) * 128 : -1;            \
        { f32x16 sa0, sa1; bf16x8 pa[4]; \
          AT_QK(sa0, sa1, Bc); AT_EXP(sa0, sa1, pa, kp); AT_PV(pa, Bc + 16384); } \
        __builtin_amdgcn_sched_barrier(0); \
        { f32x16 sb0, sb1; bf16x8 pb_[4]; \
          AT_QK(sb0, sb1, Bc + 8192); AT_EXP(sb0, sb1, pb_, (kp < 0 ? -1 : kp + 64)); AT_PV(pb_, Bc + 24576); } \
        if ((it) + 1 < ntile) AT_ST(((it) + 1) & 1, kA0, kA1, vA0, vA1); \
        __syncthreads(); } while (0)
    u32x4 kA0, kA1, vA0, vA1;
    AT_LD(0, kA0, kA1, vA0, vA1);
    __syncthreads();
    AT_ST(0, kA0, kA1, vA0, vA1);
    __syncthreads();
    for (int it = 0; it < ntile; it += 2) {
        AT_BODY(it);
        if (it + 1 < ntile) AT_BODY(it + 1);
    }
#undef AT_BODY
#undef AT_QK
#undef AT_EXP
#undef AT_PV
#undef AT_ST
#undef AT_LD
#undef AT_KT
    float lt = lsum + SWAP32(lsum);
    if (has_sink) lt += fast_exp2(sink2);
    const float inv = 1.f / lt;
#pragma unroll
    for (int g = 0; g < 4; ++g) { const float i16 = inv * 16.f;
        *(unsigned*)(Yw + (size_t)r * 1536 + 8 * g + 4 * h) = cvt4_fp8(o0[4 * g] * i16, o0[4 * g + 1] * i16, o0[4 * g + 2] * i16, o0[4 * g + 3] * i16);
        *(unsigned*)(Yw + (size_t)r * 1536 + 32 + 8 * g + 4 * h) = cvt4_fp8(o1[4 * g] * i16, o1[4 * g + 1] * i16, o1[4 * g + 2] * i16, o1[4 * g + 3] * i16); }
#undef SWAP32
}

__device__ __forceinline__ void hyena_unit_lat(const Fr& F, const bf16_t* Fg, const bf16_t* Vg, bf16_t* Yg) {
    constexpr int FREP = 8192 + 64, VPIT = 4096 + 16, VOFF = 8 * FREP;
    LAS unsigned char* L = F.lds;
    __syncthreads();
    { const int x = F.tid;
      const u32x4 lo = *(const u32x4*)(Fg + x * 8); u32x4 hi; if (x < 511) hi = *(const u32x4*)(Fg + x * 8 + 8); else { const unsigned z = zero_u32(); hi = (u32x4){z, z, z, z}; }
      const unsigned wv[8] = {lo.x, lo.y, lo.z, lo.w, hi.x, hi.y, hi.z, hi.w};
      *(LAS u32x4*)(L + x * 16) = lo;
#pragma unroll
      for (int rho = 1; rho < 8; ++rho) { u32x4 o;
          unsigned od[4];
#pragma unroll
          for (int d = 0; d < 4; ++d) { const int ob = 4 * d + 2 * rho, i = ob >> 2, s = ob & 3; od[d] = __builtin_amdgcn_alignbyte(wv[i + 1 < 8 ? i + 1 : 7], wv[i], s); }
          o.x = od[0]; o.y = od[1]; o.z = od[2]; o.w = od[3];
          *(LAS u32x4*)(L + rho * FREP + x * 16) = o; } }
    for (int i = F.tid; i < 16 * 256; i += NTHR) { const int b = i >> 8, x = i & 255; *(LAS u32x4*)(L + VOFF + b * VPIT + x * 16) = *(const u32x4*)(Vg + (size_t)b * SEQ + x * 8); }
    __syncthreads();
    const int i16 = F.lane & 15, q4 = F.lane >> 4, w = F.wave;
    const int base0 = 2047 - 256 * w - i16 + 8 * q4;
    const int rho = base0 & 7;
    LAS unsigned char* Ap = L + rho * FREP + (base0 - rho) * 2;
    LAS unsigned char* Bp = L + VOFF + i16 * VPIT + q4 * 16;
    bf16x8 A[16]; f32x4 acc[16];
#pragma unroll
    for (int rr = 0; rr < 16; ++rr) { A[rr] = *(const LAS bf16x8*)(Ap - 32 * rr); acc[rr] = (f32x4){0.f, 0.f, 0.f, 0.f}; }
    bf16x8 Bn = *(const LAS bf16x8*)(Bp);
    for (int o = 0; o < 8; ++o) {
#pragma unroll
        for (int u = 0; u < 8; ++u) {
            const int st = o * 8 + u;
            const bf16x8 Bf = Bn;
            if (st < 63) Bn = *(const LAS bf16x8*)(Bp + 64 * st + 64);
#pragma unroll
            for (int rr = 0; rr < 16; ++rr) acc[rr] = MFMA16(A[(rr - 2 * u) & 15], Bf, acc[rr]);
            if (st < 63) { A[(-2 * u - 2) & 15] = *(const LAS bf16x8*)(Ap + 64 * st + 64); A[(-2 * u - 1) & 15] = *(const LAS bf16x8*)(Ap + 64 * st + 32); }
        }
    }
#pragma unroll
    for (int rr = 0; rr < 16; ++rr) { u32x2 wv; wv.x = cvtpk(acc[rr].x, acc[rr].y); wv.y = cvtpk(acc[rr].z, acc[rr].w);
        *(u32x2*)(Yg + (size_t)i16 * SEQ + 256 * w + 16 * rr + 4 * q4) = wv; }
}
__device__ __forceinline__ void hyena_unit_ctx(const Fr& F, const bf16_t* Fg, const bf16_t* Vg, bf16_t* Yg) {
    constexpr int FREP = 1024 + 64, VPIT = 512 + 16, VOFF = 8 * FREP;
    LAS unsigned char* L = F.lds;
    __syncthreads();
    if (F.tid < 64) *(LAS u32x4*)(L + F.tid * 16) = *(const u32x4*)(Fg + F.tid * 8);
    if (F.tid >= 64 && F.tid < 68) { const unsigned z = zero_u32(); *(LAS u32x4*)(L + 1024 + (F.tid - 64) * 16) = (u32x4){z, z, z, z}; }
    { const int b = F.tid >> 5, x = F.tid & 31; *(LAS u32x4*)(L + VOFF + b * VPIT + x * 16) = *(const u32x4*)(Vg + (size_t)b * CTX + x * 8); }
    __syncthreads();
    for (int i = F.tid; i < 7 * 256; i += NTHR) { const int rho = 1 + i / 256, x2 = (i % 256) * 2; const int s0 = x2 + rho, s1 = x2 + 1 + rho;
        const unsigned e0 = s0 < 512 ? *(const LAS bf16_t*)(L + s0 * 2) : 0, e1 = s1 < 512 ? *(const LAS bf16_t*)(L + s1 * 2) : 0;
        *(LAS unsigned*)(L + rho * FREP + x2 * 2) = e0 | (e1 << 16); }
    __syncthreads();
    const int i16 = F.lane & 15, q4 = F.lane >> 4, w = F.wave;
    const int base0 = 255 - 32 * w - i16 + 8 * q4, rho = base0 & 7;
    LAS unsigned char* Ap = L + rho * FREP + (base0 - rho) * 2;
    LAS unsigned char* Bp = L + VOFF + i16 * VPIT + q4 * 16;
    f32x4 acc0 = (f32x4){0.f, 0.f, 0.f, 0.f}, acc1 = acc0;
#pragma unroll
    for (int st = 0; st < 8; ++st) { const bf16x8 Bf = *(const LAS bf16x8*)(Bp + 64 * st);
        const bf16x8 A0 = *(const LAS bf16x8*)(Ap + 64 * st), A1 = *(const LAS bf16x8*)(Ap + 64 * st - 32);
        acc0 = MFMA16(A0, Bf, acc0); acc1 = MFMA16(A1, Bf, acc1); }
    u32x2 wv; wv.x = cvtpk(acc0.x, acc0.y); wv.y = cvtpk(acc0.z, acc0.w); *(u32x2*)(Yg + (size_t)i16 * CTX + 32 * w + 4 * q4) = wv;
    wv.x = cvtpk(acc1.x, acc1.y); wv.y = cvtpk(acc1.z, acc1.w); *(u32x2*)(Yg + (size_t)i16 * CTX + 32 * w + 16 + 4 * q4) = wv;
}

__device__ __forceinline__ void mixer_phase(const Fr& F, const Args& a, int l, bool with_ctx, unsigned long long& sacc, const int swhich) {
#if defined(PROBE_P)
    unsigned long long st0 = __builtin_amdgcn_s_memrealtime();
#define SUBMARK(w) do { const unsigned long long t_ = __builtin_amdgcn_s_memrealtime(); if (swhich == (w)) sacc += t_ - st0; st0 = t_; } while (0)
#else
#define SUBMARK(w) do { } while (0)
#endif
    const bf16_t* QA = (const bf16_t*)(a.ws + WS_QA);
    unsigned char* Y8 = a.ws + WS_Y8;
    const bf16_t* KA = (const bf16_t*)(a.ws + WS_KA); const bf16_t* KW = (const bf16_t*)(a.ws + WS_KW);
    const bf16_t* VTA = (const bf16_t*)(a.ws + WS_VTA); const bf16_t* VTW = (const bf16_t*)(a.ws + WS_VTW);
    const float* sinks = a.in[I_SINK] + l * 8; const float* qkg = a.in[I_QKG] + l * 256;
    const float* ct = (const float*)(a.ws + WS_ROPE); const float* st = ct + SEQ * 32;
    const int wq = F.wave >> 1, wh = F.wave & 1;
    const int ubid = (F.G % 8 == 0) ? (F.bid & 7) * (F.G >> 3) + (F.bid >> 3) : F.bid;
#define RELANE(FX) do { int t_ = F.wave * 64 + lane_id(); asm volatile("" : "+v"(t_)); FX.tid = t_; FX.lane = t_ & 63; } while (0)
    Fr FA = F; RELANE(FA);
    const int nctx = with_ctx ? NB * 2 * 4 : 0;
    for (int unit = ubid; unit < NB * 2 * 32 + nctx; unit += F.G) {
        const bool isc = unit >= NB * 2 * 32; const int u2 = unit - NB * 2 * 32;
        const int b = isc ? u2 >> 3 : unit >> 6, kvh = isc ? (u2 >> 2) & 1 : (unit >> 5) & 1, pb = isc ? u2 & 3 : unit & 31;
        const size_t qo = (size_t)((isc ? TL + b * CTX : b * SEQ) + pb * 64 + wh * 32) * 1536 + (kvh * 4 + wq) * 64;
        attn_unit<false>(FA, QA + qo, Y8 + qo, KA + (size_t)b * KEYS * 128 + kvh * 64, VTA + (size_t)(b * 2 + kvh) * 64 * KEYS, 0, isc ? 2 : KEYS / 128, 0, 0, isc ? 0 : pb * 64 + wh * 32, false, 0.f, qkg, !isc, ct, st);
    }
    SUBMARK(30);
    Fr FW = F; RELANE(FW);
    for (int unit = ubid; unit < NB * 2 * 32 + nctx; unit += F.G) {
        const bool isc = unit >= NB * 2 * 32; const int u2 = unit - NB * 2 * 32;
        const int b = isc ? u2 >> 3 : unit >> 6, kvh = isc ? (u2 >> 2) & 1 : (unit >> 5) & 1, pb = isc ? u2 & 3 : unit & 31;
        const size_t qo = (size_t)((isc ? TL + b * CTX : b * SEQ) + pb * 64 + wh * 32) * 1536 + (kvh * 4 + wq) * 64 + 1024;
        const int lo = pb < 2 ? 0 : (pb - 2) >> 1, hi = ((64 * pb + 191) >> 7) > 15 ? 15 : ((64 * pb + 191) >> 7);
        attn_unit<true>(FW, QA + qo, Y8 + qo, KW + (size_t)b * KEYS * 128 + kvh * 64, VTW + (size_t)(b * 2 + kvh) * 64 * KEYS, 0, 2, isc ? 0 : 2 + lo, isc ? 0 : hi - lo + 1, isc ? 0 : pb * 64 + wh * 32, true, sinks[kvh * 4 + wq] * LOG2E, qkg + 128, !isc, ct, st);
    }
    SUBMARK(31);
    SUBMARK(32);
    const bf16_t* FL = (const bf16_t*)(a.ws + WS_FL) + (size_t)l * 512 * 4096; const bf16_t* FC = (const bf16_t*)(a.ws + WS_FC) + (size_t)l * 512 * 512;
    const bf16_t* VT = (const bf16_t*)(a.ws + WS_VT); bf16_t* YT = (bf16_t*)(a.ws + WS_YT);
    Fr FH = F; RELANE(FH);
    for (int c = F.bid; c < HYW; c += F.G) hyena_unit_lat(FH, FL + (size_t)c * 4096, VT + (size_t)c * NB * SEQ, YT + (size_t)c * NB * SEQ);
    if (with_ctx) for (int c = F.bid; c < HYW; c += F.G) hyena_unit_ctx(FH, FC + (size_t)c * 512, VT + VT_CTX_OFF + (size_t)c * NB * CTX, YT + VT_CTX_OFF + (size_t)c * NB * CTX);
    __syncthreads();
    SUBMARK(33);
#undef SUBMARK
#undef RELANE
}

__device__ __forceinline__ float gate_q(float x) { return fminf(256.f * sigmoid_f(x), 255.49f); }
__device__ __forceinline__ unsigned pack_u8x4(float a, float b, float c, float d) { return (unsigned)(int)a | ((unsigned)(int)b << 8) | ((unsigned)(int)c << 16) | ((unsigned)(int)d << 24); }
__device__ __forceinline__ float gq(unsigned w, int k) { return (float)((w >> (8 * k)) & 0xffu) + 0.5f; }
struct EpiInProj {
    static constexpr bool PERM = true, AFTER_DRAIN = false; static constexpr int NSEG = 1;
    unsigned char* ws; int pn_off;
    __device__ __forceinline__ void operator()(const pg8::f32x4 (&acc)[2][2][4][2], const pg8::Unit& u, int wr, int wc, int fr, int fq) const {
        asm volatile("" : "+v"(fr), "+v"(fq));
        const int pn = __builtin_amdgcn_readfirstlane(u.pn) + pn_off; unsigned long long boff; int ldc, colt; bool sig = false;
        if (pn < 2) { boff = WS_QA; ldc = 1536; colt = pn * 256; }
        else if (pn == 2) { boff = WS_RAWA; ldc = 256; colt = 0; }
        else if (pn < 9) { boff = WS_U; ldc = 1536; colt = (pn - 3) * 256; }
        else if (pn < 11) { boff = WS_QA; ldc = 1536; colt = 1024 + (pn - 9) * 256; }
        else if (pn == 11) { boff = WS_RAWW; ldc = 256; colt = 0; }
        else { boff = WS_G; ldc = 3072; colt = (pn - 12) * 256; sig = true; }
        bf16_t* base = (bf16_t*)(ws + boff); unsigned char* Gt = ws + boff;
        const int row0 = u.pm * 256 + wr * 64 + fr, col0 = colt + wc * 32 + 8 * fq;
        if (sig) {
            unsigned char* gb = (unsigned char*)Gt;
#pragma unroll
            for (int ai = 0; ai < 2; ++ai)
#pragma unroll
                for (int m = 0; m < 4; ++m) { unsigned char* rowp = gb + (size_t)(row0 + ai * 128 + m * 16) * 3072 + col0;
#pragma unroll
                    for (int bj = 0; bj < 2; ++bj) { const pg8::f32x4 v0 = acc[ai][bj][m][0], v1 = acc[ai][bj][m][1];
                        u32x2 w; w.x = pack_u8x4(gate_q(v0.x), gate_q(v0.y), gate_q(v0.z), gate_q(v0.w)); w.y = pack_u8x4(gate_q(v1.x), gate_q(v1.y), gate_q(v1.z), gate_q(v1.w));
                        *(u32x2*)(rowp + bj * 128) = w; } }
            return;
        }
#pragma unroll
        for (int ai = 0; ai < 2; ++ai)
#pragma unroll
            for (int m = 0; m < 4; ++m) { bf16_t* rowp = base + (size_t)(row0 + ai * 128 + m * 16) * ldc + col0;
#pragma unroll
                for (int bj = 0; bj < 2; ++bj) { const pg8::f32x4 v0 = acc[ai][bj][m][0], v1 = acc[ai][bj][m][1];
                    u32x4 w; w.x = cvtpk(v0.x, v0.y); w.y = cvtpk(v0.z, v0.w); w.z = cvtpk(v1.x, v1.y); w.w = cvtpk(v1.z, v1.w);
                    *(u32x4*)(rowp + bj * 128) = w; } }
    }
};
struct EpiGate {
    static constexpr bool PERM = true, AFTER_DRAIN = false; static constexpr int NSEG = 1;
    unsigned char* Gt;
    __device__ __forceinline__ void operator()(const pg8::f32x4 (&acc)[2][2][4][2], const pg8::Unit& u, int wr, int wc, int fr, int fq) const {
        asm volatile("" : "+v"(fr), "+v"(fq));
        const int row0 = u.pm * 256 + wr * 64 + fr, col0 = u.pn * 256 + wc * 32 + 8 * fq;
#pragma unroll
        for (int ai = 0; ai < 2; ++ai)
#pragma unroll
            for (int m = 0; m < 4; ++m) { unsigned char* rowp = Gt + (size_t)(row0 + ai * 128 + m * 16) * 3072 + col0;
#pragma unroll
                for (int bj = 0; bj < 2; ++bj) { const pg8::f32x4 v0 = acc[ai][bj][m][0], v1 = acc[ai][bj][m][1];
                    u32x2 w; w.x = pack_u8x4(gate_q(v0.x), gate_q(v0.y), gate_q(v0.z), gate_q(v0.w)); w.y = pack_u8x4(gate_q(v1.x), gate_q(v1.y), gate_q(v1.z), gate_q(v1.w));
                    *(u32x2*)(rowp + bj * 128) = w; } }
    }
};
struct EpiMerge {
    static constexpr bool PERM = true, AFTER_DRAIN = false; static constexpr int NSEG = 3;
    unsigned char* Mo; const unsigned char* Gt;
    __device__ __forceinline__ void rescale(pg8::f32x4 (&acc)[2][2][4][2], const pg8::Unit& u, int seg, int wr, int wc, int fr, int fq) const {
        asm volatile("" : "+v"(fr), "+v"(fq));
        const int row0 = u.pm * 256 + wr * 64 + fr, col0 = u.pn * 256 + wc * 32 + 8 * fq;
        const unsigned char* G0 = Gt + seg * 1024 + col0;
        u32x2 ga[2][4][2], gb[2][4][2];
#pragma unroll
        for (int ai = 0; ai < 2; ++ai)
#pragma unroll
            for (int m = 0; m < 4; ++m)
#pragma unroll
                for (int bj = 0; bj < 2; ++bj) { const size_t row = (size_t)(row0 + ai * 128 + m * 16);
                    ga[ai][m][bj] = *(const u32x2*)(G0 + row * 3072 + bj * 128); gb[ai][m][bj] = *(const u32x2*)(G0 + row * 3072 + 1024 + bj * 128); }
        __builtin_amdgcn_sched_barrier(0);
#pragma unroll
        for (int ai = 0; ai < 2; ++ai)
#pragma unroll
            for (int m = 0; m < 4; ++m)
#pragma unroll
                for (int bj = 0; bj < 2; ++bj) { const u32x2 a = ga[ai][m][bj], b = gb[ai][m][bj]; pg8::f32x4& v0 = acc[ai][bj][m][0]; pg8::f32x4& v1 = acc[ai][bj][m][1];
                    v0.x *= gq(a.x, 0) * fast_rcp(gq(b.x, 0)); v0.y *= gq(a.x, 1) * fast_rcp(gq(b.x, 1)); v0.z *= gq(a.x, 2) * fast_rcp(gq(b.x, 2)); v0.w *= gq(a.x, 3) * fast_rcp(gq(b.x, 3));
                    v1.x *= gq(a.y, 0) * fast_rcp(gq(b.y, 0)); v1.y *= gq(a.y, 1) * fast_rcp(gq(b.y, 1)); v1.z *= gq(a.y, 2) * fast_rcp(gq(b.y, 2)); v1.w *= gq(a.y, 3) * fast_rcp(gq(b.y, 3)); }
        __builtin_amdgcn_sched_barrier(0);
    }
    __device__ __forceinline__ void operator()(const pg8::f32x4 (&acc)[2][2][4][2], const pg8::Unit& u, int wr, int wc, int fr, int fq) const {
        asm volatile("" : "+v"(fr), "+v"(fq));
        const int row0 = u.pm * 256 + wr * 64 + fr, col0 = u.pn * 256 + wc * 32 + 8 * fq;
        constexpr float S = 16.f / 256.f;
        u32x2 gv[2][4][2];
#pragma unroll
        for (int ai = 0; ai < 2; ++ai)
#pragma unroll
            for (int m = 0; m < 4; ++m)
#pragma unroll
                for (int bj = 0; bj < 2; ++bj) gv[ai][m][bj] = *(const u32x2*)(Gt + (size_t)(row0 + ai * 128 + m * 16) * 3072 + 2048 + col0 + bj * 128);
        __builtin_amdgcn_sched_barrier(0);
#pragma unroll
        for (int ai = 0; ai < 2; ++ai) {
#pragma unroll
            for (int m = 0; m < 4; ++m)
#pragma unroll
                for (int bj = 0; bj < 2; ++bj) { const pg8::f32x4 v0 = acc[ai][bj][m][0], v1 = acc[ai][bj][m][1]; const u32x2 g = gv[ai][m][bj];
                    u32x2 w; w.x = cvt4_fp8(v0.x * (gq(g.x, 0) * S), v0.y * (gq(g.x, 1) * S), v0.z * (gq(g.x, 2) * S), v0.w * (gq(g.x, 3) * S));
                    w.y = cvt4_fp8(v1.x * (gq(g.y, 0) * S), v1.y * (gq(g.y, 1) * S), v1.z * (gq(g.y, 2) * S), v1.w * (gq(g.y, 3) * S));
                    *(u32x2*)(Mo + (size_t)(row0 + ai * 128 + m * 16) * 1024 + col0 + bj * 128) = w; }
            __builtin_amdgcn_sched_barrier(0);
        }
    }
};
struct EpiOut {
    static constexpr bool PERM = true, AFTER_DRAIN = false; static constexpr int NSEG = 1;
    bf16_t* XB; const float* MODl;
    __device__ __forceinline__ void operator()(const pg8::f32x4 (&acc)[2][2][4][2], const pg8::Unit& u, int wr, int wc, int fr, int fq) const {
        asm volatile("" : "+v"(fr), "+v"(fq));
        const int trow = u.pm * 256;
        const int row0 = trow + wr * 64 + fr, col0 = u.pn * 256 + wc * 32 + 8 * fq;
        const float* md = MODl + (size_t)mod_row(trow) * DIN + 2 * 1024 + col0;
        bf16_t* xp = XB + (size_t)row0 * D + col0;
        f32x4 mv[2][2];
#pragma unroll
        for (int bj = 0; bj < 2; ++bj)
#pragma unroll
            for (int n = 0; n < 2; ++n) mv[bj][n] = *(const f32x4*)(md + bj * 128 + 4 * n);
#pragma unroll
        for (int ai = 0; ai < 2; ++ai) {
            u32x4 xv[4][2];
#pragma unroll
            for (int m = 0; m < 4; ++m)
#pragma unroll
                for (int bj = 0; bj < 2; ++bj) xv[m][bj] = *(const u32x4*)(xp + (size_t)(ai * 128 + m * 16) * D + bj * 128);
            __builtin_amdgcn_sched_barrier(0);
#pragma unroll
            for (int m = 0; m < 4; ++m)
#pragma unroll
                for (int bj = 0; bj < 2; ++bj) { const pg8::f32x4 a0 = acc[ai][bj][m][0], a1 = acc[ai][bj][m][1]; const u32x4 x8 = xv[m][bj]; const f32x4 m0 = mv[bj][0], m1 = mv[bj][1];
                    u32x4 o; o.x = cvtpk(fmaf(m0.x, a0.x, bflo(x8.x)), fmaf(m0.y, a0.y, bfhi(x8.x))); o.y = cvtpk(fmaf(m0.z, a0.z, bflo(x8.y)), fmaf(m0.w, a0.w, bfhi(x8.y)));
                    o.z = cvtpk(fmaf(m1.x, a1.x, bflo(x8.z)), fmaf(m1.y, a1.y, bfhi(x8.z))); o.w = cvtpk(fmaf(m1.z, a1.z, bflo(x8.w)), fmaf(m1.w, a1.w, bfhi(x8.w)));
                    *(u32x4*)(xp + (size_t)(ai * 128 + m * 16) * D + bj * 128) = o; }
            __builtin_amdgcn_sched_barrier(0);
        }
    }
};
struct EpiMoe1 {
    static constexpr bool PERM = true, AFTER_DRAIN = false; static constexpr int NSEG = 1;
    unsigned char* HM;
    __device__ __forceinline__ void operator()(const pg8::f32x4 (&acc)[2][2][4][2], const pg8::Unit& u, int wr, int wc, int fr, int fq) const {
        asm volatile("" : "+v"(fr), "+v"(fq));
        const int row0 = u.pm * 256 + wr * 64 + fr, hcol0 = (u.pn & 3) * 128 + wc * 16 + 4 * fq;
#pragma unroll
        for (int ai = 0; ai < 2; ++ai)
#pragma unroll
            for (int m = 0; m < 4; ++m) { unsigned char* rowp = HM + (size_t)(row0 + ai * 128 + m * 16) * 512 + hcol0;
#pragma unroll
                for (int bj = 0; bj < 2; ++bj) { const pg8::f32x4 x = acc[ai][bj][m][0], y = acc[ai][bj][m][1] * 8.f;
                    *(unsigned*)(rowp + bj * 64) = cvt4_fp8(x.x * sigmoid_f(x.x) * y.x, x.y * sigmoid_f(x.y) * y.y, x.z * sigmoid_f(x.z) * y.z, x.w * sigmoid_f(x.w) * y.w); } }
    }
};
struct EpiMoe2 {
    static constexpr bool PERM = true, AFTER_DRAIN = false; static constexpr int NSEG = 1;
    bf16_t* Fo; const int* erow; const float* eroww; const LAS int* ebase; const LAS int* ecnt;
    __device__ __forceinline__ void operator()(const pg8::f32x4 (&acc)[2][2][4][2], const pg8::Unit& u, int wr, int wc, int fr, int fq) const {
        asm volatile("" : "+v"(fr), "+v"(fq));
        const int e = u.pn >> 2, cnt = __builtin_amdgcn_readfirstlane(ecnt[e]), pos0 = u.pm * 256 - __builtin_amdgcn_readfirstlane(ebase[e]) + wr * 64 + fr, col0 = (u.pn & 3) * 256 + wc * 32 + 8 * fq;
        const int* er = erow + (size_t)e * TT; const float* ew = eroww + (size_t)e * TT;
        int rma[2][4]; float wga[2][4];
#pragma unroll
        for (int ai = 0; ai < 2; ++ai)
#pragma unroll
            for (int m = 0; m < 4; ++m) { const int pos = pos0 + ai * 128 + m * 16; const bool ok = pos < cnt; rma[ai][m] = ok ? er[ok ? pos : 0] : -1; wga[ai][m] = ew[ok ? pos : 0]; }
        __builtin_amdgcn_sched_barrier(0);
#pragma unroll
        for (int ai = 0; ai < 2; ++ai) {
#pragma unroll
            for (int m = 0; m < 4; ++m) { const int r1 = rma[ai][m];
                if (r1 >= 0) { const float wgt = wga[ai][m]; bf16_t* rowp = Fo + ((size_t)(r1 & 1) * TT + (r1 >> 1)) * D + col0;
#pragma unroll
                    for (int bj = 0; bj < 2; ++bj) { const pg8::f32x4 v0 = acc[ai][bj][m][0], v1 = acc[ai][bj][m][1];
                        u32x4 w; w.x = cvtpk(v0.x * wgt, v0.y * wgt); w.y = cvtpk(v0.z * wgt, v0.w * wgt); w.z = cvtpk(v1.x * wgt, v1.y * wgt); w.w = cvtpk(v1.z * wgt, v1.w * wgt);
                        *(u32x4*)(rowp + bj * 128) = w; } } }
            __builtin_amdgcn_sched_barrier(0);
        }
    }
};
struct FusedOutOrder {
    int c, G, nun, wv; const unsigned* ready; unsigned* tmo;
    __device__ __forceinline__ bool next(int i, pg8::Unit& u) const {
        int q;
        if (!ready) { q = i * G + c; if (q >= nun) return false; }
        else if (G == 256 && nun == 576) { if (c < 64) { if (i > 0) return false; q = 512 + c; } else { q = i * 192 + (c - 64); if (q >= 512) return false; } }
        else { q = i * G + (G - 1 - c); if (q >= nun) return false; }
        u.pm = q >> 2; u.pn = q & 3; return true; }
    __device__ __forceinline__ void a_ready(const pg8::Unit& u) const {
        if (!ready) return;
        if (wv == 0) {
            const unsigned long long t0 = __builtin_amdgcn_s_memrealtime(); unsigned polls = 0;
            while ((unsigned)__builtin_amdgcn_readfirstlane(__hip_atomic_load(ready + 64 * u.pm, __ATOMIC_RELAXED, __HIP_MEMORY_SCOPE_AGENT)) < 32u) {
                if ((++polls & 255u) == 0u && __builtin_amdgcn_readfirstlane(__hip_atomic_load(tmo, __ATOMIC_RELAXED, __HIP_MEMORY_SCOPE_AGENT)) != 0u) break;
                if (__builtin_amdgcn_s_memrealtime() - t0 > 20000000ull) { if (lane_id() == 0) __hip_atomic_store(tmo, 1u, __ATOMIC_RELAXED, __HIP_MEMORY_SCOPE_AGENT); break; }
                __builtin_amdgcn_s_sleep(2); }
            __builtin_amdgcn_fence(__ATOMIC_ACQUIRE, "agent");
            asm volatile("s_waitcnt vmcnt(0)" ::: "memory");
        }
        asm volatile("" ::: "memory"); __builtin_amdgcn_s_barrier(); asm volatile("" ::: "memory");
    }
    __device__ __forceinline__ void done(const pg8::Unit&) const {}
};
struct LastInProjOrder {
    pg8::StaticOrder T; int nlat, G, c;
    __device__ __forceinline__ bool next(int i, pg8::Unit& u) const {
        const int L = i * G + c;
        if (L < nlat) return T.next(i, u);
        const int r = L - nlat; if (r >= 32) return false;
        u.pm = 128 + (r >> 1); u.pn = (r & 1) ? 11 : 2; return true; }
    __device__ __forceinline__ void a_ready(const pg8::Unit&) const {}
    __device__ __forceinline__ void done(const pg8::Unit&) const {}
};
struct MoeOrder {
    int nunits, G, c; const LAS int* tile_e;
    __device__ __forceinline__ bool next(int i, pg8::Unit& u) const {
        const int L0 = i * G + c; if (L0 >= nunits) return false;
        const int q = nunits / 8, r = nunits % 8, xcd = L0 % 8, off = L0 / 8; const int L = (xcd < r ? xcd * (q + 1) : r * (q + 1) + (xcd - r) * q) + off;
        const int pm = L >> 2; u.pm = pm; u.pn = __builtin_amdgcn_readfirstlane(tile_e[pm]) * 4 + (L & 3); return true; }
    __device__ __forceinline__ void a_ready(const pg8::Unit&) const {}
    __device__ __forceinline__ void done(const pg8::Unit&) const {}
};

__device__ __forceinline__ int moe_tables(const Fr& F, const Args& a, int l, LAS int* ebase  , LAS int* ecnt  , LAS int* tile_e  ) {
    const unsigned* CNT = (const unsigned*)(a.ws + WS_CTL) + CW_CNT + l * 256;
    __syncthreads();
    if (F.tid == 0) { int acc = 0;
#pragma unroll 1
        for (int e = 0; e < NE; ++e) { const int c = (int)__hip_atomic_load(&CNT[e * 16], __ATOMIC_RELAXED, __HIP_MEMORY_SCOPE_AGENT); ecnt[e] = c; ebase[e] = acc; const int nt = (c + 255) >> 8;
#pragma unroll 1
            for (int t = 0; t < nt; ++t) tile_e[(acc >> 8) + t] = e;
            acc += nt << 8; }
        ebase[NE] = acc; }
    __syncthreads();
    return ebase[NE] >> 8;
}

__device__ __forceinline__ void moe_gather_table(const Fr& F, const Args& a, const MoeOrder& S, const LAS int* ebase, const LAS int* ecnt, LAS int* gidx) {
    const int* EROW = (const int*)(a.ws + WS_EROW);
    for (int j = 0; j < 16; ++j) { pg8::Unit u; if (!S.next(j, u)) break;
        const int e = u.pn >> 2, pos0 = u.pm * 256 - ebase[e], cnt = ecnt[e];
        if (F.tid < 256) { const int pos = pos0 + F.tid; gidx[j * 256 + F.tid] = pos < cnt ? (EROW[(size_t)e * TT + pos] >> 1) : 0; } }
    __syncthreads();
}

#ifndef MK_PER_PHASE
#define MK_PER_PHASE 0
#endif
constexpr int PH_PER_LAYER = 10, PH_FINAL = 1 + NL * PH_PER_LAYER, N_PHASES = PH_FINAL + 1;

__global__ void __launch_bounds__(NTHR, 2) trunk_fwd(Args args) {
    extern __shared__ __attribute__((aligned(16))) unsigned char lds[];
    Fr F; F.lds = (LAS unsigned char*)lds; F.tid = threadIdx.x; F.lane = F.tid & 63; F.wave = __builtin_amdgcn_readfirstlane(F.tid >> 6); F.G = gridDim.x; F.bid = blockIdx.x;
    const int wave0 = F.wave;
    for (int u = F.tid; u < (LDS_BYTES - MISC_OFF) / 4; u += NTHR) ((LAS unsigned*)(F.lds + MISC_OFF))[u] = 0u;
    __syncthreads();
    const int lo = args.ph_lo, hi = args.ph_hi;
    unsigned* ctl = (unsigned*)(args.ws + WS_CTL);
    XcdBarrier bar; bar.bar = ctl + CW_BAR; bar.x = 0; bar.st = (volatile LAS unsigned*)(F.lds + MISC_OFF);
    if (hi - lo > 1) bar = xcd_barrier_post(ctl + CW_BAR, (volatile LAS unsigned*)(F.lds + MISC_OFF));
    bar.wv = (unsigned)wave0;
#ifndef DBG_ONLY
#define DBG_ONLY -1
#endif
#define SEL(p) (DBG_ONLY < 0 || DBG_ONLY == (p))
#define IN(k) (lo <= (k) && (k) < hi)
#define FRESH() do { int t_ = wave0 * 64 + lane_id(); asm volatile("" : "+v"(t_)); F.tid = t_; F.lane = t_ & 63; F.wave = wave0; } while (0)
#define SEAM(k) do { if (IN(k) && IN((k) + 1)) xcd_barrier(bar); } while (0)
#if !defined(PROBE_SUB)
#define PROBE_SUB -1
#endif
    unsigned long long pr_sub = 0ull;
#if defined(PROBE_P)
    unsigned long long pr_acc = 0ull, pr_t0 = __builtin_amdgcn_s_memrealtime();
#define PR_MARK(p) do { const unsigned long long t_ = __builtin_amdgcn_s_memrealtime(); if ((p) == PROBE_P) pr_acc += t_ - pr_t0; pr_t0 = t_; } while (0)
#else
#define PR_MARK(p) do { } while (0)
#endif
    unsigned char* ws = args.ws;
    LAS int* ebase = (LAS int*)(F.lds + MISC_OFF + 64); LAS int* ecnt = ebase + 20; LAS int* tile_e = (LAS int*)(F.lds + MISC_OFF + 512);

    #ifndef DBG_PRO
#define DBG_PRO 7
#endif
#if defined(PROBE_P)
    if (SEL(100) && IN(0)) { FRESH(); const unsigned long long tq0_ = __builtin_amdgcn_s_memrealtime(); pro_mod(F, args); __syncthreads(); const unsigned long long tq1_ = __builtin_amdgcn_s_memrealtime(); pro_rope(F, args); pro_filter(F, args); __syncthreads();
        const unsigned long long tq2_ = __builtin_amdgcn_s_memrealtime(); if (PROBE_SUB == 60) pr_sub += tq1_ - tq0_; if (PROBE_SUB == 61) pr_sub += tq2_ - tq1_; }
#else
    if (SEL(100) && IN(0)) { FRESH(); if (DBG_PRO & 1) pro_mod(F, args); __syncthreads(); if (DBG_PRO & 2) pro_rope(F, args); if (DBG_PRO & 4) pro_filter(F, args); __syncthreads(); }
#endif
    SEAM(0); PR_MARK(100);
    for (int l = 0; l < NL; ++l) {
        const int pb = 1 + PH_PER_LAYER * l;
#define LVARS() int lq_ = l; asm volatile("" : "+s"(lq_)); const bool uc = lq_ < NL - 1; const int M2 = uc ? TT : TL; (void)M2; (void)uc
        if (SEL(0) && IN(pb + 0)) { LVARS(); FRESH(); if (l == 0) filter_norm_reduce(F, args); conv_small_weights(F, args, l, 7, 0); rows_p0(F, args, l, TT); __syncthreads(); }
        SEAM(pb + 0); PR_MARK(0);
        if (SEL(1) && IN(pb + 1)) { LVARS();
            pg8::Gemm g{(const bf16_t*)(ws + WS_H8), (const bf16_t*)(ws + WS_WG8), TT, DIN, 512}; EpiInProj E{ws, 0};
            if (uc) { pg8::StaticOrder S; S.init(TT, DIN, F.G, F.bid); pg8::gemm_phase<EpiInProj, pg8::StaticOrder, true, true, false, true, -6>(F.lds, g, S, E, wave0); }
            else { LastInProjOrder S; S.T.init(TL, DIN, F.G, F.bid); S.nlat = (TL / 256) * (DIN / 256); S.G = F.G; S.c = F.bid; pg8::gemm_phase<EpiInProj, LastInProjOrder, true, true, false, true, -6>(F.lds, g, S, E, wave0); }
        }
        SEAM(pb + 1); PR_MARK(1);
        if (SEL(2) && IN(pb + 2)) { LVARS(); FRESH(); prep_phase(F, args, l, uc); }
        SEAM(pb + 2); PR_MARK(2);
        if (SEL(3) && IN(pb + 3)) { LVARS(); FRESH(); mixer_phase(F, args, l, uc, pr_sub, PROBE_SUB); }
        SEAM(pb + 3); PR_MARK(3);
        if (SEL(4) && IN(pb + 4)) { LVARS(); FRESH(); hyena_final_phase(F, args, l, uc); }
        SEAM(pb + 4); PR_MARK(4);
        if (SEL(5) && IN(pb + 5)) { LVARS();
            pg8::StaticOrder S; S.init(M2, 1024, F.G, F.bid);
            pg8::Gemm g{(const bf16_t*)(ws + WS_Y8), (const bf16_t*)(ws + WS_WBR), M2, 1024, 768}; EpiMerge E{ws + WS_H, (const unsigned char*)(ws + WS_G)};
            pg8::gemm_phase<EpiMerge, pg8::StaticOrder, true, true, false, true, -10>(F.lds, g, S, E, wave0);
            { FRESH(); __syncthreads(); const int nun = (M2 / 256) * 4, rem = nun % F.G; conv_expert_weights(F, args, l, rem, 0, CONV_E_ITEMS); __syncthreads(); }
        }
        SEAM(pb + 5); PR_MARK(5);
        if (SEL(6) && IN(pb + 6)) { LVARS();
            pg8::Gemm g{(const bf16_t*)(ws + WS_H), (const bf16_t*)(ws + WS_WOUT), M2, 1024, 512}; pg8::StaticOrder S; S.init(M2, 1024, F.G, F.bid);
            EpiOut E{(bf16_t*)(ws + WS_XB), (const float*)(ws + WS_MOD) + (size_t)l * NBM * DIN};
            pg8::gemm_phase<EpiOut, pg8::StaticOrder, true, true, false, true, -10>(F.lds, g, S, E, wave0);
        }
        SEAM(pb + 6); PR_MARK(6);
        if (SEL(7) && IN(pb + 7)) { LVARS(); FRESH(); rows_p5(F, args, l, M2, pr_sub, PROBE_SUB); __syncthreads(); }
        SEAM(pb + 7); PR_MARK(7);
        if (SEL(8) && IN(pb + 8)) { LVARS(); FRESH();
            const int ntile = moe_tables(F, args, l, ebase, ecnt, tile_e);
            pg8::Gemm g{(const bf16_t*)(ws + WS_H), (const bf16_t*)(ws + WS_W13), ntile * 256, NE * 1024, 512}; MoeOrder S{ntile * 4, F.G, F.bid, tile_e};
            LAS int* gidx = (LAS int*)(F.lds + 131072);
            moe_gather_table(F, args, S, ebase, ecnt, gidx);
            EpiMoe1 E{ws + WS_U};
            pg8::gemm_phase<EpiMoe1, MoeOrder, true, true, true, true, -6>(F.lds, g, S, E, wave0, gidx);
        }
        SEAM(pb + 8); PR_MARK(8);
        if (SEL(9) && IN(pb + 9)) { LVARS(); FRESH();
            const int ntile = moe_tables(F, args, l, ebase, ecnt, tile_e);
            pg8::Gemm g{(const bf16_t*)(ws + WS_U), (const bf16_t*)(ws + WS_W2), ntile * 256, NE * 1024, 256}; MoeOrder S{ntile * 4, F.G, F.bid, tile_e};
            EpiMoe2 E{(bf16_t*)(ws + WS_F), (const int*)(ws + WS_EROW), (const float*)(ws + WS_EROWW), ebase, ecnt};
            pg8::gemm_phase<EpiMoe2, MoeOrder, true, true, false, true, -9>(F.lds, g, S, E, wave0);
        }
        SEAM(pb + 9); PR_MARK(9);
    }
    if (SEL(101) && IN(PH_FINAL)) { FRESH(); rows_final(F, args); }
#if defined(PROBE_P)
    PR_MARK(101);
    pr_acc += pr_sub;
#if !defined(PROBE_BLK)
#define PROBE_BLK 0
#endif
    if (blockIdx.x == PROBE_BLK && F.wave == 0) { const unsigned long long t1 = __builtin_amdgcn_s_memrealtime() + 4ull * pr_acc; while (__builtin_amdgcn_s_memrealtime() < t1) __builtin_amdgcn_s_sleep(8); }
#endif
#undef IN
#undef SEAM
}

extern "C" void kernel_launch(void* const* d_in, const int* in_sizes, int n_in, void* d_out, int out_size, void* d_ws, size_t ws_size, hipStream_t stream) {
    static int grid = 0;
    if (grid == 0) {
        if (n_in != 29 || in_sizes[0] != TL * D || out_size != TL * D || ws_size < WS_END) { fprintf(stderr, "kernel_launch: unexpected shapes / workspace (n_in %d, ws %zu < %zu); nothing launched\n", n_in, ws_size, (size_t)WS_END); grid = -1; return; }
        int dev = 0, cus = 0, per_cu = 0;
        if (hipGetDevice(&dev) != hipSuccess || hipDeviceGetAttribute(&cus, hipDeviceAttributeMultiprocessorCount, dev) != hipSuccess) { grid = -1; return; }
        if (hipFuncSetAttribute((const void*)trunk_fwd, hipFuncAttributeMaxDynamicSharedMemorySize, LDS_BYTES) != hipSuccess) { fprintf(stderr, "kernel_launch: hipFuncSetAttribute failed\n"); grid = -1; return; }
        if (hipOccupancyMaxActiveBlocksPerMultiprocessor(&per_cu, (const void*)trunk_fwd, NTHR, LDS_BYTES) != hipSuccess || per_cu < 1) { fprintf(stderr, "kernel_launch: occupancy query reports %d\n", per_cu); }
        (void)hipGetLastError();
        grid = cus;
    }
    if (grid < 0) return;
    (void)hipMemsetAsync((char*)d_ws + WS_CTL, 0, CTL_ZERO_BYTES, stream);
    Args a{};
    for (int i = 0; i < 29; ++i) a.in[i] = (const float*)d_in[i];
    a.out = (float*)d_out; a.ws = (unsigned char*)d_ws;
#if MK_PER_PHASE
    for (int k = 0; k < N_PHASES; ++k) { a.ph_lo = k; a.ph_hi = k + 1; hipLaunchKernelGGL(trunk_fwd, dim3(grid), dim3(NTHR), LDS_BYTES, stream, a); }
#else
    a.ph_lo = 0; a.ph_hi = N_PHASES;
    hipLaunchKernelGGL(trunk_fwd, dim3(grid), dim3(NTHR), LDS_BYTES, stream, a);
#endif
}
```

```cpp
#include <hip/hip_runtime.h>
#include <cstdio>
#include <cstdint>

#define GAS __attribute__((address_space(1)))
#define LAS __attribute__((address_space(3)))
__device__ __forceinline__ int lane_id() { int l; asm volatile("v_mbcnt_lo_u32_b32 %0, -1, 0\n\tv_mbcnt_hi_u32_b32 %0, -1, %0" : "=v"(l)); return l; }
#define MK_PER_PHASE 0
namespace pg8 {
#define PG8_LAS __attribute__((address_space(3)))
typedef unsigned short bf16_t;
typedef short bf16x8 __attribute__((ext_vector_type(8)));
typedef float f32x4 __attribute__((ext_vector_type(4)));
typedef unsigned u32x4 __attribute__((ext_vector_type(4)));
constexpr int BM = 256, BK = 64, HALF = 128, HTB = HALF * BK * 2  , STAGE_BYTES = 8 * HTB, NXCD = 8, WGM = 8;

__host__ __device__ __forceinline__ int lds_byte(int r, int c) { const int st = (r >> 4) * 2 + (c >> 5), rr = r & 15, cc = c & 31, ob = rr * 64 + cc * 2; return st * 1024 + (ob ^ (((ob >> 9) & 1) << 5)); }
__host__ __device__ __forceinline__ void stage_rc(int b, int& R, int& C) { const int st = b / 1024, sb = b % 1024, swz = sb ^ (((sb >> 9) & 1) << 5); R = (st >> 1) * 16 + swz / 64; C = (st & 1) * 32 + (swz % 64) / 2; }
__host__ __device__ __forceinline__ int perm32(int rho) { const int n = rho >> 4, i = rho & 15; return 8 * (i >> 2) + 4 * n + (i & 3); }

struct Unit { int pm, pn; };
struct Gemm { const bf16_t* A; const bf16_t* Bt; int M, N, K; };

struct StaticOrder {
    int nM, nN, nwg, G, c;
    __host__ __device__ void init(int M, int N, int G_, int c_) { nM = M / BM; nN = N / BM; nwg = nM * nN; G = G_; c = c_; }
    __host__ __device__ bool next(int i, Unit& u) const {
        const long L = (long)i * G + c; if (L >= nwg) return false;
        int wgid = (int)L; { const int q = nwg / NXCD, r = nwg % NXCD, xcd = wgid % NXCD, off = wgid / NXCD; wgid = (xcd < r ? xcd * (q + 1) : r * (q + 1) + (xcd - r) * q) + off; }
        const int nig = WGM * nN, gid = wgid / nig, fm = gid * WGM, gsz = (nM - fm) < WGM ? (nM - fm) : WGM;
        u.pm = fm + ((wgid % nig) % gsz); u.pn = (wgid % nig) / gsz; return true;
    }
    __device__ __forceinline__ void a_ready(const Unit&) const {}
    __device__ __forceinline__ void done(const Unit&) const {}
};
__device__ __forceinline__ unsigned cvt_pk_bf16(float lo, float hi) { unsigned r; asm volatile("v_cvt_pk_bf16_f32 %0, %1, %2" : "=v"(r) : "v"(lo), "v"(hi)); return r; }
typedef float f32x2 __attribute__((ext_vector_type(2)));
template <class Epi, class Sched, bool ALIGN_EPI = false, bool SP2 = false, bool GATHER = false, bool F8 = false, int F8_SW = 0>
__device__ __forceinline__ void gemm_phase(PG8_LAS unsigned char* lds, const Gemm g, const Sched& S, const Epi& E, const int wave_id, const PG8_LAS int* gidx = nullptr) {
    static_assert(!GATHER || SP2, "GATHER is implemented for the SP2 loop only");
    int tid_ = wave_id * 64 + lane_id(); asm volatile("" : "+v"(tid_));
    const int tid = tid_, wid = __builtin_amdgcn_readfirstlane(tid >> 6), lane = tid & 63, wr = wid >> 2, wc = wid & 3, fr = lane & 15, fq = lane >> 4;
    const int K = g.K, nt = K / BK;
    unsigned voffA[2], voffB[2];
#pragma unroll
    for (int i = 0; i < 2; ++i) { int R, C; stage_rc(tid * 16 + i * 8192, R, C); const int Rb = Epi::PERM ? ((R & ~31) + perm32(R & 31)) : R;
        voffA[i] = (unsigned)(R * K + C) * 2u; voffB[i] = (unsigned)(Rb * K + C) * 2u; }
    unsigned goffA[2][2], goffN[2][2];
#define PG8_GOFF(dst, j) do { _Pragma("unroll") for (int _h = 0; _h < 2; ++_h) _Pragma("unroll") for (int _i = 0; _i < 2; ++_i) { int R_, C_; stage_rc(tid * 16 + _i * 8192, R_, C_); \
        dst[_h][_i] = ((unsigned)gidx[(j) * 256 + _h * 128 + R_] * (unsigned)K + (unsigned)C_) * 2u; } } while (0)
#define PG8_STAGE_A(bufoff, base, h, nx) do { if constexpr (GATHER) { unsigned o_[2] = {(nx) ? goffN[h][0] : goffA[h][0], (nx) ? goffN[h][1] : goffA[h][1]}; PG8_STAGE(bufoff, base, o_); } \
        else { PG8_STAGE(bufoff, (base) + ((h) ? hstep : 0), voffA); } } while (0)
    const size_t kstep = (size_t)(BK * 2);
    const size_t hstep = (size_t)HALF * K * 2;
    const size_t tstep = 2 * hstep;
    const unsigned ldsw = (unsigned)wid * 1024u;
    const int aoff = lds_byte(wr * 64 + fr, fq * 8), boff = lds_byte(wc * 32 + fr, fq * 8);
#define PG8_SA(b, h) (((b) * 2 + (h)) * HTB)
#define PG8_SB(b, h) ((4 + (b) * 2 + (h)) * HTB)
#define PG8_STAGE(bufoff, gbase, voff) do { _Pragma("unroll") for (int _i = 0; _i < 2; ++_i) \
        __builtin_amdgcn_global_load_lds((const unsigned*)((const char*)(gbase) + (voff)[_i]), (PG8_LAS unsigned*)(lds + (bufoff) + ldsw + _i * 8192), 16, 0, 0); } while (0)
#define PG8_LDA(dst, b, h) do { _Pragma("unroll") for (int m = 0; m < 4; ++m) _Pragma("unroll") for (int k = 0; k < 2; ++k) dst[m][k] = *(const PG8_LAS bf16x8*)(lds + PG8_SA(b, h) + aoff + m * 2048 + k * 1024); } while (0)
#define PG8_LDB(dst, b, h) do { _Pragma("unroll") for (int n = 0; n < 2; ++n) _Pragma("unroll") for (int k = 0; k < 2; ++k) dst[n][k] = *(const PG8_LAS bf16x8*)(lds + PG8_SB(b, h) + boff + n * 2048 + k * 1024); } while (0)
#define PG8_MMA(ai, bj, At, Bt) do { if constexpr (F8) __builtin_amdgcn_sched_barrier(0); __builtin_amdgcn_s_setprio(1); _Pragma("unroll") for (int m = 0; m < 4; ++m) _Pragma("unroll") for (int n = 0; n < 2; ++n) { \
        if constexpr (F8) { typedef int i32x4_ __attribute__((ext_vector_type(4))); typedef int i32x8_ __attribute__((ext_vector_type(8))); \
            const i32x8_ wf = __builtin_shufflevector(__builtin_bit_cast(i32x4_, Bt[n][0]), __builtin_bit_cast(i32x4_, Bt[n][1]), 0, 1, 2, 3, 4, 5, 6, 7); \
            const i32x8_ af = __builtin_shufflevector(__builtin_bit_cast(i32x4_, At[m][0]), __builtin_bit_cast(i32x4_, At[m][1]), 0, 1, 2, 3, 4, 5, 6, 7); \
              \
            asm volatile("v_mfma_scale_f32_16x16x128_f8f6f4 %0, %1, %2, %0, %3, %4 op_sel_hi:[0,0,0]" : "+v"(acc[ai][bj][m][n]) : "v"(wf), "v"(af), "v"(f8sw), "v"(f8sa)); } \
        else { _Pragma("unroll") for (int k = 0; k < 2; ++k) acc[ai][bj][m][n] = __builtin_amdgcn_mfma_f32_16x16x32_bf16(Bt[n][k], At[m][k], acc[ai][bj][m][n], 0, 0, 0); } } \
        __builtin_amdgcn_s_setprio(0); if constexpr (F8) __builtin_amdgcn_sched_barrier(0); } while (0)
#define PG8_WAIT_V(n) asm volatile("s_waitcnt vmcnt(" #n ")" ::: "memory")
#define PG8_WAIT_L(n) asm volatile("s_waitcnt lgkmcnt(" #n ")" ::: "memory")
#define PG8_BAR __builtin_amdgcn_s_barrier()
#define PG8_SCHED __builtin_amdgcn_sched_barrier(0)
    const int f8sw = 127 + F8_SW, f8sa = 127; (void)f8sw; (void)f8sa;
    Unit cur, nxt; int ui = 0;
    if (!S.next(0, cur)) return;
    f32x4 acc[2][2][4][2];
#pragma unroll
    for (int a = 0; a < 2; ++a)
#pragma unroll
        for (int b = 0; b < 2; ++b)
#pragma unroll
            for (int m = 0; m < 4; ++m)
#pragma unroll
                for (int n = 0; n < 2; ++n) acc[a][b][m][n] = (f32x4){0.f, 0.f, 0.f, 0.f};
    bf16x8 At[4][2], B0[2][2], B1[2][2];
    const char* cA = GATHER ? (const char*)g.A : (const char*)g.A + (size_t)cur.pm * tstep; const char* cB = (const char*)g.Bt + (size_t)cur.pn * tstep;
    if constexpr (GATHER) PG8_GOFF(goffA, 0);
    S.a_ready(cur);
    if constexpr (SP2) {
        PG8_STAGE(PG8_SB(0, 0), cB, voffB); PG8_STAGE(PG8_SB(0, 1), cB + hstep, voffB); PG8_STAGE_A(PG8_SA(0, 0), cA, 0, false); PG8_STAGE_A(PG8_SA(0, 1), cA, 1, false);
        if (wr == 1) PG8_BAR;
        PG8_WAIT_V(2); PG8_BAR;
        PG8_STAGE(PG8_SB(1, 0), cB + kstep, voffB); PG8_STAGE_A(PG8_SA(1, 0), cA + kstep, 0, false); PG8_STAGE(PG8_SB(1, 1), cB + hstep + kstep, voffB);
        PG8_WAIT_V(6); PG8_BAR;
    } else {
        PG8_STAGE(PG8_SB(0, 0), cB, voffB); PG8_STAGE(PG8_SA(0, 0), cA, voffA); PG8_STAGE(PG8_SB(0, 1), cB + hstep, voffB); PG8_STAGE(PG8_SA(0, 1), cA + hstep, voffA);
        if (wr == 1) PG8_BAR;
        PG8_WAIT_V(4); PG8_BAR;
        PG8_STAGE(PG8_SB(1, 0), cB + kstep, voffB); PG8_STAGE(PG8_SA(1, 0), cA + kstep, voffA); PG8_STAGE(PG8_SB(1, 1), cB + hstep + kstep, voffB);
        PG8_WAIT_V(6); PG8_BAR;
    }
    for (;;) {
        const bool has_next = S.next(ui + 1, nxt);
        if constexpr (GATHER) { if (has_next) PG8_GOFF(goffN, ui + 1); else { _Pragma("unroll") for (int _h = 0; _h < 2; ++_h) _Pragma("unroll") for (int _i = 0; _i < 2; ++_i) goffN[_h][_i] = goffA[_h][_i]; } }
        const char* nA = GATHER ? (const char*)g.A : has_next ? (const char*)g.A + (size_t)nxt.pm * tstep : cA; const char* nB = has_next ? (const char*)g.Bt + (size_t)nxt.pn * tstep : cB;
        for (int t = 0; t < nt; t += 2) {
            const bool last = (t == nt - 2);
            const char* a1 = cA + (size_t)(t + 1) * kstep;
            const char* a2 = last ? nA : cA + (size_t)(t + 2) * kstep; const char* b2 = last ? nB : cB + (size_t)(t + 2) * kstep;
            const char* a3 = a2 + kstep; const char* b3 = b2 + kstep;
            if (last && has_next) S.a_ready(nxt);
            if constexpr (SP2) {
            PG8_LDB(B0, 0, 0); PG8_LDB(B1, 0, 1); PG8_SCHED; PG8_LDA(At, 0, 0); PG8_STAGE_A(PG8_SA(1, 1), a1, 1, false);
            PG8_WAIT_V(8); PG8_WAIT_L(0); PG8_BAR; PG8_MMA(0, 0, At, B0); PG8_MMA(0, 1, At, B1); PG8_BAR; PG8_SCHED;
            PG8_LDA(At, 0, 1); PG8_STAGE(PG8_SB(0, 0), b2, voffB); PG8_STAGE(PG8_SB(0, 1), b2 + hstep, voffB); PG8_STAGE_A(PG8_SA(0, 0), a2, 0, last);
            PG8_WAIT_V(8); PG8_WAIT_L(0); PG8_BAR; PG8_MMA(1, 0, At, B0); PG8_MMA(1, 1, At, B1); PG8_BAR; PG8_SCHED;
            PG8_LDB(B0, 1, 0); PG8_LDB(B1, 1, 1); PG8_SCHED; PG8_LDA(At, 1, 0); PG8_STAGE_A(PG8_SA(0, 1), a2, 1, last);
            PG8_WAIT_V(8); PG8_WAIT_L(0); PG8_BAR; PG8_MMA(0, 0, At, B0); PG8_MMA(0, 1, At, B1); PG8_BAR; PG8_SCHED;
            PG8_LDA(At, 1, 1); PG8_STAGE(PG8_SB(1, 0), b3, voffB); PG8_STAGE(PG8_SB(1, 1), b3 + hstep, voffB); PG8_STAGE_A(PG8_SA(1, 0), a3, 0, last);
            PG8_WAIT_V(8); PG8_WAIT_L(0); PG8_BAR; PG8_MMA(1, 0, At, B0); PG8_MMA(1, 1, At, B1);
            if constexpr (Epi::NSEG > 1) { constexpr int SEGT = F8 ? 4 : 8;
                if (wr == 1 && t + 2 < nt && ((t + 2) & (SEGT - 1)) == 0) { if constexpr (F8) asm volatile("s_nop 15\n\ts_nop 15" ::: "memory"); E.rescale(acc, cur, (t + 2) / SEGT - 1, wr, wc, fr, fq); } }
            PG8_BAR; PG8_SCHED;
            if constexpr (Epi::NSEG > 1) { constexpr int SEGT = F8 ? 4 : 8;
                if (wr == 0 && t + 2 < nt && ((t + 2) & (SEGT - 1)) == 0) { if constexpr (F8) asm volatile("s_nop 15\n\ts_nop 15" ::: "memory"); E.rescale(acc, cur, (t + 2) / SEGT - 1, wr, wc, fr, fq); } }
            } else {
            PG8_LDB(B0, 0, 0); PG8_SCHED; PG8_LDA(At, 0, 0); PG8_STAGE(PG8_SA(1, 1), a1 + hstep, voffA);
            PG8_WAIT_L(8); PG8_BAR; PG8_WAIT_L(0); PG8_MMA(0, 0, At, B0); PG8_BAR; PG8_SCHED;
            PG8_LDB(B1, 0, 1); PG8_STAGE(PG8_SB(0, 0), b2, voffB);
            PG8_BAR; PG8_WAIT_L(0); PG8_MMA(0, 1, At, B1); PG8_BAR;
            PG8_LDA(At, 0, 1); PG8_STAGE(PG8_SA(0, 0), a2, voffA);
            PG8_BAR; PG8_WAIT_L(0); PG8_MMA(1, 0, At, B0); PG8_BAR; PG8_SCHED;
            PG8_STAGE(PG8_SB(0, 1), b2 + hstep, voffB);
            PG8_WAIT_V(6); PG8_BAR; PG8_MMA(1, 1, At, B1); PG8_BAR;
            PG8_LDB(B0, 1, 0); PG8_SCHED; PG8_LDA(At, 1, 0); PG8_STAGE(PG8_SA(0, 1), a2 + hstep, voffA);
            PG8_WAIT_L(8); PG8_BAR; PG8_WAIT_L(0); PG8_MMA(0, 0, At, B0); PG8_BAR; PG8_SCHED;
            PG8_LDB(B1, 1, 1); PG8_STAGE(PG8_SB(1, 0), b3, voffB);
            PG8_BAR; PG8_WAIT_L(0); PG8_MMA(0, 1, At, B1); PG8_BAR;
            PG8_LDA(At, 1, 1); PG8_STAGE(PG8_SA(1, 0), a3, voffA);
            PG8_BAR; PG8_WAIT_L(0); PG8_MMA(1, 0, At, B0); PG8_BAR; PG8_SCHED;
            PG8_STAGE(PG8_SB(1, 1), b3 + hstep, voffB);
            PG8_WAIT_V(6); PG8_BAR; PG8_MMA(1, 1, At, B1); PG8_BAR;
            }
        }
        if constexpr (ALIGN_EPI) { if (wr == 0) PG8_BAR; }
        if constexpr (F8) asm volatile("s_nop 15\n\ts_nop 15" ::: "memory");
        if constexpr (!Epi::AFTER_DRAIN) { E(acc, cur, wr, wc, fr, fq); S.done(cur); }
        if (!has_next) break;
#pragma unroll
        for (int a = 0; a < 2; ++a)
#pragma unroll
            for (int b = 0; b < 2; ++b)
#pragma unroll
                for (int m = 0; m < 4; ++m)
#pragma unroll
                    for (int n = 0; n < 2; ++n) acc[a][b][m][n] = (f32x4){0.f, 0.f, 0.f, 0.f};
        cur = nxt; cA = nA; cB = nB; ++ui;
        if constexpr (GATHER) { _Pragma("unroll") for (int _h = 0; _h < 2; ++_h) _Pragma("unroll") for (int _i = 0; _i < 2; ++_i) goffA[_h][_i] = goffN[_h][_i]; }
        if constexpr (ALIGN_EPI) { if (wr == 1) PG8_BAR; }
    }
    PG8_WAIT_V(0);
    if constexpr (!ALIGN_EPI) { if (wr == 0) PG8_BAR; }
    PG8_BAR;
    if constexpr (Epi::AFTER_DRAIN) { E.fused(acc, cur, wr, wc, fr, fq, lds, wid, lane); S.done(cur); }
#undef PG8_SA
#undef PG8_SB
#undef PG8_STAGE
#undef PG8_STAGE_A
#undef PG8_GOFF
#undef PG8_LDA
#undef PG8_LDB
#undef PG8_MMA
#undef PG8_WAIT_V
#undef PG8_WAIT_L
#undef PG8_BAR
#undef PG8_SCHED
}
}
#define XB_TMO      128
#define XB_XCNT(j)  (256  + 64 * (j))
#define XB_XSUB(j)  (1280 + 64 * (j))
#define XB_XGEN(j)  (2304 + 64 * (j))
#define XB_TOP      3328
#define XB_TOPGEN   3392
#define XCD_BAR_WORDS 3456
#define XB_SPIN_CAP (1u << 22)
#define LAS __attribute__((address_space(3)))

__device__ __forceinline__ unsigned xb_ld(unsigned* p)              { return __hip_atomic_load(p, __ATOMIC_RELAXED, __HIP_MEMORY_SCOPE_AGENT); }
__device__ __forceinline__ unsigned xb_add(unsigned* p, unsigned v) { asm volatile("" : "+v"(p));
    return __hip_atomic_fetch_add(p, v, __ATOMIC_RELAXED, __HIP_MEMORY_SCOPE_AGENT); }
__device__ __forceinline__ unsigned xb_xcc_id() { return (unsigned)__builtin_amdgcn_s_getreg((3 << 11) | 20) & 0xFu; }
#define XB_SPIN(cond, bar) do { unsigned _sp = 0; while (cond) { __builtin_amdgcn_s_sleep(1); \
    if ((++_sp & 255u) == 0u) { if (xb_ld(&(bar)[XB_TMO])) break; if (_sp > XB_SPIN_CAP) { xb_add(&(bar)[XB_TMO], 1u); break; } } } } while (0)

struct XcdBarrier {
    unsigned* bar; unsigned x; unsigned wv;
    volatile LAS unsigned* st;
};

__device__ __forceinline__ XcdBarrier xcd_barrier_post(unsigned* bar, volatile LAS unsigned* st) {
    XcdBarrier b; b.bar = bar; b.x = xb_xcc_id(); b.st = st;
    if (threadIdx.x == 0) (void)xb_add(&bar[XB_XCNT(b.x)], 1u);
    return b;
}
__device__ __forceinline__ void xcd_barrier_complete(unsigned* bar, unsigned x, unsigned& nloc, unsigned& nx) {
    const unsigned G = gridDim.x * gridDim.y * gridDim.z;
    unsigned sum, cnt, mine, sp = 0u;
    for (;;) {
        sum = 0u; cnt = 0u; mine = 0u;
#pragma unroll
        for (unsigned j = 0; j < 16; ++j) { const unsigned c = xb_ld(&bar[XB_XCNT(j)]); sum += c; cnt += (c > 0u) ? 1u : 0u; mine = (j == x) ? c : mine; }
        if (sum == G) break;
        __builtin_amdgcn_s_sleep(1);
        if ((++sp & 255u) == 0u) { if (xb_ld(&bar[XB_TMO])) break; if (sp > XB_SPIN_CAP) { xb_add(&bar[XB_TMO], 1u); break; } }
    }
    nloc = mine > 0u ? mine : 1u; nx = cnt > 0u ? cnt : 1u;
}

__device__ __forceinline__ void xcd_barrier(const XcdBarrier& b) {
    asm volatile("s_waitcnt vmcnt(0)" ::: "memory");
    __syncthreads();
    if (b.wv == 0u && lane_id() == 0) {
        unsigned* bar = b.bar;
        __builtin_amdgcn_s_waitcnt(0);
        unsigned nloc = b.st[0], nx = b.st[1];
        if (nloc == 0u) { xcd_barrier_complete(bar, b.x, nloc, nx); b.st[0] = nloc; b.st[1] = nx; }
        const unsigned old = xb_add(&bar[XB_XSUB(b.x)], 1u);
        const unsigned gen = old / nloc;
        if (old + 1u == (gen + 1u) * nloc) {
            __builtin_amdgcn_fence(__ATOMIC_RELEASE, "agent");
            asm volatile("s_waitcnt vmcnt(0)" ::: "memory");
            const unsigned og = xb_add(&bar[XB_TOP], 1u);
            const unsigned tg = og / nx;
            if (og + 1u == (tg + 1u) * nx) xb_add(&bar[XB_TOPGEN], 1u);
            else XB_SPIN(xb_ld(&bar[XB_TOPGEN]) == tg, bar);
            __builtin_amdgcn_fence(__ATOMIC_ACQUIRE, "agent");
            xb_add(&bar[XB_XGEN(b.x)], 1u);
            asm volatile("s_waitcnt vmcnt(0)" ::: "memory");
        } else {
            XB_SPIN(xb_ld(&bar[XB_XGEN(b.x)]) == gen, bar);
            __builtin_amdgcn_fence(__ATOMIC_ACQUIRE, "agent");
            asm volatile("s_waitcnt vmcnt(0)" ::: "memory");
        }
    }
    __syncthreads();
}

typedef unsigned short bf16_t;
typedef short bf16x8 __attribute__((ext_vector_type(8)));
typedef float f32x4 __attribute__((ext_vector_type(4)));
typedef float f32x16 __attribute__((ext_vector_type(16)));
typedef unsigned u32x4 __attribute__((ext_vector_type(4)));
typedef unsigned u32x2 __attribute__((ext_vector_type(2)));

constexpr int D = 1024, NB = 16, SEQ = 2048, CTX = 256, NL = 4;
constexpr int TL = NB * SEQ, TC = NB * CTX, TT = TL + TC;
constexpr int DIN = 6144, HYW = 512, NE = 16, DE = 512, KEYS = CTX + SEQ;
constexpr int NMOD = 6, NBM = NB + 1;
constexpr int APROWS = 2 * TT + NE * 256;
constexpr float EPS = 1e-6f, LOG2E = 1.4426950408889634f;
constexpr float QSCALE = 0.125f * LOG2E;

constexpr size_t MiB = 1u << 20;
constexpr size_t WS_CTL = 0, CTL_ZERO_BYTES = 1 * MiB;
constexpr size_t WS_MOD = 1 * MiB;
constexpr size_t WS_ROPE = 3 * MiB;
constexpr size_t WS_FL = 4 * MiB, WS_FC = 20 * MiB;
constexpr size_t WS_MISC = 22 * MiB;
constexpr size_t WS_FNORM = WS_MISC;
constexpr size_t WS_TOKE = WS_MISC + 64 * 1024, WS_TOKP = WS_MISC + 352 * 1024, WS_TOKW = WS_MISC + 640 * 1024;
constexpr size_t WS_ROWMAP = WS_MISC + 960 * 1024, WS_ROWW = WS_MISC + 1280 * 1024;
constexpr size_t WS_WIN = 24 * MiB, WS_WBR = 36 * MiB, WS_WOUT = 39 * MiB;
constexpr size_t WS_NP = 41 * MiB;
constexpr size_t WS_H = 57 * MiB;
constexpr size_t WS_KA = 129 * MiB, WS_VTA = 138 * MiB, WS_KW = 147 * MiB, WS_VTW = 156 * MiB;
constexpr size_t WS_QA = 165 * MiB, WS_QW = 201 * MiB, WS_YH = 237 * MiB, WS_VT = 273 * MiB, WS_YT = 309 * MiB;
constexpr size_t WS_RAWA = 309 * MiB, WS_RAWW = 327 * MiB;
constexpr size_t WS_F = 165 * MiB;
constexpr size_t WS_U = 345 * MiB;
constexpr size_t WS_G = 453 * MiB;
constexpr size_t WS_Y8 = 561 * MiB;
constexpr size_t WS_W13 = 615 * MiB, WS_W2 = 631 * MiB;
constexpr size_t WS_EROW = 30 * MiB, WS_EROWW = 33 * MiB;
constexpr size_t WS_H8 = 93 * MiB;
constexpr size_t WS_WG8 = WS_WIN;
constexpr size_t WS_XB = 639 * MiB;
constexpr size_t WS_END = 711 * MiB;
static_assert(WS_G + (size_t)TT * 3072 <= WS_Y8 && WS_Y8 + (size_t)TT * 1536 <= WS_W13 && WS_W13 + (size_t)16 * 1024 * 1024 <= WS_W2 && WS_W2 + (size_t)16 * 1024 * 512 <= WS_XB && WS_XB + (size_t)TT * 2048 <= WS_END && WS_H8 + (size_t)TT * 1024 <= WS_KA && WS_EROWW + (size_t)16 * TT * 4 <= WS_WBR, "ws map");
static_assert(WS_U + (size_t)APROWS * 1024 <= WS_G && WS_F + (size_t)2 * TT * 2048 <= WS_YT, "ws map 2");
constexpr size_t VT_CTX_OFF = (size_t)HYW * NB * SEQ;

constexpr int CW_BAR = 4096, CW_CNT = 8192, CW_PANEL = 16384, CW_HTMO = 12288;
constexpr int LDS_BYTES = 151552, MISC_OFF = 147456;
constexpr int NWAVES = 8, NTHR = 512;

struct Args { const float* in[29]; float* out; unsigned char* ws; int ph_lo, ph_hi; };
enum { I_X = 0, I_C, I_CTX, I_CCTX, I_ADAW, I_ADAB, I_N1G, I_N2G, I_WIN, I_QKG, I_HSW, I_HSB, I_HW1, I_HB1, I_HFR, I_HW2, I_HB2, I_HW3, I_HBIAS, I_SINK, I_WBR, I_WOUT,
       I_RGW, I_RGB, I_REW, I_REB, I_EW1, I_EW3, I_EW2 };

#define LDS_WAIT() asm volatile("s_waitcnt lgkmcnt(0)" ::: "memory")
#define VM_WAIT() asm volatile("s_waitcnt vmcnt(0)" ::: "memory")

typedef float f32x2_t __attribute__((ext_vector_type(2)));
typedef __bf16 bf16x2_t __attribute__((ext_vector_type(2)));
__device__ __forceinline__ unsigned cvtpk(float lo, float hi) { f32x2_t v = {lo, hi}; bf16x2_t b = __builtin_convertvector(v, bf16x2_t); return __builtin_bit_cast(unsigned, b); }
__device__ __forceinline__ unsigned zero_u32() { unsigned z; asm volatile("v_mov_b32 %0, 0" : "=v"(z)); return z; }
__device__ __forceinline__ float clamp_fp8(float x) { return __builtin_amdgcn_fmed3f(x, -448.f, 448.f); }
__device__ __forceinline__ unsigned cvt4_fp8(float a, float b, float c, float d) { int r = __builtin_amdgcn_cvt_pk_fp8_f32(a, b, 0, false); r = __builtin_amdgcn_cvt_pk_fp8_f32(c, d, r, true); return (unsigned)r; }
__device__ __forceinline__ unsigned cvt4_fp8c(float a, float b, float c, float d) { return cvt4_fp8(clamp_fp8(a), clamp_fp8(b), clamp_fp8(c), clamp_fp8(d)); }
__device__ __forceinline__ f32x4 unpack4_fp8(unsigned w) { const f32x2_t lo = __builtin_amdgcn_cvt_pk_f32_fp8((int)w, false), hi = __builtin_amdgcn_cvt_pk_f32_fp8((int)w, true); return (f32x4){lo.x, lo.y, hi.x, hi.y}; }
__device__ __forceinline__ float bflo(unsigned u) { return __builtin_bit_cast(float, u << 16); }
__device__ __forceinline__ float bfhi(unsigned u) { return __builtin_bit_cast(float, u & 0xffff0000u); }
__device__ __forceinline__ float bf1(bf16_t u) { return __builtin_bit_cast(float, (unsigned)u << 16); }
__device__ __forceinline__ bf16_t f2bf(float f) { return (bf16_t)(cvtpk(f, 0.f) & 0xffffu); }
#define DPP_F(v, ctrl) __builtin_bit_cast(float, __builtin_amdgcn_update_dpp(0, __builtin_bit_cast(int, (v)), (ctrl), 0xf, 0xf, false))
__device__ __forceinline__ float row16_sum(float v) {
    v += DPP_F(v, 0xB1);
    v += DPP_F(v, 0x4E);
    v += DPP_F(v, 0x141);
    v += DPP_F(v, 0x140);
    return v;
}
__device__ __forceinline__ float wave_sum(float v) {
    v = row16_sum(v);
    const int iv = __builtin_bit_cast(int, v);
    float r = (__builtin_bit_cast(float, __builtin_amdgcn_readlane(iv, 0)) + __builtin_bit_cast(float, __builtin_amdgcn_readlane(iv, 16)))
            + (__builtin_bit_cast(float, __builtin_amdgcn_readlane(iv, 32)) + __builtin_bit_cast(float, __builtin_amdgcn_readlane(iv, 48)));
    asm volatile("" : "+v"(r));
    return r;
}
__device__ __forceinline__ float fast_exp2(float x) { return __builtin_amdgcn_exp2f(x); }
__device__ __forceinline__ float fast_rcp(float x) { return __builtin_amdgcn_rcpf(x); }
__device__ __forceinline__ float sigmoid_f(float x) { return fast_rcp(1.f + fast_exp2(-x * LOG2E)); }

__device__ __forceinline__ void sincos_acc(float x, float& s, float& c) {
    const float q = rintf(x * 0.636619772367581f);
    float y = fmaf(-q, 1.57079625129699707031f, x);
    y = fmaf(-q, 7.54978941586159635335e-08f, y);
    const float y2 = y * y;
    float sp = fmaf(y2, 2.7557314297e-06f, -1.9841270114e-04f); sp = fmaf(sp, y2, 8.3333337680e-03f); sp = fmaf(sp, y2, -1.6666667163e-01f); sp = fmaf(sp * y2, y, y);
    float cp = fmaf(y2, -2.7557314297e-07f, 2.4801587642e-05f); cp = fmaf(cp, y2, -1.3888889225e-03f); cp = fmaf(cp, y2, 4.1666667908e-02f); cp = fmaf(cp, y2, -0.5f); cp = fmaf(cp, y2, 1.0f);
    const int n = (int)q & 3;
    const float s1 = (n & 1) ? cp : sp, c1 = (n & 1) ? sp : cp;
    s = (n & 2) ? -s1 : s1;
    c = ((n + 1) & 2) ? -c1 : c1;
}

struct Fr { LAS unsigned char* lds; int tid, lane, wave, G, bid; };

__device__ __forceinline__ void pro_mod(const Fr& F, const Args& a) {
    LAS float* s = (LAS float*)F.lds;
    LAS float* red = (LAS float*)(F.lds + 69632);
    const float* c = a.in[I_C]; const float* cc = a.in[I_CCTX]; const float* W = a.in[I_ADAW]; const float* Bv = a.in[I_ADAB];
    float* MOD = (float*)(a.ws + WS_MOD);
    { f32x4 cv[9];
#pragma unroll
      for (int q = 0; q < 9; ++q) { const int i = F.tid + NTHR * q; const int bb = i >> 8, k4 = (i & 255) * 4; if (i < NBM * 256) cv[q] = *(const f32x4*)((bb < NB) ? c + bb * 1024 + k4 : cc + k4); }
#pragma unroll
      for (int q = 0; q < 9; ++q) { const int i = F.tid + NTHR * q; if (i < NBM * 256) { f32x4 o; o.x = cv[q].x / (1.f + __expf(-cv[q].x)); o.y = cv[q].y / (1.f + __expf(-cv[q].y)); o.z = cv[q].z / (1.f + __expf(-cv[q].z)); o.w = cv[q].w / (1.f + __expf(-cv[q].w));
          *(LAS f32x4*)(s + 4 * i) = o; } } }
    __syncthreads();
    const int col = F.tid & 63, ks = F.wave;
    for (int unit = F.G - 1 - F.bid; unit < NL * 96; unit += F.G) {
        const int l = unit / 96, j0 = (unit % 96) * 64;
        float acc[NBM];
#pragma unroll
        for (int bb = 0; bb < NBM; ++bb) acc[bb] = 0.f;
        const float* Wp = W + ((size_t)l * 1024 + ks * 128) * DIN + j0 + col;
#pragma unroll 4
        for (int k = 0; k < 128; k += 4) {
            const float w0 = __builtin_nontemporal_load(Wp + (size_t)k * DIN), w1 = __builtin_nontemporal_load(Wp + (size_t)(k + 1) * DIN), w2 = __builtin_nontemporal_load(Wp + (size_t)(k + 2) * DIN), w3 = __builtin_nontemporal_load(Wp + (size_t)(k + 3) * DIN);
#pragma unroll
            for (int bb = 0; bb < NBM; ++bb) { const f32x4 sv = *(const LAS f32x4*)(s + bb * 1024 + ks * 128 + k);
                acc[bb] = fmaf(sv.x, w0, acc[bb]); acc[bb] = fmaf(sv.y, w1, acc[bb]); acc[bb] = fmaf(sv.z, w2, acc[bb]); acc[bb] = fmaf(sv.w, w3, acc[bb]); } }
#pragma unroll
        for (int bb = 0; bb < NBM; ++bb) red[(ks * NBM + bb) * 64 + col] = acc[bb];
        __syncthreads();
        for (int o = F.tid; o < NBM * 64; o += NTHR) { const int bb = o >> 6, cx = o & 63; float sum = 0.f;
#pragma unroll
            for (int k2 = 0; k2 < 8; ++k2) sum += red[(k2 * NBM + bb) * 64 + cx];
            MOD[((size_t)l * NBM + bb) * DIN + j0 + cx] = sum + Bv[l * DIN + j0 + cx]; }
        __syncthreads();
    }
}

__device__ __forceinline__ void pro_rope(const Fr& F, const Args& a) {
    float* ct = (float*)(a.ws + WS_ROPE); float* st = ct + SEQ * 32;
    for (int i = F.bid * NTHR + F.tid; i < SEQ * 32; i += F.G * NTHR) {
        const int pos = i >> 5, ax = (i >> 4) & 1, f = i & 15;
        const float inv = exp2f(-(float)f * (13.287712379549449f / 16.f));
        const float ang = (float)(ax == 0 ? (pos >> 6) : (pos & 63)) * inv;
        float sv, cv; sincos_acc(ang, sv, cv); ct[i] = cv; st[i] = sv;
    }
}

__device__ __forceinline__ void pro_filter(const Fr& F, const Args& a) {
    LAS float* L = (LAS float*)F.lds;
    constexpr int oW1 = 0, oB1 = 2112, oFR = 2176, oB2 = 2240, oW2 = 2304, oZ = 6400, oH1 = 7552, oH2 = 9600, H2P = 68, oT = 11776, TP = 36;
    bf16_t* FL = (bf16_t*)(a.ws + WS_FL); bf16_t* FC = (bf16_t*)(a.ws + WS_FC); float* NP = (float*)(a.ws + WS_NP);
    const int p = F.tid >> 4, jj = F.tid & 15;
    for (int unit = F.bid; unit < NL * 72; unit += F.G) {
        const int l = unit / 72, ch = unit % 72; const bool lat = ch < 64; const int n = lat ? SEQ : CTX, pos0 = lat ? ch * 32 : (ch - 64) * 32;
        __syncthreads();
        { f32x4 w1v[2], w2v[2]; float sv[3];
          w1v[0] = *(const f32x4*)(a.in[I_HW1] + l * 2112 + 4 * F.tid); if (F.tid < 16) w1v[1] = *(const f32x4*)(a.in[I_HW1] + l * 2112 + 2048 + 4 * F.tid);
          w2v[0] = *(const f32x4*)(a.in[I_HW2] + l * 4096 + 4 * F.tid); w2v[1] = *(const f32x4*)(a.in[I_HW2] + l * 4096 + 2048 + 4 * F.tid);
          if (F.tid < 64) { sv[0] = a.in[I_HB1][l * 64 + F.tid]; sv[1] = a.in[I_HFR][l * 64 + F.tid]; sv[2] = a.in[I_HB2][l * 64 + F.tid]; }
          *(LAS f32x4*)(L + oW1 + 4 * F.tid) = w1v[0]; if (F.tid < 16) *(LAS f32x4*)(L + oW1 + 2048 + 4 * F.tid) = w1v[1];
          *(LAS f32x4*)(L + oW2 + 4 * F.tid) = w2v[0]; *(LAS f32x4*)(L + oW2 + 2048 + 4 * F.tid) = w2v[1];
          if (F.tid < 64) { L[oB1 + F.tid] = sv[0]; L[oFR + F.tid] = sv[1]; L[oB2 + F.tid] = sv[2]; } }
        const int pos = pos0 + p; const float t = (float)pos / (float)(n - 1);
        { const float band = 1e-4f + (float)jj * ((15.f - 1e-4f) / 15.f); const float ang = ((6.2831855f * band) * (float)pos) / (float)n;
          float sv, cv; sincos_acc(ang, sv, cv); L[oZ + p * 36 + 1 + jj] = cv; L[oZ + p * 36 + 17 + jj] = -sv; if (jj == 0) L[oZ + p * 36] = t; }
        __syncthreads();
        { f32x4 acc = *(const LAS f32x4*)(L + oB1 + 4 * jj);
#pragma unroll 3
          for (int i = 0; i < 33; ++i) { const float z = L[oZ + p * 36 + i]; const f32x4 w = *(const LAS f32x4*)(L + oW1 + i * 64 + 4 * jj); acc.x = fmaf(z, w.x, acc.x); acc.y = fmaf(z, w.y, acc.y); acc.z = fmaf(z, w.z, acc.z); acc.w = fmaf(z, w.w, acc.w); }
          const f32x4 fr = *(const LAS f32x4*)(L + oFR + 4 * jj); float sv, cv; f32x4 o;
          sincos_acc(fr.x * acc.x, sv, cv); o.x = sv; sincos_acc(fr.y * acc.y, sv, cv); o.y = sv; sincos_acc(fr.z * acc.z, sv, cv); o.z = sv; sincos_acc(fr.w * acc.w, sv, cv); o.w = sv;
          *(LAS f32x4*)(L + oH1 + p * 64 + 4 * jj) = o; }
        __syncthreads();
        { f32x4 acc = *(const LAS f32x4*)(L + oB2 + 4 * jj);
#pragma unroll 4
          for (int i = 0; i < 64; ++i) { const float z = L[oH1 + p * 64 + i]; const f32x4 w = *(const LAS f32x4*)(L + oW2 + i * 64 + 4 * jj); acc.x = fmaf(z, w.x, acc.x); acc.y = fmaf(z, w.y, acc.y); acc.z = fmaf(z, w.z, acc.z); acc.w = fmaf(z, w.w, acc.w); }
          const f32x4 fr = *(const LAS f32x4*)(L + oFR + 4 * jj); float sv, cv; f32x4 o;
          sincos_acc(fr.x * acc.x, sv, cv); o.x = sv; sincos_acc(fr.y * acc.y, sv, cv); o.y = sv; sincos_acc(fr.z * acc.z, sv, cv); o.z = sv; sincos_acc(fr.w * acc.w, sv, cv); o.w = sv;
          *(LAS f32x4*)(L + oH2 + p * H2P + 4 * jj) = o; }
        LAS bf16_t* T = (LAS bf16_t*)(L + oT);
        __syncthreads();
        {
            const int j16 = F.lane & 15, kq = F.lane >> 4;
            const float* W3p = a.in[I_HW3] + ((size_t)l * 64 + 4 * kq) * 1024 + 128 * F.wave + 4 * j16;
            f32x4 acc[2][4][2];
#pragma unroll
            for (int h = 0; h < 2; ++h)
#pragma unroll
                for (int cb = 0; cb < 4; ++cb)
#pragma unroll
                    for (int rb = 0; rb < 2; ++rb) acc[h][cb][rb] = (f32x4){0.f, 0.f, 0.f, 0.f};
            f32x4 bw[2][4][2];
#define PF_LDW(buf, s) do { _Pragma("unroll") for (int j = 0; j < 4; ++j) _Pragma("unroll") for (int h = 0; h < 2; ++h) bw[buf][j][h] = *(const f32x4*)(W3p + (size_t)(16 * (s) + j) * 1024 + 64 * h); } while (0)
            PF_LDW(0, 0);
#pragma unroll
            for (int s = 0; s < 4; ++s) {
                if (s + 1 < 4) PF_LDW((s + 1) & 1, s + 1);
                f32x4 av[2];
#pragma unroll
                for (int rb = 0; rb < 2; ++rb) av[rb] = *(const LAS f32x4*)(L + oH2 + (rb * 16 + j16) * H2P + 16 * s + 4 * kq);
#pragma unroll
                for (int j = 0; j < 4; ++j)
#pragma unroll
                    for (int h = 0; h < 2; ++h)
#pragma unroll
                        for (int cb = 0; cb < 4; ++cb)
#pragma unroll
                            for (int rb = 0; rb < 2; ++rb) acc[h][cb][rb] = __builtin_amdgcn_mfma_f32_16x16x4f32(av[rb][j], bw[s & 1][j][h][cb], acc[h][cb][rb], 0, 0, 0);
            }
#undef PF_LDW
            const int dir = F.wave >> 2;
            float tt[2][4];
#pragma unroll
            for (int rb = 0; rb < 2; ++rb)
#pragma unroll
                for (int r = 0; r < 4; ++r) tt[rb][r] = (float)(pos0 + rb * 16 + 4 * kq + r) / (float)(n - 1);
#pragma unroll
            for (int h = 0; h < 2; ++h)
#pragma unroll
                for (int cb = 0; cb < 4; ++cb) { const int col = 128 * F.wave + 64 * h + 4 * j16 + cb, c = col & 511;
                    const float dl = fabsf(-3.0701134573253943f + (-15.350567286626972f + 3.0701134573253943f) * ((float)c / 511.f));
#pragma unroll
                    for (int rb = 0; rb < 2; ++rb) { const int p0 = rb * 16 + 4 * kq; float v[4];
#pragma unroll
                        for (int r = 0; r < 4; ++r) { v[r] = acc[h][cb][rb][r] * __expf(-tt[rb][r] * dl); if (dir == 1 && pos0 + p0 + r == 0) v[r] = 0.f; }
                        u32x2 w;
                        if (dir == 0) { w.x = cvtpk(v[3], v[2]); w.y = cvtpk(v[1], v[0]); *(LAS u32x2*)(T + col * TP + 28 - p0) = w; }
                        else { w.x = cvtpk(v[0], v[1]); w.y = cvtpk(v[2], v[3]); *(LAS u32x2*)(T + col * TP + p0) = w; } } }
        }
        __syncthreads();
        for (int idx = F.tid; idx < 1024 * 32; idx += NTHR) { const int col = idx >> 5, i = idx & 31, dir = col >> 9, c = col & 511;
            const int u = (dir == 0) ? (n - 32 - pos0 + i) : ((pos0 + i == 0) ? 2 * n - 1 : n - 1 + pos0 + i);
            bf16_t* Fb = lat ? FL + ((size_t)l * 512 + c) * 4096 : FC + ((size_t)l * 512 + c) * 512;
            Fb[u] = T[col * TP + i]; }
        for (int col = F.tid; col < 1024; col += NTHR) { float sum = 0.f;
#pragma unroll 8
            for (int i = 0; i < 32; ++i) sum += fabsf(bf1(T[col * TP + i]));
            NP[((size_t)l * 72 + ch) * 1024 + col] = sum; }
    }
    __syncthreads();
}
__device__ __forceinline__ void filter_norm_reduce(const Fr& F, const Args& a) {
    const float* NP = (const float*)(a.ws + WS_NP); float* FN = (float*)(a.ws + WS_FNORM);
    for (int o = F.bid * NWAVES + F.wave; o < NL * 2 * 512; o += F.G * NWAVES) { const int l = o >> 10, isc = (o >> 9) & 1, c = o & 511;
        float v = 0.f;
        if (!isc) v = NP[((size_t)l * 72 + F.lane) * 1024 + c] + NP[((size_t)l * 72 + F.lane) * 1024 + 512 + c];
        else if (F.lane < 8) v = NP[((size_t)l * 72 + 64 + F.lane) * 1024 + c] + NP[((size_t)l * 72 + 64 + F.lane) * 1024 + 512 + c];
        const float sum = wave_sum(v);
        if (F.lane == 0) FN[o] = 1.f / sum; }
}

template <int MODE>
__device__ __forceinline__ void transpose_item(const float* W, int K, int N, bf16_t* WT, int row_off, LAS float* scr, int item, int lane, int ldk = 0) {
    if (ldk == 0) ldk = K;
    const int nblk = N / 64, kb = item / nblk, nb = item % nblk, k0 = 64 * kb, n0 = 64 * nb;
    f32x4 v[16];
#pragma unroll
    for (int i = 0; i < 16; ++i) v[i] = *(const f32x4*)(W + (size_t)(k0 + 4 * i + (lane >> 4)) * N + n0 + (lane & 15) * 4);
#pragma unroll
    for (int i = 0; i < 16; ++i) *(LAS f32x4*)(scr + (4 * i + (lane >> 4)) * 68 + (lane & 15) * 4) = v[i];
    LDS_WAIT();
    const int c = lane & 7;
#pragma unroll
    for (int j = 0; j < 8; ++j) { const int n = (lane >> 3) + 8 * j; const LAS float* s = scr + (8 * c) * 68 + n;
        u32x4 o; o.x = cvtpk(s[0 * 68], s[1 * 68]); o.y = cvtpk(s[2 * 68], s[3 * 68]); o.z = cvtpk(s[4 * 68], s[5 * 68]); o.w = cvtpk(s[6 * 68], s[7 * 68]);
        const int nn = n0 + n; const int row = (MODE == 0) ? nn : ((nn >> 2) * 8 + (nn & 3) + (MODE == 2 ? 4 : 0));
        *(u32x4*)(WT + (size_t)(row_off + row) * ldk + k0 + 8 * c) = o; }
    LDS_WAIT();
}

template <int MODE>
__device__ __forceinline__ void transpose_item_f8(const float* W, int K, int N, unsigned char* WT, int row_off, LAS float* scr, int item, int lane, int ldk = 0) {
    if (ldk == 0) ldk = K;
    const int nblk = N / 64, kb = item / nblk, nb = item % nblk, k0 = 64 * kb, n0 = 64 * nb;
    f32x4 v[16];
#pragma unroll
    for (int i = 0; i < 16; ++i) v[i] = __builtin_nontemporal_load((const f32x4*)(W + (size_t)(k0 + 4 * i + (lane >> 4)) * N + n0 + (lane & 15) * 4));
#pragma unroll
    for (int i = 0; i < 16; ++i) *(LAS f32x4*)(scr + (4 * i + (lane >> 4)) * 68 + (lane & 15) * 4) = v[i];
    LDS_WAIT();
    const int c = lane & 7;
#pragma unroll
    for (int j = 0; j < 8; ++j) { const int n = (lane >> 3) + 8 * j; const LAS float* s = scr + (8 * c) * 68 + n;
        u32x2 o; o.x = cvt4_fp8(s[0 * 68] * 64.f, s[1 * 68] * 64.f, s[2 * 68] * 64.f, s[3 * 68] * 64.f); o.y = cvt4_fp8(s[4 * 68] * 64.f, s[5 * 68] * 64.f, s[6 * 68] * 64.f, s[7 * 68] * 64.f);
        const int nn = n0 + n; const int row = (MODE == 0) ? nn : ((nn >> 2) * 8 + (nn & 3) + (MODE == 2 ? 4 : 0));
        __builtin_nontemporal_store(o, (u32x2*)(WT + (size_t)(row_off + row) * ldk + k0 + 8 * c)); }
    LDS_WAIT();
}
__device__ __forceinline__ void conv_small_weights(const Fr& F, const Args& a, int l, int mask, int b0) {
    if (F.bid < b0) return;
    LAS float* scr = (LAS float*)(F.lds + F.wave * 17408);
    const int gw = (F.bid - b0) * NWAVES + F.wave, NGW = (F.G - b0) * NWAVES;
    constexpr int I_IN = (1024 / 64) * (DIN / 64), I_BR = (512 / 64) * (1024 / 64), I_OUT = (1024 / 64) * (1024 / 64);
    if (mask & 1) for (int it = gw; it < I_IN; it += NGW) transpose_item_f8<0>(a.in[I_WIN] + (size_t)l * 1024 * DIN, 1024, DIN, a.ws + WS_WG8, 0, scr, it, F.lane);
    if (mask & 2) for (int it = gw; it < 3 * I_BR; it += NGW) { const int b = it / I_BR; transpose_item_f8<0>(a.in[I_WBR] + ((size_t)l * 3 + b) * 512 * 1024, 512, 1024, a.ws + WS_WBR + b * 512, 0, scr, it % I_BR, F.lane, 1536); }
    if (mask & 4) for (int it = gw; it < I_OUT; it += NGW) transpose_item_f8<0>(a.in[I_WOUT] + (size_t)l * 1024 * 1024, 1024, 1024, a.ws + WS_WOUT, 0, scr, it, F.lane);
}
__device__ __forceinline__ void conv_expert_weights(const Fr& F, const Args& a, int l, int b0, int it0, int it1) {
    if (F.bid < b0) return;
    LAS float* scr = (LAS float*)(F.lds + F.wave * 17408);
    const int gw = (F.bid - b0) * NWAVES + F.wave, NGW = (F.G - b0) * NWAVES;
    constexpr int I_1 = (1024 / 64) * (512 / 64), I_2 = (512 / 64) * (1024 / 64);
    for (int it = it0 + gw; it < it1; it += NGW) {
        const int e = it / (2 * I_1 + I_2); int r = it % (2 * I_1 + I_2);
        unsigned char* W13 = a.ws + WS_W13; unsigned char* W2 = a.ws + WS_W2;
        if (r < I_1) { transpose_item_f8<1>(a.in[I_EW1] + ((size_t)l * NE + e) * 1024 * 512, 1024, 512, W13, e * 1024, scr, r, F.lane); continue; } r -= I_1;
        if (r < I_1) { transpose_item_f8<2>(a.in[I_EW3] + ((size_t)l * NE + e) * 1024 * 512, 1024, 512, W13, e * 1024, scr, r, F.lane); continue; } r -= I_1;
        transpose_item_f8<0>(a.in[I_EW2] + ((size_t)l * NE + e) * 512 * 1024, 512, 1024, W2, e * 1024, scr, r, F.lane);
    }
}
constexpr int CONV_E_ITEMS = NE * 384, CONV_E_SPLIT = CONV_E_ITEMS / 2;

__device__ __forceinline__ int mod_row(int row) { return row < TL ? (row >> 11) : NB; }

__device__ __forceinline__ void rows_p0(const Fr& F, const Args& a, int l, int nrows) {
    const int gw = F.bid * NWAVES + F.wave, NGW = F.G * NWAVES;
    const float* g1 = a.in[I_N1G] + l * 1024;
    const float* MODl = (const float*)(a.ws + WS_MOD) + (size_t)l * NBM * DIN;
    const float* MODp = (const float*)(a.ws + WS_MOD) + (size_t)(l > 0 ? l - 1 : 0) * NBM * DIN;
    const unsigned char* Fs = a.ws + WS_F;
    unsigned char* H8 = a.ws + WS_H8; bf16_t* XB = (bf16_t*)(a.ws + WS_XB);
    const int per = 2 * ((nrows + 2 * NGW - 1) / (2 * NGW)), w0 = gw * per, w1 = (w0 + per < nrows) ? w0 + per : nrows;
    f32x4 gv[4], shv[4], scv[4], m5v[4]; int cur = -1;
#pragma unroll
    for (int j = 0; j < 4; ++j) { gv[j] = *(const f32x4*)(g1 + F.lane * 4 + 256 * j); shv[j] = gv[j]; scv[j] = gv[j]; m5v[j] = gv[j]; }
#define P0_LOAD(rb, V, F0, F1) do { _Pragma("unroll") for (int q = 0; q < 2; ++q) { const int row = (rb) + q; const bool lat = row < TL; \
            const float* xs = lat ? a.in[I_X] + (size_t)row * D : a.in[I_CTX] + (size_t)(row - TL) * D; \
            _Pragma("unroll") for (int j = 0; j < 4; ++j) { const int col = F.lane * 4 + 256 * j; \
                if (l == 0) V[q][j] = __builtin_nontemporal_load((const u32x4*)(xs + col)); \
                else { const u32x2 t_ = *(const u32x2*)(XB + (size_t)row * D + col); V[q][j].x = t_.x; V[q][j].y = t_.y; \
                    F0[q][j] = *(const unsigned*)(Fs + (size_t)row * D + col); F1[q][j] = *(const unsigned*)(Fs + ((size_t)TT + row) * D + col); } } } } while (0)
#define P0_PROC(rb, V, F0, F1) do { _Pragma("unroll") for (int q = 0; q < 2; ++q) { const int row = (rb) + q; const int mr = mod_row(row); \
            if (mr != cur) { cur = mr; _Pragma("unroll") for (int j = 0; j < 4; ++j) { const int col = F.lane * 4 + 256 * j; \
                shv[j] = *(const f32x4*)(MODl + (size_t)mr * DIN + col); scv[j] = *(const f32x4*)(MODl + (size_t)mr * DIN + 1024 + col); m5v[j] = *(const f32x4*)(MODp + (size_t)mr * DIN + 5 * 1024 + col); } } \
            float ss = 0.f; f32x4 X[4]; \
            _Pragma("unroll") for (int j = 0; j < 4; ++j) { const u32x4 w_ = V[q][j]; \
                if (l == 0) X[j] = __builtin_bit_cast(f32x4, w_); \
                else { const f32x4 fs_ = (unpack4_fp8(F0[q][j]) + unpack4_fp8(F1[q][j])) * (1.f / 32.f); \
                       X[j].x = bflo(w_.x) + m5v[j].x * fs_.x; X[j].y = bfhi(w_.x) + m5v[j].y * fs_.y; X[j].z = bflo(w_.y) + m5v[j].z * fs_.z; X[j].w = bfhi(w_.y) + m5v[j].w * fs_.w; } } \
            _Pragma("unroll") for (int j = 0; j < 4; ++j) { const int col = F.lane * 4 + 256 * j; u32x2 xw_; xw_.x = cvtpk(X[j].x, X[j].y); xw_.y = cvtpk(X[j].z, X[j].w); \
                __builtin_nontemporal_store(xw_, (u32x2*)(XB + (size_t)row * D + col)); } \
            _Pragma("unroll") for (int j = 0; j < 4; ++j) ss += (X[j].x * X[j].x + X[j].y * X[j].y) + (X[j].z * X[j].z + X[j].w * X[j].w); \
            const float r = 1.f / sqrtf(wave_sum(ss) * (1.f / D) + EPS); \
            _Pragma("unroll") for (int j = 0; j < 4; ++j) { const int col = F.lane * 4 + 256 * j; \
                const f32x4 o = (X[j] * r * gv[j]) * (scv[j] + 1.f) + shv[j]; \
                *(unsigned*)(H8 + (size_t)row * D + col) = cvt4_fp8(o.x, o.y, o.z, o.w); } } } while (0)
    u32x4 vA[2][4], vB[2][4]; unsigned fA0[2][4], fA1[2][4], fB0[2][4], fB1[2][4];
    if (w0 < w1) P0_LOAD(w0, vA, fA0, fA1);
    for (int rb = w0; rb < w1; rb += 4) {
        if (rb + 2 < w1) P0_LOAD(rb + 2, vB, fB0, fB1);
        P0_PROC(rb, vA, fA0, fA1);
        if (rb + 2 < w1) { if (rb + 4 < w1) P0_LOAD(rb + 4, vA, fA0, fA1); P0_PROC(rb + 2, vB, fB0, fB1); }
    }
#undef P0_LOAD
#undef P0_PROC
}
__device__ __forceinline__ void rows_final(const Fr& F, const Args& a) {
    const int gw = F.bid * NWAVES + F.wave, NGW = F.G * NWAVES;
    const float* MODp = (const float*)(a.ws + WS_MOD) + (size_t)(NL - 1) * NBM * DIN;
    const unsigned char* Fs = a.ws + WS_F;
    const bf16_t* XB = (const bf16_t*)(a.ws + WS_XB);
    for (int row = gw; row < TL; row += NGW) {
        const int mr = row >> 11; float* xd = a.out + (size_t)row * D;
#pragma unroll
        for (int j = 0; j < 4; ++j) { const int col = F.lane * 4 + 256 * j;
            const u32x2 xw = *(const u32x2*)(XB + (size_t)row * D + col);
            const unsigned f0 = *(const unsigned*)(Fs + (size_t)row * D + col), f1 = *(const unsigned*)(Fs + ((size_t)TT + row) * D + col);
            const f32x4 m5 = *(const f32x4*)(MODp + (size_t)mr * DIN + 5 * 1024 + col);
            const f32x4 fs = (unpack4_fp8(f0) + unpack4_fp8(f1)) * (1.f / 32.f);
            f32x4 v; v.x = bflo(xw.x) + m5.x * fs.x; v.y = bfhi(xw.x) + m5.y * fs.y; v.z = bflo(xw.y) + m5.z * fs.z; v.w = bfhi(xw.y) + m5.w * fs.w;
            *(f32x4*)(xd + col) = v; }
    }
}

__device__ __forceinline__ void rows_p5(const Fr& F, const Args& a, int l, int nrows, unsigned long long& sacc, const int swhich) {
#if defined(PROBE_P)
    unsigned long long st0 = __builtin_amdgcn_s_memrealtime();
#define SUBMARK5(w) do { const unsigned long long t_ = __builtin_amdgcn_s_memrealtime(); if (swhich == (w)) sacc += t_ - st0; st0 = t_; } while (0)
#else
#define SUBMARK5(w) do { } while (0)
#endif
    typedef float f32x4v __attribute__((ext_vector_type(4)));
    LAS float* RW = (LAS float*)F.lds;
    constexpr int RWS = 1028;
    LAS float* RB = (LAS float*)(F.lds + 82304);
    LAS int* LC = (LAS int*)(F.lds + 82432);
    LAS int* TE = (LAS int*)(F.lds + 82560);
    LAS int* TP = TE + 256;
    LAS float* TW = (LAS float*)(TP + 256);
    LAS float* RN = (LAS float*)(F.lds + 86784);
    LAS float* LG = (LAS float*)(F.lds + 87424);
    LAS float* GM = (LAS float*)(F.lds + 99072);
    LAS float* BI = (LAS float*)(F.lds + 107264);
    LAS float* LG2 = (LAS float*)(F.lds + 107520);
    const float* g2 = a.in[I_N2G] + l * 1024;
    const float* MODl = (const float*)(a.ws + WS_MOD) + (size_t)l * NBM * DIN;
    unsigned char* H8 = a.ws + WS_H;
    const bf16_t* XB = (const bf16_t*)(a.ws + WS_XB);
    int* EROW = (int*)(a.ws + WS_EROW); float* EROWW = (float*)(a.ws + WS_EROWW);
    unsigned* CNT = (unsigned*)(a.ws + WS_CTL) + CW_CNT + l * 256;
    { f32x4 rg[2], re[8];
#pragma unroll
      for (int i = 0; i < 2; ++i) rg[i] = *(const f32x4*)(a.in[I_RGW] + ((size_t)l * 1024 + F.tid + NTHR * i) * 4);
#pragma unroll
      for (int i = 0; i < 8; ++i) { const int f = F.tid + NTHR * i; re[i] = *(const f32x4*)(a.in[I_REW] + ((size_t)l * 1024 + (f >> 2)) * 16 + (f & 3) * 4); }
#pragma unroll
      for (int i = 0; i < 2; ++i) { const int f = F.tid + NTHR * i; RW[0 * RWS + f] = rg[i].x; RW[1 * RWS + f] = rg[i].y; RW[2 * RWS + f] = rg[i].z; RW[3 * RWS + f] = rg[i].w; }
#pragma unroll
      for (int i = 0; i < 8; ++i) { const int f = F.tid + NTHR * i, k = f >> 2, c4 = (f & 3) * 4;
          RW[(4 + c4) * RWS + k] = re[i].x; RW[(5 + c4) * RWS + k] = re[i].y; RW[(6 + c4) * RWS + k] = re[i].z; RW[(7 + c4) * RWS + k] = re[i].w; } }
    if (F.tid < 20) RB[F.tid] = (F.tid < 4) ? a.in[I_RGB][l * 4 + F.tid] : a.in[I_REB][l * 16 + F.tid - 4];
    constexpr int P5_CH = 144;
    const int nch = (nrows + P5_CH - 1) / P5_CH;
    SUBMARK5(40);
    for (int ch = F.bid; ch < nch; ch += F.G) {
    const int r0 = ch * P5_CH, r1 = (r0 + P5_CH < nrows) ? r0 + P5_CH : nrows;
    const int mb0 = mod_row(r0), mb1 = mod_row(r1 - 1);
    if (F.tid < 32) LC[F.tid] = 0;
    { float gg[4], ms[4];
#pragma unroll
      for (int q = 0; q < 4; ++q) { const int i = F.tid + NTHR * q; const int s = i >> 10, k = i & 1023; gg[q] = g2[k]; ms[q] = MODl[(size_t)(s ? mb1 : mb0) * DIN + 4 * 1024 + k]; }
#pragma unroll
      for (int q = 0; q < 4; ++q) GM[F.tid + NTHR * q] = gg[q] * (1.f + ms[q]); }
    __syncthreads();
    const int wv_ = __builtin_amdgcn_readfirstlane(F.wave);
    int ln_ = lane_id(); asm volatile("" : "+v"(ln_));
    const int i16 = ln_ & 15, kq = ln_ >> 4; const int nhg = 2 * ((r1 - r0 + 15) >> 4);
    const float m1 = (i16 < 4) ? 1.f : 0.f;
#define PB_LOAD(hg_, X) do { const int gi_ = (hg_) >> 1, kh_ = (hg_) & 1; const int grow_ = r0 + 16 * gi_; const int rowi_ = (grow_ + i16 < r1) ? grow_ + i16 : r1 - 1; \
        const bf16_t* xs_ = XB + (size_t)rowi_ * D + 512 * kh_ + 8 * kq; _Pragma("unroll") for (int s = 0; s < 16; ++s) X[s] = *(const u32x4*)(xs_ + 32 * s); } while (0)
#define PB_PROC(hg_, X) do { const int gi_ = (hg_) >> 1, kh_ = (hg_) & 1; const int slot_ = (mod_row(r0 + 16 * gi_) == mb0) ? 0 : 1; \
        const LAS float* gmp = GM + slot_ * 1024 + 512 * kh_ + 8 * kq; const LAS float* w0p = RW + i16 * RWS + 512 * kh_ + 8 * kq; const LAS float* w1p = RW + (16 + (i16 & 3)) * RWS + 512 * kh_ + 8 * kq; \
        f32x4v acc0 = {0.f, 0.f, 0.f, 0.f}, acc1 = {0.f, 0.f, 0.f, 0.f}; \
        _Pragma("unroll") for (int s = 0; s < 16; ++s) { const u32x4 xw = X[s]; \
            _Pragma("unroll") for (int hh = 0; hh < 2; ++hh) { const unsigned x0 = hh ? xw.z : xw.x, x1 = hh ? xw.w : xw.y; \
                const f32x4 gv = *(const LAS f32x4*)(gmp + 32 * s + 4 * hh); \
                const f32x4 wa = *(const LAS f32x4*)(w0p + 32 * s + 4 * hh), wb = *(const LAS f32x4*)(w1p + 32 * s + 4 * hh); \
                const f32x4 ba = wa * gv, bb = wb * gv * m1; \
                acc0 = __builtin_amdgcn_mfma_f32_16x16x4f32(bflo(x0), ba.x, acc0, 0, 0, 0); acc1 = __builtin_amdgcn_mfma_f32_16x16x4f32(bflo(x0), bb.x, acc1, 0, 0, 0); \
                acc0 = __builtin_amdgcn_mfma_f32_16x16x4f32(bfhi(x0), ba.y, acc0, 0, 0, 0); acc1 = __builtin_amdgcn_mfma_f32_16x16x4f32(bfhi(x0), bb.y, acc1, 0, 0, 0); \
                acc0 = __builtin_amdgcn_mfma_f32_16x16x4f32(bflo(x1), ba.z, acc0, 0, 0, 0); acc1 = __builtin_amdgcn_mfma_f32_16x16x4f32(bflo(x1), bb.z, acc1, 0, 0, 0); \
                acc0 = __builtin_amdgcn_mfma_f32_16x16x4f32(bfhi(x1), ba.w, acc0, 0, 0, 0); acc1 = __builtin_amdgcn_mfma_f32_16x16x4f32(bfhi(x1), bb.w, acc1, 0, 0, 0); } \
            if ((s & 1) == 1) __builtin_amdgcn_sched_barrier(0); } \
        LAS float* LGo = kh_ ? LG2 : LG;                                  \
        _Pragma("unroll") for (int rg = 0; rg < 4; ++rg) { const int lr = 16 * gi_ + 4 * kq + rg; \
            if (r0 + lr < r1) { LGo[lr * 20 + i16] = acc0[rg]; if (i16 < 4) LGo[lr * 20 + 16 + i16] = acc1[rg]; } } } while (0)
    if (wv_ < 4) {
        const int w0 = r0 + wv_ * (P5_CH / 4), w1 = (w0 + P5_CH / 4 < r1) ? w0 + P5_CH / 4 : r1;
        f32x4 gmv[4], shv[4]; int cur = -1;
#pragma unroll
        for (int j = 0; j < 4; ++j) { gmv[j] = *(const LAS f32x4*)(GM + ln_ * 4 + 256 * j); shv[j] = gmv[j]; }
#define PA_LOAD(rb, X) do { _Pragma("unroll") for (int q = 0; q < 4; ++q) _Pragma("unroll") for (int j = 0; j < 4; ++j) X[q][j] = *(const u32x2*)(XB + (size_t)((rb) + q) * D + ln_ * 4 + 256 * j); } while (0)
#define PA_PROC(rb, X) do { _Pragma("unroll") for (int q = 0; q < 4; ++q) { const int rr = (rb) + q; const int mr = mod_row(rr); \
            if (mr != cur) { cur = mr; const int sl_ = (mr == mb0) ? 0 : 1; _Pragma("unroll") for (int j = 0; j < 4; ++j) { \
                gmv[j] = *(const LAS f32x4*)(GM + sl_ * 1024 + ln_ * 4 + 256 * j); shv[j] = *(const f32x4*)(MODl + (size_t)mr * DIN + 3 * 1024 + ln_ * 4 + 256 * j); } } \
            f32x4 v[4]; float ss = 0.f; \
            _Pragma("unroll") for (int j = 0; j < 4; ++j) { v[j].x = bflo(X[q][j].x); v[j].y = bfhi(X[q][j].x); v[j].z = bflo(X[q][j].y); v[j].w = bfhi(X[q][j].y); \
                ss += (v[j].x * v[j].x + v[j].y * v[j].y) + (v[j].z * v[j].z + v[j].w * v[j].w); } \
            const float r = 1.f / sqrtf(wave_sum(ss) * (1.f / D) + EPS); \
            if (ln_ == 0) RN[rr - r0] = r; \
            _Pragma("unroll") for (int j = 0; j < 4; ++j) { const f32x4 t = (v[j] * r) * gmv[j] + shv[j]; \
                *(unsigned*)(H8 + (size_t)rr * D + ln_ * 4 + 256 * j) = cvt4_fp8(t.x, t.y, t.z, t.w); } } } while (0)
        u32x2 xa[4][4], xb[4][4], xc[4][4];
        if (w0 < w1) PA_LOAD(w0, xa);
        if (w0 + 4 < w1) PA_LOAD(w0 + 4, xb);
        for (int rb = w0; rb < w1; rb += 12) {
            if (rb + 8 < w1) PA_LOAD(rb + 8, xc);
            PA_PROC(rb, xa);
            if (rb + 4 < w1) { if (rb + 12 < w1) PA_LOAD(rb + 12, xa); PA_PROC(rb + 4, xb); }
            if (rb + 8 < w1) { if (rb + 16 < w1) PA_LOAD(rb + 16, xb); PA_PROC(rb + 8, xc); }
        }
#undef PA_LOAD
#undef PA_PROC
        if (wv_ < 2 && 16 + wv_ < nhg) { u32x4 pq[16]; PB_LOAD(16 + wv_, pq); PB_PROC(16 + wv_, pq); }
        if (wv_ >= 2) { const int sl = wv_ - 2; const int mb = sl ? mb1 : mb0; f32x4 sh[4];
#pragma unroll
        for (int j = 0; j < 4; ++j) sh[j] = *(const f32x4*)(MODl + (size_t)mb * DIN + 3 * 1024 + ln_ * 4 + 256 * j);
#pragma unroll 4
        for (int cidx = 0; cidx < 20; ++cidx) { float p = 0.f;
#pragma unroll
            for (int j = 0; j < 4; ++j) { const f32x4 w = *(const LAS f32x4*)(RW + cidx * RWS + ln_ * 4 + 256 * j);
                p = fmaf(sh[j].x, w.x, p); p = fmaf(sh[j].y, w.y, p); p = fmaf(sh[j].z, w.z, p); p = fmaf(sh[j].w, w.w, p); }
            const float tot = wave_sum(p) + RB[cidx]; if (ln_ == 0) BI[sl * 20 + cidx] = tot; } }
    } else {
    u32x4 pa[16];
    const int hg0 = (wv_ - 2) & 3;
    for (int hg = hg0; hg < nhg && hg < 16; hg += 4) {
        PB_LOAD(hg, pa);
        PB_PROC(hg, pa);
    }
#undef PB_LOAD
#undef PB_PROC
    }
    __syncthreads();
    SUBMARK5(42);
    for (int lr = F.tid; lr < r1 - r0; lr += NTHR) {
        float lg[20]; { const float rn = RN[lr]; const int sl = (mod_row(r0 + lr) == mb0) ? 0 : 1;
#pragma unroll
          for (int i = 0; i < 20; ++i) lg[i] = rn * (LG[lr * 20 + i] + LG2[lr * 20 + i]) + BI[sl * 20 + i]; }
        int gs = 0; float gmx = lg[0];
#pragma unroll
        for (int i = 1; i < 4; ++i) if (lg[i] > gmx) { gmx = lg[i]; gs = i; }
        float gsum = 0.f;
#pragma unroll
        for (int i = 0; i < 4; ++i) gsum += __expf(lg[i] - gmx);
        const float pg = 1.f / gsum;
        float le[4];
#pragma unroll
        for (int i = 0; i < 4; ++i) le[i] = (gs == 0) ? lg[4 + i] : (gs == 1) ? lg[8 + i] : (gs == 2) ? lg[12 + i] : lg[16 + i];
        int i0 = 0; float v0 = le[0];
#pragma unroll
        for (int i = 1; i < 4; ++i) if (le[i] > v0) { v0 = le[i]; i0 = i; }
        int i1 = -1; float v1 = -3.4e38f;
#pragma unroll
        for (int i = 0; i < 4; ++i) if (i != i0 && le[i] > v1) { v1 = le[i]; i1 = i; }
        const float e1 = __expf(v1 - v0), den = 1.f / (1.f + e1);
        const int ex0 = gs * 4 + i0, ex1 = gs * 4 + i1;
        const int lp0 = __hip_atomic_fetch_add(&LC[ex0], 1, __ATOMIC_RELAXED, __HIP_MEMORY_SCOPE_WORKGROUP), lp1 = __hip_atomic_fetch_add(&LC[ex1], 1, __ATOMIC_RELAXED, __HIP_MEMORY_SCOPE_WORKGROUP);
        TE[lr] = ex0 | (ex1 << 8); TP[lr] = lp0 | (lp1 << 16); TW[2 * lr] = den * pg; TW[2 * lr + 1] = e1 * den * pg;
    }
    __syncthreads();
    if (F.tid < NE) LC[16 + F.tid] = (int)atomicAdd(&CNT[F.tid * 16], (unsigned)LC[F.tid]);
    __syncthreads();
    for (int lr = F.tid; lr < r1 - r0; lr += NTHR) {
        const int te = TE[lr], tp = TP[lr], ex0 = te & 255, ex1 = te >> 8, row = r0 + lr;
        const int gp0 = LC[16 + ex0] + (tp & 0xffff), gp1 = LC[16 + ex1] + (tp >> 16);
        EROW[(size_t)ex0 * TT + gp0] = row * 2; EROWW[(size_t)ex0 * TT + gp0] = TW[2 * lr];
        EROW[(size_t)ex1 * TT + gp1] = row * 2 + 1; EROWW[(size_t)ex1 * TT + gp1] = TW[2 * lr + 1];
    }
    __syncthreads();
    SUBMARK5(43);
    }
    __syncthreads();
#undef SUBMARK5
}

__device__ __forceinline__ void normrope8(float (&x)[8], const float* g64, bool rope, int pos, const float* ct, const float* st, float scale, int lane) {
    float ss = 0.f;
#pragma unroll
    for (int i = 0; i < 8; ++i) ss += x[i] * x[i];
    ss += DPP_F(ss, 0xB1); ss += DPP_F(ss, 0x4E); ss += DPP_F(ss, 0x141);
    const float r = 1.f / sqrtf(ss * (1.f / 64.f) + EPS);
    const int ch = lane & 7;
    const f32x4 g0 = *(const f32x4*)(g64 + 8 * ch), g1 = *(const f32x4*)(g64 + 8 * ch + 4);
    x[0] *= r * g0.x; x[1] *= r * g0.y; x[2] *= r * g0.z; x[3] *= r * g0.w; x[4] *= r * g1.x; x[5] *= r * g1.y; x[6] *= r * g1.z; x[7] *= r * g1.w;
    if (rope) {
        const int ax = ch >> 2, half = (ch >> 1) & 1, f0 = 8 * (ch & 1);
        const f32x4 c0 = *(const f32x4*)(ct + pos * 32 + ax * 16 + f0), c1 = *(const f32x4*)(ct + pos * 32 + ax * 16 + f0 + 4);
        const f32x4 s0 = *(const f32x4*)(st + pos * 32 + ax * 16 + f0), s1 = *(const f32x4*)(st + pos * 32 + ax * 16 + f0 + 4);
        const float cs[8] = {c0.x, c0.y, c0.z, c0.w, c1.x, c1.y, c1.z, c1.w}, sn[8] = {s0.x, s0.y, s0.z, s0.w, s1.x, s1.y, s1.z, s1.w};
#pragma unroll
        for (int i = 0; i < 8; ++i) { const float p = DPP_F(x[i], 0x4E);
            x[i] = half ? (x[i] * cs[i] + p * sn[i]) : (x[i] * cs[i] - p * sn[i]); }
    }
#pragma unroll
    for (int i = 0; i < 8; ++i) x[i] *= scale;
}
__device__ __forceinline__ void unpack8(const u32x4 w, float (&x)[8]) { x[0] = bflo(w.x); x[1] = bfhi(w.x); x[2] = bflo(w.y); x[3] = bfhi(w.y); x[4] = bflo(w.z); x[5] = bfhi(w.z); x[6] = bflo(w.w); x[7] = bfhi(w.w); }
__device__ __forceinline__ u32x4 pack8(const float (&x)[8]) { u32x4 w; w.x = cvtpk(x[0], x[1]); w.y = cvtpk(x[2], x[3]); w.z = cvtpk(x[4], x[5]); w.w = cvtpk(x[6], x[7]); return w; }

__device__ __forceinline__ void prep_phase(const Fr& F, const Args& a, int l, bool with_ctx) {
    constexpr int VROW = 272;
    LAS unsigned char* VA_l = F.lds;
    LAS unsigned char* VW_l = F.lds + 17408;
    LAS unsigned char* HT_l = F.lds + 34816;
    constexpr int HROW = 144;
    const float* ct = (const float*)(a.ws + WS_ROPE); const float* st = ct + SEQ * 32;
    const float* qkg = a.in[I_QKG] + l * 256;
    const bf16_t* RAWA = (const bf16_t*)(a.ws + WS_RAWA); const bf16_t* RAWW = (const bf16_t*)(a.ws + WS_RAWW);
    bf16_t* KA = (bf16_t*)(a.ws + WS_KA); bf16_t* KW = (bf16_t*)(a.ws + WS_KW); bf16_t* VTA = (bf16_t*)(a.ws + WS_VTA); bf16_t* VTW = (bf16_t*)(a.ws + WS_VTW);
    const bf16_t* U = (const bf16_t*)(a.ws + WS_U); bf16_t* X0 = (bf16_t*)(a.ws + WS_H); bf16_t* VT = (bf16_t*)(a.ws + WS_VT);
    const float* hsw = a.in[I_HSW] + l * 3 * 1536; const float* hsb = a.in[I_HSB] + l * 1536;
    const int nunits = NB * 32 + (with_ctx ? 3 * NB * 4 : NB * 4);
    for (int unit = F.bid; unit < nunits; unit += F.G) {
        const bool lat = unit < NB * 32; const int u2 = unit - NB * 32, sub = u2 >> 6, cu = u2 & 63;
        const bool do_kv = lat || sub == 0, do_h0 = lat || sub == 1, do_h12 = lat || sub == 2;
        const int b = lat ? unit >> 5 : cu >> 2, p0 = lat ? (unit & 31) * 64 : (cu & 3) * 64;
        const int n = lat ? SEQ : CTX;
        const int row0 = lat ? b * SEQ + p0 : TL + b * CTX + p0;
        const int j0 = lat ? CTX + p0 : p0;
        __syncthreads();
        if (do_kv) {
            const bool isw = (F.lane & 16) != 0; const int l16 = F.lane & 15, half = F.lane >> 5;
            u32x4 kw[4];
#pragma unroll
            for (int ps = 0; ps < 4; ++ps) { const int tk = 8 * F.wave + 2 * ps + half; kw[ps] = *(const u32x4*)((isw ? RAWW : RAWA) + (size_t)(row0 + tk) * 256 + l16 * 8); }
#pragma unroll
            for (int ps = 0; ps < 4; ++ps) { const int tk = 8 * F.wave + 2 * ps + half; float x[8]; unpack8(kw[ps], x);
                normrope8(x, qkg + (isw ? 192 : 64), lat, p0 + tk, ct, st, 1.f, F.lane);
                *(u32x4*)((isw ? KW : KA) + ((size_t)b * KEYS + j0 + tk) * 128 + l16 * 8) = pack8(x); }
        }
        if (do_kv) { u32x4 vt4[4];
#pragma unroll
          for (int q = 0; q < 4; ++q) { const int i = F.tid + NTHR * q; const int m = i >> 10, r = (i >> 4) & 63, cch = i & 15; vt4[q] = *(const u32x4*)((m ? RAWW : RAWA) + (size_t)(row0 + r) * 256 + 128 + cch * 8); }
#pragma unroll
          for (int q = 0; q < 4; ++q) { const int i = F.tid + NTHR * q; const int m = i >> 10, r = (i >> 4) & 63, cch = i & 15; *(LAS u32x4*)((m ? VW_l : VA_l) + r * VROW + ((cch ^ (((r >> 2) & 1) | (((r >> 4) & 3) << 1))) << 4)) = vt4[q]; } }
        const bool do_hy = do_h0 || do_h12;
        if (do_hy) {
            int tq_ = F.tid; asm volatile("" : "+v"(tq_));
            const int cg = tq_ & 63, c = 8 * cg, t0 = 8 * F.wave;
            u32x4 x1p[8];
            float w0[8], w1[8], w2[8], bb[8]; u32x4 raw[10];
#define HY_LDW(g_) do { const int ch_ = (g_) * 512 + c; \
                const f32x4 a0 = *(const f32x4*)(hsw + ch_), a1 = *(const f32x4*)(hsw + ch_ + 4), b0 = *(const f32x4*)(hsw + 1536 + ch_), b1 = *(const f32x4*)(hsw + 1536 + ch_ + 4), \
                            c0 = *(const f32x4*)(hsw + 3072 + ch_), c1 = *(const f32x4*)(hsw + 3072 + ch_ + 4), d0 = *(const f32x4*)(hsb + ch_), d1 = *(const f32x4*)(hsb + ch_ + 4); \
                w0[0] = a0.x; w0[1] = a0.y; w0[2] = a0.z; w0[3] = a0.w; w0[4] = a1.x; w0[5] = a1.y; w0[6] = a1.z; w0[7] = a1.w; \
                w1[0] = b0.x; w1[1] = b0.y; w1[2] = b0.z; w1[3] = b0.w; w1[4] = b1.x; w1[5] = b1.y; w1[6] = b1.z; w1[7] = b1.w; \
                w2[0] = c0.x; w2[1] = c0.y; w2[2] = c0.z; w2[3] = c0.w; w2[4] = c1.x; w2[5] = c1.y; w2[6] = c1.z; w2[7] = c1.w; \
                bb[0] = d0.x; bb[1] = d0.y; bb[2] = d0.z; bb[3] = d0.w; bb[4] = d1.x; bb[5] = d1.y; bb[6] = d1.z; bb[7] = d1.w; } while (0)
#define HY_LDROW(g_, i_) do { const int pos_ = p0 + t0 - 1 + (i_); \
                if (pos_ < 0 || pos_ >= n) { const unsigned z_ = zero_u32(); raw[i_] = (u32x4){z_, z_, z_, z_}; } else raw[i_] = *(const u32x4*)(U + (size_t)(row0 - p0 + pos_) * 1536 + (g_) * 512 + c); } while (0)
            const int gf = do_h0 ? 0 : 1;
            HY_LDW(gf);
#pragma unroll
            for (int i = 0; i < 10; ++i) HY_LDROW(gf, i);
#pragma unroll
            for (int g = 0; g < 3; ++g) { if (g == 0 ? !do_h0 : !do_h12) continue;
#pragma unroll
                for (int t = 0; t < 8; ++t) { float up[8], uc[8], un[8], o[8]; unpack8(raw[t], up); unpack8(raw[t + 1], uc); unpack8(raw[t + 2], un);
#pragma unroll
                    for (int i = 0; i < 8; ++i) o[i] = fmaf(w0[i], up[i], fmaf(w1[i], uc[i], fmaf(w2[i], un[i], bb[i])));
                    if (g == 0) __builtin_nontemporal_store(pack8(o), (u32x4*)(X0 + (size_t)(row0 + t0 + t) * 512 + c));
                    else if (g == 1) x1p[t] = pack8(o);
                    else { float x1[8]; unpack8(x1p[t], x1);
#pragma unroll
                        for (int i = 0; i < 8; ++i) o[i] *= x1[i];
                        x1p[t] = pack8(o); }
                    if (g < 2 && do_h12) HY_LDROW(g + 1, t); }
                if (g < 2 && do_h12) { HY_LDROW(g + 1, 8); HY_LDROW(g + 1, 9); HY_LDW(g + 1); }
            }
#undef HY_LDW
#undef HY_LDROW
            if (do_h12)
#pragma unroll
            for (int i = 0; i < 8; ++i) { unsigned short ev[8];
#pragma unroll
                for (int t = 0; t < 8; ++t) { const unsigned wsel = (i >> 1) == 0 ? x1p[t].x : (i >> 1) == 1 ? x1p[t].y : (i >> 1) == 2 ? x1p[t].z : x1p[t].w; ev[t] = (unsigned short)((i & 1) ? (wsel >> 16) : (wsel & 0xffffu)); }
                u32x4 w; w.x = ev[0] | ((unsigned)ev[1] << 16); w.y = ev[2] | ((unsigned)ev[3] << 16); w.z = ev[4] | ((unsigned)ev[5] << 16); w.w = ev[6] | ((unsigned)ev[7] << 16);
                *(LAS u32x4*)(HT_l + (c + i) * HROW + ((F.wave ^ (cg & 7)) << 4)) = w; }
        }
        __syncthreads();
        if (do_kv)
        for (int i = F.tid; i < 2 * 128 * 8; i += NTHR) { const int m = i >> 10, rr = (i >> 3) & 127, c8 = i & 7;
            LAS unsigned char* T = m ? VW_l : VA_l; unsigned short e[8];
#pragma unroll
            for (int jj = 0; jj < 8; ++jj) { const int key = 16 * (c8 >> 1) + 8 * (jj >> 2) + 4 * (c8 & 1) + (jj & 3); e[jj] = *(const LAS bf16_t*)(T + key * VROW + ((((rr >> 3) ^ (((key >> 2) & 1) | (((key >> 4) & 3) << 1))) << 4) | ((rr & 7) << 1))); }
            u32x4 w; w.x = e[0] | ((unsigned)e[1] << 16); w.y = e[2] | ((unsigned)e[3] << 16); w.z = e[4] | ((unsigned)e[5] << 16); w.w = e[6] | ((unsigned)e[7] << 16);
            *(u32x4*)((m ? VTW : VTA) + ((size_t)(b * 2 + (rr >> 6)) * 64 + (rr & 63)) * KEYS + j0 + c8 * 8) = w; }
        if (do_h12) { bf16_t* VTb = lat ? VT : VT + VT_CTX_OFF;
          for (int i = F.tid; i < 512 * 8; i += NTHR) { const int cch = i >> 3, c8 = i & 7;
              const u32x4 w = *(const LAS u32x4*)(HT_l + cch * HROW + ((c8 ^ ((cch >> 3) & 7)) << 4));
              *(u32x4*)(VTb + ((size_t)cch * NB + b) * n + p0 + c8 * 8) = w; } }
    }
    __syncthreads();
}

__device__ __forceinline__ void hyena_final_phase(const Fr& F, const Args& a, int l, bool with_ctx) {
    constexpr int HROW = 132;
    LAS unsigned char* T = F.lds;
    const bf16_t* X0 = (const bf16_t*)(a.ws + WS_H); const bf16_t* VT = (const bf16_t*)(a.ws + WS_VT); const bf16_t* YT = (const bf16_t*)(a.ws + WS_YT);
    unsigned char* YH = a.ws + WS_Y8 + 512;
    const float* FN = (const float*)(a.ws + WS_FNORM) + l * 1024; const float* skip = a.in[I_HBIAS] + l * 512;
    const int nunits = with_ctx ? NB * 32 + NB * 16 : NB * 32;
    for (int unit = F.bid; unit < nunits; unit += F.G) {
        const bool lat = unit < NB * 32; const int u2 = unit - NB * 32;
        const int b = lat ? unit >> 5 : u2 >> 4, p0 = lat ? (unit & 31) * 64 : (u2 & 15) * 16;
        const int ul = lat ? 64 : 16, ncs = lat ? 3 : 1;
        const int n = lat ? SEQ : CTX; const int row0 = lat ? b * SEQ + p0 : TL + b * CTX + p0;
        const bf16_t* Yb = lat ? YT : YT + VT_CTX_OFF; const bf16_t* Vb = lat ? VT : VT + VT_CTX_OFF; const float* inv = FN + (lat ? 0 : 512);
        __syncthreads();
        for (int ib = F.tid; ib < (512 << ncs); ib += 2 * NTHR) {
          u32x4 yv[2], vv[2];
#pragma unroll
          for (int q = 0; q < 2; ++q) { const int i = ib + NTHR * q; const int cch = i >> ncs, c8 = i & ((1 << ncs) - 1); const size_t off = ((size_t)cch * NB + b) * n + p0 + c8 * 8; yv[q] = *(const u32x4*)(Yb + off); vv[q] = *(const u32x4*)(Vb + off); }
#pragma unroll
          for (int q = 0; q < 2; ++q) { const int i = ib + NTHR * q; const int cch = i >> ncs, c8 = i & ((1 << ncs) - 1);
            const u32x4 y = yv[q], v = vv[q]; const float s = inv[cch], k = skip[cch];
            u32x4 o;
            o.x = cvtpk(bflo(y.x) * s + k * bflo(v.x), bfhi(y.x) * s + k * bfhi(v.x)); o.y = cvtpk(bflo(y.y) * s + k * bflo(v.y), bfhi(y.y) * s + k * bfhi(v.y));
            o.z = cvtpk(bflo(y.z) * s + k * bflo(v.z), bfhi(y.z) * s + k * bfhi(v.z)); o.w = cvtpk(bflo(y.w) * s + k * bflo(v.w), bfhi(y.w) * s + k * bfhi(v.w));
            LAS unsigned* tw = (LAS unsigned*)(T + cch * HROW + c8 * 16); tw[0] = o.x; tw[1] = o.y; tw[2] = o.z; tw[3] = o.w; } }
        __syncthreads();
        { const int th = F.tid & 255, half = F.tid >> 8, c = 2 * th, hl = ul >> 1;
          for (int tb = hl * half; tb < hl * half + hl; tb += 8) {
              unsigned x0v[8];
#pragma unroll
              for (int q = 0; q < 8; ++q) x0v[q] = *(const unsigned*)(X0 + (size_t)(row0 + tb + q) * 512 + c);
#pragma unroll
              for (int q = 0; q < 8; ++q) { const int t = tb + q; const unsigned x0 = x0v[q];
                  const float y0 = bf1(*(const LAS bf16_t*)(T + c * HROW + t * 2)), y1 = bf1(*(const LAS bf16_t*)(T + (c + 1) * HROW + t * 2));
                  *(unsigned short*)(YH + (size_t)(row0 + t) * 1536 + c) = (unsigned short)__builtin_amdgcn_cvt_pk_fp8_f32(clamp_fp8(bflo(x0) * y0 * 16.f), clamp_fp8(bfhi(x0) * y1 * 16.f), 0, false); } } }
    }
    __syncthreads();
}

#define MFMA32(a, b, c) __builtin_amdgcn_mfma_f32_32x32x16_bf16((a), (b), (c), 0, 0, 0)
#define MFMA16(a, b, c) __builtin_amdgcn_mfma_f32_16x16x32_bf16((a), (b), (c), 0, 0, 0)

__device__ __forceinline__ int tile_off(int row, int chunk) { return row * 128 + ((chunk ^ ((row >> 1) & 7)) << 4); }

template <bool WIN>
__device__ __forceinline__ void attn_unit(const Fr& F, u32x4 (&qw)[4], const bf16_t* Qn, unsigned char* Yw, const bf16_t* Kb, const bf16_t* VTb, int a0, int na, int b0, int nb, int qpos0, bool has_sink, float sink2, const float* g64, bool rope, const float* ct, const float* st) {
    LAS unsigned char* L = F.lds;
    const int r = F.lane & 31, h = F.lane >> 5;
    const int xaddr = (lane_id() ^ 32) << 2;
#define SWAP32(v) __builtin_bit_cast(float, __builtin_amdgcn_ds_bpermute(xaddr, __builtin_bit_cast(int, (v))))
    const int ntile = na + nb;
    const int srow = F.tid >> 3, sch = F.tid & 7;
#define AT_KT(i) ((i) < na ? a0 + (i) : b0 + ((i) - na))
    const unsigned voK = (unsigned)(srow * 128 + sch * 8) * 2u, voV = (unsigned)(srow * KEYS + sch * 8) * 2u;
#define AT_LD(i, K0, K1, V0, V1) do { const int kt_ = __builtin_amdgcn_readfirstlane(AT_KT(i)); const char* kb_ = (const char*)Kb + (size_t)kt_ * 32768; const char* vb_ = (const char*)VTb + (size_t)kt_ * 256; \
        K0 = *(const u32x4*)(kb_ + voK); K1 = *(const u32x4*)(kb_ + 16384 + voK); \
        V0 = *(const u32x4*)(vb_ + voV); V1 = *(const u32x4*)(vb_ + 128 + voV); } while (0)
    u32x4 kA0, kA1, vA0, vA1;
    AT_LD(0, kA0, kA1, vA0, vA1);
    bf16x8 q[4];
    {
        float x[4][8]; float ss = 0.f;
#pragma unroll
        for (int kk = 0; kk < 4; ++kk) { const u32x4 w = qw[kk]; unpack8(w, x[kk]);
#pragma unroll
            for (int j = 0; j < 8; ++j) ss += x[kk][j] * x[kk][j]; }
        ss += SWAP32(ss);
        const float rn = (1.f / sqrtf(ss * (1.f / 64.f) + EPS)) * QSCALE;
#pragma unroll
        for (int kk = 0; kk < 4; ++kk) { const f32x4 g0 = *(const f32x4*)(g64 + 16 * kk + 8 * h), g1 = *(const f32x4*)(g64 + 16 * kk + 8 * h + 4);
            x[kk][0] *= rn * g0.x; x[kk][1] *= rn * g0.y; x[kk][2] *= rn * g0.z; x[kk][3] *= rn * g0.w; x[kk][4] *= rn * g1.x; x[kk][5] *= rn * g1.y; x[kk][6] *= rn * g1.z; x[kk][7] *= rn * g1.w; }
        if (rope) { const int pos = qpos0 + r;
#pragma unroll
            for (int ax = 0; ax < 2; ++ax) {
                const f32x4 c0 = *(const f32x4*)(ct + pos * 32 + ax * 16 + 8 * h), c1 = *(const f32x4*)(ct + pos * 32 + ax * 16 + 8 * h + 4);
                const f32x4 s0 = *(const f32x4*)(st + pos * 32 + ax * 16 + 8 * h), s1 = *(const f32x4*)(st + pos * 32 + ax * 16 + 8 * h + 4);
                const float cs[8] = {c0.x, c0.y, c0.z, c0.w, c1.x, c1.y, c1.z, c1.w}, sn[8] = {s0.x, s0.y, s0.z, s0.w, s1.x, s1.y, s1.z, s1.w};
#pragma unroll
                for (int j = 0; j < 8; ++j) { const float av = x[2 * ax][j], bv = x[2 * ax + 1][j]; x[2 * ax][j] = av * cs[j] - bv * sn[j]; x[2 * ax + 1][j] = bv * cs[j] + av * sn[j]; } } }
#pragma unroll
        for (int kk = 0; kk < 4; ++kk) q[kk] = __builtin_bit_cast(bf16x8, pack8(x[kk]));
    }
    if (Qn) {
#pragma unroll
        for (int kk = 0; kk < 4; ++kk) qw[kk] = *(const u32x4*)(Qn + (size_t)r * 1536 + 16 * kk + 8 * h); }
    f32x16 o0, o1;
#pragma unroll
    for (int i = 0; i < 16; ++i) { o0[i] = 0.f; o1[i] = 0.f; }
    float lsum = 0.f;
    const int soff = tile_off(srow, sch);
    int t4[4];
#pragma unroll
    for (int j = 0; j < 4; ++j) t4[j] = tile_off(r, 2 * j + h);
#define AT_ST(buf, K0, K1, V0, V1) do { LAS unsigned char* B_ = L + (buf) * 32768 + soff; \
        *(LAS u32x4*)(B_) = K0; *(LAS u32x4*)(B_ + 8192) = K1; *(LAS u32x4*)(B_ + 16384) = V0; *(LAS u32x4*)(B_ + 24576) = V1; } while (0)
#define AT_QK(S0, S1, Kt) do { bf16x8 kf_[8]; \
        _Pragma("unroll") for (int kk = 0; kk < 4; ++kk) { kf_[2 * kk] = *(const LAS bf16x8*)(L + (Kt) + t4[kk]); kf_[2 * kk + 1] = *(const LAS bf16x8*)(L + (Kt) + t4[kk] + 4096); } \
        _Pragma("unroll") for (int i_ = 0; i_ < 16; ++i_) { S0[i_] = 0.f; S1[i_] = 0.f; } \
        _Pragma("unroll") for (int kk = 0; kk < 4; ++kk) { S0 = MFMA32(kf_[2 * kk], q[kk], S0); S1 = MFMA32(kf_[2 * kk + 1], q[kk], S1); } } while (0)
#define AT_EXP(S0, S1, P, kpos0) do { \
          \
        if (WIN && (kpos0) >= 0 && !((kpos0) >= qpos0 - 97 && (kpos0) <= qpos0 + 65)) { const int kbase = (kpos0) + 4 * h, qp = qpos0 + r; \
            _Pragma("unroll") for (int i = 0; i < 16; ++i) { const int kr = (i & 3) + 8 * (i >> 2); const int d0 = kbase + kr - qp, d1 = d0 + 32; \
                if (d0 > 128 || d0 < -128) S0[i] = -1e30f; if (d1 > 128 || d1 < -128) S1[i] = -1e30f; } } \
        _Pragma("unroll") for (int i = 0; i < 16; ++i) { S0[i] = fast_exp2(S0[i]); S1[i] = fast_exp2(S1[i]); lsum += S0[i] + S1[i]; } \
        { u32x4 w; \
          w.x = cvtpk(S0[0], S0[1]); w.y = cvtpk(S0[2], S0[3]); w.z = cvtpk(S0[4], S0[5]); w.w = cvtpk(S0[6], S0[7]); P[0] = __builtin_bit_cast(bf16x8, w); \
          w.x = cvtpk(S0[8], S0[9]); w.y = cvtpk(S0[10], S0[11]); w.z = cvtpk(S0[12], S0[13]); w.w = cvtpk(S0[14], S0[15]); P[1] = __builtin_bit_cast(bf16x8, w); \
          w.x = cvtpk(S1[0], S1[1]); w.y = cvtpk(S1[2], S1[3]); w.z = cvtpk(S1[4], S1[5]); w.w = cvtpk(S1[6], S1[7]); P[2] = __builtin_bit_cast(bf16x8, w); \
          w.x = cvtpk(S1[8], S1[9]); w.y = cvtpk(S1[10], S1[11]); w.z = cvtpk(S1[12], S1[13]); w.w = cvtpk(S1[14], S1[15]); P[3] = __builtin_bit_cast(bf16x8, w); } } while (0)
#define AT_PV(P, Vt) do { bf16x8 vf_[8]; \
        _Pragma("unroll") for (int c = 0; c < 4; ++c) { vf_[2 * c] = *(const LAS bf16x8*)(L + (Vt) + t4[c]); vf_[2 * c + 1] = *(const LAS bf16x8*)(L + (Vt) + t4[c] + 4096); } \
        _Pragma("unroll") for (int c = 0; c < 4; ++c) { o0 = MFMA32(vf_[2 * c], P[c], o0); o1 = MFMA32(vf_[2 * c + 1], P[c], o1); } } while (0)
#define AT_BODY(it) do { \
        const int kt = AT_KT(it); \
        if ((it) + 1 < ntile) AT_LD((it) + 1, kA0, kA1, vA0, vA1); \
        const int Bc = ((it) & 1) * 32768;                                \
        const int kp = (WIN && kt >= 2) ? (kt - 2) * 128 : -1;            \
        { f32x16 sa0, sa1; bf16x8 pa[4]; \
          AT_QK(sa0, sa1, Bc); AT_EXP(sa0, sa1, pa, kp); AT_PV(pa, Bc + 16384); } \
        __builtin_amdgcn_sched_barrier(0); \
        { f32x16 sb0, sb1; bf16x8 pb_[4]; \
          AT_QK(sb0, sb1, Bc + 8192); AT_EXP(sb0, sb1, pb_, (kp < 0 ? -1 : kp + 64)); AT_PV(pb_, Bc + 24576); } \
        if ((it) + 1 < ntile) AT_ST(((it) + 1) & 1, kA0, kA1, vA0, vA1); \
        __syncthreads(); } while (0)
    __syncthreads();
    if (__builtin_amdgcn_readfirstlane(F.wave) >= 4) __builtin_amdgcn_s_setprio(1);
    AT_ST(0, kA0, kA1, vA0, vA1);
    __syncthreads();
    for (int it = 0; it < ntile; it += 2) {
        AT_BODY(it);
        if (it + 1 < ntile) AT_BODY(it + 1);
    }
#undef AT_BODY
#undef AT_QK
#undef AT_EXP
#undef AT_PV
#undef AT_ST
#undef AT_LD
#undef AT_KT
    __builtin_amdgcn_s_setprio(0);
    float lt = lsum + SWAP32(lsum);
    if (has_sink) lt += fast_exp2(sink2);
    const float inv = 1.f / lt;
    { LAS unsigned char* Ob = L + 65536 + F.wave * 2560; const float i16 = inv * 16.f;
#pragma unroll
      for (int g = 0; g < 4; ++g) {
          *(LAS unsigned*)(Ob + r * 80 + 8 * g + 4 * h) = cvt4_fp8(o0[4 * g] * i16, o0[4 * g + 1] * i16, o0[4 * g + 2] * i16, o0[4 * g + 3] * i16);
          *(LAS unsigned*)(Ob + r * 80 + 32 + 8 * g + 4 * h) = cvt4_fp8(o1[4 * g] * i16, o1[4 * g + 1] * i16, o1[4 * g + 2] * i16, o1[4 * g + 3] * i16); }
      LDS_WAIT();
#pragma unroll
      for (int ps = 0; ps < 2; ++ps) { const int row = (F.lane >> 2) + 16 * ps, ch = F.lane & 3;
          const u32x4 v = *(const LAS u32x4*)(Ob + row * 80 + ch * 16);
          *(u32x4*)(Yw + (size_t)row * 1536 + ch * 16) = v; } }
#undef SWAP32
}

__device__ __forceinline__ void hyena_unit_lat(const Fr& F, const bf16_t* Fg, const bf16_t* Vg, bf16_t* Yg) {
    constexpr int FREP = 8192 + 64, VPIT = 4096 + 16, VOFF = 8 * FREP;
    LAS unsigned char* L = F.lds;
    u32x4 vrow[8];
#pragma unroll
    for (int q = 0; q < 8; ++q) { const int i = F.tid + NTHR * q; vrow[q] = *(const u32x4*)(Vg + (size_t)(i >> 8) * SEQ + (i & 255) * 8); }
    { const int x = F.tid;
      const u32x4 lo = *(const u32x4*)(Fg + x * 8); u32x4 hi; if (x < 511) hi = *(const u32x4*)(Fg + x * 8 + 8); else { const unsigned z = zero_u32(); hi = (u32x4){z, z, z, z}; }
      __syncthreads();
      const unsigned wv[8] = {lo.x, lo.y, lo.z, lo.w, hi.x, hi.y, hi.z, hi.w};
      *(LAS u32x4*)(L + x * 16) = lo;
#pragma unroll
      for (int rho = 1; rho < 8; ++rho) { u32x4 o;
          unsigned od[4];
#pragma unroll
          for (int d = 0; d < 4; ++d) { const int ob = 4 * d + 2 * rho, i = ob >> 2, s = ob & 3; od[d] = __builtin_amdgcn_alignbyte(wv[i + 1 < 8 ? i + 1 : 7], wv[i], s); }
          o.x = od[0]; o.y = od[1]; o.z = od[2]; o.w = od[3];
          *(LAS u32x4*)(L + rho * FREP + x * 16) = o; } }
#pragma unroll
    for (int q = 0; q < 8; ++q) { const int i = F.tid + NTHR * q; *(LAS u32x4*)(L + VOFF + (i >> 8) * VPIT + (i & 255) * 16) = vrow[q]; }
    __syncthreads();
    const int i16 = F.lane & 15, q4 = F.lane >> 4, w = F.wave;
    const int base0 = 2047 - 256 * w - i16 + 8 * q4;
    const int rho = base0 & 7;
    LAS unsigned char* Ap = L + rho * FREP + (base0 - rho) * 2;
    LAS unsigned char* Bp = L + VOFF + i16 * VPIT + q4 * 16;
    bf16x8 A[16]; f32x4 acc[16];
#pragma unroll
    for (int rr = 0; rr < 16; ++rr) { A[rr] = *(const LAS bf16x8*)(Ap - 32 * rr); acc[rr] = (f32x4){0.f, 0.f, 0.f, 0.f}; }
    bf16x8 Bn = *(const LAS bf16x8*)(Bp);
    for (int o = 0; o < 8; ++o) {
#pragma unroll
        for (int u = 0; u < 8; ++u) {
            const int st = o * 8 + u;
            const bf16x8 Bf = Bn;
            if (st < 63) Bn = *(const LAS bf16x8*)(Bp + 64 * st + 64);
#pragma unroll
            for (int rr = 0; rr < 16; ++rr) acc[rr] = MFMA16(A[(rr - 2 * u) & 15], Bf, acc[rr]);
            if (st < 63) { A[(-2 * u - 2) & 15] = *(const LAS bf16x8*)(Ap + 64 * st + 64); A[(-2 * u - 1) & 15] = *(const LAS bf16x8*)(Ap + 64 * st + 32); }
        }
    }
#pragma unroll
    for (int rr = 0; rr < 16; ++rr) { u32x2 wv; wv.x = cvtpk(acc[rr].x, acc[rr].y); wv.y = cvtpk(acc[rr].z, acc[rr].w);
        *(u32x2*)(Yg + (size_t)i16 * SEQ + 256 * w + 16 * rr + 4 * q4) = wv; }
}
__device__ __forceinline__ void hyena_unit_ctx(const Fr& F, const bf16_t* Fg, const bf16_t* Vg, bf16_t* Yg) {
    constexpr int FREP = 1024 + 64, VPIT = 512 + 16, VOFF = 8 * FREP;
    LAS unsigned char* L = F.lds;
    __syncthreads();
    if (F.tid < 64) *(LAS u32x4*)(L + F.tid * 16) = *(const u32x4*)(Fg + F.tid * 8);
    if (F.tid >= 64 && F.tid < 68) { const unsigned z = zero_u32(); *(LAS u32x4*)(L + 1024 + (F.tid - 64) * 16) = (u32x4){z, z, z, z}; }
    { const int b = F.tid >> 5, x = F.tid & 31; *(LAS u32x4*)(L + VOFF + b * VPIT + x * 16) = *(const u32x4*)(Vg + (size_t)b * CTX + x * 8); }
    __syncthreads();
    for (int i = F.tid; i < 7 * 256; i += NTHR) { const int rho = 1 + i / 256, x2 = (i % 256) * 2; const int s0 = x2 + rho, s1 = x2 + 1 + rho;
        const unsigned e0 = s0 < 512 ? *(const LAS bf16_t*)(L + s0 * 2) : 0, e1 = s1 < 512 ? *(const LAS bf16_t*)(L + s1 * 2) : 0;
        *(LAS unsigned*)(L + rho * FREP + x2 * 2) = e0 | (e1 << 16); }
    __syncthreads();
    const int i16 = F.lane & 15, q4 = F.lane >> 4, w = F.wave;
    const int base0 = 255 - 32 * w - i16 + 8 * q4, rho = base0 & 7;
    LAS unsigned char* Ap = L + rho * FREP + (base0 - rho) * 2;
    LAS unsigned char* Bp = L + VOFF + i16 * VPIT + q4 * 16;
    f32x4 acc0 = (f32x4){0.f, 0.f, 0.f, 0.f}, acc1 = acc0;
#pragma unroll
    for (int st = 0; st < 8; ++st) { const bf16x8 Bf = *(const LAS bf16x8*)(Bp + 64 * st);
        const bf16x8 A0 = *(const LAS bf16x8*)(Ap + 64 * st), A1 = *(const LAS bf16x8*)(Ap + 64 * st - 32);
        acc0 = MFMA16(A0, Bf, acc0); acc1 = MFMA16(A1, Bf, acc1); }
    u32x2 wv; wv.x = cvtpk(acc0.x, acc0.y); wv.y = cvtpk(acc0.z, acc0.w); *(u32x2*)(Yg + (size_t)i16 * CTX + 32 * w + 4 * q4) = wv;
    wv.x = cvtpk(acc1.x, acc1.y); wv.y = cvtpk(acc1.z, acc1.w); *(u32x2*)(Yg + (size_t)i16 * CTX + 32 * w + 16 + 4 * q4) = wv;
}

__device__ __forceinline__ void mixer_phase(const Fr& F, const Args& a, int l, bool with_ctx, unsigned long long& sacc, const int swhich) {
#if defined(PROBE_P)
    unsigned long long st0 = __builtin_amdgcn_s_memrealtime();
#define SUBMARK(w) do { const unsigned long long t_ = __builtin_amdgcn_s_memrealtime(); if (swhich == (w)) sacc += t_ - st0; st0 = t_; } while (0)
#else
#define SUBMARK(w) do { } while (0)
#endif
    const bf16_t* QA = (const bf16_t*)(a.ws + WS_QA);
    unsigned char* Y8 = a.ws + WS_Y8;
    const bf16_t* KA = (const bf16_t*)(a.ws + WS_KA); const bf16_t* KW = (const bf16_t*)(a.ws + WS_KW);
    const bf16_t* VTA = (const bf16_t*)(a.ws + WS_VTA); const bf16_t* VTW = (const bf16_t*)(a.ws + WS_VTW);
    const float* sinks = a.in[I_SINK] + l * 8; const float* qkg = a.in[I_QKG] + l * 256;
    const float* ct = (const float*)(a.ws + WS_ROPE); const float* st = ct + SEQ * 32;
    const int wq = F.wave >> 1, wh = F.wave & 1;
    const int ubid = (F.G % 8 == 0) ? (F.bid & 7) * (F.G >> 3) + (F.bid >> 3) : F.bid;
#define RELANE(FX) do { int t_ = F.wave * 64 + lane_id(); asm volatile("" : "+v"(t_)); FX.tid = t_; FX.lane = t_ & 63; } while (0)
    Fr FA = F; RELANE(FA);
    const int nctx = with_ctx ? NB * 2 * 4 : 0;
#define AT_QO(u_, xo_) ((size_t)((((u_) >= NB * 2 * 32) ? TL + (((u_) - NB * 2 * 32) >> 3) * CTX + (((u_) - NB * 2 * 32) & 3) * 64 : ((u_) >> 6) * SEQ + ((u_) & 31) * 64) + wh * 32) * 1536 \
                        + (((((u_) >= NB * 2 * 32) ? (((u_) - NB * 2 * 32) >> 2) : ((u_) >> 5)) & 1) * 4 + wq) * 64 + (xo_))
#define AT_QLOAD(dst, u_, xo_) do { const bf16_t* qp_ = QA + AT_QO(u_, xo_) + (size_t)(FQ.lane & 31) * 1536 + 8 * (FQ.lane >> 5); _Pragma("unroll") for (int kk = 0; kk < 4; ++kk) dst[kk] = *(const u32x4*)(qp_ + 16 * kk); } while (0)
    u32x4 qwA[4];
    { const Fr& FQ = FA; if (ubid < NB * 2 * 32 + nctx) AT_QLOAD(qwA, ubid, 0); }
    for (int unit = ubid; unit < NB * 2 * 32 + nctx; unit += F.G) {
        const bool isc = unit >= NB * 2 * 32; const int u2 = unit - NB * 2 * 32;
        const int b = isc ? u2 >> 3 : unit >> 6, kvh = isc ? (u2 >> 2) & 1 : (unit >> 5) & 1, pb = isc ? u2 & 3 : unit & 31;
        const size_t qo = (size_t)((isc ? TL + b * CTX : b * SEQ) + pb * 64 + wh * 32) * 1536 + (kvh * 4 + wq) * 64;
        const int nu = unit + F.G; const bf16_t* Qn = (nu < NB * 2 * 32 + nctx) ? QA + AT_QO(nu, 0) : nullptr;
        attn_unit<false>(FA, qwA, Qn, Y8 + qo, KA + (size_t)b * KEYS * 128 + kvh * 64, VTA + (size_t)(b * 2 + kvh) * 64 * KEYS, 0, isc ? 2 : KEYS / 128, 0, 0, isc ? 0 : pb * 64 + wh * 32, false, 0.f, qkg, !isc, ct, st);
    }
    SUBMARK(30);
    Fr FW = F; RELANE(FW);
    u32x4 qwW[4];
    { const Fr& FQ = FW; if (ubid < NB * 2 * 32 + nctx) AT_QLOAD(qwW, ubid, 1024); }
    for (int unit = ubid; unit < NB * 2 * 32 + nctx; unit += F.G) {
        const bool isc = unit >= NB * 2 * 32; const int u2 = unit - NB * 2 * 32;
        const int b = isc ? u2 >> 3 : unit >> 6, kvh = isc ? (u2 >> 2) & 1 : (unit >> 5) & 1, pb = isc ? u2 & 3 : unit & 31;
        const size_t qo = (size_t)((isc ? TL + b * CTX : b * SEQ) + pb * 64 + wh * 32) * 1536 + (kvh * 4 + wq) * 64 + 1024;
        const int nu = unit + F.G; const bf16_t* Qn = (nu < NB * 2 * 32 + nctx) ? QA + AT_QO(nu, 1024) : nullptr;
        const int lo = pb < 2 ? 0 : (pb - 2) >> 1, hi = ((64 * pb + 191) >> 7) > 15 ? 15 : ((64 * pb + 191) >> 7);
        attn_unit<true>(FW, qwW, Qn, Y8 + qo, KW + (size_t)b * KEYS * 128 + kvh * 64, VTW + (size_t)(b * 2 + kvh) * 64 * KEYS, 0, 2, isc ? 0 : 2 + lo, isc ? 0 : hi - lo + 1, isc ? 0 : pb * 64 + wh * 32, true, sinks[kvh * 4 + wq] * LOG2E, qkg + 128, !isc, ct, st);
    }
#undef AT_QO
#undef AT_QLOAD
    SUBMARK(31);
    SUBMARK(32);
    const bf16_t* FL = (const bf16_t*)(a.ws + WS_FL) + (size_t)l * 512 * 4096; const bf16_t* FC = (const bf16_t*)(a.ws + WS_FC) + (size_t)l * 512 * 512;
    const bf16_t* VT = (const bf16_t*)(a.ws + WS_VT); bf16_t* YT = (bf16_t*)(a.ws + WS_YT);
    Fr FH = F; RELANE(FH);
    for (int c = F.bid; c < HYW; c += F.G) hyena_unit_lat(FH, FL + (size_t)c * 4096, VT + (size_t)c * NB * SEQ, YT + (size_t)c * NB * SEQ);
    if (with_ctx) for (int c = F.bid; c < HYW; c += F.G) hyena_unit_ctx(FH, FC + (size_t)c * 512, VT + VT_CTX_OFF + (size_t)c * NB * CTX, YT + VT_CTX_OFF + (size_t)c * NB * CTX);
    __syncthreads();
    SUBMARK(33);
#undef SUBMARK
#undef RELANE
}

__device__ __forceinline__ float gate_q(float x) { return fminf(256.f * sigmoid_f(x), 255.49f); }
__device__ __forceinline__ unsigned pack_u8x4(float a, float b, float c, float d) { return (unsigned)(int)a | ((unsigned)(int)b << 8) | ((unsigned)(int)c << 16) | ((unsigned)(int)d << 24); }
__device__ __forceinline__ float gq(unsigned w, int k) { return (float)((w >> (8 * k)) & 0xffu) + 0.5f; }
__device__ __forceinline__ size_t gate_tile_off(int b, int pm, int pn, int wid) { return ((size_t)((b * (TT / 256) + pm) * 4 + pn) * 8 + wid) * 8192; }
struct EpiInProj {
    static constexpr bool PERM = true, AFTER_DRAIN = false; static constexpr int NSEG = 1;
    unsigned char* ws; int pn_off;
    __device__ __forceinline__ void operator()(const pg8::f32x4 (&acc)[2][2][4][2], const pg8::Unit& u, int wr, int wc, int fr, int fq) const {
        asm volatile("" : "+v"(fr), "+v"(fq));
        const int pn = __builtin_amdgcn_readfirstlane(u.pn) + pn_off; unsigned long long boff; int ldc, colt; bool sig = false;
        if (pn < 2) { boff = WS_QA; ldc = 1536; colt = pn * 256; }
        else if (pn == 2) { boff = WS_RAWA; ldc = 256; colt = 0; }
        else if (pn < 9) { boff = WS_U; ldc = 1536; colt = (pn - 3) * 256; }
        else if (pn < 11) { boff = WS_QA; ldc = 1536; colt = 1024 + (pn - 9) * 256; }
        else if (pn == 11) { boff = WS_RAWW; ldc = 256; colt = 0; }
        else { boff = WS_G; ldc = 3072; colt = (pn - 12) * 256; sig = true; }
        bf16_t* base = (bf16_t*)(ws + boff); unsigned char* Gt = ws + boff;
        const int row0 = u.pm * 256 + wr * 64 + fr, col0 = colt + wc * 32 + 8 * fq;
        if (sig) {
            unsigned char* tb = Gt + gate_tile_off((pn - 12) >> 2, u.pm, (pn - 12) & 3, wr * 4 + wc) + (fq * 16 + fr) * 16;
#pragma unroll
            for (int ai = 0; ai < 2; ++ai)
#pragma unroll
                for (int m = 0; m < 4; ++m) { u32x4 w;
                    { const pg8::f32x4 v0 = acc[ai][0][m][0], v1 = acc[ai][0][m][1]; w.x = pack_u8x4(gate_q(v0.x), gate_q(v0.y), gate_q(v0.z), gate_q(v0.w)); w.y = pack_u8x4(gate_q(v1.x), gate_q(v1.y), gate_q(v1.z), gate_q(v1.w)); }
                    { const pg8::f32x4 v0 = acc[ai][1][m][0], v1 = acc[ai][1][m][1]; w.z = pack_u8x4(gate_q(v0.x), gate_q(v0.y), gate_q(v0.z), gate_q(v0.w)); w.w = pack_u8x4(gate_q(v1.x), gate_q(v1.y), gate_q(v1.z), gate_q(v1.w)); }
                    __builtin_nontemporal_store(w, (u32x4*)(tb + (ai * 4 + m) * 1024)); }
            return;
        }
#pragma unroll
        for (int ai = 0; ai < 2; ++ai)
#pragma unroll
            for (int m = 0; m < 4; ++m) { bf16_t* rowp = base + (size_t)(row0 + ai * 128 + m * 16) * ldc + col0;
#pragma unroll
                for (int bj = 0; bj < 2; ++bj) { const pg8::f32x4 v0 = acc[ai][bj][m][0], v1 = acc[ai][bj][m][1];
                    u32x4 w; w.x = cvtpk(v0.x, v0.y); w.y = cvtpk(v0.z, v0.w); w.z = cvtpk(v1.x, v1.y); w.w = cvtpk(v1.z, v1.w);
                    *(u32x4*)(rowp + bj * 128) = w; } }
    }
};
struct EpiGate {
    static constexpr bool PERM = true, AFTER_DRAIN = false; static constexpr int NSEG = 1;
    unsigned char* Gt;
    __device__ __forceinline__ void operator()(const pg8::f32x4 (&acc)[2][2][4][2], const pg8::Unit& u, int wr, int wc, int fr, int fq) const {
        asm volatile("" : "+v"(fr), "+v"(fq));
        const int row0 = u.pm * 256 + wr * 64 + fr, col0 = u.pn * 256 + wc * 32 + 8 * fq;
#pragma unroll
        for (int ai = 0; ai < 2; ++ai)
#pragma unroll
            for (int m = 0; m < 4; ++m) { unsigned char* rowp = Gt + (size_t)(row0 + ai * 128 + m * 16) * 3072 + col0;
#pragma unroll
                for (int bj = 0; bj < 2; ++bj) { const pg8::f32x4 v0 = acc[ai][bj][m][0], v1 = acc[ai][bj][m][1];
                    u32x2 w; w.x = pack_u8x4(gate_q(v0.x), gate_q(v0.y), gate_q(v0.z), gate_q(v0.w)); w.y = pack_u8x4(gate_q(v1.x), gate_q(v1.y), gate_q(v1.z), gate_q(v1.w));
                    *(u32x2*)(rowp + bj * 128) = w; } }
    }
};
struct EpiMerge {
    static constexpr bool PERM = true, AFTER_DRAIN = false; static constexpr int NSEG = 3;
    unsigned char* Mo; const unsigned char* Gt;
    __device__ __forceinline__ void rescale(pg8::f32x4 (&acc)[2][2][4][2], const pg8::Unit& u, int seg, int wr, int wc, int fr, int fq) const {
        asm volatile("" : "+v"(fr), "+v"(fq));
        const int row0 = u.pm * 256 + wr * 64 + fr, col0 = u.pn * 256 + wc * 32 + 8 * fq;
        const unsigned char* G0 = Gt + gate_tile_off(seg, u.pm, u.pn, wr * 4 + wc) + (fq * 16 + fr) * 16;
        const unsigned char* G1 = G0 + gate_tile_off(1, 0, 0, 0);
        u32x4 ga[2][4], gb[2][4];
#pragma unroll
        for (int ai = 0; ai < 2; ++ai)
#pragma unroll
            for (int m = 0; m < 4; ++m) { ga[ai][m] = __builtin_nontemporal_load((const u32x4*)(G0 + (ai * 4 + m) * 1024)); gb[ai][m] = *(const u32x4*)(G1 + (ai * 4 + m) * 1024); }
        __builtin_amdgcn_sched_barrier(0);
#pragma unroll
        for (int ai = 0; ai < 2; ++ai)
#pragma unroll
            for (int m = 0; m < 4; ++m)
#pragma unroll
                for (int bj = 0; bj < 2; ++bj) { u32x2 a, b; a.x = bj ? ga[ai][m].z : ga[ai][m].x; a.y = bj ? ga[ai][m].w : ga[ai][m].y; b.x = bj ? gb[ai][m].z : gb[ai][m].x; b.y = bj ? gb[ai][m].w : gb[ai][m].y;
                    pg8::f32x4& v0 = acc[ai][bj][m][0]; pg8::f32x4& v1 = acc[ai][bj][m][1];
                    v0.x *= gq(a.x, 0) * fast_rcp(gq(b.x, 0)); v0.y *= gq(a.x, 1) * fast_rcp(gq(b.x, 1)); v0.z *= gq(a.x, 2) * fast_rcp(gq(b.x, 2)); v0.w *= gq(a.x, 3) * fast_rcp(gq(b.x, 3));
                    v1.x *= gq(a.y, 0) * fast_rcp(gq(b.y, 0)); v1.y *= gq(a.y, 1) * fast_rcp(gq(b.y, 1)); v1.z *= gq(a.y, 2) * fast_rcp(gq(b.y, 2)); v1.w *= gq(a.y, 3) * fast_rcp(gq(b.y, 3)); }
        __builtin_amdgcn_sched_barrier(0);
    }
    __device__ __forceinline__ void operator()(const pg8::f32x4 (&acc)[2][2][4][2], const pg8::Unit& u, int wr, int wc, int fr, int fq) const {
        asm volatile("" : "+v"(fr), "+v"(fq));
        const int row0 = u.pm * 256 + wr * 64 + fr, col0 = u.pn * 256 + wc * 32 + 8 * fq;
        constexpr float S = 16.f / 256.f;
        const unsigned char* G2 = Gt + gate_tile_off(2, u.pm, u.pn, wr * 4 + wc) + (fq * 16 + fr) * 16;
        u32x4 gv4[2][4];
#pragma unroll
        for (int ai = 0; ai < 2; ++ai)
#pragma unroll
            for (int m = 0; m < 4; ++m) gv4[ai][m] = __builtin_nontemporal_load((const u32x4*)(G2 + (ai * 4 + m) * 1024));
        __builtin_amdgcn_sched_barrier(0);
#pragma unroll
        for (int ai = 0; ai < 2; ++ai) {
#pragma unroll
            for (int m = 0; m < 4; ++m)
#pragma unroll
                for (int bj = 0; bj < 2; ++bj) { const pg8::f32x4 v0 = acc[ai][bj][m][0], v1 = acc[ai][bj][m][1]; u32x2 g; g.x = bj ? gv4[ai][m].z : gv4[ai][m].x; g.y = bj ? gv4[ai][m].w : gv4[ai][m].y;
                    u32x2 w; w.x = cvt4_fp8c(v0.x * (gq(g.x, 0) * S), v0.y * (gq(g.x, 1) * S), v0.z * (gq(g.x, 2) * S), v0.w * (gq(g.x, 3) * S));
                    w.y = cvt4_fp8c(v1.x * (gq(g.y, 0) * S), v1.y * (gq(g.y, 1) * S), v1.z * (gq(g.y, 2) * S), v1.w * (gq(g.y, 3) * S));
                    *(u32x2*)(Mo + (size_t)(row0 + ai * 128 + m * 16) * 1024 + col0 + bj * 128) = w; }
            __builtin_amdgcn_sched_barrier(0);
        }
    }
};
struct EpiOut {
    static constexpr bool PERM = true, AFTER_DRAIN = false; static constexpr int NSEG = 1;
    bf16_t* XB; const float* MODl;
    __device__ __forceinline__ void operator()(const pg8::f32x4 (&acc)[2][2][4][2], const pg8::Unit& u, int wr, int wc, int fr, int fq) const {
        asm volatile("" : "+v"(fr), "+v"(fq));
        const int trow = u.pm * 256;
        const int row0 = trow + wr * 64 + fr, col0 = u.pn * 256 + wc * 32 + 8 * fq;
        const float* md = MODl + (size_t)mod_row(trow) * DIN + 2 * 1024 + col0;
        bf16_t* xp = XB + (size_t)row0 * D + col0;
        f32x4 mv[2][2];
#pragma unroll
        for (int bj = 0; bj < 2; ++bj)
#pragma unroll
            for (int n = 0; n < 2; ++n) mv[bj][n] = *(const f32x4*)(md + bj * 128 + 4 * n);
#pragma unroll
        for (int ai = 0; ai < 2; ++ai) {
            u32x4 xv[4][2];
#pragma unroll
            for (int m = 0; m < 4; ++m)
#pragma unroll
                for (int bj = 0; bj < 2; ++bj) xv[m][bj] = *(const u32x4*)(xp + (size_t)(ai * 128 + m * 16) * D + bj * 128);
            __builtin_amdgcn_sched_barrier(0);
#pragma unroll
            for (int m = 0; m < 4; ++m)
#pragma unroll
                for (int bj = 0; bj < 2; ++bj) { const pg8::f32x4 a0 = acc[ai][bj][m][0], a1 = acc[ai][bj][m][1]; const u32x4 x8 = xv[m][bj]; const f32x4 m0 = mv[bj][0], m1 = mv[bj][1];
                    u32x4 o; o.x = cvtpk(fmaf(m0.x, a0.x, bflo(x8.x)), fmaf(m0.y, a0.y, bfhi(x8.x))); o.y = cvtpk(fmaf(m0.z, a0.z, bflo(x8.y)), fmaf(m0.w, a0.w, bfhi(x8.y)));
                    o.z = cvtpk(fmaf(m1.x, a1.x, bflo(x8.z)), fmaf(m1.y, a1.y, bfhi(x8.z))); o.w = cvtpk(fmaf(m1.z, a1.z, bflo(x8.w)), fmaf(m1.w, a1.w, bfhi(x8.w)));
                    *(u32x4*)(xp + (size_t)(ai * 128 + m * 16) * D + bj * 128) = o; }
            __builtin_amdgcn_sched_barrier(0);
        }
    }
};
struct EpiMoe1 {
    static constexpr bool PERM = true, AFTER_DRAIN = false; static constexpr int NSEG = 1;
    unsigned char* HM;
    __device__ __forceinline__ void operator()(const pg8::f32x4 (&acc)[2][2][4][2], const pg8::Unit& u, int wr, int wc, int fr, int fq) const {
        asm volatile("" : "+v"(fr), "+v"(fq));
        const int row0 = u.pm * 256 + wr * 64 + fr, hcol0 = (u.pn & 3) * 128 + wc * 16 + 4 * fq;
#pragma unroll
        for (int ai = 0; ai < 2; ++ai)
#pragma unroll
            for (int m = 0; m < 4; ++m) { unsigned char* rowp = HM + (size_t)(row0 + ai * 128 + m * 16) * 512 + hcol0;
#pragma unroll
                for (int bj = 0; bj < 2; ++bj) { const pg8::f32x4 x = acc[ai][bj][m][0], y = acc[ai][bj][m][1] * 4.f;
                    *(unsigned*)(rowp + bj * 64) = cvt4_fp8c(x.x * sigmoid_f(x.x) * y.x, x.y * sigmoid_f(x.y) * y.y, x.z * sigmoid_f(x.z) * y.z, x.w * sigmoid_f(x.w) * y.w); } }
    }
};
struct EpiMoe2 {
    static constexpr bool PERM = true, AFTER_DRAIN = false; static constexpr int NSEG = 1;
    unsigned char* Fo; const int* erow; const float* eroww; const LAS int* ebase; const LAS int* ecnt;
    __device__ __forceinline__ void operator()(const pg8::f32x4 (&acc)[2][2][4][2], const pg8::Unit& u, int wr, int wc, int fr, int fq) const {
        asm volatile("" : "+v"(fr), "+v"(fq));
        const int e = u.pn >> 2, cnt = __builtin_amdgcn_readfirstlane(ecnt[e]), pos0 = u.pm * 256 - __builtin_amdgcn_readfirstlane(ebase[e]) + wr * 64 + fr, col0 = (u.pn & 3) * 256 + wc * 32 + 8 * fq;
        const int* er = erow + (size_t)e * TT; const float* ew = eroww + (size_t)e * TT;
        int rma[2][4]; float wga[2][4];
#pragma unroll
        for (int ai = 0; ai < 2; ++ai)
#pragma unroll
            for (int m = 0; m < 4; ++m) { const int pos = pos0 + ai * 128 + m * 16; const bool ok = pos < cnt; rma[ai][m] = ok ? er[ok ? pos : 0] : -1; wga[ai][m] = ew[ok ? pos : 0]; }
        __builtin_amdgcn_sched_barrier(0);
#pragma unroll
        for (int ai = 0; ai < 2; ++ai) {
#pragma unroll
            for (int m = 0; m < 4; ++m) { const int r1 = rma[ai][m];
                if (r1 >= 0) { const float wgt = wga[ai][m] * 32.f; unsigned char* rowp = Fo + ((size_t)(r1 & 1) * TT + (r1 >> 1)) * D + col0;
#pragma unroll
                    for (int bj = 0; bj < 2; ++bj) { const pg8::f32x4 v0 = acc[ai][bj][m][0], v1 = acc[ai][bj][m][1];
                        u32x2 w; w.x = cvt4_fp8c(v0.x * wgt, v0.y * wgt, v0.z * wgt, v0.w * wgt); w.y = cvt4_fp8c(v1.x * wgt, v1.y * wgt, v1.z * wgt, v1.w * wgt);
                        *(u32x2*)(rowp + bj * 128) = w; } } }
            __builtin_amdgcn_sched_barrier(0);
        }
    }
};
struct FusedOutOrder {
    int c, G, nun, wv; const unsigned* ready; unsigned* tmo;
    __device__ __forceinline__ bool next(int i, pg8::Unit& u) const {
        int q;
        if (!ready) { q = i * G + c; if (q >= nun) return false; }
        else if (G == 256 && nun == 576) { if (c < 64) { if (i > 0) return false; q = 512 + c; } else { q = i * 192 + (c - 64); if (q >= 512) return false; } }
        else { q = i * G + (G - 1 - c); if (q >= nun) return false; }
        u.pm = q >> 2; u.pn = q & 3; return true; }
    __device__ __forceinline__ void a_ready(const pg8::Unit& u) const {
        if (!ready) return;
        if (wv == 0) {
            const unsigned long long t0 = __builtin_amdgcn_s_memrealtime(); unsigned polls = 0;
            while ((unsigned)__builtin_amdgcn_readfirstlane(__hip_atomic_load(ready + 64 * u.pm, __ATOMIC_RELAXED, __HIP_MEMORY_SCOPE_AGENT)) < 32u) {
                if ((++polls & 255u) == 0u && __builtin_amdgcn_readfirstlane(__hip_atomic_load(tmo, __ATOMIC_RELAXED, __HIP_MEMORY_SCOPE_AGENT)) != 0u) break;
                if (__builtin_amdgcn_s_memrealtime() - t0 > 20000000ull) { if (lane_id() == 0) __hip_atomic_store(tmo, 1u, __ATOMIC_RELAXED, __HIP_MEMORY_SCOPE_AGENT); break; }
                __builtin_amdgcn_s_sleep(2); }
            __builtin_amdgcn_fence(__ATOMIC_ACQUIRE, "agent");
            asm volatile("s_waitcnt vmcnt(0)" ::: "memory");
        }
        asm volatile("" ::: "memory"); __builtin_amdgcn_s_barrier(); asm volatile("" ::: "memory");
    }
    __device__ __forceinline__ void done(const pg8::Unit&) const {}
};
struct LastInProjOrder {
    pg8::StaticOrder T; int nlat, G, c;
    __device__ __forceinline__ bool next(int i, pg8::Unit& u) const {
        const int L = i * G + c;
        if (L < nlat) return T.next(i, u);
        const int r = L - nlat; if (r >= 32) return false;
        u.pm = 128 + (r >> 1); u.pn = (r & 1) ? 11 : 2; return true; }
    __device__ __forceinline__ void a_ready(const pg8::Unit&) const {}
    __device__ __forceinline__ void done(const pg8::Unit&) const {}
};
struct MoeOrder {
    int nunits, G, c; const LAS int* tile_e;
    __device__ __forceinline__ bool next(int i, pg8::Unit& u) const {
        const int L0 = i * G + c; if (L0 >= nunits) return false;
        const int q = nunits / 8, r = nunits % 8, xcd = L0 % 8, off = L0 / 8; const int L = (xcd < r ? xcd * (q + 1) : r * (q + 1) + (xcd - r) * q) + off;
        const int pm = L >> 2; u.pm = pm; u.pn = __builtin_amdgcn_readfirstlane(tile_e[pm]) * 4 + (L & 3); return true; }
    __device__ __forceinline__ void a_ready(const pg8::Unit&) const {}
    __device__ __forceinline__ void done(const pg8::Unit&) const {}
};

__device__ __forceinline__ int moe_tables(const Fr& F, const Args& a, int l, LAS int* ebase  , LAS int* ecnt  , LAS int* tile_e  ) {
    const unsigned* CNT = (const unsigned*)(a.ws + WS_CTL) + CW_CNT + l * 256;
    __syncthreads();
    if (F.tid < NE) ecnt[F.tid] = (int)__hip_atomic_load(&CNT[F.tid * 16], __ATOMIC_RELAXED, __HIP_MEMORY_SCOPE_AGENT);
    __syncthreads();
    if (F.tid == 0) { int acc = 0;
#pragma unroll 1
        for (int e = 0; e < NE; ++e) { ebase[e] = acc; acc += ((ecnt[e] + 255) >> 8) << 8; }
        ebase[NE] = acc; }
    __syncthreads();
    const int ntile = ebase[NE] >> 8;
    for (int t = F.tid; t < ntile; t += NTHR) { int e = 0;
#pragma unroll 1
        for (int q = 1; q < NE; ++q) if (ebase[q] <= (t << 8)) e = q;
        tile_e[t] = e; }
    __syncthreads();
    return ntile;
}

__device__ __forceinline__ void moe_gather_table(const Fr& F, const Args& a, const MoeOrder& S, const LAS int* ebase, const LAS int* ecnt, LAS int* gidx) {
    const int* EROW = (const int*)(a.ws + WS_EROW);
    int gv[8];
#pragma unroll
    for (int j = 0; j < 8; ++j) { pg8::Unit u; gv[j] = 0;
        if (S.next(j, u) && F.tid < 256) { const int e = u.pn >> 2, pos = u.pm * 256 - ebase[e] + F.tid; if (pos < ecnt[e]) gv[j] = EROW[(size_t)e * TT + pos] >> 1; } }
#pragma unroll
    for (int j = 0; j < 8; ++j) { pg8::Unit u; if (S.next(j, u) && F.tid < 256) gidx[j * 256 + F.tid] = gv[j]; }
    for (int j = 8; j < 16; ++j) { pg8::Unit u; if (!S.next(j, u)) break;
        const int e = u.pn >> 2, pos0 = u.pm * 256 - ebase[e], cnt = ecnt[e];
        if (F.tid < 256) { const int pos = pos0 + F.tid; gidx[j * 256 + F.tid] = pos < cnt ? (EROW[(size_t)e * TT + pos] >> 1) : 0; } }
    __syncthreads();
}

#ifndef MK_PER_PHASE
#define MK_PER_PHASE 0
#endif
constexpr int PH_PER_LAYER = 10, PH_FINAL = 1 + NL * PH_PER_LAYER, N_PHASES = PH_FINAL + 1;

__global__ void __launch_bounds__(NTHR, 2) trunk_fwd(Args args) {
    extern __shared__ __attribute__((aligned(16))) unsigned char lds[];
    Fr F; F.lds = (LAS unsigned char*)lds; F.tid = threadIdx.x; F.lane = F.tid & 63; F.wave = __builtin_amdgcn_readfirstlane(F.tid >> 6); F.G = gridDim.x; F.bid = blockIdx.x;
    const int wave0 = F.wave;
    for (int u = F.tid; u < (LDS_BYTES - MISC_OFF) / 4; u += NTHR) ((LAS unsigned*)(F.lds + MISC_OFF))[u] = 0u;
    __syncthreads();
    const int lo = args.ph_lo, hi = args.ph_hi;
    unsigned* ctl = (unsigned*)(args.ws + WS_CTL);
    XcdBarrier bar; bar.bar = ctl + CW_BAR; bar.x = 0; bar.st = (volatile LAS unsigned*)(F.lds + MISC_OFF);
    if (hi - lo > 1) bar = xcd_barrier_post(ctl + CW_BAR, (volatile LAS unsigned*)(F.lds + MISC_OFF));
    bar.wv = (unsigned)wave0;
#ifndef DBG_ONLY
#define DBG_ONLY -1
#endif
#define SEL(p) (DBG_ONLY < 0 || DBG_ONLY == (p))
#define IN(k) (lo <= (k) && (k) < hi)
#define FRESH() do { int t_ = wave0 * 64 + lane_id(); asm volatile("" : "+v"(t_)); F.tid = t_; F.lane = t_ & 63; F.wave = wave0; } while (0)
#define SEAM(k) do { if (IN(k) && IN((k) + 1)) xcd_barrier(bar); } while (0)
#if !defined(PROBE_SUB)
#define PROBE_SUB -1
#endif
    unsigned long long pr_sub = 0ull;
#if defined(PROBE_P)
    unsigned long long pr_acc = 0ull, pr_t0 = __builtin_amdgcn_s_memrealtime();
#define PR_MARK(p) do { const unsigned long long t_ = __builtin_amdgcn_s_memrealtime(); if ((p) == PROBE_P) pr_acc += t_ - pr_t0; pr_t0 = t_; } while (0)
#else
#define PR_MARK(p) do { } while (0)
#endif
    unsigned char* ws = args.ws;
    LAS int* ebase = (LAS int*)(F.lds + MISC_OFF + 64); LAS int* ecnt = ebase + 20; LAS int* tile_e = (LAS int*)(F.lds + MISC_OFF + 512);

    #ifndef DBG_PRO
#define DBG_PRO 7
#endif
#if defined(PROBE_P)
    if (SEL(100) && IN(0)) { FRESH(); const unsigned long long tq0_ = __builtin_amdgcn_s_memrealtime(); pro_mod(F, args); __syncthreads(); const unsigned long long tq1_ = __builtin_amdgcn_s_memrealtime(); pro_rope(F, args); pro_filter(F, args); __syncthreads();
        const unsigned long long tq2_ = __builtin_amdgcn_s_memrealtime(); if (PROBE_SUB == 60) pr_sub += tq1_ - tq0_; if (PROBE_SUB == 61) pr_sub += tq2_ - tq1_; }
#else
    if (SEL(100) && IN(0)) { FRESH(); if (DBG_PRO & 1) pro_mod(F, args); __syncthreads(); if (DBG_PRO & 2) pro_rope(F, args); if (DBG_PRO & 4) pro_filter(F, args); __syncthreads(); }
#endif
    SEAM(0); PR_MARK(100);
    for (int l = 0; l < NL; ++l) {
        const int pb = 1 + PH_PER_LAYER * l;
#define LVARS() int lq_ = l; asm volatile("" : "+s"(lq_)); const bool uc = lq_ < NL - 1; const int M2 = uc ? TT : TL; (void)M2; (void)uc
        if (SEL(0) && IN(pb + 0)) { LVARS(); FRESH(); if (l == 0) { filter_norm_reduce(F, args); FRESH(); } conv_small_weights(F, args, l, l == 0 ? 7 : 4, 0); rows_p0(F, args, l, TT); __syncthreads(); }
        SEAM(pb + 0); PR_MARK(0);
        if (SEL(1) && IN(pb + 1)) { LVARS();
            pg8::Gemm g{(const bf16_t*)(ws + WS_H8), (const bf16_t*)(ws + WS_WG8), TT, DIN, 512}; EpiInProj E{ws, 0};
            if (uc) { pg8::StaticOrder S; S.init(TT, DIN, F.G, F.bid); pg8::gemm_phase<EpiInProj, pg8::StaticOrder, true, true, false, true, -6>(F.lds, g, S, E, wave0); }
            else { LastInProjOrder S; S.T.init(TL, DIN, F.G, F.bid); S.nlat = (TL / 256) * (DIN / 256); S.G = F.G; S.c = F.bid; pg8::gemm_phase<EpiInProj, LastInProjOrder, true, true, false, true, -6>(F.lds, g, S, E, wave0); }
        }
        SEAM(pb + 1); PR_MARK(1);
        if (SEL(2) && IN(pb + 2)) { LVARS(); FRESH(); prep_phase(F, args, l, uc); }
        SEAM(pb + 2); PR_MARK(2);
        if (SEL(3) && IN(pb + 3)) { LVARS(); FRESH(); mixer_phase(F, args, l, uc, pr_sub, PROBE_SUB); }
        SEAM(pb + 3); PR_MARK(3);
        if (SEL(4) && IN(pb + 4)) { LVARS(); FRESH(); hyena_final_phase(F, args, l, uc); }
        SEAM(pb + 4); PR_MARK(4);
        if (SEL(5) && IN(pb + 5)) { LVARS();
            pg8::StaticOrder S; S.init(M2, 1024, F.G, F.bid);
            pg8::Gemm g{(const bf16_t*)(ws + WS_Y8), (const bf16_t*)(ws + WS_WBR), M2, 1024, 768}; EpiMerge E{ws + WS_H, (const unsigned char*)(ws + WS_G)};
            pg8::gemm_phase<EpiMerge, pg8::StaticOrder, true, true, false, true, -10>(F.lds, g, S, E, wave0);
            { FRESH(); __syncthreads(); const int nun = (M2 / 256) * 4, rem = nun % F.G; conv_expert_weights(F, args, l, rem, 0, CONV_E_ITEMS); __syncthreads(); }
        }
        SEAM(pb + 5); PR_MARK(5);
        if (SEL(6) && IN(pb + 6)) { LVARS();
            pg8::Gemm g{(const bf16_t*)(ws + WS_H), (const bf16_t*)(ws + WS_WOUT), M2, 1024, 512}; pg8::StaticOrder S; S.init(M2, 1024, F.G, F.bid);
            EpiOut E{(bf16_t*)(ws + WS_XB), (const float*)(ws + WS_MOD) + (size_t)l * NBM * DIN};
            pg8::gemm_phase<EpiOut, pg8::StaticOrder, true, true, false, true, -10>(F.lds, g, S, E, wave0);
            { FRESH(); __syncthreads(); if (l + 1 < NL) { const int nun = (M2 / 256) * 4, rem = nun % F.G; conv_small_weights(F, args, l + 1, 3, rem); } __syncthreads(); }
        }
        SEAM(pb + 6); PR_MARK(6);
        if (SEL(7) && IN(pb + 7)) { LVARS(); FRESH(); rows_p5(F, args, l, M2, pr_sub, PROBE_SUB); __syncthreads(); }
        SEAM(pb + 7); PR_MARK(7);
        if (SEL(8) && IN(pb + 8)) { LVARS(); FRESH();
            const int ntile = moe_tables(F, args, l, ebase, ecnt, tile_e);
            pg8::Gemm g{(const bf16_t*)(ws + WS_H), (const bf16_t*)(ws + WS_W13), ntile * 256, NE * 1024, 512}; MoeOrder S{ntile * 4, F.G, F.bid, tile_e};
            LAS int* gidx = (LAS int*)(F.lds + 131072);
            moe_gather_table(F, args, S, ebase, ecnt, gidx);
            EpiMoe1 E{ws + WS_U};
            pg8::gemm_phase<EpiMoe1, MoeOrder, true, true, true, true, -6>(F.lds, g, S, E, wave0, gidx);
        }
        SEAM(pb + 8); PR_MARK(8);
        if (SEL(9) && IN(pb + 9)) { LVARS(); FRESH();
            const int ntile = moe_tables(F, args, l, ebase, ecnt, tile_e);
            pg8::Gemm g{(const bf16_t*)(ws + WS_U), (const bf16_t*)(ws + WS_W2), ntile * 256, NE * 1024, 256}; MoeOrder S{ntile * 4, F.G, F.bid, tile_e};
            EpiMoe2 E{ws + WS_F, (const int*)(ws + WS_EROW), (const float*)(ws + WS_EROWW), ebase, ecnt};
            pg8::gemm_phase<EpiMoe2, MoeOrder, true, true, false, true, -8>(F.lds, g, S, E, wave0);
        }
        SEAM(pb + 9); PR_MARK(9);
    }
    if (SEL(101) && IN(PH_FINAL)) { FRESH(); rows_final(F, args); }
#if defined(PROBE_P)
    PR_MARK(101);
    pr_acc += pr_sub;
#if !defined(PROBE_BLK)
#define PROBE_BLK 0
#endif
    if (blockIdx.x == PROBE_BLK && F.wave == 0) { const unsigned long long t1 = __builtin_amdgcn_s_memrealtime() + 4ull * pr_acc; while (__builtin_amdgcn_s_memrealtime() < t1) __builtin_amdgcn_s_sleep(8); }
#endif
#undef IN
#undef SEAM
}

extern "C" void kernel_launch(void* const* d_in, const int* in_sizes, int n_in, void* d_out, int out_size, void* d_ws, size_t ws_size, hipStream_t stream) {
    static int grid = 0;
    if (grid == 0) {
        if (n_in != 29 || in_sizes[0] != TL * D || out_size != TL * D || ws_size < WS_END) { fprintf(stderr, "kernel_launch: unexpected shapes / workspace (n_in %d, ws %zu < %zu); nothing launched\n", n_in, ws_size, (size_t)WS_END); grid = -1; return; }
        int dev = 0, cus = 0, per_cu = 0;
        if (hipGetDevice(&dev) != hipSuccess || hipDeviceGetAttribute(&cus, hipDeviceAttributeMultiprocessorCount, dev) != hipSuccess) { grid = -1; return; }
        if (hipFuncSetAttribute((const void*)trunk_fwd, hipFuncAttributeMaxDynamicSharedMemorySize, LDS_BYTES) != hipSuccess) { fprintf(stderr, "kernel_launch: hipFuncSetAttribute failed\n"); grid = -1; return; }
        if (hipOccupancyMaxActiveBlocksPerMultiprocessor(&per_cu, (const void*)trunk_fwd, NTHR, LDS_BYTES) != hipSuccess || per_cu < 1) { fprintf(stderr, "kernel_launch: occupancy query reports %d\n", per_cu); }
        (void)hipGetLastError();
        grid = cus;
    }
    if (grid < 0) return;
    (void)hipMemsetAsync((char*)d_ws + WS_CTL, 0, CTL_ZERO_BYTES, stream);
    Args a{};
    for (int i = 0; i < 29; ++i) a.in[i] = (const float*)d_in[i];
    a.out = (float*)d_out; a.ws = (unsigned char*)d_ws;
#if MK_PER_PHASE
    for (int k = 0; k < N_PHASES; ++k) { a.ph_lo = k; a.ph_hi = k + 1; hipLaunchKernelGGL(trunk_fwd, dim3(grid), dim3(NTHR), LDS_BYTES, stream, a); }
#else
    a.ph_lo = 0; a.ph_hi = N_PHASES;
    hipLaunchKernelGGL(trunk_fwd, dim3(grid), dim3(NTHR), LDS_BYTES, stream, a);
#endif
}
```
